# Optimizing an MI355X kernel written in HIP

```python
import jax, jax.numpy as jnp
from jax import lax
import numpy as np

D_MODEL = 1024
BATCH = 8
SEQ = 2048
DEPTH = 1

GRID_W = 64
CTX_LEN = 256
EPS = 1e-6
D_RNN = 1024
LRU_HEADS = 8
LRU_BW = D_RNN // LRU_HEADS
CONV_W = 4
CONV_PAD_L = 2
LRU_C = 8.0
HG_HEADS = 8
HG_DK = 128
HG_DV = 128
HG_WIDTH = HG_HEADS * HG_DK
HG_VW = HG_HEADS * HG_DV
CHUNK = 32
SPLITS = (D_RNN, 2 * D_RNN, 2 * D_RNN + HG_WIDTH, 2 * D_RNN + 2 * HG_WIDTH, 2 * D_RNN + 3 * HG_WIDTH,
          2 * D_RNN + 3 * HG_WIDTH + HG_VW, 2 * D_RNN + 3 * HG_WIDTH + 2 * HG_VW,
          2 * D_RNN + 3 * HG_WIDTH + 2 * HG_VW + D_MODEL)
IN_WIDTH = 2 * D_RNN + 3 * HG_WIDTH + 2 * HG_VW + 2 * D_MODEL
N_GROUPS = 4
EXP_PER_GROUP = 8
N_EXPERTS = N_GROUPS * EXP_PER_GROUP
TOP_K = 2
D_EXPERT = 512

kernel_name = "hybrid_rglru_hgrn2_hmoe_dit_block"

F32 = jnp.float32


def rmsnorm(x, g):
    xf = x.astype(F32)
    y = xf * lax.rsqrt(jnp.mean(xf * xf, axis=-1, keepdims=True) + EPS)
    return (y * g.astype(F32)).astype(x.dtype)


def modulate(h, shift, scale):
    return h * (1.0 + scale) + shift


def to_colmajor(t, rows):
    b, L, ch = t.shape
    return t.reshape(b, rows, GRID_W, ch).swapaxes(1, 2).reshape(b, L, ch)


def from_colmajor(t, rows):
    b, L, ch = t.shape
    return t.reshape(b, GRID_W, rows, ch).swapaxes(1, 2).reshape(b, L, ch)


def dwconv_centred(u, w, b):
    L = u.shape[1]
    up = jnp.pad(u, ((0, 0), (CONV_PAD_L, CONV_W - 1 - CONV_PAD_L), (0, 0)))
    return sum(up[:, k:k + L] * w[k] for k in range(CONV_W)) + b


def rglru_coeffs(u, wa, ba, wx, bx, lam):
    bsz, L, _ = u.shape
    uf = u.astype(F32)
    ub = uf.reshape(bsz, L, LRU_HEADS, LRU_BW)
    r = jax.nn.sigmoid(jnp.einsum('blhi,hij->blhj', ub, wa.astype(F32)).reshape(bsz, L, D_RNN) + ba)
    i = jax.nn.sigmoid(jnp.einsum('blhi,hij->blhj', ub, wx.astype(F32)).reshape(bsz, L, D_RNN) + bx)
    log_a = -LRU_C * r * jax.nn.softplus(-lam.astype(F32))
    a = jnp.exp(log_a)
    b = jnp.sqrt(-jnp.expm1(2.0 * log_a)) * (i * uf)
    return a, b


def linear_scan(a, b, h0, reverse):
    idx = -1 if reverse else 0
    b = b.at[:, idx].add(a[:, idx] * h0.astype(F32))

    def combine(l, r):
        return l[0] * r[0], r[0] * l[1] + r[1]

    _, h = lax.associative_scan(combine, (a, b), reverse=reverse, axis=1)
    return h, h[:, idx]


def hgrn2_chunk_scan(q, k, v, logf, s0, with_output):
    bsz, nh, L, _ = q.shape
    n = L // CHUNK

    def blocks(t):
        return t.reshape(bsz, nh, n, CHUNK, t.shape[-1]).transpose(2, 0, 1, 3, 4)

    lc = jnp.cumsum(blocks(logf), axis=3)
    mask = jnp.tril(jnp.ones((CHUNK, CHUNK), dtype=bool))

    def step(s, inp):
        qc, kc, vc, lcc = inp
        ltot = lcc[:, :, -1:, :]
        s_new = jnp.exp(lcc[:, :, -1, :])[..., None] * s + jnp.einsum('bhck,bhcv->bhkv', kc * jnp.exp(ltot - lcc), vc)
        if not with_output:
            return s_new, None
        lmid = lcc[:, :, CHUNK // 2:CHUNK // 2 + 1, :]
        o_inter = jnp.einsum('bhck,bhkv->bhcv', qc * jnp.exp(lcc), s)
        att = jnp.einsum('bhck,bhsk->bhcs', qc * jnp.exp(lcc - lmid), kc * jnp.exp(lmid - lcc))
        att = jnp.where(mask, att, 0.0)
        return s_new, o_inter + jnp.einsum('bhcs,bhsv->bhcv', att, vc)

    s, o = lax.scan(step, s0, (blocks(q), blocks(k), blocks(v), lc))
    if with_output:
        o = o.transpose(1, 2, 0, 3, 4).reshape(bsz, nh, L, -1)
    return o, s


def hgrn2_direction(q, f, v, lb, s0, reverse, with_output):
    bsz, L, _ = q.shape
    g = lb + (1.0 - lb) * jax.nn.sigmoid(f.astype(F32))

    def heads(t):
        t = t.astype(F32).reshape(bsz, L, HG_HEADS, -1).transpose(0, 2, 1, 3)
        return jnp.flip(t, axis=2) if reverse else t

    o, s = hgrn2_chunk_scan(heads(jax.nn.silu(q.astype(F32))), heads(1.0 - g), heads(v), heads(jnp.log(g)),
                            s0, with_output)
    if with_output and reverse:
        o = jnp.flip(o, axis=2)
    return o, s


def head_rmsnorm(o, g):
    o = o * lax.rsqrt(jnp.mean(o * o, axis=-1, keepdims=True) + EPS) * g.astype(F32).reshape(HG_HEADS, 1, HG_DV)
    b, h, L, dv = o.shape
    return o.transpose(0, 2, 1, 3).reshape(b, L, h * dv)


def branch_merge(ya, ay, yb, og, ga, gb, w_proj_a, w_proj_b, w_out):
    dt = ay.dtype
    pa = (ya * jax.nn.gelu(ay.astype(F32))).astype(dt) @ w_proj_a
    pb = (yb * jax.nn.silu(og.astype(F32))).astype(dt) @ w_proj_b
    return (jax.nn.sigmoid(ga) * pa + jax.nn.sigmoid(gb) * pb) @ w_out


def token_mixer(hx, hc, rows, lb, w_in, conv_w, conv_b, lru_wa, lru_ba, lru_wx, lru_bx, lru_lam,
                hg_norm_g, w_proj_a, w_proj_b, w_out, need_ctx):
    bsz = hx.shape[0]
    ax, ayx, qx, ffx, fbx, vx, ogx, gax, gbx = jnp.split(hx @ w_in, SPLITS, axis=-1)
    ac, ayc, qc, ffc, fbc, vc, ogc, gac, gbc = jnp.split(hc @ w_in, SPLITS, axis=-1)

    ux = dwconv_centred(ax, conv_w, conv_b)
    uc = dwconv_centred(ac, conv_w, conv_b)
    h0 = jnp.zeros((bsz, D_RNN), F32)
    ya_x, ya_c = 0.0, 0.0
    for d, rev in enumerate((False, True)):
        a_c, b_c = rglru_coeffs(uc, lru_wa[d], lru_ba[d], lru_wx[d], lru_bx[d], lru_lam[d])
        h_c, s_c = linear_scan(a_c, b_c, h0, rev)
        a_x, b_x = rglru_coeffs(ux, lru_wa[d], lru_ba[d], lru_wx[d], lru_bx[d], lru_lam[d])
        h_x, _ = linear_scan(a_x, b_x, s_c, rev)
        ya_x = ya_x + h_x
        if need_ctx:
            ya_c = ya_c + h_c

    qx_cm, ffx_cm, fbx_cm, vx_cm = (to_colmajor(t, rows) for t in (qx, ffx, fbx, vx))
    s0 = jnp.zeros((bsz, HG_HEADS, HG_DK, HG_DV), F32)
    yb_x, yb_c = 0.0, 0.0
    for rev, f_x, f_c in ((False, ffx_cm, ffc), (True, fbx_cm, fbc)):
        o_c, s_c = hgrn2_direction(qc, f_c, vc, lb, s0, rev, need_ctx)
        o_x, _ = hgrn2_direction(qx_cm, f_x, vx_cm, lb, s_c, rev, True)
        yb_x = yb_x + o_x
        if need_ctx:
            yb_c = yb_c + o_c
    yb_x = from_colmajor(head_rmsnorm(yb_x, hg_norm_g), rows)

    out_x = branch_merge(ya_x, ayx, yb_x, ogx, gax, gbx, w_proj_a, w_proj_b, w_out)
    out_c = None
    if need_ctx:
        out_c = branch_merge(ya_c, ayc, head_rmsnorm(yb_c, hg_norm_g), ogc, gac, gbc, w_proj_a, w_proj_b, w_out)
    return out_x, out_c


def expert_mlp(t, w1, w3, w2):
    return (jax.nn.silu(t @ w1) * (t @ w3)) @ w2


def hier_moe(h, w_rg, b_rg, w_re, b_re, w1, w3, w2):
    shp = h.shape
    t = h.reshape(-1, shp[-1])
    n_tok = t.shape[0]
    tf = t.astype(F32)
    p_grp = jax.nn.softmax(tf @ w_rg.astype(F32) + b_rg, axis=-1)
    pg, gi = lax.top_k(p_grp, 1)
    e_logit = (tf @ w_re.astype(F32) + b_re).reshape(n_tok, N_GROUPS, EXP_PER_GROUP)
    e_sel = jnp.einsum('tge,tg->te', e_logit, jax.nn.one_hot(gi[:, 0], N_GROUPS, dtype=F32))
    pe, ei = lax.top_k(jax.nn.softmax(e_sel, axis=-1), TOP_K)
    wts = pg * pe / jnp.sum(pe, axis=-1, keepdims=True)
    eid = gi * EXP_PER_GROUP + ei
    cw = jnp.einsum('tk,tkn->tn', wts, jax.nn.one_hot(eid, N_EXPERTS, dtype=F32))
    y = jnp.zeros_like(t)
    for e in range(N_EXPERTS):
        y = y + (cw[:, e:e + 1] * expert_mlp(t, w1[e], w3[e], w2[e])).astype(t.dtype)
    return y.reshape(shp)


def setup_inputs(seed: int = 0) -> dict:
    key = jax.random.key(seed)
    ks = jax.random.split(key, 32)

    def nrm(k, shape, scale):
        return jax.random.normal(k, shape, F32) * scale

    u = jax.random.uniform(ks[14], (DEPTH, 2, D_RNN), F32, 0.9, 0.999)
    a0 = u ** (1.0 / LRU_C)
    return {
        "x": nrm(ks[0], (BATCH, SEQ, D_MODEL), 1.0),
        "c": nrm(ks[1], (BATCH, D_MODEL), 1.0),
        "ctx": nrm(ks[2], (BATCH, CTX_LEN, D_MODEL), 1.0),
        "c_ctx": nrm(ks[3], (D_MODEL,), 1.0),
        "w_mod": nrm(ks[4], (DEPTH, D_MODEL, 6 * D_MODEL), 0.5 * D_MODEL ** -0.5),
        "b_mod": nrm(ks[5], (DEPTH, 6 * D_MODEL), 0.02),
        "norm1_g": 1.0 + nrm(ks[6], (DEPTH, D_MODEL), 0.05),
        "w_in": nrm(ks[7], (DEPTH, D_MODEL, IN_WIDTH), D_MODEL ** -0.5),
        "conv_w": nrm(ks[8], (DEPTH, CONV_W, D_RNN), CONV_W ** -0.5),
        "conv_b": nrm(ks[9], (DEPTH, D_RNN), 0.02),
        "lru_wa": nrm(ks[10], (DEPTH, 2, LRU_HEADS, LRU_BW, LRU_BW), LRU_BW ** -0.5),
        "lru_ba": nrm(ks[11], (DEPTH, 2, D_RNN), 0.02),
        "lru_wx": nrm(ks[12], (DEPTH, 2, LRU_HEADS, LRU_BW, LRU_BW), LRU_BW ** -0.5),
        "lru_bx": nrm(ks[13], (DEPTH, 2, D_RNN), 0.02),
        "lru_lam": jnp.log(a0) - jnp.log1p(-a0),
        "hg_lb": nrm(ks[15], (DEPTH + 1, HG_WIDTH), 0.1),
        "hg_norm_g": 1.0 + nrm(ks[16], (DEPTH, HG_VW), 0.05),
        "w_proj_a": nrm(ks[17], (DEPTH, D_RNN, D_MODEL), D_RNN ** -0.5),
        "w_proj_b": nrm(ks[18], (DEPTH, HG_VW, D_MODEL), HG_VW ** -0.5),
        "w_out": nrm(ks[19], (DEPTH, D_MODEL, D_MODEL), D_MODEL ** -0.5),
        "norm2_g": 1.0 + nrm(ks[20], (DEPTH, D_MODEL), 0.05),
        "w_rg": nrm(ks[21], (DEPTH, D_MODEL, N_GROUPS), D_MODEL ** -0.5),
        "b_rg": nrm(ks[22], (DEPTH, N_GROUPS), 0.01),
        "w_re": nrm(ks[23], (DEPTH, D_MODEL, N_EXPERTS), D_MODEL ** -0.5),
        "b_re": nrm(ks[24], (DEPTH, N_EXPERTS), 0.01),
        "w1": nrm(ks[25], (DEPTH, N_EXPERTS, D_MODEL, D_EXPERT), D_MODEL ** -0.5),
        "w3": nrm(ks[26], (DEPTH, N_EXPERTS, D_MODEL, D_EXPERT), D_MODEL ** -0.5),
        "w2": nrm(ks[27], (DEPTH, N_EXPERTS, D_EXPERT, D_MODEL), D_EXPERT ** -0.5),
        "final_g": 1.0 + nrm(ks[28], (D_MODEL,), 0.05),
    }


def reference(x, c, ctx, c_ctx, w_mod, b_mod, norm1_g, w_in, conv_w, conv_b, lru_wa, lru_ba, lru_wx, lru_bx,
              lru_lam, hg_lb, hg_norm_g, w_proj_a, w_proj_b, w_out, norm2_g, w_rg, b_rg, w_re, b_re,
              w1, w3, w2, final_g):
    rows = x.shape[1] // GRID_W
    lb_all = jnp.cumsum(jax.nn.softmax(hg_lb.astype(F32), axis=0), axis=0)
    sc = jax.nn.silu(c)
    scc = jax.nn.silu(c_ctx)
    for l in range(DEPTH):
        need_ctx = l < DEPTH - 1
        mx = jnp.split((sc @ w_mod[l] + b_mod[l])[:, None, :], 6, axis=-1)
        mc = jnp.split(scc @ w_mod[l] + b_mod[l], 6, axis=-1)
        hx = modulate(rmsnorm(x, norm1_g[l]), mx[0], mx[1])
        hc = modulate(rmsnorm(ctx, norm1_g[l]), mc[0], mc[1])
        ox, oc = token_mixer(hx, hc, rows, lb_all[l], w_in[l], conv_w[l], conv_b[l], lru_wa[l], lru_ba[l],
                             lru_wx[l], lru_bx[l], lru_lam[l], hg_norm_g[l], w_proj_a[l], w_proj_b[l],
                             w_out[l], need_ctx)
        x = x + mx[2] * ox
        hx2 = modulate(rmsnorm(x, norm2_g[l]), mx[3], mx[4])
        x = x + mx[5] * hier_moe(hx2, w_rg[l], b_rg[l], w_re[l], b_re[l], w1[l], w3[l], w2[l])
        if need_ctx:
            ctx = ctx + mc[2] * oc
            hc2 = modulate(rmsnorm(ctx, norm2_g[l]), mc[3], mc[4])
            ctx = ctx + mc[5] * hier_moe(hc2, w_rg[l], b_rg[l], w_re[l], b_re[l], w1[l], w3[l], w2[l])
    return rmsnorm(x, final_g)
```

```cpp
#include <hip/hip_runtime.h>
#include <math.h>
#include <stdint.h>

constexpr int DM = 1024, NB = 8, SEQ = 2048, CTX = 256, LT = CTX + SEQ, INW = 9216;
constexpr int NEXP = 32, DEXP = 512, CAP = 16384;
constexpr float EPS = 1e-6f;

__device__ __forceinline__ float sigmoidf_(float x) { return 1.f / (1.f + expf(-x)); }
__device__ __forceinline__ float siluf_(float x) { return x / (1.f + expf(-x)); }
__device__ __forceinline__ float gelu_tanh(float x) { return 0.5f * x * (1.f + tanhf(0.7978845608028654f * (x + 0.044715f * x * x * x))); }

__device__ __forceinline__ float block_sum(float v, float* red) {
    for (int o = 32; o > 0; o >>= 1) v += __shfl_xor(v, o);
    int w = threadIdx.x >> 6, l = threadIdx.x & 63;
    __syncthreads();
    if (l == 0) red[w] = v;
    __syncthreads();
    float s = 0.f;
    for (int i = 0; i < (int)(blockDim.x >> 6); ++i) s += red[i];
    return s;
}

__global__ void k_mod(const float* c, const float* cctx, const float* wmod, const float* bmod, float* mod) {
    __shared__ float s[9][64];
    int j = blockIdx.x * 256 + threadIdx.x;
    float acc[9];
#pragma unroll
    for (int r = 0; r < 9; ++r) acc[r] = 0.f;
    for (int k0 = 0; k0 < DM; k0 += 64) {
        for (int i = threadIdx.x; i < 576; i += 256) { int r = i / 64, k = i % 64; float v = r < 8 ? c[r * DM + k0 + k] : cctx[k0 + k]; s[r][k] = siluf_(v); }
        __syncthreads();
        for (int k = 0; k < 64; ++k) {
            float w = wmod[(size_t)(k0 + k) * 6144 + j];
#pragma unroll
            for (int r = 0; r < 9; ++r) acc[r] += s[r][k] * w;
        }
        __syncthreads();
    }
#pragma unroll
    for (int r = 0; r < 9; ++r) mod[r * 6144 + j] = acc[r] + bmod[j];
}

__global__ void k_lb(const float* hg_lb, float* lb) {
    int j = blockIdx.x * 256 + threadIdx.x;
    if (j < DM) lb[j] = 1.f / (1.f + expf(hg_lb[DM + j] - hg_lb[j]));
}

__global__ void k_norm1(const float* x, const float* ctx, const float* g1, const float* mod, float* Hb, int b) {
    __shared__ float red[4];
    int t = blockIdx.x;
    const float* src = t < CTX ? ctx + ((size_t)b * CTX + t) * DM : x + ((size_t)b * SEQ + (t - CTX)) * DM;
    int mrow = t < CTX ? 8 : b;
    float v[4]; float ss = 0.f;
#pragma unroll
    for (int i = 0; i < 4; ++i) { v[i] = src[threadIdx.x + i * 256]; ss += v[i] * v[i]; }
    float tot = block_sum(ss, red);
    float rstd = rsqrtf(tot / DM + EPS);
#pragma unroll
    for (int i = 0; i < 4; ++i) { int k = threadIdx.x + i * 256;
        Hb[(size_t)t * DM + k] = v[i] * rstd * g1[k] * (1.f + mod[mrow * 6144 + DM + k]) + mod[mrow * 6144 + k]; }
}

template <bool DUAL>
__global__ __launch_bounds__(256) void k_gemm(const float* __restrict__ A, int lda, const float* __restrict__ B, const float* __restrict__ B2, int ldb, size_t bstride,
                                              float* __restrict__ C, int ldc, int M, int N, int K, const int* __restrict__ list, const int* __restrict__ cnt, int a_shift) {
    int e = blockIdx.z;
    int Me = M; const int* lst = nullptr;
    if (list) { Me = cnt[e]; lst = list + (size_t)e * CAP; }
    int row0 = blockIdx.y * 64; if (row0 >= Me) return;
    int col0 = blockIdx.x * 64;
    const float* Be = B + (size_t)e * bstride; const float* B2e = DUAL ? B2 + (size_t)e * bstride : nullptr;
    __shared__ float As[16][68];
    __shared__ float Bs[16][64];
    __shared__ float B2s[DUAL ? 16 : 1][64];
    __shared__ int rowA[64], rowC[64];
    int tid = threadIdx.x;
    if (tid < 64) { int r = row0 + tid; int ra = -1, rc = -1;
        if (r < Me) { if (lst) { int s = lst[r]; ra = a_shift ? (s >> 1) : s; rc = s; } else { ra = r; rc = r; } }
        rowA[tid] = ra; rowC[tid] = rc; }
    __syncthreads();
    int tx = tid & 15, ty = tid >> 4;
    float acc[4][4], acc2[4][4];
#pragma unroll
    for (int i = 0; i < 4; ++i)
#pragma unroll
        for (int j = 0; j < 4; ++j) { acc[i][j] = 0.f; acc2[i][j] = 0.f; }
    for (int k0 = 0; k0 < K; k0 += 16) {
#pragma unroll
        for (int i = 0; i < 4; ++i) { int idx = tid + i * 256; int m = idx >> 4, k = idx & 15; int ra = rowA[m];
            As[k][m] = ra >= 0 ? A[(size_t)ra * lda + k0 + k] : 0.f; }
#pragma unroll
        for (int i = 0; i < 4; ++i) { int idx = tid + i * 256; int k = idx >> 6, n = idx & 63;
            Bs[k][n] = Be[(size_t)(k0 + k) * ldb + col0 + n];
            if (DUAL) B2s[k][n] = B2e[(size_t)(k0 + k) * ldb + col0 + n]; }
        __syncthreads();
#pragma unroll
        for (int k = 0; k < 16; ++k) {
            float a[4], bb[4], b2[4];
#pragma unroll
            for (int i = 0; i < 4; ++i) a[i] = As[k][ty * 4 + i];
#pragma unroll
            for (int j = 0; j < 4; ++j) { bb[j] = Bs[k][tx * 4 + j]; if (DUAL) b2[j] = B2s[k][tx * 4 + j]; }
#pragma unroll
            for (int i = 0; i < 4; ++i)
#pragma unroll
                for (int j = 0; j < 4; ++j) { acc[i][j] += a[i] * bb[j]; if (DUAL) acc2[i][j] += a[i] * b2[j]; }
        }
        __syncthreads();
    }
#pragma unroll
    for (int i = 0; i < 4; ++i) { int rc = rowC[ty * 4 + i]; if (rc < 0) continue;
#pragma unroll
        for (int j = 0; j < 4; ++j) C[(size_t)rc * ldc + col0 + tx * 4 + j] = DUAL ? siluf_(acc[i][j]) * acc2[i][j] : acc[i][j]; }
}

__global__ void k_conv(const float* Pb, const float* cw, const float* cb, float* Ub) {
    int t = blockIdx.x; int segbase = t < CTX ? 0 : CTX; int Lseg = t < CTX ? CTX : SEQ; int lt = t - segbase;
    for (int ch = threadIdx.x; ch < DM; ch += 256) {
        float s = cb[ch];
#pragma unroll
        for (int k = 0; k < 4; ++k) { int tt = lt + k - 2; if (tt >= 0 && tt < Lseg) s += cw[k * DM + ch] * Pb[(size_t)(segbase + tt) * INW + ch]; }
        Ub[(size_t)t * DM + ch] = s;
    }
}

__global__ void k_gates(const float* Ub, const float* wa, const float* ba, const float* wx, const float* bx, const float* lam, float* Aout, float* Bout, int d) {
    __shared__ float us[128];
    int t = blockIdx.x, h = blockIdx.y, j = threadIdx.x; int ch = h * 128 + j;
    float uval = Ub[(size_t)t * DM + ch];
    us[j] = uval; __syncthreads();
    const float* wah = wa + ((size_t)(d * 8 + h) * 128) * 128; const float* wxh = wx + ((size_t)(d * 8 + h) * 128) * 128;
    float ra = 0.f, ia = 0.f;
    for (int i = 0; i < 128; ++i) { float u = us[i]; ra += u * wah[i * 128 + j]; ia += u * wxh[i * 128 + j]; }
    float r = sigmoidf_(ra + ba[d * DM + ch]); float ig = sigmoidf_(ia + bx[d * DM + ch]);
    float sp = log1pf(expf(-lam[d * DM + ch]));
    float log_a = -8.f * r * sp;
    float a = expf(log_a);
    float bcoef = sqrtf(-expm1f(2.f * log_a)) * (ig * uval);
    Aout[(size_t)t * DM + ch] = a; Bout[(size_t)t * DM + ch] = bcoef;
}

__global__ void k_lru_scan(const float* A0, const float* B0, const float* A1, const float* B1, float* YF, float* YB) {
    int g = blockIdx.x * 256 + threadIdx.x; int d = g / DM, ch = g % DM;
    if (d == 0) { float h = B0[(size_t)0 * DM + ch];
        for (int t = 0; t < SEQ; ++t) { size_t o = (size_t)(CTX + t) * DM + ch; h = A0[o] * h + B0[o]; YF[(size_t)t * DM + ch] = h; }
    } else { float h = B1[(size_t)(CTX - 1) * DM + ch];
        for (int t = SEQ - 1; t >= 0; --t) { size_t o = (size_t)(CTX + t) * DM + ch; h = A1[o] * h + B1[o]; YB[(size_t)t * DM + ch] = h; }
    }
}

__global__ __launch_bounds__(128) void k_hgrn(const float* Pb, const float* lb, float* OF, float* OB) {
    __shared__ float gs[128], ks[128], qs[128];
    int h = blockIdx.x, d = blockIdx.y, j = threadIdx.x;
    float S[128];
#pragma unroll
    for (int i = 0; i < 128; ++i) S[i] = 0.f;
    float lbj = lb[h * 128 + j];
    int fcol = (d == 0 ? 3072 : 4096) + h * 128;
    float* O = d == 0 ? OF : OB;
    for (int s = 0; s < LT; ++s) {
        int row, tok = 0; bool isx = s >= CTX;
        if (!isx) { int t = d == 0 ? s : (CTX - 1 - s); row = t; }
        else { int p = s - CTX; if (d == 1) p = SEQ - 1 - p; tok = (p % 32) * 64 + (p / 32); row = CTX + tok; }
        const float* pr = Pb + (size_t)row * INW;
        float gg = lbj + (1.f - lbj) * sigmoidf_(pr[fcol + j]);
        gs[j] = gg; ks[j] = 1.f - gg;
        if (isx) qs[j] = siluf_(pr[2048 + h * 128 + j]);
        float v = pr[5120 + h * 128 + j];
        __syncthreads();
        float o = 0.f;
#pragma unroll
        for (int i = 0; i < 128; ++i) { S[i] = gs[i] * S[i] + ks[i] * v; o += S[i] * qs[i]; }
        if (isx) O[(size_t)tok * DM + h * 128 + j] = o;
        __syncthreads();
    }
}

__global__ void k_gate(const float* Pb, const float* YF, const float* YB, const float* OF, const float* OB, const float* hgn, float* A1g, float* A2g) {
    __shared__ float red[2];
    int t = blockIdx.x, h = blockIdx.y, j = threadIdx.x; int ch = h * 128 + j;
    const float* pr = Pb + (size_t)(CTX + t) * INW;
    size_t o = (size_t)t * DM + ch;
    A1g[o] = (YF[o] + YB[o]) * gelu_tanh(pr[1024 + ch]);
    float ov = OF[o] + OB[o];
    float ss = ov * ov;
    for (int k = 32; k > 0; k >>= 1) ss += __shfl_xor(ss, k);
    if ((j & 63) == 0) red[j >> 6] = ss;
    __syncthreads();
    float ms = (red[0] + red[1]) / 128.f;
    float yb = ov * rsqrtf(ms + EPS) * hgn[ch];
    A2g[o] = yb * siluf_(pr[6144 + ch]);
}

__global__ void k_merge(const float* Pb, const float* PA, const float* PB, float* Mg) {
    int t = blockIdx.x; const float* pr = Pb + (size_t)(CTX + t) * INW;
    for (int ch = threadIdx.x; ch < DM; ch += 256) { size_t o = (size_t)t * DM + ch;
        Mg[o] = sigmoidf_(pr[7168 + ch]) * PA[o] + sigmoidf_(pr[8192 + ch]) * PB[o]; }
}

__global__ void k_res_norm2(const float* x, const float* OUTb, const float* mod, const float* g2, float* X1, float* HX2, int b) {
    __shared__ float red[4];
    int t = blockIdx.x; size_t row = (size_t)b * SEQ + t;
    float v[4]; float ss = 0.f;
#pragma unroll
    for (int i = 0; i < 4; ++i) { int k = threadIdx.x + i * 256; v[i] = x[row * DM + k] + mod[b * 6144 + 2 * DM + k] * OUTb[(size_t)t * DM + k]; ss += v[i] * v[i]; X1[row * DM + k] = v[i]; }
    float tot = block_sum(ss, red);
    float rstd = rsqrtf(tot / DM + EPS);
#pragma unroll
    for (int i = 0; i < 4; ++i) { int k = threadIdx.x + i * 256;
        HX2[row * DM + k] = v[i] * rstd * g2[k] * (1.f + mod[b * 6144 + 4 * DM + k]) + mod[b * 6144 + 3 * DM + k]; }
}

__global__ void k_route(const float* HX2, const float* wrg, const float* brg, const float* wre, const float* bre, int* cnt, int* list, float* wt) {
    int tok = blockIdx.x * 4 + (threadIdx.x >> 6); int lane = threadIdx.x & 63;
    const float* hr = HX2 + (size_t)tok * DM;
    float acc[36];
#pragma unroll
    for (int i = 0; i < 36; ++i) acc[i] = 0.f;
    for (int k = lane; k < DM; k += 64) { float hv = hr[k];
#pragma unroll
        for (int g = 0; g < 4; ++g) acc[g] += hv * wrg[k * 4 + g];
#pragma unroll
        for (int e = 0; e < 32; ++e) acc[4 + e] += hv * wre[k * 32 + e]; }
#pragma unroll
    for (int i = 0; i < 36; ++i) { float v = acc[i]; for (int o = 32; o > 0; o >>= 1) v += __shfl_xor(v, o); acc[i] = v; }
    if (lane == 0) {
        float lg[4]; float mx = -1e30f; int gi = 0;
#pragma unroll
        for (int g = 0; g < 4; ++g) { lg[g] = acc[g] + brg[g]; if (lg[g] > mx) { mx = lg[g]; gi = g; } }
        float z = 0.f;
#pragma unroll
        for (int g = 0; g < 4; ++g) z += expf(lg[g] - mx);
        float pg = 1.f / z;
        float el[8];
#pragma unroll
        for (int g = 0; g < 4; ++g) if (g == gi) {
#pragma unroll
            for (int e = 0; e < 8; ++e) el[e] = acc[4 + g * 8 + e] + bre[g * 8 + e]; }
        int e1 = 0; float m1 = el[0];
#pragma unroll
        for (int e = 1; e < 8; ++e) if (el[e] > m1) { m1 = el[e]; e1 = e; }
        int e2 = -1; float m2 = -1e30f;
#pragma unroll
        for (int e = 0; e < 8; ++e) if (e != e1 && el[e] > m2) { m2 = el[e]; e2 = e; }
        float r = expf(m2 - m1);
        float w1 = pg / (1.f + r), w2 = pg * r / (1.f + r);
        int ea = gi * 8 + e1, eb = gi * 8 + e2;
        int pa = atomicAdd(&cnt[ea], 1); list[(size_t)ea * CAP + pa] = tok * 2; wt[tok * 2] = w1;
        int pb = atomicAdd(&cnt[eb], 1); list[(size_t)eb * CAP + pb] = tok * 2 + 1; wt[tok * 2 + 1] = w2;
    }
}

__global__ void k_final(const float* X1, const float* Y, const float* wt, const float* mod, const float* fg, float* out) {
    __shared__ float red[4];
    int tok = blockIdx.x; int b = tok / SEQ;
    float w0 = wt[tok * 2], w1 = wt[tok * 2 + 1];
    float v[4]; float ss = 0.f;
#pragma unroll
    for (int i = 0; i < 4; ++i) { int k = threadIdx.x + i * 256;
        float y = w0 * Y[(size_t)(tok * 2) * DM + k] + w1 * Y[(size_t)(tok * 2 + 1) * DM + k];
        v[i] = X1[(size_t)tok * DM + k] + mod[b * 6144 + 5 * DM + k] * y; ss += v[i] * v[i]; }
    float tot = block_sum(ss, red);
    float rstd = rsqrtf(tot / DM + EPS);
#pragma unroll
    for (int i = 0; i < 4; ++i) { int k = threadIdx.x + i * 256; out[(size_t)tok * DM + k] = v[i] * rstd * fg[k]; }
}

extern "C" void kernel_launch(void* const* d_in, const int* in_sizes, int n_in, void* d_out, int out_size, void* d_ws, size_t ws_size, hipStream_t stream) {
    const float* x = (const float*)d_in[0]; const float* c = (const float*)d_in[1]; const float* ctx = (const float*)d_in[2]; const float* cctx = (const float*)d_in[3];
    const float* wmod = (const float*)d_in[4]; const float* bmod = (const float*)d_in[5]; const float* g1 = (const float*)d_in[6]; const float* win = (const float*)d_in[7];
    const float* cw = (const float*)d_in[8]; const float* cb = (const float*)d_in[9]; const float* wa = (const float*)d_in[10]; const float* ba = (const float*)d_in[11];
    const float* wx = (const float*)d_in[12]; const float* bx = (const float*)d_in[13]; const float* lam = (const float*)d_in[14]; const float* hglb = (const float*)d_in[15];
    const float* hgn = (const float*)d_in[16]; const float* wpa = (const float*)d_in[17]; const float* wpb = (const float*)d_in[18]; const float* wout = (const float*)d_in[19];
    const float* g2 = (const float*)d_in[20]; const float* wrg = (const float*)d_in[21]; const float* brg = (const float*)d_in[22]; const float* wre = (const float*)d_in[23];
    const float* bre = (const float*)d_in[24]; const float* w1 = (const float*)d_in[25]; const float* w3 = (const float*)d_in[26]; const float* w2 = (const float*)d_in[27];
    const float* fg = (const float*)d_in[28];
    float* out = (float*)d_out;
    char* ws = (char*)d_ws;
    const size_t MiB = 1u << 20;
    float* mod = (float*)(ws);
    float* lb = (float*)(ws + 256 * 1024);
    int* cnt = (int*)(ws + 272 * 1024);
    float* wt = (float*)(ws + 512 * 1024);
    int* list = (int*)(ws + 1 * MiB);
    float* HX2 = (float*)(ws + 4 * MiB);
    size_t off = 68 * MiB;
    auto take = [&](size_t bytes) { float* p = (float*)(ws + off); off += (bytes + 255) & ~(size_t)255; return p; };
    float* Hh = (float*)(ws + 68 * MiB);
    float* Y = (float*)(ws + 132 * MiB);
    float* Hb = take((size_t)LT * DM * 4);
    float* Pb = take((size_t)LT * INW * 4);
    float* Ub = take((size_t)LT * DM * 4);
    float* A0 = take((size_t)LT * DM * 4); float* B0 = take((size_t)LT * DM * 4);
    float* A1 = take((size_t)LT * DM * 4); float* B1 = take((size_t)LT * DM * 4);
    float* YF = take((size_t)SEQ * DM * 4); float* YB = take((size_t)SEQ * DM * 4);
    float* OF = take((size_t)SEQ * DM * 4); float* OB = take((size_t)SEQ * DM * 4);
    float* A1g = take((size_t)SEQ * DM * 4); float* A2g = take((size_t)SEQ * DM * 4);
    float* PA = take((size_t)SEQ * DM * 4); float* PBm = take((size_t)SEQ * DM * 4);
    float* Mg = take((size_t)SEQ * DM * 4); float* OUTb = take((size_t)SEQ * DM * 4);
    if (off > ws_size) return;
    float* X1 = out;

    hipMemsetAsync(cnt, 0, 128, stream);
    k_mod<<<24, 256, 0, stream>>>(c, cctx, wmod, bmod, mod);
    k_lb<<<4, 256, 0, stream>>>(hglb, lb);
    for (int b = 0; b < NB; ++b) {
        k_norm1<<<LT, 256, 0, stream>>>(x, ctx, g1, mod, Hb, b);
        k_gemm<false><<<dim3(INW / 64, LT / 64, 1), 256, 0, stream>>>(Hb, DM, win, nullptr, INW, 0, Pb, INW, LT, INW, DM, nullptr, nullptr, 0);
        k_conv<<<LT, 256, 0, stream>>>(Pb, cw, cb, Ub);
        k_gates<<<dim3(LT, 8), 128, 0, stream>>>(Ub, wa, ba, wx, bx, lam, A0, B0, 0);
        k_gates<<<dim3(LT, 8), 128, 0, stream>>>(Ub, wa, ba, wx, bx, lam, A1, B1, 1);
        k_lru_scan<<<8, 256, 0, stream>>>(A0, B0, A1, B1, YF, YB);
        k_hgrn<<<dim3(8, 2), 128, 0, stream>>>(Pb, lb, OF, OB);
        k_gate<<<dim3(SEQ, 8), 128, 0, stream>>>(Pb, YF, YB, OF, OB, hgn, A1g, A2g);
        k_gemm<false><<<dim3(DM / 64, SEQ / 64, 1), 256, 0, stream>>>(A1g, DM, wpa, nullptr, DM, 0, PA, DM, SEQ, DM, DM, nullptr, nullptr, 0);
        k_gemm<false><<<dim3(DM / 64, SEQ / 64, 1), 256, 0, stream>>>(A2g, DM, wpb, nullptr, DM, 0, PBm, DM, SEQ, DM, DM, nullptr, nullptr, 0);
        k_merge<<<SEQ, 256, 0, stream>>>(Pb, PA, PBm, Mg);
        k_gemm<false><<<dim3(DM / 64, SEQ / 64, 1), 256, 0, stream>>>(Mg, DM, wout, nullptr, DM, 0, OUTb, DM, SEQ, DM, DM, nullptr, nullptr, 0);
        k_res_norm2<<<SEQ, 256, 0, stream>>>(x, OUTb, mod, g2, X1, HX2, b);
    }
    k_route<<<NB * SEQ / 4, 256, 0, stream>>>(HX2, wrg, brg, wre, bre, cnt, list, wt);
    k_gemm<true><<<dim3(DEXP / 64, CAP / 64, NEXP), 256, 0, stream>>>(HX2, DM, w1, w3, DEXP, (size_t)DM * DEXP, Hh, DEXP, 0, DEXP, DM, list, cnt, 1);
    k_gemm<false><<<dim3(DM / 64, CAP / 64, NEXP), 256, 0, stream>>>(Hh, DEXP, w2, nullptr, DM, (size_t)DEXP * DM, Y, DM, 0, DM, DEXP, list, cnt, 0);
    k_final<<<NB * SEQ, 256, 0, stream>>>(X1, Y, wt, mod, fg, out);
}
```

```cpp
#include <hip/hip_runtime.h>
#include <cstdio>
#include <cstdint>
#include <math.h>

#define LAS __attribute__((address_space(3)))
#define GAS __attribute__((address_space(1)))
typedef unsigned short bf16;
typedef short bf16x8 __attribute__((ext_vector_type(8)));
typedef float f32x4 __attribute__((ext_vector_type(4)));
typedef float f32x2 __attribute__((ext_vector_type(2)));
typedef unsigned u32x4 __attribute__((ext_vector_type(4)));
typedef unsigned u32x2 __attribute__((ext_vector_type(2)));

constexpr int DM = 1024, NB = 8, SEQ = 2048, CTX = 256, NTOK = NB * SEQ, NCTX = NB * CTX, INW = 9216, LT = CTX + SEQ;
constexpr int NEXP = 32, DEXP = 512, CAP = 16384;
constexpr float EPS = 1e-6f;
constexpr int NWAVES = 8, NTHR = 512;

constexpr size_t MiB = 1u << 20, KiB = 1024;
constexpr size_t WS_CTL = 0, CTL_BYTES = 64 * KiB;
constexpr size_t WS_MODP = 256 * KiB;
constexpr size_t WS_MOD = 2 * MiB;
constexpr size_t WS_LRUAGG = 2 * MiB + 512 * KiB;
constexpr size_t WS_LRUS0 = 4 * MiB + 512 * KiB;
constexpr size_t WS_WT = 4 * MiB + 768 * KiB;
constexpr size_t WS_LIST = 5 * MiB;
constexpr size_t WS_HGD = 7 * MiB;
constexpr size_t WS_WRT = 7 * MiB + 256 * KiB;
constexpr size_t WS_WIN = 8 * MiB;
constexpr size_t WS_WPA = 26 * MiB, WS_WPB = 28 * MiB, WS_WOUT = 30 * MiB;
constexpr size_t WS_WLRU = 32 * MiB;
constexpr size_t WS_P = 33 * MiB, GS = 32 * MiB;
constexpr size_t WS_PC = 321 * MiB, CGS = 4 * MiB;
constexpr size_t WS_END = 337 * MiB;
constexpr size_t WS_W1T = WS_P + 0 * GS, WS_W3T = WS_P + 2 * GS, WS_W2T = WS_P + 5 * GS;
constexpr size_t WS_YAG = WS_P + 1 * GS;
constexpr size_t WS_OF = WS_P + 3 * GS, WS_OB = WS_P + 4 * GS;
constexpr size_t WS_YBG = WS_P + 3 * GS;
constexpr size_t WS_M = WS_P + 4 * GS;
constexpr size_t WS_HX2 = WS_P + 1 * GS;
constexpr size_t WS_HH = WS_P + 3 * GS;
constexpr size_t WS_Y = WS_P + 6 * GS;

constexpr int CW_BAR = 1024;
constexpr int CW_CNT = 12288;

constexpr int RING_BYTES = 131072, LDSCTL_OFF = RING_BYTES, LDS_BYTES = 147456;

#define LDS_WAIT() asm volatile("s_waitcnt lgkmcnt(0)" ::: "memory")
#define VM_WAIT() asm volatile("s_waitcnt vmcnt(0)" ::: "memory")

__device__ __forceinline__ unsigned f2bf(float f) { unsigned u = __builtin_bit_cast(unsigned, f); return (u + 0x7fffu + ((u >> 16) & 1u)) >> 16; }
__device__ __forceinline__ unsigned pk2(float lo, float hi) { return f2bf(lo) | (f2bf(hi) << 16); }
__device__ __forceinline__ float bf2f(unsigned short b) { return __builtin_bit_cast(float, (unsigned)b << 16); }
__device__ __forceinline__ float bflo(unsigned w) { return __builtin_bit_cast(float, w << 16); }
__device__ __forceinline__ float bfhi(unsigned w) { return __builtin_bit_cast(float, w & 0xffff0000u); }
__device__ __forceinline__ float sigmoidf_(float x) { return 1.f / (1.f + __expf(-x)); }
__device__ __forceinline__ float siluf_(float x) { return x / (1.f + __expf(-x)); }
__device__ __forceinline__ float gelu_tanh(float x) { float u = 0.7978845608028654f * (x + 0.044715f * x * x * x); float e = __expf(2.f * u); return x * (1.f - 1.f / (1.f + e)); }
__device__ __forceinline__ float wave_sum(float v) {
#pragma unroll
    for (int o = 1; o < 64; o <<= 1) v += __shfl_xor(v, o);
    return v;
}

#define XB_TMO      128
#define XB_XCNT(j)  (256  + 64 * (j))
#define XB_XSUB(j)  (1280 + 64 * (j))
#define XB_XGEN(j)  (2304 + 64 * (j))
#define XB_TOP      3328
#define XB_TOPGEN   3392
#define XCD_BAR_WORDS 3456
#define XB_SPIN_CAP (1u << 20)
__device__ __forceinline__ unsigned xb_ld(unsigned* p)              { return __hip_atomic_load(p, __ATOMIC_RELAXED, __HIP_MEMORY_SCOPE_AGENT); }
__device__ __forceinline__ unsigned xb_add(unsigned* p, unsigned v) { return __hip_atomic_fetch_add(p, v, __ATOMIC_RELAXED, __HIP_MEMORY_SCOPE_AGENT); }
__device__ __forceinline__ unsigned xb_xcc_id() { return (unsigned)__builtin_amdgcn_s_getreg((3 << 11) | 20) & 0xFu; }
#define XB_SPIN(cond, bar) do { unsigned _sp = 0; while (cond) { __builtin_amdgcn_s_sleep(1); \
    if ((++_sp & 255u) == 0u) { if (xb_ld(&(bar)[XB_TMO])) break; if (_sp > XB_SPIN_CAP) { atomicAdd(&(bar)[XB_TMO], 1u); break; } } } } while (0)
struct XcdBarrier { unsigned* bar; unsigned x; volatile LAS unsigned* st; };
__device__ __forceinline__ XcdBarrier xcd_barrier_post(unsigned* bar, volatile LAS unsigned* st) {
    XcdBarrier b; b.bar = bar; b.x = xb_xcc_id(); b.st = st;
    if (threadIdx.x == 0) (void)xb_add(&bar[XB_XCNT(b.x)], 1u);
    return b;
}
__device__ __forceinline__ void xcd_barrier_complete(unsigned* bar, unsigned x, unsigned& nloc, unsigned& nx) {
    const unsigned G = gridDim.x * gridDim.y * gridDim.z;
    unsigned sum, cnt, mine, sp = 0u;
    for (;;) {
        sum = 0u; cnt = 0u; mine = 0u;
#pragma unroll
        for (unsigned j = 0; j < 16; ++j) { const unsigned c = xb_ld(&bar[XB_XCNT(j)]); sum += c; cnt += (c > 0u) ? 1u : 0u; mine = (j == x) ? c : mine; }
        if (sum == G) break;
        __builtin_amdgcn_s_sleep(1);
        if ((++sp & 255u) == 0u) { if (xb_ld(&bar[XB_TMO])) break; if (sp > XB_SPIN_CAP) { atomicAdd(&bar[XB_TMO], 1u); break; } }
    }
    nloc = mine > 0u ? mine : 1u; nx = cnt > 0u ? cnt : 1u;
}
__device__ __forceinline__ void xcd_barrier(const XcdBarrier& b) {
    asm volatile("s_waitcnt vmcnt(0)" ::: "memory");
    __syncthreads();
    if (threadIdx.x == 0) {
        unsigned* bar = b.bar;
        __builtin_amdgcn_s_waitcnt(0);
        unsigned nloc = b.st[0], nx = b.st[1];
        if (nloc == 0u) { xcd_barrier_complete(bar, b.x, nloc, nx); b.st[0] = nloc; b.st[1] = nx; }
        const unsigned old = xb_add(&bar[XB_XSUB(b.x)], 1u);
        const unsigned gen = old / nloc;
        if (old + 1u == (gen + 1u) * nloc) {
            __builtin_amdgcn_fence(__ATOMIC_RELEASE, "agent");
            asm volatile("s_waitcnt vmcnt(0)" ::: "memory");
            const unsigned og = xb_add(&bar[XB_TOP], 1u);
            const unsigned tg = og / nx;
            if (og + 1u == (tg + 1u) * nx) xb_add(&bar[XB_TOPGEN], 1u);
            else XB_SPIN(xb_ld(&bar[XB_TOPGEN]) == tg, bar);
            __builtin_amdgcn_fence(__ATOMIC_ACQUIRE, "agent");
            xb_add(&bar[XB_XGEN(b.x)], 1u);
            asm volatile("s_waitcnt vmcnt(0)" ::: "memory");
        } else {
            XB_SPIN(xb_ld(&bar[XB_XGEN(b.x)]) == gen, bar);
            __builtin_amdgcn_fence(__ATOMIC_ACQUIRE, "agent");
            asm volatile("s_waitcnt vmcnt(0)" ::: "memory");
        }
    }
    __syncthreads();
}

namespace gm {
constexpr int BM = 256, BK = 64, HALF = 128, HTB = HALF * BK * 2;
__device__ __forceinline__ int lds_byte(int r, int c) { const int st = (r >> 4) * 2 + (c >> 5), rr = r & 15, cc = c & 31, ob = rr * 64 + cc * 2; return st * 1024 + (ob ^ (((ob >> 9) & 1) << 5)); }
__device__ __forceinline__ void stage_rc(int b, int& R, int& C) { const int st = b / 1024, sb = b % 1024, swz = sb ^ (((sb >> 9) & 1) << 5); R = (st >> 1) * 16 + swz / 64; C = (st & 1) * 32 + (swz % 64) / 2; }
__device__ __forceinline__ int perm32(int rho) { const int n = rho >> 4, i = rho & 15; return 8 * (i >> 2) + 4 * n + (i & 3); }
__device__ __forceinline__ unsigned cvt_pk_bf16(float lo, float hi) { unsigned r; asm volatile("v_cvt_pk_bf16_f32 %0, %1, %2" : "=v"(r) : "v"(lo), "v"(hi)); return r; }

struct Unit { const char* A; const char* B0; const char* B1; char* dst; int pm, pn, e, rows; };

template <class Sched, class Epi, bool GATHER>
__device__ __forceinline__ void gemm_phase(LAS unsigned char* lds, const int K, const Sched& S, const Epi& E) {
    const int tid = threadIdx.x, wid = __builtin_amdgcn_readfirstlane(tid >> 6), lane = tid & 63, wr = wid >> 2, wc = wid & 3, fr = lane & 15, fq = lane >> 4;
    const int nt = K / BK;
    unsigned voffB[2]; int Rr[2]; unsigned Cb[2];
#pragma unroll
    for (int i = 0; i < 2; ++i) { int R, C; stage_rc(tid * 16 + i * 8192, R, C); const int Rb = Epi::PERM ? ((R & ~31) + perm32(R & 31)) : R;
        Rr[i] = R; Cb[i] = (unsigned)C * 2u; voffB[i] = (unsigned)(Rb * K + C) * 2u; }
    const unsigned rowb = (unsigned)K * 2u;
    const size_t kstep = (size_t)(BK * 2);
    const unsigned ldsw = (unsigned)wid * 1024u;
    const int aoff = lds_byte(wr * 64 + fr, fq * 8), boff = lds_byte(wc * 32 + fr, fq * 8);
#define GM_SA(b, h) (((b) * 2 + (h)) * HTB)
#define GM_SB(b, h) ((4 + (b) * 2 + (h)) * HTB)
#define GM_STAGE(bufoff, gbase, voff) do { _Pragma("unroll") for (int _i = 0; _i < 2; ++_i) \
        __builtin_amdgcn_global_load_lds((const unsigned*)((const char*)(gbase) + (voff)[_i]), (LAS unsigned*)(lds + (bufoff) + ldsw + _i * 8192), 16, 0, 0); } while (0)
#define GM_LDA(dst, b, h) do { _Pragma("unroll") for (int m = 0; m < 4; ++m) _Pragma("unroll") for (int k = 0; k < 2; ++k) dst[m][k] = *(const LAS bf16x8*)(lds + GM_SA(b, h) + aoff + m * 2048 + k * 1024); } while (0)
#define GM_LDB(dst, b, h) do { _Pragma("unroll") for (int n = 0; n < 2; ++n) _Pragma("unroll") for (int k = 0; k < 2; ++k) dst[n][k] = *(const LAS bf16x8*)(lds + GM_SB(b, h) + boff + n * 2048 + k * 1024); } while (0)
#define GM_MMA(ai, bj, At, Bt) do { __builtin_amdgcn_s_setprio(1); _Pragma("unroll") for (int m = 0; m < 4; ++m) _Pragma("unroll") for (int n = 0; n < 2; ++n) _Pragma("unroll") for (int k = 0; k < 2; ++k) \
        acc[ai][bj][m][n] = __builtin_amdgcn_mfma_f32_16x16x32_bf16(Bt[n][k], At[m][k], acc[ai][bj][m][n], 0, 0, 0); __builtin_amdgcn_s_setprio(0); } while (0)
#define GM_WAIT_V(n) asm volatile("s_waitcnt vmcnt(" #n ")" ::: "memory")
#define GM_WAIT_L(n) asm volatile("s_waitcnt lgkmcnt(" #n ")" ::: "memory")
#define GM_BAR __builtin_amdgcn_s_barrier()
#define GM_SCHED __builtin_amdgcn_sched_barrier(0)
#define GM_AOFFS(u, o) do { _Pragma("unroll") for (int _h = 0; _h < 2; ++_h) _Pragma("unroll") for (int _i = 0; _i < 2; ++_i) \
        (o)[_h][_i] = (GATHER ? S.arow((u), _h * HALF + Rr[_i]) : (unsigned)(_h * HALF + Rr[_i])) * rowb + Cb[_i]; } while (0)
    Unit cur, nxt; int ui = 0;
    if (!S.next(0, cur)) return;
    f32x4 acc[2][2][4][2];
#pragma unroll
    for (int a = 0; a < 2; ++a)
#pragma unroll
        for (int b = 0; b < 2; ++b)
#pragma unroll
            for (int m = 0; m < 4; ++m)
#pragma unroll
                for (int n = 0; n < 2; ++n) acc[a][b][m][n] = (f32x4){0.f, 0.f, 0.f, 0.f};
    bf16x8 At[4][2], B0[2][2], B1[2][2];
    unsigned ca[2][2], na[2][2];
    GM_AOFFS(cur, ca);
    const char* cA = cur.A; const char* cB0 = cur.B0; const char* cB1 = cur.B1;
    GM_STAGE(GM_SB(0, 0), cB0, voffB); GM_STAGE(GM_SB(0, 1), cB1, voffB); GM_STAGE(GM_SA(0, 0), cA, ca[0]); GM_STAGE(GM_SA(0, 1), cA, ca[1]);
    if (wr == 1) GM_BAR;
    GM_WAIT_V(2); GM_BAR;
    GM_STAGE(GM_SB(1, 0), cB0 + kstep, voffB); GM_STAGE(GM_SA(1, 0), cA + kstep, ca[0]); GM_STAGE(GM_SB(1, 1), cB1 + kstep, voffB);
    GM_WAIT_V(6); GM_BAR;
    for (;;) {
        const bool has_next = S.next(ui + 1, nxt);
        const char* nA = has_next ? nxt.A : cA; const char* nB0 = has_next ? nxt.B0 : cB0; const char* nB1 = has_next ? nxt.B1 : cB1;
        if (has_next) { GM_AOFFS(nxt, na); } else {
#pragma unroll
            for (int h = 0; h < 2; ++h)
#pragma unroll
                for (int i = 0; i < 2; ++i) na[h][i] = ca[h][i]; }
        for (int t = 0; t < nt; t += 2) {
            const bool last = (t == nt - 2);
            const char* a1 = cA + (size_t)(t + 1) * kstep;
            const char* a2 = last ? nA : cA + (size_t)(t + 2) * kstep;
            const char* b20 = last ? nB0 : cB0 + (size_t)(t + 2) * kstep; const char* b21 = last ? nB1 : cB1 + (size_t)(t + 2) * kstep;
            const char* a3 = a2 + kstep; const char* b30 = b20 + kstep; const char* b31 = b21 + kstep;
            unsigned o2[2][2];
#pragma unroll
            for (int h = 0; h < 2; ++h)
#pragma unroll
                for (int i = 0; i < 2; ++i) o2[h][i] = last ? na[h][i] : ca[h][i];
            GM_LDB(B0, 0, 0); GM_LDB(B1, 0, 1); GM_SCHED; GM_LDA(At, 0, 0); GM_STAGE(GM_SA(1, 1), a1, ca[1]);
            GM_WAIT_V(8); GM_WAIT_L(0); GM_BAR; GM_MMA(0, 0, At, B0); GM_MMA(0, 1, At, B1); GM_BAR; GM_SCHED;
            GM_LDA(At, 0, 1); GM_STAGE(GM_SB(0, 0), b20, voffB); GM_STAGE(GM_SB(0, 1), b21, voffB); GM_STAGE(GM_SA(0, 0), a2, o2[0]);
            GM_WAIT_V(8); GM_WAIT_L(0); GM_BAR; GM_MMA(1, 0, At, B0); GM_MMA(1, 1, At, B1); GM_BAR; GM_SCHED;
            GM_LDB(B0, 1, 0); GM_LDB(B1, 1, 1); GM_SCHED; GM_LDA(At, 1, 0); GM_STAGE(GM_SA(0, 1), a2, o2[1]);
            GM_WAIT_V(8); GM_WAIT_L(0); GM_BAR; GM_MMA(0, 0, At, B0); GM_MMA(0, 1, At, B1); GM_BAR; GM_SCHED;
            GM_LDA(At, 1, 1); GM_STAGE(GM_SB(1, 0), b30, voffB); GM_STAGE(GM_SB(1, 1), b31, voffB); GM_STAGE(GM_SA(1, 0), a3, o2[0]);
            GM_WAIT_V(8); GM_WAIT_L(0); GM_BAR; GM_MMA(1, 0, At, B0); GM_MMA(1, 1, At, B1); GM_BAR; GM_SCHED;
        }
        if (wr == 0) GM_BAR;
        E(acc, cur, wr, wc, fr, fq);
        if (!has_next) break;
#pragma unroll
        for (int a = 0; a < 2; ++a)
#pragma unroll
            for (int b = 0; b < 2; ++b)
#pragma unroll
                for (int m = 0; m < 4; ++m)
#pragma unroll
                    for (int n = 0; n < 2; ++n) acc[a][b][m][n] = (f32x4){0.f, 0.f, 0.f, 0.f};
        cur = nxt; cA = nA; cB0 = nB0; cB1 = nB1; ++ui;
#pragma unroll
        for (int h = 0; h < 2; ++h)
#pragma unroll
            for (int i = 0; i < 2; ++i) ca[h][i] = na[h][i];
        if (wr == 1) GM_BAR;
    }
    GM_WAIT_V(0);
    GM_BAR;
#undef GM_SA
#undef GM_SB
#undef GM_STAGE
#undef GM_LDA
#undef GM_LDB
#undef GM_MMA
#undef GM_WAIT_V
#undef GM_WAIT_L
#undef GM_BAR
#undef GM_SCHED
#undef GM_AOFFS
}
}
struct Args {
    const float* in[29]; float* out; unsigned char* ws; int ph_lo, ph_hi, li, pad;
};
struct Frame {
    LAS unsigned char* lds; volatile LAS unsigned* MISC;
    unsigned* ctl; unsigned char* ws; float* out;
    int tid, lane, wave, G, bid;
};
enum { IN_X = 0, IN_C, IN_CTX, IN_CCTX, IN_WMOD, IN_BMOD, IN_G1, IN_WIN, IN_CONVW, IN_CONVB, IN_WA, IN_BA, IN_WX, IN_BX, IN_LAM, IN_HGLB, IN_HGN,
       IN_WPA, IN_WPB, IN_WOUT, IN_G2, IN_WRG, IN_BRG, IN_WRE, IN_BRE, IN_W1, IN_W3, IN_W2, IN_FG };

__device__ __forceinline__ void transpose_item(const float* W, int ldw, int K, bf16* WT, int k0, int n0, LAS float* scr, int lane) {
#pragma unroll 8
    for (int i = 0; i < 32; ++i) { const int kk = 2 * i + (lane >> 5); scr[kk * 33 + (lane & 31)] = W[(size_t)(k0 + kk) * ldw + n0 + (lane & 31)]; }
    LDS_WAIT(); asm volatile("" ::: "memory");
    const int c = lane & 7;
#pragma unroll
    for (int j = 0; j < 4; ++j) { const int n = (lane >> 3) + 8 * j; const LAS float* s = scr + (8 * c) * 33 + n;
        u32x4 o; o.x = pk2(s[0 * 33], s[1 * 33]); o.y = pk2(s[2 * 33], s[3 * 33]); o.z = pk2(s[4 * 33], s[5 * 33]); o.w = pk2(s[6 * 33], s[7 * 33]);
        *(u32x4*)(WT + (size_t)n * K + k0 + 8 * c) = o; }
    LDS_WAIT(); asm volatile("" ::: "memory");
}

__device__ __forceinline__ void p0_mod_item(Frame& F, const Args& a, int item) {
    const int cb = item % 24, ks = item / 24;
    LAS float* sv = (LAS float*)F.lds;
    LAS float* red = sv + 9 * 128;
    const float* c = a.in[IN_C]; const float* cc = a.in[IN_CCTX]; const float* wmod = a.in[IN_WMOD];
    for (int i = F.tid; i < 9 * 128; i += NTHR) { const int r = i >> 7, k = i & 127; const float v = r < 8 ? c[r * DM + ks * 128 + k] : cc[ks * 128 + k]; sv[i] = siluf_(v); }
    __syncthreads();
    const int col = cb * 256 + (F.tid & 255), kh = F.tid >> 8;
    float acc[9];
#pragma unroll
    for (int r = 0; r < 9; ++r) acc[r] = 0.f;
    for (int k = 0; k < 64; ++k) { const int kk = kh * 64 + k; const float w = wmod[(size_t)(ks * 128 + kk) * 6144 + col];
#pragma unroll
        for (int r = 0; r < 9; ++r) acc[r] += sv[r * 128 + kk] * w; }
    if (kh == 1) {
#pragma unroll
        for (int r = 0; r < 9; ++r) red[r * 256 + (F.tid & 255)] = acc[r]; }
    __syncthreads();
    float* modp = (float*)(F.ws + WS_MODP);
    if (kh == 0) {
#pragma unroll
        for (int r = 0; r < 9; ++r) modp[(size_t)(ks * 9 + r) * 6144 + col] = acc[r] + red[r * 256 + F.tid]; }
    __syncthreads();
}
__device__ __forceinline__ float mod_from_partials(const float* modp, const float* bmod, int row, int j) {
    float s = bmod[j];
#pragma unroll
    for (int ks = 0; ks < 8; ++ks) s += modp[(size_t)(ks * 9 + row) * 6144 + j];
    return s;
}

__device__ __forceinline__ void p0_prologue(Frame& F, const Args& a) {
    if (F.bid < 192) p0_mod_item(F, a, F.bid);
    LAS float* scr = (LAS float*)(F.lds + F.wave * 16384);
    const int gw = F.bid * NWAVES + F.wave, NGW = F.G * NWAVES;
    constexpr int I_IN = 16 * 288, I_PR = 16 * 32, I_LRU = 32 * 8;
    constexpr int NITEMS = I_IN + 3 * I_PR + I_LRU;
    for (int it = gw; it < NITEMS; it += NGW) {
        int r = it;
        if (r < I_IN) { const int kb = r / 288, nb = r % 288; transpose_item(a.in[IN_WIN], INW, DM, (bf16*)(F.ws + WS_WIN) + (size_t)(nb * 32) * DM, kb * 64, nb * 32, scr, F.lane); continue; } r -= I_IN;
        if (r < 3 * I_PR) { const int w = r / I_PR, q = r % I_PR, kb = q / 32, nb = q % 32;
            const float* W = a.in[w == 0 ? IN_WPA : (w == 1 ? IN_WPB : IN_WOUT)]; bf16* WT = (bf16*)(F.ws + (w == 0 ? WS_WPA : (w == 1 ? WS_WPB : WS_WOUT)));
            transpose_item(W, DM, DM, WT + (size_t)(nb * 32) * DM, kb * 64, nb * 32, scr, F.lane); continue; } r -= 3 * I_PR;
        { const int mat = r / 8, q = r % 8, kb = q / 4, nb = q % 4;
          const int which = mat >> 4, dh = mat & 15;
          const float* W = a.in[which == 0 ? IN_WA : IN_WX] + (size_t)dh * 128 * 128; bf16* WT = (bf16*)(F.ws + WS_WLRU) + (size_t)mat * 128 * 128;
          transpose_item(W, 128, 128, WT + (size_t)(nb * 32) * 128, kb * 64, nb * 32, scr, F.lane); }
    }
    float* wrt = (float*)(F.ws + WS_WRT);
    for (int i = F.bid * NTHR + F.tid; i < 36 * 1024 + 36; i += F.G * NTHR) {
        if (i < 36 * 1024) { const int o = i >> 10, k = i & 1023; wrt[i] = o < 4 ? a.in[IN_WRG][k * 4 + o] : a.in[IN_WRE][k * 32 + (o - 4)]; }
        else { const int o = i - 36 * 1024; wrt[i] = o < 4 ? a.in[IN_BRG][o] : a.in[IN_BRE][o - 4]; }
    }
}

__device__ __forceinline__ void norm_rows(Frame& F, const float* src, bf16* dst, int row0, int nrows, const LAS float* gs, const LAS float* sh) {
    for (int r = F.wave; r < nrows; r += NWAVES) {
        const f32x4* xr = (const f32x4*)(src + (size_t)(row0 + r) * DM) + F.lane;
        f32x4 v[4]; float s = 0.f;
#pragma unroll
        for (int j = 0; j < 4; ++j) { v[j] = xr[64 * j]; s += (v[j].x * v[j].x + v[j].y * v[j].y) + (v[j].z * v[j].z + v[j].w * v[j].w); }
        const float rstd = rsqrtf(wave_sum(s) * (1.f / DM) + EPS);
        unsigned long long* o8 = (unsigned long long*)(dst + (size_t)(row0 + r) * DM) + F.lane;
#pragma unroll
        for (int j = 0; j < 4; ++j) { const int k = 4 * F.lane + 256 * j;
            const f32x4 g = *(const LAS f32x4*)(gs + k), h = *(const LAS f32x4*)(sh + k);
            const float o0 = v[j].x * rstd * g.x + h.x, o1 = v[j].y * rstd * g.y + h.y, o2 = v[j].z * rstd * g.z + h.z, o3 = v[j].w * rstd * g.w + h.w;
            o8[64 * j] = (unsigned long long)pk2(o0, o1) | ((unsigned long long)pk2(o2, o3) << 32); }
    }
}
__device__ __forceinline__ void p1_norm(Frame& F, const Args& a) {
    const float* modp = (const float*)(F.ws + WS_MODP); const float* bmod = a.in[IN_BMOD]; const float* g1 = a.in[IN_G1];
    LAS float* gs = (LAS float*)F.lds; LAS float* sh = gs + DM;
    bf16* H = (bf16*)F.out;
    float* mod = (float*)(F.ws + WS_MOD);
    for (int i = F.bid * NTHR + F.tid; i < 9 * 6144; i += F.G * NTHR) mod[i] = mod_from_partials(modp, bmod, i / 6144, i % 6144);
    const int b = F.bid / 32;
    for (int k = F.tid; k < DM; k += NTHR) { gs[k] = g1[k] * (1.f + mod_from_partials(modp, bmod, b, DM + k)); sh[k] = mod_from_partials(modp, bmod, b, k); }
    __syncthreads();
    norm_rows(F, a.in[IN_X], H, F.bid * 64, 64, gs, sh);
    __syncthreads();
    for (int k = F.tid; k < DM; k += NTHR) { gs[k] = g1[k] * (1.f + mod_from_partials(modp, bmod, 8, DM + k)); sh[k] = mod_from_partials(modp, bmod, 8, k); }
    __syncthreads();
    norm_rows(F, a.in[IN_CTX], H + (size_t)NTOK * DM, F.bid * 8, 8, gs, sh);
    __syncthreads();
}

struct EpiStoreBf16 {
    static constexpr bool PERM = true;
    __device__ __forceinline__ void operator()(const f32x4 (&acc)[2][2][4][2], const gm::Unit& u, int wr, int wc, int fr, int fq) const {
        bf16* base = (bf16*)u.dst + (size_t)(wr * 64 + fr) * DM + wc * 32 + 8 * fq;
#pragma unroll
        for (int ai = 0; ai < 2; ++ai)
#pragma unroll
            for (int m = 0; m < 4; ++m) { bf16* rowp = base + (size_t)(ai * 128 + m * 16) * DM;
#pragma unroll
                for (int bj = 0; bj < 2; ++bj) { const f32x4 v0 = acc[ai][bj][m][0], v1 = acc[ai][bj][m][1];
                    u32x4 w; w.x = gm::cvt_pk_bf16(v0[0], v0[1]); w.y = gm::cvt_pk_bf16(v0[2], v0[3]); w.z = gm::cvt_pk_bf16(v1[0], v1[1]); w.w = gm::cvt_pk_bf16(v1[2], v1[3]);
                    *(u32x4*)(rowp + bj * 128) = w; } }
    }
};
__device__ __forceinline__ void tile_order(int L, int nM, int nN, int& pm, int& pn) {
    const int nwg = nM * nN; int wgid = L;
    { const int q = nwg / 8, r = nwg % 8, xcd = wgid % 8, off = wgid / 8; wgid = (xcd < r ? xcd * (q + 1) : r * (q + 1) + (xcd - r) * q) + off; }
    const int nig = 8 * nN, gid = wgid / nig, fm = gid * 8, gsz = (nM - fm) < 8 ? (nM - fm) : 8;
    pm = fm + ((wgid % nig) % gsz); pn = (wgid % nig) / gsz;
}
struct SchedP2 {
    int G, c; const char* H; const char* Wt; char* P; char* PC;
    __device__ __forceinline__ bool next(int i, gm::Unit& u) const {
        int L = i * G + c;
        if (L < 64 * 36) { int pm, pn; tile_order(L, 64, 36, pm, pn);
            u.A = H + (size_t)pm * 256 * 2048; u.B0 = Wt + (size_t)pn * 256 * 2048; u.B1 = u.B0 + (size_t)128 * 2048;
            u.dst = P + (size_t)(pn >> 2) * GS + ((size_t)pm * 256 * DM + (pn & 3) * 256) * 2; u.pm = pm; u.pn = pn; u.e = 0; u.rows = 256; return true; }
        L -= 64 * 36; if (L >= 128) return false;
        const int pmc = L >> 4, j = L & 15, slot = j >> 2, g = slot == 0 ? 0 : slot + 2, pn = g * 4 + (j & 3);
        u.A = H + (size_t)(NTOK + pmc * 256) * 2048; u.B0 = Wt + (size_t)pn * 256 * 2048; u.B1 = u.B0 + (size_t)128 * 2048;
        u.dst = PC + (size_t)slot * CGS + ((size_t)pmc * 256 * DM + (j & 3) * 256) * 2; u.pm = pmc; u.pn = pn; u.e = 0; u.rows = 256; return true;
    }
    __device__ __forceinline__ unsigned arow(const gm::Unit&, int r) const { return (unsigned)r; }
};
__device__ __forceinline__ void p_ybg(Frame& F, const Args& a) {
    const bf16* OFp = (const bf16*)(F.ws + WS_OF); const bf16* OBp = (const bf16*)(F.ws + WS_OB); const bf16* OG = (const bf16*)(F.ws + WS_P + 6 * GS);
    bf16* YBG = (bf16*)(F.ws + WS_YBG); const float* hgn = a.in[IN_HGN];
    const int gw = F.bid * NWAVES + F.wave, NGW = F.G * NWAVES;
    for (int row = gw; row < NTOK; row += NGW) {
#pragma unroll
        for (int j = 0; j < 2; ++j) { const int k = 8 * F.lane + 512 * j; const size_t o = (size_t)row * DM + k;
            const u32x4 f = *(const u32x4*)(OFp + o), b = *(const u32x4*)(OBp + o), g = *(const u32x4*)(OG + o);
            float v[8]; v[0] = bflo(f.x) + bflo(b.x); v[1] = bfhi(f.x) + bfhi(b.x); v[2] = bflo(f.y) + bflo(b.y); v[3] = bfhi(f.y) + bfhi(b.y);
            v[4] = bflo(f.z) + bflo(b.z); v[5] = bfhi(f.z) + bfhi(b.z); v[6] = bflo(f.w) + bflo(b.w); v[7] = bfhi(f.w) + bfhi(b.w);
            float ss = 0.f;
#pragma unroll
            for (int q = 0; q < 8; ++q) ss += v[q] * v[q];
            ss += __shfl_xor(ss, 1); ss += __shfl_xor(ss, 2); ss += __shfl_xor(ss, 4); ss += __shfl_xor(ss, 8);
            const float rs = rsqrtf(ss * (1.f / 128.f) + EPS);
            float gv[8]; gv[0] = bflo(g.x); gv[1] = bfhi(g.x); gv[2] = bflo(g.y); gv[3] = bfhi(g.y); gv[4] = bflo(g.z); gv[5] = bfhi(g.z); gv[6] = bflo(g.w); gv[7] = bfhi(g.w);
            const f32x4 h0 = *(const f32x4*)(hgn + k), h1 = *(const f32x4*)(hgn + k + 4);
            const float hv[8] = {h0.x, h0.y, h0.z, h0.w, h1.x, h1.y, h1.z, h1.w};
            float r[8];
#pragma unroll
            for (int q = 0; q < 8; ++q) r[q] = v[q] * rs * hv[q] * siluf_(gv[q]);
            u32x4 w; w.x = pk2(r[0], r[1]); w.y = pk2(r[2], r[3]); w.z = pk2(r[4], r[5]); w.w = pk2(r[6], r[7]);
            *(u32x4*)(YBG + o) = w; }
    }
}
__device__ __forceinline__ void p_moe_weights(Frame& F, const Args& a) {
    LAS float* scr = (LAS float*)(F.lds + F.wave * 16384);
    const int gw = F.bid * NWAVES + F.wave, NGW = F.G * NWAVES;
    constexpr int PER_E = 3 * 256;
    for (int it = gw; it < NEXP * PER_E; it += NGW) {
        const int e = it / PER_E, r = it % PER_E, w = r >> 8, q = r & 255;
        if (w < 2) { const int kb = q >> 4, nb = q & 15;
            transpose_item(a.in[w == 0 ? IN_W1 : IN_W3] + (size_t)e * DM * DEXP, DEXP, DM, (bf16*)(F.ws + (w == 0 ? WS_W1T : WS_W3T)) + ((size_t)e * DEXP + nb * 32) * DM, kb * 64, nb * 32, scr, F.lane); }
        else { const int kb = q >> 5, nb = q & 31;
            transpose_item(a.in[IN_W2] + (size_t)e * DEXP * DM, DM, DEXP, (bf16*)(F.ws + WS_W2T) + ((size_t)e * DM + nb * 32) * DEXP, kb * 64, nb * 32, scr, F.lane); }
    }
}

struct SchedP5 {
    int c; const char* YAG; const char* YBG; const char* WA; const char* WB; char* stash; char* M;
    __device__ __forceinline__ bool next(int i, gm::Unit& u) const {
        if (i >= 2) return false;
        int pm, pn; tile_order(c, 64, 4, pm, pn);
        u.A = (i == 0 ? YAG : YBG) + (size_t)pm * 256 * 2048; u.B0 = (i == 0 ? WA : WB) + (size_t)pn * 256 * 2048; u.B1 = u.B0 + (size_t)128 * 2048;
        u.dst = M + ((size_t)pm * 256 * DM + pn * 256) * 2; u.pm = pm; u.pn = pn; u.e = i; u.rows = 256; return true;
    }
    __device__ __forceinline__ unsigned arow(const gm::Unit&, int r) const { return (unsigned)r; }
};
struct EpiP5 {
    static constexpr bool PERM = true;
    float* stash; const bf16* GA; const bf16* GB;
    __device__ __forceinline__ void operator()(const f32x4 (&acc)[2][2][4][2], const gm::Unit& u, int wr, int wc, int fr, int fq) const {
        const bf16* G = (u.e == 0 ? GA : GB) + ((size_t)u.pm * 256 + wr * 64 + fr) * DM + u.pn * 256 + wc * 32 + 8 * fq;
        bf16* Mb = (bf16*)u.dst + (size_t)(wr * 64 + fr) * DM + wc * 32 + 8 * fq;
        f32x4* st = (f32x4*)stash + threadIdx.x;
        asm volatile("" : "+v"(G), "+v"(Mb), "+v"(st));
#pragma unroll
        for (int ai = 0; ai < 2; ++ai)
#pragma unroll
            for (int m = 0; m < 4; ++m)
#pragma unroll
                for (int bj = 0; bj < 2; ++bj) { const size_t ro = (size_t)(ai * 128 + m * 16) * DM + bj * 128;
                    const u32x4 g = *(const u32x4*)(G + ro);
                    f32x4 v0 = acc[ai][bj][m][0], v1 = acc[ai][bj][m][1];
                    v0[0] *= sigmoidf_(bflo(g.x)); v0[1] *= sigmoidf_(bfhi(g.x)); v0[2] *= sigmoidf_(bflo(g.y)); v0[3] *= sigmoidf_(bfhi(g.y));
                    v1[0] *= sigmoidf_(bflo(g.z)); v1[1] *= sigmoidf_(bfhi(g.z)); v1[2] *= sigmoidf_(bflo(g.w)); v1[3] *= sigmoidf_(bfhi(g.w));
                    const int si = ((ai * 4 + m) * 2 + bj) * 2;
                    if (u.e == 0) { st[(size_t)(si + 0) * NTHR] = v0; st[(size_t)(si + 1) * NTHR] = v1; }
                    else { v0 += st[(size_t)(si + 0) * NTHR]; v1 += st[(size_t)(si + 1) * NTHR];
                        u32x4 w; w.x = gm::cvt_pk_bf16(v0[0], v0[1]); w.y = gm::cvt_pk_bf16(v0[2], v0[3]); w.z = gm::cvt_pk_bf16(v1[0], v1[1]); w.w = gm::cvt_pk_bf16(v1[2], v1[3]);
                        *(u32x4*)(Mb + ro) = w; }
                    asm volatile("" ::: "memory"); }
    }
};

struct SchedP6 {
    int c; const char* M; const char* W; char* X1;
    __device__ __forceinline__ bool next(int i, gm::Unit& u) const {
        if (i >= 1) return false;
        int pm, pn; tile_order(c, 64, 4, pm, pn);
        u.A = M + (size_t)pm * 256 * 2048; u.B0 = W + (size_t)pn * 256 * 2048; u.B1 = u.B0 + (size_t)128 * 2048;
        u.dst = X1 + ((size_t)pm * 256 * DM + pn * 256) * 4; u.pm = pm; u.pn = pn; u.e = 0; u.rows = 256; return true;
    }
    __device__ __forceinline__ unsigned arow(const gm::Unit&, int r) const { return (unsigned)r; }
};
struct EpiP6 {
    static constexpr bool PERM = false;
    const float* x; const float* mod;
    __device__ __forceinline__ void operator()(const f32x4 (&acc)[2][2][4][2], const gm::Unit& u, int wr, int wc, int fr, int fq) const {
        const int b = u.pm >> 3; const int col0 = u.pn * 256 + wc * 32 + 4 * fq;
        const float* mg = mod + b * 6144 + 2 * DM + col0;
        f32x4 gv[2][2];
#pragma unroll
        for (int bj = 0; bj < 2; ++bj)
#pragma unroll
            for (int n = 0; n < 2; ++n) gv[bj][n] = *(const f32x4*)(mg + bj * 128 + n * 16);
#pragma unroll
        for (int ai = 0; ai < 2; ++ai)
#pragma unroll
            for (int m = 0; m < 4; ++m) { const size_t ro = (size_t)(wr * 64 + fr + ai * 128 + m * 16) * DM + wc * 32 + 4 * fq;
                const float* xr = x + ((size_t)u.pm * 256 * DM + u.pn * 256) + ro; float* orow = (float*)u.dst + ro;
#pragma unroll
                for (int bj = 0; bj < 2; ++bj)
#pragma unroll
                    for (int n = 0; n < 2; ++n) { const f32x4 xv = *(const f32x4*)(xr + bj * 128 + n * 16);
                        *(f32x4*)(orow + bj * 128 + n * 16) = xv + gv[bj][n] * acc[ai][bj][m][n]; } }
    }
};

__device__ __forceinline__ void p_norm2_route(Frame& F, const Args& a) {
    const float* mod = (const float*)(F.ws + WS_MOD); const float* g2 = a.in[IN_G2]; const float* wrt = (const float*)(F.ws + WS_WRT);
    const float* X1 = F.out; bf16* HX2 = (bf16*)(F.ws + WS_HX2);
    int* list = (int*)(F.ws + WS_LIST); float* wt = (float*)(F.ws + WS_WT); unsigned* cnt = F.ctl + CW_CNT;
    LAS float* gs = (LAS float*)F.lds; LAS float* sh = gs + DM;
    const int b = F.bid / 32;
    for (int k = F.tid; k < DM; k += NTHR) { gs[k] = g2[k] * (1.f + mod[b * 6144 + 4 * DM + k]); sh[k] = mod[b * 6144 + 3 * DM + k]; }
    __syncthreads();
    for (int r = F.wave; r < 64; r += NWAVES) {
        const int tok = F.bid * 64 + r;
        const f32x4* xr = (const f32x4*)(X1 + (size_t)tok * DM) + F.lane;
        f32x4 v[4]; float s = 0.f;
#pragma unroll
        for (int j = 0; j < 4; ++j) { v[j] = xr[64 * j]; s += (v[j].x * v[j].x + v[j].y * v[j].y) + (v[j].z * v[j].z + v[j].w * v[j].w); }
        const float rstd = rsqrtf(wave_sum(s) * (1.f / DM) + EPS);
        unsigned long long* o8 = (unsigned long long*)(HX2 + (size_t)tok * DM) + F.lane;
#pragma unroll
        for (int j = 0; j < 4; ++j) { const int k = 4 * F.lane + 256 * j;
            const f32x4 g = *(const LAS f32x4*)(gs + k), h = *(const LAS f32x4*)(sh + k);
            v[j].x = v[j].x * rstd * g.x + h.x; v[j].y = v[j].y * rstd * g.y + h.y; v[j].z = v[j].z * rstd * g.z + h.z; v[j].w = v[j].w * rstd * g.w + h.w;
            o8[64 * j] = (unsigned long long)pk2(v[j].x, v[j].y) | ((unsigned long long)pk2(v[j].z, v[j].w) << 32); }
        LAS float* lgs = (LAS float*)(F.lds + 8192) + F.wave * 64;
#pragma unroll 2
        for (int o = 0; o < 36; ++o) { const f32x4* wr_ = (const f32x4*)(wrt + o * DM) + F.lane; float p = 0.f;
#pragma unroll
            for (int j = 0; j < 4; ++j) { const f32x4 w = wr_[64 * j]; p += (v[j].x * w.x + v[j].y * w.y) + (v[j].z * w.z + v[j].w * w.w); }
            p = wave_sum(p) + wrt[36 * DM + o];
            if (F.lane == 0) lgs[o] = p; }
        LDS_WAIT(); asm volatile("" ::: "memory");
        float lg[36];
#pragma unroll
        for (int o = 0; o < 36; ++o) lg[o] = lgs[o];
        float mx = lg[0]; int gi = 0;
#pragma unroll
        for (int g = 1; g < 4; ++g) if (lg[g] > mx) { mx = lg[g]; gi = g; }
        float z = 0.f;
#pragma unroll
        for (int g = 0; g < 4; ++g) z += __expf(lg[g] - mx);
        const float pg = 1.f / z;
        float el[8];
#pragma unroll
        for (int e = 0; e < 8; ++e) el[e] = gi == 0 ? lg[4 + e] : (gi == 1 ? lg[12 + e] : (gi == 2 ? lg[20 + e] : lg[28 + e]));
        int e1 = 0; float m1 = el[0];
#pragma unroll
        for (int e = 1; e < 8; ++e) if (el[e] > m1) { m1 = el[e]; e1 = e; }
        int e2 = 0; float m2 = -3.0e38f;
#pragma unroll
        for (int e = 0; e < 8; ++e) if (e != e1 && el[e] > m2) { m2 = el[e]; e2 = e; }
        const float rr = __expf(m2 - m1); const float w1 = pg / (1.f + rr), w2 = pg * rr / (1.f + rr);
        if (F.lane == 0) {
            const int ea = gi * 8 + e1, eb = gi * 8 + e2;
            const unsigned pa = __hip_atomic_fetch_add(cnt + 64 * ea, 1u, __ATOMIC_RELAXED, __HIP_MEMORY_SCOPE_AGENT);
            const unsigned pb = __hip_atomic_fetch_add(cnt + 64 * eb, 1u, __ATOMIC_RELAXED, __HIP_MEMORY_SCOPE_AGENT);
            list[(size_t)ea * CAP + pa] = tok * 2; wt[tok * 2] = w1;
            list[(size_t)eb * CAP + pb] = tok * 2 + 1; wt[tok * 2 + 1] = w2;
        }
    }
}

struct MoeUnits {
    int ntile[NEXP + 1];
    int off[NEXP + 1];
};
struct SchedMoe1 {
    int G, c; const int* cntv; const int* list; const char* HX2; const char* W1T; const char* W3T; char* HH;
    __device__ __forceinline__ bool find(int L, int& e, int& rt, int& pn, int& rows, int& off) const {
        const int T = L >> 2; pn = L & 3; int acc_t = 0, acc_o = 0;
        for (int q = 0; q < NEXP; ++q) { const int cq = cntv[64 * q]; const int nt = (cq + 255) >> 8;
            if (T < acc_t + nt) { e = q; rt = T - acc_t; rows = cq - rt * 256; if (rows > 256) rows = 256; off = acc_o; return true; }
            acc_t += nt; acc_o += cq; }
        return false;
    }
    __device__ __forceinline__ bool next(int i, gm::Unit& u) const {
        int e, rt, pn, rows, off; if (!find(i * G + c, e, rt, pn, rows, off)) return false;
        u.A = HX2; u.B0 = W1T + ((size_t)e * DEXP + pn * 128) * 2048; u.B1 = W3T + ((size_t)e * DEXP + pn * 128) * 2048;
        u.dst = HH + ((size_t)(off + rt * 256) * DEXP + pn * 128) * 2; u.pm = rt; u.pn = pn; u.e = e; u.rows = rows; return true;
    }
    __device__ __forceinline__ unsigned arow(const gm::Unit& u, int r) const { const int rr = r < u.rows ? r : u.rows - 1; return (unsigned)(list[(size_t)u.e * CAP + u.pm * 256 + rr] >> 1); }
};
struct EpiMoe1 {
    static constexpr bool PERM = true;
    __device__ __forceinline__ void operator()(const f32x4 (&acc)[2][2][4][2], const gm::Unit& u, int wr, int wc, int fr, int fq) const {
        bf16* base = (bf16*)u.dst + (size_t)(wr * 64 + fr) * DEXP + wc * 32 + 8 * fq;
#pragma unroll
        for (int ai = 0; ai < 2; ++ai)
#pragma unroll
            for (int m = 0; m < 4; ++m) { const int r = ai * 128 + wr * 64 + m * 16 + fr; if (r >= u.rows) continue;
                const f32x4 u0 = acc[ai][0][m][0], u1 = acc[ai][0][m][1], v0 = acc[ai][1][m][0], v1 = acc[ai][1][m][1];
                u32x4 w; w.x = gm::cvt_pk_bf16(siluf_(u0[0]) * v0[0], siluf_(u0[1]) * v0[1]); w.y = gm::cvt_pk_bf16(siluf_(u0[2]) * v0[2], siluf_(u0[3]) * v0[3]);
                w.z = gm::cvt_pk_bf16(siluf_(u1[0]) * v1[0], siluf_(u1[1]) * v1[1]); w.w = gm::cvt_pk_bf16(siluf_(u1[2]) * v1[2], siluf_(u1[3]) * v1[3]);
                *(u32x4*)(base + (size_t)(ai * 128 + m * 16) * DEXP) = w; }
    }
};
struct SchedMoe2 {
    int G, c; const int* cntv; const char* HH; const char* W2T; char* Y;
    __device__ __forceinline__ bool next(int i, gm::Unit& u) const {
        const int L = i * G + c; const int T = L >> 2, pn = L & 3; int acc_t = 0, acc_o = 0;
        for (int q = 0; q < NEXP; ++q) { const int cq = cntv[64 * q]; const int nt = (cq + 255) >> 8;
            if (T < acc_t + nt) { const int rt = T - acc_t; int rows = cq - rt * 256; if (rows > 256) rows = 256;
                u.A = HH + (size_t)(acc_o + rt * 256) * DEXP * 2; u.B0 = W2T + ((size_t)q * DM + pn * 256) * (DEXP * 2); u.B1 = u.B0 + (size_t)128 * (DEXP * 2);
                u.dst = Y + (size_t)pn * 256 * 2; u.pm = rt; u.pn = pn; u.e = q; u.rows = rows; return true; }
            acc_t += nt; acc_o += cq; }
        return false;
    }
    __device__ __forceinline__ unsigned arow(const gm::Unit&, int r) const { return (unsigned)r; }
};
struct EpiMoe2 {
    static constexpr bool PERM = true;
    const int* list;
    __device__ __forceinline__ void operator()(const f32x4 (&acc)[2][2][4][2], const gm::Unit& u, int wr, int wc, int fr, int fq) const {
        const int* lp = list + (size_t)u.e * CAP + u.pm * 256;
#pragma unroll
        for (int ai = 0; ai < 2; ++ai)
#pragma unroll
            for (int m = 0; m < 4; ++m) { const int r = ai * 128 + wr * 64 + m * 16 + fr; if (r >= u.rows) continue;
                const int slot = lp[r]; bf16* rowp = (bf16*)u.dst + (size_t)slot * DM + wc * 32 + 8 * fq;
#pragma unroll
                for (int bj = 0; bj < 2; ++bj) { const f32x4 v0 = acc[ai][bj][m][0], v1 = acc[ai][bj][m][1];
                    u32x4 w; w.x = gm::cvt_pk_bf16(v0[0], v0[1]); w.y = gm::cvt_pk_bf16(v0[2], v0[3]); w.z = gm::cvt_pk_bf16(v1[0], v1[1]); w.w = gm::cvt_pk_bf16(v1[2], v1[3]);
                    *(u32x4*)(rowp + bj * 128) = w; } }
    }
};

__device__ __forceinline__ void p_final(Frame& F, const Args& a) {
    const float* mod = (const float*)(F.ws + WS_MOD); const float* fg = a.in[IN_FG]; const float* wt = (const float*)(F.ws + WS_WT);
    const bf16* Y = (const bf16*)(F.ws + WS_Y); float* X1 = F.out;
    for (int r = F.wave; r < 64; r += NWAVES) {
        const int tok = F.bid * 64 + r; const int b = tok >> 11;
        const float w0 = wt[tok * 2], w1 = wt[tok * 2 + 1];
        f32x4* xr = (f32x4*)(X1 + (size_t)tok * DM) + F.lane;
        const u32x2* y0 = (const u32x2*)(Y + (size_t)(tok * 2) * DM) + F.lane; const u32x2* y1 = (const u32x2*)(Y + (size_t)(tok * 2 + 1) * DM) + F.lane;
        f32x4 v[4]; float s = 0.f;
#pragma unroll
        for (int j = 0; j < 4; ++j) { const int k = 4 * F.lane + 256 * j;
            const f32x4 xv = xr[64 * j]; const u32x2 a0 = y0[64 * j], a1 = y1[64 * j]; const f32x4 g5 = *(const f32x4*)(mod + b * 6144 + 5 * DM + k);
            v[j].x = xv.x + g5.x * (w0 * bflo(a0.x) + w1 * bflo(a1.x)); v[j].y = xv.y + g5.y * (w0 * bfhi(a0.x) + w1 * bfhi(a1.x));
            v[j].z = xv.z + g5.z * (w0 * bflo(a0.y) + w1 * bflo(a1.y)); v[j].w = xv.w + g5.w * (w0 * bfhi(a0.y) + w1 * bfhi(a1.y));
            s += (v[j].x * v[j].x + v[j].y * v[j].y) + (v[j].z * v[j].z + v[j].w * v[j].w); }
        const float rstd = rsqrtf(wave_sum(s) * (1.f / DM) + EPS);
#pragma unroll
        for (int j = 0; j < 4; ++j) { const int k = 4 * F.lane + 256 * j; const f32x4 g = *(const f32x4*)(fg + k);
            xr[64 * j] = (f32x4){v[j].x * rstd * g.x, v[j].y * rstd * g.y, v[j].z * rstd * g.z, v[j].w * rstd * g.w}; }
    }
}
#ifndef MIX_FAST
#define MIX_FAST 0
#endif
__global__ void __launch_bounds__(NTHR, 2) mega(Args args) {
    extern __shared__ __attribute__((aligned(16))) unsigned char lds_raw[];
    Frame F;
    F.lds = (LAS unsigned char*)lds_raw; F.MISC = (volatile LAS unsigned*)(F.lds + LDSCTL_OFF);
    F.tid = threadIdx.x; F.lane = F.tid & 63; F.wave = __builtin_amdgcn_readfirstlane(F.tid >> 6);
    F.G = gridDim.x; F.bid = blockIdx.x; F.ws = args.ws; F.out = args.out; F.ctl = (unsigned*)(args.ws + WS_CTL);
    for (int u = F.tid; u < (LDS_BYTES - LDSCTL_OFF) / 4; u += NTHR) ((LAS unsigned*)(F.lds + LDSCTL_OFF))[u] = 0u;
    __syncthreads();
    XcdBarrier bar = xcd_barrier_post(F.ctl + CW_BAR + args.li * 3584, F.MISC + 8);
    const int lo = args.ph_lo, hi = args.ph_hi;
#define IN(k) (lo <= (k) && (k) < hi)
#define SEAM(k) do { if (IN(k) && IN((k) + 1)) xcd_barrier(bar); } while (0)
    unsigned char* ws = F.ws;
    if (IN(0)) { p0_prologue(F, args); } SEAM(0);
    if (IN(1)) { p1_norm(F, args); } SEAM(1);
    if (IN(2)) {
        SchedP2 S{F.G, F.bid, (const char*)F.out, (const char*)(ws + WS_WIN), (char*)(ws + WS_P), (char*)(ws + WS_PC)};
        EpiStoreBf16 E;
        gm::gemm_phase<SchedP2, EpiStoreBf16, false>(F.lds, DM, S, E);
    } SEAM(2);
#if MIX_FAST
    if (IN(3)) { p_mix1(F, args); } SEAM(3);
    if (IN(4)) { p_mix2(F, args); } SEAM(4);
#endif
    if (IN(5)) { p_ybg(F, args); p_moe_weights(F, args); } SEAM(5);
    if (IN(6)) {
        SchedP5 S{F.bid, (const char*)(ws + WS_YAG), (const char*)(ws + WS_YBG), (const char*)(ws + WS_WPA), (const char*)(ws + WS_WPB), nullptr, (char*)(ws + WS_M)};
        EpiP5 E{F.out + (size_t)F.bid * 65536, (const bf16*)(ws + WS_P + 7 * GS), (const bf16*)(ws + WS_P + 8 * GS)};
        gm::gemm_phase<SchedP5, EpiP5, false>(F.lds, DM, S, E);
    } SEAM(6);
    if (IN(7)) {
        SchedP6 S{F.bid, (const char*)(ws + WS_M), (const char*)(ws + WS_WOUT), (char*)F.out};
        EpiP6 E{args.in[IN_X], (const float*)(ws + WS_MOD)};
        gm::gemm_phase<SchedP6, EpiP6, false>(F.lds, DM, S, E);
    } SEAM(7);
    if (IN(8)) { p_norm2_route(F, args); } SEAM(8);
    if (IN(9)) {
        SchedMoe1 S{F.G, F.bid, (const int*)(F.ctl + CW_CNT), (const int*)(ws + WS_LIST), (const char*)(ws + WS_HX2), (const char*)(ws + WS_W1T), (const char*)(ws + WS_W3T), (char*)(ws + WS_HH)};
        EpiMoe1 E;
        gm::gemm_phase<SchedMoe1, EpiMoe1, true>(F.lds, DM, S, E);
    } SEAM(9);
    if (IN(10)) {
        SchedMoe2 S{F.G, F.bid, (const int*)(F.ctl + CW_CNT), (const char*)(ws + WS_HH), (const char*)(ws + WS_W2T), (char*)(ws + WS_Y)};
        EpiMoe2 E{(const int*)(ws + WS_LIST)};
        gm::gemm_phase<SchedMoe2, EpiMoe2, false>(F.lds, DEXP, S, E);
    } SEAM(10);
    if (IN(11)) { p_final(F, args); }
#undef IN
#undef SEAM
}

#if !MIX_FAST
__global__ void k_conv_f(const bf16* P0, const bf16* PC0, const float* cw, const float* cb, float* Ub, int b) {
    int t = blockIdx.x; int Lseg = t < CTX ? CTX : SEQ; int lt = t < CTX ? t : t - CTX;
    const bf16* base = t < CTX ? PC0 + (size_t)b * CTX * DM : P0 + (size_t)b * SEQ * DM;
    for (int ch = threadIdx.x; ch < DM; ch += 256) {
        float s = cb[ch];
#pragma unroll
        for (int k = 0; k < 4; ++k) { int tt = lt + k - 2; if (tt >= 0 && tt < Lseg) s += cw[k * DM + ch] * bf2f(base[(size_t)tt * DM + ch]); }
        Ub[(size_t)t * DM + ch] = s;
    }
}
__global__ void k_gates(const float* Ub, const float* wa, const float* ba, const float* wx, const float* bx, const float* lam, float* Aout, float* Bout, int d) {
    __shared__ float us[128];
    int t = blockIdx.x, h = blockIdx.y, j = threadIdx.x; int ch = h * 128 + j;
    float uval = Ub[(size_t)t * DM + ch];
    us[j] = uval; __syncthreads();
    const float* wah = wa + ((size_t)(d * 8 + h) * 128) * 128; const float* wxh = wx + ((size_t)(d * 8 + h) * 128) * 128;
    float ra = 0.f, ia = 0.f;
    for (int i = 0; i < 128; ++i) { float u = us[i]; ra += u * wah[i * 128 + j]; ia += u * wxh[i * 128 + j]; }
    float r = 1.f / (1.f + expf(-(ra + ba[d * DM + ch]))); float ig = 1.f / (1.f + expf(-(ia + bx[d * DM + ch])));
    float sp = log1pf(expf(-lam[d * DM + ch]));
    float log_a = -8.f * r * sp;
    Aout[(size_t)t * DM + ch] = expf(log_a); Bout[(size_t)t * DM + ch] = sqrtf(-expm1f(2.f * log_a)) * (ig * uval);
}
__global__ void k_lru_scan(const float* A0, const float* B0, const float* A1, const float* B1, float* YF, float* YB) {
    int g = blockIdx.x * 256 + threadIdx.x; int d = g / DM, ch = g % DM;
    if (d == 0) { float h = B0[ch];
        for (int t = 0; t < SEQ; ++t) { size_t o = (size_t)(CTX + t) * DM + ch; h = A0[o] * h + B0[o]; YF[(size_t)t * DM + ch] = h; }
    } else { float h = B1[(size_t)(CTX - 1) * DM + ch];
        for (int t = SEQ - 1; t >= 0; --t) { size_t o = (size_t)(CTX + t) * DM + ch; h = A1[o] * h + B1[o]; YB[(size_t)t * DM + ch] = h; }
    }
}
__global__ void k_yag_f(const float* YF, const float* YB, bf16* AY, int b) {
    int t = blockIdx.x;
    for (int ch = threadIdx.x; ch < DM; ch += 256) { size_t o = (size_t)t * DM + ch; bf16* p = AY + ((size_t)b * SEQ + t) * DM + ch;
        *p = (bf16)f2bf((YF[o] + YB[o]) * gelu_tanh(bf2f(*p))); }
}
__global__ __launch_bounds__(128) void k_hgrn_f(unsigned char* ws, const float* hg_lb) {
    __shared__ float gs[128], ks[128], qs[128];
    int h = blockIdx.x, d = blockIdx.y, b = blockIdx.z, j = threadIdx.x;
    float S[128];
#pragma unroll
    for (int i = 0; i < 128; ++i) S[i] = 0.f;
    const int c = h * 128 + j;
    const float lbj = 1.f / (1.f + expf(hg_lb[DM + c] - hg_lb[c]));
    bf16* Q = (bf16*)(ws + WS_P + 2 * GS); bf16* Fx = (bf16*)(ws + WS_P + (d == 0 ? 3 : 4) * GS); bf16* V = (bf16*)(ws + WS_P + 5 * GS);
    const bf16* Fc = (const bf16*)(ws + WS_PC + (d == 0 ? 1 : 2) * CGS); const bf16* Vc = (const bf16*)(ws + WS_PC + 3 * CGS);
    for (int s = 0; s < LT; ++s) {
        bool isx = s >= CTX; float fv, vv, qv = 0.f; size_t o;
        if (!isx) { int t = d == 0 ? s : (CTX - 1 - s); o = ((size_t)b * CTX + t) * DM + c; fv = bf2f(Fc[o]); vv = bf2f(Vc[o]); }
        else { int p = s - CTX; if (d == 1) p = SEQ - 1 - p; int tok = (p % 32) * 64 + (p / 32); o = ((size_t)b * SEQ + tok) * DM + c; fv = bf2f(Fx[o]); vv = bf2f(V[o]); qv = bf2f(Q[o]); }
        float gg = lbj + (1.f - lbj) / (1.f + expf(-fv));
        gs[j] = gg; ks[j] = 1.f - gg; qs[j] = qv / (1.f + expf(-qv));
        __syncthreads();
        float oo = 0.f;
#pragma unroll
        for (int i = 0; i < 128; ++i) { S[i] = gs[i] * S[i] + ks[i] * vv; oo += S[i] * qs[i]; }
        if (isx) Fx[o] = (bf16)f2bf(oo);
        __syncthreads();
    }
}
#endif

extern "C" void kernel_launch(void* const* d_in, const int* in_sizes, int n_in, void* d_out, int out_size, void* d_ws, size_t ws_size, hipStream_t stream) {
    static int grid = 0;
    if (grid == 0) {
        if (n_in != 29 || out_size != NTOK * DM || ws_size < WS_END) { fprintf(stderr, "kernel_launch: unexpected problem shape / workspace (%d inputs, out %d, ws %zu)\n", n_in, out_size, ws_size); grid = -1; return; }
        int dev = 0, cus = 0, per_cu = 0;
        if (hipGetDevice(&dev) != hipSuccess || hipDeviceGetAttribute(&cus, hipDeviceAttributeMultiprocessorCount, dev) != hipSuccess) { grid = -1; return; }
        if (hipFuncSetAttribute((const void*)mega, hipFuncAttributeMaxDynamicSharedMemorySize, LDS_BYTES) != hipSuccess) { grid = -1; return; }
        if (hipOccupancyMaxActiveBlocksPerMultiprocessor(&per_cu, (const void*)mega, NTHR, LDS_BYTES) != hipSuccess || per_cu < 1) { fprintf(stderr, "kernel_launch: occupancy query says %d blocks per CU\n", per_cu); }
        (void)hipGetLastError();
        grid = cus;
        if (grid != 256) { fprintf(stderr, "kernel_launch: built for 256 CUs, found %d\n", cus); grid = -1; return; }
    }
    if (grid < 0) return;
    hipMemsetAsync((char*)d_ws + WS_CTL, 0, CTL_BYTES, stream);
    Args a{};
    for (int i = 0; i < 29; ++i) a.in[i] = (const float*)d_in[i];
    a.out = (float*)d_out; a.ws = (unsigned char*)d_ws;
#if MIX_FAST
    a.ph_lo = 0; a.ph_hi = 12; a.li = 0;
    hipLaunchKernelGGL(mega, dim3(grid), dim3(NTHR), LDS_BYTES, stream, a);
#else
    a.ph_lo = 0; a.ph_hi = 3; a.li = 0;
    hipLaunchKernelGGL(mega, dim3(grid), dim3(NTHR), LDS_BYTES, stream, a);
    {
        unsigned char* ws = (unsigned char*)d_ws; float* sc = (float*)d_out;
        float* Ub = sc; float* A0 = Ub + (size_t)LT * DM; float* B0 = A0 + (size_t)LT * DM; float* A1 = B0 + (size_t)LT * DM; float* B1 = A1 + (size_t)LT * DM;
        float* YF = B1 + (size_t)LT * DM; float* YB = YF + (size_t)SEQ * DM;
        const float* cw = (const float*)d_in[IN_CONVW]; const float* cb = (const float*)d_in[IN_CONVB];
        const float* wa = (const float*)d_in[IN_WA]; const float* ba = (const float*)d_in[IN_BA]; const float* wx = (const float*)d_in[IN_WX]; const float* bx = (const float*)d_in[IN_BX]; const float* lam = (const float*)d_in[IN_LAM];
        for (int b = 0; b < NB; ++b) {
            k_conv_f<<<LT, 256, 0, stream>>>((const bf16*)(ws + WS_P), (const bf16*)(ws + WS_PC), cw, cb, Ub, b);
            k_gates<<<dim3(LT, 8), 128, 0, stream>>>(Ub, wa, ba, wx, bx, lam, A0, B0, 0);
            k_gates<<<dim3(LT, 8), 128, 0, stream>>>(Ub, wa, ba, wx, bx, lam, A1, B1, 1);
            k_lru_scan<<<8, 256, 0, stream>>>(A0, B0, A1, B1, YF, YB);
            k_yag_f<<<SEQ, 256, 0, stream>>>(YF, YB, (bf16*)(ws + WS_YAG), b);
        }
        k_hgrn_f<<<dim3(8, 2, NB), 128, 0, stream>>>(ws, (const float*)d_in[IN_HGLB]);
    }
    a.ph_lo = 5; a.ph_hi = 12; a.li = 1;
    hipLaunchKernelGGL(mega, dim3(grid), dim3(NTHR), LDS_BYTES, stream, a);
#endif
}
```

```cpp
#include <hip/hip_runtime.h>
#include <cstdio>
#include <cstdint>
#include <math.h>

#define LAS __attribute__((address_space(3)))
#define GAS __attribute__((address_space(1)))
typedef unsigned short bf16;
typedef short bf16x8 __attribute__((ext_vector_type(8)));
typedef float f32x4 __attribute__((ext_vector_type(4)));
typedef float f32x2 __attribute__((ext_vector_type(2)));
typedef unsigned u32x4 __attribute__((ext_vector_type(4)));
typedef unsigned u32x2 __attribute__((ext_vector_type(2)));

constexpr int DM = 1024, NB = 8, SEQ = 2048, CTX = 256, NTOK = NB * SEQ, NCTX = NB * CTX, INW = 9216, LT = CTX + SEQ;
constexpr int NEXP = 32, DEXP = 512, CAP = 16384;
constexpr float EPS = 1e-6f;
constexpr int NWAVES = 8, NTHR = 512;

constexpr size_t MiB = 1u << 20, KiB = 1024;
constexpr size_t WS_CTL = 0, CTL_BYTES = 64 * KiB;
constexpr size_t WS_MODP = 256 * KiB;
constexpr size_t WS_MOD = 2 * MiB;
constexpr size_t WS_LRUAGG = 2 * MiB + 512 * KiB;
constexpr size_t WS_LRUS0 = 4 * MiB + 512 * KiB;
constexpr size_t WS_WT = 4 * MiB + 768 * KiB;
constexpr size_t WS_LIST = 5 * MiB;
constexpr size_t WS_HGD = 7 * MiB;
constexpr size_t WS_WRT = 7 * MiB + 256 * KiB;
constexpr size_t WS_WIN = 8 * MiB;
constexpr size_t WS_WPA = 26 * MiB, WS_WPB = 28 * MiB, WS_WOUT = 30 * MiB;
constexpr size_t WS_WLRU = 32 * MiB;
constexpr size_t WS_P = 33 * MiB, GS = 32 * MiB;
constexpr size_t WS_PC = 321 * MiB, CGS = 4 * MiB;
constexpr size_t WS_END = 337 * MiB;
constexpr size_t WS_W1T = WS_P + 0 * GS, WS_W3T = WS_P + 2 * GS, WS_W2T = WS_P + 5 * GS;
constexpr size_t WS_YAG = WS_P + 1 * GS;
constexpr size_t WS_OF = WS_P + 3 * GS, WS_OB = WS_P + 4 * GS;
constexpr size_t WS_YBG = WS_P + 3 * GS;
constexpr size_t WS_M = WS_P + 4 * GS;
constexpr size_t WS_HX2 = WS_P + 1 * GS;
constexpr size_t WS_HH = WS_P + 3 * GS;
constexpr size_t WS_Y = WS_P + 6 * GS;

constexpr int CW_BAR = 1024;
constexpr int CW_CNT = 12288;

constexpr int RING_BYTES = 131072, LDSCTL_OFF = RING_BYTES, LDS_BYTES = 147456;

#define LDS_WAIT() asm volatile("s_waitcnt lgkmcnt(0)" ::: "memory")
#define VM_WAIT() asm volatile("s_waitcnt vmcnt(0)" ::: "memory")

__device__ __forceinline__ unsigned f2bf(float f) { unsigned u = __builtin_bit_cast(unsigned, f); return (u + 0x7fffu + ((u >> 16) & 1u)) >> 16; }
__device__ __forceinline__ unsigned pk2(float lo, float hi) { return f2bf(lo) | (f2bf(hi) << 16); }
__device__ __forceinline__ float bf2f(unsigned short b) { return __builtin_bit_cast(float, (unsigned)b << 16); }
__device__ __forceinline__ float bflo(unsigned w) { return __builtin_bit_cast(float, w << 16); }
__device__ __forceinline__ float bfhi(unsigned w) { return __builtin_bit_cast(float, w & 0xffff0000u); }
__device__ __forceinline__ float sigmoidf_(float x) { return 1.f / (1.f + __expf(-x)); }
__device__ __forceinline__ float siluf_(float x) { return x / (1.f + __expf(-x)); }
__device__ __forceinline__ float gelu_tanh(float x) { float u = 0.7978845608028654f * (x + 0.044715f * x * x * x); float e = __expf(2.f * u); return x * (1.f - 1.f / (1.f + e)); }
__device__ __forceinline__ float wave_sum(float v) {
#pragma unroll
    for (int o = 1; o < 64; o <<= 1) v += __shfl_xor(v, o);
    return v;
}

#define XB_TMO      128
#define XB_XCNT(j)  (256  + 64 * (j))
#define XB_XSUB(j)  (1280 + 64 * (j))
#define XB_XGEN(j)  (2304 + 64 * (j))
#define XB_TOP      3328
#define XB_TOPGEN   3392
#define XCD_BAR_WORDS 3456
#define XB_SPIN_CAP (1u << 20)
__device__ __forceinline__ unsigned xb_ld(unsigned* p)              { return __hip_atomic_load(p, __ATOMIC_RELAXED, __HIP_MEMORY_SCOPE_AGENT); }
__device__ __forceinline__ unsigned xb_add(unsigned* p, unsigned v) { return __hip_atomic_fetch_add(p, v, __ATOMIC_RELAXED, __HIP_MEMORY_SCOPE_AGENT); }
__device__ __forceinline__ unsigned xb_xcc_id() { return (unsigned)__builtin_amdgcn_s_getreg((3 << 11) | 20) & 0xFu; }
#define XB_SPIN(cond, bar) do { unsigned _sp = 0; while (cond) { __builtin_amdgcn_s_sleep(1); \
    if ((++_sp & 255u) == 0u) { if (xb_ld(&(bar)[XB_TMO])) break; if (_sp > XB_SPIN_CAP) { atomicAdd(&(bar)[XB_TMO], 1u); break; } } } } while (0)
struct XcdBarrier { unsigned* bar; unsigned x; volatile LAS unsigned* st; };
__device__ __forceinline__ XcdBarrier xcd_barrier_post(unsigned* bar, volatile LAS unsigned* st) {
    XcdBarrier b; b.bar = bar; b.x = xb_xcc_id(); b.st = st;
    if (threadIdx.x == 0) (void)xb_add(&bar[XB_XCNT(b.x)], 1u);
    return b;
}
__device__ __forceinline__ void xcd_barrier_complete(unsigned* bar, unsigned x, unsigned& nloc, unsigned& nx) {
    const unsigned G = gridDim.x * gridDim.y * gridDim.z;
    unsigned sum, cnt, mine, sp = 0u;
    for (;;) {
        sum = 0u; cnt = 0u; mine = 0u;
#pragma unroll
        for (unsigned j = 0; j < 16; ++j) { const unsigned c = xb_ld(&bar[XB_XCNT(j)]); sum += c; cnt += (c > 0u) ? 1u : 0u; mine = (j == x) ? c : mine; }
        if (sum == G) break;
        __builtin_amdgcn_s_sleep(1);
        if ((++sp & 255u) == 0u) { if (xb_ld(&bar[XB_TMO])) break; if (sp > XB_SPIN_CAP) { atomicAdd(&bar[XB_TMO], 1u); break; } }
    }
    nloc = mine > 0u ? mine : 1u; nx = cnt > 0u ? cnt : 1u;
}
__device__ __forceinline__ void xcd_barrier(const XcdBarrier& b) {
    asm volatile("s_waitcnt vmcnt(0)" ::: "memory");
    __syncthreads();
    if (threadIdx.x == 0) {
        unsigned* bar = b.bar;
        __builtin_amdgcn_s_waitcnt(0);
        unsigned nloc = b.st[0], nx = b.st[1];
        if (nloc == 0u) { xcd_barrier_complete(bar, b.x, nloc, nx); b.st[0] = nloc; b.st[1] = nx; }
        const unsigned old = xb_add(&bar[XB_XSUB(b.x)], 1u);
        const unsigned gen = old / nloc;
        if (old + 1u == (gen + 1u) * nloc) {
            __builtin_amdgcn_fence(__ATOMIC_RELEASE, "agent");
            asm volatile("s_waitcnt vmcnt(0)" ::: "memory");
            const unsigned og = xb_add(&bar[XB_TOP], 1u);
            const unsigned tg = og / nx;
            if (og + 1u == (tg + 1u) * nx) xb_add(&bar[XB_TOPGEN], 1u);
            else XB_SPIN(xb_ld(&bar[XB_TOPGEN]) == tg, bar);
            __builtin_amdgcn_fence(__ATOMIC_ACQUIRE, "agent");
            xb_add(&bar[XB_XGEN(b.x)], 1u);
            asm volatile("s_waitcnt vmcnt(0)" ::: "memory");
        } else {
            XB_SPIN(xb_ld(&bar[XB_XGEN(b.x)]) == gen, bar);
            __builtin_amdgcn_fence(__ATOMIC_ACQUIRE, "agent");
            asm volatile("s_waitcnt vmcnt(0)" ::: "memory");
        }
    }
    __syncthreads();
}

namespace gm {
constexpr int BM = 256, BK = 64, HALF = 128, HTB = HALF * BK * 2;
__device__ __forceinline__ int lds_byte(int r, int c) { const int st = (r >> 4) * 2 + (c >> 5), rr = r & 15, cc = c & 31, ob = rr * 64 + cc * 2; return st * 1024 + (ob ^ (((ob >> 9) & 1) << 5)); }
__device__ __forceinline__ void stage_rc(int b, int& R, int& C) { const int st = b / 1024, sb = b % 1024, swz = sb ^ (((sb >> 9) & 1) << 5); R = (st >> 1) * 16 + swz / 64; C = (st & 1) * 32 + (swz % 64) / 2; }
__device__ __forceinline__ int perm32(int rho) { const int n = rho >> 4, i = rho & 15; return 8 * (i >> 2) + 4 * n + (i & 3); }
__device__ __forceinline__ unsigned cvt_pk_bf16(float lo, float hi) { unsigned r; asm volatile("v_cvt_pk_bf16_f32 %0, %1, %2" : "=v"(r) : "v"(lo), "v"(hi)); return r; }

struct Unit { const char* A; const char* B0; const char* B1; char* dst; int pm, pn, e, rows; };

template <class Sched, class Epi, bool GATHER>
__device__ __forceinline__ void gemm_phase(LAS unsigned char* lds, const int K, const Sched& S, const Epi& E) {
    const int tid = threadIdx.x, wid = __builtin_amdgcn_readfirstlane(tid >> 6), lane = tid & 63, wr = wid >> 2, wc = wid & 3, fr = lane & 15, fq = lane >> 4;
    const int nt = K / BK;
    unsigned voffB[2]; int Rr[2]; unsigned Cb[2];
#pragma unroll
    for (int i = 0; i < 2; ++i) { int R, C; stage_rc(tid * 16 + i * 8192, R, C); const int Rb = Epi::PERM ? ((R & ~31) + perm32(R & 31)) : R;
        Rr[i] = R; Cb[i] = (unsigned)C * 2u; voffB[i] = (unsigned)(Rb * K + C) * 2u; }
    const unsigned rowb = (unsigned)K * 2u;
    const size_t kstep = (size_t)(BK * 2);
    const unsigned ldsw = (unsigned)wid * 1024u;
    const int aoff = lds_byte(wr * 64 + fr, fq * 8), boff = lds_byte(wc * 32 + fr, fq * 8);
#define GM_SA(b, h) (((b) * 2 + (h)) * HTB)
#define GM_SB(b, h) ((4 + (b) * 2 + (h)) * HTB)
#define GM_STAGE(bufoff, gbase, voff) do { _Pragma("unroll") for (int _i = 0; _i < 2; ++_i) \
        __builtin_amdgcn_global_load_lds((const unsigned*)((const char*)(gbase) + (voff)[_i]), (LAS unsigned*)(lds + (bufoff) + ldsw + _i * 8192), 16, 0, 0); } while (0)
#define GM_LDA(dst, b, h) do { _Pragma("unroll") for (int m = 0; m < 4; ++m) _Pragma("unroll") for (int k = 0; k < 2; ++k) dst[m][k] = *(const LAS bf16x8*)(lds + GM_SA(b, h) + aoff + m * 2048 + k * 1024); } while (0)
#define GM_LDB(dst, b, h) do { _Pragma("unroll") for (int n = 0; n < 2; ++n) _Pragma("unroll") for (int k = 0; k < 2; ++k) dst[n][k] = *(const LAS bf16x8*)(lds + GM_SB(b, h) + boff + n * 2048 + k * 1024); } while (0)
#define GM_MMA(ai, bj, At, Bt) do { __builtin_amdgcn_s_setprio(1); _Pragma("unroll") for (int m = 0; m < 4; ++m) _Pragma("unroll") for (int n = 0; n < 2; ++n) _Pragma("unroll") for (int k = 0; k < 2; ++k) \
        acc[ai][bj][m][n] = __builtin_amdgcn_mfma_f32_16x16x32_bf16(Bt[n][k], At[m][k], acc[ai][bj][m][n], 0, 0, 0); __builtin_amdgcn_s_setprio(0); } while (0)
#define GM_WAIT_V(n) asm volatile("s_waitcnt vmcnt(" #n ")" ::: "memory")
#define GM_WAIT_L(n) asm volatile("s_waitcnt lgkmcnt(" #n ")" ::: "memory")
#define GM_BAR __builtin_amdgcn_s_barrier()
#define GM_SCHED __builtin_amdgcn_sched_barrier(0)
#define GM_AOFFS(u, o) do { _Pragma("unroll") for (int _h = 0; _h < 2; ++_h) _Pragma("unroll") for (int _i = 0; _i < 2; ++_i) \
        (o)[_h][_i] = (GATHER ? S.arow((u), _h * HALF + Rr[_i]) : (unsigned)(_h * HALF + Rr[_i])) * rowb + Cb[_i]; } while (0)
    Unit cur, nxt; int ui = 0;
    if (!S.next(0, cur)) return;
    f32x4 acc[2][2][4][2];
#pragma unroll
    for (int a = 0; a < 2; ++a)
#pragma unroll
        for (int b = 0; b < 2; ++b)
#pragma unroll
            for (int m = 0; m < 4; ++m)
#pragma unroll
                for (int n = 0; n < 2; ++n) acc[a][b][m][n] = (f32x4){0.f, 0.f, 0.f, 0.f};
    bf16x8 At[4][2], B0[2][2], B1[2][2];
    unsigned ca[2][2], na[2][2];
    GM_AOFFS(cur, ca);
    const char* cA = cur.A; const char* cB0 = cur.B0; const char* cB1 = cur.B1;
    GM_STAGE(GM_SB(0, 0), cB0, voffB); GM_STAGE(GM_SB(0, 1), cB1, voffB); GM_STAGE(GM_SA(0, 0), cA, ca[0]); GM_STAGE(GM_SA(0, 1), cA, ca[1]);
    if (wr == 1) GM_BAR;
    GM_WAIT_V(2); GM_BAR;
    GM_STAGE(GM_SB(1, 0), cB0 + kstep, voffB); GM_STAGE(GM_SA(1, 0), cA + kstep, ca[0]); GM_STAGE(GM_SB(1, 1), cB1 + kstep, voffB);
    GM_WAIT_V(6); GM_BAR;
    for (;;) {
        const bool has_next = S.next(ui + 1, nxt);
        const char* nA = has_next ? nxt.A : cA; const char* nB0 = has_next ? nxt.B0 : cB0; const char* nB1 = has_next ? nxt.B1 : cB1;
        if (has_next) { GM_AOFFS(nxt, na); } else {
#pragma unroll
            for (int h = 0; h < 2; ++h)
#pragma unroll
                for (int i = 0; i < 2; ++i) na[h][i] = ca[h][i]; }
        for (int t = 0; t < nt; t += 2) {
            const bool last = (t == nt - 2);
            const char* a1 = cA + (size_t)(t + 1) * kstep;
            const char* a2 = last ? nA : cA + (size_t)(t + 2) * kstep;
            const char* b20 = last ? nB0 : cB0 + (size_t)(t + 2) * kstep; const char* b21 = last ? nB1 : cB1 + (size_t)(t + 2) * kstep;
            const char* a3 = a2 + kstep; const char* b30 = b20 + kstep; const char* b31 = b21 + kstep;
            unsigned o2[2][2];
#pragma unroll
            for (int h = 0; h < 2; ++h)
#pragma unroll
                for (int i = 0; i < 2; ++i) o2[h][i] = last ? na[h][i] : ca[h][i];
            GM_LDB(B0, 0, 0); GM_LDB(B1, 0, 1); GM_SCHED; GM_LDA(At, 0, 0); GM_STAGE(GM_SA(1, 1), a1, ca[1]);
            GM_WAIT_V(8); GM_WAIT_L(0); GM_BAR; GM_MMA(0, 0, At, B0); GM_MMA(0, 1, At, B1); GM_BAR; GM_SCHED;
            GM_LDA(At, 0, 1); GM_STAGE(GM_SB(0, 0), b20, voffB); GM_STAGE(GM_SB(0, 1), b21, voffB); GM_STAGE(GM_SA(0, 0), a2, o2[0]);
            GM_WAIT_V(8); GM_WAIT_L(0); GM_BAR; GM_MMA(1, 0, At, B0); GM_MMA(1, 1, At, B1); GM_BAR; GM_SCHED;
            GM_LDB(B0, 1, 0); GM_LDB(B1, 1, 1); GM_SCHED; GM_LDA(At, 1, 0); GM_STAGE(GM_SA(0, 1), a2, o2[1]);
            GM_WAIT_V(8); GM_WAIT_L(0); GM_BAR; GM_MMA(0, 0, At, B0); GM_MMA(0, 1, At, B1); GM_BAR; GM_SCHED;
            GM_LDA(At, 1, 1); GM_STAGE(GM_SB(1, 0), b30, voffB); GM_STAGE(GM_SB(1, 1), b31, voffB); GM_STAGE(GM_SA(1, 0), a3, o2[0]);
            GM_WAIT_V(8); GM_WAIT_L(0); GM_BAR; GM_MMA(1, 0, At, B0); GM_MMA(1, 1, At, B1); GM_BAR; GM_SCHED;
        }
        if (wr == 0) GM_BAR;
        E(acc, cur, wr, wc, fr, fq);
        if (!has_next) break;
#pragma unroll
        for (int a = 0; a < 2; ++a)
#pragma unroll
            for (int b = 0; b < 2; ++b)
#pragma unroll
                for (int m = 0; m < 4; ++m)
#pragma unroll
                    for (int n = 0; n < 2; ++n) acc[a][b][m][n] = (f32x4){0.f, 0.f, 0.f, 0.f};
        cur = nxt; cA = nA; cB0 = nB0; cB1 = nB1; ++ui;
#pragma unroll
        for (int h = 0; h < 2; ++h)
#pragma unroll
            for (int i = 0; i < 2; ++i) ca[h][i] = na[h][i];
        if (wr == 1) GM_BAR;
    }
    GM_WAIT_V(0);
    GM_BAR;
#undef GM_SA
#undef GM_SB
#undef GM_STAGE
#undef GM_LDA
#undef GM_LDB
#undef GM_MMA
#undef GM_WAIT_V
#undef GM_WAIT_L
#undef GM_BAR
#undef GM_SCHED
#undef GM_AOFFS
}
}
struct Args {
    const float* in[29]; float* out; unsigned char* ws; int ph_lo, ph_hi, li, pad;
};
struct Frame {
    LAS unsigned char* lds; volatile LAS unsigned* MISC;
    unsigned* ctl; unsigned char* ws; float* out;
    int tid, lane, wave, G, bid;
};
enum { IN_X = 0, IN_C, IN_CTX, IN_CCTX, IN_WMOD, IN_BMOD, IN_G1, IN_WIN, IN_CONVW, IN_CONVB, IN_WA, IN_BA, IN_WX, IN_BX, IN_LAM, IN_HGLB, IN_HGN,
       IN_WPA, IN_WPB, IN_WOUT, IN_G2, IN_WRG, IN_BRG, IN_WRE, IN_BRE, IN_W1, IN_W3, IN_W2, IN_FG };

__device__ __forceinline__ void transpose_item(const float* W, int ldw, int K, bf16* WT, int k0, int n0, LAS float* scr, int lane) {
#pragma unroll 8
    for (int i = 0; i < 32; ++i) { const int kk = 2 * i + (lane >> 5); scr[kk * 33 + (lane & 31)] = W[(size_t)(k0 + kk) * ldw + n0 + (lane & 31)]; }
    LDS_WAIT(); asm volatile("" ::: "memory");
    const int c = lane & 7;
#pragma unroll
    for (int j = 0; j < 4; ++j) { const int n = (lane >> 3) + 8 * j; const LAS float* s = scr + (8 * c) * 33 + n;
        u32x4 o; o.x = pk2(s[0 * 33], s[1 * 33]); o.y = pk2(s[2 * 33], s[3 * 33]); o.z = pk2(s[4 * 33], s[5 * 33]); o.w = pk2(s[6 * 33], s[7 * 33]);
        *(u32x4*)(WT + (size_t)n * K + k0 + 8 * c) = o; }
    LDS_WAIT(); asm volatile("" ::: "memory");
}

__device__ __forceinline__ void p0_mod_item(Frame& F, const Args& a, int item) {
    const int cb = item % 24, ks = item / 24;
    LAS float* sv = (LAS float*)F.lds;
    LAS float* red = sv + 9 * 128;
    const float* c = a.in[IN_C]; const float* cc = a.in[IN_CCTX]; const float* wmod = a.in[IN_WMOD];
    for (int i = F.tid; i < 9 * 128; i += NTHR) { const int r = i >> 7, k = i & 127; const float v = r < 8 ? c[r * DM + ks * 128 + k] : cc[ks * 128 + k]; sv[i] = siluf_(v); }
    __syncthreads();
    const int col = cb * 256 + (F.tid & 255), kh = F.tid >> 8;
    float acc[9];
#pragma unroll
    for (int r = 0; r < 9; ++r) acc[r] = 0.f;
    for (int k = 0; k < 64; ++k) { const int kk = kh * 64 + k; const float w = wmod[(size_t)(ks * 128 + kk) * 6144 + col];
#pragma unroll
        for (int r = 0; r < 9; ++r) acc[r] += sv[r * 128 + kk] * w; }
    if (kh == 1) {
#pragma unroll
        for (int r = 0; r < 9; ++r) red[r * 256 + (F.tid & 255)] = acc[r]; }
    __syncthreads();
    float* modp = (float*)(F.ws + WS_MODP);
    if (kh == 0) {
#pragma unroll
        for (int r = 0; r < 9; ++r) modp[(size_t)(ks * 9 + r) * 6144 + col] = acc[r] + red[r * 256 + F.tid]; }
    __syncthreads();
}
__device__ __forceinline__ float mod_from_partials(const float* modp, const float* bmod, int row, int j) {
    float s = bmod[j];
#pragma unroll
    for (int ks = 0; ks < 8; ++ks) s += modp[(size_t)(ks * 9 + row) * 6144 + j];
    return s;
}

__device__ __forceinline__ void p0_prologue(Frame& F, const Args& a) {
    if (F.bid < 192) p0_mod_item(F, a, F.bid);
    LAS float* scr = (LAS float*)(F.lds + F.wave * 16384);
    const int gw = F.bid * NWAVES + F.wave, NGW = F.G * NWAVES;
    constexpr int I_IN = 16 * 288, I_PR = 16 * 32, I_LRU = 32 * 8;
    constexpr int NITEMS = I_IN + 3 * I_PR + I_LRU;
    for (int it = gw; it < NITEMS; it += NGW) {
        int r = it;
        if (r < I_IN) { const int kb = r / 288, nb = r % 288; transpose_item(a.in[IN_WIN], INW, DM, (bf16*)(F.ws + WS_WIN) + (size_t)(nb * 32) * DM, kb * 64, nb * 32, scr, F.lane); continue; } r -= I_IN;
        if (r < 3 * I_PR) { const int w = r / I_PR, q = r % I_PR, kb = q / 32, nb = q % 32;
            const float* W = a.in[w == 0 ? IN_WPA : (w == 1 ? IN_WPB : IN_WOUT)]; bf16* WT = (bf16*)(F.ws + (w == 0 ? WS_WPA : (w == 1 ? WS_WPB : WS_WOUT)));
            transpose_item(W, DM, DM, WT + (size_t)(nb * 32) * DM, kb * 64, nb * 32, scr, F.lane); continue; } r -= 3 * I_PR;
        { const int mat = r / 8, q = r % 8, kb = q / 4, nb = q % 4;
          const int which = mat >> 4, dh = mat & 15;
          const float* W = a.in[which == 0 ? IN_WA : IN_WX] + (size_t)dh * 128 * 128; bf16* WT = (bf16*)(F.ws + WS_WLRU) + (size_t)mat * 128 * 128;
          transpose_item(W, 128, 128, WT + (size_t)(nb * 32) * 128, kb * 64, nb * 32, scr, F.lane); }
    }
    float* wrt = (float*)(F.ws + WS_WRT);
    for (int i = F.bid * NTHR + F.tid; i < 36 * 1024 + 36; i += F.G * NTHR) {
        if (i < 36 * 1024) { const int o = i >> 10, k = i & 1023; wrt[i] = o < 4 ? a.in[IN_WRG][k * 4 + o] : a.in[IN_WRE][k * 32 + (o - 4)]; }
        else { const int o = i - 36 * 1024; wrt[i] = o < 4 ? a.in[IN_BRG][o] : a.in[IN_BRE][o - 4]; }
    }
}

__device__ __forceinline__ void norm_rows(Frame& F, const float* src, bf16* dst, int row0, int nrows, const LAS float* gs, const LAS float* sh) {
    for (int r = F.wave; r < nrows; r += NWAVES) {
        const f32x4* xr = (const f32x4*)(src + (size_t)(row0 + r) * DM) + F.lane;
        f32x4 v[4]; float s = 0.f;
#pragma unroll
        for (int j = 0; j < 4; ++j) { v[j] = xr[64 * j]; s += (v[j].x * v[j].x + v[j].y * v[j].y) + (v[j].z * v[j].z + v[j].w * v[j].w); }
        const float rstd = rsqrtf(wave_sum(s) * (1.f / DM) + EPS);
        unsigned long long* o8 = (unsigned long long*)(dst + (size_t)(row0 + r) * DM) + F.lane;
#pragma unroll
        for (int j = 0; j < 4; ++j) { const int k = 4 * F.lane + 256 * j;
            const f32x4 g = *(const LAS f32x4*)(gs + k), h = *(const LAS f32x4*)(sh + k);
            const float o0 = v[j].x * rstd * g.x + h.x, o1 = v[j].y * rstd * g.y + h.y, o2 = v[j].z * rstd * g.z + h.z, o3 = v[j].w * rstd * g.w + h.w;
            o8[64 * j] = (unsigned long long)pk2(o0, o1) | ((unsigned long long)pk2(o2, o3) << 32); }
    }
}
__device__ __forceinline__ void p1_norm(Frame& F, const Args& a) {
    const float* modp = (const float*)(F.ws + WS_MODP); const float* bmod = a.in[IN_BMOD]; const float* g1 = a.in[IN_G1];
    LAS float* gs = (LAS float*)F.lds; LAS float* sh = gs + DM;
    bf16* H = (bf16*)F.out;
    float* mod = (float*)(F.ws + WS_MOD);
    for (int i = F.bid * NTHR + F.tid; i < 9 * 6144; i += F.G * NTHR) mod[i] = mod_from_partials(modp, bmod, i / 6144, i % 6144);
    const int b = F.bid / 32;
    for (int k = F.tid; k < DM; k += NTHR) { gs[k] = g1[k] * (1.f + mod_from_partials(modp, bmod, b, DM + k)); sh[k] = mod_from_partials(modp, bmod, b, k); }
    __syncthreads();
    norm_rows(F, a.in[IN_X], H, F.bid * 64, 64, gs, sh);
    __syncthreads();
    for (int k = F.tid; k < DM; k += NTHR) { gs[k] = g1[k] * (1.f + mod_from_partials(modp, bmod, 8, DM + k)); sh[k] = mod_from_partials(modp, bmod, 8, k); }
    __syncthreads();
    norm_rows(F, a.in[IN_CTX], H + (size_t)NTOK * DM, F.bid * 8, 8, gs, sh);
    __syncthreads();
}

struct EpiStoreBf16 {
    static constexpr bool PERM = true;
    __device__ __forceinline__ void operator()(const f32x4 (&acc)[2][2][4][2], const gm::Unit& u, int wr, int wc, int fr, int fq) const {
        bf16* base = (bf16*)u.dst + (size_t)(wr * 64 + fr) * DM + wc * 32 + 8 * fq;
#pragma unroll
        for (int ai = 0; ai < 2; ++ai)
#pragma unroll
            for (int m = 0; m < 4; ++m) { bf16* rowp = base + (size_t)(ai * 128 + m * 16) * DM;
#pragma unroll
                for (int bj = 0; bj < 2; ++bj) { const f32x4 v0 = acc[ai][bj][m][0], v1 = acc[ai][bj][m][1];
                    u32x4 w; w.x = gm::cvt_pk_bf16(v0[0], v0[1]); w.y = gm::cvt_pk_bf16(v0[2], v0[3]); w.z = gm::cvt_pk_bf16(v1[0], v1[1]); w.w = gm::cvt_pk_bf16(v1[2], v1[3]);
                    *(u32x4*)(rowp + bj * 128) = w; } }
    }
};
__device__ __forceinline__ void tile_order(int L, int nM, int nN, int& pm, int& pn) {
    const int nwg = nM * nN; int wgid = L;
    { const int q = nwg / 8, r = nwg % 8, xcd = wgid % 8, off = wgid / 8; wgid = (xcd < r ? xcd * (q + 1) : r * (q + 1) + (xcd - r) * q) + off; }
    const int nig = 8 * nN, gid = wgid / nig, fm = gid * 8, gsz = (nM - fm) < 8 ? (nM - fm) : 8;
    pm = fm + ((wgid % nig) % gsz); pn = (wgid % nig) / gsz;
}
struct SchedP2 {
    int G, c; const char* H; const char* Wt; char* P; char* PC;
    __device__ __forceinline__ bool next(int i, gm::Unit& u) const {
        int L = i * G + c;
        if (L < 64 * 36) { int pm, pn; tile_order(L, 64, 36, pm, pn);
            u.A = H + (size_t)pm * 256 * 2048; u.B0 = Wt + (size_t)pn * 256 * 2048; u.B1 = u.B0 + (size_t)128 * 2048;
            u.dst = P + (size_t)(pn >> 2) * GS + ((size_t)pm * 256 * DM + (pn & 3) * 256) * 2; u.pm = pm; u.pn = pn; u.e = 0; u.rows = 256; return true; }
        L -= 64 * 36; if (L >= 128) return false;
        const int pmc = L >> 4, j = L & 15, slot = j >> 2, g = slot == 0 ? 0 : slot + 2, pn = g * 4 + (j & 3);
        u.A = H + (size_t)(NTOK + pmc * 256) * 2048; u.B0 = Wt + (size_t)pn * 256 * 2048; u.B1 = u.B0 + (size_t)128 * 2048;
        u.dst = PC + (size_t)slot * CGS + ((size_t)pmc * 256 * DM + (j & 3) * 256) * 2; u.pm = pmc; u.pn = pn; u.e = 0; u.rows = 256; return true;
    }
    __device__ __forceinline__ unsigned arow(const gm::Unit&, int r) const { return (unsigned)r; }
};
constexpr int LRU_T = 128, LRU_NCH = SEQ / LRU_T, UF_LD = 144;
constexpr int LRU_UBF = 0, LRU_UF = 144 * 256;
constexpr float LOG2E = 1.4426950408889634f;

struct LruCoef { float ba, bx, ca; };

__device__ __forceinline__ void lru_conv(Frame& F, const Args& a, int b, int h, int c, bool special) {
    const bf16* AX = (const bf16*)(F.ws + WS_P) + (size_t)b * SEQ * DM + h * 128;
    const float* cw = a.in[IN_CONVW] + h * 128; const float* cb = a.in[IN_CONVB] + h * 128;
    LAS unsigned char* ubf = F.lds + LRU_UBF; LAS float* uf = (LAS float*)(F.lds + LRU_UF);
    const int cg = F.tid & 15;
    float w[4][8], bs[8];
#pragma unroll
    for (int k = 0; k < 4; ++k) { const f32x4 w0 = *(const f32x4*)(cw + k * DM + 8 * cg), w1 = *(const f32x4*)(cw + k * DM + 8 * cg + 4);
        w[k][0] = w0.x; w[k][1] = w0.y; w[k][2] = w0.z; w[k][3] = w0.w; w[k][4] = w1.x; w[k][5] = w1.y; w[k][6] = w1.z; w[k][7] = w1.w; }
    { const f32x4 b0 = *(const f32x4*)(cb + 8 * cg), b1 = *(const f32x4*)(cb + 8 * cg + 4); bs[0] = b0.x; bs[1] = b0.y; bs[2] = b0.z; bs[3] = b0.w; bs[4] = b1.x; bs[5] = b1.y; bs[6] = b1.z; bs[7] = b1.w; }
    const int nitem = special ? (LRU_T + 2) * 16 : LRU_T * 16;
    for (int item = F.tid; item < nitem; item += NTHR) {
        const int tl = item >> 4;
        float u[8];
#pragma unroll
        for (int q = 0; q < 8; ++q) u[q] = bs[q];
        if (tl < LRU_T) {
            const int t = c * LRU_T + tl;
#pragma unroll
            for (int k = 0; k < 4; ++k) { const int tt = t + k - 2;
                if (tt >= 0 && tt < SEQ) { const u32x4 v = *(const u32x4*)(AX + (size_t)tt * DM + 8 * cg);
                    u[0] += w[k][0] * bflo(v.x); u[1] += w[k][1] * bfhi(v.x); u[2] += w[k][2] * bflo(v.y); u[3] += w[k][3] * bfhi(v.y);
                    u[4] += w[k][4] * bflo(v.z); u[5] += w[k][5] * bfhi(v.z); u[6] += w[k][6] * bflo(v.w); u[7] += w[k][7] * bfhi(v.w); } }
        } else {
            const bf16* AC = (const bf16*)(F.ws + WS_PC) + (size_t)b * CTX * DM + h * 128;
            const int t = tl == LRU_T ? 0 : CTX - 1;
#pragma unroll
            for (int k = 0; k < 4; ++k) { const int tt = t + k - 2;
                if (tt >= 0 && tt < CTX) { const u32x4 v = *(const u32x4*)(AC + (size_t)tt * DM + 8 * cg);
                    u[0] += w[k][0] * bflo(v.x); u[1] += w[k][1] * bfhi(v.x); u[2] += w[k][2] * bflo(v.y); u[3] += w[k][3] * bfhi(v.y);
                    u[4] += w[k][4] * bflo(v.z); u[5] += w[k][5] * bfhi(v.z); u[6] += w[k][6] * bflo(v.w); u[7] += w[k][7] * bfhi(v.w); } }
        }
        *(LAS f32x4*)(uf + tl * UF_LD + 8 * cg) = (f32x4){u[0], u[1], u[2], u[3]};
        *(LAS f32x4*)(uf + tl * UF_LD + 8 * cg + 4) = (f32x4){u[4], u[5], u[6], u[7]};
        u32x4 p; p.x = pk2(u[0], u[1]); p.y = pk2(u[2], u[3]); p.z = pk2(u[4], u[5]); p.w = pk2(u[6], u[7]);
        *(LAS u32x4*)(ubf + tl * 256 + ((cg ^ (tl & 15)) << 4)) = p;
    }
    if (special) for (int item = F.tid; item < 14 * 16; item += NTHR) { const int tl = LRU_T + 2 + (item >> 4);
        *(LAS u32x4*)(ubf + tl * 256 + ((cg ^ (tl & 15)) << 4)) = (u32x4){0u, 0u, 0u, 0u}; }
}
__device__ __forceinline__ void lru_load_w(Frame& F, int d, int h, bf16x8 (&Bw)[2][4]) {
    const int fr = F.lane & 15, fq = F.lane >> 4;
#pragma unroll
    for (int which = 0; which < 2; ++which) { const bf16* W = (const bf16*)(F.ws + WS_WLRU) + (size_t)(which * 16 + d * 8 + h) * 128 * 128 + (size_t)(16 * F.wave + fr) * 128 + 8 * fq;
#pragma unroll
        for (int kk = 0; kk < 4; ++kk) Bw[which][kk] = *(const bf16x8*)(W + kk * 32); }
}
__device__ __forceinline__ LruCoef lru_coef(const Args& a, int d, int ch) {
    LruCoef k; k.ba = a.in[IN_BA][d * DM + ch]; k.bx = a.in[IN_BX][d * DM + ch];
    const float sp = log1pf(expf(-a.in[IN_LAM][d * DM + ch])); k.ca = -8.f * sp * LOG2E; return k;
}
__device__ __forceinline__ void lru_tile(Frame& F, int m, const bf16x8 (&Bw)[2][4], const LruCoef& k, float (&av)[4], float (&bv)[4]) {
    const int fr = F.lane & 15, fq = F.lane >> 4;
    const LAS unsigned char* ubf = F.lds + LRU_UBF; const LAS float* uf = (const LAS float*)(F.lds + LRU_UF);
    f32x4 ar = {0.f, 0.f, 0.f, 0.f}, ai = {0.f, 0.f, 0.f, 0.f};
    const int row = m * 16 + fr;
#pragma unroll
    for (int kk = 0; kk < 4; ++kk) { const bf16x8 A = *(const LAS bf16x8*)(ubf + row * 256 + (((kk * 4 + fq) ^ fr) << 4));
        ar = __builtin_amdgcn_mfma_f32_16x16x32_bf16(A, Bw[0][kk], ar, 0, 0, 0); ai = __builtin_amdgcn_mfma_f32_16x16x32_bf16(A, Bw[1][kk], ai, 0, 0, 0); }
#pragma unroll
    for (int r = 0; r < 4; ++r) { const float u = uf[(m * 16 + 4 * fq + r) * UF_LD + 16 * F.wave + fr];
        const float rg = __builtin_amdgcn_rcpf(1.f + __builtin_amdgcn_exp2f(-(ar[r] + k.ba) * LOG2E));
        const float ig = __builtin_amdgcn_rcpf(1.f + __builtin_amdgcn_exp2f(-(ai[r] + k.bx) * LOG2E));
        const float aa = __builtin_amdgcn_exp2f(k.ca * rg);
        av[r] = aa; bv[r] = __builtin_amdgcn_sqrtf(fmaxf(1.f - aa * aa, 0.f)) * (ig * u); }
}
template <bool FWD> __device__ __forceinline__ void lru_tile_total(int fq, float& A, float& B) {
#pragma unroll
    for (int s = 0; s < 2; ++s) { const int bit = 1 << s; const float Ap = __shfl_xor(A, 16 << s), Bp = __shfl_xor(B, 16 << s);
        const bool mine_first = FWD ? ((fq & bit) == 0) : ((fq & bit) != 0);
        if (mine_first) { B = B * Ap + Bp; A = A * Ap; } else { B = Bp * A + B; A = Ap * A; } }
}

__device__ __forceinline__ void lru_pass1(Frame& F, const Args& a, int unit) {
    const int c = unit & (LRU_NCH - 1), h = (unit >> 4) & 7, b = unit >> 7;
    const int fr = F.lane & 15, fq = F.lane >> 4; const int ch = h * 128 + 16 * F.wave + fr;
    lru_conv(F, a, b, h, c, c == 0);
    bf16x8 Bw0[2][4], Bw1[2][4]; lru_load_w(F, 0, h, Bw0); lru_load_w(F, 1, h, Bw1);
    const LruCoef k0 = lru_coef(a, 0, ch), k1 = lru_coef(a, 1, ch);
    LDS_WAIT(); __syncthreads();
    float Af = 1.f, Hf = 0.f, Ab = 1.f, Hb = 0.f;
    for (int m = 0; m < 8; ++m) {
        float av[4], bv[4];
        lru_tile(F, m, Bw0, k0, av, bv);
        float A = av[0] * av[1] * av[2] * av[3], B = ((bv[0] * av[1] + bv[1]) * av[2] + bv[2]) * av[3] + bv[3];
        lru_tile_total<true>(fq, A, B);
        Hf = Hf * A + B; Af = Af * A;
        lru_tile(F, m, Bw1, k1, av, bv);
        A = av[0] * av[1] * av[2] * av[3]; B = ((bv[3] * av[2] + bv[2]) * av[1] + bv[1]) * av[0] + bv[0];
        lru_tile_total<false>(fq, A, B);
        Hb = B * Ab + Hb; Ab = A * Ab;
    }
    float* agg = (float*)(F.ws + WS_LRUAGG);
    if (fq == 0) { *(f32x2*)(agg + ((size_t)((b * LRU_NCH + c) * 2 + 0) * DM + ch) * 2) = (f32x2){Af, Hf};
                   *(f32x2*)(agg + ((size_t)((b * LRU_NCH + c) * 2 + 1) * DM + ch) * 2) = (f32x2){Ab, Hb}; }
    if (c == 0) {
        float av[4], bv[4]; float* s0 = (float*)(F.ws + WS_LRUS0);
        lru_tile(F, 8, Bw0, k0, av, bv); if (fq == 0) s0[(b * 2 + 0) * DM + ch] = bv[0];
        lru_tile(F, 8, Bw1, k1, av, bv); if (fq == 0) s0[(b * 2 + 1) * DM + ch] = bv[1];
    }
    __syncthreads();
}

__device__ __forceinline__ void lru_pass2(Frame& F, const Args& a, int unit) {
    const int c = unit & (LRU_NCH - 1), h = (unit >> 4) & 7, b = unit >> 7;
    const int fr = F.lane & 15, fq = F.lane >> 4; const int ch = h * 128 + 16 * F.wave + fr;
    lru_conv(F, a, b, h, c, false);
    const float* agg = (const float*)(F.ws + WS_LRUAGG); const float* s0 = (const float*)(F.ws + WS_LRUS0);
    float hf = s0[(b * 2 + 0) * DM + ch], hb = s0[(b * 2 + 1) * DM + ch];
    for (int j = 0; j < c; ++j) { const f32x2 g = *(const f32x2*)(agg + ((size_t)((b * LRU_NCH + j) * 2 + 0) * DM + ch) * 2); hf = g.x * hf + g.y; }
    for (int j = LRU_NCH - 1; j > c; --j) { const f32x2 g = *(const f32x2*)(agg + ((size_t)((b * LRU_NCH + j) * 2 + 1) * DM + ch) * 2); hb = g.x * hb + g.y; }
    bf16x8 Bw[2][4]; lru_load_w(F, 0, h, Bw);
    LruCoef k = lru_coef(a, 0, ch);
    LDS_WAIT(); __syncthreads();
    float hfv[8][4];
#pragma unroll
    for (int m = 0; m < 8; ++m) {
        float av[4], bv[4];
        lru_tile(F, m, Bw, k, av, bv);
        const float A = av[0] * av[1] * av[2] * av[3], B = ((bv[0] * av[1] + bv[1]) * av[2] + bv[2]) * av[3] + bv[3];
        float hin = hf;
#pragma unroll
        for (int g = 0; g < 4; ++g) { const float Ag = __shfl(A, g * 16 + fr), Bg = __shfl(B, g * 16 + fr); if (g < fq) hin = Ag * hin + Bg; hf = Ag * hf + Bg; }
#pragma unroll
        for (int r = 0; r < 4; ++r) { hin = av[r] * hin + bv[r]; hfv[m][r] = hin; }
    }
    lru_load_w(F, 1, h, Bw); k = lru_coef(a, 1, ch);
    LAS float* uf = (LAS float*)(F.lds + LRU_UF);
#pragma unroll
    for (int m = 7; m >= 0; --m) {
        float av[4], bv[4];
        lru_tile(F, m, Bw, k, av, bv);
        const float A = av[0] * av[1] * av[2] * av[3], B = ((bv[3] * av[2] + bv[2]) * av[1] + bv[1]) * av[0] + bv[0];
        float hin = hb;
#pragma unroll
        for (int g = 3; g >= 0; --g) { const float Ag = __shfl(A, g * 16 + fr), Bg = __shfl(B, g * 16 + fr); if (g > fq) hin = Ag * hin + Bg; hb = Ag * hb + Bg; }
#pragma unroll
        for (int r = 3; r >= 0; --r) { hin = av[r] * hin + bv[r]; uf[(m * 16 + 4 * fq + r) * UF_LD + 16 * F.wave + fr] = hfv[m][r] + hin; }
    }
    LDS_WAIT(); __syncthreads();
    bf16* AY = (bf16*)(F.ws + WS_YAG) + ((size_t)b * SEQ + c * LRU_T) * DM + h * 128;
    const int cg = F.tid & 15;
    for (int item = F.tid; item < LRU_T * 16; item += NTHR) { const int tl = item >> 4;
        const f32x4 y0 = *(const LAS f32x4*)(uf + tl * UF_LD + 8 * cg), y1 = *(const LAS f32x4*)(uf + tl * UF_LD + 8 * cg + 4);
        u32x4* p = (u32x4*)(AY + (size_t)tl * DM + 8 * cg); const u32x4 g = *p;
        u32x4 o; o.x = pk2(y0.x * gelu_tanh(bflo(g.x)), y0.y * gelu_tanh(bfhi(g.x))); o.y = pk2(y0.z * gelu_tanh(bflo(g.y)), y0.w * gelu_tanh(bfhi(g.y)));
        o.z = pk2(y1.x * gelu_tanh(bflo(g.z)), y1.y * gelu_tanh(bfhi(g.z))); o.w = pk2(y1.z * gelu_tanh(bflo(g.w)), y1.w * gelu_tanh(bfhi(g.w)));
        *p = o; }
    __syncthreads();
}
constexpr int HG_C = 64, HG_SEG = 512, HG_NSEG = 4;
constexpr int HG_QS = 0, HG_QM = 16384, HG_KM = 32768, HG_KDT = 49152, HG_VT = 65536, HG_ATT = 81920, HG_PART = 90112, HG_ETOT = 94208, HG_ROWS = 94720;
constexpr size_t HGS_IMG = 65536;

__device__ __forceinline__ int hg_row(int b, int dir, bool ctx, int sigma) {
    if (ctx) { const int t = dir ? (CTX - 1 - sigma) : sigma; return b * CTX + t; }
    const int p = dir ? (SEQ - 1 - sigma) : sigma; return b * SEQ + (p & 31) * 64 + (p >> 5);
}

template <bool FULL>
__device__ __forceinline__ void hg_prep(Frame& F, const bf16* Qb, const bf16* Fb, const bf16* Vb, int b, int dir, bool ctx, int sigma0, float lb0, float lb1, float& gs0, float& gs1) {
    const int kp = F.lane, to = F.wave;
    unsigned fw[8], qw[8], vw[8];
#pragma unroll
    for (int j = 0; j < 8; ++j) { const size_t ro = (size_t)hg_row(b, dir, ctx, sigma0 + 8 * to + j) * DM + 2 * kp;
        fw[j] = *(const unsigned*)(Fb + ro); vw[j] = *(const unsigned*)(Vb + ro); if (FULL) qw[j] = *(const unsigned*)(Qb + ro); }
    float c0[8], c1[8], k0[8], k1[8];
    float a0 = 0.f, a1 = 0.f;
#pragma unroll
    for (int j = 0; j < 8; ++j) {
        const float g0 = lb0 + (1.f - lb0) * __builtin_amdgcn_rcpf(1.f + __builtin_amdgcn_exp2f(-bflo(fw[j]) * LOG2E));
        const float g1 = lb1 + (1.f - lb1) * __builtin_amdgcn_rcpf(1.f + __builtin_amdgcn_exp2f(-bfhi(fw[j]) * LOG2E));
        k0[j] = 1.f - g0; k1[j] = 1.f - g1;
        a0 += __builtin_amdgcn_logf(g0); a1 += __builtin_amdgcn_logf(g1);
        c0[j] = a0; c1[j] = a1; }
    LAS float* part = (LAS float*)(F.lds + HG_PART);
    *(LAS f32x2*)(part + to * 128 + 2 * kp) = (f32x2){a0, a1};
    LDS_WAIT(); __syncthreads();
    if (FULL && F.tid < HG_C) ((LAS int*)(F.lds + HG_ROWS))[F.tid] = hg_row(b, dir, ctx, sigma0 + F.tid);
    float off0 = 0.f, off1 = 0.f, tot0 = 0.f, tot1 = 0.f, mid0 = 0.f, mid1 = 0.f;
#pragma unroll
    for (int o = 0; o < 8; ++o) { const f32x2 p = *(const LAS f32x2*)(part + o * 128 + 2 * kp);
        if (o < to) { off0 += p.x; off1 += p.y; } if (o < 4) { mid0 += p.x; mid1 += p.y; } tot0 += p.x; tot1 += p.y; }
    gs0 += tot0; gs1 += tot1;
    const float et0 = __builtin_amdgcn_exp2f(tot0), et1 = __builtin_amdgcn_exp2f(tot1);
    const float em0 = __builtin_amdgcn_exp2f(mid0), em1 = __builtin_amdgcn_exp2f(mid1), ei0 = __builtin_amdgcn_exp2f(-mid0), ei1 = __builtin_amdgcn_exp2f(-mid1);
    if (to == 0) *(LAS f32x2*)((LAS float*)(F.lds + HG_ETOT) + 2 * kp) = (f32x2){et0, et1};
    float kd0[8], kd1[8];
#pragma unroll
    for (int j = 0; j < 8; ++j) {
        const float E0 = __builtin_amdgcn_exp2f(off0 + c0[j]), E1 = __builtin_amdgcn_exp2f(off1 + c1[j]);
        const float R0 = __builtin_amdgcn_rcpf(E0), R1 = __builtin_amdgcn_rcpf(E1);
        kd0[j] = k0[j] * R0 * et0; kd1[j] = k1[j] * R1 * et1;
        if (FULL) {
            const float q0 = bflo(qw[j]), q1 = bfhi(qw[j]);
            const float s0 = q0 * __builtin_amdgcn_rcpf(1.f + __builtin_amdgcn_exp2f(-q0 * LOG2E)) * E0, s1 = q1 * __builtin_amdgcn_rcpf(1.f + __builtin_amdgcn_exp2f(-q1 * LOG2E)) * E1;
            const int c = 8 * to + j; const int off = c * 256 + ((4 * kp) ^ ((c & 15) << 4));
            *(LAS unsigned*)(F.lds + HG_QS + off) = pk2(s0, s1);
            *(LAS unsigned*)(F.lds + HG_QM + off) = pk2(s0 * ei0, s1 * ei1);
            *(LAS unsigned*)(F.lds + HG_KM + off) = pk2(k0[j] * R0 * em0, k1[j] * R1 * em1);
        }
    }
    { const int sw = ((to ^ (kp & 7)) << 4);
      u32x4 w0, w1; w0.x = pk2(kd0[0], kd0[1]); w0.y = pk2(kd0[2], kd0[3]); w0.z = pk2(kd0[4], kd0[5]); w0.w = pk2(kd0[6], kd0[7]);
      w1.x = pk2(kd1[0], kd1[1]); w1.y = pk2(kd1[2], kd1[3]); w1.z = pk2(kd1[4], kd1[5]); w1.w = pk2(kd1[6], kd1[7]);
      *(LAS u32x4*)(F.lds + HG_KDT + (2 * kp) * 128 + sw) = w0; *(LAS u32x4*)(F.lds + HG_KDT + (2 * kp + 1) * 128 + sw) = w1;
      u32x4 v0, v1;
      v0.x = (vw[0] & 0xffffu) | (vw[1] << 16); v0.y = (vw[2] & 0xffffu) | (vw[3] << 16); v0.z = (vw[4] & 0xffffu) | (vw[5] << 16); v0.w = (vw[6] & 0xffffu) | (vw[7] << 16);
      v1.x = (vw[0] >> 16) | (vw[1] & 0xffff0000u); v1.y = (vw[2] >> 16) | (vw[3] & 0xffff0000u); v1.z = (vw[4] >> 16) | (vw[5] & 0xffff0000u); v1.w = (vw[6] >> 16) | (vw[7] & 0xffff0000u);
      *(LAS u32x4*)(F.lds + HG_VT + (2 * kp) * 128 + sw) = v0; *(LAS u32x4*)(F.lds + HG_VT + (2 * kp + 1) * 128 + sw) = v1; }
    LDS_WAIT(); __syncthreads();
}
__device__ __forceinline__ void hg_state_update(Frame& F, f32x4 (&St)[8], const bf16x8 (&vt)[2]) {
    const int fr = F.lane & 15, fq = F.lane >> 4;
    const LAS float* etot = (const LAS float*)(F.lds + HG_ETOT);
#pragma unroll
    for (int kt = 0; kt < 8; ++kt) { const f32x4 e = *(const LAS f32x4*)(etot + 16 * kt + 4 * fq); St[kt] = St[kt] * e;
        const int rk = 16 * kt + fr;
#pragma unroll
        for (int ks = 0; ks < 2; ++ks) { const bf16x8 A = *(const LAS bf16x8*)(F.lds + HG_KDT + rk * 128 + (((4 * ks + fq) ^ ((rk >> 1) & 7)) << 4));
            St[kt] = __builtin_amdgcn_mfma_f32_16x16x32_bf16(A, vt[ks], St[kt], 0, 0, 0); } }
}
__device__ __forceinline__ void hg_load_vt(Frame& F, bf16x8 (&vt)[2]) {
    const int fr = F.lane & 15, fq = F.lane >> 4; const int rv = 16 * F.wave + fr;
#pragma unroll
    for (int ks = 0; ks < 2; ++ks) vt[ks] = *(const LAS bf16x8*)(F.lds + HG_VT + rv * 128 + (((4 * ks + fq) ^ ((rv >> 1) & 7)) << 4));
}
struct HgPtrs { const bf16* Q; const bf16* Fx; const bf16* V; const bf16* Fc; const bf16* Vc; bf16* O; };
__device__ __forceinline__ HgPtrs hg_ptrs(Frame& F, int h, int dir) {
    HgPtrs p; p.Q = (const bf16*)(F.ws + WS_P + 2 * GS) + h * 128; p.Fx = (const bf16*)(F.ws + WS_P + (dir ? 4 : 3) * GS) + h * 128; p.V = (const bf16*)(F.ws + WS_P + 5 * GS) + h * 128;
    p.Fc = (const bf16*)(F.ws + WS_PC + (dir ? 2 : 1) * CGS) + h * 128; p.Vc = (const bf16*)(F.ws + WS_PC + 3 * CGS) + h * 128; p.O = (bf16*)(F.ws + WS_P + (dir ? 4 : 3) * GS) + h * 128; return p;
}
__device__ __forceinline__ void hg_lb(const Args& a, int h, int kp, float& lb0, float& lb1) {
    const float* t = a.in[IN_HGLB] + h * 128 + 2 * kp; lb0 = 1.f / (1.f + expf(t[DM] - t[0])); lb1 = 1.f / (1.f + expf(t[DM + 1] - t[1]));
}
__device__ __forceinline__ float* hg_img(Frame& F, int b, int h, int dir, int slot) { return (float*)((unsigned char*)F.out + (size_t)((((b * 8 + h) * 2 + dir) * 4) + slot) * HGS_IMG); }

__device__ __forceinline__ void hg_pass1(Frame& F, const Args& a, int unit) {
    const int slot = unit & 3, dir = (unit >> 2) & 1, h = (unit >> 3) & 7, b = unit >> 6;
    const int fr = F.lane & 15, fq = F.lane >> 4;
    const HgPtrs P = hg_ptrs(F, h, dir);
    float lb0, lb1; hg_lb(a, h, F.lane, lb0, lb1);
    f32x4 St[8];
#pragma unroll
    for (int kt = 0; kt < 8; ++kt) St[kt] = (f32x4){0.f, 0.f, 0.f, 0.f};
    const bool ctx = slot == 0; const int nchunk = ctx ? CTX / HG_C : HG_SEG / HG_C; const int sig0 = ctx ? 0 : (slot - 1) * HG_SEG;
    float gs0 = 0.f, gs1 = 0.f;
    for (int ck = 0; ck < nchunk; ++ck) {
        hg_prep<false>(F, P.Q, ctx ? P.Fc : P.Fx, ctx ? P.Vc : P.V, b, dir, ctx, sig0 + ck * HG_C, lb0, lb1, gs0, gs1);
        bf16x8 vt[2]; hg_load_vt(F, vt);
        hg_state_update(F, St, vt);
    }
    float* img = hg_img(F, b, h, dir, slot) + (size_t)(16 * F.wave + fr) * 128 + 4 * fq;
#pragma unroll
    for (int kt = 0; kt < 8; ++kt) *(f32x4*)(img + 16 * kt) = St[kt];
    if (!ctx && F.wave == 0) { float* D = (float*)(F.ws + WS_HGD) + (size_t)((((b * 8 + h) * 2 + dir) * 3) + (slot - 1)) * 128 + 2 * F.lane;
        *(f32x2*)D = (f32x2){__builtin_amdgcn_exp2f(gs0), __builtin_amdgcn_exp2f(gs1)}; }
    __syncthreads();
}

__device__ __forceinline__ void hg_pass2(Frame& F, const Args& a, int unit) {
    const int seg = unit & 3, dir = (unit >> 2) & 1, h = (unit >> 3) & 7, b = unit >> 6;
    const int fr = F.lane & 15, fq = F.lane >> 4, w = F.wave;
    const HgPtrs P = hg_ptrs(F, h, dir);
    float lb0, lb1; hg_lb(a, h, F.lane, lb0, lb1);
    f32x4 St[8];
    {
        const float* img = hg_img(F, b, h, dir, 0) + (size_t)(16 * w + fr) * 128 + 4 * fq;
#pragma unroll
        for (int kt = 0; kt < 8; ++kt) St[kt] = *(const f32x4*)(img + 16 * kt);
        for (int j = 0; j < seg; ++j) {
            const float* im = hg_img(F, b, h, dir, 1 + j) + (size_t)(16 * w + fr) * 128 + 4 * fq;
            const float* D = (const float*)(F.ws + WS_HGD) + (size_t)((((b * 8 + h) * 2 + dir) * 3) + j) * 128 + 4 * fq;
#pragma unroll
            for (int kt = 0; kt < 8; ++kt) { const f32x4 d = *(const f32x4*)(D + 16 * kt), dl = *(const f32x4*)(im + 16 * kt); St[kt] = St[kt] * d + dl; }
        }
    }
    float gs0 = 0.f, gs1 = 0.f;
    for (int ck = 0; ck < HG_SEG / HG_C; ++ck) {
        hg_prep<true>(F, P.Q, P.Fx, P.V, b, dir, false, seg * HG_SEG + ck * HG_C, lb0, lb1, gs0, gs1);
#pragma unroll
        for (int tt = 0; tt < 2; ++tt) { const int t = w + 8 * tt, ct = t >> 2, st = t & 3;
            f32x4 acc = {0.f, 0.f, 0.f, 0.f};
            const int rs = 16 * st + fr, rc = 16 * ct + fr;
#pragma unroll
            for (int kk = 0; kk < 4; ++kk) { const bf16x8 A = *(const LAS bf16x8*)(F.lds + HG_KM + rs * 256 + (((4 * kk + fq) ^ fr) << 4));
                const bf16x8 B = *(const LAS bf16x8*)(F.lds + HG_QM + rc * 256 + (((4 * kk + fq) ^ fr) << 4));
                acc = __builtin_amdgcn_mfma_f32_16x16x32_bf16(A, B, acc, 0, 0, 0); }
            const int s0 = 16 * st + 4 * fq;
            const float m0 = (s0 + 0 <= rc) ? acc[0] : 0.f, m1 = (s0 + 1 <= rc) ? acc[1] : 0.f, m2 = (s0 + 2 <= rc) ? acc[2] : 0.f, m3 = (s0 + 3 <= rc) ? acc[3] : 0.f;
            *(LAS u32x2*)(F.lds + HG_ATT + rc * 128 + (((2 * st + (fq >> 1)) ^ ((rc >> 1) & 7)) << 4) + (fq & 1) * 8) = (u32x2){pk2(m0, m1), pk2(m2, m3)}; }
        f32x4 o[4];
#pragma unroll
        for (int ct = 0; ct < 4; ++ct) o[ct] = (f32x4){0.f, 0.f, 0.f, 0.f};
#pragma unroll
        for (int kk = 0; kk < 4; ++kk) {
            union { bf16x8 v; unsigned u[4]; } A;
            A.u[0] = pk2(St[2 * kk][0], St[2 * kk][1]); A.u[1] = pk2(St[2 * kk][2], St[2 * kk][3]); A.u[2] = pk2(St[2 * kk + 1][0], St[2 * kk + 1][1]); A.u[3] = pk2(St[2 * kk + 1][2], St[2 * kk + 1][3]);
#pragma unroll
            for (int ct = 0; ct < 4; ++ct) { const int rc = 16 * ct + fr;
                union { bf16x8 v; u32x2 h[2]; } B;
                B.h[0] = *(const LAS u32x2*)(F.lds + HG_QS + rc * 256 + (((4 * kk + (fq >> 1)) ^ fr) << 4) + (fq & 1) * 8);
                B.h[1] = *(const LAS u32x2*)(F.lds + HG_QS + rc * 256 + (((4 * kk + 2 + (fq >> 1)) ^ fr) << 4) + (fq & 1) * 8);
                o[ct] = __builtin_amdgcn_mfma_f32_16x16x32_bf16(A.v, B.v, o[ct], 0, 0, 0); } }
        bf16x8 vt[2]; hg_load_vt(F, vt);
        LDS_WAIT(); __syncthreads();
#pragma unroll
        for (int ks = 0; ks < 2; ++ks)
#pragma unroll
            for (int ct = 0; ct < 4; ++ct) { const int rc = 16 * ct + fr;
                const bf16x8 B = *(const LAS bf16x8*)(F.lds + HG_ATT + rc * 128 + (((4 * ks + fq) ^ ((rc >> 1) & 7)) << 4));
                o[ct] = __builtin_amdgcn_mfma_f32_16x16x32_bf16(vt[ks], B, o[ct], 0, 0, 0); }
        { const LAS int* rows = (const LAS int*)(F.lds + HG_ROWS);
#pragma unroll
          for (int ct = 0; ct < 4; ++ct) { const int row = rows[16 * ct + fr];
              *(u32x2*)(P.O + (size_t)row * DM + 16 * w + 4 * fq) = (u32x2){pk2(o[ct][0], o[ct][1]), pk2(o[ct][2], o[ct][3])}; } }
        hg_state_update(F, St, vt);
    }
    __syncthreads();
}
__device__ __forceinline__ void p_ybg(Frame& F, const Args& a) {
    const bf16* OFp = (const bf16*)(F.ws + WS_OF); const bf16* OBp = (const bf16*)(F.ws + WS_OB); const bf16* OG = (const bf16*)(F.ws + WS_P + 6 * GS);
    bf16* YBG = (bf16*)(F.ws + WS_YBG); const float* hgn = a.in[IN_HGN];
    const int gw = F.bid * NWAVES + F.wave, NGW = F.G * NWAVES;
    for (int row = gw; row < NTOK; row += NGW) {
#pragma unroll
        for (int j = 0; j < 2; ++j) { const int k = 8 * F.lane + 512 * j; const size_t o = (size_t)row * DM + k;
            const u32x4 f = *(const u32x4*)(OFp + o), b = *(const u32x4*)(OBp + o), g = *(const u32x4*)(OG + o);
            float v[8]; v[0] = bflo(f.x) + bflo(b.x); v[1] = bfhi(f.x) + bfhi(b.x); v[2] = bflo(f.y) + bflo(b.y); v[3] = bfhi(f.y) + bfhi(b.y);
            v[4] = bflo(f.z) + bflo(b.z); v[5] = bfhi(f.z) + bfhi(b.z); v[6] = bflo(f.w) + bflo(b.w); v[7] = bfhi(f.w) + bfhi(b.w);
            float ss = 0.f;
#pragma unroll
            for (int q = 0; q < 8; ++q) ss += v[q] * v[q];
            ss += __shfl_xor(ss, 1); ss += __shfl_xor(ss, 2); ss += __shfl_xor(ss, 4); ss += __shfl_xor(ss, 8);
            const float rs = rsqrtf(ss * (1.f / 128.f) + EPS);
            float gv[8]; gv[0] = bflo(g.x); gv[1] = bfhi(g.x); gv[2] = bflo(g.y); gv[3] = bfhi(g.y); gv[4] = bflo(g.z); gv[5] = bfhi(g.z); gv[6] = bflo(g.w); gv[7] = bfhi(g.w);
            const f32x4 h0 = *(const f32x4*)(hgn + k), h1 = *(const f32x4*)(hgn + k + 4);
            const float hv[8] = {h0.x, h0.y, h0.z, h0.w, h1.x, h1.y, h1.z, h1.w};
            float r[8];
#pragma unroll
            for (int q = 0; q < 8; ++q) r[q] = v[q] * rs * hv[q] * siluf_(gv[q]);
            u32x4 w; w.x = pk2(r[0], r[1]); w.y = pk2(r[2], r[3]); w.z = pk2(r[4], r[5]); w.w = pk2(r[6], r[7]);
            *(u32x4*)(YBG + o) = w; }
    }
}
__device__ __forceinline__ void p_moe_weights(Frame& F, const Args& a) {
    LAS float* scr = (LAS float*)(F.lds + F.wave * 16384);
    const int gw = F.bid * NWAVES + F.wave, NGW = F.G * NWAVES;
    constexpr int PER_E = 3 * 256;
    for (int it = gw; it < NEXP * PER_E; it += NGW) {
        const int e = it / PER_E, r = it % PER_E, w = r >> 8, q = r & 255;
        if (w < 2) { const int kb = q >> 4, nb = q & 15;
            transpose_item(a.in[w == 0 ? IN_W1 : IN_W3] + (size_t)e * DM * DEXP, DEXP, DM, (bf16*)(F.ws + (w == 0 ? WS_W1T : WS_W3T)) + ((size_t)e * DEXP + nb * 32) * DM, kb * 64, nb * 32, scr, F.lane); }
        else { const int kb = q >> 5, nb = q & 31;
            transpose_item(a.in[IN_W2] + (size_t)e * DEXP * DM, DM, DEXP, (bf16*)(F.ws + WS_W2T) + ((size_t)e * DM + nb * 32) * DEXP, kb * 64, nb * 32, scr, F.lane); }
    }
}

struct SchedP5 {
    int c; const char* YAG; const char* YBG; const char* WA; const char* WB; char* stash; char* M;
    __device__ __forceinline__ bool next(int i, gm::Unit& u) const {
        if (i >= 2) return false;
        int pm, pn; tile_order(c, 64, 4, pm, pn);
        u.A = (i == 0 ? YAG : YBG) + (size_t)pm * 256 * 2048; u.B0 = (i == 0 ? WA : WB) + (size_t)pn * 256 * 2048; u.B1 = u.B0 + (size_t)128 * 2048;
        u.dst = M + ((size_t)pm * 256 * DM + pn * 256) * 2; u.pm = pm; u.pn = pn; u.e = i; u.rows = 256; return true;
    }
    __device__ __forceinline__ unsigned arow(const gm::Unit&, int r) const { return (unsigned)r; }
};
struct EpiP5 {
    static constexpr bool PERM = true;
    float* stash; const bf16* GA; const bf16* GB;
    __device__ __forceinline__ void operator()(const f32x4 (&acc)[2][2][4][2], const gm::Unit& u, int wr, int wc, int fr, int fq) const {
        const bf16* G = (u.e == 0 ? GA : GB) + ((size_t)u.pm * 256 + wr * 64 + fr) * DM + u.pn * 256 + wc * 32 + 8 * fq;
        bf16* Mb = (bf16*)u.dst + (size_t)(wr * 64 + fr) * DM + wc * 32 + 8 * fq;
        f32x4* st = (f32x4*)stash + threadIdx.x;
        asm volatile("" : "+v"(G), "+v"(Mb), "+v"(st));
#pragma unroll
        for (int ai = 0; ai < 2; ++ai)
#pragma unroll
            for (int m = 0; m < 4; ++m)
#pragma unroll
                for (int bj = 0; bj < 2; ++bj) { const size_t ro = (size_t)(ai * 128 + m * 16) * DM + bj * 128;
                    const u32x4 g = *(const u32x4*)(G + ro);
                    f32x4 v0 = acc[ai][bj][m][0], v1 = acc[ai][bj][m][1];
                    v0[0] *= sigmoidf_(bflo(g.x)); v0[1] *= sigmoidf_(bfhi(g.x)); v0[2] *= sigmoidf_(bflo(g.y)); v0[3] *= sigmoidf_(bfhi(g.y));
                    v1[0] *= sigmoidf_(bflo(g.z)); v1[1] *= sigmoidf_(bfhi(g.z)); v1[2] *= sigmoidf_(bflo(g.w)); v1[3] *= sigmoidf_(bfhi(g.w));
                    const int si = ((ai * 4 + m) * 2 + bj) * 2;
                    if (u.e == 0) { st[(size_t)(si + 0) * NTHR] = v0; st[(size_t)(si + 1) * NTHR] = v1; }
                    else { v0 += st[(size_t)(si + 0) * NTHR]; v1 += st[(size_t)(si + 1) * NTHR];
                        u32x4 w; w.x = gm::cvt_pk_bf16(v0[0], v0[1]); w.y = gm::cvt_pk_bf16(v0[2], v0[3]); w.z = gm::cvt_pk_bf16(v1[0], v1[1]); w.w = gm::cvt_pk_bf16(v1[2], v1[3]);
                        *(u32x4*)(Mb + ro) = w; }
                    asm volatile("" ::: "memory"); }
    }
};

struct SchedP6 {
    int c; const char* M; const char* W; char* X1;
    __device__ __forceinline__ bool next(int i, gm::Unit& u) const {
        if (i >= 1) return false;
        int pm, pn; tile_order(c, 64, 4, pm, pn);
        u.A = M + (size_t)pm * 256 * 2048; u.B0 = W + (size_t)pn * 256 * 2048; u.B1 = u.B0 + (size_t)128 * 2048;
        u.dst = X1 + ((size_t)pm * 256 * DM + pn * 256) * 4; u.pm = pm; u.pn = pn; u.e = 0; u.rows = 256; return true;
    }
    __device__ __forceinline__ unsigned arow(const gm::Unit&, int r) const { return (unsigned)r; }
};
struct EpiP6 {
    static constexpr bool PERM = false;
    const float* x; const float* mod;
    __device__ __forceinline__ void operator()(const f32x4 (&acc)[2][2][4][2], const gm::Unit& u, int wr, int wc, int fr, int fq) const {
        const int b = u.pm >> 3; const int col0 = u.pn * 256 + wc * 32 + 4 * fq;
        const float* mg = mod + b * 6144 + 2 * DM + col0;
        f32x4 gv[2][2];
#pragma unroll
        for (int bj = 0; bj < 2; ++bj)
#pragma unroll
            for (int n = 0; n < 2; ++n) gv[bj][n] = *(const f32x4*)(mg + bj * 128 + n * 16);
#pragma unroll
        for (int ai = 0; ai < 2; ++ai)
#pragma unroll
            for (int m = 0; m < 4; ++m) { const size_t ro = (size_t)(wr * 64 + fr + ai * 128 + m * 16) * DM + wc * 32 + 4 * fq;
                const float* xr = x + ((size_t)u.pm * 256 * DM + u.pn * 256) + ro; float* orow = (float*)u.dst + ro;
#pragma unroll
                for (int bj = 0; bj < 2; ++bj)
#pragma unroll
                    for (int n = 0; n < 2; ++n) { const f32x4 xv = *(const f32x4*)(xr + bj * 128 + n * 16);
                        *(f32x4*)(orow + bj * 128 + n * 16) = xv + gv[bj][n] * acc[ai][bj][m][n]; } }
    }
};

__device__ __forceinline__ void p_norm2_route(Frame& F, const Args& a) {
    const float* mod = (const float*)(F.ws + WS_MOD); const float* g2 = a.in[IN_G2]; const float* wrt = (const float*)(F.ws + WS_WRT);
    const float* X1 = F.out; bf16* HX2 = (bf16*)(F.ws + WS_HX2);
    int* list = (int*)(F.ws + WS_LIST); float* wt = (float*)(F.ws + WS_WT); unsigned* cnt = F.ctl + CW_CNT;
    LAS float* gs = (LAS float*)F.lds; LAS float* sh = gs + DM;
    const int b = F.bid / 32;
    for (int k = F.tid; k < DM; k += NTHR) { gs[k] = g2[k] * (1.f + mod[b * 6144 + 4 * DM + k]); sh[k] = mod[b * 6144 + 3 * DM + k]; }
    __syncthreads();
    for (int r = F.wave; r < 64; r += NWAVES) {
        const int tok = F.bid * 64 + r;
        const f32x4* xr = (const f32x4*)(X1 + (size_t)tok * DM) + F.lane;
        f32x4 v[4]; float s = 0.f;
#pragma unroll
        for (int j = 0; j < 4; ++j) { v[j] = xr[64 * j]; s += (v[j].x * v[j].x + v[j].y * v[j].y) + (v[j].z * v[j].z + v[j].w * v[j].w); }
        const float rstd = rsqrtf(wave_sum(s) * (1.f / DM) + EPS);
        unsigned long long* o8 = (unsigned long long*)(HX2 + (size_t)tok * DM) + F.lane;
#pragma unroll
        for (int j = 0; j < 4; ++j) { const int k = 4 * F.lane + 256 * j;
            const f32x4 g = *(const LAS f32x4*)(gs + k), h = *(const LAS f32x4*)(sh + k);
            v[j].x = v[j].x * rstd * g.x + h.x; v[j].y = v[j].y * rstd * g.y + h.y; v[j].z = v[j].z * rstd * g.z + h.z; v[j].w = v[j].w * rstd * g.w + h.w;
            o8[64 * j] = (unsigned long long)pk2(v[j].x, v[j].y) | ((unsigned long long)pk2(v[j].z, v[j].w) << 32); }
        LAS float* lgs = (LAS float*)(F.lds + 8192) + F.wave * 64;
#pragma unroll 2
        for (int o = 0; o < 36; ++o) { const f32x4* wr_ = (const f32x4*)(wrt + o * DM) + F.lane; float p = 0.f;
#pragma unroll
            for (int j = 0; j < 4; ++j) { const f32x4 w = wr_[64 * j]; p += (v[j].x * w.x + v[j].y * w.y) + (v[j].z * w.z + v[j].w * w.w); }
            p = wave_sum(p) + wrt[36 * DM + o];
            if (F.lane == 0) lgs[o] = p; }
        LDS_WAIT(); asm volatile("" ::: "memory");
        float lg[36];
#pragma unroll
        for (int o = 0; o < 36; ++o) lg[o] = lgs[o];
        float mx = lg[0]; int gi = 0;
#pragma unroll
        for (int g = 1; g < 4; ++g) if (lg[g] > mx) { mx = lg[g]; gi = g; }
        float z = 0.f;
#pragma unroll
        for (int g = 0; g < 4; ++g) z += __expf(lg[g] - mx);
        const float pg = 1.f / z;
        float el[8];
#pragma unroll
        for (int e = 0; e < 8; ++e) el[e] = gi == 0 ? lg[4 + e] : (gi == 1 ? lg[12 + e] : (gi == 2 ? lg[20 + e] : lg[28 + e]));
        int e1 = 0; float m1 = el[0];
#pragma unroll
        for (int e = 1; e < 8; ++e) if (el[e] > m1) { m1 = el[e]; e1 = e; }
        int e2 = 0; float m2 = -3.0e38f;
#pragma unroll
        for (int e = 0; e < 8; ++e) if (e != e1 && el[e] > m2) { m2 = el[e]; e2 = e; }
        const float rr = __expf(m2 - m1); const float w1 = pg / (1.f + rr), w2 = pg * rr / (1.f + rr);
        if (F.lane == 0) {
            const int ea = gi * 8 + e1, eb = gi * 8 + e2;
            const unsigned pa = __hip_atomic_fetch_add(cnt + 64 * ea, 1u, __ATOMIC_RELAXED, __HIP_MEMORY_SCOPE_AGENT);
            const unsigned pb = __hip_atomic_fetch_add(cnt + 64 * eb, 1u, __ATOMIC_RELAXED, __HIP_MEMORY_SCOPE_AGENT);
            list[(size_t)ea * CAP + pa] = tok * 2; wt[tok * 2] = w1;
            list[(size_t)eb * CAP + pb] = tok * 2 + 1; wt[tok * 2 + 1] = w2;
        }
    }
}

struct MoeUnits {
    int ntile[NEXP + 1];
    int off[NEXP + 1];
};
struct SchedMoe1 {
    int G, c; const int* cntv; const int* list; const char* HX2; const char* W1T; const char* W3T; char* HH;
    __device__ __forceinline__ bool find(int L, int& e, int& rt, int& pn, int& rows, int& off) const {
        const int T = L >> 2; pn = L & 3; int acc_t = 0, acc_o = 0;
        for (int q = 0; q < NEXP; ++q) { const int cq = cntv[64 * q]; const int nt = (cq + 255) >> 8;
            if (T < acc_t + nt) { e = q; rt = T - acc_t; rows = cq - rt * 256; if (rows > 256) rows = 256; off = acc_o; return true; }
            acc_t += nt; acc_o += cq; }
        return false;
    }
    __device__ __forceinline__ bool next(int i, gm::Unit& u) const {
        int e, rt, pn, rows, off; if (!find(i * G + c, e, rt, pn, rows, off)) return false;
        u.A = HX2; u.B0 = W1T + ((size_t)e * DEXP + pn * 128) * 2048; u.B1 = W3T + ((size_t)e * DEXP + pn * 128) * 2048;
        u.dst = HH + ((size_t)(off + rt * 256) * DEXP + pn * 128) * 2; u.pm = rt; u.pn = pn; u.e = e; u.rows = rows; return true;
    }
    __device__ __forceinline__ unsigned arow(const gm::Unit& u, int r) const { const int rr = r < u.rows ? r : u.rows - 1; return (unsigned)(list[(size_t)u.e * CAP + u.pm * 256 + rr] >> 1); }
};
struct EpiMoe1 {
    static constexpr bool PERM = true;
    __device__ __forceinline__ void operator()(const f32x4 (&acc)[2][2][4][2], const gm::Unit& u, int wr, int wc, int fr, int fq) const {
        bf16* base = (bf16*)u.dst + (size_t)(wr * 64 + fr) * DEXP + wc * 32 + 8 * fq;
#pragma unroll
        for (int ai = 0; ai < 2; ++ai)
#pragma unroll
            for (int m = 0; m < 4; ++m) { const int r = ai * 128 + wr * 64 + m * 16 + fr; if (r >= u.rows) continue;
                const f32x4 u0 = acc[ai][0][m][0], u1 = acc[ai][0][m][1], v0 = acc[ai][1][m][0], v1 = acc[ai][1][m][1];
                u32x4 w; w.x = gm::cvt_pk_bf16(siluf_(u0[0]) * v0[0], siluf_(u0[1]) * v0[1]); w.y = gm::cvt_pk_bf16(siluf_(u0[2]) * v0[2], siluf_(u0[3]) * v0[3]);
                w.z = gm::cvt_pk_bf16(siluf_(u1[0]) * v1[0], siluf_(u1[1]) * v1[1]); w.w = gm::cvt_pk_bf16(siluf_(u1[2]) * v1[2], siluf_(u1[3]) * v1[3]);
                *(u32x4*)(base + (size_t)(ai * 128 + m * 16) * DEXP) = w; }
    }
};
struct SchedMoe2 {
    int G, c; const int* cntv; const char* HH; const char* W2T; char* Y;
    __device__ __forceinline__ bool next(int i, gm::Unit& u) const {
        const int L = i * G + c; const int T = L >> 2, pn = L & 3; int acc_t = 0, acc_o = 0;
        for (int q = 0; q < NEXP; ++q) { const int cq = cntv[64 * q]; const int nt = (cq + 255) >> 8;
            if (T < acc_t + nt) { const int rt = T - acc_t; int rows = cq - rt * 256; if (rows > 256) rows = 256;
                u.A = HH + (size_t)(acc_o + rt * 256) * DEXP * 2; u.B0 = W2T + ((size_t)q * DM + pn * 256) * (DEXP * 2); u.B1 = u.B0 + (size_t)128 * (DEXP * 2);
                u.dst = Y + (size_t)pn * 256 * 2; u.pm = rt; u.pn = pn; u.e = q; u.rows = rows; return true; }
            acc_t += nt; acc_o += cq; }
        return false;
    }
    __device__ __forceinline__ unsigned arow(const gm::Unit&, int r) const { return (unsigned)r; }
};
struct EpiMoe2 {
    static constexpr bool PERM = true;
    const int* list;
    __device__ __forceinline__ void operator()(const f32x4 (&acc)[2][2][4][2], const gm::Unit& u, int wr, int wc, int fr, int fq) const {
        const int* lp = list + (size_t)u.e * CAP + u.pm * 256;
#pragma unroll
        for (int ai = 0; ai < 2; ++ai)
#pragma unroll
            for (int m = 0; m < 4; ++m) { const int r = ai * 128 + wr * 64 + m * 16 + fr; if (r >= u.rows) continue;
                const int slot = lp[r]; bf16* rowp = (bf16*)u.dst + (size_t)slot * DM + wc * 32 + 8 * fq;
#pragma unroll
                for (int bj = 0; bj < 2; ++bj) { const f32x4 v0 = acc[ai][bj][m][0], v1 = acc[ai][bj][m][1];
                    u32x4 w; w.x = gm::cvt_pk_bf16(v0[0], v0[1]); w.y = gm::cvt_pk_bf16(v0[2], v0[3]); w.z = gm::cvt_pk_bf16(v1[0], v1[1]); w.w = gm::cvt_pk_bf16(v1[2], v1[3]);
                    *(u32x4*)(rowp + bj * 128) = w; } }
    }
};

__device__ __forceinline__ void p_final(Frame& F, const Args& a) {
    const float* mod = (const float*)(F.ws + WS_MOD); const float* fg = a.in[IN_FG]; const float* wt = (const float*)(F.ws + WS_WT);
    const bf16* Y = (const bf16*)(F.ws + WS_Y); float* X1 = F.out;
    for (int r = F.wave; r < 64; r += NWAVES) {
        const int tok = F.bid * 64 + r; const int b = tok >> 11;
        const float w0 = wt[tok * 2], w1 = wt[tok * 2 + 1];
        f32x4* xr = (f32x4*)(X1 + (size_t)tok * DM) + F.lane;
        const u32x2* y0 = (const u32x2*)(Y + (size_t)(tok * 2) * DM) + F.lane; const u32x2* y1 = (const u32x2*)(Y + (size_t)(tok * 2 + 1) * DM) + F.lane;
        f32x4 v[4]; float s = 0.f;
#pragma unroll
        for (int j = 0; j < 4; ++j) { const int k = 4 * F.lane + 256 * j;
            const f32x4 xv = xr[64 * j]; const u32x2 a0 = y0[64 * j], a1 = y1[64 * j]; const f32x4 g5 = *(const f32x4*)(mod + b * 6144 + 5 * DM + k);
            v[j].x = xv.x + g5.x * (w0 * bflo(a0.x) + w1 * bflo(a1.x)); v[j].y = xv.y + g5.y * (w0 * bfhi(a0.x) + w1 * bfhi(a1.x));
            v[j].z = xv.z + g5.z * (w0 * bflo(a0.y) + w1 * bflo(a1.y)); v[j].w = xv.w + g5.w * (w0 * bfhi(a0.y) + w1 * bfhi(a1.y));
            s += (v[j].x * v[j].x + v[j].y * v[j].y) + (v[j].z * v[j].z + v[j].w * v[j].w); }
        const float rstd = rsqrtf(wave_sum(s) * (1.f / DM) + EPS);
#pragma unroll
        for (int j = 0; j < 4; ++j) { const int k = 4 * F.lane + 256 * j; const f32x4 g = *(const f32x4*)(fg + k);
            xr[64 * j] = (f32x4){v[j].x * rstd * g.x, v[j].y * rstd * g.y, v[j].z * rstd * g.z, v[j].w * rstd * g.w}; }
    }
}
#ifndef LRU_FAST
#define LRU_FAST 1
#endif
#ifndef HG_FAST
#define HG_FAST 1
#endif
#define MIX_FAST (LRU_FAST && HG_FAST)
__device__ __forceinline__ void p_mix1(Frame& F, const Args& a) {
#if LRU_FAST
    for (int u = F.bid; u < NB * 8 * LRU_NCH; u += F.G) lru_pass1(F, a, u);
#endif
#if HG_FAST
    for (int i = 0, u = F.bid; u < NB * 8 * 2 * 4; u += F.G, ++i) hg_pass1(F, a, (u & ~3) | ((u + 2 * i) & 3));
#endif
}
__device__ __forceinline__ void p_mix2(Frame& F, const Args& a) {
#if LRU_FAST
    for (int u = F.bid; u < NB * 8 * LRU_NCH; u += F.G) lru_pass2(F, a, u);
#endif
#if HG_FAST
    for (int u = F.bid; u < NB * 8 * 2 * 4; u += F.G) hg_pass2(F, a, u);
#endif
}
__global__ void __launch_bounds__(NTHR, 2) mega(Args args) {
    extern __shared__ __attribute__((aligned(16))) unsigned char lds_raw[];
    Frame F;
    F.lds = (LAS unsigned char*)lds_raw; F.MISC = (volatile LAS unsigned*)(F.lds + LDSCTL_OFF);
    F.tid = threadIdx.x; F.lane = F.tid & 63; F.wave = __builtin_amdgcn_readfirstlane(F.tid >> 6);
    F.G = gridDim.x; F.bid = blockIdx.x; F.ws = args.ws; F.out = args.out; F.ctl = (unsigned*)(args.ws + WS_CTL);
    for (int u = F.tid; u < (LDS_BYTES - LDSCTL_OFF) / 4; u += NTHR) ((LAS unsigned*)(F.lds + LDSCTL_OFF))[u] = 0u;
    __syncthreads();
    XcdBarrier bar = xcd_barrier_post(F.ctl + CW_BAR + args.li * 3584, F.MISC + 8);
    const int lo = args.ph_lo, hi = args.ph_hi;
#define IN(k) (lo <= (k) && (k) < hi)
#define SEAM(k) do { if (IN(k) && IN((k) + 1)) xcd_barrier(bar); } while (0)
    unsigned char* ws = F.ws;
    if (IN(0)) { p0_prologue(F, args); } SEAM(0);
    if (IN(1)) { p1_norm(F, args); } SEAM(1);
    if (IN(2)) {
        SchedP2 S{F.G, F.bid, (const char*)F.out, (const char*)(ws + WS_WIN), (char*)(ws + WS_P), (char*)(ws + WS_PC)};
        EpiStoreBf16 E;
        gm::gemm_phase<SchedP2, EpiStoreBf16, false>(F.lds, DM, S, E);
    } SEAM(2);
    if (IN(3)) { p_mix1(F, args); } SEAM(3);
    if (IN(4)) { p_mix2(F, args); } SEAM(4);
    if (IN(5)) { p_ybg(F, args); p_moe_weights(F, args); } SEAM(5);
    if (IN(6)) {
        SchedP5 S{F.bid, (const char*)(ws + WS_YAG), (const char*)(ws + WS_YBG), (const char*)(ws + WS_WPA), (const char*)(ws + WS_WPB), nullptr, (char*)(ws + WS_M)};
        EpiP5 E{F.out + (size_t)F.bid * 65536, (const bf16*)(ws + WS_P + 7 * GS), (const bf16*)(ws + WS_P + 8 * GS)};
        gm::gemm_phase<SchedP5, EpiP5, false>(F.lds, DM, S, E);
    } SEAM(6);
    if (IN(7)) {
        SchedP6 S{F.bid, (const char*)(ws + WS_M), (const char*)(ws + WS_WOUT), (char*)F.out};
        EpiP6 E{args.in[IN_X], (const float*)(ws + WS_MOD)};
        gm::gemm_phase<SchedP6, EpiP6, false>(F.lds, DM, S, E);
    } SEAM(7);
    if (IN(8)) { p_norm2_route(F, args); } SEAM(8);
    if (IN(9)) {
        SchedMoe1 S{F.G, F.bid, (const int*)(F.ctl + CW_CNT), (const int*)(ws + WS_LIST), (const char*)(ws + WS_HX2), (const char*)(ws + WS_W1T), (const char*)(ws + WS_W3T), (char*)(ws + WS_HH)};
        EpiMoe1 E;
        gm::gemm_phase<SchedMoe1, EpiMoe1, true>(F.lds, DM, S, E);
    } SEAM(9);
    if (IN(10)) {
        SchedMoe2 S{F.G, F.bid, (const int*)(F.ctl + CW_CNT), (const char*)(ws + WS_HH), (const char*)(ws + WS_W2T), (char*)(ws + WS_Y)};
        EpiMoe2 E{(const int*)(ws + WS_LIST)};
        gm::gemm_phase<SchedMoe2, EpiMoe2, false>(F.lds, DEXP, S, E);
    } SEAM(10);
    if (IN(11)) { p_final(F, args); }
#undef IN
#undef SEAM
}

#if !LRU_FAST
__global__ void k_conv_f(const bf16* P0, const bf16* PC0, const float* cw, const float* cb, float* Ub, int b) {
    int t = blockIdx.x; int Lseg = t < CTX ? CTX : SEQ; int lt = t < CTX ? t : t - CTX;
    const bf16* base = t < CTX ? PC0 + (size_t)b * CTX * DM : P0 + (size_t)b * SEQ * DM;
    for (int ch = threadIdx.x; ch < DM; ch += 256) {
        float s = cb[ch];
#pragma unroll
        for (int k = 0; k < 4; ++k) { int tt = lt + k - 2; if (tt >= 0 && tt < Lseg) s += cw[k * DM + ch] * bf2f(base[(size_t)tt * DM + ch]); }
        Ub[(size_t)t * DM + ch] = s;
    }
}
__global__ void k_gates(const float* Ub, const float* wa, const float* ba, const float* wx, const float* bx, const float* lam, float* Aout, float* Bout, int d) {
    __shared__ float us[128];
    int t = blockIdx.x, h = blockIdx.y, j = threadIdx.x; int ch = h * 128 + j;
    float uval = Ub[(size_t)t * DM + ch];
    us[j] = uval; __syncthreads();
    const float* wah = wa + ((size_t)(d * 8 + h) * 128) * 128; const float* wxh = wx + ((size_t)(d * 8 + h) * 128) * 128;
    float ra = 0.f, ia = 0.f;
    for (int i = 0; i < 128; ++i) { float u = us[i]; ra += u * wah[i * 128 + j]; ia += u * wxh[i * 128 + j]; }
    float r = 1.f / (1.f + expf(-(ra + ba[d * DM + ch]))); float ig = 1.f / (1.f + expf(-(ia + bx[d * DM + ch])));
    float sp = log1pf(expf(-lam[d * DM + ch]));
    float log_a = -8.f * r * sp;
    Aout[(size_t)t * DM + ch] = expf(log_a); Bout[(size_t)t * DM + ch] = sqrtf(-expm1f(2.f * log_a)) * (ig * uval);
}
__global__ void k_lru_scan(const float* A0, const float* B0, const float* A1, const float* B1, float* YF, float* YB) {
    int g = blockIdx.x * 256 + threadIdx.x; int d = g / DM, ch = g % DM;
    if (d == 0) { float h = B0[ch];
        for (int t = 0; t < SEQ; ++t) { size_t o = (size_t)(CTX + t) * DM + ch; h = A0[o] * h + B0[o]; YF[(size_t)t * DM + ch] = h; }
    } else { float h = B1[(size_t)(CTX - 1) * DM + ch];
        for (int t = SEQ - 1; t >= 0; --t) { size_t o = (size_t)(CTX + t) * DM + ch; h = A1[o] * h + B1[o]; YB[(size_t)t * DM + ch] = h; }
    }
}
__global__ void k_yag_f(const float* YF, const float* YB, bf16* AY, int b) {
    int t = blockIdx.x;
    for (int ch = threadIdx.x; ch < DM; ch += 256) { size_t o = (size_t)t * DM + ch; bf16* p = AY + ((size_t)b * SEQ + t) * DM + ch;
        *p = (bf16)f2bf((YF[o] + YB[o]) * gelu_tanh(bf2f(*p))); }
}
#endif
#if !HG_FAST
__global__ __launch_bounds__(128) void k_hgrn_f(unsigned char* ws, const float* hg_lb) {
    __shared__ float gs[128], ks[128], qs[128];
    int h = blockIdx.x, d = blockIdx.y, b = blockIdx.z, j = threadIdx.x;
    float S[128];
#pragma unroll
    for (int i = 0; i < 128; ++i) S[i] = 0.f;
    const int c = h * 128 + j;
    const float lbj = 1.f / (1.f + expf(hg_lb[DM + c] - hg_lb[c]));
    bf16* Q = (bf16*)(ws + WS_P + 2 * GS); bf16* Fx = (bf16*)(ws + WS_P + (d == 0 ? 3 : 4) * GS); bf16* V = (bf16*)(ws + WS_P + 5 * GS);
    const bf16* Fc = (const bf16*)(ws + WS_PC + (d == 0 ? 1 : 2) * CGS); const bf16* Vc = (const bf16*)(ws + WS_PC + 3 * CGS);
    for (int s = 0; s < LT; ++s) {
        bool isx = s >= CTX; float fv, vv, qv = 0.f; size_t o;
        if (!isx) { int t = d == 0 ? s : (CTX - 1 - s); o = ((size_t)b * CTX + t) * DM + c; fv = bf2f(Fc[o]); vv = bf2f(Vc[o]); }
        else { int p = s - CTX; if (d == 1) p = SEQ - 1 - p; int tok = (p % 32) * 64 + (p / 32); o = ((size_t)b * SEQ + tok) * DM + c; fv = bf2f(Fx[o]); vv = bf2f(V[o]); qv = bf2f(Q[o]); }
        float gg = lbj + (1.f - lbj) / (1.f + expf(-fv));
        gs[j] = gg; ks[j] = 1.f - gg; qs[j] = qv / (1.f + expf(-qv));
        __syncthreads();
        float oo = 0.f;
#pragma unroll
        for (int i = 0; i < 128; ++i) { S[i] = gs[i] * S[i] + ks[i] * vv; oo += S[i] * qs[i]; }
        if (isx) Fx[o] = (bf16)f2bf(oo);
        __syncthreads();
    }
}
#endif

extern "C" void kernel_launch(void* const* d_in, const int* in_sizes, int n_in, void* d_out, int out_size, void* d_ws, size_t ws_size, hipStream_t stream) {
    static int grid = 0;
    if (grid == 0) {
        if (n_in != 29 || out_size != NTOK * DM || ws_size < WS_END) { fprintf(stderr, "kernel_launch: unexpected problem shape / workspace (%d inputs, out %d, ws %zu)\n", n_in, out_size, ws_size); grid = -1; return; }
        int dev = 0, cus = 0, per_cu = 0;
        if (hipGetDevice(&dev) != hipSuccess || hipDeviceGetAttribute(&cus, hipDeviceAttributeMultiprocessorCount, dev) != hipSuccess) { grid = -1; return; }
        if (hipFuncSetAttribute((const void*)mega, hipFuncAttributeMaxDynamicSharedMemorySize, LDS_BYTES) != hipSuccess) { grid = -1; return; }
        if (hipOccupancyMaxActiveBlocksPerMultiprocessor(&per_cu, (const void*)mega, NTHR, LDS_BYTES) != hipSuccess || per_cu < 1) { fprintf(stderr, "kernel_launch: occupancy query says %d blocks per CU\n", per_cu); }
        (void)hipGetLastError();
        grid = cus;
        if (grid != 256) { fprintf(stderr, "kernel_launch: built for 256 CUs, found %d\n", cus); grid = -1; return; }
    }
    if (grid < 0) return;
    hipMemsetAsync((char*)d_ws + WS_CTL, 0, CTL_BYTES, stream);
    Args a{};
    for (int i = 0; i < 29; ++i) a.in[i] = (const float*)d_in[i];
    a.out = (float*)d_out; a.ws = (unsigned char*)d_ws;
#if MIX_FAST
    a.ph_lo = 0; a.ph_hi = 12; a.li = 0;
    hipLaunchKernelGGL(mega, dim3(grid), dim3(NTHR), LDS_BYTES, stream, a);
#else
    a.ph_lo = 0; a.ph_hi = 5; a.li = 0;
    hipLaunchKernelGGL(mega, dim3(grid), dim3(NTHR), LDS_BYTES, stream, a);
    {
        unsigned char* ws = (unsigned char*)d_ws;
#if !LRU_FAST
        float* sc = (float*)d_out;
        float* Ub = sc; float* A0 = Ub + (size_t)LT * DM; float* B0 = A0 + (size_t)LT * DM; float* A1 = B0 + (size_t)LT * DM; float* B1 = A1 + (size_t)LT * DM;
        float* YF = B1 + (size_t)LT * DM; float* YB = YF + (size_t)SEQ * DM;
        const float* cw = (const float*)d_in[IN_CONVW]; const float* cb = (const float*)d_in[IN_CONVB];
        const float* wa = (const float*)d_in[IN_WA]; const float* ba = (const float*)d_in[IN_BA]; const float* wx = (const float*)d_in[IN_WX]; const float* bx = (const float*)d_in[IN_BX]; const float* lam = (const float*)d_in[IN_LAM];
        for (int b = 0; b < NB; ++b) {
            k_conv_f<<<LT, 256, 0, stream>>>((const bf16*)(ws + WS_P), (const bf16*)(ws + WS_PC), cw, cb, Ub, b);
            k_gates<<<dim3(LT, 8), 128, 0, stream>>>(Ub, wa, ba, wx, bx, lam, A0, B0, 0);
            k_gates<<<dim3(LT, 8), 128, 0, stream>>>(Ub, wa, ba, wx, bx, lam, A1, B1, 1);
            k_lru_scan<<<8, 256, 0, stream>>>(A0, B0, A1, B1, YF, YB);
            k_yag_f<<<SEQ, 256, 0, stream>>>(YF, YB, (bf16*)(ws + WS_YAG), b);
        }
#endif
#if !HG_FAST
        k_hgrn_f<<<dim3(8, 2, NB), 128, 0, stream>>>(ws, (const float*)d_in[IN_HGLB]);
#endif
    }
    a.ph_lo = 5; a.ph_hi = 12; a.li = 1;
    hipLaunchKernelGGL(mega, dim3(grid), dim3(NTHR), LDS_BYTES, stream, a);
#endif
}
```

```cpp
#include <hip/hip_runtime.h>
#include <cstdio>
#include <cstdint>
#include <math.h>

#define LAS __attribute__((address_space(3)))
#define GAS __attribute__((address_space(1)))
typedef unsigned short bf16;
typedef short bf16x8 __attribute__((ext_vector_type(8)));
typedef float f32x4 __attribute__((ext_vector_type(4)));
typedef float f32x2 __attribute__((ext_vector_type(2)));
typedef unsigned u32x4 __attribute__((ext_vector_type(4)));
typedef unsigned u32x2 __attribute__((ext_vector_type(2)));

constexpr int DM = 1024, NB = 8, SEQ = 2048, CTX = 256, NTOK = NB * SEQ, NCTX = NB * CTX, INW = 9216, LT = CTX + SEQ;
constexpr int NEXP = 32, DEXP = 512, CAP = 16384;
constexpr float EPS = 1e-6f;
constexpr int NWAVES = 8, NTHR = 512;

constexpr size_t MiB = 1u << 20, KiB = 1024;
constexpr size_t WS_CTL = 0, CTL_BYTES = 64 * KiB;
constexpr size_t WS_MODP = 256 * KiB;
constexpr size_t WS_MOD = 2 * MiB;
constexpr size_t WS_LRUAGG = 2 * MiB + 512 * KiB;
constexpr size_t WS_LRUS0 = 4 * MiB + 512 * KiB;
constexpr size_t WS_WT = 4 * MiB + 768 * KiB;
constexpr size_t WS_LIST = 5 * MiB;
constexpr size_t WS_HGD = 7 * MiB;
constexpr size_t WS_WRT = 7 * MiB + 256 * KiB;
constexpr size_t WS_WIN = 8 * MiB;
constexpr size_t WS_WPA = 26 * MiB, WS_WPB = 28 * MiB, WS_WOUT = 30 * MiB;
constexpr size_t WS_WLRU = 32 * MiB;
constexpr size_t WS_P = 33 * MiB, GS = 32 * MiB;
constexpr size_t WS_PC = 321 * MiB, CGS = 4 * MiB;
constexpr size_t WS_END = 337 * MiB;
constexpr size_t WS_W1T = WS_P + 0 * GS, WS_W3T = WS_P + 2 * GS, WS_W2T = WS_P + 5 * GS;
constexpr size_t WS_YAG = WS_P + 1 * GS;
constexpr size_t WS_OF = WS_P + 3 * GS, WS_OB = WS_P + 4 * GS;
constexpr size_t WS_YBG = WS_P + 3 * GS;
constexpr size_t WS_M = WS_P + 4 * GS;
constexpr size_t WS_HX2 = WS_P + 1 * GS;
constexpr size_t WS_HH = WS_P + 3 * GS;
constexpr size_t WS_Y = WS_P + 6 * GS;

constexpr int CW_BAR = 1024;
constexpr int CW_CNT = 12288;

constexpr int RING_BYTES = 131072, LDS_BYTES = 147456, LDSCTL_OFF = LDS_BYTES - 1024;

#define LDS_WAIT() asm volatile("s_waitcnt lgkmcnt(0)" ::: "memory")
#define VM_WAIT() asm volatile("s_waitcnt vmcnt(0)" ::: "memory")

__device__ __forceinline__ unsigned f2bf(float f) { unsigned u = __builtin_bit_cast(unsigned, f); return (u + 0x7fffu + ((u >> 16) & 1u)) >> 16; }
__device__ __forceinline__ unsigned pk2(float lo, float hi) { return f2bf(lo) | (f2bf(hi) << 16); }
__device__ __forceinline__ float bf2f(unsigned short b) { return __builtin_bit_cast(float, (unsigned)b << 16); }
__device__ __forceinline__ float bflo(unsigned w) { return __builtin_bit_cast(float, w << 16); }
__device__ __forceinline__ float bfhi(unsigned w) { return __builtin_bit_cast(float, w & 0xffff0000u); }
__device__ __forceinline__ float sigmoidf_(float x) { return 1.f / (1.f + __expf(-x)); }
__device__ __forceinline__ float siluf_(float x) { return x / (1.f + __expf(-x)); }
__device__ __forceinline__ float gelu_tanh(float x) { float u = 0.7978845608028654f * (x + 0.044715f * x * x * x); float e = __expf(2.f * u); return x * (1.f - 1.f / (1.f + e)); }
__device__ __forceinline__ float wave_sum(float v) {
#pragma unroll
    for (int o = 1; o < 64; o <<= 1) v += __shfl_xor(v, o);
    return v;
}

#define XB_TMO      128
#define XB_XCNT(j)  (256  + 64 * (j))
#define XB_XSUB(j)  (1280 + 64 * (j))
#define XB_XGEN(j)  (2304 + 64 * (j))
#define XB_TOP      3328
#define XB_TOPGEN   3392
#define XCD_BAR_WORDS 3456
#define XB_SPIN_CAP (1u << 20)
__device__ __forceinline__ unsigned xb_ld(unsigned* p)              { return __hip_atomic_load(p, __ATOMIC_RELAXED, __HIP_MEMORY_SCOPE_AGENT); }
__device__ __forceinline__ unsigned xb_add(unsigned* p, unsigned v) { return __hip_atomic_fetch_add(p, v, __ATOMIC_RELAXED, __HIP_MEMORY_SCOPE_AGENT); }
__device__ __forceinline__ unsigned xb_xcc_id() { return (unsigned)__builtin_amdgcn_s_getreg((3 << 11) | 20) & 0xFu; }
#define XB_SPIN(cond, bar) do { unsigned _sp = 0; while (cond) { __builtin_amdgcn_s_sleep(1); \
    if ((++_sp & 255u) == 0u) { if (xb_ld(&(bar)[XB_TMO])) break; if (_sp > XB_SPIN_CAP) { atomicAdd(&(bar)[XB_TMO], 1u); break; } } } } while (0)
struct XcdBarrier { unsigned* bar; unsigned x; volatile LAS unsigned* st; };
__device__ __forceinline__ XcdBarrier xcd_barrier_post(unsigned* bar, volatile LAS unsigned* st) {
    XcdBarrier b; b.bar = bar; b.x = xb_xcc_id(); b.st = st;
    if (threadIdx.x == 0) (void)xb_add(&bar[XB_XCNT(b.x)], 1u);
    return b;
}
__device__ __forceinline__ void xcd_barrier_complete(unsigned* bar, unsigned x, unsigned& nloc, unsigned& nx) {
    const unsigned G = gridDim.x * gridDim.y * gridDim.z;
    unsigned sum, cnt, mine, sp = 0u;
    for (;;) {
        sum = 0u; cnt = 0u; mine = 0u;
#pragma unroll
        for (unsigned j = 0; j < 16; ++j) { const unsigned c = xb_ld(&bar[XB_XCNT(j)]); sum += c; cnt += (c > 0u) ? 1u : 0u; mine = (j == x) ? c : mine; }
        if (sum == G) break;
        __builtin_amdgcn_s_sleep(1);
        if ((++sp & 255u) == 0u) { if (xb_ld(&bar[XB_TMO])) break; if (sp > XB_SPIN_CAP) { atomicAdd(&bar[XB_TMO], 1u); break; } }
    }
    nloc = mine > 0u ? mine : 1u; nx = cnt > 0u ? cnt : 1u;
}
__device__ __forceinline__ void xcd_barrier(const XcdBarrier& b) {
    asm volatile("s_waitcnt vmcnt(0)" ::: "memory");
    __syncthreads();
    if (threadIdx.x == 0) {
        unsigned* bar = b.bar;
        __builtin_amdgcn_s_waitcnt(0);
        unsigned nloc = b.st[0], nx = b.st[1];
        if (nloc == 0u) { xcd_barrier_complete(bar, b.x, nloc, nx); b.st[0] = nloc; b.st[1] = nx; }
        const unsigned old = xb_add(&bar[XB_XSUB(b.x)], 1u);
        const unsigned gen = old / nloc;
        if (old + 1u == (gen + 1u) * nloc) {
            __builtin_amdgcn_fence(__ATOMIC_RELEASE, "agent");
            asm volatile("s_waitcnt vmcnt(0)" ::: "memory");
            const unsigned og = xb_add(&bar[XB_TOP], 1u);
            const unsigned tg = og / nx;
            if (og + 1u == (tg + 1u) * nx) xb_add(&bar[XB_TOPGEN], 1u);
            else XB_SPIN(xb_ld(&bar[XB_TOPGEN]) == tg, bar);
            __builtin_amdgcn_fence(__ATOMIC_ACQUIRE, "agent");
            xb_add(&bar[XB_XGEN(b.x)], 1u);
            asm volatile("s_waitcnt vmcnt(0)" ::: "memory");
        } else {
            XB_SPIN(xb_ld(&bar[XB_XGEN(b.x)]) == gen, bar);
            __builtin_amdgcn_fence(__ATOMIC_ACQUIRE, "agent");
            asm volatile("s_waitcnt vmcnt(0)" ::: "memory");
        }
    }
    __syncthreads();
}

namespace gm {
constexpr int BM = 256, BK = 64, HALF = 128, HTB = HALF * BK * 2;
__device__ __forceinline__ int lds_byte(int r, int c) { const int st = (r >> 4) * 2 + (c >> 5), rr = r & 15, cc = c & 31, ob = rr * 64 + cc * 2; return st * 1024 + (ob ^ (((ob >> 9) & 1) << 5)); }
__device__ __forceinline__ void stage_rc(int b, int& R, int& C) { const int st = b / 1024, sb = b % 1024, swz = sb ^ (((sb >> 9) & 1) << 5); R = (st >> 1) * 16 + swz / 64; C = (st & 1) * 32 + (swz % 64) / 2; }
__device__ __forceinline__ int perm32(int rho) { const int n = rho >> 4, i = rho & 15; return 8 * (i >> 2) + 4 * n + (i & 3); }
__device__ __forceinline__ unsigned cvt_pk_bf16(float lo, float hi) { unsigned r; asm volatile("v_cvt_pk_bf16_f32 %0, %1, %2" : "=v"(r) : "v"(lo), "v"(hi)); return r; }

struct Unit { const char* A; const char* B0; const char* B1; char* dst; int pm, pn, e, rows; };

template <class Sched, class Epi, bool GATHER>
__device__ __forceinline__ void gemm_phase(LAS unsigned char* lds, const int K, const Sched& S, const Epi& E) {
    const int tid = threadIdx.x, wid = __builtin_amdgcn_readfirstlane(tid >> 6), lane = tid & 63, wr = wid >> 2, wc = wid & 3, fr = lane & 15, fq = lane >> 4;
    const int nt = K / BK;
    unsigned voffB[2]; int Rr[2]; unsigned Cb[2];
#pragma unroll
    for (int i = 0; i < 2; ++i) { int R, C; stage_rc(tid * 16 + i * 8192, R, C); const int Rb = Epi::PERM ? ((R & ~31) + perm32(R & 31)) : R;
        Rr[i] = R; Cb[i] = (unsigned)C * 2u; voffB[i] = (unsigned)(Rb * K + C) * 2u; }
    const unsigned rowb = (unsigned)K * 2u;
    const size_t kstep = (size_t)(BK * 2);
    const unsigned ldsw = (unsigned)wid * 1024u;
    const int aoff = lds_byte(wr * 64 + fr, fq * 8), boff = lds_byte(wc * 32 + fr, fq * 8);
#define GM_SA(b, h) (((b) * 2 + (h)) * HTB)
#define GM_SB(b, h) ((4 + (b) * 2 + (h)) * HTB)
#define GM_STAGE(bufoff, gbase, voff) do { _Pragma("unroll") for (int _i = 0; _i < 2; ++_i) \
        __builtin_amdgcn_global_load_lds((const unsigned*)((const char*)(gbase) + (voff)[_i]), (LAS unsigned*)(lds + (bufoff) + ldsw + _i * 8192), 16, 0, 0); } while (0)
#define GM_LDA(dst, b, h) do { _Pragma("unroll") for (int m = 0; m < 4; ++m) _Pragma("unroll") for (int k = 0; k < 2; ++k) dst[m][k] = *(const LAS bf16x8*)(lds + GM_SA(b, h) + aoff + m * 2048 + k * 1024); } while (0)
#define GM_LDB(dst, b, h) do { _Pragma("unroll") for (int n = 0; n < 2; ++n) _Pragma("unroll") for (int k = 0; k < 2; ++k) dst[n][k] = *(const LAS bf16x8*)(lds + GM_SB(b, h) + boff + n * 2048 + k * 1024); } while (0)
#define GM_MMA(ai, bj, At, Bt) do { __builtin_amdgcn_s_setprio(1); _Pragma("unroll") for (int m = 0; m < 4; ++m) _Pragma("unroll") for (int n = 0; n < 2; ++n) _Pragma("unroll") for (int k = 0; k < 2; ++k) \
        acc[ai][bj][m][n] = __builtin_amdgcn_mfma_f32_16x16x32_bf16(Bt[n][k], At[m][k], acc[ai][bj][m][n], 0, 0, 0); __builtin_amdgcn_s_setprio(0); } while (0)
#define GM_WAIT_V(n) asm volatile("s_waitcnt vmcnt(" #n ")" ::: "memory")
#define GM_WAIT_L(n) asm volatile("s_waitcnt lgkmcnt(" #n ")" ::: "memory")
#define GM_BAR __builtin_amdgcn_s_barrier()
#define GM_SCHED __builtin_amdgcn_sched_barrier(0)
#define GM_AOFFS(u, o) do { _Pragma("unroll") for (int _h = 0; _h < 2; ++_h) _Pragma("unroll") for (int _i = 0; _i < 2; ++_i) \
        (o)[_h][_i] = (GATHER ? S.arow((u), _h * HALF + Rr[_i]) : (unsigned)(_h * HALF + Rr[_i])) * rowb + Cb[_i]; } while (0)
    Unit cur, nxt; int ui = 0;
    if (!S.next(0, cur)) return;
    f32x4 acc[2][2][4][2];
#pragma unroll
    for (int a = 0; a < 2; ++a)
#pragma unroll
        for (int b = 0; b < 2; ++b)
#pragma unroll
            for (int m = 0; m < 4; ++m)
#pragma unroll
                for (int n = 0; n < 2; ++n) acc[a][b][m][n] = (f32x4){0.f, 0.f, 0.f, 0.f};
    bf16x8 At[4][2], B0[2][2], B1[2][2];
    unsigned ca[2][2], na[2][2];
    GM_AOFFS(cur, ca);
    const char* cA = cur.A; const char* cB0 = cur.B0; const char* cB1 = cur.B1;
    GM_STAGE(GM_SB(0, 0), cB0, voffB); GM_STAGE(GM_SB(0, 1), cB1, voffB); GM_STAGE(GM_SA(0, 0), cA, ca[0]); GM_STAGE(GM_SA(0, 1), cA, ca[1]);
    if (wr == 1) GM_BAR;
    GM_WAIT_V(2); GM_BAR;
    GM_STAGE(GM_SB(1, 0), cB0 + kstep, voffB); GM_STAGE(GM_SA(1, 0), cA + kstep, ca[0]); GM_STAGE(GM_SB(1, 1), cB1 + kstep, voffB);
    GM_WAIT_V(6); GM_BAR;
    for (;;) {
        const bool has_next = S.next(ui + 1, nxt);
        const char* nA = has_next ? nxt.A : cA; const char* nB0 = has_next ? nxt.B0 : cB0; const char* nB1 = has_next ? nxt.B1 : cB1;
        if (has_next) { GM_AOFFS(nxt, na); } else {
#pragma unroll
            for (int h = 0; h < 2; ++h)
#pragma unroll
                for (int i = 0; i < 2; ++i) na[h][i] = ca[h][i]; }
        for (int t = 0; t < nt; t += 2) {
            const bool last = (t == nt - 2);
            const char* a1 = cA + (size_t)(t + 1) * kstep;
            const char* a2 = last ? nA : cA + (size_t)(t + 2) * kstep;
            const char* b20 = last ? nB0 : cB0 + (size_t)(t + 2) * kstep; const char* b21 = last ? nB1 : cB1 + (size_t)(t + 2) * kstep;
            const char* a3 = a2 + kstep; const char* b30 = b20 + kstep; const char* b31 = b21 + kstep;
            unsigned o2[2][2];
#pragma unroll
            for (int h = 0; h < 2; ++h)
#pragma unroll
                for (int i = 0; i < 2; ++i) o2[h][i] = last ? na[h][i] : ca[h][i];
            GM_LDB(B0, 0, 0); GM_LDB(B1, 0, 1); GM_SCHED; GM_LDA(At, 0, 0); GM_STAGE(GM_SA(1, 1), a1, ca[1]);
            GM_WAIT_V(8); GM_WAIT_L(0); GM_BAR; GM_MMA(0, 0, At, B0); GM_MMA(0, 1, At, B1); GM_BAR; GM_SCHED;
            GM_LDA(At, 0, 1); GM_STAGE(GM_SB(0, 0), b20, voffB); GM_STAGE(GM_SB(0, 1), b21, voffB); GM_STAGE(GM_SA(0, 0), a2, o2[0]);
            GM_WAIT_V(8); GM_WAIT_L(0); GM_BAR; GM_MMA(1, 0, At, B0); GM_MMA(1, 1, At, B1); GM_BAR; GM_SCHED;
            GM_LDB(B0, 1, 0); GM_LDB(B1, 1, 1); GM_SCHED; GM_LDA(At, 1, 0); GM_STAGE(GM_SA(0, 1), a2, o2[1]);
            GM_WAIT_V(8); GM_WAIT_L(0); GM_BAR; GM_MMA(0, 0, At, B0); GM_MMA(0, 1, At, B1); GM_BAR; GM_SCHED;
            GM_LDA(At, 1, 1); GM_STAGE(GM_SB(1, 0), b30, voffB); GM_STAGE(GM_SB(1, 1), b31, voffB); GM_STAGE(GM_SA(1, 0), a3, o2[0]);
            GM_WAIT_V(8); GM_WAIT_L(0); GM_BAR; GM_MMA(1, 0, At, B0); GM_MMA(1, 1, At, B1); GM_BAR; GM_SCHED;
        }
        if (wr == 0) GM_BAR;
        E(acc, cur, wr, wc, fr, fq);
        if (!has_next) break;
#pragma unroll
        for (int a = 0; a < 2; ++a)
#pragma unroll
            for (int b = 0; b < 2; ++b)
#pragma unroll
                for (int m = 0; m < 4; ++m)
#pragma unroll
                    for (int n = 0; n < 2; ++n) acc[a][b][m][n] = (f32x4){0.f, 0.f, 0.f, 0.f};
        cur = nxt; cA = nA; cB0 = nB0; cB1 = nB1; ++ui;
#pragma unroll
        for (int h = 0; h < 2; ++h)
#pragma unroll
            for (int i = 0; i < 2; ++i) ca[h][i] = na[h][i];
        if (wr == 1) GM_BAR;
    }
    GM_WAIT_V(0);
    GM_BAR;
#undef GM_SA
#undef GM_SB
#undef GM_STAGE
#undef GM_LDA
#undef GM_LDB
#undef GM_MMA
#undef GM_WAIT_V
#undef GM_WAIT_L
#undef GM_BAR
#undef GM_SCHED
#undef GM_AOFFS
}
}
struct Args {
    const float* in[29]; float* out; unsigned char* ws; int ph_lo, ph_hi, li, pad;
};
struct Frame {
    LAS unsigned char* lds; volatile LAS unsigned* MISC;
    unsigned* ctl; unsigned char* ws; float* out;
    int tid, lane, wave, G, bid;
};
enum { IN_X = 0, IN_C, IN_CTX, IN_CCTX, IN_WMOD, IN_BMOD, IN_G1, IN_WIN, IN_CONVW, IN_CONVB, IN_WA, IN_BA, IN_WX, IN_BX, IN_LAM, IN_HGLB, IN_HGN,
       IN_WPA, IN_WPB, IN_WOUT, IN_G2, IN_WRG, IN_BRG, IN_WRE, IN_BRE, IN_W1, IN_W3, IN_W2, IN_FG };

constexpr int TR_BYTES = 64 * 64 * 4;
__device__ __forceinline__ void transpose_item(const float* W, int ldw, int K, bf16* WT, int k0, int n0, LAS float* scr, int lane) {
    const int lr = lane >> 4, ls = lane & 15;
    f32x4 v[16];
#pragma unroll
    for (int i = 0; i < 16; ++i) v[i] = *(const f32x4*)(W + (size_t)(k0 + 4 * i + lr) * ldw + n0 + 4 * ls);
#pragma unroll
    for (int i = 0; i < 16; ++i) { const int k = 4 * i + lr; *(LAS f32x4*)(scr + k * 64 + ((ls ^ ((k >> 3) & 7)) << 2)) = v[i]; }
    LDS_WAIT(); asm volatile("" ::: "memory");
    const int c = lane & 7;
#pragma unroll
    for (int j = 0; j < 8; ++j) { const int n = (lane >> 3) + 8 * j; const LAS float* s = scr + (8 * c) * 64 + ((((n >> 2) ^ c) << 2) | (n & 3));
        u32x4 o; o.x = pk2(s[0 * 64], s[1 * 64]); o.y = pk2(s[2 * 64], s[3 * 64]); o.z = pk2(s[4 * 64], s[5 * 64]); o.w = pk2(s[6 * 64], s[7 * 64]);
        *(u32x4*)(WT + (size_t)n * K + k0 + 8 * c) = o; }
    LDS_WAIT(); asm volatile("" ::: "memory");
}

__device__ __forceinline__ void p0_mod_item(Frame& F, const Args& a, int item) {
    const int cb = item % 24, ks = item / 24;
    LAS float* sv = (LAS float*)F.lds;
    LAS float* red = sv + 9 * 128;
    const float* c = a.in[IN_C]; const float* cc = a.in[IN_CCTX]; const float* wmod = a.in[IN_WMOD];
    for (int i = F.tid; i < 9 * 128; i += NTHR) { const int r = i >> 7, k = i & 127; const float v = r < 8 ? c[r * DM + ks * 128 + k] : cc[ks * 128 + k]; sv[i] = siluf_(v); }
    __syncthreads();
    const int col = cb * 256 + (F.tid & 255), kh = F.tid >> 8;
    float acc[9];
#pragma unroll
    for (int r = 0; r < 9; ++r) acc[r] = 0.f;
    for (int k = 0; k < 64; ++k) { const int kk = kh * 64 + k; const float w = wmod[(size_t)(ks * 128 + kk) * 6144 + col];
#pragma unroll
        for (int r = 0; r < 9; ++r) acc[r] += sv[r * 128 + kk] * w; }
    if (kh == 1) {
#pragma unroll
        for (int r = 0; r < 9; ++r) red[r * 256 + (F.tid & 255)] = acc[r]; }
    __syncthreads();
    float* modp = (float*)(F.ws + WS_MODP);
    if (kh == 0) {
#pragma unroll
        for (int r = 0; r < 9; ++r) modp[(size_t)(ks * 9 + r) * 6144 + col] = acc[r] + red[r * 256 + F.tid]; }
    __syncthreads();
}
__device__ __forceinline__ float mod_from_partials(const float* modp, const float* bmod, int row, int j) {
    float s = bmod[j];
#pragma unroll
    for (int ks = 0; ks < 8; ++ks) s += modp[(size_t)(ks * 9 + row) * 6144 + j];
    return s;
}

__device__ __forceinline__ void p0_prologue(Frame& F, const Args& a) {
    if (F.bid < 192) p0_mod_item(F, a, F.bid);
    LAS float* scr = (LAS float*)(F.lds + F.wave * TR_BYTES);
    const int gw = F.bid * NWAVES + F.wave, NGW = F.G * NWAVES;
    constexpr int I_IN = 16 * 144, I_PR = 16 * 16, I_LRU = 32 * 4;
    constexpr int NITEMS = I_IN + 3 * I_PR + I_LRU;
    for (int it = gw; it < NITEMS; it += NGW) {
        int r = it;
        if (r < I_IN) { const int kb = r / 144, nb = r % 144; transpose_item(a.in[IN_WIN], INW, DM, (bf16*)(F.ws + WS_WIN) + (size_t)(nb * 64) * DM, kb * 64, nb * 64, scr, F.lane); continue; } r -= I_IN;
        if (r < 3 * I_PR) { const int w = r / I_PR, q = r % I_PR, kb = q / 16, nb = q % 16;
            const float* W = a.in[w == 0 ? IN_WPA : (w == 1 ? IN_WPB : IN_WOUT)]; bf16* WT = (bf16*)(F.ws + (w == 0 ? WS_WPA : (w == 1 ? WS_WPB : WS_WOUT)));
            transpose_item(W, DM, DM, WT + (size_t)(nb * 64) * DM, kb * 64, nb * 64, scr, F.lane); continue; } r -= 3 * I_PR;
        { const int mat = r / 4, q = r % 4, kb = q / 2, nb = q % 2;
          const int which = mat >> 4, dh = mat & 15;
          const float* W = a.in[which == 0 ? IN_WA : IN_WX] + (size_t)dh * 128 * 128; bf16* WT = (bf16*)(F.ws + WS_WLRU) + (size_t)mat * 128 * 128;
          transpose_item(W, 128, 128, WT + (size_t)(nb * 64) * 128, kb * 64, nb * 64, scr, F.lane); }
    }
    float* wrp = (float*)(F.ws + WS_WRT);
    for (int i = F.bid * NTHR + F.tid; i < 49152 + 48; i += F.G * NTHR) {
        if (i < 49152) { const int j = i & 3, ln = (i >> 2) & 63, sc = i >> 8, c = sc % 3, s2 = sc / 3; const int k = 16 * s2 + 4 * (ln >> 4) + j, o = 16 * c + (ln & 15);
            wrp[i] = o < 4 ? a.in[IN_WRG][k * 4 + o] : (o < 36 ? a.in[IN_WRE][k * 32 + (o - 4)] : 0.f); }
        else { const int o = i - 49152; wrp[i] = o < 4 ? a.in[IN_BRG][o] : (o < 36 ? a.in[IN_BRE][o - 4] : 0.f); }
    }
}

__device__ __forceinline__ void norm_rows(Frame& F, const float* src, bf16* dst, int row0, int nrows, const LAS float* gs, const LAS float* sh) {
    for (int r = F.wave; r < nrows; r += NWAVES) {
        const f32x4* xr = (const f32x4*)(src + (size_t)(row0 + r) * DM) + F.lane;
        f32x4 v[4]; float s = 0.f;
#pragma unroll
        for (int j = 0; j < 4; ++j) { v[j] = xr[64 * j]; s += (v[j].x * v[j].x + v[j].y * v[j].y) + (v[j].z * v[j].z + v[j].w * v[j].w); }
        const float rstd = rsqrtf(wave_sum(s) * (1.f / DM) + EPS);
        unsigned long long* o8 = (unsigned long long*)(dst + (size_t)(row0 + r) * DM) + F.lane;
#pragma unroll
        for (int j = 0; j < 4; ++j) { const int k = 4 * F.lane + 256 * j;
            const f32x4 g = *(const LAS f32x4*)(gs + k), h = *(const LAS f32x4*)(sh + k);
            const float o0 = v[j].x * rstd * g.x + h.x, o1 = v[j].y * rstd * g.y + h.y, o2 = v[j].z * rstd * g.z + h.z, o3 = v[j].w * rstd * g.w + h.w;
            o8[64 * j] = (unsigned long long)pk2(o0, o1) | ((unsigned long long)pk2(o2, o3) << 32); }
    }
}
__device__ __forceinline__ void p1_norm(Frame& F, const Args& a) {
    const float* modp = (const float*)(F.ws + WS_MODP); const float* bmod = a.in[IN_BMOD]; const float* g1 = a.in[IN_G1];
    LAS float* gs = (LAS float*)F.lds; LAS float* sh = gs + DM;
    bf16* H = (bf16*)F.out;
    float* mod = (float*)(F.ws + WS_MOD);
    for (int i = F.bid * NTHR + F.tid; i < 9 * 6144; i += F.G * NTHR) mod[i] = mod_from_partials(modp, bmod, i / 6144, i % 6144);
    const int b = F.bid / 32;
    for (int k = F.tid; k < DM; k += NTHR) { gs[k] = g1[k] * (1.f + mod_from_partials(modp, bmod, b, DM + k)); sh[k] = mod_from_partials(modp, bmod, b, k); }
    __syncthreads();
    norm_rows(F, a.in[IN_X], H, F.bid * 64, 64, gs, sh);
    __syncthreads();
    for (int k = F.tid; k < DM; k += NTHR) { gs[k] = g1[k] * (1.f + mod_from_partials(modp, bmod, 8, DM + k)); sh[k] = mod_from_partials(modp, bmod, 8, k); }
    __syncthreads();
    norm_rows(F, a.in[IN_CTX], H + (size_t)NTOK * DM, F.bid * 8, 8, gs, sh);
    __syncthreads();
}

struct EpiStoreBf16 {
    static constexpr bool PERM = true;
    __device__ __forceinline__ void operator()(const f32x4 (&acc)[2][2][4][2], const gm::Unit& u, int wr, int wc, int fr, int fq) const {
        bf16* base = (bf16*)u.dst + (size_t)(wr * 64 + fr) * DM + wc * 32 + 8 * fq;
#pragma unroll
        for (int ai = 0; ai < 2; ++ai)
#pragma unroll
            for (int m = 0; m < 4; ++m) { bf16* rowp = base + (size_t)(ai * 128 + m * 16) * DM;
#pragma unroll
                for (int bj = 0; bj < 2; ++bj) { const f32x4 v0 = acc[ai][bj][m][0], v1 = acc[ai][bj][m][1];
                    u32x4 w; w.x = gm::cvt_pk_bf16(v0[0], v0[1]); w.y = gm::cvt_pk_bf16(v0[2], v0[3]); w.z = gm::cvt_pk_bf16(v1[0], v1[1]); w.w = gm::cvt_pk_bf16(v1[2], v1[3]);
                    *(u32x4*)(rowp + bj * 128) = w; } }
    }
};
__device__ __forceinline__ void tile_order(int L, int nM, int nN, int& pm, int& pn) {
    const int nwg = nM * nN; int wgid = L;
    { const int q = nwg / 8, r = nwg % 8, xcd = wgid % 8, off = wgid / 8; wgid = (xcd < r ? xcd * (q + 1) : r * (q + 1) + (xcd - r) * q) + off; }
    const int nig = 8 * nN, gid = wgid / nig, fm = gid * 8, gsz = (nM - fm) < 8 ? (nM - fm) : 8;
    pm = fm + ((wgid % nig) % gsz); pn = (wgid % nig) / gsz;
}
struct SchedP2 {
    int G, c; const char* H; const char* Wt; char* P; char* PC;
    __device__ __forceinline__ bool next(int i, gm::Unit& u) const {
        int L = i * G + c;
        if (L < 64 * 36) { int pm, pn; tile_order(L, 64, 36, pm, pn);
            u.A = H + (size_t)pm * 256 * 2048; u.B0 = Wt + (size_t)pn * 256 * 2048; u.B1 = u.B0 + (size_t)128 * 2048;
            u.dst = P + (size_t)(pn >> 2) * GS + ((size_t)pm * 256 * DM + (pn & 3) * 256) * 2; u.pm = pm; u.pn = pn; u.e = 0; u.rows = 256; return true; }
        L -= 64 * 36; if (L >= 128) return false;
        const int pmc = L >> 4, j = L & 15, slot = j >> 2, g = slot == 0 ? 0 : slot + 2, pn = g * 4 + (j & 3);
        u.A = H + (size_t)(NTOK + pmc * 256) * 2048; u.B0 = Wt + (size_t)pn * 256 * 2048; u.B1 = u.B0 + (size_t)128 * 2048;
        u.dst = PC + (size_t)slot * CGS + ((size_t)pmc * 256 * DM + (j & 3) * 256) * 2; u.pm = pmc; u.pn = pn; u.e = 0; u.rows = 256; return true;
    }
    __device__ __forceinline__ unsigned arow(const gm::Unit&, int r) const { return (unsigned)r; }
};
constexpr int LRU_T = 128, LRU_NCH = SEQ / LRU_T, UF_LD = 144;
constexpr int LRU_UBF = 0, LRU_UF = 144 * 256;
constexpr float LOG2E = 1.4426950408889634f;

struct LruCoef { float ba, bx, ca; };

__device__ __forceinline__ void lru_conv(Frame& F, const Args& a, int b, int h, int c, bool special) {
    const bf16* AX = (const bf16*)(F.ws + WS_P) + (size_t)b * SEQ * DM + h * 128;
    const float* cw = a.in[IN_CONVW] + h * 128; const float* cb = a.in[IN_CONVB] + h * 128;
    LAS unsigned char* ubf = F.lds + LRU_UBF; LAS float* uf = (LAS float*)(F.lds + LRU_UF);
    const int cg = F.tid & 15;
    float w[4][8], bs[8];
#pragma unroll
    for (int k = 0; k < 4; ++k) { const f32x4 w0 = *(const f32x4*)(cw + k * DM + 8 * cg), w1 = *(const f32x4*)(cw + k * DM + 8 * cg + 4);
        w[k][0] = w0.x; w[k][1] = w0.y; w[k][2] = w0.z; w[k][3] = w0.w; w[k][4] = w1.x; w[k][5] = w1.y; w[k][6] = w1.z; w[k][7] = w1.w; }
    { const f32x4 b0 = *(const f32x4*)(cb + 8 * cg), b1 = *(const f32x4*)(cb + 8 * cg + 4); bs[0] = b0.x; bs[1] = b0.y; bs[2] = b0.z; bs[3] = b0.w; bs[4] = b1.x; bs[5] = b1.y; bs[6] = b1.z; bs[7] = b1.w; }
    const int nitem = special ? (LRU_T + 2) * 16 : LRU_T * 16;
    for (int item = F.tid; item < nitem; item += NTHR) {
        const int tl = item >> 4;
        float u[8];
#pragma unroll
        for (int q = 0; q < 8; ++q) u[q] = bs[q];
        if (tl < LRU_T) {
            const int t = c * LRU_T + tl;
#pragma unroll
            for (int k = 0; k < 4; ++k) { const int tt = t + k - 2;
                if (tt >= 0 && tt < SEQ) { const u32x4 v = *(const u32x4*)(AX + (size_t)tt * DM + 8 * cg);
                    u[0] += w[k][0] * bflo(v.x); u[1] += w[k][1] * bfhi(v.x); u[2] += w[k][2] * bflo(v.y); u[3] += w[k][3] * bfhi(v.y);
                    u[4] += w[k][4] * bflo(v.z); u[5] += w[k][5] * bfhi(v.z); u[6] += w[k][6] * bflo(v.w); u[7] += w[k][7] * bfhi(v.w); } }
        } else {
            const bf16* AC = (const bf16*)(F.ws + WS_PC) + (size_t)b * CTX * DM + h * 128;
            const int t = tl == LRU_T ? 0 : CTX - 1;
#pragma unroll
            for (int k = 0; k < 4; ++k) { const int tt = t + k - 2;
                if (tt >= 0 && tt < CTX) { const u32x4 v = *(const u32x4*)(AC + (size_t)tt * DM + 8 * cg);
                    u[0] += w[k][0] * bflo(v.x); u[1] += w[k][1] * bfhi(v.x); u[2] += w[k][2] * bflo(v.y); u[3] += w[k][3] * bfhi(v.y);
                    u[4] += w[k][4] * bflo(v.z); u[5] += w[k][5] * bfhi(v.z); u[6] += w[k][6] * bflo(v.w); u[7] += w[k][7] * bfhi(v.w); } }
        }
        *(LAS f32x4*)(uf + tl * UF_LD + 8 * cg) = (f32x4){u[0], u[1], u[2], u[3]};
        *(LAS f32x4*)(uf + tl * UF_LD + 8 * cg + 4) = (f32x4){u[4], u[5], u[6], u[7]};
        u32x4 p; p.x = pk2(u[0], u[1]); p.y = pk2(u[2], u[3]); p.z = pk2(u[4], u[5]); p.w = pk2(u[6], u[7]);
        *(LAS u32x4*)(ubf + tl * 256 + ((cg ^ (tl & 15)) << 4)) = p;
    }
    if (special) for (int item = F.tid; item < 14 * 16; item += NTHR) { const int tl = LRU_T + 2 + (item >> 4);
        *(LAS u32x4*)(ubf + tl * 256 + ((cg ^ (tl & 15)) << 4)) = (u32x4){0u, 0u, 0u, 0u}; }
}
__device__ __forceinline__ void lru_load_w(Frame& F, int d, int h, bf16x8 (&Bw)[2][4]) {
    const int fr = F.lane & 15, fq = F.lane >> 4;
#pragma unroll
    for (int which = 0; which < 2; ++which) { const bf16* W = (const bf16*)(F.ws + WS_WLRU) + (size_t)(which * 16 + d * 8 + h) * 128 * 128 + (size_t)(16 * F.wave + fr) * 128 + 8 * fq;
#pragma unroll
        for (int kk = 0; kk < 4; ++kk) Bw[which][kk] = *(const bf16x8*)(W + kk * 32); }
}
__device__ __forceinline__ LruCoef lru_coef(const Args& a, int d, int ch) {
    LruCoef k; k.ba = a.in[IN_BA][d * DM + ch]; k.bx = a.in[IN_BX][d * DM + ch];
    const float sp = log1pf(expf(-a.in[IN_LAM][d * DM + ch])); k.ca = -8.f * sp * LOG2E; return k;
}
__device__ __forceinline__ void lru_tile(Frame& F, int m, const bf16x8 (&Bw)[2][4], const LruCoef& k, float (&av)[4], float (&bv)[4]) {
    const int fr = F.lane & 15, fq = F.lane >> 4;
    const LAS unsigned char* ubf = F.lds + LRU_UBF; const LAS float* uf = (const LAS float*)(F.lds + LRU_UF);
    f32x4 ar = {0.f, 0.f, 0.f, 0.f}, ai = {0.f, 0.f, 0.f, 0.f};
    const int row = m * 16 + fr;
#pragma unroll
    for (int kk = 0; kk < 4; ++kk) { const bf16x8 A = *(const LAS bf16x8*)(ubf + row * 256 + (((kk * 4 + fq) ^ fr) << 4));
        ar = __builtin_amdgcn_mfma_f32_16x16x32_bf16(A, Bw[0][kk], ar, 0, 0, 0); ai = __builtin_amdgcn_mfma_f32_16x16x32_bf16(A, Bw[1][kk], ai, 0, 0, 0); }
#pragma unroll
    for (int r = 0; r < 4; ++r) { const float u = uf[(m * 16 + 4 * fq + r) * UF_LD + 16 * F.wave + fr];
        const float rg = __builtin_amdgcn_rcpf(1.f + __builtin_amdgcn_exp2f(-(ar[r] + k.ba) * LOG2E));
        const float ig = __builtin_amdgcn_rcpf(1.f + __builtin_amdgcn_exp2f(-(ai[r] + k.bx) * LOG2E));
        const float aa = __builtin_amdgcn_exp2f(k.ca * rg);
        av[r] = aa; bv[r] = __builtin_amdgcn_sqrtf(fmaxf(1.f - aa * aa, 0.f)) * (ig * u); }
}
template <bool FWD> __device__ __forceinline__ void lru_tile_total(int fq, float& A, float& B) {
#pragma unroll
    for (int s = 0; s < 2; ++s) { const int bit = 1 << s; const float Ap = __shfl_xor(A, 16 << s), Bp = __shfl_xor(B, 16 << s);
        const bool mine_first = FWD ? ((fq & bit) == 0) : ((fq & bit) != 0);
        if (mine_first) { B = B * Ap + Bp; A = A * Ap; } else { B = Bp * A + B; A = Ap * A; } }
}

__device__ __forceinline__ void lru_pass1(Frame& F, const Args& a, int unit) {
    const int c = unit & (LRU_NCH - 1), h = (unit >> 4) & 7, b = unit >> 7;
    const int fr = F.lane & 15, fq = F.lane >> 4; const int ch = h * 128 + 16 * F.wave + fr;
    lru_conv(F, a, b, h, c, c == 0);
    bf16x8 Bw0[2][4], Bw1[2][4]; lru_load_w(F, 0, h, Bw0); lru_load_w(F, 1, h, Bw1);
    const LruCoef k0 = lru_coef(a, 0, ch), k1 = lru_coef(a, 1, ch);
    LDS_WAIT(); __syncthreads();
    float Af = 1.f, Hf = 0.f, Ab = 1.f, Hb = 0.f;
    for (int m = 0; m < 8; ++m) {
        float av[4], bv[4];
        lru_tile(F, m, Bw0, k0, av, bv);
        float A = av[0] * av[1] * av[2] * av[3], B = ((bv[0] * av[1] + bv[1]) * av[2] + bv[2]) * av[3] + bv[3];
        lru_tile_total<true>(fq, A, B);
        Hf = Hf * A + B; Af = Af * A;
        lru_tile(F, m, Bw1, k1, av, bv);
        A = av[0] * av[1] * av[2] * av[3]; B = ((bv[3] * av[2] + bv[2]) * av[1] + bv[1]) * av[0] + bv[0];
        lru_tile_total<false>(fq, A, B);
        Hb = B * Ab + Hb; Ab = A * Ab;
    }
    float* agg = (float*)(F.ws + WS_LRUAGG);
    if (fq == 0) { *(f32x2*)(agg + ((size_t)((b * LRU_NCH + c) * 2 + 0) * DM + ch) * 2) = (f32x2){Af, Hf};
                   *(f32x2*)(agg + ((size_t)((b * LRU_NCH + c) * 2 + 1) * DM + ch) * 2) = (f32x2){Ab, Hb}; }
    if (c == 0) {
        float av[4], bv[4]; float* s0 = (float*)(F.ws + WS_LRUS0);
        lru_tile(F, 8, Bw0, k0, av, bv); if (fq == 0) s0[(b * 2 + 0) * DM + ch] = bv[0];
        lru_tile(F, 8, Bw1, k1, av, bv); if (fq == 0) s0[(b * 2 + 1) * DM + ch] = bv[1];
    }
    __syncthreads();
}

__device__ __forceinline__ void lru_pass2(Frame& F, const Args& a, int unit) {
    const int c = unit & (LRU_NCH - 1), h = (unit >> 4) & 7, b = unit >> 7;
    const int fr = F.lane & 15, fq = F.lane >> 4; const int ch = h * 128 + 16 * F.wave + fr;
    lru_conv(F, a, b, h, c, false);
    const float* agg = (const float*)(F.ws + WS_LRUAGG); const float* s0 = (const float*)(F.ws + WS_LRUS0);
    float hf = s0[(b * 2 + 0) * DM + ch], hb = s0[(b * 2 + 1) * DM + ch];
    for (int j = 0; j < c; ++j) { const f32x2 g = *(const f32x2*)(agg + ((size_t)((b * LRU_NCH + j) * 2 + 0) * DM + ch) * 2); hf = g.x * hf + g.y; }
    for (int j = LRU_NCH - 1; j > c; --j) { const f32x2 g = *(const f32x2*)(agg + ((size_t)((b * LRU_NCH + j) * 2 + 1) * DM + ch) * 2); hb = g.x * hb + g.y; }
    bf16x8 Bw[2][4]; lru_load_w(F, 0, h, Bw);
    LruCoef k = lru_coef(a, 0, ch);
    LDS_WAIT(); __syncthreads();
    float hfv[8][4];
#pragma unroll
    for (int m = 0; m < 8; ++m) {
        float av[4], bv[4];
        lru_tile(F, m, Bw, k, av, bv);
        const float A = av[0] * av[1] * av[2] * av[3], B = ((bv[0] * av[1] + bv[1]) * av[2] + bv[2]) * av[3] + bv[3];
        float hin = hf;
#pragma unroll
        for (int g = 0; g < 4; ++g) { const float Ag = __shfl(A, g * 16 + fr), Bg = __shfl(B, g * 16 + fr); if (g < fq) hin = Ag * hin + Bg; hf = Ag * hf + Bg; }
#pragma unroll
        for (int r = 0; r < 4; ++r) { hin = av[r] * hin + bv[r]; hfv[m][r] = hin; }
    }
    lru_load_w(F, 1, h, Bw); k = lru_coef(a, 1, ch);
    LAS float* uf = (LAS float*)(F.lds + LRU_UF);
#pragma unroll
    for (int m = 7; m >= 0; --m) {
        float av[4], bv[4];
        lru_tile(F, m, Bw, k, av, bv);
        const float A = av[0] * av[1] * av[2] * av[3], B = ((bv[3] * av[2] + bv[2]) * av[1] + bv[1]) * av[0] + bv[0];
        float hin = hb;
#pragma unroll
        for (int g = 3; g >= 0; --g) { const float Ag = __shfl(A, g * 16 + fr), Bg = __shfl(B, g * 16 + fr); if (g > fq) hin = Ag * hin + Bg; hb = Ag * hb + Bg; }
#pragma unroll
        for (int r = 3; r >= 0; --r) { hin = av[r] * hin + bv[r]; uf[(m * 16 + 4 * fq + r) * UF_LD + 16 * F.wave + fr] = hfv[m][r] + hin; }
    }
    LDS_WAIT(); __syncthreads();
    bf16* AY = (bf16*)(F.ws + WS_YAG) + ((size_t)b * SEQ + c * LRU_T) * DM + h * 128;
    const int cg = F.tid & 15;
    for (int item = F.tid; item < LRU_T * 16; item += NTHR) { const int tl = item >> 4;
        const f32x4 y0 = *(const LAS f32x4*)(uf + tl * UF_LD + 8 * cg), y1 = *(const LAS f32x4*)(uf + tl * UF_LD + 8 * cg + 4);
        u32x4* p = (u32x4*)(AY + (size_t)tl * DM + 8 * cg); const u32x4 g = *p;
        u32x4 o; o.x = pk2(y0.x * gelu_tanh(bflo(g.x)), y0.y * gelu_tanh(bfhi(g.x))); o.y = pk2(y0.z * gelu_tanh(bflo(g.y)), y0.w * gelu_tanh(bfhi(g.y)));
        o.z = pk2(y1.x * gelu_tanh(bflo(g.z)), y1.y * gelu_tanh(bfhi(g.z))); o.w = pk2(y1.z * gelu_tanh(bflo(g.w)), y1.w * gelu_tanh(bfhi(g.w)));
        *p = o; }
    __syncthreads();
}
constexpr int HG_C = 64, HG_SEG = 512, HG_NSEG = 4;
constexpr int HG_QS = 0, HG_QM = 16384, HG_KM = 32768, HG_KDT = 49152, HG_VT = 65536, HG_ATT = 81920, HG_PART = 90112, HG_ETOT = 94208, HG_ROWS = 94720;
constexpr size_t HGS_IMG = 65536;

__device__ __forceinline__ int hg_row(int b, int dir, bool ctx, int sigma) {
    if (ctx) { const int t = dir ? (CTX - 1 - sigma) : sigma; return b * CTX + t; }
    const int p = dir ? (SEQ - 1 - sigma) : sigma; return b * SEQ + (p & 31) * 64 + (p >> 5);
}

template <bool FULL>
__device__ __forceinline__ void hg_prep(Frame& F, const bf16* Qb, const bf16* Fb, const bf16* Vb, int b, int dir, bool ctx, int sigma0, float lb0, float lb1, float& gs0, float& gs1) {
    const int kp = F.lane, to = F.wave;
    unsigned fw[8], qw[8], vw[8];
#pragma unroll
    for (int j = 0; j < 8; ++j) { const size_t ro = (size_t)hg_row(b, dir, ctx, sigma0 + 8 * to + j) * DM + 2 * kp;
        fw[j] = *(const unsigned*)(Fb + ro); vw[j] = *(const unsigned*)(Vb + ro); if (FULL) qw[j] = *(const unsigned*)(Qb + ro); }
    float c0[8], c1[8], k0[8], k1[8];
    float a0 = 0.f, a1 = 0.f;
#pragma unroll
    for (int j = 0; j < 8; ++j) {
        const float g0 = lb0 + (1.f - lb0) * __builtin_amdgcn_rcpf(1.f + __builtin_amdgcn_exp2f(-bflo(fw[j]) * LOG2E));
        const float g1 = lb1 + (1.f - lb1) * __builtin_amdgcn_rcpf(1.f + __builtin_amdgcn_exp2f(-bfhi(fw[j]) * LOG2E));
        k0[j] = 1.f - g0; k1[j] = 1.f - g1;
        a0 += __builtin_amdgcn_logf(g0); a1 += __builtin_amdgcn_logf(g1);
        c0[j] = a0; c1[j] = a1; }
    LAS float* part = (LAS float*)(F.lds + HG_PART);
    *(LAS f32x2*)(part + to * 128 + 2 * kp) = (f32x2){a0, a1};
    LDS_WAIT(); __syncthreads();
    if (FULL && F.tid < HG_C) ((LAS int*)(F.lds + HG_ROWS))[F.tid] = hg_row(b, dir, ctx, sigma0 + F.tid);
    float off0 = 0.f, off1 = 0.f, tot0 = 0.f, tot1 = 0.f, mid0 = 0.f, mid1 = 0.f;
#pragma unroll
    for (int o = 0; o < 8; ++o) { const f32x2 p = *(const LAS f32x2*)(part + o * 128 + 2 * kp);
        if (o < to) { off0 += p.x; off1 += p.y; } if (o < 4) { mid0 += p.x; mid1 += p.y; } tot0 += p.x; tot1 += p.y; }
    gs0 += tot0; gs1 += tot1;
    const float et0 = __builtin_amdgcn_exp2f(tot0), et1 = __builtin_amdgcn_exp2f(tot1);
    const float em0 = __builtin_amdgcn_exp2f(mid0), em1 = __builtin_amdgcn_exp2f(mid1), ei0 = __builtin_amdgcn_exp2f(-mid0), ei1 = __builtin_amdgcn_exp2f(-mid1);
    if (to == 0) *(LAS f32x2*)((LAS float*)(F.lds + HG_ETOT) + 2 * kp) = (f32x2){et0, et1};
    float kd0[8], kd1[8];
#pragma unroll
    for (int j = 0; j < 8; ++j) {
        const float E0 = __builtin_amdgcn_exp2f(off0 + c0[j]), E1 = __builtin_amdgcn_exp2f(off1 + c1[j]);
        const float R0 = __builtin_amdgcn_rcpf(E0), R1 = __builtin_amdgcn_rcpf(E1);
        kd0[j] = k0[j] * R0 * et0; kd1[j] = k1[j] * R1 * et1;
        if (FULL) {
            const float q0 = bflo(qw[j]), q1 = bfhi(qw[j]);
            const float s0 = q0 * __builtin_amdgcn_rcpf(1.f + __builtin_amdgcn_exp2f(-q0 * LOG2E)) * E0, s1 = q1 * __builtin_amdgcn_rcpf(1.f + __builtin_amdgcn_exp2f(-q1 * LOG2E)) * E1;
            const int c = 8 * to + j; const int off = c * 256 + ((4 * kp) ^ ((c & 15) << 4));
            *(LAS unsigned*)(F.lds + HG_QS + off) = pk2(s0, s1);
            *(LAS unsigned*)(F.lds + HG_QM + off) = pk2(s0 * ei0, s1 * ei1);
            *(LAS unsigned*)(F.lds + HG_KM + off) = pk2(k0[j] * R0 * em0, k1[j] * R1 * em1);
        }
    }
    { const int sw = ((to ^ (kp & 7)) << 4);
      u32x4 w0, w1; w0.x = pk2(kd0[0], kd0[1]); w0.y = pk2(kd0[2], kd0[3]); w0.z = pk2(kd0[4], kd0[5]); w0.w = pk2(kd0[6], kd0[7]);
      w1.x = pk2(kd1[0], kd1[1]); w1.y = pk2(kd1[2], kd1[3]); w1.z = pk2(kd1[4], kd1[5]); w1.w = pk2(kd1[6], kd1[7]);
      *(LAS u32x4*)(F.lds + HG_KDT + (2 * kp) * 128 + sw) = w0; *(LAS u32x4*)(F.lds + HG_KDT + (2 * kp + 1) * 128 + sw) = w1;
      u32x4 v0, v1;
      v0.x = (vw[0] & 0xffffu) | (vw[1] << 16); v0.y = (vw[2] & 0xffffu) | (vw[3] << 16); v0.z = (vw[4] & 0xffffu) | (vw[5] << 16); v0.w = (vw[6] & 0xffffu) | (vw[7] << 16);
      v1.x = (vw[0] >> 16) | (vw[1] & 0xffff0000u); v1.y = (vw[2] >> 16) | (vw[3] & 0xffff0000u); v1.z = (vw[4] >> 16) | (vw[5] & 0xffff0000u); v1.w = (vw[6] >> 16) | (vw[7] & 0xffff0000u);
      *(LAS u32x4*)(F.lds + HG_VT + (2 * kp) * 128 + sw) = v0; *(LAS u32x4*)(F.lds + HG_VT + (2 * kp + 1) * 128 + sw) = v1; }
    LDS_WAIT(); __syncthreads();
}
__device__ __forceinline__ void hg_state_update(Frame& F, f32x4 (&St)[8], const bf16x8 (&vt)[2]) {
    const int fr = F.lane & 15, fq = F.lane >> 4;
    const LAS float* etot = (const LAS float*)(F.lds + HG_ETOT);
#pragma unroll
    for (int kt = 0; kt < 8; ++kt) { const f32x4 e = *(const LAS f32x4*)(etot + 16 * kt + 4 * fq); St[kt] = St[kt] * e;
        const int rk = 16 * kt + fr;
#pragma unroll
        for (int ks = 0; ks < 2; ++ks) { const bf16x8 A = *(const LAS bf16x8*)(F.lds + HG_KDT + rk * 128 + (((4 * ks + fq) ^ ((rk >> 1) & 7)) << 4));
            St[kt] = __builtin_amdgcn_mfma_f32_16x16x32_bf16(A, vt[ks], St[kt], 0, 0, 0); } }
}
__device__ __forceinline__ void hg_load_vt(Frame& F, bf16x8 (&vt)[2]) {
    const int fr = F.lane & 15, fq = F.lane >> 4; const int rv = 16 * F.wave + fr;
#pragma unroll
    for (int ks = 0; ks < 2; ++ks) vt[ks] = *(const LAS bf16x8*)(F.lds + HG_VT + rv * 128 + (((4 * ks + fq) ^ ((rv >> 1) & 7)) << 4));
}
struct HgPtrs { const bf16* Q; const bf16* Fx; const bf16* V; const bf16* Fc; const bf16* Vc; bf16* O; };
__device__ __forceinline__ HgPtrs hg_ptrs(Frame& F, int h, int dir) {
    HgPtrs p; p.Q = (const bf16*)(F.ws + WS_P + 2 * GS) + h * 128; p.Fx = (const bf16*)(F.ws + WS_P + (dir ? 4 : 3) * GS) + h * 128; p.V = (const bf16*)(F.ws + WS_P + 5 * GS) + h * 128;
    p.Fc = (const bf16*)(F.ws + WS_PC + (dir ? 2 : 1) * CGS) + h * 128; p.Vc = (const bf16*)(F.ws + WS_PC + 3 * CGS) + h * 128; p.O = (bf16*)(F.ws + WS_P + (dir ? 4 : 3) * GS) + h * 128; return p;
}
__device__ __forceinline__ void hg_lb(const Args& a, int h, int kp, float& lb0, float& lb1) {
    const float* t = a.in[IN_HGLB] + h * 128 + 2 * kp; lb0 = 1.f / (1.f + expf(t[DM] - t[0])); lb1 = 1.f / (1.f + expf(t[DM + 1] - t[1]));
}
__device__ __forceinline__ float* hg_img(Frame& F, int b, int h, int dir, int slot) { return (float*)((unsigned char*)F.out + (size_t)((((b * 8 + h) * 2 + dir) * 4) + slot) * HGS_IMG); }

__device__ __forceinline__ void hg_pass1(Frame& F, const Args& a, int unit) {
    const int slot = unit & 3, dir = (unit >> 2) & 1, h = (unit >> 3) & 7, b = unit >> 6;
    const int fr = F.lane & 15, fq = F.lane >> 4;
    const HgPtrs P = hg_ptrs(F, h, dir);
    float lb0, lb1; hg_lb(a, h, F.lane, lb0, lb1);
    f32x4 St[8];
#pragma unroll
    for (int kt = 0; kt < 8; ++kt) St[kt] = (f32x4){0.f, 0.f, 0.f, 0.f};
    const bool ctx = slot == 0; const int nchunk = ctx ? CTX / HG_C : HG_SEG / HG_C; const int sig0 = ctx ? 0 : (slot - 1) * HG_SEG;
    float gs0 = 0.f, gs1 = 0.f;
    for (int ck = 0; ck < nchunk; ++ck) {
        hg_prep<false>(F, P.Q, ctx ? P.Fc : P.Fx, ctx ? P.Vc : P.V, b, dir, ctx, sig0 + ck * HG_C, lb0, lb1, gs0, gs1);
        bf16x8 vt[2]; hg_load_vt(F, vt);
        hg_state_update(F, St, vt);
    }
    float* img = hg_img(F, b, h, dir, slot) + (size_t)(16 * F.wave + fr) * 128 + 4 * fq;
#pragma unroll
    for (int kt = 0; kt < 8; ++kt) *(f32x4*)(img + 16 * kt) = St[kt];
    if (!ctx && F.wave == 0) { float* D = (float*)(F.ws + WS_HGD) + (size_t)((((b * 8 + h) * 2 + dir) * 3) + (slot - 1)) * 128 + 2 * F.lane;
        *(f32x2*)D = (f32x2){__builtin_amdgcn_exp2f(gs0), __builtin_amdgcn_exp2f(gs1)}; }
    __syncthreads();
}

__device__ __forceinline__ void hg_pass2(Frame& F, const Args& a, int unit) {
    const int seg = unit & 3, dir = (unit >> 2) & 1, h = (unit >> 3) & 7, b = unit >> 6;
    const int fr = F.lane & 15, fq = F.lane >> 4, w = F.wave;
    const HgPtrs P = hg_ptrs(F, h, dir);
    float lb0, lb1; hg_lb(a, h, F.lane, lb0, lb1);
    f32x4 St[8];
    {
        const float* img = hg_img(F, b, h, dir, 0) + (size_t)(16 * w + fr) * 128 + 4 * fq;
#pragma unroll
        for (int kt = 0; kt < 8; ++kt) St[kt] = *(const f32x4*)(img + 16 * kt);
        for (int j = 0; j < seg; ++j) {
            const float* im = hg_img(F, b, h, dir, 1 + j) + (size_t)(16 * w + fr) * 128 + 4 * fq;
            const float* D = (const float*)(F.ws + WS_HGD) + (size_t)((((b * 8 + h) * 2 + dir) * 3) + j) * 128 + 4 * fq;
#pragma unroll
            for (int kt = 0; kt < 8; ++kt) { const f32x4 d = *(const f32x4*)(D + 16 * kt), dl = *(const f32x4*)(im + 16 * kt); St[kt] = St[kt] * d + dl; }
        }
    }
    float gs0 = 0.f, gs1 = 0.f;
    for (int ck = 0; ck < HG_SEG / HG_C; ++ck) {
        hg_prep<true>(F, P.Q, P.Fx, P.V, b, dir, false, seg * HG_SEG + ck * HG_C, lb0, lb1, gs0, gs1);
#pragma unroll
        for (int tt = 0; tt < 2; ++tt) { const int t = w + 8 * tt, ct = t >> 2, st = t & 3;
            f32x4 acc = {0.f, 0.f, 0.f, 0.f};
            const int rs = 16 * st + fr, rc = 16 * ct + fr;
#pragma unroll
            for (int kk = 0; kk < 4; ++kk) { const bf16x8 A = *(const LAS bf16x8*)(F.lds + HG_KM + rs * 256 + (((4 * kk + fq) ^ fr) << 4));
                const bf16x8 B = *(const LAS bf16x8*)(F.lds + HG_QM + rc * 256 + (((4 * kk + fq) ^ fr) << 4));
                acc = __builtin_amdgcn_mfma_f32_16x16x32_bf16(A, B, acc, 0, 0, 0); }
            const int s0 = 16 * st + 4 * fq;
            const float m0 = (s0 + 0 <= rc) ? acc[0] : 0.f, m1 = (s0 + 1 <= rc) ? acc[1] : 0.f, m2 = (s0 + 2 <= rc) ? acc[2] : 0.f, m3 = (s0 + 3 <= rc) ? acc[3] : 0.f;
            *(LAS u32x2*)(F.lds + HG_ATT + rc * 128 + (((2 * st + (fq >> 1)) ^ ((rc >> 1) & 7)) << 4) + (fq & 1) * 8) = (u32x2){pk2(m0, m1), pk2(m2, m3)}; }
        f32x4 o[4];
#pragma unroll
        for (int ct = 0; ct < 4; ++ct) o[ct] = (f32x4){0.f, 0.f, 0.f, 0.f};
#pragma unroll
        for (int kk = 0; kk < 4; ++kk) {
            union { bf16x8 v; unsigned u[4]; } A;
            A.u[0] = pk2(St[2 * kk][0], St[2 * kk][1]); A.u[1] = pk2(St[2 * kk][2], St[2 * kk][3]); A.u[2] = pk2(St[2 * kk + 1][0], St[2 * kk + 1][1]); A.u[3] = pk2(St[2 * kk + 1][2], St[2 * kk + 1][3]);
#pragma unroll
            for (int ct = 0; ct < 4; ++ct) { const int rc = 16 * ct + fr;
                union { bf16x8 v; u32x2 h[2]; } B;
                B.h[0] = *(const LAS u32x2*)(F.lds + HG_QS + rc * 256 + (((4 * kk + (fq >> 1)) ^ fr) << 4) + (fq & 1) * 8);
                B.h[1] = *(const LAS u32x2*)(F.lds + HG_QS + rc * 256 + (((4 * kk + 2 + (fq >> 1)) ^ fr) << 4) + (fq & 1) * 8);
                o[ct] = __builtin_amdgcn_mfma_f32_16x16x32_bf16(A.v, B.v, o[ct], 0, 0, 0); } }
        bf16x8 vt[2]; hg_load_vt(F, vt);
        LDS_WAIT(); __syncthreads();
#pragma unroll
        for (int ks = 0; ks < 2; ++ks)
#pragma unroll
            for (int ct = 0; ct < 4; ++ct) { const int rc = 16 * ct + fr;
                const bf16x8 B = *(const LAS bf16x8*)(F.lds + HG_ATT + rc * 128 + (((4 * ks + fq) ^ ((rc >> 1) & 7)) << 4));
                o[ct] = __builtin_amdgcn_mfma_f32_16x16x32_bf16(vt[ks], B, o[ct], 0, 0, 0); }
        { const LAS int* rows = (const LAS int*)(F.lds + HG_ROWS);
#pragma unroll
          for (int ct = 0; ct < 4; ++ct) { const int row = rows[16 * ct + fr];
              *(u32x2*)(P.O + (size_t)row * DM + 16 * w + 4 * fq) = (u32x2){pk2(o[ct][0], o[ct][1]), pk2(o[ct][2], o[ct][3])}; } }
        hg_state_update(F, St, vt);
    }
    __syncthreads();
}
__device__ __forceinline__ void p_ybg(Frame& F, const Args& a) {
    const bf16* OFp = (const bf16*)(F.ws + WS_OF); const bf16* OBp = (const bf16*)(F.ws + WS_OB); const bf16* OG = (const bf16*)(F.ws + WS_P + 6 * GS);
    bf16* YBG = (bf16*)(F.ws + WS_YBG); const float* hgn = a.in[IN_HGN];
    const int gw = F.bid * NWAVES + F.wave, NGW = F.G * NWAVES;
    for (int row = gw; row < NTOK; row += NGW) {
#pragma unroll
        for (int j = 0; j < 2; ++j) { const int k = 8 * F.lane + 512 * j; const size_t o = (size_t)row * DM + k;
            const u32x4 f = *(const u32x4*)(OFp + o), b = *(const u32x4*)(OBp + o), g = *(const u32x4*)(OG + o);
            float v[8]; v[0] = bflo(f.x) + bflo(b.x); v[1] = bfhi(f.x) + bfhi(b.x); v[2] = bflo(f.y) + bflo(b.y); v[3] = bfhi(f.y) + bfhi(b.y);
            v[4] = bflo(f.z) + bflo(b.z); v[5] = bfhi(f.z) + bfhi(b.z); v[6] = bflo(f.w) + bflo(b.w); v[7] = bfhi(f.w) + bfhi(b.w);
            float ss = 0.f;
#pragma unroll
            for (int q = 0; q < 8; ++q) ss += v[q] * v[q];
            ss += __shfl_xor(ss, 1); ss += __shfl_xor(ss, 2); ss += __shfl_xor(ss, 4); ss += __shfl_xor(ss, 8);
            const float rs = rsqrtf(ss * (1.f / 128.f) + EPS);
            float gv[8]; gv[0] = bflo(g.x); gv[1] = bfhi(g.x); gv[2] = bflo(g.y); gv[3] = bfhi(g.y); gv[4] = bflo(g.z); gv[5] = bfhi(g.z); gv[6] = bflo(g.w); gv[7] = bfhi(g.w);
            const f32x4 h0 = *(const f32x4*)(hgn + k), h1 = *(const f32x4*)(hgn + k + 4);
            const float hv[8] = {h0.x, h0.y, h0.z, h0.w, h1.x, h1.y, h1.z, h1.w};
            float r[8];
#pragma unroll
            for (int q = 0; q < 8; ++q) r[q] = v[q] * rs * hv[q] * siluf_(gv[q]);
            u32x4 w; w.x = pk2(r[0], r[1]); w.y = pk2(r[2], r[3]); w.z = pk2(r[4], r[5]); w.w = pk2(r[6], r[7]);
            *(u32x4*)(YBG + o) = w; }
    }
}
__device__ __forceinline__ void p_moe_weights(Frame& F, const Args& a) {
    LAS float* scr = (LAS float*)(F.lds + F.wave * TR_BYTES);
    const int gw = F.bid * NWAVES + F.wave, NGW = F.G * NWAVES;
    constexpr int PER_E = 3 * 128;
    for (int it = gw; it < NEXP * PER_E; it += NGW) {
        const int e = it / PER_E, r = it % PER_E, w = r >> 7, q = r & 127;
        if (w < 2) { const int kb = q >> 3, nb = q & 7;
            transpose_item(a.in[w == 0 ? IN_W1 : IN_W3] + (size_t)e * DM * DEXP, DEXP, DM, (bf16*)(F.ws + (w == 0 ? WS_W1T : WS_W3T)) + ((size_t)e * DEXP + nb * 64) * DM, kb * 64, nb * 64, scr, F.lane); }
        else { const int kb = q >> 4, nb = q & 15;
            transpose_item(a.in[IN_W2] + (size_t)e * DEXP * DM, DM, DEXP, (bf16*)(F.ws + WS_W2T) + ((size_t)e * DM + nb * 64) * DEXP, kb * 64, nb * 64, scr, F.lane); }
    }
}

struct SchedP5 {
    int c; const char* YAG; const char* YBG; const char* WA; const char* WB; char* stash; char* M;
    __device__ __forceinline__ bool next(int i, gm::Unit& u) const {
        if (i >= 2) return false;
        int pm, pn; tile_order(c, 64, 4, pm, pn);
        u.A = (i == 0 ? YAG : YBG) + (size_t)pm * 256 * 2048; u.B0 = (i == 0 ? WA : WB) + (size_t)pn * 256 * 2048; u.B1 = u.B0 + (size_t)128 * 2048;
        u.dst = M + ((size_t)pm * 256 * DM + pn * 256) * 2; u.pm = pm; u.pn = pn; u.e = i; u.rows = 256; return true;
    }
    __device__ __forceinline__ unsigned arow(const gm::Unit&, int r) const { return (unsigned)r; }
};
struct EpiP5 {
    static constexpr bool PERM = true;
    float* stash; const bf16* GA; const bf16* GB;
    __device__ __forceinline__ void operator()(const f32x4 (&acc)[2][2][4][2], const gm::Unit& u, int wr, int wc, int fr, int fq) const {
        const bf16* G = (u.e == 0 ? GA : GB) + ((size_t)u.pm * 256 + wr * 64 + fr) * DM + u.pn * 256 + wc * 32 + 8 * fq;
        bf16* Mb = (bf16*)u.dst + (size_t)(wr * 64 + fr) * DM + wc * 32 + 8 * fq;
        f32x4* st = (f32x4*)stash + threadIdx.x;
        asm volatile("" : "+v"(G), "+v"(Mb), "+v"(st));
#pragma unroll
        for (int ai = 0; ai < 2; ++ai)
#pragma unroll
            for (int m = 0; m < 4; ++m)
#pragma unroll
                for (int bj = 0; bj < 2; ++bj) { const size_t ro = (size_t)(ai * 128 + m * 16) * DM + bj * 128;
                    const u32x4 g = *(const u32x4*)(G + ro);
                    f32x4 v0 = acc[ai][bj][m][0], v1 = acc[ai][bj][m][1];
                    v0[0] *= sigmoidf_(bflo(g.x)); v0[1] *= sigmoidf_(bfhi(g.x)); v0[2] *= sigmoidf_(bflo(g.y)); v0[3] *= sigmoidf_(bfhi(g.y));
                    v1[0] *= sigmoidf_(bflo(g.z)); v1[1] *= sigmoidf_(bfhi(g.z)); v1[2] *= sigmoidf_(bflo(g.w)); v1[3] *= sigmoidf_(bfhi(g.w));
                    const int si = ((ai * 4 + m) * 2 + bj) * 2;
                    if (u.e == 0) { st[(size_t)(si + 0) * NTHR] = v0; st[(size_t)(si + 1) * NTHR] = v1; }
                    else { v0 += st[(size_t)(si + 0) * NTHR]; v1 += st[(size_t)(si + 1) * NTHR];
                        u32x4 w; w.x = gm::cvt_pk_bf16(v0[0], v0[1]); w.y = gm::cvt_pk_bf16(v0[2], v0[3]); w.z = gm::cvt_pk_bf16(v1[0], v1[1]); w.w = gm::cvt_pk_bf16(v1[2], v1[3]);
                        *(u32x4*)(Mb + ro) = w; }
                    asm volatile("" ::: "memory"); }
    }
};

struct SchedP6 {
    int c; const char* M; const char* W; char* X1;
    __device__ __forceinline__ bool next(int i, gm::Unit& u) const {
        if (i >= 1) return false;
        int pm, pn; tile_order(c, 64, 4, pm, pn);
        u.A = M + (size_t)pm * 256 * 2048; u.B0 = W + (size_t)pn * 256 * 2048; u.B1 = u.B0 + (size_t)128 * 2048;
        u.dst = X1 + ((size_t)pm * 256 * DM + pn * 256) * 4; u.pm = pm; u.pn = pn; u.e = 0; u.rows = 256; return true;
    }
    __device__ __forceinline__ unsigned arow(const gm::Unit&, int r) const { return (unsigned)r; }
};
struct EpiP6 {
    static constexpr bool PERM = false;
    const float* x; const float* mod;
    __device__ __forceinline__ void operator()(const f32x4 (&acc)[2][2][4][2], const gm::Unit& u, int wr, int wc, int fr, int fq) const {
        const int b = u.pm >> 3; const int col0 = u.pn * 256 + wc * 32 + 4 * fq;
        const float* mg = mod + b * 6144 + 2 * DM + col0;
        f32x4 gv[2][2];
#pragma unroll
        for (int bj = 0; bj < 2; ++bj)
#pragma unroll
            for (int n = 0; n < 2; ++n) gv[bj][n] = *(const f32x4*)(mg + bj * 128 + n * 16);
#pragma unroll
        for (int ai = 0; ai < 2; ++ai)
#pragma unroll
            for (int m = 0; m < 4; ++m) { const size_t ro = (size_t)(wr * 64 + fr + ai * 128 + m * 16) * DM + wc * 32 + 4 * fq;
                const float* xr = x + ((size_t)u.pm * 256 * DM + u.pn * 256) + ro; float* orow = (float*)u.dst + ro;
#pragma unroll
                for (int bj = 0; bj < 2; ++bj)
#pragma unroll
                    for (int n = 0; n < 2; ++n) { const f32x4 xv = *(const f32x4*)(xr + bj * 128 + n * 16);
                        *(f32x4*)(orow + bj * 128 + n * 16) = xv + gv[bj][n] * acc[ai][bj][m][n]; } }
    }
};

__device__ __forceinline__ void p_norm2_route(Frame& F, const Args& a) {
    const float* mod = (const float*)(F.ws + WS_MOD); const float* g2 = a.in[IN_G2]; const float* wrp = (const float*)(F.ws + WS_WRT);
    const float* X1 = F.out; bf16* HX2 = (bf16*)(F.ws + WS_HX2);
    int* list = (int*)(F.ws + WS_LIST); float* wt = (float*)(F.ws + WS_WT); unsigned* cnt = F.ctl + CW_CNT;
    LAS float* gs = (LAS float*)F.lds; LAS float* sh = gs + DM; LAS float* rst = sh + DM; LAS float* lgs = rst + 64;
    const int b = F.bid / 32;
    for (int k = F.tid; k < DM; k += NTHR) { gs[k] = g2[k] * (1.f + mod[b * 6144 + 4 * DM + k]); sh[k] = mod[b * 6144 + 3 * DM + k]; }
    __syncthreads();
    for (int r = F.wave; r < 64; r += NWAVES) {
        const int tok = F.bid * 64 + r;
        const f32x4* xr = (const f32x4*)(X1 + (size_t)tok * DM) + F.lane;
        f32x4 v[4]; float s = 0.f;
#pragma unroll
        for (int j = 0; j < 4; ++j) { v[j] = xr[64 * j]; s += (v[j].x * v[j].x + v[j].y * v[j].y) + (v[j].z * v[j].z + v[j].w * v[j].w); }
        const float rstd = rsqrtf(wave_sum(s) * (1.f / DM) + EPS);
        if (F.lane == 0) rst[r] = rstd;
        unsigned long long* o8 = (unsigned long long*)(HX2 + (size_t)tok * DM) + F.lane;
#pragma unroll
        for (int j = 0; j < 4; ++j) { const int k = 4 * F.lane + 256 * j;
            const f32x4 g = *(const LAS f32x4*)(gs + k), h = *(const LAS f32x4*)(sh + k);
            o8[64 * j] = (unsigned long long)pk2(v[j].x * rstd * g.x + h.x, v[j].y * rstd * g.y + h.y) | ((unsigned long long)pk2(v[j].z * rstd * g.z + h.z, v[j].w * rstd * g.w + h.w) << 32); }
    }
    LDS_WAIT(); __syncthreads();
    if (F.wave < 4) {
        const int tq = F.lane & 15, kq = F.lane >> 4; const int tl = F.wave * 16 + tq;
        const float rs = rst[tl];
        const float* xr = X1 + (size_t)(F.bid * 64 + tl) * DM + 4 * kq;
        const f32x4* wp = (const f32x4*)wrp + F.lane;
        f32x4 acc[3];
#pragma unroll
        for (int c = 0; c < 3; ++c) acc[c] = (f32x4){0.f, 0.f, 0.f, 0.f};
#pragma unroll 4
        for (int s = 0; s < 64; ++s) {
            const f32x4 x = *(const f32x4*)(xr + 16 * s); const f32x4 g = *(const LAS f32x4*)(gs + 16 * s + 4 * kq), h = *(const LAS f32x4*)(sh + 16 * s + 4 * kq);
            const f32x4 hv = x * rs * g + h;
#pragma unroll
            for (int c = 0; c < 3; ++c) { const f32x4 w = wp[(s * 3 + c) * 64];
                acc[c] = __builtin_amdgcn_mfma_f32_16x16x4f32(hv[0], w[0], acc[c], 0, 0, 0); acc[c] = __builtin_amdgcn_mfma_f32_16x16x4f32(hv[1], w[1], acc[c], 0, 0, 0);
                acc[c] = __builtin_amdgcn_mfma_f32_16x16x4f32(hv[2], w[2], acc[c], 0, 0, 0); acc[c] = __builtin_amdgcn_mfma_f32_16x16x4f32(hv[3], w[3], acc[c], 0, 0, 0); }
        }
#pragma unroll
        for (int c = 0; c < 3; ++c)
#pragma unroll
            for (int r = 0; r < 4; ++r) lgs[(F.wave * 16 + 4 * kq + r) * 48 + 16 * c + tq] = acc[c][r] + wrp[49152 + 16 * c + tq];
        LDS_WAIT(); asm volatile("" ::: "memory");
        if (F.lane < 16) {
            const LAS float* lp = lgs + (F.wave * 16 + F.lane) * 48; const int tok = F.bid * 64 + F.wave * 16 + F.lane;
            float lg[36];
#pragma unroll
            for (int q = 0; q < 9; ++q) { const f32x4 t4 = *(const LAS f32x4*)(lp + 4 * q); lg[4 * q] = t4.x; lg[4 * q + 1] = t4.y; lg[4 * q + 2] = t4.z; lg[4 * q + 3] = t4.w; }
            float mx = lg[0]; int gi = 0;
#pragma unroll
            for (int g = 1; g < 4; ++g) if (lg[g] > mx) { mx = lg[g]; gi = g; }
            float z = 0.f;
#pragma unroll
            for (int g = 0; g < 4; ++g) z += __expf(lg[g] - mx);
            const float pg = 1.f / z;
            float el[8];
#pragma unroll
            for (int e = 0; e < 8; ++e) el[e] = gi == 0 ? lg[4 + e] : (gi == 1 ? lg[12 + e] : (gi == 2 ? lg[20 + e] : lg[28 + e]));
            int e1 = 0; float m1 = el[0];
#pragma unroll
            for (int e = 1; e < 8; ++e) if (el[e] > m1) { m1 = el[e]; e1 = e; }
            int e2 = 0; float m2 = -3.0e38f;
#pragma unroll
            for (int e = 0; e < 8; ++e) if (e != e1 && el[e] > m2) { m2 = el[e]; e2 = e; }
            const float rr = __expf(m2 - m1); const float w1 = pg / (1.f + rr), w2 = pg * rr / (1.f + rr);
            const int ea = gi * 8 + e1, eb = gi * 8 + e2;
            const unsigned pa = __hip_atomic_fetch_add(cnt + 64 * ea, 1u, __ATOMIC_RELAXED, __HIP_MEMORY_SCOPE_AGENT);
            const unsigned pb = __hip_atomic_fetch_add(cnt + 64 * eb, 1u, __ATOMIC_RELAXED, __HIP_MEMORY_SCOPE_AGENT);
            list[(size_t)ea * CAP + pa] = tok * 2; wt[tok * 2] = w1;
            list[(size_t)eb * CAP + pb] = tok * 2 + 1; wt[tok * 2 + 1] = w2;
        }
    }
}

struct MoeUnits {
    int ntile[NEXP + 1];
    int off[NEXP + 1];
};
struct SchedMoe1 {
    int G, c; const int* cntv; const int* list; const char* HX2; const char* W1T; const char* W3T; char* HH;
    __device__ __forceinline__ bool find(int L, int& e, int& rt, int& pn, int& rows, int& off) const {
        const int T = L >> 2; pn = L & 3; int acc_t = 0, acc_o = 0;
        for (int q = 0; q < NEXP; ++q) { const int cq = cntv[64 * q]; const int nt = (cq + 255) >> 8;
            if (T < acc_t + nt) { e = q; rt = T - acc_t; rows = cq - rt * 256; if (rows > 256) rows = 256; off = acc_o; return true; }
            acc_t += nt; acc_o += cq; }
        return false;
    }
    __device__ __forceinline__ bool next(int i, gm::Unit& u) const {
        int e, rt, pn, rows, off; if (!find(i * G + c, e, rt, pn, rows, off)) return false;
        u.A = HX2; u.B0 = W1T + ((size_t)e * DEXP + pn * 128) * 2048; u.B1 = W3T + ((size_t)e * DEXP + pn * 128) * 2048;
        u.dst = HH + ((size_t)(off + rt * 256) * DEXP + pn * 128) * 2; u.pm = rt; u.pn = pn; u.e = e; u.rows = rows; return true;
    }
    __device__ __forceinline__ unsigned arow(const gm::Unit& u, int r) const { const int rr = r < u.rows ? r : u.rows - 1; return (unsigned)(list[(size_t)u.e * CAP + u.pm * 256 + rr] >> 1); }
};
struct EpiMoe1 {
    static constexpr bool PERM = true;
    __device__ __forceinline__ void operator()(const f32x4 (&acc)[2][2][4][2], const gm::Unit& u, int wr, int wc, int fr, int fq) const {
        bf16* base = (bf16*)u.dst + (size_t)(wr * 64 + fr) * DEXP + wc * 32 + 8 * fq;
#pragma unroll
        for (int ai = 0; ai < 2; ++ai)
#pragma unroll
            for (int m = 0; m < 4; ++m) { const int r = ai * 128 + wr * 64 + m * 16 + fr; if (r >= u.rows) continue;
                const f32x4 u0 = acc[ai][0][m][0], u1 = acc[ai][0][m][1], v0 = acc[ai][1][m][0], v1 = acc[ai][1][m][1];
                u32x4 w; w.x = gm::cvt_pk_bf16(siluf_(u0[0]) * v0[0], siluf_(u0[1]) * v0[1]); w.y = gm::cvt_pk_bf16(siluf_(u0[2]) * v0[2], siluf_(u0[3]) * v0[3]);
                w.z = gm::cvt_pk_bf16(siluf_(u1[0]) * v1[0], siluf_(u1[1]) * v1[1]); w.w = gm::cvt_pk_bf16(siluf_(u1[2]) * v1[2], siluf_(u1[3]) * v1[3]);
                *(u32x4*)(base + (size_t)(ai * 128 + m * 16) * DEXP) = w; }
    }
};
struct SchedMoe2 {
    int G, c; const int* cntv; const char* HH; const char* W2T; char* Y;
    __device__ __forceinline__ bool next(int i, gm::Unit& u) const {
        const int L = i * G + c; const int T = L >> 2, pn = L & 3; int acc_t = 0, acc_o = 0;
        for (int q = 0; q < NEXP; ++q) { const int cq = cntv[64 * q]; const int nt = (cq + 255) >> 8;
            if (T < acc_t + nt) { const int rt = T - acc_t; int rows = cq - rt * 256; if (rows > 256) rows = 256;
                u.A = HH + (size_t)(acc_o + rt * 256) * DEXP * 2; u.B0 = W2T + ((size_t)q * DM + pn * 256) * (DEXP * 2); u.B1 = u.B0 + (size_t)128 * (DEXP * 2);
                u.dst = Y + (size_t)pn * 256 * 2; u.pm = rt; u.pn = pn; u.e = q; u.rows = rows; return true; }
            acc_t += nt; acc_o += cq; }
        return false;
    }
    __device__ __forceinline__ unsigned arow(const gm::Unit&, int r) const { return (unsigned)r; }
};
struct EpiMoe2 {
    static constexpr bool PERM = true;
    const int* list;
    __device__ __forceinline__ void operator()(const f32x4 (&acc)[2][2][4][2], const gm::Unit& u, int wr, int wc, int fr, int fq) const {
        const int* lp = list + (size_t)u.e * CAP + u.pm * 256;
#pragma unroll
        for (int ai = 0; ai < 2; ++ai)
#pragma unroll
            for (int m = 0; m < 4; ++m) { const int r = ai * 128 + wr * 64 + m * 16 + fr; if (r >= u.rows) continue;
                const int slot = lp[r]; bf16* rowp = (bf16*)u.dst + (size_t)slot * DM + wc * 32 + 8 * fq;
#pragma unroll
                for (int bj = 0; bj < 2; ++bj) { const f32x4 v0 = acc[ai][bj][m][0], v1 = acc[ai][bj][m][1];
                    u32x4 w; w.x = gm::cvt_pk_bf16(v0[0], v0[1]); w.y = gm::cvt_pk_bf16(v0[2], v0[3]); w.z = gm::cvt_pk_bf16(v1[0], v1[1]); w.w = gm::cvt_pk_bf16(v1[2], v1[3]);
                    *(u32x4*)(rowp + bj * 128) = w; } }
    }
};

__device__ __forceinline__ void p_final(Frame& F, const Args& a) {
    const float* mod = (const float*)(F.ws + WS_MOD); const float* fg = a.in[IN_FG]; const float* wt = (const float*)(F.ws + WS_WT);
    const bf16* Y = (const bf16*)(F.ws + WS_Y); float* X1 = F.out;
    for (int r = F.wave; r < 64; r += NWAVES) {
        const int tok = F.bid * 64 + r; const int b = tok >> 11;
        const float w0 = wt[tok * 2], w1 = wt[tok * 2 + 1];
        f32x4* xr = (f32x4*)(X1 + (size_t)tok * DM) + F.lane;
        const u32x2* y0 = (const u32x2*)(Y + (size_t)(tok * 2) * DM) + F.lane; const u32x2* y1 = (const u32x2*)(Y + (size_t)(tok * 2 + 1) * DM) + F.lane;
        f32x4 v[4]; float s = 0.f;
#pragma unroll
        for (int j = 0; j < 4; ++j) { const int k = 4 * F.lane + 256 * j;
            const f32x4 xv = xr[64 * j]; const u32x2 a0 = y0[64 * j], a1 = y1[64 * j]; const f32x4 g5 = *(const f32x4*)(mod + b * 6144 + 5 * DM + k);
            v[j].x = xv.x + g5.x * (w0 * bflo(a0.x) + w1 * bflo(a1.x)); v[j].y = xv.y + g5.y * (w0 * bfhi(a0.x) + w1 * bfhi(a1.x));
            v[j].z = xv.z + g5.z * (w0 * bflo(a0.y) + w1 * bflo(a1.y)); v[j].w = xv.w + g5.w * (w0 * bfhi(a0.y) + w1 * bfhi(a1.y));
            s += (v[j].x * v[j].x + v[j].y * v[j].y) + (v[j].z * v[j].z + v[j].w * v[j].w); }
        const float rstd = rsqrtf(wave_sum(s) * (1.f / DM) + EPS);
#pragma unroll
        for (int j = 0; j < 4; ++j) { const int k = 4 * F.lane + 256 * j; const f32x4 g = *(const f32x4*)(fg + k);
            xr[64 * j] = (f32x4){v[j].x * rstd * g.x, v[j].y * rstd * g.y, v[j].z * rstd * g.z, v[j].w * rstd * g.w}; }
    }
}
#ifndef LRU_FAST
#define LRU_FAST 1
#endif
#ifndef HG_FAST
#define HG_FAST 1
#endif
#define MIX_FAST (LRU_FAST && HG_FAST)
__device__ __forceinline__ void p_mix1(Frame& F, const Args& a) {
#if LRU_FAST
    for (int u = F.bid; u < NB * 8 * LRU_NCH; u += F.G) lru_pass1(F, a, u);
#endif
#if HG_FAST
    for (int i = 0, u = F.bid; u < NB * 8 * 2 * 4; u += F.G, ++i) hg_pass1(F, a, (u & ~3) | ((u + 2 * i) & 3));
#endif
}
__device__ __forceinline__ void p_mix2(Frame& F, const Args& a) {
#if LRU_FAST
    for (int u = F.bid; u < NB * 8 * LRU_NCH; u += F.G) lru_pass2(F, a, u);
#endif
#if HG_FAST
    for (int u = F.bid; u < NB * 8 * 2 * 4; u += F.G) hg_pass2(F, a, u);
#endif
}
__global__ void __launch_bounds__(NTHR, 2) mega(Args args) {
    extern __shared__ __attribute__((aligned(16))) unsigned char lds_raw[];
    Frame F;
    F.lds = (LAS unsigned char*)lds_raw; F.MISC = (volatile LAS unsigned*)(F.lds + LDSCTL_OFF);
    F.tid = threadIdx.x; F.lane = F.tid & 63; F.wave = __builtin_amdgcn_readfirstlane(F.tid >> 6);
    F.G = gridDim.x; F.bid = blockIdx.x; F.ws = args.ws; F.out = args.out; F.ctl = (unsigned*)(args.ws + WS_CTL);
    for (int u = F.tid; u < (LDS_BYTES - LDSCTL_OFF) / 4; u += NTHR) ((LAS unsigned*)(F.lds + LDSCTL_OFF))[u] = 0u;
    __syncthreads();
    XcdBarrier bar = xcd_barrier_post(F.ctl + CW_BAR + args.li * 3584, F.MISC + 8);
    const int lo = args.ph_lo, hi = args.ph_hi;
#define IN(k) (lo <= (k) && (k) < hi)
#ifdef PROBE_A
#define STAMP(k) do { if (F.bid == 0 && F.tid == 0) { const unsigned long long _t = __builtin_amdgcn_s_memrealtime(); F.MISC[32 + 2 * (k)] = (unsigned)_t; F.MISC[33 + 2 * (k)] = (unsigned)(_t >> 32); } } while (0)
#else
#define STAMP(k) do { } while (0)
#endif
#define SEAM(k) do { if (IN(k) && IN((k) + 1)) xcd_barrier(bar); STAMP((k) + 1); } while (0)
    unsigned char* ws = F.ws;
    STAMP(0);
    if (IN(0)) { p0_prologue(F, args); } SEAM(0);
    if (IN(1)) { p1_norm(F, args); } SEAM(1);
    if (IN(2)) {
        SchedP2 S{F.G, F.bid, (const char*)F.out, (const char*)(ws + WS_WIN), (char*)(ws + WS_P), (char*)(ws + WS_PC)};
        EpiStoreBf16 E;
        gm::gemm_phase<SchedP2, EpiStoreBf16, false>(F.lds, DM, S, E);
    } SEAM(2);
    if (IN(3)) { p_mix1(F, args); } SEAM(3);
    if (IN(4)) { p_mix2(F, args); } SEAM(4);
    if (IN(5)) { p_ybg(F, args); p_moe_weights(F, args);
#if defined(REP_MOEW)
        __syncthreads(); p_moe_weights(F, args);
#endif
    } SEAM(5);
    if (IN(6)) {
        SchedP5 S{F.bid, (const char*)(ws + WS_YAG), (const char*)(ws + WS_YBG), (const char*)(ws + WS_WPA), (const char*)(ws + WS_WPB), nullptr, (char*)(ws + WS_M)};
        EpiP5 E{F.out + (size_t)F.bid * 65536, (const bf16*)(ws + WS_P + 7 * GS), (const bf16*)(ws + WS_P + 8 * GS)};
        gm::gemm_phase<SchedP5, EpiP5, false>(F.lds, DM, S, E);
    } SEAM(6);
    if (IN(7)) {
        SchedP6 S{F.bid, (const char*)(ws + WS_M), (const char*)(ws + WS_WOUT), (char*)F.out};
        EpiP6 E{args.in[IN_X], (const float*)(ws + WS_MOD)};
        gm::gemm_phase<SchedP6, EpiP6, false>(F.lds, DM, S, E);
    } SEAM(7);
    if (IN(8)) { p_norm2_route(F, args); } SEAM(8);
    if (IN(9)) {
        SchedMoe1 S{F.G, F.bid, (const int*)(F.ctl + CW_CNT), (const int*)(ws + WS_LIST), (const char*)(ws + WS_HX2), (const char*)(ws + WS_W1T), (const char*)(ws + WS_W3T), (char*)(ws + WS_HH)};
        EpiMoe1 E;
        gm::gemm_phase<SchedMoe1, EpiMoe1, true>(F.lds, DM, S, E);
    } SEAM(9);
    if (IN(10)) {
        SchedMoe2 S{F.G, F.bid, (const int*)(F.ctl + CW_CNT), (const char*)(ws + WS_HH), (const char*)(ws + WS_W2T), (char*)(ws + WS_Y)};
        EpiMoe2 E{(const int*)(ws + WS_LIST)};
        gm::gemm_phase<SchedMoe2, EpiMoe2, false>(F.lds, DEXP, S, E);
    } SEAM(10);
    if (IN(11)) { p_final(F, args); }
#ifdef PROBE_A
    if (F.bid == 0 && F.tid == 0) {
        const unsigned long long tend = __builtin_amdgcn_s_memrealtime();
        F.MISC[32 + 2 * 12] = (unsigned)tend; F.MISC[33 + 2 * 12] = (unsigned)(tend >> 32);
        auto T = [&](int k) { const unsigned long long t0 = ((unsigned long long)F.MISC[33 + 2 * k] << 32) | F.MISC[32 + 2 * k], t1 = ((unsigned long long)F.MISC[33 + 2 * (k + 1)] << 32) | F.MISC[32 + 2 * (k + 1)]; return (unsigned long long)((t1 - t0 + 400) / 800); };
        const unsigned long long delay = (T(PROBE_A) + 64ull * T(PROBE_B)) * 6400ull;
        while (__builtin_amdgcn_s_memrealtime() - tend < delay) __builtin_amdgcn_s_sleep(32);
    }
#endif
#undef IN
#undef SEAM
}

#if !LRU_FAST
__global__ void k_conv_f(const bf16* P0, const bf16* PC0, const float* cw, const float* cb, float* Ub, int b) {
    int t = blockIdx.x; int Lseg = t < CTX ? CTX : SEQ; int lt = t < CTX ? t : t - CTX;
    const bf16* base = t < CTX ? PC0 + (size_t)b * CTX * DM : P0 + (size_t)b * SEQ * DM;
    for (int ch = threadIdx.x; ch < DM; ch += 256) {
        float s = cb[ch];
#pragma unroll
        for (int k = 0; k < 4; ++k) { int tt = lt + k - 2; if (tt >= 0 && tt < Lseg) s += cw[k * DM + ch] * bf2f(base[(size_t)tt * DM + ch]); }
        Ub[(size_t)t * DM + ch] = s;
    }
}
__global__ void k_gates(const float* Ub, const float* wa, const float* ba, const float* wx, const float* bx, const float* lam, float* Aout, float* Bout, int d) {
    __shared__ float us[128];
    int t = blockIdx.x, h = blockIdx.y, j = threadIdx.x; int ch = h * 128 + j;
    float uval = Ub[(size_t)t * DM + ch];
    us[j] = uval; __syncthreads();
    const float* wah = wa + ((size_t)(d * 8 + h) * 128) * 128; const float* wxh = wx + ((size_t)(d * 8 + h) * 128) * 128;
    float ra = 0.f, ia = 0.f;
    for (int i = 0; i < 128; ++i) { float u = us[i]; ra += u * wah[i * 128 + j]; ia += u * wxh[i * 128 + j]; }
    float r = 1.f / (1.f + expf(-(ra + ba[d * DM + ch]))); float ig = 1.f / (1.f + expf(-(ia + bx[d * DM + ch])));
    float sp = log1pf(expf(-lam[d * DM + ch]));
    float log_a = -8.f * r * sp;
    Aout[(size_t)t * DM + ch] = expf(log_a); Bout[(size_t)t * DM + ch] = sqrtf(-expm1f(2.f * log_a)) * (ig * uval);
}
__global__ void k_lru_scan(const float* A0, const float* B0, const float* A1, const float* B1, float* YF, float* YB) {
    int g = blockIdx.x * 256 + threadIdx.x; int d = g / DM, ch = g % DM;
    if (d == 0) { float h = B0[ch];
        for (int t = 0; t < SEQ; ++t) { size_t o = (size_t)(CTX + t) * DM + ch; h = A0[o] * h + B0[o]; YF[(size_t)t * DM + ch] = h; }
    } else { float h = B1[(size_t)(CTX - 1) * DM + ch];
        for (int t = SEQ - 1; t >= 0; --t) { size_t o = (size_t)(CTX + t) * DM + ch; h = A1[o] * h + B1[o]; YB[(size_t)t * DM + ch] = h; }
    }
}
__global__ void k_yag_f(const float* YF, const float* YB, bf16* AY, int b) {
    int t = blockIdx.x;
    for (int ch = threadIdx.x; ch < DM; ch += 256) { size_t o = (size_t)t * DM + ch; bf16* p = AY + ((size_t)b * SEQ + t) * DM + ch;
        *p = (bf16)f2bf((YF[o] + YB[o]) * gelu_tanh(bf2f(*p))); }
}
#endif
#if !HG_FAST
__global__ __launch_bounds__(128) void k_hgrn_f(unsigned char* ws, const float* hg_lb) {
    __shared__ float gs[128], ks[128], qs[128];
    int h = blockIdx.x, d = blockIdx.y, b = blockIdx.z, j = threadIdx.x;
    float S[128];
#pragma unroll
    for (int i = 0; i < 128; ++i) S[i] = 0.f;
    const int c = h * 128 + j;
    const float lbj = 1.f / (1.f + expf(hg_lb[DM + c] - hg_lb[c]));
    bf16* Q = (bf16*)(ws + WS_P + 2 * GS); bf16* Fx = (bf16*)(ws + WS_P + (d == 0 ? 3 : 4) * GS); bf16* V = (bf16*)(ws + WS_P + 5 * GS);
    const bf16* Fc = (const bf16*)(ws + WS_PC + (d == 0 ? 1 : 2) * CGS); const bf16* Vc = (const bf16*)(ws + WS_PC + 3 * CGS);
    for (int s = 0; s < LT; ++s) {
        bool isx = s >= CTX; float fv, vv, qv = 0.f; size_t o;
        if (!isx) { int t = d == 0 ? s : (CTX - 1 - s); o = ((size_t)b * CTX + t) * DM + c; fv = bf2f(Fc[o]); vv = bf2f(Vc[o]); }
        else { int p = s - CTX; if (d == 1) p = SEQ - 1 - p; int tok = (p % 32) * 64 + (p / 32); o = ((size_t)b * SEQ + tok) * DM + c; fv = bf2f(Fx[o]); vv = bf2f(V[o]); qv = bf2f(Q[o]); }
        float gg = lbj + (1.f - lbj) / (1.f + expf(-fv));
        gs[j] = gg; ks[j] = 1.f - gg; qs[j] = qv / (1.f + expf(-qv));
        __syncthreads();
        float oo = 0.f;
#pragma unroll
        for (int i = 0; i < 128; ++i) { S[i] = gs[i] * S[i] + ks[i] * vv; oo += S[i] * qs[i]; }
        if (isx) Fx[o] = (bf16)f2bf(oo);
        __syncthreads();
    }
}
#endif

extern "C" void kernel_launch(void* const* d_in, const int* in_sizes, int n_in, void* d_out, int out_size, void* d_ws, size_t ws_size, hipStream_t stream) {
    static int grid = 0;
    if (grid == 0) {
        if (n_in != 29 || out_size != NTOK * DM || ws_size < WS_END) { fprintf(stderr, "kernel_launch: unexpected problem shape / workspace (%d inputs, out %d, ws %zu)\n", n_in, out_size, ws_size); grid = -1; return; }
        int dev = 0, cus = 0, per_cu = 0;
        if (hipGetDevice(&dev) != hipSuccess || hipDeviceGetAttribute(&cus, hipDeviceAttributeMultiprocessorCount, dev) != hipSuccess) { grid = -1; return; }
        if (hipFuncSetAttribute((const void*)mega, hipFuncAttributeMaxDynamicSharedMemorySize, LDS_BYTES) != hipSuccess) { grid = -1; return; }
        if (hipOccupancyMaxActiveBlocksPerMultiprocessor(&per_cu, (const void*)mega, NTHR, LDS_BYTES) != hipSuccess || per_cu < 1) { fprintf(stderr, "kernel_launch: occupancy query says %d blocks per CU\n", per_cu); }
        (void)hipGetLastError();
        grid = cus;
        if (grid != 256) { fprintf(stderr, "kernel_launch: built for 256 CUs, found %d\n", cus); grid = -1; return; }
    }
    if (grid < 0) return;
    hipMemsetAsync((char*)d_ws + WS_CTL, 0, CTL_BYTES, stream);
    Args a{};
    for (int i = 0; i < 29; ++i) a.in[i] = (const float*)d_in[i];
    a.out = (float*)d_out; a.ws = (unsigned char*)d_ws;
#if MIX_FAST
    a.ph_lo = 0; a.ph_hi = 12; a.li = 0;
    hipLaunchKernelGGL(mega, dim3(grid), dim3(NTHR), LDS_BYTES, stream, a);
#else
    a.ph_lo = 0; a.ph_hi = 5; a.li = 0;
    hipLaunchKernelGGL(mega, dim3(grid), dim3(NTHR), LDS_BYTES, stream, a);
    {
        unsigned char* ws = (unsigned char*)d_ws;
#if !LRU_FAST
        float* sc = (float*)d_out;
        float* Ub = sc; float* A0 = Ub + (size_t)LT * DM; float* B0 = A0 + (size_t)LT * DM; float* A1 = B0 + (size_t)LT * DM; float* B1 = A1 + (size_t)LT * DM;
        float* YF = B1 + (size_t)LT * DM; float* YB = YF + (size_t)SEQ * DM;
        const float* cw = (const float*)d_in[IN_CONVW]; const float* cb = (const float*)d_in[IN_CONVB];
        const float* wa = (const float*)d_in[IN_WA]; const float* ba = (const float*)d_in[IN_BA]; const float* wx = (const float*)d_in[IN_WX]; const float* bx = (const float*)d_in[IN_BX]; const float* lam = (const float*)d_in[IN_LAM];
        for (int b = 0; b < NB; ++b) {
            k_conv_f<<<LT, 256, 0, stream>>>((const bf16*)(ws + WS_P), (const bf16*)(ws + WS_PC), cw, cb, Ub, b);
            k_gates<<<dim3(LT, 8), 128, 0, stream>>>(Ub, wa, ba, wx, bx, lam, A0, B0, 0);
            k_gates<<<dim3(LT, 8), 128, 0, stream>>>(Ub, wa, ba, wx, bx, lam, A1, B1, 1);
            k_lru_scan<<<8, 256, 0, stream>>>(A0, B0, A1, B1, YF, YB);
            k_yag_f<<<SEQ, 256, 0, stream>>>(YF, YB, (bf16*)(ws + WS_YAG), b);
        }
#endif
#if !HG_FAST
        k_hgrn_f<<<dim3(8, 2, NB), 128, 0, stream>>>(ws, (const float*)d_in[IN_HGLB]);
#endif
    }
    a.ph_lo = 5; a.ph_hi = 12; a.li = 1;
    hipLaunchKernelGGL(mega, dim3(grid), dim3(NTHR), LDS_BYTES, stream, a);
#endif
}
```

```cpp
#include <hip/hip_runtime.h>
#include <cstdio>
#include <cstdint>
#include <math.h>

#define LAS __attribute__((address_space(3)))
#define GAS __attribute__((address_space(1)))
typedef unsigned short bf16;
typedef short bf16x8 __attribute__((ext_vector_type(8)));
typedef float f32x4 __attribute__((ext_vector_type(4)));
typedef float f32x2 __attribute__((ext_vector_type(2)));
typedef unsigned u32x4 __attribute__((ext_vector_type(4)));
typedef unsigned u32x2 __attribute__((ext_vector_type(2)));

constexpr int DM = 1024, NB = 8, SEQ = 2048, CTX = 256, NTOK = NB * SEQ, NCTX = NB * CTX, INW = 9216, LT = CTX + SEQ;
constexpr int NEXP = 32, DEXP = 512, CAP = 16384;
constexpr float EPS = 1e-6f;
constexpr int NWAVES = 8, NTHR = 512;

constexpr size_t MiB = 1u << 20, KiB = 1024;
constexpr size_t WS_CTL = 0, CTL_BYTES = 64 * KiB;
constexpr size_t WS_MODP = 256 * KiB;
constexpr size_t WS_MOD = 2 * MiB;
constexpr size_t WS_LRUAGG = 2 * MiB + 512 * KiB;
constexpr size_t WS_LRUS0 = 4 * MiB + 512 * KiB;
constexpr size_t WS_WT = 4 * MiB + 768 * KiB;
constexpr size_t WS_LIST = 5 * MiB;
constexpr size_t WS_HGD = 7 * MiB;
constexpr size_t WS_WRT = 7 * MiB + 256 * KiB;
constexpr size_t WS_WIN = 8 * MiB;
constexpr size_t WS_WPA = 26 * MiB, WS_WPB = 28 * MiB, WS_WOUT = 30 * MiB;
constexpr size_t WS_WLRU = 32 * MiB;
constexpr size_t WS_P = 33 * MiB, GS = 32 * MiB;
constexpr size_t WS_PC = 321 * MiB, CGS = 4 * MiB;
constexpr size_t WS_END = 337 * MiB;
constexpr size_t WS_W1T = WS_P + 0 * GS, WS_W3T = WS_P + 2 * GS, WS_W2T = WS_P + 5 * GS;
constexpr size_t WS_YAG = WS_P + 1 * GS;
constexpr size_t WS_OF = WS_P + 3 * GS, WS_OB = WS_P + 4 * GS;
constexpr size_t WS_YBG = WS_P + 3 * GS;
constexpr size_t WS_M = WS_P + 4 * GS;
constexpr size_t WS_HX2 = WS_P + 1 * GS;
constexpr size_t WS_HH = WS_P + 3 * GS;
constexpr size_t WS_Y = WS_P + 6 * GS;

constexpr int CW_BAR = 1024;
constexpr int CW_CNT = 12288;

constexpr int RING_BYTES = 131072, LDS_BYTES = 147456, LDSCTL_OFF = LDS_BYTES - 1024;

#define LDS_WAIT() asm volatile("s_waitcnt lgkmcnt(0)" ::: "memory")
#define VM_WAIT() asm volatile("s_waitcnt vmcnt(0)" ::: "memory")

typedef __bf16 bf16x2_t __attribute__((ext_vector_type(2)));
__device__ __forceinline__ unsigned pk2(float lo, float hi) { const f32x2 v = {lo, hi}; return __builtin_bit_cast(unsigned, __builtin_convertvector(v, bf16x2_t)); }
__device__ __forceinline__ unsigned f2bf(float f) { return pk2(f, 0.f) & 0xffffu; }
__device__ __forceinline__ float bf2f(unsigned short b) { return __builtin_bit_cast(float, (unsigned)b << 16); }
__device__ __forceinline__ float bflo(unsigned w) { return __builtin_bit_cast(float, w << 16); }
__device__ __forceinline__ float bfhi(unsigned w) { return __builtin_bit_cast(float, w & 0xffff0000u); }
__device__ __forceinline__ float sigmoidf_(float x) { return 1.f / (1.f + __expf(-x)); }
__device__ __forceinline__ float siluf_(float x) { return x / (1.f + __expf(-x)); }
__device__ __forceinline__ float gelu_tanh(float x) { float u = 0.7978845608028654f * (x + 0.044715f * x * x * x); float e = __expf(2.f * u); return x * (1.f - 1.f / (1.f + e)); }
__device__ __forceinline__ float wave_sum(float v) {
#pragma unroll
    for (int o = 1; o < 64; o <<= 1) v += __shfl_xor(v, o);
    return v;
}

#define XB_TMO      128
#define XB_XCNT(j)  (256  + 64 * (j))
#define XB_XSUB(j)  (1280 + 64 * (j))
#define XB_XGEN(j)  (2304 + 64 * (j))
#define XB_TOP      3328
#define XB_TOPGEN   3392
#define XCD_BAR_WORDS 3456
#define XB_SPIN_CAP (1u << 20)
__device__ __forceinline__ unsigned xb_ld(unsigned* p)              { return __hip_atomic_load(p, __ATOMIC_RELAXED, __HIP_MEMORY_SCOPE_AGENT); }
__device__ __forceinline__ unsigned xb_add(unsigned* p, unsigned v) { return __hip_atomic_fetch_add(p, v, __ATOMIC_RELAXED, __HIP_MEMORY_SCOPE_AGENT); }
__device__ __forceinline__ unsigned xb_xcc_id() { return (unsigned)__builtin_amdgcn_s_getreg((3 << 11) | 20) & 0xFu; }
#define XB_SPIN(cond, bar) do { unsigned _sp = 0; while (cond) { __builtin_amdgcn_s_sleep(1); \
    if ((++_sp & 255u) == 0u) { if (xb_ld(&(bar)[XB_TMO])) break; if (_sp > XB_SPIN_CAP) { atomicAdd(&(bar)[XB_TMO], 1u); break; } } } } while (0)
struct XcdBarrier { unsigned* bar; unsigned x; volatile LAS unsigned* st; };
__device__ __forceinline__ XcdBarrier xcd_barrier_post(unsigned* bar, volatile LAS unsigned* st) {
    XcdBarrier b; b.bar = bar; b.x = xb_xcc_id(); b.st = st;
    if (threadIdx.x == 0) (void)xb_add(&bar[XB_XCNT(b.x)], 1u);
    return b;
}
__device__ __forceinline__ void xcd_barrier_complete(unsigned* bar, unsigned x, unsigned& nloc, unsigned& nx) {
    const unsigned G = gridDim.x * gridDim.y * gridDim.z;
    unsigned sum, cnt, mine, sp = 0u;
    for (;;) {
        sum = 0u; cnt = 0u; mine = 0u;
#pragma unroll
        for (unsigned j = 0; j < 16; ++j) { const unsigned c = xb_ld(&bar[XB_XCNT(j)]); sum += c; cnt += (c > 0u) ? 1u : 0u; mine = (j == x) ? c : mine; }
        if (sum == G) break;
        __builtin_amdgcn_s_sleep(1);
        if ((++sp & 255u) == 0u) { if (xb_ld(&bar[XB_TMO])) break; if (sp > XB_SPIN_CAP) { atomicAdd(&bar[XB_TMO], 1u); break; } }
    }
    nloc = mine > 0u ? mine : 1u; nx = cnt > 0u ? cnt : 1u;
}
__device__ __forceinline__ void xcd_barrier(const XcdBarrier& b) {
    asm volatile("s_waitcnt vmcnt(0)" ::: "memory");
    __syncthreads();
    if (threadIdx.x == 0) {
        unsigned* bar = b.bar;
        __builtin_amdgcn_s_waitcnt(0);
        unsigned nloc = b.st[0], nx = b.st[1];
        if (nloc == 0u) { xcd_barrier_complete(bar, b.x, nloc, nx); b.st[0] = nloc; b.st[1] = nx; }
        const unsigned old = xb_add(&bar[XB_XSUB(b.x)], 1u);
        const unsigned gen = old / nloc;
        if (old + 1u == (gen + 1u) * nloc) {
            __builtin_amdgcn_fence(__ATOMIC_RELEASE, "agent");
            asm volatile("s_waitcnt vmcnt(0)" ::: "memory");
            const unsigned og = xb_add(&bar[XB_TOP], 1u);
            const unsigned tg = og / nx;
            if (og + 1u == (tg + 1u) * nx) xb_add(&bar[XB_TOPGEN], 1u);
            else XB_SPIN(xb_ld(&bar[XB_TOPGEN]) == tg, bar);
            __builtin_amdgcn_fence(__ATOMIC_ACQUIRE, "agent");
            xb_add(&bar[XB_XGEN(b.x)], 1u);
            asm volatile("s_waitcnt vmcnt(0)" ::: "memory");
        } else {
            XB_SPIN(xb_ld(&bar[XB_XGEN(b.x)]) == gen, bar);
            __builtin_amdgcn_fence(__ATOMIC_ACQUIRE, "agent");
            asm volatile("s_waitcnt vmcnt(0)" ::: "memory");
        }
    }
    __syncthreads();
}

namespace gm {
constexpr int BM = 256, BK = 64, HALF = 128, HTB = HALF * BK * 2;
__device__ __forceinline__ int lds_byte(int r, int c) { const int st = (r >> 4) * 2 + (c >> 5), rr = r & 15, cc = c & 31, ob = rr * 64 + cc * 2; return st * 1024 + (ob ^ (((ob >> 9) & 1) << 5)); }
__device__ __forceinline__ void stage_rc(int b, int& R, int& C) { const int st = b / 1024, sb = b % 1024, swz = sb ^ (((sb >> 9) & 1) << 5); R = (st >> 1) * 16 + swz / 64; C = (st & 1) * 32 + (swz % 64) / 2; }
__device__ __forceinline__ int perm32(int rho) { const int n = rho >> 4, i = rho & 15; return 8 * (i >> 2) + 4 * n + (i & 3); }
__device__ __forceinline__ unsigned cvt_pk_bf16(float lo, float hi) { unsigned r; asm volatile("v_cvt_pk_bf16_f32 %0, %1, %2" : "=v"(r) : "v"(lo), "v"(hi)); return r; }

struct Unit { const char* A; const char* B0; const char* B1; char* dst; int pm, pn, e, rows; };

template <class Sched, class Epi, bool GATHER>
__device__ __forceinline__ void gemm_phase(LAS unsigned char* lds, const int K, const Sched& S, const Epi& E) {
    const int tid = threadIdx.x, wid = __builtin_amdgcn_readfirstlane(tid >> 6), lane = tid & 63, wr = wid >> 2, wc = wid & 3, fr = lane & 15, fq = lane >> 4;
    const int nt = K / BK;
    unsigned voffB[2]; int Rr[2]; unsigned Cb[2];
#pragma unroll
    for (int i = 0; i < 2; ++i) { int R, C; stage_rc(tid * 16 + i * 8192, R, C); const int Rb = Epi::PERM ? ((R & ~31) + perm32(R & 31)) : R;
        Rr[i] = R; Cb[i] = (unsigned)C * 2u; voffB[i] = (unsigned)(Rb * K + C) * 2u; }
    const unsigned rowb = (unsigned)K * 2u;
    const size_t kstep = (size_t)(BK * 2);
    const unsigned ldsw = (unsigned)wid * 1024u;
    const int aoff = lds_byte(wr * 64 + fr, fq * 8), boff = lds_byte(wc * 32 + fr, fq * 8);
#define GM_SA(b, h) (((b) * 2 + (h)) * HTB)
#define GM_SB(b, h) ((4 + (b) * 2 + (h)) * HTB)
#define GM_STAGE(bufoff, gbase, voff) do { _Pragma("unroll") for (int _i = 0; _i < 2; ++_i) \
        __builtin_amdgcn_global_load_lds((const unsigned*)((const char*)(gbase) + (voff)[_i]), (LAS unsigned*)(lds + (bufoff) + ldsw + _i * 8192), 16, 0, 0); } while (0)
#define GM_LDA(dst, b, h) do { _Pragma("unroll") for (int m = 0; m < 4; ++m) _Pragma("unroll") for (int k = 0; k < 2; ++k) dst[m][k] = *(const LAS bf16x8*)(lds + GM_SA(b, h) + aoff + m * 2048 + k * 1024); } while (0)
#define GM_LDB(dst, b, h) do { _Pragma("unroll") for (int n = 0; n < 2; ++n) _Pragma("unroll") for (int k = 0; k < 2; ++k) dst[n][k] = *(const LAS bf16x8*)(lds + GM_SB(b, h) + boff + n * 2048 + k * 1024); } while (0)
#define GM_MMA(ai, bj, At, Bt) do { __builtin_amdgcn_s_setprio(1); _Pragma("unroll") for (int m = 0; m < 4; ++m) _Pragma("unroll") for (int n = 0; n < 2; ++n) _Pragma("unroll") for (int k = 0; k < 2; ++k) \
        acc[ai][bj][m][n] = __builtin_amdgcn_mfma_f32_16x16x32_bf16(Bt[n][k], At[m][k], acc[ai][bj][m][n], 0, 0, 0); __builtin_amdgcn_s_setprio(0); } while (0)
#define GM_WAIT_V(n) asm volatile("s_waitcnt vmcnt(" #n ")" ::: "memory")
#define GM_WAIT_L(n) asm volatile("s_waitcnt lgkmcnt(" #n ")" ::: "memory")
#define GM_BAR __builtin_amdgcn_s_barrier()
#define GM_SCHED __builtin_amdgcn_sched_barrier(0)
#define GM_AOFFS(u, o) do { _Pragma("unroll") for (int _h = 0; _h < 2; ++_h) _Pragma("unroll") for (int _i = 0; _i < 2; ++_i) \
        (o)[_h][_i] = (GATHER ? S.arow((u), _h * HALF + Rr[_i]) : (unsigned)(_h * HALF + Rr[_i])) * rowb + Cb[_i]; } while (0)
    Unit cur, nxt; int ui = 0;
    if (!S.next(0, cur)) return;
    f32x4 acc[2][2][4][2];
#pragma unroll
    for (int a = 0; a < 2; ++a)
#pragma unroll
        for (int b = 0; b < 2; ++b)
#pragma unroll
            for (int m = 0; m < 4; ++m)
#pragma unroll
                for (int n = 0; n < 2; ++n) acc[a][b][m][n] = (f32x4){0.f, 0.f, 0.f, 0.f};
    bf16x8 At[4][2], B0[2][2], B1[2][2];
    unsigned ca[2][2], na[2][2];
    GM_AOFFS(cur, ca);
    const char* cA = cur.A; const char* cB0 = cur.B0; const char* cB1 = cur.B1;
    GM_STAGE(GM_SB(0, 0), cB0, voffB); GM_STAGE(GM_SB(0, 1), cB1, voffB); GM_STAGE(GM_SA(0, 0), cA, ca[0]); GM_STAGE(GM_SA(0, 1), cA, ca[1]);
    if (wr == 1) GM_BAR;
    GM_WAIT_V(2); GM_BAR;
    GM_STAGE(GM_SB(1, 0), cB0 + kstep, voffB); GM_STAGE(GM_SA(1, 0), cA + kstep, ca[0]); GM_STAGE(GM_SB(1, 1), cB1 + kstep, voffB);
    GM_WAIT_V(6); GM_BAR;
    for (;;) {
        const bool has_next = S.next(ui + 1, nxt);
        const char* nA = has_next ? nxt.A : cA; const char* nB0 = has_next ? nxt.B0 : cB0; const char* nB1 = has_next ? nxt.B1 : cB1;
        if (has_next) { GM_AOFFS(nxt, na); } else {
#pragma unroll
            for (int h = 0; h < 2; ++h)
#pragma unroll
                for (int i = 0; i < 2; ++i) na[h][i] = ca[h][i]; }
        for (int t = 0; t < nt; t += 2) {
            const bool last = (t == nt - 2);
            const char* a1 = cA + (size_t)(t + 1) * kstep;
            const char* a2 = last ? nA : cA + (size_t)(t + 2) * kstep;
            const char* b20 = last ? nB0 : cB0 + (size_t)(t + 2) * kstep; const char* b21 = last ? nB1 : cB1 + (size_t)(t + 2) * kstep;
            const char* a3 = a2 + kstep; const char* b30 = b20 + kstep; const char* b31 = b21 + kstep;
            unsigned o2[2][2];
#pragma unroll
            for (int h = 0; h < 2; ++h)
#pragma unroll
                for (int i = 0; i < 2; ++i) o2[h][i] = last ? na[h][i] : ca[h][i];
            GM_LDB(B0, 0, 0); GM_LDB(B1, 0, 1); GM_SCHED; GM_LDA(At, 0, 0); GM_STAGE(GM_SA(1, 1), a1, ca[1]);
            GM_WAIT_V(8); GM_WAIT_L(0); GM_BAR; GM_MMA(0, 0, At, B0); GM_MMA(0, 1, At, B1); GM_BAR; GM_SCHED;
            GM_LDA(At, 0, 1); GM_STAGE(GM_SB(0, 0), b20, voffB); GM_STAGE(GM_SB(0, 1), b21, voffB); GM_STAGE(GM_SA(0, 0), a2, o2[0]);
            GM_WAIT_V(8); GM_WAIT_L(0); GM_BAR; GM_MMA(1, 0, At, B0); GM_MMA(1, 1, At, B1); GM_BAR; GM_SCHED;
            GM_LDB(B0, 1, 0); GM_LDB(B1, 1, 1); GM_SCHED; GM_LDA(At, 1, 0); GM_STAGE(GM_SA(0, 1), a2, o2[1]);
            GM_WAIT_V(8); GM_WAIT_L(0); GM_BAR; GM_MMA(0, 0, At, B0); GM_MMA(0, 1, At, B1); GM_BAR; GM_SCHED;
            GM_LDA(At, 1, 1); GM_STAGE(GM_SB(1, 0), b30, voffB); GM_STAGE(GM_SB(1, 1), b31, voffB); GM_STAGE(GM_SA(1, 0), a3, o2[0]);
            GM_WAIT_V(8); GM_WAIT_L(0); GM_BAR; GM_MMA(1, 0, At, B0); GM_MMA(1, 1, At, B1); GM_BAR; GM_SCHED;
        }
        if (wr == 0) GM_BAR;
        E(acc, cur, wr, wc, fr, fq);
        if (!has_next) break;
#pragma unroll
        for (int a = 0; a < 2; ++a)
#pragma unroll
            for (int b = 0; b < 2; ++b)
#pragma unroll
                for (int m = 0; m < 4; ++m)
#pragma unroll
                    for (int n = 0; n < 2; ++n) acc[a][b][m][n] = (f32x4){0.f, 0.f, 0.f, 0.f};
        cur = nxt; cA = nA; cB0 = nB0; cB1 = nB1; ++ui;
#pragma unroll
        for (int h = 0; h < 2; ++h)
#pragma unroll
            for (int i = 0; i < 2; ++i) ca[h][i] = na[h][i];
        if (wr == 1) GM_BAR;
    }
    GM_WAIT_V(0);
    GM_BAR;
#undef GM_SA
#undef GM_SB
#undef GM_STAGE
#undef GM_LDA
#undef GM_LDB
#undef GM_MMA
#undef GM_WAIT_V
#undef GM_WAIT_L
#undef GM_BAR
#undef GM_SCHED
#undef GM_AOFFS
}
}
struct Args {
    const float* in[29]; float* out; unsigned char* ws; int ph_lo, ph_hi, li, pad;
};
struct Frame {
    LAS unsigned char* lds; volatile LAS unsigned* MISC;
    unsigned* ctl; unsigned char* ws; float* out;
    int tid, lane, wave, G, bid;
};
enum { IN_X = 0, IN_C, IN_CTX, IN_CCTX, IN_WMOD, IN_BMOD, IN_G1, IN_WIN, IN_CONVW, IN_CONVB, IN_WA, IN_BA, IN_WX, IN_BX, IN_LAM, IN_HGLB, IN_HGN,
       IN_WPA, IN_WPB, IN_WOUT, IN_G2, IN_WRG, IN_BRG, IN_WRE, IN_BRE, IN_W1, IN_W3, IN_W2, IN_FG };

constexpr int TR_BYTES = 64 * 64 * 4;
__device__ __forceinline__ void transpose_item(const float* W, int ldw, int K, bf16* WT, int k0, int n0, LAS float* scr, int lane) {
    const int lr = lane >> 4, ls = lane & 15;
    f32x4 v[16];
#pragma unroll
    for (int i = 0; i < 16; ++i) v[i] = *(const f32x4*)(W + (size_t)(k0 + 4 * i + lr) * ldw + n0 + 4 * ls);
#pragma unroll
    for (int i = 0; i < 16; ++i) { const int k = 4 * i + lr; *(LAS f32x4*)(scr + k * 64 + ((ls ^ ((k >> 3) & 7)) << 2)) = v[i]; }
    LDS_WAIT(); asm volatile("" ::: "memory");
    const int c = lane & 7;
#pragma unroll
    for (int j = 0; j < 8; ++j) { const int n = (lane >> 3) + 8 * j; const LAS float* s = scr + (8 * c) * 64 + ((((n >> 2) ^ c) << 2) | (n & 3));
        u32x4 o; o.x = pk2(s[0 * 64], s[1 * 64]); o.y = pk2(s[2 * 64], s[3 * 64]); o.z = pk2(s[4 * 64], s[5 * 64]); o.w = pk2(s[6 * 64], s[7 * 64]);
        *(u32x4*)(WT + (size_t)n * K + k0 + 8 * c) = o; }
    LDS_WAIT(); asm volatile("" ::: "memory");
}

__device__ __forceinline__ void p0_mod_item(Frame& F, const Args& a, int item) {
    const int cb = item % 24, ks = item / 24;
    LAS float* sv = (LAS float*)F.lds;
    LAS float* red = sv + 9 * 128;
    const float* c = a.in[IN_C]; const float* cc = a.in[IN_CCTX]; const float* wmod = a.in[IN_WMOD];
    for (int i = F.tid; i < 9 * 128; i += NTHR) { const int r = i >> 7, k = i & 127; const float v = r < 8 ? c[r * DM + ks * 128 + k] : cc[ks * 128 + k]; sv[i] = siluf_(v); }
    __syncthreads();
    const int col = cb * 256 + (F.tid & 255), kh = F.tid >> 8;
    float acc[9];
#pragma unroll
    for (int r = 0; r < 9; ++r) acc[r] = 0.f;
    for (int k = 0; k < 64; ++k) { const int kk = kh * 64 + k; const float w = wmod[(size_t)(ks * 128 + kk) * 6144 + col];
#pragma unroll
        for (int r = 0; r < 9; ++r) acc[r] += sv[r * 128 + kk] * w; }
    if (kh == 1) {
#pragma unroll
        for (int r = 0; r < 9; ++r) red[r * 256 + (F.tid & 255)] = acc[r]; }
    __syncthreads();
    float* modp = (float*)(F.ws + WS_MODP);
    if (kh == 0) {
#pragma unroll
        for (int r = 0; r < 9; ++r) modp[(size_t)(ks * 9 + r) * 6144 + col] = acc[r] + red[r * 256 + F.tid]; }
    __syncthreads();
}
__device__ __forceinline__ float mod_from_partials(const float* modp, const float* bmod, int row, int j) {
    float s = bmod[j];
#pragma unroll
    for (int ks = 0; ks < 8; ++ks) s += modp[(size_t)(ks * 9 + row) * 6144 + j];
    return s;
}

__device__ __forceinline__ void p0_prologue(Frame& F, const Args& a) {
    if (F.bid < 192) p0_mod_item(F, a, F.bid);
    LAS float* scr = (LAS float*)(F.lds + F.wave * TR_BYTES);
    const int gw = F.bid * NWAVES + F.wave, NGW = F.G * NWAVES;
    constexpr int I_IN = 16 * 144, I_PR = 16 * 16, I_LRU = 32 * 4;
    constexpr int NITEMS = I_IN + 3 * I_PR + I_LRU;
    for (int it = gw; it < NITEMS; it += NGW) {
        int r = it;
        if (r < I_IN) { const int kb = r / 144, nb = r % 144; transpose_item(a.in[IN_WIN], INW, DM, (bf16*)(F.ws + WS_WIN) + (size_t)(nb * 64) * DM, kb * 64, nb * 64, scr, F.lane); continue; } r -= I_IN;
        if (r < 3 * I_PR) { const int w = r / I_PR, q = r % I_PR, kb = q / 16, nb = q % 16;
            const float* W = a.in[w == 0 ? IN_WPA : (w == 1 ? IN_WPB : IN_WOUT)]; bf16* WT = (bf16*)(F.ws + (w == 0 ? WS_WPA : (w == 1 ? WS_WPB : WS_WOUT)));
            transpose_item(W, DM, DM, WT + (size_t)(nb * 64) * DM, kb * 64, nb * 64, scr, F.lane); continue; } r -= 3 * I_PR;
        { const int mat = r / 4, q = r % 4, kb = q / 2, nb = q % 2;
          const int which = mat >> 4, dh = mat & 15;
          const float* W = a.in[which == 0 ? IN_WA : IN_WX] + (size_t)dh * 128 * 128; bf16* WT = (bf16*)(F.ws + WS_WLRU) + (size_t)mat * 128 * 128;
          transpose_item(W, 128, 128, WT + (size_t)(nb * 64) * 128, kb * 64, nb * 64, scr, F.lane); }
    }
    float* wrp = (float*)(F.ws + WS_WRT);
    for (int i = F.bid * NTHR + F.tid; i < 49152 + 48; i += F.G * NTHR) {
        if (i < 49152) { const int j = i & 3, ln = (i >> 2) & 63, sc = i >> 8, c = sc % 3, s2 = sc / 3; const int k = 16 * s2 + 4 * (ln >> 4) + j, o = 16 * c + (ln & 15);
            wrp[i] = o < 4 ? a.in[IN_WRG][k * 4 + o] : (o < 36 ? a.in[IN_WRE][k * 32 + (o - 4)] : 0.f); }
        else { const int o = i - 49152; wrp[i] = o < 4 ? a.in[IN_BRG][o] : (o < 36 ? a.in[IN_BRE][o - 4] : 0.f); }
    }
}

__device__ __forceinline__ void norm_rows(Frame& F, const float* src, bf16* dst, int row0, int nrows, const LAS float* gs, const LAS float* sh) {
    for (int r = F.wave; r < nrows; r += NWAVES) {
        const f32x4* xr = (const f32x4*)(src + (size_t)(row0 + r) * DM) + F.lane;
        f32x4 v[4]; float s = 0.f;
#pragma unroll
        for (int j = 0; j < 4; ++j) { v[j] = xr[64 * j]; s += (v[j].x * v[j].x + v[j].y * v[j].y) + (v[j].z * v[j].z + v[j].w * v[j].w); }
        const float rstd = rsqrtf(wave_sum(s) * (1.f / DM) + EPS);
        unsigned long long* o8 = (unsigned long long*)(dst + (size_t)(row0 + r) * DM) + F.lane;
#pragma unroll
        for (int j = 0; j < 4; ++j) { const int k = 4 * F.lane + 256 * j;
            const f32x4 g = *(const LAS f32x4*)(gs + k), h = *(const LAS f32x4*)(sh + k);
            const float o0 = v[j].x * rstd * g.x + h.x, o1 = v[j].y * rstd * g.y + h.y, o2 = v[j].z * rstd * g.z + h.z, o3 = v[j].w * rstd * g.w + h.w;
            o8[64 * j] = (unsigned long long)pk2(o0, o1) | ((unsigned long long)pk2(o2, o3) << 32); }
    }
}
__device__ __forceinline__ void p1_norm(Frame& F, const Args& a) {
    const float* modp = (const float*)(F.ws + WS_MODP); const float* bmod = a.in[IN_BMOD]; const float* g1 = a.in[IN_G1];
    LAS float* gs = (LAS float*)F.lds; LAS float* sh = gs + DM;
    bf16* H = (bf16*)F.out;
    float* mod = (float*)(F.ws + WS_MOD);
    for (int i = F.bid * NTHR + F.tid; i < 9 * 6144; i += F.G * NTHR) mod[i] = mod_from_partials(modp, bmod, i / 6144, i % 6144);
    const int b = F.bid / 32;
    for (int k = F.tid; k < DM; k += NTHR) { gs[k] = g1[k] * (1.f + mod_from_partials(modp, bmod, b, DM + k)); sh[k] = mod_from_partials(modp, bmod, b, k); }
    __syncthreads();
    norm_rows(F, a.in[IN_X], H, F.bid * 64, 64, gs, sh);
    __syncthreads();
    for (int k = F.tid; k < DM; k += NTHR) { gs[k] = g1[k] * (1.f + mod_from_partials(modp, bmod, 8, DM + k)); sh[k] = mod_from_partials(modp, bmod, 8, k); }
    __syncthreads();
    norm_rows(F, a.in[IN_CTX], H + (size_t)NTOK * DM, F.bid * 8, 8, gs, sh);
    __syncthreads();
}

struct EpiStoreBf16 {
    static constexpr bool PERM = true;
    __device__ __forceinline__ void operator()(const f32x4 (&acc)[2][2][4][2], const gm::Unit& u, int wr, int wc, int fr, int fq) const {
        bf16* base = (bf16*)u.dst + (size_t)(wr * 64 + fr) * DM + wc * 32 + 8 * fq;
#pragma unroll
        for (int ai = 0; ai < 2; ++ai)
#pragma unroll
            for (int m = 0; m < 4; ++m) { bf16* rowp = base + (size_t)(ai * 128 + m * 16) * DM;
#pragma unroll
                for (int bj = 0; bj < 2; ++bj) { const f32x4 v0 = acc[ai][bj][m][0], v1 = acc[ai][bj][m][1];
                    u32x4 w; w.x = gm::cvt_pk_bf16(v0[0], v0[1]); w.y = gm::cvt_pk_bf16(v0[2], v0[3]); w.z = gm::cvt_pk_bf16(v1[0], v1[1]); w.w = gm::cvt_pk_bf16(v1[2], v1[3]);
                    *(u32x4*)(rowp + bj * 128) = w; } }
    }
};
__device__ __forceinline__ void tile_order(int L, int nM, int nN, int& pm, int& pn) {
    const int nwg = nM * nN; int wgid = L;
    { const int q = nwg / 8, r = nwg % 8, xcd = wgid % 8, off = wgid / 8; wgid = (xcd < r ? xcd * (q + 1) : r * (q + 1) + (xcd - r) * q) + off; }
    const int nig = 8 * nN, gid = wgid / nig, fm = gid * 8, gsz = (nM - fm) < 8 ? (nM - fm) : 8;
    pm = fm + ((wgid % nig) % gsz); pn = (wgid % nig) / gsz;
}
struct SchedP2 {
    int G, c; const char* H; const char* Wt; char* P; char* PC;
    __device__ __forceinline__ bool next(int i, gm::Unit& u) const {
        int L = i * G + c;
        if (L < 64 * 36) { int pm, pn; tile_order(L, 64, 36, pm, pn);
            u.A = H + (size_t)pm * 256 * 2048; u.B0 = Wt + (size_t)pn * 256 * 2048; u.B1 = u.B0 + (size_t)128 * 2048;
            u.dst = P + (size_t)(pn >> 2) * GS + ((size_t)pm * 256 * DM + (pn & 3) * 256) * 2; u.pm = pm; u.pn = pn; u.e = 0; u.rows = 256; return true; }
        L -= 64 * 36; if (L >= 128) return false;
        const int pmc = L >> 4, j = L & 15, slot = j >> 2, g = slot == 0 ? 0 : slot + 2, pn = g * 4 + (j & 3);
        u.A = H + (size_t)(NTOK + pmc * 256) * 2048; u.B0 = Wt + (size_t)pn * 256 * 2048; u.B1 = u.B0 + (size_t)128 * 2048;
        u.dst = PC + (size_t)slot * CGS + ((size_t)pmc * 256 * DM + (j & 3) * 256) * 2; u.pm = pmc; u.pn = pn; u.e = 0; u.rows = 256; return true;
    }
    __device__ __forceinline__ unsigned arow(const gm::Unit&, int r) const { return (unsigned)r; }
};
constexpr int LRU_T = 128, LRU_NCH = SEQ / LRU_T, UF_LD = 144;
constexpr int LRU_UBF = 0, LRU_UF = 144 * 256;
constexpr float LOG2E = 1.4426950408889634f;

struct LruCoef { float ba, bx, ca; };

__device__ __forceinline__ void lru_conv(Frame& F, const Args& a, int b, int h, int c, bool special) {
    const bf16* AX = (const bf16*)(F.ws + WS_P) + (size_t)b * SEQ * DM + h * 128;
    const float* cw = a.in[IN_CONVW] + h * 128; const float* cb = a.in[IN_CONVB] + h * 128;
    LAS unsigned char* ubf = F.lds + LRU_UBF; LAS float* uf = (LAS float*)(F.lds + LRU_UF);
    const int cg = F.tid & 15, tl0 = F.tid >> 4;
    u32x4 raw[4][4];
#pragma unroll
    for (int i = 0; i < 4; ++i)
#pragma unroll
        for (int k = 0; k < 4; ++k) { int tt = c * LRU_T + tl0 + 32 * i + k - 2; tt = tt < 0 ? 0 : (tt > SEQ - 1 ? SEQ - 1 : tt); raw[i][k] = *(const u32x4*)(AX + (size_t)tt * DM + 8 * cg); }
    float w[4][8], bs[8];
#pragma unroll
    for (int k = 0; k < 4; ++k) { const f32x4 w0 = *(const f32x4*)(cw + k * DM + 8 * cg), w1 = *(const f32x4*)(cw + k * DM + 8 * cg + 4);
        w[k][0] = w0.x; w[k][1] = w0.y; w[k][2] = w0.z; w[k][3] = w0.w; w[k][4] = w1.x; w[k][5] = w1.y; w[k][6] = w1.z; w[k][7] = w1.w; }
    { const f32x4 b0 = *(const f32x4*)(cb + 8 * cg), b1 = *(const f32x4*)(cb + 8 * cg + 4); bs[0] = b0.x; bs[1] = b0.y; bs[2] = b0.z; bs[3] = b0.w; bs[4] = b1.x; bs[5] = b1.y; bs[6] = b1.z; bs[7] = b1.w; }
#pragma unroll
    for (int i = 0; i < 4; ++i) { const int tl = tl0 + 32 * i;
        float u[8];
#pragma unroll
        for (int q = 0; q < 8; ++q) u[q] = bs[q];
#pragma unroll
        for (int k = 0; k < 4; ++k) { const int tt = c * LRU_T + tl + k - 2; const float mk = (tt >= 0 && tt < SEQ) ? 1.f : 0.f; const u32x4 v = raw[i][k];
            u[0] += mk * w[k][0] * bflo(v.x); u[1] += mk * w[k][1] * bfhi(v.x); u[2] += mk * w[k][2] * bflo(v.y); u[3] += mk * w[k][3] * bfhi(v.y);
            u[4] += mk * w[k][4] * bflo(v.z); u[5] += mk * w[k][5] * bfhi(v.z); u[6] += mk * w[k][6] * bflo(v.w); u[7] += mk * w[k][7] * bfhi(v.w); }
        *(LAS f32x4*)(uf + tl * UF_LD + 8 * cg) = (f32x4){u[0], u[1], u[2], u[3]};
        *(LAS f32x4*)(uf + tl * UF_LD + 8 * cg + 4) = (f32x4){u[4], u[5], u[6], u[7]};
        u32x4 p; p.x = pk2(u[0], u[1]); p.y = pk2(u[2], u[3]); p.z = pk2(u[4], u[5]); p.w = pk2(u[6], u[7]);
        *(LAS u32x4*)(ubf + tl * 256 + ((cg ^ (tl & 15)) << 4)) = p; }
    if (special) {
        const bf16* AC = (const bf16*)(F.ws + WS_PC) + (size_t)b * CTX * DM + h * 128;
        if (F.tid < 32) { const int tl = LRU_T + (F.tid >> 4); const int t = tl == LRU_T ? 0 : CTX - 1;
            float u[8];
#pragma unroll
            for (int q = 0; q < 8; ++q) u[q] = bs[q];
#pragma unroll
            for (int k = 0; k < 4; ++k) { const int tt = t + k - 2;
                if (tt >= 0 && tt < CTX) { const u32x4 v = *(const u32x4*)(AC + (size_t)tt * DM + 8 * cg);
                    u[0] += w[k][0] * bflo(v.x); u[1] += w[k][1] * bfhi(v.x); u[2] += w[k][2] * bflo(v.y); u[3] += w[k][3] * bfhi(v.y);
                    u[4] += w[k][4] * bflo(v.z); u[5] += w[k][5] * bfhi(v.z); u[6] += w[k][6] * bflo(v.w); u[7] += w[k][7] * bfhi(v.w); } }
            *(LAS f32x4*)(uf + tl * UF_LD + 8 * cg) = (f32x4){u[0], u[1], u[2], u[3]};
            *(LAS f32x4*)(uf + tl * UF_LD + 8 * cg + 4) = (f32x4){u[4], u[5], u[6], u[7]};
            u32x4 p; p.x = pk2(u[0], u[1]); p.y = pk2(u[2], u[3]); p.z = pk2(u[4], u[5]); p.w = pk2(u[6], u[7]);
            *(LAS u32x4*)(ubf + tl * 256 + ((cg ^ (tl & 15)) << 4)) = p;
        } else if (F.tid < 32 + 14 * 16) { const int tl = LRU_T + 2 + ((F.tid - 32) >> 4);
            *(LAS u32x4*)(ubf + tl * 256 + ((cg ^ (tl & 15)) << 4)) = (u32x4){0u, 0u, 0u, 0u}; }
    }
}
__device__ __forceinline__ void lru_load_w(Frame& F, int d, int h, bf16x8 (&Bw)[2][4]) {
    const int fr = F.lane & 15, fq = F.lane >> 4;
#pragma unroll
    for (int which = 0; which < 2; ++which) { const bf16* W = (const bf16*)(F.ws + WS_WLRU) + (size_t)(which * 16 + d * 8 + h) * 128 * 128 + (size_t)(16 * F.wave + fr) * 128 + 8 * fq;
#pragma unroll
        for (int kk = 0; kk < 4; ++kk) Bw[which][kk] = *(const bf16x8*)(W + kk * 32); }
}
__device__ __forceinline__ LruCoef lru_coef(const Args& a, int d, int ch) {
    LruCoef k; k.ba = -LOG2E * a.in[IN_BA][d * DM + ch]; k.bx = -LOG2E * a.in[IN_BX][d * DM + ch];
    const float sp = log1pf(expf(-a.in[IN_LAM][d * DM + ch])); k.ca = -8.f * sp * LOG2E; return k;
}
__device__ __forceinline__ void lru_tile(Frame& F, int m, const bf16x8 (&Bw)[2][4], const LruCoef& k, float (&av)[4], float (&bv)[4]) {
    const int fr = F.lane & 15, fq = F.lane >> 4;
    const LAS unsigned char* ubf = F.lds + LRU_UBF; const LAS float* uf = (const LAS float*)(F.lds + LRU_UF);
    f32x4 ar = {0.f, 0.f, 0.f, 0.f}, ai = {0.f, 0.f, 0.f, 0.f};
    const int row = m * 16 + fr;
#pragma unroll
    for (int kk = 0; kk < 4; ++kk) { const bf16x8 A = *(const LAS bf16x8*)(ubf + row * 256 + (((kk * 4 + fq) ^ fr) << 4));
        ar = __builtin_amdgcn_mfma_f32_16x16x32_bf16(A, Bw[0][kk], ar, 0, 0, 0); ai = __builtin_amdgcn_mfma_f32_16x16x32_bf16(A, Bw[1][kk], ai, 0, 0, 0); }
#pragma unroll
    for (int r = 0; r < 4; ++r) { const float u = uf[(m * 16 + 4 * fq + r) * UF_LD + 16 * F.wave + fr];
        const float rg = __builtin_amdgcn_rcpf(1.f + __builtin_amdgcn_exp2f(__builtin_fmaf(ar[r], -LOG2E, k.ba)));
        const float ig = __builtin_amdgcn_rcpf(1.f + __builtin_amdgcn_exp2f(__builtin_fmaf(ai[r], -LOG2E, k.bx)));
        const float aa = __builtin_amdgcn_exp2f(k.ca * rg);
        av[r] = aa; bv[r] = __builtin_amdgcn_sqrtf(__builtin_fmaf(-aa, aa, 1.f)) * (ig * u); }
}
template <bool FWD> __device__ __forceinline__ void lru_tile_total(int fq, float& A, float& B) {
#pragma unroll
    for (int s = 0; s < 2; ++s) { const int bit = 1 << s; const float Ap = __shfl_xor(A, 16 << s), Bp = __shfl_xor(B, 16 << s);
        const bool mine_first = FWD ? ((fq & bit) == 0) : ((fq & bit) != 0);
        if (mine_first) { B = B * Ap + Bp; A = A * Ap; } else { B = Bp * A + B; A = Ap * A; } }
}

__device__ __forceinline__ void lru_pass1(Frame& F, const Args& a, int unit) {
    const int c = unit & (LRU_NCH - 1), h = (unit >> 4) & 7, b = unit >> 7;
    const int fr = F.lane & 15, fq = F.lane >> 4; const int ch = h * 128 + 16 * F.wave + fr;
    bf16x8 Bw0[2][4], Bw1[2][4]; lru_load_w(F, 0, h, Bw0); lru_load_w(F, 1, h, Bw1);
    const LruCoef k0 = lru_coef(a, 0, ch), k1 = lru_coef(a, 1, ch);
    lru_conv(F, a, b, h, c, c == 0);
    LDS_WAIT(); __syncthreads();
    float Af = 1.f, Hf = 0.f, Ab = 1.f, Hb = 0.f;
#pragma unroll 2
    for (int m = 0; m < 8; ++m) {
        float av[4], bv[4];
        lru_tile(F, m, Bw0, k0, av, bv);
        float A = av[0] * av[1] * av[2] * av[3], B = ((bv[0] * av[1] + bv[1]) * av[2] + bv[2]) * av[3] + bv[3];
        lru_tile_total<true>(fq, A, B);
        Hf = Hf * A + B; Af = Af * A;
        lru_tile(F, m, Bw1, k1, av, bv);
        A = av[0] * av[1] * av[2] * av[3]; B = ((bv[3] * av[2] + bv[2]) * av[1] + bv[1]) * av[0] + bv[0];
        lru_tile_total<false>(fq, A, B);
        Hb = B * Ab + Hb; Ab = A * Ab;
    }
    float* agg = (float*)(F.ws + WS_LRUAGG);
    if (fq == 0) { *(f32x2*)(agg + ((size_t)((b * LRU_NCH + c) * 2 + 0) * DM + ch) * 2) = (f32x2){Af, Hf};
                   *(f32x2*)(agg + ((size_t)((b * LRU_NCH + c) * 2 + 1) * DM + ch) * 2) = (f32x2){Ab, Hb}; }
    if (c == 0) {
        float av[4], bv[4]; float* s0 = (float*)(F.ws + WS_LRUS0);
        lru_tile(F, 8, Bw0, k0, av, bv); if (fq == 0) s0[(b * 2 + 0) * DM + ch] = bv[0];
        lru_tile(F, 8, Bw1, k1, av, bv); if (fq == 0) s0[(b * 2 + 1) * DM + ch] = bv[1];
    }
    __syncthreads();
}

__device__ __forceinline__ void lru_pass2(Frame& F, const Args& a, int unit) {
    const int c = unit & (LRU_NCH - 1), h = (unit >> 4) & 7, b = unit >> 7;
    const int fr = F.lane & 15, fq = F.lane >> 4; const int ch = h * 128 + 16 * F.wave + fr;
    const float* agg = (const float*)(F.ws + WS_LRUAGG); const float* s0 = (const float*)(F.ws + WS_LRUS0);
    f32x2 ag[LRU_NCH];
#pragma unroll
    for (int j = 0; j < LRU_NCH; ++j) ag[j] = *(const f32x2*)(agg + ((size_t)((b * LRU_NCH + j) * 2 + (j < c ? 0 : 1)) * DM + ch) * 2);
    float hf = s0[(b * 2 + 0) * DM + ch], hb = s0[(b * 2 + 1) * DM + ch];
    bf16* AY = (bf16*)(F.ws + WS_YAG) + ((size_t)b * SEQ + c * LRU_T) * DM + h * 128;
    u32x4 ayv[4];
#pragma unroll
    for (int i = 0; i < 4; ++i) ayv[i] = *(const u32x4*)(AY + (size_t)((F.tid >> 4) + 32 * i) * DM + 8 * (F.tid & 15));
    bf16x8 Bw[2][4], Bw1[2][4]; lru_load_w(F, 0, h, Bw);
    LruCoef k = lru_coef(a, 0, ch); const LruCoef k1 = lru_coef(a, 1, ch);
    lru_conv(F, a, b, h, c, false);
    lru_load_w(F, 1, h, Bw1);
#pragma unroll
    for (int j = 0; j < LRU_NCH; ++j) if (j < c) hf = ag[j].x * hf + ag[j].y;
#pragma unroll
    for (int j = LRU_NCH - 1; j >= 0; --j) if (j > c) hb = ag[j].x * hb + ag[j].y;
    LDS_WAIT(); __syncthreads();
    float hfv[8][4];
#pragma unroll
    for (int m = 0; m < 8; ++m) {
        float av[4], bv[4];
        lru_tile(F, m, Bw, k, av, bv);
        const float A = av[0] * av[1] * av[2] * av[3], B = ((bv[0] * av[1] + bv[1]) * av[2] + bv[2]) * av[3] + bv[3];
        float hin = hf;
#pragma unroll
        for (int g = 0; g < 4; ++g) { const float Ag = __shfl(A, g * 16 + fr), Bg = __shfl(B, g * 16 + fr); if (g < fq) hin = Ag * hin + Bg; hf = Ag * hf + Bg; }
#pragma unroll
        for (int r = 0; r < 4; ++r) { hin = av[r] * hin + bv[r]; hfv[m][r] = hin; }
    }
    k = k1;
    LAS float* uf = (LAS float*)(F.lds + LRU_UF);
#pragma unroll
    for (int m = 7; m >= 0; --m) {
        float av[4], bv[4];
        lru_tile(F, m, Bw1, k, av, bv);
        const float A = av[0] * av[1] * av[2] * av[3], B = ((bv[3] * av[2] + bv[2]) * av[1] + bv[1]) * av[0] + bv[0];
        float hin = hb;
#pragma unroll
        for (int g = 3; g >= 0; --g) { const float Ag = __shfl(A, g * 16 + fr), Bg = __shfl(B, g * 16 + fr); if (g > fq) hin = Ag * hin + Bg; hb = Ag * hb + Bg; }
#pragma unroll
        for (int r = 3; r >= 0; --r) { hin = av[r] * hin + bv[r]; uf[(m * 16 + 4 * fq + r) * UF_LD + 16 * F.wave + fr] = hfv[m][r] + hin; }
    }
    LDS_WAIT(); __syncthreads();
    const int cg = F.tid & 15;
#pragma unroll
    for (int i = 0; i < 4; ++i) { const int tl = (F.tid >> 4) + 32 * i;
        const f32x4 y0 = *(const LAS f32x4*)(uf + tl * UF_LD + 8 * cg), y1 = *(const LAS f32x4*)(uf + tl * UF_LD + 8 * cg + 4);
        const u32x4 g = ayv[i];
        u32x4 o; o.x = pk2(y0.x * gelu_tanh(bflo(g.x)), y0.y * gelu_tanh(bfhi(g.x))); o.y = pk2(y0.z * gelu_tanh(bflo(g.y)), y0.w * gelu_tanh(bfhi(g.y)));
        o.z = pk2(y1.x * gelu_tanh(bflo(g.z)), y1.y * gelu_tanh(bfhi(g.z))); o.w = pk2(y1.z * gelu_tanh(bflo(g.w)), y1.w * gelu_tanh(bfhi(g.w)));
        *(u32x4*)(AY + (size_t)tl * DM + 8 * cg) = o; }
    __syncthreads();
}
constexpr int HG_C = 64, HG_SEG = 512, HG_NSEG = 4;
constexpr int HG_QS = 0, HG_QM = 16384, HG_KM = 32768, HG_KDT = 49152, HG_VT = 65536, HG_ATT = 81920, HG_PART = 90112, HG_ETOT = 94208, HG_ROWS = 94720;
constexpr size_t HGS_IMG = 65536;
#ifdef PROBE_A
#define HSTAMP(i) do { if (F.bid == 0 && F.tid == 0) { const unsigned long long _t = __builtin_amdgcn_s_memrealtime(); const unsigned long long _p = ((unsigned long long)F.MISC[101] << 32) | F.MISC[100]; \
    unsigned long long _a = ((unsigned long long)F.MISC[103 + 2 * (i)] << 32) | F.MISC[102 + 2 * (i)]; _a += _t - _p; F.MISC[102 + 2 * (i)] = (unsigned)_a; F.MISC[103 + 2 * (i)] = (unsigned)(_a >> 32); F.MISC[100] = (unsigned)_t; F.MISC[101] = (unsigned)(_t >> 32); } } while (0)
#else
#define HSTAMP(i) do { } while (0)
#endif

__device__ __forceinline__ int hg_row(int b, int dir, bool ctx, int sigma) {
    if (ctx) { const int t = dir ? (CTX - 1 - sigma) : sigma; return b * CTX + t; }
    const int p = dir ? (SEQ - 1 - sigma) : sigma; return b * SEQ + (p & 31) * 64 + (p >> 5);
}

struct HgRaw { unsigned f[8], v[8], q[8]; };
template <bool FULL>
__device__ __forceinline__ void hg_load(Frame& F, const bf16* Qb, const bf16* Fb, const bf16* Vb, int b, int dir, bool ctx, int sigma0, HgRaw& r) {
#pragma unroll
    for (int j = 0; j < 8; ++j) { const size_t ro = (size_t)hg_row(b, dir, ctx, sigma0 + 8 * F.wave + j) * DM + 2 * F.lane;
        r.f[j] = *(const unsigned*)(Fb + ro); r.v[j] = *(const unsigned*)(Vb + ro); if (FULL) r.q[j] = *(const unsigned*)(Qb + ro); }
}
template <bool FULL>
__device__ __forceinline__ void hg_prep(Frame& F, const HgRaw& raw, int b, int dir, bool ctx, int sigma0, float lb0, float lb1, float& gs0, float& gs1) {
    const int kp = F.lane, to = F.wave;
    const unsigned (&fw)[8] = raw.f; const unsigned (&qw)[8] = raw.q; const unsigned (&vw)[8] = raw.v;
    float c0[8], c1[8], k0[8], k1[8];
    float a0 = 0.f, a1 = 0.f;
#pragma unroll
    for (int j = 0; j < 8; ++j) {
        const float g0 = lb0 + (1.f - lb0) * __builtin_amdgcn_rcpf(1.f + __builtin_amdgcn_exp2f(-bflo(fw[j]) * LOG2E));
        const float g1 = lb1 + (1.f - lb1) * __builtin_amdgcn_rcpf(1.f + __builtin_amdgcn_exp2f(-bfhi(fw[j]) * LOG2E));
        k0[j] = 1.f - g0; k1[j] = 1.f - g1;
        a0 += __builtin_amdgcn_logf(g0); a1 += __builtin_amdgcn_logf(g1);
        c0[j] = a0; c1[j] = a1; }
    LAS float* part = (LAS float*)(F.lds + HG_PART);
    *(LAS f32x2*)(part + to * 128 + 2 * kp) = (f32x2){a0, a1};
    if (FULL) HSTAMP(0);
    LDS_WAIT(); __syncthreads();
    if (FULL) HSTAMP(1);
    if (FULL && F.tid < HG_C) ((LAS int*)(F.lds + HG_ROWS))[F.tid] = hg_row(b, dir, ctx, sigma0 + F.tid);
    float off0 = 0.f, off1 = 0.f, tot0 = 0.f, tot1 = 0.f;
#pragma unroll
    for (int o = 0; o < 8; ++o) { const f32x2 p = *(const LAS f32x2*)(part + o * 128 + 2 * kp);
        if (o < to) { off0 += p.x; off1 += p.y; } tot0 += p.x; tot1 += p.y; }
    gs0 += tot0; gs1 += tot1;
    if (to == 0) *(LAS f32x2*)((LAS float*)(F.lds + HG_ETOT) + 2 * kp) = (f32x2){__builtin_amdgcn_exp2f(tot0), __builtin_amdgcn_exp2f(tot1)};
    float kd0[8], kd1[8];
#pragma unroll
    for (int j = 0; j < 8; ++j) {
        const float E0 = __builtin_amdgcn_exp2f(off0 + c0[j]), E1 = __builtin_amdgcn_exp2f(off1 + c1[j]);
        kd0[j] = k0[j] * __builtin_amdgcn_rcpf(E0); kd1[j] = k1[j] * __builtin_amdgcn_rcpf(E1);
        if (FULL) {
            const float q0 = bflo(qw[j]), q1 = bfhi(qw[j]);
            const float s0 = q0 * __builtin_amdgcn_rcpf(1.f + __builtin_amdgcn_exp2f(-q0 * LOG2E)) * E0, s1 = q1 * __builtin_amdgcn_rcpf(1.f + __builtin_amdgcn_exp2f(-q1 * LOG2E)) * E1;
            const int c = 8 * to + j; const int off = c * 256 + ((4 * kp) ^ ((c & 15) << 4));
            *(LAS unsigned*)(F.lds + HG_QS + off) = pk2(s0, s1);
            *(LAS unsigned*)(F.lds + HG_KM + off) = pk2(kd0[j], kd1[j]);
        }
    }
    { const int sw = ((to ^ (kp & 7)) << 4);
      u32x4 w0, w1; w0.x = pk2(kd0[0], kd0[1]); w0.y = pk2(kd0[2], kd0[3]); w0.z = pk2(kd0[4], kd0[5]); w0.w = pk2(kd0[6], kd0[7]);
      w1.x = pk2(kd1[0], kd1[1]); w1.y = pk2(kd1[2], kd1[3]); w1.z = pk2(kd1[4], kd1[5]); w1.w = pk2(kd1[6], kd1[7]);
      *(LAS u32x4*)(F.lds + HG_KDT + (2 * kp) * 128 + sw) = w0; *(LAS u32x4*)(F.lds + HG_KDT + (2 * kp + 1) * 128 + sw) = w1;
      u32x4 v0, v1;
      v0.x = (vw[0] & 0xffffu) | (vw[1] << 16); v0.y = (vw[2] & 0xffffu) | (vw[3] << 16); v0.z = (vw[4] & 0xffffu) | (vw[5] << 16); v0.w = (vw[6] & 0xffffu) | (vw[7] << 16);
      v1.x = (vw[0] >> 16) | (vw[1] & 0xffff0000u); v1.y = (vw[2] >> 16) | (vw[3] & 0xffff0000u); v1.z = (vw[4] >> 16) | (vw[5] & 0xffff0000u); v1.w = (vw[6] >> 16) | (vw[7] & 0xffff0000u);
      *(LAS u32x4*)(F.lds + HG_VT + (2 * kp) * 128 + sw) = v0; *(LAS u32x4*)(F.lds + HG_VT + (2 * kp + 1) * 128 + sw) = v1; }
    if (FULL) HSTAMP(2);
    LDS_WAIT(); __syncthreads();
    if (FULL) HSTAMP(3);
}
__device__ __forceinline__ void hg_state_update(Frame& F, f32x4 (&St)[8], const bf16x8 (&vt)[2]) {
    const int fr = F.lane & 15, fq = F.lane >> 4;
    const LAS float* etot = (const LAS float*)(F.lds + HG_ETOT);
#pragma unroll
    for (int kt = 0; kt < 8; ++kt) { const f32x4 e = *(const LAS f32x4*)(etot + 16 * kt + 4 * fq);
        const int rk = 16 * kt + fr;
#pragma unroll
        for (int ks = 0; ks < 2; ++ks) { const bf16x8 A = *(const LAS bf16x8*)(F.lds + HG_KDT + rk * 128 + (((4 * ks + fq) ^ ((rk >> 1) & 7)) << 4));
            St[kt] = __builtin_amdgcn_mfma_f32_16x16x32_bf16(A, vt[ks], St[kt], 0, 0, 0); }
        St[kt] = St[kt] * e; }
}
__device__ __forceinline__ void hg_load_vt(Frame& F, bf16x8 (&vt)[2]) {
    const int fr = F.lane & 15, fq = F.lane >> 4; const int rv = 16 * F.wave + fr;
#pragma unroll
    for (int ks = 0; ks < 2; ++ks) vt[ks] = *(const LAS bf16x8*)(F.lds + HG_VT + rv * 128 + (((4 * ks + fq) ^ ((rv >> 1) & 7)) << 4));
}
struct HgPtrs { const bf16* Q; const bf16* Fx; const bf16* V; const bf16* Fc; const bf16* Vc; bf16* O; };
__device__ __forceinline__ HgPtrs hg_ptrs(Frame& F, int h, int dir) {
    HgPtrs p; p.Q = (const bf16*)(F.ws + WS_P + 2 * GS) + h * 128; p.Fx = (const bf16*)(F.ws + WS_P + (dir ? 4 : 3) * GS) + h * 128; p.V = (const bf16*)(F.ws + WS_P + 5 * GS) + h * 128;
    p.Fc = (const bf16*)(F.ws + WS_PC + (dir ? 2 : 1) * CGS) + h * 128; p.Vc = (const bf16*)(F.ws + WS_PC + 3 * CGS) + h * 128; p.O = (bf16*)(F.ws + WS_P + (dir ? 4 : 3) * GS) + h * 128; return p;
}
__device__ __forceinline__ void hg_lb(const Args& a, int h, int kp, float& lb0, float& lb1) {
    const float* t = a.in[IN_HGLB] + h * 128 + 2 * kp; lb0 = 1.f / (1.f + expf(t[DM] - t[0])); lb1 = 1.f / (1.f + expf(t[DM + 1] - t[1]));
}
__device__ __forceinline__ float* hg_img(Frame& F, int b, int h, int dir, int slot) { return (float*)((unsigned char*)F.out + (size_t)((((b * 8 + h) * 2 + dir) * 4) + slot) * HGS_IMG); }

__device__ __forceinline__ void hg_pass1(Frame& F, const Args& a, int unit) {
    const int slot = unit & 3, dir = (unit >> 2) & 1, h = (unit >> 3) & 7, b = unit >> 6;
    const int fr = F.lane & 15, fq = F.lane >> 4;
    const HgPtrs P = hg_ptrs(F, h, dir);
    float lb0, lb1; hg_lb(a, h, F.lane, lb0, lb1);
    f32x4 St[8];
#pragma unroll
    for (int kt = 0; kt < 8; ++kt) St[kt] = (f32x4){0.f, 0.f, 0.f, 0.f};
    const bool ctx = slot == 0; const int nchunk = ctx ? CTX / HG_C : HG_SEG / HG_C; const int sig0 = ctx ? 0 : (slot - 1) * HG_SEG;
    float gs0 = 0.f, gs1 = 0.f;
    const bf16* Fsrc = ctx ? P.Fc : P.Fx; const bf16* Vsrc = ctx ? P.Vc : P.V;
    HgRaw cur; hg_load<false>(F, P.Q, Fsrc, Vsrc, b, dir, ctx, sig0, cur);
    for (int ck = 0; ck < nchunk; ++ck) {
        HgRaw nxt; { const int cn = ck + 1 < nchunk ? ck + 1 : ck; hg_load<false>(F, P.Q, Fsrc, Vsrc, b, dir, ctx, sig0 + cn * HG_C, nxt); }
        hg_prep<false>(F, cur, b, dir, ctx, sig0 + ck * HG_C, lb0, lb1, gs0, gs1);
        cur = nxt;
        bf16x8 vt[2]; hg_load_vt(F, vt);
        hg_state_update(F, St, vt);
    }
    float* img = hg_img(F, b, h, dir, slot) + (size_t)(16 * F.wave + fr) * 128 + 4 * fq;
#pragma unroll
    for (int kt = 0; kt < 8; ++kt) *(f32x4*)(img + 16 * kt) = St[kt];
    if (!ctx && F.wave == 0) { float* D = (float*)(F.ws + WS_HGD) + (size_t)((((b * 8 + h) * 2 + dir) * 3) + (slot - 1)) * 128 + 2 * F.lane;
        *(f32x2*)D = (f32x2){__builtin_amdgcn_exp2f(gs0), __builtin_amdgcn_exp2f(gs1)}; }
    __syncthreads();
}

__device__ __forceinline__ void hg_pass2(Frame& F, const Args& a, int unit) {
    const int seg = unit & 3, dir = (unit >> 2) & 1, h = (unit >> 3) & 7, b = unit >> 6;
    const int fr = F.lane & 15, fq = F.lane >> 4, w = F.wave;
    const HgPtrs P = hg_ptrs(F, h, dir);
    float lb0, lb1; hg_lb(a, h, F.lane, lb0, lb1);
    f32x4 St[8];
    {
        const float* img = hg_img(F, b, h, dir, 0) + (size_t)(16 * w + fr) * 128 + 4 * fq;
#pragma unroll
        for (int kt = 0; kt < 8; ++kt) St[kt] = *(const f32x4*)(img + 16 * kt);
        for (int j = 0; j < seg; ++j) {
            const float* im = hg_img(F, b, h, dir, 1 + j) + (size_t)(16 * w + fr) * 128 + 4 * fq;
            const float* D = (const float*)(F.ws + WS_HGD) + (size_t)((((b * 8 + h) * 2 + dir) * 3) + j) * 128 + 4 * fq;
#pragma unroll
            for (int kt = 0; kt < 8; ++kt) { const f32x4 d = *(const f32x4*)(D + 16 * kt), dl = *(const f32x4*)(im + 16 * kt); St[kt] = St[kt] * d + dl; }
        }
    }
    float gs0 = 0.f, gs1 = 0.f;
    HSTAMP(7);
    HgRaw cur; hg_load<true>(F, P.Q, P.Fx, P.V, b, dir, false, seg * HG_SEG, cur);
    for (int ck = 0; ck < HG_SEG / HG_C; ++ck) {
        HgRaw nxt; { const int cn = ck + 1 < HG_SEG / HG_C ? ck + 1 : ck; hg_load<true>(F, P.Q, P.Fx, P.V, b, dir, false, seg * HG_SEG + cn * HG_C, nxt); }
        hg_prep<true>(F, cur, b, dir, false, seg * HG_SEG + ck * HG_C, lb0, lb1, gs0, gs1);
#pragma unroll
        for (int tt = 0; tt < 2; ++tt) { const int t = w + 8 * tt, ct = t >> 2, st = t & 3;
            f32x4 acc = {0.f, 0.f, 0.f, 0.f};
            const int rs = 16 * st + fr, rc = 16 * ct + fr;
#pragma unroll
            for (int kk = 0; kk < 4; ++kk) { const bf16x8 A = *(const LAS bf16x8*)(F.lds + HG_KM + rs * 256 + (((4 * kk + fq) ^ fr) << 4));
                const bf16x8 B = *(const LAS bf16x8*)(F.lds + HG_QS + rc * 256 + (((4 * kk + fq) ^ fr) << 4));
                acc = __builtin_amdgcn_mfma_f32_16x16x32_bf16(A, B, acc, 0, 0, 0); }
            const int s0 = 16 * st + 4 * fq;
            const float m0 = (s0 + 0 <= rc) ? acc[0] : 0.f, m1 = (s0 + 1 <= rc) ? acc[1] : 0.f, m2 = (s0 + 2 <= rc) ? acc[2] : 0.f, m3 = (s0 + 3 <= rc) ? acc[3] : 0.f;
            *(LAS u32x2*)(F.lds + HG_ATT + rc * 128 + (((2 * st + (fq >> 1)) ^ ((rc >> 1) & 7)) << 4) + (fq & 1) * 8) = (u32x2){pk2(m0, m1), pk2(m2, m3)}; }
        f32x4 o[4];
#pragma unroll
        for (int ct = 0; ct < 4; ++ct) o[ct] = (f32x4){0.f, 0.f, 0.f, 0.f};
#pragma unroll
        for (int kk = 0; kk < 4; ++kk) {
            union { bf16x8 v; unsigned u[4]; } A;
            A.u[0] = pk2(St[2 * kk][0], St[2 * kk][1]); A.u[1] = pk2(St[2 * kk][2], St[2 * kk][3]); A.u[2] = pk2(St[2 * kk + 1][0], St[2 * kk + 1][1]); A.u[3] = pk2(St[2 * kk + 1][2], St[2 * kk + 1][3]);
#pragma unroll
            for (int ct = 0; ct < 4; ++ct) { const int rc = 16 * ct + fr;
                union { bf16x8 v; u32x2 h[2]; } B;
                B.h[0] = *(const LAS u32x2*)(F.lds + HG_QS + rc * 256 + (((4 * kk + (fq >> 1)) ^ fr) << 4) + (fq & 1) * 8);
                B.h[1] = *(const LAS u32x2*)(F.lds + HG_QS + rc * 256 + (((4 * kk + 2 + (fq >> 1)) ^ fr) << 4) + (fq & 1) * 8);
                o[ct] = __builtin_amdgcn_mfma_f32_16x16x32_bf16(A.v, B.v, o[ct], 0, 0, 0); } }
        bf16x8 vt[2]; hg_load_vt(F, vt);
        HSTAMP(4);
        LDS_WAIT(); __syncthreads();
        HSTAMP(5);
#pragma unroll
        for (int ks = 0; ks < 2; ++ks)
#pragma unroll
            for (int ct = 0; ct < 4; ++ct) { const int rc = 16 * ct + fr;
                const bf16x8 B = *(const LAS bf16x8*)(F.lds + HG_ATT + rc * 128 + (((4 * ks + fq) ^ ((rc >> 1) & 7)) << 4));
                o[ct] = __builtin_amdgcn_mfma_f32_16x16x32_bf16(vt[ks], B, o[ct], 0, 0, 0); }
        { const LAS int* rows = (const LAS int*)(F.lds + HG_ROWS);
#pragma unroll
          for (int ct = 0; ct < 4; ++ct) { const int row = rows[16 * ct + fr];
              *(u32x2*)(P.O + (size_t)row * DM + 16 * w + 4 * fq) = (u32x2){pk2(o[ct][0], o[ct][1]), pk2(o[ct][2], o[ct][3])}; } }
        hg_state_update(F, St, vt);
        cur = nxt;
        HSTAMP(6);
    }
    __syncthreads();
}
__device__ __forceinline__ void p_ybg(Frame& F, const Args& a) {
    const bf16* OFp = (const bf16*)(F.ws + WS_OF); const bf16* OBp = (const bf16*)(F.ws + WS_OB); const bf16* OG = (const bf16*)(F.ws + WS_P + 6 * GS);
    bf16* YBG = (bf16*)(F.ws + WS_YBG); const float* hgn = a.in[IN_HGN];
    const int gw = F.bid * NWAVES + F.wave, NGW = F.G * NWAVES;
    for (int row = gw; row < NTOK; row += NGW) {
#pragma unroll
        for (int j = 0; j < 2; ++j) { const int k = 8 * F.lane + 512 * j; const size_t o = (size_t)row * DM + k;
            const u32x4 f = *(const u32x4*)(OFp + o), b = *(const u32x4*)(OBp + o), g = *(const u32x4*)(OG + o);
            float v[8]; v[0] = bflo(f.x) + bflo(b.x); v[1] = bfhi(f.x) + bfhi(b.x); v[2] = bflo(f.y) + bflo(b.y); v[3] = bfhi(f.y) + bfhi(b.y);
            v[4] = bflo(f.z) + bflo(b.z); v[5] = bfhi(f.z) + bfhi(b.z); v[6] = bflo(f.w) + bflo(b.w); v[7] = bfhi(f.w) + bfhi(b.w);
            float ss = 0.f;
#pragma unroll
            for (int q = 0; q < 8; ++q) ss += v[q] * v[q];
            ss += __shfl_xor(ss, 1); ss += __shfl_xor(ss, 2); ss += __shfl_xor(ss, 4); ss += __shfl_xor(ss, 8);
            const float rs = rsqrtf(ss * (1.f / 128.f) + EPS);
            float gv[8]; gv[0] = bflo(g.x); gv[1] = bfhi(g.x); gv[2] = bflo(g.y); gv[3] = bfhi(g.y); gv[4] = bflo(g.z); gv[5] = bfhi(g.z); gv[6] = bflo(g.w); gv[7] = bfhi(g.w);
            const f32x4 h0 = *(const f32x4*)(hgn + k), h1 = *(const f32x4*)(hgn + k + 4);
            const float hv[8] = {h0.x, h0.y, h0.z, h0.w, h1.x, h1.y, h1.z, h1.w};
            float r[8];
#pragma unroll
            for (int q = 0; q < 8; ++q) r[q] = v[q] * rs * hv[q] * siluf_(gv[q]);
            u32x4 w; w.x = pk2(r[0], r[1]); w.y = pk2(r[2], r[3]); w.z = pk2(r[4], r[5]); w.w = pk2(r[6], r[7]);
            *(u32x4*)(YBG + o) = w; }
    }
}
__device__ __forceinline__ void p_moe_weights(Frame& F, const Args& a) {
    LAS float* scr = (LAS float*)(F.lds + F.wave * TR_BYTES);
    const int gw = F.bid * NWAVES + F.wave, NGW = F.G * NWAVES;
    constexpr int PER_E = 3 * 128;
    for (int it = gw; it < NEXP * PER_E; it += NGW) {
        const int e = it / PER_E, r = it % PER_E, w = r >> 7, q = r & 127;
        if (w < 2) { const int kb = q >> 3, nb = q & 7;
            transpose_item(a.in[w == 0 ? IN_W1 : IN_W3] + (size_t)e * DM * DEXP, DEXP, DM, (bf16*)(F.ws + (w == 0 ? WS_W1T : WS_W3T)) + ((size_t)e * DEXP + nb * 64) * DM, kb * 64, nb * 64, scr, F.lane); }
        else { const int kb = q >> 4, nb = q & 15;
            transpose_item(a.in[IN_W2] + (size_t)e * DEXP * DM, DM, DEXP, (bf16*)(F.ws + WS_W2T) + ((size_t)e * DM + nb * 64) * DEXP, kb * 64, nb * 64, scr, F.lane); }
    }
}

struct SchedP5 {
    int c; const char* YAG; const char* YBG; const char* WA; const char* WB; char* stash; char* M;
    __device__ __forceinline__ bool next(int i, gm::Unit& u) const {
        if (i >= 2) return false;
        int pm, pn; tile_order(c, 64, 4, pm, pn);
        u.A = (i == 0 ? YAG : YBG) + (size_t)pm * 256 * 2048; u.B0 = (i == 0 ? WA : WB) + (size_t)pn * 256 * 2048; u.B1 = u.B0 + (size_t)128 * 2048;
        u.dst = M + ((size_t)pm * 256 * DM + pn * 256) * 2; u.pm = pm; u.pn = pn; u.e = i; u.rows = 256; return true;
    }
    __device__ __forceinline__ unsigned arow(const gm::Unit&, int r) const { return (unsigned)r; }
};
struct EpiP5 {
    static constexpr bool PERM = true;
    float* stash; const bf16* GA; const bf16* GB;
    __device__ __forceinline__ void operator()(const f32x4 (&acc)[2][2][4][2], const gm::Unit& u, int wr, int wc, int fr, int fq) const {
        const bf16* G = (u.e == 0 ? GA : GB) + ((size_t)u.pm * 256 + wr * 64 + fr) * DM + u.pn * 256 + wc * 32 + 8 * fq;
        bf16* Mb = (bf16*)u.dst + (size_t)(wr * 64 + fr) * DM + wc * 32 + 8 * fq;
        f32x4* st = (f32x4*)stash + threadIdx.x;
        asm volatile("" : "+v"(G), "+v"(Mb), "+v"(st));
#pragma unroll
        for (int ai = 0; ai < 2; ++ai)
#pragma unroll
            for (int m = 0; m < 4; ++m)
#pragma unroll
                for (int bj = 0; bj < 2; ++bj) { const size_t ro = (size_t)(ai * 128 + m * 16) * DM + bj * 128;
                    const u32x4 g = *(const u32x4*)(G + ro);
                    f32x4 v0 = acc[ai][bj][m][0], v1 = acc[ai][bj][m][1];
                    v0[0] *= sigmoidf_(bflo(g.x)); v0[1] *= sigmoidf_(bfhi(g.x)); v0[2] *= sigmoidf_(bflo(g.y)); v0[3] *= sigmoidf_(bfhi(g.y));
                    v1[0] *= sigmoidf_(bflo(g.z)); v1[1] *= sigmoidf_(bfhi(g.z)); v1[2] *= sigmoidf_(bflo(g.w)); v1[3] *= sigmoidf_(bfhi(g.w));
                    const int si = ((ai * 4 + m) * 2 + bj) * 2;
                    if (u.e == 0) { st[(size_t)(si + 0) * NTHR] = v0; st[(size_t)(si + 1) * NTHR] = v1; }
                    else { v0 += st[(size_t)(si + 0) * NTHR]; v1 += st[(size_t)(si + 1) * NTHR];
                        u32x4 w; w.x = gm::cvt_pk_bf16(v0[0], v0[1]); w.y = gm::cvt_pk_bf16(v0[2], v0[3]); w.z = gm::cvt_pk_bf16(v1[0], v1[1]); w.w = gm::cvt_pk_bf16(v1[2], v1[3]);
                        *(u32x4*)(Mb + ro) = w; }
                    asm volatile("" ::: "memory"); }
    }
};

struct SchedP6 {
    int c; const char* M; const char* W; char* X1;
    __device__ __forceinline__ bool next(int i, gm::Unit& u) const {
        if (i >= 1) return false;
        int pm, pn; tile_order(c, 64, 4, pm, pn);
        u.A = M + (size_t)pm * 256 * 2048; u.B0 = W + (size_t)pn * 256 * 2048; u.B1 = u.B0 + (size_t)128 * 2048;
        u.dst = X1 + ((size_t)pm * 256 * DM + pn * 256) * 4; u.pm = pm; u.pn = pn; u.e = 0; u.rows = 256; return true;
    }
    __device__ __forceinline__ unsigned arow(const gm::Unit&, int r) const { return (unsigned)r; }
};
struct EpiP6 {
    static constexpr bool PERM = false;
    const float* x; const float* mod;
    __device__ __forceinline__ void operator()(const f32x4 (&acc)[2][2][4][2], const gm::Unit& u, int wr, int wc, int fr, int fq) const {
        const int b = u.pm >> 3; const int col0 = u.pn * 256 + wc * 32 + 4 * fq;
        const float* mg = mod + b * 6144 + 2 * DM + col0;
        f32x4 gv[2][2];
#pragma unroll
        for (int bj = 0; bj < 2; ++bj)
#pragma unroll
            for (int n = 0; n < 2; ++n) gv[bj][n] = *(const f32x4*)(mg + bj * 128 + n * 16);
#pragma unroll
        for (int ai = 0; ai < 2; ++ai)
#pragma unroll
            for (int m = 0; m < 4; ++m) { const size_t ro = (size_t)(wr * 64 + fr + ai * 128 + m * 16) * DM + wc * 32 + 4 * fq;
                const float* xr = x + ((size_t)u.pm * 256 * DM + u.pn * 256) + ro; float* orow = (float*)u.dst + ro;
#pragma unroll
                for (int bj = 0; bj < 2; ++bj)
#pragma unroll
                    for (int n = 0; n < 2; ++n) { const f32x4 xv = *(const f32x4*)(xr + bj * 128 + n * 16);
                        *(f32x4*)(orow + bj * 128 + n * 16) = xv + gv[bj][n] * acc[ai][bj][m][n]; } }
    }
};

__device__ __forceinline__ void p_norm2_route(Frame& F, const Args& a) {
    const float* mod = (const float*)(F.ws + WS_MOD); const float* g2 = a.in[IN_G2]; const float* wrp = (const float*)(F.ws + WS_WRT);
    const float* X1 = F.out; bf16* HX2 = (bf16*)(F.ws + WS_HX2);
    int* list = (int*)(F.ws + WS_LIST); float* wt = (float*)(F.ws + WS_WT); unsigned* cnt = F.ctl + CW_CNT;
    LAS float* gs = (LAS float*)F.lds; LAS float* sh = gs + DM; LAS float* rst = sh + DM; LAS float* lgs = rst + 64;
    const int b = F.bid / 32;
    for (int k = F.tid; k < DM; k += NTHR) { gs[k] = g2[k] * (1.f + mod[b * 6144 + 4 * DM + k]); sh[k] = mod[b * 6144 + 3 * DM + k]; }
    __syncthreads();
    for (int r = F.wave; r < 64; r += NWAVES) {
        const int tok = F.bid * 64 + r;
        const f32x4* xr = (const f32x4*)(X1 + (size_t)tok * DM) + F.lane;
        f32x4 v[4]; float s = 0.f;
#pragma unroll
        for (int j = 0; j < 4; ++j) { v[j] = xr[64 * j]; s += (v[j].x * v[j].x + v[j].y * v[j].y) + (v[j].z * v[j].z + v[j].w * v[j].w); }
        const float rstd = rsqrtf(wave_sum(s) * (1.f / DM) + EPS);
        if (F.lane == 0) rst[r] = rstd;
        unsigned long long* o8 = (unsigned long long*)(HX2 + (size_t)tok * DM) + F.lane;
#pragma unroll
        for (int j = 0; j < 4; ++j) { const int k = 4 * F.lane + 256 * j;
            const f32x4 g = *(const LAS f32x4*)(gs + k), h = *(const LAS f32x4*)(sh + k);
            o8[64 * j] = (unsigned long long)pk2(v[j].x * rstd * g.x + h.x, v[j].y * rstd * g.y + h.y) | ((unsigned long long)pk2(v[j].z * rstd * g.z + h.z, v[j].w * rstd * g.w + h.w) << 32); }
    }
    LDS_WAIT(); __syncthreads();
    {
        const int tq = F.lane & 15, kq = F.lane >> 4, wg = F.wave & 3, kh = F.wave >> 2; const int tl = wg * 16 + tq;
        const float rs = rst[tl];
        const float* xr = X1 + (size_t)(F.bid * 64 + tl) * DM + 4 * kq + 512 * kh;
        const f32x4* wp = (const f32x4*)wrp + F.lane + (size_t)kh * 32 * 3 * 64;
        const LAS float* gsp = gs + 512 * kh + 4 * kq; const LAS float* shp = sh + 512 * kh + 4 * kq;
        f32x4 acc[3];
#pragma unroll
        for (int c = 0; c < 3; ++c) acc[c] = (f32x4){0.f, 0.f, 0.f, 0.f};
#pragma unroll 8
        for (int s = 0; s < 32; ++s) {
            const f32x4 x = *(const f32x4*)(xr + 16 * s); const f32x4 g = *(const LAS f32x4*)(gsp + 16 * s), h = *(const LAS f32x4*)(shp + 16 * s);
            const f32x4 hv = x * rs * g + h;
#pragma unroll
            for (int c = 0; c < 3; ++c) { const f32x4 w = wp[(s * 3 + c) * 64];
                acc[c] = __builtin_amdgcn_mfma_f32_16x16x4f32(hv[0], w[0], acc[c], 0, 0, 0); acc[c] = __builtin_amdgcn_mfma_f32_16x16x4f32(hv[1], w[1], acc[c], 0, 0, 0);
                acc[c] = __builtin_amdgcn_mfma_f32_16x16x4f32(hv[2], w[2], acc[c], 0, 0, 0); acc[c] = __builtin_amdgcn_mfma_f32_16x16x4f32(hv[3], w[3], acc[c], 0, 0, 0); }
        }
#pragma unroll
        for (int c = 0; c < 3; ++c)
#pragma unroll
            for (int r = 0; r < 4; ++r) lgs[kh * 64 * 48 + (wg * 16 + 4 * kq + r) * 48 + 16 * c + tq] = acc[c][r];
    }
    LDS_WAIT(); __syncthreads();
    if (F.wave < 4) {
        if (F.lane < 16) {
            const LAS float* lp = lgs + (F.wave * 16 + F.lane) * 48; const int tok = F.bid * 64 + F.wave * 16 + F.lane;
            float lg[36];
#pragma unroll
            for (int q = 0; q < 9; ++q) { const f32x4 t4 = *(const LAS f32x4*)(lp + 4 * q) + *(const LAS f32x4*)(lp + 64 * 48 + 4 * q) + *(const f32x4*)(wrp + 49152 + 4 * q);
                lg[4 * q] = t4.x; lg[4 * q + 1] = t4.y; lg[4 * q + 2] = t4.z; lg[4 * q + 3] = t4.w; }
            float mx = lg[0]; int gi = 0;
#pragma unroll
            for (int g = 1; g < 4; ++g) if (lg[g] > mx) { mx = lg[g]; gi = g; }
            float z = 0.f;
#pragma unroll
            for (int g = 0; g < 4; ++g) z += __expf(lg[g] - mx);
            const float pg = 1.f / z;
            float el[8];
#pragma unroll
            for (int e = 0; e < 8; ++e) el[e] = gi == 0 ? lg[4 + e] : (gi == 1 ? lg[12 + e] : (gi == 2 ? lg[20 + e] : lg[28 + e]));
            int e1 = 0; float m1 = el[0];
#pragma unroll
            for (int e = 1; e < 8; ++e) if (el[e] > m1) { m1 = el[e]; e1 = e; }
            int e2 = 0; float m2 = -3.0e38f;
#pragma unroll
            for (int e = 0; e < 8; ++e) if (e != e1 && el[e] > m2) { m2 = el[e]; e2 = e; }
            const float rr = __expf(m2 - m1); const float w1 = pg / (1.f + rr), w2 = pg * rr / (1.f + rr);
            const int ea = gi * 8 + e1, eb = gi * 8 + e2;
            const unsigned pa = __hip_atomic_fetch_add(cnt + 64 * ea, 1u, __ATOMIC_RELAXED, __HIP_MEMORY_SCOPE_AGENT);
            const unsigned pb = __hip_atomic_fetch_add(cnt + 64 * eb, 1u, __ATOMIC_RELAXED, __HIP_MEMORY_SCOPE_AGENT);
            list[(size_t)ea * CAP + pa] = tok * 2; wt[tok * 2] = w1;
            list[(size_t)eb * CAP + pb] = tok * 2 + 1; wt[tok * 2 + 1] = w2;
        }
    }
}

__device__ __forceinline__ void moe_table(Frame& F, const int* cntv) {
    if (F.wave == 0) { const int lane = F.lane; const int cnt = lane < NEXP ? cntv[64 * lane] : 0;
        const int t = (cnt + 255) >> 8; int ti = t, oi = cnt;
#pragma unroll
        for (int d = 1; d < 32; d <<= 1) { const int tu = __shfl_up(ti, d), ou = __shfl_up(oi, d); if ((lane & 31) >= d) { ti += tu; oi += ou; } }
        if (lane < NEXP) { F.MISC[128 + lane] = (unsigned)cnt; F.MISC[160 + lane] = (unsigned)(ti - t); F.MISC[192 + lane] = (unsigned)(oi - cnt); }
        if (lane == NEXP - 1) F.MISC[224] = (unsigned)ti; }
    LDS_WAIT(); __syncthreads();
}
__device__ __forceinline__ bool moe_find(volatile LAS unsigned* MISC, int lane, int T, int& e, int& rt, int& rows, int& off) {
    if (T >= (int)MISC[224]) return false;
    const int l = lane & 31; const int cnt = (int)MISC[128 + l], tpre = (int)MISC[160 + l];
    const unsigned long long mask = __ballot(lane < NEXP && cnt > 0 && T >= tpre);
    e = __builtin_amdgcn_readfirstlane(63 - __builtin_clzll(mask));
    rt = T - (int)MISC[160 + e]; const int c = (int)MISC[128 + e]; off = (int)MISC[192 + e];
    rows = c - rt * 256; if (rows > 256) rows = 256; return true;
}
struct SchedMoe1 {
    int G, c, lane; volatile LAS unsigned* MISC; const int* list; const char* HX2; const char* W1T; const char* W3T; char* HH;
    __device__ __forceinline__ bool next(int i, gm::Unit& u) const {
        const int L = i * G + c; int e, rt, rows, off; if (!moe_find(MISC, lane, L >> 2, e, rt, rows, off)) return false;
        const int pn = L & 3;
        e = __builtin_amdgcn_readfirstlane(e); rt = __builtin_amdgcn_readfirstlane(rt); rows = __builtin_amdgcn_readfirstlane(rows); off = __builtin_amdgcn_readfirstlane(off);
        u.A = HX2; u.B0 = W1T + ((size_t)e * DEXP + pn * 128) * 2048; u.B1 = W3T + ((size_t)e * DEXP + pn * 128) * 2048;
        u.dst = HH + ((size_t)(off + rt * 256) * DEXP + pn * 128) * 2; u.pm = rt; u.pn = pn; u.e = e; u.rows = rows; return true;
    }
    __device__ __forceinline__ unsigned arow(const gm::Unit& u, int r) const { const int rr = r < u.rows ? r : u.rows - 1; return (unsigned)(list[(size_t)u.e * CAP + u.pm * 256 + rr] >> 1); }
};
struct EpiMoe1 {
    static constexpr bool PERM = true;
    __device__ __forceinline__ void operator()(const f32x4 (&acc)[2][2][4][2], const gm::Unit& u, int wr, int wc, int fr, int fq) const {
        bf16* base = (bf16*)u.dst + (size_t)(wr * 64 + fr) * DEXP + wc * 32 + 8 * fq;
#pragma unroll
        for (int ai = 0; ai < 2; ++ai)
#pragma unroll
            for (int m = 0; m < 4; ++m) { const int r = ai * 128 + wr * 64 + m * 16 + fr; if (r >= u.rows) continue;
                const f32x4 u0 = acc[ai][0][m][0], u1 = acc[ai][0][m][1], v0 = acc[ai][1][m][0], v1 = acc[ai][1][m][1];
                u32x4 w; w.x = gm::cvt_pk_bf16(siluf_(u0[0]) * v0[0], siluf_(u0[1]) * v0[1]); w.y = gm::cvt_pk_bf16(siluf_(u0[2]) * v0[2], siluf_(u0[3]) * v0[3]);
                w.z = gm::cvt_pk_bf16(siluf_(u1[0]) * v1[0], siluf_(u1[1]) * v1[1]); w.w = gm::cvt_pk_bf16(siluf_(u1[2]) * v1[2], siluf_(u1[3]) * v1[3]);
                *(u32x4*)(base + (size_t)(ai * 128 + m * 16) * DEXP) = w; }
    }
};
struct SchedMoe2 {
    int G, c, lane; volatile LAS unsigned* MISC; const char* HH; const char* W2T; char* Y;
    __device__ __forceinline__ bool next(int i, gm::Unit& u) const {
        const int L = i * G + c; int e, rt, rows, off; if (!moe_find(MISC, lane, L >> 2, e, rt, rows, off)) return false;
        const int pn = L & 3;
        e = __builtin_amdgcn_readfirstlane(e); rt = __builtin_amdgcn_readfirstlane(rt); rows = __builtin_amdgcn_readfirstlane(rows); off = __builtin_amdgcn_readfirstlane(off);
        u.A = HH + (size_t)(off + rt * 256) * DEXP * 2; u.B0 = W2T + ((size_t)e * DM + pn * 256) * (DEXP * 2); u.B1 = u.B0 + (size_t)128 * (DEXP * 2);
        u.dst = Y + (size_t)pn * 256 * 2; u.pm = rt; u.pn = pn; u.e = e; u.rows = rows; return true;
    }
    __device__ __forceinline__ unsigned arow(const gm::Unit&, int r) const { return (unsigned)r; }
};
struct EpiMoe2 {
    static constexpr bool PERM = true;
    const int* list;
    __device__ __forceinline__ void operator()(const f32x4 (&acc)[2][2][4][2], const gm::Unit& u, int wr, int wc, int fr, int fq) const {
        const int* lp = list + (size_t)u.e * CAP + u.pm * 256;
#pragma unroll
        for (int ai = 0; ai < 2; ++ai)
#pragma unroll
            for (int m = 0; m < 4; ++m) { const int r = ai * 128 + wr * 64 + m * 16 + fr; if (r >= u.rows) continue;
                const int slot = lp[r]; bf16* rowp = (bf16*)u.dst + (size_t)slot * DM + wc * 32 + 8 * fq;
#pragma unroll
                for (int bj = 0; bj < 2; ++bj) { const f32x4 v0 = acc[ai][bj][m][0], v1 = acc[ai][bj][m][1];
                    u32x4 w; w.x = gm::cvt_pk_bf16(v0[0], v0[1]); w.y = gm::cvt_pk_bf16(v0[2], v0[3]); w.z = gm::cvt_pk_bf16(v1[0], v1[1]); w.w = gm::cvt_pk_bf16(v1[2], v1[3]);
                    *(u32x4*)(rowp + bj * 128) = w; } }
    }
};

__device__ __forceinline__ void p_final(Frame& F, const Args& a) {
    const float* mod = (const float*)(F.ws + WS_MOD); const float* fg = a.in[IN_FG]; const float* wt = (const float*)(F.ws + WS_WT);
    const bf16* Y = (const bf16*)(F.ws + WS_Y); float* X1 = F.out;
    for (int r = F.wave; r < 64; r += NWAVES) {
        const int tok = F.bid * 64 + r; const int b = tok >> 11;
        const float w0 = wt[tok * 2], w1 = wt[tok * 2 + 1];
        f32x4* xr = (f32x4*)(X1 + (size_t)tok * DM) + F.lane;
        const u32x2* y0 = (const u32x2*)(Y + (size_t)(tok * 2) * DM) + F.lane; const u32x2* y1 = (const u32x2*)(Y + (size_t)(tok * 2 + 1) * DM) + F.lane;
        f32x4 v[4]; float s = 0.f;
#pragma unroll
        for (int j = 0; j < 4; ++j) { const int k = 4 * F.lane + 256 * j;
            const f32x4 xv = xr[64 * j]; const u32x2 a0 = y0[64 * j], a1 = y1[64 * j]; const f32x4 g5 = *(const f32x4*)(mod + b * 6144 + 5 * DM + k);
            v[j].x = xv.x + g5.x * (w0 * bflo(a0.x) + w1 * bflo(a1.x)); v[j].y = xv.y + g5.y * (w0 * bfhi(a0.x) + w1 * bfhi(a1.x));
            v[j].z = xv.z + g5.z * (w0 * bflo(a0.y) + w1 * bflo(a1.y)); v[j].w = xv.w + g5.w * (w0 * bfhi(a0.y) + w1 * bfhi(a1.y));
            s += (v[j].x * v[j].x + v[j].y * v[j].y) + (v[j].z * v[j].z + v[j].w * v[j].w); }
        const float rstd = rsqrtf(wave_sum(s) * (1.f / DM) + EPS);
#pragma unroll
        for (int j = 0; j < 4; ++j) { const int k = 4 * F.lane + 256 * j; const f32x4 g = *(const f32x4*)(fg + k);
            xr[64 * j] = (f32x4){v[j].x * rstd * g.x, v[j].y * rstd * g.y, v[j].z * rstd * g.z, v[j].w * rstd * g.w}; }
    }
}
#ifndef LRU_FAST
#define LRU_FAST 1
#endif
#ifndef HG_FAST
#define HG_FAST 1
#endif
#define MIX_FAST (LRU_FAST && HG_FAST)
#ifdef PROBE_A
#define STAMP(k) do { if (F.bid == 0 && F.tid == 0) { const unsigned long long _t = __builtin_amdgcn_s_memrealtime(); F.MISC[32 + 2 * (k)] = (unsigned)_t; F.MISC[33 + 2 * (k)] = (unsigned)(_t >> 32); } } while (0)
#else
#define STAMP(k) do { } while (0)
#endif
__device__ __forceinline__ void p_mix1(Frame& F, const Args& a) {
#if LRU_FAST
    for (int u = F.bid; u < NB * 8 * LRU_NCH; u += F.G) lru_pass1(F, a, u);
#endif
    STAMP(14); STAMP(15);
#if HG_FAST
    for (int i = 0, u = F.bid; u < NB * 8 * 2 * 4; u += F.G, ++i) hg_pass1(F, a, (u & ~3) | ((u + 2 * i) & 3));
#endif
}
__device__ __forceinline__ void p_mix2(Frame& F, const Args& a) {
#if LRU_FAST
    for (int u = F.bid; u < NB * 8 * LRU_NCH; u += F.G) lru_pass2(F, a, u);
#endif
    STAMP(16); STAMP(17);
#if HG_FAST
    for (int u = F.bid; u < NB * 8 * 2 * 4; u += F.G) hg_pass2(F, a, u);
#endif
}
__global__ void __launch_bounds__(NTHR, 2) mega(Args args) {
    extern __shared__ __attribute__((aligned(16))) unsigned char lds_raw[];
    Frame F;
    F.lds = (LAS unsigned char*)lds_raw; F.MISC = (volatile LAS unsigned*)(F.lds + LDSCTL_OFF);
    F.tid = threadIdx.x; F.lane = F.tid & 63; F.wave = __builtin_amdgcn_readfirstlane(F.tid >> 6);
    F.G = gridDim.x; F.bid = blockIdx.x; F.ws = args.ws; F.out = args.out; F.ctl = (unsigned*)(args.ws + WS_CTL);
    for (int u = F.tid; u < (LDS_BYTES - LDSCTL_OFF) / 4; u += NTHR) ((LAS unsigned*)(F.lds + LDSCTL_OFF))[u] = 0u;
    __syncthreads();
    XcdBarrier bar = xcd_barrier_post(F.ctl + CW_BAR + args.li * 3584, F.MISC + 8);
    const int lo = args.ph_lo, hi = args.ph_hi;
#define IN(k) (lo <= (k) && (k) < hi)
#define SEAM(k) do { if (IN(k) && IN((k) + 1)) xcd_barrier(bar); STAMP((k) + 1); } while (0)
    unsigned char* ws = F.ws;
    STAMP(0);
    if (IN(0)) { p0_prologue(F, args); } SEAM(0);
    if (IN(1)) { p1_norm(F, args); } SEAM(1);
    if (IN(2)) {
        SchedP2 S{F.G, F.bid, (const char*)F.out, (const char*)(ws + WS_WIN), (char*)(ws + WS_P), (char*)(ws + WS_PC)};
        EpiStoreBf16 E;
        gm::gemm_phase<SchedP2, EpiStoreBf16, false>(F.lds, DM, S, E);
    } SEAM(2);
    if (IN(3)) { p_mix1(F, args); } SEAM(3);
    if (IN(4)) { p_mix2(F, args); } SEAM(4);
    if (IN(5)) { p_ybg(F, args); p_moe_weights(F, args);
#if defined(REP_MOEW)
        __syncthreads(); p_moe_weights(F, args);
#endif
    } SEAM(5);
    if (IN(6)) {
        SchedP5 S{F.bid, (const char*)(ws + WS_YAG), (const char*)(ws + WS_YBG), (const char*)(ws + WS_WPA), (const char*)(ws + WS_WPB), nullptr, (char*)(ws + WS_M)};
        EpiP5 E{F.out + (size_t)F.bid * 65536, (const bf16*)(ws + WS_P + 7 * GS), (const bf16*)(ws + WS_P + 8 * GS)};
        gm::gemm_phase<SchedP5, EpiP5, false>(F.lds, DM, S, E);
    } SEAM(6);
    if (IN(7)) {
        SchedP6 S{F.bid, (const char*)(ws + WS_M), (const char*)(ws + WS_WOUT), (char*)F.out};
        EpiP6 E{args.in[IN_X], (const float*)(ws + WS_MOD)};
        gm::gemm_phase<SchedP6, EpiP6, false>(F.lds, DM, S, E);
    } SEAM(7);
    if (IN(8)) { p_norm2_route(F, args); } SEAM(8);
    if (IN(9)) {
        moe_table(F, (const int*)(F.ctl + CW_CNT));
        SchedMoe1 S{F.G, F.bid, F.lane, F.MISC, (const int*)(ws + WS_LIST), (const char*)(ws + WS_HX2), (const char*)(ws + WS_W1T), (const char*)(ws + WS_W3T), (char*)(ws + WS_HH)};
        EpiMoe1 E;
        gm::gemm_phase<SchedMoe1, EpiMoe1, true>(F.lds, DM, S, E);
    } SEAM(9);
    if (IN(10)) {
        moe_table(F, (const int*)(F.ctl + CW_CNT));
        SchedMoe2 S{F.G, F.bid, F.lane, F.MISC, (const char*)(ws + WS_HH), (const char*)(ws + WS_W2T), (char*)(ws + WS_Y)};
        EpiMoe2 E{(const int*)(ws + WS_LIST)};
        gm::gemm_phase<SchedMoe2, EpiMoe2, false>(F.lds, DEXP, S, E);
    } SEAM(10);
    if (IN(11)) { p_final(F, args); }
#ifdef PROBE_A
    if (F.bid == 0 && F.tid == 0) {
        const unsigned long long tend = __builtin_amdgcn_s_memrealtime();
        F.MISC[32 + 2 * 12] = (unsigned)tend; F.MISC[33 + 2 * 12] = (unsigned)(tend >> 32);
        auto RD = [&](int k) { return ((unsigned long long)F.MISC[33 + 2 * k] << 32) | F.MISC[32 + 2 * k]; };
        auto T = [&](int k) { if (k >= 20) { const int i = k - 20; return (unsigned long long)(((((unsigned long long)F.MISC[103 + 2 * i] << 32) | F.MISC[102 + 2 * i]) + 400) / 800); } if (k == 13) return (unsigned long long)((RD(14) - RD(3) + 400) / 800); if (k == 15) return (unsigned long long)((RD(16) - RD(4) + 400) / 800); const unsigned long long t0 = ((unsigned long long)F.MISC[33 + 2 * k] << 32) | F.MISC[32 + 2 * k], t1 = ((unsigned long long)F.MISC[33 + 2 * (k + 1)] << 32) | F.MISC[32 + 2 * (k + 1)]; return (unsigned long long)((t1 - t0 + 400) / 800); };
        const unsigned long long delay = (T(PROBE_A) + 64ull * T(PROBE_B)) * 6400ull;
        while (__builtin_amdgcn_s_memrealtime() - tend < delay) __builtin_amdgcn_s_sleep(32);
    }
#endif
#undef IN
#undef SEAM
}

#if !LRU_FAST
__global__ void k_conv_f(const bf16* P0, const bf16* PC0, const float* cw, const float* cb, float* Ub, int b) {
    int t = blockIdx.x; int Lseg = t < CTX ? CTX : SEQ; int lt = t < CTX ? t : t - CTX;
    const bf16* base = t < CTX ? PC0 + (size_t)b * CTX * DM : P0 + (size_t)b * SEQ * DM;
    for (int ch = threadIdx.x; ch < DM; ch += 256) {
        float s = cb[ch];
#pragma unroll
        for (int k = 0; k < 4; ++k) { int tt = lt + k - 2; if (tt >= 0 && tt < Lseg) s += cw[k * DM + ch] * bf2f(base[(size_t)tt * DM + ch]); }
        Ub[(size_t)t * DM + ch] = s;
    }
}
__global__ void k_gates(const float* Ub, const float* wa, const float* ba, const float* wx, const float* bx, const float* lam, float* Aout, float* Bout, int d) {
    __shared__ float us[128];
    int t = blockIdx.x, h = blockIdx.y, j = threadIdx.x; int ch = h * 128 + j;
    float uval = Ub[(size_t)t * DM + ch];
    us[j] = uval; __syncthreads();
    const float* wah = wa + ((size_t)(d * 8 + h) * 128) * 128; const float* wxh = wx + ((size_t)(d * 8 + h) * 128) * 128;
    float ra = 0.f, ia = 0.f;
    for (int i = 0; i < 128; ++i) { float u = us[i]; ra += u * wah[i * 128 + j]; ia += u * wxh[i * 128 + j]; }
    float r = 1.f / (1.f + expf(-(ra + ba[d * DM + ch]))); float ig = 1.f / (1.f + expf(-(ia + bx[d * DM + ch])));
    float sp = log1pf(expf(-lam[d * DM + ch]));
    float log_a = -8.f * r * sp;
    Aout[(size_t)t * DM + ch] = expf(log_a); Bout[(size_t)t * DM + ch] = sqrtf(-expm1f(2.f * log_a)) * (ig * uval);
}
__global__ void k_lru_scan(const float* A0, const float* B0, const float* A1, const float* B1, float* YF, float* YB) {
    int g = blockIdx.x * 256 + threadIdx.x; int d = g / DM, ch = g % DM;
    if (d == 0) { float h = B0[ch];
        for (int t = 0; t < SEQ; ++t) { size_t o = (size_t)(CTX + t) * DM + ch; h = A0[o] * h + B0[o]; YF[(size_t)t * DM + ch] = h; }
    } else { float h = B1[(size_t)(CTX - 1) * DM + ch];
        for (int t = SEQ - 1; t >= 0; --t) { size_t o = (size_t)(CTX + t) * DM + ch; h = A1[o] * h + B1[o]; YB[(size_t)t * DM + ch] = h; }
    }
}
__global__ void k_yag_f(const float* YF, const float* YB, bf16* AY, int b) {
    int t = blockIdx.x;
    for (int ch = threadIdx.x; ch < DM; ch += 256) { size_t o = (size_t)t * DM + ch; bf16* p = AY + ((size_t)b * SEQ + t) * DM + ch;
        *p = (bf16)f2bf((YF[o] + YB[o]) * gelu_tanh(bf2f(*p))); }
}
#endif
#if !HG_FAST
__global__ __launch_bounds__(128) void k_hgrn_f(unsigned char* ws, const float* hg_lb) {
    __shared__ float gs[128], ks[128], qs[128];
    int h = blockIdx.x, d = blockIdx.y, b = blockIdx.z, j = threadIdx.x;
    float S[128];
#pragma unroll
    for (int i = 0; i < 128; ++i) S[i] = 0.f;
    const int c = h * 128 + j;
    const float lbj = 1.f / (1.f + expf(hg_lb[DM + c] - hg_lb[c]));
    bf16* Q = (bf16*)(ws + WS_P + 2 * GS); bf16* Fx = (bf16*)(ws + WS_P + (d == 0 ? 3 : 4) * GS); bf16* V = (bf16*)(ws + WS_P + 5 * GS);
    const bf16* Fc = (const bf16*)(ws + WS_PC + (d == 0 ? 1 : 2) * CGS); const bf16* Vc = (const bf16*)(ws + WS_PC + 3 * CGS);
    for (int s = 0; s < LT; ++s) {
        bool isx = s >= CTX; float fv, vv, qv = 0.f; size_t o;
        if (!isx) { int t = d == 0 ? s : (CTX - 1 - s); o = ((size_t)b * CTX + t) * DM + c; fv = bf2f(Fc[o]); vv = bf2f(Vc[o]); }
        else { int p = s - CTX; if (d == 1) p = SEQ - 1 - p; int tok = (p % 32) * 64 + (p / 32); o = ((size_t)b * SEQ + tok) * DM + c; fv = bf2f(Fx[o]); vv = bf2f(V[o]); qv = bf2f(Q[o]); }
        float gg = lbj + (1.f - lbj) / (1.f + expf(-fv));
        gs[j] = gg; ks[j] = 1.f - gg; qs[j] = qv / (1.f + expf(-qv));
        __syncthreads();
        float oo = 0.f;
#pragma unroll
        for (int i = 0; i < 128; ++i) { S[i] = gs[i] * S[i] + ks[i] * vv; oo += S[i] * qs[i]; }
        if (isx) Fx[o] = (bf16)f2bf(oo);
        __syncthreads();
    }
}
#endif

extern "C" void kernel_launch(void* const* d_in, const int* in_sizes, int n_in, void* d_out, int out_size, void* d_ws, size_t ws_size, hipStream_t stream) {
    static int grid = 0;
    if (grid == 0) {
        if (n_in != 29 || out_size != NTOK * DM || ws_size < WS_END) { fprintf(stderr, "kernel_launch: unexpected problem shape / workspace (%d inputs, out %d, ws %zu)\n", n_in, out_size, ws_size); grid = -1; return; }
        int dev = 0, cus = 0, per_cu = 0;
        if (hipGetDevice(&dev) != hipSuccess || hipDeviceGetAttribute(&cus, hipDeviceAttributeMultiprocessorCount, dev) != hipSuccess) { grid = -1; return; }
        if (hipFuncSetAttribute((const void*)mega, hipFuncAttributeMaxDynamicSharedMemorySize, LDS_BYTES) != hipSuccess) { grid = -1; return; }
        if (hipOccupancyMaxActiveBlocksPerMultiprocessor(&per_cu, (const void*)mega, NTHR, LDS_BYTES) != hipSuccess || per_cu < 1) { fprintf(stderr, "kernel_launch: occupancy query says %d blocks per CU\n", per_cu); }
        (void)hipGetLastError();
        grid = cus;
        if (grid != 256) { fprintf(stderr, "kernel_launch: built for 256 CUs, found %d\n", cus); grid = -1; return; }
    }
    if (grid < 0) return;
    hipMemsetAsync((char*)d_ws + WS_CTL, 0, CTL_BYTES, stream);
    Args a{};
    for (int i = 0; i < 29; ++i) a.in[i] = (const float*)d_in[i];
    a.out = (float*)d_out; a.ws = (unsigned char*)d_ws;
#if MIX_FAST
    a.ph_lo = 0; a.ph_hi = 12; a.li = 0;
    hipLaunchKernelGGL(mega, dim3(grid), dim3(NTHR), LDS_BYTES, stream, a);
#else
    a.ph_lo = 0; a.ph_hi = 5; a.li = 0;
    hipLaunchKernelGGL(mega, dim3(grid), dim3(NTHR), LDS_BYTES, stream, a);
    {
        unsigned char* ws = (unsigned char*)d_ws;
#if !LRU_FAST
        float* sc = (float*)d_out;
        float* Ub = sc; float* A0 = Ub + (size_t)LT * DM; float* B0 = A0 + (size_t)LT * DM; float* A1 = B0 + (size_t)LT * DM; float* B1 = A1 + (size_t)LT * DM;
        float* YF = B1 + (size_t)LT * DM; float* YB = YF + (size_t)SEQ * DM;
        const float* cw = (const float*)d_in[IN_CONVW]; const float* cb = (const float*)d_in[IN_CONVB];
        const float* wa = (const float*)d_in[IN_WA]; const float* ba = (const float*)d_in[IN_BA]; const float* wx = (const float*)d_in[IN_WX]; const float* bx = (const float*)d_in[IN_BX]; const float* lam = (const float*)d_in[IN_LAM];
        for (int b = 0; b < NB; ++b) {
            k_conv_f<<<LT, 256, 0, stream>>>((const bf16*)(ws + WS_P), (const bf16*)(ws + WS_PC), cw, cb, Ub, b);
            k_gates<<<dim3(LT, 8), 128, 0, stream>>>(Ub, wa, ba, wx, bx, lam, A0, B0, 0);
            k_gates<<<dim3(LT, 8), 128, 0, stream>>>(Ub, wa, ba, wx, bx, lam, A1, B1, 1);
            k_lru_scan<<<8, 256, 0, stream>>>(A0, B0, A1, B1, YF, YB);
            k_yag_f<<<SEQ, 256, 0, stream>>>(YF, YB, (bf16*)(ws + WS_YAG), b);
        }
#endif
#if !HG_FAST
        k_hgrn_f<<<dim3(8, 2, NB), 128, 0, stream>>>(ws, (const float*)d_in[IN_HGLB]);
#endif
    }
    a.ph_lo = 5; a.ph_hi = 12; a.li = 1;
    hipLaunchKernelGGL(mega, dim3(grid), dim3(NTHR), LDS_BYTES, stream, a);
#endif
}
```

```cpp
#include <hip/hip_runtime.h>
#include <cstdio>
#include <cstdint>
#include <math.h>

#define LAS __attribute__((address_space(3)))
#define GAS __attribute__((address_space(1)))
typedef unsigned short bf16;
typedef short bf16x8 __attribute__((ext_vector_type(8)));
typedef float f32x4 __attribute__((ext_vector_type(4)));
typedef float f32x2 __attribute__((ext_vector_type(2)));
typedef unsigned u32x4 __attribute__((ext_vector_type(4)));
typedef unsigned u32x2 __attribute__((ext_vector_type(2)));

constexpr int DM = 1024, NB = 8, SEQ = 2048, CTX = 256, NTOK = NB * SEQ, NCTX = NB * CTX, INW = 9216, LT = CTX + SEQ;
constexpr int NEXP = 32, DEXP = 512, CAP = 16384;
constexpr float EPS = 1e-6f;
constexpr int NWAVES = 8, NTHR = 512;

constexpr size_t MiB = 1u << 20, KiB = 1024;
constexpr size_t WS_CTL = 0, CTL_BYTES = 64 * KiB;
constexpr size_t WS_MODP = 256 * KiB;
constexpr size_t WS_MOD = 2 * MiB;
constexpr size_t WS_LRUAGG = 2 * MiB + 512 * KiB;
constexpr size_t WS_LRUS0 = 4 * MiB + 512 * KiB;
constexpr size_t WS_WT = 4 * MiB + 768 * KiB;
constexpr size_t WS_LIST = 5 * MiB;
constexpr size_t WS_HGD = 7 * MiB;
constexpr size_t WS_WRT = 7 * MiB + 256 * KiB;
constexpr size_t WS_WIN = 8 * MiB;
constexpr size_t WS_WPA = 26 * MiB, WS_WPB = 28 * MiB, WS_WOUT = 30 * MiB;
constexpr size_t WS_WLRU = 32 * MiB;
constexpr size_t WS_P = 33 * MiB, GS = 32 * MiB;
constexpr size_t WS_PC = 321 * MiB, CGS = 4 * MiB;
constexpr size_t WS_END = 337 * MiB;
constexpr size_t WS_W1T = WS_P + 0 * GS, WS_W3T = WS_P + 2 * GS, WS_W2T = WS_P + 5 * GS;
constexpr size_t WS_YAG = WS_P + 1 * GS;
constexpr size_t WS_OF = WS_P + 3 * GS, WS_OB = WS_P + 4 * GS;
constexpr size_t WS_YBG = WS_P + 3 * GS;
constexpr size_t WS_M = WS_P + 4 * GS;
constexpr size_t WS_HX2 = WS_P + 1 * GS;
constexpr size_t WS_HH = WS_P + 3 * GS;
constexpr size_t WS_Y = WS_P + 6 * GS;

constexpr int CW_BAR = 1024;
constexpr int CW_CNT = 12288;
constexpr int CW_TILE = 14336;

constexpr int RING_BYTES = 131072, LDS_BYTES = 147456, LDSCTL_OFF = LDS_BYTES - 1024;

#define LDS_WAIT() asm volatile("s_waitcnt lgkmcnt(0)" ::: "memory")
#define VM_WAIT() asm volatile("s_waitcnt vmcnt(0)" ::: "memory")

typedef __bf16 bf16x2_t __attribute__((ext_vector_type(2)));
__device__ __forceinline__ unsigned pk2(float lo, float hi) { const f32x2 v = {lo, hi}; return __builtin_bit_cast(unsigned, __builtin_convertvector(v, bf16x2_t)); }
__device__ __forceinline__ unsigned f2bf(float f) { return pk2(f, 0.f) & 0xffffu; }
__device__ __forceinline__ float bf2f(unsigned short b) { return __builtin_bit_cast(float, (unsigned)b << 16); }
__device__ __forceinline__ float bflo(unsigned w) { return __builtin_bit_cast(float, w << 16); }
__device__ __forceinline__ float bfhi(unsigned w) { return __builtin_bit_cast(float, w & 0xffff0000u); }
__device__ __forceinline__ float sigmoidf_(float x) { return 1.f / (1.f + __expf(-x)); }
__device__ __forceinline__ float siluf_(float x) { return x / (1.f + __expf(-x)); }
__device__ __forceinline__ float gelu_tanh(float x) { float u = 0.7978845608028654f * (x + 0.044715f * x * x * x); float e = __expf(2.f * u); return x * (1.f - 1.f / (1.f + e)); }
__device__ __forceinline__ float wave_sum(float v) {
#pragma unroll
    for (int o = 1; o < 64; o <<= 1) v += __shfl_xor(v, o);
    return v;
}

#define XB_TMO      128
#define XB_XCNT(j)  (256  + 64 * (j))
#define XB_XSUB(j)  (1280 + 64 * (j))
#define XB_XGEN(j)  (2304 + 64 * (j))
#define XB_TOP      3328
#define XB_TOPGEN   3392
#define XCD_BAR_WORDS 3456
#define XB_SPIN_CAP (1u << 20)
__device__ __forceinline__ unsigned xb_ld(unsigned* p)              { return __hip_atomic_load(p, __ATOMIC_RELAXED, __HIP_MEMORY_SCOPE_AGENT); }
__device__ __forceinline__ unsigned xb_add(unsigned* p, unsigned v) { return __hip_atomic_fetch_add(p, v, __ATOMIC_RELAXED, __HIP_MEMORY_SCOPE_AGENT); }
__device__ __forceinline__ unsigned xb_xcc_id() { return (unsigned)__builtin_amdgcn_s_getreg((3 << 11) | 20) & 0xFu; }
#define XB_SPIN(cond, bar) do { unsigned _sp = 0; while (cond) { __builtin_amdgcn_s_sleep(1); \
    if ((++_sp & 255u) == 0u) { if (xb_ld(&(bar)[XB_TMO])) break; if (_sp > XB_SPIN_CAP) { atomicAdd(&(bar)[XB_TMO], 1u); break; } } } } while (0)
struct XcdBarrier { unsigned* bar; unsigned x; volatile LAS unsigned* st; };
__device__ __forceinline__ XcdBarrier xcd_barrier_post(unsigned* bar, volatile LAS unsigned* st) {
    XcdBarrier b; b.bar = bar; b.x = xb_xcc_id(); b.st = st;
    if (threadIdx.x == 0) (void)xb_add(&bar[XB_XCNT(b.x)], 1u);
    return b;
}
__device__ __forceinline__ void xcd_barrier_complete(unsigned* bar, unsigned x, unsigned& nloc, unsigned& nx) {
    const unsigned G = gridDim.x * gridDim.y * gridDim.z;
    unsigned sum, cnt, mine, sp = 0u;
    for (;;) {
        sum = 0u; cnt = 0u; mine = 0u;
#pragma unroll
        for (unsigned j = 0; j < 16; ++j) { const unsigned c = xb_ld(&bar[XB_XCNT(j)]); sum += c; cnt += (c > 0u) ? 1u : 0u; mine = (j == x) ? c : mine; }
        if (sum == G) break;
        __builtin_amdgcn_s_sleep(1);
        if ((++sp & 255u) == 0u) { if (xb_ld(&bar[XB_TMO])) break; if (sp > XB_SPIN_CAP) { atomicAdd(&bar[XB_TMO], 1u); break; } }
    }
    nloc = mine > 0u ? mine : 1u; nx = cnt > 0u ? cnt : 1u;
}
__device__ __forceinline__ void xcd_barrier(const XcdBarrier& b) {
    asm volatile("s_waitcnt vmcnt(0)" ::: "memory");
    __syncthreads();
    if (threadIdx.x == 0) {
        unsigned* bar = b.bar;
        __builtin_amdgcn_s_waitcnt(0);
        unsigned nloc = b.st[0], nx = b.st[1];
        if (nloc == 0u) { xcd_barrier_complete(bar, b.x, nloc, nx); b.st[0] = nloc; b.st[1] = nx; }
        const unsigned old = xb_add(&bar[XB_XSUB(b.x)], 1u);
        const unsigned gen = old / nloc;
        if (old + 1u == (gen + 1u) * nloc) {
            __builtin_amdgcn_fence(__ATOMIC_RELEASE, "agent");
            asm volatile("s_waitcnt vmcnt(0)" ::: "memory");
            const unsigned og = xb_add(&bar[XB_TOP], 1u);
            const unsigned tg = og / nx;
            if (og + 1u == (tg + 1u) * nx) xb_add(&bar[XB_TOPGEN], 1u);
            else XB_SPIN(xb_ld(&bar[XB_TOPGEN]) == tg, bar);
            __builtin_amdgcn_fence(__ATOMIC_ACQUIRE, "agent");
            xb_add(&bar[XB_XGEN(b.x)], 1u);
            asm volatile("s_waitcnt vmcnt(0)" ::: "memory");
        } else {
            XB_SPIN(xb_ld(&bar[XB_XGEN(b.x)]) == gen, bar);
            __builtin_amdgcn_fence(__ATOMIC_ACQUIRE, "agent");
            asm volatile("s_waitcnt vmcnt(0)" ::: "memory");
        }
    }
    __syncthreads();
}

namespace gm {
constexpr int BM = 256, BK = 64, HALF = 128, HTB = HALF * BK * 2;
__device__ __forceinline__ int lds_byte(int r, int c) { const int st = (r >> 4) * 2 + (c >> 5), rr = r & 15, cc = c & 31, ob = rr * 64 + cc * 2; return st * 1024 + (ob ^ (((ob >> 9) & 1) << 5)); }
__device__ __forceinline__ void stage_rc(int b, int& R, int& C) { const int st = b / 1024, sb = b % 1024, swz = sb ^ (((sb >> 9) & 1) << 5); R = (st >> 1) * 16 + swz / 64; C = (st & 1) * 32 + (swz % 64) / 2; }
__device__ __forceinline__ int perm32(int rho) { const int n = rho >> 4, i = rho & 15; return 8 * (i >> 2) + 4 * n + (i & 3); }
__device__ __forceinline__ unsigned cvt_pk_bf16(float lo, float hi) { unsigned r; asm volatile("v_cvt_pk_bf16_f32 %0, %1, %2" : "=v"(r) : "v"(lo), "v"(hi)); return r; }

struct Unit { const char* A; const char* B0; const char* B1; char* dst; int pm, pn, e, rows, t; };

template <class Sched, class Epi, bool GATHER, bool HOOKS = false>
__device__ __forceinline__ void gemm_phase(LAS unsigned char* lds, const int K, const Sched& S, const Epi& E) {
    const int tid = threadIdx.x, wid = __builtin_amdgcn_readfirstlane(tid >> 6), lane = tid & 63, wr = wid >> 2, wc = wid & 3, fr = lane & 15, fq = lane >> 4;
    const int nt = K / BK;
    unsigned voffB[2]; int Rr[2]; unsigned Cb[2];
#pragma unroll
    for (int i = 0; i < 2; ++i) { int R, C; stage_rc(tid * 16 + i * 8192, R, C); const int Rb = Epi::PERM ? ((R & ~31) + perm32(R & 31)) : R;
        Rr[i] = R; Cb[i] = (unsigned)C * 2u; voffB[i] = (unsigned)(Rb * K + C) * 2u; }
    const unsigned rowb = (unsigned)K * 2u;
    const size_t kstep = (size_t)(BK * 2);
    const unsigned ldsw = (unsigned)wid * 1024u;
    const int aoff = lds_byte(wr * 64 + fr, fq * 8), boff = lds_byte(wc * 32 + fr, fq * 8);
#define GM_SA(b, h) (((b) * 2 + (h)) * HTB)
#define GM_SB(b, h) ((4 + (b) * 2 + (h)) * HTB)
#define GM_STAGE(bufoff, gbase, voff) do { _Pragma("unroll") for (int _i = 0; _i < 2; ++_i) \
        __builtin_amdgcn_global_load_lds((const unsigned*)((const char*)(gbase) + (voff)[_i]), (LAS unsigned*)(lds + (bufoff) + ldsw + _i * 8192), 16, 0, 0); } while (0)
#define GM_LDA(dst, b, h) do { _Pragma("unroll") for (int m = 0; m < 4; ++m) _Pragma("unroll") for (int k = 0; k < 2; ++k) dst[m][k] = *(const LAS bf16x8*)(lds + GM_SA(b, h) + aoff + m * 2048 + k * 1024); } while (0)
#define GM_LDB(dst, b, h) do { _Pragma("unroll") for (int n = 0; n < 2; ++n) _Pragma("unroll") for (int k = 0; k < 2; ++k) dst[n][k] = *(const LAS bf16x8*)(lds + GM_SB(b, h) + boff + n * 2048 + k * 1024); } while (0)
#define GM_MMA(ai, bj, At, Bt) do { __builtin_amdgcn_s_setprio(1); _Pragma("unroll") for (int m = 0; m < 4; ++m) _Pragma("unroll") for (int n = 0; n < 2; ++n) _Pragma("unroll") for (int k = 0; k < 2; ++k) \
        acc[ai][bj][m][n] = __builtin_amdgcn_mfma_f32_16x16x32_bf16(Bt[n][k], At[m][k], acc[ai][bj][m][n], 0, 0, 0); __builtin_amdgcn_s_setprio(0); } while (0)
#define GM_WAIT_V(n) asm volatile("s_waitcnt vmcnt(" #n ")" ::: "memory")
#define GM_WAIT_L(n) asm volatile("s_waitcnt lgkmcnt(" #n ")" ::: "memory")
#define GM_BAR __builtin_amdgcn_s_barrier()
#define GM_SCHED __builtin_amdgcn_sched_barrier(0)
#define GM_AOFFS(u, o) do { _Pragma("unroll") for (int _h = 0; _h < 2; ++_h) _Pragma("unroll") for (int _i = 0; _i < 2; ++_i) \
        (o)[_h][_i] = (GATHER ? S.arow((u), _h * HALF + Rr[_i]) : (unsigned)(_h * HALF + Rr[_i])) * rowb + Cb[_i]; } while (0)
    Unit cur, nxt; int ui = 0;
    if (!S.next(0, cur)) return;
    f32x4 acc[2][2][4][2];
#pragma unroll
    for (int a = 0; a < 2; ++a)
#pragma unroll
        for (int b = 0; b < 2; ++b)
#pragma unroll
            for (int m = 0; m < 4; ++m)
#pragma unroll
                for (int n = 0; n < 2; ++n) acc[a][b][m][n] = (f32x4){0.f, 0.f, 0.f, 0.f};
    bf16x8 At[4][2], B0[2][2], B1[2][2];
    unsigned ca[2][2], na[2][2];
    GM_AOFFS(cur, ca);
    const char* cA = cur.A; const char* cB0 = cur.B0; const char* cB1 = cur.B1;
    if constexpr (HOOKS) S.a_ready(cur);
    GM_STAGE(GM_SB(0, 0), cB0, voffB); GM_STAGE(GM_SB(0, 1), cB1, voffB); GM_STAGE(GM_SA(0, 0), cA, ca[0]); GM_STAGE(GM_SA(0, 1), cA, ca[1]);
    if (wr == 1) GM_BAR;
    GM_WAIT_V(2); GM_BAR;
    GM_STAGE(GM_SB(1, 0), cB0 + kstep, voffB); GM_STAGE(GM_SA(1, 0), cA + kstep, ca[0]); GM_STAGE(GM_SB(1, 1), cB1 + kstep, voffB);
    GM_WAIT_V(6); GM_BAR;
    for (;;) {
        const bool has_next = S.next(ui + 1, nxt);
        const char* nA = has_next ? nxt.A : cA; const char* nB0 = has_next ? nxt.B0 : cB0; const char* nB1 = has_next ? nxt.B1 : cB1;
        if (has_next) { GM_AOFFS(nxt, na); } else {
#pragma unroll
            for (int h = 0; h < 2; ++h)
#pragma unroll
                for (int i = 0; i < 2; ++i) na[h][i] = ca[h][i]; }
        for (int t = 0; t < nt; t += 2) {
            const bool last = (t == nt - 2);
            if constexpr (HOOKS) { if (last && has_next) S.a_ready(nxt); }
            const char* a1 = cA + (size_t)(t + 1) * kstep;
            const char* a2 = last ? nA : cA + (size_t)(t + 2) * kstep;
            const char* b20 = last ? nB0 : cB0 + (size_t)(t + 2) * kstep; const char* b21 = last ? nB1 : cB1 + (size_t)(t + 2) * kstep;
            const char* a3 = a2 + kstep; const char* b30 = b20 + kstep; const char* b31 = b21 + kstep;
            unsigned o2[2][2];
#pragma unroll
            for (int h = 0; h < 2; ++h)
#pragma unroll
                for (int i = 0; i < 2; ++i) o2[h][i] = last ? na[h][i] : ca[h][i];
            GM_LDB(B0, 0, 0); GM_LDB(B1, 0, 1); GM_SCHED; GM_LDA(At, 0, 0); GM_STAGE(GM_SA(1, 1), a1, ca[1]);
            GM_WAIT_V(8); GM_WAIT_L(0); GM_BAR; GM_MMA(0, 0, At, B0); GM_MMA(0, 1, At, B1); GM_BAR; GM_SCHED;
            GM_LDA(At, 0, 1); GM_STAGE(GM_SB(0, 0), b20, voffB); GM_STAGE(GM_SB(0, 1), b21, voffB); GM_STAGE(GM_SA(0, 0), a2, o2[0]);
            GM_WAIT_V(8); GM_WAIT_L(0); GM_BAR; GM_MMA(1, 0, At, B0); GM_MMA(1, 1, At, B1); GM_BAR; GM_SCHED;
            GM_LDB(B0, 1, 0); GM_LDB(B1, 1, 1); GM_SCHED; GM_LDA(At, 1, 0); GM_STAGE(GM_SA(0, 1), a2, o2[1]);
            GM_WAIT_V(8); GM_WAIT_L(0); GM_BAR; GM_MMA(0, 0, At, B0); GM_MMA(0, 1, At, B1); GM_BAR; GM_SCHED;
            GM_LDA(At, 1, 1); GM_STAGE(GM_SB(1, 0), b30, voffB); GM_STAGE(GM_SB(1, 1), b31, voffB); GM_STAGE(GM_SA(1, 0), a3, o2[0]);
            GM_WAIT_V(8); GM_WAIT_L(0); GM_BAR; GM_MMA(1, 0, At, B0); GM_MMA(1, 1, At, B1); GM_BAR; GM_SCHED;
        }
        if (wr == 0) GM_BAR;
        E(acc, cur, wr, wc, fr, fq);
        if constexpr (HOOKS) S.done(cur);
        if (!has_next) break;
#pragma unroll
        for (int a = 0; a < 2; ++a)
#pragma unroll
            for (int b = 0; b < 2; ++b)
#pragma unroll
                for (int m = 0; m < 4; ++m)
#pragma unroll
                    for (int n = 0; n < 2; ++n) acc[a][b][m][n] = (f32x4){0.f, 0.f, 0.f, 0.f};
        cur = nxt; cA = nA; cB0 = nB0; cB1 = nB1; ++ui;
#pragma unroll
        for (int h = 0; h < 2; ++h)
#pragma unroll
            for (int i = 0; i < 2; ++i) ca[h][i] = na[h][i];
        if (wr == 1) GM_BAR;
    }
    GM_WAIT_V(0);
    GM_BAR;
#undef GM_SA
#undef GM_SB
#undef GM_STAGE
#undef GM_LDA
#undef GM_LDB
#undef GM_MMA
#undef GM_WAIT_V
#undef GM_WAIT_L
#undef GM_BAR
#undef GM_SCHED
#undef GM_AOFFS
}
}
struct Args {
    const float* in[29]; float* out; unsigned char* ws; int ph_lo, ph_hi, li, pad;
};
struct Frame {
    LAS unsigned char* lds; volatile LAS unsigned* MISC;
    unsigned* ctl; unsigned char* ws; float* out;
    int tid, lane, wave, G, bid;
};
enum { IN_X = 0, IN_C, IN_CTX, IN_CCTX, IN_WMOD, IN_BMOD, IN_G1, IN_WIN, IN_CONVW, IN_CONVB, IN_WA, IN_BA, IN_WX, IN_BX, IN_LAM, IN_HGLB, IN_HGN,
       IN_WPA, IN_WPB, IN_WOUT, IN_G2, IN_WRG, IN_BRG, IN_WRE, IN_BRE, IN_W1, IN_W3, IN_W2, IN_FG };

constexpr int TR_BYTES = 64 * 64 * 4;
__device__ __forceinline__ void transpose_item(const float* W, int ldw, int K, bf16* WT, int k0, int n0, LAS float* scr, int lane) {
    const int lr = lane >> 4, ls = lane & 15;
    f32x4 v[16];
#pragma unroll
    for (int i = 0; i < 16; ++i) v[i] = *(const f32x4*)(W + (size_t)(k0 + 4 * i + lr) * ldw + n0 + 4 * ls);
#pragma unroll
    for (int i = 0; i < 16; ++i) { const int k = 4 * i + lr; *(LAS f32x4*)(scr + k * 64 + ((ls ^ ((k >> 3) & 7)) << 2)) = v[i]; }
    LDS_WAIT(); asm volatile("" ::: "memory");
    const int c = lane & 7;
#pragma unroll
    for (int j = 0; j < 8; ++j) { const int n = (lane >> 3) + 8 * j; const LAS float* s = scr + (8 * c) * 64 + ((((n >> 2) ^ c) << 2) | (n & 3));
        u32x4 o; o.x = pk2(s[0 * 64], s[1 * 64]); o.y = pk2(s[2 * 64], s[3 * 64]); o.z = pk2(s[4 * 64], s[5 * 64]); o.w = pk2(s[6 * 64], s[7 * 64]);
        *(u32x4*)(WT + (size_t)n * K + k0 + 8 * c) = o; }
    LDS_WAIT(); asm volatile("" ::: "memory");
}

__device__ __forceinline__ void p0_mod_item(Frame& F, const Args& a, int item) {
    const int cb = item % 24, ks = item / 24;
    LAS float* sv = (LAS float*)F.lds;
    LAS float* red = sv + 9 * 128;
    const float* c = a.in[IN_C]; const float* cc = a.in[IN_CCTX]; const float* wmod = a.in[IN_WMOD];
    for (int i = F.tid; i < 9 * 128; i += NTHR) { const int r = i >> 7, k = i & 127; const float v = r < 8 ? c[r * DM + ks * 128 + k] : cc[ks * 128 + k]; sv[i] = siluf_(v); }
    __syncthreads();
    const int col = cb * 256 + (F.tid & 255), kh = F.tid >> 8;
    float acc[9];
#pragma unroll
    for (int r = 0; r < 9; ++r) acc[r] = 0.f;
    for (int k = 0; k < 64; ++k) { const int kk = kh * 64 + k; const float w = wmod[(size_t)(ks * 128 + kk) * 6144 + col];
#pragma unroll
        for (int r = 0; r < 9; ++r) acc[r] += sv[r * 128 + kk] * w; }
    if (kh == 1) {
#pragma unroll
        for (int r = 0; r < 9; ++r) red[r * 256 + (F.tid & 255)] = acc[r]; }
    __syncthreads();
    float* modp = (float*)(F.ws + WS_MODP);
    if (kh == 0) {
#pragma unroll
        for (int r = 0; r < 9; ++r) modp[(size_t)(ks * 9 + r) * 6144 + col] = acc[r] + red[r * 256 + F.tid]; }
    __syncthreads();
}
__device__ __forceinline__ float mod_from_partials(const float* modp, const float* bmod, int row, int j) {
    float s = bmod[j];
#pragma unroll
    for (int ks = 0; ks < 8; ++ks) s += modp[(size_t)(ks * 9 + row) * 6144 + j];
    return s;
}

__device__ __forceinline__ void p0_prologue(Frame& F, const Args& a) {
    if (F.bid < 192) p0_mod_item(F, a, F.bid);
    LAS float* scr = (LAS float*)(F.lds + F.wave * TR_BYTES);
    const int gw = F.bid * NWAVES + F.wave, NGW = F.G * NWAVES;
    constexpr int I_IN = 16 * 144, I_PR = 16 * 16, I_LRU = 32 * 4;
    constexpr int NITEMS = I_IN + 3 * I_PR + I_LRU;
    for (int it = gw; it < NITEMS; it += NGW) {
        int r = it;
        if (r < I_IN) { const int kb = r / 144, nb = r % 144; transpose_item(a.in[IN_WIN], INW, DM, (bf16*)(F.ws + WS_WIN) + (size_t)(nb * 64) * DM, kb * 64, nb * 64, scr, F.lane); continue; } r -= I_IN;
        if (r < 3 * I_PR) { const int w = r / I_PR, q = r % I_PR, kb = q / 16, nb = q % 16;
            const float* W = a.in[w == 0 ? IN_WPA : (w == 1 ? IN_WPB : IN_WOUT)]; bf16* WT = (bf16*)(F.ws + (w == 0 ? WS_WPA : (w == 1 ? WS_WPB : WS_WOUT)));
            transpose_item(W, DM, DM, WT + (size_t)(nb * 64) * DM, kb * 64, nb * 64, scr, F.lane); continue; } r -= 3 * I_PR;
        { const int mat = r / 4, q = r % 4, kb = q / 2, nb = q % 2;
          const int which = mat >> 4, dh = mat & 15;
          const float* W = a.in[which == 0 ? IN_WA : IN_WX] + (size_t)dh * 128 * 128; bf16* WT = (bf16*)(F.ws + WS_WLRU) + (size_t)mat * 128 * 128;
          transpose_item(W, 128, 128, WT + (size_t)(nb * 64) * 128, kb * 64, nb * 64, scr, F.lane); }
    }
    float* wrp = (float*)(F.ws + WS_WRT);
    for (int i = F.bid * NTHR + F.tid; i < 49152 + 48; i += F.G * NTHR) {
        if (i < 49152) { const int j = i & 3, ln = (i >> 2) & 63, sc = i >> 8, c = sc % 3, s2 = sc / 3; const int k = 16 * s2 + 4 * (ln >> 4) + j, o = 16 * c + (ln & 15);
            wrp[i] = o < 4 ? a.in[IN_WRG][k * 4 + o] : (o < 36 ? a.in[IN_WRE][k * 32 + (o - 4)] : 0.f); }
        else { const int o = i - 49152; wrp[i] = o < 4 ? a.in[IN_BRG][o] : (o < 36 ? a.in[IN_BRE][o - 4] : 0.f); }
    }
}

__device__ __forceinline__ void norm_rows(Frame& F, const float* src, bf16* dst, int row0, int nrows, const LAS float* gs, const LAS float* sh) {
    for (int r = F.wave; r < nrows; r += NWAVES) {
        const f32x4* xr = (const f32x4*)(src + (size_t)(row0 + r) * DM) + F.lane;
        f32x4 v[4]; float s = 0.f;
#pragma unroll
        for (int j = 0; j < 4; ++j) { v[j] = xr[64 * j]; s += (v[j].x * v[j].x + v[j].y * v[j].y) + (v[j].z * v[j].z + v[j].w * v[j].w); }
        const float rstd = rsqrtf(wave_sum(s) * (1.f / DM) + EPS);
        unsigned long long* o8 = (unsigned long long*)(dst + (size_t)(row0 + r) * DM) + F.lane;
#pragma unroll
        for (int j = 0; j < 4; ++j) { const int k = 4 * F.lane + 256 * j;
            const f32x4 g = *(const LAS f32x4*)(gs + k), h = *(const LAS f32x4*)(sh + k);
            const float o0 = v[j].x * rstd * g.x + h.x, o1 = v[j].y * rstd * g.y + h.y, o2 = v[j].z * rstd * g.z + h.z, o3 = v[j].w * rstd * g.w + h.w;
            o8[64 * j] = (unsigned long long)pk2(o0, o1) | ((unsigned long long)pk2(o2, o3) << 32); }
    }
}
__device__ __forceinline__ void p1_norm(Frame& F, const Args& a) {
    const float* modp = (const float*)(F.ws + WS_MODP); const float* bmod = a.in[IN_BMOD]; const float* g1 = a.in[IN_G1];
    LAS float* gs = (LAS float*)F.lds; LAS float* sh = gs + DM;
    bf16* H = (bf16*)F.out;
    float* mod = (float*)(F.ws + WS_MOD);
    for (int i = F.bid * NTHR + F.tid; i < 9 * 6144; i += F.G * NTHR) mod[i] = mod_from_partials(modp, bmod, i / 6144, i % 6144);
    const int b = F.bid / 32;
    for (int k = F.tid; k < DM; k += NTHR) { gs[k] = g1[k] * (1.f + mod_from_partials(modp, bmod, b, DM + k)); sh[k] = mod_from_partials(modp, bmod, b, k); }
    __syncthreads();
    norm_rows(F, a.in[IN_X], H, F.bid * 64, 64, gs, sh);
    __syncthreads();
    for (int k = F.tid; k < DM; k += NTHR) { gs[k] = g1[k] * (1.f + mod_from_partials(modp, bmod, 8, DM + k)); sh[k] = mod_from_partials(modp, bmod, 8, k); }
    __syncthreads();
    norm_rows(F, a.in[IN_CTX], H + (size_t)NTOK * DM, F.bid * 8, 8, gs, sh);
    __syncthreads();
}

struct EpiStoreBf16 {
    static constexpr bool PERM = true;
    __device__ __forceinline__ void operator()(const f32x4 (&acc)[2][2][4][2], const gm::Unit& u, int wr, int wc, int fr, int fq) const {
        bf16* base = (bf16*)u.dst + (size_t)(wr * 64 + fr) * DM + wc * 32 + 8 * fq;
#pragma unroll
        for (int ai = 0; ai < 2; ++ai)
#pragma unroll
            for (int m = 0; m < 4; ++m) { bf16* rowp = base + (size_t)(ai * 128 + m * 16) * DM;
#pragma unroll
                for (int bj = 0; bj < 2; ++bj) { const f32x4 v0 = acc[ai][bj][m][0], v1 = acc[ai][bj][m][1];
                    u32x4 w; w.x = gm::cvt_pk_bf16(v0[0], v0[1]); w.y = gm::cvt_pk_bf16(v0[2], v0[3]); w.z = gm::cvt_pk_bf16(v1[0], v1[1]); w.w = gm::cvt_pk_bf16(v1[2], v1[3]);
                    *(u32x4*)(rowp + bj * 128) = w; } }
    }
};
__device__ __forceinline__ void tile_order(int L, int nM, int nN, int& pm, int& pn) {
    const int nwg = nM * nN; int wgid = L;
    { const int q = nwg / 8, r = nwg % 8, xcd = wgid % 8, off = wgid / 8; wgid = (xcd < r ? xcd * (q + 1) : r * (q + 1) + (xcd - r) * q) + off; }
    const int nig = 8 * nN, gid = wgid / nig, fm = gid * 8, gsz = (nM - fm) < 8 ? (nM - fm) : 8;
    pm = fm + ((wgid % nig) % gsz); pn = (wgid % nig) / gsz;
}
struct SchedP2 {
    int G, c; const char* H; const char* Wt; char* P; char* PC;
    __device__ __forceinline__ bool next(int i, gm::Unit& u) const {
        int L = i * G + c;
        if (L < 64 * 36) { int pm, pn; tile_order(L, 64, 36, pm, pn);
            u.A = H + (size_t)pm * 256 * 2048; u.B0 = Wt + (size_t)pn * 256 * 2048; u.B1 = u.B0 + (size_t)128 * 2048;
            u.dst = P + (size_t)(pn >> 2) * GS + ((size_t)pm * 256 * DM + (pn & 3) * 256) * 2; u.pm = pm; u.pn = pn; u.e = 0; u.rows = 256; return true; }
        L -= 64 * 36; if (L >= 128) return false;
        const int pmc = L >> 4, j = L & 15, slot = j >> 2, g = slot == 0 ? 0 : slot + 2, pn = g * 4 + (j & 3);
        u.A = H + (size_t)(NTOK + pmc * 256) * 2048; u.B0 = Wt + (size_t)pn * 256 * 2048; u.B1 = u.B0 + (size_t)128 * 2048;
        u.dst = PC + (size_t)slot * CGS + ((size_t)pmc * 256 * DM + (j & 3) * 256) * 2; u.pm = pmc; u.pn = pn; u.e = 0; u.rows = 256; return true;
    }
    __device__ __forceinline__ unsigned arow(const gm::Unit&, int r) const { return (unsigned)r; }
};
constexpr int LRU_T = 128, LRU_NCH = SEQ / LRU_T, UF_LD = 144;
constexpr int LRU_UBF = 0, LRU_UF = 144 * 256;
constexpr float LOG2E = 1.4426950408889634f;

struct LruCoef { float ba, bx, ca; };

__device__ __forceinline__ void lru_conv(Frame& F, const Args& a, int b, int h, int c, bool special) {
    const bf16* AX = (const bf16*)(F.ws + WS_P) + (size_t)b * SEQ * DM + h * 128;
    const float* cw = a.in[IN_CONVW] + h * 128; const float* cb = a.in[IN_CONVB] + h * 128;
    LAS unsigned char* ubf = F.lds + LRU_UBF; LAS float* uf = (LAS float*)(F.lds + LRU_UF);
    const int cg = F.tid & 15, tl0 = F.tid >> 4;
    u32x4 raw[4][4];
#pragma unroll
    for (int i = 0; i < 4; ++i)
#pragma unroll
        for (int k = 0; k < 4; ++k) { int tt = c * LRU_T + tl0 + 32 * i + k - 2; tt = tt < 0 ? 0 : (tt > SEQ - 1 ? SEQ - 1 : tt); raw[i][k] = *(const u32x4*)(AX + (size_t)tt * DM + 8 * cg); }
    float w[4][8], bs[8];
#pragma unroll
    for (int k = 0; k < 4; ++k) { const f32x4 w0 = *(const f32x4*)(cw + k * DM + 8 * cg), w1 = *(const f32x4*)(cw + k * DM + 8 * cg + 4);
        w[k][0] = w0.x; w[k][1] = w0.y; w[k][2] = w0.z; w[k][3] = w0.w; w[k][4] = w1.x; w[k][5] = w1.y; w[k][6] = w1.z; w[k][7] = w1.w; }
    { const f32x4 b0 = *(const f32x4*)(cb + 8 * cg), b1 = *(const f32x4*)(cb + 8 * cg + 4); bs[0] = b0.x; bs[1] = b0.y; bs[2] = b0.z; bs[3] = b0.w; bs[4] = b1.x; bs[5] = b1.y; bs[6] = b1.z; bs[7] = b1.w; }
#pragma unroll
    for (int i = 0; i < 4; ++i) { const int tl = tl0 + 32 * i;
        float u[8];
#pragma unroll
        for (int q = 0; q < 8; ++q) u[q] = bs[q];
#pragma unroll
        for (int k = 0; k < 4; ++k) { const int tt = c * LRU_T + tl + k - 2; const float mk = (tt >= 0 && tt < SEQ) ? 1.f : 0.f; const u32x4 v = raw[i][k];
            u[0] += mk * w[k][0] * bflo(v.x); u[1] += mk * w[k][1] * bfhi(v.x); u[2] += mk * w[k][2] * bflo(v.y); u[3] += mk * w[k][3] * bfhi(v.y);
            u[4] += mk * w[k][4] * bflo(v.z); u[5] += mk * w[k][5] * bfhi(v.z); u[6] += mk * w[k][6] * bflo(v.w); u[7] += mk * w[k][7] * bfhi(v.w); }
        *(LAS f32x4*)(uf + tl * UF_LD + 8 * cg) = (f32x4){u[0], u[1], u[2], u[3]};
        *(LAS f32x4*)(uf + tl * UF_LD + 8 * cg + 4) = (f32x4){u[4], u[5], u[6], u[7]};
        u32x4 p; p.x = pk2(u[0], u[1]); p.y = pk2(u[2], u[3]); p.z = pk2(u[4], u[5]); p.w = pk2(u[6], u[7]);
        *(LAS u32x4*)(ubf + tl * 256 + ((cg ^ (tl & 15)) << 4)) = p; }
    if (special) {
        const bf16* AC = (const bf16*)(F.ws + WS_PC) + (size_t)b * CTX * DM + h * 128;
        if (F.tid < 32) { const int tl = LRU_T + (F.tid >> 4); const int t = tl == LRU_T ? 0 : CTX - 1;
            float u[8];
#pragma unroll
            for (int q = 0; q < 8; ++q) u[q] = bs[q];
#pragma unroll
            for (int k = 0; k < 4; ++k) { const int tt = t + k - 2;
                if (tt >= 0 && tt < CTX) { const u32x4 v = *(const u32x4*)(AC + (size_t)tt * DM + 8 * cg);
                    u[0] += w[k][0] * bflo(v.x); u[1] += w[k][1] * bfhi(v.x); u[2] += w[k][2] * bflo(v.y); u[3] += w[k][3] * bfhi(v.y);
                    u[4] += w[k][4] * bflo(v.z); u[5] += w[k][5] * bfhi(v.z); u[6] += w[k][6] * bflo(v.w); u[7] += w[k][7] * bfhi(v.w); } }
            *(LAS f32x4*)(uf + tl * UF_LD + 8 * cg) = (f32x4){u[0], u[1], u[2], u[3]};
            *(LAS f32x4*)(uf + tl * UF_LD + 8 * cg + 4) = (f32x4){u[4], u[5], u[6], u[7]};
            u32x4 p; p.x = pk2(u[0], u[1]); p.y = pk2(u[2], u[3]); p.z = pk2(u[4], u[5]); p.w = pk2(u[6], u[7]);
            *(LAS u32x4*)(ubf + tl * 256 + ((cg ^ (tl & 15)) << 4)) = p;
        } else if (F.tid < 32 + 14 * 16) { const int tl = LRU_T + 2 + ((F.tid - 32) >> 4);
            *(LAS u32x4*)(ubf + tl * 256 + ((cg ^ (tl & 15)) << 4)) = (u32x4){0u, 0u, 0u, 0u}; }
    }
}
__device__ __forceinline__ void lru_load_w(Frame& F, int d, int h, bf16x8 (&Bw)[2][4]) {
    const int fr = F.lane & 15, fq = F.lane >> 4;
#pragma unroll
    for (int which = 0; which < 2; ++which) { const bf16* W = (const bf16*)(F.ws + WS_WLRU) + (size_t)(which * 16 + d * 8 + h) * 128 * 128 + (size_t)(16 * F.wave + fr) * 128 + 8 * fq;
#pragma unroll
        for (int kk = 0; kk < 4; ++kk) Bw[which][kk] = *(const bf16x8*)(W + kk * 32); }
}
__device__ __forceinline__ LruCoef lru_coef(const Args& a, int d, int ch) {
    LruCoef k; k.ba = -LOG2E * a.in[IN_BA][d * DM + ch]; k.bx = -LOG2E * a.in[IN_BX][d * DM + ch];
    const float sp = log1pf(expf(-a.in[IN_LAM][d * DM + ch])); k.ca = -8.f * sp * LOG2E; return k;
}
__device__ __forceinline__ void lru_tile(Frame& F, int m, const bf16x8 (&Bw)[2][4], const LruCoef& k, float (&av)[4], float (&bv)[4]) {
    const int fr = F.lane & 15, fq = F.lane >> 4;
    const LAS unsigned char* ubf = F.lds + LRU_UBF; const LAS float* uf = (const LAS float*)(F.lds + LRU_UF);
    f32x4 ar = {0.f, 0.f, 0.f, 0.f}, ai = {0.f, 0.f, 0.f, 0.f};
    const int row = m * 16 + fr;
#pragma unroll
    for (int kk = 0; kk < 4; ++kk) { const bf16x8 A = *(const LAS bf16x8*)(ubf + row * 256 + (((kk * 4 + fq) ^ fr) << 4));
        ar = __builtin_amdgcn_mfma_f32_16x16x32_bf16(A, Bw[0][kk], ar, 0, 0, 0); ai = __builtin_amdgcn_mfma_f32_16x16x32_bf16(A, Bw[1][kk], ai, 0, 0, 0); }
#pragma unroll
    for (int r = 0; r < 4; ++r) { const float u = uf[(m * 16 + 4 * fq + r) * UF_LD + 16 * F.wave + fr];
        const float rg = __builtin_amdgcn_rcpf(1.f + __builtin_amdgcn_exp2f(__builtin_fmaf(ar[r], -LOG2E, k.ba)));
        const float ig = __builtin_amdgcn_rcpf(1.f + __builtin_amdgcn_exp2f(__builtin_fmaf(ai[r], -LOG2E, k.bx)));
        const float aa = __builtin_amdgcn_exp2f(k.ca * rg);
        av[r] = aa; bv[r] = __builtin_amdgcn_sqrtf(__builtin_fmaf(-aa, aa, 1.f)) * (ig * u); }
}
template <bool FWD> __device__ __forceinline__ void lru_tile_total(int fq, float& A, float& B) {
#pragma unroll
    for (int s = 0; s < 2; ++s) { const int bit = 1 << s; const float Ap = __shfl_xor(A, 16 << s), Bp = __shfl_xor(B, 16 << s);
        const bool mine_first = FWD ? ((fq & bit) == 0) : ((fq & bit) != 0);
        if (mine_first) { B = B * Ap + Bp; A = A * Ap; } else { B = Bp * A + B; A = Ap * A; } }
}

__device__ __forceinline__ void lru_pass1(Frame& F, const Args& a, int unit) {
    const int c = unit & (LRU_NCH - 1), h = (unit >> 4) & 7, b = unit >> 7;
    const int fr = F.lane & 15, fq = F.lane >> 4; const int ch = h * 128 + 16 * F.wave + fr;
    bf16x8 Bw0[2][4], Bw1[2][4]; lru_load_w(F, 0, h, Bw0); lru_load_w(F, 1, h, Bw1);
    const LruCoef k0 = lru_coef(a, 0, ch), k1 = lru_coef(a, 1, ch);
    lru_conv(F, a, b, h, c, c == 0);
    LDS_WAIT(); __syncthreads();
    float Af = 1.f, Hf = 0.f, Ab = 1.f, Hb = 0.f;
#pragma unroll 2
    for (int m = 0; m < 8; ++m) {
        float av[4], bv[4];
        lru_tile(F, m, Bw0, k0, av, bv);
        float A = av[0] * av[1] * av[2] * av[3], B = ((bv[0] * av[1] + bv[1]) * av[2] + bv[2]) * av[3] + bv[3];
        lru_tile_total<true>(fq, A, B);
        Hf = Hf * A + B; Af = Af * A;
        lru_tile(F, m, Bw1, k1, av, bv);
        A = av[0] * av[1] * av[2] * av[3]; B = ((bv[3] * av[2] + bv[2]) * av[1] + bv[1]) * av[0] + bv[0];
        lru_tile_total<false>(fq, A, B);
        Hb = B * Ab + Hb; Ab = A * Ab;
    }
    float* agg = (float*)(F.ws + WS_LRUAGG);
    if (fq == 0) { *(f32x2*)(agg + ((size_t)((b * LRU_NCH + c) * 2 + 0) * DM + ch) * 2) = (f32x2){Af, Hf};
                   *(f32x2*)(agg + ((size_t)((b * LRU_NCH + c) * 2 + 1) * DM + ch) * 2) = (f32x2){Ab, Hb}; }
    if (c == 0) {
        float av[4], bv[4]; float* s0 = (float*)(F.ws + WS_LRUS0);
        lru_tile(F, 8, Bw0, k0, av, bv); if (fq == 0) s0[(b * 2 + 0) * DM + ch] = bv[0];
        lru_tile(F, 8, Bw1, k1, av, bv); if (fq == 0) s0[(b * 2 + 1) * DM + ch] = bv[1];
    }
    __syncthreads();
}

__device__ __forceinline__ void lru_pass2(Frame& F, const Args& a, int unit) {
    const int c = unit & (LRU_NCH - 1), h = (unit >> 4) & 7, b = unit >> 7;
    const int fr = F.lane & 15, fq = F.lane >> 4; const int ch = h * 128 + 16 * F.wave + fr;
    const float* agg = (const float*)(F.ws + WS_LRUAGG); const float* s0 = (const float*)(F.ws + WS_LRUS0);
    f32x2 ag[LRU_NCH];
#pragma unroll
    for (int j = 0; j < LRU_NCH; ++j) ag[j] = *(const f32x2*)(agg + ((size_t)((b * LRU_NCH + j) * 2 + (j < c ? 0 : 1)) * DM + ch) * 2);
    float hf = s0[(b * 2 + 0) * DM + ch], hb = s0[(b * 2 + 1) * DM + ch];
    bf16* AY = (bf16*)(F.ws + WS_YAG) + ((size_t)b * SEQ + c * LRU_T) * DM + h * 128;
    u32x4 ayv[4];
#pragma unroll
    for (int i = 0; i < 4; ++i) ayv[i] = *(const u32x4*)(AY + (size_t)((F.tid >> 4) + 32 * i) * DM + 8 * (F.tid & 15));
    bf16x8 Bw[2][4], Bw1[2][4]; lru_load_w(F, 0, h, Bw);
    LruCoef k = lru_coef(a, 0, ch); const LruCoef k1 = lru_coef(a, 1, ch);
    lru_conv(F, a, b, h, c, false);
    lru_load_w(F, 1, h, Bw1);
#pragma unroll
    for (int j = 0; j < LRU_NCH; ++j) if (j < c) hf = ag[j].x * hf + ag[j].y;
#pragma unroll
    for (int j = LRU_NCH - 1; j >= 0; --j) if (j > c) hb = ag[j].x * hb + ag[j].y;
    LDS_WAIT(); __syncthreads();
    float hfv[8][4];
#pragma unroll
    for (int m = 0; m < 8; ++m) {
        float av[4], bv[4];
        lru_tile(F, m, Bw, k, av, bv);
        const float A = av[0] * av[1] * av[2] * av[3], B = ((bv[0] * av[1] + bv[1]) * av[2] + bv[2]) * av[3] + bv[3];
        float hin = hf;
#pragma unroll
        for (int g = 0; g < 4; ++g) { const float Ag = __shfl(A, g * 16 + fr), Bg = __shfl(B, g * 16 + fr); if (g < fq) hin = Ag * hin + Bg; hf = Ag * hf + Bg; }
#pragma unroll
        for (int r = 0; r < 4; ++r) { hin = av[r] * hin + bv[r]; hfv[m][r] = hin; }
    }
    k = k1;
    LAS float* uf = (LAS float*)(F.lds + LRU_UF);
#pragma unroll
    for (int m = 7; m >= 0; --m) {
        float av[4], bv[4];
        lru_tile(F, m, Bw1, k, av, bv);
        const float A = av[0] * av[1] * av[2] * av[3], B = ((bv[3] * av[2] + bv[2]) * av[1] + bv[1]) * av[0] + bv[0];
        float hin = hb;
#pragma unroll
        for (int g = 3; g >= 0; --g) { const float Ag = __shfl(A, g * 16 + fr), Bg = __shfl(B, g * 16 + fr); if (g > fq) hin = Ag * hin + Bg; hb = Ag * hb + Bg; }
#pragma unroll
        for (int r = 3; r >= 0; --r) { hin = av[r] * hin + bv[r]; uf[(m * 16 + 4 * fq + r) * UF_LD + 16 * F.wave + fr] = hfv[m][r] + hin; }
    }
    LDS_WAIT(); __syncthreads();
    const int cg = F.tid & 15;
#pragma unroll
    for (int i = 0; i < 4; ++i) { const int tl = (F.tid >> 4) + 32 * i;
        const f32x4 y0 = *(const LAS f32x4*)(uf + tl * UF_LD + 8 * cg), y1 = *(const LAS f32x4*)(uf + tl * UF_LD + 8 * cg + 4);
        const u32x4 g = ayv[i];
        u32x4 o; o.x = pk2(y0.x * gelu_tanh(bflo(g.x)), y0.y * gelu_tanh(bfhi(g.x))); o.y = pk2(y0.z * gelu_tanh(bflo(g.y)), y0.w * gelu_tanh(bfhi(g.y)));
        o.z = pk2(y1.x * gelu_tanh(bflo(g.z)), y1.y * gelu_tanh(bfhi(g.z))); o.w = pk2(y1.z * gelu_tanh(bflo(g.w)), y1.w * gelu_tanh(bfhi(g.w)));
        *(u32x4*)(AY + (size_t)tl * DM + 8 * cg) = o; }
    __syncthreads();
}
constexpr int HG_C = 64, HG_SEG = 512, HG_NSEG = 4;
constexpr int HG_QS = 0, HG_QM = 16384, HG_KM = 32768, HG_KDT = 49152, HG_VT = 65536, HG_ATT = 81920, HG_PART = 90112, HG_ETOT = 94208, HG_ROWS = 94720;
constexpr size_t HGS_IMG = 65536;
#ifdef PROBE_A
#define HSTAMP(i) do { if (F.bid == 0 && F.tid == 0) { const unsigned long long _t = __builtin_amdgcn_s_memrealtime(); const unsigned long long _p = ((unsigned long long)F.MISC[101] << 32) | F.MISC[100]; \
    unsigned long long _a = ((unsigned long long)F.MISC[103 + 2 * (i)] << 32) | F.MISC[102 + 2 * (i)]; _a += _t - _p; F.MISC[102 + 2 * (i)] = (unsigned)_a; F.MISC[103 + 2 * (i)] = (unsigned)(_a >> 32); F.MISC[100] = (unsigned)_t; F.MISC[101] = (unsigned)(_t >> 32); } } while (0)
#else
#define HSTAMP(i) do { } while (0)
#endif

__device__ __forceinline__ int hg_row(int b, int dir, bool ctx, int sigma) {
    if (ctx) { const int t = dir ? (CTX - 1 - sigma) : sigma; return b * CTX + t; }
    const int p = dir ? (SEQ - 1 - sigma) : sigma; return b * SEQ + (p & 31) * 64 + (p >> 5);
}

struct HgRaw { unsigned f[8], v[8], q[8]; };
template <bool FULL>
__device__ __forceinline__ void hg_load(Frame& F, const bf16* Qb, const bf16* Fb, const bf16* Vb, int b, int dir, bool ctx, int sigma0, HgRaw& r) {
#pragma unroll
    for (int j = 0; j < 8; ++j) { const size_t ro = (size_t)hg_row(b, dir, ctx, sigma0 + 8 * F.wave + j) * DM + 2 * F.lane;
        r.f[j] = *(const unsigned*)(Fb + ro); r.v[j] = *(const unsigned*)(Vb + ro); if (FULL) r.q[j] = *(const unsigned*)(Qb + ro); }
}
template <bool FULL>
__device__ __forceinline__ void hg_prep(Frame& F, const HgRaw& raw, int b, int dir, bool ctx, int sigma0, float lb0, float lb1, float& gs0, float& gs1) {
    const int kp = F.lane, to = F.wave;
    const unsigned (&fw)[8] = raw.f; const unsigned (&qw)[8] = raw.q; const unsigned (&vw)[8] = raw.v;
    float c0[8], c1[8], k0[8], k1[8];
    float a0 = 0.f, a1 = 0.f;
#pragma unroll
    for (int j = 0; j < 8; ++j) {
        const float g0 = lb0 + (1.f - lb0) * __builtin_amdgcn_rcpf(1.f + __builtin_amdgcn_exp2f(-bflo(fw[j]) * LOG2E));
        const float g1 = lb1 + (1.f - lb1) * __builtin_amdgcn_rcpf(1.f + __builtin_amdgcn_exp2f(-bfhi(fw[j]) * LOG2E));
        k0[j] = 1.f - g0; k1[j] = 1.f - g1;
        a0 += __builtin_amdgcn_logf(g0); a1 += __builtin_amdgcn_logf(g1);
        c0[j] = a0; c1[j] = a1; }
    LAS float* part = (LAS float*)(F.lds + HG_PART);
    *(LAS f32x2*)(part + to * 128 + 2 * kp) = (f32x2){a0, a1};
    if (FULL) HSTAMP(0);
    LDS_WAIT(); __syncthreads();
    if (FULL) HSTAMP(1);
    if (FULL && F.tid < HG_C) ((LAS int*)(F.lds + HG_ROWS))[F.tid] = hg_row(b, dir, ctx, sigma0 + F.tid);
    float off0 = 0.f, off1 = 0.f, tot0 = 0.f, tot1 = 0.f;
#pragma unroll
    for (int o = 0; o < 8; ++o) { const f32x2 p = *(const LAS f32x2*)(part + o * 128 + 2 * kp);
        if (o < to) { off0 += p.x; off1 += p.y; } tot0 += p.x; tot1 += p.y; }
    gs0 += tot0; gs1 += tot1;
    if (to == 0) *(LAS f32x2*)((LAS float*)(F.lds + HG_ETOT) + 2 * kp) = (f32x2){__builtin_amdgcn_exp2f(tot0), __builtin_amdgcn_exp2f(tot1)};
    float kd0[8], kd1[8];
#pragma unroll
    for (int j = 0; j < 8; ++j) {
        const float E0 = __builtin_amdgcn_exp2f(off0 + c0[j]), E1 = __builtin_amdgcn_exp2f(off1 + c1[j]);
        kd0[j] = k0[j] * __builtin_amdgcn_rcpf(E0); kd1[j] = k1[j] * __builtin_amdgcn_rcpf(E1);
        if (FULL) {
            const float q0 = bflo(qw[j]), q1 = bfhi(qw[j]);
            const float s0 = q0 * __builtin_amdgcn_rcpf(1.f + __builtin_amdgcn_exp2f(-q0 * LOG2E)) * E0, s1 = q1 * __builtin_amdgcn_rcpf(1.f + __builtin_amdgcn_exp2f(-q1 * LOG2E)) * E1;
            const int c = 8 * to + j; const int off = c * 256 + ((4 * kp) ^ ((c & 15) << 4));
            *(LAS unsigned*)(F.lds + HG_QS + off) = pk2(s0, s1);
            *(LAS unsigned*)(F.lds + HG_KM + off) = pk2(kd0[j], kd1[j]);
        }
    }
    { const int sw = ((to ^ (kp & 7)) << 4);
      u32x4 w0, w1; w0.x = pk2(kd0[0], kd0[1]); w0.y = pk2(kd0[2], kd0[3]); w0.z = pk2(kd0[4], kd0[5]); w0.w = pk2(kd0[6], kd0[7]);
      w1.x = pk2(kd1[0], kd1[1]); w1.y = pk2(kd1[2], kd1[3]); w1.z = pk2(kd1[4], kd1[5]); w1.w = pk2(kd1[6], kd1[7]);
      *(LAS u32x4*)(F.lds + HG_KDT + (2 * kp) * 128 + sw) = w0; *(LAS u32x4*)(F.lds + HG_KDT + (2 * kp + 1) * 128 + sw) = w1;
      u32x4 v0, v1;
      v0.x = (vw[0] & 0xffffu) | (vw[1] << 16); v0.y = (vw[2] & 0xffffu) | (vw[3] << 16); v0.z = (vw[4] & 0xffffu) | (vw[5] << 16); v0.w = (vw[6] & 0xffffu) | (vw[7] << 16);
      v1.x = (vw[0] >> 16) | (vw[1] & 0xffff0000u); v1.y = (vw[2] >> 16) | (vw[3] & 0xffff0000u); v1.z = (vw[4] >> 16) | (vw[5] & 0xffff0000u); v1.w = (vw[6] >> 16) | (vw[7] & 0xffff0000u);
      *(LAS u32x4*)(F.lds + HG_VT + (2 * kp) * 128 + sw) = v0; *(LAS u32x4*)(F.lds + HG_VT + (2 * kp + 1) * 128 + sw) = v1; }
    if (FULL) HSTAMP(2);
    LDS_WAIT(); __syncthreads();
    if (FULL) HSTAMP(3);
}
__device__ __forceinline__ void hg_state_update(Frame& F, f32x4 (&St)[8], const bf16x8 (&vt)[2]) {
    const int fr = F.lane & 15, fq = F.lane >> 4;
    const LAS float* etot = (const LAS float*)(F.lds + HG_ETOT);
#pragma unroll
    for (int kt = 0; kt < 8; ++kt) { const f32x4 e = *(const LAS f32x4*)(etot + 16 * kt + 4 * fq);
        const int rk = 16 * kt + fr;
#pragma unroll
        for (int ks = 0; ks < 2; ++ks) { const bf16x8 A = *(const LAS bf16x8*)(F.lds + HG_KDT + rk * 128 + (((4 * ks + fq) ^ ((rk >> 1) & 7)) << 4));
            St[kt] = __builtin_amdgcn_mfma_f32_16x16x32_bf16(A, vt[ks], St[kt], 0, 0, 0); }
        St[kt] = St[kt] * e; }
}
__device__ __forceinline__ void hg_load_vt(Frame& F, bf16x8 (&vt)[2]) {
    const int fr = F.lane & 15, fq = F.lane >> 4; const int rv = 16 * F.wave + fr;
#pragma unroll
    for (int ks = 0; ks < 2; ++ks) vt[ks] = *(const LAS bf16x8*)(F.lds + HG_VT + rv * 128 + (((4 * ks + fq) ^ ((rv >> 1) & 7)) << 4));
}
struct HgPtrs { const bf16* Q; const bf16* Fx; const bf16* V; const bf16* Fc; const bf16* Vc; bf16* O; };
__device__ __forceinline__ HgPtrs hg_ptrs(Frame& F, int h, int dir) {
    HgPtrs p; p.Q = (const bf16*)(F.ws + WS_P + 2 * GS) + h * 128; p.Fx = (const bf16*)(F.ws + WS_P + (dir ? 4 : 3) * GS) + h * 128; p.V = (const bf16*)(F.ws + WS_P + 5 * GS) + h * 128;
    p.Fc = (const bf16*)(F.ws + WS_PC + (dir ? 2 : 1) * CGS) + h * 128; p.Vc = (const bf16*)(F.ws + WS_PC + 3 * CGS) + h * 128; p.O = (bf16*)(F.ws + WS_P + (dir ? 4 : 3) * GS) + h * 128; return p;
}
__device__ __forceinline__ void hg_lb(const Args& a, int h, int kp, float& lb0, float& lb1) {
    const float* t = a.in[IN_HGLB] + h * 128 + 2 * kp; lb0 = 1.f / (1.f + expf(t[DM] - t[0])); lb1 = 1.f / (1.f + expf(t[DM + 1] - t[1]));
}
__device__ __forceinline__ float* hg_img(Frame& F, int b, int h, int dir, int slot) { return (float*)((unsigned char*)F.out + (size_t)((((b * 8 + h) * 2 + dir) * 4) + slot) * HGS_IMG); }

__device__ __forceinline__ void hg_pass1(Frame& F, const Args& a, int unit) {
    const int slot = unit & 3, dir = (unit >> 2) & 1, h = (unit >> 3) & 7, b = unit >> 6;
    const int fr = F.lane & 15, fq = F.lane >> 4;
    const HgPtrs P = hg_ptrs(F, h, dir);
    float lb0, lb1; hg_lb(a, h, F.lane, lb0, lb1);
    f32x4 St[8];
#pragma unroll
    for (int kt = 0; kt < 8; ++kt) St[kt] = (f32x4){0.f, 0.f, 0.f, 0.f};
    const bool ctx = slot == 0; const int nchunk = ctx ? CTX / HG_C : HG_SEG / HG_C; const int sig0 = ctx ? 0 : (slot - 1) * HG_SEG;
    float gs0 = 0.f, gs1 = 0.f;
    const bf16* Fsrc = ctx ? P.Fc : P.Fx; const bf16* Vsrc = ctx ? P.Vc : P.V;
    HgRaw cur; hg_load<false>(F, P.Q, Fsrc, Vsrc, b, dir, ctx, sig0, cur);
    for (int ck = 0; ck < nchunk; ++ck) {
        HgRaw nxt; { const int cn = ck + 1 < nchunk ? ck + 1 : ck; hg_load<false>(F, P.Q, Fsrc, Vsrc, b, dir, ctx, sig0 + cn * HG_C, nxt); }
        hg_prep<false>(F, cur, b, dir, ctx, sig0 + ck * HG_C, lb0, lb1, gs0, gs1);
        cur = nxt;
        bf16x8 vt[2]; hg_load_vt(F, vt);
        hg_state_update(F, St, vt);
    }
    float* img = hg_img(F, b, h, dir, slot) + (size_t)(16 * F.wave + fr) * 128 + 4 * fq;
#pragma unroll
    for (int kt = 0; kt < 8; ++kt) *(f32x4*)(img + 16 * kt) = St[kt];
    if (!ctx && F.wave == 0) { float* D = (float*)(F.ws + WS_HGD) + (size_t)((((b * 8 + h) * 2 + dir) * 3) + (slot - 1)) * 128 + 2 * F.lane;
        *(f32x2*)D = (f32x2){__builtin_amdgcn_exp2f(gs0), __builtin_amdgcn_exp2f(gs1)}; }
    __syncthreads();
}

__device__ __forceinline__ void hg_pass2(Frame& F, const Args& a, int unit) {
    const int seg = unit & 3, dir = (unit >> 2) & 1, h = (unit >> 3) & 7, b = unit >> 6;
    const int fr = F.lane & 15, fq = F.lane >> 4, w = F.wave;
    const HgPtrs P = hg_ptrs(F, h, dir);
    float lb0, lb1; hg_lb(a, h, F.lane, lb0, lb1);
    f32x4 St[8];
    {
        const float* img = hg_img(F, b, h, dir, 0) + (size_t)(16 * w + fr) * 128 + 4 * fq;
#pragma unroll
        for (int kt = 0; kt < 8; ++kt) St[kt] = *(const f32x4*)(img + 16 * kt);
        for (int j = 0; j < seg; ++j) {
            const float* im = hg_img(F, b, h, dir, 1 + j) + (size_t)(16 * w + fr) * 128 + 4 * fq;
            const float* D = (const float*)(F.ws + WS_HGD) + (size_t)((((b * 8 + h) * 2 + dir) * 3) + j) * 128 + 4 * fq;
#pragma unroll
            for (int kt = 0; kt < 8; ++kt) { const f32x4 d = *(const f32x4*)(D + 16 * kt), dl = *(const f32x4*)(im + 16 * kt); St[kt] = St[kt] * d + dl; }
        }
    }
    float gs0 = 0.f, gs1 = 0.f;
    HSTAMP(7);
    HgRaw cur; hg_load<true>(F, P.Q, P.Fx, P.V, b, dir, false, seg * HG_SEG, cur);
    for (int ck = 0; ck < HG_SEG / HG_C; ++ck) {
        HgRaw nxt; { const int cn = ck + 1 < HG_SEG / HG_C ? ck + 1 : ck; hg_load<true>(F, P.Q, P.Fx, P.V, b, dir, false, seg * HG_SEG + cn * HG_C, nxt); }
        hg_prep<true>(F, cur, b, dir, false, seg * HG_SEG + ck * HG_C, lb0, lb1, gs0, gs1);
#pragma unroll
        for (int tt = 0; tt < 2; ++tt) { const int t = w + 8 * tt, ct = t >> 2, st = t & 3;
            f32x4 acc = {0.f, 0.f, 0.f, 0.f};
            const int rs = 16 * st + fr, rc = 16 * ct + fr;
#pragma unroll
            for (int kk = 0; kk < 4; ++kk) { const bf16x8 A = *(const LAS bf16x8*)(F.lds + HG_KM + rs * 256 + (((4 * kk + fq) ^ fr) << 4));
                const bf16x8 B = *(const LAS bf16x8*)(F.lds + HG_QS + rc * 256 + (((4 * kk + fq) ^ fr) << 4));
                acc = __builtin_amdgcn_mfma_f32_16x16x32_bf16(A, B, acc, 0, 0, 0); }
            const int s0 = 16 * st + 4 * fq;
            const float m0 = (s0 + 0 <= rc) ? acc[0] : 0.f, m1 = (s0 + 1 <= rc) ? acc[1] : 0.f, m2 = (s0 + 2 <= rc) ? acc[2] : 0.f, m3 = (s0 + 3 <= rc) ? acc[3] : 0.f;
            *(LAS u32x2*)(F.lds + HG_ATT + rc * 128 + (((2 * st + (fq >> 1)) ^ ((rc >> 1) & 7)) << 4) + (fq & 1) * 8) = (u32x2){pk2(m0, m1), pk2(m2, m3)}; }
        f32x4 o[4];
#pragma unroll
        for (int ct = 0; ct < 4; ++ct) o[ct] = (f32x4){0.f, 0.f, 0.f, 0.f};
#pragma unroll
        for (int kk = 0; kk < 4; ++kk) {
            union { bf16x8 v; unsigned u[4]; } A;
            A.u[0] = pk2(St[2 * kk][0], St[2 * kk][1]); A.u[1] = pk2(St[2 * kk][2], St[2 * kk][3]); A.u[2] = pk2(St[2 * kk + 1][0], St[2 * kk + 1][1]); A.u[3] = pk2(St[2 * kk + 1][2], St[2 * kk + 1][3]);
#pragma unroll
            for (int ct = 0; ct < 4; ++ct) { const int rc = 16 * ct + fr;
                union { bf16x8 v; u32x2 h[2]; } B;
                B.h[0] = *(const LAS u32x2*)(F.lds + HG_QS + rc * 256 + (((4 * kk + (fq >> 1)) ^ fr) << 4) + (fq & 1) * 8);
                B.h[1] = *(const LAS u32x2*)(F.lds + HG_QS + rc * 256 + (((4 * kk + 2 + (fq >> 1)) ^ fr) << 4) + (fq & 1) * 8);
                o[ct] = __builtin_amdgcn_mfma_f32_16x16x32_bf16(A.v, B.v, o[ct], 0, 0, 0); } }
        bf16x8 vt[2]; hg_load_vt(F, vt);
        HSTAMP(4);
        LDS_WAIT(); __syncthreads();
        HSTAMP(5);
#pragma unroll
        for (int ks = 0; ks < 2; ++ks)
#pragma unroll
            for (int ct = 0; ct < 4; ++ct) { const int rc = 16 * ct + fr;
                const bf16x8 B = *(const LAS bf16x8*)(F.lds + HG_ATT + rc * 128 + (((4 * ks + fq) ^ ((rc >> 1) & 7)) << 4));
                o[ct] = __builtin_amdgcn_mfma_f32_16x16x32_bf16(vt[ks], B, o[ct], 0, 0, 0); }
        { const LAS int* rows = (const LAS int*)(F.lds + HG_ROWS);
#pragma unroll
          for (int ct = 0; ct < 4; ++ct) { const int row = rows[16 * ct + fr];
              *(u32x2*)(P.O + (size_t)row * DM + 16 * w + 4 * fq) = (u32x2){pk2(o[ct][0], o[ct][1]), pk2(o[ct][2], o[ct][3])}; } }
        hg_state_update(F, St, vt);
        cur = nxt;
        HSTAMP(6);
    }
    __syncthreads();
}
__device__ __forceinline__ void p_ybg(Frame& F, const Args& a) {
    const bf16* OFp = (const bf16*)(F.ws + WS_OF); const bf16* OBp = (const bf16*)(F.ws + WS_OB); const bf16* OG = (const bf16*)(F.ws + WS_P + 6 * GS);
    bf16* YBG = (bf16*)(F.ws + WS_YBG); const float* hgn = a.in[IN_HGN];
    const int gw = F.bid * NWAVES + F.wave, NGW = F.G * NWAVES;
    for (int row = gw; row < NTOK; row += 2 * NGW) {
        u32x4 fv[2][2], bv[2][2], gvv[2][2];
#pragma unroll
        for (int rr = 0; rr < 2; ++rr)
#pragma unroll
            for (int j = 0; j < 2; ++j) { const size_t o = (size_t)(row + rr * NGW) * DM + 8 * F.lane + 512 * j;
                fv[rr][j] = *(const u32x4*)(OFp + o); bv[rr][j] = *(const u32x4*)(OBp + o); gvv[rr][j] = *(const u32x4*)(OG + o); }
#pragma unroll
        for (int rr = 0; rr < 2; ++rr)
#pragma unroll
        for (int j = 0; j < 2; ++j) { const int k = 8 * F.lane + 512 * j; const size_t o = (size_t)(row + rr * NGW) * DM + k;
            const u32x4 f = fv[rr][j], b = bv[rr][j], g = gvv[rr][j];
            float v[8]; v[0] = bflo(f.x) + bflo(b.x); v[1] = bfhi(f.x) + bfhi(b.x); v[2] = bflo(f.y) + bflo(b.y); v[3] = bfhi(f.y) + bfhi(b.y);
            v[4] = bflo(f.z) + bflo(b.z); v[5] = bfhi(f.z) + bfhi(b.z); v[6] = bflo(f.w) + bflo(b.w); v[7] = bfhi(f.w) + bfhi(b.w);
            float ss = 0.f;
#pragma unroll
            for (int q = 0; q < 8; ++q) ss += v[q] * v[q];
            ss += __shfl_xor(ss, 1); ss += __shfl_xor(ss, 2); ss += __shfl_xor(ss, 4); ss += __shfl_xor(ss, 8);
            const float rs = rsqrtf(ss * (1.f / 128.f) + EPS);
            float gv[8]; gv[0] = bflo(g.x); gv[1] = bfhi(g.x); gv[2] = bflo(g.y); gv[3] = bfhi(g.y); gv[4] = bflo(g.z); gv[5] = bfhi(g.z); gv[6] = bflo(g.w); gv[7] = bfhi(g.w);
            const f32x4 h0 = *(const f32x4*)(hgn + k), h1 = *(const f32x4*)(hgn + k + 4);
            const float hv[8] = {h0.x, h0.y, h0.z, h0.w, h1.x, h1.y, h1.z, h1.w};
            float r[8];
#pragma unroll
            for (int q = 0; q < 8; ++q) r[q] = v[q] * rs * hv[q] * siluf_(gv[q]);
            u32x4 w; w.x = pk2(r[0], r[1]); w.y = pk2(r[2], r[3]); w.z = pk2(r[4], r[5]); w.w = pk2(r[6], r[7]);
            *(u32x4*)(YBG + o) = w; }
    }
}
__device__ __forceinline__ void p_moe_weights13(Frame& F, const Args& a) {
    LAS float* scr = (LAS float*)(F.lds + F.wave * TR_BYTES);
    const int gw = F.bid * NWAVES + F.wave, NGW = F.G * NWAVES;
    for (int it = gw; it < NEXP * 256; it += NGW) {
        const int e = it >> 8, r = it & 255, w = r >> 7, q = r & 127, kb = q >> 3, nb = q & 7;
        transpose_item(a.in[w == 0 ? IN_W1 : IN_W3] + (size_t)e * DM * DEXP, DEXP, DM, (bf16*)(F.ws + (w == 0 ? WS_W1T : WS_W3T)) + ((size_t)e * DEXP + nb * 64) * DM, kb * 64, nb * 64, scr, F.lane);
    }
}
__device__ __forceinline__ void p_moe_weights2(Frame& F, const Args& a, int rank, int nwg) {
    LAS float* scr = (LAS float*)(F.lds + F.wave * TR_BYTES);
    for (int it = rank * NWAVES + F.wave; it < NEXP * 128; it += nwg * NWAVES) {
        const int e = it >> 7, q = it & 127, kb = q >> 4, nb = q & 15;
        transpose_item(a.in[IN_W2] + (size_t)e * DEXP * DM, DM, DEXP, (bf16*)(F.ws + WS_W2T) + ((size_t)e * DM + nb * 64) * DEXP, kb * 64, nb * 64, scr, F.lane);
    }
}

struct SchedP5 {
    int c; const char* YAG; const char* YBG; const char* WA; const char* WB; char* stash; char* M;
    __device__ __forceinline__ bool next(int i, gm::Unit& u) const {
        if (i >= 2) return false;
        int pm, pn; tile_order(c, 64, 4, pm, pn);
        u.A = (i == 0 ? YAG : YBG) + (size_t)pm * 256 * 2048; u.B0 = (i == 0 ? WA : WB) + (size_t)pn * 256 * 2048; u.B1 = u.B0 + (size_t)128 * 2048;
        u.dst = M + ((size_t)pm * 256 * DM + pn * 256) * 2; u.pm = pm; u.pn = pn; u.e = i; u.rows = 256; return true;
    }
    __device__ __forceinline__ unsigned arow(const gm::Unit&, int r) const { return (unsigned)r; }
};
struct EpiP5 {
    static constexpr bool PERM = true;
    float* stash; const bf16* GA; const bf16* GB;
    __device__ __forceinline__ void operator()(const f32x4 (&acc)[2][2][4][2], const gm::Unit& u, int wr, int wc, int fr, int fq) const {
        const bf16* G = (u.e == 0 ? GA : GB) + ((size_t)u.pm * 256 + wr * 64 + fr) * DM + u.pn * 256 + wc * 32 + 8 * fq;
        bf16* Mb = (bf16*)u.dst + (size_t)(wr * 64 + fr) * DM + wc * 32 + 8 * fq;
        f32x4* st = (f32x4*)stash + threadIdx.x;
        asm volatile("" : "+v"(G), "+v"(Mb), "+v"(st));
#pragma unroll
        for (int ai = 0; ai < 2; ++ai)
#pragma unroll
            for (int m = 0; m < 4; ++m) {
                u32x4 g[2]; f32x4 s0[2], s1[2];
#pragma unroll
                for (int bj = 0; bj < 2; ++bj) { const size_t ro = (size_t)(ai * 128 + m * 16) * DM + bj * 128; const int si = ((ai * 4 + m) * 2 + bj) * 2;
                    g[bj] = *(const u32x4*)(G + ro);
                    if (u.e != 0) { s0[bj] = st[(size_t)(si + 0) * NTHR]; s1[bj] = st[(size_t)(si + 1) * NTHR]; } }
#pragma unroll
                for (int bj = 0; bj < 2; ++bj) { const size_t ro = (size_t)(ai * 128 + m * 16) * DM + bj * 128; const int si = ((ai * 4 + m) * 2 + bj) * 2;
                    f32x4 v0 = acc[ai][bj][m][0], v1 = acc[ai][bj][m][1];
                    v0[0] *= sigmoidf_(bflo(g[bj].x)); v0[1] *= sigmoidf_(bfhi(g[bj].x)); v0[2] *= sigmoidf_(bflo(g[bj].y)); v0[3] *= sigmoidf_(bfhi(g[bj].y));
                    v1[0] *= sigmoidf_(bflo(g[bj].z)); v1[1] *= sigmoidf_(bfhi(g[bj].z)); v1[2] *= sigmoidf_(bflo(g[bj].w)); v1[3] *= sigmoidf_(bfhi(g[bj].w));
                    if (u.e == 0) { st[(size_t)(si + 0) * NTHR] = v0; st[(size_t)(si + 1) * NTHR] = v1; }
                    else { v0 += s0[bj]; v1 += s1[bj];
                        u32x4 w; w.x = gm::cvt_pk_bf16(v0[0], v0[1]); w.y = gm::cvt_pk_bf16(v0[2], v0[3]); w.z = gm::cvt_pk_bf16(v1[0], v1[1]); w.w = gm::cvt_pk_bf16(v1[2], v1[3]);
                        *(u32x4*)(Mb + ro) = w; } }
                asm volatile("" ::: "memory"); }
    }
};

struct SchedP6 {
    int c; const char* M; const char* W; char* X1;
    __device__ __forceinline__ bool next(int i, gm::Unit& u) const {
        if (i >= 1) return false;
        int pm, pn; tile_order(c, 64, 4, pm, pn);
        u.A = M + (size_t)pm * 256 * 2048; u.B0 = W + (size_t)pn * 256 * 2048; u.B1 = u.B0 + (size_t)128 * 2048;
        u.dst = X1 + ((size_t)pm * 256 * DM + pn * 256) * 4; u.pm = pm; u.pn = pn; u.e = 0; u.rows = 256; return true;
    }
    __device__ __forceinline__ unsigned arow(const gm::Unit&, int r) const { return (unsigned)r; }
};
struct EpiP6 {
    static constexpr bool PERM = false;
    const float* x; const float* mod;
    __device__ __forceinline__ void operator()(const f32x4 (&acc)[2][2][4][2], const gm::Unit& u, int wr, int wc, int fr, int fq) const {
        const int b = u.pm >> 3; const int col0 = u.pn * 256 + wc * 32 + 4 * fq;
        const float* mg = mod + b * 6144 + 2 * DM + col0;
        f32x4 gv[2][2];
#pragma unroll
        for (int bj = 0; bj < 2; ++bj)
#pragma unroll
            for (int n = 0; n < 2; ++n) gv[bj][n] = *(const f32x4*)(mg + bj * 128 + n * 16);
#pragma unroll
        for (int ai = 0; ai < 2; ++ai)
#pragma unroll
            for (int m = 0; m < 4; ++m) { const size_t ro = (size_t)(wr * 64 + fr + ai * 128 + m * 16) * DM + wc * 32 + 4 * fq;
                const float* xr = x + ((size_t)u.pm * 256 * DM + u.pn * 256) + ro; float* orow = (float*)u.dst + ro;
#pragma unroll
                for (int bj = 0; bj < 2; ++bj)
#pragma unroll
                    for (int n = 0; n < 2; ++n) { const f32x4 xv = *(const f32x4*)(xr + bj * 128 + n * 16);
                        *(f32x4*)(orow + bj * 128 + n * 16) = xv + gv[bj][n] * acc[ai][bj][m][n]; } }
    }
};

__device__ __forceinline__ void p_norm2_route(Frame& F, const Args& a) {
    const float* mod = (const float*)(F.ws + WS_MOD); const float* g2 = a.in[IN_G2]; const float* wrp = (const float*)(F.ws + WS_WRT);
    const float* X1 = F.out; bf16* HX2 = (bf16*)(F.ws + WS_HX2);
    int* list = (int*)(F.ws + WS_LIST); float* wt = (float*)(F.ws + WS_WT); unsigned* cnt = F.ctl + CW_CNT;
    LAS float* gs = (LAS float*)F.lds; LAS float* sh = gs + DM; LAS float* rst = sh + DM; LAS float* lgs = rst + 64;
    const int b = F.bid / 32;
    for (int k = F.tid; k < DM; k += NTHR) { gs[k] = g2[k] * (1.f + mod[b * 6144 + 4 * DM + k]); sh[k] = mod[b * 6144 + 3 * DM + k]; }
    __syncthreads();
    for (int r = F.wave; r < 64; r += NWAVES) {
        const int tok = F.bid * 64 + r;
        const f32x4* xr = (const f32x4*)(X1 + (size_t)tok * DM) + F.lane;
        f32x4 v[4]; float s = 0.f;
#pragma unroll
        for (int j = 0; j < 4; ++j) { v[j] = xr[64 * j]; s += (v[j].x * v[j].x + v[j].y * v[j].y) + (v[j].z * v[j].z + v[j].w * v[j].w); }
        const float rstd = rsqrtf(wave_sum(s) * (1.f / DM) + EPS);
        if (F.lane == 0) rst[r] = rstd;
        unsigned long long* o8 = (unsigned long long*)(HX2 + (size_t)tok * DM) + F.lane;
#pragma unroll
        for (int j = 0; j < 4; ++j) { const int k = 4 * F.lane + 256 * j;
            const f32x4 g = *(const LAS f32x4*)(gs + k), h = *(const LAS f32x4*)(sh + k);
            o8[64 * j] = (unsigned long long)pk2(v[j].x * rstd * g.x + h.x, v[j].y * rstd * g.y + h.y) | ((unsigned long long)pk2(v[j].z * rstd * g.z + h.z, v[j].w * rstd * g.w + h.w) << 32); }
    }
    LDS_WAIT(); __syncthreads();
    {
        const int tq = F.lane & 15, kq = F.lane >> 4, wg = F.wave & 3, kh = F.wave >> 2; const int tl = wg * 16 + tq;
        const float rs = rst[tl];
        const float* xr = X1 + (size_t)(F.bid * 64 + tl) * DM + 4 * kq + 512 * kh;
        const f32x4* wp = (const f32x4*)wrp + F.lane + (size_t)kh * 32 * 3 * 64;
        const LAS float* gsp = gs + 512 * kh + 4 * kq; const LAS float* shp = sh + 512 * kh + 4 * kq;
        f32x4 acc[3];
#pragma unroll
        for (int c = 0; c < 3; ++c) acc[c] = (f32x4){0.f, 0.f, 0.f, 0.f};
#pragma unroll 8
        for (int s = 0; s < 32; ++s) {
            const f32x4 x = *(const f32x4*)(xr + 16 * s); const f32x4 g = *(const LAS f32x4*)(gsp + 16 * s), h = *(const LAS f32x4*)(shp + 16 * s);
            const f32x4 hv = x * rs * g + h;
#pragma unroll
            for (int c = 0; c < 3; ++c) { const f32x4 w = wp[(s * 3 + c) * 64];
                acc[c] = __builtin_amdgcn_mfma_f32_16x16x4f32(hv[0], w[0], acc[c], 0, 0, 0); acc[c] = __builtin_amdgcn_mfma_f32_16x16x4f32(hv[1], w[1], acc[c], 0, 0, 0);
                acc[c] = __builtin_amdgcn_mfma_f32_16x16x4f32(hv[2], w[2], acc[c], 0, 0, 0); acc[c] = __builtin_amdgcn_mfma_f32_16x16x4f32(hv[3], w[3], acc[c], 0, 0, 0); }
        }
#pragma unroll
        for (int c = 0; c < 3; ++c)
#pragma unroll
            for (int r = 0; r < 4; ++r) lgs[kh * 64 * 48 + (wg * 16 + 4 * kq + r) * 48 + 16 * c + tq] = acc[c][r];
    }
    LDS_WAIT(); __syncthreads();
    if (F.wave < 4) {
        if (F.lane < 16) {
            const LAS float* lp = lgs + (F.wave * 16 + F.lane) * 48; const int tok = F.bid * 64 + F.wave * 16 + F.lane;
            float lg[36];
#pragma unroll
            for (int q = 0; q < 9; ++q) { const f32x4 t4 = *(const LAS f32x4*)(lp + 4 * q) + *(const LAS f32x4*)(lp + 64 * 48 + 4 * q) + *(const f32x4*)(wrp + 49152 + 4 * q);
                lg[4 * q] = t4.x; lg[4 * q + 1] = t4.y; lg[4 * q + 2] = t4.z; lg[4 * q + 3] = t4.w; }
            float mx = lg[0]; int gi = 0;
#pragma unroll
            for (int g = 1; g < 4; ++g) if (lg[g] > mx) { mx = lg[g]; gi = g; }
            float z = 0.f;
#pragma unroll
            for (int g = 0; g < 4; ++g) z += __expf(lg[g] - mx);
            const float pg = 1.f / z;
            float el[8];
#pragma unroll
            for (int e = 0; e < 8; ++e) el[e] = gi == 0 ? lg[4 + e] : (gi == 1 ? lg[12 + e] : (gi == 2 ? lg[20 + e] : lg[28 + e]));
            int e1 = 0; float m1 = el[0];
#pragma unroll
            for (int e = 1; e < 8; ++e) if (el[e] > m1) { m1 = el[e]; e1 = e; }
            int e2 = 0; float m2 = -3.0e38f;
#pragma unroll
            for (int e = 0; e < 8; ++e) if (e != e1 && el[e] > m2) { m2 = el[e]; e2 = e; }
            const float rr = __expf(m2 - m1); const float w1 = pg / (1.f + rr), w2 = pg * rr / (1.f + rr);
            const int ea = gi * 8 + e1, eb = gi * 8 + e2;
            const unsigned pa = __hip_atomic_fetch_add(cnt + 64 * ea, 1u, __ATOMIC_RELAXED, __HIP_MEMORY_SCOPE_AGENT);
            const unsigned pb = __hip_atomic_fetch_add(cnt + 64 * eb, 1u, __ATOMIC_RELAXED, __HIP_MEMORY_SCOPE_AGENT);
            list[(size_t)ea * CAP + pa] = tok * 2; wt[tok * 2] = w1;
            list[(size_t)eb * CAP + pb] = tok * 2 + 1; wt[tok * 2 + 1] = w2;
        }
    }
}

__device__ __forceinline__ void moe_table(Frame& F, const int* cntv) {
    if (F.wave == 0) { const int lane = F.lane; const int cnt = lane < NEXP ? cntv[64 * lane] : 0;
        const int t = (cnt + 255) >> 8; int ti = t, oi = cnt;
#pragma unroll
        for (int d = 1; d < 32; d <<= 1) { const int tu = __shfl_up(ti, d), ou = __shfl_up(oi, d); if ((lane & 31) >= d) { ti += tu; oi += ou; } }
        if (lane < NEXP) { F.MISC[128 + lane] = (unsigned)cnt; F.MISC[160 + lane] = (unsigned)(ti - t); F.MISC[192 + lane] = (unsigned)(oi - cnt); }
        if (lane == NEXP - 1) F.MISC[224] = (unsigned)ti; }
    LDS_WAIT(); __syncthreads();
}
__device__ __forceinline__ bool moe_find(volatile LAS unsigned* MISC, int lane, int T, int& e, int& rt, int& rows, int& off) {
    if (T >= (int)MISC[224]) return false;
    const int l = lane & 31; const int cnt = (int)MISC[128 + l], tpre = (int)MISC[160 + l];
    const unsigned long long mask = __ballot(lane < NEXP && cnt > 0 && T >= tpre);
    e = __builtin_amdgcn_readfirstlane(63 - __builtin_clzll(mask));
    rt = T - (int)MISC[160 + e]; const int c = (int)MISC[128 + e]; off = (int)MISC[192 + e];
    rows = c - rt * 256; if (rows > 256) rows = 256; return true;
}
struct SchedMoe1 {
    int G, c, lane; volatile LAS unsigned* MISC; const int* list; const char* HX2; const char* W1T; const char* W3T; char* HH; unsigned* tile_cnt;
    __device__ __forceinline__ bool next(int i, gm::Unit& u) const {
        const int vc = (c & 7) * (G >> 3) + (c >> 3);
        const int L = i * G + vc; int e, rt, rows, off; if (!moe_find(MISC, lane, L >> 2, e, rt, rows, off)) return false;
        const int pn = L & 3;
        e = __builtin_amdgcn_readfirstlane(e); rt = __builtin_amdgcn_readfirstlane(rt); rows = __builtin_amdgcn_readfirstlane(rows); off = __builtin_amdgcn_readfirstlane(off);
        u.A = HX2; u.B0 = W1T + ((size_t)e * DEXP + pn * 128) * 2048; u.B1 = W3T + ((size_t)e * DEXP + pn * 128) * 2048;
        u.dst = HH + ((size_t)(off + rt * 256) * DEXP + pn * 128) * 2; u.pm = rt; u.pn = pn; u.e = e; u.rows = rows; u.t = L >> 2; return true;
    }
    __device__ __forceinline__ unsigned arow(const gm::Unit& u, int r) const { const int rr = r < u.rows ? r : u.rows - 1; return (unsigned)(list[(size_t)u.e * CAP + u.pm * 256 + rr] >> 1); }
    __device__ __forceinline__ void a_ready(const gm::Unit&) const {}
    __device__ __forceinline__ void done(const gm::Unit& u) const {
        asm volatile("s_waitcnt vmcnt(0)" ::: "memory");
        __builtin_amdgcn_s_barrier(); asm volatile("" ::: "memory");
        if (threadIdx.x == 0) __hip_atomic_fetch_add(tile_cnt + 8 * u.t, 1u, __ATOMIC_RELAXED, __HIP_MEMORY_SCOPE_AGENT);
    }
};
struct EpiMoe1 {
    static constexpr bool PERM = true;
    char* HH;
    __device__ __forceinline__ void operator()(const f32x4 (&acc)[2][2][4][2], const gm::Unit& u, int wr, int wc, int fr, int fq) const {
        const __amdgpu_buffer_rsrc_t rs = __builtin_amdgcn_make_buffer_rsrc((void*)HH, 0, 0x7fffffff, 0x00020000);
        const unsigned base = (unsigned)(u.dst - HH) + (unsigned)(((wr * 64 + fr) * DEXP + wc * 32 + 8 * fq) * 2);
#pragma unroll
        for (int ai = 0; ai < 2; ++ai)
#pragma unroll
            for (int m = 0; m < 4; ++m) { const int r = ai * 128 + wr * 64 + m * 16 + fr; if (r >= u.rows) continue;
                const f32x4 u0 = acc[ai][0][m][0], u1 = acc[ai][0][m][1], v0 = acc[ai][1][m][0], v1 = acc[ai][1][m][1];
                u32x4 w; w.x = gm::cvt_pk_bf16(siluf_(u0[0]) * v0[0], siluf_(u0[1]) * v0[1]); w.y = gm::cvt_pk_bf16(siluf_(u0[2]) * v0[2], siluf_(u0[3]) * v0[3]);
                w.z = gm::cvt_pk_bf16(siluf_(u1[0]) * v1[0], siluf_(u1[1]) * v1[1]); w.w = gm::cvt_pk_bf16(siluf_(u1[2]) * v1[2], siluf_(u1[3]) * v1[3]);
                __builtin_amdgcn_raw_buffer_store_b128(w, rs, base + (unsigned)((ai * 128 + m * 16) * DEXP * 2), 0, 16); }
    }
};
struct SchedMoe2 {
    int G, c, lane; volatile LAS unsigned* MISC; const char* HH; const char* W2T; char* Y; unsigned* tile_cnt; unsigned* tmo;
    __device__ __forceinline__ bool next(int i, gm::Unit& u) const {
        const int vc = (c & 7) * (G >> 3) + (c >> 3);
        const int L = i * G + (G - 1 - vc); int e, rt, rows, off; if (!moe_find(MISC, lane, L >> 2, e, rt, rows, off)) return false;
        const int pn = L & 3;
        e = __builtin_amdgcn_readfirstlane(e); rt = __builtin_amdgcn_readfirstlane(rt); rows = __builtin_amdgcn_readfirstlane(rows); off = __builtin_amdgcn_readfirstlane(off);
        u.A = HH + (size_t)(off + rt * 256) * DEXP * 2; u.B0 = W2T + ((size_t)e * DM + pn * 256) * (DEXP * 2); u.B1 = u.B0 + (size_t)128 * (DEXP * 2);
        u.dst = Y + (size_t)pn * 256 * 2; u.pm = rt; u.pn = pn; u.e = e; u.rows = rows; u.t = L >> 2; return true;
    }
    __device__ __forceinline__ unsigned arow(const gm::Unit&, int r) const { return (unsigned)r; }
    __device__ __forceinline__ void a_ready(const gm::Unit& u) const {
        if (threadIdx.x < 64) {
            unsigned spins = 0;
            while ((unsigned)__builtin_amdgcn_readfirstlane(__hip_atomic_load(tile_cnt + 8 * u.t, __ATOMIC_RELAXED, __HIP_MEMORY_SCOPE_AGENT)) < 4u) {
                __builtin_amdgcn_s_sleep(2);
                if (++spins > (1u << 22)) { if (threadIdx.x == 0) __hip_atomic_store(tmo, 1u, __ATOMIC_RELAXED, __HIP_MEMORY_SCOPE_AGENT); break; } }
            __builtin_amdgcn_fence(__ATOMIC_ACQUIRE, "agent");
            asm volatile("s_waitcnt vmcnt(0)" ::: "memory");
        }
        asm volatile("" ::: "memory"); __builtin_amdgcn_s_barrier(); asm volatile("" ::: "memory");
    }
    __device__ __forceinline__ void done(const gm::Unit&) const {}
};
struct EpiMoe2 {
    static constexpr bool PERM = true;
    const int* list;
    __device__ __forceinline__ void operator()(const f32x4 (&acc)[2][2][4][2], const gm::Unit& u, int wr, int wc, int fr, int fq) const {
        const int* lp = list + (size_t)u.e * CAP + u.pm * 256;
#pragma unroll
        for (int ai = 0; ai < 2; ++ai)
#pragma unroll
            for (int m = 0; m < 4; ++m) { const int r = ai * 128 + wr * 64 + m * 16 + fr; if (r >= u.rows) continue;
                const int slot = lp[r]; bf16* rowp = (bf16*)u.dst + (size_t)slot * DM + wc * 32 + 8 * fq;
#pragma unroll
                for (int bj = 0; bj < 2; ++bj) { const f32x4 v0 = acc[ai][bj][m][0], v1 = acc[ai][bj][m][1];
                    u32x4 w; w.x = gm::cvt_pk_bf16(v0[0], v0[1]); w.y = gm::cvt_pk_bf16(v0[2], v0[3]); w.z = gm::cvt_pk_bf16(v1[0], v1[1]); w.w = gm::cvt_pk_bf16(v1[2], v1[3]);
                    *(u32x4*)(rowp + bj * 128) = w; } }
    }
};

__device__ __forceinline__ void p_final(Frame& F, const Args& a) {
    const float* mod = (const float*)(F.ws + WS_MOD); const float* fg = a.in[IN_FG]; const float* wt = (const float*)(F.ws + WS_WT);
    const bf16* Y = (const bf16*)(F.ws + WS_Y); float* X1 = F.out;
    for (int r = F.wave; r < 64; r += NWAVES) {
        const int tok = F.bid * 64 + r; const int b = tok >> 11;
        const float w0 = wt[tok * 2], w1 = wt[tok * 2 + 1];
        f32x4* xr = (f32x4*)(X1 + (size_t)tok * DM) + F.lane;
        const u32x2* y0 = (const u32x2*)(Y + (size_t)(tok * 2) * DM) + F.lane; const u32x2* y1 = (const u32x2*)(Y + (size_t)(tok * 2 + 1) * DM) + F.lane;
        f32x4 v[4]; float s = 0.f;
#pragma unroll
        for (int j = 0; j < 4; ++j) { const int k = 4 * F.lane + 256 * j;
            const f32x4 xv = xr[64 * j]; const u32x2 a0 = y0[64 * j], a1 = y1[64 * j]; const f32x4 g5 = *(const f32x4*)(mod + b * 6144 + 5 * DM + k);
            v[j].x = xv.x + g5.x * (w0 * bflo(a0.x) + w1 * bflo(a1.x)); v[j].y = xv.y + g5.y * (w0 * bfhi(a0.x) + w1 * bfhi(a1.x));
            v[j].z = xv.z + g5.z * (w0 * bflo(a0.y) + w1 * bflo(a1.y)); v[j].w = xv.w + g5.w * (w0 * bfhi(a0.y) + w1 * bfhi(a1.y));
            s += (v[j].x * v[j].x + v[j].y * v[j].y) + (v[j].z * v[j].z + v[j].w * v[j].w); }
        const float rstd = rsqrtf(wave_sum(s) * (1.f / DM) + EPS);
#pragma unroll
        for (int j = 0; j < 4; ++j) { const int k = 4 * F.lane + 256 * j; const f32x4 g = *(const f32x4*)(fg + k);
            xr[64 * j] = (f32x4){v[j].x * rstd * g.x, v[j].y * rstd * g.y, v[j].z * rstd * g.z, v[j].w * rstd * g.w}; }
    }
}
#ifndef LRU_FAST
#define LRU_FAST 1
#endif
#ifndef HG_FAST
#define HG_FAST 1
#endif
#define MIX_FAST (LRU_FAST && HG_FAST)
#ifdef PROBE_A
#define STAMP(k) do { if (F.bid == 0 && F.tid == 0) { const unsigned long long _t = __builtin_amdgcn_s_memrealtime(); F.MISC[32 + 2 * (k)] = (unsigned)_t; F.MISC[33 + 2 * (k)] = (unsigned)(_t >> 32); } } while (0)
#else
#define STAMP(k) do { } while (0)
#endif
__device__ __forceinline__ void p_mix1(Frame& F, const Args& a) {
#if LRU_FAST
    for (int u = F.bid; u < NB * 8 * LRU_NCH; u += F.G) lru_pass1(F, a, u);
#endif
    STAMP(14); STAMP(15);
#if HG_FAST
    for (int i = 0, u = F.bid; u < NB * 8 * 2 * 4; u += F.G, ++i) hg_pass1(F, a, (u & ~3) | ((u + 2 * i) & 3));
#endif
}
__device__ __forceinline__ void p_mix2(Frame& F, const Args& a) {
#if LRU_FAST
    for (int u = F.bid; u < NB * 8 * LRU_NCH; u += F.G) lru_pass2(F, a, u);
#endif
    STAMP(16); STAMP(17);
#if HG_FAST
    for (int u = F.bid; u < NB * 8 * 2 * 4; u += F.G) hg_pass2(F, a, u);
#endif
}
__global__ void __launch_bounds__(NTHR, 2) mega(Args args) {
    extern __shared__ __attribute__((aligned(16))) unsigned char lds_raw[];
    Frame F;
    F.lds = (LAS unsigned char*)lds_raw; F.MISC = (volatile LAS unsigned*)(F.lds + LDSCTL_OFF);
    F.tid = threadIdx.x; F.lane = F.tid & 63; F.wave = __builtin_amdgcn_readfirstlane(F.tid >> 6);
    F.G = gridDim.x; F.bid = blockIdx.x; F.ws = args.ws; F.out = args.out; F.ctl = (unsigned*)(args.ws + WS_CTL);
    for (int u = F.tid; u < (LDS_BYTES - LDSCTL_OFF) / 4; u += NTHR) ((LAS unsigned*)(F.lds + LDSCTL_OFF))[u] = 0u;
    __syncthreads();
    XcdBarrier bar = xcd_barrier_post(F.ctl + CW_BAR + args.li * 3584, F.MISC + 8);
    const int lo = args.ph_lo, hi = args.ph_hi;
#define IN(k) (lo <= (k) && (k) < hi)
#define SEAM(k) do { if (IN(k) && IN((k) + 1)) xcd_barrier(bar); STAMP((k) + 1); if ((k) == 9) STAMP(11); } while (0)
    unsigned char* ws = F.ws;
    STAMP(0);
    if (IN(0)) { p0_prologue(F, args); } SEAM(0);
    if (IN(1)) { p1_norm(F, args); } SEAM(1);
    if (IN(2)) {
        SchedP2 S{F.G, F.bid, (const char*)F.out, (const char*)(ws + WS_WIN), (char*)(ws + WS_P), (char*)(ws + WS_PC)};
        EpiStoreBf16 E;
        gm::gemm_phase<SchedP2, EpiStoreBf16, false>(F.lds, DM, S, E);
    } SEAM(2);
    if (IN(3)) { p_mix1(F, args); } SEAM(3);
    if (IN(4)) { p_mix2(F, args); } SEAM(4);
    if (IN(5)) { p_ybg(F, args); p_moe_weights13(F, args); p_moe_weights2(F, args, F.bid, F.G); } SEAM(5);
    if (IN(6)) {
        SchedP5 S{F.bid, (const char*)(ws + WS_YAG), (const char*)(ws + WS_YBG), (const char*)(ws + WS_WPA), (const char*)(ws + WS_WPB), nullptr, (char*)(ws + WS_M)};
        EpiP5 E{F.out + (size_t)F.bid * 65536, (const bf16*)(ws + WS_P + 7 * GS), (const bf16*)(ws + WS_P + 8 * GS)};
        gm::gemm_phase<SchedP5, EpiP5, false>(F.lds, DM, S, E);
    } SEAM(6);
    if (IN(7)) {
        SchedP6 S{F.bid, (const char*)(ws + WS_M), (const char*)(ws + WS_WOUT), (char*)F.out};
        EpiP6 E{args.in[IN_X], (const float*)(ws + WS_MOD)};
        gm::gemm_phase<SchedP6, EpiP6, false>(F.lds, DM, S, E);
    } SEAM(7);
    if (IN(8)) { p_norm2_route(F, args); } SEAM(8);
    if (IN(9)) {
        moe_table(F, (const int*)(F.ctl + CW_CNT));
        {
            SchedMoe1 S{F.G, F.bid, F.lane, F.MISC, (const int*)(ws + WS_LIST), (const char*)(ws + WS_HX2), (const char*)(ws + WS_W1T), (const char*)(ws + WS_W3T), (char*)(ws + WS_HH), F.ctl + CW_TILE};
            EpiMoe1 E{(char*)(ws + WS_HH)};
            gm::gemm_phase<SchedMoe1, EpiMoe1, true, true>(F.lds, DM, S, E);
        }
        {
            SchedMoe2 S{F.G, F.bid, F.lane, F.MISC, (const char*)(ws + WS_HH), (const char*)(ws + WS_W2T), (char*)(ws + WS_Y), F.ctl + CW_TILE, F.ctl + 2};
            EpiMoe2 E{(const int*)(ws + WS_LIST)};
            gm::gemm_phase<SchedMoe2, EpiMoe2, false, true>(F.lds, DEXP, S, E);
        }
    } SEAM(9);
    if (IN(11)) { p_final(F, args); }
#ifdef PROBE_A
    if (F.bid == 0 && F.tid == 0) {
        const unsigned long long tend = __builtin_amdgcn_s_memrealtime();
        F.MISC[32 + 2 * 12] = (unsigned)tend; F.MISC[33 + 2 * 12] = (unsigned)(tend >> 32);
        auto RD = [&](int k) { return ((unsigned long long)F.MISC[33 + 2 * k] << 32) | F.MISC[32 + 2 * k]; };
        auto T = [&](int k) { if (k >= 20) { const int i = k - 20; return (unsigned long long)(((((unsigned long long)F.MISC[103 + 2 * i] << 32) | F.MISC[102 + 2 * i]) + 400) / 800); } if (k == 13) return (unsigned long long)((RD(14) - RD(3) + 400) / 800); if (k == 15) return (unsigned long long)((RD(16) - RD(4) + 400) / 800); const unsigned long long t0 = ((unsigned long long)F.MISC[33 + 2 * k] << 32) | F.MISC[32 + 2 * k], t1 = ((unsigned long long)F.MISC[33 + 2 * (k + 1)] << 32) | F.MISC[32 + 2 * (k + 1)]; return (unsigned long long)((t1 - t0 + 400) / 800); };
        const unsigned long long delay = (T(PROBE_A) + 64ull * T(PROBE_B)) * 6400ull;
        while (__builtin_amdgcn_s_memrealtime() - tend < delay) __builtin_amdgcn_s_sleep(32);
    }
#endif
#undef IN
#undef SEAM
}

#if !LRU_FAST
__global__ void k_conv_f(const bf16* P0, const bf16* PC0, const float* cw, const float* cb, float* Ub, int b) {
    int t = blockIdx.x; int Lseg = t < CTX ? CTX : SEQ; int lt = t < CTX ? t : t - CTX;
    const bf16* base = t < CTX ? PC0 + (size_t)b * CTX * DM : P0 + (size_t)b * SEQ * DM;
    for (int ch = threadIdx.x; ch < DM; ch += 256) {
        float s = cb[ch];
#pragma unroll
        for (int k = 0; k < 4; ++k) { int tt = lt + k - 2; if (tt >= 0 && tt < Lseg) s += cw[k * DM + ch] * bf2f(base[(size_t)tt * DM + ch]); }
        Ub[(size_t)t * DM + ch] = s;
    }
}
__global__ void k_gates(const float* Ub, const float* wa, const float* ba, const float* wx, const float* bx, const float* lam, float* Aout, float* Bout, int d) {
    __shared__ float us[128];
    int t = blockIdx.x, h = blockIdx.y, j = threadIdx.x; int ch = h * 128 + j;
    float uval = Ub[(size_t)t * DM + ch];
    us[j] = uval; __syncthreads();
    const float* wah = wa + ((size_t)(d * 8 + h) * 128) * 128; const float* wxh = wx + ((size_t)(d * 8 + h) * 128) * 128;
    float ra = 0.f, ia = 0.f;
    for (int i = 0; i < 128; ++i) { float u = us[i]; ra += u * wah[i * 128 + j]; ia += u * wxh[i * 128 + j]; }
    float r = 1.f / (1.f + expf(-(ra + ba[d * DM + ch]))); float ig = 1.f / (1.f + expf(-(ia + bx[d * DM + ch])));
    float sp = log1pf(expf(-lam[d * DM + ch]));
    float log_a = -8.f * r * sp;
    Aout[(size_t)t * DM + ch] = expf(log_a); Bout[(size_t)t * DM + ch] = sqrtf(-expm1f(2.f * log_a)) * (ig * uval);
}
__global__ void k_lru_scan(const float* A0, const float* B0, const float* A1, const float* B1, float* YF, float* YB) {
    int g = blockIdx.x * 256 + threadIdx.x; int d = g / DM, ch = g % DM;
    if (d == 0) { float h = B0[ch];
        for (int t = 0; t < SEQ; ++t) { size_t o = (size_t)(CTX + t) * DM + ch; h = A0[o] * h + B0[o]; YF[(size_t)t * DM + ch] = h; }
    } else { float h = B1[(size_t)(CTX - 1) * DM + ch];
        for (int t = SEQ - 1; t >= 0; --t) { size_t o = (size_t)(CTX + t) * DM + ch; h = A1[o] * h + B1[o]; YB[(size_t)t * DM + ch] = h; }
    }
}
__global__ void k_yag_f(const float* YF, const float* YB, bf16* AY, int b) {
    int t = blockIdx.x;
    for (int ch = threadIdx.x; ch < DM; ch += 256) { size_t o = (size_t)t * DM + ch; bf16* p = AY + ((size_t)b * SEQ + t) * DM + ch;
        *p = (bf16)f2bf((YF[o] + YB[o]) * gelu_tanh(bf2f(*p))); }
}
#endif
#if !HG_FAST
__global__ __launch_bounds__(128) void k_hgrn_f(unsigned char* ws, const float* hg_lb) {
    __shared__ float gs[128], ks[128], qs[128];
    int h = blockIdx.x, d = blockIdx.y, b = blockIdx.z, j = threadIdx.x;
    float S[128];
#pragma unroll
    for (int i = 0; i < 128; ++i) S[i] = 0.f;
    const int c = h * 128 + j;
    const float lbj = 1.f / (1.f + expf(hg_lb[DM + c] - hg_lb[c]));
    bf16* Q = (bf16*)(ws + WS_P + 2 * GS); bf16* Fx = (bf16*)(ws + WS_P + (d == 0 ? 3 : 4) * GS); bf16* V = (bf16*)(ws + WS_P + 5 * GS);
    const bf16* Fc = (const bf16*)(ws + WS_PC + (d == 0 ? 1 : 2) * CGS); const bf16* Vc = (const bf16*)(ws + WS_PC + 3 * CGS);
    for (int s = 0; s < LT; ++s) {
        bool isx = s >= CTX; float fv, vv, qv = 0.f; size_t o;
        if (!isx) { int t = d == 0 ? s : (CTX - 1 - s); o = ((size_t)b * CTX + t) * DM + c; fv = bf2f(Fc[o]); vv = bf2f(Vc[o]); }
        else { int p = s - CTX; if (d == 1) p = SEQ - 1 - p; int tok = (p % 32) * 64 + (p / 32); o = ((size_t)b * SEQ + tok) * DM + c; fv = bf2f(Fx[o]); vv = bf2f(V[o]); qv = bf2f(Q[o]); }
        float gg = lbj + (1.f - lbj) / (1.f + expf(-fv));
        gs[j] = gg; ks[j] = 1.f - gg; qs[j] = qv / (1.f + expf(-qv));
        __syncthreads();
        float oo = 0.f;
#pragma unroll
        for (int i = 0; i < 128; ++i) { S[i] = gs[i] * S[i] + ks[i] * vv; oo += S[i] * qs[i]; }
        if (isx) Fx[o] = (bf16)f2bf(oo);
        __syncthreads();
    }
}
#endif

extern "C" void kernel_launch(void* const* d_in, const int* in_sizes, int n_in, void* d_out, int out_size, void* d_ws, size_t ws_size, hipStream_t stream) {
    static int grid = 0;
    if (grid == 0) {
        if (n_in != 29 || out_size != NTOK * DM || ws_size < WS_END) { fprintf(stderr, "kernel_launch: unexpected problem shape / workspace (%d inputs, out %d, ws %zu)\n", n_in, out_size, ws_size); grid = -1; return; }
        int dev = 0, cus = 0, per_cu = 0;
        if (hipGetDevice(&dev) != hipSuccess || hipDeviceGetAttribute(&cus, hipDeviceAttributeMultiprocessorCount, dev) != hipSuccess) { grid = -1; return; }
        if (hipFuncSetAttribute((const void*)mega, hipFuncAttributeMaxDynamicSharedMemorySize, LDS_BYTES) != hipSuccess) { grid = -1; return; }
        if (hipOccupancyMaxActiveBlocksPerMultiprocessor(&per_cu, (const void*)mega, NTHR, LDS_BYTES) != hipSuccess || per_cu < 1) { fprintf(stderr, "kernel_launch: occupancy query says %d blocks per CU\n", per_cu); }
        (void)hipGetLastError();
        grid = cus;
        if (grid != 256) { fprintf(stderr, "kernel_launch: built for 256 CUs, found %d\n", cus); grid = -1; return; }
    }
    if (grid < 0) return;
    hipMemsetAsync((char*)d_ws + WS_CTL, 0, CTL_BYTES, stream);
    Args a{};
    for (int i = 0; i < 29; ++i) a.in[i] = (const float*)d_in[i];
    a.out = (float*)d_out; a.ws = (unsigned char*)d_ws;
#if MIX_FAST
    a.ph_lo = 0; a.ph_hi = 12; a.li = 0;
    hipLaunchKernelGGL(mega, dim3(grid), dim3(NTHR), LDS_BYTES, stream, a);
#else
    a.ph_lo = 0; a.ph_hi = 5; a.li = 0;
    hipLaunchKernelGGL(mega, dim3(grid), dim3(NTHR), LDS_BYTES, stream, a);
    {
        unsigned char* ws = (unsigned char*)d_ws;
#if !LRU_FAST
        float* sc = (float*)d_out;
        float* Ub = sc; float* A0 = Ub + (size_t)LT * DM; float* B0 = A0 + (size_t)LT * DM; float* A1 = B0 + (size_t)LT * DM; float* B1 = A1 + (size_t)LT * DM;
        float* YF = B1 + (size_t)LT * DM; float* YB = YF + (size_t)SEQ * DM;
        const float* cw = (const float*)d_in[IN_CONVW]; const float* cb = (const float*)d_in[IN_CONVB];
        const float* wa = (const float*)d_in[IN_WA]; const float* ba = (const float*)d_in[IN_BA]; const float* wx = (const float*)d_in[IN_WX]; const float* bx = (const float*)d_in[IN_BX]; const float* lam = (const float*)d_in[IN_LAM];
        for (int b = 0; b < NB; ++b) {
            k_conv_f<<<LT, 256, 0, stream>>>((const bf16*)(ws + WS_P), (const bf16*)(ws + WS_PC), cw, cb, Ub, b);
            k_gates<<<dim3(LT, 8), 128, 0, stream>>>(Ub, wa, ba, wx, bx, lam, A0, B0, 0);
            k_gates<<<dim3(LT, 8), 128, 0, stream>>>(Ub, wa, ba, wx, bx, lam, A1, B1, 1);
            k_lru_scan<<<8, 256, 0, stream>>>(A0, B0, A1, B1, YF, YB);
            k_yag_f<<<SEQ, 256, 0, stream>>>(YF, YB, (bf16*)(ws + WS_YAG), b);
        }
#endif
#if !HG_FAST
        k_hgrn_f<<<dim3(8, 2, NB), 128, 0, stream>>>(ws, (const float*)d_in[IN_HGLB]);
#endif
    }
    a.ph_lo = 5; a.ph_hi = 12; a.li = 1;
    hipLaunchKernelGGL(mega, dim3(grid), dim3(NTHR), LDS_BYTES, stream, a);
#endif
}
```

```cpp
#include <hip/hip_runtime.h>
#include <cstdio>
#include <cstdint>
#include <math.h>

#define LAS __attribute__((address_space(3)))
#define GAS __attribute__((address_space(1)))
typedef unsigned short bf16;
typedef short bf16x8 __attribute__((ext_vector_type(8)));
typedef float f32x4 __attribute__((ext_vector_type(4)));
typedef float f32x2 __attribute__((ext_vector_type(2)));
typedef unsigned u32x4 __attribute__((ext_vector_type(4)));
typedef unsigned u32x2 __attribute__((ext_vector_type(2)));

constexpr int DM = 1024, NB = 8, SEQ = 2048, CTX = 256, NTOK = NB * SEQ, NCTX = NB * CTX, INW = 9216, LT = CTX + SEQ;
constexpr int NEXP = 32, DEXP = 512, CAP = 16384;
constexpr float EPS = 1e-6f;
constexpr int NWAVES = 8, NTHR = 512;

constexpr size_t MiB = 1u << 20, KiB = 1024;
constexpr size_t WS_CTL = 0, CTL_BYTES = 64 * KiB;
constexpr size_t WS_MODP = 256 * KiB;
constexpr size_t WS_MOD = 2 * MiB;
constexpr size_t WS_LRUAGG = 2 * MiB + 512 * KiB;
constexpr size_t WS_LRUS0 = 4 * MiB + 512 * KiB;
constexpr size_t WS_WT = 4 * MiB + 768 * KiB;
constexpr size_t WS_LIST = 5 * MiB;
constexpr size_t WS_HGD = 7 * MiB;
constexpr size_t WS_WRT = 7 * MiB + 256 * KiB;
constexpr size_t WS_WIN = 8 * MiB;
constexpr size_t WS_WPA = 26 * MiB, WS_WPB = 28 * MiB, WS_WOUT = 30 * MiB;
constexpr size_t WS_WLRU = 32 * MiB;
constexpr size_t WS_P = 33 * MiB, GS = 32 * MiB;
constexpr size_t WS_PC = 321 * MiB, CGS = 4 * MiB;
constexpr size_t WS_END = 337 * MiB;
constexpr size_t WS_W1T = WS_P + 0 * GS, WS_W3T = WS_P + 2 * GS, WS_W2T = WS_P + 5 * GS;
constexpr size_t WS_YAG = WS_P + 1 * GS;
constexpr size_t WS_OF = WS_P + 3 * GS, WS_OB = WS_P + 4 * GS;
constexpr size_t WS_YBG = WS_P + 3 * GS;
constexpr size_t WS_M = WS_P + 4 * GS;
constexpr size_t WS_HX2 = WS_P + 1 * GS;
constexpr size_t WS_HH = WS_P + 3 * GS;
constexpr size_t WS_Y = WS_P + 6 * GS;

constexpr int CW_BAR = 1024;
constexpr int CW_CNT = 12288;
constexpr int CW_TILE = 14336;

constexpr int RING_BYTES = 131072, LDS_BYTES = 147456, LDSCTL_OFF = LDS_BYTES - 1024;

#define LDS_WAIT() asm volatile("s_waitcnt lgkmcnt(0)" ::: "memory")
#define VM_WAIT() asm volatile("s_waitcnt vmcnt(0)" ::: "memory")

typedef __bf16 bf16x2_t __attribute__((ext_vector_type(2)));
__device__ __forceinline__ unsigned pk2(float lo, float hi) { const f32x2 v = {lo, hi}; return __builtin_bit_cast(unsigned, __builtin_convertvector(v, bf16x2_t)); }
__device__ __forceinline__ unsigned f2bf(float f) { return pk2(f, 0.f) & 0xffffu; }
__device__ __forceinline__ float bf2f(unsigned short b) { return __builtin_bit_cast(float, (unsigned)b << 16); }
__device__ __forceinline__ float bflo(unsigned w) { return __builtin_bit_cast(float, w << 16); }
__device__ __forceinline__ float bfhi(unsigned w) { return __builtin_bit_cast(float, w & 0xffff0000u); }
__device__ __forceinline__ float sigmoidf_(float x) { return 1.f / (1.f + __expf(-x)); }
__device__ __forceinline__ float siluf_(float x) { return x / (1.f + __expf(-x)); }
__device__ __forceinline__ float gelu_tanh(float x) { float u = 0.7978845608028654f * (x + 0.044715f * x * x * x); float e = __expf(2.f * u); return x * (1.f - 1.f / (1.f + e)); }
__device__ __forceinline__ float wave_sum(float v) {
#pragma unroll
    for (int o = 1; o < 64; o <<= 1) v += __shfl_xor(v, o);
    return v;
}

#define XB_TMO      128
#define XB_XCNT(j)  (256  + 64 * (j))
#define XB_XSUB(j)  (1280 + 64 * (j))
#define XB_XGEN(j)  (2304 + 64 * (j))
#define XB_TOP      3328
#define XB_TOPGEN   3392
#define XCD_BAR_WORDS 3456
#define XB_SPIN_CAP (1u << 20)
__device__ __forceinline__ unsigned xb_ld(unsigned* p)              { return __hip_atomic_load(p, __ATOMIC_RELAXED, __HIP_MEMORY_SCOPE_AGENT); }
__device__ __forceinline__ unsigned xb_add(unsigned* p, unsigned v) { return __hip_atomic_fetch_add(p, v, __ATOMIC_RELAXED, __HIP_MEMORY_SCOPE_AGENT); }
__device__ __forceinline__ unsigned xb_xcc_id() { return (unsigned)__builtin_amdgcn_s_getreg((3 << 11) | 20) & 0xFu; }
#define XB_SPIN(cond, bar) do { unsigned _sp = 0; while (cond) { __builtin_amdgcn_s_sleep(1); \
    if ((++_sp & 255u) == 0u) { if (xb_ld(&(bar)[XB_TMO])) break; if (_sp > XB_SPIN_CAP) { atomicAdd(&(bar)[XB_TMO], 1u); break; } } } } while (0)
struct XcdBarrier { unsigned* bar; unsigned x; volatile LAS unsigned* st; };
__device__ __forceinline__ XcdBarrier xcd_barrier_post(unsigned* bar, volatile LAS unsigned* st) {
    XcdBarrier b; b.bar = bar; b.x = xb_xcc_id(); b.st = st;
    if (threadIdx.x == 0) (void)xb_add(&bar[XB_XCNT(b.x)], 1u);
    return b;
}
__device__ __forceinline__ void xcd_barrier_complete(unsigned* bar, unsigned x, unsigned& nloc, unsigned& nx) {
    const unsigned G = gridDim.x * gridDim.y * gridDim.z;
    unsigned sum, cnt, mine, sp = 0u;
    for (;;) {
        sum = 0u; cnt = 0u; mine = 0u;
#pragma unroll
        for (unsigned j = 0; j < 16; ++j) { const unsigned c = xb_ld(&bar[XB_XCNT(j)]); sum += c; cnt += (c > 0u) ? 1u : 0u; mine = (j == x) ? c : mine; }
        if (sum == G) break;
        __builtin_amdgcn_s_sleep(1);
        if ((++sp & 255u) == 0u) { if (xb_ld(&bar[XB_TMO])) break; if (sp > XB_SPIN_CAP) { atomicAdd(&bar[XB_TMO], 1u); break; } }
    }
    nloc = mine > 0u ? mine : 1u; nx = cnt > 0u ? cnt : 1u;
}
__device__ __forceinline__ void xcd_barrier(const XcdBarrier& b) {
    asm volatile("s_waitcnt vmcnt(0)" ::: "memory");
    __syncthreads();
    if (threadIdx.x == 0) {
        unsigned* bar = b.bar;
        __builtin_amdgcn_s_waitcnt(0);
        unsigned nloc = b.st[0], nx = b.st[1];
        if (nloc == 0u) { xcd_barrier_complete(bar, b.x, nloc, nx); b.st[0] = nloc; b.st[1] = nx; }
        const unsigned old = xb_add(&bar[XB_XSUB(b.x)], 1u);
        const unsigned gen = old / nloc;
        if (old + 1u == (gen + 1u) * nloc) {
            __builtin_amdgcn_fence(__ATOMIC_RELEASE, "agent");
            asm volatile("s_waitcnt vmcnt(0)" ::: "memory");
            const unsigned og = xb_add(&bar[XB_TOP], 1u);
            const unsigned tg = og / nx;
            if (og + 1u == (tg + 1u) * nx) xb_add(&bar[XB_TOPGEN], 1u);
            else XB_SPIN(xb_ld(&bar[XB_TOPGEN]) == tg, bar);
            __builtin_amdgcn_fence(__ATOMIC_ACQUIRE, "agent");
            xb_add(&bar[XB_XGEN(b.x)], 1u);
            asm volatile("s_waitcnt vmcnt(0)" ::: "memory");
        } else {
            XB_SPIN(xb_ld(&bar[XB_XGEN(b.x)]) == gen, bar);
            __builtin_amdgcn_fence(__ATOMIC_ACQUIRE, "agent");
            asm volatile("s_waitcnt vmcnt(0)" ::: "memory");
        }
    }
    __syncthreads();
}

namespace gm {
constexpr int BM = 256, BK = 64, HALF = 128, HTB = HALF * BK * 2;
__device__ __forceinline__ int lds_byte(int r, int c) { const int st = (r >> 4) * 2 + (c >> 5), rr = r & 15, cc = c & 31, ob = rr * 64 + cc * 2; return st * 1024 + (ob ^ (((ob >> 9) & 1) << 5)); }
__device__ __forceinline__ void stage_rc(int b, int& R, int& C) { const int st = b / 1024, sb = b % 1024, swz = sb ^ (((sb >> 9) & 1) << 5); R = (st >> 1) * 16 + swz / 64; C = (st & 1) * 32 + (swz % 64) / 2; }
__device__ __forceinline__ int perm32(int rho) { const int n = rho >> 4, i = rho & 15; return 8 * (i >> 2) + 4 * n + (i & 3); }
__device__ __forceinline__ unsigned cvt_pk_bf16(float lo, float hi) { unsigned r; asm volatile("v_cvt_pk_bf16_f32 %0, %1, %2" : "=v"(r) : "v"(lo), "v"(hi)); return r; }

struct Unit { const char* A; const char* B0; const char* B1; char* dst; int pm, pn, e, rows, t; };

template <class Sched, class Epi, bool GATHER, bool HOOKS = false>
__device__ __forceinline__ void gemm_phase(LAS unsigned char* lds, const int K, const Sched& S, const Epi& E) {
    const int tid = threadIdx.x, wid = __builtin_amdgcn_readfirstlane(tid >> 6), lane = tid & 63, wr = wid >> 2, wc = wid & 3, fr = lane & 15, fq = lane >> 4;
    const int nt = K / BK;
    unsigned voffB[2]; int Rr[2]; unsigned Cb[2];
#pragma unroll
    for (int i = 0; i < 2; ++i) { int R, C; stage_rc(tid * 16 + i * 8192, R, C); const int Rb = Epi::PERM ? ((R & ~31) + perm32(R & 31)) : R;
        Rr[i] = R; Cb[i] = (unsigned)C * 2u; voffB[i] = (unsigned)(Rb * K + C) * 2u; }
    const unsigned rowb = (unsigned)K * 2u;
    const size_t kstep = (size_t)(BK * 2);
    const unsigned ldsw = (unsigned)wid * 1024u;
    const int aoff = lds_byte(wr * 64 + fr, fq * 8), boff = lds_byte(wc * 32 + fr, fq * 8);
#define GM_SA(b, h) (((b) * 2 + (h)) * HTB)
#define GM_SB(b, h) ((4 + (b) * 2 + (h)) * HTB)
#define GM_STAGE(bufoff, gbase, voff) do { _Pragma("unroll") for (int _i = 0; _i < 2; ++_i) \
        __builtin_amdgcn_global_load_lds((const unsigned*)((const char*)(gbase) + (voff)[_i]), (LAS unsigned*)(lds + (bufoff) + ldsw + _i * 8192), 16, 0, 0); } while (0)
#define GM_LDA(dst, b, h) do { _Pragma("unroll") for (int m = 0; m < 4; ++m) _Pragma("unroll") for (int k = 0; k < 2; ++k) dst[m][k] = *(const LAS bf16x8*)(lds + GM_SA(b, h) + aoff + m * 2048 + k * 1024); } while (0)
#define GM_LDB(dst, b, h) do { _Pragma("unroll") for (int n = 0; n < 2; ++n) _Pragma("unroll") for (int k = 0; k < 2; ++k) dst[n][k] = *(const LAS bf16x8*)(lds + GM_SB(b, h) + boff + n * 2048 + k * 1024); } while (0)
#define GM_MMA(ai, bj, At, Bt) do { __builtin_amdgcn_s_setprio(1); _Pragma("unroll") for (int m = 0; m < 4; ++m) _Pragma("unroll") for (int n = 0; n < 2; ++n) _Pragma("unroll") for (int k = 0; k < 2; ++k) \
        acc[ai][bj][m][n] = __builtin_amdgcn_mfma_f32_16x16x32_bf16(Bt[n][k], At[m][k], acc[ai][bj][m][n], 0, 0, 0); __builtin_amdgcn_s_setprio(0); } while (0)
#define GM_WAIT_V(n) asm volatile("s_waitcnt vmcnt(" #n ")" ::: "memory")
#define GM_WAIT_L(n) asm volatile("s_waitcnt lgkmcnt(" #n ")" ::: "memory")
#define GM_BAR __builtin_amdgcn_s_barrier()
#define GM_SCHED __builtin_amdgcn_sched_barrier(0)
#define GM_AOFFS(u, o) do { _Pragma("unroll") for (int _h = 0; _h < 2; ++_h) _Pragma("unroll") for (int _i = 0; _i < 2; ++_i) \
        (o)[_h][_i] = (GATHER ? S.arow((u), _h * HALF + Rr[_i]) : (unsigned)(_h * HALF + Rr[_i])) * rowb + Cb[_i]; } while (0)
    Unit cur, nxt; int ui = 0;
    if (!S.next(0, cur)) return;
    f32x4 acc[2][2][4][2];
#pragma unroll
    for (int a = 0; a < 2; ++a)
#pragma unroll
        for (int b = 0; b < 2; ++b)
#pragma unroll
            for (int m = 0; m < 4; ++m)
#pragma unroll
                for (int n = 0; n < 2; ++n) acc[a][b][m][n] = (f32x4){0.f, 0.f, 0.f, 0.f};
    bf16x8 At[4][2], B0[2][2], B1[2][2];
    unsigned ca[2][2], na[2][2];
    GM_AOFFS(cur, ca);
    const char* cA = cur.A; const char* cB0 = cur.B0; const char* cB1 = cur.B1;
    if constexpr (HOOKS) S.a_ready(cur);
    GM_STAGE(GM_SB(0, 0), cB0, voffB); GM_STAGE(GM_SB(0, 1), cB1, voffB); GM_STAGE(GM_SA(0, 0), cA, ca[0]); GM_STAGE(GM_SA(0, 1), cA, ca[1]);
    if (wr == 1) GM_BAR;
    GM_WAIT_V(2); GM_BAR;
    GM_STAGE(GM_SB(1, 0), cB0 + kstep, voffB); GM_STAGE(GM_SA(1, 0), cA + kstep, ca[0]); GM_STAGE(GM_SB(1, 1), cB1 + kstep, voffB);
    GM_WAIT_V(6); GM_BAR;
    for (;;) {
        const bool has_next = S.next(ui + 1, nxt);
        const char* nA = has_next ? nxt.A : cA; const char* nB0 = has_next ? nxt.B0 : cB0; const char* nB1 = has_next ? nxt.B1 : cB1;
        if (has_next) { GM_AOFFS(nxt, na); } else {
#pragma unroll
            for (int h = 0; h < 2; ++h)
#pragma unroll
                for (int i = 0; i < 2; ++i) na[h][i] = ca[h][i]; }
        for (int t = 0; t < nt; t += 2) {
            const bool last = (t == nt - 2);
            if constexpr (HOOKS) { if (last && has_next) S.a_ready(nxt); }
            const char* a1 = cA + (size_t)(t + 1) * kstep;
            const char* a2 = last ? nA : cA + (size_t)(t + 2) * kstep;
            const char* b20 = last ? nB0 : cB0 + (size_t)(t + 2) * kstep; const char* b21 = last ? nB1 : cB1 + (size_t)(t + 2) * kstep;
            const char* a3 = a2 + kstep; const char* b30 = b20 + kstep; const char* b31 = b21 + kstep;
            unsigned o2[2][2];
#pragma unroll
            for (int h = 0; h < 2; ++h)
#pragma unroll
                for (int i = 0; i < 2; ++i) o2[h][i] = last ? na[h][i] : ca[h][i];
            GM_LDB(B0, 0, 0); GM_LDB(B1, 0, 1); GM_SCHED; GM_LDA(At, 0, 0); GM_STAGE(GM_SA(1, 1), a1, ca[1]);
            GM_WAIT_V(8); GM_WAIT_L(0); GM_BAR; GM_MMA(0, 0, At, B0); GM_MMA(0, 1, At, B1); GM_BAR; GM_SCHED;
            GM_LDA(At, 0, 1); GM_STAGE(GM_SB(0, 0), b20, voffB); GM_STAGE(GM_SB(0, 1), b21, voffB); GM_STAGE(GM_SA(0, 0), a2, o2[0]);
            GM_WAIT_V(8); GM_WAIT_L(0); GM_BAR; GM_MMA(1, 0, At, B0); GM_MMA(1, 1, At, B1); GM_BAR; GM_SCHED;
            GM_LDB(B0, 1, 0); GM_LDB(B1, 1, 1); GM_SCHED; GM_LDA(At, 1, 0); GM_STAGE(GM_SA(0, 1), a2, o2[1]);
            GM_WAIT_V(8); GM_WAIT_L(0); GM_BAR; GM_MMA(0, 0, At, B0); GM_MMA(0, 1, At, B1); GM_BAR; GM_SCHED;
            GM_LDA(At, 1, 1); GM_STAGE(GM_SB(1, 0), b30, voffB); GM_STAGE(GM_SB(1, 1), b31, voffB); GM_STAGE(GM_SA(1, 0), a3, o2[0]);
            GM_WAIT_V(8); GM_WAIT_L(0); GM_BAR; GM_MMA(1, 0, At, B0); GM_MMA(1, 1, At, B1); GM_BAR; GM_SCHED;
        }
        if (wr == 0) GM_BAR;
        E(acc, cur, wr, wc, fr, fq);
        if constexpr (HOOKS) S.done(cur);
        if (!has_next) break;
#pragma unroll
        for (int a = 0; a < 2; ++a)
#pragma unroll
            for (int b = 0; b < 2; ++b)
#pragma unroll
                for (int m = 0; m < 4; ++m)
#pragma unroll
                    for (int n = 0; n < 2; ++n) acc[a][b][m][n] = (f32x4){0.f, 0.f, 0.f, 0.f};
        cur = nxt; cA = nA; cB0 = nB0; cB1 = nB1; ++ui;
#pragma unroll
        for (int h = 0; h < 2; ++h)
#pragma unroll
            for (int i = 0; i < 2; ++i) ca[h][i] = na[h][i];
        if (wr == 1) GM_BAR;
    }
    GM_WAIT_V(0);
    GM_BAR;
#undef GM_SA
#undef GM_SB
#undef GM_STAGE
#undef GM_LDA
#undef GM_LDB
#undef GM_MMA
#undef GM_WAIT_V
#undef GM_WAIT_L
#undef GM_BAR
#undef GM_SCHED
#undef GM_AOFFS
}
}
struct Args {
    const float* in[29]; float* out; unsigned char* ws; int ph_lo, ph_hi, li, pad;
};
struct Frame {
    LAS unsigned char* lds; volatile LAS unsigned* MISC;
    unsigned* ctl; unsigned char* ws; float* out;
    int tid, lane, wave, G, bid;
};
enum { IN_X = 0, IN_C, IN_CTX, IN_CCTX, IN_WMOD, IN_BMOD, IN_G1, IN_WIN, IN_CONVW, IN_CONVB, IN_WA, IN_BA, IN_WX, IN_BX, IN_LAM, IN_HGLB, IN_HGN,
       IN_WPA, IN_WPB, IN_WOUT, IN_G2, IN_WRG, IN_BRG, IN_WRE, IN_BRE, IN_W1, IN_W3, IN_W2, IN_FG };

constexpr int TR_BYTES = 64 * 64 * 4;
__device__ __forceinline__ void transpose_item(const float* W, int ldw, int K, bf16* WT, int k0, int n0, LAS float* scr, int lane) {
    const int lr = lane >> 4, ls = lane & 15;
    f32x4 v[16];
#pragma unroll
    for (int i = 0; i < 16; ++i) v[i] = *(const f32x4*)(W + (size_t)(k0 + 4 * i + lr) * ldw + n0 + 4 * ls);
#pragma unroll
    for (int i = 0; i < 16; ++i) { const int k = 4 * i + lr; *(LAS f32x4*)(scr + k * 64 + ((ls ^ ((k >> 3) & 7)) << 2)) = v[i]; }
    LDS_WAIT(); asm volatile("" ::: "memory");
    const int c = lane & 7;
#pragma unroll
    for (int j = 0; j < 8; ++j) { const int n = (lane >> 3) + 8 * j; const LAS float* s = scr + (8 * c) * 64 + ((((n >> 2) ^ c) << 2) | (n & 3));
        u32x4 o; o.x = pk2(s[0 * 64], s[1 * 64]); o.y = pk2(s[2 * 64], s[3 * 64]); o.z = pk2(s[4 * 64], s[5 * 64]); o.w = pk2(s[6 * 64], s[7 * 64]);
        *(u32x4*)(WT + (size_t)n * K + k0 + 8 * c) = o; }
    LDS_WAIT(); asm volatile("" ::: "memory");
}

__device__ __forceinline__ void p0_mod_item(Frame& F, const Args& a, int item) {
    const int cb = item % 24, ks = item / 24;
    LAS float* sv = (LAS float*)F.lds;
    LAS float* red = sv + 9 * 128;
    const float* c = a.in[IN_C]; const float* cc = a.in[IN_CCTX]; const float* wmod = a.in[IN_WMOD];
    for (int i = F.tid; i < 9 * 128; i += NTHR) { const int r = i >> 7, k = i & 127; const float v = r < 8 ? c[r * DM + ks * 128 + k] : cc[ks * 128 + k]; sv[i] = siluf_(v); }
    __syncthreads();
    const int col = cb * 256 + (F.tid & 255), kh = F.tid >> 8;
    float acc[9];
#pragma unroll
    for (int r = 0; r < 9; ++r) acc[r] = 0.f;
    for (int k = 0; k < 64; ++k) { const int kk = kh * 64 + k; const float w = wmod[(size_t)(ks * 128 + kk) * 6144 + col];
#pragma unroll
        for (int r = 0; r < 9; ++r) acc[r] += sv[r * 128 + kk] * w; }
    if (kh == 1) {
#pragma unroll
        for (int r = 0; r < 9; ++r) red[r * 256 + (F.tid & 255)] = acc[r]; }
    __syncthreads();
    float* modp = (float*)(F.ws + WS_MODP);
    if (kh == 0) {
#pragma unroll
        for (int r = 0; r < 9; ++r) modp[(size_t)(ks * 9 + r) * 6144 + col] = acc[r] + red[r * 256 + F.tid]; }
    __syncthreads();
}
__device__ __forceinline__ float mod_from_partials(const float* modp, const float* bmod, int row, int j) {
    float s = bmod[j];
#pragma unroll
    for (int ks = 0; ks < 8; ++ks) s += modp[(size_t)(ks * 9 + row) * 6144 + j];
    return s;
}

__device__ __forceinline__ void p0_prologue(Frame& F, const Args& a) {
    if (F.bid < 192) p0_mod_item(F, a, F.bid);
    LAS float* scr = (LAS float*)(F.lds + F.wave * TR_BYTES);
    const int gw = F.bid * NWAVES + F.wave, NGW = F.G * NWAVES;
    constexpr int I_IN = 16 * 144, I_PR = 16 * 16, I_LRU = 32 * 4;
    constexpr int NITEMS = I_IN + 3 * I_PR + I_LRU;
    for (int it = gw; it < NITEMS; it += NGW) {
        int r = it;
        if (r < I_IN) { const int kb = r / 144, nb = r % 144; transpose_item(a.in[IN_WIN], INW, DM, (bf16*)(F.ws + WS_WIN) + (size_t)(nb * 64) * DM, kb * 64, nb * 64, scr, F.lane); continue; } r -= I_IN;
        if (r < 3 * I_PR) { const int w = r / I_PR, q = r % I_PR, kb = q / 16, nb = q % 16;
            const float* W = a.in[w == 0 ? IN_WPA : (w == 1 ? IN_WPB : IN_WOUT)]; bf16* WT = (bf16*)(F.ws + (w == 0 ? WS_WPA : (w == 1 ? WS_WPB : WS_WOUT)));
            transpose_item(W, DM, DM, WT + (size_t)(nb * 64) * DM, kb * 64, nb * 64, scr, F.lane); continue; } r -= 3 * I_PR;
        { const int mat = r / 4, q = r % 4, kb = q / 2, nb = q % 2;
          const int which = mat >> 4, dh = mat & 15;
          const float* W = a.in[which == 0 ? IN_WA : IN_WX] + (size_t)dh * 128 * 128; bf16* WT = (bf16*)(F.ws + WS_WLRU) + (size_t)mat * 128 * 128;
          transpose_item(W, 128, 128, WT + (size_t)(nb * 64) * 128, kb * 64, nb * 64, scr, F.lane); }
    }
    float* wrp = (float*)(F.ws + WS_WRT);
    for (int i = F.bid * NTHR + F.tid; i < 49152 + 48; i += F.G * NTHR) {
        if (i < 49152) { const int j = i & 3, ln = (i >> 2) & 63, sc = i >> 8, c = sc % 3, s2 = sc / 3; const int k = 16 * s2 + 4 * (ln >> 4) + j, o = 16 * c + (ln & 15);
            wrp[i] = o < 4 ? a.in[IN_WRG][k * 4 + o] : (o < 36 ? a.in[IN_WRE][k * 32 + (o - 4)] : 0.f); }
        else { const int o = i - 49152; wrp[i] = o < 4 ? a.in[IN_BRG][o] : (o < 36 ? a.in[IN_BRE][o - 4] : 0.f); }
    }
}

__device__ __forceinline__ void norm_rows(Frame& F, const float* src, bf16* dst, int row0, int nrows, const LAS float* gs, const LAS float* sh) {
    for (int r = F.wave; r < nrows; r += NWAVES) {
        const f32x4* xr = (const f32x4*)(src + (size_t)(row0 + r) * DM) + F.lane;
        f32x4 v[4]; float s = 0.f;
#pragma unroll
        for (int j = 0; j < 4; ++j) { v[j] = xr[64 * j]; s += (v[j].x * v[j].x + v[j].y * v[j].y) + (v[j].z * v[j].z + v[j].w * v[j].w); }
        const float rstd = rsqrtf(wave_sum(s) * (1.f / DM) + EPS);
        unsigned long long* o8 = (unsigned long long*)(dst + (size_t)(row0 + r) * DM) + F.lane;
#pragma unroll
        for (int j = 0; j < 4; ++j) { const int k = 4 * F.lane + 256 * j;
            const f32x4 g = *(const LAS f32x4*)(gs + k), h = *(const LAS f32x4*)(sh + k);
            const float o0 = v[j].x * rstd * g.x + h.x, o1 = v[j].y * rstd * g.y + h.y, o2 = v[j].z * rstd * g.z + h.z, o3 = v[j].w * rstd * g.w + h.w;
            o8[64 * j] = (unsigned long long)pk2(o0, o1) | ((unsigned long long)pk2(o2, o3) << 32); }
    }
}
__device__ __forceinline__ void p1_norm(Frame& F, const Args& a) {
    const float* modp = (const float*)(F.ws + WS_MODP); const float* bmod = a.in[IN_BMOD]; const float* g1 = a.in[IN_G1];
    LAS float* gs = (LAS float*)F.lds; LAS float* sh = gs + DM;
    bf16* H = (bf16*)F.out;
    float* mod = (float*)(F.ws + WS_MOD);
    for (int i = F.bid * NTHR + F.tid; i < 9 * 6144; i += F.G * NTHR) mod[i] = mod_from_partials(modp, bmod, i / 6144, i % 6144);
    const int b = F.bid / 32;
    for (int k = F.tid; k < DM; k += NTHR) { gs[k] = g1[k] * (1.f + mod_from_partials(modp, bmod, b, DM + k)); sh[k] = mod_from_partials(modp, bmod, b, k); }
    __syncthreads();
    norm_rows(F, a.in[IN_X], H, F.bid * 64, 64, gs, sh);
    __syncthreads();
    for (int k = F.tid; k < DM; k += NTHR) { gs[k] = g1[k] * (1.f + mod_from_partials(modp, bmod, 8, DM + k)); sh[k] = mod_from_partials(modp, bmod, 8, k); }
    __syncthreads();
    norm_rows(F, a.in[IN_CTX], H + (size_t)NTOK * DM, F.bid * 8, 8, gs, sh);
    __syncthreads();
}

struct EpiStoreBf16 {
    static constexpr bool PERM = true;
    __device__ __forceinline__ void operator()(const f32x4 (&acc)[2][2][4][2], const gm::Unit& u, int wr, int wc, int fr, int fq) const {
        bf16* base = (bf16*)u.dst + (size_t)(wr * 64 + fr) * DM + wc * 32 + 8 * fq;
#pragma unroll
        for (int ai = 0; ai < 2; ++ai)
#pragma unroll
            for (int m = 0; m < 4; ++m) { bf16* rowp = base + (size_t)(ai * 128 + m * 16) * DM;
#pragma unroll
                for (int bj = 0; bj < 2; ++bj) { const f32x4 v0 = acc[ai][bj][m][0], v1 = acc[ai][bj][m][1];
                    u32x4 w; w.x = gm::cvt_pk_bf16(v0[0], v0[1]); w.y = gm::cvt_pk_bf16(v0[2], v0[3]); w.z = gm::cvt_pk_bf16(v1[0], v1[1]); w.w = gm::cvt_pk_bf16(v1[2], v1[3]);
                    *(u32x4*)(rowp + bj * 128) = w; } }
    }
};
__device__ __forceinline__ void tile_order(int L, int nM, int nN, int& pm, int& pn) {
    const int nwg = nM * nN; int wgid = L;
    { const int q = nwg / 8, r = nwg % 8, xcd = wgid % 8, off = wgid / 8; wgid = (xcd < r ? xcd * (q + 1) : r * (q + 1) + (xcd - r) * q) + off; }
    const int nig = 8 * nN, gid = wgid / nig, fm = gid * 8, gsz = (nM - fm) < 8 ? (nM - fm) : 8;
    pm = fm + ((wgid % nig) % gsz); pn = (wgid % nig) / gsz;
}
struct SchedP2 {
    int G, c; const char* H; const char* Wt; char* P; char* PC;
    __device__ __forceinline__ bool next(int i, gm::Unit& u) const {
        int L = i * G + c;
        if (L < 64 * 36) { int pm, pn; tile_order(L, 64, 36, pm, pn);
            u.A = H + (size_t)pm * 256 * 2048; u.B0 = Wt + (size_t)pn * 256 * 2048; u.B1 = u.B0 + (size_t)128 * 2048;
            u.dst = P + (size_t)(pn >> 2) * GS + ((size_t)pm * 256 * DM + (pn & 3) * 256) * 2; u.pm = pm; u.pn = pn; u.e = 0; u.rows = 256; return true; }
        L -= 64 * 36; if (L >= 128) return false;
        const int pmc = L >> 4, j = L & 15, slot = j >> 2, g = slot == 0 ? 0 : slot + 2, pn = g * 4 + (j & 3);
        u.A = H + (size_t)(NTOK + pmc * 256) * 2048; u.B0 = Wt + (size_t)pn * 256 * 2048; u.B1 = u.B0 + (size_t)128 * 2048;
        u.dst = PC + (size_t)slot * CGS + ((size_t)pmc * 256 * DM + (j & 3) * 256) * 2; u.pm = pmc; u.pn = pn; u.e = 0; u.rows = 256; return true;
    }
    __device__ __forceinline__ unsigned arow(const gm::Unit&, int r) const { return (unsigned)r; }
};
constexpr int LRU_T = 128, LRU_NCH = SEQ / LRU_T, UF_LD = 144;
constexpr int LRU_UBF = 0, LRU_UF = 144 * 256;
constexpr float LOG2E = 1.4426950408889634f;

struct LruCoef { float ba, bx, ca; };

__device__ __forceinline__ void lru_conv(Frame& F, const Args& a, int b, int h, int c, bool special) {
    const bf16* AX = (const bf16*)(F.ws + WS_P) + (size_t)b * SEQ * DM + h * 128;
    const float* cw = a.in[IN_CONVW] + h * 128; const float* cb = a.in[IN_CONVB] + h * 128;
    LAS unsigned char* ubf = F.lds + LRU_UBF; LAS float* uf = (LAS float*)(F.lds + LRU_UF);
    const int cg = F.tid & 15, tl0 = F.tid >> 4;
    u32x4 raw[4][4];
#pragma unroll
    for (int i = 0; i < 4; ++i)
#pragma unroll
        for (int k = 0; k < 4; ++k) { int tt = c * LRU_T + tl0 + 32 * i + k - 2; tt = tt < 0 ? 0 : (tt > SEQ - 1 ? SEQ - 1 : tt); raw[i][k] = *(const u32x4*)(AX + (size_t)tt * DM + 8 * cg); }
    float w[4][8], bs[8];
#pragma unroll
    for (int k = 0; k < 4; ++k) { const f32x4 w0 = *(const f32x4*)(cw + k * DM + 8 * cg), w1 = *(const f32x4*)(cw + k * DM + 8 * cg + 4);
        w[k][0] = w0.x; w[k][1] = w0.y; w[k][2] = w0.z; w[k][3] = w0.w; w[k][4] = w1.x; w[k][5] = w1.y; w[k][6] = w1.z; w[k][7] = w1.w; }
    { const f32x4 b0 = *(const f32x4*)(cb + 8 * cg), b1 = *(const f32x4*)(cb + 8 * cg + 4); bs[0] = b0.x; bs[1] = b0.y; bs[2] = b0.z; bs[3] = b0.w; bs[4] = b1.x; bs[5] = b1.y; bs[6] = b1.z; bs[7] = b1.w; }
#pragma unroll
    for (int i = 0; i < 4; ++i) { const int tl = tl0 + 32 * i;
        float u[8];
#pragma unroll
        for (int q = 0; q < 8; ++q) u[q] = bs[q];
#pragma unroll
        for (int k = 0; k < 4; ++k) { const int tt = c * LRU_T + tl + k - 2; const float mk = (tt >= 0 && tt < SEQ) ? 1.f : 0.f; const u32x4 v = raw[i][k];
            u[0] += mk * w[k][0] * bflo(v.x); u[1] += mk * w[k][1] * bfhi(v.x); u[2] += mk * w[k][2] * bflo(v.y); u[3] += mk * w[k][3] * bfhi(v.y);
            u[4] += mk * w[k][4] * bflo(v.z); u[5] += mk * w[k][5] * bfhi(v.z); u[6] += mk * w[k][6] * bflo(v.w); u[7] += mk * w[k][7] * bfhi(v.w); }
        *(LAS f32x4*)(uf + tl * UF_LD + 8 * cg) = (f32x4){u[0], u[1], u[2], u[3]};
        *(LAS f32x4*)(uf + tl * UF_LD + 8 * cg + 4) = (f32x4){u[4], u[5], u[6], u[7]};
        u32x4 p; p.x = pk2(u[0], u[1]); p.y = pk2(u[2], u[3]); p.z = pk2(u[4], u[5]); p.w = pk2(u[6], u[7]);
        *(LAS u32x4*)(ubf + tl * 256 + ((cg ^ (tl & 15)) << 4)) = p; }
    if (special) {
        const bf16* AC = (const bf16*)(F.ws + WS_PC) + (size_t)b * CTX * DM + h * 128;
        if (F.tid < 32) { const int tl = LRU_T + (F.tid >> 4); const int t = tl == LRU_T ? 0 : CTX - 1;
            float u[8];
#pragma unroll
            for (int q = 0; q < 8; ++q) u[q] = bs[q];
#pragma unroll
            for (int k = 0; k < 4; ++k) { const int tt = t + k - 2;
                if (tt >= 0 && tt < CTX) { const u32x4 v = *(const u32x4*)(AC + (size_t)tt * DM + 8 * cg);
                    u[0] += w[k][0] * bflo(v.x); u[1] += w[k][1] * bfhi(v.x); u[2] += w[k][2] * bflo(v.y); u[3] += w[k][3] * bfhi(v.y);
                    u[4] += w[k][4] * bflo(v.z); u[5] += w[k][5] * bfhi(v.z); u[6] += w[k][6] * bflo(v.w); u[7] += w[k][7] * bfhi(v.w); } }
            *(LAS f32x4*)(uf + tl * UF_LD + 8 * cg) = (f32x4){u[0], u[1], u[2], u[3]};
            *(LAS f32x4*)(uf + tl * UF_LD + 8 * cg + 4) = (f32x4){u[4], u[5], u[6], u[7]};
            u32x4 p; p.x = pk2(u[0], u[1]); p.y = pk2(u[2], u[3]); p.z = pk2(u[4], u[5]); p.w = pk2(u[6], u[7]);
            *(LAS u32x4*)(ubf + tl * 256 + ((cg ^ (tl & 15)) << 4)) = p;
        } else if (F.tid < 32 + 14 * 16) { const int tl = LRU_T + 2 + ((F.tid - 32) >> 4);
            *(LAS u32x4*)(ubf + tl * 256 + ((cg ^ (tl & 15)) << 4)) = (u32x4){0u, 0u, 0u, 0u}; }
    }
}
__device__ __forceinline__ void lru_load_w(Frame& F, int d, int h, bf16x8 (&Bw)[2][4]) {
    const int fr = F.lane & 15, fq = F.lane >> 4;
#pragma unroll
    for (int which = 0; which < 2; ++which) { const bf16* W = (const bf16*)(F.ws + WS_WLRU) + (size_t)(which * 16 + d * 8 + h) * 128 * 128 + (size_t)(16 * F.wave + fr) * 128 + 8 * fq;
#pragma unroll
        for (int kk = 0; kk < 4; ++kk) Bw[which][kk] = *(const bf16x8*)(W + kk * 32); }
}
__device__ __forceinline__ LruCoef lru_coef(const Args& a, int d, int ch) {
    LruCoef k; k.ba = -LOG2E * a.in[IN_BA][d * DM + ch]; k.bx = -LOG2E * a.in[IN_BX][d * DM + ch];
    const float sp = log1pf(expf(-a.in[IN_LAM][d * DM + ch])); k.ca = -8.f * sp * LOG2E; return k;
}
template <int V = 0> __device__ __forceinline__ void lru_tile(Frame& F, int m, const bf16x8 (&Bw)[2][4], const LruCoef& k, float (&av)[4], float (&bv)[4]) {
    const int fr = F.lane & 15, fq = F.lane >> 4;
    const LAS unsigned char* ubf = F.lds + LRU_UBF; const LAS float* uf = (const LAS float*)(F.lds + LRU_UF);
    f32x4 ar = {0.f, 0.f, 0.f, 0.f}, ai = {0.f, 0.f, 0.f, 0.f};
    const int row = m * 16 + fr;
#pragma unroll
    for (int kk = 0; kk < 4; ++kk) { const bf16x8 A = *(const LAS bf16x8*)(ubf + row * 256 + (((kk * 4 + fq) ^ fr) << 4));
        ar = __builtin_amdgcn_mfma_f32_16x16x32_bf16(A, Bw[0][kk], ar, 0, 0, 0); ai = __builtin_amdgcn_mfma_f32_16x16x32_bf16(A, Bw[1][kk], ai, 0, 0, 0); }
#pragma unroll
    for (int r = 0; r < 4; ++r) { const float u = uf[(m * 16 + 4 * fq + r) * UF_LD + 16 * F.wave + fr];
        if (V == 2) { av[r] = __builtin_fmaf(ar[r], -LOG2E, k.ba) * k.ca; bv[r] = __builtin_fmaf(ai[r], -LOG2E, k.bx) * u; continue; }
        const float rg = __builtin_amdgcn_rcpf(1.f + __builtin_amdgcn_exp2f(__builtin_fmaf(ar[r], -LOG2E, k.ba)));
        const float ig = __builtin_amdgcn_rcpf(1.f + __builtin_amdgcn_exp2f(__builtin_fmaf(ai[r], -LOG2E, k.bx)));
        const float aa = __builtin_amdgcn_exp2f(k.ca * rg);
        av[r] = aa; bv[r] = __builtin_amdgcn_sqrtf(__builtin_fmaf(-aa, aa, 1.f)) * (ig * u); }
}
template <bool FWD, int V = 0> __device__ __forceinline__ void lru_tile_total(int fq, float& A, float& B) {
    if (V == 1) return;
#pragma unroll
    for (int s = 0; s < 2; ++s) { const int bit = 1 << s; const float Ap = __shfl_xor(A, 16 << s), Bp = __shfl_xor(B, 16 << s);
        const bool mine_first = FWD ? ((fq & bit) == 0) : ((fq & bit) != 0);
        if (mine_first) { B = B * Ap + Bp; A = A * Ap; } else { B = Bp * A + B; A = Ap * A; } }
}

template <int V = 0> __device__ __forceinline__ void lru_pass1(Frame& F, const Args& a, int unit, float* agg_base) {
    const int c = unit & (LRU_NCH - 1), h = (unit >> 4) & 7, b = unit >> 7;
    const int fr = F.lane & 15, fq = F.lane >> 4; const int ch = h * 128 + 16 * F.wave + fr;
    bf16x8 Bw0[2][4], Bw1[2][4]; lru_load_w(F, 0, h, Bw0); lru_load_w(F, 1, h, Bw1);
    const LruCoef k0 = lru_coef(a, 0, ch), k1 = lru_coef(a, 1, ch);
    lru_conv(F, a, b, h, c, c == 0);
    LDS_WAIT(); __syncthreads();
    float Af = 1.f, Hf = 0.f, Ab = 1.f, Hb = 0.f;
#pragma unroll 2
    for (int m = 0; m < 8; ++m) {
        float av[4], bv[4];
        lru_tile<V>(F, m, Bw0, k0, av, bv);
        float A = av[0] * av[1] * av[2] * av[3], B = ((bv[0] * av[1] + bv[1]) * av[2] + bv[2]) * av[3] + bv[3];
        lru_tile_total<true, V>(fq, A, B);
        Hf = Hf * A + B; Af = Af * A;
        lru_tile<V>(F, m, Bw1, k1, av, bv);
        A = av[0] * av[1] * av[2] * av[3]; B = ((bv[3] * av[2] + bv[2]) * av[1] + bv[1]) * av[0] + bv[0];
        lru_tile_total<false, V>(fq, A, B);
        Hb = B * Ab + Hb; Ab = A * Ab;
    }
    float* agg = agg_base;
    if (fq == 0) { *(f32x2*)(agg + ((size_t)((b * LRU_NCH + c) * 2 + 0) * DM + ch) * 2) = (f32x2){Af, Hf};
                   *(f32x2*)(agg + ((size_t)((b * LRU_NCH + c) * 2 + 1) * DM + ch) * 2) = (f32x2){Ab, Hb}; }
    if (c == 0 && V == 0) {
        float av[4], bv[4]; float* s0 = (float*)(F.ws + WS_LRUS0);
        lru_tile(F, 8, Bw0, k0, av, bv); if (fq == 0) s0[(b * 2 + 0) * DM + ch] = bv[0];
        lru_tile(F, 8, Bw1, k1, av, bv); if (fq == 0) s0[(b * 2 + 1) * DM + ch] = bv[1];
    }
    __syncthreads();
}

__device__ __forceinline__ void lru_pass2(Frame& F, const Args& a, int unit) {
    const int c = unit & (LRU_NCH - 1), h = (unit >> 4) & 7, b = unit >> 7;
    const int fr = F.lane & 15, fq = F.lane >> 4; const int ch = h * 128 + 16 * F.wave + fr;
    const float* agg = (const float*)(F.ws + WS_LRUAGG); const float* s0 = (const float*)(F.ws + WS_LRUS0);
    f32x2 ag[LRU_NCH];
#pragma unroll
    for (int j = 0; j < LRU_NCH; ++j) ag[j] = *(const f32x2*)(agg + ((size_t)((b * LRU_NCH + j) * 2 + (j < c ? 0 : 1)) * DM + ch) * 2);
    float hf = s0[(b * 2 + 0) * DM + ch], hb = s0[(b * 2 + 1) * DM + ch];
    bf16* AY = (bf16*)(F.ws + WS_YAG) + ((size_t)b * SEQ + c * LRU_T) * DM + h * 128;
    u32x4 ayv[4];
#pragma unroll
    for (int i = 0; i < 4; ++i) ayv[i] = *(const u32x4*)(AY + (size_t)((F.tid >> 4) + 32 * i) * DM + 8 * (F.tid & 15));
    bf16x8 Bw[2][4], Bw1[2][4]; lru_load_w(F, 0, h, Bw);
    LruCoef k = lru_coef(a, 0, ch); const LruCoef k1 = lru_coef(a, 1, ch);
    lru_conv(F, a, b, h, c, false);
    lru_load_w(F, 1, h, Bw1);
#pragma unroll
    for (int j = 0; j < LRU_NCH; ++j) if (j < c) hf = ag[j].x * hf + ag[j].y;
#pragma unroll
    for (int j = LRU_NCH - 1; j >= 0; --j) if (j > c) hb = ag[j].x * hb + ag[j].y;
    LDS_WAIT(); __syncthreads();
    float hfv[8][4];
#pragma unroll
    for (int m = 0; m < 8; ++m) {
        float av[4], bv[4];
        lru_tile(F, m, Bw, k, av, bv);
        const float A = av[0] * av[1] * av[2] * av[3], B = ((bv[0] * av[1] + bv[1]) * av[2] + bv[2]) * av[3] + bv[3];
        float hin = hf;
#pragma unroll
        for (int g = 0; g < 4; ++g) { const float Ag = __shfl(A, g * 16 + fr), Bg = __shfl(B, g * 16 + fr); if (g < fq) hin = Ag * hin + Bg; hf = Ag * hf + Bg; }
#pragma unroll
        for (int r = 0; r < 4; ++r) { hin = av[r] * hin + bv[r]; hfv[m][r] = hin; }
    }
    k = k1;
    LAS float* uf = (LAS float*)(F.lds + LRU_UF);
#pragma unroll
    for (int m = 7; m >= 0; --m) {
        float av[4], bv[4];
        lru_tile(F, m, Bw1, k, av, bv);
        const float A = av[0] * av[1] * av[2] * av[3], B = ((bv[3] * av[2] + bv[2]) * av[1] + bv[1]) * av[0] + bv[0];
        float hin = hb;
#pragma unroll
        for (int g = 3; g >= 0; --g) { const float Ag = __shfl(A, g * 16 + fr), Bg = __shfl(B, g * 16 + fr); if (g > fq) hin = Ag * hin + Bg; hb = Ag * hb + Bg; }
#pragma unroll
        for (int r = 3; r >= 0; --r) { hin = av[r] * hin + bv[r]; uf[(m * 16 + 4 * fq + r) * UF_LD + 16 * F.wave + fr] = hfv[m][r] + hin; }
    }
    LDS_WAIT(); __syncthreads();
    const int cg = F.tid & 15;
#pragma unroll
    for (int i = 0; i < 4; ++i) { const int tl = (F.tid >> 4) + 32 * i;
        const f32x4 y0 = *(const LAS f32x4*)(uf + tl * UF_LD + 8 * cg), y1 = *(const LAS f32x4*)(uf + tl * UF_LD + 8 * cg + 4);
        const u32x4 g = ayv[i];
        u32x4 o; o.x = pk2(y0.x * gelu_tanh(bflo(g.x)), y0.y * gelu_tanh(bfhi(g.x))); o.y = pk2(y0.z * gelu_tanh(bflo(g.y)), y0.w * gelu_tanh(bfhi(g.y)));
        o.z = pk2(y1.x * gelu_tanh(bflo(g.z)), y1.y * gelu_tanh(bfhi(g.z))); o.w = pk2(y1.z * gelu_tanh(bflo(g.w)), y1.w * gelu_tanh(bfhi(g.w)));
        *(u32x4*)(AY + (size_t)tl * DM + 8 * cg) = o; }
    __syncthreads();
}
constexpr int HG_C = 64, HG_SEG = 512, HG_NSEG = 4;
constexpr int HG_QS = 0, HG_QM = 16384, HG_KM = 32768, HG_KDT = 49152, HG_VT = 65536, HG_ATT = 81920, HG_PART = 90112, HG_ETOT = 94208, HG_ROWS = 94720;
constexpr size_t HGS_IMG = 65536;
#ifdef PROBE_A
#define HSTAMP(i) do { if (F.bid == 0 && F.tid == 0) { const unsigned long long _t = __builtin_amdgcn_s_memrealtime(); const unsigned long long _p = ((unsigned long long)F.MISC[101] << 32) | F.MISC[100]; \
    unsigned long long _a = ((unsigned long long)F.MISC[103 + 2 * (i)] << 32) | F.MISC[102 + 2 * (i)]; _a += _t - _p; F.MISC[102 + 2 * (i)] = (unsigned)_a; F.MISC[103 + 2 * (i)] = (unsigned)(_a >> 32); F.MISC[100] = (unsigned)_t; F.MISC[101] = (unsigned)(_t >> 32); } } while (0)
#else
#define HSTAMP(i) do { } while (0)
#endif

__device__ __forceinline__ int hg_row(int b, int dir, bool ctx, int sigma) {
    if (ctx) { const int t = dir ? (CTX - 1 - sigma) : sigma; return b * CTX + t; }
    const int p = dir ? (SEQ - 1 - sigma) : sigma; return b * SEQ + (p & 31) * 64 + (p >> 5);
}

struct HgRaw { unsigned f[8], v[8], q[8]; };
template <bool FULL>
__device__ __forceinline__ void hg_load(Frame& F, const bf16* Qb, const bf16* Fb, const bf16* Vb, int b, int dir, bool ctx, int sigma0, HgRaw& r) {
#pragma unroll
    for (int j = 0; j < 8; ++j) { const size_t ro = (size_t)hg_row(b, dir, ctx, sigma0 + 8 * F.wave + j) * DM + 2 * F.lane;
        r.f[j] = *(const unsigned*)(Fb + ro); r.v[j] = *(const unsigned*)(Vb + ro); if (FULL) r.q[j] = *(const unsigned*)(Qb + ro); }
}
template <bool FULL>
__device__ __forceinline__ void hg_prep(Frame& F, const HgRaw& raw, int b, int dir, bool ctx, int sigma0, float lb0, float lb1, float& gs0, float& gs1) {
    const int kp = F.lane, to = F.wave;
    const unsigned (&fw)[8] = raw.f; const unsigned (&qw)[8] = raw.q; const unsigned (&vw)[8] = raw.v;
    float c0[8], c1[8], k0[8], k1[8];
    float a0 = 0.f, a1 = 0.f;
#pragma unroll
    for (int j = 0; j < 8; ++j) {
        const float g0 = lb0 + (1.f - lb0) * __builtin_amdgcn_rcpf(1.f + __builtin_amdgcn_exp2f(-bflo(fw[j]) * LOG2E));
        const float g1 = lb1 + (1.f - lb1) * __builtin_amdgcn_rcpf(1.f + __builtin_amdgcn_exp2f(-bfhi(fw[j]) * LOG2E));
        k0[j] = 1.f - g0; k1[j] = 1.f - g1;
        a0 += __builtin_amdgcn_logf(g0); a1 += __builtin_amdgcn_logf(g1);
        c0[j] = a0; c1[j] = a1; }
    LAS float* part = (LAS float*)(F.lds + HG_PART);
    *(LAS f32x2*)(part + to * 128 + 2 * kp) = (f32x2){a0, a1};
    if (FULL) HSTAMP(0);
    LDS_WAIT(); __syncthreads();
    if (FULL) HSTAMP(1);
    if (FULL && F.tid < HG_C) ((LAS int*)(F.lds + HG_ROWS))[F.tid] = hg_row(b, dir, ctx, sigma0 + F.tid);
    float off0 = 0.f, off1 = 0.f, tot0 = 0.f, tot1 = 0.f;
#pragma unroll
    for (int o = 0; o < 8; ++o) { const f32x2 p = *(const LAS f32x2*)(part + o * 128 + 2 * kp);
        if (o < to) { off0 += p.x; off1 += p.y; } tot0 += p.x; tot1 += p.y; }
    gs0 += tot0; gs1 += tot1;
    if (to == 0) *(LAS f32x2*)((LAS float*)(F.lds + HG_ETOT) + 2 * kp) = (f32x2){__builtin_amdgcn_exp2f(tot0), __builtin_amdgcn_exp2f(tot1)};
    float kd0[8], kd1[8];
#pragma unroll
    for (int j = 0; j < 8; ++j) {
        const float E0 = __builtin_amdgcn_exp2f(off0 + c0[j]), E1 = __builtin_amdgcn_exp2f(off1 + c1[j]);
        kd0[j] = k0[j] * __builtin_amdgcn_rcpf(E0); kd1[j] = k1[j] * __builtin_amdgcn_rcpf(E1);
        if (FULL) {
            const float q0 = bflo(qw[j]), q1 = bfhi(qw[j]);
            const float s0 = q0 * __builtin_amdgcn_rcpf(1.f + __builtin_amdgcn_exp2f(-q0 * LOG2E)) * E0, s1 = q1 * __builtin_amdgcn_rcpf(1.f + __builtin_amdgcn_exp2f(-q1 * LOG2E)) * E1;
            const int c = 8 * to + j; const int off = c * 256 + ((4 * kp) ^ ((c & 15) << 4));
            *(LAS unsigned*)(F.lds + HG_QS + off) = pk2(s0, s1);
            *(LAS unsigned*)(F.lds + HG_KM + off) = pk2(kd0[j], kd1[j]);
        }
    }
    { const int sw = ((to ^ (kp & 7)) << 4);
      u32x4 w0, w1; w0.x = pk2(kd0[0], kd0[1]); w0.y = pk2(kd0[2], kd0[3]); w0.z = pk2(kd0[4], kd0[5]); w0.w = pk2(kd0[6], kd0[7]);
      w1.x = pk2(kd1[0], kd1[1]); w1.y = pk2(kd1[2], kd1[3]); w1.z = pk2(kd1[4], kd1[5]); w1.w = pk2(kd1[6], kd1[7]);
      *(LAS u32x4*)(F.lds + HG_KDT + (2 * kp) * 128 + sw) = w0; *(LAS u32x4*)(F.lds + HG_KDT + (2 * kp + 1) * 128 + sw) = w1;
      u32x4 v0, v1;
      v0.x = (vw[0] & 0xffffu) | (vw[1] << 16); v0.y = (vw[2] & 0xffffu) | (vw[3] << 16); v0.z = (vw[4] & 0xffffu) | (vw[5] << 16); v0.w = (vw[6] & 0xffffu) | (vw[7] << 16);
      v1.x = (vw[0] >> 16) | (vw[1] & 0xffff0000u); v1.y = (vw[2] >> 16) | (vw[3] & 0xffff0000u); v1.z = (vw[4] >> 16) | (vw[5] & 0xffff0000u); v1.w = (vw[6] >> 16) | (vw[7] & 0xffff0000u);
      *(LAS u32x4*)(F.lds + HG_VT + (2 * kp) * 128 + sw) = v0; *(LAS u32x4*)(F.lds + HG_VT + (2 * kp + 1) * 128 + sw) = v1; }
    if (FULL) HSTAMP(2);
    LDS_WAIT(); __syncthreads();
    if (FULL) HSTAMP(3);
}
__device__ __forceinline__ void hg_state_update(Frame& F, f32x4 (&St)[8], const bf16x8 (&vt)[2]) {
    const int fr = F.lane & 15, fq = F.lane >> 4;
    const LAS float* etot = (const LAS float*)(F.lds + HG_ETOT);
#pragma unroll
    for (int kt = 0; kt < 8; ++kt) { const f32x4 e = *(const LAS f32x4*)(etot + 16 * kt + 4 * fq);
        const int rk = 16 * kt + fr;
#pragma unroll
        for (int ks = 0; ks < 2; ++ks) { const bf16x8 A = *(const LAS bf16x8*)(F.lds + HG_KDT + rk * 128 + (((4 * ks + fq) ^ ((rk >> 1) & 7)) << 4));
            St[kt] = __builtin_amdgcn_mfma_f32_16x16x32_bf16(A, vt[ks], St[kt], 0, 0, 0); }
        St[kt] = St[kt] * e; }
}
__device__ __forceinline__ void hg_load_vt(Frame& F, bf16x8 (&vt)[2]) {
    const int fr = F.lane & 15, fq = F.lane >> 4; const int rv = 16 * F.wave + fr;
#pragma unroll
    for (int ks = 0; ks < 2; ++ks) vt[ks] = *(const LAS bf16x8*)(F.lds + HG_VT + rv * 128 + (((4 * ks + fq) ^ ((rv >> 1) & 7)) << 4));
}
struct HgPtrs { const bf16* Q; const bf16* Fx; const bf16* V; const bf16* Fc; const bf16* Vc; bf16* O; };
__device__ __forceinline__ HgPtrs hg_ptrs(Frame& F, int h, int dir) {
    HgPtrs p; p.Q = (const bf16*)(F.ws + WS_P + 2 * GS) + h * 128; p.Fx = (const bf16*)(F.ws + WS_P + (dir ? 4 : 3) * GS) + h * 128; p.V = (const bf16*)(F.ws + WS_P + 5 * GS) + h * 128;
    p.Fc = (const bf16*)(F.ws + WS_PC + (dir ? 2 : 1) * CGS) + h * 128; p.Vc = (const bf16*)(F.ws + WS_PC + 3 * CGS) + h * 128; p.O = (bf16*)(F.ws + WS_P + (dir ? 4 : 3) * GS) + h * 128; return p;
}
__device__ __forceinline__ void hg_lb(const Args& a, int h, int kp, float& lb0, float& lb1) {
    const float* t = a.in[IN_HGLB] + h * 128 + 2 * kp; lb0 = 1.f / (1.f + expf(t[DM] - t[0])); lb1 = 1.f / (1.f + expf(t[DM + 1] - t[1]));
}
__device__ __forceinline__ float* hg_img(Frame& F, int b, int h, int dir, int slot) { return (float*)((unsigned char*)F.out + (size_t)((((b * 8 + h) * 2 + dir) * 4) + slot) * HGS_IMG); }

__device__ __forceinline__ void hg_pass1(Frame& F, const Args& a, int unit) {
    const int slot = unit & 3, dir = (unit >> 2) & 1, h = (unit >> 3) & 7, b = unit >> 6;
    const int fr = F.lane & 15, fq = F.lane >> 4;
    const HgPtrs P = hg_ptrs(F, h, dir);
    float lb0, lb1; hg_lb(a, h, F.lane, lb0, lb1);
    f32x4 St[8];
#pragma unroll
    for (int kt = 0; kt < 8; ++kt) St[kt] = (f32x4){0.f, 0.f, 0.f, 0.f};
    const bool ctx = slot == 0; const int nchunk = ctx ? CTX / HG_C : HG_SEG / HG_C; const int sig0 = ctx ? 0 : (slot - 1) * HG_SEG;
    float gs0 = 0.f, gs1 = 0.f;
    const bf16* Fsrc = ctx ? P.Fc : P.Fx; const bf16* Vsrc = ctx ? P.Vc : P.V;
    HgRaw cur; hg_load<false>(F, P.Q, Fsrc, Vsrc, b, dir, ctx, sig0, cur);
    for (int ck = 0; ck < nchunk; ++ck) {
        HgRaw nxt; { const int cn = ck + 1 < nchunk ? ck + 1 : ck; hg_load<false>(F, P.Q, Fsrc, Vsrc, b, dir, ctx, sig0 + cn * HG_C, nxt); }
        hg_prep<false>(F, cur, b, dir, ctx, sig0 + ck * HG_C, lb0, lb1, gs0, gs1);
        cur = nxt;
        bf16x8 vt[2]; hg_load_vt(F, vt);
        hg_state_update(F, St, vt);
    }
    float* img = hg_img(F, b, h, dir, slot) + (size_t)(16 * F.wave + fr) * 128 + 4 * fq;
#pragma unroll
    for (int kt = 0; kt < 8; ++kt) *(f32x4*)(img + 16 * kt) = St[kt];
    if (!ctx && F.wave == 0) { float* D = (float*)(F.ws + WS_HGD) + (size_t)((((b * 8 + h) * 2 + dir) * 3) + (slot - 1)) * 128 + 2 * F.lane;
        *(f32x2*)D = (f32x2){__builtin_amdgcn_exp2f(gs0), __builtin_amdgcn_exp2f(gs1)}; }
    __syncthreads();
}

constexpr int HG_HN = 95232;
__device__ __forceinline__ void hg_pass2(Frame& F, const Args& a, int unit) {
    const int seg = unit & 3, h = (unit >> 2) & 7, b = unit >> 5;
    const int fr = F.lane & 15, fq = F.lane >> 4, w = F.wave;
    float lb0, lb1; hg_lb(a, h, F.lane, lb0, lb1);
    const int lcol = h * 128 + 16 * w + 4 * fq;
#pragma unroll 1
    for (int dir = 0; dir < 2; ++dir) {
        const int sseg = dir == 0 ? seg : 3 - seg;
        const HgPtrs P = hg_ptrs(F, h, dir);
        f32x4 St[8];
        {
            const float* img = hg_img(F, b, h, dir, 0) + (size_t)(16 * w + fr) * 128 + 4 * fq;
#pragma unroll
            for (int kt = 0; kt < 8; ++kt) St[kt] = *(const f32x4*)(img + 16 * kt);
            for (int j = 0; j < sseg; ++j) {
                const float* im = hg_img(F, b, h, dir, 1 + j) + (size_t)(16 * w + fr) * 128 + 4 * fq;
                const float* D = (const float*)(F.ws + WS_HGD) + (size_t)((((b * 8 + h) * 2 + dir) * 3) + j) * 128 + 4 * fq;
#pragma unroll
                for (int kt = 0; kt < 8; ++kt) { const f32x4 d = *(const f32x4*)(D + 16 * kt), dl = *(const f32x4*)(im + 16 * kt); St[kt] = St[kt] * d + dl; }
            }
        }
        float gs0 = 0.f, gs1 = 0.f;
        for (int ck = 0; ck < HG_SEG / HG_C; ++ck) {
            { HgRaw cur; hg_load<true>(F, P.Q, P.Fx, P.V, b, dir, false, sseg * HG_SEG + ck * HG_C, cur);
              hg_prep<true>(F, cur, b, dir, false, sseg * HG_SEG + ck * HG_C, lb0, lb1, gs0, gs1); }
            const LAS int* rows = (const LAS int*)(F.lds + HG_ROWS);
            bf16* OFW = (bf16*)(F.ws + WS_OF) + lcol; asm volatile("" : "+v"(OFW));
            u32x2 ofw[4], ogv[4];
            if (dir == 1) {
                const bf16* OG = (const bf16*)(F.ws + WS_P + 6 * GS) + lcol; asm volatile("" : "+v"(OG));
#pragma unroll
                for (int ct = 0; ct < 4; ++ct) { const size_t ro = (size_t)rows[16 * ct + fr] * DM; ofw[ct] = *(const u32x2*)(OFW + ro); ogv[ct] = *(const u32x2*)(OG + ro); } }
#pragma unroll
            for (int tt = 0; tt < 2; ++tt) { const int t = w + 8 * tt, ct = t >> 2, st = t & 3;
                f32x4 acc = {0.f, 0.f, 0.f, 0.f};
                const int rs = 16 * st + fr, rc = 16 * ct + fr;
#pragma unroll
                for (int kk = 0; kk < 4; ++kk) { const bf16x8 A = *(const LAS bf16x8*)(F.lds + HG_KM + rs * 256 + (((4 * kk + fq) ^ fr) << 4));
                    const bf16x8 B = *(const LAS bf16x8*)(F.lds + HG_QS + rc * 256 + (((4 * kk + fq) ^ fr) << 4));
                    acc = __builtin_amdgcn_mfma_f32_16x16x32_bf16(A, B, acc, 0, 0, 0); }
                const int s0 = 16 * st + 4 * fq;
                const float m0 = (s0 + 0 <= rc) ? acc[0] : 0.f, m1 = (s0 + 1 <= rc) ? acc[1] : 0.f, m2 = (s0 + 2 <= rc) ? acc[2] : 0.f, m3 = (s0 + 3 <= rc) ? acc[3] : 0.f;
                *(LAS u32x2*)(F.lds + HG_ATT + rc * 128 + (((2 * st + (fq >> 1)) ^ ((rc >> 1) & 7)) << 4) + (fq & 1) * 8) = (u32x2){pk2(m0, m1), pk2(m2, m3)}; }
            f32x4 o[4];
#pragma unroll
            for (int ct = 0; ct < 4; ++ct) o[ct] = (f32x4){0.f, 0.f, 0.f, 0.f};
#pragma unroll
            for (int kk = 0; kk < 4; ++kk) {
                union { bf16x8 v; unsigned u[4]; } A;
                A.u[0] = pk2(St[2 * kk][0], St[2 * kk][1]); A.u[1] = pk2(St[2 * kk][2], St[2 * kk][3]); A.u[2] = pk2(St[2 * kk + 1][0], St[2 * kk + 1][1]); A.u[3] = pk2(St[2 * kk + 1][2], St[2 * kk + 1][3]);
#pragma unroll
                for (int ct = 0; ct < 4; ++ct) { const int rc = 16 * ct + fr;
                    union { bf16x8 v; u32x2 h[2]; } B;
                    B.h[0] = *(const LAS u32x2*)(F.lds + HG_QS + rc * 256 + (((4 * kk + (fq >> 1)) ^ fr) << 4) + (fq & 1) * 8);
                    B.h[1] = *(const LAS u32x2*)(F.lds + HG_QS + rc * 256 + (((4 * kk + 2 + (fq >> 1)) ^ fr) << 4) + (fq & 1) * 8);
                    o[ct] = __builtin_amdgcn_mfma_f32_16x16x32_bf16(A.v, B.v, o[ct], 0, 0, 0); } }
            bf16x8 vt[2]; hg_load_vt(F, vt);
            LDS_WAIT(); __syncthreads();
#pragma unroll
            for (int ks = 0; ks < 2; ++ks)
#pragma unroll
                for (int ct = 0; ct < 4; ++ct) { const int rc = 16 * ct + fr;
                    const bf16x8 B = *(const LAS bf16x8*)(F.lds + HG_ATT + rc * 128 + (((4 * ks + fq) ^ ((rc >> 1) & 7)) << 4));
                    o[ct] = __builtin_amdgcn_mfma_f32_16x16x32_bf16(vt[ks], B, o[ct], 0, 0, 0); }
            if (dir == 0) {
#pragma unroll
                for (int ct = 0; ct < 4; ++ct) *(u32x2*)(OFW + (size_t)rows[16 * ct + fr] * DM) = (u32x2){pk2(o[ct][0], o[ct][1]), pk2(o[ct][2], o[ct][3])};
                hg_state_update(F, St, vt);
            } else {
                LAS float* hn = (LAS float*)(F.lds + HG_HN);
                const f32x4 hn4 = *(const f32x4*)(a.in[IN_HGN] + h * 128 + 16 * w + 4 * fq);
#pragma unroll
                for (int ct = 0; ct < 4; ++ct) { o[ct][0] += bflo(ofw[ct].x); o[ct][1] += bfhi(ofw[ct].x); o[ct][2] += bflo(ofw[ct].y); o[ct][3] += bfhi(ofw[ct].y);
                    float ss = (o[ct][0] * o[ct][0] + o[ct][1] * o[ct][1]) + (o[ct][2] * o[ct][2] + o[ct][3] * o[ct][3]);
                    ss += __shfl_xor(ss, 16); ss += __shfl_xor(ss, 32);
                    if (fq == 0) hn[(16 * ct + fr) * 8 + w] = ss; }
                hg_state_update(F, St, vt);
                LDS_WAIT(); __syncthreads();
#pragma unroll
                for (int ct = 0; ct < 4; ++ct) { const f32x4 p0 = *(const LAS f32x4*)(hn + (16 * ct + fr) * 8), p1 = *(const LAS f32x4*)(hn + (16 * ct + fr) * 8 + 4);
                    const float rsn = rsqrtf(((p0.x + p0.y) + (p0.z + p0.w) + (p1.x + p1.y) + (p1.z + p1.w)) * (1.f / 128.f) + EPS);
                    const float g0 = bflo(ogv[ct].x), g1 = bfhi(ogv[ct].x), g2 = bflo(ogv[ct].y), g3 = bfhi(ogv[ct].y);
                    const float y0 = o[ct][0] * rsn * hn4.x * siluf_(g0), y1 = o[ct][1] * rsn * hn4.y * siluf_(g1), y2 = o[ct][2] * rsn * hn4.z * siluf_(g2), y3 = o[ct][3] * rsn * hn4.w * siluf_(g3);
                    *(u32x2*)(OFW + (size_t)rows[16 * ct + fr] * DM) = (u32x2){pk2(y0, y1), pk2(y2, y3)}; }
            }
        }
        VM_WAIT(); __syncthreads();
    }
}
__device__ __forceinline__ void p_ybg(Frame& F, const Args& a) {
    const bf16* OFp = (const bf16*)(F.ws + WS_OF); const bf16* OBp = (const bf16*)(F.ws + WS_OB); const bf16* OG = (const bf16*)(F.ws + WS_P + 6 * GS);
    bf16* YBG = (bf16*)(F.ws + WS_YBG); const float* hgn = a.in[IN_HGN];
    const int gw = F.bid * NWAVES + F.wave, NGW = F.G * NWAVES;
    for (int row = gw; row < NTOK; row += 2 * NGW) {
        u32x4 fv[2][2], bv[2][2], gvv[2][2];
#pragma unroll
        for (int rr = 0; rr < 2; ++rr)
#pragma unroll
            for (int j = 0; j < 2; ++j) { const size_t o = (size_t)(row + rr * NGW) * DM + 8 * F.lane + 512 * j;
                fv[rr][j] = *(const u32x4*)(OFp + o); bv[rr][j] = *(const u32x4*)(OBp + o); gvv[rr][j] = *(const u32x4*)(OG + o); }
#pragma unroll
        for (int rr = 0; rr < 2; ++rr)
#pragma unroll
        for (int j = 0; j < 2; ++j) { const int k = 8 * F.lane + 512 * j; const size_t o = (size_t)(row + rr * NGW) * DM + k;
            const u32x4 f = fv[rr][j], b = bv[rr][j], g = gvv[rr][j];
            float v[8]; v[0] = bflo(f.x) + bflo(b.x); v[1] = bfhi(f.x) + bfhi(b.x); v[2] = bflo(f.y) + bflo(b.y); v[3] = bfhi(f.y) + bfhi(b.y);
            v[4] = bflo(f.z) + bflo(b.z); v[5] = bfhi(f.z) + bfhi(b.z); v[6] = bflo(f.w) + bflo(b.w); v[7] = bfhi(f.w) + bfhi(b.w);
            float ss = 0.f;
#pragma unroll
            for (int q = 0; q < 8; ++q) ss += v[q] * v[q];
            ss += __shfl_xor(ss, 1); ss += __shfl_xor(ss, 2); ss += __shfl_xor(ss, 4); ss += __shfl_xor(ss, 8);
            const float rs = rsqrtf(ss * (1.f / 128.f) + EPS);
            float gv[8]; gv[0] = bflo(g.x); gv[1] = bfhi(g.x); gv[2] = bflo(g.y); gv[3] = bfhi(g.y); gv[4] = bflo(g.z); gv[5] = bfhi(g.z); gv[6] = bflo(g.w); gv[7] = bfhi(g.w);
            const f32x4 h0 = *(const f32x4*)(hgn + k), h1 = *(const f32x4*)(hgn + k + 4);
            const float hv[8] = {h0.x, h0.y, h0.z, h0.w, h1.x, h1.y, h1.z, h1.w};
            float r[8];
#pragma unroll
            for (int q = 0; q < 8; ++q) r[q] = v[q] * rs * hv[q] * siluf_(gv[q]);
            u32x4 w; w.x = pk2(r[0], r[1]); w.y = pk2(r[2], r[3]); w.z = pk2(r[4], r[5]); w.w = pk2(r[6], r[7]);
            *(u32x4*)(YBG + o) = w; }
    }
}
__device__ __forceinline__ void p_moe_weights13(Frame& F, const Args& a) {
    LAS float* scr = (LAS float*)(F.lds + F.wave * TR_BYTES);
    const int gw = F.bid * NWAVES + F.wave, NGW = F.G * NWAVES;
    for (int it = gw; it < NEXP * 256; it += NGW) {
        const int e = it >> 8, r = it & 255, w = r >> 7, q = r & 127, kb = q >> 3, nb = q & 7;
        transpose_item(a.in[w == 0 ? IN_W1 : IN_W3] + (size_t)e * DM * DEXP, DEXP, DM, (bf16*)(F.ws + (w == 0 ? WS_W1T : WS_W3T)) + ((size_t)e * DEXP + nb * 64) * DM, kb * 64, nb * 64, scr, F.lane);
    }
}
__device__ __forceinline__ void p_moe_weights2(Frame& F, const Args& a, int rank, int nwg) {
    LAS float* scr = (LAS float*)(F.lds + F.wave * TR_BYTES);
    for (int it = rank * NWAVES + F.wave; it < NEXP * 128; it += nwg * NWAVES) {
        const int e = it >> 7, q = it & 127, kb = q >> 4, nb = q & 15;
        transpose_item(a.in[IN_W2] + (size_t)e * DEXP * DM, DM, DEXP, (bf16*)(F.ws + WS_W2T) + ((size_t)e * DM + nb * 64) * DEXP, kb * 64, nb * 64, scr, F.lane);
    }
}

struct SchedP5 {
    int c; const char* YAG; const char* YBG; const char* WA; const char* WB; char* stash; char* M;
    __device__ __forceinline__ bool next(int i, gm::Unit& u) const {
        if (i >= 2) return false;
        int pm, pn; tile_order(c, 64, 4, pm, pn);
        u.A = (i == 0 ? YAG : YBG) + (size_t)pm * 256 * 2048; u.B0 = (i == 0 ? WA : WB) + (size_t)pn * 256 * 2048; u.B1 = u.B0 + (size_t)128 * 2048;
        u.dst = M + ((size_t)pm * 256 * DM + pn * 256) * 2; u.pm = pm; u.pn = pn; u.e = i; u.rows = 256; return true;
    }
    __device__ __forceinline__ unsigned arow(const gm::Unit&, int r) const { return (unsigned)r; }
};
struct EpiP5 {
    static constexpr bool PERM = true;
    float* stash; const bf16* GA; const bf16* GB;
    __device__ __forceinline__ void operator()(const f32x4 (&acc)[2][2][4][2], const gm::Unit& u, int wr, int wc, int fr, int fq) const {
        const bf16* G = (u.e == 0 ? GA : GB) + ((size_t)u.pm * 256 + wr * 64 + fr) * DM + u.pn * 256 + wc * 32 + 8 * fq;
        bf16* Mb = (bf16*)u.dst + (size_t)(wr * 64 + fr) * DM + wc * 32 + 8 * fq;
        f32x4* st = (f32x4*)stash + threadIdx.x;
        asm volatile("" : "+v"(G), "+v"(Mb), "+v"(st));
#pragma unroll
        for (int ai = 0; ai < 2; ++ai)
#pragma unroll
            for (int m = 0; m < 4; ++m) {
                u32x4 g[2]; f32x4 s0[2], s1[2];
#pragma unroll
                for (int bj = 0; bj < 2; ++bj) { const size_t ro = (size_t)(ai * 128 + m * 16) * DM + bj * 128; const int si = ((ai * 4 + m) * 2 + bj) * 2;
                    g[bj] = *(const u32x4*)(G + ro);
                    if (u.e != 0) { s0[bj] = st[(size_t)(si + 0) * NTHR]; s1[bj] = st[(size_t)(si + 1) * NTHR]; } }
#pragma unroll
                for (int bj = 0; bj < 2; ++bj) { const size_t ro = (size_t)(ai * 128 + m * 16) * DM + bj * 128; const int si = ((ai * 4 + m) * 2 + bj) * 2;
                    f32x4 v0 = acc[ai][bj][m][0], v1 = acc[ai][bj][m][1];
                    v0[0] *= sigmoidf_(bflo(g[bj].x)); v0[1] *= sigmoidf_(bfhi(g[bj].x)); v0[2] *= sigmoidf_(bflo(g[bj].y)); v0[3] *= sigmoidf_(bfhi(g[bj].y));
                    v1[0] *= sigmoidf_(bflo(g[bj].z)); v1[1] *= sigmoidf_(bfhi(g[bj].z)); v1[2] *= sigmoidf_(bflo(g[bj].w)); v1[3] *= sigmoidf_(bfhi(g[bj].w));
                    if (u.e == 0) { st[(size_t)(si + 0) * NTHR] = v0; st[(size_t)(si + 1) * NTHR] = v1; }
                    else { v0 += s0[bj]; v1 += s1[bj];
                        u32x4 w; w.x = gm::cvt_pk_bf16(v0[0], v0[1]); w.y = gm::cvt_pk_bf16(v0[2], v0[3]); w.z = gm::cvt_pk_bf16(v1[0], v1[1]); w.w = gm::cvt_pk_bf16(v1[2], v1[3]);
                        *(u32x4*)(Mb + ro) = w; } }
                asm volatile("" ::: "memory"); }
    }
};

struct SchedP6 {
    int c; const char* M; const char* W; char* X1;
    __device__ __forceinline__ bool next(int i, gm::Unit& u) const {
        if (i >= 1) return false;
        int pm, pn; tile_order(c, 64, 4, pm, pn);
        u.A = M + (size_t)pm * 256 * 2048; u.B0 = W + (size_t)pn * 256 * 2048; u.B1 = u.B0 + (size_t)128 * 2048;
        u.dst = X1 + ((size_t)pm * 256 * DM + pn * 256) * 4; u.pm = pm; u.pn = pn; u.e = 0; u.rows = 256; return true;
    }
    __device__ __forceinline__ unsigned arow(const gm::Unit&, int r) const { return (unsigned)r; }
};
struct EpiP6 {
    static constexpr bool PERM = false;
    const float* x; const float* mod;
    __device__ __forceinline__ void operator()(const f32x4 (&acc)[2][2][4][2], const gm::Unit& u, int wr, int wc, int fr, int fq) const {
        const int b = u.pm >> 3; const int col0 = u.pn * 256 + wc * 32 + 4 * fq;
        const float* mg = mod + b * 6144 + 2 * DM + col0;
        f32x4 gv[2][2];
#pragma unroll
        for (int bj = 0; bj < 2; ++bj)
#pragma unroll
            for (int n = 0; n < 2; ++n) gv[bj][n] = *(const f32x4*)(mg + bj * 128 + n * 16);
#pragma unroll
        for (int ai = 0; ai < 2; ++ai)
#pragma unroll
            for (int m = 0; m < 4; ++m) { const size_t ro = (size_t)(wr * 64 + fr + ai * 128 + m * 16) * DM + wc * 32 + 4 * fq;
                const float* xr = x + ((size_t)u.pm * 256 * DM + u.pn * 256) + ro; float* orow = (float*)u.dst + ro;
#pragma unroll
                for (int bj = 0; bj < 2; ++bj)
#pragma unroll
                    for (int n = 0; n < 2; ++n) { const f32x4 xv = *(const f32x4*)(xr + bj * 128 + n * 16);
                        *(f32x4*)(orow + bj * 128 + n * 16) = xv + gv[bj][n] * acc[ai][bj][m][n]; } }
    }
};

__device__ __forceinline__ void p_norm2_route(Frame& F, const Args& a) {
    const float* mod = (const float*)(F.ws + WS_MOD); const float* g2 = a.in[IN_G2]; const float* wrp = (const float*)(F.ws + WS_WRT);
    const float* X1 = F.out; bf16* HX2 = (bf16*)(F.ws + WS_HX2);
    int* list = (int*)(F.ws + WS_LIST); float* wt = (float*)(F.ws + WS_WT); unsigned* cnt = F.ctl + CW_CNT;
    LAS float* gs = (LAS float*)F.lds; LAS float* sh = gs + DM; LAS float* rst = sh + DM; LAS float* lgs = rst + 64;
    const int b = F.bid / 32;
    for (int k = F.tid; k < DM; k += NTHR) { gs[k] = g2[k] * (1.f + mod[b * 6144 + 4 * DM + k]); sh[k] = mod[b * 6144 + 3 * DM + k]; }
    __syncthreads();
    for (int r = F.wave; r < 64; r += NWAVES) {
        const int tok = F.bid * 64 + r;
        const f32x4* xr = (const f32x4*)(X1 + (size_t)tok * DM) + F.lane;
        f32x4 v[4]; float s = 0.f;
#pragma unroll
        for (int j = 0; j < 4; ++j) { v[j] = xr[64 * j]; s += (v[j].x * v[j].x + v[j].y * v[j].y) + (v[j].z * v[j].z + v[j].w * v[j].w); }
        const float rstd = rsqrtf(wave_sum(s) * (1.f / DM) + EPS);
        if (F.lane == 0) rst[r] = rstd;
        unsigned long long* o8 = (unsigned long long*)(HX2 + (size_t)tok * DM) + F.lane;
#pragma unroll
        for (int j = 0; j < 4; ++j) { const int k = 4 * F.lane + 256 * j;
            const f32x4 g = *(const LAS f32x4*)(gs + k), h = *(const LAS f32x4*)(sh + k);
            o8[64 * j] = (unsigned long long)pk2(v[j].x * rstd * g.x + h.x, v[j].y * rstd * g.y + h.y) | ((unsigned long long)pk2(v[j].z * rstd * g.z + h.z, v[j].w * rstd * g.w + h.w) << 32); }
    }
    LDS_WAIT(); __syncthreads();
    {
        const int tq = F.lane & 15, kq = F.lane >> 4, wg = F.wave & 3, kh = F.wave >> 2; const int tl = wg * 16 + tq;
        const float rs = rst[tl];
        const float* xr = X1 + (size_t)(F.bid * 64 + tl) * DM + 4 * kq + 512 * kh;
        const f32x4* wp = (const f32x4*)wrp + F.lane + (size_t)kh * 32 * 3 * 64;
        const LAS float* gsp = gs + 512 * kh + 4 * kq; const LAS float* shp = sh + 512 * kh + 4 * kq;
        f32x4 acc[3];
#pragma unroll
        for (int c = 0; c < 3; ++c) acc[c] = (f32x4){0.f, 0.f, 0.f, 0.f};
#pragma unroll 8
        for (int s = 0; s < 32; ++s) {
            const f32x4 x = *(const f32x4*)(xr + 16 * s); const f32x4 g = *(const LAS f32x4*)(gsp + 16 * s), h = *(const LAS f32x4*)(shp + 16 * s);
            const f32x4 hv = x * rs * g + h;
#pragma unroll
            for (int c = 0; c < 3; ++c) { const f32x4 w = wp[(s * 3 + c) * 64];
                acc[c] = __builtin_amdgcn_mfma_f32_16x16x4f32(hv[0], w[0], acc[c], 0, 0, 0); acc[c] = __builtin_amdgcn_mfma_f32_16x16x4f32(hv[1], w[1], acc[c], 0, 0, 0);
                acc[c] = __builtin_amdgcn_mfma_f32_16x16x4f32(hv[2], w[2], acc[c], 0, 0, 0); acc[c] = __builtin_amdgcn_mfma_f32_16x16x4f32(hv[3], w[3], acc[c], 0, 0, 0); }
        }
#pragma unroll
        for (int c = 0; c < 3; ++c)
#pragma unroll
            for (int r = 0; r < 4; ++r) lgs[kh * 64 * 48 + (wg * 16 + 4 * kq + r) * 48 + 16 * c + tq] = acc[c][r];
    }
    LDS_WAIT(); __syncthreads();
    if (F.wave < 4) {
        if (F.lane < 16) {
            const LAS float* lp = lgs + (F.wave * 16 + F.lane) * 48; const int tok = F.bid * 64 + F.wave * 16 + F.lane;
            float lg[36];
#pragma unroll
            for (int q = 0; q < 9; ++q) { const f32x4 t4 = *(const LAS f32x4*)(lp + 4 * q) + *(const LAS f32x4*)(lp + 64 * 48 + 4 * q) + *(const f32x4*)(wrp + 49152 + 4 * q);
                lg[4 * q] = t4.x; lg[4 * q + 1] = t4.y; lg[4 * q + 2] = t4.z; lg[4 * q + 3] = t4.w; }
            float mx = lg[0]; int gi = 0;
#pragma unroll
            for (int g = 1; g < 4; ++g) if (lg[g] > mx) { mx = lg[g]; gi = g; }
            float z = 0.f;
#pragma unroll
            for (int g = 0; g < 4; ++g) z += __expf(lg[g] - mx);
            const float pg = 1.f / z;
            float el[8];
#pragma unroll
            for (int e = 0; e < 8; ++e) el[e] = gi == 0 ? lg[4 + e] : (gi == 1 ? lg[12 + e] : (gi == 2 ? lg[20 + e] : lg[28 + e]));
            int e1 = 0; float m1 = el[0];
#pragma unroll
            for (int e = 1; e < 8; ++e) if (el[e] > m1) { m1 = el[e]; e1 = e; }
            int e2 = 0; float m2 = -3.0e38f;
#pragma unroll
            for (int e = 0; e < 8; ++e) if (e != e1 && el[e] > m2) { m2 = el[e]; e2 = e; }
            const float rr = __expf(m2 - m1); const float w1 = pg / (1.f + rr), w2 = pg * rr / (1.f + rr);
            const int ea = gi * 8 + e1, eb = gi * 8 + e2;
            const unsigned pa = __hip_atomic_fetch_add(cnt + 64 * ea, 1u, __ATOMIC_RELAXED, __HIP_MEMORY_SCOPE_AGENT);
            const unsigned pb = __hip_atomic_fetch_add(cnt + 64 * eb, 1u, __ATOMIC_RELAXED, __HIP_MEMORY_SCOPE_AGENT);
            list[(size_t)ea * CAP + pa] = tok * 2; wt[tok * 2] = w1;
            list[(size_t)eb * CAP + pb] = tok * 2 + 1; wt[tok * 2 + 1] = w2;
        }
    }
}

__device__ __forceinline__ void moe_table(Frame& F, const int* cntv) {
    if (F.wave == 0) { const int lane = F.lane; const int cnt = lane < NEXP ? cntv[64 * lane] : 0;
        const int t = (cnt + 255) >> 8; int ti = t, oi = cnt;
#pragma unroll
        for (int d = 1; d < 32; d <<= 1) { const int tu = __shfl_up(ti, d), ou = __shfl_up(oi, d); if ((lane & 31) >= d) { ti += tu; oi += ou; } }
        if (lane < NEXP) { F.MISC[128 + lane] = (unsigned)cnt; F.MISC[160 + lane] = (unsigned)(ti - t); F.MISC[192 + lane] = (unsigned)(oi - cnt); }
        if (lane == NEXP - 1) F.MISC[224] = (unsigned)ti; }
    LDS_WAIT(); __syncthreads();
}
__device__ __forceinline__ bool moe_find(volatile LAS unsigned* MISC, int lane, int T, int& e, int& rt, int& rows, int& off) {
    if (T >= (int)MISC[224]) return false;
    const int l = lane & 31; const int cnt = (int)MISC[128 + l], tpre = (int)MISC[160 + l];
    const unsigned long long mask = __ballot(lane < NEXP && cnt > 0 && T >= tpre);
    e = __builtin_amdgcn_readfirstlane(63 - __builtin_clzll(mask));
    rt = T - (int)MISC[160 + e]; const int c = (int)MISC[128 + e]; off = (int)MISC[192 + e];
    rows = c - rt * 256; if (rows > 256) rows = 256; return true;
}
struct SchedMoe1 {
    int G, c, lane; volatile LAS unsigned* MISC; const int* list; const char* HX2; const char* W1T; const char* W3T; char* HH; unsigned* tile_cnt;
    __device__ __forceinline__ bool next(int i, gm::Unit& u) const {
        const int vc = (c & 7) * (G >> 3) + (c >> 3);
        const int L = i * G + vc; int e, rt, rows, off; if (!moe_find(MISC, lane, L >> 2, e, rt, rows, off)) return false;
        const int pn = L & 3;
        e = __builtin_amdgcn_readfirstlane(e); rt = __builtin_amdgcn_readfirstlane(rt); rows = __builtin_amdgcn_readfirstlane(rows); off = __builtin_amdgcn_readfirstlane(off);
        u.A = HX2; u.B0 = W1T + ((size_t)e * DEXP + pn * 128) * 2048; u.B1 = W3T + ((size_t)e * DEXP + pn * 128) * 2048;
        u.dst = HH + ((size_t)(off + rt * 256) * DEXP + pn * 128) * 2; u.pm = rt; u.pn = pn; u.e = e; u.rows = rows; u.t = L >> 2; return true;
    }
    __device__ __forceinline__ unsigned arow(const gm::Unit& u, int r) const { const int rr = r < u.rows ? r : u.rows - 1; return (unsigned)(list[(size_t)u.e * CAP + u.pm * 256 + rr] >> 1); }
    __device__ __forceinline__ void a_ready(const gm::Unit&) const {}
    __device__ __forceinline__ void done(const gm::Unit& u) const {
        asm volatile("s_waitcnt vmcnt(0)" ::: "memory");
        __builtin_amdgcn_s_barrier(); asm volatile("" ::: "memory");
        if (threadIdx.x == 0) __hip_atomic_fetch_add(tile_cnt + 8 * u.t, 1u, __ATOMIC_RELAXED, __HIP_MEMORY_SCOPE_AGENT);
    }
};
struct EpiMoe1 {
    static constexpr bool PERM = true;
    char* HH;
    __device__ __forceinline__ void operator()(const f32x4 (&acc)[2][2][4][2], const gm::Unit& u, int wr, int wc, int fr, int fq) const {
        const __amdgpu_buffer_rsrc_t rs = __builtin_amdgcn_make_buffer_rsrc((void*)HH, 0, 0x7fffffff, 0x00020000);
        const unsigned base = (unsigned)(u.dst - HH) + (unsigned)(((wr * 64 + fr) * DEXP + wc * 32 + 8 * fq) * 2);
#pragma unroll
        for (int ai = 0; ai < 2; ++ai)
#pragma unroll
            for (int m = 0; m < 4; ++m) { const int r = ai * 128 + wr * 64 + m * 16 + fr; if (r >= u.rows) continue;
                const f32x4 u0 = acc[ai][0][m][0], u1 = acc[ai][0][m][1], v0 = acc[ai][1][m][0], v1 = acc[ai][1][m][1];
                u32x4 w; w.x = gm::cvt_pk_bf16(siluf_(u0[0]) * v0[0], siluf_(u0[1]) * v0[1]); w.y = gm::cvt_pk_bf16(siluf_(u0[2]) * v0[2], siluf_(u0[3]) * v0[3]);
                w.z = gm::cvt_pk_bf16(siluf_(u1[0]) * v1[0], siluf_(u1[1]) * v1[1]); w.w = gm::cvt_pk_bf16(siluf_(u1[2]) * v1[2], siluf_(u1[3]) * v1[3]);
                __builtin_amdgcn_raw_buffer_store_b128(w, rs, base + (unsigned)((ai * 128 + m * 16) * DEXP * 2), 0, 16); }
    }
};
struct SchedMoe2 {
    int G, c, lane; volatile LAS unsigned* MISC; const char* HH; const char* W2T; char* Y; unsigned* tile_cnt; unsigned* tmo;
    __device__ __forceinline__ bool next(int i, gm::Unit& u) const {
        const int vc = (c & 7) * (G >> 3) + (c >> 3);
        const int L = i * G + (G - 1 - vc); int e, rt, rows, off; if (!moe_find(MISC, lane, L >> 2, e, rt, rows, off)) return false;
        const int pn = L & 3;
        e = __builtin_amdgcn_readfirstlane(e); rt = __builtin_amdgcn_readfirstlane(rt); rows = __builtin_amdgcn_readfirstlane(rows); off = __builtin_amdgcn_readfirstlane(off);
        u.A = HH + (size_t)(off + rt * 256) * DEXP * 2; u.B0 = W2T + ((size_t)e * DM + pn * 256) * (DEXP * 2); u.B1 = u.B0 + (size_t)128 * (DEXP * 2);
        u.dst = Y + (size_t)pn * 256 * 2; u.pm = rt; u.pn = pn; u.e = e; u.rows = rows; u.t = L >> 2; return true;
    }
    __device__ __forceinline__ unsigned arow(const gm::Unit&, int r) const { return (unsigned)r; }
    __device__ __forceinline__ void a_ready(const gm::Unit& u) const {
        if (threadIdx.x < 64) {
            unsigned spins = 0;
            while ((unsigned)__builtin_amdgcn_readfirstlane(__hip_atomic_load(tile_cnt + 8 * u.t, __ATOMIC_RELAXED, __HIP_MEMORY_SCOPE_AGENT)) < 4u) {
                __builtin_amdgcn_s_sleep(2);
                if (++spins > (1u << 22)) { if (threadIdx.x == 0) __hip_atomic_store(tmo, 1u, __ATOMIC_RELAXED, __HIP_MEMORY_SCOPE_AGENT); break; } }
            __builtin_amdgcn_fence(__ATOMIC_ACQUIRE, "agent");
            asm volatile("s_waitcnt vmcnt(0)" ::: "memory");
        }
        asm volatile("" ::: "memory"); __builtin_amdgcn_s_barrier(); asm volatile("" ::: "memory");
    }
    __device__ __forceinline__ void done(const gm::Unit&) const {}
};
struct EpiMoe2 {
    static constexpr bool PERM = true;
    const int* list;
    __device__ __forceinline__ void operator()(const f32x4 (&acc)[2][2][4][2], const gm::Unit& u, int wr, int wc, int fr, int fq) const {
        const int* lp = list + (size_t)u.e * CAP + u.pm * 256;
#pragma unroll
        for (int ai = 0; ai < 2; ++ai)
#pragma unroll
            for (int m = 0; m < 4; ++m) { const int r = ai * 128 + wr * 64 + m * 16 + fr; if (r >= u.rows) continue;
                const int slot = lp[r]; bf16* rowp = (bf16*)u.dst + (size_t)slot * DM + wc * 32 + 8 * fq;
#pragma unroll
                for (int bj = 0; bj < 2; ++bj) { const f32x4 v0 = acc[ai][bj][m][0], v1 = acc[ai][bj][m][1];
                    u32x4 w; w.x = gm::cvt_pk_bf16(v0[0], v0[1]); w.y = gm::cvt_pk_bf16(v0[2], v0[3]); w.z = gm::cvt_pk_bf16(v1[0], v1[1]); w.w = gm::cvt_pk_bf16(v1[2], v1[3]);
                    *(u32x4*)(rowp + bj * 128) = w; } }
    }
};

__device__ __forceinline__ void p_final(Frame& F, const Args& a) {
    const float* mod = (const float*)(F.ws + WS_MOD); const float* fg = a.in[IN_FG]; const float* wt = (const float*)(F.ws + WS_WT);
    const bf16* Y = (const bf16*)(F.ws + WS_Y); float* X1 = F.out;
    for (int r = F.wave; r < 64; r += NWAVES) {
        const int tok = F.bid * 64 + r; const int b = tok >> 11;
        const float w0 = wt[tok * 2], w1 = wt[tok * 2 + 1];
        f32x4* xr = (f32x4*)(X1 + (size_t)tok * DM) + F.lane;
        const u32x2* y0 = (const u32x2*)(Y + (size_t)(tok * 2) * DM) + F.lane; const u32x2* y1 = (const u32x2*)(Y + (size_t)(tok * 2 + 1) * DM) + F.lane;
        f32x4 v[4]; float s = 0.f;
#pragma unroll
        for (int j = 0; j < 4; ++j) { const int k = 4 * F.lane + 256 * j;
            const f32x4 xv = xr[64 * j]; const u32x2 a0 = y0[64 * j], a1 = y1[64 * j]; const f32x4 g5 = *(const f32x4*)(mod + b * 6144 + 5 * DM + k);
            v[j].x = xv.x + g5.x * (w0 * bflo(a0.x) + w1 * bflo(a1.x)); v[j].y = xv.y + g5.y * (w0 * bfhi(a0.x) + w1 * bfhi(a1.x));
            v[j].z = xv.z + g5.z * (w0 * bflo(a0.y) + w1 * bflo(a1.y)); v[j].w = xv.w + g5.w * (w0 * bfhi(a0.y) + w1 * bfhi(a1.y));
            s += (v[j].x * v[j].x + v[j].y * v[j].y) + (v[j].z * v[j].z + v[j].w * v[j].w); }
        const float rstd = rsqrtf(wave_sum(s) * (1.f / DM) + EPS);
#pragma unroll
        for (int j = 0; j < 4; ++j) { const int k = 4 * F.lane + 256 * j; const f32x4 g = *(const f32x4*)(fg + k);
            xr[64 * j] = (f32x4){v[j].x * rstd * g.x, v[j].y * rstd * g.y, v[j].z * rstd * g.z, v[j].w * rstd * g.w}; }
    }
}
#ifndef LRU_FAST
#define LRU_FAST 1
#endif
#ifndef HG_FAST
#define HG_FAST 1
#endif
#define MIX_FAST (LRU_FAST && HG_FAST)
#ifdef PROBE_A
#define STAMP(k) do { if (F.bid == 0 && F.tid == 0) { const unsigned long long _t = __builtin_amdgcn_s_memrealtime(); F.MISC[32 + 2 * (k)] = (unsigned)_t; F.MISC[33 + 2 * (k)] = (unsigned)(_t >> 32); } } while (0)
#else
#define STAMP(k) do { } while (0)
#endif
__device__ __forceinline__ void p_mix1(Frame& F, const Args& a) {
#if LRU_FAST
    for (int u = F.bid; u < NB * 8 * LRU_NCH; u += F.G) lru_pass1<0>(F, a, u, (float*)(F.ws + WS_LRUAGG));
#ifdef XLRU
    for (int u = F.bid; u < NB * 8 * LRU_NCH; u += F.G) lru_pass1<XLRU>(F, a, u, F.out + (size_t)10 * 1024 * 1024);
#endif
#endif
    STAMP(14); STAMP(15);
#if HG_FAST
    for (int i = 0, u = F.bid; u < NB * 8 * 2 * 4; u += F.G, ++i) hg_pass1(F, a, (u & ~3) | ((u + 2 * i) & 3));
#endif
}
__device__ __forceinline__ void p_mix2(Frame& F, const Args& a) {
#if LRU_FAST
    for (int u = F.bid; u < NB * 8 * LRU_NCH; u += F.G) lru_pass2(F, a, u);
#endif
    STAMP(16); STAMP(17);
#if HG_FAST
    for (int u = F.bid; u < NB * 8 * 4; u += F.G) hg_pass2(F, a, u);
#endif
}
__global__ void __launch_bounds__(NTHR, 2) mega(Args args) {
    extern __shared__ __attribute__((aligned(16))) unsigned char lds_raw[];
    Frame F;
    F.lds = (LAS unsigned char*)lds_raw; F.MISC = (volatile LAS unsigned*)(F.lds + LDSCTL_OFF);
    F.tid = threadIdx.x; F.lane = F.tid & 63; F.wave = __builtin_amdgcn_readfirstlane(F.tid >> 6);
    F.G = gridDim.x; F.bid = blockIdx.x; F.ws = args.ws; F.out = args.out; F.ctl = (unsigned*)(args.ws + WS_CTL);
    for (int u = F.tid; u < (LDS_BYTES - LDSCTL_OFF) / 4; u += NTHR) ((LAS unsigned*)(F.lds + LDSCTL_OFF))[u] = 0u;
    __syncthreads();
    XcdBarrier bar = xcd_barrier_post(F.ctl + CW_BAR + args.li * 3584, F.MISC + 8);
    const int lo = args.ph_lo, hi = args.ph_hi;
#define IN(k) (lo <= (k) && (k) < hi)
#define SEAM(k) do { if (IN(k) && IN((k) + 1)) xcd_barrier(bar); STAMP((k) + 1); if ((k) == 9) STAMP(11); } while (0)
    unsigned char* ws = F.ws;
    STAMP(0);
    if (IN(0)) { p0_prologue(F, args); } SEAM(0);
    if (IN(1)) { p1_norm(F, args); } SEAM(1);
    if (IN(2)) {
        SchedP2 S{F.G, F.bid, (const char*)F.out, (const char*)(ws + WS_WIN), (char*)(ws + WS_P), (char*)(ws + WS_PC)};
        EpiStoreBf16 E;
        gm::gemm_phase<SchedP2, EpiStoreBf16, false>(F.lds, DM, S, E);
    } SEAM(2);
    if (IN(3)) { p_mix1(F, args); } SEAM(3);
    if (IN(4)) { p_mix2(F, args); } SEAM(4);
    if (IN(6)) {
        const bool conv_first = ((F.bid >> 3) & 1) != 0;
        if (conv_first) { p_moe_weights13(F, args); p_moe_weights2(F, args, F.bid, F.G); __syncthreads(); }
        {
            SchedP5 S{F.bid, (const char*)(ws + WS_YAG), (const char*)(ws + WS_YBG), (const char*)(ws + WS_WPA), (const char*)(ws + WS_WPB), nullptr, (char*)(ws + WS_M)};
            EpiP5 E{F.out + (size_t)F.bid * 65536, (const bf16*)(ws + WS_P + 7 * GS), (const bf16*)(ws + WS_P + 8 * GS)};
            gm::gemm_phase<SchedP5, EpiP5, false>(F.lds, DM, S, E);
        }
        if (!conv_first) { __syncthreads(); p_moe_weights13(F, args); p_moe_weights2(F, args, F.bid, F.G); }
    } SEAM(6);
    if (IN(7)) {
        SchedP6 S{F.bid, (const char*)(ws + WS_M), (const char*)(ws + WS_WOUT), (char*)F.out};
        EpiP6 E{args.in[IN_X], (const float*)(ws + WS_MOD)};
        gm::gemm_phase<SchedP6, EpiP6, false>(F.lds, DM, S, E);
    } SEAM(7);
    if (IN(8)) { p_norm2_route(F, args); } SEAM(8);
    if (IN(9)) {
        moe_table(F, (const int*)(F.ctl + CW_CNT));
        {
            SchedMoe1 S{F.G, F.bid, F.lane, F.MISC, (const int*)(ws + WS_LIST), (const char*)(ws + WS_HX2), (const char*)(ws + WS_W1T), (const char*)(ws + WS_W3T), (char*)(ws + WS_HH), F.ctl + CW_TILE};
            EpiMoe1 E{(char*)(ws + WS_HH)};
            gm::gemm_phase<SchedMoe1, EpiMoe1, true, true>(F.lds, DM, S, E);
        }
        {
            SchedMoe2 S{F.G, F.bid, F.lane, F.MISC, (const char*)(ws + WS_HH), (const char*)(ws + WS_W2T), (char*)(ws + WS_Y), F.ctl + CW_TILE, F.ctl + 2};
            EpiMoe2 E{(const int*)(ws + WS_LIST)};
            gm::gemm_phase<SchedMoe2, EpiMoe2, false, true>(F.lds, DEXP, S, E);
        }
    } SEAM(9);
    if (IN(11)) { p_final(F, args); }
#ifdef PROBE_A
    if (F.bid == 0 && F.tid == 0) {
        const unsigned long long tend = __builtin_amdgcn_s_memrealtime();
        F.MISC[32 + 2 * 12] = (unsigned)tend; F.MISC[33 + 2 * 12] = (unsigned)(tend >> 32);
        auto RD = [&](int k) { return ((unsigned long long)F.MISC[33 + 2 * k] << 32) | F.MISC[32 + 2 * k]; };
        auto T = [&](int k) { if (k >= 20) { const int i = k - 20; return (unsigned long long)(((((unsigned long long)F.MISC[103 + 2 * i] << 32) | F.MISC[102 + 2 * i]) + 400) / 800); } if (k == 13) return (unsigned long long)((RD(14) - RD(3) + 400) / 800); if (k == 15) return (unsigned long long)((RD(16) - RD(4) + 400) / 800); const unsigned long long t0 = ((unsigned long long)F.MISC[33 + 2 * k] << 32) | F.MISC[32 + 2 * k], t1 = ((unsigned long long)F.MISC[33 + 2 * (k + 1)] << 32) | F.MISC[32 + 2 * (k + 1)]; return (unsigned long long)((t1 - t0 + 400) / 800); };
        const unsigned long long delay = (T(PROBE_A) + 64ull * T(PROBE_B)) * 6400ull;
        while (__builtin_amdgcn_s_memrealtime() - tend < delay) __builtin_amdgcn_s_sleep(32);
    }
#endif
#undef IN
#undef SEAM
}

#if !LRU_FAST
__global__ void k_conv_f(const bf16* P0, const bf16* PC0, const float* cw, const float* cb, float* Ub, int b) {
    int t = blockIdx.x; int Lseg = t < CTX ? CTX : SEQ; int lt = t < CTX ? t : t - CTX;
    const bf16* base = t < CTX ? PC0 + (size_t)b * CTX * DM : P0 + (size_t)b * SEQ * DM;
    for (int ch = threadIdx.x; ch < DM; ch += 256) {
        float s = cb[ch];
#pragma unroll
        for (int k = 0; k < 4; ++k) { int tt = lt + k - 2; if (tt >= 0 && tt < Lseg) s += cw[k * DM + ch] * bf2f(base[(size_t)tt * DM + ch]); }
        Ub[(size_t)t * DM + ch] = s;
    }
}
__global__ void k_gates(const float* Ub, const float* wa, const float* ba, const float* wx, const float* bx, const float* lam, float* Aout, float* Bout, int d) {
    __shared__ float us[128];
    int t = blockIdx.x, h = blockIdx.y, j = threadIdx.x; int ch = h * 128 + j;
    float uval = Ub[(size_t)t * DM + ch];
    us[j] = uval; __syncthreads();
    const float* wah = wa + ((size_t)(d * 8 + h) * 128) * 128; const float* wxh = wx + ((size_t)(d * 8 + h) * 128) * 128;
    float ra = 0.f, ia = 0.f;
    for (int i = 0; i < 128; ++i) { float u = us[i]; ra += u * wah[i * 128 + j]; ia += u * wxh[i * 128 + j]; }
    float r = 1.f / (1.f + expf(-(ra + ba[d * DM + ch]))); float ig = 1.f / (1.f + expf(-(ia + bx[d * DM + ch])));
    float sp = log1pf(expf(-lam[d * DM + ch]));
    float log_a = -8.f * r * sp;
    Aout[(size_t)t * DM + ch] = expf(log_a); Bout[(size_t)t * DM + ch] = sqrtf(-expm1f(2.f * log_a)) * (ig * uval);
}
__global__ void k_lru_scan(const float* A0, const float* B0, const float* A1, const float* B1, float* YF, float* YB) {
    int g = blockIdx.x * 256 + threadIdx.x; int d = g / DM, ch = g % DM;
    if (d == 0) { float h = B0[ch];
        for (int t = 0; t < SEQ; ++t) { size_t o = (size_t)(CTX + t) * DM + ch; h = A0[o] * h + B0[o]; YF[(size_t)t * DM + ch] = h; }
    } else { float h = B1[(size_t)(CTX - 1) * DM + ch];
        for (int t = SEQ - 1; t >= 0; --t) { size_t o = (size_t)(CTX + t) * DM + ch; h = A1[o] * h + B1[o]; YB[(size_t)t * DM + ch] = h; }
    }
}
__global__ void k_yag_f(const float* YF, const float* YB, bf16* AY, int b) {
    int t = blockIdx.x;
    for (int ch = threadIdx.x; ch < DM; ch += 256) { size_t o = (size_t)t * DM + ch; bf16* p = AY + ((size_t)b * SEQ + t) * DM + ch;
        *p = (bf16)f2bf((YF[o] + YB[o]) * gelu_tanh(bf2f(*p))); }
}
#endif
#if !HG_FAST
__global__ __launch_bounds__(128) void k_hgrn_f(unsigned char* ws, const float* hg_lb) {
    __shared__ float gs[128], ks[128], qs[128];
    int h = blockIdx.x, d = blockIdx.y, b = blockIdx.z, j = threadIdx.x;
    float S[128];
#pragma unroll
    for (int i = 0; i < 128; ++i) S[i] = 0.f;
    const int c = h * 128 + j;
    const float lbj = 1.f / (1.f + expf(hg_lb[DM + c] - hg_lb[c]));
    bf16* Q = (bf16*)(ws + WS_P + 2 * GS); bf16* Fx = (bf16*)(ws + WS_P + (d == 0 ? 3 : 4) * GS); bf16* V = (bf16*)(ws + WS_P + 5 * GS);
    const bf16* Fc = (const bf16*)(ws + WS_PC + (d == 0 ? 1 : 2) * CGS); const bf16* Vc = (const bf16*)(ws + WS_PC + 3 * CGS);
    for (int s = 0; s < LT; ++s) {
        bool isx = s >= CTX; float fv, vv, qv = 0.f; size_t o;
        if (!isx) { int t = d == 0 ? s : (CTX - 1 - s); o = ((size_t)b * CTX + t) * DM + c; fv = bf2f(Fc[o]); vv = bf2f(Vc[o]); }
        else { int p = s - CTX; if (d == 1) p = SEQ - 1 - p; int tok = (p % 32) * 64 + (p / 32); o = ((size_t)b * SEQ + tok) * DM + c; fv = bf2f(Fx[o]); vv = bf2f(V[o]); qv = bf2f(Q[o]); }
        float gg = lbj + (1.f - lbj) / (1.f + expf(-fv));
        gs[j] = gg; ks[j] = 1.f - gg; qs[j] = qv / (1.f + expf(-qv));
        __syncthreads();
        float oo = 0.f;
#pragma unroll
        for (int i = 0; i < 128; ++i) { S[i] = gs[i] * S[i] + ks[i] * vv; oo += S[i] * qs[i]; }
        if (isx) Fx[o] = (bf16)f2bf(oo);
        __syncthreads();
    }
}
#endif

extern "C" void kernel_launch(void* const* d_in, const int* in_sizes, int n_in, void* d_out, int out_size, void* d_ws, size_t ws_size, hipStream_t stream) {
    static int grid = 0;
    if (grid == 0) {
        if (n_in != 29 || out_size != NTOK * DM || ws_size < WS_END) { fprintf(stderr, "kernel_launch: unexpected problem shape / workspace (%d inputs, out %d, ws %zu)\n", n_in, out_size, ws_size); grid = -1; return; }
        int dev = 0, cus = 0, per_cu = 0;
        if (hipGetDevice(&dev) != hipSuccess || hipDeviceGetAttribute(&cus, hipDeviceAttributeMultiprocessorCount, dev) != hipSuccess) { grid = -1; return; }
        if (hipFuncSetAttribute((const void*)mega, hipFuncAttributeMaxDynamicSharedMemorySize, LDS_BYTES) != hipSuccess) { grid = -1; return; }
        if (hipOccupancyMaxActiveBlocksPerMultiprocessor(&per_cu, (const void*)mega, NTHR, LDS_BYTES) != hipSuccess || per_cu < 1) { fprintf(stderr, "kernel_launch: occupancy query says %d blocks per CU\n", per_cu); }
        (void)hipGetLastError();
        grid = cus;
        if (grid != 256) { fprintf(stderr, "kernel_launch: built for 256 CUs, found %d\n", cus); grid = -1; return; }
    }
    if (grid < 0) return;
    hipMemsetAsync((char*)d_ws + WS_CTL, 0, CTL_BYTES, stream);
    Args a{};
    for (int i = 0; i < 29; ++i) a.in[i] = (const float*)d_in[i];
    a.out = (float*)d_out; a.ws = (unsigned char*)d_ws;
#if MIX_FAST
    a.ph_lo = 0; a.ph_hi = 12; a.li = 0;
    hipLaunchKernelGGL(mega, dim3(grid), dim3(NTHR), LDS_BYTES, stream, a);
#else
    a.ph_lo = 0; a.ph_hi = 5; a.li = 0;
    hipLaunchKernelGGL(mega, dim3(grid), dim3(NTHR), LDS_BYTES, stream, a);
    {
        unsigned char* ws = (unsigned char*)d_ws;
#if !LRU_FAST
        float* sc = (float*)d_out;
        float* Ub = sc; float* A0 = Ub + (size_t)LT * DM; float* B0 = A0 + (size_t)LT * DM; float* A1 = B0 + (size_t)LT * DM; float* B1 = A1 + (size_t)LT * DM;
        float* YF = B1 + (size_t)LT * DM; float* YB = YF + (size_t)SEQ * DM;
        const float* cw = (const float*)d_in[IN_CONVW]; const float* cb = (const float*)d_in[IN_CONVB];
        const float* wa = (const float*)d_in[IN_WA]; const float* ba = (const float*)d_in[IN_BA]; const float* wx = (const float*)d_in[IN_WX]; const float* bx = (const float*)d_in[IN_BX]; const float* lam = (const float*)d_in[IN_LAM];
        for (int b = 0; b < NB; ++b) {
            k_conv_f<<<LT, 256, 0, stream>>>((const bf16*)(ws + WS_P), (const bf16*)(ws + WS_PC), cw, cb, Ub, b);
            k_gates<<<dim3(LT, 8), 128, 0, stream>>>(Ub, wa, ba, wx, bx, lam, A0, B0, 0);
            k_gates<<<dim3(LT, 8), 128, 0, stream>>>(Ub, wa, ba, wx, bx, lam, A1, B1, 1);
            k_lru_scan<<<8, 256, 0, stream>>>(A0, B0, A1, B1, YF, YB);
            k_yag_f<<<SEQ, 256, 0, stream>>>(YF, YB, (bf16*)(ws + WS_YAG), b);
        }
#endif
#if !HG_FAST
        k_hgrn_f<<<dim3(8, 2, NB), 128, 0, stream>>>(ws, (const float*)d_in[IN_HGLB]);
#endif
    }
    a.ph_lo = 5; a.ph_hi = 12; a.li = 1;
    hipLaunchKernelGGL(mega, dim3(grid), dim3(NTHR), LDS_BYTES, stream, a);
#endif
}
```

```cpp
#include <hip/hip_runtime.h>
#include <cstdio>
#include <cstdint>
#include <math.h>

#define LAS __attribute__((address_space(3)))
#define GAS __attribute__((address_space(1)))
typedef unsigned short bf16;
typedef short bf16x8 __attribute__((ext_vector_type(8)));
typedef float f32x4 __attribute__((ext_vector_type(4)));
typedef float f32x2 __attribute__((ext_vector_type(2)));
typedef unsigned u32x4 __attribute__((ext_vector_type(4)));
typedef unsigned u32x2 __attribute__((ext_vector_type(2)));

constexpr int DM = 1024, NB = 8, SEQ = 2048, CTX = 256, NTOK = NB * SEQ, NCTX = NB * CTX, INW = 9216, LT = CTX + SEQ;
constexpr int NEXP = 32, DEXP = 512, CAP = 16384;
constexpr float EPS = 1e-6f;
constexpr int NWAVES = 8, NTHR = 512;

constexpr size_t MiB = 1u << 20, KiB = 1024;
constexpr size_t WS_CTL = 0, CTL_BYTES = 64 * KiB;
constexpr size_t WS_MODP = 256 * KiB;
constexpr size_t WS_MOD = 2 * MiB;
constexpr size_t WS_LRUAGG = 2 * MiB + 512 * KiB;
constexpr size_t WS_LRUS0 = 4 * MiB + 512 * KiB;
constexpr size_t WS_WT = 4 * MiB + 768 * KiB;
constexpr size_t WS_LIST = 5 * MiB;
constexpr size_t WS_HGD = 7 * MiB;
constexpr size_t WS_WRT = 7 * MiB + 256 * KiB;
constexpr size_t WS_WIN = 8 * MiB;
constexpr size_t WS_WPA = 26 * MiB, WS_WPB = 28 * MiB, WS_WOUT = 30 * MiB;
constexpr size_t WS_WLRU = 32 * MiB;
constexpr size_t WS_P = 33 * MiB, GS = 32 * MiB;
constexpr size_t WS_PC = 321 * MiB, CGS = 4 * MiB;
constexpr size_t WS_END = 337 * MiB;
constexpr size_t WS_W1T = WS_P + 0 * GS, WS_W3T = WS_P + 2 * GS, WS_W2T = WS_P + 5 * GS;
constexpr size_t WS_YAG = WS_P + 1 * GS;
constexpr size_t WS_OF = WS_P + 3 * GS, WS_OB = WS_P + 4 * GS;
constexpr size_t WS_YBG = WS_P + 3 * GS;
constexpr size_t WS_M = WS_P + 4 * GS;
constexpr size_t WS_HX2 = WS_P + 1 * GS;
constexpr size_t WS_HH = WS_P + 3 * GS;
constexpr size_t WS_Y = WS_P + 6 * GS;

constexpr int CW_BAR = 1024;
constexpr int CW_CNT = 12288;
constexpr int CW_TILE = 14336;

constexpr int RING_BYTES = 131072, LDS_BYTES = 147456, LDSCTL_OFF = LDS_BYTES - 1024;

#define LDS_WAIT() asm volatile("s_waitcnt lgkmcnt(0)" ::: "memory")
#define VM_WAIT() asm volatile("s_waitcnt vmcnt(0)" ::: "memory")

typedef __bf16 bf16x2_t __attribute__((ext_vector_type(2)));
__device__ __forceinline__ unsigned pk2(float lo, float hi) { const f32x2 v = {lo, hi}; return __builtin_bit_cast(unsigned, __builtin_convertvector(v, bf16x2_t)); }
__device__ __forceinline__ unsigned f2bf(float f) { return pk2(f, 0.f) & 0xffffu; }
__device__ __forceinline__ float bf2f(unsigned short b) { return __builtin_bit_cast(float, (unsigned)b << 16); }
__device__ __forceinline__ float bflo(unsigned w) { return __builtin_bit_cast(float, w << 16); }
__device__ __forceinline__ float bfhi(unsigned w) { return __builtin_bit_cast(float, w & 0xffff0000u); }
__device__ __forceinline__ float sigmoidf_(float x) { return 1.f / (1.f + __expf(-x)); }
__device__ __forceinline__ float siluf_(float x) { return x / (1.f + __expf(-x)); }
__device__ __forceinline__ float gelu_tanh(float x) { float u = 0.7978845608028654f * (x + 0.044715f * x * x * x); float e = __expf(2.f * u); return x * (1.f - 1.f / (1.f + e)); }
__device__ __forceinline__ float wave_sum(float v) {
#pragma unroll
    for (int o = 1; o < 64; o <<= 1) v += __shfl_xor(v, o);
    return v;
}

#define XB_TMO      128
#define XB_XCNT(j)  (256  + 64 * (j))
#define XB_XSUB(j)  (1280 + 64 * (j))
#define XB_XGEN(j)  (2304 + 64 * (j))
#define XB_TOP      3328
#define XB_TOPGEN   3392
#define XCD_BAR_WORDS 3456
#define XB_SPIN_CAP (1u << 20)
__device__ __forceinline__ unsigned xb_ld(unsigned* p)              { return __hip_atomic_load(p, __ATOMIC_RELAXED, __HIP_MEMORY_SCOPE_AGENT); }
__device__ __forceinline__ unsigned xb_add(unsigned* p, unsigned v) { return __hip_atomic_fetch_add(p, v, __ATOMIC_RELAXED, __HIP_MEMORY_SCOPE_AGENT); }
__device__ __forceinline__ unsigned xb_xcc_id() { return (unsigned)__builtin_amdgcn_s_getreg((3 << 11) | 20) & 0xFu; }
#define XB_SPIN(cond, bar) do { unsigned _sp = 0; while (cond) { __builtin_amdgcn_s_sleep(1); \
    if ((++_sp & 255u) == 0u) { if (xb_ld(&(bar)[XB_TMO])) break; if (_sp > XB_SPIN_CAP) { atomicAdd(&(bar)[XB_TMO], 1u); break; } } } } while (0)
struct XcdBarrier { unsigned* bar; unsigned x; volatile LAS unsigned* st; };
__device__ __forceinline__ XcdBarrier xcd_barrier_post(unsigned* bar, volatile LAS unsigned* st) {
    XcdBarrier b; b.bar = bar; b.x = xb_xcc_id(); b.st = st;
    if (threadIdx.x == 0) (void)xb_add(&bar[XB_XCNT(b.x)], 1u);
    return b;
}
__device__ __forceinline__ void xcd_barrier_complete(unsigned* bar, unsigned x, unsigned& nloc, unsigned& nx) {
    const unsigned G = gridDim.x * gridDim.y * gridDim.z;
    unsigned sum, cnt, mine, sp = 0u;
    for (;;) {
        sum = 0u; cnt = 0u; mine = 0u;
#pragma unroll
        for (unsigned j = 0; j < 16; ++j) { const unsigned c = xb_ld(&bar[XB_XCNT(j)]); sum += c; cnt += (c > 0u) ? 1u : 0u; mine = (j == x) ? c : mine; }
        if (sum == G) break;
        __builtin_amdgcn_s_sleep(1);
        if ((++sp & 255u) == 0u) { if (xb_ld(&bar[XB_TMO])) break; if (sp > XB_SPIN_CAP) { atomicAdd(&bar[XB_TMO], 1u); break; } }
    }
    nloc = mine > 0u ? mine : 1u; nx = cnt > 0u ? cnt : 1u;
}
__device__ __forceinline__ void xcd_barrier(const XcdBarrier& b) {
    asm volatile("s_waitcnt vmcnt(0)" ::: "memory");
    __syncthreads();
    if (threadIdx.x == 0) {
        unsigned* bar = b.bar;
        __builtin_amdgcn_s_waitcnt(0);
        unsigned nloc = b.st[0], nx = b.st[1];
        if (nloc == 0u) { xcd_barrier_complete(bar, b.x, nloc, nx); b.st[0] = nloc; b.st[1] = nx; }
        const unsigned old = xb_add(&bar[XB_XSUB(b.x)], 1u);
        const unsigned gen = old / nloc;
        if (old + 1u == (gen + 1u) * nloc) {
            __builtin_amdgcn_fence(__ATOMIC_RELEASE, "agent");
            asm volatile("s_waitcnt vmcnt(0)" ::: "memory");
            const unsigned og = xb_add(&bar[XB_TOP], 1u);
            const unsigned tg = og / nx;
            if (og + 1u == (tg + 1u) * nx) xb_add(&bar[XB_TOPGEN], 1u);
            else XB_SPIN(xb_ld(&bar[XB_TOPGEN]) == tg, bar);
            __builtin_amdgcn_fence(__ATOMIC_ACQUIRE, "agent");
            xb_add(&bar[XB_XGEN(b.x)], 1u);
            asm volatile("s_waitcnt vmcnt(0)" ::: "memory");
        } else {
            XB_SPIN(xb_ld(&bar[XB_XGEN(b.x)]) == gen, bar);
            __builtin_amdgcn_fence(__ATOMIC_ACQUIRE, "agent");
            asm volatile("s_waitcnt vmcnt(0)" ::: "memory");
        }
    }
    __syncthreads();
}

namespace gm {
constexpr int BM = 256, BK = 64, HALF = 128, HTB = HALF * BK * 2;
__device__ __forceinline__ int lds_byte(int r, int c) { const int st = (r >> 4) * 2 + (c >> 5), rr = r & 15, cc = c & 31, ob = rr * 64 + cc * 2; return st * 1024 + (ob ^ (((ob >> 9) & 1) << 5)); }
__device__ __forceinline__ void stage_rc(int b, int& R, int& C) { const int st = b / 1024, sb = b % 1024, swz = sb ^ (((sb >> 9) & 1) << 5); R = (st >> 1) * 16 + swz / 64; C = (st & 1) * 32 + (swz % 64) / 2; }
__device__ __forceinline__ int perm32(int rho) { const int n = rho >> 4, i = rho & 15; return 8 * (i >> 2) + 4 * n + (i & 3); }
__device__ __forceinline__ unsigned cvt_pk_bf16(float lo, float hi) { unsigned r; asm volatile("v_cvt_pk_bf16_f32 %0, %1, %2" : "=v"(r) : "v"(lo), "v"(hi)); return r; }

struct Unit { const char* A; const char* B0; const char* B1; char* dst; int pm, pn, e, rows, t; };

template <class Sched, class Epi, bool GATHER, bool HOOKS = false>
__device__ __forceinline__ void gemm_phase(LAS unsigned char* lds, const int K, const Sched& S, const Epi& E) {
    const int tid = threadIdx.x, wid = __builtin_amdgcn_readfirstlane(tid >> 6), lane = tid & 63, wr = wid >> 2, wc = wid & 3, fr = lane & 15, fq = lane >> 4;
    const int nt = K / BK;
    unsigned voffB[2]; int Rr[2]; unsigned Cb[2];
#pragma unroll
    for (int i = 0; i < 2; ++i) { int R, C; stage_rc(tid * 16 + i * 8192, R, C); const int Rb = Epi::PERM ? ((R & ~31) + perm32(R & 31)) : R;
        Rr[i] = R; Cb[i] = (unsigned)C * 2u; voffB[i] = (unsigned)(Rb * K + C) * 2u; }
    const unsigned rowb = (unsigned)K * 2u;
    const size_t kstep = (size_t)(BK * 2);
    const unsigned ldsw = (unsigned)wid * 1024u;
    const int aoff = lds_byte(wr * 64 + fr, fq * 8), boff = lds_byte(wc * 32 + fr, fq * 8);
#define GM_SA(b, h) (((b) * 2 + (h)) * HTB)
#define GM_SB(b, h) ((4 + (b) * 2 + (h)) * HTB)
#define GM_STAGE(bufoff, gbase, voff) do { _Pragma("unroll") for (int _i = 0; _i < 2; ++_i) \
        __builtin_amdgcn_global_load_lds((const unsigned*)((const char*)(gbase) + (voff)[_i]), (LAS unsigned*)(lds + (bufoff) + ldsw + _i * 8192), 16, 0, 0); } while (0)
#define GM_LDA(dst, b, h) do { _Pragma("unroll") for (int m = 0; m < 4; ++m) _Pragma("unroll") for (int k = 0; k < 2; ++k) dst[m][k] = *(const LAS bf16x8*)(lds + GM_SA(b, h) + aoff + m * 2048 + k * 1024); } while (0)
#define GM_LDB(dst, b, h) do { _Pragma("unroll") for (int n = 0; n < 2; ++n) _Pragma("unroll") for (int k = 0; k < 2; ++k) dst[n][k] = *(const LAS bf16x8*)(lds + GM_SB(b, h) + boff + n * 2048 + k * 1024); } while (0)
#define GM_MMA(ai, bj, At, Bt) do { __builtin_amdgcn_s_setprio(1); _Pragma("unroll") for (int m = 0; m < 4; ++m) _Pragma("unroll") for (int n = 0; n < 2; ++n) _Pragma("unroll") for (int k = 0; k < 2; ++k) \
        acc[ai][bj][m][n] = __builtin_amdgcn_mfma_f32_16x16x32_bf16(Bt[n][k], At[m][k], acc[ai][bj][m][n], 0, 0, 0); __builtin_amdgcn_s_setprio(0); } while (0)
#define GM_WAIT_V(n) asm volatile("s_waitcnt vmcnt(" #n ")" ::: "memory")
#define GM_WAIT_L(n) asm volatile("s_waitcnt lgkmcnt(" #n ")" ::: "memory")
#define GM_BAR __builtin_amdgcn_s_barrier()
#define GM_SCHED __builtin_amdgcn_sched_barrier(0)
#define GM_AOFFS(u, o) do { _Pragma("unroll") for (int _h = 0; _h < 2; ++_h) _Pragma("unroll") for (int _i = 0; _i < 2; ++_i) \
        (o)[_h][_i] = (GATHER ? S.arow((u), _h * HALF + Rr[_i]) : (unsigned)(_h * HALF + Rr[_i])) * rowb + Cb[_i]; } while (0)
    Unit cur, nxt; int ui = 0;
    if (!S.next(0, cur)) return;
    f32x4 acc[2][2][4][2];
#pragma unroll
    for (int a = 0; a < 2; ++a)
#pragma unroll
        for (int b = 0; b < 2; ++b)
#pragma unroll
            for (int m = 0; m < 4; ++m)
#pragma unroll
                for (int n = 0; n < 2; ++n) acc[a][b][m][n] = (f32x4){0.f, 0.f, 0.f, 0.f};
    bf16x8 At[4][2], B0[2][2], B1[2][2];
    unsigned ca[2][2], na[2][2];
    GM_AOFFS(cur, ca);
    const char* cA = cur.A; const char* cB0 = cur.B0; const char* cB1 = cur.B1;
    if constexpr (HOOKS) S.a_ready(cur);
    GM_STAGE(GM_SB(0, 0), cB0, voffB); GM_STAGE(GM_SB(0, 1), cB1, voffB); GM_STAGE(GM_SA(0, 0), cA, ca[0]); GM_STAGE(GM_SA(0, 1), cA, ca[1]);
    if (wr == 1) GM_BAR;
    GM_WAIT_V(2); GM_BAR;
    GM_STAGE(GM_SB(1, 0), cB0 + kstep, voffB); GM_STAGE(GM_SA(1, 0), cA + kstep, ca[0]); GM_STAGE(GM_SB(1, 1), cB1 + kstep, voffB);
    GM_WAIT_V(6); GM_BAR;
    for (;;) {
        const bool has_next = S.next(ui + 1, nxt);
        const char* nA = has_next ? nxt.A : cA; const char* nB0 = has_next ? nxt.B0 : cB0; const char* nB1 = has_next ? nxt.B1 : cB1;
        if (has_next) { GM_AOFFS(nxt, na); } else {
#pragma unroll
            for (int h = 0; h < 2; ++h)
#pragma unroll
                for (int i = 0; i < 2; ++i) na[h][i] = ca[h][i]; }
        for (int t = 0; t < nt; t += 2) {
            const bool last = (t == nt - 2);
            if constexpr (HOOKS) { if (last && has_next) S.a_ready(nxt); }
            const char* a1 = cA + (size_t)(t + 1) * kstep;
            const char* a2 = last ? nA : cA + (size_t)(t + 2) * kstep;
            const char* b20 = last ? nB0 : cB0 + (size_t)(t + 2) * kstep; const char* b21 = last ? nB1 : cB1 + (size_t)(t + 2) * kstep;
            const char* a3 = a2 + kstep; const char* b30 = b20 + kstep; const char* b31 = b21 + kstep;
            unsigned o2[2][2];
#pragma unroll
            for (int h = 0; h < 2; ++h)
#pragma unroll
                for (int i = 0; i < 2; ++i) o2[h][i] = last ? na[h][i] : ca[h][i];
            GM_LDB(B0, 0, 0); GM_LDB(B1, 0, 1); GM_SCHED; GM_LDA(At, 0, 0); GM_STAGE(GM_SA(1, 1), a1, ca[1]);
            GM_WAIT_V(8); GM_WAIT_L(0); GM_BAR; GM_MMA(0, 0, At, B0); GM_MMA(0, 1, At, B1); GM_BAR; GM_SCHED;
            GM_LDA(At, 0, 1); GM_STAGE(GM_SB(0, 0), b20, voffB); GM_STAGE(GM_SB(0, 1), b21, voffB); GM_STAGE(GM_SA(0, 0), a2, o2[0]);
            GM_WAIT_V(8); GM_WAIT_L(0); GM_BAR; GM_MMA(1, 0, At, B0); GM_MMA(1, 1, At, B1); GM_BAR; GM_SCHED;
            GM_LDB(B0, 1, 0); GM_LDB(B1, 1, 1); GM_SCHED; GM_LDA(At, 1, 0); GM_STAGE(GM_SA(0, 1), a2, o2[1]);
            GM_WAIT_V(8); GM_WAIT_L(0); GM_BAR; GM_MMA(0, 0, At, B0); GM_MMA(0, 1, At, B1); GM_BAR; GM_SCHED;
            GM_LDA(At, 1, 1); GM_STAGE(GM_SB(1, 0), b30, voffB); GM_STAGE(GM_SB(1, 1), b31, voffB); GM_STAGE(GM_SA(1, 0), a3, o2[0]);
            GM_WAIT_V(8); GM_WAIT_L(0); GM_BAR; GM_MMA(1, 0, At, B0); GM_MMA(1, 1, At, B1); GM_BAR; GM_SCHED;
        }
        if (wr == 0) GM_BAR;
        E(acc, cur, wr, wc, fr, fq);
        if constexpr (HOOKS) S.done(cur);
        if (!has_next) break;
#pragma unroll
        for (int a = 0; a < 2; ++a)
#pragma unroll
            for (int b = 0; b < 2; ++b)
#pragma unroll
                for (int m = 0; m < 4; ++m)
#pragma unroll
                    for (int n = 0; n < 2; ++n) acc[a][b][m][n] = (f32x4){0.f, 0.f, 0.f, 0.f};
        cur = nxt; cA = nA; cB0 = nB0; cB1 = nB1; ++ui;
#pragma unroll
        for (int h = 0; h < 2; ++h)
#pragma unroll
            for (int i = 0; i < 2; ++i) ca[h][i] = na[h][i];
        if (wr == 1) GM_BAR;
    }
    GM_WAIT_V(0);
    GM_BAR;
#undef GM_SA
#undef GM_SB
#undef GM_STAGE
#undef GM_LDA
#undef GM_LDB
#undef GM_MMA
#undef GM_WAIT_V
#undef GM_WAIT_L
#undef GM_BAR
#undef GM_SCHED
#undef GM_AOFFS
}
}
struct Args {
    const float* in[29]; float* out; unsigned char* ws; int ph_lo, ph_hi, li, pad;
};
struct Frame {
    LAS unsigned char* lds; volatile LAS unsigned* MISC;
    unsigned* ctl; unsigned char* ws; float* out;
    int tid, lane, wave, G, bid;
};
enum { IN_X = 0, IN_C, IN_CTX, IN_CCTX, IN_WMOD, IN_BMOD, IN_G1, IN_WIN, IN_CONVW, IN_CONVB, IN_WA, IN_BA, IN_WX, IN_BX, IN_LAM, IN_HGLB, IN_HGN,
       IN_WPA, IN_WPB, IN_WOUT, IN_G2, IN_WRG, IN_BRG, IN_WRE, IN_BRE, IN_W1, IN_W3, IN_W2, IN_FG };

constexpr int TR_BYTES = 64 * 64 * 4;
__device__ __forceinline__ void transpose_item(const float* W, int ldw, int K, bf16* WT, int k0, int n0, LAS float* scr, int lane) {
    const int lr = lane >> 4, ls = lane & 15;
    f32x4 v[16];
#pragma unroll
    for (int i = 0; i < 16; ++i) v[i] = *(const f32x4*)(W + (size_t)(k0 + 4 * i + lr) * ldw + n0 + 4 * ls);
#pragma unroll
    for (int i = 0; i < 16; ++i) { const int k = 4 * i + lr; *(LAS f32x4*)(scr + k * 64 + ((ls ^ ((k >> 3) & 7)) << 2)) = v[i]; }
    LDS_WAIT(); asm volatile("" ::: "memory");
    const int c = lane & 7;
#pragma unroll
    for (int j = 0; j < 8; ++j) { const int n = (lane >> 3) + 8 * j; const LAS float* s = scr + (8 * c) * 64 + ((((n >> 2) ^ c) << 2) | (n & 3));
        u32x4 o; o.x = pk2(s[0 * 64], s[1 * 64]); o.y = pk2(s[2 * 64], s[3 * 64]); o.z = pk2(s[4 * 64], s[5 * 64]); o.w = pk2(s[6 * 64], s[7 * 64]);
        *(u32x4*)(WT + (size_t)n * K + k0 + 8 * c) = o; }
    LDS_WAIT(); asm volatile("" ::: "memory");
}

__device__ __forceinline__ void p0_mod_item(Frame& F, const Args& a, int item) {
    const int cb = item % 24, ks = item / 24;
    LAS float* sv = (LAS float*)F.lds;
    LAS float* red = sv + 9 * 128;
    const float* c = a.in[IN_C]; const float* cc = a.in[IN_CCTX]; const float* wmod = a.in[IN_WMOD];
    for (int i = F.tid; i < 9 * 128; i += NTHR) { const int r = i >> 7, k = i & 127; const float v = r < 8 ? c[r * DM + ks * 128 + k] : cc[ks * 128 + k]; sv[i] = siluf_(v); }
    __syncthreads();
    const int col = cb * 256 + (F.tid & 255), kh = F.tid >> 8;
    float acc[9];
#pragma unroll
    for (int r = 0; r < 9; ++r) acc[r] = 0.f;
    for (int k0 = 0; k0 < 64; k0 += 16) { float wv[16];
#pragma unroll
        for (int k = 0; k < 16; ++k) wv[k] = wmod[(size_t)(ks * 128 + kh * 64 + k0 + k) * 6144 + col];
#pragma unroll
        for (int k = 0; k < 16; ++k) { const int kk = kh * 64 + k0 + k;
#pragma unroll
            for (int r = 0; r < 9; ++r) acc[r] += sv[r * 128 + kk] * wv[k]; } }
    if (kh == 1) {
#pragma unroll
        for (int r = 0; r < 9; ++r) red[r * 256 + (F.tid & 255)] = acc[r]; }
    __syncthreads();
    float* modp = (float*)(F.ws + WS_MODP);
    if (kh == 0) {
#pragma unroll
        for (int r = 0; r < 9; ++r) modp[(size_t)(ks * 9 + r) * 6144 + col] = acc[r] + red[r * 256 + F.tid]; }
    __syncthreads();
}
__device__ __forceinline__ float mod_from_partials(const float* modp, const float* bmod, int row, int j) {
    float s = bmod[j];
#pragma unroll
    for (int ks = 0; ks < 8; ++ks) s += modp[(size_t)(ks * 9 + row) * 6144 + j];
    return s;
}

__device__ __forceinline__ void p0_prologue(Frame& F, const Args& a) {
    if (F.bid < 192) p0_mod_item(F, a, F.bid);
    LAS float* scr = (LAS float*)(F.lds + F.wave * TR_BYTES);
    const int gw = F.bid * NWAVES + F.wave, NGW = F.G * NWAVES;
    constexpr int I_IN = 16 * 144, I_PR = 16 * 16, I_LRU = 32 * 4;
    constexpr int NITEMS = I_IN + 3 * I_PR + I_LRU;
    for (int it = gw; it < NITEMS; it += NGW) {
        int r = it;
        if (r < I_IN) { const int kb = r / 144, nb = r % 144; transpose_item(a.in[IN_WIN], INW, DM, (bf16*)(F.ws + WS_WIN) + (size_t)(nb * 64) * DM, kb * 64, nb * 64, scr, F.lane); continue; } r -= I_IN;
        if (r < 3 * I_PR) { const int w = r / I_PR, q = r % I_PR, kb = q / 16, nb = q % 16;
            const float* W = a.in[w == 0 ? IN_WPA : (w == 1 ? IN_WPB : IN_WOUT)]; bf16* WT = (bf16*)(F.ws + (w == 0 ? WS_WPA : (w == 1 ? WS_WPB : WS_WOUT)));
            transpose_item(W, DM, DM, WT + (size_t)(nb * 64) * DM, kb * 64, nb * 64, scr, F.lane); continue; } r -= 3 * I_PR;
        { const int mat = r / 4, q = r % 4, kb = q / 2, nb = q % 2;
          const int which = mat >> 4, dh = mat & 15;
          const float* W = a.in[which == 0 ? IN_WA : IN_WX] + (size_t)dh * 128 * 128; bf16* WT = (bf16*)(F.ws + WS_WLRU) + (size_t)mat * 128 * 128;
          transpose_item(W, 128, 128, WT + (size_t)(nb * 64) * 128, kb * 64, nb * 64, scr, F.lane); }
    }
    float* wrp = (float*)(F.ws + WS_WRT);
    for (int i = F.bid * NTHR + F.tid; i < 49152 + 48; i += F.G * NTHR) {
        if (i < 49152) { const int j = i & 3, ln = (i >> 2) & 63, sc = i >> 8, c = sc % 3, s2 = sc / 3; const int k = 16 * s2 + 4 * (ln >> 4) + j, o = 16 * c + (ln & 15);
            wrp[i] = o < 4 ? a.in[IN_WRG][k * 4 + o] : (o < 36 ? a.in[IN_WRE][k * 32 + (o - 4)] : 0.f); }
        else { const int o = i - 49152; wrp[i] = o < 4 ? a.in[IN_BRG][o] : (o < 36 ? a.in[IN_BRE][o - 4] : 0.f); }
    }
}

__device__ __forceinline__ void norm_rows(Frame& F, const float* src, bf16* dst, int row0, int nrows, const LAS float* gs, const LAS float* sh) {
    for (int r = F.wave; r < nrows; r += 2 * NWAVES) {
        const int r1 = r + NWAVES < nrows ? r + NWAVES : r;
        const f32x4* xa = (const f32x4*)(src + (size_t)(row0 + r) * DM) + F.lane; const f32x4* xb = (const f32x4*)(src + (size_t)(row0 + r1) * DM) + F.lane;
        f32x4 va[4], vb[4]; float sa = 0.f, sb = 0.f;
#pragma unroll
        for (int j = 0; j < 4; ++j) { va[j] = xa[64 * j]; vb[j] = xb[64 * j]; }
#pragma unroll
        for (int j = 0; j < 4; ++j) { sa += (va[j].x * va[j].x + va[j].y * va[j].y) + (va[j].z * va[j].z + va[j].w * va[j].w); sb += (vb[j].x * vb[j].x + vb[j].y * vb[j].y) + (vb[j].z * vb[j].z + vb[j].w * vb[j].w); }
        const float ra = rsqrtf(wave_sum(sa) * (1.f / DM) + EPS), rb = rsqrtf(wave_sum(sb) * (1.f / DM) + EPS);
        unsigned long long* oa = (unsigned long long*)(dst + (size_t)(row0 + r) * DM) + F.lane; unsigned long long* ob = (unsigned long long*)(dst + (size_t)(row0 + r1) * DM) + F.lane;
#pragma unroll
        for (int j = 0; j < 4; ++j) { const int k = 4 * F.lane + 256 * j;
            const f32x4 g = *(const LAS f32x4*)(gs + k), h = *(const LAS f32x4*)(sh + k);
            oa[64 * j] = (unsigned long long)pk2(va[j].x * ra * g.x + h.x, va[j].y * ra * g.y + h.y) | ((unsigned long long)pk2(va[j].z * ra * g.z + h.z, va[j].w * ra * g.w + h.w) << 32);
            ob[64 * j] = (unsigned long long)pk2(vb[j].x * rb * g.x + h.x, vb[j].y * rb * g.y + h.y) | ((unsigned long long)pk2(vb[j].z * rb * g.z + h.z, vb[j].w * rb * g.w + h.w) << 32); }
    }
}
__device__ __forceinline__ void p1_norm(Frame& F, const Args& a) {
    const float* modp = (const float*)(F.ws + WS_MODP); const float* bmod = a.in[IN_BMOD]; const float* g1 = a.in[IN_G1];
    LAS float* gs = (LAS float*)F.lds; LAS float* sh = gs + DM;
    bf16* H = (bf16*)F.out;
    float* mod = (float*)(F.ws + WS_MOD);
    for (int i = F.bid * NTHR + F.tid; i < 9 * 6144; i += F.G * NTHR) mod[i] = mod_from_partials(modp, bmod, i / 6144, i % 6144);
    const int b = F.bid / 32;
    for (int k = F.tid; k < DM; k += NTHR) { gs[k] = g1[k] * (1.f + mod_from_partials(modp, bmod, b, DM + k)); sh[k] = mod_from_partials(modp, bmod, b, k); }
    __syncthreads();
    norm_rows(F, a.in[IN_X], H, F.bid * 64, 64, gs, sh);
    __syncthreads();
    for (int k = F.tid; k < DM; k += NTHR) { gs[k] = g1[k] * (1.f + mod_from_partials(modp, bmod, 8, DM + k)); sh[k] = mod_from_partials(modp, bmod, 8, k); }
    __syncthreads();
    norm_rows(F, a.in[IN_CTX], H + (size_t)NTOK * DM, F.bid * 8, 8, gs, sh);
    __syncthreads();
}

struct EpiStoreBf16 {
    static constexpr bool PERM = true;
    __device__ __forceinline__ void operator()(const f32x4 (&acc)[2][2][4][2], const gm::Unit& u, int wr, int wc, int fr, int fq) const {
        bf16* base = (bf16*)u.dst + (size_t)(wr * 64 + fr) * DM + wc * 32 + 8 * fq;
#pragma unroll
        for (int ai = 0; ai < 2; ++ai)
#pragma unroll
            for (int m = 0; m < 4; ++m) { bf16* rowp = base + (size_t)(ai * 128 + m * 16) * DM;
#pragma unroll
                for (int bj = 0; bj < 2; ++bj) { const f32x4 v0 = acc[ai][bj][m][0], v1 = acc[ai][bj][m][1];
                    u32x4 w; w.x = gm::cvt_pk_bf16(v0[0], v0[1]); w.y = gm::cvt_pk_bf16(v0[2], v0[3]); w.z = gm::cvt_pk_bf16(v1[0], v1[1]); w.w = gm::cvt_pk_bf16(v1[2], v1[3]);
                    *(u32x4*)(rowp + bj * 128) = w; } }
    }
};
__device__ __forceinline__ void tile_order(int L, int nM, int nN, int& pm, int& pn) {
    const int nwg = nM * nN; int wgid = L;
    { const int q = nwg / 8, r = nwg % 8, xcd = wgid % 8, off = wgid / 8; wgid = (xcd < r ? xcd * (q + 1) : r * (q + 1) + (xcd - r) * q) + off; }
    const int nig = 8 * nN, gid = wgid / nig, fm = gid * 8, gsz = (nM - fm) < 8 ? (nM - fm) : 8;
    pm = fm + ((wgid % nig) % gsz); pn = (wgid % nig) / gsz;
}
struct SchedP2 {
    int G, c; const char* H; const char* Wt; char* P; char* PC;
    __device__ __forceinline__ bool next(int i, gm::Unit& u) const {
        int L = i * G + c;
        if (L < 64 * 36) { int pm, pn; tile_order(L, 64, 36, pm, pn);
            u.A = H + (size_t)pm * 256 * 2048; u.B0 = Wt + (size_t)pn * 256 * 2048; u.B1 = u.B0 + (size_t)128 * 2048;
            u.dst = P + (size_t)(pn >> 2) * GS + ((size_t)pm * 256 * DM + (pn & 3) * 256) * 2; u.pm = pm; u.pn = pn; u.e = 0; u.rows = 256; return true; }
        L -= 64 * 36; if (L >= 128) return false;
        const int pmc = L >> 4, j = L & 15, slot = j >> 2, g = slot == 0 ? 0 : slot + 2, pn = g * 4 + (j & 3);
        u.A = H + (size_t)(NTOK + pmc * 256) * 2048; u.B0 = Wt + (size_t)pn * 256 * 2048; u.B1 = u.B0 + (size_t)128 * 2048;
        u.dst = PC + (size_t)slot * CGS + ((size_t)pmc * 256 * DM + (j & 3) * 256) * 2; u.pm = pmc; u.pn = pn; u.e = 0; u.rows = 256; return true;
    }
    __device__ __forceinline__ unsigned arow(const gm::Unit&, int r) const { return (unsigned)r; }
};
constexpr int LRU_T = 128, LRU_NCH = SEQ / LRU_T, UF_LD = 144;
constexpr int LRU_UBF = 0, LRU_UF = 144 * 256;
constexpr float LOG2E = 1.4426950408889634f;

struct LruCoef { float ba, bx, ca; };

__device__ __forceinline__ void lru_conv(Frame& F, const Args& a, int b, int h, int c, bool special) {
    const bf16* AX = (const bf16*)(F.ws + WS_P) + (size_t)b * SEQ * DM + h * 128;
    const float* cw = a.in[IN_CONVW] + h * 128; const float* cb = a.in[IN_CONVB] + h * 128;
    LAS unsigned char* ubf = F.lds + LRU_UBF; LAS float* uf = (LAS float*)(F.lds + LRU_UF);
    const int cg = F.tid & 15, tl0 = F.tid >> 4;
    u32x4 raw[4][4];
#pragma unroll
    for (int i = 0; i < 4; ++i)
#pragma unroll
        for (int k = 0; k < 4; ++k) { int tt = c * LRU_T + tl0 + 32 * i + k - 2; tt = tt < 0 ? 0 : (tt > SEQ - 1 ? SEQ - 1 : tt); raw[i][k] = *(const u32x4*)(AX + (size_t)tt * DM + 8 * cg); }
    float w[4][8], bs[8];
#pragma unroll
    for (int k = 0; k < 4; ++k) { const f32x4 w0 = *(const f32x4*)(cw + k * DM + 8 * cg), w1 = *(const f32x4*)(cw + k * DM + 8 * cg + 4);
        w[k][0] = w0.x; w[k][1] = w0.y; w[k][2] = w0.z; w[k][3] = w0.w; w[k][4] = w1.x; w[k][5] = w1.y; w[k][6] = w1.z; w[k][7] = w1.w; }
    { const f32x4 b0 = *(const f32x4*)(cb + 8 * cg), b1 = *(const f32x4*)(cb + 8 * cg + 4); bs[0] = b0.x; bs[1] = b0.y; bs[2] = b0.z; bs[3] = b0.w; bs[4] = b1.x; bs[5] = b1.y; bs[6] = b1.z; bs[7] = b1.w; }
#pragma unroll
    for (int i = 0; i < 4; ++i) { const int tl = tl0 + 32 * i;
        float u[8];
#pragma unroll
        for (int q = 0; q < 8; ++q) u[q] = bs[q];
#pragma unroll
        for (int k = 0; k < 4; ++k) { const int tt = c * LRU_T + tl + k - 2; const float mk = (tt >= 0 && tt < SEQ) ? 1.f : 0.f; const u32x4 v = raw[i][k];
            u[0] += mk * w[k][0] * bflo(v.x); u[1] += mk * w[k][1] * bfhi(v.x); u[2] += mk * w[k][2] * bflo(v.y); u[3] += mk * w[k][3] * bfhi(v.y);
            u[4] += mk * w[k][4] * bflo(v.z); u[5] += mk * w[k][5] * bfhi(v.z); u[6] += mk * w[k][6] * bflo(v.w); u[7] += mk * w[k][7] * bfhi(v.w); }
        *(LAS f32x4*)(uf + tl * UF_LD + 8 * cg) = (f32x4){u[0], u[1], u[2], u[3]};
        *(LAS f32x4*)(uf + tl * UF_LD + 8 * cg + 4) = (f32x4){u[4], u[5], u[6], u[7]};
        u32x4 p; p.x = pk2(u[0], u[1]); p.y = pk2(u[2], u[3]); p.z = pk2(u[4], u[5]); p.w = pk2(u[6], u[7]);
        *(LAS u32x4*)(ubf + tl * 256 + ((cg ^ (tl & 15)) << 4)) = p; }
    if (special) {
        const bf16* AC = (const bf16*)(F.ws + WS_PC) + (size_t)b * CTX * DM + h * 128;
        if (F.tid < 32) { const int tl = LRU_T + (F.tid >> 4); const int t = tl == LRU_T ? 0 : CTX - 1;
            float u[8];
#pragma unroll
            for (int q = 0; q < 8; ++q) u[q] = bs[q];
#pragma unroll
            for (int k = 0; k < 4; ++k) { const int tt = t + k - 2;
                if (tt >= 0 && tt < CTX) { const u32x4 v = *(const u32x4*)(AC + (size_t)tt * DM + 8 * cg);
                    u[0] += w[k][0] * bflo(v.x); u[1] += w[k][1] * bfhi(v.x); u[2] += w[k][2] * bflo(v.y); u[3] += w[k][3] * bfhi(v.y);
                    u[4] += w[k][4] * bflo(v.z); u[5] += w[k][5] * bfhi(v.z); u[6] += w[k][6] * bflo(v.w); u[7] += w[k][7] * bfhi(v.w); } }
            *(LAS f32x4*)(uf + tl * UF_LD + 8 * cg) = (f32x4){u[0], u[1], u[2], u[3]};
            *(LAS f32x4*)(uf + tl * UF_LD + 8 * cg + 4) = (f32x4){u[4], u[5], u[6], u[7]};
            u32x4 p; p.x = pk2(u[0], u[1]); p.y = pk2(u[2], u[3]); p.z = pk2(u[4], u[5]); p.w = pk2(u[6], u[7]);
            *(LAS u32x4*)(ubf + tl * 256 + ((cg ^ (tl & 15)) << 4)) = p;
        } else if (F.tid < 32 + 14 * 16) { const int tl = LRU_T + 2 + ((F.tid - 32) >> 4);
            *(LAS u32x4*)(ubf + tl * 256 + ((cg ^ (tl & 15)) << 4)) = (u32x4){0u, 0u, 0u, 0u}; }
    }
}
__device__ __forceinline__ void lru_load_w(Frame& F, int d, int h, bf16x8 (&Bw)[2][4]) {
    const int fr = F.lane & 15, fq = F.lane >> 4;
#pragma unroll
    for (int which = 0; which < 2; ++which) { const bf16* W = (const bf16*)(F.ws + WS_WLRU) + (size_t)(which * 16 + d * 8 + h) * 128 * 128 + (size_t)(16 * F.wave + fr) * 128 + 8 * fq;
#pragma unroll
        for (int kk = 0; kk < 4; ++kk) Bw[which][kk] = *(const bf16x8*)(W + kk * 32); }
}
__device__ __forceinline__ LruCoef lru_coef(const Args& a, int d, int ch) {
    LruCoef k; k.ba = -LOG2E * a.in[IN_BA][d * DM + ch]; k.bx = -LOG2E * a.in[IN_BX][d * DM + ch];
    const float sp = log1pf(expf(-a.in[IN_LAM][d * DM + ch])); k.ca = -8.f * sp * LOG2E; return k;
}
template <int V = 0> __device__ __forceinline__ void lru_tile(Frame& F, int m, const bf16x8 (&Bw)[2][4], const LruCoef& k, float (&av)[4], float (&bv)[4]) {
    const int fr = F.lane & 15, fq = F.lane >> 4;
    const LAS unsigned char* ubf = F.lds + LRU_UBF; const LAS float* uf = (const LAS float*)(F.lds + LRU_UF);
    f32x4 ar = {0.f, 0.f, 0.f, 0.f}, ai = {0.f, 0.f, 0.f, 0.f};
    const int row = m * 16 + fr;
#pragma unroll
    for (int kk = 0; kk < 4; ++kk) { const bf16x8 A = *(const LAS bf16x8*)(ubf + row * 256 + (((kk * 4 + fq) ^ fr) << 4));
        ar = __builtin_amdgcn_mfma_f32_16x16x32_bf16(A, Bw[0][kk], ar, 0, 0, 0); ai = __builtin_amdgcn_mfma_f32_16x16x32_bf16(A, Bw[1][kk], ai, 0, 0, 0); }
#pragma unroll
    for (int r = 0; r < 4; ++r) { const float u = uf[(m * 16 + 4 * fq + r) * UF_LD + 16 * F.wave + fr];
        if (V == 2) { av[r] = __builtin_fmaf(ar[r], -LOG2E, k.ba) * k.ca; bv[r] = __builtin_fmaf(ai[r], -LOG2E, k.bx) * u; continue; }
        const float rg = __builtin_amdgcn_rcpf(1.f + __builtin_amdgcn_exp2f(__builtin_fmaf(ar[r], -LOG2E, k.ba)));
        const float ig = __builtin_amdgcn_rcpf(1.f + __builtin_amdgcn_exp2f(__builtin_fmaf(ai[r], -LOG2E, k.bx)));
        const float aa = __builtin_amdgcn_exp2f(k.ca * rg);
        av[r] = aa; bv[r] = __builtin_amdgcn_sqrtf(__builtin_fmaf(-aa, aa, 1.f)) * (ig * u); }
}
template <bool FWD, int V = 0> __device__ __forceinline__ void lru_tile_total(int fq, float& A, float& B) {
    if (V == 1) return;
#pragma unroll
    for (int s = 0; s < 2; ++s) { const int bit = 1 << s; const float Ap = __shfl_xor(A, 16 << s), Bp = __shfl_xor(B, 16 << s);
        const bool mine_first = FWD ? ((fq & bit) == 0) : ((fq & bit) != 0);
        if (mine_first) { B = B * Ap + Bp; A = A * Ap; } else { B = Bp * A + B; A = Ap * A; } }
}

template <int V = 0> __device__ __forceinline__ void lru_pass1(Frame& F, const Args& a, int unit, float* agg_base) {
    const int c = unit & (LRU_NCH - 1), h = (unit >> 4) & 7, b = unit >> 7;
    const int fr = F.lane & 15, fq = F.lane >> 4; const int ch = h * 128 + 16 * F.wave + fr;
    bf16x8 Bw0[2][4], Bw1[2][4]; lru_load_w(F, 0, h, Bw0); lru_load_w(F, 1, h, Bw1);
    const LruCoef k0 = lru_coef(a, 0, ch), k1 = lru_coef(a, 1, ch);
    lru_conv(F, a, b, h, c, c == 0);
    LDS_WAIT(); __syncthreads();
    float Af = 1.f, Hf = 0.f, Ab = 1.f, Hb = 0.f;
#pragma unroll 2
    for (int m = 0; m < 8; ++m) {
        float av[4], bv[4];
        lru_tile<V>(F, m, Bw0, k0, av, bv);
        float A = av[0] * av[1] * av[2] * av[3], B = ((bv[0] * av[1] + bv[1]) * av[2] + bv[2]) * av[3] + bv[3];
        lru_tile_total<true, V>(fq, A, B);
        Hf = Hf * A + B; Af = Af * A;
        lru_tile<V>(F, m, Bw1, k1, av, bv);
        A = av[0] * av[1] * av[2] * av[3]; B = ((bv[3] * av[2] + bv[2]) * av[1] + bv[1]) * av[0] + bv[0];
        lru_tile_total<false, V>(fq, A, B);
        Hb = B * Ab + Hb; Ab = A * Ab;
    }
    float* agg = agg_base;
    if (fq == 0) { *(f32x2*)(agg + ((size_t)((b * LRU_NCH + c) * 2 + 0) * DM + ch) * 2) = (f32x2){Af, Hf};
                   *(f32x2*)(agg + ((size_t)((b * LRU_NCH + c) * 2 + 1) * DM + ch) * 2) = (f32x2){Ab, Hb}; }
    if (c == 0 && V == 0) {
        float av[4], bv[4]; float* s0 = (float*)(F.ws + WS_LRUS0);
        lru_tile(F, 8, Bw0, k0, av, bv); if (fq == 0) s0[(b * 2 + 0) * DM + ch] = bv[0];
        lru_tile(F, 8, Bw1, k1, av, bv); if (fq == 0) s0[(b * 2 + 1) * DM + ch] = bv[1];
    }
    __syncthreads();
}

__device__ __forceinline__ void lru_pass2(Frame& F, const Args& a, int unit) {
    const int c = unit & (LRU_NCH - 1), h = (unit >> 4) & 7, b = unit >> 7;
    const int fr = F.lane & 15, fq = F.lane >> 4; const int ch = h * 128 + 16 * F.wave + fr;
    const float* agg = (const float*)(F.ws + WS_LRUAGG); const float* s0 = (const float*)(F.ws + WS_LRUS0);
    f32x2 ag[LRU_NCH];
#pragma unroll
    for (int j = 0; j < LRU_NCH; ++j) ag[j] = *(const f32x2*)(agg + ((size_t)((b * LRU_NCH + j) * 2 + (j < c ? 0 : 1)) * DM + ch) * 2);
    float hf = s0[(b * 2 + 0) * DM + ch], hb = s0[(b * 2 + 1) * DM + ch];
    bf16* AY = (bf16*)(F.ws + WS_YAG) + ((size_t)b * SEQ + c * LRU_T) * DM + h * 128;
    u32x4 ayv[4];
#pragma unroll
    for (int i = 0; i < 4; ++i) ayv[i] = *(const u32x4*)(AY + (size_t)((F.tid >> 4) + 32 * i) * DM + 8 * (F.tid & 15));
    bf16x8 Bw[2][4], Bw1[2][4]; lru_load_w(F, 0, h, Bw);
    LruCoef k = lru_coef(a, 0, ch); const LruCoef k1 = lru_coef(a, 1, ch);
    lru_conv(F, a, b, h, c, false);
    lru_load_w(F, 1, h, Bw1);
#pragma unroll
    for (int j = 0; j < LRU_NCH; ++j) if (j < c) hf = ag[j].x * hf + ag[j].y;
#pragma unroll
    for (int j = LRU_NCH - 1; j >= 0; --j) if (j > c) hb = ag[j].x * hb + ag[j].y;
    LDS_WAIT(); __syncthreads();
    float hfv[8][4];
#pragma unroll
    for (int m = 0; m < 8; ++m) {
        float av[4], bv[4];
        lru_tile(F, m, Bw, k, av, bv);
        const float A = av[0] * av[1] * av[2] * av[3], B = ((bv[0] * av[1] + bv[1]) * av[2] + bv[2]) * av[3] + bv[3];
        float hin = hf;
#pragma unroll
        for (int g = 0; g < 4; ++g) { const float Ag = __shfl(A, g * 16 + fr), Bg = __shfl(B, g * 16 + fr); if (g < fq) hin = Ag * hin + Bg; hf = Ag * hf + Bg; }
#pragma unroll
        for (int r = 0; r < 4; ++r) { hin = av[r] * hin + bv[r]; hfv[m][r] = hin; }
    }
    k = k1;
    LAS float* uf = (LAS float*)(F.lds + LRU_UF);
#pragma unroll
    for (int m = 7; m >= 0; --m) {
        float av[4], bv[4];
        lru_tile(F, m, Bw1, k, av, bv);
        const float A = av[0] * av[1] * av[2] * av[3], B = ((bv[3] * av[2] + bv[2]) * av[1] + bv[1]) * av[0] + bv[0];
        float hin = hb;
#pragma unroll
        for (int g = 3; g >= 0; --g) { const float Ag = __shfl(A, g * 16 + fr), Bg = __shfl(B, g * 16 + fr); if (g > fq) hin = Ag * hin + Bg; hb = Ag * hb + Bg; }
#pragma unroll
        for (int r = 3; r >= 0; --r) { hin = av[r] * hin + bv[r]; uf[(m * 16 + 4 * fq + r) * UF_LD + 16 * F.wave + fr] = hfv[m][r] + hin; }
    }
    LDS_WAIT(); __syncthreads();
    const int cg = F.tid & 15;
#pragma unroll
    for (int i = 0; i < 4; ++i) { const int tl = (F.tid >> 4) + 32 * i;
        const f32x4 y0 = *(const LAS f32x4*)(uf + tl * UF_LD + 8 * cg), y1 = *(const LAS f32x4*)(uf + tl * UF_LD + 8 * cg + 4);
        const u32x4 g = ayv[i];
        u32x4 o; o.x = pk2(y0.x * gelu_tanh(bflo(g.x)), y0.y * gelu_tanh(bfhi(g.x))); o.y = pk2(y0.z * gelu_tanh(bflo(g.y)), y0.w * gelu_tanh(bfhi(g.y)));
        o.z = pk2(y1.x * gelu_tanh(bflo(g.z)), y1.y * gelu_tanh(bfhi(g.z))); o.w = pk2(y1.z * gelu_tanh(bflo(g.w)), y1.w * gelu_tanh(bfhi(g.w)));
        *(u32x4*)(AY + (size_t)tl * DM + 8 * cg) = o; }
    __syncthreads();
}
constexpr int HG_C = 64, HG_SEG = 512, HG_NSEG = 4;
constexpr int HG_QS = 0, HG_QM = 16384, HG_KM = 32768, HG_KDT = 49152, HG_VT = 65536, HG_ATT = 81920, HG_PART = 90112, HG_ETOT = 94208, HG_ROWS = 94720;
constexpr size_t HGS_IMG = 65536;
#ifdef PROBE_A
#define HSTAMP(i) do { if (F.bid == 0 && F.tid == 0) { const unsigned long long _t = __builtin_amdgcn_s_memrealtime(); const unsigned long long _p = ((unsigned long long)F.MISC[101] << 32) | F.MISC[100]; \
    unsigned long long _a = ((unsigned long long)F.MISC[103 + 2 * (i)] << 32) | F.MISC[102 + 2 * (i)]; _a += _t - _p; F.MISC[102 + 2 * (i)] = (unsigned)_a; F.MISC[103 + 2 * (i)] = (unsigned)(_a >> 32); F.MISC[100] = (unsigned)_t; F.MISC[101] = (unsigned)(_t >> 32); } } while (0)
#else
#define HSTAMP(i) do { } while (0)
#endif

__device__ __forceinline__ int hg_row(int b, int dir, bool ctx, int sigma) {
    if (ctx) { const int t = dir ? (CTX - 1 - sigma) : sigma; return b * CTX + t; }
    const int p = dir ? (SEQ - 1 - sigma) : sigma; return b * SEQ + (p & 31) * 64 + (p >> 5);
}

struct HgRaw { unsigned f[8], v[8], q[8]; };
template <bool FULL>
__device__ __forceinline__ void hg_load(Frame& F, const bf16* Qb, const bf16* Fb, const bf16* Vb, int b, int dir, bool ctx, int sigma0, HgRaw& r) {
#pragma unroll
    for (int j = 0; j < 8; ++j) { const size_t ro = (size_t)hg_row(b, dir, ctx, sigma0 + 8 * F.wave + j) * DM + 2 * F.lane;
        r.f[j] = *(const unsigned*)(Fb + ro); r.v[j] = *(const unsigned*)(Vb + ro); if (FULL) r.q[j] = *(const unsigned*)(Qb + ro); }
}
template <bool FULL>
__device__ __forceinline__ void hg_prep(Frame& F, const HgRaw& raw, int b, int dir, bool ctx, int sigma0, float lb0, float lb1, float& gs0, float& gs1) {
    const int kp = F.lane, to = F.wave;
    const unsigned (&fw)[8] = raw.f; const unsigned (&qw)[8] = raw.q; const unsigned (&vw)[8] = raw.v;
    float c0[8], c1[8], k0[8], k1[8];
    float a0 = 0.f, a1 = 0.f;
#pragma unroll
    for (int j = 0; j < 8; ++j) {
        const float g0 = lb0 + (1.f - lb0) * __builtin_amdgcn_rcpf(1.f + __builtin_amdgcn_exp2f(-bflo(fw[j]) * LOG2E));
        const float g1 = lb1 + (1.f - lb1) * __builtin_amdgcn_rcpf(1.f + __builtin_amdgcn_exp2f(-bfhi(fw[j]) * LOG2E));
        k0[j] = 1.f - g0; k1[j] = 1.f - g1;
        a0 += __builtin_amdgcn_logf(g0); a1 += __builtin_amdgcn_logf(g1);
        c0[j] = a0; c1[j] = a1; }
    LAS float* part = (LAS float*)(F.lds + HG_PART);
    *(LAS f32x2*)(part + to * 128 + 2 * kp) = (f32x2){a0, a1};
    if (FULL) HSTAMP(0);
    LDS_WAIT(); __syncthreads();
    if (FULL) HSTAMP(1);
    if (FULL && F.tid < HG_C) ((LAS int*)(F.lds + HG_ROWS))[F.tid] = hg_row(b, dir, ctx, sigma0 + F.tid);
    float off0 = 0.f, off1 = 0.f, tot0 = 0.f, tot1 = 0.f;
#pragma unroll
    for (int o = 0; o < 8; ++o) { const f32x2 p = *(const LAS f32x2*)(part + o * 128 + 2 * kp);
        if (o < to) { off0 += p.x; off1 += p.y; } tot0 += p.x; tot1 += p.y; }
    gs0 += tot0; gs1 += tot1;
    if (to == 0) *(LAS f32x2*)((LAS float*)(F.lds + HG_ETOT) + 2 * kp) = (f32x2){__builtin_amdgcn_exp2f(tot0), __builtin_amdgcn_exp2f(tot1)};
    float kd0[8], kd1[8];
#pragma unroll
    for (int j = 0; j < 8; ++j) {
        const float E0 = __builtin_amdgcn_exp2f(off0 + c0[j]), E1 = __builtin_amdgcn_exp2f(off1 + c1[j]);
        kd0[j] = k0[j] * __builtin_amdgcn_rcpf(E0); kd1[j] = k1[j] * __builtin_amdgcn_rcpf(E1);
        if (FULL) {
            const float q0 = bflo(qw[j]), q1 = bfhi(qw[j]);
            const float s0 = q0 * __builtin_amdgcn_rcpf(1.f + __builtin_amdgcn_exp2f(-q0 * LOG2E)) * E0, s1 = q1 * __builtin_amdgcn_rcpf(1.f + __builtin_amdgcn_exp2f(-q1 * LOG2E)) * E1;
            const int c = 8 * to + j; const int off = c * 256 + ((4 * kp) ^ ((c & 15) << 4));
            *(LAS unsigned*)(F.lds + HG_QS + off) = pk2(s0, s1);
            *(LAS unsigned*)(F.lds + HG_KM + off) = pk2(kd0[j], kd1[j]);
        }
    }
    { const int sw = ((to ^ (kp & 7)) << 4);
      u32x4 w0, w1; w0.x = pk2(kd0[0], kd0[1]); w0.y = pk2(kd0[2], kd0[3]); w0.z = pk2(kd0[4], kd0[5]); w0.w = pk2(kd0[6], kd0[7]);
      w1.x = pk2(kd1[0], kd1[1]); w1.y = pk2(kd1[2], kd1[3]); w1.z = pk2(kd1[4], kd1[5]); w1.w = pk2(kd1[6], kd1[7]);
      *(LAS u32x4*)(F.lds + HG_KDT + (2 * kp) * 128 + sw) = w0; *(LAS u32x4*)(F.lds + HG_KDT + (2 * kp + 1) * 128 + sw) = w1;
      u32x4 v0, v1;
      v0.x = (vw[0] & 0xffffu) | (vw[1] << 16); v0.y = (vw[2] & 0xffffu) | (vw[3] << 16); v0.z = (vw[4] & 0xffffu) | (vw[5] << 16); v0.w = (vw[6] & 0xffffu) | (vw[7] << 16);
      v1.x = (vw[0] >> 16) | (vw[1] & 0xffff0000u); v1.y = (vw[2] >> 16) | (vw[3] & 0xffff0000u); v1.z = (vw[4] >> 16) | (vw[5] & 0xffff0000u); v1.w = (vw[6] >> 16) | (vw[7] & 0xffff0000u);
      *(LAS u32x4*)(F.lds + HG_VT + (2 * kp) * 128 + sw) = v0; *(LAS u32x4*)(F.lds + HG_VT + (2 * kp + 1) * 128 + sw) = v1; }
    if (FULL) HSTAMP(2);
    LDS_WAIT(); __syncthreads();
    if (FULL) HSTAMP(3);
}
__device__ __forceinline__ void hg_state_update(Frame& F, f32x4 (&St)[8], const bf16x8 (&vt)[2]) {
    const int fr = F.lane & 15, fq = F.lane >> 4;
    const LAS float* etot = (const LAS float*)(F.lds + HG_ETOT);
#pragma unroll
    for (int kt = 0; kt < 8; ++kt) { const f32x4 e = *(const LAS f32x4*)(etot + 16 * kt + 4 * fq);
        const int rk = 16 * kt + fr;
#pragma unroll
        for (int ks = 0; ks < 2; ++ks) { const bf16x8 A = *(const LAS bf16x8*)(F.lds + HG_KDT + rk * 128 + (((4 * ks + fq) ^ ((rk >> 1) & 7)) << 4));
            St[kt] = __builtin_amdgcn_mfma_f32_16x16x32_bf16(A, vt[ks], St[kt], 0, 0, 0); }
        St[kt] = St[kt] * e; }
}
__device__ __forceinline__ void hg_load_vt(Frame& F, bf16x8 (&vt)[2]) {
    const int fr = F.lane & 15, fq = F.lane >> 4; const int rv = 16 * F.wave + fr;
#pragma unroll
    for (int ks = 0; ks < 2; ++ks) vt[ks] = *(const LAS bf16x8*)(F.lds + HG_VT + rv * 128 + (((4 * ks + fq) ^ ((rv >> 1) & 7)) << 4));
}
struct HgPtrs { const bf16* Q; const bf16* Fx; const bf16* V; const bf16* Fc; const bf16* Vc; bf16* O; };
__device__ __forceinline__ HgPtrs hg_ptrs(Frame& F, int h, int dir) {
    HgPtrs p; p.Q = (const bf16*)(F.ws + WS_P + 2 * GS) + h * 128; p.Fx = (const bf16*)(F.ws + WS_P + (dir ? 4 : 3) * GS) + h * 128; p.V = (const bf16*)(F.ws + WS_P + 5 * GS) + h * 128;
    p.Fc = (const bf16*)(F.ws + WS_PC + (dir ? 2 : 1) * CGS) + h * 128; p.Vc = (const bf16*)(F.ws + WS_PC + 3 * CGS) + h * 128; p.O = (bf16*)(F.ws + WS_P + (dir ? 4 : 3) * GS) + h * 128; return p;
}
__device__ __forceinline__ void hg_lb(const Args& a, int h, int kp, float& lb0, float& lb1) {
    const float* t = a.in[IN_HGLB] + h * 128 + 2 * kp; lb0 = 1.f / (1.f + expf(t[DM] - t[0])); lb1 = 1.f / (1.f + expf(t[DM + 1] - t[1]));
}
__device__ __forceinline__ float* hg_img(Frame& F, int b, int h, int dir, int slot) { return (float*)((unsigned char*)F.out + (size_t)((((b * 8 + h) * 2 + dir) * 4) + slot) * HGS_IMG); }

__device__ __forceinline__ void hg_pass1(Frame& F, const Args& a, int unit) {
    const int slot = unit & 3, dir = (unit >> 2) & 1, h = (unit >> 3) & 7, b = unit >> 6;
    const int fr = F.lane & 15, fq = F.lane >> 4;
    const HgPtrs P = hg_ptrs(F, h, dir);
    float lb0, lb1; hg_lb(a, h, F.lane, lb0, lb1);
    f32x4 St[8];
#pragma unroll
    for (int kt = 0; kt < 8; ++kt) St[kt] = (f32x4){0.f, 0.f, 0.f, 0.f};
    const bool ctx = slot == 0; const int nchunk = ctx ? CTX / HG_C : HG_SEG / HG_C; const int sig0 = ctx ? 0 : (slot - 1) * HG_SEG;
    float gs0 = 0.f, gs1 = 0.f;
    const bf16* Fsrc = ctx ? P.Fc : P.Fx; const bf16* Vsrc = ctx ? P.Vc : P.V;
    HgRaw cur; hg_load<false>(F, P.Q, Fsrc, Vsrc, b, dir, ctx, sig0, cur);
    for (int ck = 0; ck < nchunk; ++ck) {
        HgRaw nxt; { const int cn = ck + 1 < nchunk ? ck + 1 : ck; hg_load<false>(F, P.Q, Fsrc, Vsrc, b, dir, ctx, sig0 + cn * HG_C, nxt); }
        hg_prep<false>(F, cur, b, dir, ctx, sig0 + ck * HG_C, lb0, lb1, gs0, gs1);
        cur = nxt;
        bf16x8 vt[2]; hg_load_vt(F, vt);
        hg_state_update(F, St, vt);
    }
    float* img = hg_img(F, b, h, dir, slot) + (size_t)(16 * F.wave + fr) * 128 + 4 * fq;
#pragma unroll
    for (int kt = 0; kt < 8; ++kt) *(f32x4*)(img + 16 * kt) = St[kt];
    if (!ctx && F.wave == 0) { float* D = (float*)(F.ws + WS_HGD) + (size_t)((((b * 8 + h) * 2 + dir) * 3) + (slot - 1)) * 128 + 2 * F.lane;
        *(f32x2*)D = (f32x2){__builtin_amdgcn_exp2f(gs0), __builtin_amdgcn_exp2f(gs1)}; }
    __syncthreads();
}

constexpr int HG_HN = 95232;
__device__ __forceinline__ void hg_pass2(Frame& F, const Args& a, int unit) {
    const int seg = unit & 3, h = (unit >> 2) & 7, b = unit >> 5;
    const int fr = F.lane & 15, fq = F.lane >> 4, w = F.wave;
    float lb0, lb1; hg_lb(a, h, F.lane, lb0, lb1);
    const int lcol = h * 128 + 16 * w + 4 * fq;
#pragma unroll 1
    for (int dir = 0; dir < 2; ++dir) {
        const int sseg = dir == 0 ? seg : 3 - seg;
        const HgPtrs P = hg_ptrs(F, h, dir);
        f32x4 St[8];
        {
            const float* img = hg_img(F, b, h, dir, 0) + (size_t)(16 * w + fr) * 128 + 4 * fq;
#pragma unroll
            for (int kt = 0; kt < 8; ++kt) St[kt] = *(const f32x4*)(img + 16 * kt);
            for (int j = 0; j < sseg; ++j) {
                const float* im = hg_img(F, b, h, dir, 1 + j) + (size_t)(16 * w + fr) * 128 + 4 * fq;
                const float* D = (const float*)(F.ws + WS_HGD) + (size_t)((((b * 8 + h) * 2 + dir) * 3) + j) * 128 + 4 * fq;
#pragma unroll
                for (int kt = 0; kt < 8; ++kt) { const f32x4 d = *(const f32x4*)(D + 16 * kt), dl = *(const f32x4*)(im + 16 * kt); St[kt] = St[kt] * d + dl; }
            }
        }
        float gs0 = 0.f, gs1 = 0.f;
        for (int ck = 0; ck < HG_SEG / HG_C; ++ck) {
            { HgRaw cur; hg_load<true>(F, P.Q, P.Fx, P.V, b, dir, false, sseg * HG_SEG + ck * HG_C, cur);
              hg_prep<true>(F, cur, b, dir, false, sseg * HG_SEG + ck * HG_C, lb0, lb1, gs0, gs1); }
            const LAS int* rows = (const LAS int*)(F.lds + HG_ROWS);
            bf16* OFW = (bf16*)(F.ws + WS_OF) + lcol; asm volatile("" : "+v"(OFW));
            u32x2 ofw[4], ogv[4];
            if (dir == 1) {
                const bf16* OG = (const bf16*)(F.ws + WS_P + 6 * GS) + lcol; asm volatile("" : "+v"(OG));
#pragma unroll
                for (int ct = 0; ct < 4; ++ct) { const size_t ro = (size_t)rows[16 * ct + fr] * DM; ofw[ct] = *(const u32x2*)(OFW + ro); ogv[ct] = *(const u32x2*)(OG + ro); } }
#pragma unroll
            for (int tt = 0; tt < 2; ++tt) { const int t = w + 8 * tt, ct = t >> 2, st = t & 3;
                f32x4 acc = {0.f, 0.f, 0.f, 0.f};
                const int rs = 16 * st + fr, rc = 16 * ct + fr;
#pragma unroll
                for (int kk = 0; kk < 4; ++kk) { const bf16x8 A = *(const LAS bf16x8*)(F.lds + HG_KM + rs * 256 + (((4 * kk + fq) ^ fr) << 4));
                    const bf16x8 B = *(const LAS bf16x8*)(F.lds + HG_QS + rc * 256 + (((4 * kk + fq) ^ fr) << 4));
                    acc = __builtin_amdgcn_mfma_f32_16x16x32_bf16(A, B, acc, 0, 0, 0); }
                const int s0 = 16 * st + 4 * fq;
                const float m0 = (s0 + 0 <= rc) ? acc[0] : 0.f, m1 = (s0 + 1 <= rc) ? acc[1] : 0.f, m2 = (s0 + 2 <= rc) ? acc[2] : 0.f, m3 = (s0 + 3 <= rc) ? acc[3] : 0.f;
                *(LAS u32x2*)(F.lds + HG_ATT + rc * 128 + (((2 * st + (fq >> 1)) ^ ((rc >> 1) & 7)) << 4) + (fq & 1) * 8) = (u32x2){pk2(m0, m1), pk2(m2, m3)}; }
            f32x4 o[4];
#pragma unroll
            for (int ct = 0; ct < 4; ++ct) o[ct] = (f32x4){0.f, 0.f, 0.f, 0.f};
#pragma unroll
            for (int kk = 0; kk < 4; ++kk) {
                union { bf16x8 v; unsigned u[4]; } A;
                A.u[0] = pk2(St[2 * kk][0], St[2 * kk][1]); A.u[1] = pk2(St[2 * kk][2], St[2 * kk][3]); A.u[2] = pk2(St[2 * kk + 1][0], St[2 * kk + 1][1]); A.u[3] = pk2(St[2 * kk + 1][2], St[2 * kk + 1][3]);
#pragma unroll
                for (int ct = 0; ct < 4; ++ct) { const int rc = 16 * ct + fr;
                    union { bf16x8 v; u32x2 h[2]; } B;
                    B.h[0] = *(const LAS u32x2*)(F.lds + HG_QS + rc * 256 + (((4 * kk + (fq >> 1)) ^ fr) << 4) + (fq & 1) * 8);
                    B.h[1] = *(const LAS u32x2*)(F.lds + HG_QS + rc * 256 + (((4 * kk + 2 + (fq >> 1)) ^ fr) << 4) + (fq & 1) * 8);
                    o[ct] = __builtin_amdgcn_mfma_f32_16x16x32_bf16(A.v, B.v, o[ct], 0, 0, 0); } }
            bf16x8 vt[2]; hg_load_vt(F, vt);
            LDS_WAIT(); __syncthreads();
#pragma unroll
            for (int ks = 0; ks < 2; ++ks)
#pragma unroll
                for (int ct = 0; ct < 4; ++ct) { const int rc = 16 * ct + fr;
                    const bf16x8 B = *(const LAS bf16x8*)(F.lds + HG_ATT + rc * 128 + (((4 * ks + fq) ^ ((rc >> 1) & 7)) << 4));
                    o[ct] = __builtin_amdgcn_mfma_f32_16x16x32_bf16(vt[ks], B, o[ct], 0, 0, 0); }
            if (dir == 0) {
#pragma unroll
                for (int ct = 0; ct < 4; ++ct) *(u32x2*)(OFW + (size_t)rows[16 * ct + fr] * DM) = (u32x2){pk2(o[ct][0], o[ct][1]), pk2(o[ct][2], o[ct][3])};
                hg_state_update(F, St, vt);
            } else {
                LAS float* hn = (LAS float*)(F.lds + HG_HN);
                const f32x4 hn4 = *(const f32x4*)(a.in[IN_HGN] + h * 128 + 16 * w + 4 * fq);
#pragma unroll
                for (int ct = 0; ct < 4; ++ct) { o[ct][0] += bflo(ofw[ct].x); o[ct][1] += bfhi(ofw[ct].x); o[ct][2] += bflo(ofw[ct].y); o[ct][3] += bfhi(ofw[ct].y);
                    float ss = (o[ct][0] * o[ct][0] + o[ct][1] * o[ct][1]) + (o[ct][2] * o[ct][2] + o[ct][3] * o[ct][3]);
                    ss += __shfl_xor(ss, 16); ss += __shfl_xor(ss, 32);
                    if (fq == 0) hn[(16 * ct + fr) * 8 + w] = ss; }
                hg_state_update(F, St, vt);
                LDS_WAIT(); __syncthreads();
#pragma unroll
                for (int ct = 0; ct < 4; ++ct) { const f32x4 p0 = *(const LAS f32x4*)(hn + (16 * ct + fr) * 8), p1 = *(const LAS f32x4*)(hn + (16 * ct + fr) * 8 + 4);
                    const float rsn = rsqrtf(((p0.x + p0.y) + (p0.z + p0.w) + (p1.x + p1.y) + (p1.z + p1.w)) * (1.f / 128.f) + EPS);
                    const float g0 = bflo(ogv[ct].x), g1 = bfhi(ogv[ct].x), g2 = bflo(ogv[ct].y), g3 = bfhi(ogv[ct].y);
                    const float y0 = o[ct][0] * rsn * hn4.x * siluf_(g0), y1 = o[ct][1] * rsn * hn4.y * siluf_(g1), y2 = o[ct][2] * rsn * hn4.z * siluf_(g2), y3 = o[ct][3] * rsn * hn4.w * siluf_(g3);
                    *(u32x2*)(OFW + (size_t)rows[16 * ct + fr] * DM) = (u32x2){pk2(y0, y1), pk2(y2, y3)}; }
            }
        }
        VM_WAIT(); __syncthreads();
    }
}
__device__ __forceinline__ void p_ybg(Frame& F, const Args& a) {
    const bf16* OFp = (const bf16*)(F.ws + WS_OF); const bf16* OBp = (const bf16*)(F.ws + WS_OB); const bf16* OG = (const bf16*)(F.ws + WS_P + 6 * GS);
    bf16* YBG = (bf16*)(F.ws + WS_YBG); const float* hgn = a.in[IN_HGN];
    const int gw = F.bid * NWAVES + F.wave, NGW = F.G * NWAVES;
    for (int row = gw; row < NTOK; row += 2 * NGW) {
        u32x4 fv[2][2], bv[2][2], gvv[2][2];
#pragma unroll
        for (int rr = 0; rr < 2; ++rr)
#pragma unroll
            for (int j = 0; j < 2; ++j) { const size_t o = (size_t)(row + rr * NGW) * DM + 8 * F.lane + 512 * j;
                fv[rr][j] = *(const u32x4*)(OFp + o); bv[rr][j] = *(const u32x4*)(OBp + o); gvv[rr][j] = *(const u32x4*)(OG + o); }
#pragma unroll
        for (int rr = 0; rr < 2; ++rr)
#pragma unroll
        for (int j = 0; j < 2; ++j) { const int k = 8 * F.lane + 512 * j; const size_t o = (size_t)(row + rr * NGW) * DM + k;
            const u32x4 f = fv[rr][j], b = bv[rr][j], g = gvv[rr][j];
            float v[8]; v[0] = bflo(f.x) + bflo(b.x); v[1] = bfhi(f.x) + bfhi(b.x); v[2] = bflo(f.y) + bflo(b.y); v[3] = bfhi(f.y) + bfhi(b.y);
            v[4] = bflo(f.z) + bflo(b.z); v[5] = bfhi(f.z) + bfhi(b.z); v[6] = bflo(f.w) + bflo(b.w); v[7] = bfhi(f.w) + bfhi(b.w);
            float ss = 0.f;
#pragma unroll
            for (int q = 0; q < 8; ++q) ss += v[q] * v[q];
            ss += __shfl_xor(ss, 1); ss += __shfl_xor(ss, 2); ss += __shfl_xor(ss, 4); ss += __shfl_xor(ss, 8);
            const float rs = rsqrtf(ss * (1.f / 128.f) + EPS);
            float gv[8]; gv[0] = bflo(g.x); gv[1] = bfhi(g.x); gv[2] = bflo(g.y); gv[3] = bfhi(g.y); gv[4] = bflo(g.z); gv[5] = bfhi(g.z); gv[6] = bflo(g.w); gv[7] = bfhi(g.w);
            const f32x4 h0 = *(const f32x4*)(hgn + k), h1 = *(const f32x4*)(hgn + k + 4);
            const float hv[8] = {h0.x, h0.y, h0.z, h0.w, h1.x, h1.y, h1.z, h1.w};
            float r[8];
#pragma unroll
            for (int q = 0; q < 8; ++q) r[q] = v[q] * rs * hv[q] * siluf_(gv[q]);
            u32x4 w; w.x = pk2(r[0], r[1]); w.y = pk2(r[2], r[3]); w.z = pk2(r[4], r[5]); w.w = pk2(r[6], r[7]);
            *(u32x4*)(YBG + o) = w; }
    }
}
__device__ __forceinline__ void p_moe_weights13(Frame& F, const Args& a) {
    LAS float* scr = (LAS float*)(F.lds + F.wave * TR_BYTES);
    const int gw = F.bid * NWAVES + F.wave, NGW = F.G * NWAVES;
    for (int it = gw; it < NEXP * 256; it += NGW) {
        const int e = it >> 8, r = it & 255, w = r >> 7, q = r & 127, kb = q >> 3, nb = q & 7;
        transpose_item(a.in[w == 0 ? IN_W1 : IN_W3] + (size_t)e * DM * DEXP, DEXP, DM, (bf16*)(F.ws + (w == 0 ? WS_W1T : WS_W3T)) + ((size_t)e * DEXP + nb * 64) * DM, kb * 64, nb * 64, scr, F.lane);
    }
}
__device__ __forceinline__ void p_moe_weights2(Frame& F, const Args& a, int rank, int nwg) {
    LAS float* scr = (LAS float*)(F.lds + F.wave * TR_BYTES);
    for (int it = rank * NWAVES + F.wave; it < NEXP * 128; it += nwg * NWAVES) {
        const int e = it >> 7, q = it & 127, kb = q >> 4, nb = q & 15;
        transpose_item(a.in[IN_W2] + (size_t)e * DEXP * DM, DM, DEXP, (bf16*)(F.ws + WS_W2T) + ((size_t)e * DM + nb * 64) * DEXP, kb * 64, nb * 64, scr, F.lane);
    }
}

struct SchedP5 {
    int c; const char* YAG; const char* YBG; const char* WA; const char* WB; char* stash; char* M;
    __device__ __forceinline__ bool next(int i, gm::Unit& u) const {
        if (i >= 2) return false;
        int pm, pn; tile_order(c, 64, 4, pm, pn);
        u.A = (i == 0 ? YAG : YBG) + (size_t)pm * 256 * 2048; u.B0 = (i == 0 ? WA : WB) + (size_t)pn * 256 * 2048; u.B1 = u.B0 + (size_t)128 * 2048;
        u.dst = M + ((size_t)pm * 256 * DM + pn * 256) * 2; u.pm = pm; u.pn = pn; u.e = i; u.rows = 256; return true;
    }
    __device__ __forceinline__ unsigned arow(const gm::Unit&, int r) const { return (unsigned)r; }
};
struct EpiP5 {
    static constexpr bool PERM = true;
    float* stash; const bf16* GA; const bf16* GB;
    __device__ __forceinline__ void operator()(const f32x4 (&acc)[2][2][4][2], const gm::Unit& u, int wr, int wc, int fr, int fq) const {
        const bf16* G = (u.e == 0 ? GA : GB) + ((size_t)u.pm * 256 + wr * 64 + fr) * DM + u.pn * 256 + wc * 32 + 8 * fq;
        bf16* Mb = (bf16*)u.dst + (size_t)(wr * 64 + fr) * DM + wc * 32 + 8 * fq;
        f32x4* st = (f32x4*)stash + threadIdx.x;
        asm volatile("" : "+v"(G), "+v"(Mb), "+v"(st));
#pragma unroll
        for (int ai = 0; ai < 2; ++ai)
#pragma unroll
            for (int m = 0; m < 4; ++m) {
                u32x4 g[2]; f32x4 s0[2], s1[2];
#pragma unroll
                for (int bj = 0; bj < 2; ++bj) { const size_t ro = (size_t)(ai * 128 + m * 16) * DM + bj * 128; const int si = ((ai * 4 + m) * 2 + bj) * 2;
                    g[bj] = *(const u32x4*)(G + ro);
                    if (u.e != 0) { s0[bj] = st[(size_t)(si + 0) * NTHR]; s1[bj] = st[(size_t)(si + 1) * NTHR]; } }
#pragma unroll
                for (int bj = 0; bj < 2; ++bj) { const size_t ro = (size_t)(ai * 128 + m * 16) * DM + bj * 128; const int si = ((ai * 4 + m) * 2 + bj) * 2;
                    f32x4 v0 = acc[ai][bj][m][0], v1 = acc[ai][bj][m][1];
                    v0[0] *= sigmoidf_(bflo(g[bj].x)); v0[1] *= sigmoidf_(bfhi(g[bj].x)); v0[2] *= sigmoidf_(bflo(g[bj].y)); v0[3] *= sigmoidf_(bfhi(g[bj].y));
                    v1[0] *= sigmoidf_(bflo(g[bj].z)); v1[1] *= sigmoidf_(bfhi(g[bj].z)); v1[2] *= sigmoidf_(bflo(g[bj].w)); v1[3] *= sigmoidf_(bfhi(g[bj].w));
                    if (u.e == 0) { st[(size_t)(si + 0) * NTHR] = v0; st[(size_t)(si + 1) * NTHR] = v1; }
                    else { v0 += s0[bj]; v1 += s1[bj];
                        u32x4 w; w.x = gm::cvt_pk_bf16(v0[0], v0[1]); w.y = gm::cvt_pk_bf16(v0[2], v0[3]); w.z = gm::cvt_pk_bf16(v1[0], v1[1]); w.w = gm::cvt_pk_bf16(v1[2], v1[3]);
                        *(u32x4*)(Mb + ro) = w; } }
                asm volatile("" ::: "memory"); }
    }
};

struct SchedP6 {
    int c; const char* M; const char* W; char* X1;
    __device__ __forceinline__ bool next(int i, gm::Unit& u) const {
        if (i >= 1) return false;
        int pm, pn; tile_order(c, 64, 4, pm, pn);
        u.A = M + (size_t)pm * 256 * 2048; u.B0 = W + (size_t)pn * 256 * 2048; u.B1 = u.B0 + (size_t)128 * 2048;
        u.dst = X1 + ((size_t)pm * 256 * DM + pn * 256) * 4; u.pm = pm; u.pn = pn; u.e = 0; u.rows = 256; return true;
    }
    __device__ __forceinline__ unsigned arow(const gm::Unit&, int r) const { return (unsigned)r; }
};
struct EpiP6 {
    static constexpr bool PERM = false;
    const float* x; const float* mod;
    __device__ __forceinline__ void operator()(const f32x4 (&acc)[2][2][4][2], const gm::Unit& u, int wr, int wc, int fr, int fq) const {
        const int b = u.pm >> 3; const int col0 = u.pn * 256 + wc * 32 + 4 * fq;
        const float* mg = mod + b * 6144 + 2 * DM + col0;
        f32x4 gv[2][2];
#pragma unroll
        for (int bj = 0; bj < 2; ++bj)
#pragma unroll
            for (int n = 0; n < 2; ++n) gv[bj][n] = *(const f32x4*)(mg + bj * 128 + n * 16);
#pragma unroll
        for (int ai = 0; ai < 2; ++ai)
#pragma unroll
            for (int m = 0; m < 4; ++m) { const size_t ro = (size_t)(wr * 64 + fr + ai * 128 + m * 16) * DM + wc * 32 + 4 * fq;
                const float* xr = x + ((size_t)u.pm * 256 * DM + u.pn * 256) + ro; float* orow = (float*)u.dst + ro;
#pragma unroll
                for (int bj = 0; bj < 2; ++bj)
#pragma unroll
                    for (int n = 0; n < 2; ++n) { const f32x4 xv = *(const f32x4*)(xr + bj * 128 + n * 16);
                        *(f32x4*)(orow + bj * 128 + n * 16) = xv + gv[bj][n] * acc[ai][bj][m][n]; } }
    }
};

__device__ __forceinline__ void p_norm2_route(Frame& F, const Args& a) {
    const float* mod = (const float*)(F.ws + WS_MOD); const float* g2 = a.in[IN_G2]; const float* wrp = (const float*)(F.ws + WS_WRT);
    const float* X1 = F.out; bf16* HX2 = (bf16*)(F.ws + WS_HX2);
    int* list = (int*)(F.ws + WS_LIST); float* wt = (float*)(F.ws + WS_WT); unsigned* cnt = F.ctl + CW_CNT;
    LAS float* gs = (LAS float*)F.lds; LAS float* sh = gs + DM; LAS float* rst = sh + DM; LAS float* lgs = rst + 64;
    const int b = F.bid / 32;
    for (int k = F.tid; k < DM; k += NTHR) { gs[k] = g2[k] * (1.f + mod[b * 6144 + 4 * DM + k]); sh[k] = mod[b * 6144 + 3 * DM + k]; }
    __syncthreads();
    for (int r = F.wave; r < 64; r += NWAVES) {
        const int tok = F.bid * 64 + r;
        const f32x4* xr = (const f32x4*)(X1 + (size_t)tok * DM) + F.lane;
        f32x4 v[4]; float s = 0.f;
#pragma unroll
        for (int j = 0; j < 4; ++j) { v[j] = xr[64 * j]; s += (v[j].x * v[j].x + v[j].y * v[j].y) + (v[j].z * v[j].z + v[j].w * v[j].w); }
        const float rstd = rsqrtf(wave_sum(s) * (1.f / DM) + EPS);
        if (F.lane == 0) rst[r] = rstd;
        unsigned long long* o8 = (unsigned long long*)(HX2 + (size_t)tok * DM) + F.lane;
#pragma unroll
        for (int j = 0; j < 4; ++j) { const int k = 4 * F.lane + 256 * j;
            const f32x4 g = *(const LAS f32x4*)(gs + k), h = *(const LAS f32x4*)(sh + k);
            o8[64 * j] = (unsigned long long)pk2(v[j].x * rstd * g.x + h.x, v[j].y * rstd * g.y + h.y) | ((unsigned long long)pk2(v[j].z * rstd * g.z + h.z, v[j].w * rstd * g.w + h.w) << 32); }
    }
    LDS_WAIT(); __syncthreads();
    {
        const int tq = F.lane & 15, kq = F.lane >> 4, wg = F.wave & 3, kh = F.wave >> 2; const int tl = wg * 16 + tq;
        const float rs = rst[tl];
        const float* xr = X1 + (size_t)(F.bid * 64 + tl) * DM + 4 * kq + 512 * kh;
        const f32x4* wp = (const f32x4*)wrp + F.lane + (size_t)kh * 32 * 3 * 64;
        const LAS float* gsp = gs + 512 * kh + 4 * kq; const LAS float* shp = sh + 512 * kh + 4 * kq;
        f32x4 acc[3];
#pragma unroll
        for (int c = 0; c < 3; ++c) acc[c] = (f32x4){0.f, 0.f, 0.f, 0.f};
#pragma unroll 8
        for (int s = 0; s < 32; ++s) {
            const f32x4 x = *(const f32x4*)(xr + 16 * s); const f32x4 g = *(const LAS f32x4*)(gsp + 16 * s), h = *(const LAS f32x4*)(shp + 16 * s);
            const f32x4 hv = x * rs * g + h;
#pragma unroll
            for (int c = 0; c < 3; ++c) { const f32x4 w = wp[(s * 3 + c) * 64];
                acc[c] = __builtin_amdgcn_mfma_f32_16x16x4f32(hv[0], w[0], acc[c], 0, 0, 0); acc[c] = __builtin_amdgcn_mfma_f32_16x16x4f32(hv[1], w[1], acc[c], 0, 0, 0);
                acc[c] = __builtin_amdgcn_mfma_f32_16x16x4f32(hv[2], w[2], acc[c], 0, 0, 0); acc[c] = __builtin_amdgcn_mfma_f32_16x16x4f32(hv[3], w[3], acc[c], 0, 0, 0); }
        }
#pragma unroll
        for (int c = 0; c < 3; ++c)
#pragma unroll
            for (int r = 0; r < 4; ++r) lgs[kh * 64 * 48 + (wg * 16 + 4 * kq + r) * 48 + 16 * c + tq] = acc[c][r];
    }
    LDS_WAIT(); __syncthreads();
    if (F.wave < 4) {
        if (F.lane < 16) {
            const LAS float* lp = lgs + (F.wave * 16 + F.lane) * 48; const int tok = F.bid * 64 + F.wave * 16 + F.lane;
            float lg[36];
#pragma unroll
            for (int q = 0; q < 9; ++q) { const f32x4 t4 = *(const LAS f32x4*)(lp + 4 * q) + *(const LAS f32x4*)(lp + 64 * 48 + 4 * q) + *(const f32x4*)(wrp + 49152 + 4 * q);
                lg[4 * q] = t4.x; lg[4 * q + 1] = t4.y; lg[4 * q + 2] = t4.z; lg[4 * q + 3] = t4.w; }
            float mx = lg[0]; int gi = 0;
#pragma unroll
            for (int g = 1; g < 4; ++g) if (lg[g] > mx) { mx = lg[g]; gi = g; }
            float z = 0.f;
#pragma unroll
            for (int g = 0; g < 4; ++g) z += __expf(lg[g] - mx);
            const float pg = 1.f / z;
            float el[8];
#pragma unroll
            for (int e = 0; e < 8; ++e) el[e] = gi == 0 ? lg[4 + e] : (gi == 1 ? lg[12 + e] : (gi == 2 ? lg[20 + e] : lg[28 + e]));
            int e1 = 0; float m1 = el[0];
#pragma unroll
            for (int e = 1; e < 8; ++e) if (el[e] > m1) { m1 = el[e]; e1 = e; }
            int e2 = 0; float m2 = -3.0e38f;
#pragma unroll
            for (int e = 0; e < 8; ++e) if (e != e1 && el[e] > m2) { m2 = el[e]; e2 = e; }
            const float rr = __expf(m2 - m1); const float w1 = pg / (1.f + rr), w2 = pg * rr / (1.f + rr);
            const int ea = gi * 8 + e1, eb = gi * 8 + e2;
            const unsigned pa = __hip_atomic_fetch_add(cnt + 64 * ea, 1u, __ATOMIC_RELAXED, __HIP_MEMORY_SCOPE_AGENT);
            const unsigned pb = __hip_atomic_fetch_add(cnt + 64 * eb, 1u, __ATOMIC_RELAXED, __HIP_MEMORY_SCOPE_AGENT);
            list[(size_t)ea * CAP + pa] = tok * 2; wt[tok * 2] = w1;
            list[(size_t)eb * CAP + pb] = tok * 2 + 1; wt[tok * 2 + 1] = w2;
        }
    }
}

__device__ __forceinline__ void moe_table(Frame& F, const int* cntv) {
    if (F.wave == 0) { const int lane = F.lane; const int cnt = lane < NEXP ? cntv[64 * lane] : 0;
        const int t = (cnt + 255) >> 8; int ti = t, oi = cnt;
#pragma unroll
        for (int d = 1; d < 32; d <<= 1) { const int tu = __shfl_up(ti, d), ou = __shfl_up(oi, d); if ((lane & 31) >= d) { ti += tu; oi += ou; } }
        if (lane < NEXP) { F.MISC[128 + lane] = (unsigned)cnt; F.MISC[160 + lane] = (unsigned)(ti - t); F.MISC[192 + lane] = (unsigned)(oi - cnt); }
        if (lane == NEXP - 1) F.MISC[224] = (unsigned)ti; }
    LDS_WAIT(); __syncthreads();
}
__device__ __forceinline__ bool moe_find(volatile LAS unsigned* MISC, int lane, int T, int& e, int& rt, int& rows, int& off) {
    if (T >= (int)MISC[224]) return false;
    const int l = lane & 31; const int cnt = (int)MISC[128 + l], tpre = (int)MISC[160 + l];
    const unsigned long long mask = __ballot(lane < NEXP && cnt > 0 && T >= tpre);
    e = __builtin_amdgcn_readfirstlane(63 - __builtin_clzll(mask));
    rt = T - (int)MISC[160 + e]; const int c = (int)MISC[128 + e]; off = (int)MISC[192 + e];
    rows = c - rt * 256; if (rows > 256) rows = 256; return true;
}
struct SchedMoe1 {
    int G, c, lane; volatile LAS unsigned* MISC; const int* list; const char* HX2; const char* W1T; const char* W3T; char* HH; unsigned* tile_cnt;
    __device__ __forceinline__ bool next(int i, gm::Unit& u) const {
        const int vc = (c & 7) * (G >> 3) + (c >> 3);
        const int L = i * G + vc; int e, rt, rows, off; if (!moe_find(MISC, lane, L >> 2, e, rt, rows, off)) return false;
        const int pn = L & 3;
        e = __builtin_amdgcn_readfirstlane(e); rt = __builtin_amdgcn_readfirstlane(rt); rows = __builtin_amdgcn_readfirstlane(rows); off = __builtin_amdgcn_readfirstlane(off);
        u.A = HX2; u.B0 = W1T + ((size_t)e * DEXP + pn * 128) * 2048; u.B1 = W3T + ((size_t)e * DEXP + pn * 128) * 2048;
        u.dst = HH + ((size_t)(off + rt * 256) * DEXP + pn * 128) * 2; u.pm = rt; u.pn = pn; u.e = e; u.rows = rows; u.t = L >> 2; return true;
    }
    __device__ __forceinline__ unsigned arow(const gm::Unit& u, int r) const { const int rr = r < u.rows ? r : u.rows - 1; return (unsigned)(list[(size_t)u.e * CAP + u.pm * 256 + rr] >> 1); }
    __device__ __forceinline__ void a_ready(const gm::Unit&) const {}
    __device__ __forceinline__ void done(const gm::Unit& u) const {
        asm volatile("s_waitcnt vmcnt(0)" ::: "memory");
        __builtin_amdgcn_s_barrier(); asm volatile("" ::: "memory");
        if (threadIdx.x == 0) __hip_atomic_fetch_add(tile_cnt + 8 * u.t, 1u, __ATOMIC_RELAXED, __HIP_MEMORY_SCOPE_AGENT);
    }
};
struct EpiMoe1 {
    static constexpr bool PERM = true;
    char* HH;
    __device__ __forceinline__ void operator()(const f32x4 (&acc)[2][2][4][2], const gm::Unit& u, int wr, int wc, int fr, int fq) const {
        const __amdgpu_buffer_rsrc_t rs = __builtin_amdgcn_make_buffer_rsrc((void*)HH, 0, 0x7fffffff, 0x00020000);
        const unsigned base = (unsigned)(u.dst - HH) + (unsigned)(((wr * 64 + fr) * DEXP + wc * 32 + 8 * fq) * 2);
#pragma unroll
        for (int ai = 0; ai < 2; ++ai)
#pragma unroll
            for (int m = 0; m < 4; ++m) { const int r = ai * 128 + wr * 64 + m * 16 + fr; if (r >= u.rows) continue;
                const f32x4 u0 = acc[ai][0][m][0], u1 = acc[ai][0][m][1], v0 = acc[ai][1][m][0], v1 = acc[ai][1][m][1];
                u32x4 w; w.x = gm::cvt_pk_bf16(siluf_(u0[0]) * v0[0], siluf_(u0[1]) * v0[1]); w.y = gm::cvt_pk_bf16(siluf_(u0[2]) * v0[2], siluf_(u0[3]) * v0[3]);
                w.z = gm::cvt_pk_bf16(siluf_(u1[0]) * v1[0], siluf_(u1[1]) * v1[1]); w.w = gm::cvt_pk_bf16(siluf_(u1[2]) * v1[2], siluf_(u1[3]) * v1[3]);
                __builtin_amdgcn_raw_buffer_store_b128(w, rs, base + (unsigned)((ai * 128 + m * 16) * DEXP * 2), 0, 16); }
    }
};
struct SchedMoe2 {
    int G, c, lane; volatile LAS unsigned* MISC; const char* HH; const char* W2T; char* Y; unsigned* tile_cnt; unsigned* tmo;
    __device__ __forceinline__ bool next(int i, gm::Unit& u) const {
        const int vc = (c & 7) * (G >> 3) + (c >> 3);
        const int U = 4 * (int)MISC[224], q = U / G, r = U % G;
        const bool rebal = q >= 1 && r > 0 && 3 * r <= G;
        int L = i * G + (G - 1 - vc);
        if (rebal) {
            if (vc < r) { if (i >= q - 1) return false; }
            else if (vc < 2 * r) { if (i == q) L = (q - 1) * G + (G - 1 - (vc - r)); else if (i > q) return false; }
        }
        int e, rt, rows, off; if (!moe_find(MISC, lane, L >> 2, e, rt, rows, off)) return false;
        const int pn = L & 3;
        e = __builtin_amdgcn_readfirstlane(e); rt = __builtin_amdgcn_readfirstlane(rt); rows = __builtin_amdgcn_readfirstlane(rows); off = __builtin_amdgcn_readfirstlane(off);
        u.A = HH + (size_t)(off + rt * 256) * DEXP * 2; u.B0 = W2T + ((size_t)e * DM + pn * 256) * (DEXP * 2); u.B1 = u.B0 + (size_t)128 * (DEXP * 2);
        u.dst = Y + (size_t)pn * 256 * 2; u.pm = rt; u.pn = pn; u.e = e; u.rows = rows; u.t = L >> 2; return true;
    }
    __device__ __forceinline__ unsigned arow(const gm::Unit&, int r) const { return (unsigned)r; }
    __device__ __forceinline__ void a_ready(const gm::Unit& u) const {
        if (threadIdx.x < 64) {
            unsigned spins = 0;
            while ((unsigned)__builtin_amdgcn_readfirstlane(__hip_atomic_load(tile_cnt + 8 * u.t, __ATOMIC_RELAXED, __HIP_MEMORY_SCOPE_AGENT)) < 4u) {
                __builtin_amdgcn_s_sleep(2);
                if (++spins > (1u << 22)) { if (threadIdx.x == 0) __hip_atomic_store(tmo, 1u, __ATOMIC_RELAXED, __HIP_MEMORY_SCOPE_AGENT); break; } }
            __builtin_amdgcn_fence(__ATOMIC_ACQUIRE, "agent");
            asm volatile("s_waitcnt vmcnt(0)" ::: "memory");
        }
        asm volatile("" ::: "memory"); __builtin_amdgcn_s_barrier(); asm volatile("" ::: "memory");
    }
    __device__ __forceinline__ void done(const gm::Unit&) const {}
};
struct EpiMoe2 {
    static constexpr bool PERM = true;
    const int* list;
    __device__ __forceinline__ void operator()(const f32x4 (&acc)[2][2][4][2], const gm::Unit& u, int wr, int wc, int fr, int fq) const {
        const int* lp = list + (size_t)u.e * CAP + u.pm * 256;
#pragma unroll
        for (int ai = 0; ai < 2; ++ai)
#pragma unroll
            for (int m = 0; m < 4; ++m) { const int r = ai * 128 + wr * 64 + m * 16 + fr; if (r >= u.rows) continue;
                const int slot = lp[r]; bf16* rowp = (bf16*)u.dst + (size_t)slot * DM + wc * 32 + 8 * fq;
#pragma unroll
                for (int bj = 0; bj < 2; ++bj) { const f32x4 v0 = acc[ai][bj][m][0], v1 = acc[ai][bj][m][1];
                    u32x4 w; w.x = gm::cvt_pk_bf16(v0[0], v0[1]); w.y = gm::cvt_pk_bf16(v0[2], v0[3]); w.z = gm::cvt_pk_bf16(v1[0], v1[1]); w.w = gm::cvt_pk_bf16(v1[2], v1[3]);
                    *(u32x4*)(rowp + bj * 128) = w; } }
    }
};

__device__ __forceinline__ void p_final(Frame& F, const Args& a) {
    const float* mod = (const float*)(F.ws + WS_MOD); const float* fg = a.in[IN_FG]; const float* wt = (const float*)(F.ws + WS_WT);
    const bf16* Y = (const bf16*)(F.ws + WS_Y); float* X1 = F.out;
    for (int r = F.wave; r < 64; r += NWAVES) {
        const int tok = F.bid * 64 + r; const int b = tok >> 11;
        const float w0 = wt[tok * 2], w1 = wt[tok * 2 + 1];
        f32x4* xr = (f32x4*)(X1 + (size_t)tok * DM) + F.lane;
        const u32x2* y0 = (const u32x2*)(Y + (size_t)(tok * 2) * DM) + F.lane; const u32x2* y1 = (const u32x2*)(Y + (size_t)(tok * 2 + 1) * DM) + F.lane;
        f32x4 v[4]; float s = 0.f;
#pragma unroll
        for (int j = 0; j < 4; ++j) { const int k = 4 * F.lane + 256 * j;
            const f32x4 xv = xr[64 * j]; const u32x2 a0 = y0[64 * j], a1 = y1[64 * j]; const f32x4 g5 = *(const f32x4*)(mod + b * 6144 + 5 * DM + k);
            v[j].x = xv.x + g5.x * (w0 * bflo(a0.x) + w1 * bflo(a1.x)); v[j].y = xv.y + g5.y * (w0 * bfhi(a0.x) + w1 * bfhi(a1.x));
            v[j].z = xv.z + g5.z * (w0 * bflo(a0.y) + w1 * bflo(a1.y)); v[j].w = xv.w + g5.w * (w0 * bfhi(a0.y) + w1 * bfhi(a1.y));
            s += (v[j].x * v[j].x + v[j].y * v[j].y) + (v[j].z * v[j].z + v[j].w * v[j].w); }
        const float rstd = rsqrtf(wave_sum(s) * (1.f / DM) + EPS);
#pragma unroll
        for (int j = 0; j < 4; ++j) { const int k = 4 * F.lane + 256 * j; const f32x4 g = *(const f32x4*)(fg + k);
            xr[64 * j] = (f32x4){v[j].x * rstd * g.x, v[j].y * rstd * g.y, v[j].z * rstd * g.z, v[j].w * rstd * g.w}; }
    }
}
#ifndef LRU_FAST
#define LRU_FAST 1
#endif
#ifndef HG_FAST
#define HG_FAST 1
#endif
#define MIX_FAST (LRU_FAST && HG_FAST)
#ifdef PROBE_A
#define STAMP(k) do { if (F.bid == 0 && F.tid == 0) { const unsigned long long _t = __builtin_amdgcn_s_memrealtime(); F.MISC[32 + 2 * (k)] = (unsigned)_t; F.MISC[33 + 2 * (k)] = (unsigned)(_t >> 32); } } while (0)
#else
#define STAMP(k) do { } while (0)
#endif
__device__ __forceinline__ void p_mix1(Frame& F, const Args& a) {
#if LRU_FAST
    for (int u = F.bid; u < NB * 8 * LRU_NCH; u += F.G) lru_pass1<0>(F, a, u, (float*)(F.ws + WS_LRUAGG));
#ifdef XLRU
    for (int u = F.bid; u < NB * 8 * LRU_NCH; u += F.G) lru_pass1<XLRU>(F, a, u, F.out + (size_t)10 * 1024 * 1024);
#endif
#endif
    STAMP(14); STAMP(15);
#if HG_FAST
    for (int i = 0, u = F.bid; u < NB * 8 * 2 * 4; u += F.G, ++i) hg_pass1(F, a, (u & ~3) | ((u + 2 * i) & 3));
#endif
}
__device__ __forceinline__ void p_mix2(Frame& F, const Args& a) {
#if LRU_FAST
    for (int u = F.bid; u < NB * 8 * LRU_NCH; u += F.G) lru_pass2(F, a, u);
#endif
    STAMP(16); STAMP(17);
#if HG_FAST
    for (int u = F.bid; u < NB * 8 * 4; u += F.G) hg_pass2(F, a, u);
#endif
}
__global__ void __launch_bounds__(NTHR, 2) mega(Args args) {
    extern __shared__ __attribute__((aligned(16))) unsigned char lds_raw[];
    Frame F;
    F.lds = (LAS unsigned char*)lds_raw; F.MISC = (volatile LAS unsigned*)(F.lds + LDSCTL_OFF);
    F.tid = threadIdx.x; F.lane = F.tid & 63; F.wave = __builtin_amdgcn_readfirstlane(F.tid >> 6);
    F.G = gridDim.x; F.bid = blockIdx.x; F.ws = args.ws; F.out = args.out; F.ctl = (unsigned*)(args.ws + WS_CTL);
    for (int u = F.tid; u < (LDS_BYTES - LDSCTL_OFF) / 4; u += NTHR) ((LAS unsigned*)(F.lds + LDSCTL_OFF))[u] = 0u;
    __syncthreads();
    XcdBarrier bar = xcd_barrier_post(F.ctl + CW_BAR + args.li * 3584, F.MISC + 8);
    const int lo = args.ph_lo, hi = args.ph_hi;
#define IN(k) (lo <= (k) && (k) < hi)
#define SEAM(k) do { if (IN(k) && IN((k) + 1)) xcd_barrier(bar); STAMP((k) + 1); if ((k) == 9) STAMP(11); } while (0)
    unsigned char* ws = F.ws;
    STAMP(0);
    if (IN(0)) { p0_prologue(F, args); } SEAM(0);
    if (IN(1)) { p1_norm(F, args); } SEAM(1);
    if (IN(2)) {
        SchedP2 S{F.G, F.bid, (const char*)F.out, (const char*)(ws + WS_WIN), (char*)(ws + WS_P), (char*)(ws + WS_PC)};
        EpiStoreBf16 E;
        gm::gemm_phase<SchedP2, EpiStoreBf16, false>(F.lds, DM, S, E);
    } SEAM(2);
    if (IN(3)) { p_mix1(F, args); } SEAM(3);
    if (IN(4)) { p_mix2(F, args); } SEAM(4);
    if (IN(6)) {
        const bool conv_first = ((F.bid >> 3) & 1) != 0;
        if (conv_first) { p_moe_weights13(F, args); p_moe_weights2(F, args, F.bid, F.G); __syncthreads(); }
        {
            SchedP5 S{F.bid, (const char*)(ws + WS_YAG), (const char*)(ws + WS_YBG), (const char*)(ws + WS_WPA), (const char*)(ws + WS_WPB), nullptr, (char*)(ws + WS_M)};
            EpiP5 E{F.out + (size_t)F.bid * 65536, (const bf16*)(ws + WS_P + 7 * GS), (const bf16*)(ws + WS_P + 8 * GS)};
            gm::gemm_phase<SchedP5, EpiP5, false>(F.lds, DM, S, E);
        }
        if (!conv_first) { __syncthreads(); p_moe_weights13(F, args); p_moe_weights2(F, args, F.bid, F.G); }
    } SEAM(6);
    if (IN(7)) {
        SchedP6 S{F.bid, (const char*)(ws + WS_M), (const char*)(ws + WS_WOUT), (char*)F.out};
        EpiP6 E{args.in[IN_X], (const float*)(ws + WS_MOD)};
        gm::gemm_phase<SchedP6, EpiP6, false>(F.lds, DM, S, E);
    } SEAM(7);
    if (IN(8)) { p_norm2_route(F, args); } SEAM(8);
    if (IN(9)) {
        moe_table(F, (const int*)(F.ctl + CW_CNT));
        {
            SchedMoe1 S{F.G, F.bid, F.lane, F.MISC, (const int*)(ws + WS_LIST), (const char*)(ws + WS_HX2), (const char*)(ws + WS_W1T), (const char*)(ws + WS_W3T), (char*)(ws + WS_HH), F.ctl + CW_TILE};
            EpiMoe1 E{(char*)(ws + WS_HH)};
            gm::gemm_phase<SchedMoe1, EpiMoe1, true, true>(F.lds, DM, S, E);
        }
        {
            SchedMoe2 S{F.G, F.bid, F.lane, F.MISC, (const char*)(ws + WS_HH), (const char*)(ws + WS_W2T), (char*)(ws + WS_Y), F.ctl + CW_TILE, F.ctl + 2};
            EpiMoe2 E{(const int*)(ws + WS_LIST)};
            gm::gemm_phase<SchedMoe2, EpiMoe2, false, true>(F.lds, DEXP, S, E);
        }
    } SEAM(9);
    if (IN(11)) { p_final(F, args); }
#ifdef PROBE_A
    if (F.bid == 0 && F.tid == 0) {
        const unsigned long long tend = __builtin_amdgcn_s_memrealtime();
        F.MISC[32 + 2 * 12] = (unsigned)tend; F.MISC[33 + 2 * 12] = (unsigned)(tend >> 32);
        auto RD = [&](int k) { return ((unsigned long long)F.MISC[33 + 2 * k] << 32) | F.MISC[32 + 2 * k]; };
        auto T = [&](int k) { if (k >= 20) { const int i = k - 20; return (unsigned long long)(((((unsigned long long)F.MISC[103 + 2 * i] << 32) | F.MISC[102 + 2 * i]) + 400) / 800); } if (k == 13) return (unsigned long long)((RD(14) - RD(3) + 400) / 800); if (k == 15) return (unsigned long long)((RD(16) - RD(4) + 400) / 800); const unsigned long long t0 = ((unsigned long long)F.MISC[33 + 2 * k] << 32) | F.MISC[32 + 2 * k], t1 = ((unsigned long long)F.MISC[33 + 2 * (k + 1)] << 32) | F.MISC[32 + 2 * (k + 1)]; return (unsigned long long)((t1 - t0 + 400) / 800); };
        const unsigned long long delay = (T(PROBE_A) + 64ull * T(PROBE_B)) * 6400ull;
        while (__builtin_amdgcn_s_memrealtime() - tend < delay) __builtin_amdgcn_s_sleep(32);
    }
#endif
#undef IN
#undef SEAM
}

#if !LRU_FAST
__global__ void k_conv_f(const bf16* P0, const bf16* PC0, const float* cw, const float* cb, float* Ub, int b) {
    int t = blockIdx.x; int Lseg = t < CTX ? CTX : SEQ; int lt = t < CTX ? t : t - CTX;
    const bf16* base = t < CTX ? PC0 + (size_t)b * CTX * DM : P0 + (size_t)b * SEQ * DM;
    for (int ch = threadIdx.x; ch < DM; ch += 256) {
        float s = cb[ch];
#pragma unroll
        for (int k = 0; k < 4; ++k) { int tt = lt + k - 2; if (tt >= 0 && tt < Lseg) s += cw[k * DM + ch] * bf2f(base[(size_t)tt * DM + ch]); }
        Ub[(size_t)t * DM + ch] = s;
    }
}
__global__ void k_gates(const float* Ub, const float* wa, const float* ba, const float* wx, const float* bx, const float* lam, float* Aout, float* Bout, int d) {
    __shared__ float us[128];
    int t = blockIdx.x, h = blockIdx.y, j = threadIdx.x; int ch = h * 128 + j;
    float uval = Ub[(size_t)t * DM + ch];
    us[j] = uval; __syncthreads();
    const float* wah = wa + ((size_t)(d * 8 + h) * 128) * 128; const float* wxh = wx + ((size_t)(d * 8 + h) * 128) * 128;
    float ra = 0.f, ia = 0.f;
    for (int i = 0; i < 128; ++i) { float u = us[i]; ra += u * wah[i * 128 + j]; ia += u * wxh[i * 128 + j]; }
    float r = 1.f / (1.f + expf(-(ra + ba[d * DM + ch]))); float ig = 1.f / (1.f + expf(-(ia + bx[d * DM + ch])));
    float sp = log1pf(expf(-lam[d * DM + ch]));
    float log_a = -8.f * r * sp;
    Aout[(size_t)t * DM + ch] = expf(log_a); Bout[(size_t)t * DM + ch] = sqrtf(-expm1f(2.f * log_a)) * (ig * uval);
}
__global__ void k_lru_scan(const float* A0, const float* B0, const float* A1, const float* B1, float* YF, float* YB) {
    int g = blockIdx.x * 256 + threadIdx.x; int d = g / DM, ch = g % DM;
    if (d == 0) { float h = B0[ch];
        for (int t = 0; t < SEQ; ++t) { size_t o = (size_t)(CTX + t) * DM + ch; h = A0[o] * h + B0[o]; YF[(size_t)t * DM + ch] = h; }
    } else { float h = B1[(size_t)(CTX - 1) * DM + ch];
        for (int t = SEQ - 1; t >= 0; --t) { size_t o = (size_t)(CTX + t) * DM + ch; h = A1[o] * h + B1[o]; YB[(size_t)t * DM + ch] = h; }
    }
}
__global__ void k_yag_f(const float* YF, const float* YB, bf16* AY, int b) {
    int t = blockIdx.x;
    for (int ch = threadIdx.x; ch < DM; ch += 256) { size_t o = (size_t)t * DM + ch; bf16* p = AY + ((size_t)b * SEQ + t) * DM + ch;
        *p = (bf16)f2bf((YF[o] + YB[o]) * gelu_tanh(bf2f(*p))); }
}
#endif
#if !HG_FAST
__global__ __launch_bounds__(128) void k_hgrn_f(unsigned char* ws, const float* hg_lb) {
    __shared__ float gs[128], ks[128], qs[128];
    int h = blockIdx.x, d = blockIdx.y, b = blockIdx.z, j = threadIdx.x;
    float S[128];
#pragma unroll
    for (int i = 0; i < 128; ++i) S[i] = 0.f;
    const int c = h * 128 + j;
    const float lbj = 1.f / (1.f + expf(hg_lb[DM + c] - hg_lb[c]));
    bf16* Q = (bf16*)(ws + WS_P + 2 * GS); bf16* Fx = (bf16*)(ws + WS_P + (d == 0 ? 3 : 4) * GS); bf16* V = (bf16*)(ws + WS_P + 5 * GS);
    const bf16* Fc = (const bf16*)(ws + WS_PC + (d == 0 ? 1 : 2) * CGS); const bf16* Vc = (const bf16*)(ws + WS_PC + 3 * CGS);
    for (int s = 0; s < LT; ++s) {
        bool isx = s >= CTX; float fv, vv, qv = 0.f; size_t o;
        if (!isx) { int t = d == 0 ? s : (CTX - 1 - s); o = ((size_t)b * CTX + t) * DM + c; fv = bf2f(Fc[o]); vv = bf2f(Vc[o]); }
        else { int p = s - CTX; if (d == 1) p = SEQ - 1 - p; int tok = (p % 32) * 64 + (p / 32); o = ((size_t)b * SEQ + tok) * DM + c; fv = bf2f(Fx[o]); vv = bf2f(V[o]); qv = bf2f(Q[o]); }
        float gg = lbj + (1.f - lbj) / (1.f + expf(-fv));
        gs[j] = gg; ks[j] = 1.f - gg; qs[j] = qv / (1.f + expf(-qv));
        __syncthreads();
        float oo = 0.f;
#pragma unroll
        for (int i = 0; i < 128; ++i) { S[i] = gs[i] * S[i] + ks[i] * vv; oo += S[i] * qs[i]; }
        if (isx) Fx[o] = (bf16)f2bf(oo);
        __syncthreads();
    }
}
#endif

extern "C" void kernel_launch(void* const* d_in, const int* in_sizes, int n_in, void* d_out, int out_size, void* d_ws, size_t ws_size, hipStream_t stream) {
    static int grid = 0;
    if (grid == 0) {
        if (n_in != 29 || out_size != NTOK * DM || ws_size < WS_END) { fprintf(stderr, "kernel_launch: unexpected problem shape / workspace (%d inputs, out %d, ws %zu)\n", n_in, out_size, ws_size); grid = -1; return; }
        int dev = 0, cus = 0, per_cu = 0;
        if (hipGetDevice(&dev) != hipSuccess || hipDeviceGetAttribute(&cus, hipDeviceAttributeMultiprocessorCount, dev) != hipSuccess) { grid = -1; return; }
        if (hipFuncSetAttribute((const void*)mega, hipFuncAttributeMaxDynamicSharedMemorySize, LDS_BYTES) != hipSuccess) { grid = -1; return; }
        if (hipOccupancyMaxActiveBlocksPerMultiprocessor(&per_cu, (const void*)mega, NTHR, LDS_BYTES) != hipSuccess || per_cu < 1) { fprintf(stderr, "kernel_launch: occupancy query says %d blocks per CU\n", per_cu); }
        (void)hipGetLastError();
        grid = cus;
        if (grid != 256) { fprintf(stderr, "kernel_launch: built for 256 CUs, found %d\n", cus); grid = -1; return; }
    }
    if (grid < 0) return;
    hipMemsetAsync((char*)d_ws + WS_CTL, 0, CTL_BYTES, stream);
    Args a{};
    for (int i = 0; i < 29; ++i) a.in[i] = (const float*)d_in[i];
    a.out = (float*)d_out; a.ws = (unsigned char*)d_ws;
#if MIX_FAST
    a.ph_lo = 0; a.ph_hi = 12; a.li = 0;
    hipLaunchKernelGGL(mega, dim3(grid), dim3(NTHR), LDS_BYTES, stream, a);
#else
    a.ph_lo = 0; a.ph_hi = 5; a.li = 0;
    hipLaunchKernelGGL(mega, dim3(grid), dim3(NTHR), LDS_BYTES, stream, a);
    {
        unsigned char* ws = (unsigned char*)d_ws;
#if !LRU_FAST
        float* sc = (float*)d_out;
        float* Ub = sc; float* A0 = Ub + (size_t)LT * DM; float* B0 = A0 + (size_t)LT * DM; float* A1 = B0 + (size_t)LT * DM; float* B1 = A1 + (size_t)LT * DM;
        float* YF = B1 + (size_t)LT * DM; float* YB = YF + (size_t)SEQ * DM;
        const float* cw = (const float*)d_in[IN_CONVW]; const float* cb = (const float*)d_in[IN_CONVB];
        const float* wa = (const float*)d_in[IN_WA]; const float* ba = (const float*)d_in[IN_BA]; const float* wx = (const float*)d_in[IN_WX]; const float* bx = (const float*)d_in[IN_BX]; const float* lam = (const float*)d_in[IN_LAM];
        for (int b = 0; b < NB; ++b) {
            k_conv_f<<<LT, 256, 0, stream>>>((const bf16*)(ws + WS_P), (const bf16*)(ws + WS_PC), cw, cb, Ub, b);
            k_gates<<<dim3(LT, 8), 128, 0, stream>>>(Ub, wa, ba, wx, bx, lam, A0, B0, 0);
            k_gates<<<dim3(LT, 8), 128, 0, stream>>>(Ub, wa, ba, wx, bx, lam, A1, B1, 1);
            k_lru_scan<<<8, 256, 0, stream>>>(A0, B0, A1, B1, YF, YB);
            k_yag_f<<<SEQ, 256, 0, stream>>>(YF, YB, (bf16*)(ws + WS_YAG), b);
        }
#endif
#if !HG_FAST
        k_hgrn_f<<<dim3(8, 2, NB), 128, 0, stream>>>(ws, (const float*)d_in[IN_HGLB]);
#endif
    }
    a.ph_lo = 5; a.ph_hi = 12; a.li = 1;
    hipLaunchKernelGGL(mega, dim3(grid), dim3(NTHR), LDS_BYTES, stream, a);
#endif
}
```

```cpp
#include <hip/hip_runtime.h>
#include <cstdio>
#include <cstdint>
#include <math.h>

#define LAS __attribute__((address_space(3)))
#define GAS __attribute__((address_space(1)))
typedef unsigned short bf16;
typedef short bf16x8 __attribute__((ext_vector_type(8)));
typedef float f32x4 __attribute__((ext_vector_type(4)));
typedef float f32x2 __attribute__((ext_vector_type(2)));
typedef unsigned u32x4 __attribute__((ext_vector_type(4)));
typedef unsigned u32x2 __attribute__((ext_vector_type(2)));

constexpr int DM = 1024, NB = 8, SEQ = 2048, CTX = 256, NTOK = NB * SEQ, NCTX = NB * CTX, INW = 9216, LT = CTX + SEQ;
constexpr int NEXP = 32, DEXP = 512, CAP = 16384;
constexpr float EPS = 1e-6f;
constexpr int NWAVES = 8, NTHR = 512;

constexpr size_t MiB = 1u << 20, KiB = 1024;
constexpr size_t WS_CTL = 0, CTL_BYTES = 64 * KiB;
constexpr size_t WS_MODP = 256 * KiB;
constexpr size_t WS_MOD = 2 * MiB;
constexpr size_t WS_LRUAGG = 2 * MiB + 512 * KiB;
constexpr size_t WS_LRUS0 = 4 * MiB + 512 * KiB;
constexpr size_t WS_WT = 4 * MiB + 768 * KiB;
constexpr size_t WS_LIST = 5 * MiB;
constexpr size_t WS_HGD = 7 * MiB;
constexpr size_t WS_WRT = 7 * MiB + 256 * KiB;
constexpr size_t WS_WIN = 8 * MiB;
constexpr size_t WS_WPA = 26 * MiB, WS_WPB = 28 * MiB, WS_WOUT = 30 * MiB;
constexpr size_t WS_WLRU = 32 * MiB;
constexpr size_t WS_P = 33 * MiB, GS = 32 * MiB;
constexpr size_t WS_PC = 321 * MiB, CGS = 4 * MiB;
constexpr size_t WS_END = 337 * MiB;
constexpr size_t WS_W1T = WS_P + 0 * GS, WS_W3T = WS_P + 2 * GS, WS_W2T = WS_P + 5 * GS;
constexpr size_t WS_YAG = WS_P + 1 * GS;
constexpr size_t WS_OF = WS_P + 3 * GS, WS_OB = WS_P + 4 * GS;
constexpr size_t WS_YBG = WS_P + 3 * GS;
constexpr size_t WS_M = WS_P + 4 * GS;
constexpr size_t WS_HX2 = WS_P + 1 * GS;
constexpr size_t WS_HH = WS_P + 3 * GS;
constexpr size_t WS_Y = WS_P + 6 * GS;

constexpr int CW_BAR = 1024;
constexpr int CW_CNT = 12288;
constexpr int CW_TILE = 14336;

constexpr int RING_BYTES = 131072, LDS_BYTES = 147456, LDSCTL_OFF = LDS_BYTES - 1024;

#define LDS_WAIT() asm volatile("s_waitcnt lgkmcnt(0)" ::: "memory")
#define VM_WAIT() asm volatile("s_waitcnt vmcnt(0)" ::: "memory")

typedef __bf16 bf16x2_t __attribute__((ext_vector_type(2)));
__device__ __forceinline__ unsigned pk2(float lo, float hi) { const f32x2 v = {lo, hi}; return __builtin_bit_cast(unsigned, __builtin_convertvector(v, bf16x2_t)); }
__device__ __forceinline__ unsigned f2bf(float f) { return pk2(f, 0.f) & 0xffffu; }
__device__ __forceinline__ float bf2f(unsigned short b) { return __builtin_bit_cast(float, (unsigned)b << 16); }
__device__ __forceinline__ float bflo(unsigned w) { return __builtin_bit_cast(float, w << 16); }
__device__ __forceinline__ float bfhi(unsigned w) { return __builtin_bit_cast(float, w & 0xffff0000u); }
__device__ __forceinline__ float sigmoidf_(float x) { return 1.f / (1.f + __expf(-x)); }
__device__ __forceinline__ float siluf_(float x) { return x / (1.f + __expf(-x)); }
__device__ __forceinline__ float gelu_tanh(float x) { float u = 0.7978845608028654f * (x + 0.044715f * x * x * x); float e = __expf(2.f * u); return x * (1.f - 1.f / (1.f + e)); }
__device__ __forceinline__ float wave_sum(float v) {
#pragma unroll
    for (int o = 1; o < 64; o <<= 1) v += __shfl_xor(v, o);
    return v;
}

#define XB_TMO      128
#define XB_XCNT(j)  (256  + 64 * (j))
#define XB_XSUB(j)  (1280 + 64 * (j))
#define XB_XGEN(j)  (2304 + 64 * (j))
#define XB_TOP      3328
#define XB_TOPGEN   3392
#define XCD_BAR_WORDS 3456
#define XB_SPIN_CAP (1u << 20)
__device__ __forceinline__ unsigned xb_ld(unsigned* p)              { return __hip_atomic_load(p, __ATOMIC_RELAXED, __HIP_MEMORY_SCOPE_AGENT); }
__device__ __forceinline__ unsigned xb_add(unsigned* p, unsigned v) { return __hip_atomic_fetch_add(p, v, __ATOMIC_RELAXED, __HIP_MEMORY_SCOPE_AGENT); }
__device__ __forceinline__ unsigned xb_xcc_id() { return (unsigned)__builtin_amdgcn_s_getreg((3 << 11) | 20) & 0xFu; }
#define XB_SPIN(cond, bar) do { unsigned _sp = 0; while (cond) { __builtin_amdgcn_s_sleep(1); \
    if ((++_sp & 255u) == 0u) { if (xb_ld(&(bar)[XB_TMO])) break; if (_sp > XB_SPIN_CAP) { atomicAdd(&(bar)[XB_TMO], 1u); break; } } } } while (0)
struct XcdBarrier { unsigned* bar; unsigned x; volatile LAS unsigned* st; };
__device__ __forceinline__ XcdBarrier xcd_barrier_post(unsigned* bar, volatile LAS unsigned* st) {
    XcdBarrier b; b.bar = bar; b.x = xb_xcc_id(); b.st = st;
    if (threadIdx.x == 0) (void)xb_add(&bar[XB_XCNT(b.x)], 1u);
    return b;
}
__device__ __forceinline__ void xcd_barrier_complete(unsigned* bar, unsigned x, unsigned& nloc, unsigned& nx) {
    const unsigned G = gridDim.x * gridDim.y * gridDim.z;
    unsigned sum, cnt, mine, sp = 0u;
    for (;;) {
        sum = 0u; cnt = 0u; mine = 0u;
#pragma unroll
        for (unsigned j = 0; j < 16; ++j) { const unsigned c = xb_ld(&bar[XB_XCNT(j)]); sum += c; cnt += (c > 0u) ? 1u : 0u; mine = (j == x) ? c : mine; }
        if (sum == G) break;
        __builtin_amdgcn_s_sleep(1);
        if ((++sp & 255u) == 0u) { if (xb_ld(&bar[XB_TMO])) break; if (sp > XB_SPIN_CAP) { atomicAdd(&bar[XB_TMO], 1u); break; } }
    }
    nloc = mine > 0u ? mine : 1u; nx = cnt > 0u ? cnt : 1u;
}
__device__ __forceinline__ void xcd_barrier(const XcdBarrier& b) {
    asm volatile("s_waitcnt vmcnt(0)" ::: "memory");
    __syncthreads();
    if (threadIdx.x == 0) {
        unsigned* bar = b.bar;
        __builtin_amdgcn_s_waitcnt(0);
        unsigned nloc = b.st[0], nx = b.st[1];
        if (nloc == 0u) { xcd_barrier_complete(bar, b.x, nloc, nx); b.st[0] = nloc; b.st[1] = nx; }
        const unsigned old = xb_add(&bar[XB_XSUB(b.x)], 1u);
        const unsigned gen = old / nloc;
        if (old + 1u == (gen + 1u) * nloc) {
            __builtin_amdgcn_fence(__ATOMIC_RELEASE, "agent");
            asm volatile("s_waitcnt vmcnt(0)" ::: "memory");
            const unsigned og = xb_add(&bar[XB_TOP], 1u);
            const unsigned tg = og / nx;
            if (og + 1u == (tg + 1u) * nx) xb_add(&bar[XB_TOPGEN], 1u);
            else XB_SPIN(xb_ld(&bar[XB_TOPGEN]) == tg, bar);
            __builtin_amdgcn_fence(__ATOMIC_ACQUIRE, "agent");
            xb_add(&bar[XB_XGEN(b.x)], 1u);
            asm volatile("s_waitcnt vmcnt(0)" ::: "memory");
        } else {
            XB_SPIN(xb_ld(&bar[XB_XGEN(b.x)]) == gen, bar);
            __builtin_amdgcn_fence(__ATOMIC_ACQUIRE, "agent");
            asm volatile("s_waitcnt vmcnt(0)" ::: "memory");
        }
    }
    __syncthreads();
}

namespace gm {
constexpr int BM = 256, BK = 64, HALF = 128, HTB = HALF * BK * 2;
__device__ __forceinline__ int lds_byte(int r, int c) { const int st = (r >> 4) * 2 + (c >> 5), rr = r & 15, cc = c & 31, ob = rr * 64 + cc * 2; return st * 1024 + (ob ^ (((ob >> 9) & 1) << 5)); }
__device__ __forceinline__ void stage_rc(int b, int& R, int& C) { const int st = b / 1024, sb = b % 1024, swz = sb ^ (((sb >> 9) & 1) << 5); R = (st >> 1) * 16 + swz / 64; C = (st & 1) * 32 + (swz % 64) / 2; }
__device__ __forceinline__ int perm32(int rho) { const int n = rho >> 4, i = rho & 15; return 8 * (i >> 2) + 4 * n + (i & 3); }
__device__ __forceinline__ unsigned cvt_pk_bf16(float lo, float hi) { unsigned r; asm volatile("v_cvt_pk_bf16_f32 %0, %1, %2" : "=v"(r) : "v"(lo), "v"(hi)); return r; }

struct Unit { const char* A; const char* B0; const char* B1; char* dst; int pm, pn, e, rows, t; };

template <class Sched, class Epi, bool GATHER, bool HOOKS = false>
__device__ __forceinline__ void gemm_phase(LAS unsigned char* lds, const int K, const Sched& S, const Epi& E) {
    const int tid = threadIdx.x, wid = __builtin_amdgcn_readfirstlane(tid >> 6), lane = tid & 63, wr = wid >> 2, wc = wid & 3, fr = lane & 15, fq = lane >> 4;
    const int nt = K / BK;
    unsigned voffB[2]; int Rr[2]; unsigned Cb[2];
#pragma unroll
    for (int i = 0; i < 2; ++i) { int R, C; stage_rc(tid * 16 + i * 8192, R, C); const int Rb = Epi::PERM ? ((R & ~31) + perm32(R & 31)) : R;
        Rr[i] = R; Cb[i] = (unsigned)C * 2u; voffB[i] = (unsigned)(Rb * K + C) * 2u; }
    const unsigned rowb = (unsigned)K * 2u;
    const size_t kstep = (size_t)(BK * 2);
    const unsigned ldsw = (unsigned)wid * 1024u;
    const int aoff = lds_byte(wr * 64 + fr, fq * 8), boff = lds_byte(wc * 32 + fr, fq * 8);
#define GM_SA(b, h) (((b) * 2 + (h)) * HTB)
#define GM_SB(b, h) ((4 + (b) * 2 + (h)) * HTB)
#define GM_STAGE(bufoff, gbase, voff) do { _Pragma("unroll") for (int _i = 0; _i < 2; ++_i) \
        __builtin_amdgcn_global_load_lds((const unsigned*)((const char*)(gbase) + (voff)[_i]), (LAS unsigned*)(lds + (bufoff) + ldsw + _i * 8192), 16, 0, 0); } while (0)
#define GM_LDA(dst, b, h) do { _Pragma("unroll") for (int m = 0; m < 4; ++m) _Pragma("unroll") for (int k = 0; k < 2; ++k) dst[m][k] = *(const LAS bf16x8*)(lds + GM_SA(b, h) + aoff + m * 2048 + k * 1024); } while (0)
#define GM_LDB(dst, b, h) do { _Pragma("unroll") for (int n = 0; n < 2; ++n) _Pragma("unroll") for (int k = 0; k < 2; ++k) dst[n][k] = *(const LAS bf16x8*)(lds + GM_SB(b, h) + boff + n * 2048 + k * 1024); } while (0)
#define GM_MMA(ai, bj, At, Bt) do { __builtin_amdgcn_s_setprio(1); _Pragma("unroll") for (int m = 0; m < 4; ++m) _Pragma("unroll") for (int n = 0; n < 2; ++n) _Pragma("unroll") for (int k = 0; k < 2; ++k) \
        acc[ai][bj][m][n] = __builtin_amdgcn_mfma_f32_16x16x32_bf16(Bt[n][k], At[m][k], acc[ai][bj][m][n], 0, 0, 0); __builtin_amdgcn_s_setprio(0); } while (0)
#define GM_WAIT_V(n) asm volatile("s_waitcnt vmcnt(" #n ")" ::: "memory")
#define GM_WAIT_L(n) asm volatile("s_waitcnt lgkmcnt(" #n ")" ::: "memory")
#define GM_BAR __builtin_amdgcn_s_barrier()
#define GM_SCHED __builtin_amdgcn_sched_barrier(0)
#define GM_AOFFS(u, o) do { _Pragma("unroll") for (int _h = 0; _h < 2; ++_h) _Pragma("unroll") for (int _i = 0; _i < 2; ++_i) \
        (o)[_h][_i] = (GATHER ? S.arow((u), _h * HALF + Rr[_i]) : (unsigned)(_h * HALF + Rr[_i])) * rowb + Cb[_i]; } while (0)
    Unit cur, nxt; int ui = 0;
    if (!S.next(0, cur)) return;
    f32x4 acc[2][2][4][2];
#pragma unroll
    for (int a = 0; a < 2; ++a)
#pragma unroll
        for (int b = 0; b < 2; ++b)
#pragma unroll
            for (int m = 0; m < 4; ++m)
#pragma unroll
                for (int n = 0; n < 2; ++n) acc[a][b][m][n] = (f32x4){0.f, 0.f, 0.f, 0.f};
    bf16x8 At[4][2], B0[2][2], B1[2][2];
    unsigned ca[2][2], na[2][2];
    GM_AOFFS(cur, ca);
    const char* cA = cur.A; const char* cB0 = cur.B0; const char* cB1 = cur.B1;
    if constexpr (HOOKS) S.a_ready(cur);
    GM_STAGE(GM_SB(0, 0), cB0, voffB); GM_STAGE(GM_SB(0, 1), cB1, voffB); GM_STAGE(GM_SA(0, 0), cA, ca[0]); GM_STAGE(GM_SA(0, 1), cA, ca[1]);
    if (wr == 1) GM_BAR;
    GM_WAIT_V(2); GM_BAR;
    GM_STAGE(GM_SB(1, 0), cB0 + kstep, voffB); GM_STAGE(GM_SA(1, 0), cA + kstep, ca[0]); GM_STAGE(GM_SB(1, 1), cB1 + kstep, voffB);
    GM_WAIT_V(6); GM_BAR;
    for (;;) {
        const bool has_next = S.next(ui + 1, nxt);
        const char* nA = has_next ? nxt.A : cA; const char* nB0 = has_next ? nxt.B0 : cB0; const char* nB1 = has_next ? nxt.B1 : cB1;
        if (has_next) { GM_AOFFS(nxt, na); } else {
#pragma unroll
            for (int h = 0; h < 2; ++h)
#pragma unroll
                for (int i = 0; i < 2; ++i) na[h][i] = ca[h][i]; }
        for (int t = 0; t < nt; t += 2) {
            const bool last = (t == nt - 2);
            if constexpr (HOOKS) { if (last && has_next) S.a_ready(nxt); }
            const char* a1 = cA + (size_t)(t + 1) * kstep;
            const char* a2 = last ? nA : cA + (size_t)(t + 2) * kstep;
            const char* b20 = last ? nB0 : cB0 + (size_t)(t + 2) * kstep; const char* b21 = last ? nB1 : cB1 + (size_t)(t + 2) * kstep;
            const char* a3 = a2 + kstep; const char* b30 = b20 + kstep; const char* b31 = b21 + kstep;
            unsigned o2[2][2];
#pragma unroll
            for (int h = 0; h < 2; ++h)
#pragma unroll
                for (int i = 0; i < 2; ++i) o2[h][i] = last ? na[h][i] : ca[h][i];
            GM_LDB(B0, 0, 0); GM_LDB(B1, 0, 1); GM_SCHED; GM_LDA(At, 0, 0); GM_STAGE(GM_SA(1, 1), a1, ca[1]);
            GM_WAIT_V(8); GM_WAIT_L(0); GM_BAR; GM_MMA(0, 0, At, B0); GM_MMA(0, 1, At, B1); GM_BAR; GM_SCHED;
            GM_LDA(At, 0, 1); GM_STAGE(GM_SB(0, 0), b20, voffB); GM_STAGE(GM_SB(0, 1), b21, voffB); GM_STAGE(GM_SA(0, 0), a2, o2[0]);
            GM_WAIT_V(8); GM_WAIT_L(0); GM_BAR; GM_MMA(1, 0, At, B0); GM_MMA(1, 1, At, B1); GM_BAR; GM_SCHED;
            GM_LDB(B0, 1, 0); GM_LDB(B1, 1, 1); GM_SCHED; GM_LDA(At, 1, 0); GM_STAGE(GM_SA(0, 1), a2, o2[1]);
            GM_WAIT_V(8); GM_WAIT_L(0); GM_BAR; GM_MMA(0, 0, At, B0); GM_MMA(0, 1, At, B1); GM_BAR; GM_SCHED;
            GM_LDA(At, 1, 1); GM_STAGE(GM_SB(1, 0), b30, voffB); GM_STAGE(GM_SB(1, 1), b31, voffB); GM_STAGE(GM_SA(1, 0), a3, o2[0]);
            GM_WAIT_V(8); GM_WAIT_L(0); GM_BAR; GM_MMA(1, 0, At, B0); GM_MMA(1, 1, At, B1); GM_BAR; GM_SCHED;
        }
        if (wr == 0) GM_BAR;
        E(acc, cur, wr, wc, fr, fq);
        if constexpr (HOOKS) S.done(cur);
        if (!has_next) break;
#pragma unroll
        for (int a = 0; a < 2; ++a)
#pragma unroll
            for (int b = 0; b < 2; ++b)
#pragma unroll
                for (int m = 0; m < 4; ++m)
#pragma unroll
                    for (int n = 0; n < 2; ++n) acc[a][b][m][n] = (f32x4){0.f, 0.f, 0.f, 0.f};
        cur = nxt; cA = nA; cB0 = nB0; cB1 = nB1; ++ui;
#pragma unroll
        for (int h = 0; h < 2; ++h)
#pragma unroll
            for (int i = 0; i < 2; ++i) ca[h][i] = na[h][i];
        if (wr == 1) GM_BAR;
    }
    GM_WAIT_V(0);
    GM_BAR;
#undef GM_SA
#undef GM_SB
#undef GM_STAGE
#undef GM_LDA
#undef GM_LDB
#undef GM_MMA
#undef GM_WAIT_V
#undef GM_WAIT_L
#undef GM_BAR
#undef GM_SCHED
#undef GM_AOFFS
}
}
struct Args {
    const float* in[29]; float* out; unsigned char* ws; int ph_lo, ph_hi, li, pad;
};
struct Frame {
    LAS unsigned char* lds; volatile LAS unsigned* MISC;
    unsigned* ctl; unsigned char* ws; float* out;
    int tid, lane, wave, G, bid;
};
enum { IN_X = 0, IN_C, IN_CTX, IN_CCTX, IN_WMOD, IN_BMOD, IN_G1, IN_WIN, IN_CONVW, IN_CONVB, IN_WA, IN_BA, IN_WX, IN_BX, IN_LAM, IN_HGLB, IN_HGN,
       IN_WPA, IN_WPB, IN_WOUT, IN_G2, IN_WRG, IN_BRG, IN_WRE, IN_BRE, IN_W1, IN_W3, IN_W2, IN_FG };

constexpr int TR_BYTES = 64 * 64 * 4;
__device__ __forceinline__ void transpose_item(const float* W, int ldw, int K, bf16* WT, int k0, int n0, LAS float* scr, int lane) {
    const int lr = lane >> 4, ls = lane & 15;
    f32x4 v[16];
#pragma unroll
    for (int i = 0; i < 16; ++i) v[i] = *(const f32x4*)(W + (size_t)(k0 + 4 * i + lr) * ldw + n0 + 4 * ls);
#pragma unroll
    for (int i = 0; i < 16; ++i) { const int k = 4 * i + lr; *(LAS f32x4*)(scr + k * 64 + ((ls ^ ((k >> 3) & 7)) << 2)) = v[i]; }
    LDS_WAIT(); asm volatile("" ::: "memory");
    const int c = lane & 7;
#pragma unroll
    for (int j = 0; j < 8; ++j) { const int n = (lane >> 3) + 8 * j; const LAS float* s = scr + (8 * c) * 64 + ((((n >> 2) ^ c) << 2) | (n & 3));
        u32x4 o; o.x = pk2(s[0 * 64], s[1 * 64]); o.y = pk2(s[2 * 64], s[3 * 64]); o.z = pk2(s[4 * 64], s[5 * 64]); o.w = pk2(s[6 * 64], s[7 * 64]);
        *(u32x4*)(WT + (size_t)n * K + k0 + 8 * c) = o; }
    LDS_WAIT(); asm volatile("" ::: "memory");
}

__device__ __forceinline__ void p0_mod_item(Frame& F, const Args& a, int item) {
    const int cb = item % 24, ks = item / 24;
    LAS float* sv = (LAS float*)F.lds;
    LAS float* red = sv + 9 * 128;
    const float* c = a.in[IN_C]; const float* cc = a.in[IN_CCTX]; const float* wmod = a.in[IN_WMOD];
    for (int i = F.tid; i < 9 * 128; i += NTHR) { const int r = i >> 7, k = i & 127; const float v = r < 8 ? c[r * DM + ks * 128 + k] : cc[ks * 128 + k]; sv[i] = siluf_(v); }
    __syncthreads();
    const int col = cb * 256 + (F.tid & 255), kh = F.tid >> 8;
    float acc[9];
#pragma unroll
    for (int r = 0; r < 9; ++r) acc[r] = 0.f;
    for (int k0 = 0; k0 < 64; k0 += 16) { float wv[16];
#pragma unroll
        for (int k = 0; k < 16; ++k) wv[k] = wmod[(size_t)(ks * 128 + kh * 64 + k0 + k) * 6144 + col];
#pragma unroll
        for (int k = 0; k < 16; ++k) { const int kk = kh * 64 + k0 + k;
#pragma unroll
            for (int r = 0; r < 9; ++r) acc[r] += sv[r * 128 + kk] * wv[k]; } }
    if (kh == 1) {
#pragma unroll
        for (int r = 0; r < 9; ++r) red[r * 256 + (F.tid & 255)] = acc[r]; }
    __syncthreads();
    float* modp = (float*)(F.ws + WS_MODP);
    if (kh == 0) {
#pragma unroll
        for (int r = 0; r < 9; ++r) modp[(size_t)(ks * 9 + r) * 6144 + col] = acc[r] + red[r * 256 + F.tid]; }
    __syncthreads();
}
__device__ __forceinline__ float mod_from_partials(const float* modp, const float* bmod, int row, int j) {
    float s = bmod[j];
#pragma unroll
    for (int ks = 0; ks < 8; ++ks) s += modp[(size_t)(ks * 9 + row) * 6144 + j];
    return s;
}

__device__ __forceinline__ void p0_prologue(Frame& F, const Args& a) {
    if (F.bid < 192) p0_mod_item(F, a, F.bid);
    LAS float* scr = (LAS float*)(F.lds + F.wave * TR_BYTES);
    const int gw = F.bid * NWAVES + F.wave, NGW = F.G * NWAVES;
    constexpr int I_IN = 16 * 144, I_PR = 16 * 16, I_LRU = 32 * 4;
    constexpr int NITEMS = I_IN + 3 * I_PR + I_LRU;
    for (int it = gw; it < NITEMS; it += NGW) {
        int r = it;
        if (r < I_IN) { const int kb = r / 144, nb = r % 144; transpose_item(a.in[IN_WIN], INW, DM, (bf16*)(F.ws + WS_WIN) + (size_t)(nb * 64) * DM, kb * 64, nb * 64, scr, F.lane); continue; } r -= I_IN;
        if (r < 3 * I_PR) { const int w = r / I_PR, q = r % I_PR, kb = q / 16, nb = q % 16;
            const float* W = a.in[w == 0 ? IN_WPA : (w == 1 ? IN_WPB : IN_WOUT)]; bf16* WT = (bf16*)(F.ws + (w == 0 ? WS_WPA : (w == 1 ? WS_WPB : WS_WOUT)));
            transpose_item(W, DM, DM, WT + (size_t)(nb * 64) * DM, kb * 64, nb * 64, scr, F.lane); continue; } r -= 3 * I_PR;
        { const int mat = r / 4, q = r % 4, kb = q / 2, nb = q % 2;
          const int which = mat >> 4, dh = mat & 15;
          const float* W = a.in[which == 0 ? IN_WA : IN_WX] + (size_t)dh * 128 * 128; bf16* WT = (bf16*)(F.ws + WS_WLRU) + (size_t)mat * 128 * 128;
          transpose_item(W, 128, 128, WT + (size_t)(nb * 64) * 128, kb * 64, nb * 64, scr, F.lane); }
    }
    float* wrp = (float*)(F.ws + WS_WRT);
    for (int i = F.bid * NTHR + F.tid; i < 49152 + 48; i += F.G * NTHR) {
        if (i < 49152) { const int j = i & 3, ln = (i >> 2) & 63, sc = i >> 8, c = sc % 3, s2 = sc / 3; const int k = 16 * s2 + 4 * (ln >> 4) + j, o = 16 * c + (ln & 15);
            wrp[i] = o < 4 ? a.in[IN_WRG][k * 4 + o] : (o < 36 ? a.in[IN_WRE][k * 32 + (o - 4)] : 0.f); }
        else { const int o = i - 49152; wrp[i] = o < 4 ? a.in[IN_BRG][o] : (o < 36 ? a.in[IN_BRE][o - 4] : 0.f); }
    }
}

__device__ __forceinline__ void norm_rows(Frame& F, const float* src, bf16* dst, int row0, int nrows, const LAS float* gs, const LAS float* sh) {
    for (int r = F.wave; r < nrows; r += 2 * NWAVES) {
        const int r1 = r + NWAVES < nrows ? r + NWAVES : r;
        const f32x4* xa = (const f32x4*)(src + (size_t)(row0 + r) * DM) + F.lane; const f32x4* xb = (const f32x4*)(src + (size_t)(row0 + r1) * DM) + F.lane;
        f32x4 va[4], vb[4]; float sa = 0.f, sb = 0.f;
#pragma unroll
        for (int j = 0; j < 4; ++j) { va[j] = xa[64 * j]; vb[j] = xb[64 * j]; }
#pragma unroll
        for (int j = 0; j < 4; ++j) { sa += (va[j].x * va[j].x + va[j].y * va[j].y) + (va[j].z * va[j].z + va[j].w * va[j].w); sb += (vb[j].x * vb[j].x + vb[j].y * vb[j].y) + (vb[j].z * vb[j].z + vb[j].w * vb[j].w); }
        const float ra = rsqrtf(wave_sum(sa) * (1.f / DM) + EPS), rb = rsqrtf(wave_sum(sb) * (1.f / DM) + EPS);
        unsigned long long* oa = (unsigned long long*)(dst + (size_t)(row0 + r) * DM) + F.lane; unsigned long long* ob = (unsigned long long*)(dst + (size_t)(row0 + r1) * DM) + F.lane;
#pragma unroll
        for (int j = 0; j < 4; ++j) { const int k = 4 * F.lane + 256 * j;
            const f32x4 g = *(const LAS f32x4*)(gs + k), h = *(const LAS f32x4*)(sh + k);
            oa[64 * j] = (unsigned long long)pk2(va[j].x * ra * g.x + h.x, va[j].y * ra * g.y + h.y) | ((unsigned long long)pk2(va[j].z * ra * g.z + h.z, va[j].w * ra * g.w + h.w) << 32);
            ob[64 * j] = (unsigned long long)pk2(vb[j].x * rb * g.x + h.x, vb[j].y * rb * g.y + h.y) | ((unsigned long long)pk2(vb[j].z * rb * g.z + h.z, vb[j].w * rb * g.w + h.w) << 32); }
    }
}
__device__ __forceinline__ void p1_norm(Frame& F, const Args& a) {
    const float* modp = (const float*)(F.ws + WS_MODP); const float* bmod = a.in[IN_BMOD]; const float* g1 = a.in[IN_G1];
    LAS float* gs = (LAS float*)F.lds; LAS float* sh = gs + DM;
    bf16* H = (bf16*)F.out;
    float* mod = (float*)(F.ws + WS_MOD);
    for (int i = F.bid * NTHR + F.tid; i < 9 * 6144; i += F.G * NTHR) mod[i] = mod_from_partials(modp, bmod, i / 6144, i % 6144);
    const int b = F.bid / 32;
    for (int k = F.tid; k < DM; k += NTHR) { gs[k] = g1[k] * (1.f + mod_from_partials(modp, bmod, b, DM + k)); sh[k] = mod_from_partials(modp, bmod, b, k); }
    __syncthreads();
    norm_rows(F, a.in[IN_X], H, F.bid * 64, 64, gs, sh);
    __syncthreads();
    for (int k = F.tid; k < DM; k += NTHR) { gs[k] = g1[k] * (1.f + mod_from_partials(modp, bmod, 8, DM + k)); sh[k] = mod_from_partials(modp, bmod, 8, k); }
    __syncthreads();
    norm_rows(F, a.in[IN_CTX], H + (size_t)NTOK * DM, F.bid * 8, 8, gs, sh);
    __syncthreads();
}

struct EpiStoreBf16 {
    static constexpr bool PERM = true;
    __device__ __forceinline__ void operator()(const f32x4 (&acc)[2][2][4][2], const gm::Unit& u, int wr, int wc, int fr, int fq) const {
        bf16* base = (bf16*)u.dst + (size_t)(wr * 64 + fr) * DM + wc * 32 + 8 * fq;
#pragma unroll
        for (int ai = 0; ai < 2; ++ai)
#pragma unroll
            for (int m = 0; m < 4; ++m) { bf16* rowp = base + (size_t)(ai * 128 + m * 16) * DM;
#pragma unroll
                for (int bj = 0; bj < 2; ++bj) { const f32x4 v0 = acc[ai][bj][m][0], v1 = acc[ai][bj][m][1];
                    u32x4 w; w.x = gm::cvt_pk_bf16(v0[0], v0[1]); w.y = gm::cvt_pk_bf16(v0[2], v0[3]); w.z = gm::cvt_pk_bf16(v1[0], v1[1]); w.w = gm::cvt_pk_bf16(v1[2], v1[3]);
                    *(u32x4*)(rowp + bj * 128) = w; } }
    }
};
__device__ __forceinline__ void tile_order(int L, int nM, int nN, int& pm, int& pn) {
    const int nwg = nM * nN; int wgid = L;
    { const int q = nwg / 8, r = nwg % 8, xcd = wgid % 8, off = wgid / 8; wgid = (xcd < r ? xcd * (q + 1) : r * (q + 1) + (xcd - r) * q) + off; }
    const int nig = 8 * nN, gid = wgid / nig, fm = gid * 8, gsz = (nM - fm) < 8 ? (nM - fm) : 8;
    pm = fm + ((wgid % nig) % gsz); pn = (wgid % nig) / gsz;
}
struct SchedP2 {
    int G, c; const char* H; const char* Wt; char* P; char* PC;
    __device__ __forceinline__ bool next(int i, gm::Unit& u) const {
        int L = i * G + c;
        if (L < 64 * 36) { int pm, pn; tile_order(L, 64, 36, pm, pn);
            u.A = H + (size_t)pm * 256 * 2048; u.B0 = Wt + (size_t)pn * 256 * 2048; u.B1 = u.B0 + (size_t)128 * 2048;
            u.dst = P + (size_t)(pn >> 2) * GS + ((size_t)pm * 256 * DM + (pn & 3) * 256) * 2; u.pm = pm; u.pn = pn; u.e = 0; u.rows = 256; return true; }
        L -= 64 * 36; if (L >= 128) return false;
        const int pmc = L >> 4, j = L & 15, slot = j >> 2, g = slot == 0 ? 0 : slot + 2, pn = g * 4 + (j & 3);
        u.A = H + (size_t)(NTOK + pmc * 256) * 2048; u.B0 = Wt + (size_t)pn * 256 * 2048; u.B1 = u.B0 + (size_t)128 * 2048;
        u.dst = PC + (size_t)slot * CGS + ((size_t)pmc * 256 * DM + (j & 3) * 256) * 2; u.pm = pmc; u.pn = pn; u.e = 0; u.rows = 256; return true;
    }
    __device__ __forceinline__ unsigned arow(const gm::Unit&, int r) const { return (unsigned)r; }
};
constexpr int LRU_T = 128, LRU_NCH = SEQ / LRU_T, UF_LD = 144;
constexpr int LRU_UBF = 0, LRU_UF = 144 * 256;
constexpr float LOG2E = 1.4426950408889634f;

struct LruCoef { float ba, bx, ca; };

struct LruConvW { float w[4][8], bs[8]; };
__device__ __forceinline__ void lru_conv_weights(Frame& F, const Args& a, int h, LruConvW& cwv) {
    const float* cw = a.in[IN_CONVW] + h * 128; const float* cb = a.in[IN_CONVB] + h * 128; const int cg = F.tid & 15;
#pragma unroll
    for (int k = 0; k < 4; ++k) { const f32x4 w0 = *(const f32x4*)(cw + k * DM + 8 * cg), w1 = *(const f32x4*)(cw + k * DM + 8 * cg + 4);
        cwv.w[k][0] = w0.x; cwv.w[k][1] = w0.y; cwv.w[k][2] = w0.z; cwv.w[k][3] = w0.w; cwv.w[k][4] = w1.x; cwv.w[k][5] = w1.y; cwv.w[k][6] = w1.z; cwv.w[k][7] = w1.w; }
    { const f32x4 b0 = *(const f32x4*)(cb + 8 * cg), b1 = *(const f32x4*)(cb + 8 * cg + 4); cwv.bs[0] = b0.x; cwv.bs[1] = b0.y; cwv.bs[2] = b0.z; cwv.bs[3] = b0.w; cwv.bs[4] = b1.x; cwv.bs[5] = b1.y; cwv.bs[6] = b1.z; cwv.bs[7] = b1.w; }
}
__device__ __forceinline__ void lru_conv_load(Frame& F, int b, int h, int c, u32x4 (&raw)[4][4]) {
    const bf16* AX = (const bf16*)(F.ws + WS_P) + (size_t)b * SEQ * DM + h * 128;
    int cg = F.tid & 15, tl0 = F.tid >> 4;
    asm volatile("" : "+v"(cg), "+v"(tl0));
#pragma unroll
    for (int i = 0; i < 4; ++i)
#pragma unroll
        for (int k = 0; k < 4; ++k) { int tt = c * LRU_T + tl0 + 32 * i + k - 2; tt = tt < 0 ? 0 : (tt > SEQ - 1 ? SEQ - 1 : tt); raw[i][k] = *(const u32x4*)(AX + (size_t)tt * DM + 8 * cg); }
}
__device__ __forceinline__ void lru_conv(Frame& F, const LruConvW& cwv, const u32x4 (&raw)[4][4], int b, int h, int c, bool special) {
    LAS unsigned char* ubf = F.lds + LRU_UBF; LAS float* uf = (LAS float*)(F.lds + LRU_UF);
    int cg = F.tid & 15, tl0 = F.tid >> 4;
    asm volatile("" : "+v"(cg), "+v"(tl0));
    const float (&w)[4][8] = cwv.w; const float (&bs)[8] = cwv.bs;
#pragma unroll
    for (int i = 0; i < 4; ++i) { const int tl = tl0 + 32 * i;
        float u[8];
#pragma unroll
        for (int q = 0; q < 8; ++q) u[q] = bs[q];
#pragma unroll
        for (int k = 0; k < 4; ++k) { const int tt = c * LRU_T + tl + k - 2; const float mk = (tt >= 0 && tt < SEQ) ? 1.f : 0.f; const u32x4 v = raw[i][k];
            u[0] += mk * w[k][0] * bflo(v.x); u[1] += mk * w[k][1] * bfhi(v.x); u[2] += mk * w[k][2] * bflo(v.y); u[3] += mk * w[k][3] * bfhi(v.y);
            u[4] += mk * w[k][4] * bflo(v.z); u[5] += mk * w[k][5] * bfhi(v.z); u[6] += mk * w[k][6] * bflo(v.w); u[7] += mk * w[k][7] * bfhi(v.w); }
        *(LAS f32x4*)(uf + tl * UF_LD + 8 * cg) = (f32x4){u[0], u[1], u[2], u[3]};
        *(LAS f32x4*)(uf + tl * UF_LD + 8 * cg + 4) = (f32x4){u[4], u[5], u[6], u[7]};
        u32x4 p; p.x = pk2(u[0], u[1]); p.y = pk2(u[2], u[3]); p.z = pk2(u[4], u[5]); p.w = pk2(u[6], u[7]);
        *(LAS u32x4*)(ubf + tl * 256 + ((cg ^ (tl & 15)) << 4)) = p; }
    if (special) {
        const bf16* AC = (const bf16*)(F.ws + WS_PC) + (size_t)b * CTX * DM + h * 128;
        if (F.tid < 32) { const int tl = LRU_T + (F.tid >> 4); const int t = tl == LRU_T ? 0 : CTX - 1;
            float u[8];
#pragma unroll
            for (int q = 0; q < 8; ++q) u[q] = bs[q];
#pragma unroll
            for (int k = 0; k < 4; ++k) { const int tt = t + k - 2;
                if (tt >= 0 && tt < CTX) { const u32x4 v = *(const u32x4*)(AC + (size_t)tt * DM + 8 * cg);
                    u[0] += w[k][0] * bflo(v.x); u[1] += w[k][1] * bfhi(v.x); u[2] += w[k][2] * bflo(v.y); u[3] += w[k][3] * bfhi(v.y);
                    u[4] += w[k][4] * bflo(v.z); u[5] += w[k][5] * bfhi(v.z); u[6] += w[k][6] * bflo(v.w); u[7] += w[k][7] * bfhi(v.w); } }
            *(LAS f32x4*)(uf + tl * UF_LD + 8 * cg) = (f32x4){u[0], u[1], u[2], u[3]};
            *(LAS f32x4*)(uf + tl * UF_LD + 8 * cg + 4) = (f32x4){u[4], u[5], u[6], u[7]};
            u32x4 p; p.x = pk2(u[0], u[1]); p.y = pk2(u[2], u[3]); p.z = pk2(u[4], u[5]); p.w = pk2(u[6], u[7]);
            *(LAS u32x4*)(ubf + tl * 256 + ((cg ^ (tl & 15)) << 4)) = p;
        } else if (F.tid < 32 + 14 * 16) { const int tl = LRU_T + 2 + ((F.tid - 32) >> 4);
            *(LAS u32x4*)(ubf + tl * 256 + ((cg ^ (tl & 15)) << 4)) = (u32x4){0u, 0u, 0u, 0u}; }
    }
}
__device__ __forceinline__ void lru_load_w(Frame& F, int d, int h, bf16x8 (&Bw)[2][4]) {
    const int fr = F.lane & 15, fq = F.lane >> 4;
#pragma unroll
    for (int which = 0; which < 2; ++which) { const bf16* W = (const bf16*)(F.ws + WS_WLRU) + (size_t)(which * 16 + d * 8 + h) * 128 * 128 + (size_t)(16 * F.wave + fr) * 128 + 8 * fq;
#pragma unroll
        for (int kk = 0; kk < 4; ++kk) Bw[which][kk] = *(const bf16x8*)(W + kk * 32); }
}
__device__ __forceinline__ LruCoef lru_coef(const Args& a, int d, int ch) {
    LruCoef k; k.ba = -LOG2E * a.in[IN_BA][d * DM + ch]; k.bx = -LOG2E * a.in[IN_BX][d * DM + ch];
    const float sp = log1pf(expf(-a.in[IN_LAM][d * DM + ch])); k.ca = -8.f * sp * LOG2E; return k;
}
template <int V = 0> __device__ __forceinline__ void lru_tile(Frame& F, int m, const bf16x8 (&Bw)[2][4], const LruCoef& k, float (&av)[4], float (&bv)[4]) {
    const int fr = F.lane & 15, fq = F.lane >> 4;
    const LAS unsigned char* ubf = F.lds + LRU_UBF; const LAS float* uf = (const LAS float*)(F.lds + LRU_UF);
    f32x4 ar = {0.f, 0.f, 0.f, 0.f}, ai = {0.f, 0.f, 0.f, 0.f};
    const int row = m * 16 + fr;
#pragma unroll
    for (int kk = 0; kk < 4; ++kk) { const bf16x8 A = *(const LAS bf16x8*)(ubf + row * 256 + (((kk * 4 + fq) ^ fr) << 4));
        ar = __builtin_amdgcn_mfma_f32_16x16x32_bf16(A, Bw[0][kk], ar, 0, 0, 0); ai = __builtin_amdgcn_mfma_f32_16x16x32_bf16(A, Bw[1][kk], ai, 0, 0, 0); }
#pragma unroll
    for (int r = 0; r < 4; ++r) { const float u = uf[(m * 16 + 4 * fq + r) * UF_LD + 16 * F.wave + fr];
        if (V == 2) { av[r] = __builtin_fmaf(ar[r], -LOG2E, k.ba) * k.ca; bv[r] = __builtin_fmaf(ai[r], -LOG2E, k.bx) * u; continue; }
        const float rg = __builtin_amdgcn_rcpf(1.f + __builtin_amdgcn_exp2f(__builtin_fmaf(ar[r], -LOG2E, k.ba)));
        const float ig = __builtin_amdgcn_rcpf(1.f + __builtin_amdgcn_exp2f(__builtin_fmaf(ai[r], -LOG2E, k.bx)));
        const float aa = __builtin_amdgcn_exp2f(k.ca * rg);
        av[r] = aa; bv[r] = __builtin_amdgcn_sqrtf(__builtin_fmaf(-aa, aa, 1.f)) * (ig * u); }
}
template <bool FWD, int V = 0> __device__ __forceinline__ void lru_tile_total(int fq, float& A, float& B) {
    if (V == 1) return;
#pragma unroll
    for (int s = 0; s < 2; ++s) { const int bit = 1 << s; const float Ap = __shfl_xor(A, 16 << s), Bp = __shfl_xor(B, 16 << s);
        const bool mine_first = FWD ? ((fq & bit) == 0) : ((fq & bit) != 0);
        if (mine_first) { B = B * Ap + Bp; A = A * Ap; } else { B = Bp * A + B; A = Ap * A; } }
}

template <int V = 0> __device__ __forceinline__ void lru_phase1(Frame& F, const Args& a, float* agg_base) {
    const int NU = NB * 8 * LRU_NCH;
    if (F.bid >= NU) return;
    const int fr = F.lane & 15, fq = F.lane >> 4;
    const int h = (F.bid >> 4) & 7; const int ch = h * 128 + 16 * F.wave + fr;
    const LruCoef k0 = lru_coef(a, 0, ch), k1 = lru_coef(a, 1, ch);
    for (int unit = F.bid; unit < NU; unit += F.G) {
        const int c = unit & (LRU_NCH - 1), b = unit >> 7;
        bf16x8 Bw0[2][4], Bw1[2][4]; lru_load_w(F, 0, h, Bw0); lru_load_w(F, 1, h, Bw1);
        { u32x4 raw[4][4]; lru_conv_load(F, b, h, c, raw); LruConvW cwv; lru_conv_weights(F, a, h, cwv); lru_conv(F, cwv, raw, b, h, c, c == 0 && V == 0); }
        LDS_WAIT(); __syncthreads();
        float Af = 1.f, Hf = 0.f, Ab = 1.f, Hb = 0.f;
#pragma unroll 2
        for (int m = 0; m < 8; ++m) {
            float av[4], bv[4];
            lru_tile<V>(F, m, Bw0, k0, av, bv);
            float A = av[0] * av[1] * av[2] * av[3], B = ((bv[0] * av[1] + bv[1]) * av[2] + bv[2]) * av[3] + bv[3];
            lru_tile_total<true, V>(fq, A, B);
            Hf = Hf * A + B; Af = Af * A;
            lru_tile<V>(F, m, Bw1, k1, av, bv);
            A = av[0] * av[1] * av[2] * av[3]; B = ((bv[3] * av[2] + bv[2]) * av[1] + bv[1]) * av[0] + bv[0];
            lru_tile_total<false, V>(fq, A, B);
            Hb = B * Ab + Hb; Ab = A * Ab;
        }
        float* agg = agg_base;
        if (fq == 0) { *(f32x2*)(agg + ((size_t)((b * LRU_NCH + c) * 2 + 0) * DM + ch) * 2) = (f32x2){Af, Hf};
                       *(f32x2*)(agg + ((size_t)((b * LRU_NCH + c) * 2 + 1) * DM + ch) * 2) = (f32x2){Ab, Hb}; }
        if (c == 0 && V == 0) {
            float av[4], bv[4]; float* s0 = (float*)(F.ws + WS_LRUS0);
            lru_tile(F, 8, Bw0, k0, av, bv); if (fq == 0) s0[(b * 2 + 0) * DM + ch] = bv[0];
            lru_tile(F, 8, Bw1, k1, av, bv); if (fq == 0) s0[(b * 2 + 1) * DM + ch] = bv[1];
        }
        __syncthreads();
    }
}

__device__ __forceinline__ void lru_pass2(Frame& F, const Args& a, int unit, const LruCoef& kf, const LruCoef& kb) {
    const int c = unit & (LRU_NCH - 1), h = (unit >> 4) & 7, b = unit >> 7;
    const int fr = F.lane & 15, fq = F.lane >> 4; const int ch = h * 128 + 16 * F.wave + fr;
    const float* agg = (const float*)(F.ws + WS_LRUAGG); const float* s0 = (const float*)(F.ws + WS_LRUS0);
    f32x2 ag[LRU_NCH];
#pragma unroll
    for (int j = 0; j < LRU_NCH; ++j) ag[j] = *(const f32x2*)(agg + ((size_t)((b * LRU_NCH + j) * 2 + (j < c ? 0 : 1)) * DM + ch) * 2);
    float hf = s0[(b * 2 + 0) * DM + ch], hb = s0[(b * 2 + 1) * DM + ch];
    bf16* AY = (bf16*)(F.ws + WS_YAG) + ((size_t)b * SEQ + c * LRU_T) * DM + h * 128;
    u32x4 ayv[4];
#pragma unroll
    for (int i = 0; i < 4; ++i) ayv[i] = *(const u32x4*)(AY + (size_t)((F.tid >> 4) + 32 * i) * DM + 8 * (F.tid & 15));
    bf16x8 Bw[2][4], Bw1[2][4]; lru_load_w(F, 0, h, Bw);
    LruCoef k = kf; const LruCoef k1 = kb;
    { u32x4 raw[4][4]; lru_conv_load(F, b, h, c, raw); LruConvW cwv; lru_conv_weights(F, a, h, cwv); lru_conv(F, cwv, raw, b, h, c, false); }
    lru_load_w(F, 1, h, Bw1);
#pragma unroll
    for (int j = 0; j < LRU_NCH; ++j) if (j < c) hf = ag[j].x * hf + ag[j].y;
#pragma unroll
    for (int j = LRU_NCH - 1; j >= 0; --j) if (j > c) hb = ag[j].x * hb + ag[j].y;
    LDS_WAIT(); __syncthreads();
    float hfv[8][4];
#pragma unroll
    for (int m = 0; m < 8; ++m) {
        float av[4], bv[4];
        lru_tile(F, m, Bw, k, av, bv);
        const float A = av[0] * av[1] * av[2] * av[3], B = ((bv[0] * av[1] + bv[1]) * av[2] + bv[2]) * av[3] + bv[3];
        float hin = hf;
#pragma unroll
        for (int g = 0; g < 4; ++g) { const float Ag = __shfl(A, g * 16 + fr), Bg = __shfl(B, g * 16 + fr); if (g < fq) hin = Ag * hin + Bg; hf = Ag * hf + Bg; }
#pragma unroll
        for (int r = 0; r < 4; ++r) { hin = av[r] * hin + bv[r]; hfv[m][r] = hin; }
    }
    k = k1;
    LAS float* uf = (LAS float*)(F.lds + LRU_UF);
#pragma unroll
    for (int m = 7; m >= 0; --m) {
        float av[4], bv[4];
        lru_tile(F, m, Bw1, k, av, bv);
        const float A = av[0] * av[1] * av[2] * av[3], B = ((bv[3] * av[2] + bv[2]) * av[1] + bv[1]) * av[0] + bv[0];
        float hin = hb;
#pragma unroll
        for (int g = 3; g >= 0; --g) { const float Ag = __shfl(A, g * 16 + fr), Bg = __shfl(B, g * 16 + fr); if (g > fq) hin = Ag * hin + Bg; hb = Ag * hb + Bg; }
#pragma unroll
        for (int r = 3; r >= 0; --r) { hin = av[r] * hin + bv[r]; uf[(m * 16 + 4 * fq + r) * UF_LD + 16 * F.wave + fr] = hfv[m][r] + hin; }
    }
    LDS_WAIT(); __syncthreads();
    const int cg = F.tid & 15;
#pragma unroll
    for (int i = 0; i < 4; ++i) { const int tl = (F.tid >> 4) + 32 * i;
        const f32x4 y0 = *(const LAS f32x4*)(uf + tl * UF_LD + 8 * cg), y1 = *(const LAS f32x4*)(uf + tl * UF_LD + 8 * cg + 4);
        const u32x4 g = ayv[i];
        u32x4 o; o.x = pk2(y0.x * gelu_tanh(bflo(g.x)), y0.y * gelu_tanh(bfhi(g.x))); o.y = pk2(y0.z * gelu_tanh(bflo(g.y)), y0.w * gelu_tanh(bfhi(g.y)));
        o.z = pk2(y1.x * gelu_tanh(bflo(g.z)), y1.y * gelu_tanh(bfhi(g.z))); o.w = pk2(y1.z * gelu_tanh(bflo(g.w)), y1.w * gelu_tanh(bfhi(g.w)));
        *(u32x4*)(AY + (size_t)tl * DM + 8 * cg) = o; }
    __syncthreads();
}
constexpr int HG_C = 64, HG_SEG = 512, HG_NSEG = 4;
constexpr int HG_QS = 0, HG_QM = 16384, HG_KM = 32768, HG_KDT = 49152, HG_VT = 65536, HG_ATT = 81920, HG_PART = 90112, HG_ETOT = 94208, HG_ROWS = 94720;
constexpr size_t HGS_IMG = 65536;
#ifdef PROBE_A
#define HSTAMP(i) do { if (F.bid == 0 && F.tid == 0) { const unsigned long long _t = __builtin_amdgcn_s_memrealtime(); const unsigned long long _p = ((unsigned long long)F.MISC[101] << 32) | F.MISC[100]; \
    unsigned long long _a = ((unsigned long long)F.MISC[103 + 2 * (i)] << 32) | F.MISC[102 + 2 * (i)]; _a += _t - _p; F.MISC[102 + 2 * (i)] = (unsigned)_a; F.MISC[103 + 2 * (i)] = (unsigned)(_a >> 32); F.MISC[100] = (unsigned)_t; F.MISC[101] = (unsigned)(_t >> 32); } } while (0)
#else
#define HSTAMP(i) do { } while (0)
#endif

__device__ __forceinline__ int hg_row(int b, int dir, bool ctx, int sigma) {
    if (ctx) { const int t = dir ? (CTX - 1 - sigma) : sigma; return b * CTX + t; }
    const int p = dir ? (SEQ - 1 - sigma) : sigma; return b * SEQ + (p & 31) * 64 + (p >> 5);
}

struct HgRaw { unsigned f[8], v[8], q[8]; };
template <bool FULL>
__device__ __forceinline__ void hg_load(Frame& F, const bf16* Qb, const bf16* Fb, const bf16* Vb, int b, int dir, bool ctx, int sigma0, HgRaw& r) {
    const long step = (long)(ctx ? 1 : 64) * (dir ? -1 : 1) * DM;
    const size_t ro = (size_t)hg_row(b, dir, ctx, sigma0 + 8 * F.wave) * DM + 2 * F.lane;
    const bf16* fp = Fb + ro; const bf16* vp = Vb + ro; const bf16* qp = Qb + ro;
#pragma unroll
    for (int j = 0; j < 8; ++j) { r.f[j] = *(const unsigned*)(fp + j * step); r.v[j] = *(const unsigned*)(vp + j * step); if (FULL) r.q[j] = *(const unsigned*)(qp + j * step); }
}
template <bool FULL>
__device__ __forceinline__ void hg_prep(Frame& F, const HgRaw& raw, int b, int dir, bool ctx, int sigma0, float lb0, float lb1, float& gs0, float& gs1) {
    const int kp = F.lane, to = F.wave;
    const unsigned (&fw)[8] = raw.f; const unsigned (&qw)[8] = raw.q; const unsigned (&vw)[8] = raw.v;
    float c0[8], c1[8], k0[8], k1[8];
    float a0 = 0.f, a1 = 0.f;
#pragma unroll
    for (int j = 0; j < 8; ++j) {
        const float g0 = lb0 + (1.f - lb0) * __builtin_amdgcn_rcpf(1.f + __builtin_amdgcn_exp2f(-bflo(fw[j]) * LOG2E));
        const float g1 = lb1 + (1.f - lb1) * __builtin_amdgcn_rcpf(1.f + __builtin_amdgcn_exp2f(-bfhi(fw[j]) * LOG2E));
        k0[j] = 1.f - g0; k1[j] = 1.f - g1;
        a0 += __builtin_amdgcn_logf(g0); a1 += __builtin_amdgcn_logf(g1);
        c0[j] = a0; c1[j] = a1; }
    LAS float* part = (LAS float*)(F.lds + HG_PART);
    *(LAS f32x2*)(part + to * 128 + 2 * kp) = (f32x2){a0, a1};
    if (FULL) HSTAMP(0);
    LDS_WAIT(); __syncthreads();
    if (FULL) HSTAMP(1);
    if (FULL && F.tid < HG_C) ((LAS int*)(F.lds + HG_ROWS))[F.tid] = hg_row(b, dir, ctx, sigma0 + F.tid);
    float off0 = 0.f, off1 = 0.f, tot0 = 0.f, tot1 = 0.f;
#pragma unroll
    for (int o = 0; o < 8; ++o) { const f32x2 p = *(const LAS f32x2*)(part + o * 128 + 2 * kp);
        if (o < to) { off0 += p.x; off1 += p.y; } tot0 += p.x; tot1 += p.y; }
    gs0 += tot0; gs1 += tot1;
    if (to == 0) *(LAS f32x2*)((LAS float*)(F.lds + HG_ETOT) + 2 * kp) = (f32x2){__builtin_amdgcn_exp2f(tot0), __builtin_amdgcn_exp2f(tot1)};
    float kd0[8], kd1[8];
#pragma unroll
    for (int j = 0; j < 8; ++j) {
        const float E0 = __builtin_amdgcn_exp2f(off0 + c0[j]), E1 = __builtin_amdgcn_exp2f(off1 + c1[j]);
        kd0[j] = k0[j] * __builtin_amdgcn_rcpf(E0); kd1[j] = k1[j] * __builtin_amdgcn_rcpf(E1);
        if (FULL) {
            const float q0 = bflo(qw[j]), q1 = bfhi(qw[j]);
            const float s0 = q0 * __builtin_amdgcn_rcpf(1.f + __builtin_amdgcn_exp2f(-q0 * LOG2E)) * E0, s1 = q1 * __builtin_amdgcn_rcpf(1.f + __builtin_amdgcn_exp2f(-q1 * LOG2E)) * E1;
            const int c = 8 * to + j; const int off = c * 256 + ((4 * kp) ^ ((c & 15) << 4));
            *(LAS unsigned*)(F.lds + HG_QS + off) = pk2(s0, s1);
            *(LAS unsigned*)(F.lds + HG_KM + off) = pk2(kd0[j], kd1[j]);
        }
    }
    { const int sw = ((to ^ (kp & 7)) << 4);
      u32x4 w0, w1; w0.x = pk2(kd0[0], kd0[1]); w0.y = pk2(kd0[2], kd0[3]); w0.z = pk2(kd0[4], kd0[5]); w0.w = pk2(kd0[6], kd0[7]);
      w1.x = pk2(kd1[0], kd1[1]); w1.y = pk2(kd1[2], kd1[3]); w1.z = pk2(kd1[4], kd1[5]); w1.w = pk2(kd1[6], kd1[7]);
      *(LAS u32x4*)(F.lds + HG_KDT + (2 * kp) * 128 + sw) = w0; *(LAS u32x4*)(F.lds + HG_KDT + (2 * kp + 1) * 128 + sw) = w1;
      u32x4 v0, v1;
      v0.x = (vw[0] & 0xffffu) | (vw[1] << 16); v0.y = (vw[2] & 0xffffu) | (vw[3] << 16); v0.z = (vw[4] & 0xffffu) | (vw[5] << 16); v0.w = (vw[6] & 0xffffu) | (vw[7] << 16);
      v1.x = (vw[0] >> 16) | (vw[1] & 0xffff0000u); v1.y = (vw[2] >> 16) | (vw[3] & 0xffff0000u); v1.z = (vw[4] >> 16) | (vw[5] & 0xffff0000u); v1.w = (vw[6] >> 16) | (vw[7] & 0xffff0000u);
      *(LAS u32x4*)(F.lds + HG_VT + (2 * kp) * 128 + sw) = v0; *(LAS u32x4*)(F.lds + HG_VT + (2 * kp + 1) * 128 + sw) = v1; }
    if (FULL) HSTAMP(2);
    LDS_WAIT(); __syncthreads();
    if (FULL) HSTAMP(3);
}
__device__ __forceinline__ void hg_state_update(Frame& F, f32x4 (&St)[8], const bf16x8 (&vt)[2]) {
    const int fr = F.lane & 15, fq = F.lane >> 4;
    const LAS float* etot = (const LAS float*)(F.lds + HG_ETOT);
#pragma unroll
    for (int kt = 0; kt < 8; ++kt) { const f32x4 e = *(const LAS f32x4*)(etot + 16 * kt + 4 * fq);
        const int rk = 16 * kt + fr;
#pragma unroll
        for (int ks = 0; ks < 2; ++ks) { const bf16x8 A = *(const LAS bf16x8*)(F.lds + HG_KDT + rk * 128 + (((4 * ks + fq) ^ ((rk >> 1) & 7)) << 4));
            St[kt] = __builtin_amdgcn_mfma_f32_16x16x32_bf16(A, vt[ks], St[kt], 0, 0, 0); }
        St[kt] = St[kt] * e; }
}
__device__ __forceinline__ void hg_load_vt(Frame& F, bf16x8 (&vt)[2]) {
    const int fr = F.lane & 15, fq = F.lane >> 4; const int rv = 16 * F.wave + fr;
#pragma unroll
    for (int ks = 0; ks < 2; ++ks) vt[ks] = *(const LAS bf16x8*)(F.lds + HG_VT + rv * 128 + (((4 * ks + fq) ^ ((rv >> 1) & 7)) << 4));
}
struct HgPtrs { const bf16* Q; const bf16* Fx; const bf16* V; const bf16* Fc; const bf16* Vc; bf16* O; };
__device__ __forceinline__ HgPtrs hg_ptrs(Frame& F, int h, int dir) {
    HgPtrs p; p.Q = (const bf16*)(F.ws + WS_P + 2 * GS) + h * 128; p.Fx = (const bf16*)(F.ws + WS_P + (dir ? 4 : 3) * GS) + h * 128; p.V = (const bf16*)(F.ws + WS_P + 5 * GS) + h * 128;
    p.Fc = (const bf16*)(F.ws + WS_PC + (dir ? 2 : 1) * CGS) + h * 128; p.Vc = (const bf16*)(F.ws + WS_PC + 3 * CGS) + h * 128; p.O = (bf16*)(F.ws + WS_P + (dir ? 4 : 3) * GS) + h * 128; return p;
}
__device__ __forceinline__ void hg_lb(const Args& a, int h, int kp, float& lb0, float& lb1) {
    const float* t = a.in[IN_HGLB] + h * 128 + 2 * kp; lb0 = 1.f / (1.f + expf(t[DM] - t[0])); lb1 = 1.f / (1.f + expf(t[DM + 1] - t[1]));
}
__device__ __forceinline__ float* hg_img(Frame& F, int b, int h, int dir, int slot) { return (float*)((unsigned char*)F.out + (size_t)((((b * 8 + h) * 2 + dir) * 4) + slot) * HGS_IMG); }

__device__ __forceinline__ void hg_pass1(Frame& F, const Args& a, int unit) {
    const int slot = unit & 3, dir = (unit >> 2) & 1, h = (unit >> 3) & 7, b = unit >> 6;
    const int fr = F.lane & 15, fq = F.lane >> 4;
    const HgPtrs P = hg_ptrs(F, h, dir);
    float lb0, lb1; hg_lb(a, h, F.lane, lb0, lb1);
    f32x4 St[8];
#pragma unroll
    for (int kt = 0; kt < 8; ++kt) St[kt] = (f32x4){0.f, 0.f, 0.f, 0.f};
    const bool ctx = slot == 0; const int nchunk = ctx ? CTX / HG_C : HG_SEG / HG_C; const int sig0 = ctx ? 0 : (slot - 1) * HG_SEG;
    float gs0 = 0.f, gs1 = 0.f;
    const bf16* Fsrc = ctx ? P.Fc : P.Fx; const bf16* Vsrc = ctx ? P.Vc : P.V;
    HgRaw cur; hg_load<false>(F, P.Q, Fsrc, Vsrc, b, dir, ctx, sig0, cur);
    for (int ck = 0; ck < nchunk; ++ck) {
        HgRaw nxt; { const int cn = ck + 1 < nchunk ? ck + 1 : ck; hg_load<false>(F, P.Q, Fsrc, Vsrc, b, dir, ctx, sig0 + cn * HG_C, nxt); }
        hg_prep<false>(F, cur, b, dir, ctx, sig0 + ck * HG_C, lb0, lb1, gs0, gs1);
        cur = nxt;
        bf16x8 vt[2]; hg_load_vt(F, vt);
        hg_state_update(F, St, vt);
    }
    float* img = hg_img(F, b, h, dir, slot) + (size_t)(16 * F.wave + fr) * 128 + 4 * fq;
#pragma unroll
    for (int kt = 0; kt < 8; ++kt) *(f32x4*)(img + 16 * kt) = St[kt];
    if (!ctx && F.wave == 0) { float* D = (float*)(F.ws + WS_HGD) + (size_t)((((b * 8 + h) * 2 + dir) * 3) + (slot - 1)) * 128 + 2 * F.lane;
        *(f32x2*)D = (f32x2){__builtin_amdgcn_exp2f(gs0), __builtin_amdgcn_exp2f(gs1)}; }
    __syncthreads();
}

constexpr int HG_HN = 95232;
__device__ __forceinline__ void hg_pass2(Frame& F, const Args& a, int unit) {
    const int seg = unit & 3, h = (unit >> 2) & 7, b = unit >> 5;
    const int fr = F.lane & 15, fq = F.lane >> 4, w = F.wave;
    float lb0, lb1; hg_lb(a, h, F.lane, lb0, lb1);
    const int lcol = h * 128 + 16 * w + 4 * fq;
#pragma unroll 1
    for (int dir = 0; dir < 2; ++dir) {
        const int sseg = dir == 0 ? seg : 3 - seg;
        const HgPtrs P = hg_ptrs(F, h, dir);
        f32x4 St[8];
        {
            const float* img = hg_img(F, b, h, dir, 0) + (size_t)(16 * w + fr) * 128 + 4 * fq;
#pragma unroll
            for (int kt = 0; kt < 8; ++kt) St[kt] = *(const f32x4*)(img + 16 * kt);
            for (int j = 0; j < sseg; ++j) {
                const float* im = hg_img(F, b, h, dir, 1 + j) + (size_t)(16 * w + fr) * 128 + 4 * fq;
                const float* D = (const float*)(F.ws + WS_HGD) + (size_t)((((b * 8 + h) * 2 + dir) * 3) + j) * 128 + 4 * fq;
#pragma unroll
                for (int kt = 0; kt < 8; ++kt) { const f32x4 d = *(const f32x4*)(D + 16 * kt), dl = *(const f32x4*)(im + 16 * kt); St[kt] = St[kt] * d + dl; }
            }
        }
        float gs0 = 0.f, gs1 = 0.f;
        for (int ck = 0; ck < HG_SEG / HG_C; ++ck) {
            { HgRaw cur; hg_load<true>(F, P.Q, P.Fx, P.V, b, dir, false, sseg * HG_SEG + ck * HG_C, cur);
              hg_prep<true>(F, cur, b, dir, false, sseg * HG_SEG + ck * HG_C, lb0, lb1, gs0, gs1); }
            const LAS int* rows = (const LAS int*)(F.lds + HG_ROWS);
            bf16* OFW = (bf16*)(F.ws + WS_OF) + lcol; asm volatile("" : "+v"(OFW));
            u32x2 ofw[4], ogv[4];
            if (dir == 1) {
                const bf16* OG = (const bf16*)(F.ws + WS_P + 6 * GS) + lcol; asm volatile("" : "+v"(OG));
#pragma unroll
                for (int ct = 0; ct < 4; ++ct) { const size_t ro = (size_t)rows[16 * ct + fr] * DM; ofw[ct] = *(const u32x2*)(OFW + ro); ogv[ct] = *(const u32x2*)(OG + ro); } }
#pragma unroll
            for (int tt = 0; tt < 2; ++tt) { const int t = w + 8 * tt, ct = t >> 2, st = t & 3;
                f32x4 acc = {0.f, 0.f, 0.f, 0.f};
                const int rs = 16 * st + fr, rc = 16 * ct + fr;
#pragma unroll
                for (int kk = 0; kk < 4; ++kk) { const bf16x8 A = *(const LAS bf16x8*)(F.lds + HG_KM + rs * 256 + (((4 * kk + fq) ^ fr) << 4));
                    const bf16x8 B = *(const LAS bf16x8*)(F.lds + HG_QS + rc * 256 + (((4 * kk + fq) ^ fr) << 4));
                    acc = __builtin_amdgcn_mfma_f32_16x16x32_bf16(A, B, acc, 0, 0, 0); }
                const int s0 = 16 * st + 4 * fq;
                const float m0 = (s0 + 0 <= rc) ? acc[0] : 0.f, m1 = (s0 + 1 <= rc) ? acc[1] : 0.f, m2 = (s0 + 2 <= rc) ? acc[2] : 0.f, m3 = (s0 + 3 <= rc) ? acc[3] : 0.f;
                *(LAS u32x2*)(F.lds + HG_ATT + rc * 128 + (((2 * st + (fq >> 1)) ^ ((rc >> 1) & 7)) << 4) + (fq & 1) * 8) = (u32x2){pk2(m0, m1), pk2(m2, m3)}; }
            f32x4 o[4];
#pragma unroll
            for (int ct = 0; ct < 4; ++ct) o[ct] = (f32x4){0.f, 0.f, 0.f, 0.f};
#pragma unroll
            for (int kk = 0; kk < 4; ++kk) {
                union { bf16x8 v; unsigned u[4]; } A;
                A.u[0] = pk2(St[2 * kk][0], St[2 * kk][1]); A.u[1] = pk2(St[2 * kk][2], St[2 * kk][3]); A.u[2] = pk2(St[2 * kk + 1][0], St[2 * kk + 1][1]); A.u[3] = pk2(St[2 * kk + 1][2], St[2 * kk + 1][3]);
#pragma unroll
                for (int ct = 0; ct < 4; ++ct) { const int rc = 16 * ct + fr;
                    union { bf16x8 v; u32x2 h[2]; } B;
                    B.h[0] = *(const LAS u32x2*)(F.lds + HG_QS + rc * 256 + (((4 * kk + (fq >> 1)) ^ fr) << 4) + (fq & 1) * 8);
                    B.h[1] = *(const LAS u32x2*)(F.lds + HG_QS + rc * 256 + (((4 * kk + 2 + (fq >> 1)) ^ fr) << 4) + (fq & 1) * 8);
                    o[ct] = __builtin_amdgcn_mfma_f32_16x16x32_bf16(A.v, B.v, o[ct], 0, 0, 0); } }
            bf16x8 vt[2]; hg_load_vt(F, vt);
            LDS_WAIT(); __syncthreads();
#pragma unroll
            for (int ks = 0; ks < 2; ++ks)
#pragma unroll
                for (int ct = 0; ct < 4; ++ct) { const int rc = 16 * ct + fr;
                    const bf16x8 B = *(const LAS bf16x8*)(F.lds + HG_ATT + rc * 128 + (((4 * ks + fq) ^ ((rc >> 1) & 7)) << 4));
                    o[ct] = __builtin_amdgcn_mfma_f32_16x16x32_bf16(vt[ks], B, o[ct], 0, 0, 0); }
            if (dir == 0) {
#pragma unroll
                for (int ct = 0; ct < 4; ++ct) *(u32x2*)(OFW + (size_t)rows[16 * ct + fr] * DM) = (u32x2){pk2(o[ct][0], o[ct][1]), pk2(o[ct][2], o[ct][3])};
                hg_state_update(F, St, vt);
            } else {
                LAS float* hn = (LAS float*)(F.lds + HG_HN);
                const f32x4 hn4 = *(const f32x4*)(a.in[IN_HGN] + h * 128 + 16 * w + 4 * fq);
#pragma unroll
                for (int ct = 0; ct < 4; ++ct) { o[ct][0] += bflo(ofw[ct].x); o[ct][1] += bfhi(ofw[ct].x); o[ct][2] += bflo(ofw[ct].y); o[ct][3] += bfhi(ofw[ct].y);
                    float ss = (o[ct][0] * o[ct][0] + o[ct][1] * o[ct][1]) + (o[ct][2] * o[ct][2] + o[ct][3] * o[ct][3]);
                    ss += __shfl_xor(ss, 16); ss += __shfl_xor(ss, 32);
                    if (fq == 0) hn[(16 * ct + fr) * 8 + w] = ss; }
                hg_state_update(F, St, vt);
                LDS_WAIT(); __syncthreads();
#pragma unroll
                for (int ct = 0; ct < 4; ++ct) { const f32x4 p0 = *(const LAS f32x4*)(hn + (16 * ct + fr) * 8), p1 = *(const LAS f32x4*)(hn + (16 * ct + fr) * 8 + 4);
                    const float rsn = rsqrtf(((p0.x + p0.y) + (p0.z + p0.w) + (p1.x + p1.y) + (p1.z + p1.w)) * (1.f / 128.f) + EPS);
                    const float g0 = bflo(ogv[ct].x), g1 = bfhi(ogv[ct].x), g2 = bflo(ogv[ct].y), g3 = bfhi(ogv[ct].y);
                    const float y0 = o[ct][0] * rsn * hn4.x * siluf_(g0), y1 = o[ct][1] * rsn * hn4.y * siluf_(g1), y2 = o[ct][2] * rsn * hn4.z * siluf_(g2), y3 = o[ct][3] * rsn * hn4.w * siluf_(g3);
                    *(u32x2*)(OFW + (size_t)rows[16 * ct + fr] * DM) = (u32x2){pk2(y0, y1), pk2(y2, y3)}; }
            }
        }
        VM_WAIT(); __syncthreads();
    }
}
__device__ __forceinline__ void p_ybg(Frame& F, const Args& a) {
    const bf16* OFp = (const bf16*)(F.ws + WS_OF); const bf16* OBp = (const bf16*)(F.ws + WS_OB); const bf16* OG = (const bf16*)(F.ws + WS_P + 6 * GS);
    bf16* YBG = (bf16*)(F.ws + WS_YBG); const float* hgn = a.in[IN_HGN];
    const int gw = F.bid * NWAVES + F.wave, NGW = F.G * NWAVES;
    for (int row = gw; row < NTOK; row += 2 * NGW) {
        u32x4 fv[2][2], bv[2][2], gvv[2][2];
#pragma unroll
        for (int rr = 0; rr < 2; ++rr)
#pragma unroll
            for (int j = 0; j < 2; ++j) { const size_t o = (size_t)(row + rr * NGW) * DM + 8 * F.lane + 512 * j;
                fv[rr][j] = *(const u32x4*)(OFp + o); bv[rr][j] = *(const u32x4*)(OBp + o); gvv[rr][j] = *(const u32x4*)(OG + o); }
#pragma unroll
        for (int rr = 0; rr < 2; ++rr)
#pragma unroll
        for (int j = 0; j < 2; ++j) { const int k = 8 * F.lane + 512 * j; const size_t o = (size_t)(row + rr * NGW) * DM + k;
            const u32x4 f = fv[rr][j], b = bv[rr][j], g = gvv[rr][j];
            float v[8]; v[0] = bflo(f.x) + bflo(b.x); v[1] = bfhi(f.x) + bfhi(b.x); v[2] = bflo(f.y) + bflo(b.y); v[3] = bfhi(f.y) + bfhi(b.y);
            v[4] = bflo(f.z) + bflo(b.z); v[5] = bfhi(f.z) + bfhi(b.z); v[6] = bflo(f.w) + bflo(b.w); v[7] = bfhi(f.w) + bfhi(b.w);
            float ss = 0.f;
#pragma unroll
            for (int q = 0; q < 8; ++q) ss += v[q] * v[q];
            ss += __shfl_xor(ss, 1); ss += __shfl_xor(ss, 2); ss += __shfl_xor(ss, 4); ss += __shfl_xor(ss, 8);
            const float rs = rsqrtf(ss * (1.f / 128.f) + EPS);
            float gv[8]; gv[0] = bflo(g.x); gv[1] = bfhi(g.x); gv[2] = bflo(g.y); gv[3] = bfhi(g.y); gv[4] = bflo(g.z); gv[5] = bfhi(g.z); gv[6] = bflo(g.w); gv[7] = bfhi(g.w);
            const f32x4 h0 = *(const f32x4*)(hgn + k), h1 = *(const f32x4*)(hgn + k + 4);
            const float hv[8] = {h0.x, h0.y, h0.z, h0.w, h1.x, h1.y, h1.z, h1.w};
            float r[8];
#pragma unroll
            for (int q = 0; q < 8; ++q) r[q] = v[q] * rs * hv[q] * siluf_(gv[q]);
            u32x4 w; w.x = pk2(r[0], r[1]); w.y = pk2(r[2], r[3]); w.z = pk2(r[4], r[5]); w.w = pk2(r[6], r[7]);
            *(u32x4*)(YBG + o) = w; }
    }
}
__device__ __forceinline__ void p_moe_weights13(Frame& F, const Args& a) {
    LAS float* scr = (LAS float*)(F.lds + F.wave * TR_BYTES);
    const int gw = F.bid * NWAVES + F.wave, NGW = F.G * NWAVES;
    for (int it = gw; it < NEXP * 256; it += NGW) {
        const int e = it >> 8, r = it & 255, w = r >> 7, q = r & 127, kb = q >> 3, nb = q & 7;
        transpose_item(a.in[w == 0 ? IN_W1 : IN_W3] + (size_t)e * DM * DEXP, DEXP, DM, (bf16*)(F.ws + (w == 0 ? WS_W1T : WS_W3T)) + ((size_t)e * DEXP + nb * 64) * DM, kb * 64, nb * 64, scr, F.lane);
    }
}
__device__ __forceinline__ void p_moe_weights2(Frame& F, const Args& a, int rank, int nwg) {
    LAS float* scr = (LAS float*)(F.lds + F.wave * TR_BYTES);
    for (int it = rank * NWAVES + F.wave; it < NEXP * 128; it += nwg * NWAVES) {
        const int e = it >> 7, q = it & 127, kb = q >> 4, nb = q & 15;
        transpose_item(a.in[IN_W2] + (size_t)e * DEXP * DM, DM, DEXP, (bf16*)(F.ws + WS_W2T) + ((size_t)e * DM + nb * 64) * DEXP, kb * 64, nb * 64, scr, F.lane);
    }
}

struct SchedP5 {
    int c; const char* YAG; const char* YBG; const char* WA; const char* WB; char* stash; char* M;
    __device__ __forceinline__ bool next(int i, gm::Unit& u) const {
        if (i >= 2) return false;
        int pm, pn; tile_order(c, 64, 4, pm, pn);
        u.A = (i == 0 ? YAG : YBG) + (size_t)pm * 256 * 2048; u.B0 = (i == 0 ? WA : WB) + (size_t)pn * 256 * 2048; u.B1 = u.B0 + (size_t)128 * 2048;
        u.dst = M + ((size_t)pm * 256 * DM + pn * 256) * 2; u.pm = pm; u.pn = pn; u.e = i; u.rows = 256; return true;
    }
    __device__ __forceinline__ unsigned arow(const gm::Unit&, int r) const { return (unsigned)r; }
};
struct EpiP5 {
    static constexpr bool PERM = true;
    unsigned* stash; const bf16* GA; const bf16* GB;
    __device__ __forceinline__ void operator()(const f32x4 (&acc)[2][2][4][2], const gm::Unit& u, int wr, int wc, int fr, int fq) const {
        const bf16* G = (u.e == 0 ? GA : GB) + ((size_t)u.pm * 256 + wr * 64 + fr) * DM + u.pn * 256 + wc * 32 + 8 * fq;
        bf16* Mb = (bf16*)u.dst + (size_t)(wr * 64 + fr) * DM + wc * 32 + 8 * fq;
        u32x4* st = (u32x4*)stash + threadIdx.x;
        asm volatile("" : "+v"(G), "+v"(Mb), "+v"(st));
#pragma unroll
        for (int ai = 0; ai < 2; ++ai)
#pragma unroll
            for (int m = 0; m < 4; ++m) {
                u32x4 g[2], s[2];
#pragma unroll
                for (int bj = 0; bj < 2; ++bj) { const size_t ro = (size_t)(ai * 128 + m * 16) * DM + bj * 128; const int si = (ai * 4 + m) * 2 + bj;
                    g[bj] = *(const u32x4*)(G + ro);
                    if (u.e != 0) s[bj] = st[(size_t)si * NTHR]; }
#pragma unroll
                for (int bj = 0; bj < 2; ++bj) { const size_t ro = (size_t)(ai * 128 + m * 16) * DM + bj * 128; const int si = (ai * 4 + m) * 2 + bj;
                    f32x4 v0 = acc[ai][bj][m][0], v1 = acc[ai][bj][m][1];
                    v0[0] *= sigmoidf_(bflo(g[bj].x)); v0[1] *= sigmoidf_(bfhi(g[bj].x)); v0[2] *= sigmoidf_(bflo(g[bj].y)); v0[3] *= sigmoidf_(bfhi(g[bj].y));
                    v1[0] *= sigmoidf_(bflo(g[bj].z)); v1[1] *= sigmoidf_(bfhi(g[bj].z)); v1[2] *= sigmoidf_(bflo(g[bj].w)); v1[3] *= sigmoidf_(bfhi(g[bj].w));
                    if (u.e != 0) { v0[0] += bflo(s[bj].x); v0[1] += bfhi(s[bj].x); v0[2] += bflo(s[bj].y); v0[3] += bfhi(s[bj].y);
                                    v1[0] += bflo(s[bj].z); v1[1] += bfhi(s[bj].z); v1[2] += bflo(s[bj].w); v1[3] += bfhi(s[bj].w); }
                    u32x4 w; w.x = gm::cvt_pk_bf16(v0[0], v0[1]); w.y = gm::cvt_pk_bf16(v0[2], v0[3]); w.z = gm::cvt_pk_bf16(v1[0], v1[1]); w.w = gm::cvt_pk_bf16(v1[2], v1[3]);
                    if (u.e == 0) st[(size_t)si * NTHR] = w; else *(u32x4*)(Mb + ro) = w; }
                asm volatile("" ::: "memory"); }
    }
};

struct SchedP6 {
    int c; const char* M; const char* W; char* X1;
    __device__ __forceinline__ bool next(int i, gm::Unit& u) const {
        if (i >= 1) return false;
        int pm, pn; tile_order(c, 64, 4, pm, pn);
        u.A = M + (size_t)pm * 256 * 2048; u.B0 = W + (size_t)pn * 256 * 2048; u.B1 = u.B0 + (size_t)128 * 2048;
        u.dst = X1 + ((size_t)pm * 256 * DM + pn * 256) * 4; u.pm = pm; u.pn = pn; u.e = 0; u.rows = 256; return true;
    }
    __device__ __forceinline__ unsigned arow(const gm::Unit&, int r) const { return (unsigned)r; }
};
struct EpiP6 {
    static constexpr bool PERM = false;
    const float* x; const float* mod;
    __device__ __forceinline__ void operator()(const f32x4 (&acc)[2][2][4][2], const gm::Unit& u, int wr, int wc, int fr, int fq) const {
        const int b = u.pm >> 3; const int col0 = u.pn * 256 + wc * 32 + 4 * fq;
        const float* mg = mod + b * 6144 + 2 * DM + col0;
        f32x4 gv[2][2];
#pragma unroll
        for (int bj = 0; bj < 2; ++bj)
#pragma unroll
            for (int n = 0; n < 2; ++n) gv[bj][n] = *(const f32x4*)(mg + bj * 128 + n * 16);
#pragma unroll
        for (int ai = 0; ai < 2; ++ai)
#pragma unroll
            for (int m = 0; m < 4; ++m) { const size_t ro = (size_t)(wr * 64 + fr + ai * 128 + m * 16) * DM + wc * 32 + 4 * fq;
                const float* xr = x + ((size_t)u.pm * 256 * DM + u.pn * 256) + ro; float* orow = (float*)u.dst + ro;
#pragma unroll
                for (int bj = 0; bj < 2; ++bj)
#pragma unroll
                    for (int n = 0; n < 2; ++n) { const f32x4 xv = *(const f32x4*)(xr + bj * 128 + n * 16);
                        *(f32x4*)(orow + bj * 128 + n * 16) = xv + gv[bj][n] * acc[ai][bj][m][n]; } }
    }
};

__device__ __forceinline__ void p_norm2_route(Frame& F, const Args& a) {
    const float* mod = (const float*)(F.ws + WS_MOD); const float* g2 = a.in[IN_G2]; const float* wrp = (const float*)(F.ws + WS_WRT);
    const float* X1 = F.out; bf16* HX2 = (bf16*)(F.ws + WS_HX2);
    int* list = (int*)(F.ws + WS_LIST); float* wt = (float*)(F.ws + WS_WT); unsigned* cnt = F.ctl + CW_CNT;
    LAS float* gs = (LAS float*)F.lds; LAS float* sh = gs + DM; LAS float* rst = sh + DM; LAS float* lgs = rst + 64;
    const int b = F.bid / 32;
    for (int k = F.tid; k < DM; k += NTHR) { gs[k] = g2[k] * (1.f + mod[b * 6144 + 4 * DM + k]); sh[k] = mod[b * 6144 + 3 * DM + k]; }
    __syncthreads();
    for (int r = F.wave; r < 64; r += NWAVES) {
        const int tok = F.bid * 64 + r;
        const f32x4* xr = (const f32x4*)(X1 + (size_t)tok * DM) + F.lane;
        f32x4 v[4]; float s = 0.f;
#pragma unroll
        for (int j = 0; j < 4; ++j) { v[j] = xr[64 * j]; s += (v[j].x * v[j].x + v[j].y * v[j].y) + (v[j].z * v[j].z + v[j].w * v[j].w); }
        const float rstd = rsqrtf(wave_sum(s) * (1.f / DM) + EPS);
        if (F.lane == 0) rst[r] = rstd;
        unsigned long long* o8 = (unsigned long long*)(HX2 + (size_t)tok * DM) + F.lane;
#pragma unroll
        for (int j = 0; j < 4; ++j) { const int k = 4 * F.lane + 256 * j;
            const f32x4 g = *(const LAS f32x4*)(gs + k), h = *(const LAS f32x4*)(sh + k);
            o8[64 * j] = (unsigned long long)pk2(v[j].x * rstd * g.x + h.x, v[j].y * rstd * g.y + h.y) | ((unsigned long long)pk2(v[j].z * rstd * g.z + h.z, v[j].w * rstd * g.w + h.w) << 32); }
    }
    LDS_WAIT(); __syncthreads();
    {
        const int tq = F.lane & 15, kq = F.lane >> 4, wg = F.wave & 3, kh = F.wave >> 2; const int tl = wg * 16 + tq;
        const float rs = rst[tl];
        const float* xr = X1 + (size_t)(F.bid * 64 + tl) * DM + 4 * kq + 512 * kh;
        const f32x4* wp = (const f32x4*)wrp + F.lane + (size_t)kh * 32 * 3 * 64;
        const LAS float* gsp = gs + 512 * kh + 4 * kq; const LAS float* shp = sh + 512 * kh + 4 * kq;
        f32x4 acc[3];
#pragma unroll
        for (int c = 0; c < 3; ++c) acc[c] = (f32x4){0.f, 0.f, 0.f, 0.f};
#pragma unroll 8
        for (int s = 0; s < 32; ++s) {
            const f32x4 x = *(const f32x4*)(xr + 16 * s); const f32x4 g = *(const LAS f32x4*)(gsp + 16 * s), h = *(const LAS f32x4*)(shp + 16 * s);
            const f32x4 hv = x * rs * g + h;
#pragma unroll
            for (int c = 0; c < 3; ++c) { const f32x4 w = wp[(s * 3 + c) * 64];
                acc[c] = __builtin_amdgcn_mfma_f32_16x16x4f32(hv[0], w[0], acc[c], 0, 0, 0); acc[c] = __builtin_amdgcn_mfma_f32_16x16x4f32(hv[1], w[1], acc[c], 0, 0, 0);
                acc[c] = __builtin_amdgcn_mfma_f32_16x16x4f32(hv[2], w[2], acc[c], 0, 0, 0); acc[c] = __builtin_amdgcn_mfma_f32_16x16x4f32(hv[3], w[3], acc[c], 0, 0, 0); }
        }
#pragma unroll
        for (int c = 0; c < 3; ++c)
#pragma unroll
            for (int r = 0; r < 4; ++r) lgs[kh * 64 * 48 + (wg * 16 + 4 * kq + r) * 48 + 16 * c + tq] = acc[c][r];
    }
    LDS_WAIT(); __syncthreads();
    if (F.wave < 4) {
        if (F.lane < 16) {
            const LAS float* lp = lgs + (F.wave * 16 + F.lane) * 48; const int tok = F.bid * 64 + F.wave * 16 + F.lane;
            float lg[36];
#pragma unroll
            for (int q = 0; q < 9; ++q) { const f32x4 t4 = *(const LAS f32x4*)(lp + 4 * q) + *(const LAS f32x4*)(lp + 64 * 48 + 4 * q) + *(const f32x4*)(wrp + 49152 + 4 * q);
                lg[4 * q] = t4.x; lg[4 * q + 1] = t4.y; lg[4 * q + 2] = t4.z; lg[4 * q + 3] = t4.w; }
            float mx = lg[0]; int gi = 0;
#pragma unroll
            for (int g = 1; g < 4; ++g) if (lg[g] > mx) { mx = lg[g]; gi = g; }
            float z = 0.f;
#pragma unroll
            for (int g = 0; g < 4; ++g) z += __expf(lg[g] - mx);
            const float pg = 1.f / z;
            float el[8];
#pragma unroll
            for (int e = 0; e < 8; ++e) el[e] = gi == 0 ? lg[4 + e] : (gi == 1 ? lg[12 + e] : (gi == 2 ? lg[20 + e] : lg[28 + e]));
            int e1 = 0; float m1 = el[0];
#pragma unroll
            for (int e = 1; e < 8; ++e) if (el[e] > m1) { m1 = el[e]; e1 = e; }
            int e2 = 0; float m2 = -3.0e38f;
#pragma unroll
            for (int e = 0; e < 8; ++e) if (e != e1 && el[e] > m2) { m2 = el[e]; e2 = e; }
            const float rr = __expf(m2 - m1); const float w1 = pg / (1.f + rr), w2 = pg * rr / (1.f + rr);
            const int ea = gi * 8 + e1, eb = gi * 8 + e2;
            const unsigned pa = __hip_atomic_fetch_add(cnt + 64 * ea, 1u, __ATOMIC_RELAXED, __HIP_MEMORY_SCOPE_AGENT);
            const unsigned pb = __hip_atomic_fetch_add(cnt + 64 * eb, 1u, __ATOMIC_RELAXED, __HIP_MEMORY_SCOPE_AGENT);
            list[(size_t)ea * CAP + pa] = tok * 2; wt[tok * 2] = w1;
            list[(size_t)eb * CAP + pb] = tok * 2 + 1; wt[tok * 2 + 1] = w2;
        }
    }
}

__device__ __forceinline__ void moe_table(Frame& F, const int* cntv) {
    if (F.wave == 0) { const int lane = F.lane; const int cnt = lane < NEXP ? cntv[64 * lane] : 0;
        const int t = (cnt + 255) >> 8; int ti = t, oi = cnt;
#pragma unroll
        for (int d = 1; d < 32; d <<= 1) { const int tu = __shfl_up(ti, d), ou = __shfl_up(oi, d); if ((lane & 31) >= d) { ti += tu; oi += ou; } }
        if (lane < NEXP) { F.MISC[128 + lane] = (unsigned)cnt; F.MISC[160 + lane] = (unsigned)(ti - t); F.MISC[192 + lane] = (unsigned)(oi - cnt); }
        if (lane == NEXP - 1) F.MISC[224] = (unsigned)ti; }
    LDS_WAIT(); __syncthreads();
}
__device__ __forceinline__ bool moe_find(volatile LAS unsigned* MISC, int lane, int T, int& e, int& rt, int& rows, int& off) {
    if (T >= (int)MISC[224]) return false;
    const int l = lane & 31; const int cnt = (int)MISC[128 + l], tpre = (int)MISC[160 + l];
    const unsigned long long mask = __ballot(lane < NEXP && cnt > 0 && T >= tpre);
    e = __builtin_amdgcn_readfirstlane(63 - __builtin_clzll(mask));
    rt = T - (int)MISC[160 + e]; const int c = (int)MISC[128 + e]; off = (int)MISC[192 + e];
    rows = c - rt * 256; if (rows > 256) rows = 256; return true;
}
struct SchedMoe1 {
    int G, c, lane; volatile LAS unsigned* MISC; const int* list; const char* HX2; const char* W1T; const char* W3T; char* HH; unsigned* tile_cnt;
    __device__ __forceinline__ bool next(int i, gm::Unit& u) const {
        const int vc = (c & 7) * (G >> 3) + (c >> 3);
        const int L = i * G + vc; int e, rt, rows, off; if (!moe_find(MISC, lane, L >> 2, e, rt, rows, off)) return false;
        const int pn = L & 3;
        e = __builtin_amdgcn_readfirstlane(e); rt = __builtin_amdgcn_readfirstlane(rt); rows = __builtin_amdgcn_readfirstlane(rows); off = __builtin_amdgcn_readfirstlane(off);
        u.A = HX2; u.B0 = W1T + ((size_t)e * DEXP + pn * 128) * 2048; u.B1 = W3T + ((size_t)e * DEXP + pn * 128) * 2048;
        u.dst = HH + ((size_t)(off + rt * 256) * DEXP + pn * 128) * 2; u.pm = rt; u.pn = pn; u.e = e; u.rows = rows; u.t = L >> 2; return true;
    }
    __device__ __forceinline__ unsigned arow(const gm::Unit& u, int r) const { const int rr = r < u.rows ? r : u.rows - 1; return (unsigned)(list[(size_t)u.e * CAP + u.pm * 256 + rr] >> 1); }
    __device__ __forceinline__ void a_ready(const gm::Unit&) const {}
    __device__ __forceinline__ void done(const gm::Unit& u) const {
        asm volatile("s_waitcnt vmcnt(0)" ::: "memory");
        __builtin_amdgcn_s_barrier(); asm volatile("" ::: "memory");
        if (threadIdx.x == 0) __hip_atomic_fetch_add(tile_cnt + 8 * u.t, 1u, __ATOMIC_RELAXED, __HIP_MEMORY_SCOPE_AGENT);
    }
};
struct EpiMoe1 {
    static constexpr bool PERM = true;
    char* HH;
    __device__ __forceinline__ void operator()(const f32x4 (&acc)[2][2][4][2], const gm::Unit& u, int wr, int wc, int fr, int fq) const {
        const __amdgpu_buffer_rsrc_t rs = __builtin_amdgcn_make_buffer_rsrc((void*)HH, 0, 0x7fffffff, 0x00020000);
        const unsigned base = (unsigned)(u.dst - HH) + (unsigned)(((wr * 64 + fr) * DEXP + wc * 32 + 8 * fq) * 2);
#pragma unroll
        for (int ai = 0; ai < 2; ++ai)
#pragma unroll
            for (int m = 0; m < 4; ++m) { const int r = ai * 128 + wr * 64 + m * 16 + fr; if (r >= u.rows) continue;
                const f32x4 u0 = acc[ai][0][m][0], u1 = acc[ai][0][m][1], v0 = acc[ai][1][m][0], v1 = acc[ai][1][m][1];
                u32x4 w; w.x = gm::cvt_pk_bf16(siluf_(u0[0]) * v0[0], siluf_(u0[1]) * v0[1]); w.y = gm::cvt_pk_bf16(siluf_(u0[2]) * v0[2], siluf_(u0[3]) * v0[3]);
                w.z = gm::cvt_pk_bf16(siluf_(u1[0]) * v1[0], siluf_(u1[1]) * v1[1]); w.w = gm::cvt_pk_bf16(siluf_(u1[2]) * v1[2], siluf_(u1[3]) * v1[3]);
                __builtin_amdgcn_raw_buffer_store_b128(w, rs, base + (unsigned)((ai * 128 + m * 16) * DEXP * 2), 0, 16); }
    }
};
struct SchedMoe2 {
    int G, c, lane; volatile LAS unsigned* MISC; const char* HH; const char* W2T; char* Y; unsigned* tile_cnt; unsigned* tmo;
    __device__ __forceinline__ bool next(int i, gm::Unit& u) const {
        const int vc = (c & 7) * (G >> 3) + (c >> 3);
        const int U = 4 * (int)MISC[224], q = U / G, r = U % G;
        const bool rebal = q >= 1 && r > 0 && 3 * r <= G;
        int L = i * G + (G - 1 - vc);
        if (rebal) {
            if (vc < r) { if (i >= q - 1) return false; }
            else if (vc < 2 * r) { if (i == q) L = (q - 1) * G + (G - 1 - (vc - r)); else if (i > q) return false; }
        }
        int e, rt, rows, off; if (!moe_find(MISC, lane, L >> 2, e, rt, rows, off)) return false;
        const int pn = L & 3;
        e = __builtin_amdgcn_readfirstlane(e); rt = __builtin_amdgcn_readfirstlane(rt); rows = __builtin_amdgcn_readfirstlane(rows); off = __builtin_amdgcn_readfirstlane(off);
        u.A = HH + (size_t)(off + rt * 256) * DEXP * 2; u.B0 = W2T + ((size_t)e * DM + pn * 256) * (DEXP * 2); u.B1 = u.B0 + (size_t)128 * (DEXP * 2);
        u.dst = Y + (size_t)pn * 256 * 2; u.pm = rt; u.pn = pn; u.e = e; u.rows = rows; u.t = L >> 2; return true;
    }
    __device__ __forceinline__ unsigned arow(const gm::Unit&, int r) const { return (unsigned)r; }
    __device__ __forceinline__ void a_ready(const gm::Unit& u) const {
        if (threadIdx.x < 64) {
            unsigned spins = 0;
            while ((unsigned)__builtin_amdgcn_readfirstlane(__hip_atomic_load(tile_cnt + 8 * u.t, __ATOMIC_RELAXED, __HIP_MEMORY_SCOPE_AGENT)) < 4u) {
                __builtin_amdgcn_s_sleep(2);
                if (++spins > (1u << 22)) { if (threadIdx.x == 0) __hip_atomic_store(tmo, 1u, __ATOMIC_RELAXED, __HIP_MEMORY_SCOPE_AGENT); break; } }
            __builtin_amdgcn_fence(__ATOMIC_ACQUIRE, "agent");
            asm volatile("s_waitcnt vmcnt(0)" ::: "memory");
        }
        asm volatile("" ::: "memory"); __builtin_amdgcn_s_barrier(); asm volatile("" ::: "memory");
    }
    __device__ __forceinline__ void done(const gm::Unit&) const {}
};
struct EpiMoe2 {
    static constexpr bool PERM = true;
    const int* list;
    __device__ __forceinline__ void operator()(const f32x4 (&acc)[2][2][4][2], const gm::Unit& u, int wr, int wc, int fr, int fq) const {
        const int* lp = list + (size_t)u.e * CAP + u.pm * 256;
#pragma unroll
        for (int ai = 0; ai < 2; ++ai)
#pragma unroll
            for (int m = 0; m < 4; ++m) { const int r = ai * 128 + wr * 64 + m * 16 + fr; if (r >= u.rows) continue;
                const int slot = lp[r]; bf16* rowp = (bf16*)u.dst + (size_t)slot * DM + wc * 32 + 8 * fq;
#pragma unroll
                for (int bj = 0; bj < 2; ++bj) { const f32x4 v0 = acc[ai][bj][m][0], v1 = acc[ai][bj][m][1];
                    u32x4 w; w.x = gm::cvt_pk_bf16(v0[0], v0[1]); w.y = gm::cvt_pk_bf16(v0[2], v0[3]); w.z = gm::cvt_pk_bf16(v1[0], v1[1]); w.w = gm::cvt_pk_bf16(v1[2], v1[3]);
                    *(u32x4*)(rowp + bj * 128) = w; } }
    }
};

__device__ __forceinline__ void p_final(Frame& F, const Args& a) {
    const float* mod = (const float*)(F.ws + WS_MOD); const float* fg = a.in[IN_FG]; const float* wt = (const float*)(F.ws + WS_WT);
    const bf16* Y = (const bf16*)(F.ws + WS_Y); float* X1 = F.out;
    for (int r = F.wave; r < 64; r += NWAVES) {
        const int tok = F.bid * 64 + r; const int b = tok >> 11;
        const float w0 = wt[tok * 2], w1 = wt[tok * 2 + 1];
        f32x4* xr = (f32x4*)(X1 + (size_t)tok * DM) + F.lane;
        const u32x2* y0 = (const u32x2*)(Y + (size_t)(tok * 2) * DM) + F.lane; const u32x2* y1 = (const u32x2*)(Y + (size_t)(tok * 2 + 1) * DM) + F.lane;
        f32x4 v[4]; float s = 0.f;
#pragma unroll
        for (int j = 0; j < 4; ++j) { const int k = 4 * F.lane + 256 * j;
            const f32x4 xv = xr[64 * j]; const u32x2 a0 = y0[64 * j], a1 = y1[64 * j]; const f32x4 g5 = *(const f32x4*)(mod + b * 6144 + 5 * DM + k);
            v[j].x = xv.x + g5.x * (w0 * bflo(a0.x) + w1 * bflo(a1.x)); v[j].y = xv.y + g5.y * (w0 * bfhi(a0.x) + w1 * bfhi(a1.x));
            v[j].z = xv.z + g5.z * (w0 * bflo(a0.y) + w1 * bflo(a1.y)); v[j].w = xv.w + g5.w * (w0 * bfhi(a0.y) + w1 * bfhi(a1.y));
            s += (v[j].x * v[j].x + v[j].y * v[j].y) + (v[j].z * v[j].z + v[j].w * v[j].w); }
        const float rstd = rsqrtf(wave_sum(s) * (1.f / DM) + EPS);
#pragma unroll
        for (int j = 0; j < 4; ++j) { const int k = 4 * F.lane + 256 * j; const f32x4 g = *(const f32x4*)(fg + k);
            xr[64 * j] = (f32x4){v[j].x * rstd * g.x, v[j].y * rstd * g.y, v[j].z * rstd * g.z, v[j].w * rstd * g.w}; }
    }
}
#ifndef LRU_FAST
#define LRU_FAST 1
#endif
#ifndef HG_FAST
#define HG_FAST 1
#endif
#define MIX_FAST (LRU_FAST && HG_FAST)
#ifdef PROBE_A
#define STAMP(k) do { if (F.bid == 0 && F.tid == 0) { const unsigned long long _t = __builtin_amdgcn_s_memrealtime(); F.MISC[32 + 2 * (k)] = (unsigned)_t; F.MISC[33 + 2 * (k)] = (unsigned)(_t >> 32); } } while (0)
#else
#define STAMP(k) do { } while (0)
#endif
__device__ __forceinline__ void p_mix1(Frame& F, const Args& a) {
#if LRU_FAST
    lru_phase1<0>(F, a, (float*)(F.ws + WS_LRUAGG));
#ifdef XLRU
    lru_phase1<XLRU>(F, a, F.out + (size_t)10 * 1024 * 1024);
#endif
#endif
    STAMP(14); STAMP(15);
#if HG_FAST
    for (int i = 0, u = F.bid; u < NB * 8 * 2 * 4; u += F.G, ++i) hg_pass1(F, a, (u & ~3) | ((u + 2 * i) & 3));
#endif
}
__device__ __forceinline__ void p_mix2(Frame& F, const Args& a) {
#if LRU_FAST
    if (F.bid < NB * 8 * LRU_NCH) {
        const int h = (F.bid >> 4) & 7; int ch = h * 128 + 16 * F.wave + (F.lane & 15);
        asm volatile("" : "+v"(ch));
        const LruCoef kf = lru_coef(a, 0, ch), kb = lru_coef(a, 1, ch);
        for (int u = F.bid; u < NB * 8 * LRU_NCH; u += F.G) lru_pass2(F, a, u, kf, kb);
    }
#endif
    STAMP(16); STAMP(17);
#if HG_FAST
    for (int u = F.bid; u < NB * 8 * 4; u += F.G) hg_pass2(F, a, u);
#endif
}
__global__ void __launch_bounds__(NTHR, 2) mega(Args args) {
    extern __shared__ __attribute__((aligned(16))) unsigned char lds_raw[];
    Frame F;
    F.lds = (LAS unsigned char*)lds_raw; F.MISC = (volatile LAS unsigned*)(F.lds + LDSCTL_OFF);
    F.tid = threadIdx.x; F.lane = F.tid & 63; F.wave = __builtin_amdgcn_readfirstlane(F.tid >> 6);
    F.G = gridDim.x; F.bid = blockIdx.x; F.ws = args.ws; F.out = args.out; F.ctl = (unsigned*)(args.ws + WS_CTL);
    for (int u = F.tid; u < (LDS_BYTES - LDSCTL_OFF) / 4; u += NTHR) ((LAS unsigned*)(F.lds + LDSCTL_OFF))[u] = 0u;
    __syncthreads();
    XcdBarrier bar = xcd_barrier_post(F.ctl + CW_BAR + args.li * 3584, F.MISC + 8);
    const int lo = args.ph_lo, hi = args.ph_hi;
#define IN(k) (lo <= (k) && (k) < hi)
#define SEAM(k) do { if (IN(k) && IN((k) + 1)) xcd_barrier(bar); STAMP((k) + 1); if ((k) == 9) STAMP(11); } while (0)
    unsigned char* ws = F.ws;
    STAMP(0);
    if (IN(0)) { p0_prologue(F, args); } SEAM(0);
    if (IN(1)) { p1_norm(F, args); } SEAM(1);
    if (IN(2)) {
        SchedP2 S{F.G, F.bid, (const char*)F.out, (const char*)(ws + WS_WIN), (char*)(ws + WS_P), (char*)(ws + WS_PC)};
        EpiStoreBf16 E;
        gm::gemm_phase<SchedP2, EpiStoreBf16, false>(F.lds, DM, S, E);
    } SEAM(2);
    if (IN(3)) { p_mix1(F, args); } SEAM(3);
    if (IN(4)) { p_mix2(F, args); } SEAM(4);
    if (IN(6)) {
        const bool conv_first = ((F.bid >> 3) & 1) != 0;
        if (conv_first) { p_moe_weights13(F, args); p_moe_weights2(F, args, F.bid, F.G); __syncthreads(); }
        {
            SchedP5 S{F.bid, (const char*)(ws + WS_YAG), (const char*)(ws + WS_YBG), (const char*)(ws + WS_WPA), (const char*)(ws + WS_WPB), nullptr, (char*)(ws + WS_M)};
            EpiP5 E{(unsigned*)F.out + (size_t)F.bid * 32768, (const bf16*)(ws + WS_P + 7 * GS), (const bf16*)(ws + WS_P + 8 * GS)};
            gm::gemm_phase<SchedP5, EpiP5, false>(F.lds, DM, S, E);
        }
        if (!conv_first) { __syncthreads(); p_moe_weights13(F, args); p_moe_weights2(F, args, F.bid, F.G); }
    } SEAM(6);
    if (IN(7)) {
        SchedP6 S{F.bid, (const char*)(ws + WS_M), (const char*)(ws + WS_WOUT), (char*)F.out};
        EpiP6 E{args.in[IN_X], (const float*)(ws + WS_MOD)};
        gm::gemm_phase<SchedP6, EpiP6, false>(F.lds, DM, S, E);
    } SEAM(7);
    if (IN(8)) { p_norm2_route(F, args); } SEAM(8);
    if (IN(9)) {
        moe_table(F, (const int*)(F.ctl + CW_CNT));
        {
            SchedMoe1 S{F.G, F.bid, F.lane, F.MISC, (const int*)(ws + WS_LIST), (const char*)(ws + WS_HX2), (const char*)(ws + WS_W1T), (const char*)(ws + WS_W3T), (char*)(ws + WS_HH), F.ctl + CW_TILE};
            EpiMoe1 E{(char*)(ws + WS_HH)};
            gm::gemm_phase<SchedMoe1, EpiMoe1, true, true>(F.lds, DM, S, E);
        }
        {
            SchedMoe2 S{F.G, F.bid, F.lane, F.MISC, (const char*)(ws + WS_HH), (const char*)(ws + WS_W2T), (char*)(ws + WS_Y), F.ctl + CW_TILE, F.ctl + 2};
            EpiMoe2 E{(const int*)(ws + WS_LIST)};
            gm::gemm_phase<SchedMoe2, EpiMoe2, false, true>(F.lds, DEXP, S, E);
        }
    } SEAM(9);
    if (IN(11)) { p_final(F, args); }
#ifdef PROBE_A
    if (F.bid == 0 && F.tid == 0) {
        const unsigned long long tend = __builtin_amdgcn_s_memrealtime();
        F.MISC[32 + 2 * 12] = (unsigned)tend; F.MISC[33 + 2 * 12] = (unsigned)(tend >> 32);
        auto RD = [&](int k) { return ((unsigned long long)F.MISC[33 + 2 * k] << 32) | F.MISC[32 + 2 * k]; };
        auto T = [&](int k) { if (k >= 20) { const int i = k - 20; return (unsigned long long)(((((unsigned long long)F.MISC[103 + 2 * i] << 32) | F.MISC[102 + 2 * i]) + 400) / 800); } if (k == 13) return (unsigned long long)((RD(14) - RD(3) + 400) / 800); if (k == 15) return (unsigned long long)((RD(16) - RD(4) + 400) / 800); const unsigned long long t0 = ((unsigned long long)F.MISC[33 + 2 * k] << 32) | F.MISC[32 + 2 * k], t1 = ((unsigned long long)F.MISC[33 + 2 * (k + 1)] << 32) | F.MISC[32 + 2 * (k + 1)]; return (unsigned long long)((t1 - t0 + 400) / 800); };
        const unsigned long long delay = (T(PROBE_A) + 64ull * T(PROBE_B)) * 6400ull;
        while (__builtin_amdgcn_s_memrealtime() - tend < delay) __builtin_amdgcn_s_sleep(32);
    }
#endif
#undef IN
#undef SEAM
}

#if !LRU_FAST
__global__ void k_conv_f(const bf16* P0, const bf16* PC0, const float* cw, const float* cb, float* Ub, int b) {
    int t = blockIdx.x; int Lseg = t < CTX ? CTX : SEQ; int lt = t < CTX ? t : t - CTX;
    const bf16* base = t < CTX ? PC0 + (size_t)b * CTX * DM : P0 + (size_t)b * SEQ * DM;
    for (int ch = threadIdx.x; ch < DM; ch += 256) {
        float s = cb[ch];
#pragma unroll
        for (int k = 0; k < 4; ++k) { int tt = lt + k - 2; if (tt >= 0 && tt < Lseg) s += cw[k * DM + ch] * bf2f(base[(size_t)tt * DM + ch]); }
        Ub[(size_t)t * DM + ch] = s;
    }
}
__global__ void k_gates(const float* Ub, const float* wa, const float* ba, const float* wx, const float* bx, const float* lam, float* Aout, float* Bout, int d) {
    __shared__ float us[128];
    int t = blockIdx.x, h = blockIdx.y, j = threadIdx.x; int ch = h * 128 + j;
    float uval = Ub[(size_t)t * DM + ch];
    us[j] = uval; __syncthreads();
    const float* wah = wa + ((size_t)(d * 8 + h) * 128) * 128; const float* wxh = wx + ((size_t)(d * 8 + h) * 128) * 128;
    float ra = 0.f, ia = 0.f;
    for (int i = 0; i < 128; ++i) { float u = us[i]; ra += u * wah[i * 128 + j]; ia += u * wxh[i * 128 + j]; }
    float r = 1.f / (1.f + expf(-(ra + ba[d * DM + ch]))); float ig = 1.f / (1.f + expf(-(ia + bx[d * DM + ch])));
    float sp = log1pf(expf(-lam[d * DM + ch]));
    float log_a = -8.f * r * sp;
    Aout[(size_t)t * DM + ch] = expf(log_a); Bout[(size_t)t * DM + ch] = sqrtf(-expm1f(2.f * log_a)) * (ig * uval);
}
__global__ void k_lru_scan(const float* A0, const float* B0, const float* A1, const float* B1, float* YF, float* YB) {
    int g = blockIdx.x * 256 + threadIdx.x; int d = g / DM, ch = g % DM;
    if (d == 0) { float h = B0[ch];
        for (int t = 0; t < SEQ; ++t) { size_t o = (size_t)(CTX + t) * DM + ch; h = A0[o] * h + B0[o]; YF[(size_t)t * DM + ch] = h; }
    } else { float h = B1[(size_t)(CTX - 1) * DM + ch];
        for (int t = SEQ - 1; t >= 0; --t) { size_t o = (size_t)(CTX + t) * DM + ch; h = A1[o] * h + B1[o]; YB[(size_t)t * DM + ch] = h; }
    }
}
__global__ void k_yag_f(const float* YF, const float* YB, bf16* AY, int b) {
    int t = blockIdx.x;
    for (int ch = threadIdx.x; ch < DM; ch += 256) { size_t o = (size_t)t * DM + ch; bf16* p = AY + ((size_t)b * SEQ + t) * DM + ch;
        *p = (bf16)f2bf((YF[o] + YB[o]) * gelu_tanh(bf2f(*p))); }
}
#endif
#if !HG_FAST
__global__ __launch_bounds__(128) void k_hgrn_f(unsigned char* ws, const float* hg_lb) {
    __shared__ float gs[128], ks[128], qs[128];
    int h = blockIdx.x, d = blockIdx.y, b = blockIdx.z, j = threadIdx.x;
    float S[128];
#pragma unroll
    for (int i = 0; i < 128; ++i) S[i] = 0.f;
    const int c = h * 128 + j;
    const float lbj = 1.f / (1.f + expf(hg_lb[DM + c] - hg_lb[c]));
    bf16* Q = (bf16*)(ws + WS_P + 2 * GS); bf16* Fx = (bf16*)(ws + WS_P + (d == 0 ? 3 : 4) * GS); bf16* V = (bf16*)(ws + WS_P + 5 * GS);
    const bf16* Fc = (const bf16*)(ws + WS_PC + (d == 0 ? 1 : 2) * CGS); const bf16* Vc = (const bf16*)(ws + WS_PC + 3 * CGS);
    for (int s = 0; s < LT; ++s) {
        bool isx = s >= CTX; float fv, vv, qv = 0.f; size_t o;
        if (!isx) { int t = d == 0 ? s : (CTX - 1 - s); o = ((size_t)b * CTX + t) * DM + c; fv = bf2f(Fc[o]); vv = bf2f(Vc[o]); }
        else { int p = s - CTX; if (d == 1) p = SEQ - 1 - p; int tok = (p % 32) * 64 + (p / 32); o = ((size_t)b * SEQ + tok) * DM + c; fv = bf2f(Fx[o]); vv = bf2f(V[o]); qv = bf2f(Q[o]); }
        float gg = lbj + (1.f - lbj) / (1.f + expf(-fv));
        gs[j] = gg; ks[j] = 1.f - gg; qs[j] = qv / (1.f + expf(-qv));
        __syncthreads();
        float oo = 0.f;
#pragma unroll
        for (int i = 0; i < 128; ++i) { S[i] = gs[i] * S[i] + ks[i] * vv; oo += S[i] * qs[i]; }
        if (isx) Fx[o] = (bf16)f2bf(oo);
        __syncthreads();
    }
}
#endif

extern "C" void kernel_launch(void* const* d_in, const int* in_sizes, int n_in, void* d_out, int out_size, void* d_ws, size_t ws_size, hipStream_t stream) {
    static int grid = 0;
    if (grid == 0) {
        if (n_in != 29 || out_size != NTOK * DM || ws_size < WS_END) { fprintf(stderr, "kernel_launch: unexpected problem shape / workspace (%d inputs, out %d, ws %zu)\n", n_in, out_size, ws_size); grid = -1; return; }
        int dev = 0, cus = 0, per_cu = 0;
        if (hipGetDevice(&dev) != hipSuccess || hipDeviceGetAttribute(&cus, hipDeviceAttributeMultiprocessorCount, dev) != hipSuccess) { grid = -1; return; }
        if (hipFuncSetAttribute((const void*)mega, hipFuncAttributeMaxDynamicSharedMemorySize, LDS_BYTES) != hipSuccess) { grid = -1; return; }
        if (hipOccupancyMaxActiveBlocksPerMultiprocessor(&per_cu, (const void*)mega, NTHR, LDS_BYTES) != hipSuccess || per_cu < 1) { fprintf(stderr, "kernel_launch: occupancy query says %d blocks per CU\n", per_cu); }
        (void)hipGetLastError();
        grid = cus;
        if (grid != 256) { fprintf(stderr, "kernel_launch: built for 256 CUs, found %d\n", cus); grid = -1; return; }
    }
    if (grid < 0) return;
    hipMemsetAsync((char*)d_ws + WS_CTL, 0, CTL_BYTES, stream);
    Args a{};
    for (int i = 0; i < 29; ++i) a.in[i] = (const float*)d_in[i];
    a.out = (float*)d_out; a.ws = (unsigned char*)d_ws;
#if MIX_FAST
    a.ph_lo = 0; a.ph_hi = 12; a.li = 0;
    hipLaunchKernelGGL(mega, dim3(grid), dim3(NTHR), LDS_BYTES, stream, a);
#else
    a.ph_lo = 0; a.ph_hi = 5; a.li = 0;
    hipLaunchKernelGGL(mega, dim3(grid), dim3(NTHR), LDS_BYTES, stream, a);
    {
        unsigned char* ws = (unsigned char*)d_ws;
#if !LRU_FAST
        float* sc = (float*)d_out;
        float* Ub = sc; float* A0 = Ub + (size_t)LT * DM; float* B0 = A0 + (size_t)LT * DM; float* A1 = B0 + (size_t)LT * DM; float* B1 = A1 + (size_t)LT * DM;
        float* YF = B1 + (size_t)LT * DM; float* YB = YF + (size_t)SEQ * DM;
        const float* cw = (const float*)d_in[IN_CONVW]; const float* cb = (const float*)d_in[IN_CONVB];
        const float* wa = (const float*)d_in[IN_WA]; const float* ba = (const float*)d_in[IN_BA]; const float* wx = (const float*)d_in[IN_WX]; const float* bx = (const float*)d_in[IN_BX]; const float* lam = (const float*)d_in[IN_LAM];
        for (int b = 0; b < NB; ++b) {
            k_conv_f<<<LT, 256, 0, stream>>>((const bf16*)(ws + WS_P), (const bf16*)(ws + WS_PC), cw, cb, Ub, b);
            k_gates<<<dim3(LT, 8), 128, 0, stream>>>(Ub, wa, ba, wx, bx, lam, A0, B0, 0);
            k_gates<<<dim3(LT, 8), 128, 0, stream>>>(Ub, wa, ba, wx, bx, lam, A1, B1, 1);
            k_lru_scan<<<8, 256, 0, stream>>>(A0, B0, A1, B1, YF, YB);
            k_yag_f<<<SEQ, 256, 0, stream>>>(YF, YB, (bf16*)(ws + WS_YAG), b);
        }
#endif
#if !HG_FAST
        k_hgrn_f<<<dim3(8, 2, NB), 128, 0, stream>>>(ws, (const float*)d_in[IN_HGLB]);
#endif
    }
    a.ph_lo = 5; a.ph_hi = 12; a.li = 1;
    hipLaunchKernelGGL(mega, dim3(grid), dim3(NTHR), LDS_BYTES, stream, a);
#endif
}
```

```cpp
#include <hip/hip_runtime.h>
#include <cstdio>
#include <cstdint>
#include <math.h>

#define LAS __attribute__((address_space(3)))
#define GAS __attribute__((address_space(1)))
typedef unsigned short bf16;
typedef short bf16x8 __attribute__((ext_vector_type(8)));
typedef float f32x4 __attribute__((ext_vector_type(4)));
typedef float f32x2 __attribute__((ext_vector_type(2)));
typedef unsigned u32x4 __attribute__((ext_vector_type(4)));
typedef unsigned u32x2 __attribute__((ext_vector_type(2)));

constexpr int DM = 1024, NB = 8, SEQ = 2048, CTX = 256, NTOK = NB * SEQ, NCTX = NB * CTX, INW = 9216, LT = CTX + SEQ;
constexpr int NEXP = 32, DEXP = 512, CAP = 16384;
constexpr float EPS = 1e-6f;
constexpr int NWAVES = 8, NTHR = 512;

constexpr size_t MiB = 1u << 20, KiB = 1024;
constexpr size_t WS_CTL = 0, CTL_BYTES = 64 * KiB;
constexpr size_t WS_MODP = 256 * KiB;
constexpr size_t WS_MOD = 2 * MiB;
constexpr size_t WS_LRUAGG = 2 * MiB + 512 * KiB;
constexpr size_t WS_LRUS0 = 4 * MiB + 512 * KiB;
constexpr size_t WS_WT = 4 * MiB + 768 * KiB;
constexpr size_t WS_LIST = 5 * MiB;
constexpr size_t WS_HGD = 7 * MiB;
constexpr size_t WS_WRT = 7 * MiB + 256 * KiB;
constexpr size_t WS_WIN = 8 * MiB;
constexpr size_t WS_WPA = 26 * MiB, WS_WPB = 28 * MiB, WS_WOUT = 30 * MiB;
constexpr size_t WS_WLRU = 32 * MiB;
constexpr size_t WS_P = 33 * MiB, GS = 32 * MiB;
constexpr size_t WS_PC = 321 * MiB, CGS = 4 * MiB;
constexpr size_t WS_END = 337 * MiB;
constexpr size_t WS_W1T = WS_P + 0 * GS, WS_W3T = WS_P + 2 * GS, WS_W2T = WS_P + 5 * GS;
constexpr size_t WS_YAG = WS_P + 1 * GS;
constexpr size_t WS_OF = WS_P + 3 * GS, WS_OB = WS_P + 4 * GS;
constexpr size_t WS_YBG = WS_P + 3 * GS;
constexpr size_t WS_M = WS_P + 4 * GS;
constexpr size_t WS_HX2 = WS_P + 1 * GS;
constexpr size_t WS_HH = WS_P + 3 * GS;
constexpr size_t WS_Y = WS_P + 6 * GS;

constexpr int CW_BAR = 1024;
constexpr int CW_CNT = 12288;
constexpr int CW_TILE = 14336;

constexpr int RING_BYTES = 131072, LDS_BYTES = 147456, LDSCTL_OFF = LDS_BYTES - 1024;

#define LDS_WAIT() asm volatile("s_waitcnt lgkmcnt(0)" ::: "memory")
#define VM_WAIT() asm volatile("s_waitcnt vmcnt(0)" ::: "memory")

typedef __bf16 bf16x2_t __attribute__((ext_vector_type(2)));
__device__ __forceinline__ unsigned pk2(float lo, float hi) { const f32x2 v = {lo, hi}; return __builtin_bit_cast(unsigned, __builtin_convertvector(v, bf16x2_t)); }
__device__ __forceinline__ unsigned f2bf(float f) { return pk2(f, 0.f) & 0xffffu; }
__device__ __forceinline__ float bf2f(unsigned short b) { return __builtin_bit_cast(float, (unsigned)b << 16); }
__device__ __forceinline__ float bflo(unsigned w) { return __builtin_bit_cast(float, w << 16); }
__device__ __forceinline__ float bfhi(unsigned w) { return __builtin_bit_cast(float, w & 0xffff0000u); }
__device__ __forceinline__ float sigmoidf_(float x) { return 1.f / (1.f + __expf(-x)); }
__device__ __forceinline__ float siluf_(float x) { return x / (1.f + __expf(-x)); }
__device__ __forceinline__ float gelu_tanh(float x) { float u = 0.7978845608028654f * (x + 0.044715f * x * x * x); float e = __expf(2.f * u); return x * (1.f - 1.f / (1.f + e)); }
__device__ __forceinline__ float wave_sum(float v) {
#pragma unroll
    for (int o = 1; o < 64; o <<= 1) v += __shfl_xor(v, o);
    return v;
}

#define XB_TMO      128
#define XB_XCNT(j)  (256  + 64 * (j))
#define XB_XSUB(j)  (1280 + 64 * (j))
#define XB_XGEN(j)  (2304 + 64 * (j))
#define XB_TOP      3328
#define XB_TOPGEN   3392
#define XCD_BAR_WORDS 3456
#define XB_SPIN_CAP (1u << 20)
__device__ __forceinline__ unsigned xb_ld(unsigned* p)              { return __hip_atomic_load(p, __ATOMIC_RELAXED, __HIP_MEMORY_SCOPE_AGENT); }
__device__ __forceinline__ unsigned xb_add(unsigned* p, unsigned v) { return __hip_atomic_fetch_add(p, v, __ATOMIC_RELAXED, __HIP_MEMORY_SCOPE_AGENT); }
__device__ __forceinline__ unsigned xb_xcc_id() { return (unsigned)__builtin_amdgcn_s_getreg((3 << 11) | 20) & 0xFu; }
#define XB_SPIN(cond, bar) do { unsigned _sp = 0; while (cond) { __builtin_amdgcn_s_sleep(1); \
    if ((++_sp & 255u) == 0u) { if (xb_ld(&(bar)[XB_TMO])) break; if (_sp > XB_SPIN_CAP) { atomicAdd(&(bar)[XB_TMO], 1u); break; } } } } while (0)
struct XcdBarrier { unsigned* bar; unsigned x; volatile LAS unsigned* st; };
__device__ __forceinline__ XcdBarrier xcd_barrier_post(unsigned* bar, volatile LAS unsigned* st) {
    XcdBarrier b; b.bar = bar; b.x = xb_xcc_id(); b.st = st;
    if (threadIdx.x == 0) (void)xb_add(&bar[XB_XCNT(b.x)], 1u);
    return b;
}
__device__ __forceinline__ void xcd_barrier_complete(unsigned* bar, unsigned x, unsigned& nloc, unsigned& nx) {
    const unsigned G = gridDim.x * gridDim.y * gridDim.z;
    unsigned sum, cnt, mine, sp = 0u;
    for (;;) {
        sum = 0u; cnt = 0u; mine = 0u;
#pragma unroll
        for (unsigned j = 0; j < 16; ++j) { const unsigned c = xb_ld(&bar[XB_XCNT(j)]); sum += c; cnt += (c > 0u) ? 1u : 0u; mine = (j == x) ? c : mine; }
        if (sum == G) break;
        __builtin_amdgcn_s_sleep(1);
        if ((++sp & 255u) == 0u) { if (xb_ld(&bar[XB_TMO])) break; if (sp > XB_SPIN_CAP) { atomicAdd(&bar[XB_TMO], 1u); break; } }
    }
    nloc = mine > 0u ? mine : 1u; nx = cnt > 0u ? cnt : 1u;
}
__device__ __forceinline__ void xcd_barrier(const XcdBarrier& b) {
    asm volatile("s_waitcnt vmcnt(0)" ::: "memory");
    __syncthreads();
    if (threadIdx.x == 0) {
        unsigned* bar = b.bar;
        __builtin_amdgcn_s_waitcnt(0);
        unsigned nloc = b.st[0], nx = b.st[1];
        if (nloc == 0u) { xcd_barrier_complete(bar, b.x, nloc, nx); b.st[0] = nloc; b.st[1] = nx; }
        const unsigned old = xb_add(&bar[XB_XSUB(b.x)], 1u);
        const unsigned gen = old / nloc;
        if (old + 1u == (gen + 1u) * nloc) {
            __builtin_amdgcn_fence(__ATOMIC_RELEASE, "agent");
            asm volatile("s_waitcnt vmcnt(0)" ::: "memory");
            const unsigned og = xb_add(&bar[XB_TOP], 1u);
            const unsigned tg = og / nx;
            if (og + 1u == (tg + 1u) * nx) xb_add(&bar[XB_TOPGEN], 1u);
            else XB_SPIN(xb_ld(&bar[XB_TOPGEN]) == tg, bar);
            __builtin_amdgcn_fence(__ATOMIC_ACQUIRE, "agent");
            xb_add(&bar[XB_XGEN(b.x)], 1u);
            asm volatile("s_waitcnt vmcnt(0)" ::: "memory");
        } else {
            XB_SPIN(xb_ld(&bar[XB_XGEN(b.x)]) == gen, bar);
            __builtin_amdgcn_fence(__ATOMIC_ACQUIRE, "agent");
            asm volatile("s_waitcnt vmcnt(0)" ::: "memory");
        }
    }
    __syncthreads();
}

namespace gm {
constexpr int BM = 256, BK = 64, HALF = 128, HTB = HALF * BK * 2;
__device__ __forceinline__ int lds_byte(int r, int c) { const int st = (r >> 4) * 2 + (c >> 5), rr = r & 15, cc = c & 31, ob = rr * 64 + cc * 2; return st * 1024 + (ob ^ (((ob >> 9) & 1) << 5)); }
__device__ __forceinline__ void stage_rc(int b, int& R, int& C) { const int st = b / 1024, sb = b % 1024, swz = sb ^ (((sb >> 9) & 1) << 5); R = (st >> 1) * 16 + swz / 64; C = (st & 1) * 32 + (swz % 64) / 2; }
__device__ __forceinline__ int perm32(int rho) { const int n = rho >> 4, i = rho & 15; return 8 * (i >> 2) + 4 * n + (i & 3); }
__device__ __forceinline__ unsigned cvt_pk_bf16(float lo, float hi) { unsigned r; asm volatile("v_cvt_pk_bf16_f32 %0, %1, %2" : "=v"(r) : "v"(lo), "v"(hi)); return r; }

struct Unit { const char* A; const char* B0; const char* B1; char* dst; int pm, pn, e, rows, t; };

template <class Sched, class Epi, bool GATHER, bool HOOKS = false>
__device__ __forceinline__ void gemm_phase(LAS unsigned char* lds, const int K, const Sched& S, const Epi& E) {
    const int tid = threadIdx.x, wid = __builtin_amdgcn_readfirstlane(tid >> 6), lane = tid & 63, wr = wid >> 2, wc = wid & 3, fr = lane & 15, fq = lane >> 4;
    const int nt = K / BK;
    unsigned voffB[2]; int Rr[2]; unsigned Cb[2];
#pragma unroll
    for (int i = 0; i < 2; ++i) { int R, C; stage_rc(tid * 16 + i * 8192, R, C); const int Rb = Epi::PERM ? ((R & ~31) + perm32(R & 31)) : R;
        Rr[i] = R; Cb[i] = (unsigned)C * 2u; voffB[i] = (unsigned)(Rb * K + C) * 2u; }
    const unsigned rowb = (unsigned)K * 2u;
    const size_t kstep = (size_t)(BK * 2);
    const unsigned ldsw = (unsigned)wid * 1024u;
    const int aoff = lds_byte(wr * 64 + fr, fq * 8), boff = lds_byte(wc * 32 + fr, fq * 8);
#define GM_SA(b, h) (((b) * 2 + (h)) * HTB)
#define GM_SB(b, h) ((4 + (b) * 2 + (h)) * HTB)
#define GM_STAGE(bufoff, gbase, voff) do { _Pragma("unroll") for (int _i = 0; _i < 2; ++_i) \
        __builtin_amdgcn_global_load_lds((const unsigned*)((const char*)(gbase) + (voff)[_i]), (LAS unsigned*)(lds + (bufoff) + ldsw + _i * 8192), 16, 0, 0); } while (0)
#define GM_LDA(dst, b, h) do { _Pragma("unroll") for (int m = 0; m < 4; ++m) _Pragma("unroll") for (int k = 0; k < 2; ++k) dst[m][k] = *(const LAS bf16x8*)(lds + GM_SA(b, h) + aoff + m * 2048 + k * 1024); } while (0)
#define GM_LDB(dst, b, h) do { _Pragma("unroll") for (int n = 0; n < 2; ++n) _Pragma("unroll") for (int k = 0; k < 2; ++k) dst[n][k] = *(const LAS bf16x8*)(lds + GM_SB(b, h) + boff + n * 2048 + k * 1024); } while (0)
#define GM_MMA(ai, bj, At, Bt) do { __builtin_amdgcn_s_setprio(1); _Pragma("unroll") for (int m = 0; m < 4; ++m) _Pragma("unroll") for (int n = 0; n < 2; ++n) _Pragma("unroll") for (int k = 0; k < 2; ++k) \
        acc[ai][bj][m][n] = __builtin_amdgcn_mfma_f32_16x16x32_bf16(Bt[n][k], At[m][k], acc[ai][bj][m][n], 0, 0, 0); __builtin_amdgcn_s_setprio(0); } while (0)
#define GM_WAIT_V(n) asm volatile("s_waitcnt vmcnt(" #n ")" ::: "memory")
#define GM_WAIT_L(n) asm volatile("s_waitcnt lgkmcnt(" #n ")" ::: "memory")
#define GM_BAR __builtin_amdgcn_s_barrier()
#define GM_SCHED __builtin_amdgcn_sched_barrier(0)
#define GM_AOFFS(u, o) do { _Pragma("unroll") for (int _h = 0; _h < 2; ++_h) _Pragma("unroll") for (int _i = 0; _i < 2; ++_i) \
        (o)[_h][_i] = (GATHER ? S.arow((u), _h * HALF + Rr[_i]) : (unsigned)(_h * HALF + Rr[_i])) * rowb + Cb[_i]; } while (0)
    Unit cur, nxt; int ui = 0;
    if (!S.next(0, cur)) return;
    f32x4 acc[2][2][4][2];
#pragma unroll
    for (int a = 0; a < 2; ++a)
#pragma unroll
        for (int b = 0; b < 2; ++b)
#pragma unroll
            for (int m = 0; m < 4; ++m)
#pragma unroll
                for (int n = 0; n < 2; ++n) acc[a][b][m][n] = (f32x4){0.f, 0.f, 0.f, 0.f};
    bf16x8 At[4][2], B0[2][2], B1[2][2];
    unsigned ca[2][2], na[2][2];
    GM_AOFFS(cur, ca);
    const char* cA = cur.A; const char* cB0 = cur.B0; const char* cB1 = cur.B1;
    if constexpr (HOOKS) S.a_ready(cur);
    GM_STAGE(GM_SB(0, 0), cB0, voffB); GM_STAGE(GM_SB(0, 1), cB1, voffB); GM_STAGE(GM_SA(0, 0), cA, ca[0]); GM_STAGE(GM_SA(0, 1), cA, ca[1]);
    if (wr == 1) GM_BAR;
    GM_WAIT_V(2); GM_BAR;
    GM_STAGE(GM_SB(1, 0), cB0 + kstep, voffB); GM_STAGE(GM_SA(1, 0), cA + kstep, ca[0]); GM_STAGE(GM_SB(1, 1), cB1 + kstep, voffB);
    GM_WAIT_V(6); GM_BAR;
    for (;;) {
        const bool has_next = S.next(ui + 1, nxt);
        const char* nA = has_next ? nxt.A : cA; const char* nB0 = has_next ? nxt.B0 : cB0; const char* nB1 = has_next ? nxt.B1 : cB1;
        if (has_next) { GM_AOFFS(nxt, na); } else {
#pragma unroll
            for (int h = 0; h < 2; ++h)
#pragma unroll
                for (int i = 0; i < 2; ++i) na[h][i] = ca[h][i]; }
        for (int t = 0; t < nt; t += 2) {
            const bool last = (t == nt - 2);
            if constexpr (HOOKS) { if (last && has_next) S.a_ready(nxt); }
            const char* a1 = cA + (size_t)(t + 1) * kstep;
            const char* a2 = last ? nA : cA + (size_t)(t + 2) * kstep;
            const char* b20 = last ? nB0 : cB0 + (size_t)(t + 2) * kstep; const char* b21 = last ? nB1 : cB1 + (size_t)(t + 2) * kstep;
            const char* a3 = a2 + kstep; const char* b30 = b20 + kstep; const char* b31 = b21 + kstep;
            unsigned o2[2][2];
#pragma unroll
            for (int h = 0; h < 2; ++h)
#pragma unroll
                for (int i = 0; i < 2; ++i) o2[h][i] = last ? na[h][i] : ca[h][i];
            GM_LDB(B0, 0, 0); GM_LDB(B1, 0, 1); GM_SCHED; GM_LDA(At, 0, 0); GM_STAGE(GM_SA(1, 1), a1, ca[1]);
            GM_WAIT_V(8); GM_WAIT_L(0); GM_BAR; GM_MMA(0, 0, At, B0); GM_MMA(0, 1, At, B1); GM_BAR; GM_SCHED;
            GM_LDA(At, 0, 1); GM_STAGE(GM_SB(0, 0), b20, voffB); GM_STAGE(GM_SB(0, 1), b21, voffB); GM_STAGE(GM_SA(0, 0), a2, o2[0]);
            GM_WAIT_V(8); GM_WAIT_L(0); GM_BAR; GM_MMA(1, 0, At, B0); GM_MMA(1, 1, At, B1); GM_BAR; GM_SCHED;
            GM_LDB(B0, 1, 0); GM_LDB(B1, 1, 1); GM_SCHED; GM_LDA(At, 1, 0); GM_STAGE(GM_SA(0, 1), a2, o2[1]);
            GM_WAIT_V(8); GM_WAIT_L(0); GM_BAR; GM_MMA(0, 0, At, B0); GM_MMA(0, 1, At, B1); GM_BAR; GM_SCHED;
            GM_LDA(At, 1, 1); GM_STAGE(GM_SB(1, 0), b30, voffB); GM_STAGE(GM_SB(1, 1), b31, voffB); GM_STAGE(GM_SA(1, 0), a3, o2[0]);
            GM_WAIT_V(8); GM_WAIT_L(0); GM_BAR; GM_MMA(1, 0, At, B0); GM_MMA(1, 1, At, B1); GM_BAR; GM_SCHED;
        }
        if (wr == 0) GM_BAR;
        E(acc, cur, wr, wc, fr, fq);
        if constexpr (HOOKS) S.done(cur);
        if (!has_next) break;
#pragma unroll
        for (int a = 0; a < 2; ++a)
#pragma unroll
            for (int b = 0; b < 2; ++b)
#pragma unroll
                for (int m = 0; m < 4; ++m)
#pragma unroll
                    for (int n = 0; n < 2; ++n) acc[a][b][m][n] = (f32x4){0.f, 0.f, 0.f, 0.f};
        cur = nxt; cA = nA; cB0 = nB0; cB1 = nB1; ++ui;
#pragma unroll
        for (int h = 0; h < 2; ++h)
#pragma unroll
            for (int i = 0; i < 2; ++i) ca[h][i] = na[h][i];
        if (wr == 1) GM_BAR;
    }
    GM_WAIT_V(0);
    GM_BAR;
#undef GM_SA
#undef GM_SB
#undef GM_STAGE
#undef GM_LDA
#undef GM_LDB
#undef GM_MMA
#undef GM_WAIT_V
#undef GM_WAIT_L
#undef GM_BAR
#undef GM_SCHED
#undef GM_AOFFS
}
}
struct Args {
    const float* in[29]; float* out; unsigned char* ws; int ph_lo, ph_hi, li, pad;
};
struct Frame {
    LAS unsigned char* lds; volatile LAS unsigned* MISC;
    unsigned* ctl; unsigned char* ws; float* out;
    int tid, lane, wave, G, bid;
};
enum { IN_X = 0, IN_C, IN_CTX, IN_CCTX, IN_WMOD, IN_BMOD, IN_G1, IN_WIN, IN_CONVW, IN_CONVB, IN_WA, IN_BA, IN_WX, IN_BX, IN_LAM, IN_HGLB, IN_HGN,
       IN_WPA, IN_WPB, IN_WOUT, IN_G2, IN_WRG, IN_BRG, IN_WRE, IN_BRE, IN_W1, IN_W3, IN_W2, IN_FG };

constexpr int TR_BYTES = 64 * 64 * 4;
__device__ __forceinline__ void transpose_item(const float* W, int ldw, int K, bf16* WT, int k0, int n0, LAS float* scr, int lane) {
    const int lr = lane >> 4, ls = lane & 15;
    f32x4 v[16];
#pragma unroll
    for (int i = 0; i < 16; ++i) v[i] = *(const f32x4*)(W + (size_t)(k0 + 4 * i + lr) * ldw + n0 + 4 * ls);
#pragma unroll
    for (int i = 0; i < 16; ++i) { const int k = 4 * i + lr; *(LAS f32x4*)(scr + k * 64 + ((ls ^ ((k >> 3) & 7)) << 2)) = v[i]; }
    LDS_WAIT(); asm volatile("" ::: "memory");
    const int c = lane & 7;
#pragma unroll
    for (int j = 0; j < 8; ++j) { const int n = (lane >> 3) + 8 * j; const LAS float* s = scr + (8 * c) * 64 + ((((n >> 2) ^ c) << 2) | (n & 3));
        u32x4 o; o.x = pk2(s[0 * 64], s[1 * 64]); o.y = pk2(s[2 * 64], s[3 * 64]); o.z = pk2(s[4 * 64], s[5 * 64]); o.w = pk2(s[6 * 64], s[7 * 64]);
        *(u32x4*)(WT + (size_t)n * K + k0 + 8 * c) = o; }
    LDS_WAIT(); asm volatile("" ::: "memory");
}

__device__ __forceinline__ void p0_mod_item(Frame& F, const Args& a, int item) {
    const int cb = item % 24, ks = item / 24;
    LAS float* sv = (LAS float*)F.lds;
    LAS float* red = sv + 9 * 128;
    const float* c = a.in[IN_C]; const float* cc = a.in[IN_CCTX]; const float* wmod = a.in[IN_WMOD];
    for (int i = F.tid; i < 9 * 128; i += NTHR) { const int r = i >> 7, k = i & 127; const float v = r < 8 ? c[r * DM + ks * 128 + k] : cc[ks * 128 + k]; sv[i] = siluf_(v); }
    __syncthreads();
    const int col = cb * 256 + (F.tid & 255), kh = F.tid >> 8;
    float acc[9];
#pragma unroll
    for (int r = 0; r < 9; ++r) acc[r] = 0.f;
    for (int k0 = 0; k0 < 64; k0 += 16) { float wv[16];
#pragma unroll
        for (int k = 0; k < 16; ++k) wv[k] = wmod[(size_t)(ks * 128 + kh * 64 + k0 + k) * 6144 + col];
#pragma unroll
        for (int k = 0; k < 16; ++k) { const int kk = kh * 64 + k0 + k;
#pragma unroll
            for (int r = 0; r < 9; ++r) acc[r] += sv[r * 128 + kk] * wv[k]; } }
    if (kh == 1) {
#pragma unroll
        for (int r = 0; r < 9; ++r) red[r * 256 + (F.tid & 255)] = acc[r]; }
    __syncthreads();
    float* modp = (float*)(F.ws + WS_MODP);
    if (kh == 0) {
#pragma unroll
        for (int r = 0; r < 9; ++r) modp[(size_t)(ks * 9 + r) * 6144 + col] = acc[r] + red[r * 256 + F.tid]; }
    __syncthreads();
}
__device__ __forceinline__ float mod_from_partials(const float* modp, const float* bmod, int row, int j) {
    float s = bmod[j];
#pragma unroll
    for (int ks = 0; ks < 8; ++ks) s += modp[(size_t)(ks * 9 + row) * 6144 + j];
    return s;
}

__device__ __forceinline__ void p0_prologue(Frame& F, const Args& a) {
    if (F.bid < 192) p0_mod_item(F, a, F.bid);
    LAS float* scr = (LAS float*)(F.lds + F.wave * TR_BYTES);
    const int gw = F.bid * NWAVES + F.wave, NGW = F.G * NWAVES;
    constexpr int I_IN = 16 * 144, I_PR = 16 * 16, I_LRU = 32 * 4;
    constexpr int NITEMS = I_IN + 3 * I_PR + I_LRU;
    for (int it = gw; it < NITEMS; it += NGW) {
        int r = it;
        if (r < I_IN) { const int kb = r / 144, nb = r % 144; transpose_item(a.in[IN_WIN], INW, DM, (bf16*)(F.ws + WS_WIN) + (size_t)(nb * 64) * DM, kb * 64, nb * 64, scr, F.lane); continue; } r -= I_IN;
        if (r < 3 * I_PR) { const int w = r / I_PR, q = r % I_PR, kb = q / 16, nb = q % 16;
            const float* W = a.in[w == 0 ? IN_WPA : (w == 1 ? IN_WPB : IN_WOUT)]; bf16* WT = (bf16*)(F.ws + (w == 0 ? WS_WPA : (w == 1 ? WS_WPB : WS_WOUT)));
            transpose_item(W, DM, DM, WT + (size_t)(nb * 64) * DM, kb * 64, nb * 64, scr, F.lane); continue; } r -= 3 * I_PR;
        { const int mat = r / 4, q = r % 4, kb = q / 2, nb = q % 2;
          const int which = mat >> 4, dh = mat & 15;
          const float* W = a.in[which == 0 ? IN_WA : IN_WX] + (size_t)dh * 128 * 128; bf16* WT = (bf16*)(F.ws + WS_WLRU) + (size_t)mat * 128 * 128;
          transpose_item(W, 128, 128, WT + (size_t)(nb * 64) * 128, kb * 64, nb * 64, scr, F.lane); }
    }
    float* wrp = (float*)(F.ws + WS_WRT);
    for (int i = F.bid * NTHR + F.tid; i < 49152 + 48; i += F.G * NTHR) {
        if (i < 49152) { const int j = i & 3, ln = (i >> 2) & 63, sc = i >> 8, c = sc % 3, s2 = sc / 3; const int k = 16 * s2 + 4 * (ln >> 4) + j, o = 16 * c + (ln & 15);
            wrp[i] = o < 4 ? a.in[IN_WRG][k * 4 + o] : (o < 36 ? a.in[IN_WRE][k * 32 + (o - 4)] : 0.f); }
        else { const int o = i - 49152; wrp[i] = o < 4 ? a.in[IN_BRG][o] : (o < 36 ? a.in[IN_BRE][o - 4] : 0.f); }
    }
}

__device__ __forceinline__ void norm_rows(Frame& F, const float* src, bf16* dst, int row0, int nrows, const LAS float* gs, const LAS float* sh) {
    for (int r = F.wave; r < nrows; r += 2 * NWAVES) {
        const int r1 = r + NWAVES < nrows ? r + NWAVES : r;
        const f32x4* xa = (const f32x4*)(src + (size_t)(row0 + r) * DM) + F.lane; const f32x4* xb = (const f32x4*)(src + (size_t)(row0 + r1) * DM) + F.lane;
        f32x4 va[4], vb[4]; float sa = 0.f, sb = 0.f;
#pragma unroll
        for (int j = 0; j < 4; ++j) { va[j] = xa[64 * j]; vb[j] = xb[64 * j]; }
#pragma unroll
        for (int j = 0; j < 4; ++j) { sa += (va[j].x * va[j].x + va[j].y * va[j].y) + (va[j].z * va[j].z + va[j].w * va[j].w); sb += (vb[j].x * vb[j].x + vb[j].y * vb[j].y) + (vb[j].z * vb[j].z + vb[j].w * vb[j].w); }
        const float ra = rsqrtf(wave_sum(sa) * (1.f / DM) + EPS), rb = rsqrtf(wave_sum(sb) * (1.f / DM) + EPS);
        unsigned long long* oa = (unsigned long long*)(dst + (size_t)(row0 + r) * DM) + F.lane; unsigned long long* ob = (unsigned long long*)(dst + (size_t)(row0 + r1) * DM) + F.lane;
#pragma unroll
        for (int j = 0; j < 4; ++j) { const int k = 4 * F.lane + 256 * j;
            const f32x4 g = *(const LAS f32x4*)(gs + k), h = *(const LAS f32x4*)(sh + k);
            oa[64 * j] = (unsigned long long)pk2(va[j].x * ra * g.x + h.x, va[j].y * ra * g.y + h.y) | ((unsigned long long)pk2(va[j].z * ra * g.z + h.z, va[j].w * ra * g.w + h.w) << 32);
            ob[64 * j] = (unsigned long long)pk2(vb[j].x * rb * g.x + h.x, vb[j].y * rb * g.y + h.y) | ((unsigned long long)pk2(vb[j].z * rb * g.z + h.z, vb[j].w * rb * g.w + h.w) << 32); }
    }
}
__device__ __forceinline__ void p1_norm(Frame& F, const Args& a) {
    const float* modp = (const float*)(F.ws + WS_MODP); const float* bmod = a.in[IN_BMOD]; const float* g1 = a.in[IN_G1];
    LAS float* gs = (LAS float*)F.lds; LAS float* sh = gs + DM;
    bf16* H = (bf16*)F.out;
    float* mod = (float*)(F.ws + WS_MOD);
    for (int i = F.bid * NTHR + F.tid; i < 9 * 6144; i += F.G * NTHR) mod[i] = mod_from_partials(modp, bmod, i / 6144, i % 6144);
    const int b = F.bid / 32;
    for (int k = F.tid; k < DM; k += NTHR) { gs[k] = g1[k] * (1.f + mod_from_partials(modp, bmod, b, DM + k)); sh[k] = mod_from_partials(modp, bmod, b, k); }
    __syncthreads();
    norm_rows(F, a.in[IN_X], H, F.bid * 64, 64, gs, sh);
    __syncthreads();
    for (int k = F.tid; k < DM; k += NTHR) { gs[k] = g1[k] * (1.f + mod_from_partials(modp, bmod, 8, DM + k)); sh[k] = mod_from_partials(modp, bmod, 8, k); }
    __syncthreads();
    norm_rows(F, a.in[IN_CTX], H + (size_t)NTOK * DM, F.bid * 8, 8, gs, sh);
    __syncthreads();
}

struct EpiStoreBf16 {
    static constexpr bool PERM = true;
    __device__ __forceinline__ void operator()(const f32x4 (&acc)[2][2][4][2], const gm::Unit& u, int wr, int wc, int fr, int fq) const {
        bf16* base = (bf16*)u.dst + (size_t)(wr * 64 + fr) * DM + wc * 32 + 8 * fq;
#pragma unroll
        for (int ai = 0; ai < 2; ++ai)
#pragma unroll
            for (int m = 0; m < 4; ++m) { bf16* rowp = base + (size_t)(ai * 128 + m * 16) * DM;
#pragma unroll
                for (int bj = 0; bj < 2; ++bj) { const f32x4 v0 = acc[ai][bj][m][0], v1 = acc[ai][bj][m][1];
                    u32x4 w; w.x = gm::cvt_pk_bf16(v0[0], v0[1]); w.y = gm::cvt_pk_bf16(v0[2], v0[3]); w.z = gm::cvt_pk_bf16(v1[0], v1[1]); w.w = gm::cvt_pk_bf16(v1[2], v1[3]);
                    *(u32x4*)(rowp + bj * 128) = w; } }
    }
};
__device__ __forceinline__ void tile_order(int L, int nM, int nN, int& pm, int& pn) {
    const int nwg = nM * nN; int wgid = L;
    { const int q = nwg / 8, r = nwg % 8, xcd = wgid % 8, off = wgid / 8; wgid = (xcd < r ? xcd * (q + 1) : r * (q + 1) + (xcd - r) * q) + off; }
    const int nig = 8 * nN, gid = wgid / nig, fm = gid * 8, gsz = (nM - fm) < 8 ? (nM - fm) : 8;
    pm = fm + ((wgid % nig) % gsz); pn = (wgid % nig) / gsz;
}
struct SchedP2 {
    int G, c; const char* H; const char* Wt; char* P; char* PC;
    __device__ __forceinline__ bool next(int i, gm::Unit& u) const {
        int L = i * G + c;
        if (L < 64 * 36) { int pm, pn; tile_order(L, 64, 36, pm, pn);
            u.A = H + (size_t)pm * 256 * 2048; u.B0 = Wt + (size_t)pn * 256 * 2048; u.B1 = u.B0 + (size_t)128 * 2048;
            u.dst = P + (size_t)(pn >> 2) * GS + ((size_t)pm * 256 * DM + (pn & 3) * 256) * 2; u.pm = pm; u.pn = pn; u.e = 0; u.rows = 256; return true; }
        L -= 64 * 36; if (L >= 128) return false;
        const int pmc = L >> 4, j = L & 15, slot = j >> 2, g = slot == 0 ? 0 : slot + 2, pn = g * 4 + (j & 3);
        u.A = H + (size_t)(NTOK + pmc * 256) * 2048; u.B0 = Wt + (size_t)pn * 256 * 2048; u.B1 = u.B0 + (size_t)128 * 2048;
        u.dst = PC + (size_t)slot * CGS + ((size_t)pmc * 256 * DM + (j & 3) * 256) * 2; u.pm = pmc; u.pn = pn; u.e = 0; u.rows = 256; return true;
    }
    __device__ __forceinline__ unsigned arow(const gm::Unit&, int r) const { return (unsigned)r; }
};
constexpr int LRU_T = 128, LRU_NCH = SEQ / LRU_T, UF_LD = 144;
constexpr int LRU_UBF = 0, LRU_UF = 144 * 256;
constexpr float LOG2E = 1.4426950408889634f;

struct LruCoef { float ba, bx, ca; };

struct LruConvW { float w[4][8], bs[8]; };
__device__ __forceinline__ void lru_conv_weights(Frame& F, const Args& a, int h, LruConvW& cwv) {
    const float* cw = a.in[IN_CONVW] + h * 128; const float* cb = a.in[IN_CONVB] + h * 128; const int cg = F.tid & 15;
#pragma unroll
    for (int k = 0; k < 4; ++k) { const f32x4 w0 = *(const f32x4*)(cw + k * DM + 8 * cg), w1 = *(const f32x4*)(cw + k * DM + 8 * cg + 4);
        cwv.w[k][0] = w0.x; cwv.w[k][1] = w0.y; cwv.w[k][2] = w0.z; cwv.w[k][3] = w0.w; cwv.w[k][4] = w1.x; cwv.w[k][5] = w1.y; cwv.w[k][6] = w1.z; cwv.w[k][7] = w1.w; }
    { const f32x4 b0 = *(const f32x4*)(cb + 8 * cg), b1 = *(const f32x4*)(cb + 8 * cg + 4); cwv.bs[0] = b0.x; cwv.bs[1] = b0.y; cwv.bs[2] = b0.z; cwv.bs[3] = b0.w; cwv.bs[4] = b1.x; cwv.bs[5] = b1.y; cwv.bs[6] = b1.z; cwv.bs[7] = b1.w; }
}
__device__ __forceinline__ void lru_conv_load(Frame& F, int b, int h, int c, u32x4 (&raw)[4][4]) {
    const bf16* AX = (const bf16*)(F.ws + WS_P) + (size_t)b * SEQ * DM + h * 128;
    int cg = F.tid & 15, tl0 = F.tid >> 4;
    asm volatile("" : "+v"(cg), "+v"(tl0));
#pragma unroll
    for (int i = 0; i < 4; ++i)
#pragma unroll
        for (int k = 0; k < 4; ++k) { int tt = c * LRU_T + tl0 + 32 * i + k - 2; tt = tt < 0 ? 0 : (tt > SEQ - 1 ? SEQ - 1 : tt); raw[i][k] = *(const u32x4*)(AX + (size_t)tt * DM + 8 * cg); }
}
__device__ __forceinline__ void lru_conv(Frame& F, const LruConvW& cwv, const u32x4 (&raw)[4][4], int b, int h, int c, bool special) {
    LAS unsigned char* ubf = F.lds + LRU_UBF; LAS float* uf = (LAS float*)(F.lds + LRU_UF);
    int cg = F.tid & 15, tl0 = F.tid >> 4;
    asm volatile("" : "+v"(cg), "+v"(tl0));
    const float (&w)[4][8] = cwv.w; const float (&bs)[8] = cwv.bs;
#pragma unroll
    for (int i = 0; i < 4; ++i) { const int tl = tl0 + 32 * i;
        float u[8];
#pragma unroll
        for (int q = 0; q < 8; ++q) u[q] = bs[q];
#pragma unroll
        for (int k = 0; k < 4; ++k) { const int tt = c * LRU_T + tl + k - 2; const float mk = (tt >= 0 && tt < SEQ) ? 1.f : 0.f; const u32x4 v = raw[i][k];
            u[0] += mk * w[k][0] * bflo(v.x); u[1] += mk * w[k][1] * bfhi(v.x); u[2] += mk * w[k][2] * bflo(v.y); u[3] += mk * w[k][3] * bfhi(v.y);
            u[4] += mk * w[k][4] * bflo(v.z); u[5] += mk * w[k][5] * bfhi(v.z); u[6] += mk * w[k][6] * bflo(v.w); u[7] += mk * w[k][7] * bfhi(v.w); }
        *(LAS f32x4*)(uf + tl * UF_LD + 8 * cg) = (f32x4){u[0], u[1], u[2], u[3]};
        *(LAS f32x4*)(uf + tl * UF_LD + 8 * cg + 4) = (f32x4){u[4], u[5], u[6], u[7]};
        u32x4 p; p.x = pk2(u[0], u[1]); p.y = pk2(u[2], u[3]); p.z = pk2(u[4], u[5]); p.w = pk2(u[6], u[7]);
        *(LAS u32x4*)(ubf + tl * 256 + ((cg ^ (tl & 15)) << 4)) = p; }
    if (special) {
        const bf16* AC = (const bf16*)(F.ws + WS_PC) + (size_t)b * CTX * DM + h * 128;
        if (F.tid < 32) { const int tl = LRU_T + (F.tid >> 4); const int t = tl == LRU_T ? 0 : CTX - 1;
            float u[8];
#pragma unroll
            for (int q = 0; q < 8; ++q) u[q] = bs[q];
#pragma unroll
            for (int k = 0; k < 4; ++k) { const int tt = t + k - 2;
                if (tt >= 0 && tt < CTX) { const u32x4 v = *(const u32x4*)(AC + (size_t)tt * DM + 8 * cg);
                    u[0] += w[k][0] * bflo(v.x); u[1] += w[k][1] * bfhi(v.x); u[2] += w[k][2] * bflo(v.y); u[3] += w[k][3] * bfhi(v.y);
                    u[4] += w[k][4] * bflo(v.z); u[5] += w[k][5] * bfhi(v.z); u[6] += w[k][6] * bflo(v.w); u[7] += w[k][7] * bfhi(v.w); } }
            *(LAS f32x4*)(uf + tl * UF_LD + 8 * cg) = (f32x4){u[0], u[1], u[2], u[3]};
            *(LAS f32x4*)(uf + tl * UF_LD + 8 * cg + 4) = (f32x4){u[4], u[5], u[6], u[7]};
            u32x4 p; p.x = pk2(u[0], u[1]); p.y = pk2(u[2], u[3]); p.z = pk2(u[4], u[5]); p.w = pk2(u[6], u[7]);
            *(LAS u32x4*)(ubf + tl * 256 + ((cg ^ (tl & 15)) << 4)) = p;
        } else if (F.tid < 32 + 14 * 16) { const int tl = LRU_T + 2 + ((F.tid - 32) >> 4);
            *(LAS u32x4*)(ubf + tl * 256 + ((cg ^ (tl & 15)) << 4)) = (u32x4){0u, 0u, 0u, 0u}; }
    }
}
__device__ __forceinline__ void lru_load_w(Frame& F, int d, int h, bf16x8 (&Bw)[2][4]) {
    const int fr = F.lane & 15, fq = F.lane >> 4;
#pragma unroll
    for (int which = 0; which < 2; ++which) { const bf16* W = (const bf16*)(F.ws + WS_WLRU) + (size_t)(which * 16 + d * 8 + h) * 128 * 128 + (size_t)(16 * F.wave + fr) * 128 + 8 * fq;
#pragma unroll
        for (int kk = 0; kk < 4; ++kk) Bw[which][kk] = *(const bf16x8*)(W + kk * 32); }
}
__device__ __forceinline__ LruCoef lru_coef(const Args& a, int d, int ch) {
    LruCoef k; k.ba = -LOG2E * a.in[IN_BA][d * DM + ch]; k.bx = -LOG2E * a.in[IN_BX][d * DM + ch];
    const float sp = log1pf(expf(-a.in[IN_LAM][d * DM + ch])); k.ca = -8.f * sp * LOG2E; return k;
}
template <int V = 0> __device__ __forceinline__ void lru_tile(Frame& F, int m, const bf16x8 (&Bw)[2][4], const LruCoef& k, float (&av)[4], float (&bv)[4]) {
    const int fr = F.lane & 15, fq = F.lane >> 4;
    const LAS unsigned char* ubf = F.lds + LRU_UBF; const LAS float* uf = (const LAS float*)(F.lds + LRU_UF);
    f32x4 ar = {0.f, 0.f, 0.f, 0.f}, ai = {0.f, 0.f, 0.f, 0.f};
    const int row = m * 16 + fr;
#pragma unroll
    for (int kk = 0; kk < 4; ++kk) { const bf16x8 A = *(const LAS bf16x8*)(ubf + row * 256 + (((kk * 4 + fq) ^ fr) << 4));
        ar = __builtin_amdgcn_mfma_f32_16x16x32_bf16(A, Bw[0][kk], ar, 0, 0, 0); ai = __builtin_amdgcn_mfma_f32_16x16x32_bf16(A, Bw[1][kk], ai, 0, 0, 0); }
#pragma unroll
    for (int r = 0; r < 4; ++r) { const float u = uf[(m * 16 + 4 * fq + r) * UF_LD + 16 * F.wave + fr];
        if (V == 2) { av[r] = __builtin_fmaf(ar[r], -LOG2E, k.ba) * k.ca; bv[r] = __builtin_fmaf(ai[r], -LOG2E, k.bx) * u; continue; }
        const float rg = __builtin_amdgcn_rcpf(1.f + __builtin_amdgcn_exp2f(__builtin_fmaf(ar[r], -LOG2E, k.ba)));
        const float ig = __builtin_amdgcn_rcpf(1.f + __builtin_amdgcn_exp2f(__builtin_fmaf(ai[r], -LOG2E, k.bx)));
        const float aa = __builtin_amdgcn_exp2f(k.ca * rg);
        av[r] = aa; bv[r] = __builtin_amdgcn_sqrtf(__builtin_fmaf(-aa, aa, 1.f)) * (ig * u); }
}
template <bool FWD, int V = 0> __device__ __forceinline__ void lru_tile_total(int fq, float& A, float& B) {
    if (V == 1) return;
#pragma unroll
    for (int s = 0; s < 2; ++s) { const int bit = 1 << s; const float Ap = __shfl_xor(A, 16 << s), Bp = __shfl_xor(B, 16 << s);
        const bool mine_first = FWD ? ((fq & bit) == 0) : ((fq & bit) != 0);
        if (mine_first) { B = B * Ap + Bp; A = A * Ap; } else { B = Bp * A + B; A = Ap * A; } }
}

template <int V = 0> __device__ __forceinline__ void lru_phase1(Frame& F, const Args& a, float* agg_base) {
    const int NU = NB * 8 * LRU_NCH;
    if (F.bid >= NU) return;
    const int fr = F.lane & 15, fq = F.lane >> 4;
    const int h = (F.bid >> 4) & 7; const int ch = h * 128 + 16 * F.wave + fr;
    const LruCoef k0 = lru_coef(a, 0, ch), k1 = lru_coef(a, 1, ch);
    for (int unit = F.bid; unit < NU; unit += F.G) {
        const int c = unit & (LRU_NCH - 1), b = unit >> 7;
        bf16x8 Bw0[2][4], Bw1[2][4]; lru_load_w(F, 0, h, Bw0); lru_load_w(F, 1, h, Bw1);
        { u32x4 raw[4][4]; lru_conv_load(F, b, h, c, raw); LruConvW cwv; lru_conv_weights(F, a, h, cwv); lru_conv(F, cwv, raw, b, h, c, c == 0 && V == 0); }
        LDS_WAIT(); __syncthreads();
        float Af = 1.f, Hf = 0.f, Ab = 1.f, Hb = 0.f;
#pragma unroll 2
        for (int m = 0; m < 8; ++m) {
            float av[4], bv[4];
            lru_tile<V>(F, m, Bw0, k0, av, bv);
            float A = av[0] * av[1] * av[2] * av[3], B = ((bv[0] * av[1] + bv[1]) * av[2] + bv[2]) * av[3] + bv[3];
            lru_tile_total<true, V>(fq, A, B);
            Hf = Hf * A + B; Af = Af * A;
            lru_tile<V>(F, m, Bw1, k1, av, bv);
            A = av[0] * av[1] * av[2] * av[3]; B = ((bv[3] * av[2] + bv[2]) * av[1] + bv[1]) * av[0] + bv[0];
            lru_tile_total<false, V>(fq, A, B);
            Hb = B * Ab + Hb; Ab = A * Ab;
        }
        float* agg = agg_base;
        if (fq == 0) { *(f32x2*)(agg + ((size_t)((b * LRU_NCH + c) * 2 + 0) * DM + ch) * 2) = (f32x2){Af, Hf};
                       *(f32x2*)(agg + ((size_t)((b * LRU_NCH + c) * 2 + 1) * DM + ch) * 2) = (f32x2){Ab, Hb}; }
        if (c == 0 && V == 0) {
            float av[4], bv[4]; float* s0 = (float*)(F.ws + WS_LRUS0);
            lru_tile(F, 8, Bw0, k0, av, bv); if (fq == 0) s0[(b * 2 + 0) * DM + ch] = bv[0];
            lru_tile(F, 8, Bw1, k1, av, bv); if (fq == 0) s0[(b * 2 + 1) * DM + ch] = bv[1];
        }
        __syncthreads();
    }
}

__device__ __forceinline__ void lru_pass2(Frame& F, const Args& a, int unit, const LruCoef& kf, const LruCoef& kb) {
    const int c = unit & (LRU_NCH - 1), h = (unit >> 4) & 7, b = unit >> 7;
    const int fr = F.lane & 15, fq = F.lane >> 4; const int ch = h * 128 + 16 * F.wave + fr;
    const float* agg = (const float*)(F.ws + WS_LRUAGG); const float* s0 = (const float*)(F.ws + WS_LRUS0);
    f32x2 ag[LRU_NCH];
#pragma unroll
    for (int j = 0; j < LRU_NCH; ++j) ag[j] = *(const f32x2*)(agg + ((size_t)((b * LRU_NCH + j) * 2 + (j < c ? 0 : 1)) * DM + ch) * 2);
    float hf = s0[(b * 2 + 0) * DM + ch], hb = s0[(b * 2 + 1) * DM + ch];
    bf16* AY = (bf16*)(F.ws + WS_YAG) + ((size_t)b * SEQ + c * LRU_T) * DM + h * 128;
    u32x4 ayv[4];
#pragma unroll
    for (int i = 0; i < 4; ++i) ayv[i] = *(const u32x4*)(AY + (size_t)((F.tid >> 4) + 32 * i) * DM + 8 * (F.tid & 15));
    bf16x8 Bw[2][4], Bw1[2][4]; lru_load_w(F, 0, h, Bw);
    LruCoef k = kf; const LruCoef k1 = kb;
    { u32x4 raw[4][4]; lru_conv_load(F, b, h, c, raw); LruConvW cwv; lru_conv_weights(F, a, h, cwv); lru_conv(F, cwv, raw, b, h, c, false); }
    lru_load_w(F, 1, h, Bw1);
#pragma unroll
    for (int j = 0; j < LRU_NCH; ++j) if (j < c) hf = ag[j].x * hf + ag[j].y;
#pragma unroll
    for (int j = LRU_NCH - 1; j >= 0; --j) if (j > c) hb = ag[j].x * hb + ag[j].y;
    LDS_WAIT(); __syncthreads();
    float hfv[8][4];
#pragma unroll
    for (int m = 0; m < 8; ++m) {
        float av[4], bv[4];
        lru_tile(F, m, Bw, k, av, bv);
        const float A = av[0] * av[1] * av[2] * av[3], B = ((bv[0] * av[1] + bv[1]) * av[2] + bv[2]) * av[3] + bv[3];
        float hin = hf;
#pragma unroll
        for (int g = 0; g < 4; ++g) { const float Ag = __shfl(A, g * 16 + fr), Bg = __shfl(B, g * 16 + fr); if (g < fq) hin = Ag * hin + Bg; hf = Ag * hf + Bg; }
#pragma unroll
        for (int r = 0; r < 4; ++r) { hin = av[r] * hin + bv[r]; hfv[m][r] = hin; }
    }
    k = k1;
    LAS float* uf = (LAS float*)(F.lds + LRU_UF);
#pragma unroll
    for (int m = 7; m >= 0; --m) {
        float av[4], bv[4];
        lru_tile(F, m, Bw1, k, av, bv);
        const float A = av[0] * av[1] * av[2] * av[3], B = ((bv[3] * av[2] + bv[2]) * av[1] + bv[1]) * av[0] + bv[0];
        float hin = hb;
#pragma unroll
        for (int g = 3; g >= 0; --g) { const float Ag = __shfl(A, g * 16 + fr), Bg = __shfl(B, g * 16 + fr); if (g > fq) hin = Ag * hin + Bg; hb = Ag * hb + Bg; }
#pragma unroll
        for (int r = 3; r >= 0; --r) { hin = av[r] * hin + bv[r]; uf[(m * 16 + 4 * fq + r) * UF_LD + 16 * F.wave + fr] = hfv[m][r] + hin; }
    }
    LDS_WAIT(); __syncthreads();
    const int cg = F.tid & 15;
#pragma unroll
    for (int i = 0; i < 4; ++i) { const int tl = (F.tid >> 4) + 32 * i;
        const f32x4 y0 = *(const LAS f32x4*)(uf + tl * UF_LD + 8 * cg), y1 = *(const LAS f32x4*)(uf + tl * UF_LD + 8 * cg + 4);
        const u32x4 g = ayv[i];
        u32x4 o; o.x = pk2(y0.x * gelu_tanh(bflo(g.x)), y0.y * gelu_tanh(bfhi(g.x))); o.y = pk2(y0.z * gelu_tanh(bflo(g.y)), y0.w * gelu_tanh(bfhi(g.y)));
        o.z = pk2(y1.x * gelu_tanh(bflo(g.z)), y1.y * gelu_tanh(bfhi(g.z))); o.w = pk2(y1.z * gelu_tanh(bflo(g.w)), y1.w * gelu_tanh(bfhi(g.w)));
        *(u32x4*)(AY + (size_t)tl * DM + 8 * cg) = o; }
    __syncthreads();
}
constexpr int HG_C = 64, HG_SEG = 512, HG_NSEG = 4;
constexpr int HG_QS = 0, HG_QM = 16384, HG_KM = 32768, HG_KDT = 49152, HG_VT = 65536, HG_ATT = 81920, HG_PART = 90112, HG_ETOT = 94208, HG_ROWS = 94720;
constexpr size_t HGS_IMG = 65536;
#ifdef PROBE_A
#define HSTAMP(i) do { if (F.bid == 0 && F.tid == 0) { const unsigned long long _t = __builtin_amdgcn_s_memrealtime(); const unsigned long long _p = ((unsigned long long)F.MISC[101] << 32) | F.MISC[100]; \
    unsigned long long _a = ((unsigned long long)F.MISC[103 + 2 * (i)] << 32) | F.MISC[102 + 2 * (i)]; _a += _t - _p; F.MISC[102 + 2 * (i)] = (unsigned)_a; F.MISC[103 + 2 * (i)] = (unsigned)(_a >> 32); F.MISC[100] = (unsigned)_t; F.MISC[101] = (unsigned)(_t >> 32); } } while (0)
#else
#define HSTAMP(i) do { } while (0)
#endif

__device__ __forceinline__ int hg_row(int b, int dir, bool ctx, int sigma) {
    if (ctx) { const int t = dir ? (CTX - 1 - sigma) : sigma; return b * CTX + t; }
    const int p = dir ? (SEQ - 1 - sigma) : sigma; return b * SEQ + (p & 31) * 64 + (p >> 5);
}

struct HgRaw { unsigned f[8], v[8], q[8]; };
template <bool FULL>
__device__ __forceinline__ void hg_load(Frame& F, const bf16* Qb, const bf16* Fb, const bf16* Vb, int b, int dir, bool ctx, int sigma0, HgRaw& r) {
    const long step = (long)(ctx ? 1 : 64) * (dir ? -1 : 1) * DM;
    const size_t ro = (size_t)hg_row(b, dir, ctx, sigma0 + 8 * F.wave) * DM + 2 * F.lane;
    const bf16* fp = Fb + ro; const bf16* vp = Vb + ro; const bf16* qp = Qb + ro;
#pragma unroll
    for (int j = 0; j < 8; ++j) { r.f[j] = *(const unsigned*)(fp + j * step); r.v[j] = *(const unsigned*)(vp + j * step); if (FULL) r.q[j] = *(const unsigned*)(qp + j * step); }
}
template <bool FULL>
__device__ __forceinline__ void hg_prep(Frame& F, const HgRaw& raw, int b, int dir, bool ctx, int sigma0, float lb0, float lb1, float& gs0, float& gs1) {
    const int kp = F.lane, to = F.wave;
    const unsigned (&fw)[8] = raw.f; const unsigned (&qw)[8] = raw.q; const unsigned (&vw)[8] = raw.v;
    float c0[8], c1[8], k0[8], k1[8];
    float a0 = 0.f, a1 = 0.f;
#pragma unroll
    for (int j = 0; j < 8; ++j) {
        const float g0 = lb0 + (1.f - lb0) * __builtin_amdgcn_rcpf(1.f + __builtin_amdgcn_exp2f(-bflo(fw[j]) * LOG2E));
        const float g1 = lb1 + (1.f - lb1) * __builtin_amdgcn_rcpf(1.f + __builtin_amdgcn_exp2f(-bfhi(fw[j]) * LOG2E));
        k0[j] = 1.f - g0; k1[j] = 1.f - g1;
        a0 += __builtin_amdgcn_logf(g0); a1 += __builtin_amdgcn_logf(g1);
        c0[j] = a0; c1[j] = a1; }
    LAS float* part = (LAS float*)(F.lds + HG_PART);
    *(LAS f32x2*)(part + to * 128 + 2 * kp) = (f32x2){a0, a1};
    if (FULL) HSTAMP(0);
    LDS_WAIT(); __syncthreads();
    if (FULL) HSTAMP(1);
    if (FULL && F.tid < HG_C) ((LAS int*)(F.lds + HG_ROWS))[F.tid] = hg_row(b, dir, ctx, sigma0 + F.tid);
    float off0 = 0.f, off1 = 0.f, tot0 = 0.f, tot1 = 0.f;
#pragma unroll
    for (int o = 0; o < 8; ++o) { const f32x2 p = *(const LAS f32x2*)(part + o * 128 + 2 * kp);
        if (o < to) { off0 += p.x; off1 += p.y; } tot0 += p.x; tot1 += p.y; }
    gs0 += tot0; gs1 += tot1;
    if (to == 0) *(LAS f32x2*)((LAS float*)(F.lds + HG_ETOT) + 2 * kp) = (f32x2){__builtin_amdgcn_exp2f(tot0), __builtin_amdgcn_exp2f(tot1)};
    float kd0[8], kd1[8];
#pragma unroll
    for (int j = 0; j < 8; ++j) {
        const float E0 = __builtin_amdgcn_exp2f(off0 + c0[j]), E1 = __builtin_amdgcn_exp2f(off1 + c1[j]);
        kd0[j] = k0[j] * __builtin_amdgcn_rcpf(E0); kd1[j] = k1[j] * __builtin_amdgcn_rcpf(E1);
        if (FULL) {
            const float q0 = bflo(qw[j]), q1 = bfhi(qw[j]);
            const float s0 = q0 * __builtin_amdgcn_rcpf(1.f + __builtin_amdgcn_exp2f(-q0 * LOG2E)) * E0, s1 = q1 * __builtin_amdgcn_rcpf(1.f + __builtin_amdgcn_exp2f(-q1 * LOG2E)) * E1;
            const int c = 8 * to + j; const int off = c * 256 + ((4 * kp) ^ ((c & 15) << 4));
            *(LAS unsigned*)(F.lds + HG_QS + off) = pk2(s0, s1);
            *(LAS unsigned*)(F.lds + HG_KM + off) = pk2(kd0[j], kd1[j]);
        }
    }
    { const int sw = ((to ^ (kp & 7)) << 4);
      u32x4 w0, w1; w0.x = pk2(kd0[0], kd0[1]); w0.y = pk2(kd0[2], kd0[3]); w0.z = pk2(kd0[4], kd0[5]); w0.w = pk2(kd0[6], kd0[7]);
      w1.x = pk2(kd1[0], kd1[1]); w1.y = pk2(kd1[2], kd1[3]); w1.z = pk2(kd1[4], kd1[5]); w1.w = pk2(kd1[6], kd1[7]);
      *(LAS u32x4*)(F.lds + HG_KDT + (2 * kp) * 128 + sw) = w0; *(LAS u32x4*)(F.lds + HG_KDT + (2 * kp + 1) * 128 + sw) = w1;
      u32x4 v0, v1;
      v0.x = (vw[0] & 0xffffu) | (vw[1] << 16); v0.y = (vw[2] & 0xffffu) | (vw[3] << 16); v0.z = (vw[4] & 0xffffu) | (vw[5] << 16); v0.w = (vw[6] & 0xffffu) | (vw[7] << 16);
      v1.x = (vw[0] >> 16) | (vw[1] & 0xffff0000u); v1.y = (vw[2] >> 16) | (vw[3] & 0xffff0000u); v1.z = (vw[4] >> 16) | (vw[5] & 0xffff0000u); v1.w = (vw[6] >> 16) | (vw[7] & 0xffff0000u);
      *(LAS u32x4*)(F.lds + HG_VT + (2 * kp) * 128 + sw) = v0; *(LAS u32x4*)(F.lds + HG_VT + (2 * kp + 1) * 128 + sw) = v1; }
    if (FULL) HSTAMP(2);
    LDS_WAIT(); __syncthreads();
    if (FULL) HSTAMP(3);
}
__device__ __forceinline__ void hg_state_update(Frame& F, f32x4 (&St)[8], const bf16x8 (&vt)[2]) {
    const int fr = F.lane & 15, fq = F.lane >> 4;
    const LAS float* etot = (const LAS float*)(F.lds + HG_ETOT);
#pragma unroll
    for (int kt = 0; kt < 8; ++kt) { const f32x4 e = *(const LAS f32x4*)(etot + 16 * kt + 4 * fq);
        const int rk = 16 * kt + fr;
#pragma unroll
        for (int ks = 0; ks < 2; ++ks) { const bf16x8 A = *(const LAS bf16x8*)(F.lds + HG_KDT + rk * 128 + (((4 * ks + fq) ^ ((rk >> 1) & 7)) << 4));
            St[kt] = __builtin_amdgcn_mfma_f32_16x16x32_bf16(A, vt[ks], St[kt], 0, 0, 0); }
        St[kt] = St[kt] * e; }
}
__device__ __forceinline__ void hg_load_vt(Frame& F, bf16x8 (&vt)[2]) {
    const int fr = F.lane & 15, fq = F.lane >> 4; const int rv = 16 * F.wave + fr;
#pragma unroll
    for (int ks = 0; ks < 2; ++ks) vt[ks] = *(const LAS bf16x8*)(F.lds + HG_VT + rv * 128 + (((4 * ks + fq) ^ ((rv >> 1) & 7)) << 4));
}
struct HgPtrs { const bf16* Q; const bf16* Fx; const bf16* V; const bf16* Fc; const bf16* Vc; bf16* O; };
__device__ __forceinline__ HgPtrs hg_ptrs(Frame& F, int h, int dir) {
    HgPtrs p; p.Q = (const bf16*)(F.ws + WS_P + 2 * GS) + h * 128; p.Fx = (const bf16*)(F.ws + WS_P + (dir ? 4 : 3) * GS) + h * 128; p.V = (const bf16*)(F.ws + WS_P + 5 * GS) + h * 128;
    p.Fc = (const bf16*)(F.ws + WS_PC + (dir ? 2 : 1) * CGS) + h * 128; p.Vc = (const bf16*)(F.ws + WS_PC + 3 * CGS) + h * 128; p.O = (bf16*)(F.ws + WS_P + (dir ? 4 : 3) * GS) + h * 128; return p;
}
__device__ __forceinline__ void hg_lb(const Args& a, int h, int kp, float& lb0, float& lb1) {
    const float* t = a.in[IN_HGLB] + h * 128 + 2 * kp; lb0 = 1.f / (1.f + expf(t[DM] - t[0])); lb1 = 1.f / (1.f + expf(t[DM + 1] - t[1]));
}
__device__ __forceinline__ float* hg_img(Frame& F, int b, int h, int dir, int slot) { return (float*)((unsigned char*)F.out + (size_t)((((b * 8 + h) * 2 + dir) * 4) + slot) * HGS_IMG); }

__device__ __forceinline__ void hg_pass1(Frame& F, const Args& a, int unit) {
    const int slot = unit & 3, dir = (unit >> 2) & 1, h = (unit >> 3) & 7, b = unit >> 6;
    const int fr = F.lane & 15, fq = F.lane >> 4;
    const HgPtrs P = hg_ptrs(F, h, dir);
    float lb0, lb1; hg_lb(a, h, F.lane, lb0, lb1);
    f32x4 St[8];
#pragma unroll
    for (int kt = 0; kt < 8; ++kt) St[kt] = (f32x4){0.f, 0.f, 0.f, 0.f};
    const bool ctx = slot == 0; const int nchunk = ctx ? CTX / HG_C : HG_SEG / HG_C; const int sig0 = ctx ? 0 : (slot - 1) * HG_SEG;
    float gs0 = 0.f, gs1 = 0.f;
    const bf16* Fsrc = ctx ? P.Fc : P.Fx; const bf16* Vsrc = ctx ? P.Vc : P.V;
    HgRaw cur; hg_load<false>(F, P.Q, Fsrc, Vsrc, b, dir, ctx, sig0, cur);
    for (int ck = 0; ck < nchunk; ++ck) {
        HgRaw nxt; { const int cn = ck + 1 < nchunk ? ck + 1 : ck; hg_load<false>(F, P.Q, Fsrc, Vsrc, b, dir, ctx, sig0 + cn * HG_C, nxt); }
        hg_prep<false>(F, cur, b, dir, ctx, sig0 + ck * HG_C, lb0, lb1, gs0, gs1);
        cur = nxt;
        bf16x8 vt[2]; hg_load_vt(F, vt);
        hg_state_update(F, St, vt);
    }
    float* img = hg_img(F, b, h, dir, slot) + (size_t)(16 * F.wave + fr) * 128 + 4 * fq;
#pragma unroll
    for (int kt = 0; kt < 8; ++kt) *(f32x4*)(img + 16 * kt) = St[kt];
    if (!ctx && F.wave == 0) { float* D = (float*)(F.ws + WS_HGD) + (size_t)((((b * 8 + h) * 2 + dir) * 3) + (slot - 1)) * 128 + 2 * F.lane;
        *(f32x2*)D = (f32x2){__builtin_amdgcn_exp2f(gs0), __builtin_amdgcn_exp2f(gs1)}; }
    __syncthreads();
}

constexpr int HG_HN = 95232;
__device__ __forceinline__ void hg_pass2(Frame& F, const Args& a, int unit) {
    const int seg = unit & 3, h = (unit >> 2) & 7, b = unit >> 5;
    const int fr = F.lane & 15, fq = F.lane >> 4, w = F.wave;
    float lb0, lb1; hg_lb(a, h, F.lane, lb0, lb1);
    const int lcol = h * 128 + 16 * w + 4 * fq;
#pragma unroll 1
    for (int dir = 0; dir < 2; ++dir) {
        const int sseg = dir == 0 ? seg : 3 - seg;
        const HgPtrs P = hg_ptrs(F, h, dir);
        f32x4 St[8];
        {
            const float* img = hg_img(F, b, h, dir, 0) + (size_t)(16 * w + fr) * 128 + 4 * fq;
#pragma unroll
            for (int kt = 0; kt < 8; ++kt) St[kt] = *(const f32x4*)(img + 16 * kt);
            for (int j = 0; j < sseg; ++j) {
                const float* im = hg_img(F, b, h, dir, 1 + j) + (size_t)(16 * w + fr) * 128 + 4 * fq;
                const float* D = (const float*)(F.ws + WS_HGD) + (size_t)((((b * 8 + h) * 2 + dir) * 3) + j) * 128 + 4 * fq;
#pragma unroll
                for (int kt = 0; kt < 8; ++kt) { const f32x4 d = *(const f32x4*)(D + 16 * kt), dl = *(const f32x4*)(im + 16 * kt); St[kt] = St[kt] * d + dl; }
            }
        }
        float gs0 = 0.f, gs1 = 0.f;
        for (int ck = 0; ck < HG_SEG / HG_C; ++ck) {
            { HgRaw cur; hg_load<true>(F, P.Q, P.Fx, P.V, b, dir, false, sseg * HG_SEG + ck * HG_C, cur);
              hg_prep<true>(F, cur, b, dir, false, sseg * HG_SEG + ck * HG_C, lb0, lb1, gs0, gs1); }
            const LAS int* rows = (const LAS int*)(F.lds + HG_ROWS);
            bf16* OFW = (bf16*)(F.ws + WS_OF) + lcol; asm volatile("" : "+v"(OFW));
            u32x2 ofw[4], ogv[4];
            if (dir == 1) {
                const bf16* OG = (const bf16*)(F.ws + WS_P + 6 * GS) + lcol; asm volatile("" : "+v"(OG));
#pragma unroll
                for (int ct = 0; ct < 4; ++ct) { const size_t ro = (size_t)rows[16 * ct + fr] * DM; ofw[ct] = *(const u32x2*)(OFW + ro); ogv[ct] = *(const u32x2*)(OG + ro); } }
#pragma unroll
            for (int tt = 0; tt < 2; ++tt) { const int t = w + 8 * tt, ct = t >> 2, st = t & 3;
                f32x4 acc = {0.f, 0.f, 0.f, 0.f};
                const int rs = 16 * st + fr, rc = 16 * ct + fr;
#pragma unroll
                for (int kk = 0; kk < 4; ++kk) { const bf16x8 A = *(const LAS bf16x8*)(F.lds + HG_KM + rs * 256 + (((4 * kk + fq) ^ fr) << 4));
                    const bf16x8 B = *(const LAS bf16x8*)(F.lds + HG_QS + rc * 256 + (((4 * kk + fq) ^ fr) << 4));
                    acc = __builtin_amdgcn_mfma_f32_16x16x32_bf16(A, B, acc, 0, 0, 0); }
                const int s0 = 16 * st + 4 * fq;
                const float m0 = (s0 + 0 <= rc) ? acc[0] : 0.f, m1 = (s0 + 1 <= rc) ? acc[1] : 0.f, m2 = (s0 + 2 <= rc) ? acc[2] : 0.f, m3 = (s0 + 3 <= rc) ? acc[3] : 0.f;
                *(LAS u32x2*)(F.lds + HG_ATT + rc * 128 + (((2 * st + (fq >> 1)) ^ ((rc >> 1) & 7)) << 4) + (fq & 1) * 8) = (u32x2){pk2(m0, m1), pk2(m2, m3)}; }
            f32x4 o[4];
#pragma unroll
            for (int ct = 0; ct < 4; ++ct) o[ct] = (f32x4){0.f, 0.f, 0.f, 0.f};
#pragma unroll
            for (int kk = 0; kk < 4; ++kk) {
                union { bf16x8 v; unsigned u[4]; } A;
                A.u[0] = pk2(St[2 * kk][0], St[2 * kk][1]); A.u[1] = pk2(St[2 * kk][2], St[2 * kk][3]); A.u[2] = pk2(St[2 * kk + 1][0], St[2 * kk + 1][1]); A.u[3] = pk2(St[2 * kk + 1][2], St[2 * kk + 1][3]);
#pragma unroll
                for (int ct = 0; ct < 4; ++ct) { const int rc = 16 * ct + fr;
                    union { bf16x8 v; u32x2 h[2]; } B;
                    B.h[0] = *(const LAS u32x2*)(F.lds + HG_QS + rc * 256 + (((4 * kk + (fq >> 1)) ^ fr) << 4) + (fq & 1) * 8);
                    B.h[1] = *(const LAS u32x2*)(F.lds + HG_QS + rc * 256 + (((4 * kk + 2 + (fq >> 1)) ^ fr) << 4) + (fq & 1) * 8);
                    o[ct] = __builtin_amdgcn_mfma_f32_16x16x32_bf16(A.v, B.v, o[ct], 0, 0, 0); } }
            bf16x8 vt[2]; hg_load_vt(F, vt);
            LDS_WAIT(); __syncthreads();
#pragma unroll
            for (int ks = 0; ks < 2; ++ks)
#pragma unroll
                for (int ct = 0; ct < 4; ++ct) { const int rc = 16 * ct + fr;
                    const bf16x8 B = *(const LAS bf16x8*)(F.lds + HG_ATT + rc * 128 + (((4 * ks + fq) ^ ((rc >> 1) & 7)) << 4));
                    o[ct] = __builtin_amdgcn_mfma_f32_16x16x32_bf16(vt[ks], B, o[ct], 0, 0, 0); }
            if (dir == 0) {
#pragma unroll
                for (int ct = 0; ct < 4; ++ct) *(u32x2*)(OFW + (size_t)rows[16 * ct + fr] * DM) = (u32x2){pk2(o[ct][0], o[ct][1]), pk2(o[ct][2], o[ct][3])};
                hg_state_update(F, St, vt);
            } else {
                LAS float* hn = (LAS float*)(F.lds + HG_HN);
                const f32x4 hn4 = *(const f32x4*)(a.in[IN_HGN] + h * 128 + 16 * w + 4 * fq);
#pragma unroll
                for (int ct = 0; ct < 4; ++ct) { o[ct][0] += bflo(ofw[ct].x); o[ct][1] += bfhi(ofw[ct].x); o[ct][2] += bflo(ofw[ct].y); o[ct][3] += bfhi(ofw[ct].y);
                    float ss = (o[ct][0] * o[ct][0] + o[ct][1] * o[ct][1]) + (o[ct][2] * o[ct][2] + o[ct][3] * o[ct][3]);
                    ss += __shfl_xor(ss, 16); ss += __shfl_xor(ss, 32);
                    if (fq == 0) hn[(16 * ct + fr) * 8 + w] = ss; }
                hg_state_update(F, St, vt);
                LDS_WAIT(); __syncthreads();
#pragma unroll
                for (int ct = 0; ct < 4; ++ct) { const f32x4 p0 = *(const LAS f32x4*)(hn + (16 * ct + fr) * 8), p1 = *(const LAS f32x4*)(hn + (16 * ct + fr) * 8 + 4);
                    const float rsn = rsqrtf(((p0.x + p0.y) + (p0.z + p0.w) + (p1.x + p1.y) + (p1.z + p1.w)) * (1.f / 128.f) + EPS);
                    const float g0 = bflo(ogv[ct].x), g1 = bfhi(ogv[ct].x), g2 = bflo(ogv[ct].y), g3 = bfhi(ogv[ct].y);
                    const float y0 = o[ct][0] * rsn * hn4.x * siluf_(g0), y1 = o[ct][1] * rsn * hn4.y * siluf_(g1), y2 = o[ct][2] * rsn * hn4.z * siluf_(g2), y3 = o[ct][3] * rsn * hn4.w * siluf_(g3);
                    *(u32x2*)(OFW + (size_t)rows[16 * ct + fr] * DM) = (u32x2){pk2(y0, y1), pk2(y2, y3)}; }
            }
        }
        VM_WAIT(); __syncthreads();
    }
}
__device__ __forceinline__ void p_ybg(Frame& F, const Args& a) {
    const bf16* OFp = (const bf16*)(F.ws + WS_OF); const bf16* OBp = (const bf16*)(F.ws + WS_OB); const bf16* OG = (const bf16*)(F.ws + WS_P + 6 * GS);
    bf16* YBG = (bf16*)(F.ws + WS_YBG); const float* hgn = a.in[IN_HGN];
    const int gw = F.bid * NWAVES + F.wave, NGW = F.G * NWAVES;
    for (int row = gw; row < NTOK; row += 2 * NGW) {
        u32x4 fv[2][2], bv[2][2], gvv[2][2];
#pragma unroll
        for (int rr = 0; rr < 2; ++rr)
#pragma unroll
            for (int j = 0; j < 2; ++j) { const size_t o = (size_t)(row + rr * NGW) * DM + 8 * F.lane + 512 * j;
                fv[rr][j] = *(const u32x4*)(OFp + o); bv[rr][j] = *(const u32x4*)(OBp + o); gvv[rr][j] = *(const u32x4*)(OG + o); }
#pragma unroll
        for (int rr = 0; rr < 2; ++rr)
#pragma unroll
        for (int j = 0; j < 2; ++j) { const int k = 8 * F.lane + 512 * j; const size_t o = (size_t)(row + rr * NGW) * DM + k;
            const u32x4 f = fv[rr][j], b = bv[rr][j], g = gvv[rr][j];
            float v[8]; v[0] = bflo(f.x) + bflo(b.x); v[1] = bfhi(f.x) + bfhi(b.x); v[2] = bflo(f.y) + bflo(b.y); v[3] = bfhi(f.y) + bfhi(b.y);
            v[4] = bflo(f.z) + bflo(b.z); v[5] = bfhi(f.z) + bfhi(b.z); v[6] = bflo(f.w) + bflo(b.w); v[7] = bfhi(f.w) + bfhi(b.w);
            float ss = 0.f;
#pragma unroll
            for (int q = 0; q < 8; ++q) ss += v[q] * v[q];
            ss += __shfl_xor(ss, 1); ss += __shfl_xor(ss, 2); ss += __shfl_xor(ss, 4); ss += __shfl_xor(ss, 8);
            const float rs = rsqrtf(ss * (1.f / 128.f) + EPS);
            float gv[8]; gv[0] = bflo(g.x); gv[1] = bfhi(g.x); gv[2] = bflo(g.y); gv[3] = bfhi(g.y); gv[4] = bflo(g.z); gv[5] = bfhi(g.z); gv[6] = bflo(g.w); gv[7] = bfhi(g.w);
            const f32x4 h0 = *(const f32x4*)(hgn + k), h1 = *(const f32x4*)(hgn + k + 4);
            const float hv[8] = {h0.x, h0.y, h0.z, h0.w, h1.x, h1.y, h1.z, h1.w};
            float r[8];
#pragma unroll
            for (int q = 0; q < 8; ++q) r[q] = v[q] * rs * hv[q] * siluf_(gv[q]);
            u32x4 w; w.x = pk2(r[0], r[1]); w.y = pk2(r[2], r[3]); w.z = pk2(r[4], r[5]); w.w = pk2(r[6], r[7]);
            *(u32x4*)(YBG + o) = w; }
    }
}
__device__ __forceinline__ void p_moe_weights13(Frame& F, const Args& a) {
    LAS float* scr = (LAS float*)(F.lds + F.wave * TR_BYTES);
    const int gw = F.bid * NWAVES + F.wave, NGW = F.G * NWAVES;
    for (int it = gw; it < NEXP * 256; it += NGW) {
        const int e = it >> 8, r = it & 255, w = r >> 7, q = r & 127, kb = q >> 3, nb = q & 7;
        transpose_item(a.in[w == 0 ? IN_W1 : IN_W3] + (size_t)e * DM * DEXP, DEXP, DM, (bf16*)(F.ws + (w == 0 ? WS_W1T : WS_W3T)) + ((size_t)e * DEXP + nb * 64) * DM, kb * 64, nb * 64, scr, F.lane);
    }
}
__device__ __forceinline__ void p_moe_weights2(Frame& F, const Args& a, int rank, int nwg) {
    LAS float* scr = (LAS float*)(F.lds + F.wave * TR_BYTES);
    for (int it = rank * NWAVES + F.wave; it < NEXP * 128; it += nwg * NWAVES) {
        const int e = it >> 7, q = it & 127, kb = q >> 4, nb = q & 15;
        transpose_item(a.in[IN_W2] + (size_t)e * DEXP * DM, DM, DEXP, (bf16*)(F.ws + WS_W2T) + ((size_t)e * DM + nb * 64) * DEXP, kb * 64, nb * 64, scr, F.lane);
    }
}

struct SchedP5 {
    int c; const char* YAG; const char* YBG; const char* WA; const char* WB; char* stash; char* M;
    __device__ __forceinline__ bool next(int i, gm::Unit& u) const {
        if (i >= 2) return false;
        int pm, pn; tile_order(c, 64, 4, pm, pn);
        u.A = (i == 0 ? YAG : YBG) + (size_t)pm * 256 * 2048; u.B0 = (i == 0 ? WA : WB) + (size_t)pn * 256 * 2048; u.B1 = u.B0 + (size_t)128 * 2048;
        u.dst = M + ((size_t)pm * 256 * DM + pn * 256) * 2; u.pm = pm; u.pn = pn; u.e = i; u.rows = 256; return true;
    }
    __device__ __forceinline__ unsigned arow(const gm::Unit&, int r) const { return (unsigned)r; }
};
struct EpiP5 {
    static constexpr bool PERM = true;
    unsigned* stash; const bf16* GA; const bf16* GB;
    __device__ __forceinline__ void operator()(const f32x4 (&acc)[2][2][4][2], const gm::Unit& u, int wr, int wc, int fr, int fq) const {
        const bf16* G = (u.e == 0 ? GA : GB) + ((size_t)u.pm * 256 + wr * 64 + fr) * DM + u.pn * 256 + wc * 32 + 8 * fq;
        bf16* Mb = (bf16*)u.dst + (size_t)(wr * 64 + fr) * DM + wc * 32 + 8 * fq;
        u32x4* st = (u32x4*)stash + threadIdx.x;
        asm volatile("" : "+v"(G), "+v"(Mb), "+v"(st));
#pragma unroll
        for (int ai = 0; ai < 2; ++ai)
#pragma unroll
            for (int m = 0; m < 4; ++m) {
                u32x4 g[2], s[2];
#pragma unroll
                for (int bj = 0; bj < 2; ++bj) { const size_t ro = (size_t)(ai * 128 + m * 16) * DM + bj * 128; const int si = (ai * 4 + m) * 2 + bj;
                    g[bj] = *(const u32x4*)(G + ro);
                    if (u.e != 0) s[bj] = st[(size_t)si * NTHR]; }
#pragma unroll
                for (int bj = 0; bj < 2; ++bj) { const size_t ro = (size_t)(ai * 128 + m * 16) * DM + bj * 128; const int si = (ai * 4 + m) * 2 + bj;
                    f32x4 v0 = acc[ai][bj][m][0], v1 = acc[ai][bj][m][1];
                    v0[0] *= sigmoidf_(bflo(g[bj].x)); v0[1] *= sigmoidf_(bfhi(g[bj].x)); v0[2] *= sigmoidf_(bflo(g[bj].y)); v0[3] *= sigmoidf_(bfhi(g[bj].y));
                    v1[0] *= sigmoidf_(bflo(g[bj].z)); v1[1] *= sigmoidf_(bfhi(g[bj].z)); v1[2] *= sigmoidf_(bflo(g[bj].w)); v1[3] *= sigmoidf_(bfhi(g[bj].w));
                    if (u.e != 0) { v0[0] += bflo(s[bj].x); v0[1] += bfhi(s[bj].x); v0[2] += bflo(s[bj].y); v0[3] += bfhi(s[bj].y);
                                    v1[0] += bflo(s[bj].z); v1[1] += bfhi(s[bj].z); v1[2] += bflo(s[bj].w); v1[3] += bfhi(s[bj].w); }
                    u32x4 w; w.x = gm::cvt_pk_bf16(v0[0], v0[1]); w.y = gm::cvt_pk_bf16(v0[2], v0[3]); w.z = gm::cvt_pk_bf16(v1[0], v1[1]); w.w = gm::cvt_pk_bf16(v1[2], v1[3]);
                    if (u.e == 0) st[(size_t)si * NTHR] = w; else *(u32x4*)(Mb + ro) = w; }
                asm volatile("" ::: "memory"); }
    }
};

struct SchedP6 {
    int c; const char* M; const char* W; char* X1;
    __device__ __forceinline__ bool next(int i, gm::Unit& u) const {
        if (i >= 1) return false;
        int pm, pn; tile_order(c, 64, 4, pm, pn);
        u.A = M + (size_t)pm * 256 * 2048; u.B0 = W + (size_t)pn * 256 * 2048; u.B1 = u.B0 + (size_t)128 * 2048;
        u.dst = X1 + ((size_t)pm * 256 * DM + pn * 256) * 4; u.pm = pm; u.pn = pn; u.e = 0; u.rows = 256; return true;
    }
    __device__ __forceinline__ unsigned arow(const gm::Unit&, int r) const { return (unsigned)r; }
};
struct EpiP6 {
    static constexpr bool PERM = false;
    const float* x; const float* mod;
    __device__ __forceinline__ void operator()(const f32x4 (&acc)[2][2][4][2], const gm::Unit& u, int wr, int wc, int fr, int fq) const {
        const int b = u.pm >> 3; const int col0 = u.pn * 256 + wc * 32 + 4 * fq;
        const float* mg = mod + b * 6144 + 2 * DM + col0;
        f32x4 gv[2][2];
#pragma unroll
        for (int bj = 0; bj < 2; ++bj)
#pragma unroll
            for (int n = 0; n < 2; ++n) gv[bj][n] = *(const f32x4*)(mg + bj * 128 + n * 16);
#pragma unroll
        for (int ai = 0; ai < 2; ++ai)
#pragma unroll
            for (int m = 0; m < 4; ++m) { const size_t ro = (size_t)(wr * 64 + fr + ai * 128 + m * 16) * DM + wc * 32 + 4 * fq;
                const float* xr = x + ((size_t)u.pm * 256 * DM + u.pn * 256) + ro; float* orow = (float*)u.dst + ro;
#pragma unroll
                for (int bj = 0; bj < 2; ++bj)
#pragma unroll
                    for (int n = 0; n < 2; ++n) { const f32x4 xv = *(const f32x4*)(xr + bj * 128 + n * 16);
                        *(f32x4*)(orow + bj * 128 + n * 16) = xv + gv[bj][n] * acc[ai][bj][m][n]; } }
    }
};

__device__ __forceinline__ void p_norm2_route(Frame& F, const Args& a) {
    const float* mod = (const float*)(F.ws + WS_MOD); const float* g2 = a.in[IN_G2]; const float* wrp = (const float*)(F.ws + WS_WRT);
    const float* X1 = F.out; bf16* HX2 = (bf16*)(F.ws + WS_HX2);
    int* list = (int*)(F.ws + WS_LIST); float* wt = (float*)(F.ws + WS_WT); unsigned* cnt = F.ctl + CW_CNT;
    LAS float* gs = (LAS float*)F.lds; LAS float* sh = gs + DM; LAS float* rst = sh + DM; LAS float* lgs = rst + 64;
    const int b = F.bid / 32;
    for (int k = F.tid; k < DM; k += NTHR) { gs[k] = g2[k] * (1.f + mod[b * 6144 + 4 * DM + k]); sh[k] = mod[b * 6144 + 3 * DM + k]; }
    __syncthreads();
    for (int r = F.wave; r < 64; r += NWAVES) {
        const int tok = F.bid * 64 + r;
        const f32x4* xr = (const f32x4*)(X1 + (size_t)tok * DM) + F.lane;
        f32x4 v[4]; float s = 0.f;
#pragma unroll
        for (int j = 0; j < 4; ++j) { v[j] = xr[64 * j]; s += (v[j].x * v[j].x + v[j].y * v[j].y) + (v[j].z * v[j].z + v[j].w * v[j].w); }
        const float rstd = rsqrtf(wave_sum(s) * (1.f / DM) + EPS);
        if (F.lane == 0) rst[r] = rstd;
        unsigned long long* o8 = (unsigned long long*)(HX2 + (size_t)tok * DM) + F.lane;
#pragma unroll
        for (int j = 0; j < 4; ++j) { const int k = 4 * F.lane + 256 * j;
            const f32x4 g = *(const LAS f32x4*)(gs + k), h = *(const LAS f32x4*)(sh + k);
            o8[64 * j] = (unsigned long long)pk2(v[j].x * rstd * g.x + h.x, v[j].y * rstd * g.y + h.y) | ((unsigned long long)pk2(v[j].z * rstd * g.z + h.z, v[j].w * rstd * g.w + h.w) << 32); }
    }
    LDS_WAIT(); __syncthreads();
    {
        const int tq = F.lane & 15, kq = F.lane >> 4, wg = F.wave & 3, kh = F.wave >> 2; const int tl = wg * 16 + tq;
        const float rs = rst[tl];
        const float* xr = X1 + (size_t)(F.bid * 64 + tl) * DM + 4 * kq + 512 * kh;
        const f32x4* wp = (const f32x4*)wrp + F.lane + (size_t)kh * 32 * 3 * 64;
        const LAS float* gsp = gs + 512 * kh + 4 * kq; const LAS float* shp = sh + 512 * kh + 4 * kq;
        f32x4 acc[3];
#pragma unroll
        for (int c = 0; c < 3; ++c) acc[c] = (f32x4){0.f, 0.f, 0.f, 0.f};
#pragma unroll 8
        for (int s = 0; s < 32; ++s) {
            const f32x4 x = *(const f32x4*)(xr + 16 * s); const f32x4 g = *(const LAS f32x4*)(gsp + 16 * s), h = *(const LAS f32x4*)(shp + 16 * s);
            const f32x4 hv = x * rs * g + h;
#pragma unroll
            for (int c = 0; c < 3; ++c) { const f32x4 w = wp[(s * 3 + c) * 64];
                acc[c] = __builtin_amdgcn_mfma_f32_16x16x4f32(hv[0], w[0], acc[c], 0, 0, 0); acc[c] = __builtin_amdgcn_mfma_f32_16x16x4f32(hv[1], w[1], acc[c], 0, 0, 0);
                acc[c] = __builtin_amdgcn_mfma_f32_16x16x4f32(hv[2], w[2], acc[c], 0, 0, 0); acc[c] = __builtin_amdgcn_mfma_f32_16x16x4f32(hv[3], w[3], acc[c], 0, 0, 0); }
        }
#pragma unroll
        for (int c = 0; c < 3; ++c)
#pragma unroll
            for (int r = 0; r < 4; ++r) lgs[kh * 64 * 48 + (wg * 16 + 4 * kq + r) * 48 + 16 * c + tq] = acc[c][r];
    }
    LDS_WAIT(); __syncthreads();
    LAS unsigned* lcnt = (LAS unsigned*)(lgs + 2 * 64 * 48); LAS unsigned* lbase = lcnt + 32;
    if (F.tid < 32) lcnt[F.tid] = 0u;
    LDS_WAIT(); __syncthreads();
    int ea = 0, eb = 0; unsigned ra = 0u, rb = 0u; int tok = 0; float w1 = 0.f, w2 = 0.f;
    const bool picker = F.wave < 4 && F.lane < 16;
    if (picker) {
        const LAS float* lp = lgs + (F.wave * 16 + F.lane) * 48; tok = F.bid * 64 + F.wave * 16 + F.lane;
        float lg[36];
#pragma unroll
        for (int q = 0; q < 9; ++q) { const f32x4 t4 = *(const LAS f32x4*)(lp + 4 * q) + *(const LAS f32x4*)(lp + 64 * 48 + 4 * q) + *(const f32x4*)(wrp + 49152 + 4 * q);
            lg[4 * q] = t4.x; lg[4 * q + 1] = t4.y; lg[4 * q + 2] = t4.z; lg[4 * q + 3] = t4.w; }
        float mx = lg[0]; int gi = 0;
#pragma unroll
        for (int g = 1; g < 4; ++g) if (lg[g] > mx) { mx = lg[g]; gi = g; }
        float z = 0.f;
#pragma unroll
        for (int g = 0; g < 4; ++g) z += __expf(lg[g] - mx);
        const float pg = 1.f / z;
        float el[8];
#pragma unroll
        for (int e = 0; e < 8; ++e) el[e] = gi == 0 ? lg[4 + e] : (gi == 1 ? lg[12 + e] : (gi == 2 ? lg[20 + e] : lg[28 + e]));
        int e1 = 0; float m1 = el[0];
#pragma unroll
        for (int e = 1; e < 8; ++e) if (el[e] > m1) { m1 = el[e]; e1 = e; }
        int e2 = 0; float m2 = -3.0e38f;
#pragma unroll
        for (int e = 0; e < 8; ++e) if (e != e1 && el[e] > m2) { m2 = el[e]; e2 = e; }
        const float rr = __expf(m2 - m1); w1 = pg / (1.f + rr); w2 = pg * rr / (1.f + rr);
        ea = gi * 8 + e1; eb = gi * 8 + e2;
        ra = __hip_atomic_fetch_add(lcnt + ea, 1u, __ATOMIC_RELAXED, __HIP_MEMORY_SCOPE_WORKGROUP);
        rb = __hip_atomic_fetch_add(lcnt + eb, 1u, __ATOMIC_RELAXED, __HIP_MEMORY_SCOPE_WORKGROUP);
    }
    LDS_WAIT(); __syncthreads();
    if (F.tid < 32) { const unsigned n = lcnt[F.tid]; lbase[F.tid] = n ? __hip_atomic_fetch_add(cnt + 64 * F.tid, n, __ATOMIC_RELAXED, __HIP_MEMORY_SCOPE_AGENT) : 0u; }
    LDS_WAIT(); __syncthreads();
    if (picker) {
        list[(size_t)ea * CAP + lbase[ea] + ra] = tok * 2; wt[tok * 2] = w1;
        list[(size_t)eb * CAP + lbase[eb] + rb] = tok * 2 + 1; wt[tok * 2 + 1] = w2;
    }
}

__device__ __forceinline__ void moe_table(Frame& F, const int* cntv) {
    if (F.wave == 0) { const int lane = F.lane; const int cnt = lane < NEXP ? cntv[64 * lane] : 0;
        const int t = (cnt + 255) >> 8; int ti = t, oi = cnt;
#pragma unroll
        for (int d = 1; d < 32; d <<= 1) { const int tu = __shfl_up(ti, d), ou = __shfl_up(oi, d); if ((lane & 31) >= d) { ti += tu; oi += ou; } }
        if (lane < NEXP) { F.MISC[128 + lane] = (unsigned)cnt; F.MISC[160 + lane] = (unsigned)(ti - t); F.MISC[192 + lane] = (unsigned)(oi - cnt); }
        if (lane == NEXP - 1) F.MISC[224] = (unsigned)ti; }
    LDS_WAIT(); __syncthreads();
}
__device__ __forceinline__ bool moe_find(volatile LAS unsigned* MISC, int lane, int T, int& e, int& rt, int& rows, int& off) {
    if (T >= (int)MISC[224]) return false;
    const int l = lane & 31; const int cnt = (int)MISC[128 + l], tpre = (int)MISC[160 + l];
    const unsigned long long mask = __ballot(lane < NEXP && cnt > 0 && T >= tpre);
    e = __builtin_amdgcn_readfirstlane(63 - __builtin_clzll(mask));
    rt = T - (int)MISC[160 + e]; const int c = (int)MISC[128 + e]; off = (int)MISC[192 + e];
    rows = c - rt * 256; if (rows > 256) rows = 256; return true;
}
struct SchedMoe1 {
    int G, c, lane; volatile LAS unsigned* MISC; const int* list; const char* HX2; const char* W1T; const char* W3T; char* HH; unsigned* tile_cnt;
    __device__ __forceinline__ bool next(int i, gm::Unit& u) const {
        const int vc = (c & 7) * (G >> 3) + (c >> 3);
        const int L = i * G + vc; int e, rt, rows, off; if (!moe_find(MISC, lane, L >> 2, e, rt, rows, off)) return false;
        const int pn = L & 3;
        e = __builtin_amdgcn_readfirstlane(e); rt = __builtin_amdgcn_readfirstlane(rt); rows = __builtin_amdgcn_readfirstlane(rows); off = __builtin_amdgcn_readfirstlane(off);
        u.A = HX2; u.B0 = W1T + ((size_t)e * DEXP + pn * 128) * 2048; u.B1 = W3T + ((size_t)e * DEXP + pn * 128) * 2048;
        u.dst = HH + ((size_t)(off + rt * 256) * DEXP + pn * 128) * 2; u.pm = rt; u.pn = pn; u.e = e; u.rows = rows; u.t = L >> 2; return true;
    }
    __device__ __forceinline__ unsigned arow(const gm::Unit& u, int r) const { const int rr = r < u.rows ? r : u.rows - 1; return (unsigned)(list[(size_t)u.e * CAP + u.pm * 256 + rr] >> 1); }
    __device__ __forceinline__ void a_ready(const gm::Unit&) const {}
    __device__ __forceinline__ void done(const gm::Unit& u) const {
        asm volatile("s_waitcnt vmcnt(0)" ::: "memory");
        __builtin_amdgcn_s_barrier(); asm volatile("" ::: "memory");
        if (threadIdx.x == 0) __hip_atomic_fetch_add(tile_cnt + 8 * u.t, 1u, __ATOMIC_RELAXED, __HIP_MEMORY_SCOPE_AGENT);
    }
};
struct EpiMoe1 {
    static constexpr bool PERM = true;
    char* HH;
    __device__ __forceinline__ void operator()(const f32x4 (&acc)[2][2][4][2], const gm::Unit& u, int wr, int wc, int fr, int fq) const {
        const __amdgpu_buffer_rsrc_t rs = __builtin_amdgcn_make_buffer_rsrc((void*)HH, 0, 0x7fffffff, 0x00020000);
        const unsigned base = (unsigned)(u.dst - HH) + (unsigned)(((wr * 64 + fr) * DEXP + wc * 32 + 8 * fq) * 2);
#pragma unroll
        for (int ai = 0; ai < 2; ++ai)
#pragma unroll
            for (int m = 0; m < 4; ++m) { const int r = ai * 128 + wr * 64 + m * 16 + fr; if (r >= u.rows) continue;
                const f32x4 u0 = acc[ai][0][m][0], u1 = acc[ai][0][m][1], v0 = acc[ai][1][m][0], v1 = acc[ai][1][m][1];
                u32x4 w; w.x = gm::cvt_pk_bf16(siluf_(u0[0]) * v0[0], siluf_(u0[1]) * v0[1]); w.y = gm::cvt_pk_bf16(siluf_(u0[2]) * v0[2], siluf_(u0[3]) * v0[3]);
                w.z = gm::cvt_pk_bf16(siluf_(u1[0]) * v1[0], siluf_(u1[1]) * v1[1]); w.w = gm::cvt_pk_bf16(siluf_(u1[2]) * v1[2], siluf_(u1[3]) * v1[3]);
                __builtin_amdgcn_raw_buffer_store_b128(w, rs, base + (unsigned)((ai * 128 + m * 16) * DEXP * 2), 0, 16); }
    }
};
struct SchedMoe2 {
    int G, c, lane; volatile LAS unsigned* MISC; const char* HH; const char* W2T; char* Y; unsigned* tile_cnt; unsigned* tmo;
    __device__ __forceinline__ bool next(int i, gm::Unit& u) const {
        const int vc = (c & 7) * (G >> 3) + (c >> 3);
        const int U = 4 * (int)MISC[224], q = U / G, r = U % G;
        const bool rebal = q >= 1 && r > 0 && 3 * r <= G;
        int L = i * G + (G - 1 - vc);
        if (rebal) {
            if (vc < r) { if (i >= q - 1) return false; }
            else if (vc < 2 * r) { if (i == q) L = (q - 1) * G + (G - 1 - (vc - r)); else if (i > q) return false; }
        }
        int e, rt, rows, off; if (!moe_find(MISC, lane, L >> 2, e, rt, rows, off)) return false;
        const int pn = L & 3;
        e = __builtin_amdgcn_readfirstlane(e); rt = __builtin_amdgcn_readfirstlane(rt); rows = __builtin_amdgcn_readfirstlane(rows); off = __builtin_amdgcn_readfirstlane(off);
        u.A = HH + (size_t)(off + rt * 256) * DEXP * 2; u.B0 = W2T + ((size_t)e * DM + pn * 256) * (DEXP * 2); u.B1 = u.B0 + (size_t)128 * (DEXP * 2);
        u.dst = Y + (size_t)pn * 256 * 2; u.pm = rt; u.pn = pn; u.e = e; u.rows = rows; u.t = L >> 2; return true;
    }
    __device__ __forceinline__ unsigned arow(const gm::Unit&, int r) const { return (unsigned)r; }
    __device__ __forceinline__ void a_ready(const gm::Unit& u) const {
        if (threadIdx.x < 64) {
            unsigned spins = 0;
            while ((unsigned)__builtin_amdgcn_readfirstlane(__hip_atomic_load(tile_cnt + 8 * u.t, __ATOMIC_RELAXED, __HIP_MEMORY_SCOPE_AGENT)) < 4u) {
                __builtin_amdgcn_s_sleep(2);
                if (++spins > (1u << 22)) { if (threadIdx.x == 0) __hip_atomic_store(tmo, 1u, __ATOMIC_RELAXED, __HIP_MEMORY_SCOPE_AGENT); break; } }
            __builtin_amdgcn_fence(__ATOMIC_ACQUIRE, "agent");
            asm volatile("s_waitcnt vmcnt(0)" ::: "memory");
        }
        asm volatile("" ::: "memory"); __builtin_amdgcn_s_barrier(); asm volatile("" ::: "memory");
    }
    __device__ __forceinline__ void done(const gm::Unit&) const {}
};
struct EpiMoe2 {
    static constexpr bool PERM = true;
    const int* list;
    __device__ __forceinline__ void operator()(const f32x4 (&acc)[2][2][4][2], const gm::Unit& u, int wr, int wc, int fr, int fq) const {
        const int* lp = list + (size_t)u.e * CAP + u.pm * 256;
#pragma unroll
        for (int ai = 0; ai < 2; ++ai)
#pragma unroll
            for (int m = 0; m < 4; ++m) { const int r = ai * 128 + wr * 64 + m * 16 + fr; if (r >= u.rows) continue;
                const int slot = lp[r]; bf16* rowp = (bf16*)u.dst + (size_t)slot * DM + wc * 32 + 8 * fq;
#pragma unroll
                for (int bj = 0; bj < 2; ++bj) { const f32x4 v0 = acc[ai][bj][m][0], v1 = acc[ai][bj][m][1];
                    u32x4 w; w.x = gm::cvt_pk_bf16(v0[0], v0[1]); w.y = gm::cvt_pk_bf16(v0[2], v0[3]); w.z = gm::cvt_pk_bf16(v1[0], v1[1]); w.w = gm::cvt_pk_bf16(v1[2], v1[3]);
                    *(u32x4*)(rowp + bj * 128) = w; } }
    }
};

__device__ __forceinline__ void p_final(Frame& F, const Args& a) {
    const float* mod = (const float*)(F.ws + WS_MOD); const float* fg = a.in[IN_FG]; const float* wt = (const float*)(F.ws + WS_WT);
    const bf16* Y = (const bf16*)(F.ws + WS_Y); float* X1 = F.out;
    for (int r = F.wave; r < 64; r += NWAVES) {
        const int tok = F.bid * 64 + r; const int b = tok >> 11;
        const float w0 = wt[tok * 2], w1 = wt[tok * 2 + 1];
        f32x4* xr = (f32x4*)(X1 + (size_t)tok * DM) + F.lane;
        const u32x2* y0 = (const u32x2*)(Y + (size_t)(tok * 2) * DM) + F.lane; const u32x2* y1 = (const u32x2*)(Y + (size_t)(tok * 2 + 1) * DM) + F.lane;
        f32x4 v[4]; float s = 0.f;
#pragma unroll
        for (int j = 0; j < 4; ++j) { const int k = 4 * F.lane + 256 * j;
            const f32x4 xv = xr[64 * j]; const u32x2 a0 = y0[64 * j], a1 = y1[64 * j]; const f32x4 g5 = *(const f32x4*)(mod + b * 6144 + 5 * DM + k);
            v[j].x = xv.x + g5.x * (w0 * bflo(a0.x) + w1 * bflo(a1.x)); v[j].y = xv.y + g5.y * (w0 * bfhi(a0.x) + w1 * bfhi(a1.x));
            v[j].z = xv.z + g5.z * (w0 * bflo(a0.y) + w1 * bflo(a1.y)); v[j].w = xv.w + g5.w * (w0 * bfhi(a0.y) + w1 * bfhi(a1.y));
            s += (v[j].x * v[j].x + v[j].y * v[j].y) + (v[j].z * v[j].z + v[j].w * v[j].w); }
        const float rstd = rsqrtf(wave_sum(s) * (1.f / DM) + EPS);
#pragma unroll
        for (int j = 0; j < 4; ++j) { const int k = 4 * F.lane + 256 * j; const f32x4 g = *(const f32x4*)(fg + k);
            xr[64 * j] = (f32x4){v[j].x * rstd * g.x, v[j].y * rstd * g.y, v[j].z * rstd * g.z, v[j].w * rstd * g.w}; }
    }
}
#ifndef LRU_FAST
#define LRU_FAST 1
#endif
#ifndef HG_FAST
#define HG_FAST 1
#endif
#define MIX_FAST (LRU_FAST && HG_FAST)
#ifdef PROBE_A
#define STAMP(k) do { if (F.bid == 0 && F.tid == 0) { const unsigned long long _t = __builtin_amdgcn_s_memrealtime(); F.MISC[32 + 2 * (k)] = (unsigned)_t; F.MISC[33 + 2 * (k)] = (unsigned)(_t >> 32); } } while (0)
#else
#define STAMP(k) do { } while (0)
#endif
__device__ __forceinline__ void p_mix1(Frame& F, const Args& a) {
#if LRU_FAST
    lru_phase1<0>(F, a, (float*)(F.ws + WS_LRUAGG));
#ifdef XLRU
    lru_phase1<XLRU>(F, a, F.out + (size_t)10 * 1024 * 1024);
#endif
#endif
    STAMP(14); STAMP(15);
#if HG_FAST
    for (int i = 0, u = F.bid; u < NB * 8 * 2 * 4; u += F.G, ++i) hg_pass1(F, a, (u & ~3) | ((u + 2 * i) & 3));
#endif
}
__device__ __forceinline__ void p_mix2(Frame& F, const Args& a) {
#if LRU_FAST
    if (F.bid < NB * 8 * LRU_NCH) {
        const int h = (F.bid >> 4) & 7; int ch = h * 128 + 16 * F.wave + (F.lane & 15);
        asm volatile("" : "+v"(ch));
        const LruCoef kf = lru_coef(a, 0, ch), kb = lru_coef(a, 1, ch);
        for (int u = F.bid; u < NB * 8 * LRU_NCH; u += F.G) lru_pass2(F, a, u, kf, kb);
    }
#endif
    STAMP(16); STAMP(17);
#if HG_FAST
    for (int u = F.bid; u < NB * 8 * 4; u += F.G) hg_pass2(F, a, u);
#endif
}
__global__ void __launch_bounds__(NTHR, 2) mega(Args args) {
    extern __shared__ __attribute__((aligned(16))) unsigned char lds_raw[];
    Frame F;
    F.lds = (LAS unsigned char*)lds_raw; F.MISC = (volatile LAS unsigned*)(F.lds + LDSCTL_OFF);
    F.tid = threadIdx.x; F.lane = F.tid & 63; F.wave = __builtin_amdgcn_readfirstlane(F.tid >> 6);
    F.G = gridDim.x; F.bid = blockIdx.x; F.ws = args.ws; F.out = args.out; F.ctl = (unsigned*)(args.ws + WS_CTL);
    for (int u = F.tid; u < (LDS_BYTES - LDSCTL_OFF) / 4; u += NTHR) ((LAS unsigned*)(F.lds + LDSCTL_OFF))[u] = 0u;
    __syncthreads();
    XcdBarrier bar = xcd_barrier_post(F.ctl + CW_BAR + args.li * 3584, F.MISC + 8);
    const int lo = args.ph_lo, hi = args.ph_hi;
#define IN(k) (lo <= (k) && (k) < hi)
#define SEAM(k) do { if (IN(k) && IN((k) + 1)) xcd_barrier(bar); STAMP((k) + 1); if ((k) == 9) STAMP(11); } while (0)
    unsigned char* ws = F.ws;
    STAMP(0);
    if (IN(0)) { p0_prologue(F, args); } SEAM(0);
    if (IN(1)) { p1_norm(F, args); } SEAM(1);
    if (IN(2)) {
        SchedP2 S{F.G, F.bid, (const char*)F.out, (const char*)(ws + WS_WIN), (char*)(ws + WS_P), (char*)(ws + WS_PC)};
        EpiStoreBf16 E;
        gm::gemm_phase<SchedP2, EpiStoreBf16, false>(F.lds, DM, S, E);
    } SEAM(2);
    if (IN(3)) { p_mix1(F, args); } SEAM(3);
    if (IN(4)) { p_mix2(F, args); } SEAM(4);
    if (IN(6)) {
        const bool conv_first = ((F.bid >> 3) & 1) != 0;
        if (conv_first) { p_moe_weights13(F, args); p_moe_weights2(F, args, F.bid, F.G); __syncthreads(); }
        {
            SchedP5 S{F.bid, (const char*)(ws + WS_YAG), (const char*)(ws + WS_YBG), (const char*)(ws + WS_WPA), (const char*)(ws + WS_WPB), nullptr, (char*)(ws + WS_M)};
            EpiP5 E{(unsigned*)F.out + (size_t)F.bid * 32768, (const bf16*)(ws + WS_P + 7 * GS), (const bf16*)(ws + WS_P + 8 * GS)};
            gm::gemm_phase<SchedP5, EpiP5, false>(F.lds, DM, S, E);
        }
        if (!conv_first) { __syncthreads(); p_moe_weights13(F, args); p_moe_weights2(F, args, F.bid, F.G); }
    } SEAM(6);
    if (IN(7)) {
        SchedP6 S{F.bid, (const char*)(ws + WS_M), (const char*)(ws + WS_WOUT), (char*)F.out};
        EpiP6 E{args.in[IN_X], (const float*)(ws + WS_MOD)};
        gm::gemm_phase<SchedP6, EpiP6, false>(F.lds, DM, S, E);
    } SEAM(7);
    if (IN(8)) { p_norm2_route(F, args); } SEAM(8);
    if (IN(9)) {
        moe_table(F, (const int*)(F.ctl + CW_CNT));
        {
            SchedMoe1 S{F.G, F.bid, F.lane, F.MISC, (const int*)(ws + WS_LIST), (const char*)(ws + WS_HX2), (const char*)(ws + WS_W1T), (const char*)(ws + WS_W3T), (char*)(ws + WS_HH), F.ctl + CW_TILE};
            EpiMoe1 E{(char*)(ws + WS_HH)};
            gm::gemm_phase<SchedMoe1, EpiMoe1, true, true>(F.lds, DM, S, E);
        }
        {
            SchedMoe2 S{F.G, F.bid, F.lane, F.MISC, (const char*)(ws + WS_HH), (const char*)(ws + WS_W2T), (char*)(ws + WS_Y), F.ctl + CW_TILE, F.ctl + 2};
            EpiMoe2 E{(const int*)(ws + WS_LIST)};
            gm::gemm_phase<SchedMoe2, EpiMoe2, false, true>(F.lds, DEXP, S, E);
        }
    } SEAM(9);
    if (IN(11)) { p_final(F, args); }
#ifdef PROBE_A
    if (F.bid == 0 && F.tid == 0) {
        const unsigned long long tend = __builtin_amdgcn_s_memrealtime();
        F.MISC[32 + 2 * 12] = (unsigned)tend; F.MISC[33 + 2 * 12] = (unsigned)(tend >> 32);
        auto RD = [&](int k) { return ((unsigned long long)F.MISC[33 + 2 * k] << 32) | F.MISC[32 + 2 * k]; };
        auto T = [&](int k) { if (k >= 20) { const int i = k - 20; return (unsigned long long)(((((unsigned long long)F.MISC[103 + 2 * i] << 32) | F.MISC[102 + 2 * i]) + 400) / 800); } if (k == 13) return (unsigned long long)((RD(14) - RD(3) + 400) / 800); if (k == 15) return (unsigned long long)((RD(16) - RD(4) + 400) / 800); const unsigned long long t0 = ((unsigned long long)F.MISC[33 + 2 * k] << 32) | F.MISC[32 + 2 * k], t1 = ((unsigned long long)F.MISC[33 + 2 * (k + 1)] << 32) | F.MISC[32 + 2 * (k + 1)]; return (unsigned long long)((t1 - t0 + 400) / 800); };
        const unsigned long long delay = (T(PROBE_A) + 64ull * T(PROBE_B)) * 6400ull;
        while (__builtin_amdgcn_s_memrealtime() - tend < delay) __builtin_amdgcn_s_sleep(32);
    }
#endif
#undef IN
#undef SEAM
}

#if !LRU_FAST
__global__ void k_conv_f(const bf16* P0, const bf16* PC0, const float* cw, const float* cb, float* Ub, int b) {
    int t = blockIdx.x; int Lseg = t < CTX ? CTX : SEQ; int lt = t < CTX ? t : t - CTX;
    const bf16* base = t < CTX ? PC0 + (size_t)b * CTX * DM : P0 + (size_t)b * SEQ * DM;
    for (int ch = threadIdx.x; ch < DM; ch += 256) {
        float s = cb[ch];
#pragma unroll
        for (int k = 0; k < 4; ++k) { int tt = lt + k - 2; if (tt >= 0 && tt < Lseg) s += cw[k * DM + ch] * bf2f(base[(size_t)tt * DM + ch]); }
        Ub[(size_t)t * DM + ch] = s;
    }
}
__global__ void k_gates(const float* Ub, const float* wa, const float* ba, const float* wx, const float* bx, const float* lam, float* Aout, float* Bout, int d) {
    __shared__ float us[128];
    int t = blockIdx.x, h = blockIdx.y, j = threadIdx.x; int ch = h * 128 + j;
    float uval = Ub[(size_t)t * DM + ch];
    us[j] = uval; __syncthreads();
    const float* wah = wa + ((size_t)(d * 8 + h) * 128) * 128; const float* wxh = wx + ((size_t)(d * 8 + h) * 128) * 128;
    float ra = 0.f, ia = 0.f;
    for (int i = 0; i < 128; ++i) { float u = us[i]; ra += u * wah[i * 128 + j]; ia += u * wxh[i * 128 + j]; }
    float r = 1.f / (1.f + expf(-(ra + ba[d * DM + ch]))); float ig = 1.f / (1.f + expf(-(ia + bx[d * DM + ch])));
    float sp = log1pf(expf(-lam[d * DM + ch]));
    float log_a = -8.f * r * sp;
    Aout[(size_t)t * DM + ch] = expf(log_a); Bout[(size_t)t * DM + ch] = sqrtf(-expm1f(2.f * log_a)) * (ig * uval);
}
__global__ void k_lru_scan(const float* A0, const float* B0, const float* A1, const float* B1, float* YF, float* YB) {
    int g = blockIdx.x * 256 + threadIdx.x; int d = g / DM, ch = g % DM;
    if (d == 0) { float h = B0[ch];
        for (int t = 0; t < SEQ; ++t) { size_t o = (size_t)(CTX + t) * DM + ch; h = A0[o] * h + B0[o]; YF[(size_t)t * DM + ch] = h; }
    } else { float h = B1[(size_t)(CTX - 1) * DM + ch];
        for (int t = SEQ - 1; t >= 0; --t) { size_t o = (size_t)(CTX + t) * DM + ch; h = A1[o] * h + B1[o]; YB[(size_t)t * DM + ch] = h; }
    }
}
__global__ void k_yag_f(const float* YF, const float* YB, bf16* AY, int b) {
    int t = blockIdx.x;
    for (int ch = threadIdx.x; ch < DM; ch += 256) { size_t o = (size_t)t * DM + ch; bf16* p = AY + ((size_t)b * SEQ + t) * DM + ch;
        *p = (bf16)f2bf((YF[o] + YB[o]) * gelu_tanh(bf2f(*p))); }
}
#endif
#if !HG_FAST
__global__ __launch_bounds__(128) void k_hgrn_f(unsigned char* ws, const float* hg_lb) {
    __shared__ float gs[128], ks[128], qs[128];
    int h = blockIdx.x, d = blockIdx.y, b = blockIdx.z, j = threadIdx.x;
    float S[128];
#pragma unroll
    for (int i = 0; i < 128; ++i) S[i] = 0.f;
    const int c = h * 128 + j;
    const float lbj = 1.f / (1.f + expf(hg_lb[DM + c] - hg_lb[c]));
    bf16* Q = (bf16*)(ws + WS_P + 2 * GS); bf16* Fx = (bf16*)(ws + WS_P + (d == 0 ? 3 : 4) * GS); bf16* V = (bf16*)(ws + WS_P + 5 * GS);
    const bf16* Fc = (const bf16*)(ws + WS_PC + (d == 0 ? 1 : 2) * CGS); const bf16* Vc = (const bf16*)(ws + WS_PC + 3 * CGS);
    for (int s = 0; s < LT; ++s) {
        bool isx = s >= CTX; float fv, vv, qv = 0.f; size_t o;
        if (!isx) { int t = d == 0 ? s : (CTX - 1 - s); o = ((size_t)b * CTX + t) * DM + c; fv = bf2f(Fc[o]); vv = bf2f(Vc[o]); }
        else { int p = s - CTX; if (d == 1) p = SEQ - 1 - p; int tok = (p % 32) * 64 + (p / 32); o = ((size_t)b * SEQ + tok) * DM + c; fv = bf2f(Fx[o]); vv = bf2f(V[o]); qv = bf2f(Q[o]); }
        float gg = lbj + (1.f - lbj) / (1.f + expf(-fv));
        gs[j] = gg; ks[j] = 1.f - gg; qs[j] = qv / (1.f + expf(-qv));
        __syncthreads();
        float oo = 0.f;
#pragma unroll
        for (int i = 0; i < 128; ++i) { S[i] = gs[i] * S[i] + ks[i] * vv; oo += S[i] * qs[i]; }
        if (isx) Fx[o] = (bf16)f2bf(oo);
        __syncthreads();
    }
}
#endif

extern "C" void kernel_launch(void* const* d_in, const int* in_sizes, int n_in, void* d_out, int out_size, void* d_ws, size_t ws_size, hipStream_t stream) {
    static int grid = 0;
    if (grid == 0) {
        if (n_in != 29 || out_size != NTOK * DM || ws_size < WS_END) { fprintf(stderr, "kernel_launch: unexpected problem shape / workspace (%d inputs, out %d, ws %zu)\n", n_in, out_size, ws_size); grid = -1; return; }
        int dev = 0, cus = 0, per_cu = 0;
        if (hipGetDevice(&dev) != hipSuccess || hipDeviceGetAttribute(&cus, hipDeviceAttributeMultiprocessorCount, dev) != hipSuccess) { grid = -1; return; }
        if (hipFuncSetAttribute((const void*)mega, hipFuncAttributeMaxDynamicSharedMemorySize, LDS_BYTES) != hipSuccess) { grid = -1; return; }
        if (hipOccupancyMaxActiveBlocksPerMultiprocessor(&per_cu, (const void*)mega, NTHR, LDS_BYTES) != hipSuccess || per_cu < 1) { fprintf(stderr, "kernel_launch: occupancy query says %d blocks per CU\n", per_cu); }
        (void)hipGetLastError();
        grid = cus;
        if (grid != 256) { fprintf(stderr, "kernel_launch: built for 256 CUs, found %d\n", cus); grid = -1; return; }
    }
    if (grid < 0) return;
    hipMemsetAsync((char*)d_ws + WS_CTL, 0, CTL_BYTES, stream);
    Args a{};
    for (int i = 0; i < 29; ++i) a.in[i] = (const float*)d_in[i];
    a.out = (float*)d_out; a.ws = (unsigned char*)d_ws;
#if MIX_FAST
    a.ph_lo = 0; a.ph_hi = 12; a.li = 0;
    hipLaunchKernelGGL(mega, dim3(grid), dim3(NTHR), LDS_BYTES, stream, a);
#else
    a.ph_lo = 0; a.ph_hi = 5; a.li = 0;
    hipLaunchKernelGGL(mega, dim3(grid), dim3(NTHR), LDS_BYTES, stream, a);
    {
        unsigned char* ws = (unsigned char*)d_ws;
#if !LRU_FAST
        float* sc = (float*)d_out;
        float* Ub = sc; float* A0 = Ub + (size_t)LT * DM; float* B0 = A0 + (size_t)LT * DM; float* A1 = B0 + (size_t)LT * DM; float* B1 = A1 + (size_t)LT * DM;
        float* YF = B1 + (size_t)LT * DM; float* YB = YF + (size_t)SEQ * DM;
        const float* cw = (const float*)d_in[IN_CONVW]; const float* cb = (const float*)d_in[IN_CONVB];
        const float* wa = (const float*)d_in[IN_WA]; const float* ba = (const float*)d_in[IN_BA]; const float* wx = (const float*)d_in[IN_WX]; const float* bx = (const float*)d_in[IN_BX]; const float* lam = (const float*)d_in[IN_LAM];
        for (int b = 0; b < NB; ++b) {
            k_conv_f<<<LT, 256, 0, stream>>>((const bf16*)(ws + WS_P), (const bf16*)(ws + WS_PC), cw, cb, Ub, b);
            k_gates<<<dim3(LT, 8), 128, 0, stream>>>(Ub, wa, ba, wx, bx, lam, A0, B0, 0);
            k_gates<<<dim3(LT, 8), 128, 0, stream>>>(Ub, wa, ba, wx, bx, lam, A1, B1, 1);
            k_lru_scan<<<8, 256, 0, stream>>>(A0, B0, A1, B1, YF, YB);
            k_yag_f<<<SEQ, 256, 0, stream>>>(YF, YB, (bf16*)(ws + WS_YAG), b);
        }
#endif
#if !HG_FAST
        k_hgrn_f<<<dim3(8, 2, NB), 128, 0, stream>>>(ws, (const float*)d_in[IN_HGLB]);
#endif
    }
    a.ph_lo = 5; a.ph_hi = 12; a.li = 1;
    hipLaunchKernelGGL(mega, dim3(grid), dim3(NTHR), LDS_BYTES, stream, a);
#endif
}
```

```cpp
#include <hip/hip_runtime.h>
#include <cstdio>
#include <cstdint>
#include <math.h>

#define LAS __attribute__((address_space(3)))
#define GAS __attribute__((address_space(1)))
typedef unsigned short bf16;
typedef short bf16x8 __attribute__((ext_vector_type(8)));
typedef float f32x4 __attribute__((ext_vector_type(4)));
typedef float f32x2 __attribute__((ext_vector_type(2)));
typedef unsigned u32x4 __attribute__((ext_vector_type(4)));
typedef unsigned u32x2 __attribute__((ext_vector_type(2)));

constexpr int DM = 1024, NB = 8, SEQ = 2048, CTX = 256, NTOK = NB * SEQ, NCTX = NB * CTX, INW = 9216, LT = CTX + SEQ;
constexpr int NEXP = 32, DEXP = 512, CAP = 16384;
constexpr float EPS = 1e-6f;
constexpr int NWAVES = 8, NTHR = 512;

constexpr size_t MiB = 1u << 20, KiB = 1024;
constexpr size_t WS_CTL = 0, CTL_BYTES = 64 * KiB;
constexpr size_t WS_MODP = 256 * KiB;
constexpr size_t WS_MOD = 2 * MiB;
constexpr size_t WS_LRUAGG = 2 * MiB + 512 * KiB;
constexpr size_t WS_LRUS0 = 4 * MiB + 512 * KiB;
constexpr size_t WS_WT = 4 * MiB + 768 * KiB;
constexpr size_t WS_LIST = 5 * MiB;
constexpr size_t WS_HGD = 7 * MiB;
constexpr size_t WS_WRT = 7 * MiB + 256 * KiB;
constexpr size_t WS_WIN = 8 * MiB;
constexpr size_t WS_WPA = 26 * MiB, WS_WPB = 28 * MiB, WS_WOUT = 30 * MiB;
constexpr size_t WS_WLRU = 32 * MiB;
constexpr size_t WS_P = 33 * MiB, GS = 32 * MiB;
constexpr size_t WS_PC = 321 * MiB, CGS = 4 * MiB;
constexpr size_t WS_END = 337 * MiB;
constexpr size_t WS_W1T = WS_P + 0 * GS, WS_W3T = WS_P + 2 * GS, WS_W2T = WS_P + 5 * GS;
constexpr size_t WS_YAG = WS_P + 1 * GS;
constexpr size_t WS_OF = WS_P + 3 * GS, WS_OB = WS_P + 4 * GS;
constexpr size_t WS_YBG = WS_P + 3 * GS;
constexpr size_t WS_M = WS_P + 4 * GS;
constexpr size_t WS_HX2 = WS_P + 1 * GS;
constexpr size_t WS_HH = WS_P + 3 * GS;
constexpr size_t WS_Y = WS_P + 6 * GS;

constexpr int CW_BAR = 1024;
constexpr int CW_CNT = 12288;
constexpr int CW_TILE = 14336;
constexpr int CW_PANEL = 15616;

constexpr int RING_BYTES = 131072, LDS_BYTES = 147456, LDSCTL_OFF = LDS_BYTES - 1024;

#define LDS_WAIT() asm volatile("s_waitcnt lgkmcnt(0)" ::: "memory")
#define VM_WAIT() asm volatile("s_waitcnt vmcnt(0)" ::: "memory")

typedef __bf16 bf16x2_t __attribute__((ext_vector_type(2)));
__device__ __forceinline__ unsigned pk2(float lo, float hi) { const f32x2 v = {lo, hi}; return __builtin_bit_cast(unsigned, __builtin_convertvector(v, bf16x2_t)); }
__device__ __forceinline__ unsigned f2bf(float f) { return pk2(f, 0.f) & 0xffffu; }
__device__ __forceinline__ float bf2f(unsigned short b) { return __builtin_bit_cast(float, (unsigned)b << 16); }
__device__ __forceinline__ float bflo(unsigned w) { return __builtin_bit_cast(float, w << 16); }
__device__ __forceinline__ float bfhi(unsigned w) { return __builtin_bit_cast(float, w & 0xffff0000u); }
__device__ __forceinline__ float sigmoidf_(float x) { return 1.f / (1.f + __expf(-x)); }
__device__ __forceinline__ float siluf_(float x) { return x / (1.f + __expf(-x)); }
__device__ __forceinline__ float gelu_tanh(float x) { float u = 0.7978845608028654f * (x + 0.044715f * x * x * x); float e = __expf(2.f * u); return x * (1.f - 1.f / (1.f + e)); }
__device__ __forceinline__ float wave_sum(float v) {
#pragma unroll
    for (int o = 1; o < 64; o <<= 1) v += __shfl_xor(v, o);
    return v;
}

#define XB_TMO      128
#define XB_XCNT(j)  (256  + 64 * (j))
#define XB_XSUB(j)  (1280 + 64 * (j))
#define XB_XGEN(j)  (2304 + 64 * (j))
#define XB_TOP      3328
#define XB_TOPGEN   3392
#define XCD_BAR_WORDS 3456
#define XB_SPIN_CAP (1u << 20)
__device__ __forceinline__ unsigned xb_ld(unsigned* p)              { return __hip_atomic_load(p, __ATOMIC_RELAXED, __HIP_MEMORY_SCOPE_AGENT); }
__device__ __forceinline__ unsigned xb_add(unsigned* p, unsigned v) { return __hip_atomic_fetch_add(p, v, __ATOMIC_RELAXED, __HIP_MEMORY_SCOPE_AGENT); }
__device__ __forceinline__ unsigned xb_xcc_id() { return (unsigned)__builtin_amdgcn_s_getreg((3 << 11) | 20) & 0xFu; }
#define XB_SPIN(cond, bar) do { unsigned _sp = 0; while (cond) { __builtin_amdgcn_s_sleep(1); \
    if ((++_sp & 255u) == 0u) { if (xb_ld(&(bar)[XB_TMO])) break; if (_sp > XB_SPIN_CAP) { atomicAdd(&(bar)[XB_TMO], 1u); break; } } } } while (0)
struct XcdBarrier { unsigned* bar; unsigned x; volatile LAS unsigned* st; };
__device__ __forceinline__ XcdBarrier xcd_barrier_post(unsigned* bar, volatile LAS unsigned* st) {
    XcdBarrier b; b.bar = bar; b.x = xb_xcc_id(); b.st = st;
    if (threadIdx.x == 0) (void)xb_add(&bar[XB_XCNT(b.x)], 1u);
    return b;
}
__device__ __forceinline__ void xcd_barrier_complete(unsigned* bar, unsigned x, unsigned& nloc, unsigned& nx) {
    const unsigned G = gridDim.x * gridDim.y * gridDim.z;
    unsigned sum, cnt, mine, sp = 0u;
    for (;;) {
        sum = 0u; cnt = 0u; mine = 0u;
#pragma unroll
        for (unsigned j = 0; j < 16; ++j) { const unsigned c = xb_ld(&bar[XB_XCNT(j)]); sum += c; cnt += (c > 0u) ? 1u : 0u; mine = (j == x) ? c : mine; }
        if (sum == G) break;
        __builtin_amdgcn_s_sleep(1);
        if ((++sp & 255u) == 0u) { if (xb_ld(&bar[XB_TMO])) break; if (sp > XB_SPIN_CAP) { atomicAdd(&bar[XB_TMO], 1u); break; } }
    }
    nloc = mine > 0u ? mine : 1u; nx = cnt > 0u ? cnt : 1u;
}
__device__ __forceinline__ void xcd_barrier(const XcdBarrier& b) {
    asm volatile("s_waitcnt vmcnt(0)" ::: "memory");
    __syncthreads();
    if (threadIdx.x == 0) {
        unsigned* bar = b.bar;
        __builtin_amdgcn_s_waitcnt(0);
        unsigned nloc = b.st[0], nx = b.st[1];
        if (nloc == 0u) { xcd_barrier_complete(bar, b.x, nloc, nx); b.st[0] = nloc; b.st[1] = nx; }
        const unsigned old = xb_add(&bar[XB_XSUB(b.x)], 1u);
        const unsigned gen = old / nloc;
        if (old + 1u == (gen + 1u) * nloc) {
            __builtin_amdgcn_fence(__ATOMIC_RELEASE, "agent");
            asm volatile("s_waitcnt vmcnt(0)" ::: "memory");
            const unsigned og = xb_add(&bar[XB_TOP], 1u);
            const unsigned tg = og / nx;
            if (og + 1u == (tg + 1u) * nx) xb_add(&bar[XB_TOPGEN], 1u);
            else XB_SPIN(xb_ld(&bar[XB_TOPGEN]) == tg, bar);
            __builtin_amdgcn_fence(__ATOMIC_ACQUIRE, "agent");
            xb_add(&bar[XB_XGEN(b.x)], 1u);
            asm volatile("s_waitcnt vmcnt(0)" ::: "memory");
        } else {
            XB_SPIN(xb_ld(&bar[XB_XGEN(b.x)]) == gen, bar);
            __builtin_amdgcn_fence(__ATOMIC_ACQUIRE, "agent");
            asm volatile("s_waitcnt vmcnt(0)" ::: "memory");
        }
    }
    __syncthreads();
}

namespace gm {
constexpr int BM = 256, BK = 64, HALF = 128, HTB = HALF * BK * 2;
__device__ __forceinline__ int lds_byte(int r, int c) { const int st = (r >> 4) * 2 + (c >> 5), rr = r & 15, cc = c & 31, ob = rr * 64 + cc * 2; return st * 1024 + (ob ^ (((ob >> 9) & 1) << 5)); }
__device__ __forceinline__ void stage_rc(int b, int& R, int& C) { const int st = b / 1024, sb = b % 1024, swz = sb ^ (((sb >> 9) & 1) << 5); R = (st >> 1) * 16 + swz / 64; C = (st & 1) * 32 + (swz % 64) / 2; }
__device__ __forceinline__ int perm32(int rho) { const int n = rho >> 4, i = rho & 15; return 8 * (i >> 2) + 4 * n + (i & 3); }
__device__ __forceinline__ unsigned cvt_pk_bf16(float lo, float hi) { unsigned r; asm volatile("v_cvt_pk_bf16_f32 %0, %1, %2" : "=v"(r) : "v"(lo), "v"(hi)); return r; }

struct Unit { const char* A; const char* B0; const char* B1; char* dst; int pm, pn, e, rows, t; };

template <class Sched, class Epi, bool GATHER, bool HOOKS = false>
__device__ __forceinline__ void gemm_phase(LAS unsigned char* lds, const int K, const Sched& S, const Epi& E) {
    const int tid = threadIdx.x, wid = __builtin_amdgcn_readfirstlane(tid >> 6), lane = tid & 63, wr = wid >> 2, wc = wid & 3, fr = lane & 15, fq = lane >> 4;
    const int nt = K / BK;
    unsigned voffB[2]; int Rr[2]; unsigned Cb[2];
#pragma unroll
    for (int i = 0; i < 2; ++i) { int R, C; stage_rc(tid * 16 + i * 8192, R, C); const int Rb = Epi::PERM ? ((R & ~31) + perm32(R & 31)) : R;
        Rr[i] = R; Cb[i] = (unsigned)C * 2u; voffB[i] = (unsigned)(Rb * K + C) * 2u; }
    const unsigned rowb = (unsigned)K * 2u;
    const size_t kstep = (size_t)(BK * 2);
    const unsigned ldsw = (unsigned)wid * 1024u;
    const int aoff = lds_byte(wr * 64 + fr, fq * 8), boff = lds_byte(wc * 32 + fr, fq * 8);
#define GM_SA(b, h) (((b) * 2 + (h)) * HTB)
#define GM_SB(b, h) ((4 + (b) * 2 + (h)) * HTB)
#define GM_STAGE(bufoff, gbase, voff) do { _Pragma("unroll") for (int _i = 0; _i < 2; ++_i) \
        __builtin_amdgcn_global_load_lds((const unsigned*)((const char*)(gbase) + (voff)[_i]), (LAS unsigned*)(lds + (bufoff) + ldsw + _i * 8192), 16, 0, 0); } while (0)
#define GM_LDA(dst, b, h) do { _Pragma("unroll") for (int m = 0; m < 4; ++m) _Pragma("unroll") for (int k = 0; k < 2; ++k) dst[m][k] = *(const LAS bf16x8*)(lds + GM_SA(b, h) + aoff + m * 2048 + k * 1024); } while (0)
#define GM_LDB(dst, b, h) do { _Pragma("unroll") for (int n = 0; n < 2; ++n) _Pragma("unroll") for (int k = 0; k < 2; ++k) dst[n][k] = *(const LAS bf16x8*)(lds + GM_SB(b, h) + boff + n * 2048 + k * 1024); } while (0)
#define GM_MMA(ai, bj, At, Bt) do { __builtin_amdgcn_s_setprio(1); _Pragma("unroll") for (int m = 0; m < 4; ++m) _Pragma("unroll") for (int n = 0; n < 2; ++n) _Pragma("unroll") for (int k = 0; k < 2; ++k) \
        acc[ai][bj][m][n] = __builtin_amdgcn_mfma_f32_16x16x32_bf16(Bt[n][k], At[m][k], acc[ai][bj][m][n], 0, 0, 0); __builtin_amdgcn_s_setprio(0); } while (0)
#define GM_WAIT_V(n) asm volatile("s_waitcnt vmcnt(" #n ")" ::: "memory")
#define GM_WAIT_L(n) asm volatile("s_waitcnt lgkmcnt(" #n ")" ::: "memory")
#define GM_BAR __builtin_amdgcn_s_barrier()
#define GM_SCHED __builtin_amdgcn_sched_barrier(0)
#define GM_AOFFS(u, o) do { _Pragma("unroll") for (int _h = 0; _h < 2; ++_h) _Pragma("unroll") for (int _i = 0; _i < 2; ++_i) \
        (o)[_h][_i] = (GATHER ? S.arow((u), _h * HALF + Rr[_i]) : (unsigned)(_h * HALF + Rr[_i])) * rowb + Cb[_i]; } while (0)
    Unit cur, nxt; int ui = 0;
    if (!S.next(0, cur)) return;
    f32x4 acc[2][2][4][2];
#pragma unroll
    for (int a = 0; a < 2; ++a)
#pragma unroll
        for (int b = 0; b < 2; ++b)
#pragma unroll
            for (int m = 0; m < 4; ++m)
#pragma unroll
                for (int n = 0; n < 2; ++n) acc[a][b][m][n] = (f32x4){0.f, 0.f, 0.f, 0.f};
    bf16x8 At[4][2], B0[2][2], B1[2][2];
    unsigned ca[2][2], na[2][2];
    GM_AOFFS(cur, ca);
    const char* cA = cur.A; const char* cB0 = cur.B0; const char* cB1 = cur.B1;
    if constexpr (HOOKS) S.a_ready(cur);
    GM_STAGE(GM_SB(0, 0), cB0, voffB); GM_STAGE(GM_SB(0, 1), cB1, voffB); GM_STAGE(GM_SA(0, 0), cA, ca[0]); GM_STAGE(GM_SA(0, 1), cA, ca[1]);
    if (wr == 1) GM_BAR;
    GM_WAIT_V(2); GM_BAR;
    GM_STAGE(GM_SB(1, 0), cB0 + kstep, voffB); GM_STAGE(GM_SA(1, 0), cA + kstep, ca[0]); GM_STAGE(GM_SB(1, 1), cB1 + kstep, voffB);
    GM_WAIT_V(6); GM_BAR;
    for (;;) {
        const bool has_next = S.next(ui + 1, nxt);
        const char* nA = has_next ? nxt.A : cA; const char* nB0 = has_next ? nxt.B0 : cB0; const char* nB1 = has_next ? nxt.B1 : cB1;
        if (has_next) { GM_AOFFS(nxt, na); } else {
#pragma unroll
            for (int h = 0; h < 2; ++h)
#pragma unroll
                for (int i = 0; i < 2; ++i) na[h][i] = ca[h][i]; }
        for (int t = 0; t < nt; t += 2) {
            const bool last = (t == nt - 2);
            if constexpr (HOOKS) { if (last && has_next) S.a_ready(nxt); }
            const char* a1 = cA + (size_t)(t + 1) * kstep;
            const char* a2 = last ? nA : cA + (size_t)(t + 2) * kstep;
            const char* b20 = last ? nB0 : cB0 + (size_t)(t + 2) * kstep; const char* b21 = last ? nB1 : cB1 + (size_t)(t + 2) * kstep;
            const char* a3 = a2 + kstep; const char* b30 = b20 + kstep; const char* b31 = b21 + kstep;
            unsigned o2[2][2];
#pragma unroll
            for (int h = 0; h < 2; ++h)
#pragma unroll
                for (int i = 0; i < 2; ++i) o2[h][i] = last ? na[h][i] : ca[h][i];
            GM_LDB(B0, 0, 0); GM_LDB(B1, 0, 1); GM_SCHED; GM_LDA(At, 0, 0); GM_STAGE(GM_SA(1, 1), a1, ca[1]);
            GM_WAIT_V(8); GM_WAIT_L(0); GM_BAR; GM_MMA(0, 0, At, B0); GM_MMA(0, 1, At, B1); GM_BAR; GM_SCHED;
            GM_LDA(At, 0, 1); GM_STAGE(GM_SB(0, 0), b20, voffB); GM_STAGE(GM_SB(0, 1), b21, voffB); GM_STAGE(GM_SA(0, 0), a2, o2[0]);
            GM_WAIT_V(8); GM_WAIT_L(0); GM_BAR; GM_MMA(1, 0, At, B0); GM_MMA(1, 1, At, B1); GM_BAR; GM_SCHED;
            GM_LDB(B0, 1, 0); GM_LDB(B1, 1, 1); GM_SCHED; GM_LDA(At, 1, 0); GM_STAGE(GM_SA(0, 1), a2, o2[1]);
            GM_WAIT_V(8); GM_WAIT_L(0); GM_BAR; GM_MMA(0, 0, At, B0); GM_MMA(0, 1, At, B1); GM_BAR; GM_SCHED;
            GM_LDA(At, 1, 1); GM_STAGE(GM_SB(1, 0), b30, voffB); GM_STAGE(GM_SB(1, 1), b31, voffB); GM_STAGE(GM_SA(1, 0), a3, o2[0]);
            GM_WAIT_V(8); GM_WAIT_L(0); GM_BAR; GM_MMA(1, 0, At, B0); GM_MMA(1, 1, At, B1); GM_BAR; GM_SCHED;
        }
        if (wr == 0) GM_BAR;
        E(acc, cur, wr, wc, fr, fq);
        if constexpr (HOOKS) S.done(cur);
        if (!has_next) break;
#pragma unroll
        for (int a = 0; a < 2; ++a)
#pragma unroll
            for (int b = 0; b < 2; ++b)
#pragma unroll
                for (int m = 0; m < 4; ++m)
#pragma unroll
                    for (int n = 0; n < 2; ++n) acc[a][b][m][n] = (f32x4){0.f, 0.f, 0.f, 0.f};
        cur = nxt; cA = nA; cB0 = nB0; cB1 = nB1; ++ui;
#pragma unroll
        for (int h = 0; h < 2; ++h)
#pragma unroll
            for (int i = 0; i < 2; ++i) ca[h][i] = na[h][i];
        if (wr == 1) GM_BAR;
    }
    GM_WAIT_V(0);
    GM_BAR;
#undef GM_SA
#undef GM_SB
#undef GM_STAGE
#undef GM_LDA
#undef GM_LDB
#undef GM_MMA
#undef GM_WAIT_V
#undef GM_WAIT_L
#undef GM_BAR
#undef GM_SCHED
#undef GM_AOFFS
}
}
struct Args {
    const float* in[29]; float* out; unsigned char* ws; int ph_lo, ph_hi, li, pad;
};
struct Frame {
    LAS unsigned char* lds; volatile LAS unsigned* MISC;
    unsigned* ctl; unsigned char* ws; float* out;
    int tid, lane, wave, G, bid;
};
enum { IN_X = 0, IN_C, IN_CTX, IN_CCTX, IN_WMOD, IN_BMOD, IN_G1, IN_WIN, IN_CONVW, IN_CONVB, IN_WA, IN_BA, IN_WX, IN_BX, IN_LAM, IN_HGLB, IN_HGN,
       IN_WPA, IN_WPB, IN_WOUT, IN_G2, IN_WRG, IN_BRG, IN_WRE, IN_BRE, IN_W1, IN_W3, IN_W2, IN_FG };

constexpr int TR_BYTES = 64 * 64 * 4;
__device__ __forceinline__ void transpose_item(const float* W, int ldw, int K, bf16* WT, int k0, int n0, LAS float* scr, int lane) {
    const int lr = lane >> 4, ls = lane & 15;
    f32x4 v[16];
#pragma unroll
    for (int i = 0; i < 16; ++i) v[i] = *(const f32x4*)(W + (size_t)(k0 + 4 * i + lr) * ldw + n0 + 4 * ls);
#pragma unroll
    for (int i = 0; i < 16; ++i) { const int k = 4 * i + lr; *(LAS f32x4*)(scr + k * 64 + ((ls ^ ((k >> 3) & 7)) << 2)) = v[i]; }
    LDS_WAIT(); asm volatile("" ::: "memory");
    const int c = lane & 7;
#pragma unroll
    for (int j = 0; j < 8; ++j) { const int n = (lane >> 3) + 8 * j; const LAS float* s = scr + (8 * c) * 64 + ((((n >> 2) ^ c) << 2) | (n & 3));
        u32x4 o; o.x = pk2(s[0 * 64], s[1 * 64]); o.y = pk2(s[2 * 64], s[3 * 64]); o.z = pk2(s[4 * 64], s[5 * 64]); o.w = pk2(s[6 * 64], s[7 * 64]);
        *(u32x4*)(WT + (size_t)n * K + k0 + 8 * c) = o; }
    LDS_WAIT(); asm volatile("" ::: "memory");
}

__device__ __forceinline__ void p0_mod_item(Frame& F, const Args& a, int item) {
    const int cb = item % 24, ks = item / 24;
    LAS float* sv = (LAS float*)F.lds;
    LAS float* red = sv + 9 * 128;
    const float* c = a.in[IN_C]; const float* cc = a.in[IN_CCTX]; const float* wmod = a.in[IN_WMOD];
    for (int i = F.tid; i < 9 * 128; i += NTHR) { const int r = i >> 7, k = i & 127; const float v = r < 8 ? c[r * DM + ks * 128 + k] : cc[ks * 128 + k]; sv[i] = siluf_(v); }
    __syncthreads();
    const int col = cb * 256 + (F.tid & 255), kh = F.tid >> 8;
    float acc[9];
#pragma unroll
    for (int r = 0; r < 9; ++r) acc[r] = 0.f;
    for (int k0 = 0; k0 < 64; k0 += 16) { float wv[16];
#pragma unroll
        for (int k = 0; k < 16; ++k) wv[k] = wmod[(size_t)(ks * 128 + kh * 64 + k0 + k) * 6144 + col];
#pragma unroll
        for (int k = 0; k < 16; ++k) { const int kk = kh * 64 + k0 + k;
#pragma unroll
            for (int r = 0; r < 9; ++r) acc[r] += sv[r * 128 + kk] * wv[k]; } }
    if (kh == 1) {
#pragma unroll
        for (int r = 0; r < 9; ++r) red[r * 256 + (F.tid & 255)] = acc[r]; }
    __syncthreads();
    float* modp = (float*)(F.ws + WS_MODP);
    if (kh == 0) {
#pragma unroll
        for (int r = 0; r < 9; ++r) modp[(size_t)(ks * 9 + r) * 6144 + col] = acc[r] + red[r * 256 + F.tid]; }
    __syncthreads();
}
__device__ __forceinline__ float mod_from_partials(const float* modp, const float* bmod, int row, int j) {
    float s = bmod[j];
#pragma unroll
    for (int ks = 0; ks < 8; ++ks) s += modp[(size_t)(ks * 9 + row) * 6144 + j];
    return s;
}

__device__ __forceinline__ void p0_prologue(Frame& F, const Args& a) {
    if (F.bid < 192) p0_mod_item(F, a, F.bid);
    LAS float* scr = (LAS float*)(F.lds + F.wave * TR_BYTES);
    const int gw = F.bid * NWAVES + F.wave, NGW = F.G * NWAVES;
    constexpr int I_IN = 16 * 144, I_PR = 16 * 16, I_LRU = 32 * 4;
    constexpr int NITEMS = I_IN + 3 * I_PR + I_LRU;
    for (int it = gw; it < NITEMS; it += NGW) {
        int r = it;
        if (r < I_IN) { const int kb = r / 144, nb = r % 144; transpose_item(a.in[IN_WIN], INW, DM, (bf16*)(F.ws + WS_WIN) + (size_t)(nb * 64) * DM, kb * 64, nb * 64, scr, F.lane); continue; } r -= I_IN;
        if (r < 3 * I_PR) { const int w = r / I_PR, q = r % I_PR, kb = q / 16, nb = q % 16;
            const float* W = a.in[w == 0 ? IN_WPA : (w == 1 ? IN_WPB : IN_WOUT)]; bf16* WT = (bf16*)(F.ws + (w == 0 ? WS_WPA : (w == 1 ? WS_WPB : WS_WOUT)));
            transpose_item(W, DM, DM, WT + (size_t)(nb * 64) * DM, kb * 64, nb * 64, scr, F.lane); continue; } r -= 3 * I_PR;
        { const int mat = r / 4, q = r % 4, kb = q / 2, nb = q % 2;
          const int which = mat >> 4, dh = mat & 15;
          const float* W = a.in[which == 0 ? IN_WA : IN_WX] + (size_t)dh * 128 * 128; bf16* WT = (bf16*)(F.ws + WS_WLRU) + (size_t)mat * 128 * 128;
          transpose_item(W, 128, 128, WT + (size_t)(nb * 64) * 128, kb * 64, nb * 64, scr, F.lane); }
    }
    float* wrp = (float*)(F.ws + WS_WRT);
    for (int i = F.bid * NTHR + F.tid; i < 49152 + 48; i += F.G * NTHR) {
        if (i < 49152) { const int j = i & 3, ln = (i >> 2) & 63, sc = i >> 8, c = sc % 3, s2 = sc / 3; const int k = 16 * s2 + 4 * (ln >> 4) + j, o = 16 * c + (ln & 15);
            wrp[i] = o < 4 ? a.in[IN_WRG][k * 4 + o] : (o < 36 ? a.in[IN_WRE][k * 32 + (o - 4)] : 0.f); }
        else { const int o = i - 49152; wrp[i] = o < 4 ? a.in[IN_BRG][o] : (o < 36 ? a.in[IN_BRE][o - 4] : 0.f); }
    }
}

__device__ __forceinline__ void norm_rows(Frame& F, const float* src, bf16* dst, int row0, int nrows, const LAS float* gs, const LAS float* sh) {
    for (int r = F.wave; r < nrows; r += 2 * NWAVES) {
        const int r1 = r + NWAVES < nrows ? r + NWAVES : r;
        const f32x4* xa = (const f32x4*)(src + (size_t)(row0 + r) * DM) + F.lane; const f32x4* xb = (const f32x4*)(src + (size_t)(row0 + r1) * DM) + F.lane;
        f32x4 va[4], vb[4]; float sa = 0.f, sb = 0.f;
#pragma unroll
        for (int j = 0; j < 4; ++j) { va[j] = xa[64 * j]; vb[j] = xb[64 * j]; }
#pragma unroll
        for (int j = 0; j < 4; ++j) { sa += (va[j].x * va[j].x + va[j].y * va[j].y) + (va[j].z * va[j].z + va[j].w * va[j].w); sb += (vb[j].x * vb[j].x + vb[j].y * vb[j].y) + (vb[j].z * vb[j].z + vb[j].w * vb[j].w); }
        const float ra = rsqrtf(wave_sum(sa) * (1.f / DM) + EPS), rb = rsqrtf(wave_sum(sb) * (1.f / DM) + EPS);
        unsigned long long* oa = (unsigned long long*)(dst + (size_t)(row0 + r) * DM) + F.lane; unsigned long long* ob = (unsigned long long*)(dst + (size_t)(row0 + r1) * DM) + F.lane;
#pragma unroll
        for (int j = 0; j < 4; ++j) { const int k = 4 * F.lane + 256 * j;
            const f32x4 g = *(const LAS f32x4*)(gs + k), h = *(const LAS f32x4*)(sh + k);
            oa[64 * j] = (unsigned long long)pk2(va[j].x * ra * g.x + h.x, va[j].y * ra * g.y + h.y) | ((unsigned long long)pk2(va[j].z * ra * g.z + h.z, va[j].w * ra * g.w + h.w) << 32);
            ob[64 * j] = (unsigned long long)pk2(vb[j].x * rb * g.x + h.x, vb[j].y * rb * g.y + h.y) | ((unsigned long long)pk2(vb[j].z * rb * g.z + h.z, vb[j].w * rb * g.w + h.w) << 32); }
    }
}
struct EpiStoreBf16 {
    static constexpr bool PERM = true;
    __device__ __forceinline__ void operator()(const f32x4 (&acc)[2][2][4][2], const gm::Unit& u, int wr, int wc, int fr, int fq) const {
        bf16* base = (bf16*)u.dst + (size_t)(wr * 64 + fr) * DM + wc * 32 + 8 * fq;
#pragma unroll
        for (int ai = 0; ai < 2; ++ai)
#pragma unroll
            for (int m = 0; m < 4; ++m) { bf16* rowp = base + (size_t)(ai * 128 + m * 16) * DM;
#pragma unroll
                for (int bj = 0; bj < 2; ++bj) { const f32x4 v0 = acc[ai][bj][m][0], v1 = acc[ai][bj][m][1];
                    u32x4 w; w.x = gm::cvt_pk_bf16(v0[0], v0[1]); w.y = gm::cvt_pk_bf16(v0[2], v0[3]); w.z = gm::cvt_pk_bf16(v1[0], v1[1]); w.w = gm::cvt_pk_bf16(v1[2], v1[3]);
                    *(u32x4*)(rowp + bj * 128) = w; } }
    }
};
__device__ __forceinline__ void tile_order(int L, int nM, int nN, int& pm, int& pn) {
    const int nwg = nM * nN; int wgid = L;
    { const int q = nwg / 8, r = nwg % 8, xcd = wgid % 8, off = wgid / 8; wgid = (xcd < r ? xcd * (q + 1) : r * (q + 1) + (xcd - r) * q) + off; }
    const int nig = 8 * nN, gid = wgid / nig, fm = gid * 8, gsz = (nM - fm) < 8 ? (nM - fm) : 8;
    pm = fm + ((wgid % nig) % gsz); pn = (wgid % nig) / gsz;
}
struct SchedP2 {
    int G, c; const char* H; const char* Wt; char* P; char* PC;
    __device__ __forceinline__ bool next(int i, gm::Unit& u) const {
        int L = i * G + c;
        if (L < 64 * 36) { int pm, pn; tile_order(L, 64, 36, pm, pn);
            u.A = H + (size_t)pm * 256 * 2048; u.B0 = Wt + (size_t)pn * 256 * 2048; u.B1 = u.B0 + (size_t)128 * 2048;
            u.dst = P + (size_t)(pn >> 2) * GS + ((size_t)pm * 256 * DM + (pn & 3) * 256) * 2; u.pm = pm; u.pn = pn; u.e = 0; u.rows = 256; return true; }
        return false;
    }
    __device__ __forceinline__ unsigned arow(const gm::Unit&, int r) const { return (unsigned)r; }
};
struct SchedCtx {
    int bid; const char* H; const char* Wt; char* PC; unsigned* cnt; unsigned* tmo;
    __device__ __forceinline__ bool next(int i, gm::Unit& u) const {
        if (i > 0) return false;
        const int pmc = bid >> 4, j = bid & 15, slot = j >> 2, g = slot == 0 ? 0 : slot + 2, pn = g * 4 + (j & 3);
        u.A = H + (size_t)(NTOK + pmc * 256) * 2048; u.B0 = Wt + (size_t)pn * 256 * 2048; u.B1 = u.B0 + (size_t)128 * 2048;
        u.dst = PC + (size_t)slot * CGS + ((size_t)pmc * 256 * DM + (j & 3) * 256) * 2; u.pm = pmc; u.pn = pn; u.e = 0; u.rows = 256; u.t = pmc; return true;
    }
    __device__ __forceinline__ unsigned arow(const gm::Unit&, int r) const { return (unsigned)r; }
    __device__ __forceinline__ void a_ready(const gm::Unit& u) const {
        if (threadIdx.x < 64) {
            unsigned spins = 0;
            while ((unsigned)__builtin_amdgcn_readfirstlane(__hip_atomic_load(cnt + 8 * u.t, __ATOMIC_RELAXED, __HIP_MEMORY_SCOPE_AGENT)) < 16u) {
                __builtin_amdgcn_s_sleep(2);
                if (++spins > (1u << 22)) { if (threadIdx.x == 0) __hip_atomic_store(tmo, 1u, __ATOMIC_RELAXED, __HIP_MEMORY_SCOPE_AGENT); break; } }
            __builtin_amdgcn_fence(__ATOMIC_ACQUIRE, "agent");
            asm volatile("s_waitcnt vmcnt(0)" ::: "memory");
        }
        asm volatile("" ::: "memory"); __builtin_amdgcn_s_barrier(); asm volatile("" ::: "memory");
    }
    __device__ __forceinline__ void done(const gm::Unit&) const {}
};
__device__ __forceinline__ void p1_norm(Frame& F, const Args& a) {
    const float* modp = (const float*)(F.ws + WS_MODP); const float* bmod = a.in[IN_BMOD]; const float* g1 = a.in[IN_G1];
    LAS float* gs = (LAS float*)F.lds; LAS float* sh = gs + DM;
    bf16* H = (bf16*)F.out;
    float* mod = (float*)(F.ws + WS_MOD);
    for (int i = F.bid * NTHR + F.tid; i < 9 * 6144; i += F.G * NTHR) mod[i] = mod_from_partials(modp, bmod, i / 6144, i % 6144);
    if (F.bid >= 128) {
        const int wg = F.bid - 128, b = wg >> 4;
        for (int k = F.tid; k < DM; k += NTHR) { gs[k] = g1[k] * (1.f + mod_from_partials(modp, bmod, b, DM + k)); sh[k] = mod_from_partials(modp, bmod, b, k); }
        __syncthreads();
        norm_rows(F, a.in[IN_X], H, wg * 128, 128, gs, sh);
        __syncthreads();
    } else {
        for (int k = F.tid; k < DM; k += NTHR) { gs[k] = g1[k] * (1.f + mod_from_partials(modp, bmod, 8, DM + k)); sh[k] = mod_from_partials(modp, bmod, 8, k); }
        __syncthreads();
        const int pmc = F.bid >> 4, r0 = pmc * 256 + (F.bid & 15) * 16;
        const __amdgpu_buffer_rsrc_t rs = __builtin_amdgcn_make_buffer_rsrc((void*)(H + (size_t)NTOK * DM), 0, 0x7fffffff, 0x00020000);
#pragma unroll
        for (int q = 0; q < 2; ++q) {
            const int row = r0 + 2 * F.wave + q;
            const f32x4* xr = (const f32x4*)(a.in[IN_CTX] + (size_t)row * DM) + 2 * F.lane;
            f32x4 v[2][2]; float sq = 0.f;
#pragma unroll
            for (int j = 0; j < 2; ++j) { v[j][0] = xr[128 * j]; v[j][1] = xr[128 * j + 1];
                sq += (v[j][0].x * v[j][0].x + v[j][0].y * v[j][0].y) + (v[j][0].z * v[j][0].z + v[j][0].w * v[j][0].w) + (v[j][1].x * v[j][1].x + v[j][1].y * v[j][1].y) + (v[j][1].z * v[j][1].z + v[j][1].w * v[j][1].w); }
            const float rstd = rsqrtf(wave_sum(sq) * (1.f / DM) + EPS);
#pragma unroll
            for (int j = 0; j < 2; ++j) { const int k = 8 * F.lane + 512 * j;
                const f32x4 ga = *(const LAS f32x4*)(gs + k), gb = *(const LAS f32x4*)(gs + k + 4), ha = *(const LAS f32x4*)(sh + k), hb = *(const LAS f32x4*)(sh + k + 4);
                u32x4 w; w.x = pk2(v[j][0].x * rstd * ga.x + ha.x, v[j][0].y * rstd * ga.y + ha.y); w.y = pk2(v[j][0].z * rstd * ga.z + ha.z, v[j][0].w * rstd * ga.w + ha.w);
                w.z = pk2(v[j][1].x * rstd * gb.x + hb.x, v[j][1].y * rstd * gb.y + hb.y); w.w = pk2(v[j][1].z * rstd * gb.z + hb.z, v[j][1].w * rstd * gb.w + hb.w);
                __builtin_amdgcn_raw_buffer_store_b128(w, rs, (unsigned)(((size_t)row * DM + k) * 2), 0, 16); }
        }
        asm volatile("s_waitcnt vmcnt(0)" ::: "memory");
        __syncthreads();
        unsigned* pcnt = F.ctl + CW_PANEL;
        if (F.tid == 0) __hip_atomic_fetch_add(pcnt + 8 * pmc, 1u, __ATOMIC_RELAXED, __HIP_MEMORY_SCOPE_AGENT);
        SchedCtx S{F.bid, (const char*)F.out, (const char*)(F.ws + WS_WIN), (char*)(F.ws + WS_PC), pcnt, F.ctl + 3};
        EpiStoreBf16 E;
        gm::gemm_phase<SchedCtx, EpiStoreBf16, false, true>(F.lds, DM, S, E);
    }
}

constexpr int LRU_T = 128, LRU_NCH = SEQ / LRU_T, UF_LD = 144;
constexpr int LRU_UBF = 0, LRU_UF = 144 * 256;
constexpr float LOG2E = 1.4426950408889634f;

struct LruCoef { float ba, bx, ca; };

struct LruConvW { float w[4][8], bs[8]; };
__device__ __forceinline__ void lru_conv_weights(Frame& F, const Args& a, int h, LruConvW& cwv) {
    const float* cw = a.in[IN_CONVW] + h * 128; const float* cb = a.in[IN_CONVB] + h * 128; const int cg = F.tid & 15;
#pragma unroll
    for (int k = 0; k < 4; ++k) { const f32x4 w0 = *(const f32x4*)(cw + k * DM + 8 * cg), w1 = *(const f32x4*)(cw + k * DM + 8 * cg + 4);
        cwv.w[k][0] = w0.x; cwv.w[k][1] = w0.y; cwv.w[k][2] = w0.z; cwv.w[k][3] = w0.w; cwv.w[k][4] = w1.x; cwv.w[k][5] = w1.y; cwv.w[k][6] = w1.z; cwv.w[k][7] = w1.w; }
    { const f32x4 b0 = *(const f32x4*)(cb + 8 * cg), b1 = *(const f32x4*)(cb + 8 * cg + 4); cwv.bs[0] = b0.x; cwv.bs[1] = b0.y; cwv.bs[2] = b0.z; cwv.bs[3] = b0.w; cwv.bs[4] = b1.x; cwv.bs[5] = b1.y; cwv.bs[6] = b1.z; cwv.bs[7] = b1.w; }
}
__device__ __forceinline__ void lru_conv_load(Frame& F, int b, int h, int c, u32x4 (&raw)[4][4]) {
    const bf16* AX = (const bf16*)(F.ws + WS_P) + (size_t)b * SEQ * DM + h * 128;
    int cg = F.tid & 15, tl0 = F.tid >> 4;
    asm volatile("" : "+v"(cg), "+v"(tl0));
#pragma unroll
    for (int i = 0; i < 4; ++i)
#pragma unroll
        for (int k = 0; k < 4; ++k) { int tt = c * LRU_T + tl0 + 32 * i + k - 2; tt = tt < 0 ? 0 : (tt > SEQ - 1 ? SEQ - 1 : tt); raw[i][k] = *(const u32x4*)(AX + (size_t)tt * DM + 8 * cg); }
}
__device__ __forceinline__ void lru_conv(Frame& F, const LruConvW& cwv, const u32x4 (&raw)[4][4], int b, int h, int c, bool special) {
    LAS unsigned char* ubf = F.lds + LRU_UBF; LAS float* uf = (LAS float*)(F.lds + LRU_UF);
    int cg = F.tid & 15, tl0 = F.tid >> 4;
    asm volatile("" : "+v"(cg), "+v"(tl0));
    const float (&w)[4][8] = cwv.w; const float (&bs)[8] = cwv.bs;
#pragma unroll
    for (int i = 0; i < 4; ++i) { const int tl = tl0 + 32 * i;
        float u[8];
#pragma unroll
        for (int q = 0; q < 8; ++q) u[q] = bs[q];
#pragma unroll
        for (int k = 0; k < 4; ++k) { const int tt = c * LRU_T + tl + k - 2; const float mk = (tt >= 0 && tt < SEQ) ? 1.f : 0.f; const u32x4 v = raw[i][k];
            u[0] += mk * w[k][0] * bflo(v.x); u[1] += mk * w[k][1] * bfhi(v.x); u[2] += mk * w[k][2] * bflo(v.y); u[3] += mk * w[k][3] * bfhi(v.y);
            u[4] += mk * w[k][4] * bflo(v.z); u[5] += mk * w[k][5] * bfhi(v.z); u[6] += mk * w[k][6] * bflo(v.w); u[7] += mk * w[k][7] * bfhi(v.w); }
        *(LAS f32x4*)(uf + tl * UF_LD + 8 * cg) = (f32x4){u[0], u[1], u[2], u[3]};
        *(LAS f32x4*)(uf + tl * UF_LD + 8 * cg + 4) = (f32x4){u[4], u[5], u[6], u[7]};
        u32x4 p; p.x = pk2(u[0], u[1]); p.y = pk2(u[2], u[3]); p.z = pk2(u[4], u[5]); p.w = pk2(u[6], u[7]);
        *(LAS u32x4*)(ubf + tl * 256 + ((cg ^ (tl & 15)) << 4)) = p; }
    if (special) {
        const bf16* AC = (const bf16*)(F.ws + WS_PC) + (size_t)b * CTX * DM + h * 128;
        if (F.tid < 32) { const int tl = LRU_T + (F.tid >> 4); const int t = tl == LRU_T ? 0 : CTX - 1;
            float u[8];
#pragma unroll
            for (int q = 0; q < 8; ++q) u[q] = bs[q];
#pragma unroll
            for (int k = 0; k < 4; ++k) { const int tt = t + k - 2;
                if (tt >= 0 && tt < CTX) { const u32x4 v = *(const u32x4*)(AC + (size_t)tt * DM + 8 * cg);
                    u[0] += w[k][0] * bflo(v.x); u[1] += w[k][1] * bfhi(v.x); u[2] += w[k][2] * bflo(v.y); u[3] += w[k][3] * bfhi(v.y);
                    u[4] += w[k][4] * bflo(v.z); u[5] += w[k][5] * bfhi(v.z); u[6] += w[k][6] * bflo(v.w); u[7] += w[k][7] * bfhi(v.w); } }
            *(LAS f32x4*)(uf + tl * UF_LD + 8 * cg) = (f32x4){u[0], u[1], u[2], u[3]};
            *(LAS f32x4*)(uf + tl * UF_LD + 8 * cg + 4) = (f32x4){u[4], u[5], u[6], u[7]};
            u32x4 p; p.x = pk2(u[0], u[1]); p.y = pk2(u[2], u[3]); p.z = pk2(u[4], u[5]); p.w = pk2(u[6], u[7]);
            *(LAS u32x4*)(ubf + tl * 256 + ((cg ^ (tl & 15)) << 4)) = p;
        } else if (F.tid < 32 + 14 * 16) { const int tl = LRU_T + 2 + ((F.tid - 32) >> 4);
            *(LAS u32x4*)(ubf + tl * 256 + ((cg ^ (tl & 15)) << 4)) = (u32x4){0u, 0u, 0u, 0u}; }
    }
}
__device__ __forceinline__ void lru_load_w(Frame& F, int d, int h, bf16x8 (&Bw)[2][4]) {
    const int fr = F.lane & 15, fq = F.lane >> 4;
#pragma unroll
    for (int which = 0; which < 2; ++which) { const bf16* W = (const bf16*)(F.ws + WS_WLRU) + (size_t)(which * 16 + d * 8 + h) * 128 * 128 + (size_t)(16 * F.wave + fr) * 128 + 8 * fq;
#pragma unroll
        for (int kk = 0; kk < 4; ++kk) Bw[which][kk] = *(const bf16x8*)(W + kk * 32); }
}
__device__ __forceinline__ LruCoef lru_coef(const Args& a, int d, int ch) {
    LruCoef k; k.ba = -LOG2E * a.in[IN_BA][d * DM + ch]; k.bx = -LOG2E * a.in[IN_BX][d * DM + ch];
    const float sp = log1pf(expf(-a.in[IN_LAM][d * DM + ch])); k.ca = -8.f * sp * LOG2E; return k;
}
template <int V = 0> __device__ __forceinline__ void lru_tile(Frame& F, int m, const bf16x8 (&Bw)[2][4], const LruCoef& k, float (&av)[4], float (&bv)[4]) {
    const int fr = F.lane & 15, fq = F.lane >> 4;
    const LAS unsigned char* ubf = F.lds + LRU_UBF; const LAS float* uf = (const LAS float*)(F.lds + LRU_UF);
    f32x4 ar = {0.f, 0.f, 0.f, 0.f}, ai = {0.f, 0.f, 0.f, 0.f};
    const int row = m * 16 + fr;
#pragma unroll
    for (int kk = 0; kk < 4; ++kk) { const bf16x8 A = *(const LAS bf16x8*)(ubf + row * 256 + (((kk * 4 + fq) ^ fr) << 4));
        ar = __builtin_amdgcn_mfma_f32_16x16x32_bf16(A, Bw[0][kk], ar, 0, 0, 0); ai = __builtin_amdgcn_mfma_f32_16x16x32_bf16(A, Bw[1][kk], ai, 0, 0, 0); }
#pragma unroll
    for (int r = 0; r < 4; ++r) { const float u = uf[(m * 16 + 4 * fq + r) * UF_LD + 16 * F.wave + fr];
        if (V == 2) { av[r] = __builtin_fmaf(ar[r], -LOG2E, k.ba) * k.ca; bv[r] = __builtin_fmaf(ai[r], -LOG2E, k.bx) * u; continue; }
        const float rg = __builtin_amdgcn_rcpf(1.f + __builtin_amdgcn_exp2f(__builtin_fmaf(ar[r], -LOG2E, k.ba)));
        const float ig = __builtin_amdgcn_rcpf(1.f + __builtin_amdgcn_exp2f(__builtin_fmaf(ai[r], -LOG2E, k.bx)));
        const float aa = __builtin_amdgcn_exp2f(k.ca * rg);
        av[r] = aa; bv[r] = __builtin_amdgcn_sqrtf(__builtin_fmaf(-aa, aa, 1.f)) * (ig * u); }
}
template <bool FWD, int V = 0> __device__ __forceinline__ void lru_tile_total(int fq, float& A, float& B) {
    if (V == 1) return;
#pragma unroll
    for (int s = 0; s < 2; ++s) { const int bit = 1 << s; const float Ap = __shfl_xor(A, 16 << s), Bp = __shfl_xor(B, 16 << s);
        const bool mine_first = FWD ? ((fq & bit) == 0) : ((fq & bit) != 0);
        if (mine_first) { B = B * Ap + Bp; A = A * Ap; } else { B = Bp * A + B; A = Ap * A; } }
}

template <int V = 0> __device__ __forceinline__ void lru_phase1(Frame& F, const Args& a, float* agg_base) {
    const int NU = NB * 8 * LRU_NCH;
    if (F.bid >= NU) return;
    const int fr = F.lane & 15, fq = F.lane >> 4;
    const int h = (F.bid >> 4) & 7; const int ch = h * 128 + 16 * F.wave + fr;
    const LruCoef k0 = lru_coef(a, 0, ch), k1 = lru_coef(a, 1, ch);
    for (int unit = F.bid; unit < NU; unit += F.G) {
        const int c = unit & (LRU_NCH - 1), b = unit >> 7;
        bf16x8 Bw0[2][4], Bw1[2][4]; lru_load_w(F, 0, h, Bw0); lru_load_w(F, 1, h, Bw1);
        { u32x4 raw[4][4]; lru_conv_load(F, b, h, c, raw); LruConvW cwv; lru_conv_weights(F, a, h, cwv); lru_conv(F, cwv, raw, b, h, c, c == 0 && V == 0); }
        LDS_WAIT(); __syncthreads();
        float Af = 1.f, Hf = 0.f, Ab = 1.f, Hb = 0.f;
#pragma unroll 2
        for (int m = 0; m < 8; ++m) {
            float av[4], bv[4];
            lru_tile<V>(F, m, Bw0, k0, av, bv);
            float A = av[0] * av[1] * av[2] * av[3], B = ((bv[0] * av[1] + bv[1]) * av[2] + bv[2]) * av[3] + bv[3];
            lru_tile_total<true, V>(fq, A, B);
            Hf = Hf * A + B; Af = Af * A;
            lru_tile<V>(F, m, Bw1, k1, av, bv);
            A = av[0] * av[1] * av[2] * av[3]; B = ((bv[3] * av[2] + bv[2]) * av[1] + bv[1]) * av[0] + bv[0];
            lru_tile_total<false, V>(fq, A, B);
            Hb = B * Ab + Hb; Ab = A * Ab;
        }
        float* agg = agg_base;
        if (fq == 0) { *(f32x2*)(agg + ((size_t)((b * LRU_NCH + c) * 2 + 0) * DM + ch) * 2) = (f32x2){Af, Hf};
                       *(f32x2*)(agg + ((size_t)((b * LRU_NCH + c) * 2 + 1) * DM + ch) * 2) = (f32x2){Ab, Hb}; }
        if (c == 0 && V == 0) {
            float av[4], bv[4]; float* s0 = (float*)(F.ws + WS_LRUS0);
            lru_tile(F, 8, Bw0, k0, av, bv); if (fq == 0) s0[(b * 2 + 0) * DM + ch] = bv[0];
            lru_tile(F, 8, Bw1, k1, av, bv); if (fq == 0) s0[(b * 2 + 1) * DM + ch] = bv[1];
        }
        __syncthreads();
    }
}

__device__ __forceinline__ void lru_pass2(Frame& F, const Args& a, int unit, const LruCoef& kf, const LruCoef& kb) {
    const int c = unit & (LRU_NCH - 1), h = (unit >> 4) & 7, b = unit >> 7;
    const int fr = F.lane & 15, fq = F.lane >> 4; const int ch = h * 128 + 16 * F.wave + fr;
    const float* agg = (const float*)(F.ws + WS_LRUAGG); const float* s0 = (const float*)(F.ws + WS_LRUS0);
    f32x2 ag[LRU_NCH];
#pragma unroll
    for (int j = 0; j < LRU_NCH; ++j) ag[j] = *(const f32x2*)(agg + ((size_t)((b * LRU_NCH + j) * 2 + (j < c ? 0 : 1)) * DM + ch) * 2);
    float hf = s0[(b * 2 + 0) * DM + ch], hb = s0[(b * 2 + 1) * DM + ch];
    bf16* AY = (bf16*)(F.ws + WS_YAG) + ((size_t)b * SEQ + c * LRU_T) * DM + h * 128;
    u32x4 ayv[4];
#pragma unroll
    for (int i = 0; i < 4; ++i) ayv[i] = *(const u32x4*)(AY + (size_t)((F.tid >> 4) + 32 * i) * DM + 8 * (F.tid & 15));
    bf16x8 Bw[2][4], Bw1[2][4]; lru_load_w(F, 0, h, Bw);
    LruCoef k = kf; const LruCoef k1 = kb;
    { u32x4 raw[4][4]; lru_conv_load(F, b, h, c, raw); LruConvW cwv; lru_conv_weights(F, a, h, cwv); lru_conv(F, cwv, raw, b, h, c, false); }
    lru_load_w(F, 1, h, Bw1);
#pragma unroll
    for (int j = 0; j < LRU_NCH; ++j) if (j < c) hf = ag[j].x * hf + ag[j].y;
#pragma unroll
    for (int j = LRU_NCH - 1; j >= 0; --j) if (j > c) hb = ag[j].x * hb + ag[j].y;
    LDS_WAIT(); __syncthreads();
    float hfv[8][4];
#pragma unroll
    for (int m = 0; m < 8; ++m) {
        float av[4], bv[4];
        lru_tile(F, m, Bw, k, av, bv);
        const float A = av[0] * av[1] * av[2] * av[3], B = ((bv[0] * av[1] + bv[1]) * av[2] + bv[2]) * av[3] + bv[3];
        float hin = hf;
#pragma unroll
        for (int g = 0; g < 4; ++g) { const float Ag = __shfl(A, g * 16 + fr), Bg = __shfl(B, g * 16 + fr); if (g < fq) hin = Ag * hin + Bg; hf = Ag * hf + Bg; }
#pragma unroll
        for (int r = 0; r < 4; ++r) { hin = av[r] * hin + bv[r]; hfv[m][r] = hin; }
    }
    k = k1;
    LAS float* uf = (LAS float*)(F.lds + LRU_UF);
#pragma unroll
    for (int m = 7; m >= 0; --m) {
        float av[4], bv[4];
        lru_tile(F, m, Bw1, k, av, bv);
        const float A = av[0] * av[1] * av[2] * av[3], B = ((bv[3] * av[2] + bv[2]) * av[1] + bv[1]) * av[0] + bv[0];
        float hin = hb;
#pragma unroll
        for (int g = 3; g >= 0; --g) { const float Ag = __shfl(A, g * 16 + fr), Bg = __shfl(B, g * 16 + fr); if (g > fq) hin = Ag * hin + Bg; hb = Ag * hb + Bg; }
#pragma unroll
        for (int r = 3; r >= 0; --r) { hin = av[r] * hin + bv[r]; uf[(m * 16 + 4 * fq + r) * UF_LD + 16 * F.wave + fr] = hfv[m][r] + hin; }
    }
    LDS_WAIT(); __syncthreads();
    const int cg = F.tid & 15;
#pragma unroll
    for (int i = 0; i < 4; ++i) { const int tl = (F.tid >> 4) + 32 * i;
        const f32x4 y0 = *(const LAS f32x4*)(uf + tl * UF_LD + 8 * cg), y1 = *(const LAS f32x4*)(uf + tl * UF_LD + 8 * cg + 4);
        const u32x4 g = ayv[i];
        u32x4 o; o.x = pk2(y0.x * gelu_tanh(bflo(g.x)), y0.y * gelu_tanh(bfhi(g.x))); o.y = pk2(y0.z * gelu_tanh(bflo(g.y)), y0.w * gelu_tanh(bfhi(g.y)));
        o.z = pk2(y1.x * gelu_tanh(bflo(g.z)), y1.y * gelu_tanh(bfhi(g.z))); o.w = pk2(y1.z * gelu_tanh(bflo(g.w)), y1.w * gelu_tanh(bfhi(g.w)));
        *(u32x4*)(AY + (size_t)tl * DM + 8 * cg) = o; }
    __syncthreads();
}
constexpr int HG_C = 64, HG_SEG = 512, HG_NSEG = 4;
constexpr int HG_QS = 0, HG_QM = 16384, HG_KM = 32768, HG_KDT = 49152, HG_VT = 65536, HG_ATT = 81920, HG_PART = 90112, HG_ETOT = 94208, HG_ROWS = 94720;
constexpr size_t HGS_IMG = 65536;
#ifdef PROBE_A
#define HSTAMP(i) do { if (F.bid == 0 && F.tid == 0) { const unsigned long long _t = __builtin_amdgcn_s_memrealtime(); const unsigned long long _p = ((unsigned long long)F.MISC[101] << 32) | F.MISC[100]; \
    unsigned long long _a = ((unsigned long long)F.MISC[103 + 2 * (i)] << 32) | F.MISC[102 + 2 * (i)]; _a += _t - _p; F.MISC[102 + 2 * (i)] = (unsigned)_a; F.MISC[103 + 2 * (i)] = (unsigned)(_a >> 32); F.MISC[100] = (unsigned)_t; F.MISC[101] = (unsigned)(_t >> 32); } } while (0)
#else
#define HSTAMP(i) do { } while (0)
#endif

__device__ __forceinline__ int hg_row(int b, int dir, bool ctx, int sigma) {
    if (ctx) { const int t = dir ? (CTX - 1 - sigma) : sigma; return b * CTX + t; }
    const int p = dir ? (SEQ - 1 - sigma) : sigma; return b * SEQ + (p & 31) * 64 + (p >> 5);
}

struct HgRaw { unsigned f[8], v[8], q[8]; };
template <bool FULL>
__device__ __forceinline__ void hg_load(Frame& F, const bf16* Qb, const bf16* Fb, const bf16* Vb, int b, int dir, bool ctx, int sigma0, HgRaw& r) {
    const long step = (long)(ctx ? 1 : 64) * (dir ? -1 : 1) * DM;
    const size_t ro = (size_t)hg_row(b, dir, ctx, sigma0 + 8 * F.wave) * DM + 2 * F.lane;
    const bf16* fp = Fb + ro; const bf16* vp = Vb + ro; const bf16* qp = Qb + ro;
#pragma unroll
    for (int j = 0; j < 8; ++j) { r.f[j] = *(const unsigned*)(fp + j * step); r.v[j] = *(const unsigned*)(vp + j * step); if (FULL) r.q[j] = *(const unsigned*)(qp + j * step); }
}
template <bool FULL>
__device__ __forceinline__ void hg_prep(Frame& F, const HgRaw& raw, int b, int dir, bool ctx, int sigma0, float lb0, float lb1, float& gs0, float& gs1) {
    const int kp = F.lane, to = F.wave;
    const unsigned (&fw)[8] = raw.f; const unsigned (&qw)[8] = raw.q; const unsigned (&vw)[8] = raw.v;
    float c0[8], c1[8], k0[8], k1[8];
    float a0 = 0.f, a1 = 0.f;
#pragma unroll
    for (int j = 0; j < 8; ++j) {
        const float g0 = lb0 + (1.f - lb0) * __builtin_amdgcn_rcpf(1.f + __builtin_amdgcn_exp2f(-bflo(fw[j]) * LOG2E));
        const float g1 = lb1 + (1.f - lb1) * __builtin_amdgcn_rcpf(1.f + __builtin_amdgcn_exp2f(-bfhi(fw[j]) * LOG2E));
        k0[j] = 1.f - g0; k1[j] = 1.f - g1;
        a0 += __builtin_amdgcn_logf(g0); a1 += __builtin_amdgcn_logf(g1);
        c0[j] = a0; c1[j] = a1; }
    LAS float* part = (LAS float*)(F.lds + HG_PART);
    *(LAS f32x2*)(part + to * 128 + 2 * kp) = (f32x2){a0, a1};
    if (FULL) HSTAMP(0);
    LDS_WAIT(); __syncthreads();
    if (FULL) HSTAMP(1);
    if (FULL && F.tid < HG_C) ((LAS int*)(F.lds + HG_ROWS))[F.tid] = hg_row(b, dir, ctx, sigma0 + F.tid);
    float off0 = 0.f, off1 = 0.f, tot0 = 0.f, tot1 = 0.f;
#pragma unroll
    for (int o = 0; o < 8; ++o) { const f32x2 p = *(const LAS f32x2*)(part + o * 128 + 2 * kp);
        if (o < to) { off0 += p.x; off1 += p.y; } tot0 += p.x; tot1 += p.y; }
    gs0 += tot0; gs1 += tot1;
    if (to == 0) *(LAS f32x2*)((LAS float*)(F.lds + HG_ETOT) + 2 * kp) = (f32x2){__builtin_amdgcn_exp2f(tot0), __builtin_amdgcn_exp2f(tot1)};
    float kd0[8], kd1[8];
#pragma unroll
    for (int j = 0; j < 8; ++j) {
        const float E0 = __builtin_amdgcn_exp2f(off0 + c0[j]), E1 = __builtin_amdgcn_exp2f(off1 + c1[j]);
        kd0[j] = k0[j] * __builtin_amdgcn_rcpf(E0); kd1[j] = k1[j] * __builtin_amdgcn_rcpf(E1);
        if (FULL) {
            const float q0 = bflo(qw[j]), q1 = bfhi(qw[j]);
            const float s0 = q0 * __builtin_amdgcn_rcpf(1.f + __builtin_amdgcn_exp2f(-q0 * LOG2E)) * E0, s1 = q1 * __builtin_amdgcn_rcpf(1.f + __builtin_amdgcn_exp2f(-q1 * LOG2E)) * E1;
            const int c = 8 * to + j; const int off = c * 256 + ((4 * kp) ^ ((c & 15) << 4));
            *(LAS unsigned*)(F.lds + HG_QS + off) = pk2(s0, s1);
            *(LAS unsigned*)(F.lds + HG_KM + off) = pk2(kd0[j], kd1[j]);
        }
    }
    { const int sw = ((to ^ (kp & 7)) << 4);
      u32x4 w0, w1; w0.x = pk2(kd0[0], kd0[1]); w0.y = pk2(kd0[2], kd0[3]); w0.z = pk2(kd0[4], kd0[5]); w0.w = pk2(kd0[6], kd0[7]);
      w1.x = pk2(kd1[0], kd1[1]); w1.y = pk2(kd1[2], kd1[3]); w1.z = pk2(kd1[4], kd1[5]); w1.w = pk2(kd1[6], kd1[7]);
      *(LAS u32x4*)(F.lds + HG_KDT + (2 * kp) * 128 + sw) = w0; *(LAS u32x4*)(F.lds + HG_KDT + (2 * kp + 1) * 128 + sw) = w1;
      u32x4 v0, v1;
      v0.x = (vw[0] & 0xffffu) | (vw[1] << 16); v0.y = (vw[2] & 0xffffu) | (vw[3] << 16); v0.z = (vw[4] & 0xffffu) | (vw[5] << 16); v0.w = (vw[6] & 0xffffu) | (vw[7] << 16);
      v1.x = (vw[0] >> 16) | (vw[1] & 0xffff0000u); v1.y = (vw[2] >> 16) | (vw[3] & 0xffff0000u); v1.z = (vw[4] >> 16) | (vw[5] & 0xffff0000u); v1.w = (vw[6] >> 16) | (vw[7] & 0xffff0000u);
      *(LAS u32x4*)(F.lds + HG_VT + (2 * kp) * 128 + sw) = v0; *(LAS u32x4*)(F.lds + HG_VT + (2 * kp + 1) * 128 + sw) = v1; }
    if (FULL) HSTAMP(2);
    LDS_WAIT(); __syncthreads();
    if (FULL) HSTAMP(3);
}
__device__ __forceinline__ void hg_state_update(Frame& F, f32x4 (&St)[8], const bf16x8 (&vt)[2]) {
    const int fr = F.lane & 15, fq = F.lane >> 4;
    const LAS float* etot = (const LAS float*)(F.lds + HG_ETOT);
#pragma unroll
    for (int kt = 0; kt < 8; ++kt) { const f32x4 e = *(const LAS f32x4*)(etot + 16 * kt + 4 * fq);
        const int rk = 16 * kt + fr;
#pragma unroll
        for (int ks = 0; ks < 2; ++ks) { const bf16x8 A = *(const LAS bf16x8*)(F.lds + HG_KDT + rk * 128 + (((4 * ks + fq) ^ ((rk >> 1) & 7)) << 4));
            St[kt] = __builtin_amdgcn_mfma_f32_16x16x32_bf16(A, vt[ks], St[kt], 0, 0, 0); }
        St[kt] = St[kt] * e; }
}
__device__ __forceinline__ void hg_load_vt(Frame& F, bf16x8 (&vt)[2]) {
    const int fr = F.lane & 15, fq = F.lane >> 4; const int rv = 16 * F.wave + fr;
#pragma unroll
    for (int ks = 0; ks < 2; ++ks) vt[ks] = *(const LAS bf16x8*)(F.lds + HG_VT + rv * 128 + (((4 * ks + fq) ^ ((rv >> 1) & 7)) << 4));
}
struct HgPtrs { const bf16* Q; const bf16* Fx; const bf16* V; const bf16* Fc; const bf16* Vc; bf16* O; };
__device__ __forceinline__ HgPtrs hg_ptrs(Frame& F, int h, int dir) {
    HgPtrs p; p.Q = (const bf16*)(F.ws + WS_P + 2 * GS) + h * 128; p.Fx = (const bf16*)(F.ws + WS_P + (dir ? 4 : 3) * GS) + h * 128; p.V = (const bf16*)(F.ws + WS_P + 5 * GS) + h * 128;
    p.Fc = (const bf16*)(F.ws + WS_PC + (dir ? 2 : 1) * CGS) + h * 128; p.Vc = (const bf16*)(F.ws + WS_PC + 3 * CGS) + h * 128; p.O = (bf16*)(F.ws + WS_P + (dir ? 4 : 3) * GS) + h * 128; return p;
}
__device__ __forceinline__ void hg_lb(const Args& a, int h, int kp, float& lb0, float& lb1) {
    const float* t = a.in[IN_HGLB] + h * 128 + 2 * kp; lb0 = 1.f / (1.f + expf(t[DM] - t[0])); lb1 = 1.f / (1.f + expf(t[DM + 1] - t[1]));
}
__device__ __forceinline__ float* hg_img(Frame& F, int b, int h, int dir, int slot) { return (float*)((unsigned char*)F.out + (size_t)((((b * 8 + h) * 2 + dir) * 4) + slot) * HGS_IMG); }

__device__ __forceinline__ void hg_pass1(Frame& F, const Args& a, int unit) {
    const int slot = unit & 3, dir = (unit >> 2) & 1, h = (unit >> 3) & 7, b = unit >> 6;
    const int fr = F.lane & 15, fq = F.lane >> 4;
    const HgPtrs P = hg_ptrs(F, h, dir);
    float lb0, lb1; hg_lb(a, h, F.lane, lb0, lb1);
    f32x4 St[8];
#pragma unroll
    for (int kt = 0; kt < 8; ++kt) St[kt] = (f32x4){0.f, 0.f, 0.f, 0.f};
    const bool ctx = slot == 0; const int nchunk = ctx ? CTX / HG_C : HG_SEG / HG_C; const int sig0 = ctx ? 0 : (slot - 1) * HG_SEG;
    float gs0 = 0.f, gs1 = 0.f;
    const bf16* Fsrc = ctx ? P.Fc : P.Fx; const bf16* Vsrc = ctx ? P.Vc : P.V;
    HgRaw cur; hg_load<false>(F, P.Q, Fsrc, Vsrc, b, dir, ctx, sig0, cur);
    for (int ck = 0; ck < nchunk; ++ck) {
        HgRaw nxt; { const int cn = ck + 1 < nchunk ? ck + 1 : ck; hg_load<false>(F, P.Q, Fsrc, Vsrc, b, dir, ctx, sig0 + cn * HG_C, nxt); }
        hg_prep<false>(F, cur, b, dir, ctx, sig0 + ck * HG_C, lb0, lb1, gs0, gs1);
        cur = nxt;
        bf16x8 vt[2]; hg_load_vt(F, vt);
        hg_state_update(F, St, vt);
    }
    float* img = hg_img(F, b, h, dir, slot) + (size_t)(16 * F.wave + fr) * 128 + 4 * fq;
#pragma unroll
    for (int kt = 0; kt < 8; ++kt) *(f32x4*)(img + 16 * kt) = St[kt];
    if (!ctx && F.wave == 0) { float* D = (float*)(F.ws + WS_HGD) + (size_t)((((b * 8 + h) * 2 + dir) * 3) + (slot - 1)) * 128 + 2 * F.lane;
        *(f32x2*)D = (f32x2){__builtin_amdgcn_exp2f(gs0), __builtin_amdgcn_exp2f(gs1)}; }
    __syncthreads();
}

constexpr int HG_HN = 95232;
__device__ __forceinline__ void hg_pass2(Frame& F, const Args& a, int unit) {
    const int seg = unit & 3, h = (unit >> 2) & 7, b = unit >> 5;
    const int fr = F.lane & 15, fq = F.lane >> 4, w = F.wave;
    float lb0, lb1; hg_lb(a, h, F.lane, lb0, lb1);
    const int lcol = h * 128 + 16 * w + 4 * fq;
#pragma unroll 1
    for (int dir = 0; dir < 2; ++dir) {
        const int sseg = dir == 0 ? seg : 3 - seg;
        const HgPtrs P = hg_ptrs(F, h, dir);
        f32x4 St[8];
        {
            const float* img = hg_img(F, b, h, dir, 0) + (size_t)(16 * w + fr) * 128 + 4 * fq;
#pragma unroll
            for (int kt = 0; kt < 8; ++kt) St[kt] = *(const f32x4*)(img + 16 * kt);
            for (int j = 0; j < sseg; ++j) {
                const float* im = hg_img(F, b, h, dir, 1 + j) + (size_t)(16 * w + fr) * 128 + 4 * fq;
                const float* D = (const float*)(F.ws + WS_HGD) + (size_t)((((b * 8 + h) * 2 + dir) * 3) + j) * 128 + 4 * fq;
#pragma unroll
                for (int kt = 0; kt < 8; ++kt) { const f32x4 d = *(const f32x4*)(D + 16 * kt), dl = *(const f32x4*)(im + 16 * kt); St[kt] = St[kt] * d + dl; }
            }
        }
        float gs0 = 0.f, gs1 = 0.f;
        for (int ck = 0; ck < HG_SEG / HG_C; ++ck) {
            { HgRaw cur; hg_load<true>(F, P.Q, P.Fx, P.V, b, dir, false, sseg * HG_SEG + ck * HG_C, cur);
              hg_prep<true>(F, cur, b, dir, false, sseg * HG_SEG + ck * HG_C, lb0, lb1, gs0, gs1); }
            const LAS int* rows = (const LAS int*)(F.lds + HG_ROWS);
            bf16* OFW = (bf16*)(F.ws + WS_OF) + lcol; asm volatile("" : "+v"(OFW));
            u32x2 ofw[4], ogv[4];
            if (dir == 1) {
                const bf16* OG = (const bf16*)(F.ws + WS_P + 6 * GS) + lcol; asm volatile("" : "+v"(OG));
#pragma unroll
                for (int ct = 0; ct < 4; ++ct) { const size_t ro = (size_t)rows[16 * ct + fr] * DM; ofw[ct] = *(const u32x2*)(OFW + ro); ogv[ct] = *(const u32x2*)(OG + ro); } }
#pragma unroll
            for (int tt = 0; tt < 2; ++tt) { const int t = w + 8 * tt, ct = t >> 2, st = t & 3;
                f32x4 acc = {0.f, 0.f, 0.f, 0.f};
                const int rs = 16 * st + fr, rc = 16 * ct + fr;
#pragma unroll
                for (int kk = 0; kk < 4; ++kk) { const bf16x8 A = *(const LAS bf16x8*)(F.lds + HG_KM + rs * 256 + (((4 * kk + fq) ^ fr) << 4));
                    const bf16x8 B = *(const LAS bf16x8*)(F.lds + HG_QS + rc * 256 + (((4 * kk + fq) ^ fr) << 4));
                    acc = __builtin_amdgcn_mfma_f32_16x16x32_bf16(A, B, acc, 0, 0, 0); }
                const int s0 = 16 * st + 4 * fq;
                const float m0 = (s0 + 0 <= rc) ? acc[0] : 0.f, m1 = (s0 + 1 <= rc) ? acc[1] : 0.f, m2 = (s0 + 2 <= rc) ? acc[2] : 0.f, m3 = (s0 + 3 <= rc) ? acc[3] : 0.f;
                *(LAS u32x2*)(F.lds + HG_ATT + rc * 128 + (((2 * st + (fq >> 1)) ^ ((rc >> 1) & 7)) << 4) + (fq & 1) * 8) = (u32x2){pk2(m0, m1), pk2(m2, m3)}; }
            f32x4 o[4];
#pragma unroll
            for (int ct = 0; ct < 4; ++ct) o[ct] = (f32x4){0.f, 0.f, 0.f, 0.f};
#pragma unroll
            for (int kk = 0; kk < 4; ++kk) {
                union { bf16x8 v; unsigned u[4]; } A;
                A.u[0] = pk2(St[2 * kk][0], St[2 * kk][1]); A.u[1] = pk2(St[2 * kk][2], St[2 * kk][3]); A.u[2] = pk2(St[2 * kk + 1][0], St[2 * kk + 1][1]); A.u[3] = pk2(St[2 * kk + 1][2], St[2 * kk + 1][3]);
#pragma unroll
                for (int ct = 0; ct < 4; ++ct) { const int rc = 16 * ct + fr;
                    union { bf16x8 v; u32x2 h[2]; } B;
                    B.h[0] = *(const LAS u32x2*)(F.lds + HG_QS + rc * 256 + (((4 * kk + (fq >> 1)) ^ fr) << 4) + (fq & 1) * 8);
                    B.h[1] = *(const LAS u32x2*)(F.lds + HG_QS + rc * 256 + (((4 * kk + 2 + (fq >> 1)) ^ fr) << 4) + (fq & 1) * 8);
                    o[ct] = __builtin_amdgcn_mfma_f32_16x16x32_bf16(A.v, B.v, o[ct], 0, 0, 0); } }
            bf16x8 vt[2]; hg_load_vt(F, vt);
            LDS_WAIT(); __syncthreads();
#pragma unroll
            for (int ks = 0; ks < 2; ++ks)
#pragma unroll
                for (int ct = 0; ct < 4; ++ct) { const int rc = 16 * ct + fr;
                    const bf16x8 B = *(const LAS bf16x8*)(F.lds + HG_ATT + rc * 128 + (((4 * ks + fq) ^ ((rc >> 1) & 7)) << 4));
                    o[ct] = __builtin_amdgcn_mfma_f32_16x16x32_bf16(vt[ks], B, o[ct], 0, 0, 0); }
            if (dir == 0) {
#pragma unroll
                for (int ct = 0; ct < 4; ++ct) *(u32x2*)(OFW + (size_t)rows[16 * ct + fr] * DM) = (u32x2){pk2(o[ct][0], o[ct][1]), pk2(o[ct][2], o[ct][3])};
                hg_state_update(F, St, vt);
            } else {
                LAS float* hn = (LAS float*)(F.lds + HG_HN);
                const f32x4 hn4 = *(const f32x4*)(a.in[IN_HGN] + h * 128 + 16 * w + 4 * fq);
#pragma unroll
                for (int ct = 0; ct < 4; ++ct) { o[ct][0] += bflo(ofw[ct].x); o[ct][1] += bfhi(ofw[ct].x); o[ct][2] += bflo(ofw[ct].y); o[ct][3] += bfhi(ofw[ct].y);
                    float ss = (o[ct][0] * o[ct][0] + o[ct][1] * o[ct][1]) + (o[ct][2] * o[ct][2] + o[ct][3] * o[ct][3]);
                    ss += __shfl_xor(ss, 16); ss += __shfl_xor(ss, 32);
                    if (fq == 0) hn[(16 * ct + fr) * 8 + w] = ss; }
                hg_state_update(F, St, vt);
                LDS_WAIT(); __syncthreads();
#pragma unroll
                for (int ct = 0; ct < 4; ++ct) { const f32x4 p0 = *(const LAS f32x4*)(hn + (16 * ct + fr) * 8), p1 = *(const LAS f32x4*)(hn + (16 * ct + fr) * 8 + 4);
                    const float rsn = rsqrtf(((p0.x + p0.y) + (p0.z + p0.w) + (p1.x + p1.y) + (p1.z + p1.w)) * (1.f / 128.f) + EPS);
                    const float g0 = bflo(ogv[ct].x), g1 = bfhi(ogv[ct].x), g2 = bflo(ogv[ct].y), g3 = bfhi(ogv[ct].y);
                    const float y0 = o[ct][0] * rsn * hn4.x * siluf_(g0), y1 = o[ct][1] * rsn * hn4.y * siluf_(g1), y2 = o[ct][2] * rsn * hn4.z * siluf_(g2), y3 = o[ct][3] * rsn * hn4.w * siluf_(g3);
                    *(u32x2*)(OFW + (size_t)rows[16 * ct + fr] * DM) = (u32x2){pk2(y0, y1), pk2(y2, y3)}; }
            }
        }
        VM_WAIT(); __syncthreads();
    }
}
__device__ __forceinline__ void p_ybg(Frame& F, const Args& a) {
    const bf16* OFp = (const bf16*)(F.ws + WS_OF); const bf16* OBp = (const bf16*)(F.ws + WS_OB); const bf16* OG = (const bf16*)(F.ws + WS_P + 6 * GS);
    bf16* YBG = (bf16*)(F.ws + WS_YBG); const float* hgn = a.in[IN_HGN];
    const int gw = F.bid * NWAVES + F.wave, NGW = F.G * NWAVES;
    for (int row = gw; row < NTOK; row += 2 * NGW) {
        u32x4 fv[2][2], bv[2][2], gvv[2][2];
#pragma unroll
        for (int rr = 0; rr < 2; ++rr)
#pragma unroll
            for (int j = 0; j < 2; ++j) { const size_t o = (size_t)(row + rr * NGW) * DM + 8 * F.lane + 512 * j;
                fv[rr][j] = *(const u32x4*)(OFp + o); bv[rr][j] = *(const u32x4*)(OBp + o); gvv[rr][j] = *(const u32x4*)(OG + o); }
#pragma unroll
        for (int rr = 0; rr < 2; ++rr)
#pragma unroll
        for (int j = 0; j < 2; ++j) { const int k = 8 * F.lane + 512 * j; const size_t o = (size_t)(row + rr * NGW) * DM + k;
            const u32x4 f = fv[rr][j], b = bv[rr][j], g = gvv[rr][j];
            float v[8]; v[0] = bflo(f.x) + bflo(b.x); v[1] = bfhi(f.x) + bfhi(b.x); v[2] = bflo(f.y) + bflo(b.y); v[3] = bfhi(f.y) + bfhi(b.y);
            v[4] = bflo(f.z) + bflo(b.z); v[5] = bfhi(f.z) + bfhi(b.z); v[6] = bflo(f.w) + bflo(b.w); v[7] = bfhi(f.w) + bfhi(b.w);
            float ss = 0.f;
#pragma unroll
            for (int q = 0; q < 8; ++q) ss += v[q] * v[q];
            ss += __shfl_xor(ss, 1); ss += __shfl_xor(ss, 2); ss += __shfl_xor(ss, 4); ss += __shfl_xor(ss, 8);
            const float rs = rsqrtf(ss * (1.f / 128.f) + EPS);
            float gv[8]; gv[0] = bflo(g.x); gv[1] = bfhi(g.x); gv[2] = bflo(g.y); gv[3] = bfhi(g.y); gv[4] = bflo(g.z); gv[5] = bfhi(g.z); gv[6] = bflo(g.w); gv[7] = bfhi(g.w);
            const f32x4 h0 = *(const f32x4*)(hgn + k), h1 = *(const f32x4*)(hgn + k + 4);
            const float hv[8] = {h0.x, h0.y, h0.z, h0.w, h1.x, h1.y, h1.z, h1.w};
            float r[8];
#pragma unroll
            for (int q = 0; q < 8; ++q) r[q] = v[q] * rs * hv[q] * siluf_(gv[q]);
            u32x4 w; w.x = pk2(r[0], r[1]); w.y = pk2(r[2], r[3]); w.z = pk2(r[4], r[5]); w.w = pk2(r[6], r[7]);
            *(u32x4*)(YBG + o) = w; }
    }
}
__device__ __forceinline__ void p_moe_weights13(Frame& F, const Args& a) {
    LAS float* scr = (LAS float*)(F.lds + F.wave * TR_BYTES);
    const int gw = F.bid * NWAVES + F.wave, NGW = F.G * NWAVES;
    for (int it = gw; it < NEXP * 256; it += NGW) {
        const int e = it >> 8, r = it & 255, w = r >> 7, q = r & 127, kb = q >> 3, nb = q & 7;
        transpose_item(a.in[w == 0 ? IN_W1 : IN_W3] + (size_t)e * DM * DEXP, DEXP, DM, (bf16*)(F.ws + (w == 0 ? WS_W1T : WS_W3T)) + ((size_t)e * DEXP + nb * 64) * DM, kb * 64, nb * 64, scr, F.lane);
    }
}
__device__ __forceinline__ void p_moe_weights2(Frame& F, const Args& a, int rank, int nwg) {
    LAS float* scr = (LAS float*)(F.lds + F.wave * TR_BYTES);
    for (int it = rank * NWAVES + F.wave; it < NEXP * 128; it += nwg * NWAVES) {
        const int e = it >> 7, q = it & 127, kb = q >> 4, nb = q & 15;
        transpose_item(a.in[IN_W2] + (size_t)e * DEXP * DM, DM, DEXP, (bf16*)(F.ws + WS_W2T) + ((size_t)e * DM + nb * 64) * DEXP, kb * 64, nb * 64, scr, F.lane);
    }
}

struct SchedP5 {
    int c; const char* YAG; const char* YBG; const char* WA; const char* WB; char* stash; char* M;
    __device__ __forceinline__ bool next(int i, gm::Unit& u) const {
        if (i >= 2) return false;
        int pm, pn; tile_order(c, 64, 4, pm, pn);
        u.A = (i == 0 ? YAG : YBG) + (size_t)pm * 256 * 2048; u.B0 = (i == 0 ? WA : WB) + (size_t)pn * 256 * 2048; u.B1 = u.B0 + (size_t)128 * 2048;
        u.dst = M + ((size_t)pm * 256 * DM + pn * 256) * 2; u.pm = pm; u.pn = pn; u.e = i; u.rows = 256; return true;
    }
    __device__ __forceinline__ unsigned arow(const gm::Unit&, int r) const { return (unsigned)r; }
};
struct EpiP5 {
    static constexpr bool PERM = true;
    unsigned* stash; const bf16* GA; const bf16* GB;
    __device__ __forceinline__ void operator()(const f32x4 (&acc)[2][2][4][2], const gm::Unit& u, int wr, int wc, int fr, int fq) const {
        const bf16* G = (u.e == 0 ? GA : GB) + ((size_t)u.pm * 256 + wr * 64 + fr) * DM + u.pn * 256 + wc * 32 + 8 * fq;
        bf16* Mb = (bf16*)u.dst + (size_t)(wr * 64 + fr) * DM + wc * 32 + 8 * fq;
        u32x4* st = (u32x4*)stash + threadIdx.x;
        asm volatile("" : "+v"(G), "+v"(Mb), "+v"(st));
#pragma unroll
        for (int ai = 0; ai < 2; ++ai)
#pragma unroll
            for (int m = 0; m < 4; ++m) {
                u32x4 g[2], s[2];
#pragma unroll
                for (int bj = 0; bj < 2; ++bj) { const size_t ro = (size_t)(ai * 128 + m * 16) * DM + bj * 128; const int si = (ai * 4 + m) * 2 + bj;
                    g[bj] = *(const u32x4*)(G + ro);
                    if (u.e != 0) s[bj] = st[(size_t)si * NTHR]; }
#pragma unroll
                for (int bj = 0; bj < 2; ++bj) { const size_t ro = (size_t)(ai * 128 + m * 16) * DM + bj * 128; const int si = (ai * 4 + m) * 2 + bj;
                    f32x4 v0 = acc[ai][bj][m][0], v1 = acc[ai][bj][m][1];
                    v0[0] *= sigmoidf_(bflo(g[bj].x)); v0[1] *= sigmoidf_(bfhi(g[bj].x)); v0[2] *= sigmoidf_(bflo(g[bj].y)); v0[3] *= sigmoidf_(bfhi(g[bj].y));
                    v1[0] *= sigmoidf_(bflo(g[bj].z)); v1[1] *= sigmoidf_(bfhi(g[bj].z)); v1[2] *= sigmoidf_(bflo(g[bj].w)); v1[3] *= sigmoidf_(bfhi(g[bj].w));
                    if (u.e != 0) { v0[0] += bflo(s[bj].x); v0[1] += bfhi(s[bj].x); v0[2] += bflo(s[bj].y); v0[3] += bfhi(s[bj].y);
                                    v1[0] += bflo(s[bj].z); v1[1] += bfhi(s[bj].z); v1[2] += bflo(s[bj].w); v1[3] += bfhi(s[bj].w); }
                    u32x4 w; w.x = gm::cvt_pk_bf16(v0[0], v0[1]); w.y = gm::cvt_pk_bf16(v0[2], v0[3]); w.z = gm::cvt_pk_bf16(v1[0], v1[1]); w.w = gm::cvt_pk_bf16(v1[2], v1[3]);
                    if (u.e == 0) st[(size_t)si * NTHR] = w; else *(u32x4*)(Mb + ro) = w; }
                asm volatile("" ::: "memory"); }
    }
};

struct SchedP6 {
    int c; const char* M; const char* W; char* X1;
    __device__ __forceinline__ bool next(int i, gm::Unit& u) const {
        if (i >= 1) return false;
        int pm, pn; tile_order(c, 64, 4, pm, pn);
        u.A = M + (size_t)pm * 256 * 2048; u.B0 = W + (size_t)pn * 256 * 2048; u.B1 = u.B0 + (size_t)128 * 2048;
        u.dst = X1 + ((size_t)pm * 256 * DM + pn * 256) * 4; u.pm = pm; u.pn = pn; u.e = 0; u.rows = 256; return true;
    }
    __device__ __forceinline__ unsigned arow(const gm::Unit&, int r) const { return (unsigned)r; }
};
struct EpiP6 {
    static constexpr bool PERM = false;
    const float* x; const float* mod;
    __device__ __forceinline__ void operator()(const f32x4 (&acc)[2][2][4][2], const gm::Unit& u, int wr, int wc, int fr, int fq) const {
        const int b = u.pm >> 3; const int col0 = u.pn * 256 + wc * 32 + 4 * fq;
        const float* mg = mod + b * 6144 + 2 * DM + col0;
        f32x4 gv[2][2];
#pragma unroll
        for (int bj = 0; bj < 2; ++bj)
#pragma unroll
            for (int n = 0; n < 2; ++n) gv[bj][n] = *(const f32x4*)(mg + bj * 128 + n * 16);
#pragma unroll
        for (int ai = 0; ai < 2; ++ai)
#pragma unroll
            for (int m = 0; m < 4; ++m) { const size_t ro = (size_t)(wr * 64 + fr + ai * 128 + m * 16) * DM + wc * 32 + 4 * fq;
                const float* xr = x + ((size_t)u.pm * 256 * DM + u.pn * 256) + ro; float* orow = (float*)u.dst + ro;
#pragma unroll
                for (int bj = 0; bj < 2; ++bj)
#pragma unroll
                    for (int n = 0; n < 2; ++n) { const f32x4 xv = *(const f32x4*)(xr + bj * 128 + n * 16);
                        *(f32x4*)(orow + bj * 128 + n * 16) = xv + gv[bj][n] * acc[ai][bj][m][n]; } }
    }
};

__device__ __forceinline__ void p_norm2_route(Frame& F, const Args& a) {
    const float* mod = (const float*)(F.ws + WS_MOD); const float* g2 = a.in[IN_G2]; const float* wrp = (const float*)(F.ws + WS_WRT);
    const float* X1 = F.out; bf16* HX2 = (bf16*)(F.ws + WS_HX2);
    int* list = (int*)(F.ws + WS_LIST); float* wt = (float*)(F.ws + WS_WT); unsigned* cnt = F.ctl + CW_CNT;
    LAS float* gs = (LAS float*)F.lds; LAS float* sh = gs + DM; LAS float* rst = sh + DM; LAS float* lgs = rst + 64;
    const int b = F.bid / 32;
    for (int k = F.tid; k < DM; k += NTHR) { gs[k] = g2[k] * (1.f + mod[b * 6144 + 4 * DM + k]); sh[k] = mod[b * 6144 + 3 * DM + k]; }
    __syncthreads();
    for (int r = F.wave; r < 64; r += NWAVES) {
        const int tok = F.bid * 64 + r;
        const f32x4* xr = (const f32x4*)(X1 + (size_t)tok * DM) + F.lane;
        f32x4 v[4]; float s = 0.f;
#pragma unroll
        for (int j = 0; j < 4; ++j) { v[j] = xr[64 * j]; s += (v[j].x * v[j].x + v[j].y * v[j].y) + (v[j].z * v[j].z + v[j].w * v[j].w); }
        const float rstd = rsqrtf(wave_sum(s) * (1.f / DM) + EPS);
        if (F.lane == 0) rst[r] = rstd;
        unsigned long long* o8 = (unsigned long long*)(HX2 + (size_t)tok * DM) + F.lane;
#pragma unroll
        for (int j = 0; j < 4; ++j) { const int k = 4 * F.lane + 256 * j;
            const f32x4 g = *(const LAS f32x4*)(gs + k), h = *(const LAS f32x4*)(sh + k);
            o8[64 * j] = (unsigned long long)pk2(v[j].x * rstd * g.x + h.x, v[j].y * rstd * g.y + h.y) | ((unsigned long long)pk2(v[j].z * rstd * g.z + h.z, v[j].w * rstd * g.w + h.w) << 32); }
    }
    LDS_WAIT(); __syncthreads();
    {
        const int tq = F.lane & 15, kq = F.lane >> 4, wg = F.wave & 3, kh = F.wave >> 2; const int tl = wg * 16 + tq;
        const float rs = rst[tl];
        const float* xr = X1 + (size_t)(F.bid * 64 + tl) * DM + 4 * kq + 512 * kh;
        const f32x4* wp = (const f32x4*)wrp + F.lane + (size_t)kh * 32 * 3 * 64;
        const LAS float* gsp = gs + 512 * kh + 4 * kq; const LAS float* shp = sh + 512 * kh + 4 * kq;
        f32x4 acc[3];
#pragma unroll
        for (int c = 0; c < 3; ++c) acc[c] = (f32x4){0.f, 0.f, 0.f, 0.f};
#pragma unroll 8
        for (int s = 0; s < 32; ++s) {
            const f32x4 x = *(const f32x4*)(xr + 16 * s); const f32x4 g = *(const LAS f32x4*)(gsp + 16 * s), h = *(const LAS f32x4*)(shp + 16 * s);
            const f32x4 hv = x * rs * g + h;
#pragma unroll
            for (int c = 0; c < 3; ++c) { const f32x4 w = wp[(s * 3 + c) * 64];
                acc[c] = __builtin_amdgcn_mfma_f32_16x16x4f32(hv[0], w[0], acc[c], 0, 0, 0); acc[c] = __builtin_amdgcn_mfma_f32_16x16x4f32(hv[1], w[1], acc[c], 0, 0, 0);
                acc[c] = __builtin_amdgcn_mfma_f32_16x16x4f32(hv[2], w[2], acc[c], 0, 0, 0); acc[c] = __builtin_amdgcn_mfma_f32_16x16x4f32(hv[3], w[3], acc[c], 0, 0, 0); }
        }
#pragma unroll
        for (int c = 0; c < 3; ++c)
#pragma unroll
            for (int r = 0; r < 4; ++r) lgs[kh * 64 * 48 + (wg * 16 + 4 * kq + r) * 48 + 16 * c + tq] = acc[c][r];
    }
    LDS_WAIT(); __syncthreads();
    LAS unsigned* lcnt = (LAS unsigned*)(lgs + 2 * 64 * 48); LAS unsigned* lbase = lcnt + 32;
    if (F.tid < 32) lcnt[F.tid] = 0u;
    LDS_WAIT(); __syncthreads();
    int ea = 0, eb = 0; unsigned ra = 0u, rb = 0u; int tok = 0; float w1 = 0.f, w2 = 0.f;
    const bool picker = F.wave < 4 && F.lane < 16;
    if (picker) {
        const LAS float* lp = lgs + (F.wave * 16 + F.lane) * 48; tok = F.bid * 64 + F.wave * 16 + F.lane;
        float lg[36];
#pragma unroll
        for (int q = 0; q < 9; ++q) { const f32x4 t4 = *(const LAS f32x4*)(lp + 4 * q) + *(const LAS f32x4*)(lp + 64 * 48 + 4 * q) + *(const f32x4*)(wrp + 49152 + 4 * q);
            lg[4 * q] = t4.x; lg[4 * q + 1] = t4.y; lg[4 * q + 2] = t4.z; lg[4 * q + 3] = t4.w; }
        float mx = lg[0]; int gi = 0;
#pragma unroll
        for (int g = 1; g < 4; ++g) if (lg[g] > mx) { mx = lg[g]; gi = g; }
        float z = 0.f;
#pragma unroll
        for (int g = 0; g < 4; ++g) z += __expf(lg[g] - mx);
        const float pg = 1.f / z;
        float el[8];
#pragma unroll
        for (int e = 0; e < 8; ++e) el[e] = gi == 0 ? lg[4 + e] : (gi == 1 ? lg[12 + e] : (gi == 2 ? lg[20 + e] : lg[28 + e]));
        int e1 = 0; float m1 = el[0];
#pragma unroll
        for (int e = 1; e < 8; ++e) if (el[e] > m1) { m1 = el[e]; e1 = e; }
        int e2 = 0; float m2 = -3.0e38f;
#pragma unroll
        for (int e = 0; e < 8; ++e) if (e != e1 && el[e] > m2) { m2 = el[e]; e2 = e; }
        const float rr = __expf(m2 - m1); w1 = pg / (1.f + rr); w2 = pg * rr / (1.f + rr);
        ea = gi * 8 + e1; eb = gi * 8 + e2;
        ra = __hip_atomic_fetch_add(lcnt + ea, 1u, __ATOMIC_RELAXED, __HIP_MEMORY_SCOPE_WORKGROUP);
        rb = __hip_atomic_fetch_add(lcnt + eb, 1u, __ATOMIC_RELAXED, __HIP_MEMORY_SCOPE_WORKGROUP);
    }
    LDS_WAIT(); __syncthreads();
    if (F.tid < 32) { const unsigned n = lcnt[F.tid]; lbase[F.tid] = n ? __hip_atomic_fetch_add(cnt + 64 * F.tid, n, __ATOMIC_RELAXED, __HIP_MEMORY_SCOPE_AGENT) : 0u; }
    LDS_WAIT(); __syncthreads();
    if (picker) {
        list[(size_t)ea * CAP + lbase[ea] + ra] = tok * 2; wt[tok * 2] = w1;
        list[(size_t)eb * CAP + lbase[eb] + rb] = tok * 2 + 1; wt[tok * 2 + 1] = w2;
    }
}

__device__ __forceinline__ void moe_table(Frame& F, const int* cntv) {
    if (F.wave == 0) { const int lane = F.lane; const int cnt = lane < NEXP ? cntv[64 * lane] : 0;
        const int t = (cnt + 255) >> 8; int ti = t, oi = cnt;
#pragma unroll
        for (int d = 1; d < 32; d <<= 1) { const int tu = __shfl_up(ti, d), ou = __shfl_up(oi, d); if ((lane & 31) >= d) { ti += tu; oi += ou; } }
        if (lane < NEXP) { F.MISC[128 + lane] = (unsigned)cnt; F.MISC[160 + lane] = (unsigned)(ti - t); F.MISC[192 + lane] = (unsigned)(oi - cnt); }
        if (lane == NEXP - 1) F.MISC[224] = (unsigned)ti; }
    LDS_WAIT(); __syncthreads();
}
__device__ __forceinline__ bool moe_find(volatile LAS unsigned* MISC, int lane, int T, int& e, int& rt, int& rows, int& off) {
    if (T >= (int)MISC[224]) return false;
    const int l = lane & 31; const int cnt = (int)MISC[128 + l], tpre = (int)MISC[160 + l];
    const unsigned long long mask = __ballot(lane < NEXP && cnt > 0 && T >= tpre);
    e = __builtin_amdgcn_readfirstlane(63 - __builtin_clzll(mask));
    rt = T - (int)MISC[160 + e]; const int c = (int)MISC[128 + e]; off = (int)MISC[192 + e];
    rows = c - rt * 256; if (rows > 256) rows = 256; return true;
}
struct SchedMoe1 {
    int G, c, lane; volatile LAS unsigned* MISC; const int* list; const char* HX2; const char* W1T; const char* W3T; char* HH; unsigned* tile_cnt;
    __device__ __forceinline__ bool next(int i, gm::Unit& u) const {
        const int vc = (c & 7) * (G >> 3) + (c >> 3);
        const int L = i * G + vc; int e, rt, rows, off; if (!moe_find(MISC, lane, L >> 2, e, rt, rows, off)) return false;
        const int pn = L & 3;
        e = __builtin_amdgcn_readfirstlane(e); rt = __builtin_amdgcn_readfirstlane(rt); rows = __builtin_amdgcn_readfirstlane(rows); off = __builtin_amdgcn_readfirstlane(off);
        u.A = HX2; u.B0 = W1T + ((size_t)e * DEXP + pn * 128) * 2048; u.B1 = W3T + ((size_t)e * DEXP + pn * 128) * 2048;
        u.dst = HH + ((size_t)(off + rt * 256) * DEXP + pn * 128) * 2; u.pm = rt; u.pn = pn; u.e = e; u.rows = rows; u.t = L >> 2; return true;
    }
    __device__ __forceinline__ unsigned arow(const gm::Unit& u, int r) const { const int rr = r < u.rows ? r : u.rows - 1; return (unsigned)(list[(size_t)u.e * CAP + u.pm * 256 + rr] >> 1); }
    __device__ __forceinline__ void a_ready(const gm::Unit&) const {}
    __device__ __forceinline__ void done(const gm::Unit& u) const {
        asm volatile("s_waitcnt vmcnt(0)" ::: "memory");
        __builtin_amdgcn_s_barrier(); asm volatile("" ::: "memory");
        if (threadIdx.x == 0) __hip_atomic_fetch_add(tile_cnt + 8 * u.t, 1u, __ATOMIC_RELAXED, __HIP_MEMORY_SCOPE_AGENT);
    }
};
struct EpiMoe1 {
    static constexpr bool PERM = true;
    char* HH;
    __device__ __forceinline__ void operator()(const f32x4 (&acc)[2][2][4][2], const gm::Unit& u, int wr, int wc, int fr, int fq) const {
        const __amdgpu_buffer_rsrc_t rs = __builtin_amdgcn_make_buffer_rsrc((void*)HH, 0, 0x7fffffff, 0x00020000);
        const unsigned base = (unsigned)(u.dst - HH) + (unsigned)(((wr * 64 + fr) * DEXP + wc * 32 + 8 * fq) * 2);
#pragma unroll
        for (int ai = 0; ai < 2; ++ai)
#pragma unroll
            for (int m = 0; m < 4; ++m) { const int r = ai * 128 + wr * 64 + m * 16 + fr; if (r >= u.rows) continue;
                const f32x4 u0 = acc[ai][0][m][0], u1 = acc[ai][0][m][1], v0 = acc[ai][1][m][0], v1 = acc[ai][1][m][1];
                u32x4 w; w.x = gm::cvt_pk_bf16(siluf_(u0[0]) * v0[0], siluf_(u0[1]) * v0[1]); w.y = gm::cvt_pk_bf16(siluf_(u0[2]) * v0[2], siluf_(u0[3]) * v0[3]);
                w.z = gm::cvt_pk_bf16(siluf_(u1[0]) * v1[0], siluf_(u1[1]) * v1[1]); w.w = gm::cvt_pk_bf16(siluf_(u1[2]) * v1[2], siluf_(u1[3]) * v1[3]);
                __builtin_amdgcn_raw_buffer_store_b128(w, rs, base + (unsigned)((ai * 128 + m * 16) * DEXP * 2), 0, 16); }
    }
};
struct SchedMoe2 {
    int G, c, lane; volatile LAS unsigned* MISC; const char* HH; const char* W2T; char* Y; unsigned* tile_cnt; unsigned* tmo;
    __device__ __forceinline__ bool next(int i, gm::Unit& u) const {
        const int vc = (c & 7) * (G >> 3) + (c >> 3);
        const int U = 4 * (int)MISC[224], q = U / G, r = U % G;
        const bool rebal = q >= 1 && r > 0 && 3 * r <= G;
        int L = i * G + (G - 1 - vc);
        if (rebal) {
            if (vc < r) { if (i >= q - 1) return false; }
            else if (vc < 2 * r) { if (i == q) L = (q - 1) * G + (G - 1 - (vc - r)); else if (i > q) return false; }
        }
        int e, rt, rows, off; if (!moe_find(MISC, lane, L >> 2, e, rt, rows, off)) return false;
        const int pn = L & 3;
        e = __builtin_amdgcn_readfirstlane(e); rt = __builtin_amdgcn_readfirstlane(rt); rows = __builtin_amdgcn_readfirstlane(rows); off = __builtin_amdgcn_readfirstlane(off);
        u.A = HH + (size_t)(off + rt * 256) * DEXP * 2; u.B0 = W2T + ((size_t)e * DM + pn * 256) * (DEXP * 2); u.B1 = u.B0 + (size_t)128 * (DEXP * 2);
        u.dst = Y + (size_t)pn * 256 * 2; u.pm = rt; u.pn = pn; u.e = e; u.rows = rows; u.t = L >> 2; return true;
    }
    __device__ __forceinline__ unsigned arow(const gm::Unit&, int r) const { return (unsigned)r; }
    __device__ __forceinline__ void a_ready(const gm::Unit& u) const {
        if (threadIdx.x < 64) {
            unsigned spins = 0;
            while ((unsigned)__builtin_amdgcn_readfirstlane(__hip_atomic_load(tile_cnt + 8 * u.t, __ATOMIC_RELAXED, __HIP_MEMORY_SCOPE_AGENT)) < 4u) {
                __builtin_amdgcn_s_sleep(2);
                if (++spins > (1u << 22)) { if (threadIdx.x == 0) __hip_atomic_store(tmo, 1u, __ATOMIC_RELAXED, __HIP_MEMORY_SCOPE_AGENT); break; } }
            __builtin_amdgcn_fence(__ATOMIC_ACQUIRE, "agent");
            asm volatile("s_waitcnt vmcnt(0)" ::: "memory");
        }
        asm volatile("" ::: "memory"); __builtin_amdgcn_s_barrier(); asm volatile("" ::: "memory");
    }
    __device__ __forceinline__ void done(const gm::Unit&) const {}
};
struct EpiMoe2 {
    static constexpr bool PERM = true;
    const int* list;
    __device__ __forceinline__ void operator()(const f32x4 (&acc)[2][2][4][2], const gm::Unit& u, int wr, int wc, int fr, int fq) const {
        const int* lp = list + (size_t)u.e * CAP + u.pm * 256;
#pragma unroll
        for (int ai = 0; ai < 2; ++ai)
#pragma unroll
            for (int m = 0; m < 4; ++m) { const int r = ai * 128 + wr * 64 + m * 16 + fr; if (r >= u.rows) continue;
                const int slot = lp[r]; bf16* rowp = (bf16*)u.dst + (size_t)slot * DM + wc * 32 + 8 * fq;
#pragma unroll
                for (int bj = 0; bj < 2; ++bj) { const f32x4 v0 = acc[ai][bj][m][0], v1 = acc[ai][bj][m][1];
                    u32x4 w; w.x = gm::cvt_pk_bf16(v0[0], v0[1]); w.y = gm::cvt_pk_bf16(v0[2], v0[3]); w.z = gm::cvt_pk_bf16(v1[0], v1[1]); w.w = gm::cvt_pk_bf16(v1[2], v1[3]);
                    *(u32x4*)(rowp + bj * 128) = w; } }
    }
};

__device__ __forceinline__ void p_final(Frame& F, const Args& a) {
    const float* mod = (const float*)(F.ws + WS_MOD); const float* fg = a.in[IN_FG]; const float* wt = (const float*)(F.ws + WS_WT);
    const bf16* Y = (const bf16*)(F.ws + WS_Y); float* X1 = F.out;
    for (int r = F.wave; r < 64; r += NWAVES) {
        const int tok = F.bid * 64 + r; const int b = tok >> 11;
        const float w0 = wt[tok * 2], w1 = wt[tok * 2 + 1];
        f32x4* xr = (f32x4*)(X1 + (size_t)tok * DM) + F.lane;
        const u32x2* y0 = (const u32x2*)(Y + (size_t)(tok * 2) * DM) + F.lane; const u32x2* y1 = (const u32x2*)(Y + (size_t)(tok * 2 + 1) * DM) + F.lane;
        f32x4 v[4]; float s = 0.f;
#pragma unroll
        for (int j = 0; j < 4; ++j) { const int k = 4 * F.lane + 256 * j;
            const f32x4 xv = xr[64 * j]; const u32x2 a0 = y0[64 * j], a1 = y1[64 * j]; const f32x4 g5 = *(const f32x4*)(mod + b * 6144 + 5 * DM + k);
            v[j].x = xv.x + g5.x * (w0 * bflo(a0.x) + w1 * bflo(a1.x)); v[j].y = xv.y + g5.y * (w0 * bfhi(a0.x) + w1 * bfhi(a1.x));
            v[j].z = xv.z + g5.z * (w0 * bflo(a0.y) + w1 * bflo(a1.y)); v[j].w = xv.w + g5.w * (w0 * bfhi(a0.y) + w1 * bfhi(a1.y));
            s += (v[j].x * v[j].x + v[j].y * v[j].y) + (v[j].z * v[j].z + v[j].w * v[j].w); }
        const float rstd = rsqrtf(wave_sum(s) * (1.f / DM) + EPS);
#pragma unroll
        for (int j = 0; j < 4; ++j) { const int k = 4 * F.lane + 256 * j; const f32x4 g = *(const f32x4*)(fg + k);
            xr[64 * j] = (f32x4){v[j].x * rstd * g.x, v[j].y * rstd * g.y, v[j].z * rstd * g.z, v[j].w * rstd * g.w}; }
    }
}
#ifndef LRU_FAST
#define LRU_FAST 1
#endif
#ifndef HG_FAST
#define HG_FAST 1
#endif
#define MIX_FAST (LRU_FAST && HG_FAST)
#ifdef PROBE_A
#define STAMP(k) do { if (F.bid == 0 && F.tid == 0) { const unsigned long long _t = __builtin_amdgcn_s_memrealtime(); F.MISC[32 + 2 * (k)] = (unsigned)_t; F.MISC[33 + 2 * (k)] = (unsigned)(_t >> 32); } } while (0)
#else
#define STAMP(k) do { } while (0)
#endif
__device__ __forceinline__ void p_mix1(Frame& F, const Args& a) {
#if LRU_FAST
    lru_phase1<0>(F, a, (float*)(F.ws + WS_LRUAGG));
#ifdef XLRU
    lru_phase1<XLRU>(F, a, F.out + (size_t)10 * 1024 * 1024);
#endif
#endif
    STAMP(14); STAMP(15);
#if HG_FAST
    for (int i = 0, u = F.bid; u < NB * 8 * 2 * 4; u += F.G, ++i) hg_pass1(F, a, (u & ~3) | ((u + 2 * i) & 3));
#endif
}
__device__ __forceinline__ void p_mix2(Frame& F, const Args& a) {
#if LRU_FAST
    if (F.bid < NB * 8 * LRU_NCH) {
        const int h = (F.bid >> 4) & 7; int ch = h * 128 + 16 * F.wave + (F.lane & 15);
        asm volatile("" : "+v"(ch));
        const LruCoef kf = lru_coef(a, 0, ch), kb = lru_coef(a, 1, ch);
        for (int u = F.bid; u < NB * 8 * LRU_NCH; u += F.G) lru_pass2(F, a, u, kf, kb);
    }
#endif
    STAMP(16); STAMP(17);
#if HG_FAST
    for (int u = F.bid; u < NB * 8 * 4; u += F.G) hg_pass2(F, a, u);
#endif
}
__global__ void __launch_bounds__(NTHR, 2) mega(Args args) {
    extern __shared__ __attribute__((aligned(16))) unsigned char lds_raw[];
    Frame F;
    F.lds = (LAS unsigned char*)lds_raw; F.MISC = (volatile LAS unsigned*)(F.lds + LDSCTL_OFF);
    F.tid = threadIdx.x; F.lane = F.tid & 63; F.wave = __builtin_amdgcn_readfirstlane(F.tid >> 6);
    F.G = gridDim.x; F.bid = blockIdx.x; F.ws = args.ws; F.out = args.out; F.ctl = (unsigned*)(args.ws + WS_CTL);
    for (int u = F.tid; u < (LDS_BYTES - LDSCTL_OFF) / 4; u += NTHR) ((LAS unsigned*)(F.lds + LDSCTL_OFF))[u] = 0u;
    __syncthreads();
    XcdBarrier bar = xcd_barrier_post(F.ctl + CW_BAR + args.li * 3584, F.MISC + 8);
    const int lo = args.ph_lo, hi = args.ph_hi;
#define IN(k) (lo <= (k) && (k) < hi)
#define SEAM(k) do { if (IN(k) && IN((k) + 1)) xcd_barrier(bar); STAMP((k) + 1); if ((k) == 9) STAMP(11); } while (0)
    unsigned char* ws = F.ws;
    STAMP(0);
    if (IN(0)) { p0_prologue(F, args); } SEAM(0);
    if (IN(1)) { p1_norm(F, args); } SEAM(1);
    if (IN(2)) {
        SchedP2 S{F.G, F.bid, (const char*)F.out, (const char*)(ws + WS_WIN), (char*)(ws + WS_P), (char*)(ws + WS_PC)};
        EpiStoreBf16 E;
        gm::gemm_phase<SchedP2, EpiStoreBf16, false>(F.lds, DM, S, E);
    } SEAM(2);
    if (IN(3)) { p_mix1(F, args); } SEAM(3);
    if (IN(4)) { p_mix2(F, args); } SEAM(4);
    if (IN(6)) {
        const bool conv_first = ((F.bid >> 3) & 1) != 0;
        if (conv_first) { p_moe_weights13(F, args); p_moe_weights2(F, args, F.bid, F.G); __syncthreads(); }
        {
            SchedP5 S{F.bid, (const char*)(ws + WS_YAG), (const char*)(ws + WS_YBG), (const char*)(ws + WS_WPA), (const char*)(ws + WS_WPB), nullptr, (char*)(ws + WS_M)};
            EpiP5 E{(unsigned*)F.out + (size_t)F.bid * 32768, (const bf16*)(ws + WS_P + 7 * GS), (const bf16*)(ws + WS_P + 8 * GS)};
            gm::gemm_phase<SchedP5, EpiP5, false>(F.lds, DM, S, E);
        }
        if (!conv_first) { __syncthreads(); p_moe_weights13(F, args); p_moe_weights2(F, args, F.bid, F.G); }
    } SEAM(6);
    if (IN(7)) {
        SchedP6 S{F.bid, (const char*)(ws + WS_M), (const char*)(ws + WS_WOUT), (char*)F.out};
        EpiP6 E{args.in[IN_X], (const float*)(ws + WS_MOD)};
        gm::gemm_phase<SchedP6, EpiP6, false>(F.lds, DM, S, E);
    } SEAM(7);
    if (IN(8)) { p_norm2_route(F, args); } SEAM(8);
    if (IN(9)) {
        moe_table(F, (const int*)(F.ctl + CW_CNT));
        {
            SchedMoe1 S{F.G, F.bid, F.lane, F.MISC, (const int*)(ws + WS_LIST), (const char*)(ws + WS_HX2), (const char*)(ws + WS_W1T), (const char*)(ws + WS_W3T), (char*)(ws + WS_HH), F.ctl + CW_TILE};
            EpiMoe1 E{(char*)(ws + WS_HH)};
            gm::gemm_phase<SchedMoe1, EpiMoe1, true, true>(F.lds, DM, S, E);
        }
        {
            SchedMoe2 S{F.G, F.bid, F.lane, F.MISC, (const char*)(ws + WS_HH), (const char*)(ws + WS_W2T), (char*)(ws + WS_Y), F.ctl + CW_TILE, F.ctl + 2};
            EpiMoe2 E{(const int*)(ws + WS_LIST)};
            gm::gemm_phase<SchedMoe2, EpiMoe2, false, true>(F.lds, DEXP, S, E);
        }
    } SEAM(9);
    if (IN(11)) { p_final(F, args); }
#ifdef PROBE_A
    if (F.bid == 0 && F.tid == 0) {
        const unsigned long long tend = __builtin_amdgcn_s_memrealtime();
        F.MISC[32 + 2 * 12] = (unsigned)tend; F.MISC[33 + 2 * 12] = (unsigned)(tend >> 32);
        auto RD = [&](int k) { return ((unsigned long long)F.MISC[33 + 2 * k] << 32) | F.MISC[32 + 2 * k]; };
        auto T = [&](int k) { if (k >= 20) { const int i = k - 20; return (unsigned long long)(((((unsigned long long)F.MISC[103 + 2 * i] << 32) | F.MISC[102 + 2 * i]) + 400) / 800); } if (k == 13) return (unsigned long long)((RD(14) - RD(3) + 400) / 800); if (k == 15) return (unsigned long long)((RD(16) - RD(4) + 400) / 800); const unsigned long long t0 = ((unsigned long long)F.MISC[33 + 2 * k] << 32) | F.MISC[32 + 2 * k], t1 = ((unsigned long long)F.MISC[33 + 2 * (k + 1)] << 32) | F.MISC[32 + 2 * (k + 1)]; return (unsigned long long)((t1 - t0 + 400) / 800); };
        const unsigned long long delay = (T(PROBE_A) + 64ull * T(PROBE_B)) * 6400ull;
        while (__builtin_amdgcn_s_memrealtime() - tend < delay) __builtin_amdgcn_s_sleep(32);
    }
#endif
#undef IN
#undef SEAM
}

#if !LRU_FAST
__global__ void k_conv_f(const bf16* P0, const bf16* PC0, const float* cw, const float* cb, float* Ub, int b) {
    int t = blockIdx.x; int Lseg = t < CTX ? CTX : SEQ; int lt = t < CTX ? t : t - CTX;
    const bf16* base = t < CTX ? PC0 + (size_t)b * CTX * DM : P0 + (size_t)b * SEQ * DM;
    for (int ch = threadIdx.x; ch < DM; ch += 256) {
        float s = cb[ch];
#pragma unroll
        for (int k = 0; k < 4; ++k) { int tt = lt + k - 2; if (tt >= 0 && tt < Lseg) s += cw[k * DM + ch] * bf2f(base[(size_t)tt * DM + ch]); }
        Ub[(size_t)t * DM + ch] = s;
    }
}
__global__ void k_gates(const float* Ub, const float* wa, const float* ba, const float* wx, const float* bx, const float* lam, float* Aout, float* Bout, int d) {
    __shared__ float us[128];
    int t = blockIdx.x, h = blockIdx.y, j = threadIdx.x; int ch = h * 128 + j;
    float uval = Ub[(size_t)t * DM + ch];
    us[j] = uval; __syncthreads();
    const float* wah = wa + ((size_t)(d * 8 + h) * 128) * 128; const float* wxh = wx + ((size_t)(d * 8 + h) * 128) * 128;
    float ra = 0.f, ia = 0.f;
    for (int i = 0; i < 128; ++i) { float u = us[i]; ra += u * wah[i * 128 + j]; ia += u * wxh[i * 128 + j]; }
    float r = 1.f / (1.f + expf(-(ra + ba[d * DM + ch]))); float ig = 1.f / (1.f + expf(-(ia + bx[d * DM + ch])));
    float sp = log1pf(expf(-lam[d * DM + ch]));
    float log_a = -8.f * r * sp;
    Aout[(size_t)t * DM + ch] = expf(log_a); Bout[(size_t)t * DM + ch] = sqrtf(-expm1f(2.f * log_a)) * (ig * uval);
}
__global__ void k_lru_scan(const float* A0, const float* B0, const float* A1, const float* B1, float* YF, float* YB) {
    int g = blockIdx.x * 256 + threadIdx.x; int d = g / DM, ch = g % DM;
    if (d == 0) { float h = B0[ch];
        for (int t = 0; t < SEQ; ++t) { size_t o = (size_t)(CTX + t) * DM + ch; h = A0[o] * h + B0[o]; YF[(size_t)t * DM + ch] = h; }
    } else { float h = B1[(size_t)(CTX - 1) * DM + ch];
        for (int t = SEQ - 1; t >= 0; --t) { size_t o = (size_t)(CTX + t) * DM + ch; h = A1[o] * h + B1[o]; YB[(size_t)t * DM + ch] = h; }
    }
}
__global__ void k_yag_f(const float* YF, const float* YB, bf16* AY, int b) {
    int t = blockIdx.x;
    for (int ch = threadIdx.x; ch < DM; ch += 256) { size_t o = (size_t)t * DM + ch; bf16* p = AY + ((size_t)b * SEQ + t) * DM + ch;
        *p = (bf16)f2bf((YF[o] + YB[o]) * gelu_tanh(bf2f(*p))); }
}
#endif
#if !HG_FAST
__global__ __launch_bounds__(128) void k_hgrn_f(unsigned char* ws, const float* hg_lb) {
    __shared__ float gs[128], ks[128], qs[128];
    int h = blockIdx.x, d = blockIdx.y, b = blockIdx.z, j = threadIdx.x;
    float S[128];
#pragma unroll
    for (int i = 0; i < 128; ++i) S[i] = 0.f;
    const int c = h * 128 + j;
    const float lbj = 1.f / (1.f + expf(hg_lb[DM + c] - hg_lb[c]));
    bf16* Q = (bf16*)(ws + WS_P + 2 * GS); bf16* Fx = (bf16*)(ws + WS_P + (d == 0 ? 3 : 4) * GS); bf16* V = (bf16*)(ws + WS_P + 5 * GS);
    const bf16* Fc = (const bf16*)(ws + WS_PC + (d == 0 ? 1 : 2) * CGS); const bf16* Vc = (const bf16*)(ws + WS_PC + 3 * CGS);
    for (int s = 0; s < LT; ++s) {
        bool isx = s >= CTX; float fv, vv, qv = 0.f; size_t o;
        if (!isx) { int t = d == 0 ? s : (CTX - 1 - s); o = ((size_t)b * CTX + t) * DM + c; fv = bf2f(Fc[o]); vv = bf2f(Vc[o]); }
        else { int p = s - CTX; if (d == 1) p = SEQ - 1 - p; int tok = (p % 32) * 64 + (p / 32); o = ((size_t)b * SEQ + tok) * DM + c; fv = bf2f(Fx[o]); vv = bf2f(V[o]); qv = bf2f(Q[o]); }
        float gg = lbj + (1.f - lbj) / (1.f + expf(-fv));
        gs[j] = gg; ks[j] = 1.f - gg; qs[j] = qv / (1.f + expf(-qv));
        __syncthreads();
        float oo = 0.f;
#pragma unroll
        for (int i = 0; i < 128; ++i) { S[i] = gs[i] * S[i] + ks[i] * vv; oo += S[i] * qs[i]; }
        if (isx) Fx[o] = (bf16)f2bf(oo);
        __syncthreads();
    }
}
#endif

extern "C" void kernel_launch(void* const* d_in, const int* in_sizes, int n_in, void* d_out, int out_size, void* d_ws, size_t ws_size, hipStream_t stream) {
    static int grid = 0;
    if (grid == 0) {
        if (n_in != 29 || out_size != NTOK * DM || ws_size < WS_END) { fprintf(stderr, "kernel_launch: unexpected problem shape / workspace (%d inputs, out %d, ws %zu)\n", n_in, out_size, ws_size); grid = -1; return; }
        int dev = 0, cus = 0, per_cu = 0;
        if (hipGetDevice(&dev) != hipSuccess || hipDeviceGetAttribute(&cus, hipDeviceAttributeMultiprocessorCount, dev) != hipSuccess) { grid = -1; return; }
        if (hipFuncSetAttribute((const void*)mega, hipFuncAttributeMaxDynamicSharedMemorySize, LDS_BYTES) != hipSuccess) { grid = -1; return; }
        if (hipOccupancyMaxActiveBlocksPerMultiprocessor(&per_cu, (const void*)mega, NTHR, LDS_BYTES) != hipSuccess || per_cu < 1) { fprintf(stderr, "kernel_launch: occupancy query says %d blocks per CU\n", per_cu); }
        (void)hipGetLastError();
        grid = cus;
        if (grid != 256) { fprintf(stderr, "kernel_launch: built for 256 CUs, found %d\n", cus); grid = -1; return; }
    }
    if (grid < 0) return;
    hipMemsetAsync((char*)d_ws + WS_CTL, 0, CTL_BYTES, stream);
    Args a{};
    for (int i = 0; i < 29; ++i) a.in[i] = (const float*)d_in[i];
    a.out = (float*)d_out; a.ws = (unsigned char*)d_ws;
#if MIX_FAST
    a.ph_lo = 0; a.ph_hi = 12; a.li = 0;
    hipLaunchKernelGGL(mega, dim3(grid), dim3(NTHR), LDS_BYTES, stream, a);
#else
    a.ph_lo = 0; a.ph_hi = 5; a.li = 0;
    hipLaunchKernelGGL(mega, dim3(grid), dim3(NTHR), LDS_BYTES, stream, a);
    {
        unsigned char* ws = (unsigned char*)d_ws;
#if !LRU_FAST
        float* sc = (float*)d_out;
        float* Ub = sc; float* A0 = Ub + (size_t)LT * DM; float* B0 = A0 + (size_t)LT * DM; float* A1 = B0 + (size_t)LT * DM; float* B1 = A1 + (size_t)LT * DM;
        float* YF = B1 + (size_t)LT * DM; float* YB = YF + (size_t)SEQ * DM;
        const float* cw = (const float*)d_in[IN_CONVW]; const float* cb = (const float*)d_in[IN_CONVB];
        const float* wa = (const float*)d_in[IN_WA]; const float* ba = (const float*)d_in[IN_BA]; const float* wx = (const float*)d_in[IN_WX]; const float* bx = (const float*)d_in[IN_BX]; const float* lam = (const float*)d_in[IN_LAM];
        for (int b = 0; b < NB; ++b) {
            k_conv_f<<<LT, 256, 0, stream>>>((const bf16*)(ws + WS_P), (const bf16*)(ws + WS_PC), cw, cb, Ub, b);
            k_gates<<<dim3(LT, 8), 128, 0, stream>>>(Ub, wa, ba, wx, bx, lam, A0, B0, 0);
            k_gates<<<dim3(LT, 8), 128, 0, stream>>>(Ub, wa, ba, wx, bx, lam, A1, B1, 1);
            k_lru_scan<<<8, 256, 0, stream>>>(A0, B0, A1, B1, YF, YB);
            k_yag_f<<<SEQ, 256, 0, stream>>>(YF, YB, (bf16*)(ws + WS_YAG), b);
        }
#endif
#if !HG_FAST
        k_hgrn_f<<<dim3(8, 2, NB), 128, 0, stream>>>(ws, (const float*)d_in[IN_HGLB]);
#endif
    }
    a.ph_lo = 5; a.ph_hi = 12; a.li = 1;
    hipLaunchKernelGGL(mega, dim3(grid), dim3(NTHR), LDS_BYTES, stream, a);
#endif
}
```

```cpp
#include <hip/hip_runtime.h>
#include <cstdio>
#include <cstdint>
#include <math.h>

#define LAS __attribute__((address_space(3)))
#define GAS __attribute__((address_space(1)))
typedef unsigned short bf16;
typedef short bf16x8 __attribute__((ext_vector_type(8)));
typedef float f32x4 __attribute__((ext_vector_type(4)));
typedef float f32x2 __attribute__((ext_vector_type(2)));
typedef unsigned u32x4 __attribute__((ext_vector_type(4)));
typedef unsigned u32x2 __attribute__((ext_vector_type(2)));

constexpr int DM = 1024, NB = 8, SEQ = 2048, CTX = 256, NTOK = NB * SEQ, NCTX = NB * CTX, INW = 9216, LT = CTX + SEQ;
constexpr int NEXP = 32, DEXP = 512, CAP = 16384;
constexpr float EPS = 1e-6f;
constexpr int NWAVES = 8, NTHR = 512;

constexpr size_t MiB = 1u << 20, KiB = 1024;
constexpr size_t WS_CTL = 0, CTL_BYTES = 64 * KiB;
constexpr size_t WS_MODP = 256 * KiB;
constexpr size_t WS_MOD = 2 * MiB;
constexpr size_t WS_LRUAGG = 2 * MiB + 512 * KiB;
constexpr size_t WS_LRUS0 = 4 * MiB + 512 * KiB;
constexpr size_t WS_WT = 4 * MiB + 768 * KiB;
constexpr size_t WS_LIST = 5 * MiB;
constexpr size_t WS_HGD = 7 * MiB;
constexpr size_t WS_WRT = 7 * MiB + 256 * KiB;
constexpr size_t WS_WIN = 8 * MiB;
constexpr size_t WS_WPA = 26 * MiB, WS_WPB = 28 * MiB, WS_WOUT = 30 * MiB;
constexpr size_t WS_WLRU = 32 * MiB;
constexpr size_t WS_P = 33 * MiB, GS = 32 * MiB;
constexpr size_t WS_PC = 321 * MiB, CGS = 4 * MiB;
constexpr size_t WS_END = 337 * MiB;
constexpr size_t WS_W1T = WS_P + 0 * GS, WS_W3T = WS_P + 2 * GS, WS_W2T = WS_P + 5 * GS;
constexpr size_t WS_YAG = WS_P + 1 * GS;
constexpr size_t WS_OF = WS_P + 3 * GS, WS_OB = WS_P + 4 * GS;
constexpr size_t WS_YBG = WS_P + 3 * GS;
constexpr size_t WS_M = WS_P + 4 * GS;
constexpr size_t WS_HX2 = WS_P + 1 * GS;
constexpr size_t WS_HH = WS_P + 3 * GS;
constexpr size_t WS_Y = WS_P + 6 * GS;

constexpr int CW_BAR = 1024;
constexpr int CW_CNT = 12288;
constexpr int CW_TILE = 14336;
constexpr int CW_LRUG = 15680;
constexpr int CW_PANEL = 15616;

constexpr int RING_BYTES = 131072, LDS_BYTES = 147456, LDSCTL_OFF = LDS_BYTES - 1024;

#define LDS_WAIT() asm volatile("s_waitcnt lgkmcnt(0)" ::: "memory")
#define VM_WAIT() asm volatile("s_waitcnt vmcnt(0)" ::: "memory")

typedef __bf16 bf16x2_t __attribute__((ext_vector_type(2)));
__device__ __forceinline__ unsigned pk2(float lo, float hi) { const f32x2 v = {lo, hi}; return __builtin_bit_cast(unsigned, __builtin_convertvector(v, bf16x2_t)); }
__device__ __forceinline__ unsigned f2bf(float f) { return pk2(f, 0.f) & 0xffffu; }
__device__ __forceinline__ float bf2f(unsigned short b) { return __builtin_bit_cast(float, (unsigned)b << 16); }
__device__ __forceinline__ float bflo(unsigned w) { return __builtin_bit_cast(float, w << 16); }
__device__ __forceinline__ float bfhi(unsigned w) { return __builtin_bit_cast(float, w & 0xffff0000u); }
__device__ __forceinline__ float sigmoidf_(float x) { return 1.f / (1.f + __expf(-x)); }
__device__ __forceinline__ float siluf_(float x) { return x / (1.f + __expf(-x)); }
__device__ __forceinline__ float gelu_tanh(float x) { float u = 0.7978845608028654f * (x + 0.044715f * x * x * x); float e = __expf(2.f * u); return x * (1.f - 1.f / (1.f + e)); }
__device__ __forceinline__ float wave_sum(float v) {
#pragma unroll
    for (int o = 1; o < 64; o <<= 1) v += __shfl_xor(v, o);
    return v;
}

#define XB_TMO      128
#define XB_XCNT(j)  (256  + 64 * (j))
#define XB_XSUB(j)  (1280 + 64 * (j))
#define XB_XGEN(j)  (2304 + 64 * (j))
#define XB_TOP      3328
#define XB_TOPGEN   3392
#define XCD_BAR_WORDS 3456
#define XB_SPIN_CAP (1u << 20)
__device__ __forceinline__ unsigned xb_ld(unsigned* p)              { return __hip_atomic_load(p, __ATOMIC_RELAXED, __HIP_MEMORY_SCOPE_AGENT); }
__device__ __forceinline__ unsigned xb_add(unsigned* p, unsigned v) { return __hip_atomic_fetch_add(p, v, __ATOMIC_RELAXED, __HIP_MEMORY_SCOPE_AGENT); }
__device__ __forceinline__ unsigned xb_xcc_id() { return (unsigned)__builtin_amdgcn_s_getreg((3 << 11) | 20) & 0xFu; }
#define XB_SPIN(cond, bar) do { unsigned _sp = 0; while (cond) { __builtin_amdgcn_s_sleep(1); \
    if ((++_sp & 255u) == 0u) { if (xb_ld(&(bar)[XB_TMO])) break; if (_sp > XB_SPIN_CAP) { atomicAdd(&(bar)[XB_TMO], 1u); break; } } } } while (0)
struct XcdBarrier { unsigned* bar; unsigned x; volatile LAS unsigned* st; };
__device__ __forceinline__ XcdBarrier xcd_barrier_post(unsigned* bar, volatile LAS unsigned* st) {
    XcdBarrier b; b.bar = bar; b.x = xb_xcc_id(); b.st = st;
    if (threadIdx.x == 0) (void)xb_add(&bar[XB_XCNT(b.x)], 1u);
    return b;
}
__device__ __forceinline__ void xcd_barrier_complete(unsigned* bar, unsigned x, unsigned& nloc, unsigned& nx) {
    const unsigned G = gridDim.x * gridDim.y * gridDim.z;
    unsigned sum, cnt, mine, sp = 0u;
    for (;;) {
        sum = 0u; cnt = 0u; mine = 0u;
#pragma unroll
        for (unsigned j = 0; j < 16; ++j) { const unsigned c = xb_ld(&bar[XB_XCNT(j)]); sum += c; cnt += (c > 0u) ? 1u : 0u; mine = (j == x) ? c : mine; }
        if (sum == G) break;
        __builtin_amdgcn_s_sleep(1);
        if ((++sp & 255u) == 0u) { if (xb_ld(&bar[XB_TMO])) break; if (sp > XB_SPIN_CAP) { atomicAdd(&bar[XB_TMO], 1u); break; } }
    }
    nloc = mine > 0u ? mine : 1u; nx = cnt > 0u ? cnt : 1u;
}
__device__ __forceinline__ void xcd_barrier(const XcdBarrier& b) {
    asm volatile("s_waitcnt vmcnt(0)" ::: "memory");
    __syncthreads();
    if (threadIdx.x == 0) {
        unsigned* bar = b.bar;
        __builtin_amdgcn_s_waitcnt(0);
        unsigned nloc = b.st[0], nx = b.st[1];
        if (nloc == 0u) { xcd_barrier_complete(bar, b.x, nloc, nx); b.st[0] = nloc; b.st[1] = nx; }
        const unsigned old = xb_add(&bar[XB_XSUB(b.x)], 1u);
        const unsigned gen = old / nloc;
        if (old + 1u == (gen + 1u) * nloc) {
            __builtin_amdgcn_fence(__ATOMIC_RELEASE, "agent");
            asm volatile("s_waitcnt vmcnt(0)" ::: "memory");
            const unsigned og = xb_add(&bar[XB_TOP], 1u);
            const unsigned tg = og / nx;
            if (og + 1u == (tg + 1u) * nx) xb_add(&bar[XB_TOPGEN], 1u);
            else XB_SPIN(xb_ld(&bar[XB_TOPGEN]) == tg, bar);
            __builtin_amdgcn_fence(__ATOMIC_ACQUIRE, "agent");
            xb_add(&bar[XB_XGEN(b.x)], 1u);
            asm volatile("s_waitcnt vmcnt(0)" ::: "memory");
        } else {
            XB_SPIN(xb_ld(&bar[XB_XGEN(b.x)]) == gen, bar);
            __builtin_amdgcn_fence(__ATOMIC_ACQUIRE, "agent");
            asm volatile("s_waitcnt vmcnt(0)" ::: "memory");
        }
    }
    __syncthreads();
}

namespace gm {
constexpr int BM = 256, BK = 64, HALF = 128, HTB = HALF * BK * 2;
__device__ __forceinline__ int lds_byte(int r, int c) { const int st = (r >> 4) * 2 + (c >> 5), rr = r & 15, cc = c & 31, ob = rr * 64 + cc * 2; return st * 1024 + (ob ^ (((ob >> 9) & 1) << 5)); }
__device__ __forceinline__ void stage_rc(int b, int& R, int& C) { const int st = b / 1024, sb = b % 1024, swz = sb ^ (((sb >> 9) & 1) << 5); R = (st >> 1) * 16 + swz / 64; C = (st & 1) * 32 + (swz % 64) / 2; }
__device__ __forceinline__ int perm32(int rho) { const int n = rho >> 4, i = rho & 15; return 8 * (i >> 2) + 4 * n + (i & 3); }
__device__ __forceinline__ unsigned cvt_pk_bf16(float lo, float hi) { unsigned r; asm volatile("v_cvt_pk_bf16_f32 %0, %1, %2" : "=v"(r) : "v"(lo), "v"(hi)); return r; }

struct Unit { const char* A; const char* B0; const char* B1; char* dst; int pm, pn, e, rows, t; };

template <class Sched, class Epi, bool GATHER, bool HOOKS = false>
__device__ __forceinline__ void gemm_phase(LAS unsigned char* lds, const int K, const Sched& S, const Epi& E) {
    const int tid = threadIdx.x, wid = __builtin_amdgcn_readfirstlane(tid >> 6), lane = tid & 63, wr = wid >> 2, wc = wid & 3, fr = lane & 15, fq = lane >> 4;
    const int nt = K / BK;
    unsigned voffB[2]; int Rr[2]; unsigned Cb[2];
#pragma unroll
    for (int i = 0; i < 2; ++i) { int R, C; stage_rc(tid * 16 + i * 8192, R, C); const int Rb = Epi::PERM ? ((R & ~31) + perm32(R & 31)) : R;
        Rr[i] = R; Cb[i] = (unsigned)C * 2u; voffB[i] = (unsigned)(Rb * K + C) * 2u; }
    const unsigned rowb = (unsigned)K * 2u;
    const size_t kstep = (size_t)(BK * 2);
    const unsigned ldsw = (unsigned)wid * 1024u;
    const int aoff = lds_byte(wr * 64 + fr, fq * 8), boff = lds_byte(wc * 32 + fr, fq * 8);
#define GM_SA(b, h) (((b) * 2 + (h)) * HTB)
#define GM_SB(b, h) ((4 + (b) * 2 + (h)) * HTB)
#define GM_STAGE(bufoff, gbase, voff) do { _Pragma("unroll") for (int _i = 0; _i < 2; ++_i) \
        __builtin_amdgcn_global_load_lds((const unsigned*)((const char*)(gbase) + (voff)[_i]), (LAS unsigned*)(lds + (bufoff) + ldsw + _i * 8192), 16, 0, 0); } while (0)
#define GM_LDA(dst, b, h) do { _Pragma("unroll") for (int m = 0; m < 4; ++m) _Pragma("unroll") for (int k = 0; k < 2; ++k) dst[m][k] = *(const LAS bf16x8*)(lds + GM_SA(b, h) + aoff + m * 2048 + k * 1024); } while (0)
#define GM_LDB(dst, b, h) do { _Pragma("unroll") for (int n = 0; n < 2; ++n) _Pragma("unroll") for (int k = 0; k < 2; ++k) dst[n][k] = *(const LAS bf16x8*)(lds + GM_SB(b, h) + boff + n * 2048 + k * 1024); } while (0)
#define GM_MMA(ai, bj, At, Bt) do { __builtin_amdgcn_s_setprio(1); _Pragma("unroll") for (int m = 0; m < 4; ++m) _Pragma("unroll") for (int n = 0; n < 2; ++n) _Pragma("unroll") for (int k = 0; k < 2; ++k) \
        acc[ai][bj][m][n] = __builtin_amdgcn_mfma_f32_16x16x32_bf16(Bt[n][k], At[m][k], acc[ai][bj][m][n], 0, 0, 0); __builtin_amdgcn_s_setprio(0); } while (0)
#define GM_WAIT_V(n) asm volatile("s_waitcnt vmcnt(" #n ")" ::: "memory")
#define GM_WAIT_L(n) asm volatile("s_waitcnt lgkmcnt(" #n ")" ::: "memory")
#define GM_BAR __builtin_amdgcn_s_barrier()
#define GM_SCHED __builtin_amdgcn_sched_barrier(0)
#define GM_AOFFS(u, o) do { _Pragma("unroll") for (int _h = 0; _h < 2; ++_h) _Pragma("unroll") for (int _i = 0; _i < 2; ++_i) \
        (o)[_h][_i] = (GATHER ? S.arow((u), _h * HALF + Rr[_i]) : (unsigned)(_h * HALF + Rr[_i])) * rowb + Cb[_i]; } while (0)
    Unit cur, nxt; int ui = 0;
    if (!S.next(0, cur)) return;
    f32x4 acc[2][2][4][2];
#pragma unroll
    for (int a = 0; a < 2; ++a)
#pragma unroll
        for (int b = 0; b < 2; ++b)
#pragma unroll
            for (int m = 0; m < 4; ++m)
#pragma unroll
                for (int n = 0; n < 2; ++n) acc[a][b][m][n] = (f32x4){0.f, 0.f, 0.f, 0.f};
    bf16x8 At[4][2], B0[2][2], B1[2][2];
    unsigned ca[2][2], na[2][2];
    GM_AOFFS(cur, ca);
    const char* cA = cur.A; const char* cB0 = cur.B0; const char* cB1 = cur.B1;
    if constexpr (HOOKS) S.a_ready(cur);
    GM_STAGE(GM_SB(0, 0), cB0, voffB); GM_STAGE(GM_SB(0, 1), cB1, voffB); GM_STAGE(GM_SA(0, 0), cA, ca[0]); GM_STAGE(GM_SA(0, 1), cA, ca[1]);
    if (wr == 1) GM_BAR;
    GM_WAIT_V(2); GM_BAR;
    GM_STAGE(GM_SB(1, 0), cB0 + kstep, voffB); GM_STAGE(GM_SA(1, 0), cA + kstep, ca[0]); GM_STAGE(GM_SB(1, 1), cB1 + kstep, voffB);
    GM_WAIT_V(6); GM_BAR;
    for (;;) {
        const bool has_next = S.next(ui + 1, nxt);
        const char* nA = has_next ? nxt.A : cA; const char* nB0 = has_next ? nxt.B0 : cB0; const char* nB1 = has_next ? nxt.B1 : cB1;
        if (has_next) { GM_AOFFS(nxt, na); } else {
#pragma unroll
            for (int h = 0; h < 2; ++h)
#pragma unroll
                for (int i = 0; i < 2; ++i) na[h][i] = ca[h][i]; }
        for (int t = 0; t < nt; t += 2) {
            const bool last = (t == nt - 2);
            if constexpr (HOOKS) { if (last && has_next) S.a_ready(nxt); }
            const char* a1 = cA + (size_t)(t + 1) * kstep;
            const char* a2 = last ? nA : cA + (size_t)(t + 2) * kstep;
            const char* b20 = last ? nB0 : cB0 + (size_t)(t + 2) * kstep; const char* b21 = last ? nB1 : cB1 + (size_t)(t + 2) * kstep;
            const char* a3 = a2 + kstep; const char* b30 = b20 + kstep; const char* b31 = b21 + kstep;
            unsigned o2[2][2];
#pragma unroll
            for (int h = 0; h < 2; ++h)
#pragma unroll
                for (int i = 0; i < 2; ++i) o2[h][i] = last ? na[h][i] : ca[h][i];
            GM_LDB(B0, 0, 0); GM_LDB(B1, 0, 1); GM_SCHED; GM_LDA(At, 0, 0); GM_STAGE(GM_SA(1, 1), a1, ca[1]);
            GM_WAIT_V(8); GM_WAIT_L(0); GM_BAR; GM_MMA(0, 0, At, B0); GM_MMA(0, 1, At, B1); GM_BAR; GM_SCHED;
            GM_LDA(At, 0, 1); GM_STAGE(GM_SB(0, 0), b20, voffB); GM_STAGE(GM_SB(0, 1), b21, voffB); GM_STAGE(GM_SA(0, 0), a2, o2[0]);
            GM_WAIT_V(8); GM_WAIT_L(0); GM_BAR; GM_MMA(1, 0, At, B0); GM_MMA(1, 1, At, B1); GM_BAR; GM_SCHED;
            GM_LDB(B0, 1, 0); GM_LDB(B1, 1, 1); GM_SCHED; GM_LDA(At, 1, 0); GM_STAGE(GM_SA(0, 1), a2, o2[1]);
            GM_WAIT_V(8); GM_WAIT_L(0); GM_BAR; GM_MMA(0, 0, At, B0); GM_MMA(0, 1, At, B1); GM_BAR; GM_SCHED;
            GM_LDA(At, 1, 1); GM_STAGE(GM_SB(1, 0), b30, voffB); GM_STAGE(GM_SB(1, 1), b31, voffB); GM_STAGE(GM_SA(1, 0), a3, o2[0]);
            GM_WAIT_V(8); GM_WAIT_L(0); GM_BAR; GM_MMA(1, 0, At, B0); GM_MMA(1, 1, At, B1); GM_BAR; GM_SCHED;
        }
        if (wr == 0) GM_BAR;
        E(acc, cur, wr, wc, fr, fq);
        if constexpr (HOOKS) S.done(cur);
        if (!has_next) break;
#pragma unroll
        for (int a = 0; a < 2; ++a)
#pragma unroll
            for (int b = 0; b < 2; ++b)
#pragma unroll
                for (int m = 0; m < 4; ++m)
#pragma unroll
                    for (int n = 0; n < 2; ++n) acc[a][b][m][n] = (f32x4){0.f, 0.f, 0.f, 0.f};
        cur = nxt; cA = nA; cB0 = nB0; cB1 = nB1; ++ui;
#pragma unroll
        for (int h = 0; h < 2; ++h)
#pragma unroll
            for (int i = 0; i < 2; ++i) ca[h][i] = na[h][i];
        if (wr == 1) GM_BAR;
    }
    GM_WAIT_V(0);
    GM_BAR;
#undef GM_SA
#undef GM_SB
#undef GM_STAGE
#undef GM_LDA
#undef GM_LDB
#undef GM_MMA
#undef GM_WAIT_V
#undef GM_WAIT_L
#undef GM_BAR
#undef GM_SCHED
#undef GM_AOFFS
}
}
struct Args {
    const float* in[29]; float* out; unsigned char* ws; int ph_lo, ph_hi, li, pad;
};
struct Frame {
    LAS unsigned char* lds; volatile LAS unsigned* MISC;
    unsigned* ctl; unsigned char* ws; float* out;
    int tid, lane, wave, G, bid;
};
enum { IN_X = 0, IN_C, IN_CTX, IN_CCTX, IN_WMOD, IN_BMOD, IN_G1, IN_WIN, IN_CONVW, IN_CONVB, IN_WA, IN_BA, IN_WX, IN_BX, IN_LAM, IN_HGLB, IN_HGN,
       IN_WPA, IN_WPB, IN_WOUT, IN_G2, IN_WRG, IN_BRG, IN_WRE, IN_BRE, IN_W1, IN_W3, IN_W2, IN_FG };

constexpr int TR_BYTES = 64 * 64 * 4;
__device__ __forceinline__ void transpose_item(const float* W, int ldw, int K, bf16* WT, int k0, int n0, LAS float* scr, int lane) {
    const int lr = lane >> 4, ls = lane & 15;
    f32x4 v[16];
#pragma unroll
    for (int i = 0; i < 16; ++i) v[i] = *(const f32x4*)(W + (size_t)(k0 + 4 * i + lr) * ldw + n0 + 4 * ls);
#pragma unroll
    for (int i = 0; i < 16; ++i) { const int k = 4 * i + lr; *(LAS f32x4*)(scr + k * 64 + ((ls ^ ((k >> 3) & 7)) << 2)) = v[i]; }
    LDS_WAIT(); asm volatile("" ::: "memory");
    const int c = lane & 7;
#pragma unroll
    for (int j = 0; j < 8; ++j) { const int n = (lane >> 3) + 8 * j; const LAS float* s = scr + (8 * c) * 64 + ((((n >> 2) ^ c) << 2) | (n & 3));
        u32x4 o; o.x = pk2(s[0 * 64], s[1 * 64]); o.y = pk2(s[2 * 64], s[3 * 64]); o.z = pk2(s[4 * 64], s[5 * 64]); o.w = pk2(s[6 * 64], s[7 * 64]);
        *(u32x4*)(WT + (size_t)n * K + k0 + 8 * c) = o; }
    LDS_WAIT(); asm volatile("" ::: "memory");
}

__device__ __forceinline__ void p0_mod_item(Frame& F, const Args& a, int item) {
    const int cb = item % 24, ks = item / 24;
    LAS float* sv = (LAS float*)F.lds;
    LAS float* red = sv + 9 * 128;
    const float* c = a.in[IN_C]; const float* cc = a.in[IN_CCTX]; const float* wmod = a.in[IN_WMOD];
    for (int i = F.tid; i < 9 * 128; i += NTHR) { const int r = i >> 7, k = i & 127; const float v = r < 8 ? c[r * DM + ks * 128 + k] : cc[ks * 128 + k]; sv[i] = siluf_(v); }
    __syncthreads();
    const int col = cb * 256 + (F.tid & 255), kh = F.tid >> 8;
    float acc[9];
#pragma unroll
    for (int r = 0; r < 9; ++r) acc[r] = 0.f;
    for (int k0 = 0; k0 < 64; k0 += 16) { float wv[16];
#pragma unroll
        for (int k = 0; k < 16; ++k) wv[k] = wmod[(size_t)(ks * 128 + kh * 64 + k0 + k) * 6144 + col];
#pragma unroll
        for (int k = 0; k < 16; ++k) { const int kk = kh * 64 + k0 + k;
#pragma unroll
            for (int r = 0; r < 9; ++r) acc[r] += sv[r * 128 + kk] * wv[k]; } }
    if (kh == 1) {
#pragma unroll
        for (int r = 0; r < 9; ++r) red[r * 256 + (F.tid & 255)] = acc[r]; }
    __syncthreads();
    float* modp = (float*)(F.ws + WS_MODP);
    if (kh == 0) {
#pragma unroll
        for (int r = 0; r < 9; ++r) modp[(size_t)(ks * 9 + r) * 6144 + col] = acc[r] + red[r * 256 + F.tid]; }
    __syncthreads();
}
__device__ __forceinline__ float mod_from_partials(const float* modp, const float* bmod, int row, int j) {
    float s = bmod[j];
#pragma unroll
    for (int ks = 0; ks < 8; ++ks) s += modp[(size_t)(ks * 9 + row) * 6144 + j];
    return s;
}

__device__ __forceinline__ void p0_prologue(Frame& F, const Args& a) {
    if (F.bid < 192) p0_mod_item(F, a, F.bid);
    LAS float* scr = (LAS float*)(F.lds + F.wave * TR_BYTES);
    const int gw = F.bid * NWAVES + F.wave, NGW = F.G * NWAVES;
    constexpr int I_IN = 16 * 144, I_PR = 16 * 16, I_LRU = 32 * 4;
    constexpr int NITEMS = I_IN + 3 * I_PR + I_LRU;
    for (int it = gw; it < NITEMS; it += NGW) {
        int r = it;
        if (r < I_IN) { const int kb = r / 144, nb = r % 144; transpose_item(a.in[IN_WIN], INW, DM, (bf16*)(F.ws + WS_WIN) + (size_t)(nb * 64) * DM, kb * 64, nb * 64, scr, F.lane); continue; } r -= I_IN;
        if (r < 3 * I_PR) { const int w = r / I_PR, q = r % I_PR, kb = q / 16, nb = q % 16;
            const float* W = a.in[w == 0 ? IN_WPA : (w == 1 ? IN_WPB : IN_WOUT)]; bf16* WT = (bf16*)(F.ws + (w == 0 ? WS_WPA : (w == 1 ? WS_WPB : WS_WOUT)));
            transpose_item(W, DM, DM, WT + (size_t)(nb * 64) * DM, kb * 64, nb * 64, scr, F.lane); continue; } r -= 3 * I_PR;
        { const int mat = r / 4, q = r % 4, kb = q / 2, nb = q % 2;
          const int which = mat >> 4, dh = mat & 15;
          const float* W = a.in[which == 0 ? IN_WA : IN_WX] + (size_t)dh * 128 * 128; bf16* WT = (bf16*)(F.ws + WS_WLRU) + (size_t)mat * 128 * 128;
          transpose_item(W, 128, 128, WT + (size_t)(nb * 64) * 128, kb * 64, nb * 64, scr, F.lane); }
    }
    float* wrp = (float*)(F.ws + WS_WRT);
    for (int i = F.bid * NTHR + F.tid; i < 49152 + 48; i += F.G * NTHR) {
        if (i < 49152) { const int j = i & 3, ln = (i >> 2) & 63, sc = i >> 8, c = sc % 3, s2 = sc / 3; const int k = 16 * s2 + 4 * (ln >> 4) + j, o = 16 * c + (ln & 15);
            wrp[i] = o < 4 ? a.in[IN_WRG][k * 4 + o] : (o < 36 ? a.in[IN_WRE][k * 32 + (o - 4)] : 0.f); }
        else { const int o = i - 49152; wrp[i] = o < 4 ? a.in[IN_BRG][o] : (o < 36 ? a.in[IN_BRE][o - 4] : 0.f); }
    }
}

__device__ __forceinline__ void norm_rows(Frame& F, const float* src, bf16* dst, int row0, int nrows, const LAS float* gs, const LAS float* sh) {
    for (int r = F.wave; r < nrows; r += 2 * NWAVES) {
        const int r1 = r + NWAVES < nrows ? r + NWAVES : r;
        const f32x4* xa = (const f32x4*)(src + (size_t)(row0 + r) * DM) + F.lane; const f32x4* xb = (const f32x4*)(src + (size_t)(row0 + r1) * DM) + F.lane;
        f32x4 va[4], vb[4]; float sa = 0.f, sb = 0.f;
#pragma unroll
        for (int j = 0; j < 4; ++j) { va[j] = xa[64 * j]; vb[j] = xb[64 * j]; }
#pragma unroll
        for (int j = 0; j < 4; ++j) { sa += (va[j].x * va[j].x + va[j].y * va[j].y) + (va[j].z * va[j].z + va[j].w * va[j].w); sb += (vb[j].x * vb[j].x + vb[j].y * vb[j].y) + (vb[j].z * vb[j].z + vb[j].w * vb[j].w); }
        const float ra = rsqrtf(wave_sum(sa) * (1.f / DM) + EPS), rb = rsqrtf(wave_sum(sb) * (1.f / DM) + EPS);
        unsigned long long* oa = (unsigned long long*)(dst + (size_t)(row0 + r) * DM) + F.lane; unsigned long long* ob = (unsigned long long*)(dst + (size_t)(row0 + r1) * DM) + F.lane;
#pragma unroll
        for (int j = 0; j < 4; ++j) { const int k = 4 * F.lane + 256 * j;
            const f32x4 g = *(const LAS f32x4*)(gs + k), h = *(const LAS f32x4*)(sh + k);
            oa[64 * j] = (unsigned long long)pk2(va[j].x * ra * g.x + h.x, va[j].y * ra * g.y + h.y) | ((unsigned long long)pk2(va[j].z * ra * g.z + h.z, va[j].w * ra * g.w + h.w) << 32);
            ob[64 * j] = (unsigned long long)pk2(vb[j].x * rb * g.x + h.x, vb[j].y * rb * g.y + h.y) | ((unsigned long long)pk2(vb[j].z * rb * g.z + h.z, vb[j].w * rb * g.w + h.w) << 32); }
    }
}
struct EpiStoreBf16 {
    static constexpr bool PERM = true;
    __device__ __forceinline__ void operator()(const f32x4 (&acc)[2][2][4][2], const gm::Unit& u, int wr, int wc, int fr, int fq) const {
        bf16* base = (bf16*)u.dst + (size_t)(wr * 64 + fr) * DM + wc * 32 + 8 * fq;
#pragma unroll
        for (int ai = 0; ai < 2; ++ai)
#pragma unroll
            for (int m = 0; m < 4; ++m) { bf16* rowp = base + (size_t)(ai * 128 + m * 16) * DM;
#pragma unroll
                for (int bj = 0; bj < 2; ++bj) { const f32x4 v0 = acc[ai][bj][m][0], v1 = acc[ai][bj][m][1];
                    u32x4 w; w.x = gm::cvt_pk_bf16(v0[0], v0[1]); w.y = gm::cvt_pk_bf16(v0[2], v0[3]); w.z = gm::cvt_pk_bf16(v1[0], v1[1]); w.w = gm::cvt_pk_bf16(v1[2], v1[3]);
                    *(u32x4*)(rowp + bj * 128) = w; } }
    }
};
__device__ __forceinline__ void tile_order(int L, int nM, int nN, int& pm, int& pn) {
    const int nwg = nM * nN; int wgid = L;
    { const int q = nwg / 8, r = nwg % 8, xcd = wgid % 8, off = wgid / 8; wgid = (xcd < r ? xcd * (q + 1) : r * (q + 1) + (xcd - r) * q) + off; }
    const int nig = 8 * nN, gid = wgid / nig, fm = gid * 8, gsz = (nM - fm) < 8 ? (nM - fm) : 8;
    pm = fm + ((wgid % nig) % gsz); pn = (wgid % nig) / gsz;
}
struct SchedP2 {
    int G, c; const char* H; const char* Wt; char* P; char* PC;
    __device__ __forceinline__ bool next(int i, gm::Unit& u) const {
        int L = i * G + c;
        if (L < 64 * 36) { int pm, pn; tile_order(L, 64, 36, pm, pn);
            u.A = H + (size_t)pm * 256 * 2048; u.B0 = Wt + (size_t)pn * 256 * 2048; u.B1 = u.B0 + (size_t)128 * 2048;
            u.dst = P + (size_t)(pn >> 2) * GS + ((size_t)pm * 256 * DM + (pn & 3) * 256) * 2; u.pm = pm; u.pn = pn; u.e = 0; u.rows = 256; return true; }
        return false;
    }
    __device__ __forceinline__ unsigned arow(const gm::Unit&, int r) const { return (unsigned)r; }
};
struct SchedCtx {
    int bid; const char* H; const char* Wt; char* PC; unsigned* cnt; unsigned* tmo;
    __device__ __forceinline__ bool next(int i, gm::Unit& u) const {
        if (i > 0) return false;
        const int pmc = bid >> 4, j = bid & 15, slot = j >> 2, g = slot == 0 ? 0 : slot + 2, pn = g * 4 + (j & 3);
        u.A = H + (size_t)(NTOK + pmc * 256) * 2048; u.B0 = Wt + (size_t)pn * 256 * 2048; u.B1 = u.B0 + (size_t)128 * 2048;
        u.dst = PC + (size_t)slot * CGS + ((size_t)pmc * 256 * DM + (j & 3) * 256) * 2; u.pm = pmc; u.pn = pn; u.e = 0; u.rows = 256; u.t = pmc; return true;
    }
    __device__ __forceinline__ unsigned arow(const gm::Unit&, int r) const { return (unsigned)r; }
    __device__ __forceinline__ void a_ready(const gm::Unit& u) const {
        if (threadIdx.x < 64) {
            unsigned spins = 0;
            while ((unsigned)__builtin_amdgcn_readfirstlane(__hip_atomic_load(cnt + 8 * u.t, __ATOMIC_RELAXED, __HIP_MEMORY_SCOPE_AGENT)) < 16u) {
                __builtin_amdgcn_s_sleep(2);
                if (++spins > (1u << 22)) { if (threadIdx.x == 0) __hip_atomic_store(tmo, 1u, __ATOMIC_RELAXED, __HIP_MEMORY_SCOPE_AGENT); break; } }
            __builtin_amdgcn_fence(__ATOMIC_ACQUIRE, "agent");
            asm volatile("s_waitcnt vmcnt(0)" ::: "memory");
        }
        asm volatile("" ::: "memory"); __builtin_amdgcn_s_barrier(); asm volatile("" ::: "memory");
    }
    __device__ __forceinline__ void done(const gm::Unit&) const {}
};
__device__ __forceinline__ void p1_norm(Frame& F, const Args& a) {
    const float* modp = (const float*)(F.ws + WS_MODP); const float* bmod = a.in[IN_BMOD]; const float* g1 = a.in[IN_G1];
    LAS float* gs = (LAS float*)F.lds; LAS float* sh = gs + DM;
    bf16* H = (bf16*)F.out;
    float* mod = (float*)(F.ws + WS_MOD);
    for (int i = F.bid * NTHR + F.tid; i < 9 * 6144; i += F.G * NTHR) mod[i] = mod_from_partials(modp, bmod, i / 6144, i % 6144);
    if (F.bid >= 128) {
        const int wg = F.bid - 128, b = wg >> 4;
        for (int k = F.tid; k < DM; k += NTHR) { gs[k] = g1[k] * (1.f + mod_from_partials(modp, bmod, b, DM + k)); sh[k] = mod_from_partials(modp, bmod, b, k); }
        __syncthreads();
        norm_rows(F, a.in[IN_X], H, wg * 128, 128, gs, sh);
        __syncthreads();
    } else {
        for (int k = F.tid; k < DM; k += NTHR) { gs[k] = g1[k] * (1.f + mod_from_partials(modp, bmod, 8, DM + k)); sh[k] = mod_from_partials(modp, bmod, 8, k); }
        __syncthreads();
        const int pmc = F.bid >> 4, r0 = pmc * 256 + (F.bid & 15) * 16;
        const __amdgpu_buffer_rsrc_t rs = __builtin_amdgcn_make_buffer_rsrc((void*)(H + (size_t)NTOK * DM), 0, 0x7fffffff, 0x00020000);
#pragma unroll
        for (int q = 0; q < 2; ++q) {
            const int row = r0 + 2 * F.wave + q;
            const f32x4* xr = (const f32x4*)(a.in[IN_CTX] + (size_t)row * DM) + 2 * F.lane;
            f32x4 v[2][2]; float sq = 0.f;
#pragma unroll
            for (int j = 0; j < 2; ++j) { v[j][0] = xr[128 * j]; v[j][1] = xr[128 * j + 1];
                sq += (v[j][0].x * v[j][0].x + v[j][0].y * v[j][0].y) + (v[j][0].z * v[j][0].z + v[j][0].w * v[j][0].w) + (v[j][1].x * v[j][1].x + v[j][1].y * v[j][1].y) + (v[j][1].z * v[j][1].z + v[j][1].w * v[j][1].w); }
            const float rstd = rsqrtf(wave_sum(sq) * (1.f / DM) + EPS);
#pragma unroll
            for (int j = 0; j < 2; ++j) { const int k = 8 * F.lane + 512 * j;
                const f32x4 ga = *(const LAS f32x4*)(gs + k), gb = *(const LAS f32x4*)(gs + k + 4), ha = *(const LAS f32x4*)(sh + k), hb = *(const LAS f32x4*)(sh + k + 4);
                u32x4 w; w.x = pk2(v[j][0].x * rstd * ga.x + ha.x, v[j][0].y * rstd * ga.y + ha.y); w.y = pk2(v[j][0].z * rstd * ga.z + ha.z, v[j][0].w * rstd * ga.w + ha.w);
                w.z = pk2(v[j][1].x * rstd * gb.x + hb.x, v[j][1].y * rstd * gb.y + hb.y); w.w = pk2(v[j][1].z * rstd * gb.z + hb.z, v[j][1].w * rstd * gb.w + hb.w);
                __builtin_amdgcn_raw_buffer_store_b128(w, rs, (unsigned)(((size_t)row * DM + k) * 2), 0, 16); }
        }
        asm volatile("s_waitcnt vmcnt(0)" ::: "memory");
        __syncthreads();
        unsigned* pcnt = F.ctl + CW_PANEL;
        if (F.tid == 0) __hip_atomic_fetch_add(pcnt + 8 * pmc, 1u, __ATOMIC_RELAXED, __HIP_MEMORY_SCOPE_AGENT);
        SchedCtx S{F.bid, (const char*)F.out, (const char*)(F.ws + WS_WIN), (char*)(F.ws + WS_PC), pcnt, F.ctl + 3};
        EpiStoreBf16 E;
        gm::gemm_phase<SchedCtx, EpiStoreBf16, false, true>(F.lds, DM, S, E);
    }
}

constexpr int LRU_T = 128, LRU_NCH = SEQ / LRU_T, UF_LD = 144;
constexpr int LRU_UBF = 0, LRU_UF = 144 * 256;
constexpr float LOG2E = 1.4426950408889634f;

struct LruCoef { float ba, bx, ca; };

struct LruConvW { float w[4][8], bs[8]; };
__device__ __forceinline__ void lru_conv_weights(Frame& F, const Args& a, int h, LruConvW& cwv) {
    const float* cw = a.in[IN_CONVW] + h * 128; const float* cb = a.in[IN_CONVB] + h * 128; const int cg = F.tid & 15;
#pragma unroll
    for (int k = 0; k < 4; ++k) { const f32x4 w0 = *(const f32x4*)(cw + k * DM + 8 * cg), w1 = *(const f32x4*)(cw + k * DM + 8 * cg + 4);
        cwv.w[k][0] = w0.x; cwv.w[k][1] = w0.y; cwv.w[k][2] = w0.z; cwv.w[k][3] = w0.w; cwv.w[k][4] = w1.x; cwv.w[k][5] = w1.y; cwv.w[k][6] = w1.z; cwv.w[k][7] = w1.w; }
    { const f32x4 b0 = *(const f32x4*)(cb + 8 * cg), b1 = *(const f32x4*)(cb + 8 * cg + 4); cwv.bs[0] = b0.x; cwv.bs[1] = b0.y; cwv.bs[2] = b0.z; cwv.bs[3] = b0.w; cwv.bs[4] = b1.x; cwv.bs[5] = b1.y; cwv.bs[6] = b1.z; cwv.bs[7] = b1.w; }
}
__device__ __forceinline__ void lru_conv_load(Frame& F, int b, int h, int c, u32x4 (&raw)[4][4]) {
    const bf16* AX = (const bf16*)(F.ws + WS_P) + (size_t)b * SEQ * DM + h * 128;
    int cg = F.tid & 15, tl0 = F.tid >> 4;
    asm volatile("" : "+v"(cg), "+v"(tl0));
#pragma unroll
    for (int i = 0; i < 4; ++i)
#pragma unroll
        for (int k = 0; k < 4; ++k) { int tt = c * LRU_T + tl0 + 32 * i + k - 2; tt = tt < 0 ? 0 : (tt > SEQ - 1 ? SEQ - 1 : tt); raw[i][k] = *(const u32x4*)(AX + (size_t)tt * DM + 8 * cg); }
}
__device__ __forceinline__ void lru_conv(Frame& F, const LruConvW& cwv, const u32x4 (&raw)[4][4], int b, int h, int c, bool special) {
    LAS unsigned char* ubf = F.lds + LRU_UBF; LAS float* uf = (LAS float*)(F.lds + LRU_UF);
    int cg = F.tid & 15, tl0 = F.tid >> 4;
    asm volatile("" : "+v"(cg), "+v"(tl0));
    const float (&w)[4][8] = cwv.w; const float (&bs)[8] = cwv.bs;
#pragma unroll
    for (int i = 0; i < 4; ++i) { const int tl = tl0 + 32 * i;
        float u[8];
#pragma unroll
        for (int q = 0; q < 8; ++q) u[q] = bs[q];
#pragma unroll
        for (int k = 0; k < 4; ++k) { const int tt = c * LRU_T + tl + k - 2; const float mk = (tt >= 0 && tt < SEQ) ? 1.f : 0.f; const u32x4 v = raw[i][k];
            u[0] += mk * w[k][0] * bflo(v.x); u[1] += mk * w[k][1] * bfhi(v.x); u[2] += mk * w[k][2] * bflo(v.y); u[3] += mk * w[k][3] * bfhi(v.y);
            u[4] += mk * w[k][4] * bflo(v.z); u[5] += mk * w[k][5] * bfhi(v.z); u[6] += mk * w[k][6] * bflo(v.w); u[7] += mk * w[k][7] * bfhi(v.w); }
        *(LAS f32x4*)(uf + tl * UF_LD + 8 * cg) = (f32x4){u[0], u[1], u[2], u[3]};
        *(LAS f32x4*)(uf + tl * UF_LD + 8 * cg + 4) = (f32x4){u[4], u[5], u[6], u[7]};
        u32x4 p; p.x = pk2(u[0], u[1]); p.y = pk2(u[2], u[3]); p.z = pk2(u[4], u[5]); p.w = pk2(u[6], u[7]);
        *(LAS u32x4*)(ubf + tl * 256 + ((cg ^ (tl & 15)) << 4)) = p; }
    if (special) {
        const bf16* AC = (const bf16*)(F.ws + WS_PC) + (size_t)b * CTX * DM + h * 128;
        if (F.tid < 32) { const int tl = LRU_T + (F.tid >> 4); const int t = tl == LRU_T ? 0 : CTX - 1;
            float u[8];
#pragma unroll
            for (int q = 0; q < 8; ++q) u[q] = bs[q];
#pragma unroll
            for (int k = 0; k < 4; ++k) { const int tt = t + k - 2;
                if (tt >= 0 && tt < CTX) { const u32x4 v = *(const u32x4*)(AC + (size_t)tt * DM + 8 * cg);
                    u[0] += w[k][0] * bflo(v.x); u[1] += w[k][1] * bfhi(v.x); u[2] += w[k][2] * bflo(v.y); u[3] += w[k][3] * bfhi(v.y);
                    u[4] += w[k][4] * bflo(v.z); u[5] += w[k][5] * bfhi(v.z); u[6] += w[k][6] * bflo(v.w); u[7] += w[k][7] * bfhi(v.w); } }
            *(LAS f32x4*)(uf + tl * UF_LD + 8 * cg) = (f32x4){u[0], u[1], u[2], u[3]};
            *(LAS f32x4*)(uf + tl * UF_LD + 8 * cg + 4) = (f32x4){u[4], u[5], u[6], u[7]};
            u32x4 p; p.x = pk2(u[0], u[1]); p.y = pk2(u[2], u[3]); p.z = pk2(u[4], u[5]); p.w = pk2(u[6], u[7]);
            *(LAS u32x4*)(ubf + tl * 256 + ((cg ^ (tl & 15)) << 4)) = p;
        } else if (F.tid < 32 + 14 * 16) { const int tl = LRU_T + 2 + ((F.tid - 32) >> 4);
            *(LAS u32x4*)(ubf + tl * 256 + ((cg ^ (tl & 15)) << 4)) = (u32x4){0u, 0u, 0u, 0u}; }
    }
}
__device__ __forceinline__ void lru_load_w(Frame& F, int d, int h, bf16x8 (&Bw)[2][4]) {
    const int fr = F.lane & 15, fq = F.lane >> 4;
#pragma unroll
    for (int which = 0; which < 2; ++which) { const bf16* W = (const bf16*)(F.ws + WS_WLRU) + (size_t)(which * 16 + d * 8 + h) * 128 * 128 + (size_t)(16 * F.wave + fr) * 128 + 8 * fq;
#pragma unroll
        for (int kk = 0; kk < 4; ++kk) Bw[which][kk] = *(const bf16x8*)(W + kk * 32); }
}
__device__ __forceinline__ LruCoef lru_coef(const Args& a, int d, int ch) {
    LruCoef k; k.ba = -LOG2E * a.in[IN_BA][d * DM + ch]; k.bx = -LOG2E * a.in[IN_BX][d * DM + ch];
    const float sp = log1pf(expf(-a.in[IN_LAM][d * DM + ch])); k.ca = -8.f * sp * LOG2E; return k;
}
template <int V = 0> __device__ __forceinline__ void lru_tile(Frame& F, int m, const bf16x8 (&Bw)[2][4], const LruCoef& k, float (&av)[4], float (&bv)[4], int fr_ = -1, int fq_ = -1) {
    const int fr = fr_ < 0 ? (F.lane & 15) : fr_, fq = fq_ < 0 ? (F.lane >> 4) : fq_;
    const LAS unsigned char* ubf = F.lds + LRU_UBF; const LAS float* uf = (const LAS float*)(F.lds + LRU_UF);
    f32x4 ar = {0.f, 0.f, 0.f, 0.f}, ai = {0.f, 0.f, 0.f, 0.f};
    const int row = m * 16 + fr;
#pragma unroll
    for (int kk = 0; kk < 4; ++kk) { const bf16x8 A = *(const LAS bf16x8*)(ubf + row * 256 + (((kk * 4 + fq) ^ fr) << 4));
        ar = __builtin_amdgcn_mfma_f32_16x16x32_bf16(A, Bw[0][kk], ar, 0, 0, 0); ai = __builtin_amdgcn_mfma_f32_16x16x32_bf16(A, Bw[1][kk], ai, 0, 0, 0); }
#pragma unroll
    for (int r = 0; r < 4; ++r) { const float u = uf[(m * 16 + 4 * fq + r) * UF_LD + 16 * F.wave + fr];
        if (V == 2) { av[r] = __builtin_fmaf(ar[r], -LOG2E, k.ba) * k.ca; bv[r] = __builtin_fmaf(ai[r], -LOG2E, k.bx) * u; continue; }
        const float rg = __builtin_amdgcn_rcpf(1.f + __builtin_amdgcn_exp2f(__builtin_fmaf(ar[r], -LOG2E, k.ba)));
        const float ig = __builtin_amdgcn_rcpf(1.f + __builtin_amdgcn_exp2f(__builtin_fmaf(ai[r], -LOG2E, k.bx)));
        const float aa = __builtin_amdgcn_exp2f(k.ca * rg);
        av[r] = aa; bv[r] = __builtin_amdgcn_sqrtf(__builtin_fmaf(-aa, aa, 1.f)) * (ig * u); }
}
template <bool FWD, int V = 0> __device__ __forceinline__ void lru_tile_total(int fq, float& A, float& B) {
    if (V == 1) return;
#pragma unroll
    for (int s = 0; s < 2; ++s) { const int bit = 1 << s; const float Ap = __shfl_xor(A, 16 << s), Bp = __shfl_xor(B, 16 << s);
        const bool mine_first = FWD ? ((fq & bit) == 0) : ((fq & bit) != 0);
        if (mine_first) { B = B * Ap + Bp; A = A * Ap; } else { B = Bp * A + B; A = Ap * A; } }
}

template <int V = 0> __device__ __forceinline__ void lru_phase1(Frame& F, const Args& a, float* agg_base) {
    const int NU = NB * 8 * LRU_NCH;
    if (F.bid >= NU) return;
    const int fr = F.lane & 15, fq = F.lane >> 4;
    const int h = (F.bid >> 4) & 7; const int ch = h * 128 + 16 * F.wave + fr;
    const LruCoef k0 = lru_coef(a, 0, ch), k1 = lru_coef(a, 1, ch);
    for (int unit = F.bid; unit < NU; unit += F.G) {
        const int c = unit & (LRU_NCH - 1), b = unit >> 7;
        bf16x8 Bw0[2][4], Bw1[2][4]; lru_load_w(F, 0, h, Bw0); lru_load_w(F, 1, h, Bw1);
        { u32x4 raw[4][4]; lru_conv_load(F, b, h, c, raw); LruConvW cwv; lru_conv_weights(F, a, h, cwv); lru_conv(F, cwv, raw, b, h, c, c == 0 && V == 0); }
        LDS_WAIT(); __syncthreads();
        float Af = 1.f, Hf = 0.f, Ab = 1.f, Hb = 0.f;
#pragma unroll 2
        for (int m = 0; m < 8; ++m) {
            float av[4], bv[4];
            lru_tile<V>(F, m, Bw0, k0, av, bv);
            float A = av[0] * av[1] * av[2] * av[3], B = ((bv[0] * av[1] + bv[1]) * av[2] + bv[2]) * av[3] + bv[3];
            lru_tile_total<true, V>(fq, A, B);
            Hf = Hf * A + B; Af = Af * A;
            lru_tile<V>(F, m, Bw1, k1, av, bv);
            A = av[0] * av[1] * av[2] * av[3]; B = ((bv[3] * av[2] + bv[2]) * av[1] + bv[1]) * av[0] + bv[0];
            lru_tile_total<false, V>(fq, A, B);
            Hb = B * Ab + Hb; Ab = A * Ab;
        }
        float* agg = agg_base;
        if (fq == 0) { *(f32x2*)(agg + ((size_t)((b * LRU_NCH + c) * 2 + 0) * DM + ch) * 2) = (f32x2){Af, Hf};
                       *(f32x2*)(agg + ((size_t)((b * LRU_NCH + c) * 2 + 1) * DM + ch) * 2) = (f32x2){Ab, Hb}; }
        if (c == 0 && V == 0) {
            float av[4], bv[4]; float* s0 = (float*)(F.ws + WS_LRUS0);
            lru_tile(F, 8, Bw0, k0, av, bv); if (fq == 0) s0[(b * 2 + 0) * DM + ch] = bv[0];
            lru_tile(F, 8, Bw1, k1, av, bv); if (fq == 0) s0[(b * 2 + 1) * DM + ch] = bv[1];
        }
        __syncthreads();
    }
}

__device__ __forceinline__ void lru_pass2(Frame& F, const Args& a, int unit, const LruCoef& kf, const LruCoef& kb) {
    const int c = unit & (LRU_NCH - 1), h = (unit >> 4) & 7, b = unit >> 7;
    const int fr = F.lane & 15, fq = F.lane >> 4; const int ch = h * 128 + 16 * F.wave + fr;
    const float* agg = (const float*)(F.ws + WS_LRUAGG); const float* s0 = (const float*)(F.ws + WS_LRUS0);
    f32x2 ag[LRU_NCH];
#pragma unroll
    for (int j = 0; j < LRU_NCH; ++j) ag[j] = *(const f32x2*)(agg + ((size_t)((b * LRU_NCH + j) * 2 + (j < c ? 0 : 1)) * DM + ch) * 2);
    float hf = s0[(b * 2 + 0) * DM + ch], hb = s0[(b * 2 + 1) * DM + ch];
    bf16* AY = (bf16*)(F.ws + WS_YAG) + ((size_t)b * SEQ + c * LRU_T) * DM + h * 128;
    u32x4 ayv[4];
#pragma unroll
    for (int i = 0; i < 4; ++i) ayv[i] = *(const u32x4*)(AY + (size_t)((F.tid >> 4) + 32 * i) * DM + 8 * (F.tid & 15));
    bf16x8 Bw[2][4], Bw1[2][4]; lru_load_w(F, 0, h, Bw);
    LruCoef k = kf; const LruCoef k1 = kb;
    { u32x4 raw[4][4]; lru_conv_load(F, b, h, c, raw); LruConvW cwv; lru_conv_weights(F, a, h, cwv); lru_conv(F, cwv, raw, b, h, c, false); }
    lru_load_w(F, 1, h, Bw1);
#pragma unroll
    for (int j = 0; j < LRU_NCH; ++j) if (j < c) hf = ag[j].x * hf + ag[j].y;
#pragma unroll
    for (int j = LRU_NCH - 1; j >= 0; --j) if (j > c) hb = ag[j].x * hb + ag[j].y;
    LDS_WAIT(); __syncthreads();
    float hfv[8][4];
#pragma unroll
    for (int m = 0; m < 8; ++m) {
        float av[4], bv[4];
        lru_tile(F, m, Bw, k, av, bv);
        const float A = av[0] * av[1] * av[2] * av[3], B = ((bv[0] * av[1] + bv[1]) * av[2] + bv[2]) * av[3] + bv[3];
        float hin = hf;
#pragma unroll
        for (int g = 0; g < 4; ++g) { const float Ag = __shfl(A, g * 16 + fr), Bg = __shfl(B, g * 16 + fr); if (g < fq) hin = Ag * hin + Bg; hf = Ag * hf + Bg; }
#pragma unroll
        for (int r = 0; r < 4; ++r) { hin = av[r] * hin + bv[r]; hfv[m][r] = hin; }
    }
    k = k1;
    LAS float* uf = (LAS float*)(F.lds + LRU_UF);
#pragma unroll
    for (int m = 7; m >= 0; --m) {
        float av[4], bv[4];
        lru_tile(F, m, Bw1, k, av, bv);
        const float A = av[0] * av[1] * av[2] * av[3], B = ((bv[3] * av[2] + bv[2]) * av[1] + bv[1]) * av[0] + bv[0];
        float hin = hb;
#pragma unroll
        for (int g = 3; g >= 0; --g) { const float Ag = __shfl(A, g * 16 + fr), Bg = __shfl(B, g * 16 + fr); if (g > fq) hin = Ag * hin + Bg; hb = Ag * hb + Bg; }
#pragma unroll
        for (int r = 3; r >= 0; --r) { hin = av[r] * hin + bv[r]; uf[(m * 16 + 4 * fq + r) * UF_LD + 16 * F.wave + fr] = hfv[m][r] + hin; }
    }
    LDS_WAIT(); __syncthreads();
    const int cg = F.tid & 15;
#pragma unroll
    for (int i = 0; i < 4; ++i) { const int tl = (F.tid >> 4) + 32 * i;
        const f32x4 y0 = *(const LAS f32x4*)(uf + tl * UF_LD + 8 * cg), y1 = *(const LAS f32x4*)(uf + tl * UF_LD + 8 * cg + 4);
        const u32x4 g = ayv[i];
        u32x4 o; o.x = pk2(y0.x * gelu_tanh(bflo(g.x)), y0.y * gelu_tanh(bfhi(g.x))); o.y = pk2(y0.z * gelu_tanh(bflo(g.y)), y0.w * gelu_tanh(bfhi(g.y)));
        o.z = pk2(y1.x * gelu_tanh(bflo(g.z)), y1.y * gelu_tanh(bfhi(g.z))); o.w = pk2(y1.z * gelu_tanh(bflo(g.w)), y1.w * gelu_tanh(bfhi(g.w)));
        *(u32x4*)(AY + (size_t)tl * DM + 8 * cg) = o; }
    __syncthreads();
}

constexpr int LRU_PRIV = LRU_UF;
__device__ __forceinline__ void lru_conv_b(Frame& F, const LruConvW& cwv, const u32x4 (&raw)[4][4], int b, int h, int c, bool special) {
    LAS unsigned char* ubf = F.lds + LRU_UBF;
    int cg = F.tid & 15, tl0 = F.tid >> 4;
    asm volatile("" : "+v"(cg), "+v"(tl0));
    const float (&w)[4][8] = cwv.w; const float (&bs)[8] = cwv.bs;
#pragma unroll
    for (int i = 0; i < 4; ++i) { const int tl = tl0 + 32 * i;
        float u[8];
#pragma unroll
        for (int q = 0; q < 8; ++q) u[q] = bs[q];
#pragma unroll
        for (int k = 0; k < 4; ++k) { const int tt = c * LRU_T + tl + k - 2; const float mk = (tt >= 0 && tt < SEQ) ? 1.f : 0.f; const u32x4 v = raw[i][k];
            u[0] += mk * w[k][0] * bflo(v.x); u[1] += mk * w[k][1] * bfhi(v.x); u[2] += mk * w[k][2] * bflo(v.y); u[3] += mk * w[k][3] * bfhi(v.y);
            u[4] += mk * w[k][4] * bflo(v.z); u[5] += mk * w[k][5] * bfhi(v.z); u[6] += mk * w[k][6] * bflo(v.w); u[7] += mk * w[k][7] * bfhi(v.w); }
        u32x4 p; p.x = pk2(u[0], u[1]); p.y = pk2(u[2], u[3]); p.z = pk2(u[4], u[5]); p.w = pk2(u[6], u[7]);
        *(LAS u32x4*)(ubf + tl * 256 + ((cg ^ (tl & 15)) << 4)) = p; }
    if (special) {
        const bf16* AC = (const bf16*)(F.ws + WS_PC) + (size_t)b * CTX * DM + h * 128;
        if (F.tid < 32) { const int tl = LRU_T + (F.tid >> 4); const int t = tl == LRU_T ? 0 : CTX - 1;
            float u[8];
#pragma unroll
            for (int q = 0; q < 8; ++q) u[q] = bs[q];
#pragma unroll
            for (int k = 0; k < 4; ++k) { const int tt = t + k - 2;
                if (tt >= 0 && tt < CTX) { const u32x4 v = *(const u32x4*)(AC + (size_t)tt * DM + 8 * cg);
                    u[0] += w[k][0] * bflo(v.x); u[1] += w[k][1] * bfhi(v.x); u[2] += w[k][2] * bflo(v.y); u[3] += w[k][3] * bfhi(v.y);
                    u[4] += w[k][4] * bflo(v.z); u[5] += w[k][5] * bfhi(v.z); u[6] += w[k][6] * bflo(v.w); u[7] += w[k][7] * bfhi(v.w); } }
            u32x4 p; p.x = pk2(u[0], u[1]); p.y = pk2(u[2], u[3]); p.z = pk2(u[4], u[5]); p.w = pk2(u[6], u[7]);
            *(LAS u32x4*)(ubf + tl * 256 + ((cg ^ (tl & 15)) << 4)) = p;
        } else if (F.tid < 32 + 14 * 16) { const int tl = LRU_T + 2 + ((F.tid - 32) >> 4);
            *(LAS u32x4*)(ubf + tl * 256 + ((cg ^ (tl & 15)) << 4)) = (u32x4){0u, 0u, 0u, 0u}; }
    }
}
__device__ __forceinline__ void lru_tile_b(Frame& F, int m, const bf16x8 (&Bw)[2][4], const LruCoef& k, float (&av)[4], float (&bv)[4]) {
    const int fr = F.lane & 15, fq = F.lane >> 4;
    const LAS unsigned char* ubf = F.lds + LRU_UBF;
    f32x4 ar = {0.f, 0.f, 0.f, 0.f}, ai = {0.f, 0.f, 0.f, 0.f};
    const int row = m * 16 + fr;
#pragma unroll
    for (int kk = 0; kk < 4; ++kk) { const bf16x8 A = *(const LAS bf16x8*)(ubf + row * 256 + (((kk * 4 + fq) ^ fr) << 4));
        ar = __builtin_amdgcn_mfma_f32_16x16x32_bf16(A, Bw[0][kk], ar, 0, 0, 0); ai = __builtin_amdgcn_mfma_f32_16x16x32_bf16(A, Bw[1][kk], ai, 0, 0, 0); }
    const int n = 16 * F.wave + fr;
#pragma unroll
    for (int r = 0; r < 4; ++r) { const int tr = m * 16 + 4 * fq + r;
        const float u = bf2f(*(const LAS unsigned short*)(ubf + tr * 256 + (((n >> 3) ^ (tr & 15)) << 4) + (n & 7) * 2));
        const float rg = __builtin_amdgcn_rcpf(1.f + __builtin_amdgcn_exp2f(__builtin_fmaf(ar[r], -LOG2E, k.ba)));
        const float ig = __builtin_amdgcn_rcpf(1.f + __builtin_amdgcn_exp2f(__builtin_fmaf(ai[r], -LOG2E, k.bx)));
        const float aa = __builtin_amdgcn_exp2f(k.ca * rg);
        av[r] = aa; bv[r] = __builtin_amdgcn_sqrtf(__builtin_fmaf(-aa, aa, 1.f)) * (ig * u); }
}
__device__ __forceinline__ void lru_unit(Frame& F, const Args& a, int unit, const LruCoef& kf, const LruCoef& kb) {
    const int c = unit & (LRU_NCH - 1), h = (unit >> 4) & 7, b = unit >> 7, grp = unit >> 4;
    const int fr = F.lane & 15, fq = F.lane >> 4; const int ch = h * 128 + 16 * F.wave + fr;
    bf16* AY = (bf16*)(F.ws + WS_YAG) + ((size_t)b * SEQ + c * LRU_T) * DM + h * 128;
    bf16x8 Bw[2][4]; lru_load_w(F, 0, h, Bw);
    { u32x4 raw[4][4]; lru_conv_load(F, b, h, c, raw); LruConvW cwv; lru_conv_weights(F, a, h, cwv); lru_conv_b(F, cwv, raw, b, h, c, c == 0); }
    LAS unsigned char* priv = F.lds + LRU_PRIV + F.tid * 8;
    LDS_WAIT(); __syncthreads();
    float hf = 0.f, pf = 1.f, s0f = 0.f, s0b = 0.f;
#pragma unroll 2
    for (int m = 0; m < 8; ++m) {
        float av[4], bv[4];
        lru_tile_b(F, m, Bw, kf, av, bv);
        const float A = av[0] * av[1] * av[2] * av[3], B = ((bv[0] * av[1] + bv[1]) * av[2] + bv[2]) * av[3] + bv[3];
        float hin = hf, pin = pf;
#pragma unroll
        for (int g = 0; g < 4; ++g) { const float Ag = __shfl(A, g * 16 + fr), Bg = __shfl(B, g * 16 + fr); if (g < fq) { hin = Ag * hin + Bg; pin = Ag * pin; } hf = Ag * hf + Bg; pf = Ag * pf; }
        float pt[4], ht[4];
#pragma unroll
        for (int r = 0; r < 4; ++r) { hin = av[r] * hin + bv[r]; pin = av[r] * pin; ht[r] = hin; pt[r] = pin; }
        *(LAS u32x2*)(priv + m * 4096) = (u32x2){pk2(ht[0], ht[1]), pk2(ht[2], ht[3])};
        *(LAS u32x2*)(priv + 32768 + m * 4096) = (u32x2){pk2(pt[0], pt[1]), pk2(pt[2], pt[3])};
    }
    if (c == 0) { float av[4], bv[4]; lru_tile_b(F, 8, Bw, kf, av, bv); s0f = bv[0]; }
    lru_load_w(F, 1, h, Bw);
    float hb = 0.f, pbw = 1.f;
#pragma unroll 2
    for (int m = 7; m >= 0; --m) {
        float av[4], bv[4];
        lru_tile_b(F, m, Bw, kb, av, bv);
        const float A = av[0] * av[1] * av[2] * av[3], B = ((bv[3] * av[2] + bv[2]) * av[1] + bv[1]) * av[0] + bv[0];
        float hin = hb, pin = pbw;
#pragma unroll
        for (int g = 3; g >= 0; --g) { const float Ag = __shfl(A, g * 16 + fr), Bg = __shfl(B, g * 16 + fr); if (g > fq) { hin = Ag * hin + Bg; pin = Ag * pin; } hb = Ag * hb + Bg; pbw = Ag * pbw; }
        const u32x2 hfw = *(const LAS u32x2*)(priv + m * 4096);
        const float hfv[4] = {bflo(hfw.x), bfhi(hfw.x), bflo(hfw.y), bfhi(hfw.y)};
        float pt[4], ht[4];
#pragma unroll
        for (int r = 3; r >= 0; --r) { hin = av[r] * hin + bv[r]; pin = av[r] * pin; ht[r] = hin + hfv[r]; pt[r] = pin; }
        *(LAS u32x2*)(priv + m * 4096) = (u32x2){pk2(ht[0], ht[1]), pk2(ht[2], ht[3])};
        *(LAS u32x2*)(priv + 65536 + m * 4096) = (u32x2){pk2(pt[0], pt[1]), pk2(pt[2], pt[3])};
    }
    if (c == 0) { float av[4], bv[4]; lru_tile_b(F, 8, Bw, kb, av, bv); s0b = bv[1]; }
    float* agg = (float*)(F.ws + WS_LRUAGG); float* s0 = (float*)(F.ws + WS_LRUS0);
    if (fq == 0) {
        __hip_atomic_store((unsigned long long*)(agg + ((size_t)((b * LRU_NCH + c) * 2 + 0) * DM + ch) * 2), ((unsigned long long)__builtin_bit_cast(unsigned, hf) << 32) | __builtin_bit_cast(unsigned, pf), __ATOMIC_RELAXED, __HIP_MEMORY_SCOPE_AGENT);
        __hip_atomic_store((unsigned long long*)(agg + ((size_t)((b * LRU_NCH + c) * 2 + 1) * DM + ch) * 2), ((unsigned long long)__builtin_bit_cast(unsigned, hb) << 32) | __builtin_bit_cast(unsigned, pbw), __ATOMIC_RELAXED, __HIP_MEMORY_SCOPE_AGENT);
        if (c == 0) { __hip_atomic_store((unsigned*)(s0 + (b * 2 + 0) * DM + ch), __builtin_bit_cast(unsigned, s0f), __ATOMIC_RELAXED, __HIP_MEMORY_SCOPE_AGENT);
                      __hip_atomic_store((unsigned*)(s0 + (b * 2 + 1) * DM + ch), __builtin_bit_cast(unsigned, s0b), __ATOMIC_RELAXED, __HIP_MEMORY_SCOPE_AGENT); }
    }
    asm volatile("s_waitcnt vmcnt(0)" ::: "memory");
    __syncthreads();
    unsigned* gcnt = F.ctl + CW_LRUG + 8 * grp;
    if (F.tid == 0) __hip_atomic_fetch_add(gcnt, 1u, __ATOMIC_RELAXED, __HIP_MEMORY_SCOPE_AGENT);
    u32x4 ayv[4];
#pragma unroll
    for (int i = 0; i < 4; ++i) ayv[i] = *(const u32x4*)(AY + (size_t)((F.tid >> 4) + 32 * i) * DM + 8 * (F.tid & 15));
    if (F.wave == 0) {
        unsigned spins = 0;
        while ((unsigned)__builtin_amdgcn_readfirstlane(__hip_atomic_load(gcnt, __ATOMIC_RELAXED, __HIP_MEMORY_SCOPE_AGENT)) < (unsigned)LRU_NCH) {
            __builtin_amdgcn_s_sleep(2);
            if (++spins > (1u << 22)) { if (F.tid == 0) __hip_atomic_store(F.ctl + 3, 2u, __ATOMIC_RELAXED, __HIP_MEMORY_SCOPE_AGENT); break; } }
        __builtin_amdgcn_fence(__ATOMIC_ACQUIRE, "agent");
        asm volatile("s_waitcnt vmcnt(0)" ::: "memory");
    }
    __syncthreads();
    float cf = s0[(b * 2 + 0) * DM + ch], cb = s0[(b * 2 + 1) * DM + ch];
    {
        f32x2 ag[LRU_NCH];
#pragma unroll
        for (int j = 0; j < LRU_NCH; ++j) ag[j] = *(const f32x2*)(agg + ((size_t)((b * LRU_NCH + j) * 2 + (j < c ? 0 : 1)) * DM + ch) * 2);
#pragma unroll
        for (int j = 0; j < LRU_NCH; ++j) if (j < c) cf = ag[j].x * cf + ag[j].y;
#pragma unroll
        for (int j = LRU_NCH - 1; j >= 0; --j) if (j > c) cb = ag[j].x * cb + ag[j].y;
    }
    { LAS unsigned char* ya = F.lds + LRU_UBF; const int n = 16 * F.wave + fr;
#pragma unroll 2
      for (int m = 0; m < 8; ++m) {
          const u32x2 hw = *(const LAS u32x2*)(priv + m * 4096), pfw = *(const LAS u32x2*)(priv + 32768 + m * 4096), pbw2 = *(const LAS u32x2*)(priv + 65536 + m * 4096);
          const float y0 = bflo(hw.x) + bflo(pfw.x) * cf + bflo(pbw2.x) * cb, y1 = bfhi(hw.x) + bfhi(pfw.x) * cf + bfhi(pbw2.x) * cb;
          const float y2 = bflo(hw.y) + bflo(pfw.y) * cf + bflo(pbw2.y) * cb, y3 = bfhi(hw.y) + bfhi(pfw.y) * cf + bfhi(pbw2.y) * cb;
          const unsigned w01 = pk2(y0, y1), w23 = pk2(y2, y3);
          const int t0 = m * 16 + 4 * fq;
          *(LAS unsigned short*)(ya + (t0 + 0) * 256 + (((n >> 3) ^ ((t0 + 0) & 15)) << 4) + (n & 7) * 2) = (unsigned short)w01;
          *(LAS unsigned short*)(ya + (t0 + 1) * 256 + (((n >> 3) ^ ((t0 + 1) & 15)) << 4) + (n & 7) * 2) = (unsigned short)(w01 >> 16);
          *(LAS unsigned short*)(ya + (t0 + 2) * 256 + (((n >> 3) ^ ((t0 + 2) & 15)) << 4) + (n & 7) * 2) = (unsigned short)w23;
          *(LAS unsigned short*)(ya + (t0 + 3) * 256 + (((n >> 3) ^ ((t0 + 3) & 15)) << 4) + (n & 7) * 2) = (unsigned short)(w23 >> 16); } }
    LDS_WAIT(); __syncthreads();
    const int cg = F.tid & 15;
#pragma unroll
    for (int i = 0; i < 4; ++i) { const int tl = (F.tid >> 4) + 32 * i;
        const u32x4 y = *(const LAS u32x4*)(F.lds + LRU_UBF + tl * 256 + ((cg ^ (tl & 15)) << 4));
        const u32x4 g = ayv[i];
        u32x4 o; o.x = pk2(bflo(y.x) * gelu_tanh(bflo(g.x)), bfhi(y.x) * gelu_tanh(bfhi(g.x))); o.y = pk2(bflo(y.y) * gelu_tanh(bflo(g.y)), bfhi(y.y) * gelu_tanh(bfhi(g.y)));
        o.z = pk2(bflo(y.z) * gelu_tanh(bflo(g.z)), bfhi(y.z) * gelu_tanh(bfhi(g.z))); o.w = pk2(bflo(y.w) * gelu_tanh(bflo(g.w)), bfhi(y.w) * gelu_tanh(bfhi(g.w)));
        *(u32x4*)(AY + (size_t)tl * DM + 8 * cg) = o; }
    __syncthreads();
}
constexpr int HG_C = 64, HG_SEG = 512, HG_NSEG = 4;
constexpr int HG_QS = 0, HG_QM = 16384, HG_KM = 32768, HG_KDT = 49152, HG_VT = 65536, HG_ATT = 81920, HG_PART = 90112, HG_ETOT = 94208, HG_ROWS = 94720;
constexpr size_t HGS_IMG = 65536;
#ifdef PROBE_A
#define HSTAMP(i) do { if (F.bid == 0 && F.tid == 0) { const unsigned long long _t = __builtin_amdgcn_s_memrealtime(); const unsigned long long _p = ((unsigned long long)F.MISC[101] << 32) | F.MISC[100]; \
    unsigned long long _a = ((unsigned long long)F.MISC[103 + 2 * (i)] << 32) | F.MISC[102 + 2 * (i)]; _a += _t - _p; F.MISC[102 + 2 * (i)] = (unsigned)_a; F.MISC[103 + 2 * (i)] = (unsigned)(_a >> 32); F.MISC[100] = (unsigned)_t; F.MISC[101] = (unsigned)(_t >> 32); } } while (0)
#else
#define HSTAMP(i) do { } while (0)
#endif

__device__ __forceinline__ int hg_row(int b, int dir, bool ctx, int sigma) {
    if (ctx) { const int t = dir ? (CTX - 1 - sigma) : sigma; return b * CTX + t; }
    const int p = dir ? (SEQ - 1 - sigma) : sigma; return b * SEQ + (p & 31) * 64 + (p >> 5);
}

struct HgRaw { unsigned f[8], v[8], q[8]; };
template <bool FULL>
__device__ __forceinline__ void hg_load(Frame& F, const bf16* Qb, const bf16* Fb, const bf16* Vb, int b, int dir, bool ctx, int sigma0, HgRaw& r) {
    const long step = (long)(ctx ? 1 : 64) * (dir ? -1 : 1) * DM;
    const size_t ro = (size_t)hg_row(b, dir, ctx, sigma0 + 8 * F.wave) * DM + 2 * F.lane;
    const bf16* fp = Fb + ro; const bf16* vp = Vb + ro; const bf16* qp = Qb + ro;
#pragma unroll
    for (int j = 0; j < 8; ++j) { r.f[j] = *(const unsigned*)(fp + j * step); r.v[j] = *(const unsigned*)(vp + j * step); if (FULL) r.q[j] = *(const unsigned*)(qp + j * step); }
}
template <bool FULL>
__device__ __forceinline__ void hg_prep(Frame& F, const HgRaw& raw, int b, int dir, bool ctx, int sigma0, float lb0, float lb1, float& gs0, float& gs1) {
    const int kp = F.lane, to = F.wave;
    const unsigned (&fw)[8] = raw.f; const unsigned (&qw)[8] = raw.q; const unsigned (&vw)[8] = raw.v;
    float c0[8], c1[8], k0[8], k1[8];
    float a0 = 0.f, a1 = 0.f;
#pragma unroll
    for (int j = 0; j < 8; ++j) {
        const float g0 = lb0 + (1.f - lb0) * __builtin_amdgcn_rcpf(1.f + __builtin_amdgcn_exp2f(-bflo(fw[j]) * LOG2E));
        const float g1 = lb1 + (1.f - lb1) * __builtin_amdgcn_rcpf(1.f + __builtin_amdgcn_exp2f(-bfhi(fw[j]) * LOG2E));
        k0[j] = 1.f - g0; k1[j] = 1.f - g1;
        a0 += __builtin_amdgcn_logf(g0); a1 += __builtin_amdgcn_logf(g1);
        c0[j] = a0; c1[j] = a1; }
    LAS float* part = (LAS float*)(F.lds + HG_PART);
    *(LAS f32x2*)(part + to * 128 + 2 * kp) = (f32x2){a0, a1};
    if (FULL) HSTAMP(0);
    LDS_WAIT(); __syncthreads();
    if (FULL) HSTAMP(1);
    if (FULL && F.tid < HG_C) ((LAS int*)(F.lds + HG_ROWS))[F.tid] = hg_row(b, dir, ctx, sigma0 + F.tid);
    float off0 = 0.f, off1 = 0.f, tot0 = 0.f, tot1 = 0.f;
#pragma unroll
    for (int o = 0; o < 8; ++o) { const f32x2 p = *(const LAS f32x2*)(part + o * 128 + 2 * kp);
        if (o < to) { off0 += p.x; off1 += p.y; } tot0 += p.x; tot1 += p.y; }
    gs0 += tot0; gs1 += tot1;
    if (to == 0) *(LAS f32x2*)((LAS float*)(F.lds + HG_ETOT) + 2 * kp) = (f32x2){__builtin_amdgcn_exp2f(tot0), __builtin_amdgcn_exp2f(tot1)};
    float kd0[8], kd1[8];
#pragma unroll
    for (int j = 0; j < 8; ++j) {
        const float E0 = __builtin_amdgcn_exp2f(off0 + c0[j]), E1 = __builtin_amdgcn_exp2f(off1 + c1[j]);
        kd0[j] = k0[j] * __builtin_amdgcn_rcpf(E0); kd1[j] = k1[j] * __builtin_amdgcn_rcpf(E1);
        if (FULL) {
            const float q0 = bflo(qw[j]), q1 = bfhi(qw[j]);
            const float s0 = q0 * __builtin_amdgcn_rcpf(1.f + __builtin_amdgcn_exp2f(-q0 * LOG2E)) * E0, s1 = q1 * __builtin_amdgcn_rcpf(1.f + __builtin_amdgcn_exp2f(-q1 * LOG2E)) * E1;
            const int c = 8 * to + j; const int off = c * 256 + ((4 * kp) ^ ((c & 15) << 4));
            *(LAS unsigned*)(F.lds + HG_QS + off) = pk2(s0, s1);
            *(LAS unsigned*)(F.lds + HG_KM + off) = pk2(kd0[j], kd1[j]);
        }
    }
    { const int sw = ((to ^ (kp & 7)) << 4);
      u32x4 w0, w1; w0.x = pk2(kd0[0], kd0[1]); w0.y = pk2(kd0[2], kd0[3]); w0.z = pk2(kd0[4], kd0[5]); w0.w = pk2(kd0[6], kd0[7]);
      w1.x = pk2(kd1[0], kd1[1]); w1.y = pk2(kd1[2], kd1[3]); w1.z = pk2(kd1[4], kd1[5]); w1.w = pk2(kd1[6], kd1[7]);
      *(LAS u32x4*)(F.lds + HG_KDT + (2 * kp) * 128 + sw) = w0; *(LAS u32x4*)(F.lds + HG_KDT + (2 * kp + 1) * 128 + sw) = w1;
      u32x4 v0, v1;
      v0.x = (vw[0] & 0xffffu) | (vw[1] << 16); v0.y = (vw[2] & 0xffffu) | (vw[3] << 16); v0.z = (vw[4] & 0xffffu) | (vw[5] << 16); v0.w = (vw[6] & 0xffffu) | (vw[7] << 16);
      v1.x = (vw[0] >> 16) | (vw[1] & 0xffff0000u); v1.y = (vw[2] >> 16) | (vw[3] & 0xffff0000u); v1.z = (vw[4] >> 16) | (vw[5] & 0xffff0000u); v1.w = (vw[6] >> 16) | (vw[7] & 0xffff0000u);
      *(LAS u32x4*)(F.lds + HG_VT + (2 * kp) * 128 + sw) = v0; *(LAS u32x4*)(F.lds + HG_VT + (2 * kp + 1) * 128 + sw) = v1; }
    if (FULL) HSTAMP(2);
    LDS_WAIT(); __syncthreads();
    if (FULL) HSTAMP(3);
}
__device__ __forceinline__ void hg_state_update(Frame& F, f32x4 (&St)[8], const bf16x8 (&vt)[2]) {
    const int fr = F.lane & 15, fq = F.lane >> 4;
    const LAS float* etot = (const LAS float*)(F.lds + HG_ETOT);
#pragma unroll
    for (int kt = 0; kt < 8; ++kt) { const f32x4 e = *(const LAS f32x4*)(etot + 16 * kt + 4 * fq);
        const int rk = 16 * kt + fr;
#pragma unroll
        for (int ks = 0; ks < 2; ++ks) { const bf16x8 A = *(const LAS bf16x8*)(F.lds + HG_KDT + rk * 128 + (((4 * ks + fq) ^ ((rk >> 1) & 7)) << 4));
            St[kt] = __builtin_amdgcn_mfma_f32_16x16x32_bf16(A, vt[ks], St[kt], 0, 0, 0); }
        St[kt] = St[kt] * e; }
}
__device__ __forceinline__ void hg_load_vt(Frame& F, bf16x8 (&vt)[2]) {
    const int fr = F.lane & 15, fq = F.lane >> 4; const int rv = 16 * F.wave + fr;
#pragma unroll
    for (int ks = 0; ks < 2; ++ks) vt[ks] = *(const LAS bf16x8*)(F.lds + HG_VT + rv * 128 + (((4 * ks + fq) ^ ((rv >> 1) & 7)) << 4));
}
struct HgPtrs { const bf16* Q; const bf16* Fx; const bf16* V; const bf16* Fc; const bf16* Vc; bf16* O; };
__device__ __forceinline__ HgPtrs hg_ptrs(Frame& F, int h, int dir) {
    HgPtrs p; p.Q = (const bf16*)(F.ws + WS_P + 2 * GS) + h * 128; p.Fx = (const bf16*)(F.ws + WS_P + (dir ? 4 : 3) * GS) + h * 128; p.V = (const bf16*)(F.ws + WS_P + 5 * GS) + h * 128;
    p.Fc = (const bf16*)(F.ws + WS_PC + (dir ? 2 : 1) * CGS) + h * 128; p.Vc = (const bf16*)(F.ws + WS_PC + 3 * CGS) + h * 128; p.O = (bf16*)(F.ws + WS_P + (dir ? 4 : 3) * GS) + h * 128; return p;
}
__device__ __forceinline__ void hg_lb(const Args& a, int h, int kp, float& lb0, float& lb1) {
    const float* t = a.in[IN_HGLB] + h * 128 + 2 * kp; lb0 = 1.f / (1.f + expf(t[DM] - t[0])); lb1 = 1.f / (1.f + expf(t[DM + 1] - t[1]));
}
__device__ __forceinline__ float* hg_img(Frame& F, int b, int h, int dir, int slot) { return (float*)((unsigned char*)F.out + (size_t)((((b * 8 + h) * 2 + dir) * 4) + slot) * HGS_IMG); }

__device__ __forceinline__ void hg_pass1(Frame& F, const Args& a, int unit) {
    const int slot = unit & 3, dir = (unit >> 2) & 1, h = (unit >> 3) & 7, b = unit >> 6;
    const int fr = F.lane & 15, fq = F.lane >> 4;
    const HgPtrs P = hg_ptrs(F, h, dir);
    float lb0, lb1; hg_lb(a, h, F.lane, lb0, lb1);
    f32x4 St[8];
#pragma unroll
    for (int kt = 0; kt < 8; ++kt) St[kt] = (f32x4){0.f, 0.f, 0.f, 0.f};
    const bool ctx = slot == 0; const int nchunk = ctx ? CTX / HG_C : HG_SEG / HG_C; const int sig0 = ctx ? 0 : (slot - 1) * HG_SEG;
    float gs0 = 0.f, gs1 = 0.f;
    const bf16* Fsrc = ctx ? P.Fc : P.Fx; const bf16* Vsrc = ctx ? P.Vc : P.V;
    HgRaw cur; hg_load<false>(F, P.Q, Fsrc, Vsrc, b, dir, ctx, sig0, cur);
    for (int ck = 0; ck < nchunk; ++ck) {
        HgRaw nxt; { const int cn = ck + 1 < nchunk ? ck + 1 : ck; hg_load<false>(F, P.Q, Fsrc, Vsrc, b, dir, ctx, sig0 + cn * HG_C, nxt); }
        hg_prep<false>(F, cur, b, dir, ctx, sig0 + ck * HG_C, lb0, lb1, gs0, gs1);
        cur = nxt;
        bf16x8 vt[2]; hg_load_vt(F, vt);
        hg_state_update(F, St, vt);
    }
    float* img = hg_img(F, b, h, dir, slot) + (size_t)(16 * F.wave + fr) * 128 + 4 * fq;
#pragma unroll
    for (int kt = 0; kt < 8; ++kt) *(f32x4*)(img + 16 * kt) = St[kt];
    if (!ctx && F.wave == 0) { float* D = (float*)(F.ws + WS_HGD) + (size_t)((((b * 8 + h) * 2 + dir) * 3) + (slot - 1)) * 128 + 2 * F.lane;
        *(f32x2*)D = (f32x2){__builtin_amdgcn_exp2f(gs0), __builtin_amdgcn_exp2f(gs1)}; }
    __syncthreads();
}

constexpr int HG_HN = 95232;
__device__ __forceinline__ void hg_pass2(Frame& F, const Args& a, int unit) {
    const int seg = unit & 3, h = (unit >> 2) & 7, b = unit >> 5;
    const int fr = F.lane & 15, fq = F.lane >> 4, w = F.wave;
    float lb0, lb1; hg_lb(a, h, F.lane, lb0, lb1);
    const int lcol = h * 128 + 16 * w + 4 * fq;
#pragma unroll 1
    for (int dir = 0; dir < 2; ++dir) {
        const int sseg = dir == 0 ? seg : 3 - seg;
        const HgPtrs P = hg_ptrs(F, h, dir);
        f32x4 St[8];
        {
            const float* img = hg_img(F, b, h, dir, 0) + (size_t)(16 * w + fr) * 128 + 4 * fq;
#pragma unroll
            for (int kt = 0; kt < 8; ++kt) St[kt] = *(const f32x4*)(img + 16 * kt);
            for (int j = 0; j < sseg; ++j) {
                const float* im = hg_img(F, b, h, dir, 1 + j) + (size_t)(16 * w + fr) * 128 + 4 * fq;
                const float* D = (const float*)(F.ws + WS_HGD) + (size_t)((((b * 8 + h) * 2 + dir) * 3) + j) * 128 + 4 * fq;
#pragma unroll
                for (int kt = 0; kt < 8; ++kt) { const f32x4 d = *(const f32x4*)(D + 16 * kt), dl = *(const f32x4*)(im + 16 * kt); St[kt] = St[kt] * d + dl; }
            }
        }
        float gs0 = 0.f, gs1 = 0.f;
        for (int ck = 0; ck < HG_SEG / HG_C; ++ck) {
            { HgRaw cur; hg_load<true>(F, P.Q, P.Fx, P.V, b, dir, false, sseg * HG_SEG + ck * HG_C, cur);
              hg_prep<true>(F, cur, b, dir, false, sseg * HG_SEG + ck * HG_C, lb0, lb1, gs0, gs1); }
            const LAS int* rows = (const LAS int*)(F.lds + HG_ROWS);
            bf16* OFW = (bf16*)(F.ws + WS_OF) + lcol; asm volatile("" : "+v"(OFW));
            u32x2 ofw[4], ogv[4];
            if (dir == 1) {
                const bf16* OG = (const bf16*)(F.ws + WS_P + 6 * GS) + lcol; asm volatile("" : "+v"(OG));
#pragma unroll
                for (int ct = 0; ct < 4; ++ct) { const size_t ro = (size_t)rows[16 * ct + fr] * DM; ofw[ct] = *(const u32x2*)(OFW + ro); ogv[ct] = *(const u32x2*)(OG + ro); } }
#pragma unroll
            for (int tt = 0; tt < 2; ++tt) { const int t = w + 8 * tt, ct = t >> 2, st = t & 3;
                f32x4 acc = {0.f, 0.f, 0.f, 0.f};
                const int rs = 16 * st + fr, rc = 16 * ct + fr;
#pragma unroll
                for (int kk = 0; kk < 4; ++kk) { const bf16x8 A = *(const LAS bf16x8*)(F.lds + HG_KM + rs * 256 + (((4 * kk + fq) ^ fr) << 4));
                    const bf16x8 B = *(const LAS bf16x8*)(F.lds + HG_QS + rc * 256 + (((4 * kk + fq) ^ fr) << 4));
                    acc = __builtin_amdgcn_mfma_f32_16x16x32_bf16(A, B, acc, 0, 0, 0); }
                const int s0 = 16 * st + 4 * fq;
                const float m0 = (s0 + 0 <= rc) ? acc[0] : 0.f, m1 = (s0 + 1 <= rc) ? acc[1] : 0.f, m2 = (s0 + 2 <= rc) ? acc[2] : 0.f, m3 = (s0 + 3 <= rc) ? acc[3] : 0.f;
                *(LAS u32x2*)(F.lds + HG_ATT + rc * 128 + (((2 * st + (fq >> 1)) ^ ((rc >> 1) & 7)) << 4) + (fq & 1) * 8) = (u32x2){pk2(m0, m1), pk2(m2, m3)}; }
            f32x4 o[4];
#pragma unroll
            for (int ct = 0; ct < 4; ++ct) o[ct] = (f32x4){0.f, 0.f, 0.f, 0.f};
#pragma unroll
            for (int kk = 0; kk < 4; ++kk) {
                union { bf16x8 v; unsigned u[4]; } A;
                A.u[0] = pk2(St[2 * kk][0], St[2 * kk][1]); A.u[1] = pk2(St[2 * kk][2], St[2 * kk][3]); A.u[2] = pk2(St[2 * kk + 1][0], St[2 * kk + 1][1]); A.u[3] = pk2(St[2 * kk + 1][2], St[2 * kk + 1][3]);
#pragma unroll
                for (int ct = 0; ct < 4; ++ct) { const int rc = 16 * ct + fr;
                    union { bf16x8 v; u32x2 h[2]; } B;
                    B.h[0] = *(const LAS u32x2*)(F.lds + HG_QS + rc * 256 + (((4 * kk + (fq >> 1)) ^ fr) << 4) + (fq & 1) * 8);
                    B.h[1] = *(const LAS u32x2*)(F.lds + HG_QS + rc * 256 + (((4 * kk + 2 + (fq >> 1)) ^ fr) << 4) + (fq & 1) * 8);
                    o[ct] = __builtin_amdgcn_mfma_f32_16x16x32_bf16(A.v, B.v, o[ct], 0, 0, 0); } }
            bf16x8 vt[2]; hg_load_vt(F, vt);
            LDS_WAIT(); __syncthreads();
#pragma unroll
            for (int ks = 0; ks < 2; ++ks)
#pragma unroll
                for (int ct = 0; ct < 4; ++ct) { const int rc = 16 * ct + fr;
                    const bf16x8 B = *(const LAS bf16x8*)(F.lds + HG_ATT + rc * 128 + (((4 * ks + fq) ^ ((rc >> 1) & 7)) << 4));
                    o[ct] = __builtin_amdgcn_mfma_f32_16x16x32_bf16(vt[ks], B, o[ct], 0, 0, 0); }
            if (dir == 0) {
#pragma unroll
                for (int ct = 0; ct < 4; ++ct) *(u32x2*)(OFW + (size_t)rows[16 * ct + fr] * DM) = (u32x2){pk2(o[ct][0], o[ct][1]), pk2(o[ct][2], o[ct][3])};
                hg_state_update(F, St, vt);
            } else {
                LAS float* hn = (LAS float*)(F.lds + HG_HN);
                const f32x4 hn4 = *(const f32x4*)(a.in[IN_HGN] + h * 128 + 16 * w + 4 * fq);
#pragma unroll
                for (int ct = 0; ct < 4; ++ct) { o[ct][0] += bflo(ofw[ct].x); o[ct][1] += bfhi(ofw[ct].x); o[ct][2] += bflo(ofw[ct].y); o[ct][3] += bfhi(ofw[ct].y);
                    float ss = (o[ct][0] * o[ct][0] + o[ct][1] * o[ct][1]) + (o[ct][2] * o[ct][2] + o[ct][3] * o[ct][3]);
                    ss += __shfl_xor(ss, 16); ss += __shfl_xor(ss, 32);
                    if (fq == 0) hn[(16 * ct + fr) * 8 + w] = ss; }
                hg_state_update(F, St, vt);
                LDS_WAIT(); __syncthreads();
#pragma unroll
                for (int ct = 0; ct < 4; ++ct) { const f32x4 p0 = *(const LAS f32x4*)(hn + (16 * ct + fr) * 8), p1 = *(const LAS f32x4*)(hn + (16 * ct + fr) * 8 + 4);
                    const float rsn = rsqrtf(((p0.x + p0.y) + (p0.z + p0.w) + (p1.x + p1.y) + (p1.z + p1.w)) * (1.f / 128.f) + EPS);
                    const float g0 = bflo(ogv[ct].x), g1 = bfhi(ogv[ct].x), g2 = bflo(ogv[ct].y), g3 = bfhi(ogv[ct].y);
                    const float y0 = o[ct][0] * rsn * hn4.x * siluf_(g0), y1 = o[ct][1] * rsn * hn4.y * siluf_(g1), y2 = o[ct][2] * rsn * hn4.z * siluf_(g2), y3 = o[ct][3] * rsn * hn4.w * siluf_(g3);
                    *(u32x2*)(OFW + (size_t)rows[16 * ct + fr] * DM) = (u32x2){pk2(y0, y1), pk2(y2, y3)}; }
            }
        }
        VM_WAIT(); __syncthreads();
    }
}
__device__ __forceinline__ void p_ybg(Frame& F, const Args& a) {
    const bf16* OFp = (const bf16*)(F.ws + WS_OF); const bf16* OBp = (const bf16*)(F.ws + WS_OB); const bf16* OG = (const bf16*)(F.ws + WS_P + 6 * GS);
    bf16* YBG = (bf16*)(F.ws + WS_YBG); const float* hgn = a.in[IN_HGN];
    const int gw = F.bid * NWAVES + F.wave, NGW = F.G * NWAVES;
    for (int row = gw; row < NTOK; row += 2 * NGW) {
        u32x4 fv[2][2], bv[2][2], gvv[2][2];
#pragma unroll
        for (int rr = 0; rr < 2; ++rr)
#pragma unroll
            for (int j = 0; j < 2; ++j) { const size_t o = (size_t)(row + rr * NGW) * DM + 8 * F.lane + 512 * j;
                fv[rr][j] = *(const u32x4*)(OFp + o); bv[rr][j] = *(const u32x4*)(OBp + o); gvv[rr][j] = *(const u32x4*)(OG + o); }
#pragma unroll
        for (int rr = 0; rr < 2; ++rr)
#pragma unroll
        for (int j = 0; j < 2; ++j) { const int k = 8 * F.lane + 512 * j; const size_t o = (size_t)(row + rr * NGW) * DM + k;
            const u32x4 f = fv[rr][j], b = bv[rr][j], g = gvv[rr][j];
            float v[8]; v[0] = bflo(f.x) + bflo(b.x); v[1] = bfhi(f.x) + bfhi(b.x); v[2] = bflo(f.y) + bflo(b.y); v[3] = bfhi(f.y) + bfhi(b.y);
            v[4] = bflo(f.z) + bflo(b.z); v[5] = bfhi(f.z) + bfhi(b.z); v[6] = bflo(f.w) + bflo(b.w); v[7] = bfhi(f.w) + bfhi(b.w);
            float ss = 0.f;
#pragma unroll
            for (int q = 0; q < 8; ++q) ss += v[q] * v[q];
            ss += __shfl_xor(ss, 1); ss += __shfl_xor(ss, 2); ss += __shfl_xor(ss, 4); ss += __shfl_xor(ss, 8);
            const float rs = rsqrtf(ss * (1.f / 128.f) + EPS);
            float gv[8]; gv[0] = bflo(g.x); gv[1] = bfhi(g.x); gv[2] = bflo(g.y); gv[3] = bfhi(g.y); gv[4] = bflo(g.z); gv[5] = bfhi(g.z); gv[6] = bflo(g.w); gv[7] = bfhi(g.w);
            const f32x4 h0 = *(const f32x4*)(hgn + k), h1 = *(const f32x4*)(hgn + k + 4);
            const float hv[8] = {h0.x, h0.y, h0.z, h0.w, h1.x, h1.y, h1.z, h1.w};
            float r[8];
#pragma unroll
            for (int q = 0; q < 8; ++q) r[q] = v[q] * rs * hv[q] * siluf_(gv[q]);
            u32x4 w; w.x = pk2(r[0], r[1]); w.y = pk2(r[2], r[3]); w.z = pk2(r[4], r[5]); w.w = pk2(r[6], r[7]);
            *(u32x4*)(YBG + o) = w; }
    }
}
__device__ __forceinline__ void p_moe_weights13(Frame& F, const Args& a) {
    LAS float* scr = (LAS float*)(F.lds + F.wave * TR_BYTES);
    const int gw = F.bid * NWAVES + F.wave, NGW = F.G * NWAVES;
    for (int it = gw; it < NEXP * 256; it += NGW) {
        const int e = it >> 8, r = it & 255, w = r >> 7, q = r & 127, kb = q >> 3, nb = q & 7;
        transpose_item(a.in[w == 0 ? IN_W1 : IN_W3] + (size_t)e * DM * DEXP, DEXP, DM, (bf16*)(F.ws + (w == 0 ? WS_W1T : WS_W3T)) + ((size_t)e * DEXP + nb * 64) * DM, kb * 64, nb * 64, scr, F.lane);
    }
}
__device__ __forceinline__ void p_moe_weights2(Frame& F, const Args& a, int rank, int nwg) {
    LAS float* scr = (LAS float*)(F.lds + F.wave * TR_BYTES);
    for (int it = rank * NWAVES + F.wave; it < NEXP * 128; it += nwg * NWAVES) {
        const int e = it >> 7, q = it & 127, kb = q >> 4, nb = q & 15;
        transpose_item(a.in[IN_W2] + (size_t)e * DEXP * DM, DM, DEXP, (bf16*)(F.ws + WS_W2T) + ((size_t)e * DM + nb * 64) * DEXP, kb * 64, nb * 64, scr, F.lane);
    }
}

struct SchedP5 {
    int c; const char* YAG; const char* YBG; const char* WA; const char* WB; char* stash; char* M;
    __device__ __forceinline__ bool next(int i, gm::Unit& u) const {
        if (i >= 2) return false;
        int pm, pn; tile_order(c, 64, 4, pm, pn);
        u.A = (i == 0 ? YAG : YBG) + (size_t)pm * 256 * 2048; u.B0 = (i == 0 ? WA : WB) + (size_t)pn * 256 * 2048; u.B1 = u.B0 + (size_t)128 * 2048;
        u.dst = M + ((size_t)pm * 256 * DM + pn * 256) * 2; u.pm = pm; u.pn = pn; u.e = i; u.rows = 256; return true;
    }
    __device__ __forceinline__ unsigned arow(const gm::Unit&, int r) const { return (unsigned)r; }
};
struct EpiP5 {
    static constexpr bool PERM = true;
    unsigned* stash; const bf16* GA; const bf16* GB;
    __device__ __forceinline__ void operator()(const f32x4 (&acc)[2][2][4][2], const gm::Unit& u, int wr, int wc, int fr, int fq) const {
        const bf16* G = (u.e == 0 ? GA : GB) + ((size_t)u.pm * 256 + wr * 64 + fr) * DM + u.pn * 256 + wc * 32 + 8 * fq;
        bf16* Mb = (bf16*)u.dst + (size_t)(wr * 64 + fr) * DM + wc * 32 + 8 * fq;
        u32x4* st = (u32x4*)stash + threadIdx.x;
        asm volatile("" : "+v"(G), "+v"(Mb), "+v"(st));
#pragma unroll
        for (int ai = 0; ai < 2; ++ai)
#pragma unroll
            for (int m = 0; m < 4; ++m) {
                u32x4 g[2], s[2];
#pragma unroll
                for (int bj = 0; bj < 2; ++bj) { const size_t ro = (size_t)(ai * 128 + m * 16) * DM + bj * 128; const int si = (ai * 4 + m) * 2 + bj;
                    g[bj] = *(const u32x4*)(G + ro);
                    if (u.e != 0) s[bj] = st[(size_t)si * NTHR]; }
#pragma unroll
                for (int bj = 0; bj < 2; ++bj) { const size_t ro = (size_t)(ai * 128 + m * 16) * DM + bj * 128; const int si = (ai * 4 + m) * 2 + bj;
                    f32x4 v0 = acc[ai][bj][m][0], v1 = acc[ai][bj][m][1];
                    v0[0] *= sigmoidf_(bflo(g[bj].x)); v0[1] *= sigmoidf_(bfhi(g[bj].x)); v0[2] *= sigmoidf_(bflo(g[bj].y)); v0[3] *= sigmoidf_(bfhi(g[bj].y));
                    v1[0] *= sigmoidf_(bflo(g[bj].z)); v1[1] *= sigmoidf_(bfhi(g[bj].z)); v1[2] *= sigmoidf_(bflo(g[bj].w)); v1[3] *= sigmoidf_(bfhi(g[bj].w));
                    if (u.e != 0) { v0[0] += bflo(s[bj].x); v0[1] += bfhi(s[bj].x); v0[2] += bflo(s[bj].y); v0[3] += bfhi(s[bj].y);
                                    v1[0] += bflo(s[bj].z); v1[1] += bfhi(s[bj].z); v1[2] += bflo(s[bj].w); v1[3] += bfhi(s[bj].w); }
                    u32x4 w; w.x = gm::cvt_pk_bf16(v0[0], v0[1]); w.y = gm::cvt_pk_bf16(v0[2], v0[3]); w.z = gm::cvt_pk_bf16(v1[0], v1[1]); w.w = gm::cvt_pk_bf16(v1[2], v1[3]);
                    if (u.e == 0) st[(size_t)si * NTHR] = w; else *(u32x4*)(Mb + ro) = w; }
                asm volatile("" ::: "memory"); }
    }
};

struct SchedP6 {
    int c; const char* M; const char* W; char* X1;
    __device__ __forceinline__ bool next(int i, gm::Unit& u) const {
        if (i >= 1) return false;
        int pm, pn; tile_order(c, 64, 4, pm, pn);
        u.A = M + (size_t)pm * 256 * 2048; u.B0 = W + (size_t)pn * 256 * 2048; u.B1 = u.B0 + (size_t)128 * 2048;
        u.dst = X1 + ((size_t)pm * 256 * DM + pn * 256) * 4; u.pm = pm; u.pn = pn; u.e = 0; u.rows = 256; return true;
    }
    __device__ __forceinline__ unsigned arow(const gm::Unit&, int r) const { return (unsigned)r; }
};
struct EpiP6 {
    static constexpr bool PERM = false;
    const float* x; const float* mod;
    __device__ __forceinline__ void operator()(const f32x4 (&acc)[2][2][4][2], const gm::Unit& u, int wr, int wc, int fr, int fq) const {
        const int b = u.pm >> 3; const int col0 = u.pn * 256 + wc * 32 + 4 * fq;
        const float* mg = mod + b * 6144 + 2 * DM + col0;
        f32x4 gv[2][2];
#pragma unroll
        for (int bj = 0; bj < 2; ++bj)
#pragma unroll
            for (int n = 0; n < 2; ++n) gv[bj][n] = *(const f32x4*)(mg + bj * 128 + n * 16);
#pragma unroll
        for (int ai = 0; ai < 2; ++ai)
#pragma unroll
            for (int m = 0; m < 4; ++m) { const size_t ro = (size_t)(wr * 64 + fr + ai * 128 + m * 16) * DM + wc * 32 + 4 * fq;
                const float* xr = x + ((size_t)u.pm * 256 * DM + u.pn * 256) + ro; float* orow = (float*)u.dst + ro;
#pragma unroll
                for (int bj = 0; bj < 2; ++bj)
#pragma unroll
                    for (int n = 0; n < 2; ++n) { const f32x4 xv = *(const f32x4*)(xr + bj * 128 + n * 16);
                        *(f32x4*)(orow + bj * 128 + n * 16) = xv + gv[bj][n] * acc[ai][bj][m][n]; } }
    }
};

__device__ __forceinline__ void p_norm2_route(Frame& F, const Args& a) {
    const float* mod = (const float*)(F.ws + WS_MOD); const float* g2 = a.in[IN_G2]; const float* wrp = (const float*)(F.ws + WS_WRT);
    const float* X1 = F.out; bf16* HX2 = (bf16*)(F.ws + WS_HX2);
    int* list = (int*)(F.ws + WS_LIST); float* wt = (float*)(F.ws + WS_WT); unsigned* cnt = F.ctl + CW_CNT;
    LAS float* gs = (LAS float*)F.lds; LAS float* sh = gs + DM; LAS float* rst = sh + DM; LAS float* lgs = rst + 64;
    const int b = F.bid / 32;
    for (int k = F.tid; k < DM; k += NTHR) { gs[k] = g2[k] * (1.f + mod[b * 6144 + 4 * DM + k]); sh[k] = mod[b * 6144 + 3 * DM + k]; }
    __syncthreads();
    for (int r = F.wave; r < 64; r += NWAVES) {
        const int tok = F.bid * 64 + r;
        const f32x4* xr = (const f32x4*)(X1 + (size_t)tok * DM) + F.lane;
        f32x4 v[4]; float s = 0.f;
#pragma unroll
        for (int j = 0; j < 4; ++j) { v[j] = xr[64 * j]; s += (v[j].x * v[j].x + v[j].y * v[j].y) + (v[j].z * v[j].z + v[j].w * v[j].w); }
        const float rstd = rsqrtf(wave_sum(s) * (1.f / DM) + EPS);
        if (F.lane == 0) rst[r] = rstd;
        unsigned long long* o8 = (unsigned long long*)(HX2 + (size_t)tok * DM) + F.lane;
#pragma unroll
        for (int j = 0; j < 4; ++j) { const int k = 4 * F.lane + 256 * j;
            const f32x4 g = *(const LAS f32x4*)(gs + k), h = *(const LAS f32x4*)(sh + k);
            o8[64 * j] = (unsigned long long)pk2(v[j].x * rstd * g.x + h.x, v[j].y * rstd * g.y + h.y) | ((unsigned long long)pk2(v[j].z * rstd * g.z + h.z, v[j].w * rstd * g.w + h.w) << 32); }
    }
    LDS_WAIT(); __syncthreads();
    {
        const int tq = F.lane & 15, kq = F.lane >> 4, wg = F.wave & 3, kh = F.wave >> 2; const int tl = wg * 16 + tq;
        const float rs = rst[tl];
        const float* xr = X1 + (size_t)(F.bid * 64 + tl) * DM + 4 * kq + 512 * kh;
        const f32x4* wp = (const f32x4*)wrp + F.lane + (size_t)kh * 32 * 3 * 64;
        const LAS float* gsp = gs + 512 * kh + 4 * kq; const LAS float* shp = sh + 512 * kh + 4 * kq;
        f32x4 acc[3];
#pragma unroll
        for (int c = 0; c < 3; ++c) acc[c] = (f32x4){0.f, 0.f, 0.f, 0.f};
#pragma unroll 8
        for (int s = 0; s < 32; ++s) {
            const f32x4 x = *(const f32x4*)(xr + 16 * s); const f32x4 g = *(const LAS f32x4*)(gsp + 16 * s), h = *(const LAS f32x4*)(shp + 16 * s);
            const f32x4 hv = x * rs * g + h;
#pragma unroll
            for (int c = 0; c < 3; ++c) { const f32x4 w = wp[(s * 3 + c) * 64];
                acc[c] = __builtin_amdgcn_mfma_f32_16x16x4f32(hv[0], w[0], acc[c], 0, 0, 0); acc[c] = __builtin_amdgcn_mfma_f32_16x16x4f32(hv[1], w[1], acc[c], 0, 0, 0);
                acc[c] = __builtin_amdgcn_mfma_f32_16x16x4f32(hv[2], w[2], acc[c], 0, 0, 0); acc[c] = __builtin_amdgcn_mfma_f32_16x16x4f32(hv[3], w[3], acc[c], 0, 0, 0); }
        }
#pragma unroll
        for (int c = 0; c < 3; ++c)
#pragma unroll
            for (int r = 0; r < 4; ++r) lgs[kh * 64 * 48 + (wg * 16 + 4 * kq + r) * 48 + 16 * c + tq] = acc[c][r];
    }
    LDS_WAIT(); __syncthreads();
    LAS unsigned* lcnt = (LAS unsigned*)(lgs + 2 * 64 * 48); LAS unsigned* lbase = lcnt + 32;
    if (F.tid < 32) lcnt[F.tid] = 0u;
    LDS_WAIT(); __syncthreads();
    int ea = 0, eb = 0; unsigned ra = 0u, rb = 0u; int tok = 0; float w1 = 0.f, w2 = 0.f;
    const bool picker = F.wave < 4 && F.lane < 16;
    if (picker) {
        const LAS float* lp = lgs + (F.wave * 16 + F.lane) * 48; tok = F.bid * 64 + F.wave * 16 + F.lane;
        float lg[36];
#pragma unroll
        for (int q = 0; q < 9; ++q) { const f32x4 t4 = *(const LAS f32x4*)(lp + 4 * q) + *(const LAS f32x4*)(lp + 64 * 48 + 4 * q) + *(const f32x4*)(wrp + 49152 + 4 * q);
            lg[4 * q] = t4.x; lg[4 * q + 1] = t4.y; lg[4 * q + 2] = t4.z; lg[4 * q + 3] = t4.w; }
        float mx = lg[0]; int gi = 0;
#pragma unroll
        for (int g = 1; g < 4; ++g) if (lg[g] > mx) { mx = lg[g]; gi = g; }
        float z = 0.f;
#pragma unroll
        for (int g = 0; g < 4; ++g) z += __expf(lg[g] - mx);
        const float pg = 1.f / z;
        float el[8];
#pragma unroll
        for (int e = 0; e < 8; ++e) el[e] = gi == 0 ? lg[4 + e] : (gi == 1 ? lg[12 + e] : (gi == 2 ? lg[20 + e] : lg[28 + e]));
        int e1 = 0; float m1 = el[0];
#pragma unroll
        for (int e = 1; e < 8; ++e) if (el[e] > m1) { m1 = el[e]; e1 = e; }
        int e2 = 0; float m2 = -3.0e38f;
#pragma unroll
        for (int e = 0; e < 8; ++e) if (e != e1 && el[e] > m2) { m2 = el[e]; e2 = e; }
        const float rr = __expf(m2 - m1); w1 = pg / (1.f + rr); w2 = pg * rr / (1.f + rr);
        ea = gi * 8 + e1; eb = gi * 8 + e2;
        ra = __hip_atomic_fetch_add(lcnt + ea, 1u, __ATOMIC_RELAXED, __HIP_MEMORY_SCOPE_WORKGROUP);
        rb = __hip_atomic_fetch_add(lcnt + eb, 1u, __ATOMIC_RELAXED, __HIP_MEMORY_SCOPE_WORKGROUP);
    }
    LDS_WAIT(); __syncthreads();
    if (F.tid < 32) { const unsigned n = lcnt[F.tid]; lbase[F.tid] = n ? __hip_atomic_fetch_add(cnt + 64 * F.tid, n, __ATOMIC_RELAXED, __HIP_MEMORY_SCOPE_AGENT) : 0u; }
    LDS_WAIT(); __syncthreads();
    if (picker) {
        list[(size_t)ea * CAP + lbase[ea] + ra] = tok * 2; wt[tok * 2] = w1;
        list[(size_t)eb * CAP + lbase[eb] + rb] = tok * 2 + 1; wt[tok * 2 + 1] = w2;
    }
}

__device__ __forceinline__ void moe_table(Frame& F, const int* cntv) {
    if (F.wave == 0) { const int lane = F.lane; const int cnt = lane < NEXP ? cntv[64 * lane] : 0;
        const int t = (cnt + 255) >> 8; int ti = t, oi = cnt;
#pragma unroll
        for (int d = 1; d < 32; d <<= 1) { const int tu = __shfl_up(ti, d), ou = __shfl_up(oi, d); if ((lane & 31) >= d) { ti += tu; oi += ou; } }
        if (lane < NEXP) { F.MISC[128 + lane] = (unsigned)cnt; F.MISC[160 + lane] = (unsigned)(ti - t); F.MISC[192 + lane] = (unsigned)(oi - cnt); }
        if (lane == NEXP - 1) F.MISC[224] = (unsigned)ti; }
    LDS_WAIT(); __syncthreads();
}
__device__ __forceinline__ bool moe_find(volatile LAS unsigned* MISC, int lane, int T, int& e, int& rt, int& rows, int& off) {
    if (T >= (int)MISC[224]) return false;
    const int l = lane & 31; const int cnt = (int)MISC[128 + l], tpre = (int)MISC[160 + l];
    const unsigned long long mask = __ballot(lane < NEXP && cnt > 0 && T >= tpre);
    e = __builtin_amdgcn_readfirstlane(63 - __builtin_clzll(mask));
    rt = T - (int)MISC[160 + e]; const int c = (int)MISC[128 + e]; off = (int)MISC[192 + e];
    rows = c - rt * 256; if (rows > 256) rows = 256; return true;
}
struct SchedMoe1 {
    int G, c, lane; volatile LAS unsigned* MISC; const int* list; const char* HX2; const char* W1T; const char* W3T; char* HH; unsigned* tile_cnt;
    __device__ __forceinline__ bool next(int i, gm::Unit& u) const {
        const int vc = (c & 7) * (G >> 3) + (c >> 3);
        const int L = i * G + vc; int e, rt, rows, off; if (!moe_find(MISC, lane, L >> 2, e, rt, rows, off)) return false;
        const int pn = L & 3;
        e = __builtin_amdgcn_readfirstlane(e); rt = __builtin_amdgcn_readfirstlane(rt); rows = __builtin_amdgcn_readfirstlane(rows); off = __builtin_amdgcn_readfirstlane(off);
        u.A = HX2; u.B0 = W1T + ((size_t)e * DEXP + pn * 128) * 2048; u.B1 = W3T + ((size_t)e * DEXP + pn * 128) * 2048;
        u.dst = HH + ((size_t)(off + rt * 256) * DEXP + pn * 128) * 2; u.pm = rt; u.pn = pn; u.e = e; u.rows = rows; u.t = L >> 2; return true;
    }
    __device__ __forceinline__ unsigned arow(const gm::Unit& u, int r) const { const int rr = r < u.rows ? r : u.rows - 1; return (unsigned)(list[(size_t)u.e * CAP + u.pm * 256 + rr] >> 1); }
    __device__ __forceinline__ void a_ready(const gm::Unit&) const {}
    __device__ __forceinline__ void done(const gm::Unit& u) const {
        asm volatile("s_waitcnt vmcnt(0)" ::: "memory");
        __builtin_amdgcn_s_barrier(); asm volatile("" ::: "memory");
        if (threadIdx.x == 0) __hip_atomic_fetch_add(tile_cnt + 8 * u.t, 1u, __ATOMIC_RELAXED, __HIP_MEMORY_SCOPE_AGENT);
    }
};
struct EpiMoe1 {
    static constexpr bool PERM = true;
    char* HH;
    __device__ __forceinline__ void operator()(const f32x4 (&acc)[2][2][4][2], const gm::Unit& u, int wr, int wc, int fr, int fq) const {
        const __amdgpu_buffer_rsrc_t rs = __builtin_amdgcn_make_buffer_rsrc((void*)HH, 0, 0x7fffffff, 0x00020000);
        const unsigned base = (unsigned)(u.dst - HH) + (unsigned)(((wr * 64 + fr) * DEXP + wc * 32 + 8 * fq) * 2);
#pragma unroll
        for (int ai = 0; ai < 2; ++ai)
#pragma unroll
            for (int m = 0; m < 4; ++m) { const int r = ai * 128 + wr * 64 + m * 16 + fr; if (r >= u.rows) continue;
                const f32x4 u0 = acc[ai][0][m][0], u1 = acc[ai][0][m][1], v0 = acc[ai][1][m][0], v1 = acc[ai][1][m][1];
                u32x4 w; w.x = gm::cvt_pk_bf16(siluf_(u0[0]) * v0[0], siluf_(u0[1]) * v0[1]); w.y = gm::cvt_pk_bf16(siluf_(u0[2]) * v0[2], siluf_(u0[3]) * v0[3]);
                w.z = gm::cvt_pk_bf16(siluf_(u1[0]) * v1[0], siluf_(u1[1]) * v1[1]); w.w = gm::cvt_pk_bf16(siluf_(u1[2]) * v1[2], siluf_(u1[3]) * v1[3]);
                __builtin_amdgcn_raw_buffer_store_b128(w, rs, base + (unsigned)((ai * 128 + m * 16) * DEXP * 2), 0, 16); }
    }
};
struct SchedMoe2 {
    int G, c, lane; volatile LAS unsigned* MISC; const char* HH; const char* W2T; char* Y; unsigned* tile_cnt; unsigned* tmo;
    __device__ __forceinline__ bool next(int i, gm::Unit& u) const {
        const int vc = (c & 7) * (G >> 3) + (c >> 3);
        const int U = 4 * (int)MISC[224], q = U / G, r = U % G;
        const bool rebal = q >= 1 && r > 0 && 3 * r <= G;
        int L = i * G + (G - 1 - vc);
        if (rebal) {
            if (vc < r) { if (i >= q - 1) return false; }
            else if (vc < 2 * r) { if (i == q) L = (q - 1) * G + (G - 1 - (vc - r)); else if (i > q) return false; }
        }
        int e, rt, rows, off; if (!moe_find(MISC, lane, L >> 2, e, rt, rows, off)) return false;
        const int pn = L & 3;
        e = __builtin_amdgcn_readfirstlane(e); rt = __builtin_amdgcn_readfirstlane(rt); rows = __builtin_amdgcn_readfirstlane(rows); off = __builtin_amdgcn_readfirstlane(off);
        u.A = HH + (size_t)(off + rt * 256) * DEXP * 2; u.B0 = W2T + ((size_t)e * DM + pn * 256) * (DEXP * 2); u.B1 = u.B0 + (size_t)128 * (DEXP * 2);
        u.dst = Y + (size_t)pn * 256 * 2; u.pm = rt; u.pn = pn; u.e = e; u.rows = rows; u.t = L >> 2; return true;
    }
    __device__ __forceinline__ unsigned arow(const gm::Unit&, int r) const { return (unsigned)r; }
    __device__ __forceinline__ void a_ready(const gm::Unit& u) const {
        if (threadIdx.x < 64) {
            unsigned spins = 0;
            while ((unsigned)__builtin_amdgcn_readfirstlane(__hip_atomic_load(tile_cnt + 8 * u.t, __ATOMIC_RELAXED, __HIP_MEMORY_SCOPE_AGENT)) < 4u) {
                __builtin_amdgcn_s_sleep(2);
                if (++spins > (1u << 22)) { if (threadIdx.x == 0) __hip_atomic_store(tmo, 1u, __ATOMIC_RELAXED, __HIP_MEMORY_SCOPE_AGENT); break; } }
            __builtin_amdgcn_fence(__ATOMIC_ACQUIRE, "agent");
            asm volatile("s_waitcnt vmcnt(0)" ::: "memory");
        }
        asm volatile("" ::: "memory"); __builtin_amdgcn_s_barrier(); asm volatile("" ::: "memory");
    }
    __device__ __forceinline__ void done(const gm::Unit&) const {}
};
struct EpiMoe2 {
    static constexpr bool PERM = true;
    const int* list;
    __device__ __forceinline__ void operator()(const f32x4 (&acc)[2][2][4][2], const gm::Unit& u, int wr, int wc, int fr, int fq) const {
        const int* lp = list + (size_t)u.e * CAP + u.pm * 256;
#pragma unroll
        for (int ai = 0; ai < 2; ++ai)
#pragma unroll
            for (int m = 0; m < 4; ++m) { const int r = ai * 128 + wr * 64 + m * 16 + fr; if (r >= u.rows) continue;
                const int slot = lp[r]; bf16* rowp = (bf16*)u.dst + (size_t)slot * DM + wc * 32 + 8 * fq;
#pragma unroll
                for (int bj = 0; bj < 2; ++bj) { const f32x4 v0 = acc[ai][bj][m][0], v1 = acc[ai][bj][m][1];
                    u32x4 w; w.x = gm::cvt_pk_bf16(v0[0], v0[1]); w.y = gm::cvt_pk_bf16(v0[2], v0[3]); w.z = gm::cvt_pk_bf16(v1[0], v1[1]); w.w = gm::cvt_pk_bf16(v1[2], v1[3]);
                    *(u32x4*)(rowp + bj * 128) = w; } }
    }
};

__device__ __forceinline__ void p_final(Frame& F, const Args& a) {
    const float* mod = (const float*)(F.ws + WS_MOD); const float* fg = a.in[IN_FG]; const float* wt = (const float*)(F.ws + WS_WT);
    const bf16* Y = (const bf16*)(F.ws + WS_Y); float* X1 = F.out;
    for (int r = F.wave; r < 64; r += NWAVES) {
        const int tok = F.bid * 64 + r; const int b = tok >> 11;
        const float w0 = wt[tok * 2], w1 = wt[tok * 2 + 1];
        f32x4* xr = (f32x4*)(X1 + (size_t)tok * DM) + F.lane;
        const u32x2* y0 = (const u32x2*)(Y + (size_t)(tok * 2) * DM) + F.lane; const u32x2* y1 = (const u32x2*)(Y + (size_t)(tok * 2 + 1) * DM) + F.lane;
        f32x4 v[4]; float s = 0.f;
#pragma unroll
        for (int j = 0; j < 4; ++j) { const int k = 4 * F.lane + 256 * j;
            const f32x4 xv = xr[64 * j]; const u32x2 a0 = y0[64 * j], a1 = y1[64 * j]; const f32x4 g5 = *(const f32x4*)(mod + b * 6144 + 5 * DM + k);
            v[j].x = xv.x + g5.x * (w0 * bflo(a0.x) + w1 * bflo(a1.x)); v[j].y = xv.y + g5.y * (w0 * bfhi(a0.x) + w1 * bfhi(a1.x));
            v[j].z = xv.z + g5.z * (w0 * bflo(a0.y) + w1 * bflo(a1.y)); v[j].w = xv.w + g5.w * (w0 * bfhi(a0.y) + w1 * bfhi(a1.y));
            s += (v[j].x * v[j].x + v[j].y * v[j].y) + (v[j].z * v[j].z + v[j].w * v[j].w); }
        const float rstd = rsqrtf(wave_sum(s) * (1.f / DM) + EPS);
#pragma unroll
        for (int j = 0; j < 4; ++j) { const int k = 4 * F.lane + 256 * j; const f32x4 g = *(const f32x4*)(fg + k);
            xr[64 * j] = (f32x4){v[j].x * rstd * g.x, v[j].y * rstd * g.y, v[j].z * rstd * g.z, v[j].w * rstd * g.w}; }
    }
}
#ifndef LRU_FAST
#define LRU_FAST 1
#endif
#ifndef HG_FAST
#define HG_FAST 1
#endif
#define MIX_FAST (LRU_FAST && HG_FAST)
#ifdef PROBE_A
#define STAMP(k) do { if (F.bid == 0 && F.tid == 0) { const unsigned long long _t = __builtin_amdgcn_s_memrealtime(); F.MISC[32 + 2 * (k)] = (unsigned)_t; F.MISC[33 + 2 * (k)] = (unsigned)(_t >> 32); } } while (0)
#else
#define STAMP(k) do { } while (0)
#endif
__device__ __forceinline__ void p_mix1(Frame& F, const Args& a) {
#if LRU_FAST
    {
        const int h = (F.bid >> 4) & 7; int ch = h * 128 + 16 * F.wave + (F.lane & 15);
        const LruCoef kf = lru_coef(a, 0, ch), kb = lru_coef(a, 1, ch);
        for (int r = 0; r < 2; ++r) lru_unit(F, a, r * 256 + F.bid, kf, kb);
    }
#endif
    STAMP(14); STAMP(15);
#if HG_FAST
    for (int i = 0, u = F.bid; u < NB * 8 * 2 * 4; u += F.G, ++i) hg_pass1(F, a, (u & ~3) | ((u + 2 * i) & 3));
#endif
}
__device__ __forceinline__ void p_mix2(Frame& F, const Args& a) {
#if LRU_FAST
    {
        const int h = (F.bid >> 4) & 7; int ch = h * 128 + 16 * F.wave + (F.lane & 15);
        asm volatile("" : "+v"(ch));
        const LruCoef kf = lru_coef(a, 0, ch), kb = lru_coef(a, 1, ch);
        for (int r = 2; r < 4; ++r) lru_unit(F, a, r * 256 + F.bid, kf, kb);
    }
#endif
    STAMP(16); STAMP(17);
#if HG_FAST
    for (int u = F.bid; u < NB * 8 * 4; u += F.G) hg_pass2(F, a, u);
#endif
}
__global__ void __launch_bounds__(NTHR, 2) mega(Args args) {
    extern __shared__ __attribute__((aligned(16))) unsigned char lds_raw[];
    Frame F;
    F.lds = (LAS unsigned char*)lds_raw; F.MISC = (volatile LAS unsigned*)(F.lds + LDSCTL_OFF);
    F.tid = threadIdx.x; F.lane = F.tid & 63; F.wave = __builtin_amdgcn_readfirstlane(F.tid >> 6);
    F.G = gridDim.x; F.bid = blockIdx.x; F.ws = args.ws; F.out = args.out; F.ctl = (unsigned*)(args.ws + WS_CTL);
    for (int u = F.tid; u < (LDS_BYTES - LDSCTL_OFF) / 4; u += NTHR) ((LAS unsigned*)(F.lds + LDSCTL_OFF))[u] = 0u;
    __syncthreads();
    XcdBarrier bar = xcd_barrier_post(F.ctl + CW_BAR + args.li * 3584, F.MISC + 8);
    const int lo = args.ph_lo, hi = args.ph_hi;
#define IN(k) (lo <= (k) && (k) < hi)
#define SEAM(k) do { if (IN(k) && IN((k) + 1)) xcd_barrier(bar); STAMP((k) + 1); if ((k) == 9) STAMP(11); } while (0)
    unsigned char* ws = F.ws;
    STAMP(0);
    if (IN(0)) { p0_prologue(F, args); } SEAM(0);
    if (IN(1)) { p1_norm(F, args); } SEAM(1);
    if (IN(2)) {
        SchedP2 S{F.G, F.bid, (const char*)F.out, (const char*)(ws + WS_WIN), (char*)(ws + WS_P), (char*)(ws + WS_PC)};
        EpiStoreBf16 E;
        gm::gemm_phase<SchedP2, EpiStoreBf16, false>(F.lds, DM, S, E);
    } SEAM(2);
    if (IN(3)) { p_mix1(F, args); } SEAM(3);
    if (IN(4)) { p_mix2(F, args); } SEAM(4);
    if (IN(6)) {
        const bool conv_first = ((F.bid >> 3) & 1) != 0;
        if (conv_first) { p_moe_weights13(F, args); p_moe_weights2(F, args, F.bid, F.G); __syncthreads(); }
        {
            SchedP5 S{F.bid, (const char*)(ws + WS_YAG), (const char*)(ws + WS_YBG), (const char*)(ws + WS_WPA), (const char*)(ws + WS_WPB), nullptr, (char*)(ws + WS_M)};
            EpiP5 E{(unsigned*)F.out + (size_t)F.bid * 32768, (const bf16*)(ws + WS_P + 7 * GS), (const bf16*)(ws + WS_P + 8 * GS)};
            gm::gemm_phase<SchedP5, EpiP5, false>(F.lds, DM, S, E);
        }
        if (!conv_first) { __syncthreads(); p_moe_weights13(F, args); p_moe_weights2(F, args, F.bid, F.G); }
    } SEAM(6);
    if (IN(7)) {
        SchedP6 S{F.bid, (const char*)(ws + WS_M), (const char*)(ws + WS_WOUT), (char*)F.out};
        EpiP6 E{args.in[IN_X], (const float*)(ws + WS_MOD)};
        gm::gemm_phase<SchedP6, EpiP6, false>(F.lds, DM, S, E);
    } SEAM(7);
    if (IN(8)) { p_norm2_route(F, args); } SEAM(8);
    if (IN(9)) {
        moe_table(F, (const int*)(F.ctl + CW_CNT));
        {
            SchedMoe1 S{F.G, F.bid, F.lane, F.MISC, (const int*)(ws + WS_LIST), (const char*)(ws + WS_HX2), (const char*)(ws + WS_W1T), (const char*)(ws + WS_W3T), (char*)(ws + WS_HH), F.ctl + CW_TILE};
            EpiMoe1 E{(char*)(ws + WS_HH)};
            gm::gemm_phase<SchedMoe1, EpiMoe1, true, true>(F.lds, DM, S, E);
        }
        {
            SchedMoe2 S{F.G, F.bid, F.lane, F.MISC, (const char*)(ws + WS_HH), (const char*)(ws + WS_W2T), (char*)(ws + WS_Y), F.ctl + CW_TILE, F.ctl + 2};
            EpiMoe2 E{(const int*)(ws + WS_LIST)};
            gm::gemm_phase<SchedMoe2, EpiMoe2, false, true>(F.lds, DEXP, S, E);
        }
    } SEAM(9);
    if (IN(11)) { p_final(F, args); }
#ifdef PROBE_A
    if (F.bid == 0 && F.tid == 0) {
        const unsigned long long tend = __builtin_amdgcn_s_memrealtime();
        F.MISC[32 + 2 * 12] = (unsigned)tend; F.MISC[33 + 2 * 12] = (unsigned)(tend >> 32);
        auto RD = [&](int k) { return ((unsigned long long)F.MISC[33 + 2 * k] << 32) | F.MISC[32 + 2 * k]; };
        auto T = [&](int k) { if (k >= 20) { const int i = k - 20; return (unsigned long long)(((((unsigned long long)F.MISC[103 + 2 * i] << 32) | F.MISC[102 + 2 * i]) + 400) / 800); } if (k == 13) return (unsigned long long)((RD(14) - RD(3) + 400) / 800); if (k == 15) return (unsigned long long)((RD(16) - RD(4) + 400) / 800); const unsigned long long t0 = ((unsigned long long)F.MISC[33 + 2 * k] << 32) | F.MISC[32 + 2 * k], t1 = ((unsigned long long)F.MISC[33 + 2 * (k + 1)] << 32) | F.MISC[32 + 2 * (k + 1)]; return (unsigned long long)((t1 - t0 + 400) / 800); };
        const unsigned long long delay = (T(PROBE_A) + 64ull * T(PROBE_B)) * 6400ull;
        while (__builtin_amdgcn_s_memrealtime() - tend < delay) __builtin_amdgcn_s_sleep(32);
    }
#endif
#undef IN
#undef SEAM
}

#if !LRU_FAST
__global__ void k_conv_f(const bf16* P0, const bf16* PC0, const float* cw, const float* cb, float* Ub, int b) {
    int t = blockIdx.x; int Lseg = t < CTX ? CTX : SEQ; int lt = t < CTX ? t : t - CTX;
    const bf16* base = t < CTX ? PC0 + (size_t)b * CTX * DM : P0 + (size_t)b * SEQ * DM;
    for (int ch = threadIdx.x; ch < DM; ch += 256) {
        float s = cb[ch];
#pragma unroll
        for (int k = 0; k < 4; ++k) { int tt = lt + k - 2; if (tt >= 0 && tt < Lseg) s += cw[k * DM + ch] * bf2f(base[(size_t)tt * DM + ch]); }
        Ub[(size_t)t * DM + ch] = s;
    }
}
__global__ void k_gates(const float* Ub, const float* wa, const float* ba, const float* wx, const float* bx, const float* lam, float* Aout, float* Bout, int d) {
    __shared__ float us[128];
    int t = blockIdx.x, h = blockIdx.y, j = threadIdx.x; int ch = h * 128 + j;
    float uval = Ub[(size_t)t * DM + ch];
    us[j] = uval; __syncthreads();
    const float* wah = wa + ((size_t)(d * 8 + h) * 128) * 128; const float* wxh = wx + ((size_t)(d * 8 + h) * 128) * 128;
    float ra = 0.f, ia = 0.f;
    for (int i = 0; i < 128; ++i) { float u = us[i]; ra += u * wah[i * 128 + j]; ia += u * wxh[i * 128 + j]; }
    float r = 1.f / (1.f + expf(-(ra + ba[d * DM + ch]))); float ig = 1.f / (1.f + expf(-(ia + bx[d * DM + ch])));
    float sp = log1pf(expf(-lam[d * DM + ch]));
    float log_a = -8.f * r * sp;
    Aout[(size_t)t * DM + ch] = expf(log_a); Bout[(size_t)t * DM + ch] = sqrtf(-expm1f(2.f * log_a)) * (ig * uval);
}
__global__ void k_lru_scan(const float* A0, const float* B0, const float* A1, const float* B1, float* YF, float* YB) {
    int g = blockIdx.x * 256 + threadIdx.x; int d = g / DM, ch = g % DM;
    if (d == 0) { float h = B0[ch];
        for (int t = 0; t < SEQ; ++t) { size_t o = (size_t)(CTX + t) * DM + ch; h = A0[o] * h + B0[o]; YF[(size_t)t * DM + ch] = h; }
    } else { float h = B1[(size_t)(CTX - 1) * DM + ch];
        for (int t = SEQ - 1; t >= 0; --t) { size_t o = (size_t)(CTX + t) * DM + ch; h = A1[o] * h + B1[o]; YB[(size_t)t * DM + ch] = h; }
    }
}
__global__ void k_yag_f(const float* YF, const float* YB, bf16* AY, int b) {
    int t = blockIdx.x;
    for (int ch = threadIdx.x; ch < DM; ch += 256) { size_t o = (size_t)t * DM + ch; bf16* p = AY + ((size_t)b * SEQ + t) * DM + ch;
        *p = (bf16)f2bf((YF[o] + YB[o]) * gelu_tanh(bf2f(*p))); }
}
#endif
#if !HG_FAST
__global__ __launch_bounds__(128) void k_hgrn_f(unsigned char* ws, const float* hg_lb) {
    __shared__ float gs[128], ks[128], qs[128];
    int h = blockIdx.x, d = blockIdx.y, b = blockIdx.z, j = threadIdx.x;
    float S[128];
#pragma unroll
    for (int i = 0; i < 128; ++i) S[i] = 0.f;
    const int c = h * 128 + j;
    const float lbj = 1.f / (1.f + expf(hg_lb[DM + c] - hg_lb[c]));
    bf16* Q = (bf16*)(ws + WS_P + 2 * GS); bf16* Fx = (bf16*)(ws + WS_P + (d == 0 ? 3 : 4) * GS); bf16* V = (bf16*)(ws + WS_P + 5 * GS);
    const bf16* Fc = (const bf16*)(ws + WS_PC + (d == 0 ? 1 : 2) * CGS); const bf16* Vc = (const bf16*)(ws + WS_PC + 3 * CGS);
    for (int s = 0; s < LT; ++s) {
        bool isx = s >= CTX; float fv, vv, qv = 0.f; size_t o;
        if (!isx) { int t = d == 0 ? s : (CTX - 1 - s); o = ((size_t)b * CTX + t) * DM + c; fv = bf2f(Fc[o]); vv = bf2f(Vc[o]); }
        else { int p = s - CTX; if (d == 1) p = SEQ - 1 - p; int tok = (p % 32) * 64 + (p / 32); o = ((size_t)b * SEQ + tok) * DM + c; fv = bf2f(Fx[o]); vv = bf2f(V[o]); qv = bf2f(Q[o]); }
        float gg = lbj + (1.f - lbj) / (1.f + expf(-fv));
        gs[j] = gg; ks[j] = 1.f - gg; qs[j] = qv / (1.f + expf(-qv));
        __syncthreads();
        float oo = 0.f;
#pragma unroll
        for (int i = 0; i < 128; ++i) { S[i] = gs[i] * S[i] + ks[i] * vv; oo += S[i] * qs[i]; }
        if (isx) Fx[o] = (bf16)f2bf(oo);
        __syncthreads();
    }
}
#endif

extern "C" void kernel_launch(void* const* d_in, const int* in_sizes, int n_in, void* d_out, int out_size, void* d_ws, size_t ws_size, hipStream_t stream) {
    static int grid = 0;
    if (grid == 0) {
        if (n_in != 29 || out_size != NTOK * DM || ws_size < WS_END) { fprintf(stderr, "kernel_launch: unexpected problem shape / workspace (%d inputs, out %d, ws %zu)\n", n_in, out_size, ws_size); grid = -1; return; }
        int dev = 0, cus = 0, per_cu = 0;
        if (hipGetDevice(&dev) != hipSuccess || hipDeviceGetAttribute(&cus, hipDeviceAttributeMultiprocessorCount, dev) != hipSuccess) { grid = -1; return; }
        if (hipFuncSetAttribute((const void*)mega, hipFuncAttributeMaxDynamicSharedMemorySize, LDS_BYTES) != hipSuccess) { grid = -1; return; }
        if (hipOccupancyMaxActiveBlocksPerMultiprocessor(&per_cu, (const void*)mega, NTHR, LDS_BYTES) != hipSuccess || per_cu < 1) { fprintf(stderr, "kernel_launch: occupancy query says %d blocks per CU\n", per_cu); }
        (void)hipGetLastError();
        grid = cus;
        if (grid != 256) { fprintf(stderr, "kernel_launch: built for 256 CUs, found %d\n", cus); grid = -1; return; }
    }
    if (grid < 0) return;
    hipMemsetAsync((char*)d_ws + WS_CTL, 0, CTL_BYTES, stream);
    Args a{};
    for (int i = 0; i < 29; ++i) a.in[i] = (const float*)d_in[i];
    a.out = (float*)d_out; a.ws = (unsigned char*)d_ws;
#if MIX_FAST
    a.ph_lo = 0; a.ph_hi = 12; a.li = 0;
    hipLaunchKernelGGL(mega, dim3(grid), dim3(NTHR), LDS_BYTES, stream, a);
#else
    a.ph_lo = 0; a.ph_hi = 5; a.li = 0;
    hipLaunchKernelGGL(mega, dim3(grid), dim3(NTHR), LDS_BYTES, stream, a);
    {
        unsigned char* ws = (unsigned char*)d_ws;
#if !LRU_FAST
        float* sc = (float*)d_out;
        float* Ub = sc; float* A0 = Ub + (size_t)LT * DM; float* B0 = A0 + (size_t)LT * DM; float* A1 = B0 + (size_t)LT * DM; float* B1 = A1 + (size_t)LT * DM;
        float* YF = B1 + (size_t)LT * DM; float* YB = YF + (size_t)SEQ * DM;
        const float* cw = (const float*)d_in[IN_CONVW]; const float* cb = (const float*)d_in[IN_CONVB];
        const float* wa = (const float*)d_in[IN_WA]; const float* ba = (const float*)d_in[IN_BA]; const float* wx = (const float*)d_in[IN_WX]; const float* bx = (const float*)d_in[IN_BX]; const float* lam = (const float*)d_in[IN_LAM];
        for (int b = 0; b < NB; ++b) {
            k_conv_f<<<LT, 256, 0, stream>>>((const bf16*)(ws + WS_P), (const bf16*)(ws + WS_PC), cw, cb, Ub, b);
            k_gates<<<dim3(LT, 8), 128, 0, stream>>>(Ub, wa, ba, wx, bx, lam, A0, B0, 0);
            k_gates<<<dim3(LT, 8), 128, 0, stream>>>(Ub, wa, ba, wx, bx, lam, A1, B1, 1);
            k_lru_scan<<<8, 256, 0, stream>>>(A0, B0, A1, B1, YF, YB);
            k_yag_f<<<SEQ, 256, 0, stream>>>(YF, YB, (bf16*)(ws + WS_YAG), b);
        }
#endif
#if !HG_FAST
        k_hgrn_f<<<dim3(8, 2, NB), 128, 0, stream>>>(ws, (const float*)d_in[IN_HGLB]);
#endif
    }
    a.ph_lo = 5; a.ph_hi = 12; a.li = 1;
    hipLaunchKernelGGL(mega, dim3(grid), dim3(NTHR), LDS_BYTES, stream, a);
#endif
}
```

```cpp
#include <hip/hip_runtime.h>
#include <cstdio>
#include <cstdint>
#include <math.h>

#define LAS __attribute__((address_space(3)))
#define GAS __attribute__((address_space(1)))
typedef unsigned short bf16;
typedef short bf16x8 __attribute__((ext_vector_type(8)));
typedef float f32x4 __attribute__((ext_vector_type(4)));
typedef float f32x2 __attribute__((ext_vector_type(2)));
typedef unsigned u32x4 __attribute__((ext_vector_type(4)));
typedef unsigned u32x2 __attribute__((ext_vector_type(2)));

constexpr int DM = 1024, NB = 8, SEQ = 2048, CTX = 256, NTOK = NB * SEQ, NCTX = NB * CTX, INW = 9216, LT = CTX + SEQ;
constexpr int NEXP = 32, DEXP = 512, CAP = 16384;
constexpr float EPS = 1e-6f;
constexpr int NWAVES = 8, NTHR = 512;

constexpr size_t MiB = 1u << 20, KiB = 1024;
constexpr size_t WS_CTL = 0, CTL_BYTES = 64 * KiB;
constexpr size_t WS_MODP = 256 * KiB;
constexpr size_t WS_MOD = 2 * MiB;
constexpr size_t WS_LRUAGG = 2 * MiB + 512 * KiB;
constexpr size_t WS_LRUS0 = 4 * MiB + 512 * KiB;
constexpr size_t WS_WT = 4 * MiB + 768 * KiB;
constexpr size_t WS_LIST = 5 * MiB;
constexpr size_t WS_HGD = 7 * MiB;
constexpr size_t WS_WRT = 7 * MiB + 256 * KiB;
constexpr size_t WS_WIN = 8 * MiB;
constexpr size_t WS_WPA = 26 * MiB, WS_WPB = 28 * MiB, WS_WOUT = 30 * MiB;
constexpr size_t WS_WLRU = 32 * MiB;
constexpr size_t WS_P = 33 * MiB, GS = 32 * MiB;
constexpr size_t WS_PC = 321 * MiB, CGS = 4 * MiB;
constexpr size_t WS_END = 337 * MiB;
constexpr size_t WS_W1T = WS_P + 0 * GS, WS_W3T = WS_P + 2 * GS, WS_W2T = WS_P + 5 * GS;
constexpr size_t WS_YAG = WS_P + 1 * GS;
constexpr size_t WS_OF = WS_P + 3 * GS, WS_OB = WS_P + 4 * GS;
constexpr size_t WS_YBG = WS_P + 3 * GS;
constexpr size_t WS_M = WS_P + 4 * GS;
constexpr size_t WS_HX2 = WS_P + 1 * GS;
constexpr size_t WS_HH = WS_P + 3 * GS;
constexpr size_t WS_Y = WS_P + 6 * GS;

constexpr int CW_BAR = 1024;
constexpr int CW_CNT = 12288;
constexpr int CW_TILE = 14336;
constexpr int CW_LRUG = 15680;
constexpr int CW_PANEL = 15616;

constexpr int RING_BYTES = 131072, LDS_BYTES = 147456, LDSCTL_OFF = LDS_BYTES - 1024;

#define LDS_WAIT() asm volatile("s_waitcnt lgkmcnt(0)" ::: "memory")
#define VM_WAIT() asm volatile("s_waitcnt vmcnt(0)" ::: "memory")

typedef __bf16 bf16x2_t __attribute__((ext_vector_type(2)));
__device__ __forceinline__ unsigned pk2(float lo, float hi) { const f32x2 v = {lo, hi}; return __builtin_bit_cast(unsigned, __builtin_convertvector(v, bf16x2_t)); }
__device__ __forceinline__ unsigned f2bf(float f) { return pk2(f, 0.f) & 0xffffu; }
__device__ __forceinline__ float bf2f(unsigned short b) { return __builtin_bit_cast(float, (unsigned)b << 16); }
__device__ __forceinline__ float bflo(unsigned w) { return __builtin_bit_cast(float, w << 16); }
__device__ __forceinline__ float bfhi(unsigned w) { return __builtin_bit_cast(float, w & 0xffff0000u); }
__device__ __forceinline__ float sigmoidf_(float x) { return 1.f / (1.f + __expf(-x)); }
__device__ __forceinline__ float siluf_(float x) { return x / (1.f + __expf(-x)); }
__device__ __forceinline__ float gelu_tanh(float x) { const float e = __builtin_amdgcn_exp2f((x * 2.3022081985f) * __builtin_fmaf(x * x, 0.044715f, 1.f)); return __builtin_fmaf(-x, __builtin_amdgcn_rcpf(1.f + e), x); }
__device__ __forceinline__ float wave_sum(float v) {
#pragma unroll
    for (int o = 1; o < 64; o <<= 1) v += __shfl_xor(v, o);
    return v;
}

#define XB_TMO      128
#define XB_XCNT(j)  (256  + 64 * (j))
#define XB_XSUB(j)  (1280 + 64 * (j))
#define XB_XGEN(j)  (2304 + 64 * (j))
#define XB_TOP      3328
#define XB_TOPGEN   3392
#define XCD_BAR_WORDS 3456
#define XB_SPIN_CAP (1u << 20)
__device__ __forceinline__ unsigned xb_ld(unsigned* p)              { return __hip_atomic_load(p, __ATOMIC_RELAXED, __HIP_MEMORY_SCOPE_AGENT); }
__device__ __forceinline__ unsigned xb_add(unsigned* p, unsigned v) { return __hip_atomic_fetch_add(p, v, __ATOMIC_RELAXED, __HIP_MEMORY_SCOPE_AGENT); }
__device__ __forceinline__ unsigned xb_xcc_id() { return (unsigned)__builtin_amdgcn_s_getreg((3 << 11) | 20) & 0xFu; }
#define XB_SPIN(cond, bar) do { unsigned _sp = 0; while (cond) { __builtin_amdgcn_s_sleep(1); \
    if ((++_sp & 255u) == 0u) { if (xb_ld(&(bar)[XB_TMO])) break; if (_sp > XB_SPIN_CAP) { atomicAdd(&(bar)[XB_TMO], 1u); break; } } } } while (0)
struct XcdBarrier { unsigned* bar; unsigned x; volatile LAS unsigned* st; };
__device__ __forceinline__ XcdBarrier xcd_barrier_post(unsigned* bar, volatile LAS unsigned* st) {
    XcdBarrier b; b.bar = bar; b.x = xb_xcc_id(); b.st = st;
    if (threadIdx.x == 0) (void)xb_add(&bar[XB_XCNT(b.x)], 1u);
    return b;
}
__device__ __forceinline__ void xcd_barrier_complete(unsigned* bar, unsigned x, unsigned& nloc, unsigned& nx) {
    const unsigned G = gridDim.x * gridDim.y * gridDim.z;
    unsigned sum, cnt, mine, sp = 0u;
    for (;;) {
        sum = 0u; cnt = 0u; mine = 0u;
#pragma unroll
        for (unsigned j = 0; j < 16; ++j) { const unsigned c = xb_ld(&bar[XB_XCNT(j)]); sum += c; cnt += (c > 0u) ? 1u : 0u; mine = (j == x) ? c : mine; }
        if (sum == G) break;
        __builtin_amdgcn_s_sleep(1);
        if ((++sp & 255u) == 0u) { if (xb_ld(&bar[XB_TMO])) break; if (sp > XB_SPIN_CAP) { atomicAdd(&bar[XB_TMO], 1u); break; } }
    }
    nloc = mine > 0u ? mine : 1u; nx = cnt > 0u ? cnt : 1u;
}
__device__ __forceinline__ void xcd_barrier(const XcdBarrier& b) {
    asm volatile("s_waitcnt vmcnt(0)" ::: "memory");
    __syncthreads();
    if (threadIdx.x == 0) {
        unsigned* bar = b.bar;
        __builtin_amdgcn_s_waitcnt(0);
        unsigned nloc = b.st[0], nx = b.st[1];
        if (nloc == 0u) { xcd_barrier_complete(bar, b.x, nloc, nx); b.st[0] = nloc; b.st[1] = nx; }
        const unsigned old = xb_add(&bar[XB_XSUB(b.x)], 1u);
        const unsigned gen = old / nloc;
        if (old + 1u == (gen + 1u) * nloc) {
            __builtin_amdgcn_fence(__ATOMIC_RELEASE, "agent");
            asm volatile("s_waitcnt vmcnt(0)" ::: "memory");
            const unsigned og = xb_add(&bar[XB_TOP], 1u);
            const unsigned tg = og / nx;
            if (og + 1u == (tg + 1u) * nx) xb_add(&bar[XB_TOPGEN], 1u);
            else XB_SPIN(xb_ld(&bar[XB_TOPGEN]) == tg, bar);
            __builtin_amdgcn_fence(__ATOMIC_ACQUIRE, "agent");
            xb_add(&bar[XB_XGEN(b.x)], 1u);
            asm volatile("s_waitcnt vmcnt(0)" ::: "memory");
        } else {
            XB_SPIN(xb_ld(&bar[XB_XGEN(b.x)]) == gen, bar);
            __builtin_amdgcn_fence(__ATOMIC_ACQUIRE, "agent");
            asm volatile("s_waitcnt vmcnt(0)" ::: "memory");
        }
    }
    __syncthreads();
}

namespace gm {
constexpr int BM = 256, BK = 64, HALF = 128, HTB = HALF * BK * 2;
__device__ __forceinline__ int lds_byte(int r, int c) { const int st = (r >> 4) * 2 + (c >> 5), rr = r & 15, cc = c & 31, ob = rr * 64 + cc * 2; return st * 1024 + (ob ^ (((ob >> 9) & 1) << 5)); }
__device__ __forceinline__ void stage_rc(int b, int& R, int& C) { const int st = b / 1024, sb = b % 1024, swz = sb ^ (((sb >> 9) & 1) << 5); R = (st >> 1) * 16 + swz / 64; C = (st & 1) * 32 + (swz % 64) / 2; }
__device__ __forceinline__ int perm32(int rho) { const int n = rho >> 4, i = rho & 15; return 8 * (i >> 2) + 4 * n + (i & 3); }
__device__ __forceinline__ unsigned cvt_pk_bf16(float lo, float hi) { unsigned r; asm volatile("v_cvt_pk_bf16_f32 %0, %1, %2" : "=v"(r) : "v"(lo), "v"(hi)); return r; }

struct Unit { const char* A; const char* B0; const char* B1; char* dst; int pm, pn, e, rows, t; };

template <class Sched, class Epi, bool GATHER, bool HOOKS = false>
__device__ __forceinline__ void gemm_phase(LAS unsigned char* lds, const int K, const Sched& S, const Epi& E) {
    const int tid = threadIdx.x, wid = __builtin_amdgcn_readfirstlane(tid >> 6), lane = tid & 63, wr = wid >> 2, wc = wid & 3, fr = lane & 15, fq = lane >> 4;
    const int nt = K / BK;
    unsigned voffB[2]; int Rr[2]; unsigned Cb[2];
#pragma unroll
    for (int i = 0; i < 2; ++i) { int R, C; stage_rc(tid * 16 + i * 8192, R, C); const int Rb = Epi::PERM ? ((R & ~31) + perm32(R & 31)) : R;
        Rr[i] = R; Cb[i] = (unsigned)C * 2u; voffB[i] = (unsigned)(Rb * K + C) * 2u; }
    const unsigned rowb = (unsigned)K * 2u;
    const size_t kstep = (size_t)(BK * 2);
    const unsigned ldsw = (unsigned)wid * 1024u;
    const int aoff = lds_byte(wr * 64 + fr, fq * 8), boff = lds_byte(wc * 32 + fr, fq * 8);
#define GM_SA(b, h) (((b) * 2 + (h)) * HTB)
#define GM_SB(b, h) ((4 + (b) * 2 + (h)) * HTB)
#define GM_STAGE(bufoff, gbase, voff) do { _Pragma("unroll") for (int _i = 0; _i < 2; ++_i) \
        __builtin_amdgcn_global_load_lds((const unsigned*)((const char*)(gbase) + (voff)[_i]), (LAS unsigned*)(lds + (bufoff) + ldsw + _i * 8192), 16, 0, 0); } while (0)
#define GM_LDA(dst, b, h) do { _Pragma("unroll") for (int m = 0; m < 4; ++m) _Pragma("unroll") for (int k = 0; k < 2; ++k) dst[m][k] = *(const LAS bf16x8*)(lds + GM_SA(b, h) + aoff + m * 2048 + k * 1024); } while (0)
#define GM_LDB(dst, b, h) do { _Pragma("unroll") for (int n = 0; n < 2; ++n) _Pragma("unroll") for (int k = 0; k < 2; ++k) dst[n][k] = *(const LAS bf16x8*)(lds + GM_SB(b, h) + boff + n * 2048 + k * 1024); } while (0)
#define GM_MMA(ai, bj, At, Bt) do { __builtin_amdgcn_s_setprio(1); _Pragma("unroll") for (int m = 0; m < 4; ++m) _Pragma("unroll") for (int n = 0; n < 2; ++n) _Pragma("unroll") for (int k = 0; k < 2; ++k) \
        acc[ai][bj][m][n] = __builtin_amdgcn_mfma_f32_16x16x32_bf16(Bt[n][k], At[m][k], acc[ai][bj][m][n], 0, 0, 0); __builtin_amdgcn_s_setprio(0); } while (0)
#define GM_WAIT_V(n) asm volatile("s_waitcnt vmcnt(" #n ")" ::: "memory")
#define GM_WAIT_L(n) asm volatile("s_waitcnt lgkmcnt(" #n ")" ::: "memory")
#define GM_BAR __builtin_amdgcn_s_barrier()
#define GM_SCHED __builtin_amdgcn_sched_barrier(0)
#define GM_AOFFS(u, o) do { _Pragma("unroll") for (int _h = 0; _h < 2; ++_h) _Pragma("unroll") for (int _i = 0; _i < 2; ++_i) \
        (o)[_h][_i] = (GATHER ? S.arow((u), _h * HALF + Rr[_i]) : (unsigned)(_h * HALF + Rr[_i])) * rowb + Cb[_i]; } while (0)
    Unit cur, nxt; int ui = 0;
    if (!S.next(0, cur)) return;
    f32x4 acc[2][2][4][2];
#pragma unroll
    for (int a = 0; a < 2; ++a)
#pragma unroll
        for (int b = 0; b < 2; ++b)
#pragma unroll
            for (int m = 0; m < 4; ++m)
#pragma unroll
                for (int n = 0; n < 2; ++n) acc[a][b][m][n] = (f32x4){0.f, 0.f, 0.f, 0.f};
    bf16x8 At[4][2], B0[2][2], B1[2][2];
    unsigned ca[2][2], na[2][2];
    GM_AOFFS(cur, ca);
    const char* cA = cur.A; const char* cB0 = cur.B0; const char* cB1 = cur.B1;
    if constexpr (HOOKS) S.a_ready(cur);
    GM_STAGE(GM_SB(0, 0), cB0, voffB); GM_STAGE(GM_SB(0, 1), cB1, voffB); GM_STAGE(GM_SA(0, 0), cA, ca[0]); GM_STAGE(GM_SA(0, 1), cA, ca[1]);
    if (wr == 1) GM_BAR;
    GM_WAIT_V(2); GM_BAR;
    GM_STAGE(GM_SB(1, 0), cB0 + kstep, voffB); GM_STAGE(GM_SA(1, 0), cA + kstep, ca[0]); GM_STAGE(GM_SB(1, 1), cB1 + kstep, voffB);
    GM_WAIT_V(6); GM_BAR;
    for (;;) {
        const bool has_next = S.next(ui + 1, nxt);
        const char* nA = has_next ? nxt.A : cA; const char* nB0 = has_next ? nxt.B0 : cB0; const char* nB1 = has_next ? nxt.B1 : cB1;
        if (has_next) { GM_AOFFS(nxt, na); } else {
#pragma unroll
            for (int h = 0; h < 2; ++h)
#pragma unroll
                for (int i = 0; i < 2; ++i) na[h][i] = ca[h][i]; }
        for (int t = 0; t < nt; t += 2) {
            const bool last = (t == nt - 2);
            if constexpr (HOOKS) { if (last && has_next) S.a_ready(nxt); }
            const char* a1 = cA + (size_t)(t + 1) * kstep;
            const char* a2 = last ? nA : cA + (size_t)(t + 2) * kstep;
            const char* b20 = last ? nB0 : cB0 + (size_t)(t + 2) * kstep; const char* b21 = last ? nB1 : cB1 + (size_t)(t + 2) * kstep;
            const char* a3 = a2 + kstep; const char* b30 = b20 + kstep; const char* b31 = b21 + kstep;
            unsigned o2[2][2];
#pragma unroll
            for (int h = 0; h < 2; ++h)
#pragma unroll
                for (int i = 0; i < 2; ++i) o2[h][i] = last ? na[h][i] : ca[h][i];
            GM_LDB(B0, 0, 0); GM_LDB(B1, 0, 1); GM_SCHED; GM_LDA(At, 0, 0); GM_STAGE(GM_SA(1, 1), a1, ca[1]);
            GM_WAIT_V(8); GM_WAIT_L(0); GM_BAR; GM_MMA(0, 0, At, B0); GM_MMA(0, 1, At, B1); GM_BAR; GM_SCHED;
            GM_LDA(At, 0, 1); GM_STAGE(GM_SB(0, 0), b20, voffB); GM_STAGE(GM_SB(0, 1), b21, voffB); GM_STAGE(GM_SA(0, 0), a2, o2[0]);
            GM_WAIT_V(8); GM_WAIT_L(0); GM_BAR; GM_MMA(1, 0, At, B0); GM_MMA(1, 1, At, B1); GM_BAR; GM_SCHED;
            GM_LDB(B0, 1, 0); GM_LDB(B1, 1, 1); GM_SCHED; GM_LDA(At, 1, 0); GM_STAGE(GM_SA(0, 1), a2, o2[1]);
            GM_WAIT_V(8); GM_WAIT_L(0); GM_BAR; GM_MMA(0, 0, At, B0); GM_MMA(0, 1, At, B1); GM_BAR; GM_SCHED;
            GM_LDA(At, 1, 1); GM_STAGE(GM_SB(1, 0), b30, voffB); GM_STAGE(GM_SB(1, 1), b31, voffB); GM_STAGE(GM_SA(1, 0), a3, o2[0]);
            GM_WAIT_V(8); GM_WAIT_L(0); GM_BAR; GM_MMA(1, 0, At, B0); GM_MMA(1, 1, At, B1); GM_BAR; GM_SCHED;
        }
        if (wr == 0) GM_BAR;
        E(acc, cur, wr, wc, fr, fq);
        if constexpr (HOOKS) S.done(cur);
        if (!has_next) break;
#pragma unroll
        for (int a = 0; a < 2; ++a)
#pragma unroll
            for (int b = 0; b < 2; ++b)
#pragma unroll
                for (int m = 0; m < 4; ++m)
#pragma unroll
                    for (int n = 0; n < 2; ++n) acc[a][b][m][n] = (f32x4){0.f, 0.f, 0.f, 0.f};
        cur = nxt; cA = nA; cB0 = nB0; cB1 = nB1; ++ui;
#pragma unroll
        for (int h = 0; h < 2; ++h)
#pragma unroll
            for (int i = 0; i < 2; ++i) ca[h][i] = na[h][i];
        if (wr == 1) GM_BAR;
    }
    GM_WAIT_V(0);
    GM_BAR;
#undef GM_SA
#undef GM_SB
#undef GM_STAGE
#undef GM_LDA
#undef GM_LDB
#undef GM_MMA
#undef GM_WAIT_V
#undef GM_WAIT_L
#undef GM_BAR
#undef GM_SCHED
#undef GM_AOFFS
}
}
struct Args {
    const float* in[29]; float* out; unsigned char* ws; int ph_lo, ph_hi, li, pad;
};
struct Frame {
    LAS unsigned char* lds; volatile LAS unsigned* MISC;
    unsigned* ctl; unsigned char* ws; float* out;
    int tid, lane, wave, G, bid;
};
enum { IN_X = 0, IN_C, IN_CTX, IN_CCTX, IN_WMOD, IN_BMOD, IN_G1, IN_WIN, IN_CONVW, IN_CONVB, IN_WA, IN_BA, IN_WX, IN_BX, IN_LAM, IN_HGLB, IN_HGN,
       IN_WPA, IN_WPB, IN_WOUT, IN_G2, IN_WRG, IN_BRG, IN_WRE, IN_BRE, IN_W1, IN_W3, IN_W2, IN_FG };

constexpr int TR_BYTES = 64 * 64 * 4;
__device__ __forceinline__ void transpose_item(const float* W, int ldw, int K, bf16* WT, int k0, int n0, LAS float* scr, int lane) {
    const int lr = lane >> 4, ls = lane & 15;
    f32x4 v[16];
#pragma unroll
    for (int i = 0; i < 16; ++i) v[i] = *(const f32x4*)(W + (size_t)(k0 + 4 * i + lr) * ldw + n0 + 4 * ls);
#pragma unroll
    for (int i = 0; i < 16; ++i) { const int k = 4 * i + lr; *(LAS f32x4*)(scr + k * 64 + ((ls ^ ((k >> 3) & 7)) << 2)) = v[i]; }
    LDS_WAIT(); asm volatile("" ::: "memory");
    const int c = lane & 7;
#pragma unroll
    for (int j = 0; j < 8; ++j) { const int n = (lane >> 3) + 8 * j; const LAS float* s = scr + (8 * c) * 64 + ((((n >> 2) ^ c) << 2) | (n & 3));
        u32x4 o; o.x = pk2(s[0 * 64], s[1 * 64]); o.y = pk2(s[2 * 64], s[3 * 64]); o.z = pk2(s[4 * 64], s[5 * 64]); o.w = pk2(s[6 * 64], s[7 * 64]);
        *(u32x4*)(WT + (size_t)n * K + k0 + 8 * c) = o; }
    LDS_WAIT(); asm volatile("" ::: "memory");
}

__device__ __forceinline__ void p0_mod_item(Frame& F, const Args& a, int item) {
    const int cb = item % 24, ks = item / 24;
    LAS float* sv = (LAS float*)F.lds;
    LAS float* red = sv + 9 * 128;
    const float* c = a.in[IN_C]; const float* cc = a.in[IN_CCTX]; const float* wmod = a.in[IN_WMOD];
    for (int i = F.tid; i < 9 * 128; i += NTHR) { const int r = i >> 7, k = i & 127; const float v = r < 8 ? c[r * DM + ks * 128 + k] : cc[ks * 128 + k]; sv[i] = siluf_(v); }
    __syncthreads();
    const int col = cb * 256 + (F.tid & 255), kh = F.tid >> 8;
    float acc[9];
#pragma unroll
    for (int r = 0; r < 9; ++r) acc[r] = 0.f;
    for (int k0 = 0; k0 < 64; k0 += 16) { float wv[16];
#pragma unroll
        for (int k = 0; k < 16; ++k) wv[k] = wmod[(size_t)(ks * 128 + kh * 64 + k0 + k) * 6144 + col];
#pragma unroll
        for (int k = 0; k < 16; ++k) { const int kk = kh * 64 + k0 + k;
#pragma unroll
            for (int r = 0; r < 9; ++r) acc[r] += sv[r * 128 + kk] * wv[k]; } }
    if (kh == 1) {
#pragma unroll
        for (int r = 0; r < 9; ++r) red[r * 256 + (F.tid & 255)] = acc[r]; }
    __syncthreads();
    float* modp = (float*)(F.ws + WS_MODP);
    if (kh == 0) {
#pragma unroll
        for (int r = 0; r < 9; ++r) modp[(size_t)(ks * 9 + r) * 6144 + col] = acc[r] + red[r * 256 + F.tid]; }
    __syncthreads();
}
__device__ __forceinline__ float mod_from_partials(const float* modp, const float* bmod, int row, int j) {
    float s = bmod[j];
#pragma unroll
    for (int ks = 0; ks < 8; ++ks) s += modp[(size_t)(ks * 9 + row) * 6144 + j];
    return s;
}

__device__ __forceinline__ void p0_prologue(Frame& F, const Args& a) {
    if (F.bid < 192) p0_mod_item(F, a, F.bid);
    LAS float* scr = (LAS float*)(F.lds + F.wave * TR_BYTES);
    const int gw = F.bid * NWAVES + F.wave, NGW = F.G * NWAVES;
    constexpr int I_IN = 16 * 144, I_PR = 16 * 16, I_LRU = 32 * 4;
    constexpr int NITEMS = I_IN + 3 * I_PR + I_LRU;
    for (int it = gw; it < NITEMS; it += NGW) {
        int r = it;
        if (r < I_IN) { const int kb = r / 144, nb = r % 144; transpose_item(a.in[IN_WIN], INW, DM, (bf16*)(F.ws + WS_WIN) + (size_t)(nb * 64) * DM, kb * 64, nb * 64, scr, F.lane); continue; } r -= I_IN;
        if (r < 3 * I_PR) { const int w = r / I_PR, q = r % I_PR, kb = q / 16, nb = q % 16;
            const float* W = a.in[w == 0 ? IN_WPA : (w == 1 ? IN_WPB : IN_WOUT)]; bf16* WT = (bf16*)(F.ws + (w == 0 ? WS_WPA : (w == 1 ? WS_WPB : WS_WOUT)));
            transpose_item(W, DM, DM, WT + (size_t)(nb * 64) * DM, kb * 64, nb * 64, scr, F.lane); continue; } r -= 3 * I_PR;
        { const int mat = r / 4, q = r % 4, kb = q / 2, nb = q % 2;
          const int which = mat >> 4, dh = mat & 15;
          const float* W = a.in[which == 0 ? IN_WA : IN_WX] + (size_t)dh * 128 * 128; bf16* WT = (bf16*)(F.ws + WS_WLRU) + (size_t)mat * 128 * 128;
          transpose_item(W, 128, 128, WT + (size_t)(nb * 64) * 128, kb * 64, nb * 64, scr, F.lane); }
    }
    { u32x4* z = (u32x4*)(F.ws + WS_LRUAGG);
      for (int i = F.bid * NTHR + F.tid; i < (int)((2 * MiB + 128 * KiB) / 16); i += F.G * NTHR) z[i] = (u32x4){0u, 0u, 0u, 0u}; }
    float* wrp = (float*)(F.ws + WS_WRT);
    for (int i = F.bid * NTHR + F.tid; i < 49152 + 48; i += F.G * NTHR) {
        if (i < 49152) { const int j = i & 3, ln = (i >> 2) & 63, sc = i >> 8, c = sc % 3, s2 = sc / 3; const int k = 16 * s2 + 4 * (ln >> 4) + j, o = 16 * c + (ln & 15);
            wrp[i] = o < 4 ? a.in[IN_WRG][k * 4 + o] : (o < 36 ? a.in[IN_WRE][k * 32 + (o - 4)] : 0.f); }
        else { const int o = i - 49152; wrp[i] = o < 4 ? a.in[IN_BRG][o] : (o < 36 ? a.in[IN_BRE][o - 4] : 0.f); }
    }
}

__device__ __forceinline__ void norm_rows(Frame& F, const float* src, bf16* dst, int row0, int nrows, const LAS float* gs, const LAS float* sh) {
    for (int r = F.wave; r < nrows; r += 2 * NWAVES) {
        const int r1 = r + NWAVES < nrows ? r + NWAVES : r;
        const f32x4* xa = (const f32x4*)(src + (size_t)(row0 + r) * DM) + F.lane; const f32x4* xb = (const f32x4*)(src + (size_t)(row0 + r1) * DM) + F.lane;
        f32x4 va[4], vb[4]; float sa = 0.f, sb = 0.f;
#pragma unroll
        for (int j = 0; j < 4; ++j) { va[j] = xa[64 * j]; vb[j] = xb[64 * j]; }
#pragma unroll
        for (int j = 0; j < 4; ++j) { sa += (va[j].x * va[j].x + va[j].y * va[j].y) + (va[j].z * va[j].z + va[j].w * va[j].w); sb += (vb[j].x * vb[j].x + vb[j].y * vb[j].y) + (vb[j].z * vb[j].z + vb[j].w * vb[j].w); }
        const float ra = rsqrtf(wave_sum(sa) * (1.f / DM) + EPS), rb = rsqrtf(wave_sum(sb) * (1.f / DM) + EPS);
        unsigned long long* oa = (unsigned long long*)(dst + (size_t)(row0 + r) * DM) + F.lane; unsigned long long* ob = (unsigned long long*)(dst + (size_t)(row0 + r1) * DM) + F.lane;
#pragma unroll
        for (int j = 0; j < 4; ++j) { const int k = 4 * F.lane + 256 * j;
            const f32x4 g = *(const LAS f32x4*)(gs + k), h = *(const LAS f32x4*)(sh + k);
            oa[64 * j] = (unsigned long long)pk2(va[j].x * ra * g.x + h.x, va[j].y * ra * g.y + h.y) | ((unsigned long long)pk2(va[j].z * ra * g.z + h.z, va[j].w * ra * g.w + h.w) << 32);
            ob[64 * j] = (unsigned long long)pk2(vb[j].x * rb * g.x + h.x, vb[j].y * rb * g.y + h.y) | ((unsigned long long)pk2(vb[j].z * rb * g.z + h.z, vb[j].w * rb * g.w + h.w) << 32); }
    }
}
struct EpiStoreBf16 {
    static constexpr bool PERM = true;
    __device__ __forceinline__ void operator()(const f32x4 (&acc)[2][2][4][2], const gm::Unit& u, int wr, int wc, int fr, int fq) const {
        bf16* base = (bf16*)u.dst + (size_t)(wr * 64 + fr) * DM + wc * 32 + 8 * fq;
#pragma unroll
        for (int ai = 0; ai < 2; ++ai)
#pragma unroll
            for (int m = 0; m < 4; ++m) { bf16* rowp = base + (size_t)(ai * 128 + m * 16) * DM;
#pragma unroll
                for (int bj = 0; bj < 2; ++bj) { const f32x4 v0 = acc[ai][bj][m][0], v1 = acc[ai][bj][m][1];
                    u32x4 w; w.x = gm::cvt_pk_bf16(v0[0], v0[1]); w.y = gm::cvt_pk_bf16(v0[2], v0[3]); w.z = gm::cvt_pk_bf16(v1[0], v1[1]); w.w = gm::cvt_pk_bf16(v1[2], v1[3]);
                    *(u32x4*)(rowp + bj * 128) = w; } }
    }
};
__device__ __forceinline__ void tile_order(int L, int nM, int nN, int& pm, int& pn) {
    const int nwg = nM * nN; int wgid = L;
    { const int q = nwg / 8, r = nwg % 8, xcd = wgid % 8, off = wgid / 8; wgid = (xcd < r ? xcd * (q + 1) : r * (q + 1) + (xcd - r) * q) + off; }
    const int nig = 8 * nN, gid = wgid / nig, fm = gid * 8, gsz = (nM - fm) < 8 ? (nM - fm) : 8;
    pm = fm + ((wgid % nig) % gsz); pn = (wgid % nig) / gsz;
}
struct SchedP2 {
    int G, c; const char* H; const char* Wt; char* P; char* PC;
    __device__ __forceinline__ bool next(int i, gm::Unit& u) const {
        int L = i * G + c;
        if (L < 64 * 36) { int pm, pn; tile_order(L, 64, 36, pm, pn);
            u.A = H + (size_t)pm * 256 * 2048; u.B0 = Wt + (size_t)pn * 256 * 2048; u.B1 = u.B0 + (size_t)128 * 2048;
            u.dst = P + (size_t)(pn >> 2) * GS + ((size_t)pm * 256 * DM + (pn & 3) * 256) * 2; u.pm = pm; u.pn = pn; u.e = 0; u.rows = 256; return true; }
        return false;
    }
    __device__ __forceinline__ unsigned arow(const gm::Unit&, int r) const { return (unsigned)r; }
};
struct SchedCtx {
    int bid; const char* H; const char* Wt; char* PC; unsigned* cnt; unsigned* tmo;
    __device__ __forceinline__ bool next(int i, gm::Unit& u) const {
        if (i > 0) return false;
        const int pmc = bid >> 4, j = bid & 15, slot = j >> 2, g = slot == 0 ? 0 : slot + 2, pn = g * 4 + (j & 3);
        u.A = H + (size_t)(NTOK + pmc * 256) * 2048; u.B0 = Wt + (size_t)pn * 256 * 2048; u.B1 = u.B0 + (size_t)128 * 2048;
        u.dst = PC + (size_t)slot * CGS + ((size_t)pmc * 256 * DM + (j & 3) * 256) * 2; u.pm = pmc; u.pn = pn; u.e = 0; u.rows = 256; u.t = pmc; return true;
    }
    __device__ __forceinline__ unsigned arow(const gm::Unit&, int r) const { return (unsigned)r; }
    __device__ __forceinline__ void a_ready(const gm::Unit& u) const {
        if (threadIdx.x < 64) {
            unsigned spins = 0;
            while ((unsigned)__builtin_amdgcn_readfirstlane(__hip_atomic_load(cnt + 8 * u.t, __ATOMIC_RELAXED, __HIP_MEMORY_SCOPE_AGENT)) < 16u) {
                __builtin_amdgcn_s_sleep(2);
                if (++spins > (1u << 22)) { if (threadIdx.x == 0) __hip_atomic_store(tmo, 1u, __ATOMIC_RELAXED, __HIP_MEMORY_SCOPE_AGENT); break; } }
            __builtin_amdgcn_fence(__ATOMIC_ACQUIRE, "agent");
            asm volatile("s_waitcnt vmcnt(0)" ::: "memory");
        }
        asm volatile("" ::: "memory"); __builtin_amdgcn_s_barrier(); asm volatile("" ::: "memory");
    }
    __device__ __forceinline__ void done(const gm::Unit&) const {}
};
__device__ __forceinline__ void p1_norm(Frame& F, const Args& a) {
    const float* modp = (const float*)(F.ws + WS_MODP); const float* bmod = a.in[IN_BMOD]; const float* g1 = a.in[IN_G1];
    LAS float* gs = (LAS float*)F.lds; LAS float* sh = gs + DM;
    bf16* H = (bf16*)F.out;
    float* mod = (float*)(F.ws + WS_MOD);
    for (int i = F.bid * NTHR + F.tid; i < 9 * 6144; i += F.G * NTHR) mod[i] = mod_from_partials(modp, bmod, i / 6144, i % 6144);
    if (F.bid >= 128) {
        const int wg = F.bid - 128, b = wg >> 4;
        for (int k = F.tid; k < DM; k += NTHR) { gs[k] = g1[k] * (1.f + mod_from_partials(modp, bmod, b, DM + k)); sh[k] = mod_from_partials(modp, bmod, b, k); }
        __syncthreads();
        norm_rows(F, a.in[IN_X], H, wg * 128, 128, gs, sh);
        __syncthreads();
    } else {
        for (int k = F.tid; k < DM; k += NTHR) { gs[k] = g1[k] * (1.f + mod_from_partials(modp, bmod, 8, DM + k)); sh[k] = mod_from_partials(modp, bmod, 8, k); }
        __syncthreads();
        const int pmc = F.bid >> 4, r0 = pmc * 256 + (F.bid & 15) * 16;
        const __amdgpu_buffer_rsrc_t rs = __builtin_amdgcn_make_buffer_rsrc((void*)(H + (size_t)NTOK * DM), 0, 0x7fffffff, 0x00020000);
#pragma unroll
        for (int q = 0; q < 2; ++q) {
            const int row = r0 + 2 * F.wave + q;
            const f32x4* xr = (const f32x4*)(a.in[IN_CTX] + (size_t)row * DM) + 2 * F.lane;
            f32x4 v[2][2]; float sq = 0.f;
#pragma unroll
            for (int j = 0; j < 2; ++j) { v[j][0] = xr[128 * j]; v[j][1] = xr[128 * j + 1];
                sq += (v[j][0].x * v[j][0].x + v[j][0].y * v[j][0].y) + (v[j][0].z * v[j][0].z + v[j][0].w * v[j][0].w) + (v[j][1].x * v[j][1].x + v[j][1].y * v[j][1].y) + (v[j][1].z * v[j][1].z + v[j][1].w * v[j][1].w); }
            const float rstd = rsqrtf(wave_sum(sq) * (1.f / DM) + EPS);
#pragma unroll
            for (int j = 0; j < 2; ++j) { const int k = 8 * F.lane + 512 * j;
                const f32x4 ga = *(const LAS f32x4*)(gs + k), gb = *(const LAS f32x4*)(gs + k + 4), ha = *(const LAS f32x4*)(sh + k), hb = *(const LAS f32x4*)(sh + k + 4);
                u32x4 w; w.x = pk2(v[j][0].x * rstd * ga.x + ha.x, v[j][0].y * rstd * ga.y + ha.y); w.y = pk2(v[j][0].z * rstd * ga.z + ha.z, v[j][0].w * rstd * ga.w + ha.w);
                w.z = pk2(v[j][1].x * rstd * gb.x + hb.x, v[j][1].y * rstd * gb.y + hb.y); w.w = pk2(v[j][1].z * rstd * gb.z + hb.z, v[j][1].w * rstd * gb.w + hb.w);
                __builtin_amdgcn_raw_buffer_store_b128(w, rs, (unsigned)(((size_t)row * DM + k) * 2), 0, 16); }
        }
        asm volatile("s_waitcnt vmcnt(0)" ::: "memory");
        __syncthreads();
        unsigned* pcnt = F.ctl + CW_PANEL;
        if (F.tid == 0) __hip_atomic_fetch_add(pcnt + 8 * pmc, 1u, __ATOMIC_RELAXED, __HIP_MEMORY_SCOPE_AGENT);
        SchedCtx S{F.bid, (const char*)F.out, (const char*)(F.ws + WS_WIN), (char*)(F.ws + WS_PC), pcnt, F.ctl + 3};
        EpiStoreBf16 E;
        gm::gemm_phase<SchedCtx, EpiStoreBf16, false, true>(F.lds, DM, S, E);
    }
}

#ifdef PROBE_A
#define HSTAMP(i) do { if (F.bid == 0 && F.tid == 0) { const unsigned long long _t = __builtin_amdgcn_s_memrealtime(); const unsigned long long _p = ((unsigned long long)F.MISC[101] << 32) | F.MISC[100]; \
    unsigned long long _a = ((unsigned long long)F.MISC[103 + 2 * (i)] << 32) | F.MISC[102 + 2 * (i)]; _a += _t - _p; F.MISC[102 + 2 * (i)] = (unsigned)_a; F.MISC[103 + 2 * (i)] = (unsigned)(_a >> 32); F.MISC[100] = (unsigned)_t; F.MISC[101] = (unsigned)(_t >> 32); } } while (0)
#else
#define HSTAMP(i) do { } while (0)
#endif
constexpr int LRU_T = 128, LRU_NCH = SEQ / LRU_T, UF_LD = 144;
constexpr int LRU_UBF = 0, LRU_UF = 144 * 256;
constexpr float LOG2E = 1.4426950408889634f;

struct LruCoef { float ba, bx, ca; };

struct LruConvW { float w[4][8], bs[8]; };
__device__ __forceinline__ void lru_conv_weights(Frame& F, const Args& a, int h, LruConvW& cwv) {
    const float* cw = a.in[IN_CONVW] + h * 128; const float* cb = a.in[IN_CONVB] + h * 128; const int cg = F.tid & 15;
#pragma unroll
    for (int k = 0; k < 4; ++k) { const f32x4 w0 = *(const f32x4*)(cw + k * DM + 8 * cg), w1 = *(const f32x4*)(cw + k * DM + 8 * cg + 4);
        cwv.w[k][0] = w0.x; cwv.w[k][1] = w0.y; cwv.w[k][2] = w0.z; cwv.w[k][3] = w0.w; cwv.w[k][4] = w1.x; cwv.w[k][5] = w1.y; cwv.w[k][6] = w1.z; cwv.w[k][7] = w1.w; }
    { const f32x4 b0 = *(const f32x4*)(cb + 8 * cg), b1 = *(const f32x4*)(cb + 8 * cg + 4); cwv.bs[0] = b0.x; cwv.bs[1] = b0.y; cwv.bs[2] = b0.z; cwv.bs[3] = b0.w; cwv.bs[4] = b1.x; cwv.bs[5] = b1.y; cwv.bs[6] = b1.z; cwv.bs[7] = b1.w; }
}
__device__ __forceinline__ void lru_conv_load(Frame& F, int b, int h, int c, u32x4 (&raw)[4][4]) {
    const bf16* AX = (const bf16*)(F.ws + WS_P) + (size_t)b * SEQ * DM + h * 128;
    int cg = F.tid & 15, tl0 = F.tid >> 4;
    asm volatile("" : "+v"(cg), "+v"(tl0));
#pragma unroll
    for (int i = 0; i < 4; ++i)
#pragma unroll
        for (int k = 0; k < 4; ++k) { int tt = c * LRU_T + tl0 + 32 * i + k - 2; tt = tt < 0 ? 0 : (tt > SEQ - 1 ? SEQ - 1 : tt); raw[i][k] = *(const u32x4*)(AX + (size_t)tt * DM + 8 * cg); }
}
__device__ __forceinline__ void lru_conv(Frame& F, const LruConvW& cwv, const u32x4 (&raw)[4][4], int b, int h, int c, bool special) {
    LAS unsigned char* ubf = F.lds + LRU_UBF; LAS float* uf = (LAS float*)(F.lds + LRU_UF);
    int cg = F.tid & 15, tl0 = F.tid >> 4;
    asm volatile("" : "+v"(cg), "+v"(tl0));
    const float (&w)[4][8] = cwv.w; const float (&bs)[8] = cwv.bs;
#pragma unroll
    for (int i = 0; i < 4; ++i) { const int tl = tl0 + 32 * i;
        float u[8];
#pragma unroll
        for (int q = 0; q < 8; ++q) u[q] = bs[q];
#pragma unroll
        for (int k = 0; k < 4; ++k) { const int tt = c * LRU_T + tl + k - 2; const float mk = (tt >= 0 && tt < SEQ) ? 1.f : 0.f; const u32x4 v = raw[i][k];
            u[0] += mk * w[k][0] * bflo(v.x); u[1] += mk * w[k][1] * bfhi(v.x); u[2] += mk * w[k][2] * bflo(v.y); u[3] += mk * w[k][3] * bfhi(v.y);
            u[4] += mk * w[k][4] * bflo(v.z); u[5] += mk * w[k][5] * bfhi(v.z); u[6] += mk * w[k][6] * bflo(v.w); u[7] += mk * w[k][7] * bfhi(v.w); }
        *(LAS f32x4*)(uf + tl * UF_LD + 8 * cg) = (f32x4){u[0], u[1], u[2], u[3]};
        *(LAS f32x4*)(uf + tl * UF_LD + 8 * cg + 4) = (f32x4){u[4], u[5], u[6], u[7]};
        u32x4 p; p.x = pk2(u[0], u[1]); p.y = pk2(u[2], u[3]); p.z = pk2(u[4], u[5]); p.w = pk2(u[6], u[7]);
        *(LAS u32x4*)(ubf + tl * 256 + ((cg ^ (tl & 15)) << 4)) = p; }
    if (special) {
        const bf16* AC = (const bf16*)(F.ws + WS_PC) + (size_t)b * CTX * DM + h * 128;
        if (F.tid < 32) { const int tl = LRU_T + (F.tid >> 4); const int t = tl == LRU_T ? 0 : CTX - 1;
            float u[8];
#pragma unroll
            for (int q = 0; q < 8; ++q) u[q] = bs[q];
#pragma unroll
            for (int k = 0; k < 4; ++k) { const int tt = t + k - 2;
                if (tt >= 0 && tt < CTX) { const u32x4 v = *(const u32x4*)(AC + (size_t)tt * DM + 8 * cg);
                    u[0] += w[k][0] * bflo(v.x); u[1] += w[k][1] * bfhi(v.x); u[2] += w[k][2] * bflo(v.y); u[3] += w[k][3] * bfhi(v.y);
                    u[4] += w[k][4] * bflo(v.z); u[5] += w[k][5] * bfhi(v.z); u[6] += w[k][6] * bflo(v.w); u[7] += w[k][7] * bfhi(v.w); } }
            *(LAS f32x4*)(uf + tl * UF_LD + 8 * cg) = (f32x4){u[0], u[1], u[2], u[3]};
            *(LAS f32x4*)(uf + tl * UF_LD + 8 * cg + 4) = (f32x4){u[4], u[5], u[6], u[7]};
            u32x4 p; p.x = pk2(u[0], u[1]); p.y = pk2(u[2], u[3]); p.z = pk2(u[4], u[5]); p.w = pk2(u[6], u[7]);
            *(LAS u32x4*)(ubf + tl * 256 + ((cg ^ (tl & 15)) << 4)) = p;
        } else if (F.tid < 32 + 14 * 16) { const int tl = LRU_T + 2 + ((F.tid - 32) >> 4);
            *(LAS u32x4*)(ubf + tl * 256 + ((cg ^ (tl & 15)) << 4)) = (u32x4){0u, 0u, 0u, 0u}; }
    }
}
__device__ __forceinline__ void lru_load_w(Frame& F, int d, int h, bf16x8 (&Bw)[2][4]) {
    const int fr = F.lane & 15, fq = F.lane >> 4;
#pragma unroll
    for (int which = 0; which < 2; ++which) { const bf16* W = (const bf16*)(F.ws + WS_WLRU) + (size_t)(which * 16 + d * 8 + h) * 128 * 128 + (size_t)(16 * F.wave + fr) * 128 + 8 * fq;
#pragma unroll
        for (int kk = 0; kk < 4; ++kk) Bw[which][kk] = *(const bf16x8*)(W + kk * 32); }
}
__device__ __forceinline__ LruCoef lru_coef(const Args& a, int d, int ch) {
    LruCoef k; k.ba = -LOG2E * a.in[IN_BA][d * DM + ch]; k.bx = -LOG2E * a.in[IN_BX][d * DM + ch];
    const float sp = log1pf(expf(-a.in[IN_LAM][d * DM + ch])); k.ca = -8.f * sp * LOG2E; return k;
}
template <int V = 0> __device__ __forceinline__ void lru_tile(Frame& F, int m, const bf16x8 (&Bw)[2][4], const LruCoef& k, float (&av)[4], float (&bv)[4], int fr_ = -1, int fq_ = -1) {
    const int fr = fr_ < 0 ? (F.lane & 15) : fr_, fq = fq_ < 0 ? (F.lane >> 4) : fq_;
    const LAS unsigned char* ubf = F.lds + LRU_UBF; const LAS float* uf = (const LAS float*)(F.lds + LRU_UF);
    f32x4 ar = {0.f, 0.f, 0.f, 0.f}, ai = {0.f, 0.f, 0.f, 0.f};
    const int row = m * 16 + fr;
#pragma unroll
    for (int kk = 0; kk < 4; ++kk) { const bf16x8 A = *(const LAS bf16x8*)(ubf + row * 256 + (((kk * 4 + fq) ^ fr) << 4));
        ar = __builtin_amdgcn_mfma_f32_16x16x32_bf16(A, Bw[0][kk], ar, 0, 0, 0); ai = __builtin_amdgcn_mfma_f32_16x16x32_bf16(A, Bw[1][kk], ai, 0, 0, 0); }
#pragma unroll
    for (int r = 0; r < 4; ++r) { const float u = uf[(m * 16 + 4 * fq + r) * UF_LD + 16 * F.wave + fr];
        if (V == 2) { av[r] = __builtin_fmaf(ar[r], -LOG2E, k.ba) * k.ca; bv[r] = __builtin_fmaf(ai[r], -LOG2E, k.bx) * u; continue; }
        const float rg = __builtin_amdgcn_rcpf(1.f + __builtin_amdgcn_exp2f(__builtin_fmaf(ar[r], -LOG2E, k.ba)));
        const float ig = __builtin_amdgcn_rcpf(1.f + __builtin_amdgcn_exp2f(__builtin_fmaf(ai[r], -LOG2E, k.bx)));
        const float aa = __builtin_amdgcn_exp2f(k.ca * rg);
        av[r] = aa; bv[r] = __builtin_amdgcn_sqrtf(__builtin_fmaf(-aa, aa, 1.f)) * (ig * u); }
}
template <bool FWD, int V = 0> __device__ __forceinline__ void lru_tile_total(int fq, float& A, float& B) {
    if (V == 1) return;
#pragma unroll
    for (int s = 0; s < 2; ++s) { const int bit = 1 << s; const float Ap = __shfl_xor(A, 16 << s), Bp = __shfl_xor(B, 16 << s);
        const bool mine_first = FWD ? ((fq & bit) == 0) : ((fq & bit) != 0);
        if (mine_first) { B = B * Ap + Bp; A = A * Ap; } else { B = Bp * A + B; A = Ap * A; } }
}

template <int V = 0> __device__ __forceinline__ void lru_phase1(Frame& F, const Args& a, float* agg_base) {
    const int NU = NB * 8 * LRU_NCH;
    if (F.bid >= NU) return;
    const int fr = F.lane & 15, fq = F.lane >> 4;
    const int h = (F.bid >> 4) & 7; const int ch = h * 128 + 16 * F.wave + fr;
    const LruCoef k0 = lru_coef(a, 0, ch), k1 = lru_coef(a, 1, ch);
    for (int unit = F.bid; unit < NU; unit += F.G) {
        const int c = unit & (LRU_NCH - 1), b = unit >> 7;
        bf16x8 Bw0[2][4], Bw1[2][4]; lru_load_w(F, 0, h, Bw0); lru_load_w(F, 1, h, Bw1);
        { u32x4 raw[4][4]; lru_conv_load(F, b, h, c, raw); LruConvW cwv; lru_conv_weights(F, a, h, cwv); lru_conv(F, cwv, raw, b, h, c, c == 0 && V == 0); }
        LDS_WAIT(); __syncthreads();
        float Af = 1.f, Hf = 0.f, Ab = 1.f, Hb = 0.f;
#pragma unroll 2
        for (int m = 0; m < 8; ++m) {
            float av[4], bv[4];
            lru_tile<V>(F, m, Bw0, k0, av, bv);
            float A = av[0] * av[1] * av[2] * av[3], B = ((bv[0] * av[1] + bv[1]) * av[2] + bv[2]) * av[3] + bv[3];
            lru_tile_total<true, V>(fq, A, B);
            Hf = Hf * A + B; Af = Af * A;
            lru_tile<V>(F, m, Bw1, k1, av, bv);
            A = av[0] * av[1] * av[2] * av[3]; B = ((bv[3] * av[2] + bv[2]) * av[1] + bv[1]) * av[0] + bv[0];
            lru_tile_total<false, V>(fq, A, B);
            Hb = B * Ab + Hb; Ab = A * Ab;
        }
        float* agg = agg_base;
        if (fq == 0) { *(f32x2*)(agg + ((size_t)((b * LRU_NCH + c) * 2 + 0) * DM + ch) * 2) = (f32x2){Af, Hf};
                       *(f32x2*)(agg + ((size_t)((b * LRU_NCH + c) * 2 + 1) * DM + ch) * 2) = (f32x2){Ab, Hb}; }
        if (c == 0 && V == 0) {
            float av[4], bv[4]; float* s0 = (float*)(F.ws + WS_LRUS0);
            lru_tile(F, 8, Bw0, k0, av, bv); if (fq == 0) s0[(b * 2 + 0) * DM + ch] = bv[0];
            lru_tile(F, 8, Bw1, k1, av, bv); if (fq == 0) s0[(b * 2 + 1) * DM + ch] = bv[1];
        }
        __syncthreads();
    }
}

__device__ __forceinline__ void lru_pass2(Frame& F, const Args& a, int unit, const LruCoef& kf, const LruCoef& kb) {
    const int c = unit & (LRU_NCH - 1), h = (unit >> 4) & 7, b = unit >> 7;
    const int fr = F.lane & 15, fq = F.lane >> 4; const int ch = h * 128 + 16 * F.wave + fr;
    const float* agg = (const float*)(F.ws + WS_LRUAGG); const float* s0 = (const float*)(F.ws + WS_LRUS0);
    f32x2 ag[LRU_NCH];
#pragma unroll
    for (int j = 0; j < LRU_NCH; ++j) ag[j] = *(const f32x2*)(agg + ((size_t)((b * LRU_NCH + j) * 2 + (j < c ? 0 : 1)) * DM + ch) * 2);
    float hf = s0[(b * 2 + 0) * DM + ch], hb = s0[(b * 2 + 1) * DM + ch];
    bf16* AY = (bf16*)(F.ws + WS_YAG) + ((size_t)b * SEQ + c * LRU_T) * DM + h * 128;
    u32x4 ayv[4];
#pragma unroll
    for (int i = 0; i < 4; ++i) ayv[i] = *(const u32x4*)(AY + (size_t)((F.tid >> 4) + 32 * i) * DM + 8 * (F.tid & 15));
    bf16x8 Bw[2][4], Bw1[2][4]; lru_load_w(F, 0, h, Bw);
    LruCoef k = kf; const LruCoef k1 = kb;
    { u32x4 raw[4][4]; lru_conv_load(F, b, h, c, raw); LruConvW cwv; lru_conv_weights(F, a, h, cwv); lru_conv(F, cwv, raw, b, h, c, false); }
    lru_load_w(F, 1, h, Bw1);
#pragma unroll
    for (int j = 0; j < LRU_NCH; ++j) if (j < c) hf = ag[j].x * hf + ag[j].y;
#pragma unroll
    for (int j = LRU_NCH - 1; j >= 0; --j) if (j > c) hb = ag[j].x * hb + ag[j].y;
    LDS_WAIT(); __syncthreads();
    float hfv[8][4];
#pragma unroll
    for (int m = 0; m < 8; ++m) {
        float av[4], bv[4];
        lru_tile(F, m, Bw, k, av, bv);
        const float A = av[0] * av[1] * av[2] * av[3], B = ((bv[0] * av[1] + bv[1]) * av[2] + bv[2]) * av[3] + bv[3];
        float hin = hf;
#pragma unroll
        for (int g = 0; g < 4; ++g) { const float Ag = __shfl(A, g * 16 + fr), Bg = __shfl(B, g * 16 + fr); if (g < fq) hin = Ag * hin + Bg; hf = Ag * hf + Bg; }
#pragma unroll
        for (int r = 0; r < 4; ++r) { hin = av[r] * hin + bv[r]; hfv[m][r] = hin; }
    }
    k = k1;
    LAS float* uf = (LAS float*)(F.lds + LRU_UF);
#pragma unroll
    for (int m = 7; m >= 0; --m) {
        float av[4], bv[4];
        lru_tile(F, m, Bw1, k, av, bv);
        const float A = av[0] * av[1] * av[2] * av[3], B = ((bv[3] * av[2] + bv[2]) * av[1] + bv[1]) * av[0] + bv[0];
        float hin = hb;
#pragma unroll
        for (int g = 3; g >= 0; --g) { const float Ag = __shfl(A, g * 16 + fr), Bg = __shfl(B, g * 16 + fr); if (g > fq) hin = Ag * hin + Bg; hb = Ag * hb + Bg; }
#pragma unroll
        for (int r = 3; r >= 0; --r) { hin = av[r] * hin + bv[r]; uf[(m * 16 + 4 * fq + r) * UF_LD + 16 * F.wave + fr] = hfv[m][r] + hin; }
    }
    LDS_WAIT(); __syncthreads();
    const int cg = F.tid & 15;
#pragma unroll
    for (int i = 0; i < 4; ++i) { const int tl = (F.tid >> 4) + 32 * i;
        const f32x4 y0 = *(const LAS f32x4*)(uf + tl * UF_LD + 8 * cg), y1 = *(const LAS f32x4*)(uf + tl * UF_LD + 8 * cg + 4);
        const u32x4 g = ayv[i];
        u32x4 o; o.x = pk2(y0.x * gelu_tanh(bflo(g.x)), y0.y * gelu_tanh(bfhi(g.x))); o.y = pk2(y0.z * gelu_tanh(bflo(g.y)), y0.w * gelu_tanh(bfhi(g.y)));
        o.z = pk2(y1.x * gelu_tanh(bflo(g.z)), y1.y * gelu_tanh(bfhi(g.z))); o.w = pk2(y1.z * gelu_tanh(bflo(g.w)), y1.w * gelu_tanh(bfhi(g.w)));
        *(u32x4*)(AY + (size_t)tl * DM + 8 * cg) = o; }
    __syncthreads();
}

constexpr int LRU_PRIV = LRU_UF;
__device__ __forceinline__ void lru_conv_b(Frame& F, const LruConvW& cwv, const u32x4 (&raw)[4][4], int b, int h, int c, bool special) {
    LAS unsigned char* ubf = F.lds + LRU_UBF;
    int cg = F.tid & 15, tl0 = F.tid >> 4;
    asm volatile("" : "+v"(cg), "+v"(tl0));
    const float (&w)[4][8] = cwv.w; const float (&bs)[8] = cwv.bs;
#pragma unroll
    for (int i = 0; i < 4; ++i) { const int tl = tl0 + 32 * i;
        float u[8];
#pragma unroll
        for (int q = 0; q < 8; ++q) u[q] = bs[q];
#pragma unroll
        for (int k = 0; k < 4; ++k) { const int tt = c * LRU_T + tl + k - 2; const float mk = (tt >= 0 && tt < SEQ) ? 1.f : 0.f; const u32x4 v = raw[i][k];
            u[0] += mk * w[k][0] * bflo(v.x); u[1] += mk * w[k][1] * bfhi(v.x); u[2] += mk * w[k][2] * bflo(v.y); u[3] += mk * w[k][3] * bfhi(v.y);
            u[4] += mk * w[k][4] * bflo(v.z); u[5] += mk * w[k][5] * bfhi(v.z); u[6] += mk * w[k][6] * bflo(v.w); u[7] += mk * w[k][7] * bfhi(v.w); }
        u32x4 p; p.x = pk2(u[0], u[1]); p.y = pk2(u[2], u[3]); p.z = pk2(u[4], u[5]); p.w = pk2(u[6], u[7]);
        *(LAS u32x4*)(ubf + tl * 256 + ((cg ^ (tl & 15)) << 4)) = p; }
    if (special) {
        const bf16* AC = (const bf16*)(F.ws + WS_PC) + (size_t)b * CTX * DM + h * 128;
        if (F.tid < 32) { const int tl = LRU_T + (F.tid >> 4); const int t = tl == LRU_T ? 0 : CTX - 1;
            float u[8];
#pragma unroll
            for (int q = 0; q < 8; ++q) u[q] = bs[q];
#pragma unroll
            for (int k = 0; k < 4; ++k) { const int tt = t + k - 2;
                if (tt >= 0 && tt < CTX) { const u32x4 v = *(const u32x4*)(AC + (size_t)tt * DM + 8 * cg);
                    u[0] += w[k][0] * bflo(v.x); u[1] += w[k][1] * bfhi(v.x); u[2] += w[k][2] * bflo(v.y); u[3] += w[k][3] * bfhi(v.y);
                    u[4] += w[k][4] * bflo(v.z); u[5] += w[k][5] * bfhi(v.z); u[6] += w[k][6] * bflo(v.w); u[7] += w[k][7] * bfhi(v.w); } }
            u32x4 p; p.x = pk2(u[0], u[1]); p.y = pk2(u[2], u[3]); p.z = pk2(u[4], u[5]); p.w = pk2(u[6], u[7]);
            *(LAS u32x4*)(ubf + tl * 256 + ((cg ^ (tl & 15)) << 4)) = p;
        } else if (F.tid < 32 + 14 * 16) { const int tl = LRU_T + 2 + ((F.tid - 32) >> 4);
            *(LAS u32x4*)(ubf + tl * 256 + ((cg ^ (tl & 15)) << 4)) = (u32x4){0u, 0u, 0u, 0u}; }
    }
}
__device__ __forceinline__ void lru_tile_b(Frame& F, int m, const bf16x8 (&Bw)[2][4], const LruCoef& k, float (&av)[4], float (&bv)[4]) {
    const int fr = F.lane & 15, fq = F.lane >> 4;
    const LAS unsigned char* ubf = F.lds + LRU_UBF;
    f32x4 ar = {0.f, 0.f, 0.f, 0.f}, ai = {0.f, 0.f, 0.f, 0.f};
    const int row = m * 16 + fr;
#pragma unroll
    for (int kk = 0; kk < 4; ++kk) { const bf16x8 A = *(const LAS bf16x8*)(ubf + row * 256 + (((kk * 4 + fq) ^ fr) << 4));
        ar = __builtin_amdgcn_mfma_f32_16x16x32_bf16(A, Bw[0][kk], ar, 0, 0, 0); ai = __builtin_amdgcn_mfma_f32_16x16x32_bf16(A, Bw[1][kk], ai, 0, 0, 0); }
    const int n = 16 * F.wave + fr;
#pragma unroll
    for (int r = 0; r < 4; ++r) { const int tr = m * 16 + 4 * fq + r;
        const float u = bf2f(*(const LAS unsigned short*)(ubf + tr * 256 + (((n >> 3) ^ (tr & 15)) << 4) + (n & 7) * 2));
        const float rg = __builtin_amdgcn_rcpf(1.f + __builtin_amdgcn_exp2f(__builtin_fmaf(ar[r], -LOG2E, k.ba)));
        const float ig = __builtin_amdgcn_rcpf(1.f + __builtin_amdgcn_exp2f(__builtin_fmaf(ai[r], -LOG2E, k.bx)));
        const float aa = __builtin_amdgcn_exp2f(k.ca * rg);
        av[r] = aa; bv[r] = __builtin_amdgcn_sqrtf(__builtin_fmaf(-aa, aa, 1.f)) * (ig * u); }
}
__device__ __forceinline__ void lru_unit(Frame& F, const Args& a, int unit, const LruCoef& kf, const LruCoef& kb) {
    const int c = unit & (LRU_NCH - 1), h = (unit >> 4) & 7, b = unit >> 7, grp = unit >> 4;
    const int fr = F.lane & 15, fq = F.lane >> 4; const int ch = h * 128 + 16 * F.wave + fr;
    bf16* AY = (bf16*)(F.ws + WS_YAG) + ((size_t)b * SEQ + c * LRU_T) * DM + h * 128;
    bf16x8 Bw[2][4]; lru_load_w(F, 0, h, Bw);
    { u32x4 raw[4][4]; lru_conv_load(F, b, h, c, raw); LruConvW cwv; lru_conv_weights(F, a, h, cwv); lru_conv_b(F, cwv, raw, b, h, c, c == 0); }
    LAS unsigned char* priv = F.lds + LRU_PRIV + F.tid * 8;
    LDS_WAIT(); __syncthreads();
    float hf = 0.f, pf = 1.f, s0f = 0.f, s0b = 0.f;
#pragma unroll 2
    for (int m = 0; m < 8; ++m) {
        float av[4], bv[4];
        lru_tile_b(F, m, Bw, kf, av, bv);
        const float A = av[0] * av[1] * av[2] * av[3], B = ((bv[0] * av[1] + bv[1]) * av[2] + bv[2]) * av[3] + bv[3];
        float hin = hf, pin = pf;
#pragma unroll
        for (int g = 0; g < 4; ++g) { const float Ag = __shfl(A, g * 16 + fr), Bg = __shfl(B, g * 16 + fr); if (g < fq) { hin = Ag * hin + Bg; pin = Ag * pin; } hf = Ag * hf + Bg; pf = Ag * pf; }
        float pt[4], ht[4];
#pragma unroll
        for (int r = 0; r < 4; ++r) { hin = av[r] * hin + bv[r]; pin = av[r] * pin; ht[r] = hin; pt[r] = pin; }
        *(LAS u32x2*)(priv + m * 4096) = (u32x2){pk2(ht[0], ht[1]), pk2(ht[2], ht[3])};
        *(LAS u32x2*)(priv + 32768 + m * 4096) = (u32x2){pk2(pt[0], pt[1]), pk2(pt[2], pt[3])};
    }
    if (c == 0) { float av[4], bv[4]; lru_tile_b(F, 8, Bw, kf, av, bv); s0f = bv[0]; }
    lru_load_w(F, 1, h, Bw);
    float hb = 0.f, pbw = 1.f;
#pragma unroll 2
    for (int m = 7; m >= 0; --m) {
        float av[4], bv[4];
        lru_tile_b(F, m, Bw, kb, av, bv);
        const float A = av[0] * av[1] * av[2] * av[3], B = ((bv[3] * av[2] + bv[2]) * av[1] + bv[1]) * av[0] + bv[0];
        float hin = hb, pin = pbw;
#pragma unroll
        for (int g = 3; g >= 0; --g) { const float Ag = __shfl(A, g * 16 + fr), Bg = __shfl(B, g * 16 + fr); if (g > fq) { hin = Ag * hin + Bg; pin = Ag * pin; } hb = Ag * hb + Bg; pbw = Ag * pbw; }
        const u32x2 hfw = *(const LAS u32x2*)(priv + m * 4096);
        const float hfv[4] = {bflo(hfw.x), bfhi(hfw.x), bflo(hfw.y), bfhi(hfw.y)};
        float pt[4], ht[4];
#pragma unroll
        for (int r = 3; r >= 0; --r) { hin = av[r] * hin + bv[r]; pin = av[r] * pin; ht[r] = hin + hfv[r]; pt[r] = pin; }
        *(LAS u32x2*)(priv + m * 4096) = (u32x2){pk2(ht[0], ht[1]), pk2(ht[2], ht[3])};
        *(LAS u32x2*)(priv + 65536 + m * 4096) = (u32x2){pk2(pt[0], pt[1]), pk2(pt[2], pt[3])};
    }
    if (c == 0) { float av[4], bv[4]; lru_tile_b(F, 8, Bw, kb, av, bv); s0b = bv[1]; }
    unsigned long long* agg = (unsigned long long*)(F.ws + WS_LRUAGG); unsigned long long* s0 = (unsigned long long*)(F.ws + WS_LRUS0);
    if (fq == 0) {
        __hip_atomic_store(agg + (size_t)((b * LRU_NCH + c) * 2 + 0) * DM + ch, ((unsigned long long)__builtin_bit_cast(unsigned, hf) << 32) | __builtin_bit_cast(unsigned, pf + 1.f), __ATOMIC_RELAXED, __HIP_MEMORY_SCOPE_AGENT);
        __hip_atomic_store(agg + (size_t)((b * LRU_NCH + c) * 2 + 1) * DM + ch, ((unsigned long long)__builtin_bit_cast(unsigned, hb) << 32) | __builtin_bit_cast(unsigned, pbw + 1.f), __ATOMIC_RELAXED, __HIP_MEMORY_SCOPE_AGENT);
        if (c == 0) { __hip_atomic_store(s0 + (b * 2 + 0) * DM + ch, ((unsigned long long)__builtin_bit_cast(unsigned, s0f) << 32) | 0x3f800000u, __ATOMIC_RELAXED, __HIP_MEMORY_SCOPE_AGENT);
                      __hip_atomic_store(s0 + (b * 2 + 1) * DM + ch, ((unsigned long long)__builtin_bit_cast(unsigned, s0b) << 32) | 0x3f800000u, __ATOMIC_RELAXED, __HIP_MEMORY_SCOPE_AGENT); }
    }
    u32x4 gv[4];
#pragma unroll
    for (int i = 0; i < 4; ++i) { const u32x4 g = *(const u32x4*)(AY + (size_t)((F.tid >> 4) + 32 * i) * DM + 8 * (F.tid & 15));
        gv[i].x = pk2(gelu_tanh(bflo(g.x)), gelu_tanh(bfhi(g.x))); gv[i].y = pk2(gelu_tanh(bflo(g.y)), gelu_tanh(bfhi(g.y)));
        gv[i].z = pk2(gelu_tanh(bflo(g.z)), gelu_tanh(bfhi(g.z))); gv[i].w = pk2(gelu_tanh(bflo(g.w)), gelu_tanh(bfhi(g.w))); }
    float cf, cb;
    {
        unsigned long long ag[LRU_NCH], sf, sb; unsigned spins = 0;
        const unsigned long long* ab = agg + (size_t)(b * LRU_NCH * 2) * DM + ch;
        for (;;) {
            bool ok = true;
            sf = __hip_atomic_load(s0 + (b * 2 + 0) * DM + ch, __ATOMIC_RELAXED, __HIP_MEMORY_SCOPE_AGENT); sb = __hip_atomic_load(s0 + (b * 2 + 1) * DM + ch, __ATOMIC_RELAXED, __HIP_MEMORY_SCOPE_AGENT);
#pragma unroll
            for (int j = 0; j < LRU_NCH; ++j) ag[j] = j == c ? 1ull : __hip_atomic_load(ab + (size_t)(j * 2 + (j < c ? 0 : 1)) * DM, __ATOMIC_RELAXED, __HIP_MEMORY_SCOPE_AGENT);
            ok = ((unsigned)sf != 0u) && ((unsigned)sb != 0u);
#pragma unroll
            for (int j = 0; j < LRU_NCH; ++j) ok = ok && ((unsigned)ag[j] != 0u);
            if (__all(ok)) break;
            __builtin_amdgcn_s_sleep(1);
            if (++spins > (1u << 22)) { if (F.lane == 0) __hip_atomic_store(F.ctl + 3, 2u, __ATOMIC_RELAXED, __HIP_MEMORY_SCOPE_AGENT); break; }
        }
        cf = __builtin_bit_cast(float, (unsigned)(sf >> 32)); cb = __builtin_bit_cast(float, (unsigned)(sb >> 32));
#pragma unroll
        for (int j = 0; j < LRU_NCH; ++j) if (j < c) cf = (__builtin_bit_cast(float, (unsigned)ag[j]) - 1.f) * cf + __builtin_bit_cast(float, (unsigned)(ag[j] >> 32));
#pragma unroll
        for (int j = LRU_NCH - 1; j >= 0; --j) if (j > c) cb = (__builtin_bit_cast(float, (unsigned)ag[j]) - 1.f) * cb + __builtin_bit_cast(float, (unsigned)(ag[j] >> 32));
    }
    __syncthreads();
    { LAS unsigned char* ya = F.lds + LRU_UBF; const int n = 16 * F.wave + fr;
#pragma unroll 2
      for (int m = 0; m < 8; ++m) {
          const u32x2 hw = *(const LAS u32x2*)(priv + m * 4096), pfw = *(const LAS u32x2*)(priv + 32768 + m * 4096), pbw2 = *(const LAS u32x2*)(priv + 65536 + m * 4096);
          const float y0 = bflo(hw.x) + bflo(pfw.x) * cf + bflo(pbw2.x) * cb, y1 = bfhi(hw.x) + bfhi(pfw.x) * cf + bfhi(pbw2.x) * cb;
          const float y2 = bflo(hw.y) + bflo(pfw.y) * cf + bflo(pbw2.y) * cb, y3 = bfhi(hw.y) + bfhi(pfw.y) * cf + bfhi(pbw2.y) * cb;
          const unsigned w01 = pk2(y0, y1), w23 = pk2(y2, y3);
          const int t0 = m * 16 + 4 * fq;
          *(LAS unsigned short*)(ya + (t0 + 0) * 256 + (((n >> 3) ^ ((t0 + 0) & 15)) << 4) + (n & 7) * 2) = (unsigned short)w01;
          *(LAS unsigned short*)(ya + (t0 + 1) * 256 + (((n >> 3) ^ ((t0 + 1) & 15)) << 4) + (n & 7) * 2) = (unsigned short)(w01 >> 16);
          *(LAS unsigned short*)(ya + (t0 + 2) * 256 + (((n >> 3) ^ ((t0 + 2) & 15)) << 4) + (n & 7) * 2) = (unsigned short)w23;
          *(LAS unsigned short*)(ya + (t0 + 3) * 256 + (((n >> 3) ^ ((t0 + 3) & 15)) << 4) + (n & 7) * 2) = (unsigned short)(w23 >> 16); } }
    LDS_WAIT(); __syncthreads();
    const int cg = F.tid & 15;
#pragma unroll
    for (int i = 0; i < 4; ++i) { const int tl = (F.tid >> 4) + 32 * i;
        const u32x4 y = *(const LAS u32x4*)(F.lds + LRU_UBF + tl * 256 + ((cg ^ (tl & 15)) << 4));
        const u32x4 g = gv[i];
        u32x4 o; o.x = pk2(bflo(y.x) * bflo(g.x), bfhi(y.x) * bfhi(g.x)); o.y = pk2(bflo(y.y) * bflo(g.y), bfhi(y.y) * bfhi(g.y));
        o.z = pk2(bflo(y.z) * bflo(g.z), bfhi(y.z) * bfhi(g.z)); o.w = pk2(bflo(y.w) * bflo(g.w), bfhi(y.w) * bfhi(g.w));
        *(u32x4*)(AY + (size_t)tl * DM + 8 * cg) = o; }
    __syncthreads();
}
constexpr int HG_C = 64, HG_SEG = 512, HG_NSEG = 4;
constexpr int HG_QS = 0, HG_QM = 16384, HG_KM = 32768, HG_KDT = 49152, HG_VT = 65536, HG_ATT = 81920, HG_PART = 90112, HG_ETOT = 94208, HG_ROWS = 94720;
constexpr size_t HGS_IMG = 65536;

__device__ __forceinline__ int hg_row(int b, int dir, bool ctx, int sigma) {
    if (ctx) { const int t = dir ? (CTX - 1 - sigma) : sigma; return b * CTX + t; }
    const int p = dir ? (SEQ - 1 - sigma) : sigma; return b * SEQ + (p & 31) * 64 + (p >> 5);
}

struct HgRaw { unsigned f[8], v[8], q[8]; };
template <bool FULL>
__device__ __forceinline__ void hg_load(Frame& F, const bf16* Qb, const bf16* Fb, const bf16* Vb, int b, int dir, bool ctx, int sigma0, HgRaw& r) {
    const long step = (long)(ctx ? 1 : 64) * (dir ? -1 : 1) * DM;
    const size_t ro = (size_t)hg_row(b, dir, ctx, sigma0 + 8 * F.wave) * DM + 2 * F.lane;
    const bf16* fp = Fb + ro; const bf16* vp = Vb + ro; const bf16* qp = Qb + ro;
#pragma unroll
    for (int j = 0; j < 8; ++j) { r.f[j] = *(const unsigned*)(fp + j * step); r.v[j] = *(const unsigned*)(vp + j * step); if (FULL) r.q[j] = *(const unsigned*)(qp + j * step); }
}
template <bool FULL>
__device__ __forceinline__ void hg_prep(Frame& F, const HgRaw& raw, int b, int dir, bool ctx, int sigma0, float lb0, float lb1, float& gs0, float& gs1) {
    const int kp = F.lane, to = F.wave;
    const unsigned (&fw)[8] = raw.f; const unsigned (&qw)[8] = raw.q; const unsigned (&vw)[8] = raw.v;
    const f32x2 lbv = {lb0, lb1}, omlb = {1.f - lb0, 1.f - lb1};
    f32x2 cs[8], kk2[8]; f32x2 accv = {0.f, 0.f};
#pragma unroll
    for (int j = 0; j < 8; ++j) {
        const f32x2 x = (f32x2){bflo(fw[j]), bfhi(fw[j])} * (-LOG2E);
        const f32x2 d = (f32x2){__builtin_amdgcn_exp2f(x.x), __builtin_amdgcn_exp2f(x.y)} + 1.f;
        const f32x2 g = lbv + omlb * (f32x2){__builtin_amdgcn_rcpf(d.x), __builtin_amdgcn_rcpf(d.y)};
        kk2[j] = 1.f - g;
        accv += (f32x2){__builtin_amdgcn_logf(g.x), __builtin_amdgcn_logf(g.y)};
        cs[j] = accv; }
    const float a0 = accv.x, a1 = accv.y;
    LAS float* part = (LAS float*)(F.lds + HG_PART);
    *(LAS f32x2*)(part + to * 128 + 2 * kp) = (f32x2){a0, a1};
    if (FULL) HSTAMP(0);
    LDS_WAIT(); __syncthreads();
    if (FULL) HSTAMP(1);
    if (FULL && F.tid < HG_C) ((LAS int*)(F.lds + HG_ROWS))[F.tid] = hg_row(b, dir, ctx, sigma0 + F.tid);
    f32x2 offv = {0.f, 0.f}, totv = {0.f, 0.f};
#pragma unroll
    for (int o = 0; o < 8; ++o) { const f32x2 p = *(const LAS f32x2*)(part + o * 128 + 2 * kp);
        if (o < to) offv += p; totv += p; }
    gs0 += totv.x; gs1 += totv.y;
    if (to == 0) *(LAS f32x2*)((LAS float*)(F.lds + HG_ETOT) + 2 * kp) = (f32x2){__builtin_amdgcn_exp2f(totv.x), __builtin_amdgcn_exp2f(totv.y)};
    float kd0[8], kd1[8];
#pragma unroll
    for (int j = 0; j < 8; ++j) {
        const f32x2 G = offv + cs[j];
        const f32x2 E = {__builtin_amdgcn_exp2f(G.x), __builtin_amdgcn_exp2f(G.y)};
        const f32x2 kd = kk2[j] * (f32x2){__builtin_amdgcn_rcpf(E.x), __builtin_amdgcn_rcpf(E.y)};
        kd0[j] = kd.x; kd1[j] = kd.y;
        if (FULL) {
            const f32x2 q = {bflo(qw[j]), bfhi(qw[j])};
            const f32x2 xq = q * (-LOG2E);
            const f32x2 dq = (f32x2){__builtin_amdgcn_exp2f(xq.x), __builtin_amdgcn_exp2f(xq.y)} + 1.f;
            const f32x2 sv = q * (f32x2){__builtin_amdgcn_rcpf(dq.x), __builtin_amdgcn_rcpf(dq.y)} * E;
            const int c = 8 * to + j; const int off = c * 256 + ((4 * kp) ^ ((c & 15) << 4));
            *(LAS unsigned*)(F.lds + HG_QS + off) = pk2(sv.x, sv.y);
            *(LAS unsigned*)(F.lds + HG_KM + off) = pk2(kd.x, kd.y);
        }
    }
    { const int sw = ((to ^ (kp & 7)) << 4);
      u32x4 w0, w1; w0.x = pk2(kd0[0], kd0[1]); w0.y = pk2(kd0[2], kd0[3]); w0.z = pk2(kd0[4], kd0[5]); w0.w = pk2(kd0[6], kd0[7]);
      w1.x = pk2(kd1[0], kd1[1]); w1.y = pk2(kd1[2], kd1[3]); w1.z = pk2(kd1[4], kd1[5]); w1.w = pk2(kd1[6], kd1[7]);
      *(LAS u32x4*)(F.lds + HG_KDT + (2 * kp) * 128 + sw) = w0; *(LAS u32x4*)(F.lds + HG_KDT + (2 * kp + 1) * 128 + sw) = w1;
      u32x4 v0, v1;
      v0.x = (vw[0] & 0xffffu) | (vw[1] << 16); v0.y = (vw[2] & 0xffffu) | (vw[3] << 16); v0.z = (vw[4] & 0xffffu) | (vw[5] << 16); v0.w = (vw[6] & 0xffffu) | (vw[7] << 16);
      v1.x = (vw[0] >> 16) | (vw[1] & 0xffff0000u); v1.y = (vw[2] >> 16) | (vw[3] & 0xffff0000u); v1.z = (vw[4] >> 16) | (vw[5] & 0xffff0000u); v1.w = (vw[6] >> 16) | (vw[7] & 0xffff0000u);
      *(LAS u32x4*)(F.lds + HG_VT + (2 * kp) * 128 + sw) = v0; *(LAS u32x4*)(F.lds + HG_VT + (2 * kp + 1) * 128 + sw) = v1; }
    if (FULL) HSTAMP(2);
    LDS_WAIT(); __syncthreads();
    if (FULL) HSTAMP(3);
}
__device__ __forceinline__ void hg_state_update(Frame& F, f32x4 (&St)[8], const bf16x8 (&vt)[2]) {
    const int fr = F.lane & 15, fq = F.lane >> 4;
    const LAS float* etot = (const LAS float*)(F.lds + HG_ETOT);
#pragma unroll
    for (int kt = 0; kt < 8; ++kt) { const f32x4 e = *(const LAS f32x4*)(etot + 16 * kt + 4 * fq);
        const int rk = 16 * kt + fr;
#pragma unroll
        for (int ks = 0; ks < 2; ++ks) { const bf16x8 A = *(const LAS bf16x8*)(F.lds + HG_KDT + rk * 128 + (((4 * ks + fq) ^ ((rk >> 1) & 7)) << 4));
            St[kt] = __builtin_amdgcn_mfma_f32_16x16x32_bf16(A, vt[ks], St[kt], 0, 0, 0); }
        St[kt] = St[kt] * e; }
}
__device__ __forceinline__ void hg_load_vt(Frame& F, bf16x8 (&vt)[2]) {
    const int fr = F.lane & 15, fq = F.lane >> 4; const int rv = 16 * F.wave + fr;
#pragma unroll
    for (int ks = 0; ks < 2; ++ks) vt[ks] = *(const LAS bf16x8*)(F.lds + HG_VT + rv * 128 + (((4 * ks + fq) ^ ((rv >> 1) & 7)) << 4));
}
struct HgPtrs { const bf16* Q; const bf16* Fx; const bf16* V; const bf16* Fc; const bf16* Vc; bf16* O; };
__device__ __forceinline__ HgPtrs hg_ptrs(Frame& F, int h, int dir) {
    HgPtrs p; p.Q = (const bf16*)(F.ws + WS_P + 2 * GS) + h * 128; p.Fx = (const bf16*)(F.ws + WS_P + (dir ? 4 : 3) * GS) + h * 128; p.V = (const bf16*)(F.ws + WS_P + 5 * GS) + h * 128;
    p.Fc = (const bf16*)(F.ws + WS_PC + (dir ? 2 : 1) * CGS) + h * 128; p.Vc = (const bf16*)(F.ws + WS_PC + 3 * CGS) + h * 128; p.O = (bf16*)(F.ws + WS_P + (dir ? 4 : 3) * GS) + h * 128; return p;
}
__device__ __forceinline__ void hg_lb(const Args& a, int h, int kp, float& lb0, float& lb1) {
    const float* t = a.in[IN_HGLB] + h * 128 + 2 * kp; lb0 = 1.f / (1.f + expf(t[DM] - t[0])); lb1 = 1.f / (1.f + expf(t[DM + 1] - t[1]));
}
__device__ __forceinline__ float* hg_img(Frame& F, int b, int h, int dir, int slot) { return (float*)((unsigned char*)F.out + (size_t)((((b * 8 + h) * 2 + dir) * 4) + slot) * HGS_IMG); }

__device__ __forceinline__ void hg_pass1(Frame& F, const Args& a, int unit) {
    const int slot = unit & 3, dir = (unit >> 2) & 1, h = (unit >> 3) & 7, b = unit >> 6;
    const int fr = F.lane & 15, fq = F.lane >> 4;
    const HgPtrs P = hg_ptrs(F, h, dir);
    float lb0, lb1; hg_lb(a, h, F.lane, lb0, lb1);
    f32x4 St[8];
#pragma unroll
    for (int kt = 0; kt < 8; ++kt) St[kt] = (f32x4){0.f, 0.f, 0.f, 0.f};
    const bool ctx = slot == 0; const int nchunk = ctx ? CTX / HG_C : HG_SEG / HG_C; const int sig0 = ctx ? 0 : (slot - 1) * HG_SEG;
    float gs0 = 0.f, gs1 = 0.f;
    const bf16* Fsrc = ctx ? P.Fc : P.Fx; const bf16* Vsrc = ctx ? P.Vc : P.V;
    HgRaw cur; hg_load<false>(F, P.Q, Fsrc, Vsrc, b, dir, ctx, sig0, cur);
    for (int ck = 0; ck < nchunk; ++ck) {
        HgRaw nxt; { const int cn = ck + 1 < nchunk ? ck + 1 : ck; hg_load<false>(F, P.Q, Fsrc, Vsrc, b, dir, ctx, sig0 + cn * HG_C, nxt); }
        hg_prep<false>(F, cur, b, dir, ctx, sig0 + ck * HG_C, lb0, lb1, gs0, gs1);
        cur = nxt;
        bf16x8 vt[2]; hg_load_vt(F, vt);
        hg_state_update(F, St, vt);
    }
    float* img = hg_img(F, b, h, dir, slot) + (size_t)(16 * F.wave + fr) * 128 + 4 * fq;
#pragma unroll
    for (int kt = 0; kt < 8; ++kt) *(f32x4*)(img + 16 * kt) = St[kt];
    if (!ctx && F.wave == 0) { float* D = (float*)(F.ws + WS_HGD) + (size_t)((((b * 8 + h) * 2 + dir) * 3) + (slot - 1)) * 128 + 2 * F.lane;
        *(f32x2*)D = (f32x2){__builtin_amdgcn_exp2f(gs0), __builtin_amdgcn_exp2f(gs1)}; }
    __syncthreads();
}

constexpr int HG_HN = 95232;
__device__ __forceinline__ void hg_pass2(Frame& F, const Args& a, int unit) {
    const int seg = unit & 3, h = (unit >> 2) & 7, b = unit >> 5;
    const int fr = F.lane & 15, fq = F.lane >> 4, w = F.wave;
    float lb0, lb1; hg_lb(a, h, F.lane, lb0, lb1);
    const int lcol = h * 128 + 16 * w + 4 * fq;
#pragma unroll 1
    for (int dir = 0; dir < 2; ++dir) {
        HSTAMP(15);
        const int sseg = dir == 0 ? seg : 3 - seg;
        const HgPtrs P = hg_ptrs(F, h, dir);
        f32x4 St[8];
        {
            const float* img = hg_img(F, b, h, dir, 0) + (size_t)(16 * w + fr) * 128 + 4 * fq;
#pragma unroll
            for (int kt = 0; kt < 8; ++kt) St[kt] = *(const f32x4*)(img + 16 * kt);
            for (int j = 0; j < sseg; ++j) {
                const float* im = hg_img(F, b, h, dir, 1 + j) + (size_t)(16 * w + fr) * 128 + 4 * fq;
                const float* D = (const float*)(F.ws + WS_HGD) + (size_t)((((b * 8 + h) * 2 + dir) * 3) + j) * 128 + 4 * fq;
#pragma unroll
                for (int kt = 0; kt < 8; ++kt) { const f32x4 d = *(const f32x4*)(D + 16 * kt), dl = *(const f32x4*)(im + 16 * kt); St[kt] = St[kt] * d + dl; }
            }
        }
        float gs0 = 0.f, gs1 = 0.f;
        HSTAMP(9);
        for (int ck = 0; ck < HG_SEG / HG_C; ++ck) {
            { HgRaw cur; hg_load<true>(F, P.Q, P.Fx, P.V, b, dir, false, sseg * HG_SEG + ck * HG_C, cur);
              hg_prep<true>(F, cur, b, dir, false, sseg * HG_SEG + ck * HG_C, lb0, lb1, gs0, gs1); }
            const LAS int* rows = (const LAS int*)(F.lds + HG_ROWS);
            bf16* OFW = (bf16*)(F.ws + WS_OF) + lcol; asm volatile("" : "+v"(OFW));
            u32x2 ofw[4], ogv[4];
            if (dir == 1) {
                const bf16* OG = (const bf16*)(F.ws + WS_P + 6 * GS) + lcol; asm volatile("" : "+v"(OG));
#pragma unroll
                for (int ct = 0; ct < 4; ++ct) { const size_t ro = (size_t)rows[16 * ct + fr] * DM; ofw[ct] = *(const u32x2*)(OFW + ro); ogv[ct] = *(const u32x2*)(OG + ro); } }
#pragma unroll
            for (int tt = 0; tt < 2; ++tt) { const int t = w + 8 * tt, ct = t >> 2, st = t & 3;
                f32x4 acc = {0.f, 0.f, 0.f, 0.f};
                const int rs = 16 * st + fr, rc = 16 * ct + fr;
#pragma unroll
                for (int kk = 0; kk < 4; ++kk) { const bf16x8 A = *(const LAS bf16x8*)(F.lds + HG_KM + rs * 256 + (((4 * kk + fq) ^ fr) << 4));
                    const bf16x8 B = *(const LAS bf16x8*)(F.lds + HG_QS + rc * 256 + (((4 * kk + fq) ^ fr) << 4));
                    acc = __builtin_amdgcn_mfma_f32_16x16x32_bf16(A, B, acc, 0, 0, 0); }
                const int s0 = 16 * st + 4 * fq;
                const float m0 = (s0 + 0 <= rc) ? acc[0] : 0.f, m1 = (s0 + 1 <= rc) ? acc[1] : 0.f, m2 = (s0 + 2 <= rc) ? acc[2] : 0.f, m3 = (s0 + 3 <= rc) ? acc[3] : 0.f;
                *(LAS u32x2*)(F.lds + HG_ATT + rc * 128 + (((2 * st + (fq >> 1)) ^ ((rc >> 1) & 7)) << 4) + (fq & 1) * 8) = (u32x2){pk2(m0, m1), pk2(m2, m3)}; }
            f32x4 o[4];
#pragma unroll
            for (int ct = 0; ct < 4; ++ct) o[ct] = (f32x4){0.f, 0.f, 0.f, 0.f};
#pragma unroll
            for (int kk = 0; kk < 4; ++kk) {
                union { bf16x8 v; unsigned u[4]; } A;
                A.u[0] = pk2(St[2 * kk][0], St[2 * kk][1]); A.u[1] = pk2(St[2 * kk][2], St[2 * kk][3]); A.u[2] = pk2(St[2 * kk + 1][0], St[2 * kk + 1][1]); A.u[3] = pk2(St[2 * kk + 1][2], St[2 * kk + 1][3]);
#pragma unroll
                for (int ct = 0; ct < 4; ++ct) { const int rc = 16 * ct + fr;
                    union { bf16x8 v; u32x2 h[2]; } B;
                    B.h[0] = *(const LAS u32x2*)(F.lds + HG_QS + rc * 256 + (((4 * kk + (fq >> 1)) ^ fr) << 4) + (fq & 1) * 8);
                    B.h[1] = *(const LAS u32x2*)(F.lds + HG_QS + rc * 256 + (((4 * kk + 2 + (fq >> 1)) ^ fr) << 4) + (fq & 1) * 8);
                    o[ct] = __builtin_amdgcn_mfma_f32_16x16x32_bf16(A.v, B.v, o[ct], 0, 0, 0); } }
            bf16x8 vt[2]; hg_load_vt(F, vt);
            HSTAMP(4);
            LDS_WAIT(); __syncthreads();
            HSTAMP(5);
#pragma unroll
            for (int ks = 0; ks < 2; ++ks)
#pragma unroll
                for (int ct = 0; ct < 4; ++ct) { const int rc = 16 * ct + fr;
                    const bf16x8 B = *(const LAS bf16x8*)(F.lds + HG_ATT + rc * 128 + (((4 * ks + fq) ^ ((rc >> 1) & 7)) << 4));
                    o[ct] = __builtin_amdgcn_mfma_f32_16x16x32_bf16(vt[ks], B, o[ct], 0, 0, 0); }
            if (dir == 0) {
#pragma unroll
                for (int ct = 0; ct < 4; ++ct) *(u32x2*)(OFW + (size_t)rows[16 * ct + fr] * DM) = (u32x2){pk2(o[ct][0], o[ct][1]), pk2(o[ct][2], o[ct][3])};
                hg_state_update(F, St, vt);
                HSTAMP(6);
            } else {
                LAS float* hn = (LAS float*)(F.lds + HG_HN);
                const f32x4 hn4 = *(const f32x4*)(a.in[IN_HGN] + h * 128 + 16 * w + 4 * fq);
#pragma unroll
                for (int ct = 0; ct < 4; ++ct) { o[ct][0] += bflo(ofw[ct].x); o[ct][1] += bfhi(ofw[ct].x); o[ct][2] += bflo(ofw[ct].y); o[ct][3] += bfhi(ofw[ct].y);
                    float ss = (o[ct][0] * o[ct][0] + o[ct][1] * o[ct][1]) + (o[ct][2] * o[ct][2] + o[ct][3] * o[ct][3]);
                    ss += __shfl_xor(ss, 16); ss += __shfl_xor(ss, 32);
                    if (fq == 0) hn[(16 * ct + fr) * 8 + w] = ss; }
                hg_state_update(F, St, vt);
                HSTAMP(6);
                LDS_WAIT(); __syncthreads();
#pragma unroll
                for (int ct = 0; ct < 4; ++ct) { const f32x4 p0 = *(const LAS f32x4*)(hn + (16 * ct + fr) * 8), p1 = *(const LAS f32x4*)(hn + (16 * ct + fr) * 8 + 4);
                    const float rsn = rsqrtf(((p0.x + p0.y) + (p0.z + p0.w) + (p1.x + p1.y) + (p1.z + p1.w)) * (1.f / 128.f) + EPS);
                    const float g0 = bflo(ogv[ct].x), g1 = bfhi(ogv[ct].x), g2 = bflo(ogv[ct].y), g3 = bfhi(ogv[ct].y);
                    const float y0 = o[ct][0] * rsn * hn4.x * siluf_(g0), y1 = o[ct][1] * rsn * hn4.y * siluf_(g1), y2 = o[ct][2] * rsn * hn4.z * siluf_(g2), y3 = o[ct][3] * rsn * hn4.w * siluf_(g3);
                    *(u32x2*)(OFW + (size_t)rows[16 * ct + fr] * DM) = (u32x2){pk2(y0, y1), pk2(y2, y3)}; }
                HSTAMP(7);
            }
        }
        VM_WAIT(); __syncthreads();
        HSTAMP(8);
    }
}
__device__ __forceinline__ void p_ybg(Frame& F, const Args& a) {
    const bf16* OFp = (const bf16*)(F.ws + WS_OF); const bf16* OBp = (const bf16*)(F.ws + WS_OB); const bf16* OG = (const bf16*)(F.ws + WS_P + 6 * GS);
    bf16* YBG = (bf16*)(F.ws + WS_YBG); const float* hgn = a.in[IN_HGN];
    const int gw = F.bid * NWAVES + F.wave, NGW = F.G * NWAVES;
    for (int row = gw; row < NTOK; row += 2 * NGW) {
        u32x4 fv[2][2], bv[2][2], gvv[2][2];
#pragma unroll
        for (int rr = 0; rr < 2; ++rr)
#pragma unroll
            for (int j = 0; j < 2; ++j) { const size_t o = (size_t)(row + rr * NGW) * DM + 8 * F.lane + 512 * j;
                fv[rr][j] = *(const u32x4*)(OFp + o); bv[rr][j] = *(const u32x4*)(OBp + o); gvv[rr][j] = *(const u32x4*)(OG + o); }
#pragma unroll
        for (int rr = 0; rr < 2; ++rr)
#pragma unroll
        for (int j = 0; j < 2; ++j) { const int k = 8 * F.lane + 512 * j; const size_t o = (size_t)(row + rr * NGW) * DM + k;
            const u32x4 f = fv[rr][j], b = bv[rr][j], g = gvv[rr][j];
            float v[8]; v[0] = bflo(f.x) + bflo(b.x); v[1] = bfhi(f.x) + bfhi(b.x); v[2] = bflo(f.y) + bflo(b.y); v[3] = bfhi(f.y) + bfhi(b.y);
            v[4] = bflo(f.z) + bflo(b.z); v[5] = bfhi(f.z) + bfhi(b.z); v[6] = bflo(f.w) + bflo(b.w); v[7] = bfhi(f.w) + bfhi(b.w);
            float ss = 0.f;
#pragma unroll
            for (int q = 0; q < 8; ++q) ss += v[q] * v[q];
            ss += __shfl_xor(ss, 1); ss += __shfl_xor(ss, 2); ss += __shfl_xor(ss, 4); ss += __shfl_xor(ss, 8);
            const float rs = rsqrtf(ss * (1.f / 128.f) + EPS);
            float gv[8]; gv[0] = bflo(g.x); gv[1] = bfhi(g.x); gv[2] = bflo(g.y); gv[3] = bfhi(g.y); gv[4] = bflo(g.z); gv[5] = bfhi(g.z); gv[6] = bflo(g.w); gv[7] = bfhi(g.w);
            const f32x4 h0 = *(const f32x4*)(hgn + k), h1 = *(const f32x4*)(hgn + k + 4);
            const float hv[8] = {h0.x, h0.y, h0.z, h0.w, h1.x, h1.y, h1.z, h1.w};
            float r[8];
#pragma unroll
            for (int q = 0; q < 8; ++q) r[q] = v[q] * rs * hv[q] * siluf_(gv[q]);
            u32x4 w; w.x = pk2(r[0], r[1]); w.y = pk2(r[2], r[3]); w.z = pk2(r[4], r[5]); w.w = pk2(r[6], r[7]);
            *(u32x4*)(YBG + o) = w; }
    }
}
__device__ __forceinline__ void p_moe_weights13(Frame& F, const Args& a) {
    LAS float* scr = (LAS float*)(F.lds + F.wave * TR_BYTES);
    const int gw = F.bid * NWAVES + F.wave, NGW = F.G * NWAVES;
    for (int it = gw; it < NEXP * 256; it += NGW) {
        const int e = it >> 8, r = it & 255, w = r >> 7, q = r & 127, kb = q >> 3, nb = q & 7;
        transpose_item(a.in[w == 0 ? IN_W1 : IN_W3] + (size_t)e * DM * DEXP, DEXP, DM, (bf16*)(F.ws + (w == 0 ? WS_W1T : WS_W3T)) + ((size_t)e * DEXP + nb * 64) * DM, kb * 64, nb * 64, scr, F.lane);
    }
}
__device__ __forceinline__ void p_moe_weights2(Frame& F, const Args& a, int rank, int nwg) {
    LAS float* scr = (LAS float*)(F.lds + F.wave * TR_BYTES);
    for (int it = rank * NWAVES + F.wave; it < NEXP * 128; it += nwg * NWAVES) {
        const int e = it >> 7, q = it & 127, kb = q >> 4, nb = q & 15;
        transpose_item(a.in[IN_W2] + (size_t)e * DEXP * DM, DM, DEXP, (bf16*)(F.ws + WS_W2T) + ((size_t)e * DM + nb * 64) * DEXP, kb * 64, nb * 64, scr, F.lane);
    }
}

struct SchedP5 {
    int c; const char* YAG; const char* YBG; const char* WA; const char* WB; char* stash; char* M; int i0, n;
    __device__ __forceinline__ bool next(int i, gm::Unit& u) const {
        if (i >= n) return false;
        i += i0;
        int pm, pn; tile_order(c, 64, 4, pm, pn);
        u.A = (i == 0 ? YAG : YBG) + (size_t)pm * 256 * 2048; u.B0 = (i == 0 ? WA : WB) + (size_t)pn * 256 * 2048; u.B1 = u.B0 + (size_t)128 * 2048;
        u.dst = M + ((size_t)pm * 256 * DM + pn * 256) * 2; u.pm = pm; u.pn = pn; u.e = i; u.rows = 256; return true;
    }
    __device__ __forceinline__ unsigned arow(const gm::Unit&, int r) const { return (unsigned)r; }
};
struct EpiP5 {
    static constexpr bool PERM = true;
    unsigned* stash; const bf16* GA; const bf16* GB;
    __device__ __forceinline__ void operator()(const f32x4 (&acc)[2][2][4][2], const gm::Unit& u, int wr, int wc, int fr, int fq) const {
        const bf16* G = (u.e == 0 ? GA : GB) + ((size_t)u.pm * 256 + wr * 64 + fr) * DM + u.pn * 256 + wc * 32 + 8 * fq;
        bf16* Mb = (bf16*)u.dst + (size_t)(wr * 64 + fr) * DM + wc * 32 + 8 * fq;
        u32x4* st = (u32x4*)stash + threadIdx.x;
        asm volatile("" : "+v"(G), "+v"(Mb), "+v"(st));
#pragma unroll
        for (int ai = 0; ai < 2; ++ai)
#pragma unroll
            for (int m = 0; m < 4; ++m) {
                u32x4 g[2], s[2];
#pragma unroll
                for (int bj = 0; bj < 2; ++bj) { const size_t ro = (size_t)(ai * 128 + m * 16) * DM + bj * 128; const int si = (ai * 4 + m) * 2 + bj;
                    g[bj] = *(const u32x4*)(G + ro);
                    if (u.e != 0) s[bj] = st[(size_t)si * NTHR]; }
#pragma unroll
                for (int bj = 0; bj < 2; ++bj) { const size_t ro = (size_t)(ai * 128 + m * 16) * DM + bj * 128; const int si = (ai * 4 + m) * 2 + bj;
                    f32x4 v0 = acc[ai][bj][m][0], v1 = acc[ai][bj][m][1];
                    v0[0] *= sigmoidf_(bflo(g[bj].x)); v0[1] *= sigmoidf_(bfhi(g[bj].x)); v0[2] *= sigmoidf_(bflo(g[bj].y)); v0[3] *= sigmoidf_(bfhi(g[bj].y));
                    v1[0] *= sigmoidf_(bflo(g[bj].z)); v1[1] *= sigmoidf_(bfhi(g[bj].z)); v1[2] *= sigmoidf_(bflo(g[bj].w)); v1[3] *= sigmoidf_(bfhi(g[bj].w));
                    if (u.e != 0) { v0[0] += bflo(s[bj].x); v0[1] += bfhi(s[bj].x); v0[2] += bflo(s[bj].y); v0[3] += bfhi(s[bj].y);
                                    v1[0] += bflo(s[bj].z); v1[1] += bfhi(s[bj].z); v1[2] += bflo(s[bj].w); v1[3] += bfhi(s[bj].w); }
                    u32x4 w; w.x = gm::cvt_pk_bf16(v0[0], v0[1]); w.y = gm::cvt_pk_bf16(v0[2], v0[3]); w.z = gm::cvt_pk_bf16(v1[0], v1[1]); w.w = gm::cvt_pk_bf16(v1[2], v1[3]);
                    if (u.e == 0) st[(size_t)si * NTHR] = w; else *(u32x4*)(Mb + ro) = w; }
                asm volatile("" ::: "memory"); }
    }
};

struct SchedP6 {
    int c; const char* M; const char* W; char* X1;
    __device__ __forceinline__ bool next(int i, gm::Unit& u) const {
        if (i >= 1) return false;
        int pm, pn; tile_order(c, 64, 4, pm, pn);
        u.A = M + (size_t)pm * 256 * 2048; u.B0 = W + (size_t)pn * 256 * 2048; u.B1 = u.B0 + (size_t)128 * 2048;
        u.dst = X1 + ((size_t)pm * 256 * DM + pn * 256) * 4; u.pm = pm; u.pn = pn; u.e = 0; u.rows = 256; return true;
    }
    __device__ __forceinline__ unsigned arow(const gm::Unit&, int r) const { return (unsigned)r; }
};
struct EpiP6 {
    static constexpr bool PERM = false;
    const float* x; const float* mod;
    __device__ __forceinline__ void operator()(const f32x4 (&acc)[2][2][4][2], const gm::Unit& u, int wr, int wc, int fr, int fq) const {
        const int b = u.pm >> 3; const int col0 = u.pn * 256 + wc * 32 + 4 * fq;
        const float* mg = mod + b * 6144 + 2 * DM + col0;
        f32x4 gv[2][2];
#pragma unroll
        for (int bj = 0; bj < 2; ++bj)
#pragma unroll
            for (int n = 0; n < 2; ++n) gv[bj][n] = *(const f32x4*)(mg + bj * 128 + n * 16);
#pragma unroll
        for (int ai = 0; ai < 2; ++ai)
#pragma unroll
            for (int m = 0; m < 4; ++m) { const size_t ro = (size_t)(wr * 64 + fr + ai * 128 + m * 16) * DM + wc * 32 + 4 * fq;
                const float* xr = x + ((size_t)u.pm * 256 * DM + u.pn * 256) + ro; float* orow = (float*)u.dst + ro;
#pragma unroll
                for (int bj = 0; bj < 2; ++bj)
#pragma unroll
                    for (int n = 0; n < 2; ++n) { const f32x4 xv = *(const f32x4*)(xr + bj * 128 + n * 16);
                        *(f32x4*)(orow + bj * 128 + n * 16) = xv + gv[bj][n] * acc[ai][bj][m][n]; } }
    }
};

__device__ __forceinline__ void p_norm2_route(Frame& F, const Args& a) {
    const float* mod = (const float*)(F.ws + WS_MOD); const float* g2 = a.in[IN_G2]; const float* wrp = (const float*)(F.ws + WS_WRT);
    const float* X1 = F.out; bf16* HX2 = (bf16*)(F.ws + WS_HX2);
    int* list = (int*)(F.ws + WS_LIST); float* wt = (float*)(F.ws + WS_WT); unsigned* cnt = F.ctl + CW_CNT;
    LAS float* gs = (LAS float*)F.lds; LAS float* sh = gs + DM; LAS float* rst = sh + DM; LAS float* lgs = rst + 64;
    const int b = F.bid / 32;
    for (int k = F.tid; k < DM; k += NTHR) { gs[k] = g2[k] * (1.f + mod[b * 6144 + 4 * DM + k]); sh[k] = mod[b * 6144 + 3 * DM + k]; }
    __syncthreads();
    for (int r = F.wave; r < 64; r += NWAVES) {
        const int tok = F.bid * 64 + r;
        const f32x4* xr = (const f32x4*)(X1 + (size_t)tok * DM) + F.lane;
        f32x4 v[4]; float s = 0.f;
#pragma unroll
        for (int j = 0; j < 4; ++j) { v[j] = xr[64 * j]; s += (v[j].x * v[j].x + v[j].y * v[j].y) + (v[j].z * v[j].z + v[j].w * v[j].w); }
        const float rstd = rsqrtf(wave_sum(s) * (1.f / DM) + EPS);
        if (F.lane == 0) rst[r] = rstd;
        unsigned long long* o8 = (unsigned long long*)(HX2 + (size_t)tok * DM) + F.lane;
#pragma unroll
        for (int j = 0; j < 4; ++j) { const int k = 4 * F.lane + 256 * j;
            const f32x4 g = *(const LAS f32x4*)(gs + k), h = *(const LAS f32x4*)(sh + k);
            o8[64 * j] = (unsigned long long)pk2(v[j].x * rstd * g.x + h.x, v[j].y * rstd * g.y + h.y) | ((unsigned long long)pk2(v[j].z * rstd * g.z + h.z, v[j].w * rstd * g.w + h.w) << 32); }
    }
    LDS_WAIT(); __syncthreads();
    {
        const int tq = F.lane & 15, kq = F.lane >> 4, wg = F.wave & 3, kh = F.wave >> 2; const int tl = wg * 16 + tq;
        const float rs = rst[tl];
        const float* xr = X1 + (size_t)(F.bid * 64 + tl) * DM + 4 * kq + 512 * kh;
        const f32x4* wp = (const f32x4*)wrp + F.lane + (size_t)kh * 32 * 3 * 64;
        const LAS float* gsp = gs + 512 * kh + 4 * kq; const LAS float* shp = sh + 512 * kh + 4 * kq;
        f32x4 acc[3];
#pragma unroll
        for (int c = 0; c < 3; ++c) acc[c] = (f32x4){0.f, 0.f, 0.f, 0.f};
#pragma unroll 8
        for (int s = 0; s < 32; ++s) {
            const f32x4 x = *(const f32x4*)(xr + 16 * s); const f32x4 g = *(const LAS f32x4*)(gsp + 16 * s), h = *(const LAS f32x4*)(shp + 16 * s);
            const f32x4 hv = x * rs * g + h;
#pragma unroll
            for (int c = 0; c < 3; ++c) { const f32x4 w = wp[(s * 3 + c) * 64];
                acc[c] = __builtin_amdgcn_mfma_f32_16x16x4f32(hv[0], w[0], acc[c], 0, 0, 0); acc[c] = __builtin_amdgcn_mfma_f32_16x16x4f32(hv[1], w[1], acc[c], 0, 0, 0);
                acc[c] = __builtin_amdgcn_mfma_f32_16x16x4f32(hv[2], w[2], acc[c], 0, 0, 0); acc[c] = __builtin_amdgcn_mfma_f32_16x16x4f32(hv[3], w[3], acc[c], 0, 0, 0); }
        }
#pragma unroll
        for (int c = 0; c < 3; ++c)
#pragma unroll
            for (int r = 0; r < 4; ++r) lgs[kh * 64 * 48 + (wg * 16 + 4 * kq + r) * 48 + 16 * c + tq] = acc[c][r];
    }
    LDS_WAIT(); __syncthreads();
    LAS unsigned* lcnt = (LAS unsigned*)(lgs + 2 * 64 * 48); LAS unsigned* lbase = lcnt + 32;
    if (F.tid < 32) lcnt[F.tid] = 0u;
    LDS_WAIT(); __syncthreads();
    int ea = 0, eb = 0; unsigned ra = 0u, rb = 0u; int tok = 0; float w1 = 0.f, w2 = 0.f;
    const bool picker = F.wave < 4 && F.lane < 16;
    if (picker) {
        const LAS float* lp = lgs + (F.wave * 16 + F.lane) * 48; tok = F.bid * 64 + F.wave * 16 + F.lane;
        float lg[36];
#pragma unroll
        for (int q = 0; q < 9; ++q) { const f32x4 t4 = *(const LAS f32x4*)(lp + 4 * q) + *(const LAS f32x4*)(lp + 64 * 48 + 4 * q) + *(const f32x4*)(wrp + 49152 + 4 * q);
            lg[4 * q] = t4.x; lg[4 * q + 1] = t4.y; lg[4 * q + 2] = t4.z; lg[4 * q + 3] = t4.w; }
        float mx = lg[0]; int gi = 0;
#pragma unroll
        for (int g = 1; g < 4; ++g) if (lg[g] > mx) { mx = lg[g]; gi = g; }
        float z = 0.f;
#pragma unroll
        for (int g = 0; g < 4; ++g) z += __expf(lg[g] - mx);
        const float pg = 1.f / z;
        float el[8];
#pragma unroll
        for (int e = 0; e < 8; ++e) el[e] = gi == 0 ? lg[4 + e] : (gi == 1 ? lg[12 + e] : (gi == 2 ? lg[20 + e] : lg[28 + e]));
        int e1 = 0; float m1 = el[0];
#pragma unroll
        for (int e = 1; e < 8; ++e) if (el[e] > m1) { m1 = el[e]; e1 = e; }
        int e2 = 0; float m2 = -3.0e38f;
#pragma unroll
        for (int e = 0; e < 8; ++e) if (e != e1 && el[e] > m2) { m2 = el[e]; e2 = e; }
        const float rr = __expf(m2 - m1); w1 = pg / (1.f + rr); w2 = pg * rr / (1.f + rr);
        ea = gi * 8 + e1; eb = gi * 8 + e2;
        ra = __hip_atomic_fetch_add(lcnt + ea, 1u, __ATOMIC_RELAXED, __HIP_MEMORY_SCOPE_WORKGROUP);
        rb = __hip_atomic_fetch_add(lcnt + eb, 1u, __ATOMIC_RELAXED, __HIP_MEMORY_SCOPE_WORKGROUP);
    }
    LDS_WAIT(); __syncthreads();
    if (F.tid < 32) { const unsigned n = lcnt[F.tid]; lbase[F.tid] = n ? __hip_atomic_fetch_add(cnt + 64 * F.tid, n, __ATOMIC_RELAXED, __HIP_MEMORY_SCOPE_AGENT) : 0u; }
    LDS_WAIT(); __syncthreads();
    if (picker) {
        list[(size_t)ea * CAP + lbase[ea] + ra] = tok * 2; wt[tok * 2] = w1;
        list[(size_t)eb * CAP + lbase[eb] + rb] = tok * 2 + 1; wt[tok * 2 + 1] = w2;
    }
}

__device__ __forceinline__ void moe_table(Frame& F, const int* cntv) {
    if (F.wave == 0) { const int lane = F.lane; const int cnt = lane < NEXP ? cntv[64 * lane] : 0;
        const int t = (cnt + 255) >> 8; int ti = t, oi = cnt;
#pragma unroll
        for (int d = 1; d < 32; d <<= 1) { const int tu = __shfl_up(ti, d), ou = __shfl_up(oi, d); if ((lane & 31) >= d) { ti += tu; oi += ou; } }
        if (lane < NEXP) { F.MISC[128 + lane] = (unsigned)cnt; F.MISC[160 + lane] = (unsigned)(ti - t); F.MISC[192 + lane] = (unsigned)(oi - cnt); }
        if (lane == NEXP - 1) F.MISC[224] = (unsigned)ti; }
    LDS_WAIT(); __syncthreads();
}
__device__ __forceinline__ bool moe_find(volatile LAS unsigned* MISC, int lane, int T, int& e, int& rt, int& rows, int& off) {
    if (T >= (int)MISC[224]) return false;
    const int l = lane & 31; const int cnt = (int)MISC[128 + l], tpre = (int)MISC[160 + l];
    const unsigned long long mask = __ballot(lane < NEXP && cnt > 0 && T >= tpre);
    e = __builtin_amdgcn_readfirstlane(63 - __builtin_clzll(mask));
    rt = T - (int)MISC[160 + e]; const int c = (int)MISC[128 + e]; off = (int)MISC[192 + e];
    rows = c - rt * 256; if (rows > 256) rows = 256; return true;
}
struct SchedMoe1 {
    int G, c, lane; volatile LAS unsigned* MISC; const int* list; const char* HX2; const char* W1T; const char* W3T; char* HH; unsigned* tile_cnt;
    __device__ __forceinline__ bool next(int i, gm::Unit& u) const {
        const int vc = (c & 7) * (G >> 3) + (c >> 3);
        const int L = i * G + vc; int e, rt, rows, off; if (!moe_find(MISC, lane, L >> 2, e, rt, rows, off)) return false;
        const int pn = L & 3;
        e = __builtin_amdgcn_readfirstlane(e); rt = __builtin_amdgcn_readfirstlane(rt); rows = __builtin_amdgcn_readfirstlane(rows); off = __builtin_amdgcn_readfirstlane(off);
        u.A = HX2; u.B0 = W1T + ((size_t)e * DEXP + pn * 128) * 2048; u.B1 = W3T + ((size_t)e * DEXP + pn * 128) * 2048;
        u.dst = HH + ((size_t)(off + rt * 256) * DEXP + pn * 128) * 2; u.pm = rt; u.pn = pn; u.e = e; u.rows = rows; u.t = L >> 2; return true;
    }
    __device__ __forceinline__ unsigned arow(const gm::Unit& u, int r) const { const int rr = r < u.rows ? r : u.rows - 1; return (unsigned)(list[(size_t)u.e * CAP + u.pm * 256 + rr] >> 1); }
    __device__ __forceinline__ void a_ready(const gm::Unit&) const {}
    __device__ __forceinline__ void done(const gm::Unit& u) const {
        asm volatile("s_waitcnt vmcnt(0)" ::: "memory");
        __builtin_amdgcn_s_barrier(); asm volatile("" ::: "memory");
        if (threadIdx.x == 0) __hip_atomic_fetch_add(tile_cnt + 8 * u.t, 1u, __ATOMIC_RELAXED, __HIP_MEMORY_SCOPE_AGENT);
    }
};
struct EpiMoe1 {
    static constexpr bool PERM = true;
    char* HH;
    __device__ __forceinline__ void operator()(const f32x4 (&acc)[2][2][4][2], const gm::Unit& u, int wr, int wc, int fr, int fq) const {
        const __amdgpu_buffer_rsrc_t rs = __builtin_amdgcn_make_buffer_rsrc((void*)HH, 0, 0x7fffffff, 0x00020000);
        const unsigned base = (unsigned)(u.dst - HH) + (unsigned)(((wr * 64 + fr) * DEXP + wc * 32 + 8 * fq) * 2);
#pragma unroll
        for (int ai = 0; ai < 2; ++ai)
#pragma unroll
            for (int m = 0; m < 4; ++m) { const int r = ai * 128 + wr * 64 + m * 16 + fr; if (r >= u.rows) continue;
                const f32x4 u0 = acc[ai][0][m][0], u1 = acc[ai][0][m][1], v0 = acc[ai][1][m][0], v1 = acc[ai][1][m][1];
                u32x4 w; w.x = gm::cvt_pk_bf16(siluf_(u0[0]) * v0[0], siluf_(u0[1]) * v0[1]); w.y = gm::cvt_pk_bf16(siluf_(u0[2]) * v0[2], siluf_(u0[3]) * v0[3]);
                w.z = gm::cvt_pk_bf16(siluf_(u1[0]) * v1[0], siluf_(u1[1]) * v1[1]); w.w = gm::cvt_pk_bf16(siluf_(u1[2]) * v1[2], siluf_(u1[3]) * v1[3]);
                __builtin_amdgcn_raw_buffer_store_b128(w, rs, base + (unsigned)((ai * 128 + m * 16) * DEXP * 2), 0, 16); }
    }
};
struct SchedMoe2 {
    int G, c, lane; volatile LAS unsigned* MISC; const char* HH; const char* W2T; char* Y; unsigned* tile_cnt; unsigned* tmo;
    __device__ __forceinline__ bool next(int i, gm::Unit& u) const {
        const int vc = (c & 7) * (G >> 3) + (c >> 3);
        const int U = 4 * (int)MISC[224], q = U / G, r = U % G;
        const bool rebal = q >= 1 && r > 0 && 3 * r <= G;
        int L = i * G + (G - 1 - vc);
        if (rebal) {
            if (vc < r) { if (i >= q - 1) return false; }
            else if (vc < 2 * r) { if (i == q) L = (q - 1) * G + (G - 1 - (vc - r)); else if (i > q) return false; }
        }
        int e, rt, rows, off; if (!moe_find(MISC, lane, L >> 2, e, rt, rows, off)) return false;
        const int pn = L & 3;
        e = __builtin_amdgcn_readfirstlane(e); rt = __builtin_amdgcn_readfirstlane(rt); rows = __builtin_amdgcn_readfirstlane(rows); off = __builtin_amdgcn_readfirstlane(off);
        u.A = HH + (size_t)(off + rt * 256) * DEXP * 2; u.B0 = W2T + ((size_t)e * DM + pn * 256) * (DEXP * 2); u.B1 = u.B0 + (size_t)128 * (DEXP * 2);
        u.dst = Y + (size_t)pn * 256 * 2; u.pm = rt; u.pn = pn; u.e = e; u.rows = rows; u.t = L >> 2; return true;
    }
    __device__ __forceinline__ unsigned arow(const gm::Unit&, int r) const { return (unsigned)r; }
    __device__ __forceinline__ void a_ready(const gm::Unit& u) const {
        if (threadIdx.x < 64) {
            unsigned spins = 0;
            while ((unsigned)__builtin_amdgcn_readfirstlane(__hip_atomic_load(tile_cnt + 8 * u.t, __ATOMIC_RELAXED, __HIP_MEMORY_SCOPE_AGENT)) < 4u) {
                __builtin_amdgcn_s_sleep(2);
                if (++spins > (1u << 22)) { if (threadIdx.x == 0) __hip_atomic_store(tmo, 1u, __ATOMIC_RELAXED, __HIP_MEMORY_SCOPE_AGENT); break; } }
            __builtin_amdgcn_fence(__ATOMIC_ACQUIRE, "agent");
            asm volatile("s_waitcnt vmcnt(0)" ::: "memory");
        }
        asm volatile("" ::: "memory"); __builtin_amdgcn_s_barrier(); asm volatile("" ::: "memory");
    }
    __device__ __forceinline__ void done(const gm::Unit&) const {}
};
struct EpiMoe2 {
    static constexpr bool PERM = true;
    const int* list;
    __device__ __forceinline__ void operator()(const f32x4 (&acc)[2][2][4][2], const gm::Unit& u, int wr, int wc, int fr, int fq) const {
        const int* lp = list + (size_t)u.e * CAP + u.pm * 256;
#pragma unroll
        for (int ai = 0; ai < 2; ++ai)
#pragma unroll
            for (int m = 0; m < 4; ++m) { const int r = ai * 128 + wr * 64 + m * 16 + fr; if (r >= u.rows) continue;
                const int slot = lp[r]; bf16* rowp = (bf16*)u.dst + (size_t)slot * DM + wc * 32 + 8 * fq;
#pragma unroll
                for (int bj = 0; bj < 2; ++bj) { const f32x4 v0 = acc[ai][bj][m][0], v1 = acc[ai][bj][m][1];
                    u32x4 w; w.x = gm::cvt_pk_bf16(v0[0], v0[1]); w.y = gm::cvt_pk_bf16(v0[2], v0[3]); w.z = gm::cvt_pk_bf16(v1[0], v1[1]); w.w = gm::cvt_pk_bf16(v1[2], v1[3]);
                    *(u32x4*)(rowp + bj * 128) = w; } }
    }
};

__device__ __forceinline__ void p_final(Frame& F, const Args& a) {
    const float* mod = (const float*)(F.ws + WS_MOD); const float* fg = a.in[IN_FG]; const float* wt = (const float*)(F.ws + WS_WT);
    const bf16* Y = (const bf16*)(F.ws + WS_Y); float* X1 = F.out;
    for (int r = F.wave; r < 64; r += NWAVES) {
        const int tok = F.bid * 64 + r; const int b = tok >> 11;
        const float w0 = wt[tok * 2], w1 = wt[tok * 2 + 1];
        f32x4* xr = (f32x4*)(X1 + (size_t)tok * DM) + F.lane;
        const u32x2* y0 = (const u32x2*)(Y + (size_t)(tok * 2) * DM) + F.lane; const u32x2* y1 = (const u32x2*)(Y + (size_t)(tok * 2 + 1) * DM) + F.lane;
        f32x4 v[4]; float s = 0.f;
#pragma unroll
        for (int j = 0; j < 4; ++j) { const int k = 4 * F.lane + 256 * j;
            const f32x4 xv = xr[64 * j]; const u32x2 a0 = y0[64 * j], a1 = y1[64 * j]; const f32x4 g5 = *(const f32x4*)(mod + b * 6144 + 5 * DM + k);
            v[j].x = xv.x + g5.x * (w0 * bflo(a0.x) + w1 * bflo(a1.x)); v[j].y = xv.y + g5.y * (w0 * bfhi(a0.x) + w1 * bfhi(a1.x));
            v[j].z = xv.z + g5.z * (w0 * bflo(a0.y) + w1 * bflo(a1.y)); v[j].w = xv.w + g5.w * (w0 * bfhi(a0.y) + w1 * bfhi(a1.y));
            s += (v[j].x * v[j].x + v[j].y * v[j].y) + (v[j].z * v[j].z + v[j].w * v[j].w); }
        const float rstd = rsqrtf(wave_sum(s) * (1.f / DM) + EPS);
#pragma unroll
        for (int j = 0; j < 4; ++j) { const int k = 4 * F.lane + 256 * j; const f32x4 g = *(const f32x4*)(fg + k);
            xr[64 * j] = (f32x4){v[j].x * rstd * g.x, v[j].y * rstd * g.y, v[j].z * rstd * g.z, v[j].w * rstd * g.w}; }
    }
}
#ifndef LRU_FAST
#define LRU_FAST 1
#endif
#ifndef HG_FAST
#define HG_FAST 1
#endif
#define MIX_FAST (LRU_FAST && HG_FAST)
#ifdef PROBE_A
#define STAMP(k) do { if (F.bid == 0 && F.tid == 0) { const unsigned long long _t = __builtin_amdgcn_s_memrealtime(); F.MISC[32 + 2 * (k)] = (unsigned)_t; F.MISC[33 + 2 * (k)] = (unsigned)(_t >> 32); } } while (0)
#else
#define STAMP(k) do { } while (0)
#endif
__device__ __forceinline__ void p_mix1(Frame& F, const Args& a) {
#if LRU_FAST
    {
        const int h = (F.bid >> 4) & 7; int ch = h * 128 + 16 * F.wave + (F.lane & 15);
        const LruCoef kf = lru_coef(a, 0, ch), kb = lru_coef(a, 1, ch);
        for (int r = 0; r < 2; ++r) lru_unit(F, a, r * 256 + F.bid, kf, kb);
    }
#endif
    STAMP(14); STAMP(15);
#if HG_FAST
    for (int i = 0, u = F.bid; u < NB * 8 * 2 * 4; u += F.G, ++i) hg_pass1(F, a, (u & ~3) | ((u + 2 * i) & 3));
#endif
}
__device__ __forceinline__ void p_mix2(Frame& F, const Args& a) {
#if LRU_FAST
    {
        const int h = (F.bid >> 4) & 7; int ch = h * 128 + 16 * F.wave + (F.lane & 15);
        asm volatile("" : "+v"(ch));
        const LruCoef kf = lru_coef(a, 0, ch), kb = lru_coef(a, 1, ch);
        for (int r = 2; r < 4; ++r) lru_unit(F, a, r * 256 + F.bid, kf, kb);
    }
#endif
    STAMP(16); STAMP(17);
#if HG_FAST
    for (int u = F.bid; u < NB * 8 * 4; u += F.G) hg_pass2(F, a, u);
#endif
}
__global__ void __launch_bounds__(NTHR, 2) mega(Args args) {
    extern __shared__ __attribute__((aligned(16))) unsigned char lds_raw[];
    Frame F;
    F.lds = (LAS unsigned char*)lds_raw; F.MISC = (volatile LAS unsigned*)(F.lds + LDSCTL_OFF);
    F.tid = threadIdx.x; F.lane = F.tid & 63; F.wave = __builtin_amdgcn_readfirstlane(F.tid >> 6);
    F.G = gridDim.x; F.bid = blockIdx.x; F.ws = args.ws; F.out = args.out; F.ctl = (unsigned*)(args.ws + WS_CTL);
    for (int u = F.tid; u < (LDS_BYTES - LDSCTL_OFF) / 4; u += NTHR) ((LAS unsigned*)(F.lds + LDSCTL_OFF))[u] = 0u;
    __syncthreads();
    XcdBarrier bar = xcd_barrier_post(F.ctl + CW_BAR + args.li * 3584, F.MISC + 8);
    const int lo = args.ph_lo, hi = args.ph_hi;
#define IN(k) (lo <= (k) && (k) < hi)
#define SEAM(k) do { if (IN(k) && IN((k) + 1)) xcd_barrier(bar); STAMP((k) + 1); if ((k) == 9) STAMP(11); } while (0)
    unsigned char* ws = F.ws;
    STAMP(0);
    if (IN(0)) { p0_prologue(F, args); } SEAM(0);
    if (IN(1)) { p1_norm(F, args); } SEAM(1);
    if (IN(2)) {
        SchedP2 S{F.G, F.bid, (const char*)F.out, (const char*)(ws + WS_WIN), (char*)(ws + WS_P), (char*)(ws + WS_PC)};
        EpiStoreBf16 E;
        gm::gemm_phase<SchedP2, EpiStoreBf16, false>(F.lds, DM, S, E);
    } SEAM(2);
    if (IN(3)) { p_mix1(F, args); } SEAM(3);
    if (IN(4)) { p_mix2(F, args); } SEAM(4); STAMP(6);
    if (IN(6)) {
        const int slot = (F.bid >> 3) % 3;
        EpiP5 E{(unsigned*)F.out + (size_t)F.bid * 32768, (const bf16*)(ws + WS_P + 7 * GS), (const bf16*)(ws + WS_P + 8 * GS)};
        if (slot == 0) { p_moe_weights13(F, args); p_moe_weights2(F, args, F.bid, F.G); __syncthreads(); }
        {
            SchedP5 S{F.bid, (const char*)(ws + WS_YAG), (const char*)(ws + WS_YBG), (const char*)(ws + WS_WPA), (const char*)(ws + WS_WPB), nullptr, (char*)(ws + WS_M), 0, slot == 1 ? 1 : 2};
            gm::gemm_phase<SchedP5, EpiP5, false>(F.lds, DM, S, E);
        }
        if (slot == 1) {
            __syncthreads(); p_moe_weights13(F, args); p_moe_weights2(F, args, F.bid, F.G); __syncthreads();
            SchedP5 S{F.bid, (const char*)(ws + WS_YAG), (const char*)(ws + WS_YBG), (const char*)(ws + WS_WPA), (const char*)(ws + WS_WPB), nullptr, (char*)(ws + WS_M), 1, 1};
            gm::gemm_phase<SchedP5, EpiP5, false>(F.lds, DM, S, E);
        }
        if (slot == 2) { __syncthreads(); p_moe_weights13(F, args); p_moe_weights2(F, args, F.bid, F.G); }
    } SEAM(6);
    if (IN(7)) {
        SchedP6 S{F.bid, (const char*)(ws + WS_M), (const char*)(ws + WS_WOUT), (char*)F.out};
        EpiP6 E{args.in[IN_X], (const float*)(ws + WS_MOD)};
        gm::gemm_phase<SchedP6, EpiP6, false>(F.lds, DM, S, E);
    } SEAM(7);
    if (IN(8)) { p_norm2_route(F, args); } SEAM(8);
    if (IN(9)) {
        moe_table(F, (const int*)(F.ctl + CW_CNT));
        {
            SchedMoe1 S{F.G, F.bid, F.lane, F.MISC, (const int*)(ws + WS_LIST), (const char*)(ws + WS_HX2), (const char*)(ws + WS_W1T), (const char*)(ws + WS_W3T), (char*)(ws + WS_HH), F.ctl + CW_TILE};
            EpiMoe1 E{(char*)(ws + WS_HH)};
            gm::gemm_phase<SchedMoe1, EpiMoe1, true, true>(F.lds, DM, S, E);
        }
        {
            SchedMoe2 S{F.G, F.bid, F.lane, F.MISC, (const char*)(ws + WS_HH), (const char*)(ws + WS_W2T), (char*)(ws + WS_Y), F.ctl + CW_TILE, F.ctl + 2};
            EpiMoe2 E{(const int*)(ws + WS_LIST)};
            gm::gemm_phase<SchedMoe2, EpiMoe2, false, true>(F.lds, DEXP, S, E);
        }
    } SEAM(9);
    if (IN(11)) { p_final(F, args); }
#ifdef PROBE_A
    if (F.bid == 0 && F.tid == 0) {
        const unsigned long long tend = __builtin_amdgcn_s_memrealtime();
        F.MISC[32 + 2 * 12] = (unsigned)tend; F.MISC[33 + 2 * 12] = (unsigned)(tend >> 32);
        auto RD = [&](int k) { return ((unsigned long long)F.MISC[33 + 2 * k] << 32) | F.MISC[32 + 2 * k]; };
        auto T = [&](int k) { if (k >= 20) { const int i = k - 20; return ((unsigned long long)F.MISC[103 + 2 * i] << 32) | F.MISC[102 + 2 * i]; } if (k == 13) return RD(14) - RD(3); if (k == 15) return RD(16) - RD(4); return RD(k + 1) - RD(k); };
        const unsigned long long delay = T(PROBE_B) * 256ull;
        while (__builtin_amdgcn_s_memrealtime() - tend < delay) __builtin_amdgcn_s_sleep(32);
    }
#endif
#undef IN
#undef SEAM
}

#if !LRU_FAST
__global__ void k_conv_f(const bf16* P0, const bf16* PC0, const float* cw, const float* cb, float* Ub, int b) {
    int t = blockIdx.x; int Lseg = t < CTX ? CTX : SEQ; int lt = t < CTX ? t : t - CTX;
    const bf16* base = t < CTX ? PC0 + (size_t)b * CTX * DM : P0 + (size_t)b * SEQ * DM;
    for (int ch = threadIdx.x; ch < DM; ch += 256) {
        float s = cb[ch];
#pragma unroll
        for (int k = 0; k < 4; ++k) { int tt = lt + k - 2; if (tt >= 0 && tt < Lseg) s += cw[k * DM + ch] * bf2f(base[(size_t)tt * DM + ch]); }
        Ub[(size_t)t * DM + ch] = s;
    }
}
__global__ void k_gates(const float* Ub, const float* wa, const float* ba, const float* wx, const float* bx, const float* lam, float* Aout, float* Bout, int d) {
    __shared__ float us[128];
    int t = blockIdx.x, h = blockIdx.y, j = threadIdx.x; int ch = h * 128 + j;
    float uval = Ub[(size_t)t * DM + ch];
    us[j] = uval; __syncthreads();
    const float* wah = wa + ((size_t)(d * 8 + h) * 128) * 128; const float* wxh = wx + ((size_t)(d * 8 + h) * 128) * 128;
    float ra = 0.f, ia = 0.f;
    for (int i = 0; i < 128; ++i) { float u = us[i]; ra += u * wah[i * 128 + j]; ia += u * wxh[i * 128 + j]; }
    float r = 1.f / (1.f + expf(-(ra + ba[d * DM + ch]))); float ig = 1.f / (1.f + expf(-(ia + bx[d * DM + ch])));
    float sp = log1pf(expf(-lam[d * DM + ch]));
    float log_a = -8.f * r * sp;
    Aout[(size_t)t * DM + ch] = expf(log_a); Bout[(size_t)t * DM + ch] = sqrtf(-expm1f(2.f * log_a)) * (ig * uval);
}
__global__ void k_lru_scan(const float* A0, const float* B0, const float* A1, const float* B1, float* YF, float* YB) {
    int g = blockIdx.x * 256 + threadIdx.x; int d = g / DM, ch = g % DM;
    if (d == 0) { float h = B0[ch];
        for (int t = 0; t < SEQ; ++t) { size_t o = (size_t)(CTX + t) * DM + ch; h = A0[o] * h + B0[o]; YF[(size_t)t * DM + ch] = h; }
    } else { float h = B1[(size_t)(CTX - 1) * DM + ch];
        for (int t = SEQ - 1; t >= 0; --t) { size_t o = (size_t)(CTX + t) * DM + ch; h = A1[o] * h + B1[o]; YB[(size_t)t * DM + ch] = h; }
    }
}
__global__ void k_yag_f(const float* YF, const float* YB, bf16* AY, int b) {
    int t = blockIdx.x;
    for (int ch = threadIdx.x; ch < DM; ch += 256) { size_t o = (size_t)t * DM + ch; bf16* p = AY + ((size_t)b * SEQ + t) * DM + ch;
        *p = (bf16)f2bf((YF[o] + YB[o]) * gelu_tanh(bf2f(*p))); }
}
#endif
#if !HG_FAST
__global__ __launch_bounds__(128) void k_hgrn_f(unsigned char* ws, const float* hg_lb) {
    __shared__ float gs[128], ks[128], qs[128];
    int h = blockIdx.x, d = blockIdx.y, b = blockIdx.z, j = threadIdx.x;
    float S[128];
#pragma unroll
    for (int i = 0; i < 128; ++i) S[i] = 0.f;
    const int c = h * 128 + j;
    const float lbj = 1.f / (1.f + expf(hg_lb[DM + c] - hg_lb[c]));
    bf16* Q = (bf16*)(ws + WS_P + 2 * GS); bf16* Fx = (bf16*)(ws + WS_P + (d == 0 ? 3 : 4) * GS); bf16* V = (bf16*)(ws + WS_P + 5 * GS);
    const bf16* Fc = (const bf16*)(ws + WS_PC + (d == 0 ? 1 : 2) * CGS); const bf16* Vc = (const bf16*)(ws + WS_PC + 3 * CGS);
    for (int s = 0; s < LT; ++s) {
        bool isx = s >= CTX; float fv, vv, qv = 0.f; size_t o;
        if (!isx) { int t = d == 0 ? s : (CTX - 1 - s); o = ((size_t)b * CTX + t) * DM + c; fv = bf2f(Fc[o]); vv = bf2f(Vc[o]); }
        else { int p = s - CTX; if (d == 1) p = SEQ - 1 - p; int tok = (p % 32) * 64 + (p / 32); o = ((size_t)b * SEQ + tok) * DM + c; fv = bf2f(Fx[o]); vv = bf2f(V[o]); qv = bf2f(Q[o]); }
        float gg = lbj + (1.f - lbj) / (1.f + expf(-fv));
        gs[j] = gg; ks[j] = 1.f - gg; qs[j] = qv / (1.f + expf(-qv));
        __syncthreads();
        float oo = 0.f;
#pragma unroll
        for (int i = 0; i < 128; ++i) { S[i] = gs[i] * S[i] + ks[i] * vv; oo += S[i] * qs[i]; }
        if (isx) Fx[o] = (bf16)f2bf(oo);
        __syncthreads();
    }
}
#endif

extern "C" void kernel_launch(void* const* d_in, const int* in_sizes, int n_in, void* d_out, int out_size, void* d_ws, size_t ws_size, hipStream_t stream) {
    static int grid = 0;
    if (grid == 0) {
        if (n_in != 29 || out_size != NTOK * DM || ws_size < WS_END) { fprintf(stderr, "kernel_launch: unexpected problem shape / workspace (%d inputs, out %d, ws %zu)\n", n_in, out_size, ws_size); grid = -1; return; }
        int dev = 0, cus = 0, per_cu = 0;
        if (hipGetDevice(&dev) != hipSuccess || hipDeviceGetAttribute(&cus, hipDeviceAttributeMultiprocessorCount, dev) != hipSuccess) { grid = -1; return; }
        if (hipFuncSetAttribute((const void*)mega, hipFuncAttributeMaxDynamicSharedMemorySize, LDS_BYTES) != hipSuccess) { grid = -1; return; }
        if (hipOccupancyMaxActiveBlocksPerMultiprocessor(&per_cu, (const void*)mega, NTHR, LDS_BYTES) != hipSuccess || per_cu < 1) { fprintf(stderr, "kernel_launch: occupancy query says %d blocks per CU\n", per_cu); }
        (void)hipGetLastError();
        grid = cus;
        if (grid != 256) { fprintf(stderr, "kernel_launch: built for 256 CUs, found %d\n", cus); grid = -1; return; }
    }
    if (grid < 0) return;
    hipMemsetAsync((char*)d_ws + WS_CTL, 0, CTL_BYTES, stream);
    Args a{};
    for (int i = 0; i < 29; ++i) a.in[i] = (const float*)d_in[i];
    a.out = (float*)d_out; a.ws = (unsigned char*)d_ws;
#if MIX_FAST
    a.ph_lo = 0; a.ph_hi = 12; a.li = 0;
    hipLaunchKernelGGL(mega, dim3(grid), dim3(NTHR), LDS_BYTES, stream, a);
#else
    a.ph_lo = 0; a.ph_hi = 5; a.li = 0;
    hipLaunchKernelGGL(mega, dim3(grid), dim3(NTHR), LDS_BYTES, stream, a);
    {
        unsigned char* ws = (unsigned char*)d_ws;
#if !LRU_FAST
        float* sc = (float*)d_out;
        float* Ub = sc; float* A0 = Ub + (size_t)LT * DM; float* B0 = A0 + (size_t)LT * DM; float* A1 = B0 + (size_t)LT * DM; float* B1 = A1 + (size_t)LT * DM;
        float* YF = B1 + (size_t)LT * DM; float* YB = YF + (size_t)SEQ * DM;
        const float* cw = (const float*)d_in[IN_CONVW]; const float* cb = (const float*)d_in[IN_CONVB];
        const float* wa = (const float*)d_in[IN_WA]; const float* ba = (const float*)d_in[IN_BA]; const float* wx = (const float*)d_in[IN_WX]; const float* bx = (const float*)d_in[IN_BX]; const float* lam = (const float*)d_in[IN_LAM];
        for (int b = 0; b < NB; ++b) {
            k_conv_f<<<LT, 256, 0, stream>>>((const bf16*)(ws + WS_P), (const bf16*)(ws + WS_PC), cw, cb, Ub, b);
            k_gates<<<dim3(LT, 8), 128, 0, stream>>>(Ub, wa, ba, wx, bx, lam, A0, B0, 0);
            k_gates<<<dim3(LT, 8), 128, 0, stream>>>(Ub, wa, ba, wx, bx, lam, A1, B1, 1);
            k_lru_scan<<<8, 256, 0, stream>>>(A0, B0, A1, B1, YF, YB);
            k_yag_f<<<SEQ, 256, 0, stream>>>(YF, YB, (bf16*)(ws + WS_YAG), b);
        }
#endif
#if !HG_FAST
        k_hgrn_f<<<dim3(8, 2, NB), 128, 0, stream>>>(ws, (const float*)d_in[IN_HGLB]);
#endif
    }
    a.ph_lo = 5; a.ph_hi = 12; a.li = 1;
    hipLaunchKernelGGL(mega, dim3(grid), dim3(NTHR), LDS_BYTES, stream, a);
#endif
}
```

```cpp
#include <hip/hip_runtime.h>
#include <cstdio>
#include <cstdint>
#include <math.h>

#define LAS __attribute__((address_space(3)))
#define GAS __attribute__((address_space(1)))
typedef unsigned short bf16;
typedef short bf16x8 __attribute__((ext_vector_type(8)));
typedef float f32x4 __attribute__((ext_vector_type(4)));
typedef float f32x2 __attribute__((ext_vector_type(2)));
typedef unsigned u32x4 __attribute__((ext_vector_type(4)));
typedef unsigned u32x2 __attribute__((ext_vector_type(2)));

constexpr int DM = 1024, NB = 8, SEQ = 2048, CTX = 256, NTOK = NB * SEQ, NCTX = NB * CTX, INW = 9216, LT = CTX + SEQ;
constexpr int NEXP = 32, DEXP = 512, CAP = 16384;
constexpr float EPS = 1e-6f;
constexpr int NWAVES = 8, NTHR = 512;

constexpr size_t MiB = 1u << 20, KiB = 1024;
constexpr size_t WS_CTL = 0, CTL_BYTES = 64 * KiB;
constexpr size_t WS_MODP = 256 * KiB;
constexpr size_t WS_MOD = 2 * MiB;
constexpr size_t WS_LRUAGG = 2 * MiB + 512 * KiB;
constexpr size_t WS_LRUS0 = 4 * MiB + 512 * KiB;
constexpr size_t WS_WT = 4 * MiB + 768 * KiB;
constexpr size_t WS_LIST = 5 * MiB;
constexpr size_t WS_HGD = 7 * MiB;
constexpr size_t WS_WRT = 7 * MiB + 256 * KiB;
constexpr size_t WS_WIN = 8 * MiB;
constexpr size_t WS_WPA = 26 * MiB, WS_WPB = 28 * MiB, WS_WOUT = 30 * MiB;
constexpr size_t WS_WLRU = 32 * MiB;
constexpr size_t WS_P = 33 * MiB, GS = 32 * MiB;
constexpr size_t WS_PC = 321 * MiB, CGS = 4 * MiB;
constexpr size_t WS_END = 337 * MiB;
constexpr size_t WS_W1T = WS_P + 0 * GS, WS_W3T = WS_P + 2 * GS, WS_W2T = WS_P + 5 * GS;
constexpr size_t WS_YAG = WS_P + 1 * GS;
constexpr size_t WS_OF = WS_P + 3 * GS, WS_OB = WS_P + 4 * GS;
constexpr size_t WS_YBG = WS_P + 3 * GS;
constexpr size_t WS_M = WS_P + 4 * GS;
constexpr size_t WS_HX2 = WS_P + 1 * GS;
constexpr size_t WS_HH = WS_P + 3 * GS;
constexpr size_t WS_Y = WS_P + 6 * GS;

constexpr int CW_BAR = 1024;
constexpr int CW_CNT = 12288;
constexpr int CW_TILE = 14336;
constexpr int CW_LRUG = 15680;
constexpr int CW_PANEL = 15616;

constexpr int RING_BYTES = 131072, LDS_BYTES = 147456, LDSCTL_OFF = LDS_BYTES - 1024;

#define GAS __attribute__((address_space(1)))
#define LDS_WAIT() asm volatile("s_waitcnt lgkmcnt(0)" ::: "memory")
#define VM_WAIT() asm volatile("s_waitcnt vmcnt(0)" ::: "memory")

typedef __bf16 bf16x2_t __attribute__((ext_vector_type(2)));
__device__ __forceinline__ unsigned pk2(float lo, float hi) { const f32x2 v = {lo, hi}; return __builtin_bit_cast(unsigned, __builtin_convertvector(v, bf16x2_t)); }
__device__ __forceinline__ unsigned f2bf(float f) { return pk2(f, 0.f) & 0xffffu; }
__device__ __forceinline__ float bf2f(unsigned short b) { return __builtin_bit_cast(float, (unsigned)b << 16); }
__device__ __forceinline__ float bflo(unsigned w) { return __builtin_bit_cast(float, w << 16); }
__device__ __forceinline__ float bfhi(unsigned w) { return __builtin_bit_cast(float, w & 0xffff0000u); }
__device__ __forceinline__ float sigmoidf_(float x) { return __builtin_amdgcn_rcpf(1.f + __builtin_amdgcn_exp2f(x * -1.4426950408889634f)); }
__device__ __forceinline__ float siluf_(float x) { return x * __builtin_amdgcn_rcpf(1.f + __builtin_amdgcn_exp2f(x * -1.4426950408889634f)); }
__device__ __forceinline__ float gelu_tanh(float x) { const float e = __builtin_amdgcn_exp2f((x * 2.3022081985f) * __builtin_fmaf(x * x, 0.044715f, 1.f)); return __builtin_fmaf(-x, __builtin_amdgcn_rcpf(1.f + e), x); }
__device__ __forceinline__ float wave_sum(float v) {
#pragma unroll
    for (int o = 1; o < 64; o <<= 1) v += __shfl_xor(v, o);
    return v;
}

#define XB_TMO      128
#define XB_XCNT(j)  (256  + 64 * (j))
#define XB_XSUB(j)  (1280 + 64 * (j))
#define XB_XGEN(j)  (2304 + 64 * (j))
#define XB_TOP      3328
#define XB_TOPGEN   3392
#define XCD_BAR_WORDS 3456
#define XB_SPIN_CAP (1u << 20)
__device__ __forceinline__ unsigned xb_ld(unsigned* p)              { return __hip_atomic_load(p, __ATOMIC_RELAXED, __HIP_MEMORY_SCOPE_AGENT); }
__device__ __forceinline__ unsigned xb_add(unsigned* p, unsigned v) { return __hip_atomic_fetch_add(p, v, __ATOMIC_RELAXED, __HIP_MEMORY_SCOPE_AGENT); }
__device__ __forceinline__ unsigned xb_xcc_id() { return (unsigned)__builtin_amdgcn_s_getreg((3 << 11) | 20) & 0xFu; }
#define XB_SPIN(cond, bar) do { unsigned _sp = 0; while (cond) { __builtin_amdgcn_s_sleep(1); \
    if ((++_sp & 255u) == 0u) { if (xb_ld(&(bar)[XB_TMO])) break; if (_sp > XB_SPIN_CAP) { atomicAdd(&(bar)[XB_TMO], 1u); break; } } } } while (0)
struct XcdBarrier { unsigned* bar; unsigned x; volatile LAS unsigned* st; };
__device__ __forceinline__ XcdBarrier xcd_barrier_post(unsigned* bar, volatile LAS unsigned* st) {
    XcdBarrier b; b.bar = bar; b.x = xb_xcc_id(); b.st = st;
    if (threadIdx.x == 0) (void)xb_add(&bar[XB_XCNT(b.x)], 1u);
    return b;
}
__device__ __forceinline__ void xcd_barrier_complete(unsigned* bar, unsigned x, unsigned& nloc, unsigned& nx) {
    const unsigned G = gridDim.x * gridDim.y * gridDim.z;
    unsigned sum, cnt, mine, sp = 0u;
    for (;;) {
        sum = 0u; cnt = 0u; mine = 0u;
#pragma unroll
        for (unsigned j = 0; j < 16; ++j) { const unsigned c = xb_ld(&bar[XB_XCNT(j)]); sum += c; cnt += (c > 0u) ? 1u : 0u; mine = (j == x) ? c : mine; }
        if (sum == G) break;
        __builtin_amdgcn_s_sleep(1);
        if ((++sp & 255u) == 0u) { if (xb_ld(&bar[XB_TMO])) break; if (sp > XB_SPIN_CAP) { atomicAdd(&bar[XB_TMO], 1u); break; } }
    }
    nloc = mine > 0u ? mine : 1u; nx = cnt > 0u ? cnt : 1u;
}
__device__ __forceinline__ void xcd_barrier(const XcdBarrier& b) {
    asm volatile("s_waitcnt vmcnt(0)" ::: "memory");
    __syncthreads();
    if (threadIdx.x == 0) {
        unsigned* bar = b.bar;
        __builtin_amdgcn_s_waitcnt(0);
        unsigned nloc = b.st[0], nx = b.st[1];
        if (nloc == 0u) { xcd_barrier_complete(bar, b.x, nloc, nx); b.st[0] = nloc; b.st[1] = nx; }
        const unsigned old = xb_add(&bar[XB_XSUB(b.x)], 1u);
        const unsigned gen = old / nloc;
        if (old + 1u == (gen + 1u) * nloc) {
            __builtin_amdgcn_fence(__ATOMIC_RELEASE, "agent");
            asm volatile("s_waitcnt vmcnt(0)" ::: "memory");
            const unsigned og = xb_add(&bar[XB_TOP], 1u);
            const unsigned tg = og / nx;
            if (og + 1u == (tg + 1u) * nx) xb_add(&bar[XB_TOPGEN], 1u);
            else XB_SPIN(xb_ld(&bar[XB_TOPGEN]) == tg, bar);
            __builtin_amdgcn_fence(__ATOMIC_ACQUIRE, "agent");
            xb_add(&bar[XB_XGEN(b.x)], 1u);
            asm volatile("s_waitcnt vmcnt(0)" ::: "memory");
        } else {
            XB_SPIN(xb_ld(&bar[XB_XGEN(b.x)]) == gen, bar);
            __builtin_amdgcn_fence(__ATOMIC_ACQUIRE, "agent");
            asm volatile("s_waitcnt vmcnt(0)" ::: "memory");
        }
    }
    __syncthreads();
}

namespace gm {
constexpr int BM = 256, BK = 64, HALF = 128, HTB = HALF * BK * 2;
__device__ __forceinline__ int lds_byte(int r, int c) { const int st = (r >> 4) * 2 + (c >> 5), rr = r & 15, cc = c & 31, ob = rr * 64 + cc * 2; return st * 1024 + (ob ^ (((ob >> 9) & 1) << 5)); }
__device__ __forceinline__ void stage_rc(int b, int& R, int& C) { const int st = b / 1024, sb = b % 1024, swz = sb ^ (((sb >> 9) & 1) << 5); R = (st >> 1) * 16 + swz / 64; C = (st & 1) * 32 + (swz % 64) / 2; }
__device__ __forceinline__ int perm32(int rho) { const int n = rho >> 4, i = rho & 15; return 8 * (i >> 2) + 4 * n + (i & 3); }
__device__ __forceinline__ unsigned cvt_pk_bf16(float lo, float hi) { unsigned r; asm volatile("v_cvt_pk_bf16_f32 %0, %1, %2" : "=v"(r) : "v"(lo), "v"(hi)); return r; }

struct Unit { const char* A; const char* B0; const char* B1; char* dst; int pm, pn, e, rows, t; };

template <class Sched, class Epi, bool GATHER, bool HOOKS = false>
__device__ __forceinline__ void gemm_phase(LAS unsigned char* lds, const int K, const Sched& S, const Epi& E) {
    const int tid = threadIdx.x, wid = __builtin_amdgcn_readfirstlane(tid >> 6), lane = tid & 63, wr = wid >> 2, wc = wid & 3, fr = lane & 15, fq = lane >> 4;
    const int nt = K / BK;
    unsigned voffB[2]; int Rr[2]; unsigned Cb[2];
#pragma unroll
    for (int i = 0; i < 2; ++i) { int R, C; stage_rc(tid * 16 + i * 8192, R, C); const int Rb = Epi::PERM ? ((R & ~31) + perm32(R & 31)) : R;
        Rr[i] = R; Cb[i] = (unsigned)C * 2u; voffB[i] = (unsigned)(Rb * K + C) * 2u; }
    const unsigned rowb = (unsigned)K * 2u;
    const size_t kstep = (size_t)(BK * 2);
    const unsigned ldsw = (unsigned)wid * 1024u;
    const int aoff = lds_byte(wr * 64 + fr, fq * 8), boff = lds_byte(wc * 32 + fr, fq * 8);
#define GM_SA(b, h) (((b) * 2 + (h)) * HTB)
#define GM_SB(b, h) ((4 + (b) * 2 + (h)) * HTB)
#define GM_STAGE(bufoff, gbase, voff) do { _Pragma("unroll") for (int _i = 0; _i < 2; ++_i) \
        __builtin_amdgcn_global_load_lds((const unsigned*)((const char*)(gbase) + (voff)[_i]), (LAS unsigned*)(lds + (bufoff) + ldsw + _i * 8192), 16, 0, 0); } while (0)
#define GM_LDA(dst, b, h) do { _Pragma("unroll") for (int m = 0; m < 4; ++m) _Pragma("unroll") for (int k = 0; k < 2; ++k) dst[m][k] = *(const LAS bf16x8*)(lds + GM_SA(b, h) + aoff + m * 2048 + k * 1024); } while (0)
#define GM_LDB(dst, b, h) do { _Pragma("unroll") for (int n = 0; n < 2; ++n) _Pragma("unroll") for (int k = 0; k < 2; ++k) dst[n][k] = *(const LAS bf16x8*)(lds + GM_SB(b, h) + boff + n * 2048 + k * 1024); } while (0)
#define GM_MMA(ai, bj, At, Bt) do { __builtin_amdgcn_s_setprio(1); _Pragma("unroll") for (int m = 0; m < 4; ++m) _Pragma("unroll") for (int n = 0; n < 2; ++n) _Pragma("unroll") for (int k = 0; k < 2; ++k) \
        acc[ai][bj][m][n] = __builtin_amdgcn_mfma_f32_16x16x32_bf16(Bt[n][k], At[m][k], acc[ai][bj][m][n], 0, 0, 0); __builtin_amdgcn_s_setprio(0); } while (0)
#define GM_WAIT_V(n) asm volatile("s_waitcnt vmcnt(" #n ")" ::: "memory")
#define GM_WAIT_L(n) asm volatile("s_waitcnt lgkmcnt(" #n ")" ::: "memory")
#define GM_BAR __builtin_amdgcn_s_barrier()
#define GM_SCHED __builtin_amdgcn_sched_barrier(0)
#define GM_AOFFS(u, o) do { _Pragma("unroll") for (int _h = 0; _h < 2; ++_h) _Pragma("unroll") for (int _i = 0; _i < 2; ++_i) \
        (o)[_h][_i] = (GATHER ? S.arow((u), _h * HALF + Rr[_i]) : (unsigned)(_h * HALF + Rr[_i])) * rowb + Cb[_i]; } while (0)
    Unit cur, nxt; int ui = 0;
    if (!S.next(0, cur)) return;
    f32x4 acc[2][2][4][2];
#pragma unroll
    for (int a = 0; a < 2; ++a)
#pragma unroll
        for (int b = 0; b < 2; ++b)
#pragma unroll
            for (int m = 0; m < 4; ++m)
#pragma unroll
                for (int n = 0; n < 2; ++n) acc[a][b][m][n] = (f32x4){0.f, 0.f, 0.f, 0.f};
    bf16x8 At[4][2], B0[2][2], B1[2][2];
    unsigned ca[2][2], na[2][2];
    GM_AOFFS(cur, ca);
    const char* cA = cur.A; const char* cB0 = cur.B0; const char* cB1 = cur.B1;
    if constexpr (HOOKS) S.a_ready(cur);
    GM_STAGE(GM_SB(0, 0), cB0, voffB); GM_STAGE(GM_SB(0, 1), cB1, voffB); GM_STAGE(GM_SA(0, 0), cA, ca[0]); GM_STAGE(GM_SA(0, 1), cA, ca[1]);
    if (wr == 1) GM_BAR;
    GM_WAIT_V(2); GM_BAR;
    GM_STAGE(GM_SB(1, 0), cB0 + kstep, voffB); GM_STAGE(GM_SA(1, 0), cA + kstep, ca[0]); GM_STAGE(GM_SB(1, 1), cB1 + kstep, voffB);
    GM_WAIT_V(6); GM_BAR;
    for (;;) {
        const bool has_next = S.next(ui + 1, nxt);
        const char* nA = has_next ? nxt.A : cA; const char* nB0 = has_next ? nxt.B0 : cB0; const char* nB1 = has_next ? nxt.B1 : cB1;
        if (has_next) { GM_AOFFS(nxt, na); } else {
#pragma unroll
            for (int h = 0; h < 2; ++h)
#pragma unroll
                for (int i = 0; i < 2; ++i) na[h][i] = ca[h][i]; }
        for (int t = 0; t < nt; t += 2) {
            const bool last = (t == nt - 2);
            if constexpr (HOOKS) { if (last && has_next) S.a_ready(nxt); }
            const char* a1 = cA + (size_t)(t + 1) * kstep;
            const char* a2 = last ? nA : cA + (size_t)(t + 2) * kstep;
            const char* b20 = last ? nB0 : cB0 + (size_t)(t + 2) * kstep; const char* b21 = last ? nB1 : cB1 + (size_t)(t + 2) * kstep;
            const char* a3 = a2 + kstep; const char* b30 = b20 + kstep; const char* b31 = b21 + kstep;
            unsigned o2[2][2];
#pragma unroll
            for (int h = 0; h < 2; ++h)
#pragma unroll
                for (int i = 0; i < 2; ++i) o2[h][i] = last ? na[h][i] : ca[h][i];
            GM_LDB(B0, 0, 0); GM_LDB(B1, 0, 1); GM_SCHED; GM_LDA(At, 0, 0); GM_STAGE(GM_SA(1, 1), a1, ca[1]);
            GM_WAIT_V(8); GM_WAIT_L(0); GM_BAR; GM_MMA(0, 0, At, B0); GM_MMA(0, 1, At, B1); GM_BAR; GM_SCHED;
            GM_LDA(At, 0, 1); GM_STAGE(GM_SB(0, 0), b20, voffB); GM_STAGE(GM_SB(0, 1), b21, voffB); GM_STAGE(GM_SA(0, 0), a2, o2[0]);
            GM_WAIT_V(8); GM_WAIT_L(0); GM_BAR; GM_MMA(1, 0, At, B0); GM_MMA(1, 1, At, B1); GM_BAR; GM_SCHED;
            GM_LDB(B0, 1, 0); GM_LDB(B1, 1, 1); GM_SCHED; GM_LDA(At, 1, 0); GM_STAGE(GM_SA(0, 1), a2, o2[1]);
            GM_WAIT_V(8); GM_WAIT_L(0); GM_BAR; GM_MMA(0, 0, At, B0); GM_MMA(0, 1, At, B1); GM_BAR; GM_SCHED;
            GM_LDA(At, 1, 1); GM_STAGE(GM_SB(1, 0), b30, voffB); GM_STAGE(GM_SB(1, 1), b31, voffB); GM_STAGE(GM_SA(1, 0), a3, o2[0]);
            GM_WAIT_V(8); GM_WAIT_L(0); GM_BAR; GM_MMA(1, 0, At, B0); GM_MMA(1, 1, At, B1); GM_BAR; GM_SCHED;
        }
        if (wr == 0) GM_BAR;
        E(acc, cur, wr, wc, fr, fq);
        if constexpr (HOOKS) S.done(cur);
        if (!has_next) break;
#pragma unroll
        for (int a = 0; a < 2; ++a)
#pragma unroll
            for (int b = 0; b < 2; ++b)
#pragma unroll
                for (int m = 0; m < 4; ++m)
#pragma unroll
                    for (int n = 0; n < 2; ++n) acc[a][b][m][n] = (f32x4){0.f, 0.f, 0.f, 0.f};
        cur = nxt; cA = nA; cB0 = nB0; cB1 = nB1; ++ui;
#pragma unroll
        for (int h = 0; h < 2; ++h)
#pragma unroll
            for (int i = 0; i < 2; ++i) ca[h][i] = na[h][i];
        if (wr == 1) GM_BAR;
    }
    GM_WAIT_V(0);
    GM_BAR;
#undef GM_SA
#undef GM_SB
#undef GM_STAGE
#undef GM_LDA
#undef GM_LDB
#undef GM_MMA
#undef GM_WAIT_V
#undef GM_WAIT_L
#undef GM_BAR
#undef GM_SCHED
#undef GM_AOFFS
}
}
struct Args {
    const float* in[29]; float* out; unsigned char* ws; int ph_lo, ph_hi, li, pad;
};
struct Frame {
    LAS unsigned char* lds; volatile LAS unsigned* MISC;
    unsigned* ctl; unsigned char* ws; float* out;
    int tid, lane, wave, G, bid;
};
enum { IN_X = 0, IN_C, IN_CTX, IN_CCTX, IN_WMOD, IN_BMOD, IN_G1, IN_WIN, IN_CONVW, IN_CONVB, IN_WA, IN_BA, IN_WX, IN_BX, IN_LAM, IN_HGLB, IN_HGN,
       IN_WPA, IN_WPB, IN_WOUT, IN_G2, IN_WRG, IN_BRG, IN_WRE, IN_BRE, IN_W1, IN_W3, IN_W2, IN_FG };

constexpr int TR_BYTES = 64 * 64 * 4;
__device__ __forceinline__ void transpose_item(const float* W, int ldw, int K, bf16* WT, int k0, int n0, LAS float* scr, int lane) {
    const int lr = lane >> 4, ls = lane & 15;
    f32x4 v[16];
#pragma unroll
    for (int i = 0; i < 16; ++i) v[i] = *(const f32x4*)(W + (size_t)(k0 + 4 * i + lr) * ldw + n0 + 4 * ls);
#pragma unroll
    for (int i = 0; i < 16; ++i) { const int k = 4 * i + lr; *(LAS f32x4*)(scr + k * 64 + ((ls ^ ((k >> 3) & 7)) << 2)) = v[i]; }
    LDS_WAIT(); asm volatile("" ::: "memory");
    const int c = lane & 7;
#pragma unroll
    for (int j = 0; j < 8; ++j) { const int n = (lane >> 3) + 8 * j; const LAS float* s = scr + (8 * c) * 64 + ((((n >> 2) ^ c) << 2) | (n & 3));
        u32x4 o; o.x = pk2(s[0 * 64], s[1 * 64]); o.y = pk2(s[2 * 64], s[3 * 64]); o.z = pk2(s[4 * 64], s[5 * 64]); o.w = pk2(s[6 * 64], s[7 * 64]);
        *(u32x4*)(WT + (size_t)n * K + k0 + 8 * c) = o; }
    LDS_WAIT(); asm volatile("" ::: "memory");
}

__device__ __forceinline__ void p0_mod_item(Frame& F, const Args& a, int item) {
    const int cb = item % 24, ks = item / 24;
    LAS float* sv = (LAS float*)F.lds;
    LAS float* red = sv + 9 * 128;
    const float* c = a.in[IN_C]; const float* cc = a.in[IN_CCTX]; const float* wmod = a.in[IN_WMOD];
    for (int i = F.tid; i < 9 * 128; i += NTHR) { const int r = i >> 7, k = i & 127; const float v = r < 8 ? c[r * DM + ks * 128 + k] : cc[ks * 128 + k]; sv[i] = siluf_(v); }
    __syncthreads();
    const int col = cb * 256 + (F.tid & 255), kh = F.tid >> 8;
    float acc[9];
#pragma unroll
    for (int r = 0; r < 9; ++r) acc[r] = 0.f;
    for (int k0 = 0; k0 < 64; k0 += 16) { float wv[16];
#pragma unroll
        for (int k = 0; k < 16; ++k) wv[k] = wmod[(size_t)(ks * 128 + kh * 64 + k0 + k) * 6144 + col];
#pragma unroll
        for (int k = 0; k < 16; ++k) { const int kk = kh * 64 + k0 + k;
#pragma unroll
            for (int r = 0; r < 9; ++r) acc[r] += sv[r * 128 + kk] * wv[k]; } }
    if (kh == 1) {
#pragma unroll
        for (int r = 0; r < 9; ++r) red[r * 256 + (F.tid & 255)] = acc[r]; }
    __syncthreads();
    float* modp = (float*)(F.ws + WS_MODP);
    if (kh == 0) {
#pragma unroll
        for (int r = 0; r < 9; ++r) modp[(size_t)(ks * 9 + r) * 6144 + col] = acc[r] + red[r * 256 + F.tid]; }
    __syncthreads();
}
__device__ __forceinline__ float mod_from_partials(const float* modp, const float* bmod, int row, int j) {
    float s = bmod[j];
#pragma unroll
    for (int ks = 0; ks < 8; ++ks) s += modp[(size_t)(ks * 9 + row) * 6144 + j];
    return s;
}

__device__ __forceinline__ void p0_prologue(Frame& F, const Args& a) {
    if (F.bid < 192) p0_mod_item(F, a, F.bid);
    LAS float* scr = (LAS float*)(F.lds + F.wave * TR_BYTES);
    const int gw = F.bid * NWAVES + F.wave, NGW = F.G * NWAVES;
    constexpr int I_IN = 16 * 144, I_PR = 16 * 16, I_LRU = 32 * 4;
    constexpr int NITEMS = I_IN + 3 * I_PR + I_LRU;
    for (int it = gw; it < NITEMS; it += NGW) {
        int r = it;
        if (r < I_IN) { const int kb = r / 144, nb = r % 144; transpose_item(a.in[IN_WIN], INW, DM, (bf16*)(F.ws + WS_WIN) + (size_t)(nb * 64) * DM, kb * 64, nb * 64, scr, F.lane); continue; } r -= I_IN;
        if (r < 3 * I_PR) { const int w = r / I_PR, q = r % I_PR, kb = q / 16, nb = q % 16;
            const float* W = a.in[w == 0 ? IN_WPA : (w == 1 ? IN_WPB : IN_WOUT)]; bf16* WT = (bf16*)(F.ws + (w == 0 ? WS_WPA : (w == 1 ? WS_WPB : WS_WOUT)));
            transpose_item(W, DM, DM, WT + (size_t)(nb * 64) * DM, kb * 64, nb * 64, scr, F.lane); continue; } r -= 3 * I_PR;
        { const int mat = r / 4, q = r % 4, kb = q / 2, nb = q % 2;
          const int which = mat >> 4, dh = mat & 15;
          const float* W = a.in[which == 0 ? IN_WA : IN_WX] + (size_t)dh * 128 * 128; bf16* WT = (bf16*)(F.ws + WS_WLRU) + (size_t)mat * 128 * 128;
          transpose_item(W, 128, 128, WT + (size_t)(nb * 64) * 128, kb * 64, nb * 64, scr, F.lane); }
    }
    { u32x4* z = (u32x4*)(F.ws + WS_LRUAGG);
      for (int i = F.bid * NTHR + F.tid; i < (int)((2 * MiB + 128 * KiB) / 16); i += F.G * NTHR) z[i] = (u32x4){0u, 0u, 0u, 0u}; }
    float* wrp = (float*)(F.ws + WS_WRT);
    for (int i = F.bid * NTHR + F.tid; i < 49152 + 48; i += F.G * NTHR) {
        if (i < 49152) { const int j = i & 3, ln = (i >> 2) & 63, sc = i >> 8, c = sc % 3, s2 = sc / 3; const int k = 16 * s2 + 4 * (ln >> 4) + j, o = 16 * c + (ln & 15);
            wrp[i] = o < 4 ? a.in[IN_WRG][k * 4 + o] : (o < 36 ? a.in[IN_WRE][k * 32 + (o - 4)] : 0.f); }
        else { const int o = i - 49152; wrp[i] = o < 4 ? a.in[IN_BRG][o] : (o < 36 ? a.in[IN_BRE][o - 4] : 0.f); }
    }
}

__device__ __forceinline__ void norm_rows(Frame& F, const float* src, bf16* dst, int row0, int nrows, const LAS float* gs, const LAS float* sh) {
    for (int r = F.wave; r < nrows; r += 2 * NWAVES) {
        const int r1 = r + NWAVES < nrows ? r + NWAVES : r;
        const f32x4* xa = (const f32x4*)(src + (size_t)(row0 + r) * DM) + F.lane; const f32x4* xb = (const f32x4*)(src + (size_t)(row0 + r1) * DM) + F.lane;
        f32x4 va[4], vb[4]; float sa = 0.f, sb = 0.f;
#pragma unroll
        for (int j = 0; j < 4; ++j) { va[j] = xa[64 * j]; vb[j] = xb[64 * j]; }
#pragma unroll
        for (int j = 0; j < 4; ++j) { sa += (va[j].x * va[j].x + va[j].y * va[j].y) + (va[j].z * va[j].z + va[j].w * va[j].w); sb += (vb[j].x * vb[j].x + vb[j].y * vb[j].y) + (vb[j].z * vb[j].z + vb[j].w * vb[j].w); }
        const float ra = rsqrtf(wave_sum(sa) * (1.f / DM) + EPS), rb = rsqrtf(wave_sum(sb) * (1.f / DM) + EPS);
        unsigned long long* oa = (unsigned long long*)(dst + (size_t)(row0 + r) * DM) + F.lane; unsigned long long* ob = (unsigned long long*)(dst + (size_t)(row0 + r1) * DM) + F.lane;
#pragma unroll
        for (int j = 0; j < 4; ++j) { const int k = 4 * F.lane + 256 * j;
            const f32x4 g = *(const LAS f32x4*)(gs + k), h = *(const LAS f32x4*)(sh + k);
            oa[64 * j] = (unsigned long long)pk2(va[j].x * ra * g.x + h.x, va[j].y * ra * g.y + h.y) | ((unsigned long long)pk2(va[j].z * ra * g.z + h.z, va[j].w * ra * g.w + h.w) << 32);
            ob[64 * j] = (unsigned long long)pk2(vb[j].x * rb * g.x + h.x, vb[j].y * rb * g.y + h.y) | ((unsigned long long)pk2(vb[j].z * rb * g.z + h.z, vb[j].w * rb * g.w + h.w) << 32); }
    }
}
struct EpiStoreBf16 {
    static constexpr bool PERM = true;
    __device__ __forceinline__ void operator()(const f32x4 (&acc)[2][2][4][2], const gm::Unit& u, int wr, int wc, int fr, int fq) const {
        bf16* base = (bf16*)u.dst + (size_t)(wr * 64 + fr) * DM + wc * 32 + 8 * fq;
#pragma unroll
        for (int ai = 0; ai < 2; ++ai)
#pragma unroll
            for (int m = 0; m < 4; ++m) { bf16* rowp = base + (size_t)(ai * 128 + m * 16) * DM;
#pragma unroll
                for (int bj = 0; bj < 2; ++bj) { const f32x4 v0 = acc[ai][bj][m][0], v1 = acc[ai][bj][m][1];
                    u32x4 w; w.x = gm::cvt_pk_bf16(v0[0], v0[1]); w.y = gm::cvt_pk_bf16(v0[2], v0[3]); w.z = gm::cvt_pk_bf16(v1[0], v1[1]); w.w = gm::cvt_pk_bf16(v1[2], v1[3]);
                    *(u32x4*)(rowp + bj * 128) = w; } }
    }
};
__device__ __forceinline__ void tile_order(int L, int nM, int nN, int& pm, int& pn) {
    const int nwg = nM * nN; int wgid = L;
    { const int q = nwg / 8, r = nwg % 8, xcd = wgid % 8, off = wgid / 8; wgid = (xcd < r ? xcd * (q + 1) : r * (q + 1) + (xcd - r) * q) + off; }
    const int nig = 8 * nN, gid = wgid / nig, fm = gid * 8, gsz = (nM - fm) < 8 ? (nM - fm) : 8;
    pm = fm + ((wgid % nig) % gsz); pn = (wgid % nig) / gsz;
}
struct SchedP2 {
    int G, c; const char* H; const char* Wt; char* P; char* PC;
    __device__ __forceinline__ bool next(int i, gm::Unit& u) const {
        int L = i * G + c;
        if (L < 64 * 36) { int pm, pn; tile_order(L, 64, 36, pm, pn);
            u.A = H + (size_t)pm * 256 * 2048; u.B0 = Wt + (size_t)pn * 256 * 2048; u.B1 = u.B0 + (size_t)128 * 2048;
            u.dst = P + (size_t)(pn >> 2) * GS + ((size_t)pm * 256 * DM + (pn & 3) * 256) * 2; u.pm = pm; u.pn = pn; u.e = 0; u.rows = 256; return true; }
        return false;
    }
    __device__ __forceinline__ unsigned arow(const gm::Unit&, int r) const { return (unsigned)r; }
};
struct SchedCtx {
    int bid; const char* H; const char* Wt; char* PC; unsigned* cnt; unsigned* tmo;
    __device__ __forceinline__ bool next(int i, gm::Unit& u) const {
        if (i > 0) return false;
        const int pmc = bid >> 4, j = bid & 15, slot = j >> 2, g = slot == 0 ? 0 : slot + 2, pn = g * 4 + (j & 3);
        u.A = H + (size_t)(NTOK + pmc * 256) * 2048; u.B0 = Wt + (size_t)pn * 256 * 2048; u.B1 = u.B0 + (size_t)128 * 2048;
        u.dst = PC + (size_t)slot * CGS + ((size_t)pmc * 256 * DM + (j & 3) * 256) * 2; u.pm = pmc; u.pn = pn; u.e = 0; u.rows = 256; u.t = pmc; return true;
    }
    __device__ __forceinline__ unsigned arow(const gm::Unit&, int r) const { return (unsigned)r; }
    __device__ __forceinline__ void a_ready(const gm::Unit& u) const {
        if (threadIdx.x < 64) {
            unsigned spins = 0;
            while ((unsigned)__builtin_amdgcn_readfirstlane(__hip_atomic_load(cnt + 8 * u.t, __ATOMIC_RELAXED, __HIP_MEMORY_SCOPE_AGENT)) < 16u) {
                __builtin_amdgcn_s_sleep(2);
                if (++spins > (1u << 22)) { if (threadIdx.x == 0) __hip_atomic_store(tmo, 1u, __ATOMIC_RELAXED, __HIP_MEMORY_SCOPE_AGENT); break; } }
            __builtin_amdgcn_fence(__ATOMIC_ACQUIRE, "agent");
            asm volatile("s_waitcnt vmcnt(0)" ::: "memory");
        }
        asm volatile("" ::: "memory"); __builtin_amdgcn_s_barrier(); asm volatile("" ::: "memory");
    }
    __device__ __forceinline__ void done(const gm::Unit&) const {}
};
__device__ __forceinline__ void p1_norm(Frame& F, const Args& a) {
    const float* modp = (const float*)(F.ws + WS_MODP); const float* bmod = a.in[IN_BMOD]; const float* g1 = a.in[IN_G1];
    LAS float* gs = (LAS float*)F.lds; LAS float* sh = gs + DM;
    bf16* H = (bf16*)F.out;
    float* mod = (float*)(F.ws + WS_MOD);
    for (int i = F.bid * NTHR + F.tid; i < 9 * 6144; i += F.G * NTHR) mod[i] = mod_from_partials(modp, bmod, i / 6144, i % 6144);
    if (F.bid >= 128) {
        const int wg = F.bid - 128, b = wg >> 4;
        for (int k = F.tid; k < DM; k += NTHR) { gs[k] = g1[k] * (1.f + mod_from_partials(modp, bmod, b, DM + k)); sh[k] = mod_from_partials(modp, bmod, b, k); }
        __syncthreads();
        norm_rows(F, a.in[IN_X], H, wg * 128, 128, gs, sh);
        __syncthreads();
    } else {
        for (int k = F.tid; k < DM; k += NTHR) { gs[k] = g1[k] * (1.f + mod_from_partials(modp, bmod, 8, DM + k)); sh[k] = mod_from_partials(modp, bmod, 8, k); }
        __syncthreads();
        const int pmc = F.bid >> 4, r0 = pmc * 256 + (F.bid & 15) * 16;
        const __amdgpu_buffer_rsrc_t rs = __builtin_amdgcn_make_buffer_rsrc((void*)(H + (size_t)NTOK * DM), 0, 0x7fffffff, 0x00020000);
#pragma unroll
        for (int q = 0; q < 2; ++q) {
            const int row = r0 + 2 * F.wave + q;
            const f32x4* xr = (const f32x4*)(a.in[IN_CTX] + (size_t)row * DM) + 2 * F.lane;
            f32x4 v[2][2]; float sq = 0.f;
#pragma unroll
            for (int j = 0; j < 2; ++j) { v[j][0] = xr[128 * j]; v[j][1] = xr[128 * j + 1];
                sq += (v[j][0].x * v[j][0].x + v[j][0].y * v[j][0].y) + (v[j][0].z * v[j][0].z + v[j][0].w * v[j][0].w) + (v[j][1].x * v[j][1].x + v[j][1].y * v[j][1].y) + (v[j][1].z * v[j][1].z + v[j][1].w * v[j][1].w); }
            const float rstd = rsqrtf(wave_sum(sq) * (1.f / DM) + EPS);
#pragma unroll
            for (int j = 0; j < 2; ++j) { const int k = 8 * F.lane + 512 * j;
                const f32x4 ga = *(const LAS f32x4*)(gs + k), gb = *(const LAS f32x4*)(gs + k + 4), ha = *(const LAS f32x4*)(sh + k), hb = *(const LAS f32x4*)(sh + k + 4);
                u32x4 w; w.x = pk2(v[j][0].x * rstd * ga.x + ha.x, v[j][0].y * rstd * ga.y + ha.y); w.y = pk2(v[j][0].z * rstd * ga.z + ha.z, v[j][0].w * rstd * ga.w + ha.w);
                w.z = pk2(v[j][1].x * rstd * gb.x + hb.x, v[j][1].y * rstd * gb.y + hb.y); w.w = pk2(v[j][1].z * rstd * gb.z + hb.z, v[j][1].w * rstd * gb.w + hb.w);
                __builtin_amdgcn_raw_buffer_store_b128(w, rs, (unsigned)(((size_t)row * DM + k) * 2), 0, 16); }
        }
        asm volatile("s_waitcnt vmcnt(0)" ::: "memory");
        __syncthreads();
        unsigned* pcnt = F.ctl + CW_PANEL;
        if (F.tid == 0) __hip_atomic_fetch_add(pcnt + 8 * pmc, 1u, __ATOMIC_RELAXED, __HIP_MEMORY_SCOPE_AGENT);
        SchedCtx S{F.bid, (const char*)F.out, (const char*)(F.ws + WS_WIN), (char*)(F.ws + WS_PC), pcnt, F.ctl + 3};
        EpiStoreBf16 E;
        gm::gemm_phase<SchedCtx, EpiStoreBf16, false, true>(F.lds, DM, S, E);
    }
}

#ifdef PROBE_A
#define HSTAMP(i) do { if (F.bid == 0 && F.tid == 0) { const unsigned long long _t = __builtin_amdgcn_s_memrealtime(); const unsigned long long _p = ((unsigned long long)F.MISC[101] << 32) | F.MISC[100]; \
    unsigned long long _a = ((unsigned long long)F.MISC[103 + 2 * (i)] << 32) | F.MISC[102 + 2 * (i)]; _a += _t - _p; F.MISC[102 + 2 * (i)] = (unsigned)_a; F.MISC[103 + 2 * (i)] = (unsigned)(_a >> 32); F.MISC[100] = (unsigned)_t; F.MISC[101] = (unsigned)(_t >> 32); } } while (0)
#else
#define HSTAMP(i) do { } while (0)
#endif
constexpr int LRU_T = 128, LRU_NCH = SEQ / LRU_T, UF_LD = 144;
constexpr int LRU_UBF = 0, LRU_UF = 144 * 256;
constexpr float LOG2E = 1.4426950408889634f;

struct LruCoef { float ba, bx, ca; };

struct LruConvW { float w[4][8], bs[8]; };
__device__ __forceinline__ void lru_conv_weights(Frame& F, const Args& a, int h, LruConvW& cwv) {
    const float* cw = a.in[IN_CONVW] + h * 128; const float* cb = a.in[IN_CONVB] + h * 128; const int cg = F.tid & 15;
#pragma unroll
    for (int k = 0; k < 4; ++k) { const f32x4 w0 = *(const f32x4*)(cw + k * DM + 8 * cg), w1 = *(const f32x4*)(cw + k * DM + 8 * cg + 4);
        cwv.w[k][0] = w0.x; cwv.w[k][1] = w0.y; cwv.w[k][2] = w0.z; cwv.w[k][3] = w0.w; cwv.w[k][4] = w1.x; cwv.w[k][5] = w1.y; cwv.w[k][6] = w1.z; cwv.w[k][7] = w1.w; }
    { const f32x4 b0 = *(const f32x4*)(cb + 8 * cg), b1 = *(const f32x4*)(cb + 8 * cg + 4); cwv.bs[0] = b0.x; cwv.bs[1] = b0.y; cwv.bs[2] = b0.z; cwv.bs[3] = b0.w; cwv.bs[4] = b1.x; cwv.bs[5] = b1.y; cwv.bs[6] = b1.z; cwv.bs[7] = b1.w; }
}
__device__ __forceinline__ void lru_conv_load(Frame& F, int b, int h, int c, u32x4 (&raw)[4][4]) {
    const bf16* AX = (const bf16*)(F.ws + WS_P) + (size_t)b * SEQ * DM + h * 128;
    int cg = F.tid & 15, tl0 = F.tid >> 4;
    asm volatile("" : "+v"(cg), "+v"(tl0));
#pragma unroll
    for (int i = 0; i < 4; ++i)
#pragma unroll
        for (int k = 0; k < 4; ++k) { int tt = c * LRU_T + tl0 + 32 * i + k - 2; tt = tt < 0 ? 0 : (tt > SEQ - 1 ? SEQ - 1 : tt); raw[i][k] = *(const u32x4*)(AX + (size_t)tt * DM + 8 * cg); }
}
__device__ __forceinline__ void lru_conv(Frame& F, const LruConvW& cwv, const u32x4 (&raw)[4][4], int b, int h, int c, bool special) {
    LAS unsigned char* ubf = F.lds + LRU_UBF; LAS float* uf = (LAS float*)(F.lds + LRU_UF);
    int cg = F.tid & 15, tl0 = F.tid >> 4;
    asm volatile("" : "+v"(cg), "+v"(tl0));
    const float (&w)[4][8] = cwv.w; const float (&bs)[8] = cwv.bs;
#pragma unroll
    for (int i = 0; i < 4; ++i) { const int tl = tl0 + 32 * i;
        float u[8];
#pragma unroll
        for (int q = 0; q < 8; ++q) u[q] = bs[q];
#pragma unroll
        for (int k = 0; k < 4; ++k) { const int tt = c * LRU_T + tl + k - 2; const float mk = (tt >= 0 && tt < SEQ) ? 1.f : 0.f; const u32x4 v = raw[i][k];
            u[0] += mk * w[k][0] * bflo(v.x); u[1] += mk * w[k][1] * bfhi(v.x); u[2] += mk * w[k][2] * bflo(v.y); u[3] += mk * w[k][3] * bfhi(v.y);
            u[4] += mk * w[k][4] * bflo(v.z); u[5] += mk * w[k][5] * bfhi(v.z); u[6] += mk * w[k][6] * bflo(v.w); u[7] += mk * w[k][7] * bfhi(v.w); }
        *(LAS f32x4*)(uf + tl * UF_LD + 8 * cg) = (f32x4){u[0], u[1], u[2], u[3]};
        *(LAS f32x4*)(uf + tl * UF_LD + 8 * cg + 4) = (f32x4){u[4], u[5], u[6], u[7]};
        u32x4 p; p.x = pk2(u[0], u[1]); p.y = pk2(u[2], u[3]); p.z = pk2(u[4], u[5]); p.w = pk2(u[6], u[7]);
        *(LAS u32x4*)(ubf + tl * 256 + ((cg ^ (tl & 15)) << 4)) = p; }
    if (special) {
        const bf16* AC = (const bf16*)(F.ws + WS_PC) + (size_t)b * CTX * DM + h * 128;
        if (F.tid < 32) { const int tl = LRU_T + (F.tid >> 4); const int t = tl == LRU_T ? 0 : CTX - 1;
            float u[8];
#pragma unroll
            for (int q = 0; q < 8; ++q) u[q] = bs[q];
#pragma unroll
            for (int k = 0; k < 4; ++k) { const int tt = t + k - 2;
                if (tt >= 0 && tt < CTX) { const u32x4 v = *(const u32x4*)(AC + (size_t)tt * DM + 8 * cg);
                    u[0] += w[k][0] * bflo(v.x); u[1] += w[k][1] * bfhi(v.x); u[2] += w[k][2] * bflo(v.y); u[3] += w[k][3] * bfhi(v.y);
                    u[4] += w[k][4] * bflo(v.z); u[5] += w[k][5] * bfhi(v.z); u[6] += w[k][6] * bflo(v.w); u[7] += w[k][7] * bfhi(v.w); } }
            *(LAS f32x4*)(uf + tl * UF_LD + 8 * cg) = (f32x4){u[0], u[1], u[2], u[3]};
            *(LAS f32x4*)(uf + tl * UF_LD + 8 * cg + 4) = (f32x4){u[4], u[5], u[6], u[7]};
            u32x4 p; p.x = pk2(u[0], u[1]); p.y = pk2(u[2], u[3]); p.z = pk2(u[4], u[5]); p.w = pk2(u[6], u[7]);
            *(LAS u32x4*)(ubf + tl * 256 + ((cg ^ (tl & 15)) << 4)) = p;
        } else if (F.tid < 32 + 14 * 16) { const int tl = LRU_T + 2 + ((F.tid - 32) >> 4);
            *(LAS u32x4*)(ubf + tl * 256 + ((cg ^ (tl & 15)) << 4)) = (u32x4){0u, 0u, 0u, 0u}; }
    }
}
__device__ __forceinline__ void lru_load_w(Frame& F, int d, int h, bf16x8 (&Bw)[2][4]) {
    const int fr = F.lane & 15, fq = F.lane >> 4;
#pragma unroll
    for (int which = 0; which < 2; ++which) { const bf16* W = (const bf16*)(F.ws + WS_WLRU) + (size_t)(which * 16 + d * 8 + h) * 128 * 128 + (size_t)(16 * F.wave + fr) * 128 + 8 * fq;
#pragma unroll
        for (int kk = 0; kk < 4; ++kk) Bw[which][kk] = *(const bf16x8*)(W + kk * 32); }
}
__device__ __forceinline__ LruCoef lru_coef(const Args& a, int d, int ch) {
    LruCoef k; k.ba = -LOG2E * a.in[IN_BA][d * DM + ch]; k.bx = -LOG2E * a.in[IN_BX][d * DM + ch];
    const float sp = log1pf(expf(-a.in[IN_LAM][d * DM + ch])); k.ca = -8.f * sp * LOG2E; return k;
}
template <int V = 0> __device__ __forceinline__ void lru_tile(Frame& F, int m, const bf16x8 (&Bw)[2][4], const LruCoef& k, float (&av)[4], float (&bv)[4], int fr_ = -1, int fq_ = -1) {
    const int fr = fr_ < 0 ? (F.lane & 15) : fr_, fq = fq_ < 0 ? (F.lane >> 4) : fq_;
    const LAS unsigned char* ubf = F.lds + LRU_UBF; const LAS float* uf = (const LAS float*)(F.lds + LRU_UF);
    f32x4 ar = {0.f, 0.f, 0.f, 0.f}, ai = {0.f, 0.f, 0.f, 0.f};
    const int row = m * 16 + fr;
#pragma unroll
    for (int kk = 0; kk < 4; ++kk) { const bf16x8 A = *(const LAS bf16x8*)(ubf + row * 256 + (((kk * 4 + fq) ^ fr) << 4));
        ar = __builtin_amdgcn_mfma_f32_16x16x32_bf16(A, Bw[0][kk], ar, 0, 0, 0); ai = __builtin_amdgcn_mfma_f32_16x16x32_bf16(A, Bw[1][kk], ai, 0, 0, 0); }
#pragma unroll
    for (int r = 0; r < 4; ++r) { const float u = uf[(m * 16 + 4 * fq + r) * UF_LD + 16 * F.wave + fr];
        if (V == 2) { av[r] = __builtin_fmaf(ar[r], -LOG2E, k.ba) * k.ca; bv[r] = __builtin_fmaf(ai[r], -LOG2E, k.bx) * u; continue; }
        const float rg = __builtin_amdgcn_rcpf(1.f + __builtin_amdgcn_exp2f(__builtin_fmaf(ar[r], -LOG2E, k.ba)));
        const float ig = __builtin_amdgcn_rcpf(1.f + __builtin_amdgcn_exp2f(__builtin_fmaf(ai[r], -LOG2E, k.bx)));
        const float aa = __builtin_amdgcn_exp2f(k.ca * rg);
        av[r] = aa; bv[r] = __builtin_amdgcn_sqrtf(__builtin_fmaf(-aa, aa, 1.f)) * (ig * u); }
}
template <bool FWD, int V = 0> __device__ __forceinline__ void lru_tile_total(int fq, float& A, float& B) {
    if (V == 1) return;
#pragma unroll
    for (int s = 0; s < 2; ++s) { const int bit = 1 << s; const float Ap = __shfl_xor(A, 16 << s), Bp = __shfl_xor(B, 16 << s);
        const bool mine_first = FWD ? ((fq & bit) == 0) : ((fq & bit) != 0);
        if (mine_first) { B = B * Ap + Bp; A = A * Ap; } else { B = Bp * A + B; A = Ap * A; } }
}

template <int V = 0> __device__ __forceinline__ void lru_phase1(Frame& F, const Args& a, float* agg_base) {
    const int NU = NB * 8 * LRU_NCH;
    if (F.bid >= NU) return;
    const int fr = F.lane & 15, fq = F.lane >> 4;
    const int h = (F.bid >> 4) & 7; const int ch = h * 128 + 16 * F.wave + fr;
    const LruCoef k0 = lru_coef(a, 0, ch), k1 = lru_coef(a, 1, ch);
    for (int unit = F.bid; unit < NU; unit += F.G) {
        const int c = unit & (LRU_NCH - 1), b = unit >> 7;
        bf16x8 Bw0[2][4], Bw1[2][4]; lru_load_w(F, 0, h, Bw0); lru_load_w(F, 1, h, Bw1);
        { u32x4 raw[4][4]; lru_conv_load(F, b, h, c, raw); LruConvW cwv; lru_conv_weights(F, a, h, cwv); lru_conv(F, cwv, raw, b, h, c, c == 0 && V == 0); }
        LDS_WAIT(); __syncthreads();
        float Af = 1.f, Hf = 0.f, Ab = 1.f, Hb = 0.f;
#pragma unroll 2
        for (int m = 0; m < 8; ++m) {
            float av[4], bv[4];
            lru_tile<V>(F, m, Bw0, k0, av, bv);
            float A = av[0] * av[1] * av[2] * av[3], B = ((bv[0] * av[1] + bv[1]) * av[2] + bv[2]) * av[3] + bv[3];
            lru_tile_total<true, V>(fq, A, B);
            Hf = Hf * A + B; Af = Af * A;
            lru_tile<V>(F, m, Bw1, k1, av, bv);
            A = av[0] * av[1] * av[2] * av[3]; B = ((bv[3] * av[2] + bv[2]) * av[1] + bv[1]) * av[0] + bv[0];
            lru_tile_total<false, V>(fq, A, B);
            Hb = B * Ab + Hb; Ab = A * Ab;
        }
        float* agg = agg_base;
        if (fq == 0) { *(f32x2*)(agg + ((size_t)((b * LRU_NCH + c) * 2 + 0) * DM + ch) * 2) = (f32x2){Af, Hf};
                       *(f32x2*)(agg + ((size_t)((b * LRU_NCH + c) * 2 + 1) * DM + ch) * 2) = (f32x2){Ab, Hb}; }
        if (c == 0 && V == 0) {
            float av[4], bv[4]; float* s0 = (float*)(F.ws + WS_LRUS0);
            lru_tile(F, 8, Bw0, k0, av, bv); if (fq == 0) s0[(b * 2 + 0) * DM + ch] = bv[0];
            lru_tile(F, 8, Bw1, k1, av, bv); if (fq == 0) s0[(b * 2 + 1) * DM + ch] = bv[1];
        }
        __syncthreads();
    }
}

__device__ __forceinline__ void lru_pass2(Frame& F, const Args& a, int unit, const LruCoef& kf, const LruCoef& kb) {
    const int c = unit & (LRU_NCH - 1), h = (unit >> 4) & 7, b = unit >> 7;
    const int fr = F.lane & 15, fq = F.lane >> 4; const int ch = h * 128 + 16 * F.wave + fr;
    const float* agg = (const float*)(F.ws + WS_LRUAGG); const float* s0 = (const float*)(F.ws + WS_LRUS0);
    f32x2 ag[LRU_NCH];
#pragma unroll
    for (int j = 0; j < LRU_NCH; ++j) ag[j] = *(const f32x2*)(agg + ((size_t)((b * LRU_NCH + j) * 2 + (j < c ? 0 : 1)) * DM + ch) * 2);
    float hf = s0[(b * 2 + 0) * DM + ch], hb = s0[(b * 2 + 1) * DM + ch];
    bf16* AY = (bf16*)(F.ws + WS_YAG) + ((size_t)b * SEQ + c * LRU_T) * DM + h * 128;
    u32x4 ayv[4];
#pragma unroll
    for (int i = 0; i < 4; ++i) ayv[i] = *(const u32x4*)(AY + (size_t)((F.tid >> 4) + 32 * i) * DM + 8 * (F.tid & 15));
    bf16x8 Bw[2][4], Bw1[2][4]; lru_load_w(F, 0, h, Bw);
    LruCoef k = kf; const LruCoef k1 = kb;
    { u32x4 raw[4][4]; lru_conv_load(F, b, h, c, raw); LruConvW cwv; lru_conv_weights(F, a, h, cwv); lru_conv(F, cwv, raw, b, h, c, false); }
    lru_load_w(F, 1, h, Bw1);
#pragma unroll
    for (int j = 0; j < LRU_NCH; ++j) if (j < c) hf = ag[j].x * hf + ag[j].y;
#pragma unroll
    for (int j = LRU_NCH - 1; j >= 0; --j) if (j > c) hb = ag[j].x * hb + ag[j].y;
    LDS_WAIT(); __syncthreads();
    float hfv[8][4];
#pragma unroll
    for (int m = 0; m < 8; ++m) {
        float av[4], bv[4];
        lru_tile(F, m, Bw, k, av, bv);
        const float A = av[0] * av[1] * av[2] * av[3], B = ((bv[0] * av[1] + bv[1]) * av[2] + bv[2]) * av[3] + bv[3];
        float hin = hf;
#pragma unroll
        for (int g = 0; g < 4; ++g) { const float Ag = __shfl(A, g * 16 + fr), Bg = __shfl(B, g * 16 + fr); if (g < fq) hin = Ag * hin + Bg; hf = Ag * hf + Bg; }
#pragma unroll
        for (int r = 0; r < 4; ++r) { hin = av[r] * hin + bv[r]; hfv[m][r] = hin; }
    }
    k = k1;
    LAS float* uf = (LAS float*)(F.lds + LRU_UF);
#pragma unroll
    for (int m = 7; m >= 0; --m) {
        float av[4], bv[4];
        lru_tile(F, m, Bw1, k, av, bv);
        const float A = av[0] * av[1] * av[2] * av[3], B = ((bv[3] * av[2] + bv[2]) * av[1] + bv[1]) * av[0] + bv[0];
        float hin = hb;
#pragma unroll
        for (int g = 3; g >= 0; --g) { const float Ag = __shfl(A, g * 16 + fr), Bg = __shfl(B, g * 16 + fr); if (g > fq) hin = Ag * hin + Bg; hb = Ag * hb + Bg; }
#pragma unroll
        for (int r = 3; r >= 0; --r) { hin = av[r] * hin + bv[r]; uf[(m * 16 + 4 * fq + r) * UF_LD + 16 * F.wave + fr] = hfv[m][r] + hin; }
    }
    LDS_WAIT(); __syncthreads();
    const int cg = F.tid & 15;
#pragma unroll
    for (int i = 0; i < 4; ++i) { const int tl = (F.tid >> 4) + 32 * i;
        const f32x4 y0 = *(const LAS f32x4*)(uf + tl * UF_LD + 8 * cg), y1 = *(const LAS f32x4*)(uf + tl * UF_LD + 8 * cg + 4);
        const u32x4 g = ayv[i];
        u32x4 o; o.x = pk2(y0.x * gelu_tanh(bflo(g.x)), y0.y * gelu_tanh(bfhi(g.x))); o.y = pk2(y0.z * gelu_tanh(bflo(g.y)), y0.w * gelu_tanh(bfhi(g.y)));
        o.z = pk2(y1.x * gelu_tanh(bflo(g.z)), y1.y * gelu_tanh(bfhi(g.z))); o.w = pk2(y1.z * gelu_tanh(bflo(g.w)), y1.w * gelu_tanh(bfhi(g.w)));
        *(u32x4*)(AY + (size_t)tl * DM + 8 * cg) = o; }
    __syncthreads();
}

constexpr int LRU_PRIV = LRU_UF;
__device__ __forceinline__ void lru_conv_b(Frame& F, const LruConvW& cwv, const u32x4 (&raw)[4][4], int b, int h, int c, bool special) {
    LAS unsigned char* ubf = F.lds + LRU_UBF;
    int cg = F.tid & 15, tl0 = F.tid >> 4;
    asm volatile("" : "+v"(cg), "+v"(tl0));
    const float (&w)[4][8] = cwv.w; const float (&bs)[8] = cwv.bs;
#pragma unroll
    for (int i = 0; i < 4; ++i) { const int tl = tl0 + 32 * i;
        float u[8];
#pragma unroll
        for (int q = 0; q < 8; ++q) u[q] = bs[q];
#pragma unroll
        for (int k = 0; k < 4; ++k) { const int tt = c * LRU_T + tl + k - 2; const float mk = (tt >= 0 && tt < SEQ) ? 1.f : 0.f; const u32x4 v = raw[i][k];
            u[0] += mk * w[k][0] * bflo(v.x); u[1] += mk * w[k][1] * bfhi(v.x); u[2] += mk * w[k][2] * bflo(v.y); u[3] += mk * w[k][3] * bfhi(v.y);
            u[4] += mk * w[k][4] * bflo(v.z); u[5] += mk * w[k][5] * bfhi(v.z); u[6] += mk * w[k][6] * bflo(v.w); u[7] += mk * w[k][7] * bfhi(v.w); }
        u32x4 p; p.x = pk2(u[0], u[1]); p.y = pk2(u[2], u[3]); p.z = pk2(u[4], u[5]); p.w = pk2(u[6], u[7]);
        *(LAS u32x4*)(ubf + tl * 256 + ((cg ^ (tl & 15)) << 4)) = p; }
    if (special) {
        const bf16* AC = (const bf16*)(F.ws + WS_PC) + (size_t)b * CTX * DM + h * 128;
        if (F.tid < 32) { const int tl = LRU_T + (F.tid >> 4); const int t = tl == LRU_T ? 0 : CTX - 1;
            float u[8];
#pragma unroll
            for (int q = 0; q < 8; ++q) u[q] = bs[q];
#pragma unroll
            for (int k = 0; k < 4; ++k) { const int tt = t + k - 2;
                if (tt >= 0 && tt < CTX) { const u32x4 v = *(const u32x4*)(AC + (size_t)tt * DM + 8 * cg);
                    u[0] += w[k][0] * bflo(v.x); u[1] += w[k][1] * bfhi(v.x); u[2] += w[k][2] * bflo(v.y); u[3] += w[k][3] * bfhi(v.y);
                    u[4] += w[k][4] * bflo(v.z); u[5] += w[k][5] * bfhi(v.z); u[6] += w[k][6] * bflo(v.w); u[7] += w[k][7] * bfhi(v.w); } }
            u32x4 p; p.x = pk2(u[0], u[1]); p.y = pk2(u[2], u[3]); p.z = pk2(u[4], u[5]); p.w = pk2(u[6], u[7]);
            *(LAS u32x4*)(ubf + tl * 256 + ((cg ^ (tl & 15)) << 4)) = p;
        } else if (F.tid < 32 + 14 * 16) { const int tl = LRU_T + 2 + ((F.tid - 32) >> 4);
            *(LAS u32x4*)(ubf + tl * 256 + ((cg ^ (tl & 15)) << 4)) = (u32x4){0u, 0u, 0u, 0u}; }
    }
}
__device__ __forceinline__ void lru_tile_b(Frame& F, int m, const bf16x8 (&Bw)[2][4], const LruCoef& k, float (&av)[4], float (&bv)[4]) {
    const int fr = F.lane & 15, fq = F.lane >> 4;
    const LAS unsigned char* ubf = F.lds + LRU_UBF;
    f32x4 ar = {0.f, 0.f, 0.f, 0.f}, ai = {0.f, 0.f, 0.f, 0.f};
    const int row = m * 16 + fr;
#pragma unroll
    for (int kk = 0; kk < 4; ++kk) { const bf16x8 A = *(const LAS bf16x8*)(ubf + row * 256 + (((kk * 4 + fq) ^ fr) << 4));
        ar = __builtin_amdgcn_mfma_f32_16x16x32_bf16(A, Bw[0][kk], ar, 0, 0, 0); ai = __builtin_amdgcn_mfma_f32_16x16x32_bf16(A, Bw[1][kk], ai, 0, 0, 0); }
    const int n = 16 * F.wave + fr;
#pragma unroll
    for (int r = 0; r < 4; ++r) { const int tr = m * 16 + 4 * fq + r;
        const float u = bf2f(*(const LAS unsigned short*)(ubf + tr * 256 + (((n >> 3) ^ (tr & 15)) << 4) + (n & 7) * 2));
        const float rg = __builtin_amdgcn_rcpf(1.f + __builtin_amdgcn_exp2f(__builtin_fmaf(ar[r], -LOG2E, k.ba)));
        const float ig = __builtin_amdgcn_rcpf(1.f + __builtin_amdgcn_exp2f(__builtin_fmaf(ai[r], -LOG2E, k.bx)));
        const float aa = __builtin_amdgcn_exp2f(k.ca * rg);
        av[r] = aa; bv[r] = __builtin_amdgcn_sqrtf(__builtin_fmaf(-aa, aa, 1.f)) * (ig * u); }
}
__device__ __forceinline__ void lru_unit(Frame& F, const Args& a, int unit, const LruCoef& kf, const LruCoef& kb) {
    const int c = unit & (LRU_NCH - 1), h = (unit >> 4) & 7, b = unit >> 7, grp = unit >> 4;
    const int fr = F.lane & 15, fq = F.lane >> 4; const int ch = h * 128 + 16 * F.wave + fr;
    bf16* AY = (bf16*)(F.ws + WS_YAG) + ((size_t)b * SEQ + c * LRU_T) * DM + h * 128;
    bf16x8 Bw[2][4]; lru_load_w(F, 0, h, Bw);
    { u32x4 raw[4][4]; lru_conv_load(F, b, h, c, raw); LruConvW cwv; lru_conv_weights(F, a, h, cwv); lru_conv_b(F, cwv, raw, b, h, c, c == 0); }
    LAS unsigned char* priv = F.lds + LRU_PRIV + F.tid * 8;
    LDS_WAIT(); __syncthreads();
    float hf = 0.f, pf = 1.f, s0f = 0.f, s0b = 0.f;
#pragma unroll 2
    for (int m = 0; m < 8; ++m) {
        float av[4], bv[4];
        lru_tile_b(F, m, Bw, kf, av, bv);
        const float A = av[0] * av[1] * av[2] * av[3], B = ((bv[0] * av[1] + bv[1]) * av[2] + bv[2]) * av[3] + bv[3];
        float hin = hf, pin = pf;
#pragma unroll
        for (int g = 0; g < 4; ++g) { const float Ag = __shfl(A, g * 16 + fr), Bg = __shfl(B, g * 16 + fr); if (g < fq) { hin = Ag * hin + Bg; pin = Ag * pin; } hf = Ag * hf + Bg; pf = Ag * pf; }
        float pt[4], ht[4];
#pragma unroll
        for (int r = 0; r < 4; ++r) { hin = av[r] * hin + bv[r]; pin = av[r] * pin; ht[r] = hin; pt[r] = pin; }
        *(LAS u32x2*)(priv + m * 4096) = (u32x2){pk2(ht[0], ht[1]), pk2(ht[2], ht[3])};
        *(LAS u32x2*)(priv + 32768 + m * 4096) = (u32x2){pk2(pt[0], pt[1]), pk2(pt[2], pt[3])};
    }
    if (c == 0) { float av[4], bv[4]; lru_tile_b(F, 8, Bw, kf, av, bv); s0f = bv[0]; }
    lru_load_w(F, 1, h, Bw);
    float hb = 0.f, pbw = 1.f;
#pragma unroll 2
    for (int m = 7; m >= 0; --m) {
        float av[4], bv[4];
        lru_tile_b(F, m, Bw, kb, av, bv);
        const float A = av[0] * av[1] * av[2] * av[3], B = ((bv[3] * av[2] + bv[2]) * av[1] + bv[1]) * av[0] + bv[0];
        float hin = hb, pin = pbw;
#pragma unroll
        for (int g = 3; g >= 0; --g) { const float Ag = __shfl(A, g * 16 + fr), Bg = __shfl(B, g * 16 + fr); if (g > fq) { hin = Ag * hin + Bg; pin = Ag * pin; } hb = Ag * hb + Bg; pbw = Ag * pbw; }
        const u32x2 hfw = *(const LAS u32x2*)(priv + m * 4096);
        const float hfv[4] = {bflo(hfw.x), bfhi(hfw.x), bflo(hfw.y), bfhi(hfw.y)};
        float pt[4], ht[4];
#pragma unroll
        for (int r = 3; r >= 0; --r) { hin = av[r] * hin + bv[r]; pin = av[r] * pin; ht[r] = hin + hfv[r]; pt[r] = pin; }
        *(LAS u32x2*)(priv + m * 4096) = (u32x2){pk2(ht[0], ht[1]), pk2(ht[2], ht[3])};
        *(LAS u32x2*)(priv + 65536 + m * 4096) = (u32x2){pk2(pt[0], pt[1]), pk2(pt[2], pt[3])};
    }
    if (c == 0) { float av[4], bv[4]; lru_tile_b(F, 8, Bw, kb, av, bv); s0b = bv[1]; }
    unsigned long long* agg = (unsigned long long*)(F.ws + WS_LRUAGG); unsigned long long* s0 = (unsigned long long*)(F.ws + WS_LRUS0);
    if (fq == 0) {
        __hip_atomic_store(agg + (size_t)((b * LRU_NCH + c) * 2 + 0) * DM + ch, ((unsigned long long)__builtin_bit_cast(unsigned, hf) << 32) | __builtin_bit_cast(unsigned, pf + 1.f), __ATOMIC_RELAXED, __HIP_MEMORY_SCOPE_AGENT);
        __hip_atomic_store(agg + (size_t)((b * LRU_NCH + c) * 2 + 1) * DM + ch, ((unsigned long long)__builtin_bit_cast(unsigned, hb) << 32) | __builtin_bit_cast(unsigned, pbw + 1.f), __ATOMIC_RELAXED, __HIP_MEMORY_SCOPE_AGENT);
        if (c == 0) { __hip_atomic_store(s0 + (b * 2 + 0) * DM + ch, ((unsigned long long)__builtin_bit_cast(unsigned, s0f) << 32) | 0x3f800000u, __ATOMIC_RELAXED, __HIP_MEMORY_SCOPE_AGENT);
                      __hip_atomic_store(s0 + (b * 2 + 1) * DM + ch, ((unsigned long long)__builtin_bit_cast(unsigned, s0b) << 32) | 0x3f800000u, __ATOMIC_RELAXED, __HIP_MEMORY_SCOPE_AGENT); }
    }
    u32x4 gv[4];
#pragma unroll
    for (int i = 0; i < 4; ++i) { const u32x4 g = *(const u32x4*)(AY + (size_t)((F.tid >> 4) + 32 * i) * DM + 8 * (F.tid & 15));
        gv[i].x = pk2(gelu_tanh(bflo(g.x)), gelu_tanh(bfhi(g.x))); gv[i].y = pk2(gelu_tanh(bflo(g.y)), gelu_tanh(bfhi(g.y)));
        gv[i].z = pk2(gelu_tanh(bflo(g.z)), gelu_tanh(bfhi(g.z))); gv[i].w = pk2(gelu_tanh(bflo(g.w)), gelu_tanh(bfhi(g.w))); }
    float cf, cb;
    {
        unsigned long long ag[LRU_NCH], sf, sb; unsigned spins = 0;
        const unsigned long long* ab = agg + (size_t)(b * LRU_NCH * 2) * DM + ch;
        for (;;) {
            bool ok = true;
            sf = __hip_atomic_load(s0 + (b * 2 + 0) * DM + ch, __ATOMIC_RELAXED, __HIP_MEMORY_SCOPE_AGENT); sb = __hip_atomic_load(s0 + (b * 2 + 1) * DM + ch, __ATOMIC_RELAXED, __HIP_MEMORY_SCOPE_AGENT);
#pragma unroll
            for (int j = 0; j < LRU_NCH; ++j) ag[j] = j == c ? 1ull : __hip_atomic_load(ab + (size_t)(j * 2 + (j < c ? 0 : 1)) * DM, __ATOMIC_RELAXED, __HIP_MEMORY_SCOPE_AGENT);
            ok = ((unsigned)sf != 0u) && ((unsigned)sb != 0u);
#pragma unroll
            for (int j = 0; j < LRU_NCH; ++j) ok = ok && ((unsigned)ag[j] != 0u);
            if (__all(ok)) break;
            __builtin_amdgcn_s_sleep(1);
            if (++spins > (1u << 22)) { if (F.lane == 0) __hip_atomic_store(F.ctl + 3, 2u, __ATOMIC_RELAXED, __HIP_MEMORY_SCOPE_AGENT); break; }
        }
        cf = __builtin_bit_cast(float, (unsigned)(sf >> 32)); cb = __builtin_bit_cast(float, (unsigned)(sb >> 32));
#pragma unroll
        for (int j = 0; j < LRU_NCH; ++j) if (j < c) cf = (__builtin_bit_cast(float, (unsigned)ag[j]) - 1.f) * cf + __builtin_bit_cast(float, (unsigned)(ag[j] >> 32));
#pragma unroll
        for (int j = LRU_NCH - 1; j >= 0; --j) if (j > c) cb = (__builtin_bit_cast(float, (unsigned)ag[j]) - 1.f) * cb + __builtin_bit_cast(float, (unsigned)(ag[j] >> 32));
    }
    __syncthreads();
    { LAS unsigned char* ya = F.lds + LRU_UBF; const int n = 16 * F.wave + fr;
#pragma unroll 2
      for (int m = 0; m < 8; ++m) {
          const u32x2 hw = *(const LAS u32x2*)(priv + m * 4096), pfw = *(const LAS u32x2*)(priv + 32768 + m * 4096), pbw2 = *(const LAS u32x2*)(priv + 65536 + m * 4096);
          const float y0 = bflo(hw.x) + bflo(pfw.x) * cf + bflo(pbw2.x) * cb, y1 = bfhi(hw.x) + bfhi(pfw.x) * cf + bfhi(pbw2.x) * cb;
          const float y2 = bflo(hw.y) + bflo(pfw.y) * cf + bflo(pbw2.y) * cb, y3 = bfhi(hw.y) + bfhi(pfw.y) * cf + bfhi(pbw2.y) * cb;
          const unsigned w01 = pk2(y0, y1), w23 = pk2(y2, y3);
          const int t0 = m * 16 + 4 * fq;
          *(LAS unsigned short*)(ya + (t0 + 0) * 256 + (((n >> 3) ^ ((t0 + 0) & 15)) << 4) + (n & 7) * 2) = (unsigned short)w01;
          *(LAS unsigned short*)(ya + (t0 + 1) * 256 + (((n >> 3) ^ ((t0 + 1) & 15)) << 4) + (n & 7) * 2) = (unsigned short)(w01 >> 16);
          *(LAS unsigned short*)(ya + (t0 + 2) * 256 + (((n >> 3) ^ ((t0 + 2) & 15)) << 4) + (n & 7) * 2) = (unsigned short)w23;
          *(LAS unsigned short*)(ya + (t0 + 3) * 256 + (((n >> 3) ^ ((t0 + 3) & 15)) << 4) + (n & 7) * 2) = (unsigned short)(w23 >> 16); } }
    LDS_WAIT(); __syncthreads();
    const int cg = F.tid & 15;
#pragma unroll
    for (int i = 0; i < 4; ++i) { const int tl = (F.tid >> 4) + 32 * i;
        const u32x4 y = *(const LAS u32x4*)(F.lds + LRU_UBF + tl * 256 + ((cg ^ (tl & 15)) << 4));
        const u32x4 g = gv[i];
        u32x4 o; o.x = pk2(bflo(y.x) * bflo(g.x), bfhi(y.x) * bfhi(g.x)); o.y = pk2(bflo(y.y) * bflo(g.y), bfhi(y.y) * bfhi(g.y));
        o.z = pk2(bflo(y.z) * bflo(g.z), bfhi(y.z) * bfhi(g.z)); o.w = pk2(bflo(y.w) * bflo(g.w), bfhi(y.w) * bfhi(g.w));
        *(u32x4*)(AY + (size_t)tl * DM + 8 * cg) = o; }
    __syncthreads();
}
constexpr int HG_C = 64, HG_SEG = 512, HG_NSEG = 4;
constexpr int HG_QS = 0, HG_QM = 16384, HG_KM = 32768, HG_KDT = 49152, HG_VT = 65536, HG_ATT = 81920, HG_PART = 90112, HG_ETOT = 94208, HG_ROWS = 94720;
constexpr size_t HGS_IMG = 65536;

__device__ __forceinline__ int hg_row(int b, int dir, bool ctx, int sigma) {
    if (ctx) { const int t = dir ? (CTX - 1 - sigma) : sigma; return b * CTX + t; }
    const int p = dir ? (SEQ - 1 - sigma) : sigma; return b * SEQ + (p & 31) * 64 + (p >> 5);
}

struct HgRaw { unsigned f[8], v[8], q[8]; };
template <bool FULL>
__device__ __forceinline__ void hg_load(Frame& F, const bf16* Qb, const bf16* Fb, const bf16* Vb, int b, int dir, bool ctx, int sigma0, HgRaw& r) {
    const long step = (long)(ctx ? 1 : 64) * (dir ? -1 : 1) * DM;
    const size_t ro = (size_t)hg_row(b, dir, ctx, sigma0 + 8 * F.wave) * DM + 2 * F.lane;
    const bf16* fp = Fb + ro; const bf16* vp = Vb + ro; const bf16* qp = Qb + ro;
#pragma unroll
    for (int j = 0; j < 8; ++j) { r.f[j] = *(const unsigned*)(fp + j * step); r.v[j] = *(const unsigned*)(vp + j * step); if (FULL) r.q[j] = *(const unsigned*)(qp + j * step); }
}
template <bool FULL>
__device__ __forceinline__ void hg_prep(Frame& F, const HgRaw& raw, int b, int dir, bool ctx, int sigma0, float lb0, float lb1, float& gs0, float& gs1) {
    const int kp = F.lane, to = F.wave;
    const unsigned (&fw)[8] = raw.f; const unsigned (&qw)[8] = raw.q; const unsigned (&vw)[8] = raw.v;
    const f32x2 lbv = {lb0, lb1}, omlb = {1.f - lb0, 1.f - lb1};
    f32x2 cs[8], kk2[8]; f32x2 accv = {0.f, 0.f};
#pragma unroll
    for (int j = 0; j < 8; ++j) {
        const f32x2 x = (f32x2){bflo(fw[j]), bfhi(fw[j])} * (-LOG2E);
        const f32x2 d = (f32x2){__builtin_amdgcn_exp2f(x.x), __builtin_amdgcn_exp2f(x.y)} + 1.f;
        const f32x2 g = lbv + omlb * (f32x2){__builtin_amdgcn_rcpf(d.x), __builtin_amdgcn_rcpf(d.y)};
        kk2[j] = 1.f - g;
        accv += (f32x2){__builtin_amdgcn_logf(g.x), __builtin_amdgcn_logf(g.y)};
        cs[j] = accv; }
    const float a0 = accv.x, a1 = accv.y;
    LAS float* part = (LAS float*)(F.lds + HG_PART);
    *(LAS f32x2*)(part + to * 128 + 2 * kp) = (f32x2){a0, a1};
    if (FULL) HSTAMP(0);
    LDS_WAIT(); __syncthreads();
    if (FULL) HSTAMP(1);
    if (FULL && F.tid < HG_C) ((LAS int*)(F.lds + HG_ROWS))[F.tid] = hg_row(b, dir, ctx, sigma0 + F.tid);
    f32x2 offv = {0.f, 0.f}, totv = {0.f, 0.f};
#pragma unroll
    for (int o = 0; o < 8; ++o) { const f32x2 p = *(const LAS f32x2*)(part + o * 128 + 2 * kp);
        if (o < to) offv += p; totv += p; }
    gs0 += totv.x; gs1 += totv.y;
    if (to == 0) *(LAS f32x2*)((LAS float*)(F.lds + HG_ETOT) + 2 * kp) = (f32x2){__builtin_amdgcn_exp2f(totv.x), __builtin_amdgcn_exp2f(totv.y)};
    float kd0[8], kd1[8];
#pragma unroll
    for (int j = 0; j < 8; ++j) {
        const f32x2 G = offv + cs[j];
        const f32x2 E = {__builtin_amdgcn_exp2f(G.x), __builtin_amdgcn_exp2f(G.y)};
        const f32x2 kd = kk2[j] * (f32x2){__builtin_amdgcn_rcpf(E.x), __builtin_amdgcn_rcpf(E.y)};
        kd0[j] = kd.x; kd1[j] = kd.y;
        if (FULL) {
            const f32x2 q = {bflo(qw[j]), bfhi(qw[j])};
            const f32x2 xq = q * (-LOG2E);
            const f32x2 dq = (f32x2){__builtin_amdgcn_exp2f(xq.x), __builtin_amdgcn_exp2f(xq.y)} + 1.f;
            const f32x2 sv = q * (f32x2){__builtin_amdgcn_rcpf(dq.x), __builtin_amdgcn_rcpf(dq.y)} * E;
            const int c = 8 * to + j; const int off = c * 256 + ((4 * kp) ^ ((c & 15) << 4));
            *(LAS unsigned*)(F.lds + HG_QS + off) = pk2(sv.x, sv.y);
            *(LAS unsigned*)(F.lds + HG_KM + off) = pk2(kd.x, kd.y);
        }
    }
    { const int sw = ((to ^ (kp & 7)) << 4);
      u32x4 w0, w1; w0.x = pk2(kd0[0], kd0[1]); w0.y = pk2(kd0[2], kd0[3]); w0.z = pk2(kd0[4], kd0[5]); w0.w = pk2(kd0[6], kd0[7]);
      w1.x = pk2(kd1[0], kd1[1]); w1.y = pk2(kd1[2], kd1[3]); w1.z = pk2(kd1[4], kd1[5]); w1.w = pk2(kd1[6], kd1[7]);
      *(LAS u32x4*)(F.lds + HG_KDT + (2 * kp) * 128 + sw) = w0; *(LAS u32x4*)(F.lds + HG_KDT + (2 * kp + 1) * 128 + sw) = w1;
      u32x4 v0, v1;
      v0.x = (vw[0] & 0xffffu) | (vw[1] << 16); v0.y = (vw[2] & 0xffffu) | (vw[3] << 16); v0.z = (vw[4] & 0xffffu) | (vw[5] << 16); v0.w = (vw[6] & 0xffffu) | (vw[7] << 16);
      v1.x = (vw[0] >> 16) | (vw[1] & 0xffff0000u); v1.y = (vw[2] >> 16) | (vw[3] & 0xffff0000u); v1.z = (vw[4] >> 16) | (vw[5] & 0xffff0000u); v1.w = (vw[6] >> 16) | (vw[7] & 0xffff0000u);
      *(LAS u32x4*)(F.lds + HG_VT + (2 * kp) * 128 + sw) = v0; *(LAS u32x4*)(F.lds + HG_VT + (2 * kp + 1) * 128 + sw) = v1; }
    if (FULL) HSTAMP(2);
    LDS_WAIT(); __syncthreads();
    if (FULL) HSTAMP(3);
}
__device__ __forceinline__ void hg_state_update(Frame& F, f32x4 (&St)[8], const bf16x8 (&vt)[2]) {
    const int fr = F.lane & 15, fq = F.lane >> 4;
    const LAS float* etot = (const LAS float*)(F.lds + HG_ETOT);
#pragma unroll
    for (int kt = 0; kt < 8; ++kt) { const f32x4 e = *(const LAS f32x4*)(etot + 16 * kt + 4 * fq);
        const int rk = 16 * kt + fr;
#pragma unroll
        for (int ks = 0; ks < 2; ++ks) { const bf16x8 A = *(const LAS bf16x8*)(F.lds + HG_KDT + rk * 128 + (((4 * ks + fq) ^ ((rk >> 1) & 7)) << 4));
            St[kt] = __builtin_amdgcn_mfma_f32_16x16x32_bf16(A, vt[ks], St[kt], 0, 0, 0); }
        St[kt] = St[kt] * e; }
}
__device__ __forceinline__ void hg_load_vt(Frame& F, bf16x8 (&vt)[2]) {
    const int fr = F.lane & 15, fq = F.lane >> 4; const int rv = 16 * F.wave + fr;
#pragma unroll
    for (int ks = 0; ks < 2; ++ks) vt[ks] = *(const LAS bf16x8*)(F.lds + HG_VT + rv * 128 + (((4 * ks + fq) ^ ((rv >> 1) & 7)) << 4));
}
struct HgPtrs { const bf16* Q; const bf16* Fx; const bf16* V; const bf16* Fc; const bf16* Vc; bf16* O; };
__device__ __forceinline__ HgPtrs hg_ptrs(Frame& F, int h, int dir) {
    HgPtrs p; p.Q = (const bf16*)(F.ws + WS_P + 2 * GS) + h * 128; p.Fx = (const bf16*)(F.ws + WS_P + (dir ? 4 : 3) * GS) + h * 128; p.V = (const bf16*)(F.ws + WS_P + 5 * GS) + h * 128;
    p.Fc = (const bf16*)(F.ws + WS_PC + (dir ? 2 : 1) * CGS) + h * 128; p.Vc = (const bf16*)(F.ws + WS_PC + 3 * CGS) + h * 128; p.O = (bf16*)(F.ws + WS_P + (dir ? 4 : 3) * GS) + h * 128; return p;
}
__device__ __forceinline__ void hg_lb(const Args& a, int h, int kp, float& lb0, float& lb1) {
    const float* t = a.in[IN_HGLB] + h * 128 + 2 * kp; lb0 = 1.f / (1.f + expf(t[DM] - t[0])); lb1 = 1.f / (1.f + expf(t[DM + 1] - t[1]));
}
__device__ __forceinline__ float* hg_img(Frame& F, int b, int h, int dir, int slot) { return (float*)((unsigned char*)F.out + (size_t)((((b * 8 + h) * 2 + dir) * 4) + slot) * HGS_IMG); }

__device__ __forceinline__ void hg_pass1(Frame& F, const Args& a, int unit) {
    const int slot = unit & 3, dir = (unit >> 2) & 1, h = (unit >> 3) & 7, b = unit >> 6;
    const int fr = F.lane & 15, fq = F.lane >> 4;
    const HgPtrs P = hg_ptrs(F, h, dir);
    float lb0, lb1; hg_lb(a, h, F.lane, lb0, lb1);
    f32x4 St[8];
#pragma unroll
    for (int kt = 0; kt < 8; ++kt) St[kt] = (f32x4){0.f, 0.f, 0.f, 0.f};
    const bool ctx = slot == 0; const int nchunk = ctx ? CTX / HG_C : HG_SEG / HG_C; const int sig0 = ctx ? 0 : (slot - 1) * HG_SEG;
    float gs0 = 0.f, gs1 = 0.f;
    const bf16* Fsrc = ctx ? P.Fc : P.Fx; const bf16* Vsrc = ctx ? P.Vc : P.V;
    HgRaw cur; hg_load<false>(F, P.Q, Fsrc, Vsrc, b, dir, ctx, sig0, cur);
    for (int ck = 0; ck < nchunk; ++ck) {
        HgRaw nxt; { const int cn = ck + 1 < nchunk ? ck + 1 : ck; hg_load<false>(F, P.Q, Fsrc, Vsrc, b, dir, ctx, sig0 + cn * HG_C, nxt); }
        hg_prep<false>(F, cur, b, dir, ctx, sig0 + ck * HG_C, lb0, lb1, gs0, gs1);
        cur = nxt;
        bf16x8 vt[2]; hg_load_vt(F, vt);
        hg_state_update(F, St, vt);
    }
    float* img = hg_img(F, b, h, dir, slot) + (size_t)(16 * F.wave + fr) * 128 + 4 * fq;
#pragma unroll
    for (int kt = 0; kt < 8; ++kt) *(f32x4*)(img + 16 * kt) = St[kt];
    if (!ctx && F.wave == 0) { float* D = (float*)(F.ws + WS_HGD) + (size_t)((((b * 8 + h) * 2 + dir) * 3) + (slot - 1)) * 128 + 2 * F.lane;
        *(f32x2*)D = (f32x2){__builtin_amdgcn_exp2f(gs0), __builtin_amdgcn_exp2f(gs1)}; }
    __syncthreads();
}

constexpr int HG_HN = 95232;
__device__ __forceinline__ void hg_pass2(Frame& F, const Args& a, int unit) {
    const int seg = unit & 3, h = (unit >> 2) & 7, b = unit >> 5;
    const int fr = F.lane & 15, fq = F.lane >> 4, w = F.wave;
    float lb0, lb1; { int kp = F.lane; asm volatile("" : "+v"(kp)); hg_lb(a, h, kp, lb0, lb1); }
    const int lcol = h * 128 + 16 * w + 4 * fq;
#pragma unroll 1
    for (int dir = 0; dir < 2; ++dir) {
        HSTAMP(15);
        const int sseg = dir == 0 ? seg : 3 - seg;
        const HgPtrs P = hg_ptrs(F, h, dir);
        f32x4 St[8];
        {
            const float* img = hg_img(F, b, h, dir, 0) + (size_t)(16 * w + fr) * 128 + 4 * fq;
#pragma unroll
            for (int kt = 0; kt < 8; ++kt) St[kt] = *(const f32x4*)(img + 16 * kt);
            for (int j = 0; j < sseg; ++j) {
                const float* im = hg_img(F, b, h, dir, 1 + j) + (size_t)(16 * w + fr) * 128 + 4 * fq;
                const float* D = (const float*)(F.ws + WS_HGD) + (size_t)((((b * 8 + h) * 2 + dir) * 3) + j) * 128 + 4 * fq;
#pragma unroll
                for (int kt = 0; kt < 8; ++kt) { const f32x4 d = *(const f32x4*)(D + 16 * kt), dl = *(const f32x4*)(im + 16 * kt); St[kt] = St[kt] * d + dl; }
            }
        }
        float gs0 = 0.f, gs1 = 0.f;
        HSTAMP(9);
        for (int ck = 0; ck < HG_SEG / HG_C; ++ck) {
            { HgRaw cur; hg_load<true>(F, P.Q, P.Fx, P.V, b, dir, false, sseg * HG_SEG + ck * HG_C, cur);
              hg_prep<true>(F, cur, b, dir, false, sseg * HG_SEG + ck * HG_C, lb0, lb1, gs0, gs1); }
            const LAS int* rows = (const LAS int*)(F.lds + HG_ROWS);
            bf16* OFW = (bf16*)(F.ws + WS_OF) + lcol; asm volatile("" : "+v"(OFW));
            u32x2 ofw[4], ogv[4];
            if (dir == 1) {
                const bf16* OG = (const bf16*)(F.ws + WS_P + 6 * GS) + lcol; asm volatile("" : "+v"(OG));
#pragma unroll
                for (int ct = 0; ct < 4; ++ct) { const size_t ro = (size_t)rows[16 * ct + fr] * DM; ofw[ct] = *(const GAS u32x2*)(OFW + ro); ogv[ct] = *(const GAS u32x2*)(OG + ro); } }
#pragma unroll
            for (int tt = 0; tt < 2; ++tt) { const int t = w + 8 * tt, ct = t >> 2, st = t & 3;
                f32x4 acc = {0.f, 0.f, 0.f, 0.f};
                const int rs = 16 * st + fr, rc = 16 * ct + fr;
#pragma unroll
                for (int kk = 0; kk < 4; ++kk) { const bf16x8 A = *(const LAS bf16x8*)(F.lds + HG_KM + rs * 256 + (((4 * kk + fq) ^ fr) << 4));
                    const bf16x8 B = *(const LAS bf16x8*)(F.lds + HG_QS + rc * 256 + (((4 * kk + fq) ^ fr) << 4));
                    acc = __builtin_amdgcn_mfma_f32_16x16x32_bf16(A, B, acc, 0, 0, 0); }
                const int s0 = 16 * st + 4 * fq;
                const float m0 = (s0 + 0 <= rc) ? acc[0] : 0.f, m1 = (s0 + 1 <= rc) ? acc[1] : 0.f, m2 = (s0 + 2 <= rc) ? acc[2] : 0.f, m3 = (s0 + 3 <= rc) ? acc[3] : 0.f;
                *(LAS u32x2*)(F.lds + HG_ATT + rc * 128 + (((2 * st + (fq >> 1)) ^ ((rc >> 1) & 7)) << 4) + (fq & 1) * 8) = (u32x2){pk2(m0, m1), pk2(m2, m3)}; }
            f32x4 o[4];
#pragma unroll
            for (int ct = 0; ct < 4; ++ct) o[ct] = (f32x4){0.f, 0.f, 0.f, 0.f};
#pragma unroll
            for (int kk = 0; kk < 4; ++kk) {
                union { bf16x8 v; unsigned u[4]; } A;
                A.u[0] = pk2(St[2 * kk][0], St[2 * kk][1]); A.u[1] = pk2(St[2 * kk][2], St[2 * kk][3]); A.u[2] = pk2(St[2 * kk + 1][0], St[2 * kk + 1][1]); A.u[3] = pk2(St[2 * kk + 1][2], St[2 * kk + 1][3]);
#pragma unroll
                for (int ct = 0; ct < 4; ++ct) { const int rc = 16 * ct + fr;
                    union { bf16x8 v; u32x2 h[2]; } B;
                    B.h[0] = *(const LAS u32x2*)(F.lds + HG_QS + rc * 256 + (((4 * kk + (fq >> 1)) ^ fr) << 4) + (fq & 1) * 8);
                    B.h[1] = *(const LAS u32x2*)(F.lds + HG_QS + rc * 256 + (((4 * kk + 2 + (fq >> 1)) ^ fr) << 4) + (fq & 1) * 8);
                    o[ct] = __builtin_amdgcn_mfma_f32_16x16x32_bf16(A.v, B.v, o[ct], 0, 0, 0); } }
            bf16x8 vt[2]; hg_load_vt(F, vt);
            HSTAMP(4);
            LDS_WAIT(); __syncthreads();
            HSTAMP(5);
#pragma unroll
            for (int ks = 0; ks < 2; ++ks)
#pragma unroll
                for (int ct = 0; ct < 4; ++ct) { const int rc = 16 * ct + fr;
                    const bf16x8 B = *(const LAS bf16x8*)(F.lds + HG_ATT + rc * 128 + (((4 * ks + fq) ^ ((rc >> 1) & 7)) << 4));
                    o[ct] = __builtin_amdgcn_mfma_f32_16x16x32_bf16(vt[ks], B, o[ct], 0, 0, 0); }
            if (dir == 0) {
#pragma unroll
                for (int ct = 0; ct < 4; ++ct) *(GAS u32x2*)(OFW + (size_t)rows[16 * ct + fr] * DM) = (u32x2){pk2(o[ct][0], o[ct][1]), pk2(o[ct][2], o[ct][3])};
                hg_state_update(F, St, vt);
                HSTAMP(6);
            } else {
                LAS float* hn = (LAS float*)(F.lds + HG_HN);
                int hni = h * 128 + 16 * w + 4 * fq; asm volatile("" : "+v"(hni));
                const f32x4 hn4 = *(const f32x4*)(a.in[IN_HGN] + hni);
#pragma unroll
                for (int ct = 0; ct < 4; ++ct) { o[ct][0] += bflo(ofw[ct].x); o[ct][1] += bfhi(ofw[ct].x); o[ct][2] += bflo(ofw[ct].y); o[ct][3] += bfhi(ofw[ct].y);
                    float ss = (o[ct][0] * o[ct][0] + o[ct][1] * o[ct][1]) + (o[ct][2] * o[ct][2] + o[ct][3] * o[ct][3]);
                    ss += __shfl_xor(ss, 16); ss += __shfl_xor(ss, 32);
                    if (fq == 0) hn[(16 * ct + fr) * 8 + w] = ss; }
                hg_state_update(F, St, vt);
                HSTAMP(6);
                LDS_WAIT(); __syncthreads();
#pragma unroll
                for (int ct = 0; ct < 4; ++ct) { const f32x4 p0 = *(const LAS f32x4*)(hn + (16 * ct + fr) * 8), p1 = *(const LAS f32x4*)(hn + (16 * ct + fr) * 8 + 4);
                    const float rsn = rsqrtf(((p0.x + p0.y) + (p0.z + p0.w) + (p1.x + p1.y) + (p1.z + p1.w)) * (1.f / 128.f) + EPS);
                    const float g0 = bflo(ogv[ct].x), g1 = bfhi(ogv[ct].x), g2 = bflo(ogv[ct].y), g3 = bfhi(ogv[ct].y);
                    const float y0 = o[ct][0] * rsn * hn4.x * siluf_(g0), y1 = o[ct][1] * rsn * hn4.y * siluf_(g1), y2 = o[ct][2] * rsn * hn4.z * siluf_(g2), y3 = o[ct][3] * rsn * hn4.w * siluf_(g3);
                    *(GAS u32x2*)(OFW + (size_t)rows[16 * ct + fr] * DM) = (u32x2){pk2(y0, y1), pk2(y2, y3)}; }
                HSTAMP(7);
            }
        }
        VM_WAIT(); __syncthreads();
        HSTAMP(8);
    }
}
__device__ __forceinline__ void p_ybg(Frame& F, const Args& a) {
    const bf16* OFp = (const bf16*)(F.ws + WS_OF); const bf16* OBp = (const bf16*)(F.ws + WS_OB); const bf16* OG = (const bf16*)(F.ws + WS_P + 6 * GS);
    bf16* YBG = (bf16*)(F.ws + WS_YBG); const float* hgn = a.in[IN_HGN];
    const int gw = F.bid * NWAVES + F.wave, NGW = F.G * NWAVES;
    for (int row = gw; row < NTOK; row += 2 * NGW) {
        u32x4 fv[2][2], bv[2][2], gvv[2][2];
#pragma unroll
        for (int rr = 0; rr < 2; ++rr)
#pragma unroll
            for (int j = 0; j < 2; ++j) { const size_t o = (size_t)(row + rr * NGW) * DM + 8 * F.lane + 512 * j;
                fv[rr][j] = *(const u32x4*)(OFp + o); bv[rr][j] = *(const u32x4*)(OBp + o); gvv[rr][j] = *(const u32x4*)(OG + o); }
#pragma unroll
        for (int rr = 0; rr < 2; ++rr)
#pragma unroll
        for (int j = 0; j < 2; ++j) { const int k = 8 * F.lane + 512 * j; const size_t o = (size_t)(row + rr * NGW) * DM + k;
            const u32x4 f = fv[rr][j], b = bv[rr][j], g = gvv[rr][j];
            float v[8]; v[0] = bflo(f.x) + bflo(b.x); v[1] = bfhi(f.x) + bfhi(b.x); v[2] = bflo(f.y) + bflo(b.y); v[3] = bfhi(f.y) + bfhi(b.y);
            v[4] = bflo(f.z) + bflo(b.z); v[5] = bfhi(f.z) + bfhi(b.z); v[6] = bflo(f.w) + bflo(b.w); v[7] = bfhi(f.w) + bfhi(b.w);
            float ss = 0.f;
#pragma unroll
            for (int q = 0; q < 8; ++q) ss += v[q] * v[q];
            ss += __shfl_xor(ss, 1); ss += __shfl_xor(ss, 2); ss += __shfl_xor(ss, 4); ss += __shfl_xor(ss, 8);
            const float rs = rsqrtf(ss * (1.f / 128.f) + EPS);
            float gv[8]; gv[0] = bflo(g.x); gv[1] = bfhi(g.x); gv[2] = bflo(g.y); gv[3] = bfhi(g.y); gv[4] = bflo(g.z); gv[5] = bfhi(g.z); gv[6] = bflo(g.w); gv[7] = bfhi(g.w);
            const f32x4 h0 = *(const f32x4*)(hgn + k), h1 = *(const f32x4*)(hgn + k + 4);
            const float hv[8] = {h0.x, h0.y, h0.z, h0.w, h1.x, h1.y, h1.z, h1.w};
            float r[8];
#pragma unroll
            for (int q = 0; q < 8; ++q) r[q] = v[q] * rs * hv[q] * siluf_(gv[q]);
            u32x4 w; w.x = pk2(r[0], r[1]); w.y = pk2(r[2], r[3]); w.z = pk2(r[4], r[5]); w.w = pk2(r[6], r[7]);
            *(u32x4*)(YBG + o) = w; }
    }
}
__device__ __forceinline__ void p_moe_weights13(Frame& F, const Args& a) {
    LAS float* scr = (LAS float*)(F.lds + F.wave * TR_BYTES);
    const int gw = F.bid * NWAVES + F.wave, NGW = F.G * NWAVES;
    for (int it = gw; it < NEXP * 256; it += NGW) {
        const int e = it >> 8, r = it & 255, w = r >> 7, q = r & 127, kb = q >> 3, nb = q & 7;
        transpose_item(a.in[w == 0 ? IN_W1 : IN_W3] + (size_t)e * DM * DEXP, DEXP, DM, (bf16*)(F.ws + (w == 0 ? WS_W1T : WS_W3T)) + ((size_t)e * DEXP + nb * 64) * DM, kb * 64, nb * 64, scr, F.lane);
    }
}
__device__ __forceinline__ void p_moe_weights2(Frame& F, const Args& a, int rank, int nwg) {
    LAS float* scr = (LAS float*)(F.lds + F.wave * TR_BYTES);
    for (int it = rank * NWAVES + F.wave; it < NEXP * 128; it += nwg * NWAVES) {
        const int e = it >> 7, q = it & 127, kb = q >> 4, nb = q & 15;
        transpose_item(a.in[IN_W2] + (size_t)e * DEXP * DM, DM, DEXP, (bf16*)(F.ws + WS_W2T) + ((size_t)e * DM + nb * 64) * DEXP, kb * 64, nb * 64, scr, F.lane);
    }
}

struct SchedP5 {
    int c; const char* YAG; const char* YBG; const char* WA; const char* WB; char* stash; char* M; int i0, n;
    __device__ __forceinline__ bool next(int i, gm::Unit& u) const {
        if (i >= n) return false;
        i += i0;
        int pm, pn; tile_order(c, 64, 4, pm, pn);
        u.A = (i == 0 ? YAG : YBG) + (size_t)pm * 256 * 2048; u.B0 = (i == 0 ? WA : WB) + (size_t)pn * 256 * 2048; u.B1 = u.B0 + (size_t)128 * 2048;
        u.dst = M + ((size_t)pm * 256 * DM + pn * 256) * 2; u.pm = pm; u.pn = pn; u.e = i; u.rows = 256; return true;
    }
    __device__ __forceinline__ unsigned arow(const gm::Unit&, int r) const { return (unsigned)r; }
};
struct EpiP5 {
    static constexpr bool PERM = true;
    unsigned* stash; const bf16* GA; const bf16* GB;
    __device__ __forceinline__ void operator()(const f32x4 (&acc)[2][2][4][2], const gm::Unit& u, int wr, int wc, int fr, int fq) const {
        const bf16* G = (u.e == 0 ? GA : GB) + ((size_t)u.pm * 256 + wr * 64 + fr) * DM + u.pn * 256 + wc * 32 + 8 * fq;
        bf16* Mb = (bf16*)u.dst + (size_t)(wr * 64 + fr) * DM + wc * 32 + 8 * fq;
        u32x4* st = (u32x4*)stash + threadIdx.x;
        asm volatile("" : "+v"(G), "+v"(Mb), "+v"(st));
#pragma unroll
        for (int ai = 0; ai < 2; ++ai)
#pragma unroll
            for (int m = 0; m < 4; ++m) {
                u32x4 g[2], s[2];
#pragma unroll
                for (int bj = 0; bj < 2; ++bj) { const size_t ro = (size_t)(ai * 128 + m * 16) * DM + bj * 128; const int si = (ai * 4 + m) * 2 + bj;
                    g[bj] = *(const GAS u32x4*)(G + ro);
                    if (u.e != 0) s[bj] = *(const GAS u32x4*)(st + (size_t)si * NTHR); }
#pragma unroll
                for (int bj = 0; bj < 2; ++bj) { const size_t ro = (size_t)(ai * 128 + m * 16) * DM + bj * 128; const int si = (ai * 4 + m) * 2 + bj;
                    f32x4 v0 = acc[ai][bj][m][0], v1 = acc[ai][bj][m][1];
                    v0[0] *= sigmoidf_(bflo(g[bj].x)); v0[1] *= sigmoidf_(bfhi(g[bj].x)); v0[2] *= sigmoidf_(bflo(g[bj].y)); v0[3] *= sigmoidf_(bfhi(g[bj].y));
                    v1[0] *= sigmoidf_(bflo(g[bj].z)); v1[1] *= sigmoidf_(bfhi(g[bj].z)); v1[2] *= sigmoidf_(bflo(g[bj].w)); v1[3] *= sigmoidf_(bfhi(g[bj].w));
                    if (u.e != 0) { v0[0] += bflo(s[bj].x); v0[1] += bfhi(s[bj].x); v0[2] += bflo(s[bj].y); v0[3] += bfhi(s[bj].y);
                                    v1[0] += bflo(s[bj].z); v1[1] += bfhi(s[bj].z); v1[2] += bflo(s[bj].w); v1[3] += bfhi(s[bj].w); }
                    u32x4 w; w.x = gm::cvt_pk_bf16(v0[0], v0[1]); w.y = gm::cvt_pk_bf16(v0[2], v0[3]); w.z = gm::cvt_pk_bf16(v1[0], v1[1]); w.w = gm::cvt_pk_bf16(v1[2], v1[3]);
                    if (u.e == 0) *(GAS u32x4*)(st + (size_t)si * NTHR) = w; else *(GAS u32x4*)(Mb + ro) = w; }
                asm volatile("" ::: "memory"); }
    }
};

struct SchedP6 {
    int c; const char* M; const char* W; char* X1;
    __device__ __forceinline__ bool next(int i, gm::Unit& u) const {
        if (i >= 1) return false;
        int pm, pn; tile_order(c, 64, 4, pm, pn);
        u.A = M + (size_t)pm * 256 * 2048; u.B0 = W + (size_t)pn * 256 * 2048; u.B1 = u.B0 + (size_t)128 * 2048;
        u.dst = X1 + ((size_t)pm * 256 * DM + pn * 256) * 4; u.pm = pm; u.pn = pn; u.e = 0; u.rows = 256; return true;
    }
    __device__ __forceinline__ unsigned arow(const gm::Unit&, int r) const { return (unsigned)r; }
};
struct EpiP6 {
    static constexpr bool PERM = false;
    const float* x; const float* mod;
    __device__ __forceinline__ void operator()(const f32x4 (&acc)[2][2][4][2], const gm::Unit& u, int wr, int wc, int fr, int fq) const {
        const int b = u.pm >> 3; const int col0 = u.pn * 256 + wc * 32 + 4 * fq;
        const float* mg = mod + b * 6144 + 2 * DM + col0;
        f32x4 gv[2][2];
#pragma unroll
        for (int bj = 0; bj < 2; ++bj)
#pragma unroll
            for (int n = 0; n < 2; ++n) gv[bj][n] = *(const GAS f32x4*)(mg + bj * 128 + n * 16);
#pragma unroll
        for (int ai = 0; ai < 2; ++ai)
#pragma unroll
            for (int m = 0; m < 4; ++m) { const size_t ro = (size_t)(wr * 64 + fr + ai * 128 + m * 16) * DM + wc * 32 + 4 * fq;
                const float* xr = x + ((size_t)u.pm * 256 * DM + u.pn * 256) + ro; float* orow = (float*)u.dst + ro;
#pragma unroll
                for (int bj = 0; bj < 2; ++bj)
#pragma unroll
                    for (int n = 0; n < 2; ++n) { const f32x4 xv = *(const GAS f32x4*)(xr + bj * 128 + n * 16);
                        *(GAS f32x4*)(orow + bj * 128 + n * 16) = xv + gv[bj][n] * acc[ai][bj][m][n]; } }
    }
};

__device__ __forceinline__ void p_norm2_route(Frame& F, const Args& a) {
    const float* mod = (const float*)(F.ws + WS_MOD); const float* g2 = a.in[IN_G2]; const float* wrp = (const float*)(F.ws + WS_WRT);
    const float* X1 = F.out; bf16* HX2 = (bf16*)(F.ws + WS_HX2);
    int* list = (int*)(F.ws + WS_LIST); float* wt = (float*)(F.ws + WS_WT); unsigned* cnt = F.ctl + CW_CNT;
    LAS float* gs = (LAS float*)F.lds; LAS float* sh = gs + DM; LAS float* rst = sh + DM; LAS float* lgs = rst + 64;
    const int b = F.bid / 32;
    for (int k = F.tid; k < DM; k += NTHR) { gs[k] = g2[k] * (1.f + mod[b * 6144 + 4 * DM + k]); sh[k] = mod[b * 6144 + 3 * DM + k]; }
    __syncthreads();
    for (int r = F.wave; r < 64; r += NWAVES) {
        const int tok = F.bid * 64 + r;
        const f32x4* xr = (const f32x4*)(X1 + (size_t)tok * DM) + F.lane;
        f32x4 v[4]; float s = 0.f;
#pragma unroll
        for (int j = 0; j < 4; ++j) { v[j] = xr[64 * j]; s += (v[j].x * v[j].x + v[j].y * v[j].y) + (v[j].z * v[j].z + v[j].w * v[j].w); }
        const float rstd = rsqrtf(wave_sum(s) * (1.f / DM) + EPS);
        if (F.lane == 0) rst[r] = rstd;
        unsigned long long* o8 = (unsigned long long*)(HX2 + (size_t)tok * DM) + F.lane;
#pragma unroll
        for (int j = 0; j < 4; ++j) { const int k = 4 * F.lane + 256 * j;
            const f32x4 g = *(const LAS f32x4*)(gs + k), h = *(const LAS f32x4*)(sh + k);
            o8[64 * j] = (unsigned long long)pk2(v[j].x * rstd * g.x + h.x, v[j].y * rstd * g.y + h.y) | ((unsigned long long)pk2(v[j].z * rstd * g.z + h.z, v[j].w * rstd * g.w + h.w) << 32); }
    }
    LDS_WAIT(); __syncthreads();
    {
        const int tq = F.lane & 15, kq = F.lane >> 4, wg = F.wave & 3, kh = F.wave >> 2; const int tl = wg * 16 + tq;
        const float rs = rst[tl];
        const float* xr = X1 + (size_t)(F.bid * 64 + tl) * DM + 4 * kq + 512 * kh;
        const f32x4* wp = (const f32x4*)wrp + F.lane + (size_t)kh * 32 * 3 * 64;
        const LAS float* gsp = gs + 512 * kh + 4 * kq; const LAS float* shp = sh + 512 * kh + 4 * kq;
        f32x4 acc[3];
#pragma unroll
        for (int c = 0; c < 3; ++c) acc[c] = (f32x4){0.f, 0.f, 0.f, 0.f};
#pragma unroll 8
        for (int s = 0; s < 32; ++s) {
            const f32x4 x = *(const f32x4*)(xr + 16 * s); const f32x4 g = *(const LAS f32x4*)(gsp + 16 * s), h = *(const LAS f32x4*)(shp + 16 * s);
            const f32x4 hv = x * rs * g + h;
#pragma unroll
            for (int c = 0; c < 3; ++c) { const f32x4 w = wp[(s * 3 + c) * 64];
                acc[c] = __builtin_amdgcn_mfma_f32_16x16x4f32(hv[0], w[0], acc[c], 0, 0, 0); acc[c] = __builtin_amdgcn_mfma_f32_16x16x4f32(hv[1], w[1], acc[c], 0, 0, 0);
                acc[c] = __builtin_amdgcn_mfma_f32_16x16x4f32(hv[2], w[2], acc[c], 0, 0, 0); acc[c] = __builtin_amdgcn_mfma_f32_16x16x4f32(hv[3], w[3], acc[c], 0, 0, 0); }
        }
#pragma unroll
        for (int c = 0; c < 3; ++c)
#pragma unroll
            for (int r = 0; r < 4; ++r) lgs[kh * 64 * 48 + (wg * 16 + 4 * kq + r) * 48 + 16 * c + tq] = acc[c][r];
    }
    LDS_WAIT(); __syncthreads();
    LAS unsigned* lcnt = (LAS unsigned*)(lgs + 2 * 64 * 48); LAS unsigned* lbase = lcnt + 32;
    if (F.tid < 32) lcnt[F.tid] = 0u;
    LDS_WAIT(); __syncthreads();
    int ea = 0, eb = 0; unsigned ra = 0u, rb = 0u; int tok = 0; float w1 = 0.f, w2 = 0.f;
    const bool picker = F.wave < 4 && F.lane < 16;
    if (picker) {
        const LAS float* lp = lgs + (F.wave * 16 + F.lane) * 48; tok = F.bid * 64 + F.wave * 16 + F.lane;
        float lg[36];
#pragma unroll
        for (int q = 0; q < 9; ++q) { const f32x4 t4 = *(const LAS f32x4*)(lp + 4 * q) + *(const LAS f32x4*)(lp + 64 * 48 + 4 * q) + *(const f32x4*)(wrp + 49152 + 4 * q);
            lg[4 * q] = t4.x; lg[4 * q + 1] = t4.y; lg[4 * q + 2] = t4.z; lg[4 * q + 3] = t4.w; }
        float mx = lg[0]; int gi = 0;
#pragma unroll
        for (int g = 1; g < 4; ++g) if (lg[g] > mx) { mx = lg[g]; gi = g; }
        float z = 0.f;
#pragma unroll
        for (int g = 0; g < 4; ++g) z += __expf(lg[g] - mx);
        const float pg = 1.f / z;
        float el[8];
#pragma unroll
        for (int e = 0; e < 8; ++e) el[e] = gi == 0 ? lg[4 + e] : (gi == 1 ? lg[12 + e] : (gi == 2 ? lg[20 + e] : lg[28 + e]));
        int e1 = 0; float m1 = el[0];
#pragma unroll
        for (int e = 1; e < 8; ++e) if (el[e] > m1) { m1 = el[e]; e1 = e; }
        int e2 = 0; float m2 = -3.0e38f;
#pragma unroll
        for (int e = 0; e < 8; ++e) if (e != e1 && el[e] > m2) { m2 = el[e]; e2 = e; }
        const float rr = __expf(m2 - m1); w1 = pg / (1.f + rr); w2 = pg * rr / (1.f + rr);
        ea = gi * 8 + e1; eb = gi * 8 + e2;
        ra = __hip_atomic_fetch_add(lcnt + ea, 1u, __ATOMIC_RELAXED, __HIP_MEMORY_SCOPE_WORKGROUP);
        rb = __hip_atomic_fetch_add(lcnt + eb, 1u, __ATOMIC_RELAXED, __HIP_MEMORY_SCOPE_WORKGROUP);
    }
    LDS_WAIT(); __syncthreads();
    if (F.tid < 32) { const unsigned n = lcnt[F.tid]; lbase[F.tid] = n ? __hip_atomic_fetch_add(cnt + 64 * F.tid, n, __ATOMIC_RELAXED, __HIP_MEMORY_SCOPE_AGENT) : 0u; }
    LDS_WAIT(); __syncthreads();
    if (picker) {
        list[(size_t)ea * CAP + lbase[ea] + ra] = tok * 2; wt[tok * 2] = w1;
        list[(size_t)eb * CAP + lbase[eb] + rb] = tok * 2 + 1; wt[tok * 2 + 1] = w2;
    }
}

__device__ __forceinline__ void moe_table(Frame& F, const int* cntv) {
    if (F.wave == 0) { const int lane = F.lane; const int cnt = lane < NEXP ? cntv[64 * lane] : 0;
        const int t = (cnt + 255) >> 8; int ti = t, oi = cnt;
#pragma unroll
        for (int d = 1; d < 32; d <<= 1) { const int tu = __shfl_up(ti, d), ou = __shfl_up(oi, d); if ((lane & 31) >= d) { ti += tu; oi += ou; } }
        if (lane < NEXP) { F.MISC[128 + lane] = (unsigned)cnt; F.MISC[160 + lane] = (unsigned)(ti - t); F.MISC[192 + lane] = (unsigned)(oi - cnt); }
        if (lane == NEXP - 1) F.MISC[224] = (unsigned)ti; }
    LDS_WAIT(); __syncthreads();
}
__device__ __forceinline__ bool moe_find(volatile LAS unsigned* MISC, int lane, int T, int& e, int& rt, int& rows, int& off) {
    if (T >= (int)MISC[224]) return false;
    const int l = lane & 31; const int cnt = (int)MISC[128 + l], tpre = (int)MISC[160 + l];
    const unsigned long long mask = __ballot(lane < NEXP && cnt > 0 && T >= tpre);
    e = __builtin_amdgcn_readfirstlane(63 - __builtin_clzll(mask));
    rt = T - (int)MISC[160 + e]; const int c = (int)MISC[128 + e]; off = (int)MISC[192 + e];
    rows = c - rt * 256; if (rows > 256) rows = 256; return true;
}
struct SchedMoe1 {
    int G, c, lane; volatile LAS unsigned* MISC; const int* list; const char* HX2; const char* W1T; const char* W3T; char* HH; unsigned* tile_cnt;
    __device__ __forceinline__ bool next(int i, gm::Unit& u) const {
        const int vc = (c & 7) * (G >> 3) + (c >> 3);
        const int L = i * G + vc; int e, rt, rows, off; if (!moe_find(MISC, lane, L >> 2, e, rt, rows, off)) return false;
        const int pn = L & 3;
        e = __builtin_amdgcn_readfirstlane(e); rt = __builtin_amdgcn_readfirstlane(rt); rows = __builtin_amdgcn_readfirstlane(rows); off = __builtin_amdgcn_readfirstlane(off);
        u.A = HX2; u.B0 = W1T + ((size_t)e * DEXP + pn * 128) * 2048; u.B1 = W3T + ((size_t)e * DEXP + pn * 128) * 2048;
        u.dst = HH + ((size_t)(off + rt * 256) * DEXP + pn * 128) * 2; u.pm = rt; u.pn = pn; u.e = e; u.rows = rows; u.t = L >> 2; return true;
    }
    __device__ __forceinline__ unsigned arow(const gm::Unit& u, int r) const { const int rr = r < u.rows ? r : u.rows - 1; return (unsigned)(list[(size_t)u.e * CAP + u.pm * 256 + rr] >> 1); }
    __device__ __forceinline__ void a_ready(const gm::Unit&) const {}
    __device__ __forceinline__ void done(const gm::Unit& u) const {
        asm volatile("s_waitcnt vmcnt(0)" ::: "memory");
        __builtin_amdgcn_s_barrier(); asm volatile("" ::: "memory");
        if (threadIdx.x == 0) __hip_atomic_fetch_add(tile_cnt + 8 * u.t, 1u, __ATOMIC_RELAXED, __HIP_MEMORY_SCOPE_AGENT);
    }
};
struct EpiMoe1 {
    static constexpr bool PERM = true;
    char* HH;
    __device__ __forceinline__ void operator()(const f32x4 (&acc)[2][2][4][2], const gm::Unit& u, int wr, int wc, int fr, int fq) const {
        const __amdgpu_buffer_rsrc_t rs = __builtin_amdgcn_make_buffer_rsrc((void*)HH, 0, 0x7fffffff, 0x00020000);
        const unsigned base = (unsigned)(u.dst - HH) + (unsigned)(((wr * 64 + fr) * DEXP + wc * 32 + 8 * fq) * 2);
#pragma unroll
        for (int ai = 0; ai < 2; ++ai)
#pragma unroll
            for (int m = 0; m < 4; ++m) { const int r = ai * 128 + wr * 64 + m * 16 + fr; if (r >= u.rows) continue;
                const f32x4 u0 = acc[ai][0][m][0], u1 = acc[ai][0][m][1], v0 = acc[ai][1][m][0], v1 = acc[ai][1][m][1];
                u32x4 w; w.x = gm::cvt_pk_bf16(siluf_(u0[0]) * v0[0], siluf_(u0[1]) * v0[1]); w.y = gm::cvt_pk_bf16(siluf_(u0[2]) * v0[2], siluf_(u0[3]) * v0[3]);
                w.z = gm::cvt_pk_bf16(siluf_(u1[0]) * v1[0], siluf_(u1[1]) * v1[1]); w.w = gm::cvt_pk_bf16(siluf_(u1[2]) * v1[2], siluf_(u1[3]) * v1[3]);
                __builtin_amdgcn_raw_buffer_store_b128(w, rs, base + (unsigned)((ai * 128 + m * 16) * DEXP * 2), 0, 16); }
    }
};
struct SchedMoe2 {
    int G, c, lane; volatile LAS unsigned* MISC; const char* HH; const char* W2T; char* Y; unsigned* tile_cnt; unsigned* tmo;
    __device__ __forceinline__ bool next(int i, gm::Unit& u) const {
        const int vc = (c & 7) * (G >> 3) + (c >> 3);
        const int U = 4 * (int)MISC[224], q = U / G, r = U % G;
        const bool rebal = q >= 1 && r > 0 && 3 * r <= G;
        int L = i * G + (G - 1 - vc);
        if (rebal) {
            if (vc < r) { if (i >= q - 1) return false; }
            else if (vc < 2 * r) { if (i == q) L = (q - 1) * G + (G - 1 - (vc - r)); else if (i > q) return false; }
        }
        int e, rt, rows, off; if (!moe_find(MISC, lane, L >> 2, e, rt, rows, off)) return false;
        const int pn = L & 3;
        e = __builtin_amdgcn_readfirstlane(e); rt = __builtin_amdgcn_readfirstlane(rt); rows = __builtin_amdgcn_readfirstlane(rows); off = __builtin_amdgcn_readfirstlane(off);
        u.A = HH + (size_t)(off + rt * 256) * DEXP * 2; u.B0 = W2T + ((size_t)e * DM + pn * 256) * (DEXP * 2); u.B1 = u.B0 + (size_t)128 * (DEXP * 2);
        u.dst = Y + (size_t)pn * 256 * 2; u.pm = rt; u.pn = pn; u.e = e; u.rows = rows; u.t = L >> 2; return true;
    }
    __device__ __forceinline__ unsigned arow(const gm::Unit&, int r) const { return (unsigned)r; }
    __device__ __forceinline__ void a_ready(const gm::Unit& u) const {
        if (threadIdx.x < 64) {
            unsigned spins = 0;
            while ((unsigned)__builtin_amdgcn_readfirstlane(__hip_atomic_load(tile_cnt + 8 * u.t, __ATOMIC_RELAXED, __HIP_MEMORY_SCOPE_AGENT)) < 4u) {
                __builtin_amdgcn_s_sleep(2);
                if (++spins > (1u << 22)) { if (threadIdx.x == 0) __hip_atomic_store(tmo, 1u, __ATOMIC_RELAXED, __HIP_MEMORY_SCOPE_AGENT); break; } }
            __builtin_amdgcn_fence(__ATOMIC_ACQUIRE, "agent");
            asm volatile("s_waitcnt vmcnt(0)" ::: "memory");
        }
        asm volatile("" ::: "memory"); __builtin_amdgcn_s_barrier(); asm volatile("" ::: "memory");
    }
    __device__ __forceinline__ void done(const gm::Unit&) const {}
};
struct EpiMoe2 {
    static constexpr bool PERM = true;
    const int* list;
    __device__ __forceinline__ void operator()(const f32x4 (&acc)[2][2][4][2], const gm::Unit& u, int wr, int wc, int fr, int fq) const {
        const int* lp = list + (size_t)u.e * CAP + u.pm * 256;
#pragma unroll
        for (int ai = 0; ai < 2; ++ai)
#pragma unroll
            for (int m = 0; m < 4; ++m) { const int r = ai * 128 + wr * 64 + m * 16 + fr; if (r >= u.rows) continue;
                const int slot = lp[r]; bf16* rowp = (bf16*)u.dst + (size_t)slot * DM + wc * 32 + 8 * fq;
#pragma unroll
                for (int bj = 0; bj < 2; ++bj) { const f32x4 v0 = acc[ai][bj][m][0], v1 = acc[ai][bj][m][1];
                    u32x4 w; w.x = gm::cvt_pk_bf16(v0[0], v0[1]); w.y = gm::cvt_pk_bf16(v0[2], v0[3]); w.z = gm::cvt_pk_bf16(v1[0], v1[1]); w.w = gm::cvt_pk_bf16(v1[2], v1[3]);
                    *(u32x4*)(rowp + bj * 128) = w; } }
    }
};

__device__ __forceinline__ void p_final(Frame& F, const Args& a) {
    const float* mod = (const float*)(F.ws + WS_MOD); const float* fg = a.in[IN_FG]; const float* wt = (const float*)(F.ws + WS_WT);
    const bf16* Y = (const bf16*)(F.ws + WS_Y); float* X1 = F.out;
    for (int r = F.wave; r < 64; r += NWAVES) {
        const int tok = F.bid * 64 + r; const int b = tok >> 11;
        const float w0 = wt[tok * 2], w1 = wt[tok * 2 + 1];
        f32x4* xr = (f32x4*)(X1 + (size_t)tok * DM) + F.lane;
        const u32x2* y0 = (const u32x2*)(Y + (size_t)(tok * 2) * DM) + F.lane; const u32x2* y1 = (const u32x2*)(Y + (size_t)(tok * 2 + 1) * DM) + F.lane;
        f32x4 v[4]; float s = 0.f;
#pragma unroll
        for (int j = 0; j < 4; ++j) { const int k = 4 * F.lane + 256 * j;
            const f32x4 xv = xr[64 * j]; const u32x2 a0 = y0[64 * j], a1 = y1[64 * j]; const f32x4 g5 = *(const f32x4*)(mod + b * 6144 + 5 * DM + k);
            v[j].x = xv.x + g5.x * (w0 * bflo(a0.x) + w1 * bflo(a1.x)); v[j].y = xv.y + g5.y * (w0 * bfhi(a0.x) + w1 * bfhi(a1.x));
            v[j].z = xv.z + g5.z * (w0 * bflo(a0.y) + w1 * bflo(a1.y)); v[j].w = xv.w + g5.w * (w0 * bfhi(a0.y) + w1 * bfhi(a1.y));
            s += (v[j].x * v[j].x + v[j].y * v[j].y) + (v[j].z * v[j].z + v[j].w * v[j].w); }
        const float rstd = rsqrtf(wave_sum(s) * (1.f / DM) + EPS);
#pragma unroll
        for (int j = 0; j < 4; ++j) { const int k = 4 * F.lane + 256 * j; const f32x4 g = *(const f32x4*)(fg + k);
            xr[64 * j] = (f32x4){v[j].x * rstd * g.x, v[j].y * rstd * g.y, v[j].z * rstd * g.z, v[j].w * rstd * g.w}; }
    }
}
#ifndef LRU_FAST
#define LRU_FAST 1
#endif
#ifndef HG_FAST
#define HG_FAST 1
#endif
#define MIX_FAST (LRU_FAST && HG_FAST)
#ifdef PROBE_A
#define STAMP(k) do { if (F.bid == 0 && F.tid == 0) { const unsigned long long _t = __builtin_amdgcn_s_memrealtime(); F.MISC[32 + 2 * (k)] = (unsigned)_t; F.MISC[33 + 2 * (k)] = (unsigned)(_t >> 32); } } while (0)
#else
#define STAMP(k) do { } while (0)
#endif
__device__ __forceinline__ void p_mix1(Frame& F, const Args& a) {
#if LRU_FAST
    {
        const int h = (F.bid >> 4) & 7; int ch = h * 128 + 16 * F.wave + (F.lane & 15);
        const LruCoef kf = lru_coef(a, 0, ch), kb = lru_coef(a, 1, ch);
        for (int r = 0; r < 2; ++r) lru_unit(F, a, r * 256 + F.bid, kf, kb);
    }
#endif
    STAMP(14); STAMP(15);
#if HG_FAST
    { Frame Fh = F; { int t_ = threadIdx.x; asm volatile("" : "+v"(t_)); Fh.tid = t_; Fh.lane = t_ & 63; }
      for (int i = 0, u = F.bid; u < NB * 8 * 2 * 4; u += F.G, ++i) hg_pass1(Fh, a, (u & ~3) | ((u + 2 * i) & 3)); }
#endif
}
__device__ __forceinline__ void p_mix2(Frame& F, const Args& a) {
#if LRU_FAST
    {
        const int h = (F.bid >> 4) & 7; int ch = h * 128 + 16 * F.wave + (F.lane & 15);
        asm volatile("" : "+v"(ch));
        const LruCoef kf = lru_coef(a, 0, ch), kb = lru_coef(a, 1, ch);
        for (int r = 2; r < 4; ++r) lru_unit(F, a, r * 256 + F.bid, kf, kb);
    }
#endif
    STAMP(16); STAMP(17);
#if HG_FAST
    { Frame Fh = F; { int t_ = threadIdx.x; asm volatile("" : "+v"(t_)); Fh.tid = t_; Fh.lane = t_ & 63; }
      for (int u = F.bid; u < NB * 8 * 4; u += F.G) hg_pass2(Fh, a, u); }
#endif
}
__global__ void __launch_bounds__(NTHR, 2) mega(Args args) {
    extern __shared__ __attribute__((aligned(16))) unsigned char lds_raw[];
    Frame F;
    F.lds = (LAS unsigned char*)lds_raw; F.MISC = (volatile LAS unsigned*)(F.lds + LDSCTL_OFF);
    F.tid = threadIdx.x; F.lane = F.tid & 63; F.wave = __builtin_amdgcn_readfirstlane(F.tid >> 6);
    F.G = gridDim.x; F.bid = blockIdx.x; F.ws = args.ws; F.out = args.out; F.ctl = (unsigned*)(args.ws + WS_CTL);
    for (int u = F.tid; u < (LDS_BYTES - LDSCTL_OFF) / 4; u += NTHR) ((LAS unsigned*)(F.lds + LDSCTL_OFF))[u] = 0u;
    __syncthreads();
    XcdBarrier bar = xcd_barrier_post(F.ctl + CW_BAR + args.li * 3584, F.MISC + 8);
    const int lo = args.ph_lo, hi = args.ph_hi;
#define IN(k) (lo <= (k) && (k) < hi)
#define SEAM(k) do { if (IN(k) && IN((k) + 1)) xcd_barrier(bar); STAMP((k) + 1); if ((k) == 9) STAMP(11); } while (0)
    unsigned char* ws = F.ws;
#define REFRESH() do { int _t = threadIdx.x; asm volatile("" : "+v"(_t)); F.tid = _t; F.lane = _t & 63; } while (0)
    STAMP(0);
    if (IN(0)) { p0_prologue(F, args); } SEAM(0);
    REFRESH();
    if (IN(1)) { p1_norm(F, args); } SEAM(1);
    REFRESH();
    if (IN(2)) {
        SchedP2 S{F.G, F.bid, (const char*)F.out, (const char*)(ws + WS_WIN), (char*)(ws + WS_P), (char*)(ws + WS_PC)};
        EpiStoreBf16 E;
        gm::gemm_phase<SchedP2, EpiStoreBf16, false>(F.lds, DM, S, E);
    } SEAM(2);
    REFRESH();
    if (IN(3)) { p_mix1(F, args); } SEAM(3);
    REFRESH();
    if (IN(4)) { p_mix2(F, args); } SEAM(4); STAMP(6);
    REFRESH();
    if (IN(6)) {
        const int slot = (F.bid >> 3) % 3;
        EpiP5 E{(unsigned*)F.out + (size_t)F.bid * 32768, (const bf16*)(ws + WS_P + 7 * GS), (const bf16*)(ws + WS_P + 8 * GS)};
        if (slot == 0) { p_moe_weights13(F, args); p_moe_weights2(F, args, F.bid, F.G); __syncthreads(); }
        {
            SchedP5 S{F.bid, (const char*)(ws + WS_YAG), (const char*)(ws + WS_YBG), (const char*)(ws + WS_WPA), (const char*)(ws + WS_WPB), nullptr, (char*)(ws + WS_M), 0, slot == 1 ? 1 : 2};
            gm::gemm_phase<SchedP5, EpiP5, false>(F.lds, DM, S, E);
        }
        if (slot == 1) {
            __syncthreads(); p_moe_weights13(F, args); p_moe_weights2(F, args, F.bid, F.G); __syncthreads();
            SchedP5 S{F.bid, (const char*)(ws + WS_YAG), (const char*)(ws + WS_YBG), (const char*)(ws + WS_WPA), (const char*)(ws + WS_WPB), nullptr, (char*)(ws + WS_M), 1, 1};
            gm::gemm_phase<SchedP5, EpiP5, false>(F.lds, DM, S, E);
        }
        if (slot == 2) { __syncthreads(); p_moe_weights13(F, args); p_moe_weights2(F, args, F.bid, F.G); }
    } SEAM(6);
    if (IN(7)) {
        SchedP6 S{F.bid, (const char*)(ws + WS_M), (const char*)(ws + WS_WOUT), (char*)F.out};
        EpiP6 E{args.in[IN_X], (const float*)(ws + WS_MOD)};
        gm::gemm_phase<SchedP6, EpiP6, false>(F.lds, DM, S, E);
    } SEAM(7);
    REFRESH();
    if (IN(8)) { p_norm2_route(F, args); } SEAM(8);
    REFRESH();
    if (IN(9)) {
        moe_table(F, (const int*)(F.ctl + CW_CNT));
        {
            SchedMoe1 S{F.G, F.bid, F.lane, F.MISC, (const int*)(ws + WS_LIST), (const char*)(ws + WS_HX2), (const char*)(ws + WS_W1T), (const char*)(ws + WS_W3T), (char*)(ws + WS_HH), F.ctl + CW_TILE};
            EpiMoe1 E{(char*)(ws + WS_HH)};
            gm::gemm_phase<SchedMoe1, EpiMoe1, true, true>(F.lds, DM, S, E);
        }
        {
            SchedMoe2 S{F.G, F.bid, F.lane, F.MISC, (const char*)(ws + WS_HH), (const char*)(ws + WS_W2T), (char*)(ws + WS_Y), F.ctl + CW_TILE, F.ctl + 2};
            EpiMoe2 E{(const int*)(ws + WS_LIST)};
            gm::gemm_phase<SchedMoe2, EpiMoe2, false, true>(F.lds, DEXP, S, E);
        }
    } SEAM(9);
    REFRESH();
    if (IN(11)) { p_final(F, args); }
#ifdef PROBE_A
    if (F.bid == 0 && F.tid == 0) {
        const unsigned long long tend = __builtin_amdgcn_s_memrealtime();
        F.MISC[32 + 2 * 12] = (unsigned)tend; F.MISC[33 + 2 * 12] = (unsigned)(tend >> 32);
        auto RD = [&](int k) { return ((unsigned long long)F.MISC[33 + 2 * k] << 32) | F.MISC[32 + 2 * k]; };
        auto T = [&](int k) { if (k >= 20) { const int i = k - 20; return ((unsigned long long)F.MISC[103 + 2 * i] << 32) | F.MISC[102 + 2 * i]; } if (k == 13) return RD(14) - RD(3); if (k == 15) return RD(16) - RD(4); return RD(k + 1) - RD(k); };
        const unsigned long long delay = T(PROBE_B) * 256ull;
        while (__builtin_amdgcn_s_memrealtime() - tend < delay) __builtin_amdgcn_s_sleep(32);
    }
#endif
#undef IN
#undef SEAM
}

#if !LRU_FAST
__global__ void k_conv_f(const bf16* P0, const bf16* PC0, const float* cw, const float* cb, float* Ub, int b) {
    int t = blockIdx.x; int Lseg = t < CTX ? CTX : SEQ; int lt = t < CTX ? t : t - CTX;
    const bf16* base = t < CTX ? PC0 + (size_t)b * CTX * DM : P0 + (size_t)b * SEQ * DM;
    for (int ch = threadIdx.x; ch < DM; ch += 256) {
        float s = cb[ch];
#pragma unroll
        for (int k = 0; k < 4; ++k) { int tt = lt + k - 2; if (tt >= 0 && tt < Lseg) s += cw[k * DM + ch] * bf2f(base[(size_t)tt * DM + ch]); }
        Ub[(size_t)t * DM + ch] = s;
    }
}
__global__ void k_gates(const float* Ub, const float* wa, const float* ba, const float* wx, const float* bx, const float* lam, float* Aout, float* Bout, int d) {
    __shared__ float us[128];
    int t = blockIdx.x, h = blockIdx.y, j = threadIdx.x; int ch = h * 128 + j;
    float uval = Ub[(size_t)t * DM + ch];
    us[j] = uval; __syncthreads();
    const float* wah = wa + ((size_t)(d * 8 + h) * 128) * 128; const float* wxh = wx + ((size_t)(d * 8 + h) * 128) * 128;
    float ra = 0.f, ia = 0.f;
    for (int i = 0; i < 128; ++i) { float u = us[i]; ra += u * wah[i * 128 + j]; ia += u * wxh[i * 128 + j]; }
    float r = 1.f / (1.f + expf(-(ra + ba[d * DM + ch]))); float ig = 1.f / (1.f + expf(-(ia + bx[d * DM + ch])));
    float sp = log1pf(expf(-lam[d * DM + ch]));
    float log_a = -8.f * r * sp;
    Aout[(size_t)t * DM + ch] = expf(log_a); Bout[(size_t)t * DM + ch] = sqrtf(-expm1f(2.f * log_a)) * (ig * uval);
}
__global__ void k_lru_scan(const float* A0, const float* B0, const float* A1, const float* B1, float* YF, float* YB) {
    int g = blockIdx.x * 256 + threadIdx.x; int d = g / DM, ch = g % DM;
    if (d == 0) { float h = B0[ch];
        for (int t = 0; t < SEQ; ++t) { size_t o = (size_t)(CTX + t) * DM + ch; h = A0[o] * h + B0[o]; YF[(size_t)t * DM + ch] = h; }
    } else { float h = B1[(size_t)(CTX - 1) * DM + ch];
        for (int t = SEQ - 1; t >= 0; --t) { size_t o = (size_t)(CTX + t) * DM + ch; h = A1[o] * h + B1[o]; YB[(size_t)t * DM + ch] = h; }
    }
}
__global__ void k_yag_f(const float* YF, const float* YB, bf16* AY, int b) {
    int t = blockIdx.x;
    for (int ch = threadIdx.x; ch < DM; ch += 256) { size_t o = (size_t)t * DM + ch; bf16* p = AY + ((size_t)b * SEQ + t) * DM + ch;
        *p = (bf16)f2bf((YF[o] + YB[o]) * gelu_tanh(bf2f(*p))); }
}
#endif
#if !HG_FAST
__global__ __launch_bounds__(128) void k_hgrn_f(unsigned char* ws, const float* hg_lb) {
    __shared__ float gs[128], ks[128], qs[128];
    int h = blockIdx.x, d = blockIdx.y, b = blockIdx.z, j = threadIdx.x;
    float S[128];
#pragma unroll
    for (int i = 0; i < 128; ++i) S[i] = 0.f;
    const int c = h * 128 + j;
    const float lbj = 1.f / (1.f + expf(hg_lb[DM + c] - hg_lb[c]));
    bf16* Q = (bf16*)(ws + WS_P + 2 * GS); bf16* Fx = (bf16*)(ws + WS_P + (d == 0 ? 3 : 4) * GS); bf16* V = (bf16*)(ws + WS_P + 5 * GS);
    const bf16* Fc = (const bf16*)(ws + WS_PC + (d == 0 ? 1 : 2) * CGS); const bf16* Vc = (const bf16*)(ws + WS_PC + 3 * CGS);
    for (int s = 0; s < LT; ++s) {
        bool isx = s >= CTX; float fv, vv, qv = 0.f; size_t o;
        if (!isx) { int t = d == 0 ? s : (CTX - 1 - s); o = ((size_t)b * CTX + t) * DM + c; fv = bf2f(Fc[o]); vv = bf2f(Vc[o]); }
        else { int p = s - CTX; if (d == 1) p = SEQ - 1 - p; int tok = (p % 32) * 64 + (p / 32); o = ((size_t)b * SEQ + tok) * DM + c; fv = bf2f(Fx[o]); vv = bf2f(V[o]); qv = bf2f(Q[o]); }
        float gg = lbj + (1.f - lbj) / (1.f + expf(-fv));
        gs[j] = gg; ks[j] = 1.f - gg; qs[j] = qv / (1.f + expf(-qv));
        __syncthreads();
        float oo = 0.f;
#pragma unroll
        for (int i = 0; i < 128; ++i) { S[i] = gs[i] * S[i] + ks[i] * vv; oo += S[i] * qs[i]; }
        if (isx) Fx[o] = (bf16)f2bf(oo);
        __syncthreads();
    }
}
#endif

extern "C" void kernel_launch(void* const* d_in, const int* in_sizes, int n_in, void* d_out, int out_size, void* d_ws, size_t ws_size, hipStream_t stream) {
    static int grid = 0;
    if (grid == 0) {
        if (n_in != 29 || out_size != NTOK * DM || ws_size < WS_END) { fprintf(stderr, "kernel_launch: unexpected problem shape / workspace (%d inputs, out %d, ws %zu)\n", n_in, out_size, ws_size); grid = -1; return; }
        int dev = 0, cus = 0, per_cu = 0;
        if (hipGetDevice(&dev) != hipSuccess || hipDeviceGetAttribute(&cus, hipDeviceAttributeMultiprocessorCount, dev) != hipSuccess) { grid = -1; return; }
        if (hipFuncSetAttribute((const void*)mega, hipFuncAttributeMaxDynamicSharedMemorySize, LDS_BYTES) != hipSuccess) { grid = -1; return; }
        if (hipOccupancyMaxActiveBlocksPerMultiprocessor(&per_cu, (const void*)mega, NTHR, LDS_BYTES) != hipSuccess || per_cu < 1) { fprintf(stderr, "kernel_launch: occupancy query says %d blocks per CU\n", per_cu); }
        (void)hipGetLastError();
        grid = cus;
        if (grid != 256) { fprintf(stderr, "kernel_launch: built for 256 CUs, found %d\n", cus); grid = -1; return; }
    }
    if (grid < 0) return;
    hipMemsetAsync((char*)d_ws + WS_CTL, 0, CTL_BYTES, stream);
    Args a{};
    for (int i = 0; i < 29; ++i) a.in[i] = (const float*)d_in[i];
    a.out = (float*)d_out; a.ws = (unsigned char*)d_ws;
#if MIX_FAST
    a.ph_lo = 0; a.ph_hi = 12; a.li = 0;
    hipLaunchKernelGGL(mega, dim3(grid), dim3(NTHR), LDS_BYTES, stream, a);
#else
    a.ph_lo = 0; a.ph_hi = 5; a.li = 0;
    hipLaunchKernelGGL(mega, dim3(grid), dim3(NTHR), LDS_BYTES, stream, a);
    {
        unsigned char* ws = (unsigned char*)d_ws;
#if !LRU_FAST
        float* sc = (float*)d_out;
        float* Ub = sc; float* A0 = Ub + (size_t)LT * DM; float* B0 = A0 + (size_t)LT * DM; float* A1 = B0 + (size_t)LT * DM; float* B1 = A1 + (size_t)LT * DM;
        float* YF = B1 + (size_t)LT * DM; float* YB = YF + (size_t)SEQ * DM;
        const float* cw = (const float*)d_in[IN_CONVW]; const float* cb = (const float*)d_in[IN_CONVB];
        const float* wa = (const float*)d_in[IN_WA]; const float* ba = (const float*)d_in[IN_BA]; const float* wx = (const float*)d_in[IN_WX]; const float* bx = (const float*)d_in[IN_BX]; const float* lam = (const float*)d_in[IN_LAM];
        for (int b = 0; b < NB; ++b) {
            k_conv_f<<<LT, 256, 0, stream>>>((const bf16*)(ws + WS_P), (const bf16*)(ws + WS_PC), cw, cb, Ub, b);
            k_gates<<<dim3(LT, 8), 128, 0, stream>>>(Ub, wa, ba, wx, bx, lam, A0, B0, 0);
            k_gates<<<dim3(LT, 8), 128, 0, stream>>>(Ub, wa, ba, wx, bx, lam, A1, B1, 1);
            k_lru_scan<<<8, 256, 0, stream>>>(A0, B0, A1, B1, YF, YB);
            k_yag_f<<<SEQ, 256, 0, stream>>>(YF, YB, (bf16*)(ws + WS_YAG), b);
        }
#endif
#if !HG_FAST
        k_hgrn_f<<<dim3(8, 2, NB), 128, 0, stream>>>(ws, (const float*)d_in[IN_HGLB]);
#endif
    }
    a.ph_lo = 5; a.ph_hi = 12; a.li = 1;
    hipLaunchKernelGGL(mega, dim3(grid), dim3(NTHR), LDS_BYTES, stream, a);
#endif
}
```

```cpp
#include <hip/hip_runtime.h>
#include <cstdio>
#include <cstdint>
#include <math.h>

#define LAS __attribute__((address_space(3)))
#define GAS __attribute__((address_space(1)))
typedef unsigned short bf16;
typedef short bf16x8 __attribute__((ext_vector_type(8)));
typedef float f32x4 __attribute__((ext_vector_type(4)));
typedef float f32x2 __attribute__((ext_vector_type(2)));
typedef unsigned u32x4 __attribute__((ext_vector_type(4)));
typedef unsigned u32x2 __attribute__((ext_vector_type(2)));

constexpr int DM = 1024, NB = 8, SEQ = 2048, CTX = 256, NTOK = NB * SEQ, NCTX = NB * CTX, INW = 9216, LT = CTX + SEQ;
constexpr int NEXP = 32, DEXP = 512, CAP = 16384;
constexpr float EPS = 1e-6f;
constexpr int NWAVES = 8, NTHR = 512;

constexpr size_t MiB = 1u << 20, KiB = 1024;
constexpr size_t WS_CTL = 0, CTL_BYTES = 64 * KiB;
constexpr size_t WS_MODP = 256 * KiB;
constexpr size_t WS_MOD = 2 * MiB;
constexpr size_t WS_LRUAGG = 2 * MiB + 512 * KiB;
constexpr size_t WS_LRUS0 = 4 * MiB + 512 * KiB;
constexpr size_t WS_WT = 4 * MiB + 768 * KiB;
constexpr size_t WS_LIST = 5 * MiB;
constexpr size_t WS_HGD = 7 * MiB;
constexpr size_t WS_WRT = 7 * MiB + 256 * KiB;
constexpr size_t WS_WIN = 8 * MiB;
constexpr size_t WS_WPA = 26 * MiB, WS_WPB = 28 * MiB, WS_WOUT = 30 * MiB;
constexpr size_t WS_WLRU = 32 * MiB;
constexpr size_t WS_P = 33 * MiB, GS = 32 * MiB;
constexpr size_t WS_PC = 321 * MiB, CGS = 4 * MiB;
constexpr size_t WS_END = 337 * MiB;
constexpr size_t WS_W1T = WS_P + 0 * GS, WS_W3T = WS_P + 2 * GS, WS_W2T = WS_P + 5 * GS;
constexpr size_t WS_YAG = WS_P + 1 * GS;
constexpr size_t WS_OF = WS_P + 3 * GS, WS_OB = WS_P + 4 * GS;
constexpr size_t WS_YBG = WS_P + 3 * GS;
constexpr size_t WS_M = WS_P + 4 * GS;
constexpr size_t WS_HX2 = WS_P + 1 * GS;
constexpr size_t WS_HH = WS_P + 3 * GS;
constexpr size_t WS_X1 = WS_P + 8 * GS;
constexpr size_t WS_Y = WS_P + 6 * GS;

constexpr int CW_BAR = 1024;
constexpr int CW_CNT = 12288;
constexpr int CW_TILE = 14336;
constexpr int CW_LRUG = 15680;
constexpr int CW_PANEL = 15616;

constexpr int RING_BYTES = 131072, LDS_BYTES = 147456, LDSCTL_OFF = LDS_BYTES - 1024;

#define GAS __attribute__((address_space(1)))
#define LDS_WAIT() asm volatile("s_waitcnt lgkmcnt(0)" ::: "memory")
#define VM_WAIT() asm volatile("s_waitcnt vmcnt(0)" ::: "memory")

typedef __bf16 bf16x2_t __attribute__((ext_vector_type(2)));
__device__ __forceinline__ unsigned pk2(float lo, float hi) { const f32x2 v = {lo, hi}; return __builtin_bit_cast(unsigned, __builtin_convertvector(v, bf16x2_t)); }
__device__ __forceinline__ unsigned f2bf(float f) { return pk2(f, 0.f) & 0xffffu; }
__device__ __forceinline__ float bf2f(unsigned short b) { return __builtin_bit_cast(float, (unsigned)b << 16); }
__device__ __forceinline__ float bflo(unsigned w) { return __builtin_bit_cast(float, w << 16); }
__device__ __forceinline__ float bfhi(unsigned w) { return __builtin_bit_cast(float, w & 0xffff0000u); }
__device__ __forceinline__ float sigmoidf_(float x) { return __builtin_amdgcn_rcpf(1.f + __builtin_amdgcn_exp2f(x * -1.4426950408889634f)); }
__device__ __forceinline__ float siluf_(float x) { return x * __builtin_amdgcn_rcpf(1.f + __builtin_amdgcn_exp2f(x * -1.4426950408889634f)); }
__device__ __forceinline__ float gelu_tanh(float x) { const float e = __builtin_amdgcn_exp2f((x * 2.3022081985f) * __builtin_fmaf(x * x, 0.044715f, 1.f)); return __builtin_fmaf(-x, __builtin_amdgcn_rcpf(1.f + e), x); }
__device__ __forceinline__ float wave_sum(float v) {
#pragma unroll
    for (int o = 1; o < 64; o <<= 1) v += __shfl_xor(v, o);
    return v;
}

#define XB_TMO      128
#define XB_XCNT(j)  (256  + 64 * (j))
#define XB_XSUB(j)  (1280 + 64 * (j))
#define XB_XGEN(j)  (2304 + 64 * (j))
#define XB_TOP      3328
#define XB_TOPGEN   3392
#define XCD_BAR_WORDS 3456
#define XB_SPIN_CAP (1u << 20)
__device__ __forceinline__ unsigned xb_ld(unsigned* p)              { return __hip_atomic_load(p, __ATOMIC_RELAXED, __HIP_MEMORY_SCOPE_AGENT); }
__device__ __forceinline__ unsigned xb_add(unsigned* p, unsigned v) { return __hip_atomic_fetch_add(p, v, __ATOMIC_RELAXED, __HIP_MEMORY_SCOPE_AGENT); }
__device__ __forceinline__ unsigned xb_xcc_id() { return (unsigned)__builtin_amdgcn_s_getreg((3 << 11) | 20) & 0xFu; }
#define XB_SPIN(cond, bar) do { unsigned _sp = 0; while (cond) { __builtin_amdgcn_s_sleep(1); \
    if ((++_sp & 255u) == 0u) { if (xb_ld(&(bar)[XB_TMO])) break; if (_sp > XB_SPIN_CAP) { atomicAdd(&(bar)[XB_TMO], 1u); break; } } } } while (0)
struct XcdBarrier { unsigned* bar; unsigned x; volatile LAS unsigned* st; };
__device__ __forceinline__ XcdBarrier xcd_barrier_post(unsigned* bar, volatile LAS unsigned* st) {
    XcdBarrier b; b.bar = bar; b.x = xb_xcc_id(); b.st = st;
    if (threadIdx.x == 0) (void)xb_add(&bar[XB_XCNT(b.x)], 1u);
    return b;
}
__device__ __forceinline__ void xcd_barrier_complete(unsigned* bar, unsigned x, unsigned& nloc, unsigned& nx) {
    const unsigned G = gridDim.x * gridDim.y * gridDim.z;
    unsigned sum, cnt, mine, sp = 0u;
    for (;;) {
        sum = 0u; cnt = 0u; mine = 0u;
#pragma unroll
        for (unsigned j = 0; j < 16; ++j) { const unsigned c = xb_ld(&bar[XB_XCNT(j)]); sum += c; cnt += (c > 0u) ? 1u : 0u; mine = (j == x) ? c : mine; }
        if (sum == G) break;
        __builtin_amdgcn_s_sleep(1);
        if ((++sp & 255u) == 0u) { if (xb_ld(&bar[XB_TMO])) break; if (sp > XB_SPIN_CAP) { atomicAdd(&bar[XB_TMO], 1u); break; } }
    }
    nloc = mine > 0u ? mine : 1u; nx = cnt > 0u ? cnt : 1u;
}
__device__ __forceinline__ void xcd_barrier(const XcdBarrier& b) {
    asm volatile("s_waitcnt vmcnt(0)" ::: "memory");
    __syncthreads();
    if (threadIdx.x == 0) {
        unsigned* bar = b.bar;
        __builtin_amdgcn_s_waitcnt(0);
        unsigned nloc = b.st[0], nx = b.st[1];
        if (nloc == 0u) { xcd_barrier_complete(bar, b.x, nloc, nx); b.st[0] = nloc; b.st[1] = nx; }
        const unsigned old = xb_add(&bar[XB_XSUB(b.x)], 1u);
        const unsigned gen = old / nloc;
        if (old + 1u == (gen + 1u) * nloc) {
            __builtin_amdgcn_fence(__ATOMIC_RELEASE, "agent");
            asm volatile("s_waitcnt vmcnt(0)" ::: "memory");
            const unsigned og = xb_add(&bar[XB_TOP], 1u);
            const unsigned tg = og / nx;
            if (og + 1u == (tg + 1u) * nx) xb_add(&bar[XB_TOPGEN], 1u);
            else XB_SPIN(xb_ld(&bar[XB_TOPGEN]) == tg, bar);
            __builtin_amdgcn_fence(__ATOMIC_ACQUIRE, "agent");
            xb_add(&bar[XB_XGEN(b.x)], 1u);
            asm volatile("s_waitcnt vmcnt(0)" ::: "memory");
        } else {
            XB_SPIN(xb_ld(&bar[XB_XGEN(b.x)]) == gen, bar);
            __builtin_amdgcn_fence(__ATOMIC_ACQUIRE, "agent");
            asm volatile("s_waitcnt vmcnt(0)" ::: "memory");
        }
    }
    __syncthreads();
}

namespace gm {
constexpr int BM = 256, BK = 64, HALF = 128, HTB = HALF * BK * 2;
__device__ __forceinline__ int lds_byte(int r, int c) { const int st = (r >> 4) * 2 + (c >> 5), rr = r & 15, cc = c & 31, ob = rr * 64 + cc * 2; return st * 1024 + (ob ^ (((ob >> 9) & 1) << 5)); }
__device__ __forceinline__ void stage_rc(int b, int& R, int& C) { const int st = b / 1024, sb = b % 1024, swz = sb ^ (((sb >> 9) & 1) << 5); R = (st >> 1) * 16 + swz / 64; C = (st & 1) * 32 + (swz % 64) / 2; }
__device__ __forceinline__ int perm32(int rho) { const int n = rho >> 4, i = rho & 15; return 8 * (i >> 2) + 4 * n + (i & 3); }
__device__ __forceinline__ unsigned cvt_pk_bf16(float lo, float hi) { unsigned r; asm volatile("v_cvt_pk_bf16_f32 %0, %1, %2" : "=v"(r) : "v"(lo), "v"(hi)); return r; }

struct Unit { const char* A; const char* B0; const char* B1; char* dst; int pm, pn, e, rows, t; };

template <class Sched, class Epi, bool GATHER, bool HOOKS = false>
__device__ __forceinline__ void gemm_phase(LAS unsigned char* lds, const int K, const Sched& S, const Epi& E) {
    const int tid = threadIdx.x, wid = __builtin_amdgcn_readfirstlane(tid >> 6), lane = tid & 63, wr = wid >> 2, wc = wid & 3, fr = lane & 15, fq = lane >> 4;
    const int nt = K / BK;
    unsigned voffB[2]; int Rr[2]; unsigned Cb[2];
#pragma unroll
    for (int i = 0; i < 2; ++i) { int R, C; stage_rc(tid * 16 + i * 8192, R, C); const int Rb = Epi::PERM ? ((R & ~31) + perm32(R & 31)) : R;
        Rr[i] = R; Cb[i] = (unsigned)C * 2u; voffB[i] = (unsigned)(Rb * K + C) * 2u; }
    const unsigned rowb = (unsigned)K * 2u;
    const size_t kstep = (size_t)(BK * 2);
    const unsigned ldsw = (unsigned)wid * 1024u;
    const int aoff = lds_byte(wr * 64 + fr, fq * 8), boff = lds_byte(wc * 32 + fr, fq * 8);
#define GM_SA(b, h) (((b) * 2 + (h)) * HTB)
#define GM_SB(b, h) ((4 + (b) * 2 + (h)) * HTB)
#define GM_STAGE(bufoff, gbase, voff) do { _Pragma("unroll") for (int _i = 0; _i < 2; ++_i) \
        __builtin_amdgcn_global_load_lds((const unsigned*)((const char*)(gbase) + (voff)[_i]), (LAS unsigned*)(lds + (bufoff) + ldsw + _i * 8192), 16, 0, 0); } while (0)
#define GM_LDA(dst, b, h) do { _Pragma("unroll") for (int m = 0; m < 4; ++m) _Pragma("unroll") for (int k = 0; k < 2; ++k) dst[m][k] = *(const LAS bf16x8*)(lds + GM_SA(b, h) + aoff + m * 2048 + k * 1024); } while (0)
#define GM_LDB(dst, b, h) do { _Pragma("unroll") for (int n = 0; n < 2; ++n) _Pragma("unroll") for (int k = 0; k < 2; ++k) dst[n][k] = *(const LAS bf16x8*)(lds + GM_SB(b, h) + boff + n * 2048 + k * 1024); } while (0)
#define GM_MMA(ai, bj, At, Bt) do { __builtin_amdgcn_s_setprio(1); _Pragma("unroll") for (int m = 0; m < 4; ++m) _Pragma("unroll") for (int n = 0; n < 2; ++n) _Pragma("unroll") for (int k = 0; k < 2; ++k) \
        acc[ai][bj][m][n] = __builtin_amdgcn_mfma_f32_16x16x32_bf16(Bt[n][k], At[m][k], acc[ai][bj][m][n], 0, 0, 0); __builtin_amdgcn_s_setprio(0); } while (0)
#define GM_WAIT_V(n) asm volatile("s_waitcnt vmcnt(" #n ")" ::: "memory")
#define GM_WAIT_L(n) asm volatile("s_waitcnt lgkmcnt(" #n ")" ::: "memory")
#define GM_BAR __builtin_amdgcn_s_barrier()
#define GM_SCHED __builtin_amdgcn_sched_barrier(0)
#define GM_AOFFS(u, o) do { _Pragma("unroll") for (int _h = 0; _h < 2; ++_h) _Pragma("unroll") for (int _i = 0; _i < 2; ++_i) \
        (o)[_h][_i] = (GATHER ? S.arow((u), _h * HALF + Rr[_i]) : (unsigned)(_h * HALF + Rr[_i])) * rowb + Cb[_i]; } while (0)
    Unit cur, nxt; int ui = 0;
    if (!S.next(0, cur)) return;
    f32x4 acc[2][2][4][2];
#pragma unroll
    for (int a = 0; a < 2; ++a)
#pragma unroll
        for (int b = 0; b < 2; ++b)
#pragma unroll
            for (int m = 0; m < 4; ++m)
#pragma unroll
                for (int n = 0; n < 2; ++n) acc[a][b][m][n] = (f32x4){0.f, 0.f, 0.f, 0.f};
    bf16x8 At[4][2], B0[2][2], B1[2][2];
    unsigned ca[2][2], na[2][2];
    GM_AOFFS(cur, ca);
    const char* cA = cur.A; const char* cB0 = cur.B0; const char* cB1 = cur.B1;
    if constexpr (HOOKS) S.a_ready(cur);
    GM_STAGE(GM_SB(0, 0), cB0, voffB); GM_STAGE(GM_SB(0, 1), cB1, voffB); GM_STAGE(GM_SA(0, 0), cA, ca[0]); GM_STAGE(GM_SA(0, 1), cA, ca[1]);
    if (wr == 1) GM_BAR;
    GM_WAIT_V(2); GM_BAR;
    GM_STAGE(GM_SB(1, 0), cB0 + kstep, voffB); GM_STAGE(GM_SA(1, 0), cA + kstep, ca[0]); GM_STAGE(GM_SB(1, 1), cB1 + kstep, voffB);
    GM_WAIT_V(6); GM_BAR;
    for (;;) {
        const bool has_next = S.next(ui + 1, nxt);
        const char* nA = has_next ? nxt.A : cA; const char* nB0 = has_next ? nxt.B0 : cB0; const char* nB1 = has_next ? nxt.B1 : cB1;
        if (has_next) { GM_AOFFS(nxt, na); } else {
#pragma unroll
            for (int h = 0; h < 2; ++h)
#pragma unroll
                for (int i = 0; i < 2; ++i) na[h][i] = ca[h][i]; }
        for (int t = 0; t < nt; t += 2) {
            const bool last = (t == nt - 2);
            if constexpr (HOOKS) { if (last && has_next) S.a_ready(nxt); }
            const char* a1 = cA + (size_t)(t + 1) * kstep;
            const char* a2 = last ? nA : cA + (size_t)(t + 2) * kstep;
            const char* b20 = last ? nB0 : cB0 + (size_t)(t + 2) * kstep; const char* b21 = last ? nB1 : cB1 + (size_t)(t + 2) * kstep;
            const char* a3 = a2 + kstep; const char* b30 = b20 + kstep; const char* b31 = b21 + kstep;
            unsigned o2[2][2];
#pragma unroll
            for (int h = 0; h < 2; ++h)
#pragma unroll
                for (int i = 0; i < 2; ++i) o2[h][i] = last ? na[h][i] : ca[h][i];
            GM_LDB(B0, 0, 0); GM_LDB(B1, 0, 1); GM_SCHED; GM_LDA(At, 0, 0); GM_STAGE(GM_SA(1, 1), a1, ca[1]);
            GM_WAIT_V(8); GM_WAIT_L(0); GM_BAR; GM_MMA(0, 0, At, B0); GM_MMA(0, 1, At, B1); GM_BAR; GM_SCHED;
            GM_LDA(At, 0, 1); GM_STAGE(GM_SB(0, 0), b20, voffB); GM_STAGE(GM_SB(0, 1), b21, voffB); GM_STAGE(GM_SA(0, 0), a2, o2[0]);
            GM_WAIT_V(8); GM_WAIT_L(0); GM_BAR; GM_MMA(1, 0, At, B0); GM_MMA(1, 1, At, B1); GM_BAR; GM_SCHED;
            GM_LDB(B0, 1, 0); GM_LDB(B1, 1, 1); GM_SCHED; GM_LDA(At, 1, 0); GM_STAGE(GM_SA(0, 1), a2, o2[1]);
            GM_WAIT_V(8); GM_WAIT_L(0); GM_BAR; GM_MMA(0, 0, At, B0); GM_MMA(0, 1, At, B1); GM_BAR; GM_SCHED;
            GM_LDA(At, 1, 1); GM_STAGE(GM_SB(1, 0), b30, voffB); GM_STAGE(GM_SB(1, 1), b31, voffB); GM_STAGE(GM_SA(1, 0), a3, o2[0]);
            GM_WAIT_V(8); GM_WAIT_L(0); GM_BAR; GM_MMA(1, 0, At, B0); GM_MMA(1, 1, At, B1); GM_BAR; GM_SCHED;
        }
        if (wr == 0) GM_BAR;
        E(acc, cur, wr, wc, fr, fq);
        if constexpr (HOOKS) S.done(cur);
        if (!has_next) break;
#pragma unroll
        for (int a = 0; a < 2; ++a)
#pragma unroll
            for (int b = 0; b < 2; ++b)
#pragma unroll
                for (int m = 0; m < 4; ++m)
#pragma unroll
                    for (int n = 0; n < 2; ++n) acc[a][b][m][n] = (f32x4){0.f, 0.f, 0.f, 0.f};
        cur = nxt; cA = nA; cB0 = nB0; cB1 = nB1; ++ui;
#pragma unroll
        for (int h = 0; h < 2; ++h)
#pragma unroll
            for (int i = 0; i < 2; ++i) ca[h][i] = na[h][i];
        if (wr == 1) GM_BAR;
    }
    GM_WAIT_V(0);
    GM_BAR;
#undef GM_SA
#undef GM_SB
#undef GM_STAGE
#undef GM_LDA
#undef GM_LDB
#undef GM_MMA
#undef GM_WAIT_V
#undef GM_WAIT_L
#undef GM_BAR
#undef GM_SCHED
#undef GM_AOFFS
}
}
struct Args {
    const float* in[29]; float* out; unsigned char* ws; int ph_lo, ph_hi, li, pad;
};
struct Frame {
    LAS unsigned char* lds; volatile LAS unsigned* MISC;
    unsigned* ctl; unsigned char* ws; float* out;
    int tid, lane, wave, G, bid;
};
enum { IN_X = 0, IN_C, IN_CTX, IN_CCTX, IN_WMOD, IN_BMOD, IN_G1, IN_WIN, IN_CONVW, IN_CONVB, IN_WA, IN_BA, IN_WX, IN_BX, IN_LAM, IN_HGLB, IN_HGN,
       IN_WPA, IN_WPB, IN_WOUT, IN_G2, IN_WRG, IN_BRG, IN_WRE, IN_BRE, IN_W1, IN_W3, IN_W2, IN_FG };

constexpr int TR_BYTES = 64 * 64 * 4;
__device__ __forceinline__ void transpose_item(const float* W, int ldw, int K, bf16* WT, int k0, int n0, LAS float* scr, int lane) {
    const int lr = lane >> 4, ls = lane & 15;
    f32x4 v[16];
#pragma unroll
    for (int i = 0; i < 16; ++i) v[i] = *(const f32x4*)(W + (size_t)(k0 + 4 * i + lr) * ldw + n0 + 4 * ls);
#pragma unroll
    for (int i = 0; i < 16; ++i) { const int k = 4 * i + lr; *(LAS f32x4*)(scr + k * 64 + ((ls ^ ((k >> 3) & 7)) << 2)) = v[i]; }
    LDS_WAIT(); asm volatile("" ::: "memory");
    const int c = lane & 7;
#pragma unroll
    for (int j = 0; j < 8; ++j) { const int n = (lane >> 3) + 8 * j; const LAS float* s = scr + (8 * c) * 64 + ((((n >> 2) ^ c) << 2) | (n & 3));
        u32x4 o; o.x = pk2(s[0 * 64], s[1 * 64]); o.y = pk2(s[2 * 64], s[3 * 64]); o.z = pk2(s[4 * 64], s[5 * 64]); o.w = pk2(s[6 * 64], s[7 * 64]);
        *(u32x4*)(WT + (size_t)n * K + k0 + 8 * c) = o; }
    LDS_WAIT(); asm volatile("" ::: "memory");
}

__device__ __forceinline__ void p0_mod_item(Frame& F, const Args& a, int item) {
    const int cb = item % 24, ks = item / 24;
    LAS float* sv = (LAS float*)F.lds;
    LAS float* red = sv + 9 * 128;
    const float* c = a.in[IN_C]; const float* cc = a.in[IN_CCTX]; const float* wmod = a.in[IN_WMOD];
    for (int i = F.tid; i < 9 * 128; i += NTHR) { const int r = i >> 7, k = i & 127; const float v = r < 8 ? c[r * DM + ks * 128 + k] : cc[ks * 128 + k]; sv[i] = siluf_(v); }
    __syncthreads();
    const int col = cb * 256 + (F.tid & 255), kh = F.tid >> 8;
    float acc[9];
#pragma unroll
    for (int r = 0; r < 9; ++r) acc[r] = 0.f;
    for (int k0 = 0; k0 < 64; k0 += 16) { float wv[16];
#pragma unroll
        for (int k = 0; k < 16; ++k) wv[k] = wmod[(size_t)(ks * 128 + kh * 64 + k0 + k) * 6144 + col];
#pragma unroll
        for (int k = 0; k < 16; ++k) { const int kk = kh * 64 + k0 + k;
#pragma unroll
            for (int r = 0; r < 9; ++r) acc[r] += sv[r * 128 + kk] * wv[k]; } }
    if (kh == 1) {
#pragma unroll
        for (int r = 0; r < 9; ++r) red[r * 256 + (F.tid & 255)] = acc[r]; }
    __syncthreads();
    float* modp = (float*)(F.ws + WS_MODP);
    if (kh == 0) {
#pragma unroll
        for (int r = 0; r < 9; ++r) modp[(size_t)(ks * 9 + r) * 6144 + col] = acc[r] + red[r * 256 + F.tid]; }
    __syncthreads();
}
__device__ __forceinline__ float mod_from_partials(const float* modp, const float* bmod, int row, int j) {
    float s = bmod[j];
#pragma unroll
    for (int ks = 0; ks < 8; ++ks) s += modp[(size_t)(ks * 9 + row) * 6144 + j];
    return s;
}

__device__ __forceinline__ void p0_prologue(Frame& F, const Args& a) {
    if (F.bid < 192) p0_mod_item(F, a, F.bid);
    LAS float* scr = (LAS float*)(F.lds + F.wave * TR_BYTES);
    const int gw = F.bid * NWAVES + F.wave, NGW = F.G * NWAVES;
    constexpr int I_IN = 16 * 144, I_PR = 16 * 16, I_LRU = 32 * 4;
    constexpr int NITEMS = I_IN + 3 * I_PR + I_LRU;
    for (int it = gw; it < NITEMS; it += NGW) {
        int r = it;
        if (r < I_IN) { const int kb = r / 144, nb = r % 144; transpose_item(a.in[IN_WIN], INW, DM, (bf16*)(F.ws + WS_WIN) + (size_t)(nb * 64) * DM, kb * 64, nb * 64, scr, F.lane); continue; } r -= I_IN;
        if (r < 3 * I_PR) { const int w = r / I_PR, q = r % I_PR, kb = q / 16, nb = q % 16;
            const float* W = a.in[w == 0 ? IN_WPA : (w == 1 ? IN_WPB : IN_WOUT)]; bf16* WT = (bf16*)(F.ws + (w == 0 ? WS_WPA : (w == 1 ? WS_WPB : WS_WOUT)));
            transpose_item(W, DM, DM, WT + (size_t)(nb * 64) * DM, kb * 64, nb * 64, scr, F.lane); continue; } r -= 3 * I_PR;
        { const int mat = r / 4, q = r % 4, kb = q / 2, nb = q % 2;
          const int which = mat >> 4, dh = mat & 15;
          const float* W = a.in[which == 0 ? IN_WA : IN_WX] + (size_t)dh * 128 * 128; bf16* WT = (bf16*)(F.ws + WS_WLRU) + (size_t)mat * 128 * 128;
          transpose_item(W, 128, 128, WT + (size_t)(nb * 64) * 128, kb * 64, nb * 64, scr, F.lane); }
    }
    { u32x4* z = (u32x4*)(F.ws + WS_LRUAGG);
      for (int i = F.bid * NTHR + F.tid; i < (int)((2 * MiB + 128 * KiB) / 16); i += F.G * NTHR) z[i] = (u32x4){0u, 0u, 0u, 0u}; }
    float* wrp = (float*)(F.ws + WS_WRT);
    for (int i = F.bid * NTHR + F.tid; i < 49152 + 48; i += F.G * NTHR) {
        if (i < 49152) { const int j = i & 3, ln = (i >> 2) & 63, sc = i >> 8, c = sc % 3, s2 = sc / 3; const int k = 16 * s2 + 4 * (ln >> 4) + j, o = 16 * c + (ln & 15);
            wrp[i] = o < 4 ? a.in[IN_WRG][k * 4 + o] : (o < 36 ? a.in[IN_WRE][k * 32 + (o - 4)] : 0.f); }
        else { const int o = i - 49152; wrp[i] = o < 4 ? a.in[IN_BRG][o] : (o < 36 ? a.in[IN_BRE][o - 4] : 0.f); }
    }
}

__device__ __forceinline__ void norm_rows(Frame& F, const float* src, bf16* dst, int row0, int nrows, const LAS float* gs, const LAS float* sh) {
    for (int r = F.wave; r < nrows; r += 2 * NWAVES) {
        const int r1 = r + NWAVES < nrows ? r + NWAVES : r;
        const f32x4* xa = (const f32x4*)(src + (size_t)(row0 + r) * DM) + F.lane; const f32x4* xb = (const f32x4*)(src + (size_t)(row0 + r1) * DM) + F.lane;
        f32x4 va[4], vb[4]; float sa = 0.f, sb = 0.f;
#pragma unroll
        for (int j = 0; j < 4; ++j) { va[j] = xa[64 * j]; vb[j] = xb[64 * j]; }
#pragma unroll
        for (int j = 0; j < 4; ++j) { sa += (va[j].x * va[j].x + va[j].y * va[j].y) + (va[j].z * va[j].z + va[j].w * va[j].w); sb += (vb[j].x * vb[j].x + vb[j].y * vb[j].y) + (vb[j].z * vb[j].z + vb[j].w * vb[j].w); }
        const float ra = rsqrtf(wave_sum(sa) * (1.f / DM) + EPS), rb = rsqrtf(wave_sum(sb) * (1.f / DM) + EPS);
        unsigned long long* oa = (unsigned long long*)(dst + (size_t)(row0 + r) * DM) + F.lane; unsigned long long* ob = (unsigned long long*)(dst + (size_t)(row0 + r1) * DM) + F.lane;
#pragma unroll
        for (int j = 0; j < 4; ++j) { const int k = 4 * F.lane + 256 * j;
            const f32x4 g = *(const LAS f32x4*)(gs + k), h = *(const LAS f32x4*)(sh + k);
            oa[64 * j] = (unsigned long long)pk2(va[j].x * ra * g.x + h.x, va[j].y * ra * g.y + h.y) | ((unsigned long long)pk2(va[j].z * ra * g.z + h.z, va[j].w * ra * g.w + h.w) << 32);
            ob[64 * j] = (unsigned long long)pk2(vb[j].x * rb * g.x + h.x, vb[j].y * rb * g.y + h.y) | ((unsigned long long)pk2(vb[j].z * rb * g.z + h.z, vb[j].w * rb * g.w + h.w) << 32); }
    }
}
struct EpiStoreBf16 {
    static constexpr bool PERM = true;
    __device__ __forceinline__ void operator()(const f32x4 (&acc)[2][2][4][2], const gm::Unit& u, int wr, int wc, int fr, int fq) const {
        bf16* base = (bf16*)u.dst + (size_t)(wr * 64 + fr) * DM + wc * 32 + 8 * fq;
#pragma unroll
        for (int ai = 0; ai < 2; ++ai)
#pragma unroll
            for (int m = 0; m < 4; ++m) { bf16* rowp = base + (size_t)(ai * 128 + m * 16) * DM;
#pragma unroll
                for (int bj = 0; bj < 2; ++bj) { const f32x4 v0 = acc[ai][bj][m][0], v1 = acc[ai][bj][m][1];
                    u32x4 w; w.x = gm::cvt_pk_bf16(v0[0], v0[1]); w.y = gm::cvt_pk_bf16(v0[2], v0[3]); w.z = gm::cvt_pk_bf16(v1[0], v1[1]); w.w = gm::cvt_pk_bf16(v1[2], v1[3]);
                    *(u32x4*)(rowp + bj * 128) = w; } }
    }
};
__device__ __forceinline__ void tile_order(int L, int nM, int nN, int& pm, int& pn) {
    const int nwg = nM * nN; int wgid = L;
    { const int q = nwg / 8, r = nwg % 8, xcd = wgid % 8, off = wgid / 8; wgid = (xcd < r ? xcd * (q + 1) : r * (q + 1) + (xcd - r) * q) + off; }
    const int nig = 8 * nN, gid = wgid / nig, fm = gid * 8, gsz = (nM - fm) < 8 ? (nM - fm) : 8;
    pm = fm + ((wgid % nig) % gsz); pn = (wgid % nig) / gsz;
}
struct SchedP2 {
    int G, c; const char* H; const char* Wt; char* P; char* PC;
    __device__ __forceinline__ bool next(int i, gm::Unit& u) const {
        int L = i * G + c;
        if (L < 64 * 36) { int pm, pn; tile_order(L, 64, 36, pm, pn);
            u.A = H + (size_t)pm * 256 * 2048; u.B0 = Wt + (size_t)pn * 256 * 2048; u.B1 = u.B0 + (size_t)128 * 2048;
            u.dst = P + (size_t)(pn >> 2) * GS + ((size_t)pm * 256 * DM + (pn & 3) * 256) * 2; u.pm = pm; u.pn = pn; u.e = 0; u.rows = 256; return true; }
        return false;
    }
    __device__ __forceinline__ unsigned arow(const gm::Unit&, int r) const { return (unsigned)r; }
};
struct SchedCtx {
    int bid; const char* H; const char* Wt; char* PC; unsigned* cnt; unsigned* tmo;
    __device__ __forceinline__ bool next(int i, gm::Unit& u) const {
        if (i > 0) return false;
        const int pmc = bid >> 4, j = bid & 15, slot = j >> 2, g = slot == 0 ? 0 : slot + 2, pn = g * 4 + (j & 3);
        u.A = H + (size_t)(NTOK + pmc * 256) * 2048; u.B0 = Wt + (size_t)pn * 256 * 2048; u.B1 = u.B0 + (size_t)128 * 2048;
        u.dst = PC + (size_t)slot * CGS + ((size_t)pmc * 256 * DM + (j & 3) * 256) * 2; u.pm = pmc; u.pn = pn; u.e = 0; u.rows = 256; u.t = pmc; return true;
    }
    __device__ __forceinline__ unsigned arow(const gm::Unit&, int r) const { return (unsigned)r; }
    __device__ __forceinline__ void a_ready(const gm::Unit& u) const {
        if (threadIdx.x < 64) {
            unsigned spins = 0;
            while ((unsigned)__builtin_amdgcn_readfirstlane(__hip_atomic_load(cnt + 8 * u.t, __ATOMIC_RELAXED, __HIP_MEMORY_SCOPE_AGENT)) < 16u) {
                __builtin_amdgcn_s_sleep(2);
                if (++spins > (1u << 22)) { if (threadIdx.x == 0) __hip_atomic_store(tmo, 1u, __ATOMIC_RELAXED, __HIP_MEMORY_SCOPE_AGENT); break; } }
            __builtin_amdgcn_fence(__ATOMIC_ACQUIRE, "agent");
            asm volatile("s_waitcnt vmcnt(0)" ::: "memory");
        }
        asm volatile("" ::: "memory"); __builtin_amdgcn_s_barrier(); asm volatile("" ::: "memory");
    }
    __device__ __forceinline__ void done(const gm::Unit&) const {}
};
__device__ __forceinline__ void p1_norm(Frame& F, const Args& a) {
    const float* modp = (const float*)(F.ws + WS_MODP); const float* bmod = a.in[IN_BMOD]; const float* g1 = a.in[IN_G1];
    LAS float* gs = (LAS float*)F.lds; LAS float* sh = gs + DM;
    bf16* H = (bf16*)F.out;
    float* mod = (float*)(F.ws + WS_MOD);
    for (int i = F.bid * NTHR + F.tid; i < 9 * 6144; i += F.G * NTHR) mod[i] = mod_from_partials(modp, bmod, i / 6144, i % 6144);
    if (F.bid >= 128) {
        const int wg = F.bid - 128, b = wg >> 4;
        for (int k = F.tid; k < DM; k += NTHR) { gs[k] = g1[k] * (1.f + mod_from_partials(modp, bmod, b, DM + k)); sh[k] = mod_from_partials(modp, bmod, b, k); }
        __syncthreads();
        norm_rows(F, a.in[IN_X], H, wg * 128, 128, gs, sh);
        __syncthreads();
    } else {
        for (int k = F.tid; k < DM; k += NTHR) { gs[k] = g1[k] * (1.f + mod_from_partials(modp, bmod, 8, DM + k)); sh[k] = mod_from_partials(modp, bmod, 8, k); }
        __syncthreads();
        const int pmc = F.bid >> 4, r0 = pmc * 256 + (F.bid & 15) * 16;
        const __amdgpu_buffer_rsrc_t rs = __builtin_amdgcn_make_buffer_rsrc((void*)(H + (size_t)NTOK * DM), 0, 0x7fffffff, 0x00020000);
#pragma unroll
        for (int q = 0; q < 2; ++q) {
            const int row = r0 + 2 * F.wave + q;
            const f32x4* xr = (const f32x4*)(a.in[IN_CTX] + (size_t)row * DM) + 2 * F.lane;
            f32x4 v[2][2]; float sq = 0.f;
#pragma unroll
            for (int j = 0; j < 2; ++j) { v[j][0] = xr[128 * j]; v[j][1] = xr[128 * j + 1];
                sq += (v[j][0].x * v[j][0].x + v[j][0].y * v[j][0].y) + (v[j][0].z * v[j][0].z + v[j][0].w * v[j][0].w) + (v[j][1].x * v[j][1].x + v[j][1].y * v[j][1].y) + (v[j][1].z * v[j][1].z + v[j][1].w * v[j][1].w); }
            const float rstd = rsqrtf(wave_sum(sq) * (1.f / DM) + EPS);
#pragma unroll
            for (int j = 0; j < 2; ++j) { const int k = 8 * F.lane + 512 * j;
                const f32x4 ga = *(const LAS f32x4*)(gs + k), gb = *(const LAS f32x4*)(gs + k + 4), ha = *(const LAS f32x4*)(sh + k), hb = *(const LAS f32x4*)(sh + k + 4);
                u32x4 w; w.x = pk2(v[j][0].x * rstd * ga.x + ha.x, v[j][0].y * rstd * ga.y + ha.y); w.y = pk2(v[j][0].z * rstd * ga.z + ha.z, v[j][0].w * rstd * ga.w + ha.w);
                w.z = pk2(v[j][1].x * rstd * gb.x + hb.x, v[j][1].y * rstd * gb.y + hb.y); w.w = pk2(v[j][1].z * rstd * gb.z + hb.z, v[j][1].w * rstd * gb.w + hb.w);
                __builtin_amdgcn_raw_buffer_store_b128(w, rs, (unsigned)(((size_t)row * DM + k) * 2), 0, 16); }
        }
        asm volatile("s_waitcnt vmcnt(0)" ::: "memory");
        __syncthreads();
        unsigned* pcnt = F.ctl + CW_PANEL;
        if (F.tid == 0) __hip_atomic_fetch_add(pcnt + 8 * pmc, 1u, __ATOMIC_RELAXED, __HIP_MEMORY_SCOPE_AGENT);
        SchedCtx S{F.bid, (const char*)F.out, (const char*)(F.ws + WS_WIN), (char*)(F.ws + WS_PC), pcnt, F.ctl + 3};
        EpiStoreBf16 E;
        gm::gemm_phase<SchedCtx, EpiStoreBf16, false, true>(F.lds, DM, S, E);
    }
}

#ifdef PROBE_A
#define HSTAMP(i) do { if (F.bid == 0 && F.tid == 0) { const unsigned long long _t = __builtin_amdgcn_s_memrealtime(); const unsigned long long _p = ((unsigned long long)F.MISC[101] << 32) | F.MISC[100]; \
    unsigned long long _a = ((unsigned long long)F.MISC[103 + 2 * (i)] << 32) | F.MISC[102 + 2 * (i)]; _a += _t - _p; F.MISC[102 + 2 * (i)] = (unsigned)_a; F.MISC[103 + 2 * (i)] = (unsigned)(_a >> 32); F.MISC[100] = (unsigned)_t; F.MISC[101] = (unsigned)(_t >> 32); } } while (0)
#else
#define HSTAMP(i) do { } while (0)
#endif
constexpr int LRU_T = 128, LRU_NCH = SEQ / LRU_T, UF_LD = 144;
constexpr int LRU_UBF = 0, LRU_UF = 144 * 256;
constexpr float LOG2E = 1.4426950408889634f;

struct LruCoef { float ba, bx, ca; };

struct LruConvW { float w[4][8], bs[8]; };
__device__ __forceinline__ void lru_conv_weights(Frame& F, const Args& a, int h, LruConvW& cwv) {
    const float* cw = a.in[IN_CONVW] + h * 128; const float* cb = a.in[IN_CONVB] + h * 128; const int cg = F.tid & 15;
#pragma unroll
    for (int k = 0; k < 4; ++k) { const f32x4 w0 = *(const f32x4*)(cw + k * DM + 8 * cg), w1 = *(const f32x4*)(cw + k * DM + 8 * cg + 4);
        cwv.w[k][0] = w0.x; cwv.w[k][1] = w0.y; cwv.w[k][2] = w0.z; cwv.w[k][3] = w0.w; cwv.w[k][4] = w1.x; cwv.w[k][5] = w1.y; cwv.w[k][6] = w1.z; cwv.w[k][7] = w1.w; }
    { const f32x4 b0 = *(const f32x4*)(cb + 8 * cg), b1 = *(const f32x4*)(cb + 8 * cg + 4); cwv.bs[0] = b0.x; cwv.bs[1] = b0.y; cwv.bs[2] = b0.z; cwv.bs[3] = b0.w; cwv.bs[4] = b1.x; cwv.bs[5] = b1.y; cwv.bs[6] = b1.z; cwv.bs[7] = b1.w; }
}
__device__ __forceinline__ void lru_conv_load(Frame& F, int b, int h, int c, u32x4 (&raw)[4][4]) {
    const bf16* AX = (const bf16*)(F.ws + WS_P) + (size_t)b * SEQ * DM + h * 128;
    int cg = F.tid & 15, tl0 = F.tid >> 4;
    asm volatile("" : "+v"(cg), "+v"(tl0));
#pragma unroll
    for (int i = 0; i < 4; ++i)
#pragma unroll
        for (int k = 0; k < 4; ++k) { int tt = c * LRU_T + tl0 + 32 * i + k - 2; tt = tt < 0 ? 0 : (tt > SEQ - 1 ? SEQ - 1 : tt); raw[i][k] = *(const u32x4*)(AX + (size_t)tt * DM + 8 * cg); }
}
__device__ __forceinline__ void lru_conv(Frame& F, const LruConvW& cwv, const u32x4 (&raw)[4][4], int b, int h, int c, bool special) {
    LAS unsigned char* ubf = F.lds + LRU_UBF; LAS float* uf = (LAS float*)(F.lds + LRU_UF);
    int cg = F.tid & 15, tl0 = F.tid >> 4;
    asm volatile("" : "+v"(cg), "+v"(tl0));
    const float (&w)[4][8] = cwv.w; const float (&bs)[8] = cwv.bs;
#pragma unroll
    for (int i = 0; i < 4; ++i) { const int tl = tl0 + 32 * i;
        float u[8];
#pragma unroll
        for (int q = 0; q < 8; ++q) u[q] = bs[q];
#pragma unroll
        for (int k = 0; k < 4; ++k) { const int tt = c * LRU_T + tl + k - 2; const float mk = (tt >= 0 && tt < SEQ) ? 1.f : 0.f; const u32x4 v = raw[i][k];
            u[0] += mk * w[k][0] * bflo(v.x); u[1] += mk * w[k][1] * bfhi(v.x); u[2] += mk * w[k][2] * bflo(v.y); u[3] += mk * w[k][3] * bfhi(v.y);
            u[4] += mk * w[k][4] * bflo(v.z); u[5] += mk * w[k][5] * bfhi(v.z); u[6] += mk * w[k][6] * bflo(v.w); u[7] += mk * w[k][7] * bfhi(v.w); }
        *(LAS f32x4*)(uf + tl * UF_LD + 8 * cg) = (f32x4){u[0], u[1], u[2], u[3]};
        *(LAS f32x4*)(uf + tl * UF_LD + 8 * cg + 4) = (f32x4){u[4], u[5], u[6], u[7]};
        u32x4 p; p.x = pk2(u[0], u[1]); p.y = pk2(u[2], u[3]); p.z = pk2(u[4], u[5]); p.w = pk2(u[6], u[7]);
        *(LAS u32x4*)(ubf + tl * 256 + ((cg ^ (tl & 15)) << 4)) = p; }
    if (special) {
        const bf16* AC = (const bf16*)(F.ws + WS_PC) + (size_t)b * CTX * DM + h * 128;
        if (F.tid < 32) { const int tl = LRU_T + (F.tid >> 4); const int t = tl == LRU_T ? 0 : CTX - 1;
            float u[8];
#pragma unroll
            for (int q = 0; q < 8; ++q) u[q] = bs[q];
#pragma unroll
            for (int k = 0; k < 4; ++k) { const int tt = t + k - 2;
                if (tt >= 0 && tt < CTX) { const u32x4 v = *(const u32x4*)(AC + (size_t)tt * DM + 8 * cg);
                    u[0] += w[k][0] * bflo(v.x); u[1] += w[k][1] * bfhi(v.x); u[2] += w[k][2] * bflo(v.y); u[3] += w[k][3] * bfhi(v.y);
                    u[4] += w[k][4] * bflo(v.z); u[5] += w[k][5] * bfhi(v.z); u[6] += w[k][6] * bflo(v.w); u[7] += w[k][7] * bfhi(v.w); } }
            *(LAS f32x4*)(uf + tl * UF_LD + 8 * cg) = (f32x4){u[0], u[1], u[2], u[3]};
            *(LAS f32x4*)(uf + tl * UF_LD + 8 * cg + 4) = (f32x4){u[4], u[5], u[6], u[7]};
            u32x4 p; p.x = pk2(u[0], u[1]); p.y = pk2(u[2], u[3]); p.z = pk2(u[4], u[5]); p.w = pk2(u[6], u[7]);
            *(LAS u32x4*)(ubf + tl * 256 + ((cg ^ (tl & 15)) << 4)) = p;
        } else if (F.tid < 32 + 14 * 16) { const int tl = LRU_T + 2 + ((F.tid - 32) >> 4);
            *(LAS u32x4*)(ubf + tl * 256 + ((cg ^ (tl & 15)) << 4)) = (u32x4){0u, 0u, 0u, 0u}; }
    }
}
__device__ __forceinline__ void lru_load_w(Frame& F, int d, int h, bf16x8 (&Bw)[2][4]) {
    const int fr = F.lane & 15, fq = F.lane >> 4;
#pragma unroll
    for (int which = 0; which < 2; ++which) { const bf16* W = (const bf16*)(F.ws + WS_WLRU) + (size_t)(which * 16 + d * 8 + h) * 128 * 128 + (size_t)(16 * F.wave + fr) * 128 + 8 * fq;
#pragma unroll
        for (int kk = 0; kk < 4; ++kk) Bw[which][kk] = *(const bf16x8*)(W + kk * 32); }
}
__device__ __forceinline__ LruCoef lru_coef(const Args& a, int d, int ch) {
    LruCoef k; k.ba = -LOG2E * a.in[IN_BA][d * DM + ch]; k.bx = -LOG2E * a.in[IN_BX][d * DM + ch];
    const float sp = log1pf(expf(-a.in[IN_LAM][d * DM + ch])); k.ca = -8.f * sp * LOG2E; return k;
}
template <int V = 0> __device__ __forceinline__ void lru_tile(Frame& F, int m, const bf16x8 (&Bw)[2][4], const LruCoef& k, float (&av)[4], float (&bv)[4], int fr_ = -1, int fq_ = -1) {
    const int fr = fr_ < 0 ? (F.lane & 15) : fr_, fq = fq_ < 0 ? (F.lane >> 4) : fq_;
    const LAS unsigned char* ubf = F.lds + LRU_UBF; const LAS float* uf = (const LAS float*)(F.lds + LRU_UF);
    f32x4 ar = {0.f, 0.f, 0.f, 0.f}, ai = {0.f, 0.f, 0.f, 0.f};
    const int row = m * 16 + fr;
#pragma unroll
    for (int kk = 0; kk < 4; ++kk) { const bf16x8 A = *(const LAS bf16x8*)(ubf + row * 256 + (((kk * 4 + fq) ^ fr) << 4));
        ar = __builtin_amdgcn_mfma_f32_16x16x32_bf16(A, Bw[0][kk], ar, 0, 0, 0); ai = __builtin_amdgcn_mfma_f32_16x16x32_bf16(A, Bw[1][kk], ai, 0, 0, 0); }
#pragma unroll
    for (int r = 0; r < 4; ++r) { const float u = uf[(m * 16 + 4 * fq + r) * UF_LD + 16 * F.wave + fr];
        if (V == 2) { av[r] = __builtin_fmaf(ar[r], -LOG2E, k.ba) * k.ca; bv[r] = __builtin_fmaf(ai[r], -LOG2E, k.bx) * u; continue; }
        const float rg = __builtin_amdgcn_rcpf(1.f + __builtin_amdgcn_exp2f(__builtin_fmaf(ar[r], -LOG2E, k.ba)));
        const float ig = __builtin_amdgcn_rcpf(1.f + __builtin_amdgcn_exp2f(__builtin_fmaf(ai[r], -LOG2E, k.bx)));
        const float aa = __builtin_amdgcn_exp2f(k.ca * rg);
        av[r] = aa; bv[r] = __builtin_amdgcn_sqrtf(__builtin_fmaf(-aa, aa, 1.f)) * (ig * u); }
}
template <bool FWD, int V = 0> __device__ __forceinline__ void lru_tile_total(int fq, float& A, float& B) {
    if (V == 1) return;
#pragma unroll
    for (int s = 0; s < 2; ++s) { const int bit = 1 << s; const float Ap = __shfl_xor(A, 16 << s), Bp = __shfl_xor(B, 16 << s);
        const bool mine_first = FWD ? ((fq & bit) == 0) : ((fq & bit) != 0);
        if (mine_first) { B = B * Ap + Bp; A = A * Ap; } else { B = Bp * A + B; A = Ap * A; } }
}

template <int V = 0> __device__ __forceinline__ void lru_phase1(Frame& F, const Args& a, float* agg_base) {
    const int NU = NB * 8 * LRU_NCH;
    if (F.bid >= NU) return;
    const int fr = F.lane & 15, fq = F.lane >> 4;
    const int h = (F.bid >> 4) & 7; const int ch = h * 128 + 16 * F.wave + fr;
    const LruCoef k0 = lru_coef(a, 0, ch), k1 = lru_coef(a, 1, ch);
    for (int unit = F.bid; unit < NU; unit += F.G) {
        const int c = unit & (LRU_NCH - 1), b = unit >> 7;
        bf16x8 Bw0[2][4], Bw1[2][4]; lru_load_w(F, 0, h, Bw0); lru_load_w(F, 1, h, Bw1);
        { u32x4 raw[4][4]; lru_conv_load(F, b, h, c, raw); LruConvW cwv; lru_conv_weights(F, a, h, cwv); lru_conv(F, cwv, raw, b, h, c, c == 0 && V == 0); }
        LDS_WAIT(); __syncthreads();
        float Af = 1.f, Hf = 0.f, Ab = 1.f, Hb = 0.f;
#pragma unroll 2
        for (int m = 0; m < 8; ++m) {
            float av[4], bv[4];
            lru_tile<V>(F, m, Bw0, k0, av, bv);
            float A = av[0] * av[1] * av[2] * av[3], B = ((bv[0] * av[1] + bv[1]) * av[2] + bv[2]) * av[3] + bv[3];
            lru_tile_total<true, V>(fq, A, B);
            Hf = Hf * A + B; Af = Af * A;
            lru_tile<V>(F, m, Bw1, k1, av, bv);
            A = av[0] * av[1] * av[2] * av[3]; B = ((bv[3] * av[2] + bv[2]) * av[1] + bv[1]) * av[0] + bv[0];
            lru_tile_total<false, V>(fq, A, B);
            Hb = B * Ab + Hb; Ab = A * Ab;
        }
        float* agg = agg_base;
        if (fq == 0) { *(f32x2*)(agg + ((size_t)((b * LRU_NCH + c) * 2 + 0) * DM + ch) * 2) = (f32x2){Af, Hf};
                       *(f32x2*)(agg + ((size_t)((b * LRU_NCH + c) * 2 + 1) * DM + ch) * 2) = (f32x2){Ab, Hb}; }
        if (c == 0 && V == 0) {
            float av[4], bv[4]; float* s0 = (float*)(F.ws + WS_LRUS0);
            lru_tile(F, 8, Bw0, k0, av, bv); if (fq == 0) s0[(b * 2 + 0) * DM + ch] = bv[0];
            lru_tile(F, 8, Bw1, k1, av, bv); if (fq == 0) s0[(b * 2 + 1) * DM + ch] = bv[1];
        }
        __syncthreads();
    }
}

__device__ __forceinline__ void lru_pass2(Frame& F, const Args& a, int unit, const LruCoef& kf, const LruCoef& kb) {
    const int c = unit & (LRU_NCH - 1), h = (unit >> 4) & 7, b = unit >> 7;
    const int fr = F.lane & 15, fq = F.lane >> 4; const int ch = h * 128 + 16 * F.wave + fr;
    const float* agg = (const float*)(F.ws + WS_LRUAGG); const float* s0 = (const float*)(F.ws + WS_LRUS0);
    f32x2 ag[LRU_NCH];
#pragma unroll
    for (int j = 0; j < LRU_NCH; ++j) ag[j] = *(const f32x2*)(agg + ((size_t)((b * LRU_NCH + j) * 2 + (j < c ? 0 : 1)) * DM + ch) * 2);
    float hf = s0[(b * 2 + 0) * DM + ch], hb = s0[(b * 2 + 1) * DM + ch];
    bf16* AY = (bf16*)(F.ws + WS_YAG) + ((size_t)b * SEQ + c * LRU_T) * DM + h * 128;
    u32x4 ayv[4];
#pragma unroll
    for (int i = 0; i < 4; ++i) ayv[i] = *(const u32x4*)(AY + (size_t)((F.tid >> 4) + 32 * i) * DM + 8 * (F.tid & 15));
    bf16x8 Bw[2][4], Bw1[2][4]; lru_load_w(F, 0, h, Bw);
    LruCoef k = kf; const LruCoef k1 = kb;
    { u32x4 raw[4][4]; lru_conv_load(F, b, h, c, raw); LruConvW cwv; lru_conv_weights(F, a, h, cwv); lru_conv(F, cwv, raw, b, h, c, false); }
    lru_load_w(F, 1, h, Bw1);
#pragma unroll
    for (int j = 0; j < LRU_NCH; ++j) if (j < c) hf = ag[j].x * hf + ag[j].y;
#pragma unroll
    for (int j = LRU_NCH - 1; j >= 0; --j) if (j > c) hb = ag[j].x * hb + ag[j].y;
    LDS_WAIT(); __syncthreads();
    float hfv[8][4];
#pragma unroll
    for (int m = 0; m < 8; ++m) {
        float av[4], bv[4];
        lru_tile(F, m, Bw, k, av, bv);
        const float A = av[0] * av[1] * av[2] * av[3], B = ((bv[0] * av[1] + bv[1]) * av[2] + bv[2]) * av[3] + bv[3];
        float hin = hf;
#pragma unroll
        for (int g = 0; g < 4; ++g) { const float Ag = __shfl(A, g * 16 + fr), Bg = __shfl(B, g * 16 + fr); if (g < fq) hin = Ag * hin + Bg; hf = Ag * hf + Bg; }
#pragma unroll
        for (int r = 0; r < 4; ++r) { hin = av[r] * hin + bv[r]; hfv[m][r] = hin; }
    }
    k = k1;
    LAS float* uf = (LAS float*)(F.lds + LRU_UF);
#pragma unroll
    for (int m = 7; m >= 0; --m) {
        float av[4], bv[4];
        lru_tile(F, m, Bw1, k, av, bv);
        const float A = av[0] * av[1] * av[2] * av[3], B = ((bv[3] * av[2] + bv[2]) * av[1] + bv[1]) * av[0] + bv[0];
        float hin = hb;
#pragma unroll
        for (int g = 3; g >= 0; --g) { const float Ag = __shfl(A, g * 16 + fr), Bg = __shfl(B, g * 16 + fr); if (g > fq) hin = Ag * hin + Bg; hb = Ag * hb + Bg; }
#pragma unroll
        for (int r = 3; r >= 0; --r) { hin = av[r] * hin + bv[r]; uf[(m * 16 + 4 * fq + r) * UF_LD + 16 * F.wave + fr] = hfv[m][r] + hin; }
    }
    LDS_WAIT(); __syncthreads();
    const int cg = F.tid & 15;
#pragma unroll
    for (int i = 0; i < 4; ++i) { const int tl = (F.tid >> 4) + 32 * i;
        const f32x4 y0 = *(const LAS f32x4*)(uf + tl * UF_LD + 8 * cg), y1 = *(const LAS f32x4*)(uf + tl * UF_LD + 8 * cg + 4);
        const u32x4 g = ayv[i];
        u32x4 o; o.x = pk2(y0.x * gelu_tanh(bflo(g.x)), y0.y * gelu_tanh(bfhi(g.x))); o.y = pk2(y0.z * gelu_tanh(bflo(g.y)), y0.w * gelu_tanh(bfhi(g.y)));
        o.z = pk2(y1.x * gelu_tanh(bflo(g.z)), y1.y * gelu_tanh(bfhi(g.z))); o.w = pk2(y1.z * gelu_tanh(bflo(g.w)), y1.w * gelu_tanh(bfhi(g.w)));
        *(u32x4*)(AY + (size_t)tl * DM + 8 * cg) = o; }
    __syncthreads();
}

constexpr int LRU_PRIV = LRU_UF;
__device__ __forceinline__ void lru_conv_b(Frame& F, const LruConvW& cwv, const u32x4 (&raw)[4][4], int b, int h, int c, bool special) {
    LAS unsigned char* ubf = F.lds + LRU_UBF;
    int cg = F.tid & 15, tl0 = F.tid >> 4;
    asm volatile("" : "+v"(cg), "+v"(tl0));
    const float (&w)[4][8] = cwv.w; const float (&bs)[8] = cwv.bs;
#pragma unroll
    for (int i = 0; i < 4; ++i) { const int tl = tl0 + 32 * i;
        float u[8];
#pragma unroll
        for (int q = 0; q < 8; ++q) u[q] = bs[q];
#pragma unroll
        for (int k = 0; k < 4; ++k) { const int tt = c * LRU_T + tl + k - 2; const float mk = (tt >= 0 && tt < SEQ) ? 1.f : 0.f; const u32x4 v = raw[i][k];
            u[0] += mk * w[k][0] * bflo(v.x); u[1] += mk * w[k][1] * bfhi(v.x); u[2] += mk * w[k][2] * bflo(v.y); u[3] += mk * w[k][3] * bfhi(v.y);
            u[4] += mk * w[k][4] * bflo(v.z); u[5] += mk * w[k][5] * bfhi(v.z); u[6] += mk * w[k][6] * bflo(v.w); u[7] += mk * w[k][7] * bfhi(v.w); }
        u32x4 p; p.x = pk2(u[0], u[1]); p.y = pk2(u[2], u[3]); p.z = pk2(u[4], u[5]); p.w = pk2(u[6], u[7]);
        *(LAS u32x4*)(ubf + tl * 256 + ((cg ^ (tl & 15)) << 4)) = p; }
    if (special) {
        const bf16* AC = (const bf16*)(F.ws + WS_PC) + (size_t)b * CTX * DM + h * 128;
        if (F.tid < 32) { const int tl = LRU_T + (F.tid >> 4); const int t = tl == LRU_T ? 0 : CTX - 1;
            float u[8];
#pragma unroll
            for (int q = 0; q < 8; ++q) u[q] = bs[q];
#pragma unroll
            for (int k = 0; k < 4; ++k) { const int tt = t + k - 2;
                if (tt >= 0 && tt < CTX) { const u32x4 v = *(const u32x4*)(AC + (size_t)tt * DM + 8 * cg);
                    u[0] += w[k][0] * bflo(v.x); u[1] += w[k][1] * bfhi(v.x); u[2] += w[k][2] * bflo(v.y); u[3] += w[k][3] * bfhi(v.y);
                    u[4] += w[k][4] * bflo(v.z); u[5] += w[k][5] * bfhi(v.z); u[6] += w[k][6] * bflo(v.w); u[7] += w[k][7] * bfhi(v.w); } }
            u32x4 p; p.x = pk2(u[0], u[1]); p.y = pk2(u[2], u[3]); p.z = pk2(u[4], u[5]); p.w = pk2(u[6], u[7]);
            *(LAS u32x4*)(ubf + tl * 256 + ((cg ^ (tl & 15)) << 4)) = p;
        } else if (F.tid < 32 + 14 * 16) { const int tl = LRU_T + 2 + ((F.tid - 32) >> 4);
            *(LAS u32x4*)(ubf + tl * 256 + ((cg ^ (tl & 15)) << 4)) = (u32x4){0u, 0u, 0u, 0u}; }
    }
}
__device__ __forceinline__ void lru_tile_b(Frame& F, int m, const bf16x8 (&Bw)[2][4], const LruCoef& k, float (&av)[4], float (&bv)[4]) {
    const int fr = F.lane & 15, fq = F.lane >> 4;
    const LAS unsigned char* ubf = F.lds + LRU_UBF;
    f32x4 ar = {0.f, 0.f, 0.f, 0.f}, ai = {0.f, 0.f, 0.f, 0.f};
    const int row = m * 16 + fr;
#pragma unroll
    for (int kk = 0; kk < 4; ++kk) { const bf16x8 A = *(const LAS bf16x8*)(ubf + row * 256 + (((kk * 4 + fq) ^ fr) << 4));
        ar = __builtin_amdgcn_mfma_f32_16x16x32_bf16(A, Bw[0][kk], ar, 0, 0, 0); ai = __builtin_amdgcn_mfma_f32_16x16x32_bf16(A, Bw[1][kk], ai, 0, 0, 0); }
    const int n = 16 * F.wave + fr;
#pragma unroll
    for (int r = 0; r < 4; ++r) { const int tr = m * 16 + 4 * fq + r;
        const float u = bf2f(*(const LAS unsigned short*)(ubf + tr * 256 + (((n >> 3) ^ (tr & 15)) << 4) + (n & 7) * 2));
        const float rg = __builtin_amdgcn_rcpf(1.f + __builtin_amdgcn_exp2f(__builtin_fmaf(ar[r], -LOG2E, k.ba)));
        const float ig = __builtin_amdgcn_rcpf(1.f + __builtin_amdgcn_exp2f(__builtin_fmaf(ai[r], -LOG2E, k.bx)));
        const float aa = __builtin_amdgcn_exp2f(k.ca * rg);
        av[r] = aa; bv[r] = __builtin_amdgcn_sqrtf(__builtin_fmaf(-aa, aa, 1.f)) * (ig * u); }
}
__device__ __forceinline__ void lru_unit(Frame& F, const Args& a, int unit, const LruCoef& kf, const LruCoef& kb) {
    const int c = unit & (LRU_NCH - 1), h = (unit >> 4) & 7, b = unit >> 7, grp = unit >> 4;
    const int fr = F.lane & 15, fq = F.lane >> 4; const int ch = h * 128 + 16 * F.wave + fr;
    bf16* AY = (bf16*)(F.ws + WS_YAG) + ((size_t)b * SEQ + c * LRU_T) * DM + h * 128;
    bf16x8 Bw[2][4]; lru_load_w(F, 0, h, Bw);
    { u32x4 raw[4][4]; lru_conv_load(F, b, h, c, raw); LruConvW cwv; lru_conv_weights(F, a, h, cwv); lru_conv_b(F, cwv, raw, b, h, c, c == 0); }
    LAS unsigned char* priv = F.lds + LRU_PRIV + F.tid * 8;
    LDS_WAIT(); __syncthreads();
    float hf = 0.f, pf = 1.f, s0f = 0.f, s0b = 0.f;
#pragma unroll 2
    for (int m = 0; m < 8; ++m) {
        float av[4], bv[4];
        lru_tile_b(F, m, Bw, kf, av, bv);
        const float A = av[0] * av[1] * av[2] * av[3], B = ((bv[0] * av[1] + bv[1]) * av[2] + bv[2]) * av[3] + bv[3];
        float hin = hf, pin = pf;
#pragma unroll
        for (int g = 0; g < 4; ++g) { const float Ag = __shfl(A, g * 16 + fr), Bg = __shfl(B, g * 16 + fr); if (g < fq) { hin = Ag * hin + Bg; pin = Ag * pin; } hf = Ag * hf + Bg; pf = Ag * pf; }
        float pt[4], ht[4];
#pragma unroll
        for (int r = 0; r < 4; ++r) { hin = av[r] * hin + bv[r]; pin = av[r] * pin; ht[r] = hin; pt[r] = pin; }
        *(LAS u32x2*)(priv + m * 4096) = (u32x2){pk2(ht[0], ht[1]), pk2(ht[2], ht[3])};
        *(LAS u32x2*)(priv + 32768 + m * 4096) = (u32x2){pk2(pt[0], pt[1]), pk2(pt[2], pt[3])};
    }
    if (c == 0) { float av[4], bv[4]; lru_tile_b(F, 8, Bw, kf, av, bv); s0f = bv[0]; }
    lru_load_w(F, 1, h, Bw);
    float hb = 0.f, pbw = 1.f;
#pragma unroll 2
    for (int m = 7; m >= 0; --m) {
        float av[4], bv[4];
        lru_tile_b(F, m, Bw, kb, av, bv);
        const float A = av[0] * av[1] * av[2] * av[3], B = ((bv[3] * av[2] + bv[2]) * av[1] + bv[1]) * av[0] + bv[0];
        float hin = hb, pin = pbw;
#pragma unroll
        for (int g = 3; g >= 0; --g) { const float Ag = __shfl(A, g * 16 + fr), Bg = __shfl(B, g * 16 + fr); if (g > fq) { hin = Ag * hin + Bg; pin = Ag * pin; } hb = Ag * hb + Bg; pbw = Ag * pbw; }
        const u32x2 hfw = *(const LAS u32x2*)(priv + m * 4096);
        const float hfv[4] = {bflo(hfw.x), bfhi(hfw.x), bflo(hfw.y), bfhi(hfw.y)};
        float pt[4], ht[4];
#pragma unroll
        for (int r = 3; r >= 0; --r) { hin = av[r] * hin + bv[r]; pin = av[r] * pin; ht[r] = hin + hfv[r]; pt[r] = pin; }
        *(LAS u32x2*)(priv + m * 4096) = (u32x2){pk2(ht[0], ht[1]), pk2(ht[2], ht[3])};
        *(LAS u32x2*)(priv + 65536 + m * 4096) = (u32x2){pk2(pt[0], pt[1]), pk2(pt[2], pt[3])};
    }
    if (c == 0) { float av[4], bv[4]; lru_tile_b(F, 8, Bw, kb, av, bv); s0b = bv[1]; }
    unsigned long long* agg = (unsigned long long*)(F.ws + WS_LRUAGG); unsigned long long* s0 = (unsigned long long*)(F.ws + WS_LRUS0);
    if (fq == 0) {
        __hip_atomic_store(agg + (size_t)((b * LRU_NCH + c) * 2 + 0) * DM + ch, ((unsigned long long)__builtin_bit_cast(unsigned, hf) << 32) | __builtin_bit_cast(unsigned, pf + 1.f), __ATOMIC_RELAXED, __HIP_MEMORY_SCOPE_AGENT);
        __hip_atomic_store(agg + (size_t)((b * LRU_NCH + c) * 2 + 1) * DM + ch, ((unsigned long long)__builtin_bit_cast(unsigned, hb) << 32) | __builtin_bit_cast(unsigned, pbw + 1.f), __ATOMIC_RELAXED, __HIP_MEMORY_SCOPE_AGENT);
        if (c == 0) { __hip_atomic_store(s0 + (b * 2 + 0) * DM + ch, ((unsigned long long)__builtin_bit_cast(unsigned, s0f) << 32) | 0x3f800000u, __ATOMIC_RELAXED, __HIP_MEMORY_SCOPE_AGENT);
                      __hip_atomic_store(s0 + (b * 2 + 1) * DM + ch, ((unsigned long long)__builtin_bit_cast(unsigned, s0b) << 32) | 0x3f800000u, __ATOMIC_RELAXED, __HIP_MEMORY_SCOPE_AGENT); }
    }
    u32x4 gv[4];
#pragma unroll
    for (int i = 0; i < 4; ++i) { const u32x4 g = *(const u32x4*)(AY + (size_t)((F.tid >> 4) + 32 * i) * DM + 8 * (F.tid & 15));
        gv[i].x = pk2(gelu_tanh(bflo(g.x)), gelu_tanh(bfhi(g.x))); gv[i].y = pk2(gelu_tanh(bflo(g.y)), gelu_tanh(bfhi(g.y)));
        gv[i].z = pk2(gelu_tanh(bflo(g.z)), gelu_tanh(bfhi(g.z))); gv[i].w = pk2(gelu_tanh(bflo(g.w)), gelu_tanh(bfhi(g.w))); }
    float cf, cb;
    {
        unsigned long long ag[LRU_NCH], sf, sb; unsigned spins = 0;
        const unsigned long long* ab = agg + (size_t)(b * LRU_NCH * 2) * DM + ch;
        for (;;) {
            bool ok = true;
            sf = __hip_atomic_load(s0 + (b * 2 + 0) * DM + ch, __ATOMIC_RELAXED, __HIP_MEMORY_SCOPE_AGENT); sb = __hip_atomic_load(s0 + (b * 2 + 1) * DM + ch, __ATOMIC_RELAXED, __HIP_MEMORY_SCOPE_AGENT);
#pragma unroll
            for (int j = 0; j < LRU_NCH; ++j) ag[j] = j == c ? 1ull : __hip_atomic_load(ab + (size_t)(j * 2 + (j < c ? 0 : 1)) * DM, __ATOMIC_RELAXED, __HIP_MEMORY_SCOPE_AGENT);
            ok = ((unsigned)sf != 0u) && ((unsigned)sb != 0u);
#pragma unroll
            for (int j = 0; j < LRU_NCH; ++j) ok = ok && ((unsigned)ag[j] != 0u);
            if (__all(ok)) break;
            __builtin_amdgcn_s_sleep(1);
            if (++spins > (1u << 22)) { if (F.lane == 0) __hip_atomic_store(F.ctl + 3, 2u, __ATOMIC_RELAXED, __HIP_MEMORY_SCOPE_AGENT); break; }
        }
        cf = __builtin_bit_cast(float, (unsigned)(sf >> 32)); cb = __builtin_bit_cast(float, (unsigned)(sb >> 32));
#pragma unroll
        for (int j = 0; j < LRU_NCH; ++j) if (j < c) cf = (__builtin_bit_cast(float, (unsigned)ag[j]) - 1.f) * cf + __builtin_bit_cast(float, (unsigned)(ag[j] >> 32));
#pragma unroll
        for (int j = LRU_NCH - 1; j >= 0; --j) if (j > c) cb = (__builtin_bit_cast(float, (unsigned)ag[j]) - 1.f) * cb + __builtin_bit_cast(float, (unsigned)(ag[j] >> 32));
    }
    __syncthreads();
    { LAS unsigned char* ya = F.lds + LRU_UBF; const int n = 16 * F.wave + fr;
#pragma unroll 2
      for (int m = 0; m < 8; ++m) {
          const u32x2 hw = *(const LAS u32x2*)(priv + m * 4096), pfw = *(const LAS u32x2*)(priv + 32768 + m * 4096), pbw2 = *(const LAS u32x2*)(priv + 65536 + m * 4096);
          const float y0 = bflo(hw.x) + bflo(pfw.x) * cf + bflo(pbw2.x) * cb, y1 = bfhi(hw.x) + bfhi(pfw.x) * cf + bfhi(pbw2.x) * cb;
          const float y2 = bflo(hw.y) + bflo(pfw.y) * cf + bflo(pbw2.y) * cb, y3 = bfhi(hw.y) + bfhi(pfw.y) * cf + bfhi(pbw2.y) * cb;
          const unsigned w01 = pk2(y0, y1), w23 = pk2(y2, y3);
          const int t0 = m * 16 + 4 * fq;
          *(LAS unsigned short*)(ya + (t0 + 0) * 256 + (((n >> 3) ^ ((t0 + 0) & 15)) << 4) + (n & 7) * 2) = (unsigned short)w01;
          *(LAS unsigned short*)(ya + (t0 + 1) * 256 + (((n >> 3) ^ ((t0 + 1) & 15)) << 4) + (n & 7) * 2) = (unsigned short)(w01 >> 16);
          *(LAS unsigned short*)(ya + (t0 + 2) * 256 + (((n >> 3) ^ ((t0 + 2) & 15)) << 4) + (n & 7) * 2) = (unsigned short)w23;
          *(LAS unsigned short*)(ya + (t0 + 3) * 256 + (((n >> 3) ^ ((t0 + 3) & 15)) << 4) + (n & 7) * 2) = (unsigned short)(w23 >> 16); } }
    LDS_WAIT(); __syncthreads();
    const int cg = F.tid & 15;
#pragma unroll
    for (int i = 0; i < 4; ++i) { const int tl = (F.tid >> 4) + 32 * i;
        const u32x4 y = *(const LAS u32x4*)(F.lds + LRU_UBF + tl * 256 + ((cg ^ (tl & 15)) << 4));
        const u32x4 g = gv[i];
        u32x4 o; o.x = pk2(bflo(y.x) * bflo(g.x), bfhi(y.x) * bfhi(g.x)); o.y = pk2(bflo(y.y) * bflo(g.y), bfhi(y.y) * bfhi(g.y));
        o.z = pk2(bflo(y.z) * bflo(g.z), bfhi(y.z) * bfhi(g.z)); o.w = pk2(bflo(y.w) * bflo(g.w), bfhi(y.w) * bfhi(g.w));
        *(u32x4*)(AY + (size_t)tl * DM + 8 * cg) = o; }
    __syncthreads();
}
constexpr int HG_C = 64, HG_SEG = 512, HG_NSEG = 4;
constexpr int HG_QS = 0, HG_QM = 16384, HG_KM = 32768, HG_KDT = 49152, HG_VT = 65536, HG_ATT = 81920, HG_PART = 90112, HG_ETOT = 94208, HG_ROWS = 94720;
constexpr size_t HGS_IMG = 65536;

__device__ __forceinline__ int hg_row(int b, int dir, bool ctx, int sigma) {
    if (ctx) { const int t = dir ? (CTX - 1 - sigma) : sigma; return b * CTX + t; }
    const int p = dir ? (SEQ - 1 - sigma) : sigma; return b * SEQ + (p & 31) * 64 + (p >> 5);
}

struct HgRaw { unsigned f[8], v[8], q[8]; };
template <bool FULL>
__device__ __forceinline__ void hg_load(Frame& F, const bf16* Qb, const bf16* Fb, const bf16* Vb, int b, int dir, bool ctx, int sigma0, HgRaw& r) {
    const long step = (long)(ctx ? 1 : 64) * (dir ? -1 : 1) * DM;
    const size_t ro = (size_t)hg_row(b, dir, ctx, sigma0 + 8 * F.wave) * DM + 2 * F.lane;
    const bf16* fp = Fb + ro; const bf16* vp = Vb + ro; const bf16* qp = Qb + ro;
#pragma unroll
    for (int j = 0; j < 8; ++j) { r.f[j] = *(const unsigned*)(fp + j * step); r.v[j] = *(const unsigned*)(vp + j * step); if (FULL) r.q[j] = *(const unsigned*)(qp + j * step); }
}
template <bool FULL>
__device__ __forceinline__ void hg_prep(Frame& F, const HgRaw& raw, int b, int dir, bool ctx, int sigma0, float lb0, float lb1, float& gs0, float& gs1) {
    const int kp = F.lane, to = F.wave;
    const unsigned (&fw)[8] = raw.f; const unsigned (&qw)[8] = raw.q; const unsigned (&vw)[8] = raw.v;
    const f32x2 lbv = {lb0, lb1}, omlb = {1.f - lb0, 1.f - lb1};
    f32x2 cs[8], kk2[8]; f32x2 accv = {0.f, 0.f};
#pragma unroll
    for (int j = 0; j < 8; ++j) {
        const f32x2 x = (f32x2){bflo(fw[j]), bfhi(fw[j])} * (-LOG2E);
        const f32x2 d = (f32x2){__builtin_amdgcn_exp2f(x.x), __builtin_amdgcn_exp2f(x.y)} + 1.f;
        const f32x2 g = lbv + omlb * (f32x2){__builtin_amdgcn_rcpf(d.x), __builtin_amdgcn_rcpf(d.y)};
        kk2[j] = 1.f - g;
        accv += (f32x2){__builtin_amdgcn_logf(g.x), __builtin_amdgcn_logf(g.y)};
        cs[j] = accv; }
    const float a0 = accv.x, a1 = accv.y;
    LAS float* part = (LAS float*)(F.lds + HG_PART);
    *(LAS f32x2*)(part + to * 128 + 2 * kp) = (f32x2){a0, a1};
    if (FULL) HSTAMP(0);
    LDS_WAIT(); __syncthreads();
    if (FULL) HSTAMP(1);
    if (FULL && F.tid < HG_C) ((LAS int*)(F.lds + HG_ROWS))[F.tid] = hg_row(b, dir, ctx, sigma0 + F.tid);
    f32x2 offv = {0.f, 0.f}, totv = {0.f, 0.f};
#pragma unroll
    for (int o = 0; o < 8; ++o) { const f32x2 p = *(const LAS f32x2*)(part + o * 128 + 2 * kp);
        if (o < to) offv += p; totv += p; }
    gs0 += totv.x; gs1 += totv.y;
    if (to == 0) *(LAS f32x2*)((LAS float*)(F.lds + HG_ETOT) + 2 * kp) = (f32x2){__builtin_amdgcn_exp2f(totv.x), __builtin_amdgcn_exp2f(totv.y)};
    float kd0[8], kd1[8];
#pragma unroll
    for (int j = 0; j < 8; ++j) {
        const f32x2 G = offv + cs[j];
        const f32x2 E = {__builtin_amdgcn_exp2f(G.x), __builtin_amdgcn_exp2f(G.y)};
        const f32x2 kd = kk2[j] * (f32x2){__builtin_amdgcn_rcpf(E.x), __builtin_amdgcn_rcpf(E.y)};
        kd0[j] = kd.x; kd1[j] = kd.y;
        if (FULL) {
            const f32x2 q = {bflo(qw[j]), bfhi(qw[j])};
            const f32x2 xq = q * (-LOG2E);
            const f32x2 dq = (f32x2){__builtin_amdgcn_exp2f(xq.x), __builtin_amdgcn_exp2f(xq.y)} + 1.f;
            const f32x2 sv = q * (f32x2){__builtin_amdgcn_rcpf(dq.x), __builtin_amdgcn_rcpf(dq.y)} * E;
            const int c = 8 * to + j; const int off = c * 256 + (((4 * (kp >> 4) + ((kp >> 1) & 3)) ^ (c & 15)) << 4) + 8 * ((kp >> 3) & 1) + 4 * (kp & 1);
            *(LAS unsigned*)(F.lds + HG_QS + off) = pk2(sv.x, sv.y);
            *(LAS unsigned*)(F.lds + HG_KM + off) = pk2(kd.x, kd.y);
        }
    }
    { const int sw = ((to ^ (kp & 7)) << 4);
      u32x4 w0, w1; w0.x = pk2(kd0[0], kd0[1]); w0.y = pk2(kd0[2], kd0[3]); w0.z = pk2(kd0[4], kd0[5]); w0.w = pk2(kd0[6], kd0[7]);
      w1.x = pk2(kd1[0], kd1[1]); w1.y = pk2(kd1[2], kd1[3]); w1.z = pk2(kd1[4], kd1[5]); w1.w = pk2(kd1[6], kd1[7]);
      *(LAS u32x4*)(F.lds + HG_KDT + (2 * kp) * 128 + sw) = w0; *(LAS u32x4*)(F.lds + HG_KDT + (2 * kp + 1) * 128 + sw) = w1;
      u32x4 v0, v1;
      v0.x = (vw[0] & 0xffffu) | (vw[1] << 16); v0.y = (vw[2] & 0xffffu) | (vw[3] << 16); v0.z = (vw[4] & 0xffffu) | (vw[5] << 16); v0.w = (vw[6] & 0xffffu) | (vw[7] << 16);
      v1.x = (vw[0] >> 16) | (vw[1] & 0xffff0000u); v1.y = (vw[2] >> 16) | (vw[3] & 0xffff0000u); v1.z = (vw[4] >> 16) | (vw[5] & 0xffff0000u); v1.w = (vw[6] >> 16) | (vw[7] & 0xffff0000u);
      *(LAS u32x4*)(F.lds + HG_VT + (2 * kp) * 128 + sw) = v0; *(LAS u32x4*)(F.lds + HG_VT + (2 * kp + 1) * 128 + sw) = v1; }
    if (FULL) HSTAMP(2);
    LDS_WAIT(); __syncthreads();
    if (FULL) HSTAMP(3);
}
__device__ __forceinline__ void hg_state_update(Frame& F, f32x4 (&St)[8], const bf16x8 (&vt)[2]) {
    const int fr = F.lane & 15, fq = F.lane >> 4;
    const LAS float* etot = (const LAS float*)(F.lds + HG_ETOT);
#pragma unroll
    for (int kt = 0; kt < 8; ++kt) { const f32x4 e = *(const LAS f32x4*)(etot + 16 * kt + 4 * fq);
        const int rk = 16 * kt + fr;
#pragma unroll
        for (int ks = 0; ks < 2; ++ks) { const bf16x8 A = *(const LAS bf16x8*)(F.lds + HG_KDT + rk * 128 + (((4 * ks + fq) ^ ((rk >> 1) & 7)) << 4));
            St[kt] = __builtin_amdgcn_mfma_f32_16x16x32_bf16(A, vt[ks], St[kt], 0, 0, 0); }
        St[kt] = St[kt] * e; }
}
__device__ __forceinline__ void hg_load_vt(Frame& F, bf16x8 (&vt)[2]) {
    const int fr = F.lane & 15, fq = F.lane >> 4; const int rv = 16 * F.wave + fr;
#pragma unroll
    for (int ks = 0; ks < 2; ++ks) vt[ks] = *(const LAS bf16x8*)(F.lds + HG_VT + rv * 128 + (((4 * ks + fq) ^ ((rv >> 1) & 7)) << 4));
}
struct HgPtrs { const bf16* Q; const bf16* Fx; const bf16* V; const bf16* Fc; const bf16* Vc; bf16* O; };
__device__ __forceinline__ HgPtrs hg_ptrs(Frame& F, int h, int dir) {
    HgPtrs p; p.Q = (const bf16*)(F.ws + WS_P + 2 * GS) + h * 128; p.Fx = (const bf16*)(F.ws + WS_P + (dir ? 4 : 3) * GS) + h * 128; p.V = (const bf16*)(F.ws + WS_P + 5 * GS) + h * 128;
    p.Fc = (const bf16*)(F.ws + WS_PC + (dir ? 2 : 1) * CGS) + h * 128; p.Vc = (const bf16*)(F.ws + WS_PC + 3 * CGS) + h * 128; p.O = (bf16*)(F.ws + WS_P + (dir ? 4 : 3) * GS) + h * 128; return p;
}
__device__ __forceinline__ void hg_lb(const Args& a, int h, int kp, float& lb0, float& lb1) {
    const float* t = a.in[IN_HGLB] + h * 128 + 2 * kp; lb0 = 1.f / (1.f + expf(t[DM] - t[0])); lb1 = 1.f / (1.f + expf(t[DM + 1] - t[1]));
}
__device__ __forceinline__ float* hg_img(Frame& F, int b, int h, int dir, int slot) { return (float*)((unsigned char*)F.out + (size_t)((((b * 8 + h) * 2 + dir) * 4) + slot) * HGS_IMG); }

__device__ __forceinline__ void hg_pass1(Frame& F, const Args& a, int unit) {
    const int slot = unit & 3, dir = (unit >> 2) & 1, h = (unit >> 3) & 7, b = unit >> 6;
    const int fr = F.lane & 15, fq = F.lane >> 4;
    const HgPtrs P = hg_ptrs(F, h, dir);
    float lb0, lb1; hg_lb(a, h, F.lane, lb0, lb1);
    f32x4 St[8];
#pragma unroll
    for (int kt = 0; kt < 8; ++kt) St[kt] = (f32x4){0.f, 0.f, 0.f, 0.f};
    const bool ctx = slot == 0; const int nchunk = ctx ? CTX / HG_C : HG_SEG / HG_C; const int sig0 = ctx ? 0 : (slot - 1) * HG_SEG;
    float gs0 = 0.f, gs1 = 0.f;
    const bf16* Fsrc = ctx ? P.Fc : P.Fx; const bf16* Vsrc = ctx ? P.Vc : P.V;
    HgRaw cur; hg_load<false>(F, P.Q, Fsrc, Vsrc, b, dir, ctx, sig0, cur);
    for (int ck = 0; ck < nchunk; ++ck) {
        HgRaw nxt; { const int cn = ck + 1 < nchunk ? ck + 1 : ck; hg_load<false>(F, P.Q, Fsrc, Vsrc, b, dir, ctx, sig0 + cn * HG_C, nxt); }
        hg_prep<false>(F, cur, b, dir, ctx, sig0 + ck * HG_C, lb0, lb1, gs0, gs1);
        cur = nxt;
        bf16x8 vt[2]; hg_load_vt(F, vt);
        hg_state_update(F, St, vt);
    }
    float* img = hg_img(F, b, h, dir, slot) + (size_t)(16 * F.wave + fr) * 128 + 4 * fq;
#pragma unroll
    for (int kt = 0; kt < 8; ++kt) *(f32x4*)(img + 16 * kt) = St[kt];
    if (!ctx && F.wave == 0) { float* D = (float*)(F.ws + WS_HGD) + (size_t)((((b * 8 + h) * 2 + dir) * 3) + (slot - 1)) * 128 + 2 * F.lane;
        *(f32x2*)D = (f32x2){__builtin_amdgcn_exp2f(gs0), __builtin_amdgcn_exp2f(gs1)}; }
    __syncthreads();
}

constexpr int HG_HN = 95232;
__device__ __forceinline__ void hg_pass2(Frame& F, const Args& a, int unit) {
    const int seg = unit & 3, h = (unit >> 2) & 7, b = unit >> 5;
    const int fr = F.lane & 15, fq = F.lane >> 4, w = F.wave;
    float lb0, lb1; { int kp = F.lane; asm volatile("" : "+v"(kp)); hg_lb(a, h, kp, lb0, lb1); }
    const int lcol = h * 128 + 16 * w + 4 * fq;
#pragma unroll 1
    for (int dir = 0; dir < 2; ++dir) {
        HSTAMP(15);
        const int sseg = dir == 0 ? seg : 3 - seg;
        const HgPtrs P = hg_ptrs(F, h, dir);
        f32x4 St[8];
        {
            const float* img = hg_img(F, b, h, dir, 0) + (size_t)(16 * w + fr) * 128 + 4 * fq;
#pragma unroll
            for (int kt = 0; kt < 8; ++kt) St[kt] = *(const f32x4*)(img + 16 * kt);
            for (int j = 0; j < sseg; ++j) {
                const float* im = hg_img(F, b, h, dir, 1 + j) + (size_t)(16 * w + fr) * 128 + 4 * fq;
                const float* D = (const float*)(F.ws + WS_HGD) + (size_t)((((b * 8 + h) * 2 + dir) * 3) + j) * 128 + 4 * fq;
#pragma unroll
                for (int kt = 0; kt < 8; ++kt) { const f32x4 d = *(const f32x4*)(D + 16 * kt), dl = *(const f32x4*)(im + 16 * kt); St[kt] = St[kt] * d + dl; }
            }
        }
        float gs0 = 0.f, gs1 = 0.f;
        HSTAMP(9);
        for (int ck = 0; ck < HG_SEG / HG_C; ++ck) {
            { HgRaw cur; hg_load<true>(F, P.Q, P.Fx, P.V, b, dir, false, sseg * HG_SEG + ck * HG_C, cur);
              hg_prep<true>(F, cur, b, dir, false, sseg * HG_SEG + ck * HG_C, lb0, lb1, gs0, gs1); }
            const LAS int* rows = (const LAS int*)(F.lds + HG_ROWS);
            bf16* OFW = (bf16*)(F.ws + WS_OF) + lcol; asm volatile("" : "+v"(OFW));
            u32x2 ofw[4], ogv[4];
            if (dir == 1) {
                const bf16* OG = (const bf16*)(F.ws + WS_P + 6 * GS) + lcol; asm volatile("" : "+v"(OG));
#pragma unroll
                for (int ct = 0; ct < 4; ++ct) { const size_t ro = (size_t)rows[16 * ct + fr] * DM; ofw[ct] = *(const GAS u32x2*)(OFW + ro); ogv[ct] = *(const GAS u32x2*)(OG + ro); } }
#pragma unroll
            for (int tt = 0; tt < 2; ++tt) { const int t = w + 8 * tt, ct = t >> 2, st = t & 3;
                f32x4 acc = {0.f, 0.f, 0.f, 0.f};
                const int rs = 16 * st + fr, rc = 16 * ct + fr;
#pragma unroll
                for (int kk = 0; kk < 4; ++kk) { const bf16x8 A = *(const LAS bf16x8*)(F.lds + HG_KM + rs * 256 + (((4 * kk + fq) ^ fr) << 4));
                    const bf16x8 B = *(const LAS bf16x8*)(F.lds + HG_QS + rc * 256 + (((4 * kk + fq) ^ fr) << 4));
                    acc = __builtin_amdgcn_mfma_f32_16x16x32_bf16(A, B, acc, 0, 0, 0); }
                const int s0 = 16 * st + 4 * fq;
                const float m0 = (s0 + 0 <= rc) ? acc[0] : 0.f, m1 = (s0 + 1 <= rc) ? acc[1] : 0.f, m2 = (s0 + 2 <= rc) ? acc[2] : 0.f, m3 = (s0 + 3 <= rc) ? acc[3] : 0.f;
                *(LAS u32x2*)(F.lds + HG_ATT + rc * 128 + (((2 * st + (fq >> 1)) ^ ((rc >> 1) & 7)) << 4) + (fq & 1) * 8) = (u32x2){pk2(m0, m1), pk2(m2, m3)}; }
            f32x4 o[4];
#pragma unroll
            for (int ct = 0; ct < 4; ++ct) o[ct] = (f32x4){0.f, 0.f, 0.f, 0.f};
#pragma unroll
            for (int kk = 0; kk < 4; ++kk) {
                union { bf16x8 v; unsigned u[4]; } A;
                A.u[0] = pk2(St[2 * kk][0], St[2 * kk][1]); A.u[1] = pk2(St[2 * kk][2], St[2 * kk][3]); A.u[2] = pk2(St[2 * kk + 1][0], St[2 * kk + 1][1]); A.u[3] = pk2(St[2 * kk + 1][2], St[2 * kk + 1][3]);
#pragma unroll
                for (int ct = 0; ct < 4; ++ct) { const int rc = 16 * ct + fr;
                    const bf16x8 B = *(const LAS bf16x8*)(F.lds + HG_QS + rc * 256 + (((4 * kk + fq) ^ fr) << 4));
                    o[ct] = __builtin_amdgcn_mfma_f32_16x16x32_bf16(A.v, B, o[ct], 0, 0, 0); } }
            bf16x8 vt[2]; hg_load_vt(F, vt);
            HSTAMP(4);
            LDS_WAIT(); __syncthreads();
            HSTAMP(5);
#pragma unroll
            for (int ks = 0; ks < 2; ++ks)
#pragma unroll
                for (int ct = 0; ct < 4; ++ct) { const int rc = 16 * ct + fr;
                    const bf16x8 B = *(const LAS bf16x8*)(F.lds + HG_ATT + rc * 128 + (((4 * ks + fq) ^ ((rc >> 1) & 7)) << 4));
                    o[ct] = __builtin_amdgcn_mfma_f32_16x16x32_bf16(vt[ks], B, o[ct], 0, 0, 0); }
            if (dir == 0) {
#pragma unroll
                for (int ct = 0; ct < 4; ++ct) *(GAS u32x2*)(OFW + (size_t)rows[16 * ct + fr] * DM) = (u32x2){pk2(o[ct][0], o[ct][1]), pk2(o[ct][2], o[ct][3])};
                hg_state_update(F, St, vt);
                HSTAMP(6);
            } else {
                LAS float* hn = (LAS float*)(F.lds + HG_HN);
                int hni = h * 128 + 16 * w + 4 * fq; asm volatile("" : "+v"(hni));
                const f32x4 hn4 = *(const f32x4*)(a.in[IN_HGN] + hni);
#pragma unroll
                for (int ct = 0; ct < 4; ++ct) { o[ct][0] += bflo(ofw[ct].x); o[ct][1] += bfhi(ofw[ct].x); o[ct][2] += bflo(ofw[ct].y); o[ct][3] += bfhi(ofw[ct].y);
                    float ss = (o[ct][0] * o[ct][0] + o[ct][1] * o[ct][1]) + (o[ct][2] * o[ct][2] + o[ct][3] * o[ct][3]);
                    ss += __shfl_xor(ss, 16); ss += __shfl_xor(ss, 32);
                    if (fq == 0) hn[(16 * ct + fr) * 8 + w] = ss; }
                hg_state_update(F, St, vt);
                HSTAMP(6);
                LDS_WAIT(); __syncthreads();
#pragma unroll
                for (int ct = 0; ct < 4; ++ct) { const f32x4 p0 = *(const LAS f32x4*)(hn + (16 * ct + fr) * 8), p1 = *(const LAS f32x4*)(hn + (16 * ct + fr) * 8 + 4);
                    const float rsn = rsqrtf(((p0.x + p0.y) + (p0.z + p0.w) + (p1.x + p1.y) + (p1.z + p1.w)) * (1.f / 128.f) + EPS);
                    const float g0 = bflo(ogv[ct].x), g1 = bfhi(ogv[ct].x), g2 = bflo(ogv[ct].y), g3 = bfhi(ogv[ct].y);
                    const float y0 = o[ct][0] * rsn * hn4.x * siluf_(g0), y1 = o[ct][1] * rsn * hn4.y * siluf_(g1), y2 = o[ct][2] * rsn * hn4.z * siluf_(g2), y3 = o[ct][3] * rsn * hn4.w * siluf_(g3);
                    *(GAS u32x2*)(OFW + (size_t)rows[16 * ct + fr] * DM) = (u32x2){pk2(y0, y1), pk2(y2, y3)}; }
                HSTAMP(7);
            }
        }
        VM_WAIT(); __syncthreads();
        HSTAMP(8);
    }
}
__device__ __forceinline__ void p_ybg(Frame& F, const Args& a) {
    const bf16* OFp = (const bf16*)(F.ws + WS_OF); const bf16* OBp = (const bf16*)(F.ws + WS_OB); const bf16* OG = (const bf16*)(F.ws + WS_P + 6 * GS);
    bf16* YBG = (bf16*)(F.ws + WS_YBG); const float* hgn = a.in[IN_HGN];
    const int gw = F.bid * NWAVES + F.wave, NGW = F.G * NWAVES;
    for (int row = gw; row < NTOK; row += 2 * NGW) {
        u32x4 fv[2][2], bv[2][2], gvv[2][2];
#pragma unroll
        for (int rr = 0; rr < 2; ++rr)
#pragma unroll
            for (int j = 0; j < 2; ++j) { const size_t o = (size_t)(row + rr * NGW) * DM + 8 * F.lane + 512 * j;
                fv[rr][j] = *(const u32x4*)(OFp + o); bv[rr][j] = *(const u32x4*)(OBp + o); gvv[rr][j] = *(const u32x4*)(OG + o); }
#pragma unroll
        for (int rr = 0; rr < 2; ++rr)
#pragma unroll
        for (int j = 0; j < 2; ++j) { const int k = 8 * F.lane + 512 * j; const size_t o = (size_t)(row + rr * NGW) * DM + k;
            const u32x4 f = fv[rr][j], b = bv[rr][j], g = gvv[rr][j];
            float v[8]; v[0] = bflo(f.x) + bflo(b.x); v[1] = bfhi(f.x) + bfhi(b.x); v[2] = bflo(f.y) + bflo(b.y); v[3] = bfhi(f.y) + bfhi(b.y);
            v[4] = bflo(f.z) + bflo(b.z); v[5] = bfhi(f.z) + bfhi(b.z); v[6] = bflo(f.w) + bflo(b.w); v[7] = bfhi(f.w) + bfhi(b.w);
            float ss = 0.f;
#pragma unroll
            for (int q = 0; q < 8; ++q) ss += v[q] * v[q];
            ss += __shfl_xor(ss, 1); ss += __shfl_xor(ss, 2); ss += __shfl_xor(ss, 4); ss += __shfl_xor(ss, 8);
            const float rs = rsqrtf(ss * (1.f / 128.f) + EPS);
            float gv[8]; gv[0] = bflo(g.x); gv[1] = bfhi(g.x); gv[2] = bflo(g.y); gv[3] = bfhi(g.y); gv[4] = bflo(g.z); gv[5] = bfhi(g.z); gv[6] = bflo(g.w); gv[7] = bfhi(g.w);
            const f32x4 h0 = *(const f32x4*)(hgn + k), h1 = *(const f32x4*)(hgn + k + 4);
            const float hv[8] = {h0.x, h0.y, h0.z, h0.w, h1.x, h1.y, h1.z, h1.w};
            float r[8];
#pragma unroll
            for (int q = 0; q < 8; ++q) r[q] = v[q] * rs * hv[q] * siluf_(gv[q]);
            u32x4 w; w.x = pk2(r[0], r[1]); w.y = pk2(r[2], r[3]); w.z = pk2(r[4], r[5]); w.w = pk2(r[6], r[7]);
            *(u32x4*)(YBG + o) = w; }
    }
}
__device__ __forceinline__ void p_moe_weights13(Frame& F, const Args& a) {
    LAS float* scr = (LAS float*)(F.lds + F.wave * TR_BYTES);
    const int gw = F.bid * NWAVES + F.wave, NGW = F.G * NWAVES;
    for (int it = gw; it < NEXP * 256; it += NGW) {
        const int e = it >> 8, r = it & 255, w = r >> 7, q = r & 127, kb = q >> 3, nb = q & 7;
        transpose_item(a.in[w == 0 ? IN_W1 : IN_W3] + (size_t)e * DM * DEXP, DEXP, DM, (bf16*)(F.ws + (w == 0 ? WS_W1T : WS_W3T)) + ((size_t)e * DEXP + nb * 64) * DM, kb * 64, nb * 64, scr, F.lane);
    }
}
__device__ __forceinline__ void p_moe_weights2(Frame& F, const Args& a, int rank, int nwg) {
    LAS float* scr = (LAS float*)(F.lds + F.wave * TR_BYTES);
    for (int it = rank * NWAVES + F.wave; it < NEXP * 128; it += nwg * NWAVES) {
        const int e = it >> 7, q = it & 127, kb = q >> 4, nb = q & 15;
        transpose_item(a.in[IN_W2] + (size_t)e * DEXP * DM, DM, DEXP, (bf16*)(F.ws + WS_W2T) + ((size_t)e * DM + nb * 64) * DEXP, kb * 64, nb * 64, scr, F.lane);
    }
}

struct SchedP5 {
    int c; const char* YAG; const char* YBG; const char* WA; const char* WB; char* stash; char* M; int i0, n;
    __device__ __forceinline__ bool next(int i, gm::Unit& u) const {
        if (i >= n) return false;
        i += i0;
        int pm, pn; tile_order(c, 64, 4, pm, pn);
        u.A = (i == 0 ? YAG : YBG) + (size_t)pm * 256 * 2048; u.B0 = (i == 0 ? WA : WB) + (size_t)pn * 256 * 2048; u.B1 = u.B0 + (size_t)128 * 2048;
        u.dst = M + ((size_t)pm * 256 * DM + pn * 256) * 2; u.pm = pm; u.pn = pn; u.e = i; u.rows = 256; return true;
    }
    __device__ __forceinline__ unsigned arow(const gm::Unit&, int r) const { return (unsigned)r; }
};
struct EpiP5 {
    static constexpr bool PERM = true;
    unsigned* stash; const bf16* GA; const bf16* GB;
    __device__ __forceinline__ void operator()(const f32x4 (&acc)[2][2][4][2], const gm::Unit& u, int wr, int wc, int fr, int fq) const {
        const bf16* G = (u.e == 0 ? GA : GB) + ((size_t)u.pm * 256 + wr * 64 + fr) * DM + u.pn * 256 + wc * 32 + 8 * fq;
        bf16* Mb = (bf16*)u.dst + (size_t)(wr * 64 + fr) * DM + wc * 32 + 8 * fq;
        u32x4* st = (u32x4*)stash + threadIdx.x;
        asm volatile("" : "+v"(G), "+v"(Mb), "+v"(st));
#pragma unroll
        for (int ai = 0; ai < 2; ++ai)
#pragma unroll
            for (int m = 0; m < 4; ++m) {
                u32x4 g[2], s[2];
#pragma unroll
                for (int bj = 0; bj < 2; ++bj) { const size_t ro = (size_t)(ai * 128 + m * 16) * DM + bj * 128; const int si = (ai * 4 + m) * 2 + bj;
                    g[bj] = *(const GAS u32x4*)(G + ro);
                    if (u.e != 0) s[bj] = *(const GAS u32x4*)(st + (size_t)si * NTHR); }
#pragma unroll
                for (int bj = 0; bj < 2; ++bj) { const size_t ro = (size_t)(ai * 128 + m * 16) * DM + bj * 128; const int si = (ai * 4 + m) * 2 + bj;
                    f32x4 v0 = acc[ai][bj][m][0], v1 = acc[ai][bj][m][1];
                    v0[0] *= sigmoidf_(bflo(g[bj].x)); v0[1] *= sigmoidf_(bfhi(g[bj].x)); v0[2] *= sigmoidf_(bflo(g[bj].y)); v0[3] *= sigmoidf_(bfhi(g[bj].y));
                    v1[0] *= sigmoidf_(bflo(g[bj].z)); v1[1] *= sigmoidf_(bfhi(g[bj].z)); v1[2] *= sigmoidf_(bflo(g[bj].w)); v1[3] *= sigmoidf_(bfhi(g[bj].w));
                    if (u.e != 0) { v0[0] += bflo(s[bj].x); v0[1] += bfhi(s[bj].x); v0[2] += bflo(s[bj].y); v0[3] += bfhi(s[bj].y);
                                    v1[0] += bflo(s[bj].z); v1[1] += bfhi(s[bj].z); v1[2] += bflo(s[bj].w); v1[3] += bfhi(s[bj].w); }
                    u32x4 w; w.x = gm::cvt_pk_bf16(v0[0], v0[1]); w.y = gm::cvt_pk_bf16(v0[2], v0[3]); w.z = gm::cvt_pk_bf16(v1[0], v1[1]); w.w = gm::cvt_pk_bf16(v1[2], v1[3]);
                    if (u.e == 0) *(GAS u32x4*)(st + (size_t)si * NTHR) = w; else *(GAS u32x4*)(Mb + ro) = w; }
                asm volatile("" ::: "memory"); }
    }
};

struct SchedP6 {
    int c; const char* M; const char* W; char* X1;
    __device__ __forceinline__ bool next(int i, gm::Unit& u) const {
        if (i >= 1) return false;
        int pm, pn; tile_order(c, 64, 4, pm, pn);
        u.A = M + (size_t)pm * 256 * 2048; u.B0 = W + (size_t)pn * 256 * 2048; u.B1 = u.B0 + (size_t)128 * 2048;
        u.dst = X1 + ((size_t)pm * 256 * DM + pn * 256) * 2; u.pm = pm; u.pn = pn; u.e = 0; u.rows = 256; return true;
    }
    __device__ __forceinline__ unsigned arow(const gm::Unit&, int r) const { return (unsigned)r; }
};
struct EpiP6 {
    static constexpr bool PERM = false;
    const float* x; const float* mod;
    __device__ __forceinline__ void operator()(const f32x4 (&acc)[2][2][4][2], const gm::Unit& u, int wr, int wc, int fr, int fq) const {
        const int b = u.pm >> 3; const int col0 = u.pn * 256 + wc * 32 + 4 * fq;
        const float* mg = mod + b * 6144 + 2 * DM + col0;
        f32x4 gv[2][2];
#pragma unroll
        for (int bj = 0; bj < 2; ++bj)
#pragma unroll
            for (int n = 0; n < 2; ++n) gv[bj][n] = *(const GAS f32x4*)(mg + bj * 128 + n * 16);
#pragma unroll
        for (int ai = 0; ai < 2; ++ai)
#pragma unroll
            for (int m = 0; m < 4; ++m) { const size_t ro = (size_t)(wr * 64 + fr + ai * 128 + m * 16) * DM + wc * 32 + 4 * fq;
                const float* xr = x + ((size_t)u.pm * 256 * DM + u.pn * 256) + ro; bf16* orow = (bf16*)u.dst + ro;
#pragma unroll
                for (int bj = 0; bj < 2; ++bj)
#pragma unroll
                    for (int n = 0; n < 2; ++n) { const f32x4 xv = *(const GAS f32x4*)(xr + bj * 128 + n * 16);
                        const f32x4 o = xv + gv[bj][n] * acc[ai][bj][m][n];
                        *(GAS u32x2*)(orow + bj * 128 + n * 16) = (u32x2){pk2(o.x, o.y), pk2(o.z, o.w)}; } }
    }
};

__device__ __forceinline__ void p_norm2_route(Frame& F, const Args& a) {
    const float* mod = (const float*)(F.ws + WS_MOD); const float* g2 = a.in[IN_G2]; const float* wrp = (const float*)(F.ws + WS_WRT);
    const bf16* X1 = (const bf16*)(F.ws + WS_X1); bf16* HX2 = (bf16*)(F.ws + WS_HX2);
    int* list = (int*)(F.ws + WS_LIST); float* wt = (float*)(F.ws + WS_WT); unsigned* cnt = F.ctl + CW_CNT;
    LAS float* gs = (LAS float*)F.lds; LAS float* sh = gs + DM; LAS float* rst = sh + DM; LAS float* lgs = rst + 64;
    const int b = F.bid / 32;
    for (int k = F.tid; k < DM; k += NTHR) { gs[k] = g2[k] * (1.f + mod[b * 6144 + 4 * DM + k]); sh[k] = mod[b * 6144 + 3 * DM + k]; }
    __syncthreads();
    for (int r = F.wave; r < 64; r += NWAVES) {
        const int tok = F.bid * 64 + r;
        const u32x2* xr = (const u32x2*)(X1 + (size_t)tok * DM) + F.lane;
        f32x4 v[4]; float s = 0.f;
#pragma unroll
        for (int j = 0; j < 4; ++j) { const u32x2 xw = xr[64 * j]; v[j] = (f32x4){bflo(xw.x), bfhi(xw.x), bflo(xw.y), bfhi(xw.y)}; s += (v[j].x * v[j].x + v[j].y * v[j].y) + (v[j].z * v[j].z + v[j].w * v[j].w); }
        const float rstd = rsqrtf(wave_sum(s) * (1.f / DM) + EPS);
        if (F.lane == 0) rst[r] = rstd;
        unsigned long long* o8 = (unsigned long long*)(HX2 + (size_t)tok * DM) + F.lane;
#pragma unroll
        for (int j = 0; j < 4; ++j) { const int k = 4 * F.lane + 256 * j;
            const f32x4 g = *(const LAS f32x4*)(gs + k), h = *(const LAS f32x4*)(sh + k);
            o8[64 * j] = (unsigned long long)pk2(v[j].x * rstd * g.x + h.x, v[j].y * rstd * g.y + h.y) | ((unsigned long long)pk2(v[j].z * rstd * g.z + h.z, v[j].w * rstd * g.w + h.w) << 32); }
    }
    LDS_WAIT(); __syncthreads();
    {
        const int tq = F.lane & 15, kq = F.lane >> 4, wg = F.wave & 3, kh = F.wave >> 2; const int tl = wg * 16 + tq;
        const float rs = rst[tl];
        const bf16* xr = X1 + (size_t)(F.bid * 64 + tl) * DM + 4 * kq + 512 * kh;
        const f32x4* wp = (const f32x4*)wrp + F.lane + (size_t)kh * 32 * 3 * 64;
        const LAS float* gsp = gs + 512 * kh + 4 * kq; const LAS float* shp = sh + 512 * kh + 4 * kq;
        f32x4 acc[3];
#pragma unroll
        for (int c = 0; c < 3; ++c) acc[c] = (f32x4){0.f, 0.f, 0.f, 0.f};
#pragma unroll 8
        for (int s = 0; s < 32; ++s) {
            const u32x2 xw = *(const u32x2*)(xr + 16 * s); const f32x4 x = {bflo(xw.x), bfhi(xw.x), bflo(xw.y), bfhi(xw.y)}; const f32x4 g = *(const LAS f32x4*)(gsp + 16 * s), h = *(const LAS f32x4*)(shp + 16 * s);
            const f32x4 hv = x * rs * g + h;
#pragma unroll
            for (int c = 0; c < 3; ++c) { const f32x4 w = wp[(s * 3 + c) * 64];
                acc[c] = __builtin_amdgcn_mfma_f32_16x16x4f32(hv[0], w[0], acc[c], 0, 0, 0); acc[c] = __builtin_amdgcn_mfma_f32_16x16x4f32(hv[1], w[1], acc[c], 0, 0, 0);
                acc[c] = __builtin_amdgcn_mfma_f32_16x16x4f32(hv[2], w[2], acc[c], 0, 0, 0); acc[c] = __builtin_amdgcn_mfma_f32_16x16x4f32(hv[3], w[3], acc[c], 0, 0, 0); }
        }
#pragma unroll
        for (int c = 0; c < 3; ++c)
#pragma unroll
            for (int r = 0; r < 4; ++r) lgs[kh * 64 * 48 + (wg * 16 + 4 * kq + r) * 48 + 16 * c + tq] = acc[c][r];
    }
    LDS_WAIT(); __syncthreads();
    LAS unsigned* lcnt = (LAS unsigned*)(lgs + 2 * 64 * 48); LAS unsigned* lbase = lcnt + 32;
    if (F.tid < 32) lcnt[F.tid] = 0u;
    LDS_WAIT(); __syncthreads();
    int ea = 0, eb = 0; unsigned ra = 0u, rb = 0u; int tok = 0; float w1 = 0.f, w2 = 0.f;
    const bool picker = F.wave < 4 && F.lane < 16;
    if (picker) {
        const LAS float* lp = lgs + (F.wave * 16 + F.lane) * 48; tok = F.bid * 64 + F.wave * 16 + F.lane;
        float lg[36];
#pragma unroll
        for (int q = 0; q < 9; ++q) { const f32x4 t4 = *(const LAS f32x4*)(lp + 4 * q) + *(const LAS f32x4*)(lp + 64 * 48 + 4 * q) + *(const f32x4*)(wrp + 49152 + 4 * q);
            lg[4 * q] = t4.x; lg[4 * q + 1] = t4.y; lg[4 * q + 2] = t4.z; lg[4 * q + 3] = t4.w; }
        float mx = lg[0]; int gi = 0;
#pragma unroll
        for (int g = 1; g < 4; ++g) if (lg[g] > mx) { mx = lg[g]; gi = g; }
        float z = 0.f;
#pragma unroll
        for (int g = 0; g < 4; ++g) z += __expf(lg[g] - mx);
        const float pg = 1.f / z;
        float el[8];
#pragma unroll
        for (int e = 0; e < 8; ++e) el[e] = gi == 0 ? lg[4 + e] : (gi == 1 ? lg[12 + e] : (gi == 2 ? lg[20 + e] : lg[28 + e]));
        int e1 = 0; float m1 = el[0];
#pragma unroll
        for (int e = 1; e < 8; ++e) if (el[e] > m1) { m1 = el[e]; e1 = e; }
        int e2 = 0; float m2 = -3.0e38f;
#pragma unroll
        for (int e = 0; e < 8; ++e) if (e != e1 && el[e] > m2) { m2 = el[e]; e2 = e; }
        const float rr = __expf(m2 - m1); w1 = pg / (1.f + rr); w2 = pg * rr / (1.f + rr);
        ea = gi * 8 + e1; eb = gi * 8 + e2;
        ra = __hip_atomic_fetch_add(lcnt + ea, 1u, __ATOMIC_RELAXED, __HIP_MEMORY_SCOPE_WORKGROUP);
        rb = __hip_atomic_fetch_add(lcnt + eb, 1u, __ATOMIC_RELAXED, __HIP_MEMORY_SCOPE_WORKGROUP);
    }
    LDS_WAIT(); __syncthreads();
    if (F.tid < 32) { const unsigned n = lcnt[F.tid]; lbase[F.tid] = n ? __hip_atomic_fetch_add(cnt + 64 * F.tid, n, __ATOMIC_RELAXED, __HIP_MEMORY_SCOPE_AGENT) : 0u; }
    LDS_WAIT(); __syncthreads();
    if (picker) {
        list[(size_t)ea * CAP + lbase[ea] + ra] = tok * 2; wt[tok * 2] = w1;
        list[(size_t)eb * CAP + lbase[eb] + rb] = tok * 2 + 1; wt[tok * 2 + 1] = w2;
    }
}

__device__ __forceinline__ void moe_table(Frame& F, const int* cntv) {
    if (F.wave == 0) { const int lane = F.lane; const int cnt = lane < NEXP ? cntv[64 * lane] : 0;
        const int t = (cnt + 255) >> 8; int ti = t, oi = cnt;
#pragma unroll
        for (int d = 1; d < 32; d <<= 1) { const int tu = __shfl_up(ti, d), ou = __shfl_up(oi, d); if ((lane & 31) >= d) { ti += tu; oi += ou; } }
        if (lane < NEXP) { F.MISC[128 + lane] = (unsigned)cnt; F.MISC[160 + lane] = (unsigned)(ti - t); F.MISC[192 + lane] = (unsigned)(oi - cnt); }
        if (lane == NEXP - 1) F.MISC[224] = (unsigned)ti; }
    LDS_WAIT(); __syncthreads();
}
__device__ __forceinline__ bool moe_find(volatile LAS unsigned* MISC, int lane, int T, int& e, int& rt, int& rows, int& off) {
    if (T >= (int)MISC[224]) return false;
    const int l = lane & 31; const int cnt = (int)MISC[128 + l], tpre = (int)MISC[160 + l];
    const unsigned long long mask = __ballot(lane < NEXP && cnt > 0 && T >= tpre);
    e = __builtin_amdgcn_readfirstlane(63 - __builtin_clzll(mask));
    rt = T - (int)MISC[160 + e]; const int c = (int)MISC[128 + e]; off = (int)MISC[192 + e];
    rows = c - rt * 256; if (rows > 256) rows = 256; return true;
}
struct SchedMoe1 {
    int G, c, lane; volatile LAS unsigned* MISC; const int* list; const char* HX2; const char* W1T; const char* W3T; char* HH; unsigned* tile_cnt;
    __device__ __forceinline__ bool next(int i, gm::Unit& u) const {
        const int vc = (c & 7) * (G >> 3) + (c >> 3);
        const int L = i * G + vc; int e, rt, rows, off; if (!moe_find(MISC, lane, L >> 2, e, rt, rows, off)) return false;
        const int pn = L & 3;
        e = __builtin_amdgcn_readfirstlane(e); rt = __builtin_amdgcn_readfirstlane(rt); rows = __builtin_amdgcn_readfirstlane(rows); off = __builtin_amdgcn_readfirstlane(off);
        u.A = HX2; u.B0 = W1T + ((size_t)e * DEXP + pn * 128) * 2048; u.B1 = W3T + ((size_t)e * DEXP + pn * 128) * 2048;
        u.dst = HH + ((size_t)(off + rt * 256) * DEXP + pn * 128) * 2; u.pm = rt; u.pn = pn; u.e = e; u.rows = rows; u.t = L >> 2; return true;
    }
    __device__ __forceinline__ unsigned arow(const gm::Unit& u, int r) const { const int rr = r < u.rows ? r : u.rows - 1; return (unsigned)(list[(size_t)u.e * CAP + u.pm * 256 + rr] >> 1); }
    __device__ __forceinline__ void a_ready(const gm::Unit&) const {}
    __device__ __forceinline__ void done(const gm::Unit& u) const {
        asm volatile("s_waitcnt vmcnt(0)" ::: "memory");
        __builtin_amdgcn_s_barrier(); asm volatile("" ::: "memory");
        if (threadIdx.x == 0) __hip_atomic_fetch_add(tile_cnt + 8 * u.t, 1u, __ATOMIC_RELAXED, __HIP_MEMORY_SCOPE_AGENT);
    }
};
struct EpiMoe1 {
    static constexpr bool PERM = true;
    char* HH;
    __device__ __forceinline__ void operator()(const f32x4 (&acc)[2][2][4][2], const gm::Unit& u, int wr, int wc, int fr, int fq) const {
        const __amdgpu_buffer_rsrc_t rs = __builtin_amdgcn_make_buffer_rsrc((void*)HH, 0, 0x7fffffff, 0x00020000);
        const unsigned base = (unsigned)(u.dst - HH) + (unsigned)(((wr * 64 + fr) * DEXP + wc * 32 + 8 * fq) * 2);
#pragma unroll
        for (int ai = 0; ai < 2; ++ai)
#pragma unroll
            for (int m = 0; m < 4; ++m) { const int r = ai * 128 + wr * 64 + m * 16 + fr; if (r >= u.rows) continue;
                const f32x4 u0 = acc[ai][0][m][0], u1 = acc[ai][0][m][1], v0 = acc[ai][1][m][0], v1 = acc[ai][1][m][1];
                u32x4 w; w.x = gm::cvt_pk_bf16(siluf_(u0[0]) * v0[0], siluf_(u0[1]) * v0[1]); w.y = gm::cvt_pk_bf16(siluf_(u0[2]) * v0[2], siluf_(u0[3]) * v0[3]);
                w.z = gm::cvt_pk_bf16(siluf_(u1[0]) * v1[0], siluf_(u1[1]) * v1[1]); w.w = gm::cvt_pk_bf16(siluf_(u1[2]) * v1[2], siluf_(u1[3]) * v1[3]);
                __builtin_amdgcn_raw_buffer_store_b128(w, rs, base + (unsigned)((ai * 128 + m * 16) * DEXP * 2), 0, 16); }
    }
};
struct SchedMoe2 {
    int G, c, lane; volatile LAS unsigned* MISC; const char* HH; const char* W2T; char* Y; unsigned* tile_cnt; unsigned* tmo;
    __device__ __forceinline__ bool next(int i, gm::Unit& u) const {
        const int vc = (c & 7) * (G >> 3) + (c >> 3);
        const int U = 4 * (int)MISC[224], q = U / G, r = U % G;
        const bool rebal = q >= 1 && r > 0 && 3 * r <= G;
        int L = i * G + (G - 1 - vc);
        if (rebal) {
            if (vc < r) { if (i >= q - 1) return false; }
            else if (vc < 2 * r) { if (i == q) L = (q - 1) * G + (G - 1 - (vc - r)); else if (i > q) return false; }
        }
        int e, rt, rows, off; if (!moe_find(MISC, lane, L >> 2, e, rt, rows, off)) return false;
        const int pn = L & 3;
        e = __builtin_amdgcn_readfirstlane(e); rt = __builtin_amdgcn_readfirstlane(rt); rows = __builtin_amdgcn_readfirstlane(rows); off = __builtin_amdgcn_readfirstlane(off);
        u.A = HH + (size_t)(off + rt * 256) * DEXP * 2; u.B0 = W2T + ((size_t)e * DM + pn * 256) * (DEXP * 2); u.B1 = u.B0 + (size_t)128 * (DEXP * 2);
        u.dst = Y + (size_t)pn * 256 * 2; u.pm = rt; u.pn = pn; u.e = e; u.rows = rows; u.t = L >> 2; return true;
    }
    __device__ __forceinline__ unsigned arow(const gm::Unit&, int r) const { return (unsigned)r; }
    __device__ __forceinline__ void a_ready(const gm::Unit& u) const {
        if (threadIdx.x < 64) {
            unsigned spins = 0;
            while ((unsigned)__builtin_amdgcn_readfirstlane(__hip_atomic_load(tile_cnt + 8 * u.t, __ATOMIC_RELAXED, __HIP_MEMORY_SCOPE_AGENT)) < 4u) {
                __builtin_amdgcn_s_sleep(2);
                if (++spins > (1u << 22)) { if (threadIdx.x == 0) __hip_atomic_store(tmo, 1u, __ATOMIC_RELAXED, __HIP_MEMORY_SCOPE_AGENT); break; } }
            __builtin_amdgcn_fence(__ATOMIC_ACQUIRE, "agent");
            asm volatile("s_waitcnt vmcnt(0)" ::: "memory");
        }
        asm volatile("" ::: "memory"); __builtin_amdgcn_s_barrier(); asm volatile("" ::: "memory");
    }
    __device__ __forceinline__ void done(const gm::Unit&) const {}
};
struct EpiMoe2 {
    static constexpr bool PERM = true;
    const int* list;
    __device__ __forceinline__ void operator()(const f32x4 (&acc)[2][2][4][2], const gm::Unit& u, int wr, int wc, int fr, int fq) const {
        const int* lp = list + (size_t)u.e * CAP + u.pm * 256;
#pragma unroll
        for (int ai = 0; ai < 2; ++ai)
#pragma unroll
            for (int m = 0; m < 4; ++m) { const int r = ai * 128 + wr * 64 + m * 16 + fr; if (r >= u.rows) continue;
                const int slot = lp[r]; bf16* rowp = (bf16*)u.dst + (size_t)slot * DM + wc * 32 + 8 * fq;
#pragma unroll
                for (int bj = 0; bj < 2; ++bj) { const f32x4 v0 = acc[ai][bj][m][0], v1 = acc[ai][bj][m][1];
                    u32x4 w; w.x = gm::cvt_pk_bf16(v0[0], v0[1]); w.y = gm::cvt_pk_bf16(v0[2], v0[3]); w.z = gm::cvt_pk_bf16(v1[0], v1[1]); w.w = gm::cvt_pk_bf16(v1[2], v1[3]);
                    *(u32x4*)(rowp + bj * 128) = w; } }
    }
};

__device__ __forceinline__ void p_final(Frame& F, const Args& a) {
    const float* mod = (const float*)(F.ws + WS_MOD); const float* fg = a.in[IN_FG]; const float* wt = (const float*)(F.ws + WS_WT);
    const bf16* Y = (const bf16*)(F.ws + WS_Y); const bf16* X1 = (const bf16*)(F.ws + WS_X1); float* OUT = F.out;
    for (int r = F.wave; r < 64; r += NWAVES) {
        const int tok = F.bid * 64 + r; const int b = tok >> 11;
        const float w0 = wt[tok * 2], w1 = wt[tok * 2 + 1];
        const u32x2* xr = (const u32x2*)(X1 + (size_t)tok * DM) + F.lane; f32x4* orow = (f32x4*)(OUT + (size_t)tok * DM) + F.lane;
        const u32x2* y0 = (const u32x2*)(Y + (size_t)(tok * 2) * DM) + F.lane; const u32x2* y1 = (const u32x2*)(Y + (size_t)(tok * 2 + 1) * DM) + F.lane;
        f32x4 v[4]; float s = 0.f;
#pragma unroll
        for (int j = 0; j < 4; ++j) { const int k = 4 * F.lane + 256 * j;
            const u32x2 xw = xr[64 * j]; const f32x4 xv = {bflo(xw.x), bfhi(xw.x), bflo(xw.y), bfhi(xw.y)}; const u32x2 a0 = y0[64 * j], a1 = y1[64 * j]; const f32x4 g5 = *(const f32x4*)(mod + b * 6144 + 5 * DM + k);
            v[j].x = xv.x + g5.x * (w0 * bflo(a0.x) + w1 * bflo(a1.x)); v[j].y = xv.y + g5.y * (w0 * bfhi(a0.x) + w1 * bfhi(a1.x));
            v[j].z = xv.z + g5.z * (w0 * bflo(a0.y) + w1 * bflo(a1.y)); v[j].w = xv.w + g5.w * (w0 * bfhi(a0.y) + w1 * bfhi(a1.y));
            s += (v[j].x * v[j].x + v[j].y * v[j].y) + (v[j].z * v[j].z + v[j].w * v[j].w); }
        const float rstd = rsqrtf(wave_sum(s) * (1.f / DM) + EPS);
#pragma unroll
        for (int j = 0; j < 4; ++j) { const int k = 4 * F.lane + 256 * j; const f32x4 g = *(const f32x4*)(fg + k);
            orow[64 * j] = (f32x4){v[j].x * rstd * g.x, v[j].y * rstd * g.y, v[j].z * rstd * g.z, v[j].w * rstd * g.w}; }
    }
}
#ifndef LRU_FAST
#define LRU_FAST 1
#endif
#ifndef HG_FAST
#define HG_FAST 1
#endif
#define MIX_FAST (LRU_FAST && HG_FAST)
#ifdef PROBE_A
#define STAMP(k) do { if (F.bid == 0 && F.tid == 0) { const unsigned long long _t = __builtin_amdgcn_s_memrealtime(); F.MISC[32 + 2 * (k)] = (unsigned)_t; F.MISC[33 + 2 * (k)] = (unsigned)(_t >> 32); } } while (0)
#else
#define STAMP(k) do { } while (0)
#endif
__device__ __forceinline__ void p_mix1(Frame& F, const Args& a) {
#if LRU_FAST
    {
        const int h = (F.bid >> 4) & 7; int ch = h * 128 + 16 * F.wave + (F.lane & 15);
        const LruCoef kf = lru_coef(a, 0, ch), kb = lru_coef(a, 1, ch);
        for (int r = 0; r < 2; ++r) lru_unit(F, a, r * 256 + F.bid, kf, kb);
    }
#endif
    STAMP(14); STAMP(15);
#if HG_FAST
    { Frame Fh = F; { int t_ = threadIdx.x; asm volatile("" : "+v"(t_)); Fh.tid = t_; Fh.lane = t_ & 63; }
      for (int i = 0, u = F.bid; u < NB * 8 * 2 * 4; u += F.G, ++i) hg_pass1(Fh, a, (u & ~3) | ((u + 2 * i) & 3)); }
#endif
}
__device__ __forceinline__ void p_mix2(Frame& F, const Args& a) {
#if LRU_FAST
    {
        const int h = (F.bid >> 4) & 7; int ch = h * 128 + 16 * F.wave + (F.lane & 15);
        asm volatile("" : "+v"(ch));
        const LruCoef kf = lru_coef(a, 0, ch), kb = lru_coef(a, 1, ch);
        for (int r = 2; r < 4; ++r) lru_unit(F, a, r * 256 + F.bid, kf, kb);
    }
#endif
    STAMP(16); STAMP(17);
#if HG_FAST
    { Frame Fh = F; { int t_ = threadIdx.x; asm volatile("" : "+v"(t_)); Fh.tid = t_; Fh.lane = t_ & 63; }
      for (int u = F.bid; u < NB * 8 * 4; u += F.G) hg_pass2(Fh, a, u); }
#endif
}
__global__ void __launch_bounds__(NTHR, 2) mega(Args args) {
    extern __shared__ __attribute__((aligned(16))) unsigned char lds_raw[];
    Frame F;
    F.lds = (LAS unsigned char*)lds_raw; F.MISC = (volatile LAS unsigned*)(F.lds + LDSCTL_OFF);
    F.tid = threadIdx.x; F.lane = F.tid & 63; F.wave = __builtin_amdgcn_readfirstlane(F.tid >> 6);
    F.G = gridDim.x; F.bid = blockIdx.x; F.ws = args.ws; F.out = args.out; F.ctl = (unsigned*)(args.ws + WS_CTL);
    for (int u = F.tid; u < (LDS_BYTES - LDSCTL_OFF) / 4; u += NTHR) ((LAS unsigned*)(F.lds + LDSCTL_OFF))[u] = 0u;
    __syncthreads();
    XcdBarrier bar = xcd_barrier_post(F.ctl + CW_BAR + args.li * 3584, F.MISC + 8);
    const int lo = args.ph_lo, hi = args.ph_hi;
#define IN(k) (lo <= (k) && (k) < hi)
#define SEAM(k) do { if (IN(k) && IN((k) + 1)) xcd_barrier(bar); STAMP((k) + 1); if ((k) == 9) STAMP(11); } while (0)
    unsigned char* ws = F.ws;
#define REFRESH() do { int _t = threadIdx.x; asm volatile("" : "+v"(_t)); F.tid = _t; F.lane = _t & 63; } while (0)
    STAMP(0);
    if (IN(0)) { p0_prologue(F, args); } SEAM(0);
    REFRESH();
    if (IN(1)) { p1_norm(F, args); } SEAM(1);
    REFRESH();
    if (IN(2)) {
        SchedP2 S{F.G, F.bid, (const char*)F.out, (const char*)(ws + WS_WIN), (char*)(ws + WS_P), (char*)(ws + WS_PC)};
        EpiStoreBf16 E;
        gm::gemm_phase<SchedP2, EpiStoreBf16, false>(F.lds, DM, S, E);
    } SEAM(2);
    REFRESH();
    if (IN(3)) { p_mix1(F, args); } SEAM(3);
    REFRESH();
    if (IN(4)) { p_mix2(F, args); } SEAM(4); STAMP(6);
    REFRESH();
    if (IN(6)) {
        const int slot = (F.bid >> 3) % 3;
        EpiP5 E{(unsigned*)F.out + (size_t)F.bid * 32768, (const bf16*)(ws + WS_P + 7 * GS), (const bf16*)(ws + WS_P + 8 * GS)};
        if (slot == 0) { p_moe_weights13(F, args); p_moe_weights2(F, args, F.bid, F.G); __syncthreads(); }
        {
            SchedP5 S{F.bid, (const char*)(ws + WS_YAG), (const char*)(ws + WS_YBG), (const char*)(ws + WS_WPA), (const char*)(ws + WS_WPB), nullptr, (char*)(ws + WS_M), 0, slot == 1 ? 1 : 2};
            gm::gemm_phase<SchedP5, EpiP5, false>(F.lds, DM, S, E);
        }
        if (slot == 1) {
            __syncthreads(); p_moe_weights13(F, args); p_moe_weights2(F, args, F.bid, F.G); __syncthreads();
            SchedP5 S{F.bid, (const char*)(ws + WS_YAG), (const char*)(ws + WS_YBG), (const char*)(ws + WS_WPA), (const char*)(ws + WS_WPB), nullptr, (char*)(ws + WS_M), 1, 1};
            gm::gemm_phase<SchedP5, EpiP5, false>(F.lds, DM, S, E);
        }
        if (slot == 2) { __syncthreads(); p_moe_weights13(F, args); p_moe_weights2(F, args, F.bid, F.G); }
    } SEAM(6);
    if (IN(7)) {
        SchedP6 S{F.bid, (const char*)(ws + WS_M), (const char*)(ws + WS_WOUT), (char*)(ws + WS_X1)};
        EpiP6 E{args.in[IN_X], (const float*)(ws + WS_MOD)};
        gm::gemm_phase<SchedP6, EpiP6, false>(F.lds, DM, S, E);
    } SEAM(7);
    REFRESH();
    if (IN(8)) { p_norm2_route(F, args); } SEAM(8);
    REFRESH();
    if (IN(9)) {
        moe_table(F, (const int*)(F.ctl + CW_CNT));
        {
            SchedMoe1 S{F.G, F.bid, F.lane, F.MISC, (const int*)(ws + WS_LIST), (const char*)(ws + WS_HX2), (const char*)(ws + WS_W1T), (const char*)(ws + WS_W3T), (char*)(ws + WS_HH), F.ctl + CW_TILE};
            EpiMoe1 E{(char*)(ws + WS_HH)};
            gm::gemm_phase<SchedMoe1, EpiMoe1, true, true>(F.lds, DM, S, E);
        }
        {
            SchedMoe2 S{F.G, F.bid, F.lane, F.MISC, (const char*)(ws + WS_HH), (const char*)(ws + WS_W2T), (char*)(ws + WS_Y), F.ctl + CW_TILE, F.ctl + 2};
            EpiMoe2 E{(const int*)(ws + WS_LIST)};
            gm::gemm_phase<SchedMoe2, EpiMoe2, false, true>(F.lds, DEXP, S, E);
        }
    } SEAM(9);
    REFRESH();
    if (IN(11)) { p_final(F, args); }
#ifdef PROBE_A
    if (F.bid == 0 && F.tid == 0) {
        const unsigned long long tend = __builtin_amdgcn_s_memrealtime();
        F.MISC[32 + 2 * 12] = (unsigned)tend; F.MISC[33 + 2 * 12] = (unsigned)(tend >> 32);
        auto RD = [&](int k) { return ((unsigned long long)F.MISC[33 + 2 * k] << 32) | F.MISC[32 + 2 * k]; };
        auto T = [&](int k) { if (k >= 20) { const int i = k - 20; return ((unsigned long long)F.MISC[103 + 2 * i] << 32) | F.MISC[102 + 2 * i]; } if (k == 13) return RD(14) - RD(3); if (k == 15) return RD(16) - RD(4); return RD(k + 1) - RD(k); };
        const unsigned long long delay = T(PROBE_B) * 256ull;
        while (__builtin_amdgcn_s_memrealtime() - tend < delay) __builtin_amdgcn_s_sleep(32);
    }
#endif
#undef IN
#undef SEAM
}

#if !LRU_FAST
__global__ void k_conv_f(const bf16* P0, const bf16* PC0, const float* cw, const float* cb, float* Ub, int b) {
    int t = blockIdx.x; int Lseg = t < CTX ? CTX : SEQ; int lt = t < CTX ? t : t - CTX;
    const bf16* base = t < CTX ? PC0 + (size_t)b * CTX * DM : P0 + (size_t)b * SEQ * DM;
    for (int ch = threadIdx.x; ch < DM; ch += 256) {
        float s = cb[ch];
#pragma unroll
        for (int k = 0; k < 4; ++k) { int tt = lt + k - 2; if (tt >= 0 && tt < Lseg) s += cw[k * DM + ch] * bf2f(base[(size_t)tt * DM + ch]); }
        Ub[(size_t)t * DM + ch] = s;
    }
}
__global__ void k_gates(const float* Ub, const float* wa, const float* ba, const float* wx, const float* bx, const float* lam, float* Aout, float* Bout, int d) {
    __shared__ float us[128];
    int t = blockIdx.x, h = blockIdx.y, j = threadIdx.x; int ch = h * 128 + j;
    float uval = Ub[(size_t)t * DM + ch];
    us[j] = uval; __syncthreads();
    const float* wah = wa + ((size_t)(d * 8 + h) * 128) * 128; const float* wxh = wx + ((size_t)(d * 8 + h) * 128) * 128;
    float ra = 0.f, ia = 0.f;
    for (int i = 0; i < 128; ++i) { float u = us[i]; ra += u * wah[i * 128 + j]; ia += u * wxh[i * 128 + j]; }
    float r = 1.f / (1.f + expf(-(ra + ba[d * DM + ch]))); float ig = 1.f / (1.f + expf(-(ia + bx[d * DM + ch])));
    float sp = log1pf(expf(-lam[d * DM + ch]));
    float log_a = -8.f * r * sp;
    Aout[(size_t)t * DM + ch] = expf(log_a); Bout[(size_t)t * DM + ch] = sqrtf(-expm1f(2.f * log_a)) * (ig * uval);
}
__global__ void k_lru_scan(const float* A0, const float* B0, const float* A1, const float* B1, float* YF, float* YB) {
    int g = blockIdx.x * 256 + threadIdx.x; int d = g / DM, ch = g % DM;
    if (d == 0) { float h = B0[ch];
        for (int t = 0; t < SEQ; ++t) { size_t o = (size_t)(CTX + t) * DM + ch; h = A0[o] * h + B0[o]; YF[(size_t)t * DM + ch] = h; }
    } else { float h = B1[(size_t)(CTX - 1) * DM + ch];
        for (int t = SEQ - 1; t >= 0; --t) { size_t o = (size_t)(CTX + t) * DM + ch; h = A1[o] * h + B1[o]; YB[(size_t)t * DM + ch] = h; }
    }
}
__global__ void k_yag_f(const float* YF, const float* YB, bf16* AY, int b) {
    int t = blockIdx.x;
    for (int ch = threadIdx.x; ch < DM; ch += 256) { size_t o = (size_t)t * DM + ch; bf16* p = AY + ((size_t)b * SEQ + t) * DM + ch;
        *p = (bf16)f2bf((YF[o] + YB[o]) * gelu_tanh(bf2f(*p))); }
}
#endif
#if !HG_FAST
__global__ __launch_bounds__(128) void k_hgrn_f(unsigned char* ws, const float* hg_lb) {
    __shared__ float gs[128], ks[128], qs[128];
    int h = blockIdx.x, d = blockIdx.y, b = blockIdx.z, j = threadIdx.x;
    float S[128];
#pragma unroll
    for (int i = 0; i < 128; ++i) S[i] = 0.f;
    const int c = h * 128 + j;
    const float lbj = 1.f / (1.f + expf(hg_lb[DM + c] - hg_lb[c]));
    bf16* Q = (bf16*)(ws + WS_P + 2 * GS); bf16* Fx = (bf16*)(ws + WS_P + (d == 0 ? 3 : 4) * GS); bf16* V = (bf16*)(ws + WS_P + 5 * GS);
    const bf16* Fc = (const bf16*)(ws + WS_PC + (d == 0 ? 1 : 2) * CGS); const bf16* Vc = (const bf16*)(ws + WS_PC + 3 * CGS);
    for (int s = 0; s < LT; ++s) {
        bool isx = s >= CTX; float fv, vv, qv = 0.f; size_t o;
        if (!isx) { int t = d == 0 ? s : (CTX - 1 - s); o = ((size_t)b * CTX + t) * DM + c; fv = bf2f(Fc[o]); vv = bf2f(Vc[o]); }
        else { int p = s - CTX; if (d == 1) p = SEQ - 1 - p; int tok = (p % 32) * 64 + (p / 32); o = ((size_t)b * SEQ + tok) * DM + c; fv = bf2f(Fx[o]); vv = bf2f(V[o]); qv = bf2f(Q[o]); }
        float gg = lbj + (1.f - lbj) / (1.f + expf(-fv));
        gs[j] = gg; ks[j] = 1.f - gg; qs[j] = qv / (1.f + expf(-qv));
        __syncthreads();
        float oo = 0.f;
#pragma unroll
        for (int i = 0; i < 128; ++i) { S[i] = gs[i] * S[i] + ks[i] * vv; oo += S[i] * qs[i]; }
        if (isx) Fx[o] = (bf16)f2bf(oo);
        __syncthreads();
    }
}
#endif

extern "C" void kernel_launch(void* const* d_in, const int* in_sizes, int n_in, void* d_out, int out_size, void* d_ws, size_t ws_size, hipStream_t stream) {
    static int grid = 0;
    if (grid == 0) {
        if (n_in != 29 || out_size != NTOK * DM || ws_size < WS_END) { fprintf(stderr, "kernel_launch: unexpected problem shape / workspace (%d inputs, out %d, ws %zu)\n", n_in, out_size, ws_size); grid = -1; return; }
        int dev = 0, cus = 0, per_cu = 0;
        if (hipGetDevice(&dev) != hipSuccess || hipDeviceGetAttribute(&cus, hipDeviceAttributeMultiprocessorCount, dev) != hipSuccess) { grid = -1; return; }
        if (hipFuncSetAttribute((const void*)mega, hipFuncAttributeMaxDynamicSharedMemorySize, LDS_BYTES) != hipSuccess) { grid = -1; return; }
        if (hipOccupancyMaxActiveBlocksPerMultiprocessor(&per_cu, (const void*)mega, NTHR, LDS_BYTES) != hipSuccess || per_cu < 1) { fprintf(stderr, "kernel_launch: occupancy query says %d blocks per CU\n", per_cu); }
        (void)hipGetLastError();
        grid = cus;
        if (grid != 256) { fprintf(stderr, "kernel_launch: built for 256 CUs, found %d\n", cus); grid = -1; return; }
    }
    if (grid < 0) return;
    hipMemsetAsync((char*)d_ws + WS_CTL, 0, CTL_BYTES, stream);
    Args a{};
    for (int i = 0; i < 29; ++i) a.in[i] = (const float*)d_in[i];
    a.out = (float*)d_out; a.ws = (unsigned char*)d_ws;
#if MIX_FAST
    a.ph_lo = 0; a.ph_hi = 12; a.li = 0;
    hipLaunchKernelGGL(mega, dim3(grid), dim3(NTHR), LDS_BYTES, stream, a);
#else
    a.ph_lo = 0; a.ph_hi = 5; a.li = 0;
    hipLaunchKernelGGL(mega, dim3(grid), dim3(NTHR), LDS_BYTES, stream, a);
    {
        unsigned char* ws = (unsigned char*)d_ws;
#if !LRU_FAST
        float* sc = (float*)d_out;
        float* Ub = sc; float* A0 = Ub + (size_t)LT * DM; float* B0 = A0 + (size_t)LT * DM; float* A1 = B0 + (size_t)LT * DM; float* B1 = A1 + (size_t)LT * DM;
        float* YF = B1 + (size_t)LT * DM; float* YB = YF + (size_t)SEQ * DM;
        const float* cw = (const float*)d_in[IN_CONVW]; const float* cb = (const float*)d_in[IN_CONVB];
        const float* wa = (const float*)d_in[IN_WA]; const float* ba = (const float*)d_in[IN_BA]; const float* wx = (const float*)d_in[IN_WX]; const float* bx = (const float*)d_in[IN_BX]; const float* lam = (const float*)d_in[IN_LAM];
        for (int b = 0; b < NB; ++b) {
            k_conv_f<<<LT, 256, 0, stream>>>((const bf16*)(ws + WS_P), (const bf16*)(ws + WS_PC), cw, cb, Ub, b);
            k_gates<<<dim3(LT, 8), 128, 0, stream>>>(Ub, wa, ba, wx, bx, lam, A0, B0, 0);
            k_gates<<<dim3(LT, 8), 128, 0, stream>>>(Ub, wa, ba, wx, bx, lam, A1, B1, 1);
            k_lru_scan<<<8, 256, 0, stream>>>(A0, B0, A1, B1, YF, YB);
            k_yag_f<<<SEQ, 256, 0, stream>>>(YF, YB, (bf16*)(ws + WS_YAG), b);
        }
#endif
#if !HG_FAST
        k_hgrn_f<<<dim3(8, 2, NB), 128, 0, stream>>>(ws, (const float*)d_in[IN_HGLB]);
#endif
    }
    a.ph_lo = 5; a.ph_hi = 12; a.li = 1;
    hipLaunchKernelGGL(mega, dim3(grid), dim3(NTHR), LDS_BYTES, stream, a);
#endif
}
```
